# Optimizing an MI355X kernel written in HIP

```python
import math
import jax, jax.numpy as jnp
from jax import lax
import numpy as np

D_MODEL = 2048
BATCH = 8
SEQ = 4096
DEPTH = 4
DEC_BATCH = 1
DEC_SEQ = 8192
PAST_LEN = 128

MIX_WIDTH = D_MODEL
S5_WIDTH = MIX_WIDTH // 4
POOL_WIDTH = MIX_WIDTH // 4
RET_WIDTH = MIX_WIDTH // 2
S5_GROUP = 16
S5_GROUPS = S5_WIDTH // S5_GROUP
S5_STATE = 64
POOL_WINDOWS = (2, 4, 8, 16)
POOL_GROUP = POOL_WIDTH // len(POOL_WINDOWS)
RET_HEADS = 4
RET_HEAD_DIM = RET_WIDTH // RET_HEADS
RET_CHUNK = 128
IN_WIDTH = S5_WIDTH + POOL_WIDTH + 4 * RET_WIDTH
PEER_HEADS = 8
PEER_QDIM = 256
PEER_HALF = PEER_QDIM // 2
PEER_NKEYS = 128
PEER_EXPERTS = PEER_NKEYS * PEER_NKEYS
PEER_TOPK = 16
PEER_TOKEN_BLOCK = 128
ALPHA = (2 * DEPTH) ** 0.25
BETA = (8 * DEPTH) ** -0.25
LN_EPS = 1e-5
GN_EPS = 1e-6

kernel_name = 'hybrid_s5_pool_retention_peer_encoder'

F32 = jnp.float32


def layer_norm(x, g, b):
    xf = x.astype(F32)
    mu = jnp.mean(xf, axis=-1, keepdims=True)
    var = jnp.mean(jnp.square(xf - mu), axis=-1, keepdims=True)
    y = (xf - mu) * lax.rsqrt(var + LN_EPS) * g.astype(F32) + b.astype(F32)
    return y.astype(x.dtype)


def _cmul(ar, ai, br, bi):
    return ar * br - ai * bi, ar * bi + ai * br


def _lin_rec_combine(e1, e2):
    a1r, a1i, b1r, b1i = e1
    a2r, a2i, b2r, b2i = e2
    ar, ai = _cmul(a1r, a1i, a2r, a2i)
    br, bi = _cmul(a2r, a2i, b1r, b1i)
    return ar, ai, br + b2r, bi + b2i


def s5_direction(u, lam_re, lam_im, log_step, b_re, b_im, c_re, c_im, reverse):
    lr = lam_re.astype(F32)
    li = lam_im.astype(F32)
    dt = jnp.exp(log_step.astype(F32))[:, None]
    mag = jnp.exp(lr * dt)
    abar_r = mag * jnp.cos(li * dt)
    abar_i = mag * jnp.sin(li * dt)
    den = lr * lr + li * li
    zr = ((abar_r - 1.0) * lr + abar_i * li) / den
    zi = (abar_i * lr - (abar_r - 1.0) * li) / den
    bb_r, bb_i = _cmul(zr[..., None], zi[..., None], b_re.astype(F32), b_im.astype(F32))
    bu_r = jnp.einsum('gpc,blgc->blgp', bb_r, u)
    bu_i = jnp.einsum('gpc,blgc->blgp', bb_i, u)
    a_r = jnp.broadcast_to(abar_r, bu_r.shape)
    a_i = jnp.broadcast_to(abar_i, bu_i.shape)
    _, _, xr, xi = lax.associative_scan(_lin_rec_combine, (a_r, a_i, bu_r, bu_i), reverse=reverse, axis=1)
    return jnp.einsum('gcp,blgp->blgc', c_re.astype(F32), xr) - jnp.einsum('gcp,blgp->blgc', c_im.astype(F32), xi)


def s5_mixer(u, lam_re, lam_im, log_step, b_re, b_im, c_re, c_im, d, w_glu, b_glu):
    bsz, L, _ = u.shape
    uf = u.astype(F32)
    ug = uf.reshape(bsz, L, S5_GROUPS, S5_GROUP)
    y = (s5_direction(ug, lam_re[0], lam_im[0], log_step[0], b_re[0], b_im[0], c_re[0], c_im[0], False)
         + s5_direction(ug, lam_re[1], lam_im[1], log_step[1], b_re[1], b_im[1], c_re[1], c_im[1], True))
    y = y.reshape(bsz, L, S5_WIDTH) + d.astype(F32) * uf
    y = jax.nn.gelu(y, approximate=False)
    return y * jax.nn.sigmoid(y @ w_glu.astype(F32) + b_glu.astype(F32))


def pool_mixer(u, pool_w, pool_scale):
    bsz, L, _ = u.shape
    uf = u.astype(F32)
    cs = jnp.concatenate([jnp.zeros((bsz, 1, POOL_WIDTH), F32), jnp.cumsum(uf, axis=1)], axis=1)
    t = np.arange(L)
    outs = []
    for gi, w in enumerate(POOL_WINDOWS):
        lo = np.maximum(t - w // 2, 0)
        hi = np.minimum(t + w // 2 - 1, L - 1)
        cnt = (hi - lo + 1).astype(np.float32)
        sl = slice(gi * POOL_GROUP, (gi + 1) * POOL_GROUP)
        csg = cs[:, :, sl]
        mean = (csg[:, hi + 1] - csg[:, lo]) / cnt[None, :, None]
        outs.append(mean - uf[:, :, sl])
    p = jnp.stack(outs, axis=2)
    p = jnp.einsum('blgc,gcd->blgd', p, pool_w.astype(F32)).reshape(bsz, L, POOL_WIDTH)
    return p * pool_scale.astype(F32)


def rotary(x):
    L = x.shape[1]
    half = RET_HEAD_DIM // 2
    inv = 1.0 / (10000.0 ** jnp.linspace(0.0, 1.0, half, dtype=F32))
    ang = jnp.arange(L, dtype=F32)[:, None] * inv[None, :]
    cos = jnp.cos(ang)[:, None, :]
    sin = jnp.sin(ang)[:, None, :]
    x1, x2 = x[..., :half], x[..., half:]
    return jnp.concatenate([x1 * cos - x2 * sin, x2 * cos + x1 * sin], axis=-1)


def retention_mixer(q, k, v, g):
    bsz, L, _ = q.shape
    nc = L // RET_CHUNK
    B = RET_CHUNK
    q = rotary(q.astype(F32).reshape(bsz, L, RET_HEADS, RET_HEAD_DIM))
    k = rotary(k.astype(F32).reshape(bsz, L, RET_HEADS, RET_HEAD_DIM)) * (RET_HEAD_DIM ** -0.5)
    v = v.astype(F32).reshape(bsz, L, RET_HEADS, RET_HEAD_DIM)

    def to_chunks(t):
        return t.reshape(bsz, nc, B, RET_HEADS, RET_HEAD_DIM).transpose(1, 0, 3, 2, 4)

    qc, kc, vc = to_chunks(q), to_chunks(k), to_chunks(v)
    log_gamma = jnp.log(1.0 - 2.0 ** (-5.0 - jnp.arange(RET_HEADS, dtype=F32)))
    pos = jnp.arange(B, dtype=F32)
    lg = log_gamma[:, None]
    decay_intra = jnp.exp(log_gamma[:, None, None] * jnp.abs(pos[:, None] - pos[None, :]))
    scores = jnp.einsum('cbhid,cbhjd->cbhij', qc, kc) * decay_intra
    o = jnp.einsum('cbhij,cbhje->cbhie', scores, vc)
    q_fwd = jnp.exp(lg * (pos + 1.0))[:, :, None]
    k_fwd = jnp.exp(lg * (B - 1.0 - pos))[:, :, None]
    q_bwd = jnp.exp(lg * (B - pos))[:, :, None]
    k_bwd = jnp.exp(lg * pos)[:, :, None]
    chunk_decay = jnp.exp(log_gamma * B)[:, None, None]

    def make_step(qd, kd):
        def step(state, inp):
            qi, ki, vi = inp
            out = jnp.einsum('bhid,bhde->bhie', qi * qd, state)
            state = chunk_decay * state + jnp.einsum('bhjd,bhje->bhde', ki * kd, vi)
            return state, out
        return step

    s0 = jnp.zeros((bsz, RET_HEADS, RET_HEAD_DIM, RET_HEAD_DIM), F32)
    _, o_f = lax.scan(make_step(q_fwd, k_fwd), s0, (qc, kc, vc))
    _, o_b = lax.scan(make_step(q_bwd, k_bwd), s0, (qc, kc, vc), reverse=True)
    o = (o + o_f + o_b).transpose(1, 0, 3, 2, 4).reshape(bsz, L, RET_HEADS, RET_HEAD_DIM)
    mu = jnp.mean(o, axis=-1, keepdims=True)
    var = jnp.mean(jnp.square(o - mu), axis=-1, keepdims=True)
    o = ((o - mu) * lax.rsqrt(var + GN_EPS)).reshape(bsz, L, RET_WIDTH)
    return jax.nn.silu(g.astype(F32)) * o


def peer_ffn(x, w_q, sub_keys, u_tab, v_tab):
    bsz, L, D = x.shape
    q = (x @ w_q).astype(F32).reshape(bsz, L, PEER_HEADS, 2, PEER_HALF)
    s = jnp.einsum('blhpc,pnc->blhpn', q, sub_keys.astype(F32))
    top_s, top_i = lax.top_k(s, PEER_TOPK)
    cand = top_s[..., 0, :, None] + top_s[..., 1, None, :]
    cand_idx = top_i[..., 0, :, None] * PEER_NKEYS + top_i[..., 1, None, :]
    cand = cand.reshape(bsz, L, PEER_HEADS, PEER_TOPK * PEER_TOPK)
    cand_idx = cand_idx.reshape(bsz, L, PEER_HEADS, PEER_TOPK * PEER_TOPK)
    best_s, best_pos = lax.top_k(cand, PEER_TOPK)
    idx = jnp.take_along_axis(cand_idx, best_pos, axis=-1)
    gates = jax.nn.softmax(best_s, axis=-1)
    n_tok = bsz * L
    nb = n_tok // PEER_TOKEN_BLOCK
    xb = x.reshape(nb, PEER_TOKEN_BLOCK, D)
    ib = idx.reshape(nb, PEER_TOKEN_BLOCK, PEER_HEADS * PEER_TOPK)
    gb = gates.reshape(nb, PEER_TOKEN_BLOCK, PEER_HEADS * PEER_TOPK).astype(x.dtype)

    def block(args):
        xt, it, gt = args
        u = jnp.take(u_tab, it, axis=0)
        hdn = jax.nn.gelu(jnp.einsum('td,tkd->tk', xt, u), approximate=False)
        vv = jnp.take(v_tab, it, axis=0)
        return jnp.einsum('tk,tkd->td', gt * hdn, vv)

    out = lax.map(block, (xb, ib, gb))
    return out.reshape(bsz, L, D)


def encoder_layer(x, p, l):
    h = x @ p['w_in'][l]
    r0 = S5_WIDTH + POOL_WIDTH
    u_a = h[..., :S5_WIDTH]
    u_b = h[..., S5_WIDTH:r0]
    q = h[..., r0:r0 + RET_WIDTH]
    k = h[..., r0 + RET_WIDTH:r0 + 2 * RET_WIDTH]
    v = h[..., r0 + 2 * RET_WIDTH:r0 + 3 * RET_WIDTH]
    g = h[..., r0 + 3 * RET_WIDTH:r0 + 4 * RET_WIDTH]
    y_a = s5_mixer(u_a, p['s5_lambda_re'][l], p['s5_lambda_im'][l], p['s5_log_step'][l],
                   p['s5_b_re'][l], p['s5_b_im'][l], p['s5_c_re'][l], p['s5_c_im'][l],
                   p['s5_d'][l], p['s5_w_glu'][l], p['s5_b_glu'][l])
    y_b = pool_mixer(u_b, p['pool_w'][l], p['pool_scale'][l])
    y_c = retention_mixer(q, k, v, g)
    mix = jnp.concatenate([y_a.astype(x.dtype), y_b.astype(x.dtype), y_c.astype(x.dtype)], axis=-1) @ p['w_out'][l]
    x = layer_norm(ALPHA * x + mix, p['ln1_g'][l], p['ln1_b'][l])
    ff = peer_ffn(x, p['peer_w_q'][l], p['peer_sub_keys'][l], p['peer_u'][l], p['peer_v'][l])
    x = layer_norm(ALPHA * x + ff.astype(x.dtype), p['ln2_g'][l], p['ln2_b'][l])
    return x


def trunk(x, p):
    x = layer_norm(x, p['ln_in_g'], p['ln_in_b'])
    for l in range(DEPTH):
        x = encoder_layer(x, p, l)
    return x


def setup_inputs(seed: int = 0) -> dict:
    key = jax.random.key(seed)
    ks = jax.random.split(key, 32)
    n = jax.random.normal
    G, P, C = S5_GROUPS, S5_STATE, S5_GROUP
    lam_im_base = math.pi * jnp.arange(P, dtype=F32)
    return {
        'x_prompt': n(ks[0], (BATCH, SEQ, D_MODEL), F32),
        'x_sample': n(ks[1], (DEC_BATCH, DEC_SEQ, D_MODEL), F32),
        'ln_in_g': 1.0 + 0.02 * n(ks[2], (D_MODEL,), F32),
        'ln_in_b': 0.02 * n(ks[3], (D_MODEL,), F32),
        'w_in': n(ks[4], (DEPTH, D_MODEL, IN_WIDTH), F32) * D_MODEL ** -0.5,
        's5_lambda_re': -0.5 + 0.01 * n(ks[5], (DEPTH, 2, G, P), F32),
        's5_lambda_im': lam_im_base + 0.01 * n(ks[6], (DEPTH, 2, G, P), F32),
        's5_log_step': jax.random.uniform(ks[7], (DEPTH, 2, G), F32, math.log(1e-3), math.log(1e-1)),
        's5_b_re': n(ks[8], (DEPTH, 2, G, P, C), F32) * (2 * C) ** -0.5,
        's5_b_im': n(ks[9], (DEPTH, 2, G, P, C), F32) * (2 * C) ** -0.5,
        's5_c_re': n(ks[10], (DEPTH, 2, G, C, P), F32) * P ** -0.5,
        's5_c_im': n(ks[11], (DEPTH, 2, G, C, P), F32) * P ** -0.5,
        's5_d': n(ks[12], (DEPTH, S5_WIDTH), F32),
        's5_w_glu': n(ks[13], (DEPTH, S5_WIDTH, S5_WIDTH), F32) * S5_WIDTH ** -0.5,
        's5_b_glu': 0.01 * n(ks[14], (DEPTH, S5_WIDTH), F32),
        'pool_w': n(ks[15], (DEPTH, len(POOL_WINDOWS), POOL_GROUP, POOL_GROUP), F32) * POOL_GROUP ** -0.5,
        'pool_scale': 1.0 + 0.02 * n(ks[16], (DEPTH, POOL_WIDTH), F32),
        'w_out': n(ks[17], (DEPTH, MIX_WIDTH, D_MODEL), F32) * (MIX_WIDTH ** -0.5 * BETA),
        'ln1_g': 1.0 + 0.02 * n(ks[18], (DEPTH, D_MODEL), F32),
        'ln1_b': 0.02 * n(ks[19], (DEPTH, D_MODEL), F32),
        'peer_w_q': n(ks[20], (DEPTH, D_MODEL, PEER_HEADS * PEER_QDIM), F32) * D_MODEL ** -0.5,
        'peer_sub_keys': n(ks[21], (DEPTH, 2, PEER_NKEYS, PEER_HALF), F32) * PEER_HALF ** -0.5,
        'peer_u': n(ks[22], (DEPTH, PEER_EXPERTS, D_MODEL), F32) * D_MODEL ** -0.5,
        'peer_v': n(ks[23], (DEPTH, PEER_EXPERTS, D_MODEL), F32) * (BETA * PEER_HEADS ** -0.5),
        'ln2_g': 1.0 + 0.02 * n(ks[24], (DEPTH, D_MODEL), F32),
        'ln2_b': 0.02 * n(ks[25], (DEPTH, D_MODEL), F32),
    }


def reference(x_prompt, x_sample, ln_in_g, ln_in_b, w_in, s5_lambda_re, s5_lambda_im, s5_log_step,
              s5_b_re, s5_b_im, s5_c_re, s5_c_im, s5_d, s5_w_glu, s5_b_glu, pool_w, pool_scale,
              w_out, ln1_g, ln1_b, peer_w_q, peer_sub_keys, peer_u, peer_v, ln2_g, ln2_b):
    p = dict(ln_in_g=ln_in_g, ln_in_b=ln_in_b, w_in=w_in, s5_lambda_re=s5_lambda_re,
             s5_lambda_im=s5_lambda_im, s5_log_step=s5_log_step, s5_b_re=s5_b_re, s5_b_im=s5_b_im,
             s5_c_re=s5_c_re, s5_c_im=s5_c_im, s5_d=s5_d, s5_w_glu=s5_w_glu, s5_b_glu=s5_b_glu,
             pool_w=pool_w, pool_scale=pool_scale, w_out=w_out, ln1_g=ln1_g, ln1_b=ln1_b,
             peer_w_q=peer_w_q, peer_sub_keys=peer_sub_keys, peer_u=peer_u, peer_v=peer_v,
             ln2_g=ln2_g, ln2_b=ln2_b)
    y_prompt = trunk(x_prompt, p)
    y_sample = trunk(x_sample, p)
    return (y_prompt, y_sample)
```

```cpp
#include <hip/hip_runtime.h>
#include <cstdio>
#include <cstdint>
#include <cmath>
__device__ __forceinline__ int opaque(int v) { asm volatile("" : "+v"(v)); return v; }
__device__ __forceinline__ int opaque_s(int v) { asm volatile("" : "+s"(v)); return v; }
#define MK_ONE_LAUNCH 0
namespace pg8 {
#define PG8_LAS __attribute__((address_space(3)))
typedef unsigned short bf16_t;
typedef short bf16x8 __attribute__((ext_vector_type(8)));
typedef float f32x4 __attribute__((ext_vector_type(4)));
typedef unsigned u32x4 __attribute__((ext_vector_type(4)));
constexpr int BM = 256, BK = 64, HALF = 128, HTB = HALF * BK * 2  , STAGE_BYTES = 8 * HTB, NXCD = 8, WGM = 8;

__host__ __device__ __forceinline__ int lds_byte(int r, int c) { const int st = (r >> 4) * 2 + (c >> 5), rr = r & 15, cc = c & 31, ob = rr * 64 + cc * 2; return st * 1024 + (ob ^ (((ob >> 9) & 1) << 5)); }
__host__ __device__ __forceinline__ void stage_rc(int b, int& R, int& C) { const int st = b / 1024, sb = b % 1024, swz = sb ^ (((sb >> 9) & 1) << 5); R = (st >> 1) * 16 + swz / 64; C = (st & 1) * 32 + (swz % 64) / 2; }
__host__ __device__ __forceinline__ int perm32(int rho) { const int n = rho >> 4, i = rho & 15; return 8 * (i >> 2) + 4 * n + (i & 3); }

struct Unit { int pm, pn; };
struct Gemm { const bf16_t* A; const bf16_t* Bt; int M, N, K; };

struct StaticOrder {
    int nM, nN, nwg, G, c;
    __host__ __device__ void init(int M, int N, int G_, int c_) { nM = M / BM; nN = N / BM; nwg = nM * nN; G = G_; c = c_; }
    __host__ __device__ bool next(int i, Unit& u) const {
        const long L = (long)i * G + c; if (L >= nwg) return false;
        int wgid = (int)L; { const int q = nwg / NXCD, r = nwg % NXCD, xcd = wgid % NXCD, off = wgid / NXCD; wgid = (xcd < r ? xcd * (q + 1) : r * (q + 1) + (xcd - r) * q) + off; }
        const int nig = WGM * nN, gid = wgid / nig, fm = gid * WGM, gsz = (nM - fm) < WGM ? (nM - fm) : WGM;
        u.pm = fm + ((wgid % nig) % gsz); u.pn = (wgid % nig) / gsz; return true;
    }
    __device__ __forceinline__ void a_ready(const Unit&) const {}
    __device__ __forceinline__ void done(const Unit&) const {}
};
__device__ __forceinline__ unsigned cvt_pk_bf16(float lo, float hi) { unsigned r; asm volatile("v_cvt_pk_bf16_f32 %0, %1, %2" : "=v"(r) : "v"(lo), "v"(hi)); return r; }
typedef float f32x2 __attribute__((ext_vector_type(2)));
template <class Epi, class Sched, bool ALIGN_EPI = false, bool SP2 = false>
__device__ __forceinline__ void gemm_phase(PG8_LAS unsigned char* lds, const Gemm g, const Sched& S, const Epi& E) {
    const int tid = opaque((int)threadIdx.x), wid = __builtin_amdgcn_readfirstlane(tid >> 6), lane = tid & 63, wr = wid >> 2, wc = wid & 3, fr = lane & 15, fq = lane >> 4;
    const int K = g.K, nt = K / BK;
    unsigned voffA[2], voffB[2];
#pragma unroll
    for (int i = 0; i < 2; ++i) { int R, C; stage_rc(tid * 16 + i * 8192, R, C); const int Rb = Epi::PERM ? ((R & ~31) + perm32(R & 31)) : R;
        voffA[i] = (unsigned)(R * K + C) * 2u; voffB[i] = (unsigned)(Rb * K + C) * 2u; }
    const size_t kstep = (size_t)(BK * 2);
    const size_t hstep = (size_t)HALF * K * 2;
    const size_t tstep = 2 * hstep;
    const unsigned ldsw = (unsigned)wid * 1024u;
    const int aoff = lds_byte(wr * 64 + fr, fq * 8), boff = lds_byte(wc * 32 + fr, fq * 8);
#define PG8_SA(b, h) (((b) * 2 + (h)) * HTB)
#define PG8_SB(b, h) ((4 + (b) * 2 + (h)) * HTB)
#define PG8_STAGE(bufoff, gbase, voff) do { _Pragma("unroll") for (int _i = 0; _i < 2; ++_i) \
        __builtin_amdgcn_global_load_lds((const unsigned*)((const char*)(gbase) + (voff)[_i]), (PG8_LAS unsigned*)(lds + (bufoff) + ldsw + _i * 8192), 16, 0, 0); } while (0)
#define PG8_LDA(dst, b, h) do { _Pragma("unroll") for (int m = 0; m < 4; ++m) _Pragma("unroll") for (int k = 0; k < 2; ++k) dst[m][k] = *(const PG8_LAS bf16x8*)(lds + PG8_SA(b, h) + aoff + m * 2048 + k * 1024); } while (0)
#define PG8_LDB(dst, b, h) do { _Pragma("unroll") for (int n = 0; n < 2; ++n) _Pragma("unroll") for (int k = 0; k < 2; ++k) dst[n][k] = *(const PG8_LAS bf16x8*)(lds + PG8_SB(b, h) + boff + n * 2048 + k * 1024); } while (0)
#define PG8_MMA(ai, bj, At, Bt) do { __builtin_amdgcn_s_setprio(1); _Pragma("unroll") for (int m = 0; m < 4; ++m) _Pragma("unroll") for (int n = 0; n < 2; ++n) _Pragma("unroll") for (int k = 0; k < 2; ++k) \
        acc[ai][bj][m][n] = __builtin_amdgcn_mfma_f32_16x16x32_bf16(Bt[n][k], At[m][k], acc[ai][bj][m][n], 0, 0, 0); __builtin_amdgcn_s_setprio(0); } while (0)
#define PG8_WAIT_V(n) asm volatile("s_waitcnt vmcnt(" #n ")" ::: "memory")
#define PG8_WAIT_L(n) asm volatile("s_waitcnt lgkmcnt(" #n ")" ::: "memory")
#define PG8_BAR __builtin_amdgcn_s_barrier()
#define PG8_SCHED __builtin_amdgcn_sched_barrier(0)
    Unit cur, nxt; int ui = 0;
    if (!S.next(0, cur)) return;
    f32x4 acc[2][2][4][2];
#pragma unroll
    for (int a = 0; a < 2; ++a)
#pragma unroll
        for (int b = 0; b < 2; ++b)
#pragma unroll
            for (int m = 0; m < 4; ++m)
#pragma unroll
                for (int n = 0; n < 2; ++n) acc[a][b][m][n] = (f32x4){0.f, 0.f, 0.f, 0.f};
    bf16x8 At[4][2], B0[2][2], B1[2][2];
    const char* cA = (const char*)g.A + (size_t)cur.pm * tstep; const char* cB = (const char*)g.Bt + (size_t)cur.pn * tstep;
    S.a_ready(cur);
    if constexpr (SP2) {
        PG8_STAGE(PG8_SB(0, 0), cB, voffB); PG8_STAGE(PG8_SB(0, 1), cB + hstep, voffB); PG8_STAGE(PG8_SA(0, 0), cA, voffA); PG8_STAGE(PG8_SA(0, 1), cA + hstep, voffA);
        if (wr == 1) PG8_BAR;
        PG8_WAIT_V(2); PG8_BAR;
        PG8_STAGE(PG8_SB(1, 0), cB + kstep, voffB); PG8_STAGE(PG8_SA(1, 0), cA + kstep, voffA); PG8_STAGE(PG8_SB(1, 1), cB + hstep + kstep, voffB);
        PG8_WAIT_V(6); PG8_BAR;
    } else {
        PG8_STAGE(PG8_SB(0, 0), cB, voffB); PG8_STAGE(PG8_SA(0, 0), cA, voffA); PG8_STAGE(PG8_SB(0, 1), cB + hstep, voffB); PG8_STAGE(PG8_SA(0, 1), cA + hstep, voffA);
        if (wr == 1) PG8_BAR;
        PG8_WAIT_V(4); PG8_BAR;
        PG8_STAGE(PG8_SB(1, 0), cB + kstep, voffB); PG8_STAGE(PG8_SA(1, 0), cA + kstep, voffA); PG8_STAGE(PG8_SB(1, 1), cB + hstep + kstep, voffB);
        PG8_WAIT_V(6); PG8_BAR;
    }
    for (;;) {
        const bool has_next = S.next(ui + 1, nxt);
        const char* nA = has_next ? (const char*)g.A + (size_t)nxt.pm * tstep : cA; const char* nB = has_next ? (const char*)g.Bt + (size_t)nxt.pn * tstep : cB;
        for (int t = 0; t < nt; t += 2) {
            const bool last = (t == nt - 2);
            const char* a1 = cA + (size_t)(t + 1) * kstep;
            const char* a2 = last ? nA : cA + (size_t)(t + 2) * kstep; const char* b2 = last ? nB : cB + (size_t)(t + 2) * kstep;
            const char* a3 = a2 + kstep; const char* b3 = b2 + kstep;
            if (last && has_next) S.a_ready(nxt);
            if constexpr (SP2) {
            PG8_LDB(B0, 0, 0); PG8_LDB(B1, 0, 1); PG8_SCHED; PG8_LDA(At, 0, 0); PG8_STAGE(PG8_SA(1, 1), a1 + hstep, voffA);
            PG8_WAIT_V(8); PG8_WAIT_L(0); PG8_BAR; PG8_MMA(0, 0, At, B0); PG8_MMA(0, 1, At, B1); PG8_BAR; PG8_SCHED;
            PG8_LDA(At, 0, 1); PG8_STAGE(PG8_SB(0, 0), b2, voffB); PG8_STAGE(PG8_SB(0, 1), b2 + hstep, voffB); PG8_STAGE(PG8_SA(0, 0), a2, voffA);
            PG8_WAIT_V(8); PG8_WAIT_L(0); PG8_BAR; PG8_MMA(1, 0, At, B0); PG8_MMA(1, 1, At, B1); PG8_BAR; PG8_SCHED;
            PG8_LDB(B0, 1, 0); PG8_LDB(B1, 1, 1); PG8_SCHED; PG8_LDA(At, 1, 0); PG8_STAGE(PG8_SA(0, 1), a2 + hstep, voffA);
            PG8_WAIT_V(8); PG8_WAIT_L(0); PG8_BAR; PG8_MMA(0, 0, At, B0); PG8_MMA(0, 1, At, B1); PG8_BAR; PG8_SCHED;
            PG8_LDA(At, 1, 1); PG8_STAGE(PG8_SB(1, 0), b3, voffB); PG8_STAGE(PG8_SB(1, 1), b3 + hstep, voffB); PG8_STAGE(PG8_SA(1, 0), a3, voffA);
            PG8_WAIT_V(8); PG8_WAIT_L(0); PG8_BAR; PG8_MMA(1, 0, At, B0); PG8_MMA(1, 1, At, B1); PG8_BAR; PG8_SCHED;
            } else {
            PG8_LDB(B0, 0, 0); PG8_SCHED; PG8_LDA(At, 0, 0); PG8_STAGE(PG8_SA(1, 1), a1 + hstep, voffA);
            PG8_WAIT_L(8); PG8_BAR; PG8_WAIT_L(0); PG8_MMA(0, 0, At, B0); PG8_BAR; PG8_SCHED;
            PG8_LDB(B1, 0, 1); PG8_STAGE(PG8_SB(0, 0), b2, voffB);
            PG8_BAR; PG8_WAIT_L(0); PG8_MMA(0, 1, At, B1); PG8_BAR;
            PG8_LDA(At, 0, 1); PG8_STAGE(PG8_SA(0, 0), a2, voffA);
            PG8_BAR; PG8_WAIT_L(0); PG8_MMA(1, 0, At, B0); PG8_BAR; PG8_SCHED;
            PG8_STAGE(PG8_SB(0, 1), b2 + hstep, voffB);
            PG8_WAIT_V(6); PG8_BAR; PG8_MMA(1, 1, At, B1); PG8_BAR;
            PG8_LDB(B0, 1, 0); PG8_SCHED; PG8_LDA(At, 1, 0); PG8_STAGE(PG8_SA(0, 1), a2 + hstep, voffA);
            PG8_WAIT_L(8); PG8_BAR; PG8_WAIT_L(0); PG8_MMA(0, 0, At, B0); PG8_BAR; PG8_SCHED;
            PG8_LDB(B1, 1, 1); PG8_STAGE(PG8_SB(1, 0), b3, voffB);
            PG8_BAR; PG8_WAIT_L(0); PG8_MMA(0, 1, At, B1); PG8_BAR;
            PG8_LDA(At, 1, 1); PG8_STAGE(PG8_SA(1, 0), a3, voffA);
            PG8_BAR; PG8_WAIT_L(0); PG8_MMA(1, 0, At, B0); PG8_BAR; PG8_SCHED;
            PG8_STAGE(PG8_SB(1, 1), b3 + hstep, voffB);
            PG8_WAIT_V(6); PG8_BAR; PG8_MMA(1, 1, At, B1); PG8_BAR;
            }
        }
        if constexpr (ALIGN_EPI) { if (wr == 0) PG8_BAR; }
        if constexpr (!Epi::AFTER_DRAIN) { E(acc, cur, wr, wc, fr, fq); S.done(cur); }
        if (!has_next) break;
#pragma unroll
        for (int a = 0; a < 2; ++a)
#pragma unroll
            for (int b = 0; b < 2; ++b)
#pragma unroll
                for (int m = 0; m < 4; ++m)
#pragma unroll
                    for (int n = 0; n < 2; ++n) acc[a][b][m][n] = (f32x4){0.f, 0.f, 0.f, 0.f};
        cur = nxt; cA = nA; cB = nB; ++ui;
        if constexpr (ALIGN_EPI) { if (wr == 1) PG8_BAR; }
    }
    PG8_WAIT_V(0);
    if constexpr (!ALIGN_EPI) { if (wr == 0) PG8_BAR; }
    PG8_BAR;
    if constexpr (Epi::AFTER_DRAIN) { E.fused(acc, cur, wr, wc, fr, fq, lds, wid, lane); S.done(cur); }
#undef PG8_SA
#undef PG8_SB
#undef PG8_STAGE
#undef PG8_LDA
#undef PG8_LDB
#undef PG8_MMA
#undef PG8_WAIT_V
#undef PG8_WAIT_L
#undef PG8_BAR
#undef PG8_SCHED
}
}
#define LAS __attribute__((address_space(3)))
#define XB_TMO      128
#define XB_XCNT(j)  (256  + 64 * (j))
#define XB_XSUB(j)  (1280 + 64 * (j))
#define XB_XGEN(j)  (2304 + 64 * (j))
#define XB_TOP      3328
#define XB_TOPGEN   3392
#define XCD_BAR_WORDS 3456
#define XB_SPIN_CAP (1u << 18)

__device__ __forceinline__ unsigned xb_ld(unsigned* p)              { return __hip_atomic_load(p, __ATOMIC_RELAXED, __HIP_MEMORY_SCOPE_AGENT); }
__device__ __forceinline__ unsigned xb_add(unsigned* p, unsigned v) { return __hip_atomic_fetch_add(p, v, __ATOMIC_RELAXED, __HIP_MEMORY_SCOPE_AGENT); }
__device__ __forceinline__ unsigned xb_xcc_id() { return (unsigned)__builtin_amdgcn_s_getreg((3 << 11) | 20) & 0xFu; }
#define XB_SPIN(cond, bar) do { unsigned _sp = 0; while (cond) { __builtin_amdgcn_s_sleep(1); \
    if ((++_sp & 255u) == 0u) { if (xb_ld(&(bar)[XB_TMO])) break; if (_sp > XB_SPIN_CAP) { atomicAdd(&(bar)[XB_TMO], 1u); break; } } } } while (0)

struct XcdBarrier {
    unsigned* bar; unsigned x;
    volatile LAS unsigned* st;
};

__device__ __forceinline__ XcdBarrier xcd_barrier_post(unsigned* bar, volatile LAS unsigned* st) {
    XcdBarrier b; b.bar = bar; b.x = xb_xcc_id(); b.st = st;
    if (threadIdx.x == 0) (void)xb_add(&bar[XB_XCNT(b.x)], 1u);
    return b;
}
__device__ __forceinline__ void xcd_barrier_complete(unsigned* bar, unsigned x, unsigned& nloc, unsigned& nx) {
    const unsigned G = gridDim.x * gridDim.y * gridDim.z;
    unsigned sum, cnt, mine, sp = 0u;
    for (;;) {
        sum = 0u; cnt = 0u; mine = 0u;
#pragma unroll
        for (unsigned j = 0; j < 16; ++j) { const unsigned c = xb_ld(&bar[XB_XCNT(j)]); sum += c; cnt += (c > 0u) ? 1u : 0u; mine = (j == x) ? c : mine; }
        if (sum == G) break;
        __builtin_amdgcn_s_sleep(1);
        if ((++sp & 255u) == 0u) { if (xb_ld(&bar[XB_TMO])) break; if (sp > XB_SPIN_CAP) { atomicAdd(&bar[XB_TMO], 1u); break; } }
    }
    nloc = mine > 0u ? mine : 1u; nx = cnt > 0u ? cnt : 1u;
}

__device__ __forceinline__ void xcd_barrier(const XcdBarrier& b) {
    asm volatile("s_waitcnt vmcnt(0)" ::: "memory");
    __syncthreads();
    if (threadIdx.x == 0) {
        unsigned* bar = b.bar;
        __builtin_amdgcn_s_waitcnt(0);
        unsigned nloc = b.st[0], nx = b.st[1];
        if (nloc == 0u) { xcd_barrier_complete(bar, b.x, nloc, nx); b.st[0] = nloc; b.st[1] = nx; }
        const unsigned old = xb_add(&bar[XB_XSUB(b.x)], 1u);
        const unsigned gen = old / nloc;
        if (old + 1u == (gen + 1u) * nloc) {
            __builtin_amdgcn_fence(__ATOMIC_RELEASE, "agent");
            asm volatile("s_waitcnt vmcnt(0)" ::: "memory");
            const unsigned og = xb_add(&bar[XB_TOP], 1u);
            const unsigned tg = og / nx;
            if (og + 1u == (tg + 1u) * nx) xb_add(&bar[XB_TOPGEN], 1u);
            else XB_SPIN(xb_ld(&bar[XB_TOPGEN]) == tg, bar);
            __builtin_amdgcn_fence(__ATOMIC_ACQUIRE, "agent");
            xb_add(&bar[XB_XGEN(b.x)], 1u);
            asm volatile("s_waitcnt vmcnt(0)" ::: "memory");
        } else {
            XB_SPIN(xb_ld(&bar[XB_XGEN(b.x)]) == gen, bar);
            __builtin_amdgcn_fence(__ATOMIC_ACQUIRE, "agent");
            asm volatile("s_waitcnt vmcnt(0)" ::: "memory");
        }
    }
    __syncthreads();
}
#undef LAS
using pg8::bf16x8; using pg8::f32x4; using pg8::u32x4; using pg8::f32x2;
#define GAS __attribute__((address_space(1)))
#define LAS __attribute__((address_space(3)))
typedef unsigned short bf16;
typedef unsigned v4u __attribute__((ext_vector_type(4)));
typedef unsigned v2u __attribute__((ext_vector_type(2)));
typedef float f32x2v __attribute__((ext_vector_type(2)));

constexpr int NTOK = 40960, DM = 2048, NLAYER = 4, INW = 5120;
constexpr int COL_UA = 0, COL_UB = 512, COL_Q = 1024, COL_K = 2048, COL_V = 3072, COL_G = 4096;
constexpr float ALPHA = 1.6817928305074290f;
constexpr float LN_EPS = 1e-5f, GN_EPS = 1e-6f;
constexpr int NEXP = 16384;
constexpr int NWAVES = 8, NTHR = 512;

constexpr size_t MiB = 1u << 20;
constexpr size_t WS_CTL = 0, CTL_ZERO_BYTES = 1 * MiB;
constexpr size_t WS_WIN = 1 * MiB;
constexpr size_t WS_WOUT = 81 * MiB;
constexpr size_t WS_WS = 113 * MiB;
constexpr size_t WS_WGLU = 145 * MiB;
constexpr size_t WS_WPOOL = 147 * MiB;
constexpr size_t WS_S5A = 149 * MiB;
constexpr size_t WS_S5B = 150 * MiB;
constexpr size_t WS_ROT = 152 * MiB;
constexpr size_t WS_U16 = 160 * MiB;
constexpr size_t WS_V16 = 416 * MiB;
constexpr size_t WS_XN = 672 * MiB;
constexpr size_t WS_H = 832 * MiB;
constexpr size_t WS_CONCAT = 1232 * MiB;
constexpr size_t WS_BUFY = 1392 * MiB;
constexpr size_t WS_BUFP = 1432 * MiB;
constexpr size_t WS_STF = 1472 * MiB;
constexpr size_t WS_STB = 1632 * MiB;
constexpr size_t WS_IDX = 1792 * MiB;
constexpr size_t WS_GATE = 1812 * MiB;
constexpr size_t WS_S5ST = 1832 * MiB;
constexpr size_t WS_END = 1852 * MiB;
constexpr int CW_BAR = 4096;
constexpr int NPHASE = 1 + NLAYER * 10;

constexpr int LDS_SCRATCH = 147456;
constexpr int LDS_MISC = LDS_SCRATCH;
constexpr int LDS_BYTES = LDS_SCRATCH + 256;

__device__ __forceinline__ float bf_lo(unsigned w) { return __uint_as_float(w << 16); }
__device__ __forceinline__ float bf_hi(unsigned w) { return __uint_as_float(w & 0xffff0000u); }
typedef __bf16 bf16x2_t __attribute__((ext_vector_type(2)));
__device__ __forceinline__ unsigned pkbf(float lo, float hi) { const bf16x2_t v = {(__bf16)lo, (__bf16)hi}; return __builtin_bit_cast(unsigned, v); }
__device__ __forceinline__ bf16 f2bf(float f) { return __builtin_bit_cast(unsigned short, (__bf16)f); }
__device__ __forceinline__ float wave_sum(float v) {
#pragma unroll
    for (int o = 1; o < 64; o <<= 1) v += __shfl_xor(v, o);
    return v;
}
__device__ __forceinline__ float gelu_erf(float v) { return 0.5f * v * (1.0f + erff(v * 0.70710678118654752f)); }
__device__ __forceinline__ int tok_pos(int t) { return t < 32768 ? (t & 4095) : (t - 32768); }
__device__ __forceinline__ int tok_len(int t) { return t < 32768 ? 4096 : 8192; }
__device__ __forceinline__ void unpack8(const v4u q, float (&f)[8]) {
    f[0] = bf_lo(q.x); f[1] = bf_hi(q.x); f[2] = bf_lo(q.y); f[3] = bf_hi(q.y); f[4] = bf_lo(q.z); f[5] = bf_hi(q.z); f[6] = bf_lo(q.w); f[7] = bf_hi(q.w);
}
__device__ __forceinline__ v4u pack8(const float (&f)[8]) { v4u q; q.x = pkbf(f[0], f[1]); q.y = pkbf(f[2], f[3]); q.z = pkbf(f[4], f[5]); q.w = pkbf(f[6], f[7]); return q; }
#define LDS_WAIT() asm volatile("s_waitcnt lgkmcnt(0)" ::: "memory")
#define MFMA16(a, b, c) __builtin_amdgcn_mfma_f32_16x16x32_bf16((a), (b), (c), 0, 0, 0)

struct EpiStoreBf16 {
    static constexpr bool PERM = true, AFTER_DRAIN = false;
    bf16* O; int ldo;
    __device__ __forceinline__ void operator()(const f32x4 (&acc)[2][2][4][2], const pg8::Unit& u, int wr, int wc, int fr, int fq) const {
        const int row0 = u.pm * 256 + wr * 64 + fr, col0 = u.pn * 256 + wc * 32 + 8 * fq;
#pragma unroll
        for (int ai = 0; ai < 2; ++ai)
#pragma unroll
            for (int m = 0; m < 4; ++m) { bf16* rowp = O + (size_t)(row0 + ai * 128 + m * 16) * ldo + col0;
#pragma unroll
                for (int bj = 0; bj < 2; ++bj) { const f32x4 v0 = acc[ai][bj][m][0], v1 = acc[ai][bj][m][1];
                    v4u w; w.x = pkbf(v0[0], v0[1]); w.y = pkbf(v0[2], v0[3]); w.z = pkbf(v1[0], v1[1]); w.w = pkbf(v1[2], v1[3]);
                    *(v4u*)(rowp + bj * 128) = w; } }
    }
};
struct EpiGlu {
    static constexpr bool PERM = true, AFTER_DRAIN = false;
    const bf16* Y; int ldy; bf16* O; int ldo; const float* bias;
    __device__ __forceinline__ void operator()(const f32x4 (&acc)[2][2][4][2], const pg8::Unit& u, int wr, int wc, int fr, int fq) const {
        const int row0 = u.pm * 256 + wr * 64 + fr, col0 = u.pn * 256 + wc * 32 + 8 * fq;
#pragma unroll
        for (int bj = 0; bj < 2; ++bj) {
            const f32x4 b0 = *(const f32x4*)(bias + col0 + bj * 128), b1 = *(const f32x4*)(bias + col0 + bj * 128 + 4);
#pragma unroll
            for (int ai = 0; ai < 2; ++ai)
#pragma unroll
                for (int m = 0; m < 4; ++m) { const size_t r = (size_t)(row0 + ai * 128 + m * 16);
                    const v4u yq = *(const v4u*)(Y + r * ldy + col0 + bj * 128); float y[8]; unpack8(yq, y);
                    const f32x4 v0 = acc[ai][bj][m][0] + b0, v1 = acc[ai][bj][m][1] + b1; float o[8];
#pragma unroll
                    for (int k = 0; k < 4; ++k) { o[k] = y[k] / (1.0f + __expf(-v0[k])); o[4 + k] = y[4 + k] / (1.0f + __expf(-v1[k])); }
                    *(v4u*)(O + r * ldo + col0 + bj * 128) = pack8(o); }
        }
    }
};
struct EpiScaleBf16 {
    static constexpr bool PERM = true, AFTER_DRAIN = false;
    bf16* O; int ldo; const float* scale;
    __device__ __forceinline__ void operator()(const f32x4 (&acc)[2][2][4][2], const pg8::Unit& u, int wr, int wc, int fr, int fq) const {
        const int row0 = u.pm * 256 + wr * 64 + fr, col0 = u.pn * 256 + wc * 32 + 8 * fq;
#pragma unroll
        for (int bj = 0; bj < 2; ++bj) {
            const f32x4 s0 = *(const f32x4*)(scale + col0 + bj * 128), s1 = *(const f32x4*)(scale + col0 + bj * 128 + 4);
#pragma unroll
            for (int ai = 0; ai < 2; ++ai)
#pragma unroll
                for (int m = 0; m < 4; ++m) { const size_t r = (size_t)(row0 + ai * 128 + m * 16);
                    const f32x4 v0 = acc[ai][bj][m][0] * s0, v1 = acc[ai][bj][m][1] * s1;
                    v4u w; w.x = pkbf(v0[0], v0[1]); w.y = pkbf(v0[2], v0[3]); w.z = pkbf(v1[0], v1[1]); w.w = pkbf(v1[2], v1[3]);
                    *(v4u*)(O + r * ldo + col0 + bj * 128) = w; }
        }
    }
};
struct EpiResid {
    static constexpr bool PERM = false, AFTER_DRAIN = false;
    float* X; int ldx; float alpha;
    __device__ __forceinline__ void operator()(const f32x4 (&acc)[2][2][4][2], const pg8::Unit& u, int wr, int wc, int fr, int fq) const {
        const int row0 = u.pm * 256 + wr * 64 + fr, col0 = u.pn * 256 + wc * 32 + 4 * fq;
#pragma unroll
        for (int ai = 0; ai < 2; ++ai)
#pragma unroll
            for (int m = 0; m < 4; ++m) { float* rowp = X + (size_t)(row0 + ai * 128 + m * 16) * ldx + col0;
#pragma unroll
                for (int bj = 0; bj < 2; ++bj)
#pragma unroll
                    for (int n = 0; n < 2; ++n) { f32x4* p = (f32x4*)(rowp + bj * 128 + n * 16); const f32x4 x = *p; *p = x * alpha + acc[ai][bj][m][n]; } }
    }
};
struct EpiStoreF32 {
    static constexpr bool PERM = false, AFTER_DRAIN = false;
    float* C; int ldc;
    __device__ __forceinline__ void operator()(const f32x4 (&acc)[2][2][4][2], const pg8::Unit& u, int wr, int wc, int fr, int fq) const {
        const int row0 = u.pm * 256 + wr * 64 + fr, col0 = u.pn * 256 + wc * 32 + 4 * fq;
#pragma unroll
        for (int ai = 0; ai < 2; ++ai)
#pragma unroll
            for (int m = 0; m < 4; ++m) { float* rowp = C + (size_t)(row0 + ai * 128 + m * 16) * ldc + col0;
#pragma unroll
                for (int bj = 0; bj < 2; ++bj)
#pragma unroll
                    for (int n = 0; n < 2; ++n) *(f32x4*)(rowp + bj * 128 + n * 16) = acc[ai][bj][m][n]; }
    }
};

struct Args { const float* in[26]; float* out; unsigned char* ws; int ph_lo, ph_hi, li, pad; };
struct Frame {
    LAS unsigned char* lds;
    int tid, lane, wave, G, bx;
    int gw, NGW;
    size_t gtid, NT;
    float* out; unsigned char* ws;
};
enum InIdx { I_XP = 0, I_XS, I_LNIN_G, I_LNIN_B, I_WIN, I_LAMRE, I_LAMIM, I_LOGSTEP, I_BRE, I_BIM, I_CRE, I_CIM, I_S5D, I_WGLU, I_BGLU, I_POOLW, I_POOLS,
             I_WOUT, I_LN1G, I_LN1B, I_WQ, I_KEYS, I_PU, I_PV, I_LN2G, I_LN2B };

__device__ __forceinline__ void ln_row(const float* src, const float* g, const float* b, float* dst, bf16* dstb, int lane) {
    f32x4 v[8]; float s = 0.f;
#pragma unroll
    for (int j = 0; j < 8; ++j) { v[j] = ((const f32x4*)src)[lane + 64 * j]; s += (v[j][0] + v[j][1]) + (v[j][2] + v[j][3]); }
    const float mean = wave_sum(s) * (1.0f / DM); float s2 = 0.f;
#pragma unroll
    for (int j = 0; j < 8; ++j) { v[j] = v[j] - mean; s2 += (v[j][0] * v[j][0] + v[j][1] * v[j][1]) + (v[j][2] * v[j][2] + v[j][3] * v[j][3]); }
    const float rstd = 1.0f / sqrtf(wave_sum(s2) * (1.0f / DM) + LN_EPS);
#pragma unroll
    for (int j = 0; j < 8; ++j) { const f32x4 gg = ((const f32x4*)g)[lane + 64 * j], bb = ((const f32x4*)b)[lane + 64 * j];
        const f32x4 o = v[j] * rstd * gg + bb; ((f32x4*)dst)[lane + 64 * j] = o;
        v2u w; w.x = pkbf(o[0], o[1]); w.y = pkbf(o[2], o[3]); ((v2u*)dstb)[lane + 64 * j] = w; }
}

__device__ __forceinline__ void transpose_item(const float* W, int K, int N, bf16* WT, LAS float* scr, int item, int lane) {
    const int nblk = N / 32, kb = item / nblk, nb = item % nblk, k0 = 64 * kb, n0 = 32 * nb;
#pragma unroll 8
    for (int i = 0; i < 32; ++i) { const int kk = 2 * i + (lane >> 5); scr[kk * 33 + (lane & 31)] = W[(size_t)(k0 + kk) * N + n0 + (lane & 31)]; }
    LDS_WAIT();
    const int c = lane & 7;
#pragma unroll
    for (int j = 0; j < 4; ++j) { const int n = (lane >> 3) + 8 * j; const LAS float* s = scr + (8 * c) * 33 + n;
        v4u o; o.x = pkbf(s[0 * 33], s[1 * 33]); o.y = pkbf(s[2 * 33], s[3 * 33]); o.z = pkbf(s[4 * 33], s[5 * 33]); o.w = pkbf(s[6 * 33], s[7 * 33]);
        *(v4u*)(WT + (size_t)(n0 + n) * K + k0 + 8 * c) = o; }
    LDS_WAIT();
}

__device__ __forceinline__ void p0_prologue(const Frame& F, const Args& A) {
    {
        LAS float* scr = (LAS float*)(F.lds + F.wave * 16384);
        constexpr int I_IN = (DM / 64) * (INW / 32), I_OUT = (DM / 64) * (DM / 32), I_GLU = (512 / 64) * (512 / 32);
        constexpr int NITEMS = NLAYER * (I_IN + I_OUT + I_GLU);
        for (int it = F.gw; it < NITEMS; it += F.NGW) {
            int r = it;
            if (r < NLAYER * I_IN) { const int l = r / I_IN; transpose_item(A.in[I_WIN] + (size_t)l * DM * INW, DM, INW, (bf16*)(A.ws + WS_WIN) + (size_t)l * INW * DM, scr, r % I_IN, F.lane); continue; }
            r -= NLAYER * I_IN;
            if (r < NLAYER * I_OUT) { const int l = r / I_OUT; transpose_item(A.in[I_WOUT] + (size_t)l * DM * DM, DM, DM, (bf16*)(A.ws + WS_WOUT) + (size_t)l * DM * DM, scr, r % I_OUT, F.lane); continue; }
            r -= NLAYER * I_OUT;
            { const int l = r / I_GLU; transpose_item(A.in[I_WGLU] + (size_t)l * 512 * 512, 512, 512, (bf16*)(A.ws + WS_WGLU) + (size_t)l * 512 * 512, scr, r % I_GLU, F.lane); }
        }
    }
    {
        const size_t n8 = (size_t)NLAYER * NEXP * DM / 8;
        const float* pu = A.in[I_PU]; const float* pv = A.in[I_PV]; v4u* du = (v4u*)(A.ws + WS_U16); v4u* dv = (v4u*)(A.ws + WS_V16);
        for (size_t i = F.gtid; i < n8; i += F.NT) {
            const f32x4 a = ((const f32x4*)pu)[2 * i], b = ((const f32x4*)pu)[2 * i + 1];
            v4u q; q.x = pkbf(a[0], a[1]); q.y = pkbf(a[2], a[3]); q.z = pkbf(b[0], b[1]); q.w = pkbf(b[2], b[3]); du[i] = q;
            const f32x4 c = ((const f32x4*)pv)[2 * i], d = ((const f32x4*)pv)[2 * i + 1];
            v4u r; r.x = pkbf(c[0], c[1]); r.y = pkbf(c[2], c[3]); r.z = pkbf(d[0], d[1]); r.w = pkbf(d[2], d[3]); dv[i] = r;
        }
    }
    {
        const float* pw = A.in[I_POOLW]; v4u* dst = (v4u*)(A.ws + WS_WPOOL);
        for (size_t i = F.gtid; i < (size_t)NLAYER * 512 * 64; i += F.NT) {
            const int k8 = (int)(i & 63), n = (int)((i >> 6) & 511), l = (int)(i >> 15);
            const int g = n >> 7, d = n & 127, kg = k8 >> 4, c0 = (k8 & 15) * 8;
            float f[8];
#pragma unroll
            for (int k = 0; k < 8; ++k) f[k] = (kg == g) ? pw[(((size_t)l * 4 + g) * 128 + (c0 + k)) * 128 + d] : 0.f;
            dst[i] = pack8(f);
        }
    }
    {
        const float* lre = A.in[I_LAMRE]; const float* lim = A.in[I_LAMIM]; const float* lst = A.in[I_LOGSTEP]; const float* bre = A.in[I_BRE]; const float* bim = A.in[I_BIM];
        f32x2v* ab = (f32x2v*)(A.ws + WS_S5A); f32x2v* ab64 = (f32x2v*)(A.ws + WS_S5A + 512 * 1024); f32x2v* bb = (f32x2v*)(A.ws + WS_S5B);
        for (size_t i = F.gtid; i < (size_t)NLAYER * 2 * 32 * 64; i += F.NT) {
            const float lr = lre[i], li = lim[i], dt = expf(lst[i >> 6]);
            const float mag = expf(lr * dt), ar = mag * cosf(li * dt), ai = mag * sinf(li * dt);
            const float den = lr * lr + li * li;
            const float zr = ((ar - 1.0f) * lr + ai * li) / den, zi = (ai * lr - (ar - 1.0f) * li) / den;
            ab[i] = (f32x2v){ar, ai};
            const float m64 = expf(lr * dt * 64.0f), an = li * dt * 64.0f;
            ab64[i] = (f32x2v){m64 * cosf(an), m64 * sinf(an)};
#pragma unroll
            for (int c = 0; c < 16; ++c) { const float br = bre[i * 16 + c], bi = bim[i * 16 + c]; bb[i * 16 + c] = (f32x2v){zr * br - zi * bi, zr * bi + zi * br}; }
        }
    }
    if (F.bx == 0 && F.tid < 128) {
        ((float*)(A.ws + WS_ROT))[F.tid] = (float)exp(-(double)F.tid / 127.0 * 9.210340371976184);
    }
    __syncthreads();
    {
        LAS float* KS = (LAS float*)F.lds;
        LAS float* WQ = (LAS float*)(F.lds + 128 * 132 * 4);
        const float* keys = A.in[I_KEYS]; const float* wq = A.in[I_WQ]; bf16* wst = (bf16*)(A.ws + WS_WS);
        for (int u = F.bx; u < NLAYER * 16 * 32; u += F.G) {
            const int dtl = u & 31, hp = (u >> 5) & 15, l = u >> 9, p = hp & 1;
#pragma unroll
            for (int r = 0; r < 8; ++r) { const int f = F.tid + 512 * r, nk = f >> 5, c4 = f & 31;
                *(LAS f32x4*)(KS + nk * 132 + c4 * 4) = *(const f32x4*)(keys + (((size_t)l * 2 + p) * 128 + nk) * 128 + c4 * 4); }
#pragma unroll
            for (int r = 0; r < 4; ++r) { const int f = F.tid + 512 * r, dd = f >> 5, c4 = f & 31;
                *(LAS f32x4*)(WQ + dd * 132 + c4 * 4) = *(const f32x4*)(wq + ((size_t)l * DM + dtl * 64 + dd) * DM + hp * 128 + c4 * 4); }
            __syncthreads();
            const int nk = F.tid & 127, dg = F.tid >> 7;
            float acc[16];
#pragma unroll
            for (int i = 0; i < 16; ++i) acc[i] = 0.f;
            for (int c4 = 0; c4 < 32; ++c4) {
                const f32x4 kv = *(const LAS f32x4*)(KS + nk * 132 + c4 * 4);
#pragma unroll
                for (int i = 0; i < 16; ++i) { const f32x4 wv = *(const LAS f32x4*)(WQ + (dg * 16 + i) * 132 + c4 * 4);
                    acc[i] += (kv[0] * wv[0] + kv[1] * wv[1]) + (kv[2] * wv[2] + kv[3] * wv[3]); }
            }
            bf16* o = wst + ((size_t)l * DM + hp * 128 + nk) * DM + dtl * 64 + dg * 16;
            v4u q0, q1; q0.x = pkbf(acc[0], acc[1]); q0.y = pkbf(acc[2], acc[3]); q0.z = pkbf(acc[4], acc[5]); q0.w = pkbf(acc[6], acc[7]);
            q1.x = pkbf(acc[8], acc[9]); q1.y = pkbf(acc[10], acc[11]); q1.z = pkbf(acc[12], acc[13]); q1.w = pkbf(acc[14], acc[15]);
            *(v4u*)o = q0; *(v4u*)(o + 8) = q1;
            __syncthreads();
        }
    }
    for (int t = F.gw; t < NTOK; t += F.NGW) {
        const float* src = t < 32768 ? A.in[I_XP] + (size_t)t * DM : A.in[I_XS] + (size_t)(t - 32768) * DM;
        ln_row(src, A.in[I_LNIN_G], A.in[I_LNIN_B], A.out + (size_t)t * DM, (bf16*)(A.ws + WS_XN) + (size_t)t * DM, F.lane);
    }
}

__device__ __forceinline__ float ret_log2_gamma(int h) { return log2f(1.0f - exp2f(-5.0f - (float)h)); }

__device__ __forceinline__ void s5_pass1(const Frame& F, const Args& A, int l) {
    LAS float* Uw = (LAS float*)(F.lds + F.wave * 4096);
    const bf16* H = (const bf16*)(A.ws + WS_H);
    const f32x2v* ab = (const f32x2v*)(A.ws + WS_S5A); const f32x4* bb = (const f32x4*)(A.ws + WS_S5B);
    f32x2v* st = (f32x2v*)(A.ws + WS_S5ST);
    for (int task = F.gw; task < 640 * 32 * 2; task += F.NGW) {
        const int dir = task & 1, g = (task >> 1) & 31, ck = task >> 6;
        const int pidx = ((l * 2 + dir) * 32 + g) * 64 + F.lane;
        const f32x2v a = ab[pidx];
        float Br[16], Bi[16];
#pragma unroll
        for (int c2 = 0; c2 < 8; ++c2) { const f32x4 q = bb[(size_t)pidx * 8 + c2]; Br[2 * c2] = q[0]; Bi[2 * c2] = q[1]; Br[2 * c2 + 1] = q[2]; Bi[2 * c2 + 1] = q[3]; }
        {
            const bf16* urow = H + (size_t)(ck * 64 + F.lane) * INW + COL_UA + g * 16;
            const v4u q0 = *(const v4u*)urow, q1 = *(const v4u*)(urow + 8); float f0[8], f1[8]; unpack8(q0, f0); unpack8(q1, f1);
            LAS f32x4* d = (LAS f32x4*)(Uw + F.lane * 16);
            d[0] = (f32x4){f0[0], f0[1], f0[2], f0[3]}; d[1] = (f32x4){f0[4], f0[5], f0[6], f0[7]}; d[2] = (f32x4){f1[0], f1[1], f1[2], f1[3]}; d[3] = (f32x4){f1[4], f1[5], f1[6], f1[7]};
        }
        LDS_WAIT();
        float xr = 0.f, xi = 0.f;
        for (int s = 0; s < 64; ++s) {
            const int t = dir ? 63 - s : s;
            const LAS f32x4* up = (const LAS f32x4*)(Uw + t * 16);
            float bur = 0.f, bui = 0.f;
#pragma unroll
            for (int c4 = 0; c4 < 4; ++c4) { const f32x4 uv = up[c4];
#pragma unroll
                for (int k = 0; k < 4; ++k) { bur += Br[4 * c4 + k] * uv[k]; bui += Bi[4 * c4 + k] * uv[k]; } }
            const float nxr = a[0] * xr - a[1] * xi + bur, nxi = a[0] * xi + a[1] * xr + bui; xr = nxr; xi = nxi;
        }
        st[(size_t)((ck * 32 + g) * 2 + dir) * 64 + F.lane] = (f32x2v){xr, xi};
        LDS_WAIT();
    }
}
__device__ __forceinline__ void s5_carry(const Frame& F, const Args& A, int l) {
    const f32x2v* ab64 = (const f32x2v*)(A.ws + WS_S5A + 512 * 1024); f32x2v* st = (f32x2v*)(A.ws + WS_S5ST);
    for (size_t it = F.gtid; it < (size_t)9 * 32 * 2 * 64; it += F.NT) {
        const int p = (int)(it & 63), dir = (int)((it >> 6) & 1), g = (int)((it >> 7) & 31), s = (int)(it >> 12);
        const int ck0 = s < 8 ? s * 64 : 512, n = s < 8 ? 64 : 128;
        const f32x2v a = ab64[((l * 2 + dir) * 32 + g) * 64 + p];
        float cr = 0.f, ci = 0.f;
        for (int k = 0; k < n; ++k) {
            const int ck = dir ? (ck0 + n - 1 - k) : (ck0 + k);
            f32x2v* q = st + (size_t)((ck * 32 + g) * 2 + dir) * 64 + p;
            const f32x2v le = *q; *q = (f32x2v){cr, ci};
            const float ncr = a[0] * cr - a[1] * ci + le[0], nci = a[0] * ci + a[1] * cr + le[1]; cr = ncr; ci = nci;
        }
    }
}
__device__ __forceinline__ void s5_pass3(const Frame& F, const Args& A, int l) {
    LAS unsigned char* wb = F.lds + F.wave * 17152;
    LAS float* Uw = (LAS float*)wb;
    LAS bf16* Xw = (LAS bf16*)(wb + 4096);
    LAS bf16* Ctw = (LAS bf16*)(wb + 4096 + 8704);
    const bf16* H = (const bf16*)(A.ws + WS_H); bf16* BY = (bf16*)(A.ws + WS_BUFY);
    const f32x2v* ab = (const f32x2v*)(A.ws + WS_S5A); const f32x4* bb = (const f32x4*)(A.ws + WS_S5B);
    const f32x2v* st = (const f32x2v*)(A.ws + WS_S5ST);
    const float* cre = A.in[I_CRE]; const float* cim = A.in[I_CIM]; const float* dvec = A.in[I_S5D] + (size_t)l * 512;
    const int lane = F.lane, lr = lane & 15, lq = lane >> 4;
    for (int task = F.gw; task < 640 * 32; task += F.NGW) {
        const int g = task & 31, ck = task >> 5;
        {
            const bf16* urow = H + (size_t)(ck * 64 + lane) * INW + COL_UA + g * 16;
            const v4u q0 = *(const v4u*)urow, q1 = *(const v4u*)(urow + 8); float f0[8], f1[8]; unpack8(q0, f0); unpack8(q1, f1);
            LAS f32x4* d = (LAS f32x4*)(Uw + lane * 16);
            d[0] = (f32x4){f0[0], f0[1], f0[2], f0[3]}; d[1] = (f32x4){f0[4], f0[5], f0[6], f0[7]}; d[2] = (f32x4){f1[0], f1[1], f1[2], f1[3]}; d[3] = (f32x4){f1[4], f1[5], f1[6], f1[7]};
        }
        f32x4 Y[4];
#pragma unroll
        for (int m = 0; m < 4; ++m) Y[m] = (f32x4){0.f, 0.f, 0.f, 0.f};
#pragma unroll
        for (int dir = 0; dir < 2; ++dir) {
            const int pidx = ((l * 2 + dir) * 32 + g) * 64 + lane;
            const f32x2v a = ab[pidx];
            float Br[16], Bi[16];
#pragma unroll
            for (int c2 = 0; c2 < 8; ++c2) { const f32x4 q = bb[(size_t)pidx * 8 + c2]; Br[2 * c2] = q[0]; Bi[2 * c2] = q[1]; Br[2 * c2 + 1] = q[2]; Bi[2 * c2 + 1] = q[3]; }
            {
                const size_t cb = (size_t)((l * 2 + dir) * 32 + g) * 16 * 64;
#pragma unroll
                for (int c = 0; c < 16; ++c) { Ctw[c * 136 + lane] = f2bf(cre[cb + c * 64 + lane]); Ctw[c * 136 + 64 + lane] = f2bf(-cim[cb + c * 64 + lane]); }
            }
            const f32x2v x0 = st[(size_t)((ck * 32 + g) * 2 + dir) * 64 + lane];
            float xr = x0[0], xi = x0[1];
            LDS_WAIT();
#pragma unroll
            for (int half = 0; half < 2; ++half) {
                for (int s = 0; s < 32; ++s) {
                    const int step = half * 32 + s, t = dir ? 63 - step : step;
                    const LAS f32x4* up = (const LAS f32x4*)(Uw + t * 16);
                    float bur = 0.f, bui = 0.f;
#pragma unroll
                    for (int c4 = 0; c4 < 4; ++c4) { const f32x4 uv = up[c4];
#pragma unroll
                        for (int k = 0; k < 4; ++k) { bur += Br[4 * c4 + k] * uv[k]; bui += Bi[4 * c4 + k] * uv[k]; } }
                    const float nxr = a[0] * xr - a[1] * xi + bur, nxi = a[0] * xi + a[1] * xr + bui; xr = nxr; xi = nxi;
                    Xw[(t & 31) * 136 + lane] = f2bf(xr); Xw[(t & 31) * 136 + 64 + lane] = f2bf(xi);
                }
                LDS_WAIT();
                const int tb = dir ? (1 - half) : half;
#pragma unroll
                for (int m = 0; m < 2; ++m)
#pragma unroll
                    for (int ks = 0; ks < 4; ++ks) {
                        const bf16x8 av = *(const LAS bf16x8*)(Ctw + lr * 136 + 32 * ks + lq * 8);
                        const bf16x8 bv = *(const LAS bf16x8*)(Xw + (16 * m + lr) * 136 + 32 * ks + lq * 8);
                        Y[2 * tb + m] = MFMA16(av, bv, Y[2 * tb + m]);
                    }
                LDS_WAIT();
            }
        }
#pragma unroll
        for (int m = 0; m < 4; ++m) {
            const int t = 16 * m + lr, c0 = 4 * lq;
            const f32x4 uv = *(const LAS f32x4*)(Uw + t * 16 + c0); const f32x4 dv = *(const f32x4*)(dvec + g * 16 + c0);
            const f32x4 y = Y[m] + dv * uv;
            v2u w; w.x = pkbf(gelu_erf(y[0]), gelu_erf(y[1])); w.y = pkbf(gelu_erf(y[2]), gelu_erf(y[3]));
            *(v2u*)(BY + (size_t)(ck * 64 + t) * 512 + g * 16 + c0) = w;
        }
        LDS_WAIT();
    }
}
__device__ __forceinline__ void pool_phase(const Frame& F, const Args& A) {
    const bf16* H = (const bf16*)(A.ws + WS_H); bf16* BP = (bf16*)(A.ws + WS_BUFP);
    for (size_t it = F.gtid; it < (size_t)NTOK * 64; it += F.NT) {
        const int t = (int)(it >> 6), o = (int)(it & 63), gi = o >> 4, w = 2 << gi;
        const int pos = tok_pos(t), L = tok_len(t);
        const int lo = max(pos - w / 2, 0), hi = min(pos + w / 2 - 1, L - 1);
        const bf16* base = H + (size_t)(t - pos) * INW + COL_UB + o * 8;
        float s[8];
#pragma unroll
        for (int k = 0; k < 8; ++k) s[k] = 0.f;
        for (int si = lo; si <= hi; ++si) { float f[8]; unpack8(*(const v4u*)(base + (size_t)si * INW), f);
#pragma unroll
            for (int k = 0; k < 8; ++k) s[k] += f[k]; }
        const float inv = 1.0f / (float)(hi - lo + 1);
        float c[8]; unpack8(*(const v4u*)(base + (size_t)pos * INW), c);
#pragma unroll
        for (int k = 0; k < 8; ++k) s[k] = s[k] * inv - c[k];
        *(v4u*)(BP + (size_t)t * 512 + o * 8) = pack8(s);
    }
}
__device__ __forceinline__ void rotary_phase(const Frame& F, const Args& A) {
    bf16* H = (bf16*)(A.ws + WS_H); const float* rot = (const float*)(A.ws + WS_ROT);
    for (size_t it = F.gtid; it < (size_t)NTOK * 16; it += F.NT) {
        const int t = (int)(it >> 4), o = (int)(it & 15); const float pos = (float)tok_pos(t);
        float cs[8], sn[8];
#pragma unroll
        for (int k = 0; k < 8; ++k) { const float ang = pos * rot[o * 8 + k]; cs[k] = cosf(ang); sn[k] = sinf(ang); }
#pragma unroll
        for (int which = 0; which < 2; ++which) {
            const float sc = which ? 0.0625f : 1.0f;
#pragma unroll
            for (int hd = 0; hd < 4; ++hd) {
                bf16* p1 = H + (size_t)t * INW + (which ? COL_K : COL_Q) + hd * 256 + o * 8; bf16* p2 = p1 + 128;
                float x1[8], x2[8], o1[8], o2[8]; unpack8(*(const v4u*)p1, x1); unpack8(*(const v4u*)p2, x2);
#pragma unroll
                for (int k = 0; k < 8; ++k) { o1[k] = (x1[k] * cs[k] - x2[k] * sn[k]) * sc; o2[k] = (x2[k] * cs[k] + x1[k] * sn[k]) * sc; }
                *(v4u*)p1 = pack8(o1); *(v4u*)p2 = pack8(o2);
            }
        }
    }
}
constexpr int RS = 136;
__device__ __forceinline__ void ret_state_phase(const Frame& F, const Args& A) {
    const bf16* H = (const bf16*)(A.ws + WS_H); bf16* STF = (bf16*)(A.ws + WS_STF); bf16* STB = (bf16*)(A.ws + WS_STB);
    LAS bf16* Kt = (LAS bf16*)F.lds; LAS bf16* VtF = Kt + 128 * RS; LAS bf16* VtB = Kt + 256 * RS;
    const int tid = F.tid, lane = F.lane, lr = lane & 15, lq = lane >> 4, we = F.wave >> 1, wd = F.wave & 1;
    for (int u = F.bx; u < 5120; u += F.G) {
        const int dh = u & 1, eh = (u >> 1) & 1, h = (u >> 2) & 3, c = u >> 4;
        {
            const int tq = opaque(tid), jp = tq & 63, j = 2 * jp, pc0 = tq >> 6;
            const bf16* krow = H + (size_t)(c * 128 + j) * INW + COL_K + h * 256 + dh * 128;
            const bf16* vrow = H + (size_t)(c * 128 + j) * INW + COL_V + h * 256 + eh * 128;
            const float lg = ret_log2_gamma(h), fF0 = exp2f(lg * (float)(127 - j)), fF1 = exp2f(lg * (float)(126 - j)), fB0 = exp2f(lg * (float)j), fB1 = exp2f(lg * (float)(j + 1));
            LAS unsigned* Kt32 = (LAS unsigned*)Kt; LAS unsigned* VtF32 = (LAS unsigned*)VtF; LAS unsigned* VtB32 = (LAS unsigned*)VtB;
#pragma unroll
            for (int r = 0; r < 2; ++r) {
                const int pc = pc0 + 8 * r;
                const v4u k0 = *(const v4u*)(krow + pc * 8), k1 = *(const v4u*)(krow + INW + pc * 8);
                const v4u v0 = *(const v4u*)(vrow + pc * 8), v1 = *(const v4u*)(vrow + INW + pc * 8);
                const unsigned ka0[4] = {k0.x, k0.y, k0.z, k0.w}, ka1[4] = {k1.x, k1.y, k1.z, k1.w};
                float f0[8], f1[8]; unpack8(v0, f0); unpack8(v1, f1);
#pragma unroll
                for (int i = 0; i < 8; ++i) {
                    const unsigned a = ka0[i >> 1], b = ka1[i >> 1];
                    const unsigned kk = (i & 1) ? ((a >> 16) | (b & 0xffff0000u)) : ((a & 0xffffu) | (b << 16));
                    const int o = ((pc * 8 + i) * RS) / 2 + jp;
                    Kt32[o] = kk; VtF32[o] = pkbf(f0[i] * fF0, f1[i] * fF1); VtB32[o] = pkbf(f0[i] * fB0, f1[i] * fB1);
                }
            }
        }
        __syncthreads();
        f32x4 aF[4][2], aB[4][2];
#pragma unroll
        for (int td = 0; td < 4; ++td)
#pragma unroll
            for (int te = 0; te < 2; ++te) { aF[td][te] = (f32x4){0.f, 0.f, 0.f, 0.f}; aB[td][te] = (f32x4){0.f, 0.f, 0.f, 0.f}; }
#pragma unroll
        for (int ks = 0; ks < 4; ++ks) {
            bf16x8 ka[4], vF[2], vB[2];
#pragma unroll
            for (int td = 0; td < 4; ++td) ka[td] = *(const LAS bf16x8*)(Kt + (64 * wd + 16 * td + lr) * RS + 32 * ks + lq * 8);
#pragma unroll
            for (int te = 0; te < 2; ++te) { vF[te] = *(const LAS bf16x8*)(VtF + (32 * we + 16 * te + lr) * RS + 32 * ks + lq * 8); vB[te] = *(const LAS bf16x8*)(VtB + (32 * we + 16 * te + lr) * RS + 32 * ks + lq * 8); }
#pragma unroll
            for (int td = 0; td < 4; ++td)
#pragma unroll
                for (int te = 0; te < 2; ++te) { aF[td][te] = MFMA16(ka[td], vF[te], aF[td][te]); aB[td][te] = MFMA16(ka[td], vB[te], aB[td][te]); }
        }
#pragma unroll
        for (int td = 0; td < 4; ++td)
#pragma unroll
            for (int te = 0; te < 2; ++te) {
                const int e = eh * 128 + 32 * we + 16 * te + lr, d = dh * 128 + 64 * wd + 16 * td + 4 * lq;
                const size_t off = ((size_t)(c * 4 + h) * 256 + e) * 256 + d;
                v2u w; w.x = pkbf(aF[td][te][0], aF[td][te][1]); w.y = pkbf(aF[td][te][2], aF[td][te][3]); *(v2u*)(STF + off) = w;
                v2u x; x.x = pkbf(aB[td][te][0], aB[td][te][1]); x.y = pkbf(aB[td][te][2], aB[td][te][3]); *(v2u*)(STB + off) = x;
            }
        __syncthreads();
    }
}
__device__ __forceinline__ void ret_prefix_phase(const Frame& F, const Args& A) {
    bf16* STF = (bf16*)(A.ws + WS_STF); bf16* STB = (bf16*)(A.ws + WS_STB);
    for (size_t it = F.gtid; it < (size_t)36 * 2 * 8192; it += F.NT) {
        const int o = (int)(it & 8191), which = (int)((it >> 13) & 1), bh = (int)(it >> 14), h = bh & 3, s = bh >> 2;
        const int c0 = s < 8 ? s * 32 : 256, n = s < 8 ? 32 : 64;
        const float dec = exp2f(128.0f * ret_log2_gamma(h));
        float st[8];
#pragma unroll
        for (int k = 0; k < 8; ++k) st[k] = 0.f;
        bf16* base = (which ? STB : STF) + (size_t)h * 65536 + (size_t)o * 8;
        for (int k = 0; k < n; ++k) {
            const int c = which ? (c0 + n - 1 - k) : (c0 + k);
            v4u* p = (v4u*)(base + (size_t)c * 4 * 65536);
            float f[8]; unpack8(*p, f);
#pragma unroll
            for (int i = 0; i < 8; ++i) st[i] = dec * st[i] + f[i];
            *p = pack8(st);
        }
    }
}
__device__ __forceinline__ void ret_out_phase(const Frame& F, const Args& A) {
    const bf16* H = (const bf16*)(A.ws + WS_H); const bf16* STF = (const bf16*)(A.ws + WS_STF); const bf16* STB = (const bf16*)(A.ws + WS_STB);
    bf16* CC = (bf16*)(A.ws + WS_CONCAT);
    LAS bf16* RA = (LAS bf16*)F.lds; LAS bf16* RB = RA + 128 * RS; LAS bf16* RC = RA + 384 * RS;
    const int tid = F.tid, lane = F.lane, lr = lane & 15, lq = lane >> 4, wi = F.wave >> 2, wj = F.wave & 3, we = F.wave & 3;
    for (int u = F.bx; u < 1280; u += F.G) {
        const int h = u & 3, c = u >> 2, t0 = c * 128;
        const int cs = c < 256 ? (c & 31) : (c - 256), ncs = c < 256 ? 32 : 64;
        const bool has_f = cs > 0, has_b = cs < ncs - 1;
        const float lg = ret_log2_gamma(h);
        f32x4 S[4][2];
#pragma unroll
        for (int ti = 0; ti < 4; ++ti)
#pragma unroll
            for (int tj = 0; tj < 2; ++tj) S[ti][tj] = (f32x4){0.f, 0.f, 0.f, 0.f};
#pragma unroll
        for (int dh = 0; dh < 2; ++dh) {
            if (dh) __syncthreads();
#pragma unroll 1
            for (int r = 0; r < 4; ++r) { const int f = opaque(tid) + 512 * r, row = f >> 4, pc = f & 15;
                const bf16* src = H + (size_t)(t0 + row) * INW + h * 256 + dh * 128 + pc * 8;
                *(LAS v4u*)(RA + row * RS + pc * 8) = *(const v4u*)(src + COL_Q);
                *(LAS v4u*)(RB + row * RS + pc * 8) = *(const v4u*)(src + COL_K); }
            __syncthreads();
#pragma unroll
            for (int ks = 0; ks < 4; ++ks) {
                bf16x8 ka[2], qb[4];
#pragma unroll
                for (int tj = 0; tj < 2; ++tj) ka[tj] = *(const LAS bf16x8*)(RB + (32 * wj + 16 * tj + lr) * RS + 32 * ks + lq * 8);
#pragma unroll
                for (int ti = 0; ti < 4; ++ti) qb[ti] = *(const LAS bf16x8*)(RA + (64 * wi + 16 * ti + lr) * RS + 32 * ks + lq * 8);
#pragma unroll
                for (int ti = 0; ti < 4; ++ti)
#pragma unroll
                    for (int tj = 0; tj < 2; ++tj) S[ti][tj] = MFMA16(ka[tj], qb[ti], S[ti][tj]);
            }
        }
#pragma unroll
        for (int ti = 0; ti < 4; ++ti)
#pragma unroll
            for (int tj = 0; tj < 2; ++tj) {
                const int i = 64 * wi + 16 * ti + lr, j0 = 32 * wj + 16 * tj + 4 * lq; float p[4];
#pragma unroll
                for (int jj = 0; jj < 4; ++jj) { const int d = i - (j0 + jj); p[jj] = S[ti][tj][jj] * exp2f(lg * (float)(d < 0 ? -d : d)); }
                v2u w; w.x = pkbf(p[0], p[1]); w.y = pkbf(p[2], p[3]); *(LAS v2u*)(RC + i * RS + j0) = w;
            }
        __syncthreads();
        {
            const int tq = opaque(tid), jp = tq & 63, pc0 = tq >> 6; const bf16* vrow = H + (size_t)(t0 + 2 * jp) * INW + COL_V + h * 256;
            LAS unsigned* RB32 = (LAS unsigned*)RB;
#pragma unroll 1
            for (int r = 0; r < 4; ++r) { const int pc = pc0 + 8 * r; const v4u v0 = *(const v4u*)(vrow + pc * 8), v1 = *(const v4u*)(vrow + INW + pc * 8);
                const unsigned va0[4] = {v0.x, v0.y, v0.z, v0.w}, va1[4] = {v1.x, v1.y, v1.z, v1.w};
#pragma unroll
                for (int i = 0; i < 8; ++i) { const unsigned a = va0[i >> 1], b = va1[i >> 1];
                    RB32[((pc * 8 + i) * RS) / 2 + jp] = (i & 1) ? ((a >> 16) | (b & 0xffff0000u)) : ((a & 0xffffu) | (b << 16)); } }
        }
        __syncthreads();
        f32x4 O[4][4];
#pragma unroll
        for (int ti = 0; ti < 4; ++ti)
#pragma unroll
            for (int te = 0; te < 4; ++te) O[ti][te] = (f32x4){0.f, 0.f, 0.f, 0.f};
#pragma unroll
        for (int ks = 0; ks < 4; ++ks) {
            bf16x8 va[4], pb[4];
#pragma unroll
            for (int te = 0; te < 4; ++te) va[te] = *(const LAS bf16x8*)(RB + (64 * we + 16 * te + lr) * RS + 32 * ks + lq * 8);
#pragma unroll
            for (int ti = 0; ti < 4; ++ti) pb[ti] = *(const LAS bf16x8*)(RC + (64 * wi + 16 * ti + lr) * RS + 32 * ks + lq * 8);
#pragma unroll
            for (int ti = 0; ti < 4; ++ti)
#pragma unroll
                for (int te = 0; te < 4; ++te) O[ti][te] = MFMA16(va[te], pb[ti], O[ti][te]);
        }
#pragma unroll
        for (int dir = 0; dir < 2; ++dir) {
            if (dir == 0 ? has_f : has_b) {
                const bf16* St = (dir == 0 ? STF + (size_t)((c - 1) * 4 + h) * 65536 : STB + (size_t)((c + 1) * 4 + h) * 65536);
#pragma unroll
                for (int dh = 0; dh < 2; ++dh) {
                    __syncthreads();
#pragma unroll 1
                    for (int r = 0; r < 4; ++r) { const int f = opaque(tid) + 512 * r, row = f >> 4, pc = f & 15;
                        const float fac = exp2f(lg * (dir == 0 ? (float)(row + 1) : (float)(128 - row)));
                        float qf[8]; unpack8(*(const v4u*)(H + (size_t)(t0 + row) * INW + COL_Q + h * 256 + dh * 128 + pc * 8), qf);
#pragma unroll
                        for (int k = 0; k < 8; ++k) qf[k] *= fac;
                        *(LAS v4u*)(RA + row * RS + pc * 8) = pack8(qf); }
#pragma unroll 2
                    for (int r = 0; r < 8; ++r) { const int f = opaque(tid) + 512 * r, row = f >> 4, pc = f & 15;
                        *(LAS v4u*)(RB + row * RS + pc * 8) = *(const v4u*)(St + (size_t)row * 256 + dh * 128 + pc * 8); }
                    __syncthreads();
#pragma unroll
                    for (int ks = 0; ks < 4; ++ks) {
                        bf16x8 sa[4], qb[4];
#pragma unroll
                        for (int te = 0; te < 4; ++te) sa[te] = *(const LAS bf16x8*)(RB + (64 * we + 16 * te + lr) * RS + 32 * ks + lq * 8);
#pragma unroll
                        for (int ti = 0; ti < 4; ++ti) qb[ti] = *(const LAS bf16x8*)(RA + (64 * wi + 16 * ti + lr) * RS + 32 * ks + lq * 8);
#pragma unroll
                        for (int ti = 0; ti < 4; ++ti)
#pragma unroll
                            for (int te = 0; te < 4; ++te) O[ti][te] = MFMA16(sa[te], qb[ti], O[ti][te]);
                    }
                }
            }
        }
        __syncthreads();
        LAS float* RED = (LAS float*)RA;
#pragma unroll
        for (int ti = 0; ti < 4; ++ti) { float s1 = 0.f, s2 = 0.f;
#pragma unroll
            for (int te = 0; te < 4; ++te)
#pragma unroll
                for (int jj = 0; jj < 4; ++jj) { const float v = O[ti][te][jj]; s1 += v; s2 += v * v; }
            s1 += __shfl_xor(s1, 16); s1 += __shfl_xor(s1, 32); s2 += __shfl_xor(s2, 16); s2 += __shfl_xor(s2, 32);
            if (lq == 0) { RED[((64 * wi + 16 * ti + lr) * 4 + we) * 2] = s1; RED[((64 * wi + 16 * ti + lr) * 4 + we) * 2 + 1] = s2; } }
        __syncthreads();
#pragma unroll
        for (int ti = 0; ti < 4; ++ti) { const int i = 64 * wi + 16 * ti + lr;
            const f32x4 r0 = *(const LAS f32x4*)(RED + i * 8), r1 = *(const LAS f32x4*)(RED + i * 8 + 4);
            const float m = (r0[0] + r0[2] + r1[0] + r1[2]) * (1.0f / 256.0f), q = (r0[1] + r0[3] + r1[1] + r1[3]) * (1.0f / 256.0f);
            const float var = fmaxf(q - m * m, 0.f), rstd = 1.0f / sqrtf(var + GN_EPS);
#pragma unroll
            for (int te = 0; te < 4; ++te) { const int e0 = 64 * we + 16 * te + 4 * lq;
                const v2u gq = *(const v2u*)(H + (size_t)(t0 + i) * INW + COL_G + h * 256 + e0);
                const float gv[4] = {bf_lo(gq.x), bf_hi(gq.x), bf_lo(gq.y), bf_hi(gq.y)}; float ov[4];
#pragma unroll
                for (int jj = 0; jj < 4; ++jj) { const float gg = gv[jj]; ov[jj] = (gg / (1.0f + __expf(-gg))) * ((O[ti][te][jj] - m) * rstd); }
                v2u w; w.x = pkbf(ov[0], ov[1]); w.y = pkbf(ov[2], ov[3]);
                *(v2u*)(CC + (size_t)(t0 + i) * DM + 1024 + h * 256 + e0) = w; } }
        __syncthreads();
    }
}

__device__ __forceinline__ void topk_insert(float (&tv)[16], int (&ti)[16], float v, int n) {
    if (v > tv[15]) {
        tv[15] = v; ti[15] = n;
#pragma unroll
        for (int k = 15; k >= 1; --k) {
            const bool sw = tv[k] > tv[k - 1];
            const float a = tv[k - 1], b = tv[k]; const int ia = ti[k - 1], ib = ti[k];
            tv[k - 1] = sw ? b : a; tv[k] = sw ? a : b; ti[k - 1] = sw ? ib : ia; ti[k] = sw ? ia : ib;
        }
    }
}
__device__ __forceinline__ void topk_phase(const Frame& F, const Args& A) {
    const float* SC = (const float*)(A.ws + WS_H); int* IDX = (int*)(A.ws + WS_IDX); float* GATE = (float*)(A.ws + WS_GATE);
    LAS float* LV = (LAS float*)F.lds;
    LAS int* LI = (LAS int*)(F.lds + 512 * 17 * 4);
    const int tid = F.tid, tl = tid >> 4, hp = tid & 15;
    for (int blk = F.bx; blk < NTOK / 32; blk += F.G) {
        const int t = blk * 32 + tl;
        const float* row = SC + (size_t)t * DM + hp * 128;
        float tv[16]; int ti[16];
#pragma unroll
        for (int k = 0; k < 16; ++k) { tv[k] = -INFINITY; ti[k] = 0; }
        for (int n4 = 0; n4 < 32; ++n4) {
            const f32x4 v = *(const f32x4*)(row + n4 * 4);
            topk_insert(tv, ti, v[0], n4 * 4); topk_insert(tv, ti, v[1], n4 * 4 + 1); topk_insert(tv, ti, v[2], n4 * 4 + 2); topk_insert(tv, ti, v[3], n4 * 4 + 3);
        }
#pragma unroll
        for (int k = 0; k < 16; ++k) { LV[tid * 17 + k] = tv[k]; LI[tid * 17 + k] = ti[k]; }
        __syncthreads();
        if ((hp & 1) == 0) {
            float a[16], b[16];
#pragma unroll
            for (int k = 0; k < 16; ++k) { a[k] = LV[tid * 17 + k]; b[k] = LV[(tid + 1) * 17 + k]; }
            float sv[16]; int si[16];
#pragma unroll
            for (int k = 0; k < 16; ++k) { sv[k] = -INFINITY; si[k] = 0; }
#pragma unroll
            for (int i = 0; i < 16; ++i)
#pragma unroll
                for (int j = 0; j < 16; ++j) if ((i + 1) * (j + 1) <= 16) topk_insert(sv, si, a[i] + b[j], i * 16 + j);
            float e[16], sum = 0.f;
#pragma unroll
            for (int k = 0; k < 16; ++k) { e[k] = __expf(sv[k] - sv[0]); sum += e[k]; }
            const float inv = 1.0f / sum; const int head = hp >> 1;
#pragma unroll
            for (int k = 0; k < 16; ++k) {
                const int cell = si[k];
                IDX[(size_t)t * 128 + head * 16 + k] = LI[tid * 17 + (cell >> 4)] * 128 + LI[(tid + 1) * 17 + (cell & 15)];
                GATE[(size_t)t * 128 + head * 16 + k] = e[k] * inv;
            }
        }
        __syncthreads();
    }
}
__device__ __forceinline__ void peer_gather_phase(const Frame& F, const Args& A, int l) {
    const bf16* U16 = (const bf16*)(A.ws + WS_U16) + (size_t)l * NEXP * DM; const bf16* V16 = (const bf16*)(A.ws + WS_V16) + (size_t)l * NEXP * DM;
    const int* IDX = (const int*)(A.ws + WS_IDX); const float* GATE = (const float*)(A.ws + WS_GATE);
    const float* g2 = A.in[I_LN2G] + (size_t)l * DM; const float* b2 = A.in[I_LN2B] + (size_t)l * DM;
    bf16* XN = (bf16*)(A.ws + WS_XN);
    const int lane = F.lane, slot = 8 * (lane & 7) + (lane >> 3);
    for (int t = F.gw; t < NTOK; t += F.NGW) {
        float* xrow = A.out + (size_t)t * DM;
        float x[4][8];
#pragma unroll
        for (int c = 0; c < 4; ++c) { const f32x4 a = *(const f32x4*)(xrow + (c * 64 + lane) * 8), b = *(const f32x4*)(xrow + (c * 64 + lane) * 8 + 4);
            x[c][0] = a[0]; x[c][1] = a[1]; x[c][2] = a[2]; x[c][3] = a[3]; x[c][4] = b[0]; x[c][5] = b[1]; x[c][6] = b[2]; x[c][7] = b[3]; }
        int idxp[2]; float wv[2];
#pragma unroll
        for (int hf = 0; hf < 2; ++hf) {
            idxp[hf] = IDX[(size_t)t * 128 + hf * 64 + slot];
            const float gate = GATE[(size_t)t * 128 + hf * 64 + slot];
            float hval = 0.f;
            for (int outer = 0; outer < 8; ++outer) {
                float part[8];
#pragma unroll
                for (int ii = 0; ii < 8; ++ii) {
                    const int e = __builtin_amdgcn_readlane(idxp[hf], ii * 8 + outer);
                    const bf16* urow = U16 + (size_t)e * DM;
                    float s = 0.f;
#pragma unroll
                    for (int c = 0; c < 4; ++c) { const v4u w = *(const v4u*)(urow + (c * 64 + lane) * 8);
                        s += bf_lo(w.x) * x[c][0]; s += bf_hi(w.x) * x[c][1]; s += bf_lo(w.y) * x[c][2]; s += bf_hi(w.y) * x[c][3];
                        s += bf_lo(w.z) * x[c][4]; s += bf_hi(w.z) * x[c][5]; s += bf_lo(w.w) * x[c][6]; s += bf_hi(w.w) * x[c][7]; }
                    part[ii] = s;
                }
                {
                    const bool b5 = (lane & 32) != 0, b4 = (lane & 16) != 0, b3 = (lane & 8) != 0;
#pragma unroll
                    for (int i = 0; i < 4; ++i) { const float mine = b5 ? part[i + 4] : part[i], send = b5 ? part[i] : part[i + 4]; part[i] = mine + __shfl_xor(send, 32); }
#pragma unroll
                    for (int i = 0; i < 2; ++i) { const float mine = b4 ? part[i + 2] : part[i], send = b4 ? part[i] : part[i + 2]; part[i] = mine + __shfl_xor(send, 16); }
                    { const float mine = b3 ? part[1] : part[0], send = b3 ? part[0] : part[1]; part[0] = mine + __shfl_xor(send, 8); }
                    float v = part[0]; v += __shfl_xor(v, 4); v += __shfl_xor(v, 2); v += __shfl_xor(v, 1);
                    hval = ((lane & 7) == outer) ? v : hval;
                }
            }
            wv[hf] = gate * gelu_erf(hval);
        }
        float acc[4][8];
#pragma unroll
        for (int c = 0; c < 4; ++c)
#pragma unroll
            for (int k = 0; k < 8; ++k) acc[c][k] = 0.f;
#pragma unroll
        for (int hf = 0; hf < 2; ++hf) {
#pragma unroll 4
            for (int ll = 0; ll < 64; ++ll) {
                const int e = __builtin_amdgcn_readlane(idxp[hf], ll);
                const float w = __uint_as_float((unsigned)__builtin_amdgcn_readlane((int)__float_as_uint(wv[hf]), ll));
                const bf16* vrow = V16 + (size_t)e * DM;
#pragma unroll
                for (int c = 0; c < 4; ++c) { const v4u q = *(const v4u*)(vrow + (c * 64 + lane) * 8);
                    acc[c][0] += w * bf_lo(q.x); acc[c][1] += w * bf_hi(q.x); acc[c][2] += w * bf_lo(q.y); acc[c][3] += w * bf_hi(q.y);
                    acc[c][4] += w * bf_lo(q.z); acc[c][5] += w * bf_hi(q.z); acc[c][6] += w * bf_lo(q.w); acc[c][7] += w * bf_hi(q.w); }
            }
        }
        float s = 0.f;
#pragma unroll
        for (int c = 0; c < 4; ++c)
#pragma unroll
            for (int k = 0; k < 8; ++k) { acc[c][k] = ALPHA * x[c][k] + acc[c][k]; s += acc[c][k]; }
        const float mean = wave_sum(s) * (1.0f / DM); float s2 = 0.f;
#pragma unroll
        for (int c = 0; c < 4; ++c)
#pragma unroll
            for (int k = 0; k < 8; ++k) { acc[c][k] -= mean; s2 += acc[c][k] * acc[c][k]; }
        const float rstd = 1.0f / sqrtf(wave_sum(s2) * (1.0f / DM) + LN_EPS);
#pragma unroll
        for (int c = 0; c < 4; ++c) { const int col = (c * 64 + lane) * 8;
            const f32x4 ga = *(const f32x4*)(g2 + col), gb = *(const f32x4*)(g2 + col + 4), ba = *(const f32x4*)(b2 + col), bb = *(const f32x4*)(b2 + col + 4);
            float o[8];
#pragma unroll
            for (int k = 0; k < 4; ++k) { o[k] = acc[c][k] * rstd * ga[k] + ba[k]; o[4 + k] = acc[c][4 + k] * rstd * gb[k] + bb[k]; }
            *(f32x4*)(xrow + col) = (f32x4){o[0], o[1], o[2], o[3]}; *(f32x4*)(xrow + col + 4) = (f32x4){o[4], o[5], o[6], o[7]};
            *(v4u*)(XN + (size_t)t * DM + col) = pack8(o); }
    }
}

#ifndef PHASE_TEST_ONLY
__global__ void __launch_bounds__(NTHR, 2) fwd_kernel(Args A) {
    extern __shared__ __attribute__((aligned(16))) unsigned char lds_raw[];
#define MKFRAME() Frame F; { F.lds = (LAS unsigned char*)lds_raw; F.tid = opaque((int)threadIdx.x); F.lane = F.tid & 63; F.wave = __builtin_amdgcn_readfirstlane(F.tid >> 6); \
        const int bx_ = opaque_s((int)blockIdx.x); F.G = gridDim.x; F.gw = bx_ * NWAVES + F.wave; F.NGW = F.G * NWAVES; F.gtid = (size_t)bx_ * NTHR + F.tid; F.NT = (size_t)F.G * NTHR; F.out = A.out; F.ws = A.ws; F.bx = bx_; }
    volatile LAS unsigned* MISC = (volatile LAS unsigned*)((LAS unsigned char*)lds_raw + LDS_MISC);
    if (threadIdx.x < 64) MISC[threadIdx.x] = 0u;
    __syncthreads();
    XcdBarrier bar = xcd_barrier_post((unsigned*)(A.ws + WS_CTL) + CW_BAR + A.li * XCD_BAR_WORDS, MISC + 8);
    const int lo = A.ph_lo, hi = A.ph_hi;
#define IN(k) (lo <= (k) && (k) < hi)
#define SEAM(k) do { if (lo <= (k) && (k) + 1 < hi) xcd_barrier(bar); } while (0)

    if (IN(0)) { MKFRAME(); p0_prologue(F, A); } SEAM(0);

    for (int l = 0; l < NLAYER; ++l) {
        const int pb = 1 + l * 10;
        bf16* XN = (bf16*)(A.ws + WS_XN); bf16* H = (bf16*)(A.ws + WS_H); bf16* CC = (bf16*)(A.ws + WS_CONCAT);
        if (IN(pb + 0)) { MKFRAME();
            pg8::Gemm g{XN, (const bf16*)(A.ws + WS_WIN) + (size_t)l * INW * DM, NTOK, INW, DM}; pg8::StaticOrder S; S.init(NTOK, INW, F.G, F.bx);
            EpiStoreBf16 E{H, INW};
            pg8::gemm_phase<EpiStoreBf16, pg8::StaticOrder, true, true>(F.lds, g, S, E);
        } SEAM(pb + 0);
        if (IN(pb + 1)) { MKFRAME(); s5_pass1(F, A, l); pool_phase(F, A); rotary_phase(F, A); } SEAM(pb + 1);
        if (IN(pb + 2)) { MKFRAME(); s5_carry(F, A, l); __syncthreads(); ret_state_phase(F, A); } SEAM(pb + 2);
        if (IN(pb + 3)) { MKFRAME(); s5_pass3(F, A, l); ret_prefix_phase(F, A); } SEAM(pb + 3);
        if (IN(pb + 4)) { MKFRAME();
            __syncthreads();
            ret_out_phase(F, A);
            {
                pg8::Gemm g{(const bf16*)(A.ws + WS_BUFY), (const bf16*)(A.ws + WS_WGLU) + (size_t)l * 512 * 512, NTOK, 512, 512}; pg8::StaticOrder S; S.init(NTOK, 512, F.G, F.bx);
                EpiGlu E{(const bf16*)(A.ws + WS_BUFY), 512, CC, DM, A.in[I_BGLU] + (size_t)l * 512};
                pg8::gemm_phase<EpiGlu, pg8::StaticOrder, true, true>(F.lds, g, S, E);
            }
            {
                pg8::Gemm g{(const bf16*)(A.ws + WS_BUFP), (const bf16*)(A.ws + WS_WPOOL) + (size_t)l * 512 * 512, NTOK, 512, 512}; pg8::StaticOrder S; S.init(NTOK, 512, F.G, F.bx);
                EpiScaleBf16 E{CC + 512, DM, A.in[I_POOLS] + (size_t)l * 512};
                pg8::gemm_phase<EpiScaleBf16, pg8::StaticOrder, true, true>(F.lds, g, S, E);
            }
        } SEAM(pb + 4);
        if (IN(pb + 5)) { MKFRAME();
            pg8::Gemm g{CC, (const bf16*)(A.ws + WS_WOUT) + (size_t)l * DM * DM, NTOK, DM, DM}; pg8::StaticOrder S; S.init(NTOK, DM, F.G, F.bx);
            EpiResid E{A.out, DM, ALPHA};
            pg8::gemm_phase<EpiResid, pg8::StaticOrder, true, true>(F.lds, g, S, E);
        } SEAM(pb + 5);
        if (IN(pb + 6)) { MKFRAME();
            for (int t = F.gw; t < NTOK; t += F.NGW) ln_row(A.out + (size_t)t * DM, A.in[I_LN1G] + (size_t)l * DM, A.in[I_LN1B] + (size_t)l * DM, A.out + (size_t)t * DM, XN + (size_t)t * DM, F.lane);
        } SEAM(pb + 6);
        if (IN(pb + 7)) { MKFRAME();
            pg8::Gemm g{XN, (const bf16*)(A.ws + WS_WS) + (size_t)l * DM * DM, NTOK, DM, DM}; pg8::StaticOrder S; S.init(NTOK, DM, F.G, F.bx);
            EpiStoreF32 E{(float*)(A.ws + WS_H), DM};
            pg8::gemm_phase<EpiStoreF32, pg8::StaticOrder, true, true>(F.lds, g, S, E);
        } SEAM(pb + 7);
        if (IN(pb + 8)) { MKFRAME(); __syncthreads(); topk_phase(F, A); } SEAM(pb + 8);
        if (IN(pb + 9)) { MKFRAME(); peer_gather_phase(F, A, l); } SEAM(pb + 9);
    }
#undef IN
#undef SEAM
}


#ifndef DBG_STOP
#define DBG_STOP NPHASE
#endif
#ifndef DBG_DUMP
#define DBG_DUMP 0
#endif
__global__ void dbg_dump_kernel(float* out, const unsigned char* ws, int mode) {
    const size_t n = (size_t)NTOK * DM;
    for (size_t i = (size_t)blockIdx.x * blockDim.x + threadIdx.x; i < n; i += (size_t)gridDim.x * blockDim.x) {
        float v = 0.f;
        if (mode == 1) v = bf_lo(((const bf16*)(ws + WS_H))[i]);
        else if (mode == 2) v = bf_lo(((const bf16*)(ws + WS_CONCAT))[i]);
        else if (mode == 3) v = bf_lo(((const bf16*)(ws + WS_BUFY))[i % ((size_t)NTOK * 1024)]);
        else if (mode == 4) v = bf_lo(((const bf16*)(ws + WS_STF))[i]);
        else if (mode == 5) v = ((const float*)(ws + WS_H))[i];
        else if (mode == 6) v = (i < (size_t)NTOK * 128) ? (float)((const int*)(ws + WS_IDX))[i] : ((i < (size_t)NTOK * 256) ? ((const float*)(ws + WS_GATE))[i - (size_t)NTOK * 128] : 0.f);
        else if (mode == 7) v = bf_lo(((const bf16*)(ws + WS_XN))[i]);
        else if (mode == 8) v = bf_lo(((const bf16*)(ws + WS_STB))[i]);
        else if (mode == 9) v = bf_lo(((const bf16*)(ws + WS_H))[i + (size_t)NTOK * DM]);
        else if (mode == 10) v = bf_lo(((const bf16*)(ws + WS_WIN))[i % ((size_t)72 * 1024 * 1024)]);
        else if (mode == 11) v = ((const float*)(ws + WS_S5ST))[i % ((size_t)5 * 1024 * 1024)];
        else if (mode == 12) v = bf_lo(((const bf16*)(ws + WS_H))[i]) + bf_lo(((const bf16*)(ws + WS_H))[i + (size_t)NTOK * DM]) + bf_lo(((const bf16*)(ws + WS_BUFP))[i % ((size_t)NTOK * 512)]) + ((const float*)(ws + WS_S5ST))[i % ((size_t)5 * 1024 * 1024)];
        else if (mode == 13) v = bf_lo(((const bf16*)(ws + WS_STF))[i]) + bf_lo(((const bf16*)(ws + WS_STB))[i]) + ((const float*)(ws + WS_S5ST))[i % ((size_t)5 * 1024 * 1024)];
        else if (mode == 14) v = bf_lo(((const bf16*)(ws + WS_STF))[i]) + bf_lo(((const bf16*)(ws + WS_STB))[i]) + bf_lo(((const bf16*)(ws + WS_BUFY))[i % ((size_t)NTOK * 512)]);
        else if (mode == 15) v = bf_lo(((const bf16*)(ws + WS_H))[i]) + bf_lo(((const bf16*)(ws + WS_H))[i + (size_t)NTOK * DM]) + bf_lo(((const bf16*)(ws + WS_H))[i + (size_t)NTOK * 3072]);
        out[i] = v;
    }
}
#ifndef MK_ONE_LAUNCH
#define MK_ONE_LAUNCH 0
#endif
extern "C" void kernel_launch(void* const* d_in, const int* in_sizes, int n_in, void* d_out, int out_size, void* d_ws, size_t ws_size, hipStream_t stream) {
    static int grid = 0;
    if (grid == 0) {
        if (n_in != 26 || out_size != NTOK * DM || ws_size < WS_END) { fprintf(stderr, "kernel_launch: unexpected shapes (n_in %d out %d ws %zu)\n", n_in, out_size, ws_size); grid = -1; return; }
        int dev = 0, cus = 0, per_cu = 0;
        if (hipGetDevice(&dev) != hipSuccess || hipDeviceGetAttribute(&cus, hipDeviceAttributeMultiprocessorCount, dev) != hipSuccess) { grid = -1; return; }
        if (hipFuncSetAttribute((const void*)fwd_kernel, hipFuncAttributeMaxDynamicSharedMemorySize, LDS_BYTES) != hipSuccess) { fprintf(stderr, "kernel_launch: hipFuncSetAttribute failed\n"); grid = -1; return; }
        if (hipOccupancyMaxActiveBlocksPerMultiprocessor(&per_cu, (const void*)fwd_kernel, NTHR, LDS_BYTES) != hipSuccess || per_cu < 1) { fprintf(stderr, "kernel_launch: occupancy query says %d\n", per_cu); grid = -1; (void)hipGetLastError(); return; }
        (void)hipGetLastError();
        grid = cus;
    }
    if (grid < 0) return;
    if (hipMemsetAsync((char*)d_ws + WS_CTL, 0, CTL_ZERO_BYTES, stream) != hipSuccess) return;
    Args a{};
    for (int i = 0; i < 26; ++i) a.in[i] = (const float*)d_in[i];
    a.out = (float*)d_out; a.ws = (unsigned char*)d_ws; a.pad = 0;
#if MK_ONE_LAUNCH
    a.ph_lo = 0; a.ph_hi = NPHASE; a.li = 0;
    hipLaunchKernelGGL(fwd_kernel, dim3(grid), dim3(NTHR), LDS_BYTES, stream, a);
#else
    for (int p = 0; p < DBG_STOP; ++p) { a.ph_lo = p; a.ph_hi = p + 1; a.li = p; hipLaunchKernelGGL(fwd_kernel, dim3(grid), dim3(NTHR), LDS_BYTES, stream, a); }
#endif
    if (DBG_DUMP) hipLaunchKernelGGL(dbg_dump_kernel, dim3(2048), dim3(256), 0, stream, (float*)d_out, (const unsigned char*)d_ws, DBG_DUMP);
}
#endif
```

```cpp
#include <hip/hip_runtime.h>
#include <cstdio>
#include <cstdint>
#include <cmath>
__device__ __forceinline__ int opaque(int v) { asm volatile("" : "+v"(v)); return v; }
__device__ __forceinline__ int opaque_s(int v) { asm volatile("" : "+s"(v)); return v; }
#define MK_ONE_LAUNCH 1
namespace pg8 {
#define PG8_LAS __attribute__((address_space(3)))
typedef unsigned short bf16_t;
typedef short bf16x8 __attribute__((ext_vector_type(8)));
typedef float f32x4 __attribute__((ext_vector_type(4)));
typedef unsigned u32x4 __attribute__((ext_vector_type(4)));
constexpr int BM = 256, BK = 64, HALF = 128, HTB = HALF * BK * 2  , STAGE_BYTES = 8 * HTB, NXCD = 8, WGM = 8;

__host__ __device__ __forceinline__ int lds_byte(int r, int c) { const int st = (r >> 4) * 2 + (c >> 5), rr = r & 15, cc = c & 31, ob = rr * 64 + cc * 2; return st * 1024 + (ob ^ (((ob >> 9) & 1) << 5)); }
__host__ __device__ __forceinline__ void stage_rc(int b, int& R, int& C) { const int st = b / 1024, sb = b % 1024, swz = sb ^ (((sb >> 9) & 1) << 5); R = (st >> 1) * 16 + swz / 64; C = (st & 1) * 32 + (swz % 64) / 2; }
__host__ __device__ __forceinline__ int perm32(int rho) { const int n = rho >> 4, i = rho & 15; return 8 * (i >> 2) + 4 * n + (i & 3); }

struct Unit { int pm, pn; };
struct Gemm { const bf16_t* A; const bf16_t* Bt; int M, N, K; };

struct StaticOrder {
    int nM, nN, nwg, G, c;
    __host__ __device__ void init(int M, int N, int G_, int c_) { nM = M / BM; nN = N / BM; nwg = nM * nN; G = G_; c = c_; }
    __host__ __device__ bool next(int i, Unit& u) const {
        const long L = (long)i * G + c; if (L >= nwg) return false;
        int wgid = (int)L; { const int q = nwg / NXCD, r = nwg % NXCD, xcd = wgid % NXCD, off = wgid / NXCD; wgid = (xcd < r ? xcd * (q + 1) : r * (q + 1) + (xcd - r) * q) + off; }
        const int nig = WGM * nN, gid = wgid / nig, fm = gid * WGM, gsz = (nM - fm) < WGM ? (nM - fm) : WGM;
        u.pm = fm + ((wgid % nig) % gsz); u.pn = (wgid % nig) / gsz; return true;
    }
    __device__ __forceinline__ void a_ready(const Unit&) const {}
    __device__ __forceinline__ void done(const Unit&) const {}
};
__device__ __forceinline__ unsigned cvt_pk_bf16(float lo, float hi) { unsigned r; asm volatile("v_cvt_pk_bf16_f32 %0, %1, %2" : "=v"(r) : "v"(lo), "v"(hi)); return r; }
typedef float f32x2 __attribute__((ext_vector_type(2)));
template <class Epi, class Sched, bool ALIGN_EPI = false, bool SP2 = false>
__device__ __forceinline__ void gemm_phase(PG8_LAS unsigned char* lds, const Gemm g, const Sched& S, const Epi& E) {
    const int tid = opaque((int)threadIdx.x), wid = __builtin_amdgcn_readfirstlane(tid >> 6), lane = tid & 63, wr = wid >> 2, wc = wid & 3, fr = lane & 15, fq = lane >> 4;
    const int K = g.K, nt = K / BK;
    unsigned voffA[2], voffB[2];
#pragma unroll
    for (int i = 0; i < 2; ++i) { int R, C; stage_rc(tid * 16 + i * 8192, R, C); const int Rb = Epi::PERM ? ((R & ~31) + perm32(R & 31)) : R;
        voffA[i] = (unsigned)(R * K + C) * 2u; voffB[i] = (unsigned)(Rb * K + C) * 2u; }
    const size_t kstep = (size_t)(BK * 2);
    const size_t hstep = (size_t)HALF * K * 2;
    const size_t tstep = 2 * hstep;
    const unsigned ldsw = (unsigned)wid * 1024u;
    const int aoff = lds_byte(wr * 64 + fr, fq * 8), boff = lds_byte(wc * 32 + fr, fq * 8);
#define PG8_SA(b, h) (((b) * 2 + (h)) * HTB)
#define PG8_SB(b, h) ((4 + (b) * 2 + (h)) * HTB)
#define PG8_STAGE(bufoff, gbase, voff) do { _Pragma("unroll") for (int _i = 0; _i < 2; ++_i) \
        __builtin_amdgcn_global_load_lds((const unsigned*)((const char*)(gbase) + (voff)[_i]), (PG8_LAS unsigned*)(lds + (bufoff) + ldsw + _i * 8192), 16, 0, 0); } while (0)
#define PG8_LDA(dst, b, h) do { _Pragma("unroll") for (int m = 0; m < 4; ++m) _Pragma("unroll") for (int k = 0; k < 2; ++k) dst[m][k] = *(const PG8_LAS bf16x8*)(lds + PG8_SA(b, h) + aoff + m * 2048 + k * 1024); } while (0)
#define PG8_LDB(dst, b, h) do { _Pragma("unroll") for (int n = 0; n < 2; ++n) _Pragma("unroll") for (int k = 0; k < 2; ++k) dst[n][k] = *(const PG8_LAS bf16x8*)(lds + PG8_SB(b, h) + boff + n * 2048 + k * 1024); } while (0)
#define PG8_MMA(ai, bj, At, Bt) do { __builtin_amdgcn_s_setprio(1); _Pragma("unroll") for (int m = 0; m < 4; ++m) _Pragma("unroll") for (int n = 0; n < 2; ++n) _Pragma("unroll") for (int k = 0; k < 2; ++k) \
        acc[ai][bj][m][n] = __builtin_amdgcn_mfma_f32_16x16x32_bf16(Bt[n][k], At[m][k], acc[ai][bj][m][n], 0, 0, 0); __builtin_amdgcn_s_setprio(0); } while (0)
#define PG8_WAIT_V(n) asm volatile("s_waitcnt vmcnt(" #n ")" ::: "memory")
#define PG8_WAIT_L(n) asm volatile("s_waitcnt lgkmcnt(" #n ")" ::: "memory")
#define PG8_BAR __builtin_amdgcn_s_barrier()
#define PG8_SCHED __builtin_amdgcn_sched_barrier(0)
    Unit cur, nxt; int ui = 0;
    if (!S.next(0, cur)) return;
    f32x4 acc[2][2][4][2];
#pragma unroll
    for (int a = 0; a < 2; ++a)
#pragma unroll
        for (int b = 0; b < 2; ++b)
#pragma unroll
            for (int m = 0; m < 4; ++m)
#pragma unroll
                for (int n = 0; n < 2; ++n) acc[a][b][m][n] = (f32x4){0.f, 0.f, 0.f, 0.f};
    bf16x8 At[4][2], B0[2][2], B1[2][2];
    const char* cA = (const char*)g.A + (size_t)cur.pm * tstep; const char* cB = (const char*)g.Bt + (size_t)cur.pn * tstep;
    S.a_ready(cur);
    if constexpr (SP2) {
        PG8_STAGE(PG8_SB(0, 0), cB, voffB); PG8_STAGE(PG8_SB(0, 1), cB + hstep, voffB); PG8_STAGE(PG8_SA(0, 0), cA, voffA); PG8_STAGE(PG8_SA(0, 1), cA + hstep, voffA);
        if (wr == 1) PG8_BAR;
        PG8_WAIT_V(2); PG8_BAR;
        PG8_STAGE(PG8_SB(1, 0), cB + kstep, voffB); PG8_STAGE(PG8_SA(1, 0), cA + kstep, voffA); PG8_STAGE(PG8_SB(1, 1), cB + hstep + kstep, voffB);
        PG8_WAIT_V(6); PG8_BAR;
    } else {
        PG8_STAGE(PG8_SB(0, 0), cB, voffB); PG8_STAGE(PG8_SA(0, 0), cA, voffA); PG8_STAGE(PG8_SB(0, 1), cB + hstep, voffB); PG8_STAGE(PG8_SA(0, 1), cA + hstep, voffA);
        if (wr == 1) PG8_BAR;
        PG8_WAIT_V(4); PG8_BAR;
        PG8_STAGE(PG8_SB(1, 0), cB + kstep, voffB); PG8_STAGE(PG8_SA(1, 0), cA + kstep, voffA); PG8_STAGE(PG8_SB(1, 1), cB + hstep + kstep, voffB);
        PG8_WAIT_V(6); PG8_BAR;
    }
    for (;;) {
        const bool has_next = S.next(ui + 1, nxt);
        const char* nA = has_next ? (const char*)g.A + (size_t)nxt.pm * tstep : cA; const char* nB = has_next ? (const char*)g.Bt + (size_t)nxt.pn * tstep : cB;
        for (int t = 0; t < nt; t += 2) {
            const bool last = (t == nt - 2);
            const char* a1 = cA + (size_t)(t + 1) * kstep;
            const char* a2 = last ? nA : cA + (size_t)(t + 2) * kstep; const char* b2 = last ? nB : cB + (size_t)(t + 2) * kstep;
            const char* a3 = a2 + kstep; const char* b3 = b2 + kstep;
            if (last && has_next) S.a_ready(nxt);
            if constexpr (SP2) {
            PG8_LDB(B0, 0, 0); PG8_LDB(B1, 0, 1); PG8_SCHED; PG8_LDA(At, 0, 0); PG8_STAGE(PG8_SA(1, 1), a1 + hstep, voffA);
            PG8_WAIT_V(8); PG8_WAIT_L(0); PG8_BAR; PG8_MMA(0, 0, At, B0); PG8_MMA(0, 1, At, B1); PG8_BAR; PG8_SCHED;
            PG8_LDA(At, 0, 1); PG8_STAGE(PG8_SB(0, 0), b2, voffB); PG8_STAGE(PG8_SB(0, 1), b2 + hstep, voffB); PG8_STAGE(PG8_SA(0, 0), a2, voffA);
            PG8_WAIT_V(8); PG8_WAIT_L(0); PG8_BAR; PG8_MMA(1, 0, At, B0); PG8_MMA(1, 1, At, B1); PG8_BAR; PG8_SCHED;
            PG8_LDB(B0, 1, 0); PG8_LDB(B1, 1, 1); PG8_SCHED; PG8_LDA(At, 1, 0); PG8_STAGE(PG8_SA(0, 1), a2 + hstep, voffA);
            PG8_WAIT_V(8); PG8_WAIT_L(0); PG8_BAR; PG8_MMA(0, 0, At, B0); PG8_MMA(0, 1, At, B1); PG8_BAR; PG8_SCHED;
            PG8_LDA(At, 1, 1); PG8_STAGE(PG8_SB(1, 0), b3, voffB); PG8_STAGE(PG8_SB(1, 1), b3 + hstep, voffB); PG8_STAGE(PG8_SA(1, 0), a3, voffA);
            PG8_WAIT_V(8); PG8_WAIT_L(0); PG8_BAR; PG8_MMA(1, 0, At, B0); PG8_MMA(1, 1, At, B1); PG8_BAR; PG8_SCHED;
            } else {
            PG8_LDB(B0, 0, 0); PG8_SCHED; PG8_LDA(At, 0, 0); PG8_STAGE(PG8_SA(1, 1), a1 + hstep, voffA);
            PG8_WAIT_L(8); PG8_BAR; PG8_WAIT_L(0); PG8_MMA(0, 0, At, B0); PG8_BAR; PG8_SCHED;
            PG8_LDB(B1, 0, 1); PG8_STAGE(PG8_SB(0, 0), b2, voffB);
            PG8_BAR; PG8_WAIT_L(0); PG8_MMA(0, 1, At, B1); PG8_BAR;
            PG8_LDA(At, 0, 1); PG8_STAGE(PG8_SA(0, 0), a2, voffA);
            PG8_BAR; PG8_WAIT_L(0); PG8_MMA(1, 0, At, B0); PG8_BAR; PG8_SCHED;
            PG8_STAGE(PG8_SB(0, 1), b2 + hstep, voffB);
            PG8_WAIT_V(6); PG8_BAR; PG8_MMA(1, 1, At, B1); PG8_BAR;
            PG8_LDB(B0, 1, 0); PG8_SCHED; PG8_LDA(At, 1, 0); PG8_STAGE(PG8_SA(0, 1), a2 + hstep, voffA);
            PG8_WAIT_L(8); PG8_BAR; PG8_WAIT_L(0); PG8_MMA(0, 0, At, B0); PG8_BAR; PG8_SCHED;
            PG8_LDB(B1, 1, 1); PG8_STAGE(PG8_SB(1, 0), b3, voffB);
            PG8_BAR; PG8_WAIT_L(0); PG8_MMA(0, 1, At, B1); PG8_BAR;
            PG8_LDA(At, 1, 1); PG8_STAGE(PG8_SA(1, 0), a3, voffA);
            PG8_BAR; PG8_WAIT_L(0); PG8_MMA(1, 0, At, B0); PG8_BAR; PG8_SCHED;
            PG8_STAGE(PG8_SB(1, 1), b3 + hstep, voffB);
            PG8_WAIT_V(6); PG8_BAR; PG8_MMA(1, 1, At, B1); PG8_BAR;
            }
        }
        if constexpr (ALIGN_EPI) { if (wr == 0) PG8_BAR; }
        if constexpr (!Epi::AFTER_DRAIN) { E(acc, cur, wr, wc, fr, fq); S.done(cur); }
        if (!has_next) break;
#pragma unroll
        for (int a = 0; a < 2; ++a)
#pragma unroll
            for (int b = 0; b < 2; ++b)
#pragma unroll
                for (int m = 0; m < 4; ++m)
#pragma unroll
                    for (int n = 0; n < 2; ++n) acc[a][b][m][n] = (f32x4){0.f, 0.f, 0.f, 0.f};
        cur = nxt; cA = nA; cB = nB; ++ui;
        if constexpr (ALIGN_EPI) { if (wr == 1) PG8_BAR; }
    }
    PG8_WAIT_V(0);
    if constexpr (!ALIGN_EPI) { if (wr == 0) PG8_BAR; }
    PG8_BAR;
    if constexpr (Epi::AFTER_DRAIN) { E.fused(acc, cur, wr, wc, fr, fq, lds, wid, lane); S.done(cur); }
#undef PG8_SA
#undef PG8_SB
#undef PG8_STAGE
#undef PG8_LDA
#undef PG8_LDB
#undef PG8_MMA
#undef PG8_WAIT_V
#undef PG8_WAIT_L
#undef PG8_BAR
#undef PG8_SCHED
}
}
#define LAS __attribute__((address_space(3)))
#define XB_TMO      128
#define XB_XCNT(j)  (256  + 64 * (j))
#define XB_XSUB(j)  (1280 + 64 * (j))
#define XB_XGEN(j)  (2304 + 64 * (j))
#define XB_TOP      3328
#define XB_TOPGEN   3392
#define XCD_BAR_WORDS 3456
#define XB_SPIN_CAP (1u << 18)

__device__ __forceinline__ unsigned xb_ld(unsigned* p)              { return __hip_atomic_load(p, __ATOMIC_RELAXED, __HIP_MEMORY_SCOPE_AGENT); }
__device__ __forceinline__ unsigned xb_add(unsigned* p, unsigned v) { return __hip_atomic_fetch_add(p, v, __ATOMIC_RELAXED, __HIP_MEMORY_SCOPE_AGENT); }
__device__ __forceinline__ unsigned xb_xcc_id() { return (unsigned)__builtin_amdgcn_s_getreg((3 << 11) | 20) & 0xFu; }
#define XB_SPIN(cond, bar) do { unsigned _sp = 0; while (cond) { __builtin_amdgcn_s_sleep(1); \
    if ((++_sp & 255u) == 0u) { if (xb_ld(&(bar)[XB_TMO])) break; if (_sp > XB_SPIN_CAP) { atomicAdd(&(bar)[XB_TMO], 1u); break; } } } } while (0)

struct XcdBarrier {
    unsigned* bar; unsigned x;
    volatile LAS unsigned* st;
};

__device__ __forceinline__ XcdBarrier xcd_barrier_post(unsigned* bar, volatile LAS unsigned* st) {
    XcdBarrier b; b.bar = bar; b.x = xb_xcc_id(); b.st = st;
    if (threadIdx.x == 0) (void)xb_add(&bar[XB_XCNT(b.x)], 1u);
    return b;
}
__device__ __forceinline__ void xcd_barrier_complete(unsigned* bar, unsigned x, unsigned& nloc, unsigned& nx) {
    const unsigned G = gridDim.x * gridDim.y * gridDim.z;
    unsigned sum, cnt, mine, sp = 0u;
    for (;;) {
        sum = 0u; cnt = 0u; mine = 0u;
#pragma unroll
        for (unsigned j = 0; j < 16; ++j) { const unsigned c = xb_ld(&bar[XB_XCNT(j)]); sum += c; cnt += (c > 0u) ? 1u : 0u; mine = (j == x) ? c : mine; }
        if (sum == G) break;
        __builtin_amdgcn_s_sleep(1);
        if ((++sp & 255u) == 0u) { if (xb_ld(&bar[XB_TMO])) break; if (sp > XB_SPIN_CAP) { atomicAdd(&bar[XB_TMO], 1u); break; } }
    }
    nloc = mine > 0u ? mine : 1u; nx = cnt > 0u ? cnt : 1u;
}

__device__ __forceinline__ void xcd_barrier(const XcdBarrier& b) {
    asm volatile("s_waitcnt vmcnt(0)" ::: "memory");
    __syncthreads();
    if (threadIdx.x == 0) {
        unsigned* bar = b.bar;
        __builtin_amdgcn_s_waitcnt(0);
        unsigned nloc = b.st[0], nx = b.st[1];
        if (nloc == 0u) { xcd_barrier_complete(bar, b.x, nloc, nx); b.st[0] = nloc; b.st[1] = nx; }
        const unsigned old = xb_add(&bar[XB_XSUB(b.x)], 1u);
        const unsigned gen = old / nloc;
        if (old + 1u == (gen + 1u) * nloc) {
            __builtin_amdgcn_fence(__ATOMIC_RELEASE, "agent");
            asm volatile("s_waitcnt vmcnt(0)" ::: "memory");
            const unsigned og = xb_add(&bar[XB_TOP], 1u);
            const unsigned tg = og / nx;
            if (og + 1u == (tg + 1u) * nx) xb_add(&bar[XB_TOPGEN], 1u);
            else XB_SPIN(xb_ld(&bar[XB_TOPGEN]) == tg, bar);
            __builtin_amdgcn_fence(__ATOMIC_ACQUIRE, "agent");
            xb_add(&bar[XB_XGEN(b.x)], 1u);
            asm volatile("s_waitcnt vmcnt(0)" ::: "memory");
        } else {
            XB_SPIN(xb_ld(&bar[XB_XGEN(b.x)]) == gen, bar);
            __builtin_amdgcn_fence(__ATOMIC_ACQUIRE, "agent");
            asm volatile("s_waitcnt vmcnt(0)" ::: "memory");
        }
    }
    __syncthreads();
}
#undef LAS
using pg8::bf16x8; using pg8::f32x4; using pg8::u32x4; using pg8::f32x2;
#define GAS __attribute__((address_space(1)))
#define LAS __attribute__((address_space(3)))
typedef unsigned short bf16;
typedef unsigned v4u __attribute__((ext_vector_type(4)));
typedef unsigned v2u __attribute__((ext_vector_type(2)));
typedef float f32x2v __attribute__((ext_vector_type(2)));

constexpr int NTOK = 40960, DM = 2048, NLAYER = 4, INW = 5120;
constexpr int COL_UA = 0, COL_UB = 512, COL_Q = 1024, COL_K = 2048, COL_V = 3072, COL_G = 4096;
constexpr float ALPHA = 1.6817928305074290f;
constexpr float LN_EPS = 1e-5f, GN_EPS = 1e-6f;
constexpr int NEXP = 16384;
constexpr int NWAVES = 8, NTHR = 512;

constexpr size_t MiB = 1u << 20;
constexpr size_t WS_CTL = 0, CTL_ZERO_BYTES = 1 * MiB;
constexpr size_t WS_WIN = 1 * MiB;
constexpr size_t WS_WOUT = 81 * MiB;
constexpr size_t WS_WS = 113 * MiB;
constexpr size_t WS_WGLU = 145 * MiB;
constexpr size_t WS_WPOOL = 147 * MiB;
constexpr size_t WS_S5A = 149 * MiB;
constexpr size_t WS_S5B = 150 * MiB;
constexpr size_t WS_ROT = 152 * MiB;
constexpr size_t WS_U16 = 160 * MiB;
constexpr size_t WS_V16 = 416 * MiB;
constexpr size_t WS_XN = 672 * MiB;
constexpr size_t WS_H = 832 * MiB;
constexpr size_t WS_CONCAT = 1232 * MiB;
constexpr size_t WS_BUFY = 1392 * MiB;
constexpr size_t WS_BUFP = 1432 * MiB;
constexpr size_t WS_STF = 1472 * MiB;
constexpr size_t WS_STB = 1632 * MiB;
constexpr size_t WS_IDX = 1792 * MiB;
constexpr size_t WS_GATE = 1812 * MiB;
constexpr size_t WS_S5ST = 1832 * MiB;
constexpr size_t WS_END = 1852 * MiB;
constexpr int CW_BAR = 4096;
constexpr int NPHASE = 1 + NLAYER * 10;

constexpr int LDS_SCRATCH = 147456;
constexpr int LDS_MISC = LDS_SCRATCH;
constexpr int LDS_BYTES = LDS_SCRATCH + 256;

__device__ __forceinline__ float bf_lo(unsigned w) { return __uint_as_float(w << 16); }
__device__ __forceinline__ float bf_hi(unsigned w) { return __uint_as_float(w & 0xffff0000u); }
typedef __bf16 bf16x2_t __attribute__((ext_vector_type(2)));
__device__ __forceinline__ unsigned pkbf(float lo, float hi) { const bf16x2_t v = {(__bf16)lo, (__bf16)hi}; return __builtin_bit_cast(unsigned, v); }
__device__ __forceinline__ bf16 f2bf(float f) { return __builtin_bit_cast(unsigned short, (__bf16)f); }
__device__ __forceinline__ float wave_sum(float v) {
#pragma unroll
    for (int o = 1; o < 64; o <<= 1) v += __shfl_xor(v, o);
    return v;
}
__device__ __forceinline__ float gelu_erf(float v) { return 0.5f * v * (1.0f + erff(v * 0.70710678118654752f)); }
__device__ __forceinline__ int tok_pos(int t) { return t < 32768 ? (t & 4095) : (t - 32768); }
__device__ __forceinline__ int tok_len(int t) { return t < 32768 ? 4096 : 8192; }
__device__ __forceinline__ void unpack8(const v4u q, float (&f)[8]) {
    f[0] = bf_lo(q.x); f[1] = bf_hi(q.x); f[2] = bf_lo(q.y); f[3] = bf_hi(q.y); f[4] = bf_lo(q.z); f[5] = bf_hi(q.z); f[6] = bf_lo(q.w); f[7] = bf_hi(q.w);
}
__device__ __forceinline__ v4u pack8(const float (&f)[8]) { v4u q; q.x = pkbf(f[0], f[1]); q.y = pkbf(f[2], f[3]); q.z = pkbf(f[4], f[5]); q.w = pkbf(f[6], f[7]); return q; }
#define LDS_WAIT() asm volatile("s_waitcnt lgkmcnt(0)" ::: "memory")
#define MFMA16(a, b, c) __builtin_amdgcn_mfma_f32_16x16x32_bf16((a), (b), (c), 0, 0, 0)

struct EpiStoreBf16 {
    static constexpr bool PERM = true, AFTER_DRAIN = false;
    bf16* O; int ldo;
    __device__ __forceinline__ void operator()(const f32x4 (&acc)[2][2][4][2], const pg8::Unit& u, int wr, int wc, int fr, int fq) const {
        const int row0 = u.pm * 256 + wr * 64 + fr, col0 = u.pn * 256 + wc * 32 + 8 * fq;
#pragma unroll
        for (int ai = 0; ai < 2; ++ai)
#pragma unroll
            for (int m = 0; m < 4; ++m) { bf16* rowp = O + (size_t)(row0 + ai * 128 + m * 16) * ldo + col0;
#pragma unroll
                for (int bj = 0; bj < 2; ++bj) { const f32x4 v0 = acc[ai][bj][m][0], v1 = acc[ai][bj][m][1];
                    v4u w; w.x = pkbf(v0[0], v0[1]); w.y = pkbf(v0[2], v0[3]); w.z = pkbf(v1[0], v1[1]); w.w = pkbf(v1[2], v1[3]);
                    *(v4u*)(rowp + bj * 128) = w; } }
    }
};
struct EpiGlu {
    static constexpr bool PERM = true, AFTER_DRAIN = false;
    const bf16* Y; int ldy; bf16* O; int ldo; const float* bias;
    __device__ __forceinline__ void operator()(const f32x4 (&acc)[2][2][4][2], const pg8::Unit& u, int wr, int wc, int fr, int fq) const {
        const int row0 = u.pm * 256 + wr * 64 + fr, col0 = u.pn * 256 + wc * 32 + 8 * fq;
#pragma unroll
        for (int bj = 0; bj < 2; ++bj) {
            const f32x4 b0 = *(const f32x4*)(bias + col0 + bj * 128), b1 = *(const f32x4*)(bias + col0 + bj * 128 + 4);
#pragma unroll
            for (int ai = 0; ai < 2; ++ai)
#pragma unroll
                for (int m = 0; m < 4; ++m) { const size_t r = (size_t)(row0 + ai * 128 + m * 16);
                    const v4u yq = *(const v4u*)(Y + r * ldy + col0 + bj * 128); float y[8]; unpack8(yq, y);
                    const f32x4 v0 = acc[ai][bj][m][0] + b0, v1 = acc[ai][bj][m][1] + b1; float o[8];
#pragma unroll
                    for (int k = 0; k < 4; ++k) { o[k] = y[k] / (1.0f + __expf(-v0[k])); o[4 + k] = y[4 + k] / (1.0f + __expf(-v1[k])); }
                    *(v4u*)(O + r * ldo + col0 + bj * 128) = pack8(o); }
        }
    }
};
struct EpiScaleBf16 {
    static constexpr bool PERM = true, AFTER_DRAIN = false;
    bf16* O; int ldo; const float* scale;
    __device__ __forceinline__ void operator()(const f32x4 (&acc)[2][2][4][2], const pg8::Unit& u, int wr, int wc, int fr, int fq) const {
        const int row0 = u.pm * 256 + wr * 64 + fr, col0 = u.pn * 256 + wc * 32 + 8 * fq;
#pragma unroll
        for (int bj = 0; bj < 2; ++bj) {
            const f32x4 s0 = *(const f32x4*)(scale + col0 + bj * 128), s1 = *(const f32x4*)(scale + col0 + bj * 128 + 4);
#pragma unroll
            for (int ai = 0; ai < 2; ++ai)
#pragma unroll
                for (int m = 0; m < 4; ++m) { const size_t r = (size_t)(row0 + ai * 128 + m * 16);
                    const f32x4 v0 = acc[ai][bj][m][0] * s0, v1 = acc[ai][bj][m][1] * s1;
                    v4u w; w.x = pkbf(v0[0], v0[1]); w.y = pkbf(v0[2], v0[3]); w.z = pkbf(v1[0], v1[1]); w.w = pkbf(v1[2], v1[3]);
                    *(v4u*)(O + r * ldo + col0 + bj * 128) = w; }
        }
    }
};
struct EpiResid {
    static constexpr bool PERM = false, AFTER_DRAIN = false;
    float* X; int ldx; float alpha;
    __device__ __forceinline__ void operator()(const f32x4 (&acc)[2][2][4][2], const pg8::Unit& u, int wr, int wc, int fr, int fq) const {
        const int row0 = u.pm * 256 + wr * 64 + fr, col0 = u.pn * 256 + wc * 32 + 4 * fq;
#pragma unroll
        for (int ai = 0; ai < 2; ++ai)
#pragma unroll
            for (int m = 0; m < 4; ++m) { float* rowp = X + (size_t)(row0 + ai * 128 + m * 16) * ldx + col0;
#pragma unroll
                for (int bj = 0; bj < 2; ++bj)
#pragma unroll
                    for (int n = 0; n < 2; ++n) { f32x4* p = (f32x4*)(rowp + bj * 128 + n * 16); const f32x4 x = *p; *p = x * alpha + acc[ai][bj][m][n]; } }
    }
};
struct EpiStoreF32 {
    static constexpr bool PERM = false, AFTER_DRAIN = false;
    float* C; int ldc;
    __device__ __forceinline__ void operator()(const f32x4 (&acc)[2][2][4][2], const pg8::Unit& u, int wr, int wc, int fr, int fq) const {
        const int row0 = u.pm * 256 + wr * 64 + fr, col0 = u.pn * 256 + wc * 32 + 4 * fq;
#pragma unroll
        for (int ai = 0; ai < 2; ++ai)
#pragma unroll
            for (int m = 0; m < 4; ++m) { float* rowp = C + (size_t)(row0 + ai * 128 + m * 16) * ldc + col0;
#pragma unroll
                for (int bj = 0; bj < 2; ++bj)
#pragma unroll
                    for (int n = 0; n < 2; ++n) *(f32x4*)(rowp + bj * 128 + n * 16) = acc[ai][bj][m][n]; }
    }
};

struct Args { const float* in[26]; float* out; unsigned char* ws; int ph_lo, ph_hi, li, pad; };
struct Frame {
    LAS unsigned char* lds;
    int tid, lane, wave, G, bx;
    int gw, NGW;
    size_t gtid, NT;
    float* out; unsigned char* ws;
};
enum InIdx { I_XP = 0, I_XS, I_LNIN_G, I_LNIN_B, I_WIN, I_LAMRE, I_LAMIM, I_LOGSTEP, I_BRE, I_BIM, I_CRE, I_CIM, I_S5D, I_WGLU, I_BGLU, I_POOLW, I_POOLS,
             I_WOUT, I_LN1G, I_LN1B, I_WQ, I_KEYS, I_PU, I_PV, I_LN2G, I_LN2B };

__device__ __forceinline__ void ln_row(const float* src, const float* g, const float* b, float* dst, bf16* dstb, int lane) {
    f32x4 v[8]; float s = 0.f;
#pragma unroll
    for (int j = 0; j < 8; ++j) { v[j] = ((const f32x4*)src)[lane + 64 * j]; s += (v[j][0] + v[j][1]) + (v[j][2] + v[j][3]); }
    const float mean = wave_sum(s) * (1.0f / DM); float s2 = 0.f;
#pragma unroll
    for (int j = 0; j < 8; ++j) { v[j] = v[j] - mean; s2 += (v[j][0] * v[j][0] + v[j][1] * v[j][1]) + (v[j][2] * v[j][2] + v[j][3] * v[j][3]); }
    const float rstd = 1.0f / sqrtf(wave_sum(s2) * (1.0f / DM) + LN_EPS);
#pragma unroll
    for (int j = 0; j < 8; ++j) { const f32x4 gg = ((const f32x4*)g)[lane + 64 * j], bb = ((const f32x4*)b)[lane + 64 * j];
        const f32x4 o = v[j] * rstd * gg + bb; ((f32x4*)dst)[lane + 64 * j] = o;
        v2u w; w.x = pkbf(o[0], o[1]); w.y = pkbf(o[2], o[3]); ((v2u*)dstb)[lane + 64 * j] = w; }
}

__device__ __forceinline__ void transpose_item(const float* W, int K, int N, bf16* WT, LAS float* scr, int item, int lane) {
    const int nblk = N / 32, kb = item / nblk, nb = item % nblk, k0 = 64 * kb, n0 = 32 * nb;
#pragma unroll 8
    for (int i = 0; i < 32; ++i) { const int kk = 2 * i + (lane >> 5); scr[kk * 33 + (lane & 31)] = W[(size_t)(k0 + kk) * N + n0 + (lane & 31)]; }
    LDS_WAIT();
    const int c = lane & 7;
#pragma unroll
    for (int j = 0; j < 4; ++j) { const int n = (lane >> 3) + 8 * j; const LAS float* s = scr + (8 * c) * 33 + n;
        v4u o; o.x = pkbf(s[0 * 33], s[1 * 33]); o.y = pkbf(s[2 * 33], s[3 * 33]); o.z = pkbf(s[4 * 33], s[5 * 33]); o.w = pkbf(s[6 * 33], s[7 * 33]);
        *(v4u*)(WT + (size_t)(n0 + n) * K + k0 + 8 * c) = o; }
    LDS_WAIT();
}

__device__ __forceinline__ void p0_prologue(const Frame& F, const Args& A) {
    {
        LAS float* scr = (LAS float*)(F.lds + F.wave * 16384);
        constexpr int I_IN = (DM / 64) * (INW / 32), I_OUT = (DM / 64) * (DM / 32), I_GLU = (512 / 64) * (512 / 32);
        constexpr int NITEMS = NLAYER * (I_IN + I_OUT + I_GLU);
        for (int it = F.gw; it < NITEMS; it += F.NGW) {
            int r = it;
            if (r < NLAYER * I_IN) { const int l = r / I_IN; transpose_item(A.in[I_WIN] + (size_t)l * DM * INW, DM, INW, (bf16*)(A.ws + WS_WIN) + (size_t)l * INW * DM, scr, r % I_IN, F.lane); continue; }
            r -= NLAYER * I_IN;
            if (r < NLAYER * I_OUT) { const int l = r / I_OUT; transpose_item(A.in[I_WOUT] + (size_t)l * DM * DM, DM, DM, (bf16*)(A.ws + WS_WOUT) + (size_t)l * DM * DM, scr, r % I_OUT, F.lane); continue; }
            r -= NLAYER * I_OUT;
            { const int l = r / I_GLU; transpose_item(A.in[I_WGLU] + (size_t)l * 512 * 512, 512, 512, (bf16*)(A.ws + WS_WGLU) + (size_t)l * 512 * 512, scr, r % I_GLU, F.lane); }
        }
    }
    {
        const size_t n8 = (size_t)NLAYER * NEXP * DM / 8;
        const float* pu = A.in[I_PU]; const float* pv = A.in[I_PV]; v4u* du = (v4u*)(A.ws + WS_U16); v4u* dv = (v4u*)(A.ws + WS_V16);
        for (size_t i = F.gtid; i < n8; i += F.NT) {
            const f32x4 a = ((const f32x4*)pu)[2 * i], b = ((const f32x4*)pu)[2 * i + 1];
            v4u q; q.x = pkbf(a[0], a[1]); q.y = pkbf(a[2], a[3]); q.z = pkbf(b[0], b[1]); q.w = pkbf(b[2], b[3]); du[i] = q;
            const f32x4 c = ((const f32x4*)pv)[2 * i], d = ((const f32x4*)pv)[2 * i + 1];
            v4u r; r.x = pkbf(c[0], c[1]); r.y = pkbf(c[2], c[3]); r.z = pkbf(d[0], d[1]); r.w = pkbf(d[2], d[3]); dv[i] = r;
        }
    }
    {
        const float* pw = A.in[I_POOLW]; v4u* dst = (v4u*)(A.ws + WS_WPOOL);
        for (size_t i = F.gtid; i < (size_t)NLAYER * 512 * 64; i += F.NT) {
            const int k8 = (int)(i & 63), n = (int)((i >> 6) & 511), l = (int)(i >> 15);
            const int g = n >> 7, d = n & 127, kg = k8 >> 4, c0 = (k8 & 15) * 8;
            float f[8];
#pragma unroll
            for (int k = 0; k < 8; ++k) f[k] = (kg == g) ? pw[(((size_t)l * 4 + g) * 128 + (c0 + k)) * 128 + d] : 0.f;
            dst[i] = pack8(f);
        }
    }
    {
        const float* lre = A.in[I_LAMRE]; const float* lim = A.in[I_LAMIM]; const float* lst = A.in[I_LOGSTEP]; const float* bre = A.in[I_BRE]; const float* bim = A.in[I_BIM];
        f32x2v* ab = (f32x2v*)(A.ws + WS_S5A); f32x2v* ab64 = (f32x2v*)(A.ws + WS_S5A + 512 * 1024); f32x2v* bb = (f32x2v*)(A.ws + WS_S5B);
        for (size_t i = F.gtid; i < (size_t)NLAYER * 2 * 32 * 64; i += F.NT) {
            const float lr = lre[i], li = lim[i], dt = expf(lst[i >> 6]);
            const float mag = expf(lr * dt), ar = mag * cosf(li * dt), ai = mag * sinf(li * dt);
            const float den = lr * lr + li * li;
            const float zr = ((ar - 1.0f) * lr + ai * li) / den, zi = (ai * lr - (ar - 1.0f) * li) / den;
            ab[i] = (f32x2v){ar, ai};
            const float m64 = expf(lr * dt * 64.0f), an = li * dt * 64.0f;
            ab64[i] = (f32x2v){m64 * cosf(an), m64 * sinf(an)};
#pragma unroll
            for (int c = 0; c < 16; ++c) { const float br = bre[i * 16 + c], bi = bim[i * 16 + c]; bb[i * 16 + c] = (f32x2v){zr * br - zi * bi, zr * bi + zi * br}; }
        }
    }
    if (F.bx == 0 && F.tid < 128) {
        ((float*)(A.ws + WS_ROT))[F.tid] = (float)exp(-(double)F.tid / 127.0 * 9.210340371976184);
    }
    __syncthreads();
    {
        LAS float* KS = (LAS float*)F.lds;
        LAS float* WQ = (LAS float*)(F.lds + 128 * 132 * 4);
        const float* keys = A.in[I_KEYS]; const float* wq = A.in[I_WQ]; bf16* wst = (bf16*)(A.ws + WS_WS);
        for (int u = F.bx; u < NLAYER * 16 * 32; u += F.G) {
            const int dtl = u & 31, hp = (u >> 5) & 15, l = u >> 9, p = hp & 1;
#pragma unroll
            for (int r = 0; r < 8; ++r) { const int f = F.tid + 512 * r, nk = f >> 5, c4 = f & 31;
                *(LAS f32x4*)(KS + nk * 132 + c4 * 4) = *(const f32x4*)(keys + (((size_t)l * 2 + p) * 128 + nk) * 128 + c4 * 4); }
#pragma unroll
            for (int r = 0; r < 4; ++r) { const int f = F.tid + 512 * r, dd = f >> 5, c4 = f & 31;
                *(LAS f32x4*)(WQ + dd * 132 + c4 * 4) = *(const f32x4*)(wq + ((size_t)l * DM + dtl * 64 + dd) * DM + hp * 128 + c4 * 4); }
            __syncthreads();
            const int nk = F.tid & 127, dg = F.tid >> 7;
            float acc[16];
#pragma unroll
            for (int i = 0; i < 16; ++i) acc[i] = 0.f;
            for (int c4 = 0; c4 < 32; ++c4) {
                const f32x4 kv = *(const LAS f32x4*)(KS + nk * 132 + c4 * 4);
#pragma unroll
                for (int i = 0; i < 16; ++i) { const f32x4 wv = *(const LAS f32x4*)(WQ + (dg * 16 + i) * 132 + c4 * 4);
                    acc[i] += (kv[0] * wv[0] + kv[1] * wv[1]) + (kv[2] * wv[2] + kv[3] * wv[3]); }
            }
            bf16* o = wst + ((size_t)l * DM + hp * 128 + nk) * DM + dtl * 64 + dg * 16;
            v4u q0, q1; q0.x = pkbf(acc[0], acc[1]); q0.y = pkbf(acc[2], acc[3]); q0.z = pkbf(acc[4], acc[5]); q0.w = pkbf(acc[6], acc[7]);
            q1.x = pkbf(acc[8], acc[9]); q1.y = pkbf(acc[10], acc[11]); q1.z = pkbf(acc[12], acc[13]); q1.w = pkbf(acc[14], acc[15]);
            *(v4u*)o = q0; *(v4u*)(o + 8) = q1;
            __syncthreads();
        }
    }
    for (int t = F.gw; t < NTOK; t += F.NGW) {
        const float* src = t < 32768 ? A.in[I_XP] + (size_t)t * DM : A.in[I_XS] + (size_t)(t - 32768) * DM;
        ln_row(src, A.in[I_LNIN_G], A.in[I_LNIN_B], A.out + (size_t)t * DM, (bf16*)(A.ws + WS_XN) + (size_t)t * DM, F.lane);
    }
}

__device__ __forceinline__ float ret_log2_gamma(int h) { return log2f(1.0f - exp2f(-5.0f - (float)h)); }

__device__ __forceinline__ void s5_pass1(const Frame& F, const Args& A, int l) {
    LAS float* Uw = (LAS float*)(F.lds + F.wave * 4096);
    const bf16* H = (const bf16*)(A.ws + WS_H);
    const f32x2v* ab = (const f32x2v*)(A.ws + WS_S5A); const f32x4* bb = (const f32x4*)(A.ws + WS_S5B);
    f32x2v* st = (f32x2v*)(A.ws + WS_S5ST);
    for (int task = F.gw; task < 640 * 32 * 2; task += F.NGW) {
        const int dir = task & 1, g = (task >> 1) & 31, ck = task >> 6;
        const int pidx = ((l * 2 + dir) * 32 + g) * 64 + F.lane;
        const f32x2v a = ab[pidx];
        float Br[16], Bi[16];
#pragma unroll
        for (int c2 = 0; c2 < 8; ++c2) { const f32x4 q = bb[(size_t)pidx * 8 + c2]; Br[2 * c2] = q[0]; Bi[2 * c2] = q[1]; Br[2 * c2 + 1] = q[2]; Bi[2 * c2 + 1] = q[3]; }
        {
            const bf16* urow = H + (size_t)(ck * 64 + F.lane) * INW + COL_UA + g * 16;
            const v4u q0 = *(const v4u*)urow, q1 = *(const v4u*)(urow + 8); float f0[8], f1[8]; unpack8(q0, f0); unpack8(q1, f1);
            LAS f32x4* d = (LAS f32x4*)(Uw + F.lane * 16);
            d[0] = (f32x4){f0[0], f0[1], f0[2], f0[3]}; d[1] = (f32x4){f0[4], f0[5], f0[6], f0[7]}; d[2] = (f32x4){f1[0], f1[1], f1[2], f1[3]}; d[3] = (f32x4){f1[4], f1[5], f1[6], f1[7]};
        }
        LDS_WAIT();
        float xr = 0.f, xi = 0.f;
        for (int s = 0; s < 64; ++s) {
            const int t = dir ? 63 - s : s;
            const LAS f32x4* up = (const LAS f32x4*)(Uw + t * 16);
            float bur = 0.f, bui = 0.f;
#pragma unroll
            for (int c4 = 0; c4 < 4; ++c4) { const f32x4 uv = up[c4];
#pragma unroll
                for (int k = 0; k < 4; ++k) { bur += Br[4 * c4 + k] * uv[k]; bui += Bi[4 * c4 + k] * uv[k]; } }
            const float nxr = a[0] * xr - a[1] * xi + bur, nxi = a[0] * xi + a[1] * xr + bui; xr = nxr; xi = nxi;
        }
        st[(size_t)((ck * 32 + g) * 2 + dir) * 64 + F.lane] = (f32x2v){xr, xi};
        LDS_WAIT();
    }
}
__device__ __forceinline__ void s5_carry(const Frame& F, const Args& A, int l) {
    const f32x2v* ab64 = (const f32x2v*)(A.ws + WS_S5A + 512 * 1024); f32x2v* st = (f32x2v*)(A.ws + WS_S5ST);
    for (size_t it = F.gtid; it < (size_t)9 * 32 * 2 * 64; it += F.NT) {
        const int p = (int)(it & 63), dir = (int)((it >> 6) & 1), g = (int)((it >> 7) & 31), s = (int)(it >> 12);
        const int ck0 = s < 8 ? s * 64 : 512, n = s < 8 ? 64 : 128;
        const f32x2v a = ab64[((l * 2 + dir) * 32 + g) * 64 + p];
        float cr = 0.f, ci = 0.f;
        for (int k = 0; k < n; ++k) {
            const int ck = dir ? (ck0 + n - 1 - k) : (ck0 + k);
            f32x2v* q = st + (size_t)((ck * 32 + g) * 2 + dir) * 64 + p;
            const f32x2v le = *q; *q = (f32x2v){cr, ci};
            const float ncr = a[0] * cr - a[1] * ci + le[0], nci = a[0] * ci + a[1] * cr + le[1]; cr = ncr; ci = nci;
        }
    }
}
__device__ __forceinline__ void s5_pass3(const Frame& F, const Args& A, int l) {
    LAS unsigned char* wb = F.lds + F.wave * 17152;
    LAS float* Uw = (LAS float*)wb;
    LAS bf16* Xw = (LAS bf16*)(wb + 4096);
    LAS bf16* Ctw = (LAS bf16*)(wb + 4096 + 8704);
    const bf16* H = (const bf16*)(A.ws + WS_H); bf16* BY = (bf16*)(A.ws + WS_BUFY);
    const f32x2v* ab = (const f32x2v*)(A.ws + WS_S5A); const f32x4* bb = (const f32x4*)(A.ws + WS_S5B);
    const f32x2v* st = (const f32x2v*)(A.ws + WS_S5ST);
    const float* cre = A.in[I_CRE]; const float* cim = A.in[I_CIM]; const float* dvec = A.in[I_S5D] + (size_t)l * 512;
    const int lane = F.lane, lr = lane & 15, lq = lane >> 4;
    for (int task = F.gw; task < 640 * 32; task += F.NGW) {
        const int g = task & 31, ck = task >> 5;
        {
            const bf16* urow = H + (size_t)(ck * 64 + lane) * INW + COL_UA + g * 16;
            const v4u q0 = *(const v4u*)urow, q1 = *(const v4u*)(urow + 8); float f0[8], f1[8]; unpack8(q0, f0); unpack8(q1, f1);
            LAS f32x4* d = (LAS f32x4*)(Uw + lane * 16);
            d[0] = (f32x4){f0[0], f0[1], f0[2], f0[3]}; d[1] = (f32x4){f0[4], f0[5], f0[6], f0[7]}; d[2] = (f32x4){f1[0], f1[1], f1[2], f1[3]}; d[3] = (f32x4){f1[4], f1[5], f1[6], f1[7]};
        }
        f32x4 Y[4];
#pragma unroll
        for (int m = 0; m < 4; ++m) Y[m] = (f32x4){0.f, 0.f, 0.f, 0.f};
#pragma unroll
        for (int dir = 0; dir < 2; ++dir) {
            const int pidx = ((l * 2 + dir) * 32 + g) * 64 + lane;
            const f32x2v a = ab[pidx];
            float Br[16], Bi[16];
#pragma unroll
            for (int c2 = 0; c2 < 8; ++c2) { const f32x4 q = bb[(size_t)pidx * 8 + c2]; Br[2 * c2] = q[0]; Bi[2 * c2] = q[1]; Br[2 * c2 + 1] = q[2]; Bi[2 * c2 + 1] = q[3]; }
            {
                const size_t cb = (size_t)((l * 2 + dir) * 32 + g) * 16 * 64;
#pragma unroll
                for (int c = 0; c < 16; ++c) { Ctw[c * 136 + lane] = f2bf(cre[cb + c * 64 + lane]); Ctw[c * 136 + 64 + lane] = f2bf(-cim[cb + c * 64 + lane]); }
            }
            const f32x2v x0 = st[(size_t)((ck * 32 + g) * 2 + dir) * 64 + lane];
            float xr = x0[0], xi = x0[1];
            LDS_WAIT();
#pragma unroll
            for (int half = 0; half < 2; ++half) {
                for (int s = 0; s < 32; ++s) {
                    const int step = half * 32 + s, t = dir ? 63 - step : step;
                    const LAS f32x4* up = (const LAS f32x4*)(Uw + t * 16);
                    float bur = 0.f, bui = 0.f;
#pragma unroll
                    for (int c4 = 0; c4 < 4; ++c4) { const f32x4 uv = up[c4];
#pragma unroll
                        for (int k = 0; k < 4; ++k) { bur += Br[4 * c4 + k] * uv[k]; bui += Bi[4 * c4 + k] * uv[k]; } }
                    const float nxr = a[0] * xr - a[1] * xi + bur, nxi = a[0] * xi + a[1] * xr + bui; xr = nxr; xi = nxi;
                    Xw[(t & 31) * 136 + lane] = f2bf(xr); Xw[(t & 31) * 136 + 64 + lane] = f2bf(xi);
                }
                LDS_WAIT();
                const int tb = dir ? (1 - half) : half;
#pragma unroll
                for (int m = 0; m < 2; ++m)
#pragma unroll
                    for (int ks = 0; ks < 4; ++ks) {
                        const bf16x8 av = *(const LAS bf16x8*)(Ctw + lr * 136 + 32 * ks + lq * 8);
                        const bf16x8 bv = *(const LAS bf16x8*)(Xw + (16 * m + lr) * 136 + 32 * ks + lq * 8);
                        Y[2 * tb + m] = MFMA16(av, bv, Y[2 * tb + m]);
                    }
                LDS_WAIT();
            }
        }
#pragma unroll
        for (int m = 0; m < 4; ++m) {
            const int t = 16 * m + lr, c0 = 4 * lq;
            const f32x4 uv = *(const LAS f32x4*)(Uw + t * 16 + c0); const f32x4 dv = *(const f32x4*)(dvec + g * 16 + c0);
            const f32x4 y = Y[m] + dv * uv;
            v2u w; w.x = pkbf(gelu_erf(y[0]), gelu_erf(y[1])); w.y = pkbf(gelu_erf(y[2]), gelu_erf(y[3]));
            *(v2u*)(BY + (size_t)(ck * 64 + t) * 512 + g * 16 + c0) = w;
        }
        LDS_WAIT();
    }
}
__device__ __forceinline__ void pool_phase(const Frame& F, const Args& A) {
    const bf16* H = (const bf16*)(A.ws + WS_H); bf16* BP = (bf16*)(A.ws + WS_BUFP);
    for (size_t it = F.gtid; it < (size_t)NTOK * 64; it += F.NT) {
        const int t = (int)(it >> 6), o = (int)(it & 63), gi = o >> 4, w = 2 << gi;
        const int pos = tok_pos(t), L = tok_len(t);
        const int lo = max(pos - w / 2, 0), hi = min(pos + w / 2 - 1, L - 1);
        const bf16* base = H + (size_t)(t - pos) * INW + COL_UB + o * 8;
        float s[8];
#pragma unroll
        for (int k = 0; k < 8; ++k) s[k] = 0.f;
        for (int si = lo; si <= hi; ++si) { float f[8]; unpack8(*(const v4u*)(base + (size_t)si * INW), f);
#pragma unroll
            for (int k = 0; k < 8; ++k) s[k] += f[k]; }
        const float inv = 1.0f / (float)(hi - lo + 1);
        float c[8]; unpack8(*(const v4u*)(base + (size_t)pos * INW), c);
#pragma unroll
        for (int k = 0; k < 8; ++k) s[k] = s[k] * inv - c[k];
        *(v4u*)(BP + (size_t)t * 512 + o * 8) = pack8(s);
    }
}
__device__ __forceinline__ void rotary_phase(const Frame& F, const Args& A) {
    bf16* H = (bf16*)(A.ws + WS_H); const float* rot = (const float*)(A.ws + WS_ROT);
    for (size_t it = F.gtid; it < (size_t)NTOK * 16; it += F.NT) {
        const int t = (int)(it >> 4), o = (int)(it & 15); const float pos = (float)tok_pos(t);
        float cs[8], sn[8];
#pragma unroll
        for (int k = 0; k < 8; ++k) { const float ang = pos * rot[o * 8 + k]; cs[k] = cosf(ang); sn[k] = sinf(ang); }
#pragma unroll
        for (int which = 0; which < 2; ++which) {
            const float sc = which ? 0.0625f : 1.0f;
#pragma unroll
            for (int hd = 0; hd < 4; ++hd) {
                bf16* p1 = H + (size_t)t * INW + (which ? COL_K : COL_Q) + hd * 256 + o * 8; bf16* p2 = p1 + 128;
                float x1[8], x2[8], o1[8], o2[8]; unpack8(*(const v4u*)p1, x1); unpack8(*(const v4u*)p2, x2);
#pragma unroll
                for (int k = 0; k < 8; ++k) { o1[k] = (x1[k] * cs[k] - x2[k] * sn[k]) * sc; o2[k] = (x2[k] * cs[k] + x1[k] * sn[k]) * sc; }
                *(v4u*)p1 = pack8(o1); *(v4u*)p2 = pack8(o2);
            }
        }
    }
}
constexpr int RS = 136;
__device__ __forceinline__ void ret_state_phase(const Frame& F, const Args& A) {
    const bf16* H = (const bf16*)(A.ws + WS_H); bf16* STF = (bf16*)(A.ws + WS_STF); bf16* STB = (bf16*)(A.ws + WS_STB);
    LAS bf16* Kt = (LAS bf16*)F.lds; LAS bf16* VtF = Kt + 128 * RS; LAS bf16* VtB = Kt + 256 * RS;
    const int tid = F.tid, lane = F.lane, lr = lane & 15, lq = lane >> 4, we = F.wave >> 1, wd = F.wave & 1;
    for (int u = F.bx; u < 5120; u += F.G) {
        const int dh = u & 1, eh = (u >> 1) & 1, h = (u >> 2) & 3, c = u >> 4;
        {
            const int tq = opaque(tid), jp = tq & 63, j = 2 * jp, pc0 = tq >> 6;
            const bf16* krow = H + (size_t)(c * 128 + j) * INW + COL_K + h * 256 + dh * 128;
            const bf16* vrow = H + (size_t)(c * 128 + j) * INW + COL_V + h * 256 + eh * 128;
            const float lg = ret_log2_gamma(h), fF0 = exp2f(lg * (float)(127 - j)), fF1 = exp2f(lg * (float)(126 - j)), fB0 = exp2f(lg * (float)j), fB1 = exp2f(lg * (float)(j + 1));
            LAS unsigned* Kt32 = (LAS unsigned*)Kt; LAS unsigned* VtF32 = (LAS unsigned*)VtF; LAS unsigned* VtB32 = (LAS unsigned*)VtB;
#pragma unroll
            for (int r = 0; r < 2; ++r) {
                const int pc = pc0 + 8 * r;
                const v4u k0 = *(const v4u*)(krow + pc * 8), k1 = *(const v4u*)(krow + INW + pc * 8);
                const v4u v0 = *(const v4u*)(vrow + pc * 8), v1 = *(const v4u*)(vrow + INW + pc * 8);
                const unsigned ka0[4] = {k0.x, k0.y, k0.z, k0.w}, ka1[4] = {k1.x, k1.y, k1.z, k1.w};
                float f0[8], f1[8]; unpack8(v0, f0); unpack8(v1, f1);
#pragma unroll
                for (int i = 0; i < 8; ++i) {
                    const unsigned a = ka0[i >> 1], b = ka1[i >> 1];
                    const unsigned kk = (i & 1) ? ((a >> 16) | (b & 0xffff0000u)) : ((a & 0xffffu) | (b << 16));
                    const int o = ((pc * 8 + i) * RS) / 2 + jp;
                    Kt32[o] = kk; VtF32[o] = pkbf(f0[i] * fF0, f1[i] * fF1); VtB32[o] = pkbf(f0[i] * fB0, f1[i] * fB1);
                }
            }
        }
        __syncthreads();
        f32x4 aF[4][2], aB[4][2];
#pragma unroll
        for (int td = 0; td < 4; ++td)
#pragma unroll
            for (int te = 0; te < 2; ++te) { aF[td][te] = (f32x4){0.f, 0.f, 0.f, 0.f}; aB[td][te] = (f32x4){0.f, 0.f, 0.f, 0.f}; }
#pragma unroll
        for (int ks = 0; ks < 4; ++ks) {
            bf16x8 ka[4], vF[2], vB[2];
#pragma unroll
            for (int td = 0; td < 4; ++td) ka[td] = *(const LAS bf16x8*)(Kt + (64 * wd + 16 * td + lr) * RS + 32 * ks + lq * 8);
#pragma unroll
            for (int te = 0; te < 2; ++te) { vF[te] = *(const LAS bf16x8*)(VtF + (32 * we + 16 * te + lr) * RS + 32 * ks + lq * 8); vB[te] = *(const LAS bf16x8*)(VtB + (32 * we + 16 * te + lr) * RS + 32 * ks + lq * 8); }
#pragma unroll
            for (int td = 0; td < 4; ++td)
#pragma unroll
                for (int te = 0; te < 2; ++te) { aF[td][te] = MFMA16(ka[td], vF[te], aF[td][te]); aB[td][te] = MFMA16(ka[td], vB[te], aB[td][te]); }
        }
#pragma unroll
        for (int td = 0; td < 4; ++td)
#pragma unroll
            for (int te = 0; te < 2; ++te) {
                const int e = eh * 128 + 32 * we + 16 * te + lr, d = dh * 128 + 64 * wd + 16 * td + 4 * lq;
                const size_t off = ((size_t)(c * 4 + h) * 256 + e) * 256 + d;
                v2u w; w.x = pkbf(aF[td][te][0], aF[td][te][1]); w.y = pkbf(aF[td][te][2], aF[td][te][3]); *(v2u*)(STF + off) = w;
                v2u x; x.x = pkbf(aB[td][te][0], aB[td][te][1]); x.y = pkbf(aB[td][te][2], aB[td][te][3]); *(v2u*)(STB + off) = x;
            }
        __syncthreads();
    }
}
__device__ __forceinline__ void ret_prefix_phase(const Frame& F, const Args& A) {
    bf16* STF = (bf16*)(A.ws + WS_STF); bf16* STB = (bf16*)(A.ws + WS_STB);
    for (size_t it = F.gtid; it < (size_t)36 * 2 * 8192; it += F.NT) {
        const int o = (int)(it & 8191), which = (int)((it >> 13) & 1), bh = (int)(it >> 14), h = bh & 3, s = bh >> 2;
        const int c0 = s < 8 ? s * 32 : 256, n = s < 8 ? 32 : 64;
        const float dec = exp2f(128.0f * ret_log2_gamma(h));
        float st[8];
#pragma unroll
        for (int k = 0; k < 8; ++k) st[k] = 0.f;
        bf16* base = (which ? STB : STF) + (size_t)h * 65536 + (size_t)o * 8;
        for (int k = 0; k < n; ++k) {
            const int c = which ? (c0 + n - 1 - k) : (c0 + k);
            v4u* p = (v4u*)(base + (size_t)c * 4 * 65536);
            float f[8]; unpack8(*p, f);
#pragma unroll
            for (int i = 0; i < 8; ++i) st[i] = dec * st[i] + f[i];
            *p = pack8(st);
        }
    }
}
__device__ __forceinline__ void ret_out_phase(const Frame& F, const Args& A) {
    const bf16* H = (const bf16*)(A.ws + WS_H); const bf16* STF = (const bf16*)(A.ws + WS_STF); const bf16* STB = (const bf16*)(A.ws + WS_STB);
    bf16* CC = (bf16*)(A.ws + WS_CONCAT);
    LAS bf16* RA = (LAS bf16*)F.lds; LAS bf16* RB = RA + 128 * RS; LAS bf16* RC = RA + 384 * RS;
    const int tid = F.tid, lane = F.lane, lr = lane & 15, lq = lane >> 4, wi = F.wave >> 2, wj = F.wave & 3, we = F.wave & 3;
    for (int u = F.bx; u < 1280; u += F.G) {
        const int h = u & 3, c = u >> 2, t0 = c * 128;
        const int cs = c < 256 ? (c & 31) : (c - 256), ncs = c < 256 ? 32 : 64;
        const bool has_f = cs > 0, has_b = cs < ncs - 1;
        const float lg = ret_log2_gamma(h);
        f32x4 S[4][2];
#pragma unroll
        for (int ti = 0; ti < 4; ++ti)
#pragma unroll
            for (int tj = 0; tj < 2; ++tj) S[ti][tj] = (f32x4){0.f, 0.f, 0.f, 0.f};
#pragma unroll
        for (int dh = 0; dh < 2; ++dh) {
            if (dh) __syncthreads();
#pragma unroll 1
            for (int r = 0; r < 4; ++r) { const int f = opaque(tid) + 512 * r, row = f >> 4, pc = f & 15;
                const bf16* src = H + (size_t)(t0 + row) * INW + h * 256 + dh * 128 + pc * 8;
                *(LAS v4u*)(RA + row * RS + pc * 8) = *(const v4u*)(src + COL_Q);
                *(LAS v4u*)(RB + row * RS + pc * 8) = *(const v4u*)(src + COL_K); }
            __syncthreads();
#pragma unroll
            for (int ks = 0; ks < 4; ++ks) {
                bf16x8 ka[2], qb[4];
#pragma unroll
                for (int tj = 0; tj < 2; ++tj) ka[tj] = *(const LAS bf16x8*)(RB + (32 * wj + 16 * tj + lr) * RS + 32 * ks + lq * 8);
#pragma unroll
                for (int ti = 0; ti < 4; ++ti) qb[ti] = *(const LAS bf16x8*)(RA + (64 * wi + 16 * ti + lr) * RS + 32 * ks + lq * 8);
#pragma unroll
                for (int ti = 0; ti < 4; ++ti)
#pragma unroll
                    for (int tj = 0; tj < 2; ++tj) S[ti][tj] = MFMA16(ka[tj], qb[ti], S[ti][tj]);
            }
        }
#pragma unroll
        for (int ti = 0; ti < 4; ++ti)
#pragma unroll
            for (int tj = 0; tj < 2; ++tj) {
                const int i = 64 * wi + 16 * ti + lr, j0 = 32 * wj + 16 * tj + 4 * lq; float p[4];
#pragma unroll
                for (int jj = 0; jj < 4; ++jj) { const int d = i - (j0 + jj); p[jj] = S[ti][tj][jj] * exp2f(lg * (float)(d < 0 ? -d : d)); }
                v2u w; w.x = pkbf(p[0], p[1]); w.y = pkbf(p[2], p[3]); *(LAS v2u*)(RC + i * RS + j0) = w;
            }
        __syncthreads();
        {
            const int tq = opaque(tid), jp = tq & 63, pc0 = tq >> 6; const bf16* vrow = H + (size_t)(t0 + 2 * jp) * INW + COL_V + h * 256;
            LAS unsigned* RB32 = (LAS unsigned*)RB;
#pragma unroll 1
            for (int r = 0; r < 4; ++r) { const int pc = pc0 + 8 * r; const v4u v0 = *(const v4u*)(vrow + pc * 8), v1 = *(const v4u*)(vrow + INW + pc * 8);
                const unsigned va0[4] = {v0.x, v0.y, v0.z, v0.w}, va1[4] = {v1.x, v1.y, v1.z, v1.w};
#pragma unroll
                for (int i = 0; i < 8; ++i) { const unsigned a = va0[i >> 1], b = va1[i >> 1];
                    RB32[((pc * 8 + i) * RS) / 2 + jp] = (i & 1) ? ((a >> 16) | (b & 0xffff0000u)) : ((a & 0xffffu) | (b << 16)); } }
        }
        __syncthreads();
        f32x4 O[4][4];
#pragma unroll
        for (int ti = 0; ti < 4; ++ti)
#pragma unroll
            for (int te = 0; te < 4; ++te) O[ti][te] = (f32x4){0.f, 0.f, 0.f, 0.f};
#pragma unroll
        for (int ks = 0; ks < 4; ++ks) {
            bf16x8 va[4], pb[4];
#pragma unroll
            for (int te = 0; te < 4; ++te) va[te] = *(const LAS bf16x8*)(RB + (64 * we + 16 * te + lr) * RS + 32 * ks + lq * 8);
#pragma unroll
            for (int ti = 0; ti < 4; ++ti) pb[ti] = *(const LAS bf16x8*)(RC + (64 * wi + 16 * ti + lr) * RS + 32 * ks + lq * 8);
#pragma unroll
            for (int ti = 0; ti < 4; ++ti)
#pragma unroll
                for (int te = 0; te < 4; ++te) O[ti][te] = MFMA16(va[te], pb[ti], O[ti][te]);
        }
#pragma unroll
        for (int dir = 0; dir < 2; ++dir) {
            if (dir == 0 ? has_f : has_b) {
                const bf16* St = (dir == 0 ? STF + (size_t)((c - 1) * 4 + h) * 65536 : STB + (size_t)((c + 1) * 4 + h) * 65536);
#pragma unroll
                for (int dh = 0; dh < 2; ++dh) {
                    __syncthreads();
#pragma unroll 1
                    for (int r = 0; r < 4; ++r) { const int f = opaque(tid) + 512 * r, row = f >> 4, pc = f & 15;
                        const float fac = exp2f(lg * (dir == 0 ? (float)(row + 1) : (float)(128 - row)));
                        float qf[8]; unpack8(*(const v4u*)(H + (size_t)(t0 + row) * INW + COL_Q + h * 256 + dh * 128 + pc * 8), qf);
#pragma unroll
                        for (int k = 0; k < 8; ++k) qf[k] *= fac;
                        *(LAS v4u*)(RA + row * RS + pc * 8) = pack8(qf); }
#pragma unroll 2
                    for (int r = 0; r < 8; ++r) { const int f = opaque(tid) + 512 * r, row = f >> 4, pc = f & 15;
                        *(LAS v4u*)(RB + row * RS + pc * 8) = *(const v4u*)(St + (size_t)row * 256 + dh * 128 + pc * 8); }
                    __syncthreads();
#pragma unroll
                    for (int ks = 0; ks < 4; ++ks) {
                        bf16x8 sa[4], qb[4];
#pragma unroll
                        for (int te = 0; te < 4; ++te) sa[te] = *(const LAS bf16x8*)(RB + (64 * we + 16 * te + lr) * RS + 32 * ks + lq * 8);
#pragma unroll
                        for (int ti = 0; ti < 4; ++ti) qb[ti] = *(const LAS bf16x8*)(RA + (64 * wi + 16 * ti + lr) * RS + 32 * ks + lq * 8);
#pragma unroll
                        for (int ti = 0; ti < 4; ++ti)
#pragma unroll
                            for (int te = 0; te < 4; ++te) O[ti][te] = MFMA16(sa[te], qb[ti], O[ti][te]);
                    }
                }
            }
        }
        __syncthreads();
        LAS float* RED = (LAS float*)RA;
#pragma unroll
        for (int ti = 0; ti < 4; ++ti) { float s1 = 0.f, s2 = 0.f;
#pragma unroll
            for (int te = 0; te < 4; ++te)
#pragma unroll
                for (int jj = 0; jj < 4; ++jj) { const float v = O[ti][te][jj]; s1 += v; s2 += v * v; }
            s1 += __shfl_xor(s1, 16); s1 += __shfl_xor(s1, 32); s2 += __shfl_xor(s2, 16); s2 += __shfl_xor(s2, 32);
            if (lq == 0) { RED[((64 * wi + 16 * ti + lr) * 4 + we) * 2] = s1; RED[((64 * wi + 16 * ti + lr) * 4 + we) * 2 + 1] = s2; } }
        __syncthreads();
#pragma unroll
        for (int ti = 0; ti < 4; ++ti) { const int i = 64 * wi + 16 * ti + lr;
            const f32x4 r0 = *(const LAS f32x4*)(RED + i * 8), r1 = *(const LAS f32x4*)(RED + i * 8 + 4);
            const float m = (r0[0] + r0[2] + r1[0] + r1[2]) * (1.0f / 256.0f), q = (r0[1] + r0[3] + r1[1] + r1[3]) * (1.0f / 256.0f);
            const float var = fmaxf(q - m * m, 0.f), rstd = 1.0f / sqrtf(var + GN_EPS);
#pragma unroll
            for (int te = 0; te < 4; ++te) { const int e0 = 64 * we + 16 * te + 4 * lq;
                const v2u gq = *(const v2u*)(H + (size_t)(t0 + i) * INW + COL_G + h * 256 + e0);
                const float gv[4] = {bf_lo(gq.x), bf_hi(gq.x), bf_lo(gq.y), bf_hi(gq.y)}; float ov[4];
#pragma unroll
                for (int jj = 0; jj < 4; ++jj) { const float gg = gv[jj]; ov[jj] = (gg / (1.0f + __expf(-gg))) * ((O[ti][te][jj] - m) * rstd); }
                v2u w; w.x = pkbf(ov[0], ov[1]); w.y = pkbf(ov[2], ov[3]);
                *(v2u*)(CC + (size_t)(t0 + i) * DM + 1024 + h * 256 + e0) = w; } }
        __syncthreads();
    }
}

__device__ __forceinline__ void topk_insert(float (&tv)[16], int (&ti)[16], float v, int n) {
    if (v > tv[15]) {
        tv[15] = v; ti[15] = n;
#pragma unroll
        for (int k = 15; k >= 1; --k) {
            const bool sw = tv[k] > tv[k - 1];
            const float a = tv[k - 1], b = tv[k]; const int ia = ti[k - 1], ib = ti[k];
            tv[k - 1] = sw ? b : a; tv[k] = sw ? a : b; ti[k - 1] = sw ? ib : ia; ti[k] = sw ? ia : ib;
        }
    }
}
__device__ __forceinline__ void topk_phase(const Frame& F, const Args& A) {
    const float* SC = (const float*)(A.ws + WS_H); int* IDX = (int*)(A.ws + WS_IDX); float* GATE = (float*)(A.ws + WS_GATE);
    LAS float* LV = (LAS float*)F.lds;
    LAS int* LI = (LAS int*)(F.lds + 512 * 17 * 4);
    const int tid = F.tid, tl = tid >> 4, hp = tid & 15;
    for (int blk = F.bx; blk < NTOK / 32; blk += F.G) {
        const int t = blk * 32 + tl;
        const float* row = SC + (size_t)t * DM + hp * 128;
        float tv[16]; int ti[16];
#pragma unroll
        for (int k = 0; k < 16; ++k) { tv[k] = -INFINITY; ti[k] = 0; }
        for (int n4 = 0; n4 < 32; ++n4) {
            const f32x4 v = *(const f32x4*)(row + n4 * 4);
            topk_insert(tv, ti, v[0], n4 * 4); topk_insert(tv, ti, v[1], n4 * 4 + 1); topk_insert(tv, ti, v[2], n4 * 4 + 2); topk_insert(tv, ti, v[3], n4 * 4 + 3);
        }
#pragma unroll
        for (int k = 0; k < 16; ++k) { LV[tid * 17 + k] = tv[k]; LI[tid * 17 + k] = ti[k]; }
        __syncthreads();
        if ((hp & 1) == 0) {
            float a[16], b[16];
#pragma unroll
            for (int k = 0; k < 16; ++k) { a[k] = LV[tid * 17 + k]; b[k] = LV[(tid + 1) * 17 + k]; }
            float sv[16]; int si[16];
#pragma unroll
            for (int k = 0; k < 16; ++k) { sv[k] = -INFINITY; si[k] = 0; }
#pragma unroll
            for (int i = 0; i < 16; ++i)
#pragma unroll
                for (int j = 0; j < 16; ++j) if ((i + 1) * (j + 1) <= 16) topk_insert(sv, si, a[i] + b[j], i * 16 + j);
            float e[16], sum = 0.f;
#pragma unroll
            for (int k = 0; k < 16; ++k) { e[k] = __expf(sv[k] - sv[0]); sum += e[k]; }
            const float inv = 1.0f / sum; const int head = hp >> 1;
#pragma unroll
            for (int k = 0; k < 16; ++k) {
                const int cell = si[k];
                IDX[(size_t)t * 128 + head * 16 + k] = LI[tid * 17 + (cell >> 4)] * 128 + LI[(tid + 1) * 17 + (cell & 15)];
                GATE[(size_t)t * 128 + head * 16 + k] = e[k] * inv;
            }
        }
        __syncthreads();
    }
}
__device__ __forceinline__ void peer_gather_phase(const Frame& F, const Args& A, int l) {
    const bf16* U16 = (const bf16*)(A.ws + WS_U16) + (size_t)l * NEXP * DM; const bf16* V16 = (const bf16*)(A.ws + WS_V16) + (size_t)l * NEXP * DM;
    const int* IDX = (const int*)(A.ws + WS_IDX); const float* GATE = (const float*)(A.ws + WS_GATE);
    const float* g2 = A.in[I_LN2G] + (size_t)l * DM; const float* b2 = A.in[I_LN2B] + (size_t)l * DM;
    bf16* XN = (bf16*)(A.ws + WS_XN);
    const int lane = F.lane, slot = 8 * (lane & 7) + (lane >> 3);
    for (int t = F.gw; t < NTOK; t += F.NGW) {
        float* xrow = A.out + (size_t)t * DM;
        float x[4][8];
#pragma unroll
        for (int c = 0; c < 4; ++c) { const f32x4 a = *(const f32x4*)(xrow + (c * 64 + lane) * 8), b = *(const f32x4*)(xrow + (c * 64 + lane) * 8 + 4);
            x[c][0] = a[0]; x[c][1] = a[1]; x[c][2] = a[2]; x[c][3] = a[3]; x[c][4] = b[0]; x[c][5] = b[1]; x[c][6] = b[2]; x[c][7] = b[3]; }
        int idxp[2]; float wv[2];
#pragma unroll
        for (int hf = 0; hf < 2; ++hf) {
            idxp[hf] = IDX[(size_t)t * 128 + hf * 64 + slot];
            const float gate = GATE[(size_t)t * 128 + hf * 64 + slot];
            float hval = 0.f;
            for (int outer = 0; outer < 8; ++outer) {
                float part[8];
#pragma unroll
                for (int ii = 0; ii < 8; ++ii) {
                    const int e = __builtin_amdgcn_readlane(idxp[hf], ii * 8 + outer);
                    const bf16* urow = U16 + (size_t)e * DM;
                    float s = 0.f;
#pragma unroll
                    for (int c = 0; c < 4; ++c) { const v4u w = *(const v4u*)(urow + (c * 64 + lane) * 8);
                        s += bf_lo(w.x) * x[c][0]; s += bf_hi(w.x) * x[c][1]; s += bf_lo(w.y) * x[c][2]; s += bf_hi(w.y) * x[c][3];
                        s += bf_lo(w.z) * x[c][4]; s += bf_hi(w.z) * x[c][5]; s += bf_lo(w.w) * x[c][6]; s += bf_hi(w.w) * x[c][7]; }
                    part[ii] = s;
                }
                {
                    const bool b5 = (lane & 32) != 0, b4 = (lane & 16) != 0, b3 = (lane & 8) != 0;
#pragma unroll
                    for (int i = 0; i < 4; ++i) { const float mine = b5 ? part[i + 4] : part[i], send = b5 ? part[i] : part[i + 4]; part[i] = mine + __shfl_xor(send, 32); }
#pragma unroll
                    for (int i = 0; i < 2; ++i) { const float mine = b4 ? part[i + 2] : part[i], send = b4 ? part[i] : part[i + 2]; part[i] = mine + __shfl_xor(send, 16); }
                    { const float mine = b3 ? part[1] : part[0], send = b3 ? part[0] : part[1]; part[0] = mine + __shfl_xor(send, 8); }
                    float v = part[0]; v += __shfl_xor(v, 4); v += __shfl_xor(v, 2); v += __shfl_xor(v, 1);
                    hval = ((lane & 7) == outer) ? v : hval;
                }
            }
            wv[hf] = gate * gelu_erf(hval);
        }
        float acc[4][8];
#pragma unroll
        for (int c = 0; c < 4; ++c)
#pragma unroll
            for (int k = 0; k < 8; ++k) acc[c][k] = 0.f;
#pragma unroll
        for (int hf = 0; hf < 2; ++hf) {
#pragma unroll 4
            for (int ll = 0; ll < 64; ++ll) {
                const int e = __builtin_amdgcn_readlane(idxp[hf], ll);
                const float w = __uint_as_float((unsigned)__builtin_amdgcn_readlane((int)__float_as_uint(wv[hf]), ll));
                const bf16* vrow = V16 + (size_t)e * DM;
#pragma unroll
                for (int c = 0; c < 4; ++c) { const v4u q = *(const v4u*)(vrow + (c * 64 + lane) * 8);
                    acc[c][0] += w * bf_lo(q.x); acc[c][1] += w * bf_hi(q.x); acc[c][2] += w * bf_lo(q.y); acc[c][3] += w * bf_hi(q.y);
                    acc[c][4] += w * bf_lo(q.z); acc[c][5] += w * bf_hi(q.z); acc[c][6] += w * bf_lo(q.w); acc[c][7] += w * bf_hi(q.w); }
            }
        }
        float s = 0.f;
#pragma unroll
        for (int c = 0; c < 4; ++c)
#pragma unroll
            for (int k = 0; k < 8; ++k) { acc[c][k] = ALPHA * x[c][k] + acc[c][k]; s += acc[c][k]; }
        const float mean = wave_sum(s) * (1.0f / DM); float s2 = 0.f;
#pragma unroll
        for (int c = 0; c < 4; ++c)
#pragma unroll
            for (int k = 0; k < 8; ++k) { acc[c][k] -= mean; s2 += acc[c][k] * acc[c][k]; }
        const float rstd = 1.0f / sqrtf(wave_sum(s2) * (1.0f / DM) + LN_EPS);
#pragma unroll
        for (int c = 0; c < 4; ++c) { const int col = (c * 64 + lane) * 8;
            const f32x4 ga = *(const f32x4*)(g2 + col), gb = *(const f32x4*)(g2 + col + 4), ba = *(const f32x4*)(b2 + col), bb = *(const f32x4*)(b2 + col + 4);
            float o[8];
#pragma unroll
            for (int k = 0; k < 4; ++k) { o[k] = acc[c][k] * rstd * ga[k] + ba[k]; o[4 + k] = acc[c][4 + k] * rstd * gb[k] + bb[k]; }
            *(f32x4*)(xrow + col) = (f32x4){o[0], o[1], o[2], o[3]}; *(f32x4*)(xrow + col + 4) = (f32x4){o[4], o[5], o[6], o[7]};
            *(v4u*)(XN + (size_t)t * DM + col) = pack8(o); }
    }
}

#ifndef PHASE_TEST_ONLY
__global__ void __launch_bounds__(NTHR, 2) fwd_kernel(Args A) {
    extern __shared__ __attribute__((aligned(16))) unsigned char lds_raw[];
#define MKFRAME() Frame F; { F.lds = (LAS unsigned char*)lds_raw; F.tid = opaque((int)threadIdx.x); F.lane = F.tid & 63; F.wave = __builtin_amdgcn_readfirstlane(F.tid >> 6); \
        const int bx_ = opaque_s((int)blockIdx.x); F.G = gridDim.x; F.gw = bx_ * NWAVES + F.wave; F.NGW = F.G * NWAVES; F.gtid = (size_t)bx_ * NTHR + F.tid; F.NT = (size_t)F.G * NTHR; F.out = A.out; F.ws = A.ws; F.bx = bx_; }
    volatile LAS unsigned* MISC = (volatile LAS unsigned*)((LAS unsigned char*)lds_raw + LDS_MISC);
    if (threadIdx.x < 64) MISC[threadIdx.x] = 0u;
    __syncthreads();
    XcdBarrier bar = xcd_barrier_post((unsigned*)(A.ws + WS_CTL) + CW_BAR + A.li * XCD_BAR_WORDS, MISC + 8);
    const int lo = A.ph_lo, hi = A.ph_hi;
#define IN(k) (lo <= (k) && (k) < hi)
#define SEAM(k) do { if (lo <= (k) && (k) + 1 < hi) xcd_barrier(bar); } while (0)

    if (IN(0)) { MKFRAME(); p0_prologue(F, A); } SEAM(0);

    for (int l = 0; l < NLAYER; ++l) {
        const int pb = 1 + l * 10;
        bf16* XN = (bf16*)(A.ws + WS_XN); bf16* H = (bf16*)(A.ws + WS_H); bf16* CC = (bf16*)(A.ws + WS_CONCAT);
        if (IN(pb + 0)) { MKFRAME();
            pg8::Gemm g{XN, (const bf16*)(A.ws + WS_WIN) + (size_t)l * INW * DM, NTOK, INW, DM}; pg8::StaticOrder S; S.init(NTOK, INW, F.G, F.bx);
            EpiStoreBf16 E{H, INW};
            pg8::gemm_phase<EpiStoreBf16, pg8::StaticOrder, true, true>(F.lds, g, S, E);
        } SEAM(pb + 0);
        if (IN(pb + 1)) { MKFRAME(); s5_pass1(F, A, l); pool_phase(F, A); rotary_phase(F, A); } SEAM(pb + 1);
        if (IN(pb + 2)) { MKFRAME(); s5_carry(F, A, l); __syncthreads(); ret_state_phase(F, A); } SEAM(pb + 2);
        if (IN(pb + 3)) { MKFRAME(); s5_pass3(F, A, l); ret_prefix_phase(F, A); } SEAM(pb + 3);
        if (IN(pb + 4)) { MKFRAME();
            __syncthreads();
            ret_out_phase(F, A);
            {
                pg8::Gemm g{(const bf16*)(A.ws + WS_BUFY), (const bf16*)(A.ws + WS_WGLU) + (size_t)l * 512 * 512, NTOK, 512, 512}; pg8::StaticOrder S; S.init(NTOK, 512, F.G, F.bx);
                EpiGlu E{(const bf16*)(A.ws + WS_BUFY), 512, CC, DM, A.in[I_BGLU] + (size_t)l * 512};
                pg8::gemm_phase<EpiGlu, pg8::StaticOrder, true, true>(F.lds, g, S, E);
            }
            {
                pg8::Gemm g{(const bf16*)(A.ws + WS_BUFP), (const bf16*)(A.ws + WS_WPOOL) + (size_t)l * 512 * 512, NTOK, 512, 512}; pg8::StaticOrder S; S.init(NTOK, 512, F.G, F.bx);
                EpiScaleBf16 E{CC + 512, DM, A.in[I_POOLS] + (size_t)l * 512};
                pg8::gemm_phase<EpiScaleBf16, pg8::StaticOrder, true, true>(F.lds, g, S, E);
            }
        } SEAM(pb + 4);
        if (IN(pb + 5)) { MKFRAME();
            pg8::Gemm g{CC, (const bf16*)(A.ws + WS_WOUT) + (size_t)l * DM * DM, NTOK, DM, DM}; pg8::StaticOrder S; S.init(NTOK, DM, F.G, F.bx);
            EpiResid E{A.out, DM, ALPHA};
            pg8::gemm_phase<EpiResid, pg8::StaticOrder, true, true>(F.lds, g, S, E);
        } SEAM(pb + 5);
        if (IN(pb + 6)) { MKFRAME();
            for (int t = F.gw; t < NTOK; t += F.NGW) ln_row(A.out + (size_t)t * DM, A.in[I_LN1G] + (size_t)l * DM, A.in[I_LN1B] + (size_t)l * DM, A.out + (size_t)t * DM, XN + (size_t)t * DM, F.lane);
        } SEAM(pb + 6);
        if (IN(pb + 7)) { MKFRAME();
            pg8::Gemm g{XN, (const bf16*)(A.ws + WS_WS) + (size_t)l * DM * DM, NTOK, DM, DM}; pg8::StaticOrder S; S.init(NTOK, DM, F.G, F.bx);
            EpiStoreF32 E{(float*)(A.ws + WS_H), DM};
            pg8::gemm_phase<EpiStoreF32, pg8::StaticOrder, true, true>(F.lds, g, S, E);
        } SEAM(pb + 7);
        if (IN(pb + 8)) { MKFRAME(); __syncthreads(); topk_phase(F, A); } SEAM(pb + 8);
        if (IN(pb + 9)) { MKFRAME(); peer_gather_phase(F, A, l); } SEAM(pb + 9);
    }
#undef IN
#undef SEAM
}


#ifndef DBG_STOP
#define DBG_STOP NPHASE
#endif
#ifndef DBG_DUMP
#define DBG_DUMP 0
#endif
__global__ void dbg_dump_kernel(float* out, const unsigned char* ws, int mode) {
    const size_t n = (size_t)NTOK * DM;
    for (size_t i = (size_t)blockIdx.x * blockDim.x + threadIdx.x; i < n; i += (size_t)gridDim.x * blockDim.x) {
        float v = 0.f;
        if (mode == 1) v = bf_lo(((const bf16*)(ws + WS_H))[i]);
        else if (mode == 2) v = bf_lo(((const bf16*)(ws + WS_CONCAT))[i]);
        else if (mode == 3) v = bf_lo(((const bf16*)(ws + WS_BUFY))[i % ((size_t)NTOK * 1024)]);
        else if (mode == 4) v = bf_lo(((const bf16*)(ws + WS_STF))[i]);
        else if (mode == 5) v = ((const float*)(ws + WS_H))[i];
        else if (mode == 6) v = (i < (size_t)NTOK * 128) ? (float)((const int*)(ws + WS_IDX))[i] : ((i < (size_t)NTOK * 256) ? ((const float*)(ws + WS_GATE))[i - (size_t)NTOK * 128] : 0.f);
        else if (mode == 7) v = bf_lo(((const bf16*)(ws + WS_XN))[i]);
        else if (mode == 8) v = bf_lo(((const bf16*)(ws + WS_STB))[i]);
        else if (mode == 9) v = bf_lo(((const bf16*)(ws + WS_H))[i + (size_t)NTOK * DM]);
        else if (mode == 10) v = bf_lo(((const bf16*)(ws + WS_WIN))[i % ((size_t)72 * 1024 * 1024)]);
        else if (mode == 11) v = ((const float*)(ws + WS_S5ST))[i % ((size_t)5 * 1024 * 1024)];
        else if (mode == 12) v = bf_lo(((const bf16*)(ws + WS_H))[i]) + bf_lo(((const bf16*)(ws + WS_H))[i + (size_t)NTOK * DM]) + bf_lo(((const bf16*)(ws + WS_BUFP))[i % ((size_t)NTOK * 512)]) + ((const float*)(ws + WS_S5ST))[i % ((size_t)5 * 1024 * 1024)];
        else if (mode == 13) v = bf_lo(((const bf16*)(ws + WS_STF))[i]) + bf_lo(((const bf16*)(ws + WS_STB))[i]) + ((const float*)(ws + WS_S5ST))[i % ((size_t)5 * 1024 * 1024)];
        else if (mode == 14) v = bf_lo(((const bf16*)(ws + WS_STF))[i]) + bf_lo(((const bf16*)(ws + WS_STB))[i]) + bf_lo(((const bf16*)(ws + WS_BUFY))[i % ((size_t)NTOK * 512)]);
        else if (mode == 15) v = bf_lo(((const bf16*)(ws + WS_H))[i]) + bf_lo(((const bf16*)(ws + WS_H))[i + (size_t)NTOK * DM]) + bf_lo(((const bf16*)(ws + WS_H))[i + (size_t)NTOK * 3072]);
        out[i] = v;
    }
}
#ifndef MK_ONE_LAUNCH
#define MK_ONE_LAUNCH 0
#endif
extern "C" void kernel_launch(void* const* d_in, const int* in_sizes, int n_in, void* d_out, int out_size, void* d_ws, size_t ws_size, hipStream_t stream) {
    static int grid = 0;
    if (grid == 0) {
        if (n_in != 26 || out_size != NTOK * DM || ws_size < WS_END) { fprintf(stderr, "kernel_launch: unexpected shapes (n_in %d out %d ws %zu)\n", n_in, out_size, ws_size); grid = -1; return; }
        int dev = 0, cus = 0, per_cu = 0;
        if (hipGetDevice(&dev) != hipSuccess || hipDeviceGetAttribute(&cus, hipDeviceAttributeMultiprocessorCount, dev) != hipSuccess) { grid = -1; return; }
        if (hipFuncSetAttribute((const void*)fwd_kernel, hipFuncAttributeMaxDynamicSharedMemorySize, LDS_BYTES) != hipSuccess) { fprintf(stderr, "kernel_launch: hipFuncSetAttribute failed\n"); grid = -1; return; }
        if (hipOccupancyMaxActiveBlocksPerMultiprocessor(&per_cu, (const void*)fwd_kernel, NTHR, LDS_BYTES) != hipSuccess || per_cu < 1) { fprintf(stderr, "kernel_launch: occupancy query says %d\n", per_cu); grid = -1; (void)hipGetLastError(); return; }
        (void)hipGetLastError();
        grid = cus;
    }
    if (grid < 0) return;
    if (hipMemsetAsync((char*)d_ws + WS_CTL, 0, CTL_ZERO_BYTES, stream) != hipSuccess) return;
    Args a{};
    for (int i = 0; i < 26; ++i) a.in[i] = (const float*)d_in[i];
    a.out = (float*)d_out; a.ws = (unsigned char*)d_ws; a.pad = 0;
#if MK_ONE_LAUNCH
    a.ph_lo = 0; a.ph_hi = NPHASE; a.li = 0;
    hipLaunchKernelGGL(fwd_kernel, dim3(grid), dim3(NTHR), LDS_BYTES, stream, a);
#else
    for (int p = 0; p < DBG_STOP; ++p) { a.ph_lo = p; a.ph_hi = p + 1; a.li = p; hipLaunchKernelGGL(fwd_kernel, dim3(grid), dim3(NTHR), LDS_BYTES, stream, a); }
#endif
    if (DBG_DUMP) hipLaunchKernelGGL(dbg_dump_kernel, dim3(2048), dim3(256), 0, stream, (float*)d_out, (const unsigned char*)d_ws, DBG_DUMP);
}
#endif
```

```cpp
#include <hip/hip_runtime.h>
#include <cstdio>
#include <cstdint>
#include <cmath>
__device__ __forceinline__ int opaque(int v) { asm volatile("" : "+v"(v)); return v; }
__device__ __forceinline__ int opaque_s(int v) { asm volatile("" : "+s"(v)); return v; }
#define MK_ONE_LAUNCH 1
namespace pg8 {
#define PG8_LAS __attribute__((address_space(3)))
typedef unsigned short bf16_t;
typedef short bf16x8 __attribute__((ext_vector_type(8)));
typedef float f32x4 __attribute__((ext_vector_type(4)));
typedef unsigned u32x4 __attribute__((ext_vector_type(4)));
constexpr int BM = 256, BK = 64, HALF = 128, HTB = HALF * BK * 2  , STAGE_BYTES = 8 * HTB, NXCD = 8, WGM = 8;

__host__ __device__ __forceinline__ int lds_byte(int r, int c) { const int st = (r >> 4) * 2 + (c >> 5), rr = r & 15, cc = c & 31, ob = rr * 64 + cc * 2; return st * 1024 + (ob ^ (((ob >> 9) & 1) << 5)); }
__host__ __device__ __forceinline__ void stage_rc(int b, int& R, int& C) { const int st = b / 1024, sb = b % 1024, swz = sb ^ (((sb >> 9) & 1) << 5); R = (st >> 1) * 16 + swz / 64; C = (st & 1) * 32 + (swz % 64) / 2; }
__host__ __device__ __forceinline__ int perm32(int rho) { const int n = rho >> 4, i = rho & 15; return 8 * (i >> 2) + 4 * n + (i & 3); }

struct Unit { int pm, pn; };
struct Gemm { const bf16_t* A; const bf16_t* Bt; int M, N, K; };

struct StaticOrder {
    int nM, nN, nwg, G, c;
    __host__ __device__ void init(int M, int N, int G_, int c_) { nM = M / BM; nN = N / BM; nwg = nM * nN; G = G_; c = c_; }
    __host__ __device__ bool next(int i, Unit& u) const {
        const long L = (long)i * G + c; if (L >= nwg) return false;
        int wgid = (int)L; { const int q = nwg / NXCD, r = nwg % NXCD, xcd = wgid % NXCD, off = wgid / NXCD; wgid = (xcd < r ? xcd * (q + 1) : r * (q + 1) + (xcd - r) * q) + off; }
        const int nig = WGM * nN, gid = wgid / nig, fm = gid * WGM, gsz = (nM - fm) < WGM ? (nM - fm) : WGM;
        u.pm = fm + ((wgid % nig) % gsz); u.pn = (wgid % nig) / gsz; return true;
    }
    __device__ __forceinline__ void a_ready(const Unit&) const {}
    __device__ __forceinline__ void done(const Unit&) const {}
};
__device__ __forceinline__ unsigned cvt_pk_bf16(float lo, float hi) { unsigned r; asm volatile("v_cvt_pk_bf16_f32 %0, %1, %2" : "=v"(r) : "v"(lo), "v"(hi)); return r; }
typedef float f32x2 __attribute__((ext_vector_type(2)));
template <class Epi, class Sched, bool ALIGN_EPI = false, bool SP2 = false>
__device__ __forceinline__ void gemm_phase(PG8_LAS unsigned char* lds, const Gemm g, const Sched& S, const Epi& E) {
    const int tid = opaque((int)threadIdx.x), wid = __builtin_amdgcn_readfirstlane(tid >> 6), lane = tid & 63, wr = wid >> 2, wc = wid & 3, fr = lane & 15, fq = lane >> 4;
    const int K = g.K, nt = K / BK;
    unsigned voffA[2], voffB[2];
#pragma unroll
    for (int i = 0; i < 2; ++i) { int R, C; stage_rc(tid * 16 + i * 8192, R, C); const int Rb = Epi::PERM ? ((R & ~31) + perm32(R & 31)) : R;
        voffA[i] = (unsigned)(R * K + C) * 2u; voffB[i] = (unsigned)(Rb * K + C) * 2u; }
    const size_t kstep = (size_t)(BK * 2);
    const size_t hstep = (size_t)HALF * K * 2;
    const size_t tstep = 2 * hstep;
    const unsigned ldsw = (unsigned)wid * 1024u;
    const int aoff = lds_byte(wr * 64 + fr, fq * 8), boff = lds_byte(wc * 32 + fr, fq * 8);
#define PG8_SA(b, h) (((b) * 2 + (h)) * HTB)
#define PG8_SB(b, h) ((4 + (b) * 2 + (h)) * HTB)
#define PG8_STAGE(bufoff, gbase, voff) do { _Pragma("unroll") for (int _i = 0; _i < 2; ++_i) \
        __builtin_amdgcn_global_load_lds((const unsigned*)((const char*)(gbase) + (voff)[_i]), (PG8_LAS unsigned*)(lds + (bufoff) + ldsw + _i * 8192), 16, 0, 0); } while (0)
#define PG8_LDA(dst, b, h) do { _Pragma("unroll") for (int m = 0; m < 4; ++m) _Pragma("unroll") for (int k = 0; k < 2; ++k) dst[m][k] = *(const PG8_LAS bf16x8*)(lds + PG8_SA(b, h) + aoff + m * 2048 + k * 1024); } while (0)
#define PG8_LDB(dst, b, h) do { _Pragma("unroll") for (int n = 0; n < 2; ++n) _Pragma("unroll") for (int k = 0; k < 2; ++k) dst[n][k] = *(const PG8_LAS bf16x8*)(lds + PG8_SB(b, h) + boff + n * 2048 + k * 1024); } while (0)
#define PG8_MMA(ai, bj, At, Bt) do { __builtin_amdgcn_s_setprio(1); _Pragma("unroll") for (int m = 0; m < 4; ++m) _Pragma("unroll") for (int n = 0; n < 2; ++n) _Pragma("unroll") for (int k = 0; k < 2; ++k) \
        acc[ai][bj][m][n] = __builtin_amdgcn_mfma_f32_16x16x32_bf16(Bt[n][k], At[m][k], acc[ai][bj][m][n], 0, 0, 0); __builtin_amdgcn_s_setprio(0); } while (0)
#define PG8_WAIT_V(n) asm volatile("s_waitcnt vmcnt(" #n ")" ::: "memory")
#define PG8_WAIT_L(n) asm volatile("s_waitcnt lgkmcnt(" #n ")" ::: "memory")
#define PG8_BAR __builtin_amdgcn_s_barrier()
#define PG8_SCHED __builtin_amdgcn_sched_barrier(0)
    Unit cur, nxt; int ui = 0;
    if (!S.next(0, cur)) return;
    f32x4 acc[2][2][4][2];
#pragma unroll
    for (int a = 0; a < 2; ++a)
#pragma unroll
        for (int b = 0; b < 2; ++b)
#pragma unroll
            for (int m = 0; m < 4; ++m)
#pragma unroll
                for (int n = 0; n < 2; ++n) acc[a][b][m][n] = (f32x4){0.f, 0.f, 0.f, 0.f};
    bf16x8 At[4][2], B0[2][2], B1[2][2];
    const char* cA = (const char*)g.A + (size_t)cur.pm * tstep; const char* cB = (const char*)g.Bt + (size_t)cur.pn * tstep;
    S.a_ready(cur);
    if constexpr (SP2) {
        PG8_STAGE(PG8_SB(0, 0), cB, voffB); PG8_STAGE(PG8_SB(0, 1), cB + hstep, voffB); PG8_STAGE(PG8_SA(0, 0), cA, voffA); PG8_STAGE(PG8_SA(0, 1), cA + hstep, voffA);
        if (wr == 1) PG8_BAR;
        PG8_WAIT_V(2); PG8_BAR;
        PG8_STAGE(PG8_SB(1, 0), cB + kstep, voffB); PG8_STAGE(PG8_SA(1, 0), cA + kstep, voffA); PG8_STAGE(PG8_SB(1, 1), cB + hstep + kstep, voffB);
        PG8_WAIT_V(6); PG8_BAR;
    } else {
        PG8_STAGE(PG8_SB(0, 0), cB, voffB); PG8_STAGE(PG8_SA(0, 0), cA, voffA); PG8_STAGE(PG8_SB(0, 1), cB + hstep, voffB); PG8_STAGE(PG8_SA(0, 1), cA + hstep, voffA);
        if (wr == 1) PG8_BAR;
        PG8_WAIT_V(4); PG8_BAR;
        PG8_STAGE(PG8_SB(1, 0), cB + kstep, voffB); PG8_STAGE(PG8_SA(1, 0), cA + kstep, voffA); PG8_STAGE(PG8_SB(1, 1), cB + hstep + kstep, voffB);
        PG8_WAIT_V(6); PG8_BAR;
    }
    for (;;) {
        const bool has_next = S.next(ui + 1, nxt);
        const char* nA = has_next ? (const char*)g.A + (size_t)nxt.pm * tstep : cA; const char* nB = has_next ? (const char*)g.Bt + (size_t)nxt.pn * tstep : cB;
        for (int t = 0; t < nt; t += 2) {
            const bool last = (t == nt - 2);
            const char* a1 = cA + (size_t)(t + 1) * kstep;
            const char* a2 = last ? nA : cA + (size_t)(t + 2) * kstep; const char* b2 = last ? nB : cB + (size_t)(t + 2) * kstep;
            const char* a3 = a2 + kstep; const char* b3 = b2 + kstep;
            if (last && has_next) S.a_ready(nxt);
            if constexpr (SP2) {
            PG8_LDB(B0, 0, 0); PG8_LDB(B1, 0, 1); PG8_SCHED; PG8_LDA(At, 0, 0); PG8_STAGE(PG8_SA(1, 1), a1 + hstep, voffA);
            PG8_WAIT_V(8); PG8_WAIT_L(0); PG8_BAR; PG8_MMA(0, 0, At, B0); PG8_MMA(0, 1, At, B1); PG8_BAR; PG8_SCHED;
            PG8_LDA(At, 0, 1); PG8_STAGE(PG8_SB(0, 0), b2, voffB); PG8_STAGE(PG8_SB(0, 1), b2 + hstep, voffB); PG8_STAGE(PG8_SA(0, 0), a2, voffA);
            PG8_WAIT_V(8); PG8_WAIT_L(0); PG8_BAR; PG8_MMA(1, 0, At, B0); PG8_MMA(1, 1, At, B1); PG8_BAR; PG8_SCHED;
            PG8_LDB(B0, 1, 0); PG8_LDB(B1, 1, 1); PG8_SCHED; PG8_LDA(At, 1, 0); PG8_STAGE(PG8_SA(0, 1), a2 + hstep, voffA);
            PG8_WAIT_V(8); PG8_WAIT_L(0); PG8_BAR; PG8_MMA(0, 0, At, B0); PG8_MMA(0, 1, At, B1); PG8_BAR; PG8_SCHED;
            PG8_LDA(At, 1, 1); PG8_STAGE(PG8_SB(1, 0), b3, voffB); PG8_STAGE(PG8_SB(1, 1), b3 + hstep, voffB); PG8_STAGE(PG8_SA(1, 0), a3, voffA);
            PG8_WAIT_V(8); PG8_WAIT_L(0); PG8_BAR; PG8_MMA(1, 0, At, B0); PG8_MMA(1, 1, At, B1); PG8_BAR; PG8_SCHED;
            } else {
            PG8_LDB(B0, 0, 0); PG8_SCHED; PG8_LDA(At, 0, 0); PG8_STAGE(PG8_SA(1, 1), a1 + hstep, voffA);
            PG8_WAIT_L(8); PG8_BAR; PG8_WAIT_L(0); PG8_MMA(0, 0, At, B0); PG8_BAR; PG8_SCHED;
            PG8_LDB(B1, 0, 1); PG8_STAGE(PG8_SB(0, 0), b2, voffB);
            PG8_BAR; PG8_WAIT_L(0); PG8_MMA(0, 1, At, B1); PG8_BAR;
            PG8_LDA(At, 0, 1); PG8_STAGE(PG8_SA(0, 0), a2, voffA);
            PG8_BAR; PG8_WAIT_L(0); PG8_MMA(1, 0, At, B0); PG8_BAR; PG8_SCHED;
            PG8_STAGE(PG8_SB(0, 1), b2 + hstep, voffB);
            PG8_WAIT_V(6); PG8_BAR; PG8_MMA(1, 1, At, B1); PG8_BAR;
            PG8_LDB(B0, 1, 0); PG8_SCHED; PG8_LDA(At, 1, 0); PG8_STAGE(PG8_SA(0, 1), a2 + hstep, voffA);
            PG8_WAIT_L(8); PG8_BAR; PG8_WAIT_L(0); PG8_MMA(0, 0, At, B0); PG8_BAR; PG8_SCHED;
            PG8_LDB(B1, 1, 1); PG8_STAGE(PG8_SB(1, 0), b3, voffB);
            PG8_BAR; PG8_WAIT_L(0); PG8_MMA(0, 1, At, B1); PG8_BAR;
            PG8_LDA(At, 1, 1); PG8_STAGE(PG8_SA(1, 0), a3, voffA);
            PG8_BAR; PG8_WAIT_L(0); PG8_MMA(1, 0, At, B0); PG8_BAR; PG8_SCHED;
            PG8_STAGE(PG8_SB(1, 1), b3 + hstep, voffB);
            PG8_WAIT_V(6); PG8_BAR; PG8_MMA(1, 1, At, B1); PG8_BAR;
            }
        }
        if constexpr (ALIGN_EPI) { if (wr == 0) PG8_BAR; }
        if constexpr (!Epi::AFTER_DRAIN) { E(acc, cur, wr, wc, fr, fq); S.done(cur); }
        if (!has_next) break;
#pragma unroll
        for (int a = 0; a < 2; ++a)
#pragma unroll
            for (int b = 0; b < 2; ++b)
#pragma unroll
                for (int m = 0; m < 4; ++m)
#pragma unroll
                    for (int n = 0; n < 2; ++n) acc[a][b][m][n] = (f32x4){0.f, 0.f, 0.f, 0.f};
        cur = nxt; cA = nA; cB = nB; ++ui;
        if constexpr (ALIGN_EPI) { if (wr == 1) PG8_BAR; }
    }
    PG8_WAIT_V(0);
    if constexpr (!ALIGN_EPI) { if (wr == 0) PG8_BAR; }
    PG8_BAR;
    if constexpr (Epi::AFTER_DRAIN) { E.fused(acc, cur, wr, wc, fr, fq, lds, wid, lane); S.done(cur); }
#undef PG8_SA
#undef PG8_SB
#undef PG8_STAGE
#undef PG8_LDA
#undef PG8_LDB
#undef PG8_MMA
#undef PG8_WAIT_V
#undef PG8_WAIT_L
#undef PG8_BAR
#undef PG8_SCHED
}
}
#define LAS __attribute__((address_space(3)))
#define XB_TMO      128
#define XB_XCNT(j)  (256  + 64 * (j))
#define XB_XSUB(j)  (1280 + 64 * (j))
#define XB_XGEN(j)  (2304 + 64 * (j))
#define XB_TOP      3328
#define XB_TOPGEN   3392
#define XCD_BAR_WORDS 3456
#define XB_SPIN_CAP (1u << 18)

__device__ __forceinline__ unsigned xb_ld(unsigned* p)              { return __hip_atomic_load(p, __ATOMIC_RELAXED, __HIP_MEMORY_SCOPE_AGENT); }
__device__ __forceinline__ unsigned xb_add(unsigned* p, unsigned v) { return __hip_atomic_fetch_add(p, v, __ATOMIC_RELAXED, __HIP_MEMORY_SCOPE_AGENT); }
__device__ __forceinline__ unsigned xb_xcc_id() { return (unsigned)__builtin_amdgcn_s_getreg((3 << 11) | 20) & 0xFu; }
#define XB_SPIN(cond, bar) do { unsigned _sp = 0; while (cond) { __builtin_amdgcn_s_sleep(1); \
    if ((++_sp & 255u) == 0u) { if (xb_ld(&(bar)[XB_TMO])) break; if (_sp > XB_SPIN_CAP) { atomicAdd(&(bar)[XB_TMO], 1u); break; } } } } while (0)

struct XcdBarrier {
    unsigned* bar; unsigned x;
    volatile LAS unsigned* st;
};

__device__ __forceinline__ XcdBarrier xcd_barrier_post(unsigned* bar, volatile LAS unsigned* st) {
    XcdBarrier b; b.bar = bar; b.x = xb_xcc_id(); b.st = st;
    if (threadIdx.x == 0) (void)xb_add(&bar[XB_XCNT(b.x)], 1u);
    return b;
}
__device__ __forceinline__ void xcd_barrier_complete(unsigned* bar, unsigned x, unsigned& nloc, unsigned& nx) {
    const unsigned G = gridDim.x * gridDim.y * gridDim.z;
    unsigned sum, cnt, mine, sp = 0u;
    for (;;) {
        sum = 0u; cnt = 0u; mine = 0u;
#pragma unroll
        for (unsigned j = 0; j < 16; ++j) { const unsigned c = xb_ld(&bar[XB_XCNT(j)]); sum += c; cnt += (c > 0u) ? 1u : 0u; mine = (j == x) ? c : mine; }
        if (sum == G) break;
        __builtin_amdgcn_s_sleep(1);
        if ((++sp & 255u) == 0u) { if (xb_ld(&bar[XB_TMO])) break; if (sp > XB_SPIN_CAP) { atomicAdd(&bar[XB_TMO], 1u); break; } }
    }
    nloc = mine > 0u ? mine : 1u; nx = cnt > 0u ? cnt : 1u;
}

__device__ __forceinline__ void xcd_barrier(const XcdBarrier& b) {
    asm volatile("s_waitcnt vmcnt(0)" ::: "memory");
    __syncthreads();
    if (threadIdx.x == 0) {
        unsigned* bar = b.bar;
        __builtin_amdgcn_s_waitcnt(0);
        unsigned nloc = b.st[0], nx = b.st[1];
        if (nloc == 0u) { xcd_barrier_complete(bar, b.x, nloc, nx); b.st[0] = nloc; b.st[1] = nx; }
        const unsigned old = xb_add(&bar[XB_XSUB(b.x)], 1u);
        const unsigned gen = old / nloc;
        if (old + 1u == (gen + 1u) * nloc) {
            __builtin_amdgcn_fence(__ATOMIC_RELEASE, "agent");
            asm volatile("s_waitcnt vmcnt(0)" ::: "memory");
            const unsigned og = xb_add(&bar[XB_TOP], 1u);
            const unsigned tg = og / nx;
            if (og + 1u == (tg + 1u) * nx) xb_add(&bar[XB_TOPGEN], 1u);
            else XB_SPIN(xb_ld(&bar[XB_TOPGEN]) == tg, bar);
            __builtin_amdgcn_fence(__ATOMIC_ACQUIRE, "agent");
            xb_add(&bar[XB_XGEN(b.x)], 1u);
            asm volatile("s_waitcnt vmcnt(0)" ::: "memory");
        } else {
            XB_SPIN(xb_ld(&bar[XB_XGEN(b.x)]) == gen, bar);
            __builtin_amdgcn_fence(__ATOMIC_ACQUIRE, "agent");
            asm volatile("s_waitcnt vmcnt(0)" ::: "memory");
        }
    }
    __syncthreads();
}
#undef LAS
using pg8::bf16x8; using pg8::f32x4; using pg8::u32x4; using pg8::f32x2;
#define GAS __attribute__((address_space(1)))
#define LAS __attribute__((address_space(3)))
typedef unsigned short bf16;
typedef unsigned v4u __attribute__((ext_vector_type(4)));
typedef unsigned v2u __attribute__((ext_vector_type(2)));
typedef float f32x2v __attribute__((ext_vector_type(2)));

constexpr int NTOK = 40960, DM = 2048, NLAYER = 4, INW = 5120;
constexpr int COL_UA = 0, COL_UB = 512, COL_Q = 1024, COL_K = 2048, COL_V = 3072, COL_G = 4096;
constexpr float ALPHA = 1.6817928305074290f;
constexpr float LN_EPS = 1e-5f, GN_EPS = 1e-6f;
constexpr int NEXP = 16384;
constexpr int NWAVES = 8, NTHR = 512;

constexpr size_t MiB = 1u << 20;
constexpr size_t WS_CTL = 0, CTL_ZERO_BYTES = 1 * MiB;
constexpr size_t WS_WIN = 1 * MiB;
constexpr size_t WS_WOUT = 81 * MiB;
constexpr size_t WS_WS = 113 * MiB;
constexpr size_t WS_WGLU = 145 * MiB;
constexpr size_t WS_WPOOL = 147 * MiB;
constexpr size_t WS_S5A = 149 * MiB;
constexpr size_t WS_S5B = 150 * MiB;
constexpr size_t WS_ROT = 152 * MiB;
constexpr size_t WS_U16 = 160 * MiB;
constexpr size_t WS_V16 = 416 * MiB;
constexpr size_t WS_U8 = 160 * MiB;
constexpr size_t WS_V8 = 288 * MiB;
constexpr size_t WS_USC = 416 * MiB;
constexpr size_t WS_VSC = 417 * MiB;
constexpr size_t WS_XN = 672 * MiB;
constexpr size_t WS_H = 832 * MiB;
constexpr size_t WS_CONCAT = 1232 * MiB;
constexpr size_t WS_BUFY = 1392 * MiB;
constexpr size_t WS_BUFP = 1432 * MiB;
constexpr size_t WS_STF = 1472 * MiB;
constexpr size_t WS_STB = 1632 * MiB;
constexpr size_t WS_IDX = 1792 * MiB;
constexpr size_t WS_GATE = 1812 * MiB;
constexpr size_t WS_S5ST = 1832 * MiB;
constexpr size_t WS_END = 1852 * MiB;
constexpr int CW_BAR = 4096;
constexpr int NPHASE = 1 + NLAYER * 10;

constexpr int LDS_SCRATCH = 147456;
constexpr int LDS_MISC = LDS_SCRATCH;
constexpr int LDS_BYTES = LDS_SCRATCH + 256;

__device__ __forceinline__ float bf_lo(unsigned w) { return __uint_as_float(w << 16); }
__device__ __forceinline__ float bf_hi(unsigned w) { return __uint_as_float(w & 0xffff0000u); }
typedef __bf16 bf16x2_t __attribute__((ext_vector_type(2)));
__device__ __forceinline__ unsigned pkbf(float lo, float hi) { const bf16x2_t v = {(__bf16)lo, (__bf16)hi}; return __builtin_bit_cast(unsigned, v); }
__device__ __forceinline__ bf16 f2bf(float f) { return __builtin_bit_cast(unsigned short, (__bf16)f); }
__device__ __forceinline__ float wave_sum(float v) {
#pragma unroll
    for (int o = 1; o < 64; o <<= 1) v += __shfl_xor(v, o);
    return v;
}
__device__ __forceinline__ float gelu_erf(float v) { return 0.5f * v * (1.0f + erff(v * 0.70710678118654752f)); }
__device__ __forceinline__ int tok_pos(int t) { return t < 32768 ? (t & 4095) : (t - 32768); }
__device__ __forceinline__ int tok_len(int t) { return t < 32768 ? 4096 : 8192; }
__device__ __forceinline__ void unpack8(const v4u q, float (&f)[8]) {
    f[0] = bf_lo(q.x); f[1] = bf_hi(q.x); f[2] = bf_lo(q.y); f[3] = bf_hi(q.y); f[4] = bf_lo(q.z); f[5] = bf_hi(q.z); f[6] = bf_lo(q.w); f[7] = bf_hi(q.w);
}
__device__ __forceinline__ v4u pack8(const float (&f)[8]) { v4u q; q.x = pkbf(f[0], f[1]); q.y = pkbf(f[2], f[3]); q.z = pkbf(f[4], f[5]); q.w = pkbf(f[6], f[7]); return q; }
#define LDS_WAIT() asm volatile("s_waitcnt lgkmcnt(0)" ::: "memory")
#define MFMA16(a, b, c) __builtin_amdgcn_mfma_f32_16x16x32_bf16((a), (b), (c), 0, 0, 0)

struct EpiStoreBf16 {
    static constexpr bool PERM = true, AFTER_DRAIN = false;
    bf16* O; int ldo;
    __device__ __forceinline__ void operator()(const f32x4 (&acc)[2][2][4][2], const pg8::Unit& u, int wr, int wc, int fr, int fq) const {
        const int row0 = u.pm * 256 + wr * 64 + fr, col0 = u.pn * 256 + wc * 32 + 8 * fq;
#pragma unroll
        for (int ai = 0; ai < 2; ++ai)
#pragma unroll
            for (int m = 0; m < 4; ++m) { bf16* rowp = O + (size_t)(row0 + ai * 128 + m * 16) * ldo + col0;
#pragma unroll
                for (int bj = 0; bj < 2; ++bj) { const f32x4 v0 = acc[ai][bj][m][0], v1 = acc[ai][bj][m][1];
                    v4u w; w.x = pkbf(v0[0], v0[1]); w.y = pkbf(v0[2], v0[3]); w.z = pkbf(v1[0], v1[1]); w.w = pkbf(v1[2], v1[3]);
                    *(v4u*)(rowp + bj * 128) = w; } }
    }
};
struct EpiGlu {
    static constexpr bool PERM = true, AFTER_DRAIN = false;
    const bf16* Y; int ldy; bf16* O; int ldo; const float* bias;
    __device__ __forceinline__ void operator()(const f32x4 (&acc)[2][2][4][2], const pg8::Unit& u, int wr, int wc, int fr, int fq) const {
        const int row0 = u.pm * 256 + wr * 64 + fr, col0 = u.pn * 256 + wc * 32 + 8 * fq;
#pragma unroll
        for (int bj = 0; bj < 2; ++bj) {
            const f32x4 b0 = *(const f32x4*)(bias + col0 + bj * 128), b1 = *(const f32x4*)(bias + col0 + bj * 128 + 4);
#pragma unroll
            for (int ai = 0; ai < 2; ++ai)
#pragma unroll
                for (int m = 0; m < 4; ++m) { const size_t r = (size_t)(row0 + ai * 128 + m * 16);
                    const v4u yq = *(const v4u*)(Y + r * ldy + col0 + bj * 128); float y[8]; unpack8(yq, y);
                    const f32x4 v0 = acc[ai][bj][m][0] + b0, v1 = acc[ai][bj][m][1] + b1; float o[8];
#pragma unroll
                    for (int k = 0; k < 4; ++k) { o[k] = y[k] / (1.0f + __expf(-v0[k])); o[4 + k] = y[4 + k] / (1.0f + __expf(-v1[k])); }
                    *(v4u*)(O + r * ldo + col0 + bj * 128) = pack8(o); }
        }
    }
};
struct EpiScaleBf16 {
    static constexpr bool PERM = true, AFTER_DRAIN = false;
    bf16* O; int ldo; const float* scale;
    __device__ __forceinline__ void operator()(const f32x4 (&acc)[2][2][4][2], const pg8::Unit& u, int wr, int wc, int fr, int fq) const {
        const int row0 = u.pm * 256 + wr * 64 + fr, col0 = u.pn * 256 + wc * 32 + 8 * fq;
#pragma unroll
        for (int bj = 0; bj < 2; ++bj) {
            const f32x4 s0 = *(const f32x4*)(scale + col0 + bj * 128), s1 = *(const f32x4*)(scale + col0 + bj * 128 + 4);
#pragma unroll
            for (int ai = 0; ai < 2; ++ai)
#pragma unroll
                for (int m = 0; m < 4; ++m) { const size_t r = (size_t)(row0 + ai * 128 + m * 16);
                    const f32x4 v0 = acc[ai][bj][m][0] * s0, v1 = acc[ai][bj][m][1] * s1;
                    v4u w; w.x = pkbf(v0[0], v0[1]); w.y = pkbf(v0[2], v0[3]); w.z = pkbf(v1[0], v1[1]); w.w = pkbf(v1[2], v1[3]);
                    *(v4u*)(O + r * ldo + col0 + bj * 128) = w; }
        }
    }
};
struct EpiResid {
    static constexpr bool PERM = false, AFTER_DRAIN = false;
    float* X; int ldx; float alpha;
    __device__ __forceinline__ void operator()(const f32x4 (&acc)[2][2][4][2], const pg8::Unit& u, int wr, int wc, int fr, int fq) const {
        const int row0 = u.pm * 256 + wr * 64 + fr, col0 = u.pn * 256 + wc * 32 + 4 * fq;
#pragma unroll
        for (int ai = 0; ai < 2; ++ai)
#pragma unroll
            for (int m = 0; m < 4; ++m) { float* rowp = X + (size_t)(row0 + ai * 128 + m * 16) * ldx + col0;
#pragma unroll
                for (int bj = 0; bj < 2; ++bj)
#pragma unroll
                    for (int n = 0; n < 2; ++n) { f32x4* p = (f32x4*)(rowp + bj * 128 + n * 16); const f32x4 x = *p; *p = x * alpha + acc[ai][bj][m][n]; } }
    }
};
struct EpiStoreF32 {
    static constexpr bool PERM = false, AFTER_DRAIN = false;
    float* C; int ldc;
    __device__ __forceinline__ void operator()(const f32x4 (&acc)[2][2][4][2], const pg8::Unit& u, int wr, int wc, int fr, int fq) const {
        const int row0 = u.pm * 256 + wr * 64 + fr, col0 = u.pn * 256 + wc * 32 + 4 * fq;
#pragma unroll
        for (int ai = 0; ai < 2; ++ai)
#pragma unroll
            for (int m = 0; m < 4; ++m) { float* rowp = C + (size_t)(row0 + ai * 128 + m * 16) * ldc + col0;
#pragma unroll
                for (int bj = 0; bj < 2; ++bj)
#pragma unroll
                    for (int n = 0; n < 2; ++n) *(f32x4*)(rowp + bj * 128 + n * 16) = acc[ai][bj][m][n]; }
    }
};

struct Args { const float* in[26]; float* out; unsigned char* ws; int ph_lo, ph_hi, li, pad; };
struct Frame {
    LAS unsigned char* lds;
    int tid, lane, wave, G, bx;
    int gw, NGW;
    size_t gtid, NT;
    float* out; unsigned char* ws;
};
enum InIdx { I_XP = 0, I_XS, I_LNIN_G, I_LNIN_B, I_WIN, I_LAMRE, I_LAMIM, I_LOGSTEP, I_BRE, I_BIM, I_CRE, I_CIM, I_S5D, I_WGLU, I_BGLU, I_POOLW, I_POOLS,
             I_WOUT, I_LN1G, I_LN1B, I_WQ, I_KEYS, I_PU, I_PV, I_LN2G, I_LN2B };

__device__ __forceinline__ void ln_row(const float* src, const float* g, const float* b, float* dst, bf16* dstb, int lane) {
    f32x4 v[8]; float s = 0.f;
#pragma unroll
    for (int j = 0; j < 8; ++j) { v[j] = ((const f32x4*)src)[lane + 64 * j]; s += (v[j][0] + v[j][1]) + (v[j][2] + v[j][3]); }
    const float mean = wave_sum(s) * (1.0f / DM); float s2 = 0.f;
#pragma unroll
    for (int j = 0; j < 8; ++j) { v[j] = v[j] - mean; s2 += (v[j][0] * v[j][0] + v[j][1] * v[j][1]) + (v[j][2] * v[j][2] + v[j][3] * v[j][3]); }
    const float rstd = 1.0f / sqrtf(wave_sum(s2) * (1.0f / DM) + LN_EPS);
#pragma unroll
    for (int j = 0; j < 8; ++j) { const f32x4 gg = ((const f32x4*)g)[lane + 64 * j], bb = ((const f32x4*)b)[lane + 64 * j];
        const f32x4 o = v[j] * rstd * gg + bb; ((f32x4*)dst)[lane + 64 * j] = o;
        v2u w; w.x = pkbf(o[0], o[1]); w.y = pkbf(o[2], o[3]); ((v2u*)dstb)[lane + 64 * j] = w; }
}

__device__ __forceinline__ void transpose_item(const float* W, int K, int N, bf16* WT, LAS float* scr, int item, int lane) {
    const int nblk = N / 32, kb = item / nblk, nb = item % nblk, k0 = 64 * kb, n0 = 32 * nb;
#pragma unroll 8
    for (int i = 0; i < 32; ++i) { const int kk = 2 * i + (lane >> 5); scr[kk * 33 + (lane & 31)] = W[(size_t)(k0 + kk) * N + n0 + (lane & 31)]; }
    LDS_WAIT();
    const int c = lane & 7;
#pragma unroll
    for (int j = 0; j < 4; ++j) { const int n = (lane >> 3) + 8 * j; const LAS float* s = scr + (8 * c) * 33 + n;
        v4u o; o.x = pkbf(s[0 * 33], s[1 * 33]); o.y = pkbf(s[2 * 33], s[3 * 33]); o.z = pkbf(s[4 * 33], s[5 * 33]); o.w = pkbf(s[6 * 33], s[7 * 33]);
        *(v4u*)(WT + (size_t)(n0 + n) * K + k0 + 8 * c) = o; }
    LDS_WAIT();
}

__device__ __forceinline__ void p0_prologue(const Frame& F, const Args& A) {
    {
        LAS float* scr = (LAS float*)(F.lds + F.wave * 16384);
        constexpr int I_IN = (DM / 64) * (INW / 32), I_OUT = (DM / 64) * (DM / 32), I_GLU = (512 / 64) * (512 / 32);
        constexpr int NITEMS = NLAYER * (I_IN + I_OUT + I_GLU);
        for (int it = F.gw; it < NITEMS; it += F.NGW) {
            int r = it;
            if (r < NLAYER * I_IN) { const int l = r / I_IN; transpose_item(A.in[I_WIN] + (size_t)l * DM * INW, DM, INW, (bf16*)(A.ws + WS_WIN) + (size_t)l * INW * DM, scr, r % I_IN, F.lane); continue; }
            r -= NLAYER * I_IN;
            if (r < NLAYER * I_OUT) { const int l = r / I_OUT; transpose_item(A.in[I_WOUT] + (size_t)l * DM * DM, DM, DM, (bf16*)(A.ws + WS_WOUT) + (size_t)l * DM * DM, scr, r % I_OUT, F.lane); continue; }
            r -= NLAYER * I_OUT;
            { const int l = r / I_GLU; transpose_item(A.in[I_WGLU] + (size_t)l * 512 * 512, 512, 512, (bf16*)(A.ws + WS_WGLU) + (size_t)l * 512 * 512, scr, r % I_GLU, F.lane); }
        }
    }
    {
        for (int r = F.gw; r < 2 * NLAYER * NEXP; r += F.NGW) {
            const int tab = r >= NLAYER * NEXP, ri = tab ? r - NLAYER * NEXP : r;
            const float* src = (tab ? A.in[I_PV] : A.in[I_PU]) + (size_t)ri * DM;
            f32x4 v[2][4]; float am = 0.f;
#pragma unroll
            for (int c = 0; c < 2; ++c)
#pragma unroll
                for (int q = 0; q < 4; ++q) { v[c][q] = *(const f32x4*)(src + (c * 64 + F.lane) * 16 + q * 4);
                    am = fmaxf(am, fmaxf(fmaxf(fabsf(v[c][q][0]), fabsf(v[c][q][1])), fmaxf(fabsf(v[c][q][2]), fabsf(v[c][q][3])))); }
#pragma unroll
            for (int o = 1; o < 64; o <<= 1) am = fmaxf(am, __shfl_xor(am, o));
            const float sc = am > 0.f ? 384.0f / am : 1.0f, isc = am > 0.f ? am * (1.0f / 384.0f) : 1.0f;
            unsigned char* dst = A.ws + (tab ? WS_V8 : WS_U8) + (size_t)ri * DM;
#pragma unroll
            for (int c = 0; c < 2; ++c) { v4u w;
#pragma unroll
                for (int q = 0; q < 4; ++q) { int pk = 0; pk = __builtin_amdgcn_cvt_pk_fp8_f32(v[c][q][0] * sc, v[c][q][1] * sc, pk, false); pk = __builtin_amdgcn_cvt_pk_fp8_f32(v[c][q][2] * sc, v[c][q][3] * sc, pk, true); w[q] = (unsigned)pk; }
                *(v4u*)(dst + (c * 64 + F.lane) * 16) = w; }
            if (F.lane == 0) ((float*)(A.ws + (tab ? WS_VSC : WS_USC)))[ri] = isc;
        }
    }
    {
        const float* pw = A.in[I_POOLW]; v4u* dst = (v4u*)(A.ws + WS_WPOOL);
        for (size_t i = F.gtid; i < (size_t)NLAYER * 512 * 64; i += F.NT) {
            const int k8 = (int)(i & 63), n = (int)((i >> 6) & 511), l = (int)(i >> 15);
            const int g = n >> 7, d = n & 127, kg = k8 >> 4, c0 = (k8 & 15) * 8;
            float f[8];
#pragma unroll
            for (int k = 0; k < 8; ++k) f[k] = (kg == g) ? pw[(((size_t)l * 4 + g) * 128 + (c0 + k)) * 128 + d] : 0.f;
            dst[i] = pack8(f);
        }
    }
    {
        const float* lre = A.in[I_LAMRE]; const float* lim = A.in[I_LAMIM]; const float* lst = A.in[I_LOGSTEP]; const float* bre = A.in[I_BRE]; const float* bim = A.in[I_BIM];
        f32x2v* ab = (f32x2v*)(A.ws + WS_S5A); f32x2v* ab64 = (f32x2v*)(A.ws + WS_S5A + 512 * 1024); f32x2v* bb = (f32x2v*)(A.ws + WS_S5B);
        for (size_t i = F.gtid; i < (size_t)NLAYER * 2 * 32 * 64; i += F.NT) {
            const float lr = lre[i], li = lim[i], dt = expf(lst[i >> 6]);
            const float mag = expf(lr * dt), ar = mag * cosf(li * dt), ai = mag * sinf(li * dt);
            const float den = lr * lr + li * li;
            const float zr = ((ar - 1.0f) * lr + ai * li) / den, zi = (ai * lr - (ar - 1.0f) * li) / den;
            ab[i] = (f32x2v){ar, ai};
            const float m64 = expf(lr * dt * 64.0f), an = li * dt * 64.0f;
            ab64[i] = (f32x2v){m64 * cosf(an), m64 * sinf(an)};
#pragma unroll
            for (int c = 0; c < 16; ++c) { const float br = bre[i * 16 + c], bi = bim[i * 16 + c]; bb[i * 16 + c] = (f32x2v){zr * br - zi * bi, zr * bi + zi * br}; }
        }
    }
    if (F.bx == 0 && F.tid < 128) {
        ((float*)(A.ws + WS_ROT))[F.tid] = (float)exp(-(double)F.tid / 127.0 * 9.210340371976184);
    }
    __syncthreads();
    {
        LAS float* KS = (LAS float*)F.lds;
        LAS float* WQ = (LAS float*)(F.lds + 128 * 132 * 4);
        const float* keys = A.in[I_KEYS]; const float* wq = A.in[I_WQ]; bf16* wst = (bf16*)(A.ws + WS_WS);
        for (int u = F.bx; u < NLAYER * 16 * 32; u += F.G) {
            const int dtl = u & 31, hp = (u >> 5) & 15, l = u >> 9, p = hp & 1;
#pragma unroll
            for (int r = 0; r < 8; ++r) { const int f = F.tid + 512 * r, nk = f >> 5, c4 = f & 31;
                *(LAS f32x4*)(KS + nk * 132 + c4 * 4) = *(const f32x4*)(keys + (((size_t)l * 2 + p) * 128 + nk) * 128 + c4 * 4); }
#pragma unroll
            for (int r = 0; r < 4; ++r) { const int f = F.tid + 512 * r, dd = f >> 5, c4 = f & 31;
                *(LAS f32x4*)(WQ + dd * 132 + c4 * 4) = *(const f32x4*)(wq + ((size_t)l * DM + dtl * 64 + dd) * DM + hp * 128 + c4 * 4); }
            __syncthreads();
            const int nk = F.tid & 127, dg = F.tid >> 7;
            float acc[16];
#pragma unroll
            for (int i = 0; i < 16; ++i) acc[i] = 0.f;
            for (int c4 = 0; c4 < 32; ++c4) {
                const f32x4 kv = *(const LAS f32x4*)(KS + nk * 132 + c4 * 4);
#pragma unroll
                for (int i = 0; i < 16; ++i) { const f32x4 wv = *(const LAS f32x4*)(WQ + (dg * 16 + i) * 132 + c4 * 4);
                    acc[i] += (kv[0] * wv[0] + kv[1] * wv[1]) + (kv[2] * wv[2] + kv[3] * wv[3]); }
            }
            bf16* o = wst + ((size_t)l * DM + hp * 128 + nk) * DM + dtl * 64 + dg * 16;
            v4u q0, q1; q0.x = pkbf(acc[0], acc[1]); q0.y = pkbf(acc[2], acc[3]); q0.z = pkbf(acc[4], acc[5]); q0.w = pkbf(acc[6], acc[7]);
            q1.x = pkbf(acc[8], acc[9]); q1.y = pkbf(acc[10], acc[11]); q1.z = pkbf(acc[12], acc[13]); q1.w = pkbf(acc[14], acc[15]);
            *(v4u*)o = q0; *(v4u*)(o + 8) = q1;
            __syncthreads();
        }
    }
    for (int t = F.gw; t < NTOK; t += F.NGW) {
        const float* src = t < 32768 ? A.in[I_XP] + (size_t)t * DM : A.in[I_XS] + (size_t)(t - 32768) * DM;
        ln_row(src, A.in[I_LNIN_G], A.in[I_LNIN_B], A.out + (size_t)t * DM, (bf16*)(A.ws + WS_XN) + (size_t)t * DM, F.lane);
    }
}

__device__ __forceinline__ float ret_log2_gamma(int h) { return log2f(1.0f - exp2f(-5.0f - (float)h)); }

__device__ __forceinline__ void s5_pass1(const Frame& F, const Args& A, int l) {
    LAS float* Uw = (LAS float*)(F.lds + F.wave * 4096);
    const bf16* H = (const bf16*)(A.ws + WS_H);
    const f32x2v* ab = (const f32x2v*)(A.ws + WS_S5A); const f32x4* bb = (const f32x4*)(A.ws + WS_S5B);
    f32x2v* st = (f32x2v*)(A.ws + WS_S5ST);
    for (int task = F.gw; task < 640 * 32 * 2; task += F.NGW) {
        const int dir = task & 1, g = (task >> 1) & 31, ck = task >> 6;
        const int pidx = ((l * 2 + dir) * 32 + g) * 64 + F.lane;
        const f32x2v a = ab[pidx];
        float Br[16], Bi[16];
#pragma unroll
        for (int c2 = 0; c2 < 8; ++c2) { const f32x4 q = bb[(size_t)pidx * 8 + c2]; Br[2 * c2] = q[0]; Bi[2 * c2] = q[1]; Br[2 * c2 + 1] = q[2]; Bi[2 * c2 + 1] = q[3]; }
        {
            const bf16* urow = H + (size_t)(ck * 64 + F.lane) * INW + COL_UA + g * 16;
            const v4u q0 = *(const v4u*)urow, q1 = *(const v4u*)(urow + 8); float f0[8], f1[8]; unpack8(q0, f0); unpack8(q1, f1);
            LAS f32x4* d = (LAS f32x4*)(Uw + F.lane * 16);
            d[0] = (f32x4){f0[0], f0[1], f0[2], f0[3]}; d[1] = (f32x4){f0[4], f0[5], f0[6], f0[7]}; d[2] = (f32x4){f1[0], f1[1], f1[2], f1[3]}; d[3] = (f32x4){f1[4], f1[5], f1[6], f1[7]};
        }
        LDS_WAIT();
        float xr = 0.f, xi = 0.f;
        for (int s = 0; s < 64; ++s) {
            const int t = dir ? 63 - s : s;
            const LAS f32x4* up = (const LAS f32x4*)(Uw + t * 16);
            float bur = 0.f, bui = 0.f;
#pragma unroll
            for (int c4 = 0; c4 < 4; ++c4) { const f32x4 uv = up[c4];
#pragma unroll
                for (int k = 0; k < 4; ++k) { bur += Br[4 * c4 + k] * uv[k]; bui += Bi[4 * c4 + k] * uv[k]; } }
            const float nxr = a[0] * xr - a[1] * xi + bur, nxi = a[0] * xi + a[1] * xr + bui; xr = nxr; xi = nxi;
        }
        st[(size_t)((ck * 32 + g) * 2 + dir) * 64 + F.lane] = (f32x2v){xr, xi};
        LDS_WAIT();
    }
}
__device__ __forceinline__ void s5_carry(const Frame& F, const Args& A, int l) {
    const f32x2v* ab64 = (const f32x2v*)(A.ws + WS_S5A + 512 * 1024); f32x2v* st = (f32x2v*)(A.ws + WS_S5ST);
    for (size_t it = F.gtid; it < (size_t)9 * 32 * 2 * 64; it += F.NT) {
        const int p = (int)(it & 63), dir = (int)((it >> 6) & 1), g = (int)((it >> 7) & 31), s = (int)(it >> 12);
        const int ck0 = s < 8 ? s * 64 : 512, n = s < 8 ? 64 : 128;
        const f32x2v a = ab64[((l * 2 + dir) * 32 + g) * 64 + p];
        float cr = 0.f, ci = 0.f;
        for (int k = 0; k < n; ++k) {
            const int ck = dir ? (ck0 + n - 1 - k) : (ck0 + k);
            f32x2v* q = st + (size_t)((ck * 32 + g) * 2 + dir) * 64 + p;
            const f32x2v le = *q; *q = (f32x2v){cr, ci};
            const float ncr = a[0] * cr - a[1] * ci + le[0], nci = a[0] * ci + a[1] * cr + le[1]; cr = ncr; ci = nci;
        }
    }
}
__device__ __forceinline__ void s5_pass3(const Frame& F, const Args& A, int l) {
    LAS unsigned char* wb = F.lds + F.wave * 17152;
    LAS float* Uw = (LAS float*)wb;
    LAS bf16* Xw = (LAS bf16*)(wb + 4096);
    LAS bf16* Ctw = (LAS bf16*)(wb + 4096 + 8704);
    const bf16* H = (const bf16*)(A.ws + WS_H); bf16* BY = (bf16*)(A.ws + WS_BUFY);
    const f32x2v* ab = (const f32x2v*)(A.ws + WS_S5A); const f32x4* bb = (const f32x4*)(A.ws + WS_S5B);
    const f32x2v* st = (const f32x2v*)(A.ws + WS_S5ST);
    const float* cre = A.in[I_CRE]; const float* cim = A.in[I_CIM]; const float* dvec = A.in[I_S5D] + (size_t)l * 512;
    const int lane = F.lane, lr = lane & 15, lq = lane >> 4;
    for (int task = F.gw; task < 640 * 32; task += F.NGW) {
        const int g = task & 31, ck = task >> 5;
        {
            const bf16* urow = H + (size_t)(ck * 64 + lane) * INW + COL_UA + g * 16;
            const v4u q0 = *(const v4u*)urow, q1 = *(const v4u*)(urow + 8); float f0[8], f1[8]; unpack8(q0, f0); unpack8(q1, f1);
            LAS f32x4* d = (LAS f32x4*)(Uw + lane * 16);
            d[0] = (f32x4){f0[0], f0[1], f0[2], f0[3]}; d[1] = (f32x4){f0[4], f0[5], f0[6], f0[7]}; d[2] = (f32x4){f1[0], f1[1], f1[2], f1[3]}; d[3] = (f32x4){f1[4], f1[5], f1[6], f1[7]};
        }
        f32x4 Y[4];
#pragma unroll
        for (int m = 0; m < 4; ++m) Y[m] = (f32x4){0.f, 0.f, 0.f, 0.f};
#pragma unroll
        for (int dir = 0; dir < 2; ++dir) {
            const int pidx = ((l * 2 + dir) * 32 + g) * 64 + lane;
            const f32x2v a = ab[pidx];
            float Br[16], Bi[16];
#pragma unroll
            for (int c2 = 0; c2 < 8; ++c2) { const f32x4 q = bb[(size_t)pidx * 8 + c2]; Br[2 * c2] = q[0]; Bi[2 * c2] = q[1]; Br[2 * c2 + 1] = q[2]; Bi[2 * c2 + 1] = q[3]; }
            {
                const size_t cb = (size_t)((l * 2 + dir) * 32 + g) * 16 * 64;
#pragma unroll
                for (int c = 0; c < 16; ++c) { Ctw[c * 136 + lane] = f2bf(cre[cb + c * 64 + lane]); Ctw[c * 136 + 64 + lane] = f2bf(-cim[cb + c * 64 + lane]); }
            }
            const f32x2v x0 = st[(size_t)((ck * 32 + g) * 2 + dir) * 64 + lane];
            float xr = x0[0], xi = x0[1];
            LDS_WAIT();
#pragma unroll
            for (int half = 0; half < 2; ++half) {
                for (int s = 0; s < 32; ++s) {
                    const int step = half * 32 + s, t = dir ? 63 - step : step;
                    const LAS f32x4* up = (const LAS f32x4*)(Uw + t * 16);
                    float bur = 0.f, bui = 0.f;
#pragma unroll
                    for (int c4 = 0; c4 < 4; ++c4) { const f32x4 uv = up[c4];
#pragma unroll
                        for (int k = 0; k < 4; ++k) { bur += Br[4 * c4 + k] * uv[k]; bui += Bi[4 * c4 + k] * uv[k]; } }
                    const float nxr = a[0] * xr - a[1] * xi + bur, nxi = a[0] * xi + a[1] * xr + bui; xr = nxr; xi = nxi;
                    Xw[(t & 31) * 136 + lane] = f2bf(xr); Xw[(t & 31) * 136 + 64 + lane] = f2bf(xi);
                }
                LDS_WAIT();
                const int tb = dir ? (1 - half) : half;
#pragma unroll
                for (int m = 0; m < 2; ++m)
#pragma unroll
                    for (int ks = 0; ks < 4; ++ks) {
                        const bf16x8 av = *(const LAS bf16x8*)(Ctw + lr * 136 + 32 * ks + lq * 8);
                        const bf16x8 bv = *(const LAS bf16x8*)(Xw + (16 * m + lr) * 136 + 32 * ks + lq * 8);
                        Y[2 * tb + m] = MFMA16(av, bv, Y[2 * tb + m]);
                    }
                LDS_WAIT();
            }
        }
#pragma unroll
        for (int m = 0; m < 4; ++m) {
            const int t = 16 * m + lr, c0 = 4 * lq;
            const f32x4 uv = *(const LAS f32x4*)(Uw + t * 16 + c0); const f32x4 dv = *(const f32x4*)(dvec + g * 16 + c0);
            const f32x4 y = Y[m] + dv * uv;
            v2u w; w.x = pkbf(gelu_erf(y[0]), gelu_erf(y[1])); w.y = pkbf(gelu_erf(y[2]), gelu_erf(y[3]));
            *(v2u*)(BY + (size_t)(ck * 64 + t) * 512 + g * 16 + c0) = w;
        }
        LDS_WAIT();
    }
}
__device__ __forceinline__ void pool_phase(const Frame& F, const Args& A) {
    const bf16* H = (const bf16*)(A.ws + WS_H); bf16* BP = (bf16*)(A.ws + WS_BUFP);
    for (size_t it = F.gtid; it < (size_t)NTOK * 64; it += F.NT) {
        const int t = (int)(it >> 6), o = (int)(it & 63), gi = o >> 4, w = 2 << gi;
        const int pos = tok_pos(t), L = tok_len(t);
        const int lo = max(pos - w / 2, 0), hi = min(pos + w / 2 - 1, L - 1);
        const bf16* base = H + (size_t)(t - pos) * INW + COL_UB + o * 8;
        float s[8];
#pragma unroll
        for (int k = 0; k < 8; ++k) s[k] = 0.f;
        for (int si = lo; si <= hi; ++si) { float f[8]; unpack8(*(const v4u*)(base + (size_t)si * INW), f);
#pragma unroll
            for (int k = 0; k < 8; ++k) s[k] += f[k]; }
        const float inv = 1.0f / (float)(hi - lo + 1);
        float c[8]; unpack8(*(const v4u*)(base + (size_t)pos * INW), c);
#pragma unroll
        for (int k = 0; k < 8; ++k) s[k] = s[k] * inv - c[k];
        *(v4u*)(BP + (size_t)t * 512 + o * 8) = pack8(s);
    }
}
__device__ __forceinline__ void rotary_phase(const Frame& F, const Args& A) {
    bf16* H = (bf16*)(A.ws + WS_H); const float* rot = (const float*)(A.ws + WS_ROT);
    for (size_t it = F.gtid; it < (size_t)NTOK * 16; it += F.NT) {
        const int t = (int)(it >> 4), o = (int)(it & 15); const float pos = (float)tok_pos(t);
        float cs[8], sn[8];
#pragma unroll
        for (int k = 0; k < 8; ++k) { const float ang = pos * rot[o * 8 + k]; cs[k] = cosf(ang); sn[k] = sinf(ang); }
#pragma unroll
        for (int which = 0; which < 2; ++which) {
            const float sc = which ? 0.0625f : 1.0f;
#pragma unroll
            for (int hd = 0; hd < 4; ++hd) {
                bf16* p1 = H + (size_t)t * INW + (which ? COL_K : COL_Q) + hd * 256 + o * 8; bf16* p2 = p1 + 128;
                float x1[8], x2[8], o1[8], o2[8]; unpack8(*(const v4u*)p1, x1); unpack8(*(const v4u*)p2, x2);
#pragma unroll
                for (int k = 0; k < 8; ++k) { o1[k] = (x1[k] * cs[k] - x2[k] * sn[k]) * sc; o2[k] = (x2[k] * cs[k] + x1[k] * sn[k]) * sc; }
                *(v4u*)p1 = pack8(o1); *(v4u*)p2 = pack8(o2);
            }
        }
    }
}
constexpr int RS = 136;
__device__ __forceinline__ void ret_state_phase(const Frame& F, const Args& A) {
    const bf16* H = (const bf16*)(A.ws + WS_H); bf16* STF = (bf16*)(A.ws + WS_STF); bf16* STB = (bf16*)(A.ws + WS_STB);
    LAS bf16* Kt = (LAS bf16*)F.lds; LAS bf16* VtF = Kt + 128 * RS; LAS bf16* VtB = Kt + 256 * RS;
    const int tid = F.tid, lane = F.lane, lr = lane & 15, lq = lane >> 4, we = F.wave >> 1, wd = F.wave & 1;
    for (int u = F.bx; u < 5120; u += F.G) {
        const int dh = u & 1, eh = (u >> 1) & 1, h = (u >> 2) & 3, c = u >> 4;
        {
            const int tq = opaque(tid), jp = tq & 63, j = 2 * jp, pc0 = tq >> 6;
            const bf16* krow = H + (size_t)(c * 128 + j) * INW + COL_K + h * 256 + dh * 128;
            const bf16* vrow = H + (size_t)(c * 128 + j) * INW + COL_V + h * 256 + eh * 128;
            const float lg = ret_log2_gamma(h), fF0 = exp2f(lg * (float)(127 - j)), fF1 = exp2f(lg * (float)(126 - j)), fB0 = exp2f(lg * (float)j), fB1 = exp2f(lg * (float)(j + 1));
            LAS unsigned* Kt32 = (LAS unsigned*)Kt; LAS unsigned* VtF32 = (LAS unsigned*)VtF; LAS unsigned* VtB32 = (LAS unsigned*)VtB;
#pragma unroll
            for (int r = 0; r < 2; ++r) {
                const int pc = pc0 + 8 * r;
                const v4u k0 = *(const v4u*)(krow + pc * 8), k1 = *(const v4u*)(krow + INW + pc * 8);
                const v4u v0 = *(const v4u*)(vrow + pc * 8), v1 = *(const v4u*)(vrow + INW + pc * 8);
                const unsigned ka0[4] = {k0.x, k0.y, k0.z, k0.w}, ka1[4] = {k1.x, k1.y, k1.z, k1.w};
                float f0[8], f1[8]; unpack8(v0, f0); unpack8(v1, f1);
#pragma unroll
                for (int i = 0; i < 8; ++i) {
                    const unsigned a = ka0[i >> 1], b = ka1[i >> 1];
                    const unsigned kk = (i & 1) ? ((a >> 16) | (b & 0xffff0000u)) : ((a & 0xffffu) | (b << 16));
                    const int o = ((pc * 8 + i) * RS) / 2 + jp;
                    Kt32[o] = kk; VtF32[o] = pkbf(f0[i] * fF0, f1[i] * fF1); VtB32[o] = pkbf(f0[i] * fB0, f1[i] * fB1);
                }
            }
        }
        __syncthreads();
        f32x4 aF[4][2], aB[4][2];
#pragma unroll
        for (int td = 0; td < 4; ++td)
#pragma unroll
            for (int te = 0; te < 2; ++te) { aF[td][te] = (f32x4){0.f, 0.f, 0.f, 0.f}; aB[td][te] = (f32x4){0.f, 0.f, 0.f, 0.f}; }
#pragma unroll
        for (int ks = 0; ks < 4; ++ks) {
            bf16x8 ka[4], vF[2], vB[2];
#pragma unroll
            for (int td = 0; td < 4; ++td) ka[td] = *(const LAS bf16x8*)(Kt + (64 * wd + 16 * td + lr) * RS + 32 * ks + lq * 8);
#pragma unroll
            for (int te = 0; te < 2; ++te) { vF[te] = *(const LAS bf16x8*)(VtF + (32 * we + 16 * te + lr) * RS + 32 * ks + lq * 8); vB[te] = *(const LAS bf16x8*)(VtB + (32 * we + 16 * te + lr) * RS + 32 * ks + lq * 8); }
#pragma unroll
            for (int td = 0; td < 4; ++td)
#pragma unroll
                for (int te = 0; te < 2; ++te) { aF[td][te] = MFMA16(ka[td], vF[te], aF[td][te]); aB[td][te] = MFMA16(ka[td], vB[te], aB[td][te]); }
        }
#pragma unroll
        for (int td = 0; td < 4; ++td)
#pragma unroll
            for (int te = 0; te < 2; ++te) {
                const int e = eh * 128 + 32 * we + 16 * te + lr, d = dh * 128 + 64 * wd + 16 * td + 4 * lq;
                const size_t off = ((size_t)(c * 4 + h) * 256 + e) * 256 + d;
                v2u w; w.x = pkbf(aF[td][te][0], aF[td][te][1]); w.y = pkbf(aF[td][te][2], aF[td][te][3]); *(v2u*)(STF + off) = w;
                v2u x; x.x = pkbf(aB[td][te][0], aB[td][te][1]); x.y = pkbf(aB[td][te][2], aB[td][te][3]); *(v2u*)(STB + off) = x;
            }
        __syncthreads();
    }
}
__device__ __forceinline__ void ret_prefix_phase(const Frame& F, const Args& A) {
    bf16* STF = (bf16*)(A.ws + WS_STF); bf16* STB = (bf16*)(A.ws + WS_STB);
    for (size_t it = F.gtid; it < (size_t)36 * 2 * 8192; it += F.NT) {
        const int o = (int)(it & 8191), which = (int)((it >> 13) & 1), bh = (int)(it >> 14), h = bh & 3, s = bh >> 2;
        const int c0 = s < 8 ? s * 32 : 256, n = s < 8 ? 32 : 64;
        const float dec = exp2f(128.0f * ret_log2_gamma(h));
        float st[8];
#pragma unroll
        for (int k = 0; k < 8; ++k) st[k] = 0.f;
        bf16* base = (which ? STB : STF) + (size_t)h * 65536 + (size_t)o * 8;
        for (int k = 0; k < n; ++k) {
            const int c = which ? (c0 + n - 1 - k) : (c0 + k);
            v4u* p = (v4u*)(base + (size_t)c * 4 * 65536);
            float f[8]; unpack8(*p, f);
#pragma unroll
            for (int i = 0; i < 8; ++i) st[i] = dec * st[i] + f[i];
            *p = pack8(st);
        }
    }
}
__device__ __forceinline__ void ret_out_phase(const Frame& F, const Args& A) {
    const bf16* H = (const bf16*)(A.ws + WS_H); const bf16* STF = (const bf16*)(A.ws + WS_STF); const bf16* STB = (const bf16*)(A.ws + WS_STB);
    bf16* CC = (bf16*)(A.ws + WS_CONCAT);
    LAS bf16* RA = (LAS bf16*)F.lds; LAS bf16* RB = RA + 128 * RS; LAS bf16* RC = RA + 384 * RS;
    const int tid = F.tid, lane = F.lane, lr = lane & 15, lq = lane >> 4, wi = F.wave >> 2, wj = F.wave & 3, we = F.wave & 3;
    for (int u = F.bx; u < 1280; u += F.G) {
        const int h = u & 3, c = u >> 2, t0 = c * 128;
        const int cs = c < 256 ? (c & 31) : (c - 256), ncs = c < 256 ? 32 : 64;
        const bool has_f = cs > 0, has_b = cs < ncs - 1;
        const float lg = ret_log2_gamma(h);
        f32x4 S[4][2];
#pragma unroll
        for (int ti = 0; ti < 4; ++ti)
#pragma unroll
            for (int tj = 0; tj < 2; ++tj) S[ti][tj] = (f32x4){0.f, 0.f, 0.f, 0.f};
#pragma unroll
        for (int dh = 0; dh < 2; ++dh) {
            if (dh) __syncthreads();
#pragma unroll 1
            for (int r = 0; r < 4; ++r) { const int f = opaque(tid) + 512 * r, row = f >> 4, pc = f & 15;
                const bf16* src = H + (size_t)(t0 + row) * INW + h * 256 + dh * 128 + pc * 8;
                *(LAS v4u*)(RA + row * RS + pc * 8) = *(const v4u*)(src + COL_Q);
                *(LAS v4u*)(RB + row * RS + pc * 8) = *(const v4u*)(src + COL_K); }
            __syncthreads();
#pragma unroll
            for (int ks = 0; ks < 4; ++ks) {
                bf16x8 ka[2], qb[4];
#pragma unroll
                for (int tj = 0; tj < 2; ++tj) ka[tj] = *(const LAS bf16x8*)(RB + (32 * wj + 16 * tj + lr) * RS + 32 * ks + lq * 8);
#pragma unroll
                for (int ti = 0; ti < 4; ++ti) qb[ti] = *(const LAS bf16x8*)(RA + (64 * wi + 16 * ti + lr) * RS + 32 * ks + lq * 8);
#pragma unroll
                for (int ti = 0; ti < 4; ++ti)
#pragma unroll
                    for (int tj = 0; tj < 2; ++tj) S[ti][tj] = MFMA16(ka[tj], qb[ti], S[ti][tj]);
            }
        }
#pragma unroll
        for (int ti = 0; ti < 4; ++ti)
#pragma unroll
            for (int tj = 0; tj < 2; ++tj) {
                const int i = 64 * wi + 16 * ti + lr, j0 = 32 * wj + 16 * tj + 4 * lq; float p[4];
#pragma unroll
                for (int jj = 0; jj < 4; ++jj) { const int d = i - (j0 + jj); p[jj] = S[ti][tj][jj] * exp2f(lg * (float)(d < 0 ? -d : d)); }
                v2u w; w.x = pkbf(p[0], p[1]); w.y = pkbf(p[2], p[3]); *(LAS v2u*)(RC + i * RS + j0) = w;
            }
        __syncthreads();
        {
            const int tq = opaque(tid), jp = tq & 63, pc0 = tq >> 6; const bf16* vrow = H + (size_t)(t0 + 2 * jp) * INW + COL_V + h * 256;
            LAS unsigned* RB32 = (LAS unsigned*)RB;
#pragma unroll 1
            for (int r = 0; r < 4; ++r) { const int pc = pc0 + 8 * r; const v4u v0 = *(const v4u*)(vrow + pc * 8), v1 = *(const v4u*)(vrow + INW + pc * 8);
                const unsigned va0[4] = {v0.x, v0.y, v0.z, v0.w}, va1[4] = {v1.x, v1.y, v1.z, v1.w};
#pragma unroll
                for (int i = 0; i < 8; ++i) { const unsigned a = va0[i >> 1], b = va1[i >> 1];
                    RB32[((pc * 8 + i) * RS) / 2 + jp] = (i & 1) ? ((a >> 16) | (b & 0xffff0000u)) : ((a & 0xffffu) | (b << 16)); } }
        }
        __syncthreads();
        f32x4 O[4][4];
#pragma unroll
        for (int ti = 0; ti < 4; ++ti)
#pragma unroll
            for (int te = 0; te < 4; ++te) O[ti][te] = (f32x4){0.f, 0.f, 0.f, 0.f};
#pragma unroll
        for (int ks = 0; ks < 4; ++ks) {
            bf16x8 va[4], pb[4];
#pragma unroll
            for (int te = 0; te < 4; ++te) va[te] = *(const LAS bf16x8*)(RB + (64 * we + 16 * te + lr) * RS + 32 * ks + lq * 8);
#pragma unroll
            for (int ti = 0; ti < 4; ++ti) pb[ti] = *(const LAS bf16x8*)(RC + (64 * wi + 16 * ti + lr) * RS + 32 * ks + lq * 8);
#pragma unroll
            for (int ti = 0; ti < 4; ++ti)
#pragma unroll
                for (int te = 0; te < 4; ++te) O[ti][te] = MFMA16(va[te], pb[ti], O[ti][te]);
        }
#pragma unroll
        for (int dir = 0; dir < 2; ++dir) {
            if (dir == 0 ? has_f : has_b) {
                const bf16* St = (dir == 0 ? STF + (size_t)((c - 1) * 4 + h) * 65536 : STB + (size_t)((c + 1) * 4 + h) * 65536);
#pragma unroll
                for (int dh = 0; dh < 2; ++dh) {
                    __syncthreads();
#pragma unroll 1
                    for (int r = 0; r < 4; ++r) { const int f = opaque(tid) + 512 * r, row = f >> 4, pc = f & 15;
                        const float fac = exp2f(lg * (dir == 0 ? (float)(row + 1) : (float)(128 - row)));
                        float qf[8]; unpack8(*(const v4u*)(H + (size_t)(t0 + row) * INW + COL_Q + h * 256 + dh * 128 + pc * 8), qf);
#pragma unroll
                        for (int k = 0; k < 8; ++k) qf[k] *= fac;
                        *(LAS v4u*)(RA + row * RS + pc * 8) = pack8(qf); }
#pragma unroll 2
                    for (int r = 0; r < 8; ++r) { const int f = opaque(tid) + 512 * r, row = f >> 4, pc = f & 15;
                        *(LAS v4u*)(RB + row * RS + pc * 8) = *(const v4u*)(St + (size_t)row * 256 + dh * 128 + pc * 8); }
                    __syncthreads();
#pragma unroll
                    for (int ks = 0; ks < 4; ++ks) {
                        bf16x8 sa[4], qb[4];
#pragma unroll
                        for (int te = 0; te < 4; ++te) sa[te] = *(const LAS bf16x8*)(RB + (64 * we + 16 * te + lr) * RS + 32 * ks + lq * 8);
#pragma unroll
                        for (int ti = 0; ti < 4; ++ti) qb[ti] = *(const LAS bf16x8*)(RA + (64 * wi + 16 * ti + lr) * RS + 32 * ks + lq * 8);
#pragma unroll
                        for (int ti = 0; ti < 4; ++ti)
#pragma unroll
                            for (int te = 0; te < 4; ++te) O[ti][te] = MFMA16(sa[te], qb[ti], O[ti][te]);
                    }
                }
            }
        }
        __syncthreads();
        LAS float* RED = (LAS float*)RA;
#pragma unroll
        for (int ti = 0; ti < 4; ++ti) { float s1 = 0.f, s2 = 0.f;
#pragma unroll
            for (int te = 0; te < 4; ++te)
#pragma unroll
                for (int jj = 0; jj < 4; ++jj) { const float v = O[ti][te][jj]; s1 += v; s2 += v * v; }
            s1 += __shfl_xor(s1, 16); s1 += __shfl_xor(s1, 32); s2 += __shfl_xor(s2, 16); s2 += __shfl_xor(s2, 32);
            if (lq == 0) { RED[((64 * wi + 16 * ti + lr) * 4 + we) * 2] = s1; RED[((64 * wi + 16 * ti + lr) * 4 + we) * 2 + 1] = s2; } }
        __syncthreads();
#pragma unroll
        for (int ti = 0; ti < 4; ++ti) { const int i = 64 * wi + 16 * ti + lr;
            const f32x4 r0 = *(const LAS f32x4*)(RED + i * 8), r1 = *(const LAS f32x4*)(RED + i * 8 + 4);
            const float m = (r0[0] + r0[2] + r1[0] + r1[2]) * (1.0f / 256.0f), q = (r0[1] + r0[3] + r1[1] + r1[3]) * (1.0f / 256.0f);
            const float var = fmaxf(q - m * m, 0.f), rstd = 1.0f / sqrtf(var + GN_EPS);
#pragma unroll
            for (int te = 0; te < 4; ++te) { const int e0 = 64 * we + 16 * te + 4 * lq;
                const v2u gq = *(const v2u*)(H + (size_t)(t0 + i) * INW + COL_G + h * 256 + e0);
                const float gv[4] = {bf_lo(gq.x), bf_hi(gq.x), bf_lo(gq.y), bf_hi(gq.y)}; float ov[4];
#pragma unroll
                for (int jj = 0; jj < 4; ++jj) { const float gg = gv[jj]; ov[jj] = (gg / (1.0f + __expf(-gg))) * ((O[ti][te][jj] - m) * rstd); }
                v2u w; w.x = pkbf(ov[0], ov[1]); w.y = pkbf(ov[2], ov[3]);
                *(v2u*)(CC + (size_t)(t0 + i) * DM + 1024 + h * 256 + e0) = w; } }
        __syncthreads();
    }
}

__device__ __forceinline__ void topk_insert(float (&tv)[16], int (&ti)[16], float v, int n) {
    if (v > tv[15]) {
        tv[15] = v; ti[15] = n;
#pragma unroll
        for (int k = 15; k >= 1; --k) {
            const bool sw = tv[k] > tv[k - 1];
            const float a = tv[k - 1], b = tv[k]; const int ia = ti[k - 1], ib = ti[k];
            tv[k - 1] = sw ? b : a; tv[k] = sw ? a : b; ti[k - 1] = sw ? ib : ia; ti[k] = sw ? ia : ib;
        }
    }
}
__device__ __forceinline__ void topk_phase(const Frame& F, const Args& A) {
    const float* SC = (const float*)(A.ws + WS_H); int* IDX = (int*)(A.ws + WS_IDX); float* GATE = (float*)(A.ws + WS_GATE);
    LAS float* LV = (LAS float*)F.lds;
    LAS int* LI = (LAS int*)(F.lds + 512 * 17 * 4);
    const int tid = F.tid, tl = tid >> 4, hp = tid & 15;
    for (int blk = F.bx; blk < NTOK / 32; blk += F.G) {
        const int t = blk * 32 + tl;
        const float* row = SC + (size_t)t * DM + hp * 128;
        float tv[16]; int ti[16];
#pragma unroll
        for (int k = 0; k < 16; ++k) { tv[k] = -INFINITY; ti[k] = 0; }
        for (int n4 = 0; n4 < 32; ++n4) {
            const f32x4 v = *(const f32x4*)(row + n4 * 4);
            topk_insert(tv, ti, v[0], n4 * 4); topk_insert(tv, ti, v[1], n4 * 4 + 1); topk_insert(tv, ti, v[2], n4 * 4 + 2); topk_insert(tv, ti, v[3], n4 * 4 + 3);
        }
#pragma unroll
        for (int k = 0; k < 16; ++k) { LV[tid * 17 + k] = tv[k]; LI[tid * 17 + k] = ti[k]; }
        __syncthreads();
        if ((hp & 1) == 0) {
            float a[16], b[16];
#pragma unroll
            for (int k = 0; k < 16; ++k) { a[k] = LV[tid * 17 + k]; b[k] = LV[(tid + 1) * 17 + k]; }
            float sv[16]; int si[16];
#pragma unroll
            for (int k = 0; k < 16; ++k) { sv[k] = -INFINITY; si[k] = 0; }
#pragma unroll
            for (int i = 0; i < 16; ++i)
#pragma unroll
                for (int j = 0; j < 16; ++j) if ((i + 1) * (j + 1) <= 16) topk_insert(sv, si, a[i] + b[j], i * 16 + j);
            float e[16], sum = 0.f;
#pragma unroll
            for (int k = 0; k < 16; ++k) { e[k] = __expf(sv[k] - sv[0]); sum += e[k]; }
            const float inv = 1.0f / sum; const int head = hp >> 1;
#pragma unroll
            for (int k = 0; k < 16; ++k) {
                const int cell = si[k];
                IDX[(size_t)t * 128 + head * 16 + k] = LI[tid * 17 + (cell >> 4)] * 128 + LI[(tid + 1) * 17 + (cell & 15)];
                GATE[(size_t)t * 128 + head * 16 + k] = e[k] * inv;
            }
        }
        __syncthreads();
    }
}
__device__ __forceinline__ void peer_gather_phase(const Frame& F, const Args& A, int l) {
    const unsigned char* U8 = A.ws + WS_U8 + (size_t)l * NEXP * DM; const unsigned char* V8 = A.ws + WS_V8 + (size_t)l * NEXP * DM;
    const float* USC = (const float*)(A.ws + WS_USC) + (size_t)l * NEXP; const float* VSC = (const float*)(A.ws + WS_VSC) + (size_t)l * NEXP;
    const int* IDX = (const int*)(A.ws + WS_IDX); const float* GATE = (const float*)(A.ws + WS_GATE);
    const float* g2 = A.in[I_LN2G] + (size_t)l * DM; const float* b2 = A.in[I_LN2B] + (size_t)l * DM;
    bf16* XN = (bf16*)(A.ws + WS_XN);
    const int lane = F.lane, slot = 8 * (lane & 7) + (lane >> 3);
    for (int t = F.gw; t < NTOK; t += F.NGW) {
        float* xrow = A.out + (size_t)t * DM;
        f32x2v x[2][8];
#pragma unroll
        for (int c = 0; c < 2; ++c)
#pragma unroll
            for (int q = 0; q < 4; ++q) { const f32x4 a = *(const f32x4*)(xrow + (c * 64 + lane) * 16 + q * 4); x[c][2 * q] = (f32x2v){a[0], a[1]}; x[c][2 * q + 1] = (f32x2v){a[2], a[3]}; }
        int idxp[2]; float wv[2];
#pragma unroll
        for (int hf = 0; hf < 2; ++hf) {
            idxp[hf] = IDX[(size_t)t * 128 + hf * 64 + slot];
            const float gate = GATE[(size_t)t * 128 + hf * 64 + slot];
            const float usc = USC[idxp[hf]], vsc = VSC[idxp[hf]];
            float hval = 0.f;
            for (int outer = 0; outer < 8; ++outer) {
                float part[8];
#pragma unroll
                for (int ii = 0; ii < 8; ++ii) {
                    const int e = __builtin_amdgcn_readlane(idxp[hf], ii * 8 + outer);
                    const unsigned char* urow = U8 + (size_t)e * DM;
                    f32x2v s2 = (f32x2v){0.f, 0.f};
#pragma unroll
                    for (int c = 0; c < 2; ++c) { const v4u w = *(const v4u*)(urow + (c * 64 + lane) * 16);
#pragma unroll
                        for (int q = 0; q < 4; ++q) { s2 += __builtin_amdgcn_cvt_pk_f32_fp8((int)w[q], false) * x[c][2 * q]; s2 += __builtin_amdgcn_cvt_pk_f32_fp8((int)w[q], true) * x[c][2 * q + 1]; } }
                    part[ii] = s2[0] + s2[1];
                }
                {
                    const bool b5 = (lane & 32) != 0, b4 = (lane & 16) != 0, b3 = (lane & 8) != 0;
#pragma unroll
                    for (int i = 0; i < 4; ++i) { const float mine = b5 ? part[i + 4] : part[i], send = b5 ? part[i] : part[i + 4]; part[i] = mine + __shfl_xor(send, 32); }
#pragma unroll
                    for (int i = 0; i < 2; ++i) { const float mine = b4 ? part[i + 2] : part[i], send = b4 ? part[i] : part[i + 2]; part[i] = mine + __shfl_xor(send, 16); }
                    { const float mine = b3 ? part[1] : part[0], send = b3 ? part[0] : part[1]; part[0] = mine + __shfl_xor(send, 8); }
                    float v = part[0]; v += __shfl_xor(v, 4); v += __shfl_xor(v, 2); v += __shfl_xor(v, 1);
                    hval = ((lane & 7) == outer) ? v : hval;
                }
            }
            wv[hf] = gate * gelu_erf(hval * usc) * vsc;
        }
        f32x2v acc[2][8];
#pragma unroll
        for (int c = 0; c < 2; ++c)
#pragma unroll
            for (int k = 0; k < 8; ++k) acc[c][k] = (f32x2v){0.f, 0.f};
#pragma unroll
        for (int hf = 0; hf < 2; ++hf) {
#pragma unroll 4
            for (int ll = 0; ll < 64; ++ll) {
                const int e = __builtin_amdgcn_readlane(idxp[hf], ll);
                const float w = __uint_as_float((unsigned)__builtin_amdgcn_readlane((int)__float_as_uint(wv[hf]), ll));
                const f32x2v w2 = (f32x2v){w, w};
                const unsigned char* vrow = V8 + (size_t)e * DM;
#pragma unroll
                for (int c = 0; c < 2; ++c) { const v4u q4 = *(const v4u*)(vrow + (c * 64 + lane) * 16);
#pragma unroll
                    for (int q = 0; q < 4; ++q) { acc[c][2 * q] += w2 * __builtin_amdgcn_cvt_pk_f32_fp8((int)q4[q], false); acc[c][2 * q + 1] += w2 * __builtin_amdgcn_cvt_pk_f32_fp8((int)q4[q], true); } }
            }
        }
        float s = 0.f;
#pragma unroll
        for (int c = 0; c < 2; ++c)
#pragma unroll
            for (int k = 0; k < 8; ++k) { acc[c][k] = x[c][k] * ALPHA + acc[c][k]; s += acc[c][k][0] + acc[c][k][1]; }
        const float mean = wave_sum(s) * (1.0f / DM); float s2 = 0.f;
#pragma unroll
        for (int c = 0; c < 2; ++c)
#pragma unroll
            for (int k = 0; k < 8; ++k) { acc[c][k] = acc[c][k] - mean; s2 += acc[c][k][0] * acc[c][k][0] + acc[c][k][1] * acc[c][k][1]; }
        const float rstd = 1.0f / sqrtf(wave_sum(s2) * (1.0f / DM) + LN_EPS);
#pragma unroll
        for (int c = 0; c < 2; ++c) { const int col = (c * 64 + lane) * 16;
#pragma unroll
            for (int h8 = 0; h8 < 2; ++h8) { float o[8];
#pragma unroll
                for (int q = 0; q < 2; ++q) { const f32x4 gg = *(const f32x4*)(g2 + col + h8 * 8 + q * 4), bb = *(const f32x4*)(b2 + col + h8 * 8 + q * 4);
                    const f32x2v a0 = acc[c][h8 * 4 + 2 * q], a1 = acc[c][h8 * 4 + 2 * q + 1];
                    o[4 * q] = a0[0] * rstd * gg[0] + bb[0]; o[4 * q + 1] = a0[1] * rstd * gg[1] + bb[1]; o[4 * q + 2] = a1[0] * rstd * gg[2] + bb[2]; o[4 * q + 3] = a1[1] * rstd * gg[3] + bb[3];
                    *(f32x4*)(xrow + col + h8 * 8 + q * 4) = (f32x4){o[4 * q], o[4 * q + 1], o[4 * q + 2], o[4 * q + 3]}; }
                *(v4u*)(XN + (size_t)t * DM + col + h8 * 8) = pack8(o); } }
    }
}

#ifndef PHASE_TEST_ONLY
__global__ void __launch_bounds__(NTHR, 2) fwd_kernel(Args A) {
    extern __shared__ __attribute__((aligned(16))) unsigned char lds_raw[];
#define MKFRAME() Frame F; { F.lds = (LAS unsigned char*)lds_raw; F.tid = opaque((int)threadIdx.x); F.lane = F.tid & 63; F.wave = __builtin_amdgcn_readfirstlane(F.tid >> 6); \
        const int bx_ = opaque_s((int)blockIdx.x); F.G = gridDim.x; F.gw = bx_ * NWAVES + F.wave; F.NGW = F.G * NWAVES; F.gtid = (size_t)bx_ * NTHR + F.tid; F.NT = (size_t)F.G * NTHR; F.out = A.out; F.ws = A.ws; F.bx = bx_; }
    volatile LAS unsigned* MISC = (volatile LAS unsigned*)((LAS unsigned char*)lds_raw + LDS_MISC);
    if (threadIdx.x < 64) MISC[threadIdx.x] = 0u;
    __syncthreads();
    XcdBarrier bar = xcd_barrier_post((unsigned*)(A.ws + WS_CTL) + CW_BAR + A.li * XCD_BAR_WORDS, MISC + 8);
    const int lo = A.ph_lo, hi = A.ph_hi;
#define IN(k) (lo <= (k) && (k) < hi)
#define SEAM(k) do { if (lo <= (k) && (k) + 1 < hi) xcd_barrier(bar); } while (0)

    if (IN(0)) { MKFRAME(); p0_prologue(F, A); } SEAM(0);

    for (int l = 0; l < NLAYER; ++l) {
        const int pb = 1 + l * 10;
        bf16* XN = (bf16*)(A.ws + WS_XN); bf16* H = (bf16*)(A.ws + WS_H); bf16* CC = (bf16*)(A.ws + WS_CONCAT);
        if (IN(pb + 0)) { MKFRAME();
            pg8::Gemm g{XN, (const bf16*)(A.ws + WS_WIN) + (size_t)l * INW * DM, NTOK, INW, DM}; pg8::StaticOrder S; S.init(NTOK, INW, F.G, F.bx);
            EpiStoreBf16 E{H, INW};
            pg8::gemm_phase<EpiStoreBf16, pg8::StaticOrder, true, true>(F.lds, g, S, E);
        } SEAM(pb + 0);
        if (IN(pb + 1)) { MKFRAME(); s5_pass1(F, A, l); pool_phase(F, A); rotary_phase(F, A); } SEAM(pb + 1);
        if (IN(pb + 2)) { MKFRAME(); s5_carry(F, A, l); __syncthreads(); ret_state_phase(F, A); } SEAM(pb + 2);
        if (IN(pb + 3)) { MKFRAME(); s5_pass3(F, A, l); ret_prefix_phase(F, A); } SEAM(pb + 3);
        if (IN(pb + 4)) { MKFRAME();
            __syncthreads();
            ret_out_phase(F, A);
            {
                pg8::Gemm g{(const bf16*)(A.ws + WS_BUFY), (const bf16*)(A.ws + WS_WGLU) + (size_t)l * 512 * 512, NTOK, 512, 512}; pg8::StaticOrder S; S.init(NTOK, 512, F.G, F.bx);
                EpiGlu E{(const bf16*)(A.ws + WS_BUFY), 512, CC, DM, A.in[I_BGLU] + (size_t)l * 512};
                pg8::gemm_phase<EpiGlu, pg8::StaticOrder, true, true>(F.lds, g, S, E);
            }
            {
                pg8::Gemm g{(const bf16*)(A.ws + WS_BUFP), (const bf16*)(A.ws + WS_WPOOL) + (size_t)l * 512 * 512, NTOK, 512, 512}; pg8::StaticOrder S; S.init(NTOK, 512, F.G, F.bx);
                EpiScaleBf16 E{CC + 512, DM, A.in[I_POOLS] + (size_t)l * 512};
                pg8::gemm_phase<EpiScaleBf16, pg8::StaticOrder, true, true>(F.lds, g, S, E);
            }
        } SEAM(pb + 4);
        if (IN(pb + 5)) { MKFRAME();
            pg8::Gemm g{CC, (const bf16*)(A.ws + WS_WOUT) + (size_t)l * DM * DM, NTOK, DM, DM}; pg8::StaticOrder S; S.init(NTOK, DM, F.G, F.bx);
            EpiResid E{A.out, DM, ALPHA};
            pg8::gemm_phase<EpiResid, pg8::StaticOrder, true, true>(F.lds, g, S, E);
        } SEAM(pb + 5);
        if (IN(pb + 6)) { MKFRAME();
            for (int t = F.gw; t < NTOK; t += F.NGW) ln_row(A.out + (size_t)t * DM, A.in[I_LN1G] + (size_t)l * DM, A.in[I_LN1B] + (size_t)l * DM, A.out + (size_t)t * DM, XN + (size_t)t * DM, F.lane);
        } SEAM(pb + 6);
        if (IN(pb + 7)) { MKFRAME();
            pg8::Gemm g{XN, (const bf16*)(A.ws + WS_WS) + (size_t)l * DM * DM, NTOK, DM, DM}; pg8::StaticOrder S; S.init(NTOK, DM, F.G, F.bx);
            EpiStoreF32 E{(float*)(A.ws + WS_H), DM};
            pg8::gemm_phase<EpiStoreF32, pg8::StaticOrder, true, true>(F.lds, g, S, E);
        } SEAM(pb + 7);
        if (IN(pb + 8)) { MKFRAME(); __syncthreads(); topk_phase(F, A); } SEAM(pb + 8);
        if (IN(pb + 9)) { MKFRAME(); peer_gather_phase(F, A, l); } SEAM(pb + 9);
    }
#undef IN
#undef SEAM
}


#ifndef DBG_STOP
#define DBG_STOP NPHASE
#endif
#ifndef DBG_DUMP
#define DBG_DUMP 0
#endif
__global__ void dbg_dump_kernel(float* out, const unsigned char* ws, int mode) {
    const size_t n = (size_t)NTOK * DM;
    for (size_t i = (size_t)blockIdx.x * blockDim.x + threadIdx.x; i < n; i += (size_t)gridDim.x * blockDim.x) {
        float v = 0.f;
        if (mode == 1) v = bf_lo(((const bf16*)(ws + WS_H))[i]);
        else if (mode == 2) v = bf_lo(((const bf16*)(ws + WS_CONCAT))[i]);
        else if (mode == 3) v = bf_lo(((const bf16*)(ws + WS_BUFY))[i % ((size_t)NTOK * 1024)]);
        else if (mode == 4) v = bf_lo(((const bf16*)(ws + WS_STF))[i]);
        else if (mode == 5) v = ((const float*)(ws + WS_H))[i];
        else if (mode == 6) v = (i < (size_t)NTOK * 128) ? (float)((const int*)(ws + WS_IDX))[i] : ((i < (size_t)NTOK * 256) ? ((const float*)(ws + WS_GATE))[i - (size_t)NTOK * 128] : 0.f);
        else if (mode == 7) v = bf_lo(((const bf16*)(ws + WS_XN))[i]);
        else if (mode == 8) v = bf_lo(((const bf16*)(ws + WS_STB))[i]);
        else if (mode == 9) v = bf_lo(((const bf16*)(ws + WS_H))[i + (size_t)NTOK * DM]);
        else if (mode == 10) v = bf_lo(((const bf16*)(ws + WS_WIN))[i % ((size_t)72 * 1024 * 1024)]);
        else if (mode == 11) v = ((const float*)(ws + WS_S5ST))[i % ((size_t)5 * 1024 * 1024)];
        else if (mode == 12) v = bf_lo(((const bf16*)(ws + WS_H))[i]) + bf_lo(((const bf16*)(ws + WS_H))[i + (size_t)NTOK * DM]) + bf_lo(((const bf16*)(ws + WS_BUFP))[i % ((size_t)NTOK * 512)]) + ((const float*)(ws + WS_S5ST))[i % ((size_t)5 * 1024 * 1024)];
        else if (mode == 13) v = bf_lo(((const bf16*)(ws + WS_STF))[i]) + bf_lo(((const bf16*)(ws + WS_STB))[i]) + ((const float*)(ws + WS_S5ST))[i % ((size_t)5 * 1024 * 1024)];
        else if (mode == 14) v = bf_lo(((const bf16*)(ws + WS_STF))[i]) + bf_lo(((const bf16*)(ws + WS_STB))[i]) + bf_lo(((const bf16*)(ws + WS_BUFY))[i % ((size_t)NTOK * 512)]);
        else if (mode == 15) v = bf_lo(((const bf16*)(ws + WS_H))[i]) + bf_lo(((const bf16*)(ws + WS_H))[i + (size_t)NTOK * DM]) + bf_lo(((const bf16*)(ws + WS_H))[i + (size_t)NTOK * 3072]);
        out[i] = v;
    }
}
#ifndef MK_ONE_LAUNCH
#define MK_ONE_LAUNCH 0
#endif
extern "C" void kernel_launch(void* const* d_in, const int* in_sizes, int n_in, void* d_out, int out_size, void* d_ws, size_t ws_size, hipStream_t stream) {
    static int grid = 0;
    if (grid == 0) {
        if (n_in != 26 || out_size != NTOK * DM || ws_size < WS_END) { fprintf(stderr, "kernel_launch: unexpected shapes (n_in %d out %d ws %zu)\n", n_in, out_size, ws_size); grid = -1; return; }
        int dev = 0, cus = 0, per_cu = 0;
        if (hipGetDevice(&dev) != hipSuccess || hipDeviceGetAttribute(&cus, hipDeviceAttributeMultiprocessorCount, dev) != hipSuccess) { grid = -1; return; }
        if (hipFuncSetAttribute((const void*)fwd_kernel, hipFuncAttributeMaxDynamicSharedMemorySize, LDS_BYTES) != hipSuccess) { fprintf(stderr, "kernel_launch: hipFuncSetAttribute failed\n"); grid = -1; return; }
        if (hipOccupancyMaxActiveBlocksPerMultiprocessor(&per_cu, (const void*)fwd_kernel, NTHR, LDS_BYTES) != hipSuccess || per_cu < 1) { fprintf(stderr, "kernel_launch: occupancy query says %d\n", per_cu); grid = -1; (void)hipGetLastError(); return; }
        (void)hipGetLastError();
        grid = cus;
    }
    if (grid < 0) return;
    if (hipMemsetAsync((char*)d_ws + WS_CTL, 0, CTL_ZERO_BYTES, stream) != hipSuccess) return;
    Args a{};
    for (int i = 0; i < 26; ++i) a.in[i] = (const float*)d_in[i];
    a.out = (float*)d_out; a.ws = (unsigned char*)d_ws; a.pad = 0;
#if MK_ONE_LAUNCH
    a.ph_lo = 0; a.ph_hi = NPHASE; a.li = 0;
    hipLaunchKernelGGL(fwd_kernel, dim3(grid), dim3(NTHR), LDS_BYTES, stream, a);
#else
    for (int p = 0; p < DBG_STOP; ++p) { a.ph_lo = p; a.ph_hi = p + 1; a.li = p; hipLaunchKernelGGL(fwd_kernel, dim3(grid), dim3(NTHR), LDS_BYTES, stream, a); }
#endif
    if (DBG_DUMP) hipLaunchKernelGGL(dbg_dump_kernel, dim3(2048), dim3(256), 0, stream, (float*)d_out, (const unsigned char*)d_ws, DBG_DUMP);
}
#endif
```

```cpp
#include <hip/hip_runtime.h>
#include <cstdio>
#include <cstdint>
#include <cmath>
__device__ __forceinline__ int opaque(int v) { asm volatile("" : "+v"(v)); return v; }
__device__ __forceinline__ int opaque_s(int v) { asm volatile("" : "+s"(v)); return v; }
__device__ __forceinline__ void* opaque_p(void* p) { asm volatile("" : "+s"(p)); return p; }
__device__ __forceinline__ unsigned long long opaque_u64(unsigned long long v) { asm volatile("" : "+s"(v)); return v; }
#define MK_ONE_LAUNCH 1
namespace pg8 {
#define PG8_LAS __attribute__((address_space(3)))
typedef unsigned short bf16_t;
typedef short bf16x8 __attribute__((ext_vector_type(8)));
typedef float f32x4 __attribute__((ext_vector_type(4)));
typedef unsigned u32x4 __attribute__((ext_vector_type(4)));
constexpr int BM = 256, BK = 64, HALF = 128, HTB = HALF * BK * 2  , STAGE_BYTES = 8 * HTB, NXCD = 8, WGM = 8;

__host__ __device__ __forceinline__ int lds_byte(int r, int c) { const int st = (r >> 4) * 2 + (c >> 5), rr = r & 15, cc = c & 31, ob = rr * 64 + cc * 2; return st * 1024 + (ob ^ (((ob >> 9) & 1) << 5)); }
__host__ __device__ __forceinline__ void stage_rc(int b, int& R, int& C) { const int st = b / 1024, sb = b % 1024, swz = sb ^ (((sb >> 9) & 1) << 5); R = (st >> 1) * 16 + swz / 64; C = (st & 1) * 32 + (swz % 64) / 2; }
__host__ __device__ __forceinline__ int perm32(int rho) { const int n = rho >> 4, i = rho & 15; return 8 * (i >> 2) + 4 * n + (i & 3); }

struct Unit { int pm, pn; };
struct Gemm { const bf16_t* A; const bf16_t* Bt; int M, N, K; };

struct StaticOrder {
    int nM, nN, nwg, G, c;
    __host__ __device__ void init(int M, int N, int G_, int c_) { nM = M / BM; nN = N / BM; nwg = nM * nN; G = G_; c = c_; }
    __host__ __device__ bool next(int i, Unit& u) const {
        const long L = (long)i * G + c; if (L >= nwg) return false;
        int wgid = (int)L; { const int q = nwg / NXCD, r = nwg % NXCD, xcd = wgid % NXCD, off = wgid / NXCD; wgid = (xcd < r ? xcd * (q + 1) : r * (q + 1) + (xcd - r) * q) + off; }
        const int nig = WGM * nN, gid = wgid / nig, fm = gid * WGM, gsz = (nM - fm) < WGM ? (nM - fm) : WGM;
        u.pm = fm + ((wgid % nig) % gsz); u.pn = (wgid % nig) / gsz; return true;
    }
    __device__ __forceinline__ void a_ready(const Unit&) const {}
    __device__ __forceinline__ void done(const Unit&) const {}
};
__device__ __forceinline__ unsigned cvt_pk_bf16(float lo, float hi) { unsigned r; asm volatile("v_cvt_pk_bf16_f32 %0, %1, %2" : "=v"(r) : "v"(lo), "v"(hi)); return r; }
typedef float f32x2 __attribute__((ext_vector_type(2)));
template <class Epi, class Sched, bool ALIGN_EPI = false, bool SP2 = false>
__device__ __forceinline__ void gemm_phase(PG8_LAS unsigned char* lds, const Gemm g, const Sched& S, const Epi& E) {
    const int tid = opaque((int)threadIdx.x), wid = __builtin_amdgcn_readfirstlane(tid >> 6), lane = tid & 63, wr = wid >> 2, wc = wid & 3, fr = lane & 15, fq = lane >> 4;
    const int K = g.K, nt = K / BK;
    unsigned voffA[2], voffB[2];
#pragma unroll
    for (int i = 0; i < 2; ++i) { int R, C; stage_rc(tid * 16 + i * 8192, R, C); const int Rb = Epi::PERM ? ((R & ~31) + perm32(R & 31)) : R;
        voffA[i] = (unsigned)(R * K + C) * 2u; voffB[i] = (unsigned)(Rb * K + C) * 2u; }
    const size_t kstep = (size_t)(BK * 2);
    const size_t hstep = (size_t)HALF * K * 2;
    const size_t tstep = 2 * hstep;
    const unsigned ldsw = (unsigned)wid * 1024u;
    const int aoff = lds_byte(wr * 64 + fr, fq * 8), boff = lds_byte(wc * 32 + fr, fq * 8);
#define PG8_SA(b, h) (((b) * 2 + (h)) * HTB)
#define PG8_SB(b, h) ((4 + (b) * 2 + (h)) * HTB)
#define PG8_STAGE(bufoff, gbase, voff) do { _Pragma("unroll") for (int _i = 0; _i < 2; ++_i) \
        __builtin_amdgcn_global_load_lds((const unsigned*)((const char*)(gbase) + (voff)[_i]), (PG8_LAS unsigned*)(lds + (bufoff) + ldsw + _i * 8192), 16, 0, 0); } while (0)
#define PG8_LDA(dst, b, h) do { _Pragma("unroll") for (int m = 0; m < 4; ++m) _Pragma("unroll") for (int k = 0; k < 2; ++k) dst[m][k] = *(const PG8_LAS bf16x8*)(lds + PG8_SA(b, h) + aoff + m * 2048 + k * 1024); } while (0)
#define PG8_LDB(dst, b, h) do { _Pragma("unroll") for (int n = 0; n < 2; ++n) _Pragma("unroll") for (int k = 0; k < 2; ++k) dst[n][k] = *(const PG8_LAS bf16x8*)(lds + PG8_SB(b, h) + boff + n * 2048 + k * 1024); } while (0)
#define PG8_MMA(ai, bj, At, Bt) do { __builtin_amdgcn_s_setprio(1); _Pragma("unroll") for (int m = 0; m < 4; ++m) _Pragma("unroll") for (int n = 0; n < 2; ++n) _Pragma("unroll") for (int k = 0; k < 2; ++k) \
        acc[ai][bj][m][n] = __builtin_amdgcn_mfma_f32_16x16x32_bf16(Bt[n][k], At[m][k], acc[ai][bj][m][n], 0, 0, 0); __builtin_amdgcn_s_setprio(0); } while (0)
#define PG8_WAIT_V(n) asm volatile("s_waitcnt vmcnt(" #n ")" ::: "memory")
#define PG8_WAIT_L(n) asm volatile("s_waitcnt lgkmcnt(" #n ")" ::: "memory")
#define PG8_BAR __builtin_amdgcn_s_barrier()
#define PG8_SCHED __builtin_amdgcn_sched_barrier(0)
    Unit cur, nxt; int ui = 0;
    if (!S.next(0, cur)) return;
    f32x4 acc[2][2][4][2];
#pragma unroll
    for (int a = 0; a < 2; ++a)
#pragma unroll
        for (int b = 0; b < 2; ++b)
#pragma unroll
            for (int m = 0; m < 4; ++m)
#pragma unroll
                for (int n = 0; n < 2; ++n) acc[a][b][m][n] = (f32x4){0.f, 0.f, 0.f, 0.f};
    bf16x8 At[4][2], B0[2][2], B1[2][2];
    const char* cA = (const char*)g.A + (size_t)cur.pm * tstep; const char* cB = (const char*)g.Bt + (size_t)cur.pn * tstep;
    S.a_ready(cur);
    if constexpr (SP2) {
        PG8_STAGE(PG8_SB(0, 0), cB, voffB); PG8_STAGE(PG8_SB(0, 1), cB + hstep, voffB); PG8_STAGE(PG8_SA(0, 0), cA, voffA); PG8_STAGE(PG8_SA(0, 1), cA + hstep, voffA);
        if (wr == 1) PG8_BAR;
        PG8_WAIT_V(2); PG8_BAR;
        PG8_STAGE(PG8_SB(1, 0), cB + kstep, voffB); PG8_STAGE(PG8_SA(1, 0), cA + kstep, voffA); PG8_STAGE(PG8_SB(1, 1), cB + hstep + kstep, voffB);
        PG8_WAIT_V(6); PG8_BAR;
    } else {
        PG8_STAGE(PG8_SB(0, 0), cB, voffB); PG8_STAGE(PG8_SA(0, 0), cA, voffA); PG8_STAGE(PG8_SB(0, 1), cB + hstep, voffB); PG8_STAGE(PG8_SA(0, 1), cA + hstep, voffA);
        if (wr == 1) PG8_BAR;
        PG8_WAIT_V(4); PG8_BAR;
        PG8_STAGE(PG8_SB(1, 0), cB + kstep, voffB); PG8_STAGE(PG8_SA(1, 0), cA + kstep, voffA); PG8_STAGE(PG8_SB(1, 1), cB + hstep + kstep, voffB);
        PG8_WAIT_V(6); PG8_BAR;
    }
    for (;;) {
        const bool has_next = S.next(ui + 1, nxt);
        const char* nA = has_next ? (const char*)g.A + (size_t)nxt.pm * tstep : cA; const char* nB = has_next ? (const char*)g.Bt + (size_t)nxt.pn * tstep : cB;
        for (int t = 0; t < nt; t += 2) {
            const bool last = (t == nt - 2);
            const char* a1 = cA + (size_t)(t + 1) * kstep;
            const char* a2 = last ? nA : cA + (size_t)(t + 2) * kstep; const char* b2 = last ? nB : cB + (size_t)(t + 2) * kstep;
            const char* a3 = a2 + kstep; const char* b3 = b2 + kstep;
            if (last && has_next) S.a_ready(nxt);
            if constexpr (SP2) {
            PG8_LDB(B0, 0, 0); PG8_LDB(B1, 0, 1); PG8_SCHED; PG8_LDA(At, 0, 0); PG8_STAGE(PG8_SA(1, 1), a1 + hstep, voffA);
            PG8_WAIT_V(8); PG8_WAIT_L(0); PG8_BAR; PG8_MMA(0, 0, At, B0); PG8_MMA(0, 1, At, B1); PG8_BAR; PG8_SCHED;
            PG8_LDA(At, 0, 1); PG8_STAGE(PG8_SB(0, 0), b2, voffB); PG8_STAGE(PG8_SB(0, 1), b2 + hstep, voffB); PG8_STAGE(PG8_SA(0, 0), a2, voffA);
            PG8_WAIT_V(8); PG8_WAIT_L(0); PG8_BAR; PG8_MMA(1, 0, At, B0); PG8_MMA(1, 1, At, B1); PG8_BAR; PG8_SCHED;
            PG8_LDB(B0, 1, 0); PG8_LDB(B1, 1, 1); PG8_SCHED; PG8_LDA(At, 1, 0); PG8_STAGE(PG8_SA(0, 1), a2 + hstep, voffA);
            PG8_WAIT_V(8); PG8_WAIT_L(0); PG8_BAR; PG8_MMA(0, 0, At, B0); PG8_MMA(0, 1, At, B1); PG8_BAR; PG8_SCHED;
            PG8_LDA(At, 1, 1); PG8_STAGE(PG8_SB(1, 0), b3, voffB); PG8_STAGE(PG8_SB(1, 1), b3 + hstep, voffB); PG8_STAGE(PG8_SA(1, 0), a3, voffA);
            PG8_WAIT_V(8); PG8_WAIT_L(0); PG8_BAR; PG8_MMA(1, 0, At, B0); PG8_MMA(1, 1, At, B1); PG8_BAR; PG8_SCHED;
            } else {
            PG8_LDB(B0, 0, 0); PG8_SCHED; PG8_LDA(At, 0, 0); PG8_STAGE(PG8_SA(1, 1), a1 + hstep, voffA);
            PG8_WAIT_L(8); PG8_BAR; PG8_WAIT_L(0); PG8_MMA(0, 0, At, B0); PG8_BAR; PG8_SCHED;
            PG8_LDB(B1, 0, 1); PG8_STAGE(PG8_SB(0, 0), b2, voffB);
            PG8_BAR; PG8_WAIT_L(0); PG8_MMA(0, 1, At, B1); PG8_BAR;
            PG8_LDA(At, 0, 1); PG8_STAGE(PG8_SA(0, 0), a2, voffA);
            PG8_BAR; PG8_WAIT_L(0); PG8_MMA(1, 0, At, B0); PG8_BAR; PG8_SCHED;
            PG8_STAGE(PG8_SB(0, 1), b2 + hstep, voffB);
            PG8_WAIT_V(6); PG8_BAR; PG8_MMA(1, 1, At, B1); PG8_BAR;
            PG8_LDB(B0, 1, 0); PG8_SCHED; PG8_LDA(At, 1, 0); PG8_STAGE(PG8_SA(0, 1), a2 + hstep, voffA);
            PG8_WAIT_L(8); PG8_BAR; PG8_WAIT_L(0); PG8_MMA(0, 0, At, B0); PG8_BAR; PG8_SCHED;
            PG8_LDB(B1, 1, 1); PG8_STAGE(PG8_SB(1, 0), b3, voffB);
            PG8_BAR; PG8_WAIT_L(0); PG8_MMA(0, 1, At, B1); PG8_BAR;
            PG8_LDA(At, 1, 1); PG8_STAGE(PG8_SA(1, 0), a3, voffA);
            PG8_BAR; PG8_WAIT_L(0); PG8_MMA(1, 0, At, B0); PG8_BAR; PG8_SCHED;
            PG8_STAGE(PG8_SB(1, 1), b3 + hstep, voffB);
            PG8_WAIT_V(6); PG8_BAR; PG8_MMA(1, 1, At, B1); PG8_BAR;
            }
        }
        if constexpr (ALIGN_EPI) { if (wr == 0) PG8_BAR; }
        if constexpr (!Epi::AFTER_DRAIN) { E(acc, cur, wr, wc, fr, fq); S.done(cur); }
        if (!has_next) break;
#pragma unroll
        for (int a = 0; a < 2; ++a)
#pragma unroll
            for (int b = 0; b < 2; ++b)
#pragma unroll
                for (int m = 0; m < 4; ++m)
#pragma unroll
                    for (int n = 0; n < 2; ++n) acc[a][b][m][n] = (f32x4){0.f, 0.f, 0.f, 0.f};
        cur = nxt; cA = nA; cB = nB; ++ui;
        if constexpr (ALIGN_EPI) { if (wr == 1) PG8_BAR; }
    }
    PG8_WAIT_V(0);
    if constexpr (!ALIGN_EPI) { if (wr == 0) PG8_BAR; }
    PG8_BAR;
    if constexpr (Epi::AFTER_DRAIN) { E.fused(acc, cur, wr, wc, fr, fq, lds, wid, lane); S.done(cur); }
#undef PG8_SA
#undef PG8_SB
#undef PG8_STAGE
#undef PG8_LDA
#undef PG8_LDB
#undef PG8_MMA
#undef PG8_WAIT_V
#undef PG8_WAIT_L
#undef PG8_BAR
#undef PG8_SCHED
}
}
#define LAS __attribute__((address_space(3)))
#define XB_TMO      128
#define XB_XCNT(j)  (256  + 64 * (j))
#define XB_XSUB(j)  (1280 + 64 * (j))
#define XB_XGEN(j)  (2304 + 64 * (j))
#define XB_TOP      3328
#define XB_TOPGEN   3392
#define XCD_BAR_WORDS 3456
#define XB_SPIN_CAP (1u << 18)

__device__ __forceinline__ unsigned xb_ld(unsigned* p)              { return __hip_atomic_load(p, __ATOMIC_RELAXED, __HIP_MEMORY_SCOPE_AGENT); }
__device__ __forceinline__ unsigned xb_add(unsigned* p, unsigned v) { return __hip_atomic_fetch_add(p, v, __ATOMIC_RELAXED, __HIP_MEMORY_SCOPE_AGENT); }
__device__ __forceinline__ unsigned xb_xcc_id() { return (unsigned)__builtin_amdgcn_s_getreg((3 << 11) | 20) & 0xFu; }
#define XB_SPIN(cond, bar) do { unsigned _sp = 0; while (cond) { __builtin_amdgcn_s_sleep(1); \
    if ((++_sp & 255u) == 0u) { if (xb_ld(&(bar)[XB_TMO])) break; if (_sp > XB_SPIN_CAP) { atomicAdd(&(bar)[XB_TMO], 1u); break; } } } } while (0)

struct XcdBarrier {
    unsigned* bar; unsigned x;
    volatile LAS unsigned* st;
};

__device__ __forceinline__ XcdBarrier xcd_barrier_post(unsigned* bar, volatile LAS unsigned* st) {
    XcdBarrier b; b.bar = bar; b.x = xb_xcc_id(); b.st = st;
    if (threadIdx.x == 0) (void)xb_add(&bar[XB_XCNT(b.x)], 1u);
    return b;
}
__device__ __forceinline__ void xcd_barrier_complete(unsigned* bar, unsigned x, unsigned& nloc, unsigned& nx) {
    const unsigned G = gridDim.x * gridDim.y * gridDim.z;
    unsigned sum, cnt, mine, sp = 0u;
    for (;;) {
        sum = 0u; cnt = 0u; mine = 0u;
#pragma unroll
        for (unsigned j = 0; j < 16; ++j) { const unsigned c = xb_ld(&bar[XB_XCNT(j)]); sum += c; cnt += (c > 0u) ? 1u : 0u; mine = (j == x) ? c : mine; }
        if (sum == G) break;
        __builtin_amdgcn_s_sleep(1);
        if ((++sp & 255u) == 0u) { if (xb_ld(&bar[XB_TMO])) break; if (sp > XB_SPIN_CAP) { atomicAdd(&bar[XB_TMO], 1u); break; } }
    }
    nloc = mine > 0u ? mine : 1u; nx = cnt > 0u ? cnt : 1u;
}

__device__ __forceinline__ void xcd_barrier(const XcdBarrier& b) {
    asm volatile("s_waitcnt vmcnt(0)" ::: "memory");
    __syncthreads();
    if (threadIdx.x == 0) {
        unsigned* bar = b.bar;
        __builtin_amdgcn_s_waitcnt(0);
        unsigned nloc = b.st[0], nx = b.st[1];
        if (nloc == 0u) { xcd_barrier_complete(bar, b.x, nloc, nx); b.st[0] = nloc; b.st[1] = nx; }
        const unsigned old = xb_add(&bar[XB_XSUB(b.x)], 1u);
        const unsigned gen = old / nloc;
        if (old + 1u == (gen + 1u) * nloc) {
            __builtin_amdgcn_fence(__ATOMIC_RELEASE, "agent");
            asm volatile("s_waitcnt vmcnt(0)" ::: "memory");
            const unsigned og = xb_add(&bar[XB_TOP], 1u);
            const unsigned tg = og / nx;
            if (og + 1u == (tg + 1u) * nx) xb_add(&bar[XB_TOPGEN], 1u);
            else XB_SPIN(xb_ld(&bar[XB_TOPGEN]) == tg, bar);
            __builtin_amdgcn_fence(__ATOMIC_ACQUIRE, "agent");
            xb_add(&bar[XB_XGEN(b.x)], 1u);
            asm volatile("s_waitcnt vmcnt(0)" ::: "memory");
        } else {
            XB_SPIN(xb_ld(&bar[XB_XGEN(b.x)]) == gen, bar);
            __builtin_amdgcn_fence(__ATOMIC_ACQUIRE, "agent");
            asm volatile("s_waitcnt vmcnt(0)" ::: "memory");
        }
    }
    __syncthreads();
}
#undef LAS
using pg8::bf16x8; using pg8::f32x4; using pg8::u32x4; using pg8::f32x2;
#define GAS __attribute__((address_space(1)))
#define LAS __attribute__((address_space(3)))
typedef unsigned short bf16;
typedef unsigned v4u __attribute__((ext_vector_type(4)));
typedef unsigned v2u __attribute__((ext_vector_type(2)));
typedef float f32x2v __attribute__((ext_vector_type(2)));

constexpr int NTOK = 40960, DM = 2048, NLAYER = 4, INW = 5120;
constexpr int COL_UA = 0, COL_UB = 512, COL_Q = 1024, COL_K = 2048, COL_V = 3072, COL_G = 4096;
constexpr float ALPHA = 1.6817928305074290f;
constexpr float LN_EPS = 1e-5f, GN_EPS = 1e-6f;
constexpr int NEXP = 16384;
constexpr int NWAVES = 8, NTHR = 512;

constexpr size_t MiB = 1u << 20;
constexpr size_t WS_CTL = 0, CTL_ZERO_BYTES = 1 * MiB;
constexpr size_t WS_WIN = 1 * MiB;
constexpr size_t WS_WOUT = 81 * MiB;
constexpr size_t WS_WS = 113 * MiB;
constexpr size_t WS_WGLU = 145 * MiB;
constexpr size_t WS_WPOOL = 147 * MiB;
constexpr size_t WS_S5A = 149 * MiB;
constexpr size_t WS_S5B = 150 * MiB;
constexpr size_t WS_ROT = 152 * MiB;
constexpr size_t WS_U16 = 160 * MiB;
constexpr size_t WS_V16 = 416 * MiB;
constexpr size_t WS_U8 = 160 * MiB;
constexpr size_t WS_V8 = 288 * MiB;
constexpr size_t WS_USC = 416 * MiB;
constexpr size_t WS_VSC = 417 * MiB;
constexpr size_t WS_XN = 672 * MiB;
constexpr size_t WS_H = 832 * MiB;
constexpr size_t WS_CONCAT = 1232 * MiB;
constexpr size_t WS_BUFY = 1392 * MiB;
constexpr size_t WS_BUFP = 1432 * MiB;
constexpr size_t WS_STF = 1472 * MiB;
constexpr size_t WS_STB = 1632 * MiB;
constexpr size_t WS_IDX = 1792 * MiB;
constexpr size_t WS_GATE = 1812 * MiB;
constexpr size_t WS_S5ST = 1832 * MiB;
constexpr size_t WS_END = 1852 * MiB;
constexpr int CW_BAR = 4096;
constexpr int NPHASE = 1 + NLAYER * 10;

constexpr int LDS_SCRATCH = 147456;
constexpr int LDS_MISC = LDS_SCRATCH;
constexpr int LDS_BYTES = LDS_SCRATCH + 256;

__device__ __forceinline__ float bf_lo(unsigned w) { return __uint_as_float(w << 16); }
__device__ __forceinline__ float bf_hi(unsigned w) { return __uint_as_float(w & 0xffff0000u); }
typedef __bf16 bf16x2_t __attribute__((ext_vector_type(2)));
__device__ __forceinline__ unsigned pkbf(float lo, float hi) { const bf16x2_t v = {(__bf16)lo, (__bf16)hi}; return __builtin_bit_cast(unsigned, v); }
__device__ __forceinline__ bf16 f2bf(float f) { return __builtin_bit_cast(unsigned short, (__bf16)f); }
__device__ __forceinline__ float wave_sum(float v) {
#pragma unroll
    for (int o = 1; o < 64; o <<= 1) v += __shfl_xor(v, o);
    return v;
}
__device__ __forceinline__ float gelu_erf(float v) { return 0.5f * v * (1.0f + erff(v * 0.70710678118654752f)); }
__device__ __forceinline__ int tok_pos(int t) { return t < 32768 ? (t & 4095) : (t - 32768); }
__device__ __forceinline__ int tok_len(int t) { return t < 32768 ? 4096 : 8192; }
__device__ __forceinline__ void unpack8(const v4u q, float (&f)[8]) {
    f[0] = bf_lo(q.x); f[1] = bf_hi(q.x); f[2] = bf_lo(q.y); f[3] = bf_hi(q.y); f[4] = bf_lo(q.z); f[5] = bf_hi(q.z); f[6] = bf_lo(q.w); f[7] = bf_hi(q.w);
}
__device__ __forceinline__ v4u pack8(const float (&f)[8]) { v4u q; q.x = pkbf(f[0], f[1]); q.y = pkbf(f[2], f[3]); q.z = pkbf(f[4], f[5]); q.w = pkbf(f[6], f[7]); return q; }
#define LDS_WAIT() asm volatile("s_waitcnt lgkmcnt(0)" ::: "memory")
#define MFMA16(a, b, c) __builtin_amdgcn_mfma_f32_16x16x32_bf16((a), (b), (c), 0, 0, 0)

struct EpiStoreBf16 {
    static constexpr bool PERM = true, AFTER_DRAIN = false;
    bf16* O; int ldo;
    __device__ __forceinline__ void operator()(const f32x4 (&acc)[2][2][4][2], const pg8::Unit& u, int wr, int wc, int fr, int fq) const {
        const int row0 = u.pm * 256 + wr * 64 + fr, col0 = u.pn * 256 + wc * 32 + 8 * fq;
#pragma unroll
        for (int ai = 0; ai < 2; ++ai)
#pragma unroll
            for (int m = 0; m < 4; ++m) { bf16* rowp = O + (size_t)(row0 + ai * 128 + m * 16) * ldo + col0;
#pragma unroll
                for (int bj = 0; bj < 2; ++bj) { const f32x4 v0 = acc[ai][bj][m][0], v1 = acc[ai][bj][m][1];
                    v4u w; w.x = pkbf(v0[0], v0[1]); w.y = pkbf(v0[2], v0[3]); w.z = pkbf(v1[0], v1[1]); w.w = pkbf(v1[2], v1[3]);
                    *(v4u*)(rowp + bj * 128) = w; } }
    }
};
struct EpiGlu {
    static constexpr bool PERM = true, AFTER_DRAIN = false;
    const bf16* Y; int ldy; bf16* O; int ldo; const float* bias;
    __device__ __forceinline__ void operator()(const f32x4 (&acc)[2][2][4][2], const pg8::Unit& u, int wr, int wc, int fr, int fq) const {
        const int row0 = u.pm * 256 + wr * 64 + fr, col0 = u.pn * 256 + wc * 32 + 8 * fq;
#pragma unroll
        for (int bj = 0; bj < 2; ++bj) {
            const f32x4 b0 = *(const f32x4*)(bias + col0 + bj * 128), b1 = *(const f32x4*)(bias + col0 + bj * 128 + 4);
#pragma unroll
            for (int ai = 0; ai < 2; ++ai)
#pragma unroll
                for (int m = 0; m < 4; ++m) { const size_t r = (size_t)(row0 + ai * 128 + m * 16);
                    const v4u yq = *(const v4u*)(Y + r * ldy + col0 + bj * 128); float y[8]; unpack8(yq, y);
                    const f32x4 v0 = acc[ai][bj][m][0] + b0, v1 = acc[ai][bj][m][1] + b1; float o[8];
#pragma unroll
                    for (int k = 0; k < 4; ++k) { o[k] = y[k] / (1.0f + __expf(-v0[k])); o[4 + k] = y[4 + k] / (1.0f + __expf(-v1[k])); }
                    *(v4u*)(O + r * ldo + col0 + bj * 128) = pack8(o); }
        }
    }
};
struct EpiScaleBf16 {
    static constexpr bool PERM = true, AFTER_DRAIN = false;
    bf16* O; int ldo; const float* scale;
    __device__ __forceinline__ void operator()(const f32x4 (&acc)[2][2][4][2], const pg8::Unit& u, int wr, int wc, int fr, int fq) const {
        const int row0 = u.pm * 256 + wr * 64 + fr, col0 = u.pn * 256 + wc * 32 + 8 * fq;
#pragma unroll
        for (int bj = 0; bj < 2; ++bj) {
            const f32x4 s0 = *(const f32x4*)(scale + col0 + bj * 128), s1 = *(const f32x4*)(scale + col0 + bj * 128 + 4);
#pragma unroll
            for (int ai = 0; ai < 2; ++ai)
#pragma unroll
                for (int m = 0; m < 4; ++m) { const size_t r = (size_t)(row0 + ai * 128 + m * 16);
                    const f32x4 v0 = acc[ai][bj][m][0] * s0, v1 = acc[ai][bj][m][1] * s1;
                    v4u w; w.x = pkbf(v0[0], v0[1]); w.y = pkbf(v0[2], v0[3]); w.z = pkbf(v1[0], v1[1]); w.w = pkbf(v1[2], v1[3]);
                    *(v4u*)(O + r * ldo + col0 + bj * 128) = w; }
        }
    }
};
struct EpiResid {
    static constexpr bool PERM = false, AFTER_DRAIN = false;
    float* X; int ldx; float alpha;
    __device__ __forceinline__ void operator()(const f32x4 (&acc)[2][2][4][2], const pg8::Unit& u, int wr, int wc, int fr, int fq) const {
        const int row0 = u.pm * 256 + wr * 64 + fr, col0 = u.pn * 256 + wc * 32 + 4 * fq;
#pragma unroll
        for (int ai = 0; ai < 2; ++ai)
#pragma unroll
            for (int m = 0; m < 4; ++m) { float* rowp = X + (size_t)(row0 + ai * 128 + m * 16) * ldx + col0;
#pragma unroll
                for (int bj = 0; bj < 2; ++bj)
#pragma unroll
                    for (int n = 0; n < 2; ++n) { f32x4* p = (f32x4*)(rowp + bj * 128 + n * 16); const f32x4 x = *p; *p = x * alpha + acc[ai][bj][m][n]; } }
    }
};
struct EpiStoreF32 {
    static constexpr bool PERM = false, AFTER_DRAIN = false;
    float* C; int ldc;
    __device__ __forceinline__ void operator()(const f32x4 (&acc)[2][2][4][2], const pg8::Unit& u, int wr, int wc, int fr, int fq) const {
        const int row0 = u.pm * 256 + wr * 64 + fr, col0 = u.pn * 256 + wc * 32 + 4 * fq;
#pragma unroll
        for (int ai = 0; ai < 2; ++ai)
#pragma unroll
            for (int m = 0; m < 4; ++m) { float* rowp = C + (size_t)(row0 + ai * 128 + m * 16) * ldc + col0;
#pragma unroll
                for (int bj = 0; bj < 2; ++bj)
#pragma unroll
                    for (int n = 0; n < 2; ++n) *(f32x4*)(rowp + bj * 128 + n * 16) = acc[ai][bj][m][n]; }
    }
};

struct Args { const float* in[26]; float* out; unsigned char* ws; int ph_lo, ph_hi, li, pad; };
typedef const Args __attribute__((address_space(4))) CArgs;
struct Frame {
    LAS unsigned char* lds;
    int tid, lane, wave, G, bx;
    int gw, NGW;
    size_t gtid, NT;
    float* out; unsigned char* ws;
};
enum InIdx { I_XP = 0, I_XS, I_LNIN_G, I_LNIN_B, I_WIN, I_LAMRE, I_LAMIM, I_LOGSTEP, I_BRE, I_BIM, I_CRE, I_CIM, I_S5D, I_WGLU, I_BGLU, I_POOLW, I_POOLS,
             I_WOUT, I_LN1G, I_LN1B, I_WQ, I_KEYS, I_PU, I_PV, I_LN2G, I_LN2B };

__device__ __forceinline__ void ln_row(const float* src, const float* g, const float* b, float* dst, bf16* dstb, int lane) {
    f32x4 v[8]; float s = 0.f;
#pragma unroll
    for (int j = 0; j < 8; ++j) { v[j] = ((const f32x4*)src)[lane + 64 * j]; s += (v[j][0] + v[j][1]) + (v[j][2] + v[j][3]); }
    const float mean = wave_sum(s) * (1.0f / DM); float s2 = 0.f;
#pragma unroll
    for (int j = 0; j < 8; ++j) { v[j] = v[j] - mean; s2 += (v[j][0] * v[j][0] + v[j][1] * v[j][1]) + (v[j][2] * v[j][2] + v[j][3] * v[j][3]); }
    const float rstd = 1.0f / sqrtf(wave_sum(s2) * (1.0f / DM) + LN_EPS);
#pragma unroll
    for (int j = 0; j < 8; ++j) { const f32x4 gg = ((const f32x4*)g)[lane + 64 * j], bb = ((const f32x4*)b)[lane + 64 * j];
        const f32x4 o = v[j] * rstd * gg + bb; ((f32x4*)dst)[lane + 64 * j] = o;
        v2u w; w.x = pkbf(o[0], o[1]); w.y = pkbf(o[2], o[3]); ((v2u*)dstb)[lane + 64 * j] = w; }
}

__device__ __forceinline__ void transpose_item(const float* W, int K, int N, bf16* WT, LAS float* scr, int item, int lane) {
    const int nblk = N / 32, kb = item / nblk, nb = item % nblk, k0 = 64 * kb, n0 = 32 * nb;
#pragma unroll 8
    for (int i = 0; i < 32; ++i) { const int kk = 2 * i + (lane >> 5); scr[kk * 33 + (lane & 31)] = W[(size_t)(k0 + kk) * N + n0 + (lane & 31)]; }
    LDS_WAIT();
    const int c = lane & 7;
#pragma unroll
    for (int j = 0; j < 4; ++j) { const int n = (lane >> 3) + 8 * j; const LAS float* s = scr + (8 * c) * 33 + n;
        v4u o; o.x = pkbf(s[0 * 33], s[1 * 33]); o.y = pkbf(s[2 * 33], s[3 * 33]); o.z = pkbf(s[4 * 33], s[5 * 33]); o.w = pkbf(s[6 * 33], s[7 * 33]);
        *(v4u*)(WT + (size_t)(n0 + n) * K + k0 + 8 * c) = o; }
    LDS_WAIT();
}

__device__ __forceinline__ void p0_prologue(const Frame& F, CArgs& A) {
    {
        LAS float* scr = (LAS float*)(F.lds + F.wave * 16384);
        constexpr int I_IN = (DM / 64) * (INW / 32), I_OUT = (DM / 64) * (DM / 32), I_GLU = (512 / 64) * (512 / 32);
        constexpr int NITEMS = NLAYER * (I_IN + I_OUT + I_GLU);
        for (int it = F.gw; it < NITEMS; it += F.NGW) {
            int r = it;
            if (r < NLAYER * I_IN) { const int l = r / I_IN; transpose_item(A.in[I_WIN] + (size_t)l * DM * INW, DM, INW, (bf16*)(F.ws + WS_WIN) + (size_t)l * INW * DM, scr, r % I_IN, F.lane); continue; }
            r -= NLAYER * I_IN;
            if (r < NLAYER * I_OUT) { const int l = r / I_OUT; transpose_item(A.in[I_WOUT] + (size_t)l * DM * DM, DM, DM, (bf16*)(F.ws + WS_WOUT) + (size_t)l * DM * DM, scr, r % I_OUT, F.lane); continue; }
            r -= NLAYER * I_OUT;
            { const int l = r / I_GLU; transpose_item(A.in[I_WGLU] + (size_t)l * 512 * 512, 512, 512, (bf16*)(F.ws + WS_WGLU) + (size_t)l * 512 * 512, scr, r % I_GLU, F.lane); }
        }
    }
    {
        for (int r = F.gw; r < 2 * NLAYER * NEXP; r += F.NGW) {
            const int tab = r >= NLAYER * NEXP, ri = tab ? r - NLAYER * NEXP : r;
            const float* src = (tab ? A.in[I_PV] : A.in[I_PU]) + (size_t)ri * DM;
            f32x4 v[2][4]; float am = 0.f;
#pragma unroll
            for (int c = 0; c < 2; ++c)
#pragma unroll
                for (int q = 0; q < 4; ++q) { v[c][q] = *(const f32x4*)(src + (c * 64 + F.lane) * 16 + q * 4);
                    am = fmaxf(am, fmaxf(fmaxf(fabsf(v[c][q][0]), fabsf(v[c][q][1])), fmaxf(fabsf(v[c][q][2]), fabsf(v[c][q][3])))); }
#pragma unroll
            for (int o = 1; o < 64; o <<= 1) am = fmaxf(am, __shfl_xor(am, o));
            const float sc = am > 0.f ? 384.0f / am : 1.0f, isc = am > 0.f ? am * (1.0f / 384.0f) : 1.0f;
            unsigned char* dst = F.ws + (tab ? WS_V8 : WS_U8) + (size_t)ri * DM;
#pragma unroll
            for (int c = 0; c < 2; ++c) { v4u w;
#pragma unroll
                for (int q = 0; q < 4; ++q) { int pk = 0; pk = __builtin_amdgcn_cvt_pk_fp8_f32(v[c][q][0] * sc, v[c][q][1] * sc, pk, false); pk = __builtin_amdgcn_cvt_pk_fp8_f32(v[c][q][2] * sc, v[c][q][3] * sc, pk, true); w[q] = (unsigned)pk; }
                *(v4u*)(dst + (c * 64 + F.lane) * 16) = w; }
            if (F.lane == 0) ((float*)(F.ws + (tab ? WS_VSC : WS_USC)))[ri] = isc;
        }
    }
    {
        const float* pw = A.in[I_POOLW]; v4u* dst = (v4u*)(F.ws + WS_WPOOL);
        for (size_t i = F.gtid; i < (size_t)NLAYER * 512 * 64; i += F.NT) {
            const int k8 = (int)(i & 63), n = (int)((i >> 6) & 511), l = (int)(i >> 15);
            const int g = n >> 7, d = n & 127, kg = k8 >> 4, c0 = (k8 & 15) * 8;
            float f[8];
#pragma unroll
            for (int k = 0; k < 8; ++k) f[k] = (kg == g) ? pw[(((size_t)l * 4 + g) * 128 + (c0 + k)) * 128 + d] : 0.f;
            dst[i] = pack8(f);
        }
    }
    {
        const float* lre = A.in[I_LAMRE]; const float* lim = A.in[I_LAMIM]; const float* lst = A.in[I_LOGSTEP]; const float* bre = A.in[I_BRE]; const float* bim = A.in[I_BIM];
        f32x2v* ab = (f32x2v*)(F.ws + WS_S5A); f32x2v* ab64 = (f32x2v*)(F.ws + WS_S5A + 512 * 1024); f32x2v* bb = (f32x2v*)(F.ws + WS_S5B);
        for (size_t i = F.gtid; i < (size_t)NLAYER * 2 * 32 * 64; i += F.NT) {
            const float lr = lre[i], li = lim[i], dt = expf(lst[i >> 6]);
            const float mag = expf(lr * dt), ar = mag * cosf(li * dt), ai = mag * sinf(li * dt);
            const float den = lr * lr + li * li;
            const float zr = ((ar - 1.0f) * lr + ai * li) / den, zi = (ai * lr - (ar - 1.0f) * li) / den;
            ab[i] = (f32x2v){ar, ai};
            const float m64 = expf(lr * dt * 64.0f), an = li * dt * 64.0f;
            ab64[i] = (f32x2v){m64 * cosf(an), m64 * sinf(an)};
#pragma unroll
            for (int c = 0; c < 16; ++c) { const float br = bre[i * 16 + c], bi = bim[i * 16 + c]; bb[i * 16 + c] = (f32x2v){zr * br - zi * bi, zr * bi + zi * br}; }
        }
    }
    if (F.bx == 0 && F.tid < 128) {
        ((float*)(F.ws + WS_ROT))[F.tid] = (float)exp(-(double)F.tid / 127.0 * 9.210340371976184);
    }
    __syncthreads();
    {
        LAS float* KS = (LAS float*)F.lds;
        LAS float* WQ = (LAS float*)(F.lds + 128 * 132 * 4);
        const float* keys = A.in[I_KEYS]; const float* wq = A.in[I_WQ]; bf16* wst = (bf16*)(F.ws + WS_WS);
        for (int u = F.bx; u < NLAYER * 16 * 32; u += F.G) {
            const int dtl = u & 31, hp = (u >> 5) & 15, l = u >> 9, p = hp & 1;
#pragma unroll
            for (int r = 0; r < 8; ++r) { const int f = F.tid + 512 * r, nk = f >> 5, c4 = f & 31;
                *(LAS f32x4*)(KS + nk * 132 + c4 * 4) = *(const f32x4*)(keys + (((size_t)l * 2 + p) * 128 + nk) * 128 + c4 * 4); }
#pragma unroll
            for (int r = 0; r < 4; ++r) { const int f = F.tid + 512 * r, dd = f >> 5, c4 = f & 31;
                *(LAS f32x4*)(WQ + dd * 132 + c4 * 4) = *(const f32x4*)(wq + ((size_t)l * DM + dtl * 64 + dd) * DM + hp * 128 + c4 * 4); }
            __syncthreads();
            const int nk = F.tid & 127, dg = F.tid >> 7;
            float acc[16];
#pragma unroll
            for (int i = 0; i < 16; ++i) acc[i] = 0.f;
            for (int c4 = 0; c4 < 32; ++c4) {
                const f32x4 kv = *(const LAS f32x4*)(KS + nk * 132 + c4 * 4);
#pragma unroll
                for (int i = 0; i < 16; ++i) { const f32x4 wv = *(const LAS f32x4*)(WQ + (dg * 16 + i) * 132 + c4 * 4);
                    acc[i] += (kv[0] * wv[0] + kv[1] * wv[1]) + (kv[2] * wv[2] + kv[3] * wv[3]); }
            }
            bf16* o = wst + ((size_t)l * DM + hp * 128 + nk) * DM + dtl * 64 + dg * 16;
            v4u q0, q1; q0.x = pkbf(acc[0], acc[1]); q0.y = pkbf(acc[2], acc[3]); q0.z = pkbf(acc[4], acc[5]); q0.w = pkbf(acc[6], acc[7]);
            q1.x = pkbf(acc[8], acc[9]); q1.y = pkbf(acc[10], acc[11]); q1.z = pkbf(acc[12], acc[13]); q1.w = pkbf(acc[14], acc[15]);
            *(v4u*)o = q0; *(v4u*)(o + 8) = q1;
            __syncthreads();
        }
    }
    for (int t = F.gw; t < NTOK; t += F.NGW) {
        const float* src = t < 32768 ? A.in[I_XP] + (size_t)t * DM : A.in[I_XS] + (size_t)(t - 32768) * DM;
        ln_row(src, A.in[I_LNIN_G], A.in[I_LNIN_B], F.out + (size_t)t * DM, (bf16*)(F.ws + WS_XN) + (size_t)t * DM, F.lane);
    }
}

__device__ __forceinline__ float ret_log2_gamma(int h) { return log2f(1.0f - exp2f(-5.0f - (float)h)); }

__device__ __forceinline__ void s5_pass1(const Frame& F, CArgs& A, int l) {
    LAS float* Uw = (LAS float*)(F.lds + F.wave * 4096);
    const bf16* H = (const bf16*)(F.ws + WS_H);
    const f32x2v* ab = (const f32x2v*)(F.ws + WS_S5A); const f32x4* bb = (const f32x4*)(F.ws + WS_S5B);
    f32x2v* st = (f32x2v*)(F.ws + WS_S5ST);
    for (int task = F.gw; task < 640 * 32 * 2; task += F.NGW) {
        const int dir = task & 1, g = (task >> 1) & 31, ck = task >> 6;
        const int pidx = ((l * 2 + dir) * 32 + g) * 64 + F.lane;
        const f32x2v a = ab[pidx];
        float Br[16], Bi[16];
#pragma unroll
        for (int c2 = 0; c2 < 8; ++c2) { const f32x4 q = bb[(size_t)pidx * 8 + c2]; Br[2 * c2] = q[0]; Bi[2 * c2] = q[1]; Br[2 * c2 + 1] = q[2]; Bi[2 * c2 + 1] = q[3]; }
        {
            const bf16* urow = H + (size_t)(ck * 64 + F.lane) * INW + COL_UA + g * 16;
            const v4u q0 = *(const v4u*)urow, q1 = *(const v4u*)(urow + 8); float f0[8], f1[8]; unpack8(q0, f0); unpack8(q1, f1);
            LAS f32x4* d = (LAS f32x4*)(Uw + F.lane * 16);
            d[0] = (f32x4){f0[0], f0[1], f0[2], f0[3]}; d[1] = (f32x4){f0[4], f0[5], f0[6], f0[7]}; d[2] = (f32x4){f1[0], f1[1], f1[2], f1[3]}; d[3] = (f32x4){f1[4], f1[5], f1[6], f1[7]};
        }
        LDS_WAIT();
        float xr = 0.f, xi = 0.f;
        for (int s = 0; s < 64; ++s) {
            const int t = dir ? 63 - s : s;
            const LAS f32x4* up = (const LAS f32x4*)(Uw + t * 16);
            float bur = 0.f, bui = 0.f;
#pragma unroll
            for (int c4 = 0; c4 < 4; ++c4) { const f32x4 uv = up[c4];
#pragma unroll
                for (int k = 0; k < 4; ++k) { bur += Br[4 * c4 + k] * uv[k]; bui += Bi[4 * c4 + k] * uv[k]; } }
            const float nxr = a[0] * xr - a[1] * xi + bur, nxi = a[0] * xi + a[1] * xr + bui; xr = nxr; xi = nxi;
        }
        st[(size_t)((ck * 32 + g) * 2 + dir) * 64 + F.lane] = (f32x2v){xr, xi};
        LDS_WAIT();
    }
}
__device__ __forceinline__ void s5_carry(const Frame& F, CArgs& A, int l) {
    const f32x2v* ab64 = (const f32x2v*)(F.ws + WS_S5A + 512 * 1024); f32x2v* st = (f32x2v*)(F.ws + WS_S5ST);
    for (size_t it = F.gtid; it < (size_t)9 * 32 * 2 * 64; it += F.NT) {
        const int p = (int)(it & 63), dir = (int)((it >> 6) & 1), g = (int)((it >> 7) & 31), s = (int)(it >> 12);
        const int ck0 = s < 8 ? s * 64 : 512, n = s < 8 ? 64 : 128;
        const f32x2v a = ab64[((l * 2 + dir) * 32 + g) * 64 + p];
        float cr = 0.f, ci = 0.f;
        for (int k = 0; k < n; ++k) {
            const int ck = dir ? (ck0 + n - 1 - k) : (ck0 + k);
            f32x2v* q = st + (size_t)((ck * 32 + g) * 2 + dir) * 64 + p;
            const f32x2v le = *q; *q = (f32x2v){cr, ci};
            const float ncr = a[0] * cr - a[1] * ci + le[0], nci = a[0] * ci + a[1] * cr + le[1]; cr = ncr; ci = nci;
        }
    }
}
__device__ __forceinline__ void s5_pass3(const Frame& F, CArgs& A, int l) {
    LAS unsigned char* wb = F.lds + F.wave * 17152;
    LAS float* Uw = (LAS float*)wb;
    LAS bf16* Xw = (LAS bf16*)(wb + 4096);
    LAS bf16* Ctw = (LAS bf16*)(wb + 4096 + 8704);
    const bf16* H = (const bf16*)(F.ws + WS_H); bf16* BY = (bf16*)(F.ws + WS_BUFY);
    const f32x2v* ab = (const f32x2v*)(F.ws + WS_S5A); const f32x4* bb = (const f32x4*)(F.ws + WS_S5B);
    const f32x2v* st = (const f32x2v*)(F.ws + WS_S5ST);
    const float* cre = A.in[I_CRE]; const float* cim = A.in[I_CIM]; const float* dvec = A.in[I_S5D] + (size_t)l * 512;
    const int lane = F.lane, lr = lane & 15, lq = lane >> 4;
    for (int task = F.gw; task < 640 * 32; task += F.NGW) {
        const int g = task & 31, ck = task >> 5;
        {
            const bf16* urow = H + (size_t)(ck * 64 + lane) * INW + COL_UA + g * 16;
            const v4u q0 = *(const v4u*)urow, q1 = *(const v4u*)(urow + 8); float f0[8], f1[8]; unpack8(q0, f0); unpack8(q1, f1);
            LAS f32x4* d = (LAS f32x4*)(Uw + lane * 16);
            d[0] = (f32x4){f0[0], f0[1], f0[2], f0[3]}; d[1] = (f32x4){f0[4], f0[5], f0[6], f0[7]}; d[2] = (f32x4){f1[0], f1[1], f1[2], f1[3]}; d[3] = (f32x4){f1[4], f1[5], f1[6], f1[7]};
        }
        f32x4 Y[4];
#pragma unroll
        for (int m = 0; m < 4; ++m) Y[m] = (f32x4){0.f, 0.f, 0.f, 0.f};
#pragma unroll
        for (int dir = 0; dir < 2; ++dir) {
            const int pidx = ((l * 2 + dir) * 32 + g) * 64 + lane;
            const f32x2v a = ab[pidx];
            float Br[16], Bi[16];
#pragma unroll
            for (int c2 = 0; c2 < 8; ++c2) { const f32x4 q = bb[(size_t)pidx * 8 + c2]; Br[2 * c2] = q[0]; Bi[2 * c2] = q[1]; Br[2 * c2 + 1] = q[2]; Bi[2 * c2 + 1] = q[3]; }
            {
                const size_t cb = (size_t)((l * 2 + dir) * 32 + g) * 16 * 64;
#pragma unroll
                for (int c = 0; c < 16; ++c) { Ctw[c * 136 + lane] = f2bf(cre[cb + c * 64 + lane]); Ctw[c * 136 + 64 + lane] = f2bf(-cim[cb + c * 64 + lane]); }
            }
            const f32x2v x0 = st[(size_t)((ck * 32 + g) * 2 + dir) * 64 + lane];
            float xr = x0[0], xi = x0[1];
            LDS_WAIT();
#pragma unroll
            for (int half = 0; half < 2; ++half) {
                for (int s = 0; s < 32; ++s) {
                    const int step = half * 32 + s, t = dir ? 63 - step : step;
                    const LAS f32x4* up = (const LAS f32x4*)(Uw + t * 16);
                    float bur = 0.f, bui = 0.f;
#pragma unroll
                    for (int c4 = 0; c4 < 4; ++c4) { const f32x4 uv = up[c4];
#pragma unroll
                        for (int k = 0; k < 4; ++k) { bur += Br[4 * c4 + k] * uv[k]; bui += Bi[4 * c4 + k] * uv[k]; } }
                    const float nxr = a[0] * xr - a[1] * xi + bur, nxi = a[0] * xi + a[1] * xr + bui; xr = nxr; xi = nxi;
                    Xw[(t & 31) * 136 + lane] = f2bf(xr); Xw[(t & 31) * 136 + 64 + lane] = f2bf(xi);
                }
                LDS_WAIT();
                const int tb = dir ? (1 - half) : half;
#pragma unroll
                for (int m = 0; m < 2; ++m)
#pragma unroll
                    for (int ks = 0; ks < 4; ++ks) {
                        const bf16x8 av = *(const LAS bf16x8*)(Ctw + lr * 136 + 32 * ks + lq * 8);
                        const bf16x8 bv = *(const LAS bf16x8*)(Xw + (16 * m + lr) * 136 + 32 * ks + lq * 8);
                        Y[2 * tb + m] = MFMA16(av, bv, Y[2 * tb + m]);
                    }
                LDS_WAIT();
            }
        }
#pragma unroll
        for (int m = 0; m < 4; ++m) {
            const int t = 16 * m + lr, c0 = 4 * lq;
            const f32x4 uv = *(const LAS f32x4*)(Uw + t * 16 + c0); const f32x4 dv = *(const f32x4*)(dvec + g * 16 + c0);
            const f32x4 y = Y[m] + dv * uv;
            v2u w; w.x = pkbf(gelu_erf(y[0]), gelu_erf(y[1])); w.y = pkbf(gelu_erf(y[2]), gelu_erf(y[3]));
            *(v2u*)(BY + (size_t)(ck * 64 + t) * 512 + g * 16 + c0) = w;
        }
        LDS_WAIT();
    }
}
__device__ __forceinline__ void pool_phase(const Frame& F, CArgs& A) {
    const bf16* H = (const bf16*)(F.ws + WS_H); bf16* BP = (bf16*)(F.ws + WS_BUFP);
    for (size_t it = F.gtid; it < (size_t)NTOK * 64; it += F.NT) {
        const int t = (int)(it >> 6), o = (int)(it & 63), gi = o >> 4, w = 2 << gi;
        const int pos = tok_pos(t), L = tok_len(t);
        const int lo = max(pos - w / 2, 0), hi = min(pos + w / 2 - 1, L - 1);
        const bf16* base = H + (size_t)(t - pos) * INW + COL_UB + o * 8;
        float s[8];
#pragma unroll
        for (int k = 0; k < 8; ++k) s[k] = 0.f;
        for (int si = lo; si <= hi; ++si) { float f[8]; unpack8(*(const v4u*)(base + (size_t)si * INW), f);
#pragma unroll
            for (int k = 0; k < 8; ++k) s[k] += f[k]; }
        const float inv = 1.0f / (float)(hi - lo + 1);
        float c[8]; unpack8(*(const v4u*)(base + (size_t)pos * INW), c);
#pragma unroll
        for (int k = 0; k < 8; ++k) s[k] = s[k] * inv - c[k];
        *(v4u*)(BP + (size_t)t * 512 + o * 8) = pack8(s);
    }
}
__device__ __forceinline__ void rotary_phase(const Frame& F, CArgs& A) {
    bf16* H = (bf16*)(F.ws + WS_H); const float* rot = (const float*)(F.ws + WS_ROT);
    for (size_t it = F.gtid; it < (size_t)NTOK * 16; it += F.NT) {
        const int t = (int)(it >> 4), o = (int)(it & 15); const float pos = (float)tok_pos(t);
        float cs[8], sn[8];
#pragma unroll
        for (int k = 0; k < 8; ++k) { const float ang = pos * rot[o * 8 + k]; cs[k] = cosf(ang); sn[k] = sinf(ang); }
#pragma unroll
        for (int which = 0; which < 2; ++which) {
            const float sc = which ? 0.0625f : 1.0f;
#pragma unroll
            for (int hd = 0; hd < 4; ++hd) {
                bf16* p1 = H + (size_t)t * INW + (which ? COL_K : COL_Q) + hd * 256 + o * 8; bf16* p2 = p1 + 128;
                float x1[8], x2[8], o1[8], o2[8]; unpack8(*(const v4u*)p1, x1); unpack8(*(const v4u*)p2, x2);
#pragma unroll
                for (int k = 0; k < 8; ++k) { o1[k] = (x1[k] * cs[k] - x2[k] * sn[k]) * sc; o2[k] = (x2[k] * cs[k] + x1[k] * sn[k]) * sc; }
                *(v4u*)p1 = pack8(o1); *(v4u*)p2 = pack8(o2);
            }
        }
    }
}
constexpr int RS = 136;
__device__ __forceinline__ void ret_state_phase(const Frame& F, CArgs& A) {
    const bf16* H = (const bf16*)(F.ws + WS_H); bf16* STF = (bf16*)(F.ws + WS_STF); bf16* STB = (bf16*)(F.ws + WS_STB);
    LAS bf16* Kt = (LAS bf16*)F.lds; LAS bf16* VtF = Kt + 128 * RS; LAS bf16* VtB = Kt + 256 * RS;
    const int tid = F.tid, lane = F.lane, lr = lane & 15, lq = lane >> 4, we = F.wave >> 1, wd = F.wave & 1;
    for (int u = F.bx; u < 5120; u += F.G) {
        const int dh = u & 1, eh = (u >> 1) & 1, h = (u >> 2) & 3, c = u >> 4;
        {
            const int tq = opaque(tid), jp = tq & 63, j = 2 * jp, pc0 = tq >> 6;
            const bf16* krow = H + (size_t)(c * 128 + j) * INW + COL_K + h * 256 + dh * 128;
            const bf16* vrow = H + (size_t)(c * 128 + j) * INW + COL_V + h * 256 + eh * 128;
            const float lg = ret_log2_gamma(h), fF0 = exp2f(lg * (float)(127 - j)), fF1 = exp2f(lg * (float)(126 - j)), fB0 = exp2f(lg * (float)j), fB1 = exp2f(lg * (float)(j + 1));
            LAS unsigned* Kt32 = (LAS unsigned*)Kt; LAS unsigned* VtF32 = (LAS unsigned*)VtF; LAS unsigned* VtB32 = (LAS unsigned*)VtB;
#pragma unroll
            for (int r = 0; r < 2; ++r) {
                const int pc = pc0 + 8 * r;
                const v4u k0 = *(const v4u*)(krow + pc * 8), k1 = *(const v4u*)(krow + INW + pc * 8);
                const v4u v0 = *(const v4u*)(vrow + pc * 8), v1 = *(const v4u*)(vrow + INW + pc * 8);
                const unsigned ka0[4] = {k0.x, k0.y, k0.z, k0.w}, ka1[4] = {k1.x, k1.y, k1.z, k1.w};
                float f0[8], f1[8]; unpack8(v0, f0); unpack8(v1, f1);
#pragma unroll
                for (int i = 0; i < 8; ++i) {
                    const unsigned a = ka0[i >> 1], b = ka1[i >> 1];
                    const unsigned kk = (i & 1) ? ((a >> 16) | (b & 0xffff0000u)) : ((a & 0xffffu) | (b << 16));
                    const int o = ((pc * 8 + i) * RS) / 2 + jp;
                    Kt32[o] = kk; VtF32[o] = pkbf(f0[i] * fF0, f1[i] * fF1); VtB32[o] = pkbf(f0[i] * fB0, f1[i] * fB1);
                }
            }
        }
        __syncthreads();
        f32x4 aF[4][2], aB[4][2];
#pragma unroll
        for (int td = 0; td < 4; ++td)
#pragma unroll
            for (int te = 0; te < 2; ++te) { aF[td][te] = (f32x4){0.f, 0.f, 0.f, 0.f}; aB[td][te] = (f32x4){0.f, 0.f, 0.f, 0.f}; }
#pragma unroll
        for (int ks = 0; ks < 4; ++ks) {
            bf16x8 ka[4], vF[2], vB[2];
#pragma unroll
            for (int td = 0; td < 4; ++td) ka[td] = *(const LAS bf16x8*)(Kt + (64 * wd + 16 * td + lr) * RS + 32 * ks + lq * 8);
#pragma unroll
            for (int te = 0; te < 2; ++te) { vF[te] = *(const LAS bf16x8*)(VtF + (32 * we + 16 * te + lr) * RS + 32 * ks + lq * 8); vB[te] = *(const LAS bf16x8*)(VtB + (32 * we + 16 * te + lr) * RS + 32 * ks + lq * 8); }
#pragma unroll
            for (int td = 0; td < 4; ++td)
#pragma unroll
                for (int te = 0; te < 2; ++te) { aF[td][te] = MFMA16(ka[td], vF[te], aF[td][te]); aB[td][te] = MFMA16(ka[td], vB[te], aB[td][te]); }
        }
#pragma unroll
        for (int td = 0; td < 4; ++td)
#pragma unroll
            for (int te = 0; te < 2; ++te) {
                const int e = eh * 128 + 32 * we + 16 * te + lr, d = dh * 128 + 64 * wd + 16 * td + 4 * lq;
                const size_t off = ((size_t)(c * 4 + h) * 256 + e) * 256 + d;
                v2u w; w.x = pkbf(aF[td][te][0], aF[td][te][1]); w.y = pkbf(aF[td][te][2], aF[td][te][3]); *(v2u*)(STF + off) = w;
                v2u x; x.x = pkbf(aB[td][te][0], aB[td][te][1]); x.y = pkbf(aB[td][te][2], aB[td][te][3]); *(v2u*)(STB + off) = x;
            }
        __syncthreads();
    }
}
__device__ __forceinline__ void ret_prefix_phase(const Frame& F, CArgs& A) {
    bf16* STF = (bf16*)(F.ws + WS_STF); bf16* STB = (bf16*)(F.ws + WS_STB);
    for (size_t it = F.gtid; it < (size_t)36 * 2 * 8192; it += F.NT) {
        const int o = (int)(it & 8191), which = (int)((it >> 13) & 1), bh = (int)(it >> 14), h = bh & 3, s = bh >> 2;
        const int c0 = s < 8 ? s * 32 : 256, n = s < 8 ? 32 : 64;
        const float dec = exp2f(128.0f * ret_log2_gamma(h));
        float st[8];
#pragma unroll
        for (int k = 0; k < 8; ++k) st[k] = 0.f;
        bf16* base = (which ? STB : STF) + (size_t)h * 65536 + (size_t)o * 8;
        for (int k = 0; k < n; ++k) {
            const int c = which ? (c0 + n - 1 - k) : (c0 + k);
            v4u* p = (v4u*)(base + (size_t)c * 4 * 65536);
            float f[8]; unpack8(*p, f);
#pragma unroll
            for (int i = 0; i < 8; ++i) st[i] = dec * st[i] + f[i];
            *p = pack8(st);
        }
    }
}
__device__ __forceinline__ void ret_out_phase(const Frame& F, CArgs& A) {
    const bf16* H = (const bf16*)(F.ws + WS_H); const bf16* STF = (const bf16*)(F.ws + WS_STF); const bf16* STB = (const bf16*)(F.ws + WS_STB);
    bf16* CC = (bf16*)(F.ws + WS_CONCAT);
    LAS bf16* RA = (LAS bf16*)F.lds; LAS bf16* RB = RA + 128 * RS; LAS bf16* RC = RA + 384 * RS;
    const int tid = F.tid, lane = F.lane, lr = lane & 15, lq = lane >> 4, wi = F.wave >> 2, wj = F.wave & 3, we = F.wave & 3;
    for (int u = F.bx; u < 1280; u += F.G) {
        const int h = u & 3, c = u >> 2, t0 = c * 128;
        const int cs = c < 256 ? (c & 31) : (c - 256), ncs = c < 256 ? 32 : 64;
        const bool has_f = cs > 0, has_b = cs < ncs - 1;
        const float lg = ret_log2_gamma(h);
        f32x4 S[4][2];
#pragma unroll
        for (int ti = 0; ti < 4; ++ti)
#pragma unroll
            for (int tj = 0; tj < 2; ++tj) S[ti][tj] = (f32x4){0.f, 0.f, 0.f, 0.f};
#pragma unroll
        for (int dh = 0; dh < 2; ++dh) {
            if (dh) __syncthreads();
#pragma unroll 1
            for (int r = 0; r < 4; ++r) { const int f = opaque(tid) + 512 * r, row = f >> 4, pc = f & 15;
                const bf16* src = H + (size_t)(t0 + row) * INW + h * 256 + dh * 128 + pc * 8;
                *(LAS v4u*)(RA + row * RS + pc * 8) = *(const v4u*)(src + COL_Q);
                *(LAS v4u*)(RB + row * RS + pc * 8) = *(const v4u*)(src + COL_K); }
            __syncthreads();
#pragma unroll
            for (int ks = 0; ks < 4; ++ks) {
                bf16x8 ka[2], qb[4];
#pragma unroll
                for (int tj = 0; tj < 2; ++tj) ka[tj] = *(const LAS bf16x8*)(RB + (32 * wj + 16 * tj + lr) * RS + 32 * ks + lq * 8);
#pragma unroll
                for (int ti = 0; ti < 4; ++ti) qb[ti] = *(const LAS bf16x8*)(RA + (64 * wi + 16 * ti + lr) * RS + 32 * ks + lq * 8);
#pragma unroll
                for (int ti = 0; ti < 4; ++ti)
#pragma unroll
                    for (int tj = 0; tj < 2; ++tj) S[ti][tj] = MFMA16(ka[tj], qb[ti], S[ti][tj]);
            }
        }
#pragma unroll
        for (int ti = 0; ti < 4; ++ti)
#pragma unroll
            for (int tj = 0; tj < 2; ++tj) {
                const int i = 64 * wi + 16 * ti + lr, j0 = 32 * wj + 16 * tj + 4 * lq; float p[4];
#pragma unroll
                for (int jj = 0; jj < 4; ++jj) { const int d = i - (j0 + jj); p[jj] = S[ti][tj][jj] * exp2f(lg * (float)(d < 0 ? -d : d)); }
                v2u w; w.x = pkbf(p[0], p[1]); w.y = pkbf(p[2], p[3]); *(LAS v2u*)(RC + i * RS + j0) = w;
            }
        __syncthreads();
        {
            const int tq = opaque(tid), jp = tq & 63, pc0 = tq >> 6; const bf16* vrow = H + (size_t)(t0 + 2 * jp) * INW + COL_V + h * 256;
            LAS unsigned* RB32 = (LAS unsigned*)RB;
#pragma unroll 1
            for (int r = 0; r < 4; ++r) { const int pc = pc0 + 8 * r; const v4u v0 = *(const v4u*)(vrow + pc * 8), v1 = *(const v4u*)(vrow + INW + pc * 8);
                const unsigned va0[4] = {v0.x, v0.y, v0.z, v0.w}, va1[4] = {v1.x, v1.y, v1.z, v1.w};
#pragma unroll
                for (int i = 0; i < 8; ++i) { const unsigned a = va0[i >> 1], b = va1[i >> 1];
                    RB32[((pc * 8 + i) * RS) / 2 + jp] = (i & 1) ? ((a >> 16) | (b & 0xffff0000u)) : ((a & 0xffffu) | (b << 16)); } }
        }
        __syncthreads();
        f32x4 O[4][4];
#pragma unroll
        for (int ti = 0; ti < 4; ++ti)
#pragma unroll
            for (int te = 0; te < 4; ++te) O[ti][te] = (f32x4){0.f, 0.f, 0.f, 0.f};
#pragma unroll
        for (int ks = 0; ks < 4; ++ks) {
            bf16x8 va[4], pb[4];
#pragma unroll
            for (int te = 0; te < 4; ++te) va[te] = *(const LAS bf16x8*)(RB + (64 * we + 16 * te + lr) * RS + 32 * ks + lq * 8);
#pragma unroll
            for (int ti = 0; ti < 4; ++ti) pb[ti] = *(const LAS bf16x8*)(RC + (64 * wi + 16 * ti + lr) * RS + 32 * ks + lq * 8);
#pragma unroll
            for (int ti = 0; ti < 4; ++ti)
#pragma unroll
                for (int te = 0; te < 4; ++te) O[ti][te] = MFMA16(va[te], pb[ti], O[ti][te]);
        }
#pragma unroll
        for (int dir = 0; dir < 2; ++dir) {
            if (dir == 0 ? has_f : has_b) {
                const bf16* St = (dir == 0 ? STF + (size_t)((c - 1) * 4 + h) * 65536 : STB + (size_t)((c + 1) * 4 + h) * 65536);
#pragma unroll
                for (int dh = 0; dh < 2; ++dh) {
                    __syncthreads();
#pragma unroll 1
                    for (int r = 0; r < 4; ++r) { const int f = opaque(tid) + 512 * r, row = f >> 4, pc = f & 15;
                        const float fac = exp2f(lg * (dir == 0 ? (float)(row + 1) : (float)(128 - row)));
                        float qf[8]; unpack8(*(const v4u*)(H + (size_t)(t0 + row) * INW + COL_Q + h * 256 + dh * 128 + pc * 8), qf);
#pragma unroll
                        for (int k = 0; k < 8; ++k) qf[k] *= fac;
                        *(LAS v4u*)(RA + row * RS + pc * 8) = pack8(qf); }
#pragma unroll 2
                    for (int r = 0; r < 8; ++r) { const int f = opaque(tid) + 512 * r, row = f >> 4, pc = f & 15;
                        *(LAS v4u*)(RB + row * RS + pc * 8) = *(const v4u*)(St + (size_t)row * 256 + dh * 128 + pc * 8); }
                    __syncthreads();
#pragma unroll
                    for (int ks = 0; ks < 4; ++ks) {
                        bf16x8 sa[4], qb[4];
#pragma unroll
                        for (int te = 0; te < 4; ++te) sa[te] = *(const LAS bf16x8*)(RB + (64 * we + 16 * te + lr) * RS + 32 * ks + lq * 8);
#pragma unroll
                        for (int ti = 0; ti < 4; ++ti) qb[ti] = *(const LAS bf16x8*)(RA + (64 * wi + 16 * ti + lr) * RS + 32 * ks + lq * 8);
#pragma unroll
                        for (int ti = 0; ti < 4; ++ti)
#pragma unroll
                            for (int te = 0; te < 4; ++te) O[ti][te] = MFMA16(sa[te], qb[ti], O[ti][te]);
                    }
                }
            }
        }
        __syncthreads();
        LAS float* RED = (LAS float*)RA;
#pragma unroll
        for (int ti = 0; ti < 4; ++ti) { float s1 = 0.f, s2 = 0.f;
#pragma unroll
            for (int te = 0; te < 4; ++te)
#pragma unroll
                for (int jj = 0; jj < 4; ++jj) { const float v = O[ti][te][jj]; s1 += v; s2 += v * v; }
            s1 += __shfl_xor(s1, 16); s1 += __shfl_xor(s1, 32); s2 += __shfl_xor(s2, 16); s2 += __shfl_xor(s2, 32);
            if (lq == 0) { RED[((64 * wi + 16 * ti + lr) * 4 + we) * 2] = s1; RED[((64 * wi + 16 * ti + lr) * 4 + we) * 2 + 1] = s2; } }
        __syncthreads();
#pragma unroll
        for (int ti = 0; ti < 4; ++ti) { const int i = 64 * wi + 16 * ti + lr;
            const f32x4 r0 = *(const LAS f32x4*)(RED + i * 8), r1 = *(const LAS f32x4*)(RED + i * 8 + 4);
            const float m = (r0[0] + r0[2] + r1[0] + r1[2]) * (1.0f / 256.0f), q = (r0[1] + r0[3] + r1[1] + r1[3]) * (1.0f / 256.0f);
            const float var = fmaxf(q - m * m, 0.f), rstd = 1.0f / sqrtf(var + GN_EPS);
#pragma unroll
            for (int te = 0; te < 4; ++te) { const int e0 = 64 * we + 16 * te + 4 * lq;
                const v2u gq = *(const v2u*)(H + (size_t)(t0 + i) * INW + COL_G + h * 256 + e0);
                const float gv[4] = {bf_lo(gq.x), bf_hi(gq.x), bf_lo(gq.y), bf_hi(gq.y)}; float ov[4];
#pragma unroll
                for (int jj = 0; jj < 4; ++jj) { const float gg = gv[jj]; ov[jj] = (gg / (1.0f + __expf(-gg))) * ((O[ti][te][jj] - m) * rstd); }
                v2u w; w.x = pkbf(ov[0], ov[1]); w.y = pkbf(ov[2], ov[3]);
                *(v2u*)(CC + (size_t)(t0 + i) * DM + 1024 + h * 256 + e0) = w; } }
        __syncthreads();
    }
}

__device__ __forceinline__ void topk_insert(float (&tv)[16], int (&ti)[16], float v, int n) {
    if (v > tv[15]) {
        tv[15] = v; ti[15] = n;
#pragma unroll
        for (int k = 15; k >= 1; --k) {
            const bool sw = tv[k] > tv[k - 1];
            const float a = tv[k - 1], b = tv[k]; const int ia = ti[k - 1], ib = ti[k];
            tv[k - 1] = sw ? b : a; tv[k] = sw ? a : b; ti[k - 1] = sw ? ib : ia; ti[k] = sw ? ia : ib;
        }
    }
}
__device__ __forceinline__ void topk_phase(const Frame& F, CArgs& A) {
    const float* SC = (const float*)(F.ws + WS_H); int* IDX = (int*)(F.ws + WS_IDX); float* GATE = (float*)(F.ws + WS_GATE);
    LAS float* LV = (LAS float*)F.lds;
    LAS int* LI = (LAS int*)(F.lds + 512 * 17 * 4);
    const int tid = F.tid, tl = tid >> 4, hp = tid & 15;
    for (int blk = F.bx; blk < NTOK / 32; blk += F.G) {
        const int t = blk * 32 + tl;
        const float* row = SC + (size_t)t * DM + hp * 128;
        float tv[16]; int ti[16];
#pragma unroll
        for (int k = 0; k < 16; ++k) { tv[k] = -INFINITY; ti[k] = 0; }
        for (int n4 = 0; n4 < 32; ++n4) {
            const f32x4 v = *(const f32x4*)(row + n4 * 4);
            topk_insert(tv, ti, v[0], n4 * 4); topk_insert(tv, ti, v[1], n4 * 4 + 1); topk_insert(tv, ti, v[2], n4 * 4 + 2); topk_insert(tv, ti, v[3], n4 * 4 + 3);
        }
#pragma unroll
        for (int k = 0; k < 16; ++k) { LV[tid * 17 + k] = tv[k]; LI[tid * 17 + k] = ti[k]; }
        __syncthreads();
        if ((hp & 1) == 0) {
            float a[16], b[16];
#pragma unroll
            for (int k = 0; k < 16; ++k) { a[k] = LV[tid * 17 + k]; b[k] = LV[(tid + 1) * 17 + k]; }
            float sv[16]; int si[16];
#pragma unroll
            for (int k = 0; k < 16; ++k) { sv[k] = -INFINITY; si[k] = 0; }
#pragma unroll
            for (int i = 0; i < 16; ++i)
#pragma unroll
                for (int j = 0; j < 16; ++j) if ((i + 1) * (j + 1) <= 16) topk_insert(sv, si, a[i] + b[j], i * 16 + j);
            float e[16], sum = 0.f;
#pragma unroll
            for (int k = 0; k < 16; ++k) { e[k] = __expf(sv[k] - sv[0]); sum += e[k]; }
            const float inv = 1.0f / sum; const int head = hp >> 1;
#pragma unroll
            for (int k = 0; k < 16; ++k) {
                const int cell = si[k];
                IDX[(size_t)t * 128 + head * 16 + k] = LI[tid * 17 + (cell >> 4)] * 128 + LI[(tid + 1) * 17 + (cell & 15)];
                GATE[(size_t)t * 128 + head * 16 + k] = e[k] * inv;
            }
        }
        __syncthreads();
    }
}
__device__ __forceinline__ void peer_gather_phase(const Frame& F, CArgs& A, int l) {
    const unsigned char* U8 = F.ws + WS_U8 + (size_t)l * NEXP * DM; const unsigned char* V8 = F.ws + WS_V8 + (size_t)l * NEXP * DM;
    const float* USC = (const float*)(F.ws + WS_USC) + (size_t)l * NEXP; const float* VSC = (const float*)(F.ws + WS_VSC) + (size_t)l * NEXP;
    const int* IDX = (const int*)(F.ws + WS_IDX); const float* GATE = (const float*)(F.ws + WS_GATE);
    const float* g2 = A.in[I_LN2G] + (size_t)l * DM; const float* b2 = A.in[I_LN2B] + (size_t)l * DM;
    bf16* XN = (bf16*)(F.ws + WS_XN);
    const int lane = F.lane, slot = 8 * (lane & 7) + (lane >> 3);
    for (int t = F.gw; t < NTOK; t += F.NGW) {
        float* xrow = F.out + (size_t)t * DM;
        f32x2v x[2][8];
#pragma unroll
        for (int c = 0; c < 2; ++c)
#pragma unroll
            for (int q = 0; q < 4; ++q) { const f32x4 a = *(const f32x4*)(xrow + (c * 64 + lane) * 16 + q * 4); x[c][2 * q] = (f32x2v){a[0], a[1]}; x[c][2 * q + 1] = (f32x2v){a[2], a[3]}; }
        const int idx0 = IDX[(size_t)t * 128 + slot], idx1 = IDX[(size_t)t * 128 + 64 + slot];
        v4u BU[8][2];
        const unsigned loff0 = (unsigned)lane * 16u, loff1 = (unsigned)lane * 16u + 1024u;
#define G_ROW_U(i, b) (U8 + (size_t)(unsigned)__builtin_amdgcn_readlane(((b) >> 3) ? idx1 : idx0, (i) * 8 + ((b) & 7)) * DM)
#define G_ROW_V(i, b) (V8 + (size_t)(unsigned)__builtin_amdgcn_readlane(((b) >> 3) ? idx1 : idx0, ((b) & 7) * 8 + (i)) * DM)
#define G_REQ(i, rowptr) do { const unsigned char* r_ = (rowptr); BU[i][0] = *(const v4u*)(r_ + loff0); BU[i][1] = *(const v4u*)(r_ + loff1); } while (0)
#define G_DOT(i, dst) do { f32x2v s2_ = (f32x2v){0.f, 0.f}; \
            _Pragma("unroll") for (int c = 0; c < 2; ++c) _Pragma("unroll") for (int q = 0; q < 4; ++q) { s2_ += __builtin_amdgcn_cvt_pk_f32_fp8((int)BU[i][c][q], false) * x[c][2 * q]; s2_ += __builtin_amdgcn_cvt_pk_f32_fp8((int)BU[i][c][q], true) * x[c][2 * q + 1]; } \
            dst = s2_[0] + s2_[1]; } while (0)
#define G_REDUCE(b) do { \
            _Pragma("unroll") for (int i = 0; i < 4; ++i) { const float mine = b5 ? part[i + 4] : part[i], send = b5 ? part[i] : part[i + 4]; part[i] = mine + __shfl_xor(send, 32); } \
            _Pragma("unroll") for (int i = 0; i < 2; ++i) { const float mine = b4 ? part[i + 2] : part[i], send = b4 ? part[i] : part[i + 2]; part[i] = mine + __shfl_xor(send, 16); } \
            { const float mine = b3 ? part[1] : part[0], send = b3 ? part[0] : part[1]; part[0] = mine + __shfl_xor(send, 8); } \
            float v_ = part[0]; v_ += __shfl_xor(v_, 4); v_ += __shfl_xor(v_, 2); v_ += __shfl_xor(v_, 1); \
            const bool mine_ = (lane & 7) == ((b) & 7); hval0 = (mine_ && ((b) >> 3) == 0) ? v_ : hval0; hval1 = (mine_ && ((b) >> 3) == 1) ? v_ : hval1; } while (0)
        const bool b5 = (lane & 32) != 0, b4 = (lane & 16) != 0, b3 = (lane & 8) != 0;
        float hval0 = 0.f, hval1 = 0.f;
#pragma unroll
        for (int i = 0; i < 8; ++i) G_REQ(i, G_ROW_U(i, 0));
        for (int b = 0; b < 15; ++b) {
            float part[8];
#pragma unroll
            for (int i = 0; i < 8; ++i) { G_DOT(i, part[i]); G_REQ(i, G_ROW_U(i, b + 1)); }
            G_REDUCE(b);
        }
        {
            float part[8];
#pragma unroll
            for (int i = 0; i < 8; ++i) { G_DOT(i, part[i]); G_REQ(i, G_ROW_V(i, 0)); }
            G_REDUCE(15);
        }
        const float gate0 = GATE[(size_t)t * 128 + slot], gate1 = GATE[(size_t)t * 128 + 64 + slot];
        const float usc0 = USC[idx0], usc1 = USC[idx1], vsc0 = VSC[idx0], vsc1 = VSC[idx1];
        const float w0 = gate0 * gelu_erf(hval0 * usc0) * vsc0, w1 = gate1 * gelu_erf(hval1 * usc1) * vsc1;
        f32x2v acc[2][8];
#pragma unroll
        for (int c = 0; c < 2; ++c)
#pragma unroll
            for (int k = 0; k < 8; ++k) acc[c][k] = (f32x2v){0.f, 0.f};
#define G_AXPY(i, b) do { const float w_ = __uint_as_float((unsigned)__builtin_amdgcn_readlane((int)__float_as_uint(((b) >> 3) ? w1 : w0), ((b) & 7) * 8 + (i))); const f32x2v w2_ = (f32x2v){w_, w_}; \
            _Pragma("unroll") for (int c = 0; c < 2; ++c) _Pragma("unroll") for (int q = 0; q < 4; ++q) { acc[c][2 * q] += w2_ * __builtin_amdgcn_cvt_pk_f32_fp8((int)BU[i][c][q], false); acc[c][2 * q + 1] += w2_ * __builtin_amdgcn_cvt_pk_f32_fp8((int)BU[i][c][q], true); } } while (0)
        for (int b = 0; b < 15; ++b) {
#pragma unroll
            for (int i = 0; i < 8; ++i) { G_AXPY(i, b); G_REQ(i, G_ROW_V(i, b + 1)); }
        }
#pragma unroll
        for (int i = 0; i < 8; ++i) G_AXPY(i, 15);
#undef G_ROW_U
#undef G_ROW_V
#undef G_REQ
#undef G_DOT
#undef G_REDUCE
#undef G_AXPY
        const int le = opaque(lane);
        float s = 0.f;
#pragma unroll
        for (int c = 0; c < 2; ++c)
#pragma unroll
            for (int k = 0; k < 8; ++k) { const f32x2v xr = *(const f32x2v*)(xrow + (c * 64 + le) * 16 + 2 * k);
                acc[c][k] = xr * ALPHA + acc[c][k]; s += acc[c][k][0] + acc[c][k][1]; }
        const float mean = wave_sum(s) * (1.0f / DM); float s2 = 0.f;
#pragma unroll
        for (int c = 0; c < 2; ++c)
#pragma unroll
            for (int k = 0; k < 8; ++k) { acc[c][k] = acc[c][k] - mean; s2 += acc[c][k][0] * acc[c][k][0] + acc[c][k][1] * acc[c][k][1]; }
        const float rstd = 1.0f / sqrtf(wave_sum(s2) * (1.0f / DM) + LN_EPS);
#pragma unroll
        for (int c = 0; c < 2; ++c) { const int col = (c * 64 + le) * 16;
#pragma unroll
            for (int h8 = 0; h8 < 2; ++h8) { float o[8];
#pragma unroll
                for (int q = 0; q < 2; ++q) { const f32x4 gg = *(const f32x4*)(g2 + col + h8 * 8 + q * 4), bb = *(const f32x4*)(b2 + col + h8 * 8 + q * 4);
                    const f32x2v a0 = acc[c][h8 * 4 + 2 * q], a1 = acc[c][h8 * 4 + 2 * q + 1];
                    o[4 * q] = a0[0] * rstd * gg[0] + bb[0]; o[4 * q + 1] = a0[1] * rstd * gg[1] + bb[1]; o[4 * q + 2] = a1[0] * rstd * gg[2] + bb[2]; o[4 * q + 3] = a1[1] * rstd * gg[3] + bb[3];
                    *(f32x4*)(xrow + col + h8 * 8 + q * 4) = (f32x4){o[4 * q], o[4 * q + 1], o[4 * q + 2], o[4 * q + 3]}; }
                *(v4u*)(XN + (size_t)t * DM + col + h8 * 8) = pack8(o); } }
    }
}

#ifndef DUP_MASK
#define DUP_MASK 0
#endif
#ifndef PHASE_TEST_ONLY
__global__ void __launch_bounds__(NTHR, 2) fwd_kernel(Args A) {
    extern __shared__ __attribute__((aligned(16))) unsigned char lds_raw[];
#define MKFRAME() Frame F; CArgs& KA = *(CArgs*)opaque_u64((unsigned long long)__builtin_amdgcn_kernarg_segment_ptr()); { F.lds = (LAS unsigned char*)lds_raw; F.tid = opaque((int)threadIdx.x); F.lane = F.tid & 63; F.wave = __builtin_amdgcn_readfirstlane(F.tid >> 6); \
        const int bx_ = opaque_s((int)blockIdx.x); F.G = gridDim.x; F.gw = bx_ * NWAVES + F.wave; F.NGW = F.G * NWAVES; F.gtid = (size_t)bx_ * NTHR + F.tid; F.NT = (size_t)F.G * NTHR; F.out = (float*)opaque_p(KA.out); F.ws = (unsigned char*)opaque_p(KA.ws); F.bx = bx_; } \
        bf16* XN = (bf16*)(F.ws + WS_XN); bf16* H = (bf16*)(F.ws + WS_H); bf16* CC = (bf16*)(F.ws + WS_CONCAT); (void)XN; (void)H; (void)CC;
    volatile LAS unsigned* MISC = (volatile LAS unsigned*)((LAS unsigned char*)lds_raw + LDS_MISC);
    if (threadIdx.x < 64) MISC[threadIdx.x] = 0u;
    __syncthreads();
    XcdBarrier bar = xcd_barrier_post((unsigned*)(A.ws + WS_CTL) + CW_BAR + A.li * XCD_BAR_WORDS, MISC + 8);
    const int lo = A.ph_lo, hi = A.ph_hi;
#define IN(k) (lo <= (k) && (k) < hi)
#define SEAM(k) do { if (lo <= (k) && (k) + 1 < hi) xcd_barrier(bar); } while (0)

    if (IN(0)) { MKFRAME(); p0_prologue(F, KA); } SEAM(0);

    for (int l = 0; l < NLAYER; ++l) {
        const int pb = 1 + l * 10;
        if (IN(pb + 0)) { MKFRAME();
            pg8::Gemm g{XN, (const bf16*)(F.ws + WS_WIN) + (size_t)l * INW * DM, NTOK, INW, DM}; pg8::StaticOrder S; S.init(NTOK, INW, F.G, F.bx);
            EpiStoreBf16 E{H, INW};
            pg8::gemm_phase<EpiStoreBf16, pg8::StaticOrder, true, true>(F.lds, g, S, E);
            if (DUP_MASK & 64) { pg8::gemm_phase<EpiStoreBf16, pg8::StaticOrder, true, true>(F.lds, g, S, E); }
        } SEAM(pb + 0);
        if (IN(pb + 1)) { MKFRAME(); s5_pass1(F, KA, l); pool_phase(F, KA); if (DUP_MASK & 1) { s5_pass1(F, KA, l); } if (DUP_MASK & 2) { pool_phase(F, KA); } rotary_phase(F, KA); } SEAM(pb + 1);
        if (IN(pb + 2)) { MKFRAME(); s5_carry(F, KA, l); __syncthreads(); ret_state_phase(F, KA); if (DUP_MASK & 4) { ret_state_phase(F, KA); } } SEAM(pb + 2);
        if (IN(pb + 3)) { MKFRAME(); s5_pass3(F, KA, l); if (DUP_MASK & 8) { s5_pass3(F, KA, l); } ret_prefix_phase(F, KA); } SEAM(pb + 3);
        if (IN(pb + 4)) { MKFRAME();
            __syncthreads();
            ret_out_phase(F, KA);
            if (DUP_MASK & 16) { ret_out_phase(F, KA); }
            {
                pg8::Gemm g{(const bf16*)(F.ws + WS_BUFY), (const bf16*)(F.ws + WS_WGLU) + (size_t)l * 512 * 512, NTOK, 512, 512}; pg8::StaticOrder S; S.init(NTOK, 512, F.G, F.bx);
                EpiGlu E{(const bf16*)(F.ws + WS_BUFY), 512, CC, DM, KA.in[I_BGLU] + (size_t)l * 512};
                pg8::gemm_phase<EpiGlu, pg8::StaticOrder, true, true>(F.lds, g, S, E);
            }
            {
                pg8::Gemm g{(const bf16*)(F.ws + WS_BUFP), (const bf16*)(F.ws + WS_WPOOL) + (size_t)l * 512 * 512, NTOK, 512, 512}; pg8::StaticOrder S; S.init(NTOK, 512, F.G, F.bx);
                EpiScaleBf16 E{CC + 512, DM, KA.in[I_POOLS] + (size_t)l * 512};
                pg8::gemm_phase<EpiScaleBf16, pg8::StaticOrder, true, true>(F.lds, g, S, E);
            }
        } SEAM(pb + 4);
        if (IN(pb + 5)) { MKFRAME();
            pg8::Gemm g{CC, (const bf16*)(F.ws + WS_WOUT) + (size_t)l * DM * DM, NTOK, DM, DM}; pg8::StaticOrder S; S.init(NTOK, DM, F.G, F.bx);
            EpiResid E{F.out, DM, ALPHA};
            pg8::gemm_phase<EpiResid, pg8::StaticOrder, true, true>(F.lds, g, S, E);
        } SEAM(pb + 5);
        if (IN(pb + 6)) { MKFRAME();
            for (int t = F.gw; t < NTOK; t += F.NGW) ln_row(F.out + (size_t)t * DM, KA.in[I_LN1G] + (size_t)l * DM, KA.in[I_LN1B] + (size_t)l * DM, F.out + (size_t)t * DM, XN + (size_t)t * DM, F.lane);
        } SEAM(pb + 6);
        if (IN(pb + 7)) { MKFRAME();
            pg8::Gemm g{XN, (const bf16*)(F.ws + WS_WS) + (size_t)l * DM * DM, NTOK, DM, DM}; pg8::StaticOrder S; S.init(NTOK, DM, F.G, F.bx);
            EpiStoreF32 E{(float*)(F.ws + WS_H), DM};
            pg8::gemm_phase<EpiStoreF32, pg8::StaticOrder, true, true>(F.lds, g, S, E);
            if (DUP_MASK & 128) { pg8::gemm_phase<EpiStoreF32, pg8::StaticOrder, true, true>(F.lds, g, S, E); }
        } SEAM(pb + 7);
        if (IN(pb + 8)) { MKFRAME(); __syncthreads(); topk_phase(F, KA); if (DUP_MASK & 32) { topk_phase(F, KA); } } SEAM(pb + 8);
        if (IN(pb + 9)) { MKFRAME(); peer_gather_phase(F, KA, l); } SEAM(pb + 9);
    }
#undef IN
#undef SEAM
}


#ifndef DBG_STOP
#define DBG_STOP NPHASE
#endif
#ifndef DBG_DUMP
#define DBG_DUMP 0
#endif
__global__ void dbg_dump_kernel(float* out, const unsigned char* ws, int mode) {
    const size_t n = (size_t)NTOK * DM;
    for (size_t i = (size_t)blockIdx.x * blockDim.x + threadIdx.x; i < n; i += (size_t)gridDim.x * blockDim.x) {
        float v = 0.f;
        if (mode == 1) v = bf_lo(((const bf16*)(ws + WS_H))[i]);
        else if (mode == 2) v = bf_lo(((const bf16*)(ws + WS_CONCAT))[i]);
        else if (mode == 3) v = bf_lo(((const bf16*)(ws + WS_BUFY))[i % ((size_t)NTOK * 1024)]);
        else if (mode == 4) v = bf_lo(((const bf16*)(ws + WS_STF))[i]);
        else if (mode == 5) v = ((const float*)(ws + WS_H))[i];
        else if (mode == 6) v = (i < (size_t)NTOK * 128) ? (float)((const int*)(ws + WS_IDX))[i] : ((i < (size_t)NTOK * 256) ? ((const float*)(ws + WS_GATE))[i - (size_t)NTOK * 128] : 0.f);
        else if (mode == 7) v = bf_lo(((const bf16*)(ws + WS_XN))[i]);
        else if (mode == 8) v = bf_lo(((const bf16*)(ws + WS_STB))[i]);
        else if (mode == 9) v = bf_lo(((const bf16*)(ws + WS_H))[i + (size_t)NTOK * DM]);
        else if (mode == 10) v = bf_lo(((const bf16*)(ws + WS_WIN))[i % ((size_t)72 * 1024 * 1024)]);
        else if (mode == 11) v = ((const float*)(ws + WS_S5ST))[i % ((size_t)5 * 1024 * 1024)];
        else if (mode == 12) v = bf_lo(((const bf16*)(ws + WS_H))[i]) + bf_lo(((const bf16*)(ws + WS_H))[i + (size_t)NTOK * DM]) + bf_lo(((const bf16*)(ws + WS_BUFP))[i % ((size_t)NTOK * 512)]) + ((const float*)(ws + WS_S5ST))[i % ((size_t)5 * 1024 * 1024)];
        else if (mode == 13) v = bf_lo(((const bf16*)(ws + WS_STF))[i]) + bf_lo(((const bf16*)(ws + WS_STB))[i]) + ((const float*)(ws + WS_S5ST))[i % ((size_t)5 * 1024 * 1024)];
        else if (mode == 14) v = bf_lo(((const bf16*)(ws + WS_STF))[i]) + bf_lo(((const bf16*)(ws + WS_STB))[i]) + bf_lo(((const bf16*)(ws + WS_BUFY))[i % ((size_t)NTOK * 512)]);
        else if (mode == 15) v = bf_lo(((const bf16*)(ws + WS_H))[i]) + bf_lo(((const bf16*)(ws + WS_H))[i + (size_t)NTOK * DM]) + bf_lo(((const bf16*)(ws + WS_H))[i + (size_t)NTOK * 3072]);
        out[i] = v;
    }
}
#ifndef MK_ONE_LAUNCH
#define MK_ONE_LAUNCH 0
#endif
extern "C" void kernel_launch(void* const* d_in, const int* in_sizes, int n_in, void* d_out, int out_size, void* d_ws, size_t ws_size, hipStream_t stream) {
    static int grid = 0;
    if (grid == 0) {
        if (n_in != 26 || out_size != NTOK * DM || ws_size < WS_END) { fprintf(stderr, "kernel_launch: unexpected shapes (n_in %d out %d ws %zu)\n", n_in, out_size, ws_size); grid = -1; return; }
        int dev = 0, cus = 0, per_cu = 0;
        if (hipGetDevice(&dev) != hipSuccess || hipDeviceGetAttribute(&cus, hipDeviceAttributeMultiprocessorCount, dev) != hipSuccess) { grid = -1; return; }
        if (hipFuncSetAttribute((const void*)fwd_kernel, hipFuncAttributeMaxDynamicSharedMemorySize, LDS_BYTES) != hipSuccess) { fprintf(stderr, "kernel_launch: hipFuncSetAttribute failed\n"); grid = -1; return; }
        if (hipOccupancyMaxActiveBlocksPerMultiprocessor(&per_cu, (const void*)fwd_kernel, NTHR, LDS_BYTES) != hipSuccess || per_cu < 1) { fprintf(stderr, "kernel_launch: occupancy query says %d\n", per_cu); grid = -1; (void)hipGetLastError(); return; }
        (void)hipGetLastError();
        grid = cus;
    }
    if (grid < 0) return;
    if (hipMemsetAsync((char*)d_ws + WS_CTL, 0, CTL_ZERO_BYTES, stream) != hipSuccess) return;
    Args a{};
    for (int i = 0; i < 26; ++i) a.in[i] = (const float*)d_in[i];
    a.out = (float*)d_out; a.ws = (unsigned char*)d_ws; a.pad = 0;
#if MK_ONE_LAUNCH
    a.ph_lo = 0; a.ph_hi = NPHASE; a.li = 0;
    hipLaunchKernelGGL(fwd_kernel, dim3(grid), dim3(NTHR), LDS_BYTES, stream, a);
#else
    for (int p = 0; p < DBG_STOP; ++p) { a.ph_lo = p; a.ph_hi = p + 1; a.li = p; hipLaunchKernelGGL(fwd_kernel, dim3(grid), dim3(NTHR), LDS_BYTES, stream, a); }
#endif
    if (DBG_DUMP) hipLaunchKernelGGL(dbg_dump_kernel, dim3(2048), dim3(256), 0, stream, (float*)d_out, (const unsigned char*)d_ws, DBG_DUMP);
}
#endif
```

```cpp
#include <hip/hip_runtime.h>
#include <cstdio>
#include <cstdint>
#include <cmath>
__device__ __forceinline__ int opaque(int v) { asm volatile("" : "+v"(v)); return v; }
__device__ __forceinline__ int opaque_s(int v) { asm volatile("" : "+s"(v)); return v; }
__device__ __forceinline__ void* opaque_p(void* p) { asm volatile("" : "+s"(p)); return p; }
__device__ __forceinline__ unsigned long long opaque_u64(unsigned long long v) { asm volatile("" : "+s"(v)); return v; }
#define MK_ONE_LAUNCH 1
namespace pg8 {
#define PG8_LAS __attribute__((address_space(3)))
typedef unsigned short bf16_t;
typedef short bf16x8 __attribute__((ext_vector_type(8)));
typedef float f32x4 __attribute__((ext_vector_type(4)));
typedef unsigned u32x4 __attribute__((ext_vector_type(4)));
constexpr int BM = 256, BK = 64, HALF = 128, HTB = HALF * BK * 2  , STAGE_BYTES = 8 * HTB, NXCD = 8, WGM = 8;

__host__ __device__ __forceinline__ int lds_byte(int r, int c) { const int st = (r >> 4) * 2 + (c >> 5), rr = r & 15, cc = c & 31, ob = rr * 64 + cc * 2; return st * 1024 + (ob ^ (((ob >> 9) & 1) << 5)); }
__host__ __device__ __forceinline__ void stage_rc(int b, int& R, int& C) { const int st = b / 1024, sb = b % 1024, swz = sb ^ (((sb >> 9) & 1) << 5); R = (st >> 1) * 16 + swz / 64; C = (st & 1) * 32 + (swz % 64) / 2; }
__host__ __device__ __forceinline__ int perm32(int rho) { const int n = rho >> 4, i = rho & 15; return 8 * (i >> 2) + 4 * n + (i & 3); }

struct Unit { int pm, pn; };
struct Gemm { const bf16_t* A; const bf16_t* Bt; int M, N, K; };

struct StaticOrder {
    int nM, nN, nwg, G, c;
    __host__ __device__ void init(int M, int N, int G_, int c_) { nM = M / BM; nN = N / BM; nwg = nM * nN; G = G_; c = c_; }
    __host__ __device__ bool next(int i, Unit& u) const {
        const long L = (long)i * G + c; if (L >= nwg) return false;
        int wgid = (int)L; { const int q = nwg / NXCD, r = nwg % NXCD, xcd = wgid % NXCD, off = wgid / NXCD; wgid = (xcd < r ? xcd * (q + 1) : r * (q + 1) + (xcd - r) * q) + off; }
        const int nig = WGM * nN, gid = wgid / nig, fm = gid * WGM, gsz = (nM - fm) < WGM ? (nM - fm) : WGM;
        u.pm = fm + ((wgid % nig) % gsz); u.pn = (wgid % nig) / gsz; return true;
    }
    __device__ __forceinline__ void a_ready(const Unit&) const {}
    __device__ __forceinline__ void done(const Unit&) const {}
};
__device__ __forceinline__ unsigned cvt_pk_bf16(float lo, float hi) { unsigned r; asm volatile("v_cvt_pk_bf16_f32 %0, %1, %2" : "=v"(r) : "v"(lo), "v"(hi)); return r; }
typedef float f32x2 __attribute__((ext_vector_type(2)));
template <class Epi, class Sched, bool ALIGN_EPI = false, bool SP2 = false>
__device__ __forceinline__ void gemm_phase(PG8_LAS unsigned char* lds, const Gemm g, const Sched& S, const Epi& E) {
    const int tid = opaque((int)threadIdx.x), wid = __builtin_amdgcn_readfirstlane(tid >> 6), lane = tid & 63, wr = wid >> 2, wc = wid & 3, fr = lane & 15, fq = lane >> 4;
    const int K = g.K, nt = K / BK;
    unsigned voffA[2], voffB[2];
#pragma unroll
    for (int i = 0; i < 2; ++i) { int R, C; stage_rc(tid * 16 + i * 8192, R, C); const int Rb = Epi::PERM ? ((R & ~31) + perm32(R & 31)) : R;
        voffA[i] = (unsigned)(R * K + C) * 2u; voffB[i] = (unsigned)(Rb * K + C) * 2u; }
    const size_t kstep = (size_t)(BK * 2);
    const size_t hstep = (size_t)HALF * K * 2;
    const size_t tstep = 2 * hstep;
    const unsigned ldsw = (unsigned)wid * 1024u;
    const int aoff = lds_byte(wr * 64 + fr, fq * 8), boff = lds_byte(wc * 32 + fr, fq * 8);
#define PG8_SA(b, h) (((b) * 2 + (h)) * HTB)
#define PG8_SB(b, h) ((4 + (b) * 2 + (h)) * HTB)
#define PG8_STAGE(bufoff, gbase, voff) do { _Pragma("unroll") for (int _i = 0; _i < 2; ++_i) \
        __builtin_amdgcn_global_load_lds((const unsigned*)((const char*)(gbase) + (voff)[_i]), (PG8_LAS unsigned*)(lds + (bufoff) + ldsw + _i * 8192), 16, 0, 0); } while (0)
#define PG8_LDA(dst, b, h) do { _Pragma("unroll") for (int m = 0; m < 4; ++m) _Pragma("unroll") for (int k = 0; k < 2; ++k) dst[m][k] = *(const PG8_LAS bf16x8*)(lds + PG8_SA(b, h) + aoff + m * 2048 + k * 1024); } while (0)
#define PG8_LDB(dst, b, h) do { _Pragma("unroll") for (int n = 0; n < 2; ++n) _Pragma("unroll") for (int k = 0; k < 2; ++k) dst[n][k] = *(const PG8_LAS bf16x8*)(lds + PG8_SB(b, h) + boff + n * 2048 + k * 1024); } while (0)
#define PG8_MMA(ai, bj, At, Bt) do { __builtin_amdgcn_s_setprio(1); _Pragma("unroll") for (int m = 0; m < 4; ++m) _Pragma("unroll") for (int n = 0; n < 2; ++n) _Pragma("unroll") for (int k = 0; k < 2; ++k) \
        acc[ai][bj][m][n] = __builtin_amdgcn_mfma_f32_16x16x32_bf16(Bt[n][k], At[m][k], acc[ai][bj][m][n], 0, 0, 0); __builtin_amdgcn_s_setprio(0); } while (0)
#define PG8_WAIT_V(n) asm volatile("s_waitcnt vmcnt(" #n ")" ::: "memory")
#define PG8_WAIT_L(n) asm volatile("s_waitcnt lgkmcnt(" #n ")" ::: "memory")
#define PG8_BAR __builtin_amdgcn_s_barrier()
#define PG8_SCHED __builtin_amdgcn_sched_barrier(0)
    Unit cur, nxt; int ui = 0;
    if (!S.next(0, cur)) return;
    f32x4 acc[2][2][4][2];
#pragma unroll
    for (int a = 0; a < 2; ++a)
#pragma unroll
        for (int b = 0; b < 2; ++b)
#pragma unroll
            for (int m = 0; m < 4; ++m)
#pragma unroll
                for (int n = 0; n < 2; ++n) acc[a][b][m][n] = (f32x4){0.f, 0.f, 0.f, 0.f};
    bf16x8 At[4][2], B0[2][2], B1[2][2];
    const char* cA = (const char*)g.A + (size_t)cur.pm * tstep; const char* cB = (const char*)g.Bt + (size_t)cur.pn * tstep;
    S.a_ready(cur);
    if constexpr (SP2) {
        PG8_STAGE(PG8_SB(0, 0), cB, voffB); PG8_STAGE(PG8_SB(0, 1), cB + hstep, voffB); PG8_STAGE(PG8_SA(0, 0), cA, voffA); PG8_STAGE(PG8_SA(0, 1), cA + hstep, voffA);
        if (wr == 1) PG8_BAR;
        PG8_WAIT_V(2); PG8_BAR;
        PG8_STAGE(PG8_SB(1, 0), cB + kstep, voffB); PG8_STAGE(PG8_SA(1, 0), cA + kstep, voffA); PG8_STAGE(PG8_SB(1, 1), cB + hstep + kstep, voffB);
        PG8_WAIT_V(6); PG8_BAR;
    } else {
        PG8_STAGE(PG8_SB(0, 0), cB, voffB); PG8_STAGE(PG8_SA(0, 0), cA, voffA); PG8_STAGE(PG8_SB(0, 1), cB + hstep, voffB); PG8_STAGE(PG8_SA(0, 1), cA + hstep, voffA);
        if (wr == 1) PG8_BAR;
        PG8_WAIT_V(4); PG8_BAR;
        PG8_STAGE(PG8_SB(1, 0), cB + kstep, voffB); PG8_STAGE(PG8_SA(1, 0), cA + kstep, voffA); PG8_STAGE(PG8_SB(1, 1), cB + hstep + kstep, voffB);
        PG8_WAIT_V(6); PG8_BAR;
    }
    for (;;) {
        const bool has_next = S.next(ui + 1, nxt);
        const char* nA = has_next ? (const char*)g.A + (size_t)nxt.pm * tstep : cA; const char* nB = has_next ? (const char*)g.Bt + (size_t)nxt.pn * tstep : cB;
        for (int t = 0; t < nt; t += 2) {
            const bool last = (t == nt - 2);
            const char* a1 = cA + (size_t)(t + 1) * kstep;
            const char* a2 = last ? nA : cA + (size_t)(t + 2) * kstep; const char* b2 = last ? nB : cB + (size_t)(t + 2) * kstep;
            const char* a3 = a2 + kstep; const char* b3 = b2 + kstep;
            if (last && has_next) S.a_ready(nxt);
            if constexpr (SP2) {
            PG8_LDB(B0, 0, 0); PG8_LDB(B1, 0, 1); PG8_SCHED; PG8_LDA(At, 0, 0); PG8_STAGE(PG8_SA(1, 1), a1 + hstep, voffA);
            PG8_WAIT_V(8); PG8_WAIT_L(0); PG8_BAR; PG8_MMA(0, 0, At, B0); PG8_MMA(0, 1, At, B1); PG8_BAR; PG8_SCHED;
            PG8_LDA(At, 0, 1); PG8_STAGE(PG8_SB(0, 0), b2, voffB); PG8_STAGE(PG8_SB(0, 1), b2 + hstep, voffB); PG8_STAGE(PG8_SA(0, 0), a2, voffA);
            PG8_WAIT_V(8); PG8_WAIT_L(0); PG8_BAR; PG8_MMA(1, 0, At, B0); PG8_MMA(1, 1, At, B1); PG8_BAR; PG8_SCHED;
            PG8_LDB(B0, 1, 0); PG8_LDB(B1, 1, 1); PG8_SCHED; PG8_LDA(At, 1, 0); PG8_STAGE(PG8_SA(0, 1), a2 + hstep, voffA);
            PG8_WAIT_V(8); PG8_WAIT_L(0); PG8_BAR; PG8_MMA(0, 0, At, B0); PG8_MMA(0, 1, At, B1); PG8_BAR; PG8_SCHED;
            PG8_LDA(At, 1, 1); PG8_STAGE(PG8_SB(1, 0), b3, voffB); PG8_STAGE(PG8_SB(1, 1), b3 + hstep, voffB); PG8_STAGE(PG8_SA(1, 0), a3, voffA);
            PG8_WAIT_V(8); PG8_WAIT_L(0); PG8_BAR; PG8_MMA(1, 0, At, B0); PG8_MMA(1, 1, At, B1); PG8_BAR; PG8_SCHED;
            } else {
            PG8_LDB(B0, 0, 0); PG8_SCHED; PG8_LDA(At, 0, 0); PG8_STAGE(PG8_SA(1, 1), a1 + hstep, voffA);
            PG8_WAIT_L(8); PG8_BAR; PG8_WAIT_L(0); PG8_MMA(0, 0, At, B0); PG8_BAR; PG8_SCHED;
            PG8_LDB(B1, 0, 1); PG8_STAGE(PG8_SB(0, 0), b2, voffB);
            PG8_BAR; PG8_WAIT_L(0); PG8_MMA(0, 1, At, B1); PG8_BAR;
            PG8_LDA(At, 0, 1); PG8_STAGE(PG8_SA(0, 0), a2, voffA);
            PG8_BAR; PG8_WAIT_L(0); PG8_MMA(1, 0, At, B0); PG8_BAR; PG8_SCHED;
            PG8_STAGE(PG8_SB(0, 1), b2 + hstep, voffB);
            PG8_WAIT_V(6); PG8_BAR; PG8_MMA(1, 1, At, B1); PG8_BAR;
            PG8_LDB(B0, 1, 0); PG8_SCHED; PG8_LDA(At, 1, 0); PG8_STAGE(PG8_SA(0, 1), a2 + hstep, voffA);
            PG8_WAIT_L(8); PG8_BAR; PG8_WAIT_L(0); PG8_MMA(0, 0, At, B0); PG8_BAR; PG8_SCHED;
            PG8_LDB(B1, 1, 1); PG8_STAGE(PG8_SB(1, 0), b3, voffB);
            PG8_BAR; PG8_WAIT_L(0); PG8_MMA(0, 1, At, B1); PG8_BAR;
            PG8_LDA(At, 1, 1); PG8_STAGE(PG8_SA(1, 0), a3, voffA);
            PG8_BAR; PG8_WAIT_L(0); PG8_MMA(1, 0, At, B0); PG8_BAR; PG8_SCHED;
            PG8_STAGE(PG8_SB(1, 1), b3 + hstep, voffB);
            PG8_WAIT_V(6); PG8_BAR; PG8_MMA(1, 1, At, B1); PG8_BAR;
            }
        }
        if constexpr (ALIGN_EPI) { if (wr == 0) PG8_BAR; }
        if constexpr (!Epi::AFTER_DRAIN) { E(acc, cur, wr, wc, fr, fq); S.done(cur); }
        if (!has_next) break;
#pragma unroll
        for (int a = 0; a < 2; ++a)
#pragma unroll
            for (int b = 0; b < 2; ++b)
#pragma unroll
                for (int m = 0; m < 4; ++m)
#pragma unroll
                    for (int n = 0; n < 2; ++n) acc[a][b][m][n] = (f32x4){0.f, 0.f, 0.f, 0.f};
        cur = nxt; cA = nA; cB = nB; ++ui;
        if constexpr (ALIGN_EPI) { if (wr == 1) PG8_BAR; }
    }
    PG8_WAIT_V(0);
    if constexpr (!ALIGN_EPI) { if (wr == 0) PG8_BAR; }
    PG8_BAR;
    if constexpr (Epi::AFTER_DRAIN) { E.fused(acc, cur, wr, wc, fr, fq, lds, wid, lane); S.done(cur); }
#undef PG8_SA
#undef PG8_SB
#undef PG8_STAGE
#undef PG8_LDA
#undef PG8_LDB
#undef PG8_MMA
#undef PG8_WAIT_V
#undef PG8_WAIT_L
#undef PG8_BAR
#undef PG8_SCHED
}
}
#define LAS __attribute__((address_space(3)))
#define XB_TMO      128
#define XB_XCNT(j)  (256  + 64 * (j))
#define XB_XSUB(j)  (1280 + 64 * (j))
#define XB_XGEN(j)  (2304 + 64 * (j))
#define XB_TOP      3328
#define XB_TOPGEN   3392
#define XCD_BAR_WORDS 3456
#define XB_SPIN_CAP (1u << 18)

__device__ __forceinline__ unsigned xb_ld(unsigned* p)              { return __hip_atomic_load(p, __ATOMIC_RELAXED, __HIP_MEMORY_SCOPE_AGENT); }
__device__ __forceinline__ unsigned xb_add(unsigned* p, unsigned v) { return __hip_atomic_fetch_add(p, v, __ATOMIC_RELAXED, __HIP_MEMORY_SCOPE_AGENT); }
__device__ __forceinline__ unsigned xb_xcc_id() { return (unsigned)__builtin_amdgcn_s_getreg((3 << 11) | 20) & 0xFu; }
#define XB_SPIN(cond, bar) do { unsigned _sp = 0; while (cond) { __builtin_amdgcn_s_sleep(1); \
    if ((++_sp & 255u) == 0u) { if (xb_ld(&(bar)[XB_TMO])) break; if (_sp > XB_SPIN_CAP) { atomicAdd(&(bar)[XB_TMO], 1u); break; } } } } while (0)

struct XcdBarrier {
    unsigned* bar; unsigned x;
    volatile LAS unsigned* st;
};

__device__ __forceinline__ XcdBarrier xcd_barrier_post(unsigned* bar, volatile LAS unsigned* st) {
    XcdBarrier b; b.bar = bar; b.x = xb_xcc_id(); b.st = st;
    if (threadIdx.x == 0) (void)xb_add(&bar[XB_XCNT(b.x)], 1u);
    return b;
}
__device__ __forceinline__ void xcd_barrier_complete(unsigned* bar, unsigned x, unsigned& nloc, unsigned& nx) {
    const unsigned G = gridDim.x * gridDim.y * gridDim.z;
    unsigned sum, cnt, mine, sp = 0u;
    for (;;) {
        sum = 0u; cnt = 0u; mine = 0u;
#pragma unroll
        for (unsigned j = 0; j < 16; ++j) { const unsigned c = xb_ld(&bar[XB_XCNT(j)]); sum += c; cnt += (c > 0u) ? 1u : 0u; mine = (j == x) ? c : mine; }
        if (sum == G) break;
        __builtin_amdgcn_s_sleep(1);
        if ((++sp & 255u) == 0u) { if (xb_ld(&bar[XB_TMO])) break; if (sp > XB_SPIN_CAP) { atomicAdd(&bar[XB_TMO], 1u); break; } }
    }
    nloc = mine > 0u ? mine : 1u; nx = cnt > 0u ? cnt : 1u;
}

__device__ __forceinline__ void xcd_barrier(const XcdBarrier& b) {
    asm volatile("s_waitcnt vmcnt(0)" ::: "memory");
    __syncthreads();
    if (threadIdx.x == 0) {
        unsigned* bar = b.bar;
        __builtin_amdgcn_s_waitcnt(0);
        unsigned nloc = b.st[0], nx = b.st[1];
        if (nloc == 0u) { xcd_barrier_complete(bar, b.x, nloc, nx); b.st[0] = nloc; b.st[1] = nx; }
        const unsigned old = xb_add(&bar[XB_XSUB(b.x)], 1u);
        const unsigned gen = old / nloc;
        if (old + 1u == (gen + 1u) * nloc) {
            __builtin_amdgcn_fence(__ATOMIC_RELEASE, "agent");
            asm volatile("s_waitcnt vmcnt(0)" ::: "memory");
            const unsigned og = xb_add(&bar[XB_TOP], 1u);
            const unsigned tg = og / nx;
            if (og + 1u == (tg + 1u) * nx) xb_add(&bar[XB_TOPGEN], 1u);
            else XB_SPIN(xb_ld(&bar[XB_TOPGEN]) == tg, bar);
            __builtin_amdgcn_fence(__ATOMIC_ACQUIRE, "agent");
            xb_add(&bar[XB_XGEN(b.x)], 1u);
            asm volatile("s_waitcnt vmcnt(0)" ::: "memory");
        } else {
            XB_SPIN(xb_ld(&bar[XB_XGEN(b.x)]) == gen, bar);
            __builtin_amdgcn_fence(__ATOMIC_ACQUIRE, "agent");
            asm volatile("s_waitcnt vmcnt(0)" ::: "memory");
        }
    }
    __syncthreads();
}
#undef LAS
using pg8::bf16x8; using pg8::f32x4; using pg8::u32x4; using pg8::f32x2;
#define GAS __attribute__((address_space(1)))
#define LAS __attribute__((address_space(3)))
typedef unsigned short bf16;
typedef unsigned v4u __attribute__((ext_vector_type(4)));
typedef unsigned v2u __attribute__((ext_vector_type(2)));
typedef float f32x2v __attribute__((ext_vector_type(2)));

constexpr int NTOK = 40960, DM = 2048, NLAYER = 4, INW = 5120;
constexpr int COL_UA = 0, COL_UB = 512, COL_Q = 1024, COL_K = 2048, COL_V = 3072, COL_G = 4096;
constexpr float ALPHA = 1.6817928305074290f;
constexpr float LN_EPS = 1e-5f, GN_EPS = 1e-6f;
constexpr int NEXP = 16384;
constexpr int NWAVES = 8, NTHR = 512;

constexpr size_t MiB = 1u << 20;
constexpr size_t WS_CTL = 0, CTL_ZERO_BYTES = 1 * MiB;
constexpr size_t WS_WIN = 1 * MiB;
constexpr size_t WS_WOUT = 81 * MiB;
constexpr size_t WS_WS = 113 * MiB;
constexpr size_t WS_WGLU = 145 * MiB;
constexpr size_t WS_WPOOL = 147 * MiB;
constexpr size_t WS_S5A = 149 * MiB;
constexpr size_t WS_S5B = 150 * MiB;
constexpr size_t WS_ROT = 152 * MiB;
constexpr size_t WS_U16 = 160 * MiB;
constexpr size_t WS_V16 = 416 * MiB;
constexpr size_t WS_U8 = 160 * MiB;
constexpr size_t WS_V8 = 288 * MiB;
constexpr size_t WS_USC = 416 * MiB;
constexpr size_t WS_VSC = 417 * MiB;
constexpr size_t WS_XN = 672 * MiB;
constexpr size_t WS_H = 832 * MiB;
constexpr size_t WS_CONCAT = 1232 * MiB;
constexpr size_t WS_BUFY = 1392 * MiB;
constexpr size_t WS_BUFP = 1432 * MiB;
constexpr size_t WS_STF = 1472 * MiB;
constexpr size_t WS_STB = 1632 * MiB;
constexpr size_t WS_IDX = 1792 * MiB;
constexpr size_t WS_GATE = 1812 * MiB;
constexpr size_t WS_S5ST = 1832 * MiB;
constexpr size_t WS_END = 1852 * MiB;
constexpr int CW_BAR = 4096;
constexpr int NPHASE = 1 + NLAYER * 10;

constexpr int LDS_SCRATCH = 147456;
constexpr int LDS_MISC = LDS_SCRATCH;
constexpr int LDS_BYTES = LDS_SCRATCH + 256;

__device__ __forceinline__ float bf_lo(unsigned w) { return __uint_as_float(w << 16); }
__device__ __forceinline__ float bf_hi(unsigned w) { return __uint_as_float(w & 0xffff0000u); }
typedef __bf16 bf16x2_t __attribute__((ext_vector_type(2)));
__device__ __forceinline__ unsigned pkbf(float lo, float hi) { const bf16x2_t v = {(__bf16)lo, (__bf16)hi}; return __builtin_bit_cast(unsigned, v); }
__device__ __forceinline__ bf16 f2bf(float f) { return __builtin_bit_cast(unsigned short, (__bf16)f); }
__device__ __forceinline__ float wave_sum(float v) {
#pragma unroll
    for (int o = 1; o < 64; o <<= 1) v += __shfl_xor(v, o);
    return v;
}
__device__ __forceinline__ float gelu_erf(float v) { return 0.5f * v * (1.0f + erff(v * 0.70710678118654752f)); }
__device__ __forceinline__ int tok_pos(int t) { return t < 32768 ? (t & 4095) : (t - 32768); }
__device__ __forceinline__ int tok_len(int t) { return t < 32768 ? 4096 : 8192; }
__device__ __forceinline__ void unpack8(const v4u q, float (&f)[8]) {
    f[0] = bf_lo(q.x); f[1] = bf_hi(q.x); f[2] = bf_lo(q.y); f[3] = bf_hi(q.y); f[4] = bf_lo(q.z); f[5] = bf_hi(q.z); f[6] = bf_lo(q.w); f[7] = bf_hi(q.w);
}
__device__ __forceinline__ v4u pack8(const float (&f)[8]) { v4u q; q.x = pkbf(f[0], f[1]); q.y = pkbf(f[2], f[3]); q.z = pkbf(f[4], f[5]); q.w = pkbf(f[6], f[7]); return q; }
#define LDS_WAIT() asm volatile("s_waitcnt lgkmcnt(0)" ::: "memory")
#define MFMA16(a, b, c) __builtin_amdgcn_mfma_f32_16x16x32_bf16((a), (b), (c), 0, 0, 0)

struct EpiStoreBf16 {
    static constexpr bool PERM = true, AFTER_DRAIN = false;
    bf16* O; int ldo;
    __device__ __forceinline__ void operator()(const f32x4 (&acc)[2][2][4][2], const pg8::Unit& u, int wr, int wc, int fr, int fq) const {
        const int row0 = u.pm * 256 + wr * 64 + fr, col0 = u.pn * 256 + wc * 32 + 8 * fq;
#pragma unroll
        for (int ai = 0; ai < 2; ++ai)
#pragma unroll
            for (int m = 0; m < 4; ++m) { bf16* rowp = O + (size_t)(row0 + ai * 128 + m * 16) * ldo + col0;
#pragma unroll
                for (int bj = 0; bj < 2; ++bj) { const f32x4 v0 = acc[ai][bj][m][0], v1 = acc[ai][bj][m][1];
                    v4u w; w.x = pkbf(v0[0], v0[1]); w.y = pkbf(v0[2], v0[3]); w.z = pkbf(v1[0], v1[1]); w.w = pkbf(v1[2], v1[3]);
                    *(v4u*)(rowp + bj * 128) = w; } }
    }
};
struct EpiGlu {
    static constexpr bool PERM = true, AFTER_DRAIN = false;
    const bf16* Y; int ldy; bf16* O; int ldo; const float* bias;
    __device__ __forceinline__ void operator()(const f32x4 (&acc)[2][2][4][2], const pg8::Unit& u, int wr, int wc, int fr, int fq) const {
        const int row0 = u.pm * 256 + wr * 64 + fr, col0 = u.pn * 256 + wc * 32 + 8 * fq;
#pragma unroll
        for (int bj = 0; bj < 2; ++bj) {
            const f32x4 b0 = *(const f32x4*)(bias + col0 + bj * 128), b1 = *(const f32x4*)(bias + col0 + bj * 128 + 4);
#pragma unroll
            for (int ai = 0; ai < 2; ++ai)
#pragma unroll
                for (int m = 0; m < 4; ++m) { const size_t r = (size_t)(row0 + ai * 128 + m * 16);
                    const v4u yq = *(const v4u*)(Y + r * ldy + col0 + bj * 128); float y[8]; unpack8(yq, y);
                    const f32x4 v0 = acc[ai][bj][m][0] + b0, v1 = acc[ai][bj][m][1] + b1; float o[8];
#pragma unroll
                    for (int k = 0; k < 4; ++k) { o[k] = y[k] / (1.0f + __expf(-v0[k])); o[4 + k] = y[4 + k] / (1.0f + __expf(-v1[k])); }
                    *(v4u*)(O + r * ldo + col0 + bj * 128) = pack8(o); }
        }
    }
};
struct EpiScaleBf16 {
    static constexpr bool PERM = true, AFTER_DRAIN = false;
    bf16* O; int ldo; const float* scale;
    __device__ __forceinline__ void operator()(const f32x4 (&acc)[2][2][4][2], const pg8::Unit& u, int wr, int wc, int fr, int fq) const {
        const int row0 = u.pm * 256 + wr * 64 + fr, col0 = u.pn * 256 + wc * 32 + 8 * fq;
#pragma unroll
        for (int bj = 0; bj < 2; ++bj) {
            const f32x4 s0 = *(const f32x4*)(scale + col0 + bj * 128), s1 = *(const f32x4*)(scale + col0 + bj * 128 + 4);
#pragma unroll
            for (int ai = 0; ai < 2; ++ai)
#pragma unroll
                for (int m = 0; m < 4; ++m) { const size_t r = (size_t)(row0 + ai * 128 + m * 16);
                    const f32x4 v0 = acc[ai][bj][m][0] * s0, v1 = acc[ai][bj][m][1] * s1;
                    v4u w; w.x = pkbf(v0[0], v0[1]); w.y = pkbf(v0[2], v0[3]); w.z = pkbf(v1[0], v1[1]); w.w = pkbf(v1[2], v1[3]);
                    *(v4u*)(O + r * ldo + col0 + bj * 128) = w; }
        }
    }
};
struct EpiResid {
    static constexpr bool PERM = false, AFTER_DRAIN = false;
    float* X; int ldx; float alpha;
    __device__ __forceinline__ void operator()(const f32x4 (&acc)[2][2][4][2], const pg8::Unit& u, int wr, int wc, int fr, int fq) const {
        const int row0 = u.pm * 256 + wr * 64 + fr, col0 = u.pn * 256 + wc * 32 + 4 * fq;
#pragma unroll
        for (int ai = 0; ai < 2; ++ai)
#pragma unroll
            for (int m = 0; m < 4; ++m) { float* rowp = X + (size_t)(row0 + ai * 128 + m * 16) * ldx + col0;
#pragma unroll
                for (int bj = 0; bj < 2; ++bj)
#pragma unroll
                    for (int n = 0; n < 2; ++n) { f32x4* p = (f32x4*)(rowp + bj * 128 + n * 16); const f32x4 x = *p; *p = x * alpha + acc[ai][bj][m][n]; } }
    }
};
struct EpiStoreF32 {
    static constexpr bool PERM = false, AFTER_DRAIN = false;
    float* C; int ldc;
    __device__ __forceinline__ void operator()(const f32x4 (&acc)[2][2][4][2], const pg8::Unit& u, int wr, int wc, int fr, int fq) const {
        const int row0 = u.pm * 256 + wr * 64 + fr, col0 = u.pn * 256 + wc * 32 + 4 * fq;
#pragma unroll
        for (int ai = 0; ai < 2; ++ai)
#pragma unroll
            for (int m = 0; m < 4; ++m) { float* rowp = C + (size_t)(row0 + ai * 128 + m * 16) * ldc + col0;
#pragma unroll
                for (int bj = 0; bj < 2; ++bj)
#pragma unroll
                    for (int n = 0; n < 2; ++n) *(f32x4*)(rowp + bj * 128 + n * 16) = acc[ai][bj][m][n]; }
    }
};

struct Args { const float* in[26]; float* out; unsigned char* ws; int ph_lo, ph_hi, li, pad; };
typedef const Args __attribute__((address_space(4))) CArgs;
struct Frame {
    LAS unsigned char* lds;
    int tid, lane, wave, G, bx;
    int gw, NGW;
    size_t gtid, NT;
    float* out; unsigned char* ws;
};
enum InIdx { I_XP = 0, I_XS, I_LNIN_G, I_LNIN_B, I_WIN, I_LAMRE, I_LAMIM, I_LOGSTEP, I_BRE, I_BIM, I_CRE, I_CIM, I_S5D, I_WGLU, I_BGLU, I_POOLW, I_POOLS,
             I_WOUT, I_LN1G, I_LN1B, I_WQ, I_KEYS, I_PU, I_PV, I_LN2G, I_LN2B };

__device__ __forceinline__ void ln_row(const float* src, const float* g, const float* b, float* dst, bf16* dstb, int lane) {
    f32x4 v[8]; float s = 0.f;
#pragma unroll
    for (int j = 0; j < 8; ++j) { v[j] = ((const f32x4*)src)[lane + 64 * j]; s += (v[j][0] + v[j][1]) + (v[j][2] + v[j][3]); }
    const float mean = wave_sum(s) * (1.0f / DM); float s2 = 0.f;
#pragma unroll
    for (int j = 0; j < 8; ++j) { v[j] = v[j] - mean; s2 += (v[j][0] * v[j][0] + v[j][1] * v[j][1]) + (v[j][2] * v[j][2] + v[j][3] * v[j][3]); }
    const float rstd = 1.0f / sqrtf(wave_sum(s2) * (1.0f / DM) + LN_EPS);
#pragma unroll
    for (int j = 0; j < 8; ++j) { const f32x4 gg = ((const f32x4*)g)[lane + 64 * j], bb = ((const f32x4*)b)[lane + 64 * j];
        const f32x4 o = v[j] * rstd * gg + bb; ((f32x4*)dst)[lane + 64 * j] = o;
        v2u w; w.x = pkbf(o[0], o[1]); w.y = pkbf(o[2], o[3]); ((v2u*)dstb)[lane + 64 * j] = w; }
}

__device__ __forceinline__ void transpose_item(const float* W, int K, int N, bf16* WT, LAS float* scr, int item, int lane) {
    const int nblk = N / 32, kb = item / nblk, nb = item % nblk, k0 = 64 * kb, n0 = 32 * nb;
#pragma unroll 8
    for (int i = 0; i < 32; ++i) { const int kk = 2 * i + (lane >> 5); scr[kk * 33 + (lane & 31)] = W[(size_t)(k0 + kk) * N + n0 + (lane & 31)]; }
    LDS_WAIT();
    const int c = lane & 7;
#pragma unroll
    for (int j = 0; j < 4; ++j) { const int n = (lane >> 3) + 8 * j; const LAS float* s = scr + (8 * c) * 33 + n;
        v4u o; o.x = pkbf(s[0 * 33], s[1 * 33]); o.y = pkbf(s[2 * 33], s[3 * 33]); o.z = pkbf(s[4 * 33], s[5 * 33]); o.w = pkbf(s[6 * 33], s[7 * 33]);
        *(v4u*)(WT + (size_t)(n0 + n) * K + k0 + 8 * c) = o; }
    LDS_WAIT();
}

__device__ __forceinline__ void p0_prologue(const Frame& F, CArgs& A) {
    {
        LAS float* scr = (LAS float*)(F.lds + F.wave * 16384);
        constexpr int I_IN = (DM / 64) * (INW / 32), I_OUT = (DM / 64) * (DM / 32), I_GLU = (512 / 64) * (512 / 32);
        constexpr int NITEMS = NLAYER * (I_IN + I_OUT + I_GLU);
        for (int it = F.gw; it < NITEMS; it += F.NGW) {
            int r = it;
            if (r < NLAYER * I_IN) { const int l = r / I_IN; transpose_item(A.in[I_WIN] + (size_t)l * DM * INW, DM, INW, (bf16*)(F.ws + WS_WIN) + (size_t)l * INW * DM, scr, r % I_IN, F.lane); continue; }
            r -= NLAYER * I_IN;
            if (r < NLAYER * I_OUT) { const int l = r / I_OUT; transpose_item(A.in[I_WOUT] + (size_t)l * DM * DM, DM, DM, (bf16*)(F.ws + WS_WOUT) + (size_t)l * DM * DM, scr, r % I_OUT, F.lane); continue; }
            r -= NLAYER * I_OUT;
            { const int l = r / I_GLU; transpose_item(A.in[I_WGLU] + (size_t)l * 512 * 512, 512, 512, (bf16*)(F.ws + WS_WGLU) + (size_t)l * 512 * 512, scr, r % I_GLU, F.lane); }
        }
    }
    {
        for (int r = F.gw; r < 2 * NLAYER * NEXP; r += F.NGW) {
            const int tab = r >= NLAYER * NEXP, ri = tab ? r - NLAYER * NEXP : r;
            const float* src = (tab ? A.in[I_PV] : A.in[I_PU]) + (size_t)ri * DM;
            f32x4 v[2][4]; float am = 0.f;
#pragma unroll
            for (int c = 0; c < 2; ++c)
#pragma unroll
                for (int q = 0; q < 4; ++q) { v[c][q] = *(const f32x4*)(src + (c * 64 + F.lane) * 16 + q * 4);
                    am = fmaxf(am, fmaxf(fmaxf(fabsf(v[c][q][0]), fabsf(v[c][q][1])), fmaxf(fabsf(v[c][q][2]), fabsf(v[c][q][3])))); }
#pragma unroll
            for (int o = 1; o < 64; o <<= 1) am = fmaxf(am, __shfl_xor(am, o));
            const float sc = am > 0.f ? 384.0f / am : 1.0f, isc = am > 0.f ? am * (1.0f / 384.0f) : 1.0f;
            unsigned char* dst = F.ws + (tab ? WS_V8 : WS_U8) + (size_t)ri * DM;
#pragma unroll
            for (int c = 0; c < 2; ++c) { v4u w;
#pragma unroll
                for (int q = 0; q < 4; ++q) { int pk = 0; pk = __builtin_amdgcn_cvt_pk_fp8_f32(v[c][q][0] * sc, v[c][q][1] * sc, pk, false); pk = __builtin_amdgcn_cvt_pk_fp8_f32(v[c][q][2] * sc, v[c][q][3] * sc, pk, true); w[q] = (unsigned)pk; }
                *(v4u*)(dst + (c * 64 + F.lane) * 16) = w; }
            if (F.lane == 0) ((float*)(F.ws + (tab ? WS_VSC : WS_USC)))[ri] = isc;
        }
    }
    {
        const float* pw = A.in[I_POOLW]; v4u* dst = (v4u*)(F.ws + WS_WPOOL);
        for (size_t i = F.gtid; i < (size_t)NLAYER * 512 * 64; i += F.NT) {
            const int k8 = (int)(i & 63), n = (int)((i >> 6) & 511), l = (int)(i >> 15);
            const int g = n >> 7, d = n & 127, kg = k8 >> 4, c0 = (k8 & 15) * 8;
            float f[8];
#pragma unroll
            for (int k = 0; k < 8; ++k) f[k] = (kg == g) ? pw[(((size_t)l * 4 + g) * 128 + (c0 + k)) * 128 + d] : 0.f;
            dst[i] = pack8(f);
        }
    }
    {
        const float* lre = A.in[I_LAMRE]; const float* lim = A.in[I_LAMIM]; const float* lst = A.in[I_LOGSTEP]; const float* bre = A.in[I_BRE]; const float* bim = A.in[I_BIM];
        f32x2v* ab = (f32x2v*)(F.ws + WS_S5A); f32x2v* ab64 = (f32x2v*)(F.ws + WS_S5A + 512 * 1024); f32x2v* bb = (f32x2v*)(F.ws + WS_S5B);
        for (size_t i = F.gtid; i < (size_t)NLAYER * 2 * 32 * 64; i += F.NT) {
            const float lr = lre[i], li = lim[i], dt = expf(lst[i >> 6]);
            const float mag = expf(lr * dt), ar = mag * cosf(li * dt), ai = mag * sinf(li * dt);
            const float den = lr * lr + li * li;
            const float zr = ((ar - 1.0f) * lr + ai * li) / den, zi = (ai * lr - (ar - 1.0f) * li) / den;
            ab[i] = (f32x2v){ar, ai};
            const float m64 = expf(lr * dt * 64.0f), an = li * dt * 64.0f;
            ab64[i] = (f32x2v){m64 * cosf(an), m64 * sinf(an)};
#pragma unroll
            for (int c = 0; c < 16; ++c) { const float br = bre[i * 16 + c], bi = bim[i * 16 + c]; bb[i * 16 + c] = (f32x2v){zr * br - zi * bi, zr * bi + zi * br}; }
        }
    }
    if (F.bx == 0 && F.tid < 128) {
        ((float*)(F.ws + WS_ROT))[F.tid] = (float)exp(-(double)F.tid / 127.0 * 9.210340371976184);
    }
    __syncthreads();
    {
        LAS float* KS = (LAS float*)F.lds;
        LAS float* WQ = (LAS float*)(F.lds + 128 * 132 * 4);
        const float* keys = A.in[I_KEYS]; const float* wq = A.in[I_WQ]; bf16* wst = (bf16*)(F.ws + WS_WS);
        for (int u = F.bx; u < NLAYER * 16 * 32; u += F.G) {
            const int dtl = u & 31, hp = (u >> 5) & 15, l = u >> 9, p = hp & 1;
#pragma unroll
            for (int r = 0; r < 8; ++r) { const int f = F.tid + 512 * r, nk = f >> 5, c4 = f & 31;
                *(LAS f32x4*)(KS + nk * 132 + c4 * 4) = *(const f32x4*)(keys + (((size_t)l * 2 + p) * 128 + nk) * 128 + c4 * 4); }
#pragma unroll
            for (int r = 0; r < 4; ++r) { const int f = F.tid + 512 * r, dd = f >> 5, c4 = f & 31;
                *(LAS f32x4*)(WQ + dd * 132 + c4 * 4) = *(const f32x4*)(wq + ((size_t)l * DM + dtl * 64 + dd) * DM + hp * 128 + c4 * 4); }
            __syncthreads();
            const int nk = F.tid & 127, dg = F.tid >> 7;
            float acc[16];
#pragma unroll
            for (int i = 0; i < 16; ++i) acc[i] = 0.f;
            for (int c4 = 0; c4 < 32; ++c4) {
                const f32x4 kv = *(const LAS f32x4*)(KS + nk * 132 + c4 * 4);
#pragma unroll
                for (int i = 0; i < 16; ++i) { const f32x4 wv = *(const LAS f32x4*)(WQ + (dg * 16 + i) * 132 + c4 * 4);
                    acc[i] += (kv[0] * wv[0] + kv[1] * wv[1]) + (kv[2] * wv[2] + kv[3] * wv[3]); }
            }
            bf16* o = wst + ((size_t)l * DM + hp * 128 + nk) * DM + dtl * 64 + dg * 16;
            v4u q0, q1; q0.x = pkbf(acc[0], acc[1]); q0.y = pkbf(acc[2], acc[3]); q0.z = pkbf(acc[4], acc[5]); q0.w = pkbf(acc[6], acc[7]);
            q1.x = pkbf(acc[8], acc[9]); q1.y = pkbf(acc[10], acc[11]); q1.z = pkbf(acc[12], acc[13]); q1.w = pkbf(acc[14], acc[15]);
            *(v4u*)o = q0; *(v4u*)(o + 8) = q1;
            __syncthreads();
        }
    }
    for (int t = F.gw; t < NTOK; t += F.NGW) {
        const float* src = t < 32768 ? A.in[I_XP] + (size_t)t * DM : A.in[I_XS] + (size_t)(t - 32768) * DM;
        ln_row(src, A.in[I_LNIN_G], A.in[I_LNIN_B], F.out + (size_t)t * DM, (bf16*)(F.ws + WS_XN) + (size_t)t * DM, F.lane);
    }
}

__device__ __forceinline__ float ret_log2_gamma(int h) { return log2f(1.0f - exp2f(-5.0f - (float)h)); }

__device__ __forceinline__ void s5_pass1(const Frame& F, CArgs& A, int l) {
    LAS float* Uw = (LAS float*)(F.lds + F.wave * 4096);
    const bf16* H = (const bf16*)(F.ws + WS_H);
    const f32x2v* ab = (const f32x2v*)(F.ws + WS_S5A); const f32x4* bb = (const f32x4*)(F.ws + WS_S5B);
    f32x2v* st = (f32x2v*)(F.ws + WS_S5ST);
    for (int task = F.gw; task < 640 * 32 * 2; task += F.NGW) {
        const int dir = task & 1, g = (task >> 1) & 31, ck = task >> 6;
        const int pidx = ((l * 2 + dir) * 32 + g) * 64 + F.lane;
        const f32x2v a = ab[pidx];
        float Br[16], Bi[16];
#pragma unroll
        for (int c2 = 0; c2 < 8; ++c2) { const f32x4 q = bb[(size_t)pidx * 8 + c2]; Br[2 * c2] = q[0]; Bi[2 * c2] = q[1]; Br[2 * c2 + 1] = q[2]; Bi[2 * c2 + 1] = q[3]; }
        {
            const bf16* urow = H + (size_t)(ck * 64 + F.lane) * INW + COL_UA + g * 16;
            const v4u q0 = *(const v4u*)urow, q1 = *(const v4u*)(urow + 8); float f0[8], f1[8]; unpack8(q0, f0); unpack8(q1, f1);
            LAS f32x4* d = (LAS f32x4*)(Uw + F.lane * 16);
            d[0] = (f32x4){f0[0], f0[1], f0[2], f0[3]}; d[1] = (f32x4){f0[4], f0[5], f0[6], f0[7]}; d[2] = (f32x4){f1[0], f1[1], f1[2], f1[3]}; d[3] = (f32x4){f1[4], f1[5], f1[6], f1[7]};
        }
        LDS_WAIT();
        float xr = 0.f, xi = 0.f;
        for (int s = 0; s < 64; ++s) {
            const int t = dir ? 63 - s : s;
            const LAS f32x4* up = (const LAS f32x4*)(Uw + t * 16);
            float bur = 0.f, bui = 0.f;
#pragma unroll
            for (int c4 = 0; c4 < 4; ++c4) { const f32x4 uv = up[c4];
#pragma unroll
                for (int k = 0; k < 4; ++k) { bur += Br[4 * c4 + k] * uv[k]; bui += Bi[4 * c4 + k] * uv[k]; } }
            const float nxr = a[0] * xr - a[1] * xi + bur, nxi = a[0] * xi + a[1] * xr + bui; xr = nxr; xi = nxi;
        }
        st[(size_t)((ck * 32 + g) * 2 + dir) * 64 + F.lane] = (f32x2v){xr, xi};
        LDS_WAIT();
    }
}
__device__ __forceinline__ void s5_carry(const Frame& F, CArgs& A, int l) {
    const f32x2v* ab64 = (const f32x2v*)(F.ws + WS_S5A + 512 * 1024); f32x2v* st = (f32x2v*)(F.ws + WS_S5ST);
    for (size_t it = F.gtid; it < (size_t)9 * 32 * 2 * 64; it += F.NT) {
        const int p = (int)(it & 63), dir = (int)((it >> 6) & 1), g = (int)((it >> 7) & 31), s = (int)(it >> 12);
        const int ck0 = s < 8 ? s * 64 : 512, n = s < 8 ? 64 : 128;
        const f32x2v a = ab64[((l * 2 + dir) * 32 + g) * 64 + p];
        float cr = 0.f, ci = 0.f;
        for (int k = 0; k < n; ++k) {
            const int ck = dir ? (ck0 + n - 1 - k) : (ck0 + k);
            f32x2v* q = st + (size_t)((ck * 32 + g) * 2 + dir) * 64 + p;
            const f32x2v le = *q; *q = (f32x2v){cr, ci};
            const float ncr = a[0] * cr - a[1] * ci + le[0], nci = a[0] * ci + a[1] * cr + le[1]; cr = ncr; ci = nci;
        }
    }
}
__device__ __forceinline__ void s5_pass3(const Frame& F, CArgs& A, int l) {
    LAS unsigned char* wb = F.lds + F.wave * 17152;
    LAS float* Uw = (LAS float*)wb;
    LAS bf16* Xw = (LAS bf16*)(wb + 4096);
    LAS bf16* Ctw = (LAS bf16*)(wb + 4096 + 8704);
    const bf16* H = (const bf16*)(F.ws + WS_H); bf16* BY = (bf16*)(F.ws + WS_BUFY);
    const f32x2v* ab = (const f32x2v*)(F.ws + WS_S5A); const f32x4* bb = (const f32x4*)(F.ws + WS_S5B);
    const f32x2v* st = (const f32x2v*)(F.ws + WS_S5ST);
    const float* cre = A.in[I_CRE]; const float* cim = A.in[I_CIM]; const float* dvec = A.in[I_S5D] + (size_t)l * 512;
    const int lane = F.lane, lr = lane & 15, lq = lane >> 4;
    for (int task = F.gw; task < 640 * 32; task += F.NGW) {
        const int g = task & 31, ck = task >> 5;
        {
            const bf16* urow = H + (size_t)(ck * 64 + lane) * INW + COL_UA + g * 16;
            const v4u q0 = *(const v4u*)urow, q1 = *(const v4u*)(urow + 8); float f0[8], f1[8]; unpack8(q0, f0); unpack8(q1, f1);
            LAS f32x4* d = (LAS f32x4*)(Uw + lane * 16);
            d[0] = (f32x4){f0[0], f0[1], f0[2], f0[3]}; d[1] = (f32x4){f0[4], f0[5], f0[6], f0[7]}; d[2] = (f32x4){f1[0], f1[1], f1[2], f1[3]}; d[3] = (f32x4){f1[4], f1[5], f1[6], f1[7]};
        }
        f32x4 Y[4];
#pragma unroll
        for (int m = 0; m < 4; ++m) Y[m] = (f32x4){0.f, 0.f, 0.f, 0.f};
#pragma unroll
        for (int dir = 0; dir < 2; ++dir) {
            const int pidx = ((l * 2 + dir) * 32 + g) * 64 + lane;
            const f32x2v a = ab[pidx];
            float Br[16], Bi[16];
#pragma unroll
            for (int c2 = 0; c2 < 8; ++c2) { const f32x4 q = bb[(size_t)pidx * 8 + c2]; Br[2 * c2] = q[0]; Bi[2 * c2] = q[1]; Br[2 * c2 + 1] = q[2]; Bi[2 * c2 + 1] = q[3]; }
            {
                const size_t cb = (size_t)((l * 2 + dir) * 32 + g) * 16 * 64;
#pragma unroll
                for (int c = 0; c < 16; ++c) { Ctw[c * 136 + lane] = f2bf(cre[cb + c * 64 + lane]); Ctw[c * 136 + 64 + lane] = f2bf(-cim[cb + c * 64 + lane]); }
            }
            const f32x2v x0 = st[(size_t)((ck * 32 + g) * 2 + dir) * 64 + lane];
            float xr = x0[0], xi = x0[1];
            LDS_WAIT();
#pragma unroll
            for (int half = 0; half < 2; ++half) {
                for (int s = 0; s < 32; ++s) {
                    const int step = half * 32 + s, t = dir ? 63 - step : step;
                    const LAS f32x4* up = (const LAS f32x4*)(Uw + t * 16);
                    float bur = 0.f, bui = 0.f;
#pragma unroll
                    for (int c4 = 0; c4 < 4; ++c4) { const f32x4 uv = up[c4];
#pragma unroll
                        for (int k = 0; k < 4; ++k) { bur += Br[4 * c4 + k] * uv[k]; bui += Bi[4 * c4 + k] * uv[k]; } }
                    const float nxr = a[0] * xr - a[1] * xi + bur, nxi = a[0] * xi + a[1] * xr + bui; xr = nxr; xi = nxi;
                    Xw[(t & 31) * 136 + lane] = f2bf(xr); Xw[(t & 31) * 136 + 64 + lane] = f2bf(xi);
                }
                LDS_WAIT();
                const int tb = dir ? (1 - half) : half;
#pragma unroll
                for (int m = 0; m < 2; ++m)
#pragma unroll
                    for (int ks = 0; ks < 4; ++ks) {
                        const bf16x8 av = *(const LAS bf16x8*)(Ctw + lr * 136 + 32 * ks + lq * 8);
                        const bf16x8 bv = *(const LAS bf16x8*)(Xw + (16 * m + lr) * 136 + 32 * ks + lq * 8);
                        Y[2 * tb + m] = MFMA16(av, bv, Y[2 * tb + m]);
                    }
                LDS_WAIT();
            }
        }
#pragma unroll
        for (int m = 0; m < 4; ++m) {
            const int t = 16 * m + lr, c0 = 4 * lq;
            const f32x4 uv = *(const LAS f32x4*)(Uw + t * 16 + c0); const f32x4 dv = *(const f32x4*)(dvec + g * 16 + c0);
            const f32x4 y = Y[m] + dv * uv;
            v2u w; w.x = pkbf(gelu_erf(y[0]), gelu_erf(y[1])); w.y = pkbf(gelu_erf(y[2]), gelu_erf(y[3]));
            *(v2u*)(BY + (size_t)(ck * 64 + t) * 512 + g * 16 + c0) = w;
        }
        LDS_WAIT();
    }
}
__device__ __forceinline__ void pool_phase(const Frame& F, CArgs& A) {
    const bf16* H = (const bf16*)(F.ws + WS_H); bf16* BP = (bf16*)(F.ws + WS_BUFP);
    for (size_t it = F.gtid; it < (size_t)NTOK * 64; it += F.NT) {
        const int t = (int)(it >> 6), o = (int)(it & 63), gi = o >> 4, w = 2 << gi;
        const int pos = tok_pos(t), L = tok_len(t);
        const int lo = max(pos - w / 2, 0), hi = min(pos + w / 2 - 1, L - 1);
        const bf16* base = H + (size_t)(t - pos) * INW + COL_UB + o * 8;
        float s[8];
#pragma unroll
        for (int k = 0; k < 8; ++k) s[k] = 0.f;
        for (int si = lo; si <= hi; ++si) { float f[8]; unpack8(*(const v4u*)(base + (size_t)si * INW), f);
#pragma unroll
            for (int k = 0; k < 8; ++k) s[k] += f[k]; }
        const float inv = 1.0f / (float)(hi - lo + 1);
        float c[8]; unpack8(*(const v4u*)(base + (size_t)pos * INW), c);
#pragma unroll
        for (int k = 0; k < 8; ++k) s[k] = s[k] * inv - c[k];
        *(v4u*)(BP + (size_t)t * 512 + o * 8) = pack8(s);
    }
}
__device__ __forceinline__ void rotary_phase(const Frame& F, CArgs& A) {
    bf16* H = (bf16*)(F.ws + WS_H); const float* rot = (const float*)(F.ws + WS_ROT);
    for (size_t it = F.gtid; it < (size_t)NTOK * 16; it += F.NT) {
        const int t = (int)(it >> 4), o = (int)(it & 15); const float pos = (float)tok_pos(t);
        float cs[8], sn[8];
#pragma unroll
        for (int k = 0; k < 8; ++k) { const float ang = pos * rot[o * 8 + k]; cs[k] = cosf(ang); sn[k] = sinf(ang); }
#pragma unroll
        for (int which = 0; which < 2; ++which) {
            const float sc = which ? 0.0625f : 1.0f;
#pragma unroll
            for (int hd = 0; hd < 4; ++hd) {
                bf16* p1 = H + (size_t)t * INW + (which ? COL_K : COL_Q) + hd * 256 + o * 8; bf16* p2 = p1 + 128;
                float x1[8], x2[8], o1[8], o2[8]; unpack8(*(const v4u*)p1, x1); unpack8(*(const v4u*)p2, x2);
#pragma unroll
                for (int k = 0; k < 8; ++k) { o1[k] = (x1[k] * cs[k] - x2[k] * sn[k]) * sc; o2[k] = (x2[k] * cs[k] + x1[k] * sn[k]) * sc; }
                *(v4u*)p1 = pack8(o1); *(v4u*)p2 = pack8(o2);
            }
        }
    }
}
constexpr int RS = 136;
__device__ __forceinline__ void ret_state_phase(const Frame& F, CArgs& A) {
    const bf16* H = (const bf16*)(F.ws + WS_H); bf16* STF = (bf16*)(F.ws + WS_STF); bf16* STB = (bf16*)(F.ws + WS_STB);
    LAS bf16* Kt = (LAS bf16*)F.lds; LAS bf16* VtF = Kt + 128 * RS; LAS bf16* VtB = Kt + 256 * RS;
    const int tid = F.tid, lane = F.lane, lr = lane & 15, lq = lane >> 4, we = F.wave >> 1, wd = F.wave & 1;
    for (int u = F.bx; u < 5120; u += F.G) {
        const int dh = u & 1, eh = (u >> 1) & 1, h = (u >> 2) & 3, c = u >> 4;
        {
            const int tq = opaque(tid), jp = tq & 63, j = 2 * jp, pc0 = tq >> 6;
            const bf16* krow = H + (size_t)(c * 128 + j) * INW + COL_K + h * 256 + dh * 128;
            const bf16* vrow = H + (size_t)(c * 128 + j) * INW + COL_V + h * 256 + eh * 128;
            const float lg = ret_log2_gamma(h), fF0 = exp2f(lg * (float)(127 - j)), fF1 = exp2f(lg * (float)(126 - j)), fB0 = exp2f(lg * (float)j), fB1 = exp2f(lg * (float)(j + 1));
            LAS unsigned* Kt32 = (LAS unsigned*)Kt; LAS unsigned* VtF32 = (LAS unsigned*)VtF; LAS unsigned* VtB32 = (LAS unsigned*)VtB;
#pragma unroll
            for (int r = 0; r < 2; ++r) {
                const int pc = pc0 + 8 * r;
                const v4u k0 = *(const v4u*)(krow + pc * 8), k1 = *(const v4u*)(krow + INW + pc * 8);
                const v4u v0 = *(const v4u*)(vrow + pc * 8), v1 = *(const v4u*)(vrow + INW + pc * 8);
                const unsigned ka0[4] = {k0.x, k0.y, k0.z, k0.w}, ka1[4] = {k1.x, k1.y, k1.z, k1.w};
                float f0[8], f1[8]; unpack8(v0, f0); unpack8(v1, f1);
#pragma unroll
                for (int i = 0; i < 8; ++i) {
                    const unsigned a = ka0[i >> 1], b = ka1[i >> 1];
                    const unsigned kk = (i & 1) ? ((a >> 16) | (b & 0xffff0000u)) : ((a & 0xffffu) | (b << 16));
                    const int o = ((pc * 8 + i) * RS) / 2 + jp;
                    Kt32[o] = kk; VtF32[o] = pkbf(f0[i] * fF0, f1[i] * fF1); VtB32[o] = pkbf(f0[i] * fB0, f1[i] * fB1);
                }
            }
        }
        __syncthreads();
        f32x4 aF[4][2], aB[4][2];
#pragma unroll
        for (int td = 0; td < 4; ++td)
#pragma unroll
            for (int te = 0; te < 2; ++te) { aF[td][te] = (f32x4){0.f, 0.f, 0.f, 0.f}; aB[td][te] = (f32x4){0.f, 0.f, 0.f, 0.f}; }
#pragma unroll
        for (int ks = 0; ks < 4; ++ks) {
            bf16x8 ka[4], vF[2], vB[2];
#pragma unroll
            for (int td = 0; td < 4; ++td) ka[td] = *(const LAS bf16x8*)(Kt + (64 * wd + 16 * td + lr) * RS + 32 * ks + lq * 8);
#pragma unroll
            for (int te = 0; te < 2; ++te) { vF[te] = *(const LAS bf16x8*)(VtF + (32 * we + 16 * te + lr) * RS + 32 * ks + lq * 8); vB[te] = *(const LAS bf16x8*)(VtB + (32 * we + 16 * te + lr) * RS + 32 * ks + lq * 8); }
#pragma unroll
            for (int td = 0; td < 4; ++td)
#pragma unroll
                for (int te = 0; te < 2; ++te) { aF[td][te] = MFMA16(ka[td], vF[te], aF[td][te]); aB[td][te] = MFMA16(ka[td], vB[te], aB[td][te]); }
        }
#pragma unroll
        for (int td = 0; td < 4; ++td)
#pragma unroll
            for (int te = 0; te < 2; ++te) {
                const int e = eh * 128 + 32 * we + 16 * te + lr, d = dh * 128 + 64 * wd + 16 * td + 4 * lq;
                const size_t off = ((size_t)(c * 4 + h) * 256 + e) * 256 + d;
                v2u w; w.x = pkbf(aF[td][te][0], aF[td][te][1]); w.y = pkbf(aF[td][te][2], aF[td][te][3]); *(v2u*)(STF + off) = w;
                v2u x; x.x = pkbf(aB[td][te][0], aB[td][te][1]); x.y = pkbf(aB[td][te][2], aB[td][te][3]); *(v2u*)(STB + off) = x;
            }
        __syncthreads();
    }
}
__device__ __forceinline__ void ret_prefix_phase(const Frame& F, CArgs& A) {
    bf16* STF = (bf16*)(F.ws + WS_STF); bf16* STB = (bf16*)(F.ws + WS_STB);
    for (size_t it = F.gtid; it < (size_t)36 * 2 * 8192; it += F.NT) {
        const int o = (int)(it & 8191), which = (int)((it >> 13) & 1), bh = (int)(it >> 14), h = bh & 3, s = bh >> 2;
        const int c0 = s < 8 ? s * 32 : 256, n = s < 8 ? 32 : 64;
        const float dec = exp2f(128.0f * ret_log2_gamma(h));
        float st[8];
#pragma unroll
        for (int k = 0; k < 8; ++k) st[k] = 0.f;
        bf16* base = (which ? STB : STF) + (size_t)h * 65536 + (size_t)o * 8;
        for (int k = 0; k < n; ++k) {
            const int c = which ? (c0 + n - 1 - k) : (c0 + k);
            v4u* p = (v4u*)(base + (size_t)c * 4 * 65536);
            float f[8]; unpack8(*p, f);
#pragma unroll
            for (int i = 0; i < 8; ++i) st[i] = dec * st[i] + f[i];
            *p = pack8(st);
        }
    }
}
__device__ __forceinline__ void ret_out_phase(const Frame& F, CArgs& A) {
    const bf16* H = (const bf16*)(F.ws + WS_H); const bf16* STF = (const bf16*)(F.ws + WS_STF); const bf16* STB = (const bf16*)(F.ws + WS_STB);
    bf16* CC = (bf16*)(F.ws + WS_CONCAT);
    LAS bf16* RA = (LAS bf16*)F.lds; LAS bf16* RB = RA + 128 * RS; LAS bf16* RC = RA + 384 * RS;
    const int tid = F.tid, lane = F.lane, lr = lane & 15, lq = lane >> 4, wi = F.wave >> 2, wj = F.wave & 3, we = F.wave & 3;
    for (int u = F.bx; u < 1280; u += F.G) {
        const int h = u & 3, c = u >> 2, t0 = c * 128;
        const int cs = c < 256 ? (c & 31) : (c - 256), ncs = c < 256 ? 32 : 64;
        const bool has_f = cs > 0, has_b = cs < ncs - 1;
        const float lg = ret_log2_gamma(h);
        f32x4 S[4][2];
#pragma unroll
        for (int ti = 0; ti < 4; ++ti)
#pragma unroll
            for (int tj = 0; tj < 2; ++tj) S[ti][tj] = (f32x4){0.f, 0.f, 0.f, 0.f};
#pragma unroll
        for (int dh = 0; dh < 2; ++dh) {
            if (dh) __syncthreads();
#pragma unroll 1
            for (int r = 0; r < 4; ++r) { const int f = opaque(tid) + 512 * r, row = f >> 4, pc = f & 15;
                const bf16* src = H + (size_t)(t0 + row) * INW + h * 256 + dh * 128 + pc * 8;
                *(LAS v4u*)(RA + row * RS + pc * 8) = *(const v4u*)(src + COL_Q);
                *(LAS v4u*)(RB + row * RS + pc * 8) = *(const v4u*)(src + COL_K); }
            __syncthreads();
#pragma unroll
            for (int ks = 0; ks < 4; ++ks) {
                bf16x8 ka[2], qb[4];
#pragma unroll
                for (int tj = 0; tj < 2; ++tj) ka[tj] = *(const LAS bf16x8*)(RB + (32 * wj + 16 * tj + lr) * RS + 32 * ks + lq * 8);
#pragma unroll
                for (int ti = 0; ti < 4; ++ti) qb[ti] = *(const LAS bf16x8*)(RA + (64 * wi + 16 * ti + lr) * RS + 32 * ks + lq * 8);
#pragma unroll
                for (int ti = 0; ti < 4; ++ti)
#pragma unroll
                    for (int tj = 0; tj < 2; ++tj) S[ti][tj] = MFMA16(ka[tj], qb[ti], S[ti][tj]);
            }
        }
#pragma unroll
        for (int ti = 0; ti < 4; ++ti)
#pragma unroll
            for (int tj = 0; tj < 2; ++tj) {
                const int i = 64 * wi + 16 * ti + lr, j0 = 32 * wj + 16 * tj + 4 * lq; float p[4];
#pragma unroll
                for (int jj = 0; jj < 4; ++jj) { const int d = i - (j0 + jj); p[jj] = S[ti][tj][jj] * exp2f(lg * (float)(d < 0 ? -d : d)); }
                v2u w; w.x = pkbf(p[0], p[1]); w.y = pkbf(p[2], p[3]); *(LAS v2u*)(RC + i * RS + j0) = w;
            }
        __syncthreads();
        {
            const int tq = opaque(tid), jp = tq & 63, pc0 = tq >> 6; const bf16* vrow = H + (size_t)(t0 + 2 * jp) * INW + COL_V + h * 256;
            LAS unsigned* RB32 = (LAS unsigned*)RB;
#pragma unroll 1
            for (int r = 0; r < 4; ++r) { const int pc = pc0 + 8 * r; const v4u v0 = *(const v4u*)(vrow + pc * 8), v1 = *(const v4u*)(vrow + INW + pc * 8);
                const unsigned va0[4] = {v0.x, v0.y, v0.z, v0.w}, va1[4] = {v1.x, v1.y, v1.z, v1.w};
#pragma unroll
                for (int i = 0; i < 8; ++i) { const unsigned a = va0[i >> 1], b = va1[i >> 1];
                    RB32[((pc * 8 + i) * RS) / 2 + jp] = (i & 1) ? ((a >> 16) | (b & 0xffff0000u)) : ((a & 0xffffu) | (b << 16)); } }
        }
        __syncthreads();
        f32x4 O[4][4];
#pragma unroll
        for (int ti = 0; ti < 4; ++ti)
#pragma unroll
            for (int te = 0; te < 4; ++te) O[ti][te] = (f32x4){0.f, 0.f, 0.f, 0.f};
#pragma unroll
        for (int ks = 0; ks < 4; ++ks) {
            bf16x8 va[4], pb[4];
#pragma unroll
            for (int te = 0; te < 4; ++te) va[te] = *(const LAS bf16x8*)(RB + (64 * we + 16 * te + lr) * RS + 32 * ks + lq * 8);
#pragma unroll
            for (int ti = 0; ti < 4; ++ti) pb[ti] = *(const LAS bf16x8*)(RC + (64 * wi + 16 * ti + lr) * RS + 32 * ks + lq * 8);
#pragma unroll
            for (int ti = 0; ti < 4; ++ti)
#pragma unroll
                for (int te = 0; te < 4; ++te) O[ti][te] = MFMA16(va[te], pb[ti], O[ti][te]);
        }
#pragma unroll
        for (int dir = 0; dir < 2; ++dir) {
            if (dir == 0 ? has_f : has_b) {
                const bf16* St = (dir == 0 ? STF + (size_t)((c - 1) * 4 + h) * 65536 : STB + (size_t)((c + 1) * 4 + h) * 65536);
#pragma unroll
                for (int dh = 0; dh < 2; ++dh) {
                    __syncthreads();
#pragma unroll 1
                    for (int r = 0; r < 4; ++r) { const int f = opaque(tid) + 512 * r, row = f >> 4, pc = f & 15;
                        const float fac = exp2f(lg * (dir == 0 ? (float)(row + 1) : (float)(128 - row)));
                        float qf[8]; unpack8(*(const v4u*)(H + (size_t)(t0 + row) * INW + COL_Q + h * 256 + dh * 128 + pc * 8), qf);
#pragma unroll
                        for (int k = 0; k < 8; ++k) qf[k] *= fac;
                        *(LAS v4u*)(RA + row * RS + pc * 8) = pack8(qf); }
#pragma unroll 2
                    for (int r = 0; r < 8; ++r) { const int f = opaque(tid) + 512 * r, row = f >> 4, pc = f & 15;
                        *(LAS v4u*)(RB + row * RS + pc * 8) = *(const v4u*)(St + (size_t)row * 256 + dh * 128 + pc * 8); }
                    __syncthreads();
#pragma unroll
                    for (int ks = 0; ks < 4; ++ks) {
                        bf16x8 sa[4], qb[4];
#pragma unroll
                        for (int te = 0; te < 4; ++te) sa[te] = *(const LAS bf16x8*)(RB + (64 * we + 16 * te + lr) * RS + 32 * ks + lq * 8);
#pragma unroll
                        for (int ti = 0; ti < 4; ++ti) qb[ti] = *(const LAS bf16x8*)(RA + (64 * wi + 16 * ti + lr) * RS + 32 * ks + lq * 8);
#pragma unroll
                        for (int ti = 0; ti < 4; ++ti)
#pragma unroll
                            for (int te = 0; te < 4; ++te) O[ti][te] = MFMA16(sa[te], qb[ti], O[ti][te]);
                    }
                }
            }
        }
        __syncthreads();
        LAS float* RED = (LAS float*)RA;
#pragma unroll
        for (int ti = 0; ti < 4; ++ti) { float s1 = 0.f, s2 = 0.f;
#pragma unroll
            for (int te = 0; te < 4; ++te)
#pragma unroll
                for (int jj = 0; jj < 4; ++jj) { const float v = O[ti][te][jj]; s1 += v; s2 += v * v; }
            s1 += __shfl_xor(s1, 16); s1 += __shfl_xor(s1, 32); s2 += __shfl_xor(s2, 16); s2 += __shfl_xor(s2, 32);
            if (lq == 0) { RED[((64 * wi + 16 * ti + lr) * 4 + we) * 2] = s1; RED[((64 * wi + 16 * ti + lr) * 4 + we) * 2 + 1] = s2; } }
        __syncthreads();
#pragma unroll
        for (int ti = 0; ti < 4; ++ti) { const int i = 64 * wi + 16 * ti + lr;
            const f32x4 r0 = *(const LAS f32x4*)(RED + i * 8), r1 = *(const LAS f32x4*)(RED + i * 8 + 4);
            const float m = (r0[0] + r0[2] + r1[0] + r1[2]) * (1.0f / 256.0f), q = (r0[1] + r0[3] + r1[1] + r1[3]) * (1.0f / 256.0f);
            const float var = fmaxf(q - m * m, 0.f), rstd = 1.0f / sqrtf(var + GN_EPS);
#pragma unroll
            for (int te = 0; te < 4; ++te) { const int e0 = 64 * we + 16 * te + 4 * lq;
                const v2u gq = *(const v2u*)(H + (size_t)(t0 + i) * INW + COL_G + h * 256 + e0);
                const float gv[4] = {bf_lo(gq.x), bf_hi(gq.x), bf_lo(gq.y), bf_hi(gq.y)}; float ov[4];
#pragma unroll
                for (int jj = 0; jj < 4; ++jj) { const float gg = gv[jj]; ov[jj] = (gg / (1.0f + __expf(-gg))) * ((O[ti][te][jj] - m) * rstd); }
                v2u w; w.x = pkbf(ov[0], ov[1]); w.y = pkbf(ov[2], ov[3]);
                *(v2u*)(CC + (size_t)(t0 + i) * DM + 1024 + h * 256 + e0) = w; } }
        __syncthreads();
    }
}

__device__ __forceinline__ unsigned f2key(float f) { const unsigned u = __float_as_uint(f); return (u & 0x80000000u) ? ~u : (u | 0x80000000u); }
__device__ __forceinline__ float key2f(unsigned k) { const unsigned u = (k & 0x80000000u) ? (k & 0x7fffffffu) : ~k; return __uint_as_float(u); }
#define TK_CE(a, b) do { const unsigned hi_ = (a) > (b) ? (a) : (b), lo_ = (a) > (b) ? (b) : (a); (a) = hi_; (b) = lo_; } while (0)
__device__ __forceinline__ void bitonic_merge16(unsigned (&v)[16]) {
#pragma unroll
    for (int j = 8; j > 0; j >>= 1)
#pragma unroll
        for (int i = 0; i < 16; ++i) { const int l = i ^ j; if (l > i) TK_CE(v[i], v[l]); }
}
__device__ __forceinline__ void bitonic_sort16(unsigned (&v)[16]) {
#pragma unroll
    for (int k = 2; k <= 16; k <<= 1)
#pragma unroll
        for (int j = k >> 1; j > 0; j >>= 1)
#pragma unroll
            for (int i = 0; i < 16; ++i) { const int l = i ^ j; if (l > i) { if ((i & k) == 0) TK_CE(v[i], v[l]); else TK_CE(v[l], v[i]); } }
}
__device__ __forceinline__ void topk_phase(const Frame& F, CArgs& A) {
    const float* SC = (const float*)(F.ws + WS_H); int* IDX = (int*)(F.ws + WS_IDX); float* GATE = (float*)(F.ws + WS_GATE);
    LAS unsigned* LK = (LAS unsigned*)F.lds;
    const int tid = F.tid, tl = tid >> 4, hp = tid & 15;
    for (int blk = F.bx; blk < NTOK / 32; blk += F.G) {
        const int t = blk * 32 + tl;
        const float* row = SC + (size_t)t * DM + hp * 128;
        unsigned run[16];
#pragma unroll
        for (int k = 0; k < 16; ++k) run[k] = 0u;
        f32x4 cur[8], nxt[8];
#pragma unroll
        for (int q = 0; q < 8; ++q) cur[q] = *(const f32x4*)(row + q * 4);
        for (int n32 = 0; n32 < 4; ++n32) {
            if (n32 < 3) {
#pragma unroll
                for (int q = 0; q < 8; ++q) nxt[q] = *(const f32x4*)(row + (n32 + 1) * 32 + q * 4);
            }
#pragma unroll
            for (int hc = 0; hc < 2; ++hc) {
                unsigned ch[16];
#pragma unroll
                for (int q = 0; q < 4; ++q)
#pragma unroll
                    for (int e = 0; e < 4; ++e) { const int n = n32 * 32 + hc * 16 + q * 4 + e; ch[q * 4 + e] = (f2key(cur[hc * 4 + q][e]) & ~127u) | (unsigned)(127 - n); }
                bitonic_sort16(ch);
#pragma unroll
                for (int i = 0; i < 16; ++i) run[i] = run[i] > ch[15 - i] ? run[i] : ch[15 - i];
                bitonic_merge16(run);
            }
#pragma unroll
            for (int q = 0; q < 8; ++q) cur[q] = nxt[q];
        }
#pragma unroll
        for (int k = 0; k < 16; ++k) LK[tid * 17 + k] = run[k];
        __syncthreads();
        if ((hp & 1) == 0) {
            float a[16], b[16];
#pragma unroll
            for (int k = 0; k < 16; ++k) { a[k] = key2f(LK[tid * 17 + k] & ~127u); b[k] = key2f(LK[(tid + 1) * 17 + k] & ~127u); }
            unsigned sk[16];
#pragma unroll
            for (int k = 0; k < 16; ++k) sk[k] = 0u;
#pragma unroll
            for (int i = 0; i < 16; ++i)
#pragma unroll
                for (int j = 0; j < 16; ++j) if ((i + 1) * (j + 1) <= 16) {
                    unsigned key = (f2key(a[i] + b[j]) & ~255u) | (unsigned)(255 - (i * 16 + j));
#pragma unroll
                    for (int k = 0; k < 16; ++k) { const unsigned hi = sk[k] > key ? sk[k] : key, lo = sk[k] > key ? key : sk[k]; sk[k] = hi; key = lo; }
                }
            float e[16], sum = 0.f; const float s0 = key2f(sk[0] & ~255u);
#pragma unroll
            for (int k = 0; k < 16; ++k) { e[k] = __expf(key2f(sk[k] & ~255u) - s0); sum += e[k]; }
            const float inv = 1.0f / sum; const int head = hp >> 1;
#pragma unroll
            for (int k = 0; k < 16; ++k) {
                const int cell = 255 - (int)(sk[k] & 255u);
                const int i1 = 127 - (int)(LK[tid * 17 + (cell >> 4)] & 127u), i2 = 127 - (int)(LK[(tid + 1) * 17 + (cell & 15)] & 127u);
                IDX[(size_t)t * 128 + head * 16 + k] = i1 * 128 + i2;
                GATE[(size_t)t * 128 + head * 16 + k] = e[k] * inv;
            }
        }
        __syncthreads();
    }
}
__device__ __forceinline__ void peer_gather_phase(const Frame& F, CArgs& A, int l) {
    const unsigned char* U8 = F.ws + WS_U8 + (size_t)l * NEXP * DM; const unsigned char* V8 = F.ws + WS_V8 + (size_t)l * NEXP * DM;
    const float* USC = (const float*)(F.ws + WS_USC) + (size_t)l * NEXP; const float* VSC = (const float*)(F.ws + WS_VSC) + (size_t)l * NEXP;
    const int* IDX = (const int*)(F.ws + WS_IDX); const float* GATE = (const float*)(F.ws + WS_GATE);
    const float* g2 = A.in[I_LN2G] + (size_t)l * DM; const float* b2 = A.in[I_LN2B] + (size_t)l * DM;
    bf16* XN = (bf16*)(F.ws + WS_XN);
    const int lane = F.lane, slot = 8 * (lane & 7) + (lane >> 3);
    for (int t = F.gw; t < NTOK; t += F.NGW) {
        float* xrow = F.out + (size_t)t * DM;
        f32x2v x[2][8];
#pragma unroll
        for (int c = 0; c < 2; ++c)
#pragma unroll
            for (int q = 0; q < 4; ++q) { const f32x4 a = *(const f32x4*)(xrow + (c * 64 + lane) * 16 + q * 4); x[c][2 * q] = (f32x2v){a[0], a[1]}; x[c][2 * q + 1] = (f32x2v){a[2], a[3]}; }
        const int idx0 = IDX[(size_t)t * 128 + slot], idx1 = IDX[(size_t)t * 128 + 64 + slot];
        v4u BU[8][2];
        const unsigned loff0 = (unsigned)lane * 16u, loff1 = (unsigned)lane * 16u + 1024u;
#define G_ROW_U(i, b) (U8 + (size_t)(unsigned)__builtin_amdgcn_readlane(((b) >> 3) ? idx1 : idx0, (i) * 8 + ((b) & 7)) * DM)
#define G_ROW_V(i, b) (V8 + (size_t)(unsigned)__builtin_amdgcn_readlane(((b) >> 3) ? idx1 : idx0, ((b) & 7) * 8 + (i)) * DM)
#define G_REQ(i, rowptr) do { const unsigned char* r_ = (rowptr); BU[i][0] = *(const v4u*)(r_ + loff0); BU[i][1] = *(const v4u*)(r_ + loff1); } while (0)
#define G_DOT(i, dst) do { f32x2v s2_ = (f32x2v){0.f, 0.f}; \
            _Pragma("unroll") for (int c = 0; c < 2; ++c) _Pragma("unroll") for (int q = 0; q < 4; ++q) { s2_ += __builtin_amdgcn_cvt_pk_f32_fp8((int)BU[i][c][q], false) * x[c][2 * q]; s2_ += __builtin_amdgcn_cvt_pk_f32_fp8((int)BU[i][c][q], true) * x[c][2 * q + 1]; } \
            dst = s2_[0] + s2_[1]; } while (0)
#define G_REDUCE(b) do { \
            _Pragma("unroll") for (int i = 0; i < 4; ++i) { const float mine = b5 ? part[i + 4] : part[i], send = b5 ? part[i] : part[i + 4]; part[i] = mine + __shfl_xor(send, 32); } \
            _Pragma("unroll") for (int i = 0; i < 2; ++i) { const float mine = b4 ? part[i + 2] : part[i], send = b4 ? part[i] : part[i + 2]; part[i] = mine + __shfl_xor(send, 16); } \
            { const float mine = b3 ? part[1] : part[0], send = b3 ? part[0] : part[1]; part[0] = mine + __shfl_xor(send, 8); } \
            float v_ = part[0]; v_ += __shfl_xor(v_, 4); v_ += __shfl_xor(v_, 2); v_ += __shfl_xor(v_, 1); \
            const bool mine_ = (lane & 7) == ((b) & 7); hval0 = (mine_ && ((b) >> 3) == 0) ? v_ : hval0; hval1 = (mine_ && ((b) >> 3) == 1) ? v_ : hval1; } while (0)
        const bool b5 = (lane & 32) != 0, b4 = (lane & 16) != 0, b3 = (lane & 8) != 0;
        float hval0 = 0.f, hval1 = 0.f;
#pragma unroll
        for (int i = 0; i < 8; ++i) G_REQ(i, G_ROW_U(i, 0));
        for (int b = 0; b < 15; ++b) {
            float part[8];
#pragma unroll
            for (int i = 0; i < 8; ++i) { G_DOT(i, part[i]); G_REQ(i, G_ROW_U(i, b + 1)); }
            G_REDUCE(b);
        }
        {
            float part[8];
#pragma unroll
            for (int i = 0; i < 8; ++i) { G_DOT(i, part[i]); G_REQ(i, G_ROW_V(i, 0)); }
            G_REDUCE(15);
        }
        const float gate0 = GATE[(size_t)t * 128 + slot], gate1 = GATE[(size_t)t * 128 + 64 + slot];
        const float usc0 = USC[idx0], usc1 = USC[idx1], vsc0 = VSC[idx0], vsc1 = VSC[idx1];
        const float w0 = gate0 * gelu_erf(hval0 * usc0) * vsc0, w1 = gate1 * gelu_erf(hval1 * usc1) * vsc1;
        f32x2v acc[2][8];
#pragma unroll
        for (int c = 0; c < 2; ++c)
#pragma unroll
            for (int k = 0; k < 8; ++k) acc[c][k] = (f32x2v){0.f, 0.f};
#define G_AXPY(i, b) do { const float w_ = __uint_as_float((unsigned)__builtin_amdgcn_readlane((int)__float_as_uint(((b) >> 3) ? w1 : w0), ((b) & 7) * 8 + (i))); const f32x2v w2_ = (f32x2v){w_, w_}; \
            _Pragma("unroll") for (int c = 0; c < 2; ++c) _Pragma("unroll") for (int q = 0; q < 4; ++q) { acc[c][2 * q] += w2_ * __builtin_amdgcn_cvt_pk_f32_fp8((int)BU[i][c][q], false); acc[c][2 * q + 1] += w2_ * __builtin_amdgcn_cvt_pk_f32_fp8((int)BU[i][c][q], true); } } while (0)
        for (int b = 0; b < 15; ++b) {
#pragma unroll
            for (int i = 0; i < 8; ++i) { G_AXPY(i, b); G_REQ(i, G_ROW_V(i, b + 1)); }
        }
#pragma unroll
        for (int i = 0; i < 8; ++i) G_AXPY(i, 15);
#undef G_ROW_U
#undef G_ROW_V
#undef G_REQ
#undef G_DOT
#undef G_REDUCE
#undef G_AXPY
        const int le = opaque(lane);
        float s = 0.f;
#pragma unroll
        for (int c = 0; c < 2; ++c)
#pragma unroll
            for (int k = 0; k < 8; ++k) { const f32x2v xr = *(const f32x2v*)(xrow + (c * 64 + le) * 16 + 2 * k);
                acc[c][k] = xr * ALPHA + acc[c][k]; s += acc[c][k][0] + acc[c][k][1]; }
        const float mean = wave_sum(s) * (1.0f / DM); float s2 = 0.f;
#pragma unroll
        for (int c = 0; c < 2; ++c)
#pragma unroll
            for (int k = 0; k < 8; ++k) { acc[c][k] = acc[c][k] - mean; s2 += acc[c][k][0] * acc[c][k][0] + acc[c][k][1] * acc[c][k][1]; }
        const float rstd = 1.0f / sqrtf(wave_sum(s2) * (1.0f / DM) + LN_EPS);
#pragma unroll
        for (int c = 0; c < 2; ++c) { const int col = (c * 64 + le) * 16;
#pragma unroll
            for (int h8 = 0; h8 < 2; ++h8) { float o[8];
#pragma unroll
                for (int q = 0; q < 2; ++q) { const f32x4 gg = *(const f32x4*)(g2 + col + h8 * 8 + q * 4), bb = *(const f32x4*)(b2 + col + h8 * 8 + q * 4);
                    const f32x2v a0 = acc[c][h8 * 4 + 2 * q], a1 = acc[c][h8 * 4 + 2 * q + 1];
                    o[4 * q] = a0[0] * rstd * gg[0] + bb[0]; o[4 * q + 1] = a0[1] * rstd * gg[1] + bb[1]; o[4 * q + 2] = a1[0] * rstd * gg[2] + bb[2]; o[4 * q + 3] = a1[1] * rstd * gg[3] + bb[3];
                    *(f32x4*)(xrow + col + h8 * 8 + q * 4) = (f32x4){o[4 * q], o[4 * q + 1], o[4 * q + 2], o[4 * q + 3]}; }
                *(v4u*)(XN + (size_t)t * DM + col + h8 * 8) = pack8(o); } }
    }
}

#ifndef DUP_MASK
#define DUP_MASK 0
#endif
#ifndef PHASE_TEST_ONLY
__global__ void __launch_bounds__(NTHR, 2) fwd_kernel(Args A) {
    extern __shared__ __attribute__((aligned(16))) unsigned char lds_raw[];
#define MKFRAME() Frame F; CArgs& KA = *(CArgs*)opaque_u64((unsigned long long)__builtin_amdgcn_kernarg_segment_ptr()); { F.lds = (LAS unsigned char*)lds_raw; F.tid = opaque((int)threadIdx.x); F.lane = F.tid & 63; F.wave = __builtin_amdgcn_readfirstlane(F.tid >> 6); \
        const int bx_ = opaque_s((int)blockIdx.x); F.G = gridDim.x; F.gw = bx_ * NWAVES + F.wave; F.NGW = F.G * NWAVES; F.gtid = (size_t)bx_ * NTHR + F.tid; F.NT = (size_t)F.G * NTHR; F.out = (float*)opaque_p(KA.out); F.ws = (unsigned char*)opaque_p(KA.ws); F.bx = bx_; } \
        bf16* XN = (bf16*)(F.ws + WS_XN); bf16* H = (bf16*)(F.ws + WS_H); bf16* CC = (bf16*)(F.ws + WS_CONCAT); (void)XN; (void)H; (void)CC;
    volatile LAS unsigned* MISC = (volatile LAS unsigned*)((LAS unsigned char*)lds_raw + LDS_MISC);
    if (threadIdx.x < 64) MISC[threadIdx.x] = 0u;
    __syncthreads();
    XcdBarrier bar = xcd_barrier_post((unsigned*)(A.ws + WS_CTL) + CW_BAR + A.li * XCD_BAR_WORDS, MISC + 8);
    const int lo = A.ph_lo, hi = A.ph_hi;
#define IN(k) (lo <= (k) && (k) < hi)
#define SEAM(k) do { if (lo <= (k) && (k) + 1 < hi) xcd_barrier(bar); } while (0)

    if (IN(0)) { MKFRAME(); p0_prologue(F, KA); } SEAM(0);

    for (int l = 0; l < NLAYER; ++l) {
        const int pb = 1 + l * 10;
        if (IN(pb + 0)) { MKFRAME();
            pg8::Gemm g{XN, (const bf16*)(F.ws + WS_WIN) + (size_t)l * INW * DM, NTOK, INW, DM}; pg8::StaticOrder S; S.init(NTOK, INW, F.G, F.bx);
            EpiStoreBf16 E{H, INW};
            pg8::gemm_phase<EpiStoreBf16, pg8::StaticOrder, true, true>(F.lds, g, S, E);
            if (DUP_MASK & 64) { pg8::gemm_phase<EpiStoreBf16, pg8::StaticOrder, true, true>(F.lds, g, S, E); }
        } SEAM(pb + 0);
        if (IN(pb + 1)) { MKFRAME(); s5_pass1(F, KA, l); pool_phase(F, KA); if (DUP_MASK & 1) { s5_pass1(F, KA, l); } if (DUP_MASK & 2) { pool_phase(F, KA); } rotary_phase(F, KA); } SEAM(pb + 1);
        if (IN(pb + 2)) { MKFRAME(); s5_carry(F, KA, l); __syncthreads(); ret_state_phase(F, KA); if (DUP_MASK & 4) { ret_state_phase(F, KA); } } SEAM(pb + 2);
        if (IN(pb + 3)) { MKFRAME(); s5_pass3(F, KA, l); if (DUP_MASK & 8) { s5_pass3(F, KA, l); } ret_prefix_phase(F, KA); } SEAM(pb + 3);
        if (IN(pb + 4)) { MKFRAME();
            __syncthreads();
            ret_out_phase(F, KA);
            if (DUP_MASK & 16) { ret_out_phase(F, KA); }
            {
                pg8::Gemm g{(const bf16*)(F.ws + WS_BUFY), (const bf16*)(F.ws + WS_WGLU) + (size_t)l * 512 * 512, NTOK, 512, 512}; pg8::StaticOrder S; S.init(NTOK, 512, F.G, F.bx);
                EpiGlu E{(const bf16*)(F.ws + WS_BUFY), 512, CC, DM, KA.in[I_BGLU] + (size_t)l * 512};
                pg8::gemm_phase<EpiGlu, pg8::StaticOrder, true, true>(F.lds, g, S, E);
            }
            {
                pg8::Gemm g{(const bf16*)(F.ws + WS_BUFP), (const bf16*)(F.ws + WS_WPOOL) + (size_t)l * 512 * 512, NTOK, 512, 512}; pg8::StaticOrder S; S.init(NTOK, 512, F.G, F.bx);
                EpiScaleBf16 E{CC + 512, DM, KA.in[I_POOLS] + (size_t)l * 512};
                pg8::gemm_phase<EpiScaleBf16, pg8::StaticOrder, true, true>(F.lds, g, S, E);
            }
        } SEAM(pb + 4);
        if (IN(pb + 5)) { MKFRAME();
            pg8::Gemm g{CC, (const bf16*)(F.ws + WS_WOUT) + (size_t)l * DM * DM, NTOK, DM, DM}; pg8::StaticOrder S; S.init(NTOK, DM, F.G, F.bx);
            EpiResid E{F.out, DM, ALPHA};
            pg8::gemm_phase<EpiResid, pg8::StaticOrder, true, true>(F.lds, g, S, E);
        } SEAM(pb + 5);
        if (IN(pb + 6)) { MKFRAME();
            for (int t = F.gw; t < NTOK; t += F.NGW) ln_row(F.out + (size_t)t * DM, KA.in[I_LN1G] + (size_t)l * DM, KA.in[I_LN1B] + (size_t)l * DM, F.out + (size_t)t * DM, XN + (size_t)t * DM, F.lane);
        } SEAM(pb + 6);
        if (IN(pb + 7)) { MKFRAME();
            pg8::Gemm g{XN, (const bf16*)(F.ws + WS_WS) + (size_t)l * DM * DM, NTOK, DM, DM}; pg8::StaticOrder S; S.init(NTOK, DM, F.G, F.bx);
            EpiStoreF32 E{(float*)(F.ws + WS_H), DM};
            pg8::gemm_phase<EpiStoreF32, pg8::StaticOrder, true, true>(F.lds, g, S, E);
            if (DUP_MASK & 128) { pg8::gemm_phase<EpiStoreF32, pg8::StaticOrder, true, true>(F.lds, g, S, E); }
        } SEAM(pb + 7);
        if (IN(pb + 8)) { MKFRAME(); __syncthreads(); topk_phase(F, KA); if (DUP_MASK & 32) { topk_phase(F, KA); } } SEAM(pb + 8);
        if (IN(pb + 9)) { MKFRAME(); peer_gather_phase(F, KA, l); } SEAM(pb + 9);
    }
#undef IN
#undef SEAM
}


#ifndef DBG_STOP
#define DBG_STOP NPHASE
#endif
#ifndef DBG_DUMP
#define DBG_DUMP 0
#endif
__global__ void dbg_dump_kernel(float* out, const unsigned char* ws, int mode) {
    const size_t n = (size_t)NTOK * DM;
    for (size_t i = (size_t)blockIdx.x * blockDim.x + threadIdx.x; i < n; i += (size_t)gridDim.x * blockDim.x) {
        float v = 0.f;
        if (mode == 1) v = bf_lo(((const bf16*)(ws + WS_H))[i]);
        else if (mode == 2) v = bf_lo(((const bf16*)(ws + WS_CONCAT))[i]);
        else if (mode == 3) v = bf_lo(((const bf16*)(ws + WS_BUFY))[i % ((size_t)NTOK * 1024)]);
        else if (mode == 4) v = bf_lo(((const bf16*)(ws + WS_STF))[i]);
        else if (mode == 5) v = ((const float*)(ws + WS_H))[i];
        else if (mode == 6) v = (i < (size_t)NTOK * 128) ? (float)((const int*)(ws + WS_IDX))[i] : ((i < (size_t)NTOK * 256) ? ((const float*)(ws + WS_GATE))[i - (size_t)NTOK * 128] : 0.f);
        else if (mode == 7) v = bf_lo(((const bf16*)(ws + WS_XN))[i]);
        else if (mode == 8) v = bf_lo(((const bf16*)(ws + WS_STB))[i]);
        else if (mode == 9) v = bf_lo(((const bf16*)(ws + WS_H))[i + (size_t)NTOK * DM]);
        else if (mode == 10) v = bf_lo(((const bf16*)(ws + WS_WIN))[i % ((size_t)72 * 1024 * 1024)]);
        else if (mode == 11) v = ((const float*)(ws + WS_S5ST))[i % ((size_t)5 * 1024 * 1024)];
        else if (mode == 12) v = bf_lo(((const bf16*)(ws + WS_H))[i]) + bf_lo(((const bf16*)(ws + WS_H))[i + (size_t)NTOK * DM]) + bf_lo(((const bf16*)(ws + WS_BUFP))[i % ((size_t)NTOK * 512)]) + ((const float*)(ws + WS_S5ST))[i % ((size_t)5 * 1024 * 1024)];
        else if (mode == 13) v = bf_lo(((const bf16*)(ws + WS_STF))[i]) + bf_lo(((const bf16*)(ws + WS_STB))[i]) + ((const float*)(ws + WS_S5ST))[i % ((size_t)5 * 1024 * 1024)];
        else if (mode == 14) v = bf_lo(((const bf16*)(ws + WS_STF))[i]) + bf_lo(((const bf16*)(ws + WS_STB))[i]) + bf_lo(((const bf16*)(ws + WS_BUFY))[i % ((size_t)NTOK * 512)]);
        else if (mode == 15) v = bf_lo(((const bf16*)(ws + WS_H))[i]) + bf_lo(((const bf16*)(ws + WS_H))[i + (size_t)NTOK * DM]) + bf_lo(((const bf16*)(ws + WS_H))[i + (size_t)NTOK * 3072]);
        out[i] = v;
    }
}
#ifndef MK_ONE_LAUNCH
#define MK_ONE_LAUNCH 0
#endif
extern "C" void kernel_launch(void* const* d_in, const int* in_sizes, int n_in, void* d_out, int out_size, void* d_ws, size_t ws_size, hipStream_t stream) {
    static int grid = 0;
    if (grid == 0) {
        if (n_in != 26 || out_size != NTOK * DM || ws_size < WS_END) { fprintf(stderr, "kernel_launch: unexpected shapes (n_in %d out %d ws %zu)\n", n_in, out_size, ws_size); grid = -1; return; }
        int dev = 0, cus = 0, per_cu = 0;
        if (hipGetDevice(&dev) != hipSuccess || hipDeviceGetAttribute(&cus, hipDeviceAttributeMultiprocessorCount, dev) != hipSuccess) { grid = -1; return; }
        if (hipFuncSetAttribute((const void*)fwd_kernel, hipFuncAttributeMaxDynamicSharedMemorySize, LDS_BYTES) != hipSuccess) { fprintf(stderr, "kernel_launch: hipFuncSetAttribute failed\n"); grid = -1; return; }
        if (hipOccupancyMaxActiveBlocksPerMultiprocessor(&per_cu, (const void*)fwd_kernel, NTHR, LDS_BYTES) != hipSuccess || per_cu < 1) { fprintf(stderr, "kernel_launch: occupancy query says %d\n", per_cu); grid = -1; (void)hipGetLastError(); return; }
        (void)hipGetLastError();
        grid = cus;
    }
    if (grid < 0) return;
    if (hipMemsetAsync((char*)d_ws + WS_CTL, 0, CTL_ZERO_BYTES, stream) != hipSuccess) return;
    Args a{};
    for (int i = 0; i < 26; ++i) a.in[i] = (const float*)d_in[i];
    a.out = (float*)d_out; a.ws = (unsigned char*)d_ws; a.pad = 0;
#if MK_ONE_LAUNCH
    a.ph_lo = 0; a.ph_hi = NPHASE; a.li = 0;
    hipLaunchKernelGGL(fwd_kernel, dim3(grid), dim3(NTHR), LDS_BYTES, stream, a);
#else
    for (int p = 0; p < DBG_STOP; ++p) { a.ph_lo = p; a.ph_hi = p + 1; a.li = p; hipLaunchKernelGGL(fwd_kernel, dim3(grid), dim3(NTHR), LDS_BYTES, stream, a); }
#endif
    if (DBG_DUMP) hipLaunchKernelGGL(dbg_dump_kernel, dim3(2048), dim3(256), 0, stream, (float*)d_out, (const unsigned char*)d_ws, DBG_DUMP);
}
#endif
```

```cpp
#include <hip/hip_runtime.h>
#include <cstdio>
#include <cstdint>
#include <cmath>
__device__ __forceinline__ int opaque(int v) { asm volatile("" : "+v"(v)); return v; }
__device__ __forceinline__ int opaque_s(int v) { asm volatile("" : "+s"(v)); return v; }
__device__ __forceinline__ void* opaque_p(void* p) { asm volatile("" : "+s"(p)); return p; }
__device__ __forceinline__ unsigned long long opaque_u64(unsigned long long v) { asm volatile("" : "+s"(v)); return v; }
#ifndef PEER_FP4
#define PEER_FP4 1
#endif
#define MK_ONE_LAUNCH 1
namespace pg8 {
#define PG8_LAS __attribute__((address_space(3)))
typedef unsigned short bf16_t;
typedef short bf16x8 __attribute__((ext_vector_type(8)));
typedef float f32x4 __attribute__((ext_vector_type(4)));
typedef unsigned u32x4 __attribute__((ext_vector_type(4)));
constexpr int BM = 256, BK = 64, HALF = 128, HTB = HALF * BK * 2  , STAGE_BYTES = 8 * HTB, NXCD = 8, WGM = 8;

__host__ __device__ __forceinline__ int lds_byte(int r, int c) { const int st = (r >> 4) * 2 + (c >> 5), rr = r & 15, cc = c & 31, ob = rr * 64 + cc * 2; return st * 1024 + (ob ^ (((ob >> 9) & 1) << 5)); }
__host__ __device__ __forceinline__ void stage_rc(int b, int& R, int& C) { const int st = b / 1024, sb = b % 1024, swz = sb ^ (((sb >> 9) & 1) << 5); R = (st >> 1) * 16 + swz / 64; C = (st & 1) * 32 + (swz % 64) / 2; }
__host__ __device__ __forceinline__ int perm32(int rho) { const int n = rho >> 4, i = rho & 15; return 8 * (i >> 2) + 4 * n + (i & 3); }

struct Unit { int pm, pn; };
struct Gemm { const bf16_t* A; const bf16_t* Bt; int M, N, K; };

struct StaticOrder {
    int nM, nN, nwg, G, c;
    __host__ __device__ void init(int M, int N, int G_, int c_) { nM = M / BM; nN = N / BM; nwg = nM * nN; G = G_; c = c_; }
    __host__ __device__ bool next(int i, Unit& u) const {
        const long L = (long)i * G + c; if (L >= nwg) return false;
        int wgid = (int)L; { const int q = nwg / NXCD, r = nwg % NXCD, xcd = wgid % NXCD, off = wgid / NXCD; wgid = (xcd < r ? xcd * (q + 1) : r * (q + 1) + (xcd - r) * q) + off; }
        const int nig = WGM * nN, gid = wgid / nig, fm = gid * WGM, gsz = (nM - fm) < WGM ? (nM - fm) : WGM;
        u.pm = fm + ((wgid % nig) % gsz); u.pn = (wgid % nig) / gsz; return true;
    }
    __device__ __forceinline__ void a_ready(const Unit&) const {}
    __device__ __forceinline__ void done(const Unit&) const {}
};
__device__ __forceinline__ unsigned cvt_pk_bf16(float lo, float hi) { unsigned r; asm volatile("v_cvt_pk_bf16_f32 %0, %1, %2" : "=v"(r) : "v"(lo), "v"(hi)); return r; }
typedef float f32x2 __attribute__((ext_vector_type(2)));
template <class Epi, class Sched, bool ALIGN_EPI = false, bool SP2 = false>
__device__ __forceinline__ void gemm_phase(PG8_LAS unsigned char* lds, const Gemm g, const Sched& S, const Epi& E) {
    const int tid = opaque((int)threadIdx.x), wid = __builtin_amdgcn_readfirstlane(tid >> 6), lane = tid & 63, wr = wid >> 2, wc = wid & 3, fr = lane & 15, fq = lane >> 4;
    const int K = g.K, nt = K / BK;
    unsigned voffA[2], voffB[2];
#pragma unroll
    for (int i = 0; i < 2; ++i) { int R, C; stage_rc(tid * 16 + i * 8192, R, C); const int Rb = Epi::PERM ? ((R & ~31) + perm32(R & 31)) : R;
        voffA[i] = (unsigned)(R * K + C) * 2u; voffB[i] = (unsigned)(Rb * K + C) * 2u; }
    const size_t kstep = (size_t)(BK * 2);
    const size_t hstep = (size_t)HALF * K * 2;
    const size_t tstep = 2 * hstep;
    const unsigned ldsw = (unsigned)wid * 1024u;
    const int aoff = lds_byte(wr * 64 + fr, fq * 8), boff = lds_byte(wc * 32 + fr, fq * 8);
#define PG8_SA(b, h) (((b) * 2 + (h)) * HTB)
#define PG8_SB(b, h) ((4 + (b) * 2 + (h)) * HTB)
#define PG8_STAGE(bufoff, gbase, voff) do { _Pragma("unroll") for (int _i = 0; _i < 2; ++_i) \
        __builtin_amdgcn_global_load_lds((const unsigned*)((const char*)(gbase) + (voff)[_i]), (PG8_LAS unsigned*)(lds + (bufoff) + ldsw + _i * 8192), 16, 0, 0); } while (0)
#define PG8_LDA(dst, b, h) do { _Pragma("unroll") for (int m = 0; m < 4; ++m) _Pragma("unroll") for (int k = 0; k < 2; ++k) dst[m][k] = *(const PG8_LAS bf16x8*)(lds + PG8_SA(b, h) + aoff + m * 2048 + k * 1024); } while (0)
#define PG8_LDB(dst, b, h) do { _Pragma("unroll") for (int n = 0; n < 2; ++n) _Pragma("unroll") for (int k = 0; k < 2; ++k) dst[n][k] = *(const PG8_LAS bf16x8*)(lds + PG8_SB(b, h) + boff + n * 2048 + k * 1024); } while (0)
#define PG8_MMA(ai, bj, At, Bt) do { __builtin_amdgcn_s_setprio(1); _Pragma("unroll") for (int m = 0; m < 4; ++m) _Pragma("unroll") for (int n = 0; n < 2; ++n) _Pragma("unroll") for (int k = 0; k < 2; ++k) \
        acc[ai][bj][m][n] = __builtin_amdgcn_mfma_f32_16x16x32_bf16(Bt[n][k], At[m][k], acc[ai][bj][m][n], 0, 0, 0); __builtin_amdgcn_s_setprio(0); } while (0)
#define PG8_WAIT_V(n) asm volatile("s_waitcnt vmcnt(" #n ")" ::: "memory")
#define PG8_WAIT_L(n) asm volatile("s_waitcnt lgkmcnt(" #n ")" ::: "memory")
#define PG8_BAR __builtin_amdgcn_s_barrier()
#define PG8_SCHED __builtin_amdgcn_sched_barrier(0)
    Unit cur, nxt; int ui = 0;
    if (!S.next(0, cur)) return;
    f32x4 acc[2][2][4][2];
#pragma unroll
    for (int a = 0; a < 2; ++a)
#pragma unroll
        for (int b = 0; b < 2; ++b)
#pragma unroll
            for (int m = 0; m < 4; ++m)
#pragma unroll
                for (int n = 0; n < 2; ++n) acc[a][b][m][n] = (f32x4){0.f, 0.f, 0.f, 0.f};
    bf16x8 At[4][2], B0[2][2], B1[2][2];
    const char* cA = (const char*)g.A + (size_t)cur.pm * tstep; const char* cB = (const char*)g.Bt + (size_t)cur.pn * tstep;
    S.a_ready(cur);
    if constexpr (SP2) {
        PG8_STAGE(PG8_SB(0, 0), cB, voffB); PG8_STAGE(PG8_SB(0, 1), cB + hstep, voffB); PG8_STAGE(PG8_SA(0, 0), cA, voffA); PG8_STAGE(PG8_SA(0, 1), cA + hstep, voffA);
        if (wr == 1) PG8_BAR;
        PG8_WAIT_V(2); PG8_BAR;
        PG8_STAGE(PG8_SB(1, 0), cB + kstep, voffB); PG8_STAGE(PG8_SA(1, 0), cA + kstep, voffA); PG8_STAGE(PG8_SB(1, 1), cB + hstep + kstep, voffB);
        PG8_WAIT_V(6); PG8_BAR;
    } else {
        PG8_STAGE(PG8_SB(0, 0), cB, voffB); PG8_STAGE(PG8_SA(0, 0), cA, voffA); PG8_STAGE(PG8_SB(0, 1), cB + hstep, voffB); PG8_STAGE(PG8_SA(0, 1), cA + hstep, voffA);
        if (wr == 1) PG8_BAR;
        PG8_WAIT_V(4); PG8_BAR;
        PG8_STAGE(PG8_SB(1, 0), cB + kstep, voffB); PG8_STAGE(PG8_SA(1, 0), cA + kstep, voffA); PG8_STAGE(PG8_SB(1, 1), cB + hstep + kstep, voffB);
        PG8_WAIT_V(6); PG8_BAR;
    }
    for (;;) {
        const bool has_next = S.next(ui + 1, nxt);
        const char* nA = has_next ? (const char*)g.A + (size_t)nxt.pm * tstep : cA; const char* nB = has_next ? (const char*)g.Bt + (size_t)nxt.pn * tstep : cB;
        for (int t = 0; t < nt; t += 2) {
            const bool last = (t == nt - 2);
            const char* a1 = cA + (size_t)(t + 1) * kstep;
            const char* a2 = last ? nA : cA + (size_t)(t + 2) * kstep; const char* b2 = last ? nB : cB + (size_t)(t + 2) * kstep;
            const char* a3 = a2 + kstep; const char* b3 = b2 + kstep;
            if (last && has_next) S.a_ready(nxt);
            if constexpr (SP2) {
            PG8_LDB(B0, 0, 0); PG8_LDB(B1, 0, 1); PG8_SCHED; PG8_LDA(At, 0, 0); PG8_STAGE(PG8_SA(1, 1), a1 + hstep, voffA);
            PG8_WAIT_V(8); PG8_WAIT_L(0); PG8_BAR; PG8_MMA(0, 0, At, B0); PG8_MMA(0, 1, At, B1); PG8_BAR; PG8_SCHED;
            PG8_LDA(At, 0, 1); PG8_STAGE(PG8_SB(0, 0), b2, voffB); PG8_STAGE(PG8_SB(0, 1), b2 + hstep, voffB); PG8_STAGE(PG8_SA(0, 0), a2, voffA);
            PG8_WAIT_V(8); PG8_WAIT_L(0); PG8_BAR; PG8_MMA(1, 0, At, B0); PG8_MMA(1, 1, At, B1); PG8_BAR; PG8_SCHED;
            PG8_LDB(B0, 1, 0); PG8_LDB(B1, 1, 1); PG8_SCHED; PG8_LDA(At, 1, 0); PG8_STAGE(PG8_SA(0, 1), a2 + hstep, voffA);
            PG8_WAIT_V(8); PG8_WAIT_L(0); PG8_BAR; PG8_MMA(0, 0, At, B0); PG8_MMA(0, 1, At, B1); PG8_BAR; PG8_SCHED;
            PG8_LDA(At, 1, 1); PG8_STAGE(PG8_SB(1, 0), b3, voffB); PG8_STAGE(PG8_SB(1, 1), b3 + hstep, voffB); PG8_STAGE(PG8_SA(1, 0), a3, voffA);
            PG8_WAIT_V(8); PG8_WAIT_L(0); PG8_BAR; PG8_MMA(1, 0, At, B0); PG8_MMA(1, 1, At, B1); PG8_BAR; PG8_SCHED;
            } else {
            PG8_LDB(B0, 0, 0); PG8_SCHED; PG8_LDA(At, 0, 0); PG8_STAGE(PG8_SA(1, 1), a1 + hstep, voffA);
            PG8_WAIT_L(8); PG8_BAR; PG8_WAIT_L(0); PG8_MMA(0, 0, At, B0); PG8_BAR; PG8_SCHED;
            PG8_LDB(B1, 0, 1); PG8_STAGE(PG8_SB(0, 0), b2, voffB);
            PG8_BAR; PG8_WAIT_L(0); PG8_MMA(0, 1, At, B1); PG8_BAR;
            PG8_LDA(At, 0, 1); PG8_STAGE(PG8_SA(0, 0), a2, voffA);
            PG8_BAR; PG8_WAIT_L(0); PG8_MMA(1, 0, At, B0); PG8_BAR; PG8_SCHED;
            PG8_STAGE(PG8_SB(0, 1), b2 + hstep, voffB);
            PG8_WAIT_V(6); PG8_BAR; PG8_MMA(1, 1, At, B1); PG8_BAR;
            PG8_LDB(B0, 1, 0); PG8_SCHED; PG8_LDA(At, 1, 0); PG8_STAGE(PG8_SA(0, 1), a2 + hstep, voffA);
            PG8_WAIT_L(8); PG8_BAR; PG8_WAIT_L(0); PG8_MMA(0, 0, At, B0); PG8_BAR; PG8_SCHED;
            PG8_LDB(B1, 1, 1); PG8_STAGE(PG8_SB(1, 0), b3, voffB);
            PG8_BAR; PG8_WAIT_L(0); PG8_MMA(0, 1, At, B1); PG8_BAR;
            PG8_LDA(At, 1, 1); PG8_STAGE(PG8_SA(1, 0), a3, voffA);
            PG8_BAR; PG8_WAIT_L(0); PG8_MMA(1, 0, At, B0); PG8_BAR; PG8_SCHED;
            PG8_STAGE(PG8_SB(1, 1), b3 + hstep, voffB);
            PG8_WAIT_V(6); PG8_BAR; PG8_MMA(1, 1, At, B1); PG8_BAR;
            }
        }
        if constexpr (ALIGN_EPI) { if (wr == 0) PG8_BAR; }
        if constexpr (!Epi::AFTER_DRAIN) { E(acc, cur, wr, wc, fr, fq); S.done(cur); }
        if (!has_next) break;
#pragma unroll
        for (int a = 0; a < 2; ++a)
#pragma unroll
            for (int b = 0; b < 2; ++b)
#pragma unroll
                for (int m = 0; m < 4; ++m)
#pragma unroll
                    for (int n = 0; n < 2; ++n) acc[a][b][m][n] = (f32x4){0.f, 0.f, 0.f, 0.f};
        cur = nxt; cA = nA; cB = nB; ++ui;
        if constexpr (ALIGN_EPI) { if (wr == 1) PG8_BAR; }
    }
    PG8_WAIT_V(0);
    if constexpr (!ALIGN_EPI) { if (wr == 0) PG8_BAR; }
    PG8_BAR;
    if constexpr (Epi::AFTER_DRAIN) { E.fused(acc, cur, wr, wc, fr, fq, lds, wid, lane); S.done(cur); }
#undef PG8_SA
#undef PG8_SB
#undef PG8_STAGE
#undef PG8_LDA
#undef PG8_LDB
#undef PG8_MMA
#undef PG8_WAIT_V
#undef PG8_WAIT_L
#undef PG8_BAR
#undef PG8_SCHED
}
}
#define LAS __attribute__((address_space(3)))
#define XB_TMO      128
#define XB_XCNT(j)  (256  + 64 * (j))
#define XB_XSUB(j)  (1280 + 64 * (j))
#define XB_XGEN(j)  (2304 + 64 * (j))
#define XB_TOP      3328
#define XB_TOPGEN   3392
#define XCD_BAR_WORDS 3456
#define XB_SPIN_CAP (1u << 18)

__device__ __forceinline__ unsigned xb_ld(unsigned* p)              { return __hip_atomic_load(p, __ATOMIC_RELAXED, __HIP_MEMORY_SCOPE_AGENT); }
__device__ __forceinline__ unsigned xb_add(unsigned* p, unsigned v) { return __hip_atomic_fetch_add(p, v, __ATOMIC_RELAXED, __HIP_MEMORY_SCOPE_AGENT); }
__device__ __forceinline__ unsigned xb_xcc_id() { return (unsigned)__builtin_amdgcn_s_getreg((3 << 11) | 20) & 0xFu; }
#define XB_SPIN(cond, bar) do { unsigned _sp = 0; while (cond) { __builtin_amdgcn_s_sleep(1); \
    if ((++_sp & 255u) == 0u) { if (xb_ld(&(bar)[XB_TMO])) break; if (_sp > XB_SPIN_CAP) { atomicAdd(&(bar)[XB_TMO], 1u); break; } } } } while (0)

struct XcdBarrier {
    unsigned* bar; unsigned x;
    volatile LAS unsigned* st;
};

__device__ __forceinline__ XcdBarrier xcd_barrier_post(unsigned* bar, volatile LAS unsigned* st) {
    XcdBarrier b; b.bar = bar; b.x = xb_xcc_id(); b.st = st;
    if (threadIdx.x == 0) (void)xb_add(&bar[XB_XCNT(b.x)], 1u);
    return b;
}
__device__ __forceinline__ void xcd_barrier_complete(unsigned* bar, unsigned x, unsigned& nloc, unsigned& nx) {
    const unsigned G = gridDim.x * gridDim.y * gridDim.z;
    unsigned sum, cnt, mine, sp = 0u;
    for (;;) {
        sum = 0u; cnt = 0u; mine = 0u;
#pragma unroll
        for (unsigned j = 0; j < 16; ++j) { const unsigned c = xb_ld(&bar[XB_XCNT(j)]); sum += c; cnt += (c > 0u) ? 1u : 0u; mine = (j == x) ? c : mine; }
        if (sum == G) break;
        __builtin_amdgcn_s_sleep(1);
        if ((++sp & 255u) == 0u) { if (xb_ld(&bar[XB_TMO])) break; if (sp > XB_SPIN_CAP) { atomicAdd(&bar[XB_TMO], 1u); break; } }
    }
    nloc = mine > 0u ? mine : 1u; nx = cnt > 0u ? cnt : 1u;
}

__device__ __forceinline__ void xcd_barrier(const XcdBarrier& b) {
    asm volatile("s_waitcnt vmcnt(0)" ::: "memory");
    __syncthreads();
    if (threadIdx.x == 0) {
        unsigned* bar = b.bar;
        __builtin_amdgcn_s_waitcnt(0);
        unsigned nloc = b.st[0], nx = b.st[1];
        if (nloc == 0u) { xcd_barrier_complete(bar, b.x, nloc, nx); b.st[0] = nloc; b.st[1] = nx; }
        const unsigned old = xb_add(&bar[XB_XSUB(b.x)], 1u);
        const unsigned gen = old / nloc;
        if (old + 1u == (gen + 1u) * nloc) {
            __builtin_amdgcn_fence(__ATOMIC_RELEASE, "agent");
            asm volatile("s_waitcnt vmcnt(0)" ::: "memory");
            const unsigned og = xb_add(&bar[XB_TOP], 1u);
            const unsigned tg = og / nx;
            if (og + 1u == (tg + 1u) * nx) xb_add(&bar[XB_TOPGEN], 1u);
            else XB_SPIN(xb_ld(&bar[XB_TOPGEN]) == tg, bar);
            __builtin_amdgcn_fence(__ATOMIC_ACQUIRE, "agent");
            xb_add(&bar[XB_XGEN(b.x)], 1u);
            asm volatile("s_waitcnt vmcnt(0)" ::: "memory");
        } else {
            XB_SPIN(xb_ld(&bar[XB_XGEN(b.x)]) == gen, bar);
            __builtin_amdgcn_fence(__ATOMIC_ACQUIRE, "agent");
            asm volatile("s_waitcnt vmcnt(0)" ::: "memory");
        }
    }
    __syncthreads();
}
#undef LAS
using pg8::bf16x8; using pg8::f32x4; using pg8::u32x4; using pg8::f32x2;
#define GAS __attribute__((address_space(1)))
#define LAS __attribute__((address_space(3)))
typedef unsigned short bf16;
typedef unsigned v4u __attribute__((ext_vector_type(4)));
typedef unsigned v2u __attribute__((ext_vector_type(2)));
typedef float f32x2v __attribute__((ext_vector_type(2)));

constexpr int NTOK = 40960, DM = 2048, NLAYER = 4, INW = 5120;
constexpr int COL_UA = 0, COL_UB = 512, COL_Q = 1024, COL_K = 2048, COL_V = 3072, COL_G = 4096;
constexpr float ALPHA = 1.6817928305074290f;
constexpr float LN_EPS = 1e-5f, GN_EPS = 1e-6f;
constexpr int NEXP = 16384;
constexpr int NWAVES = 8, NTHR = 512;

constexpr size_t MiB = 1u << 20;
constexpr size_t WS_CTL = 0, CTL_ZERO_BYTES = 1 * MiB;
constexpr size_t WS_WIN = 1 * MiB;
constexpr size_t WS_WOUT = 81 * MiB;
constexpr size_t WS_WS = 113 * MiB;
constexpr size_t WS_WGLU = 145 * MiB;
constexpr size_t WS_WPOOL = 147 * MiB;
constexpr size_t WS_S5A = 149 * MiB;
constexpr size_t WS_S5B = 150 * MiB;
constexpr size_t WS_ROT = 152 * MiB;
constexpr size_t WS_U16 = 160 * MiB;
constexpr size_t WS_V16 = 416 * MiB;
constexpr size_t WS_U8 = 160 * MiB;
constexpr size_t WS_V8 = 288 * MiB;
constexpr size_t WS_USC = 416 * MiB;
constexpr size_t WS_VSC = 417 * MiB;
constexpr size_t WS_XN = 672 * MiB;
constexpr size_t WS_H = 832 * MiB;
constexpr size_t WS_CONCAT = 1232 * MiB;
constexpr size_t WS_BUFY = 1392 * MiB;
constexpr size_t WS_BUFP = 1432 * MiB;
constexpr size_t WS_STF = 1472 * MiB;
constexpr size_t WS_STB = 1632 * MiB;
constexpr size_t WS_IDX = 1792 * MiB;
constexpr size_t WS_GATE = 1812 * MiB;
constexpr size_t WS_S5ST = 1832 * MiB;
constexpr size_t WS_END = 1852 * MiB;
constexpr int CW_BAR = 4096;
constexpr int NPHASE = 1 + NLAYER * 10;

constexpr int LDS_SCRATCH = 147456;
constexpr int LDS_MISC = LDS_SCRATCH;
constexpr int LDS_BYTES = LDS_SCRATCH + 256;

__device__ __forceinline__ float bf_lo(unsigned w) { return __uint_as_float(w << 16); }
__device__ __forceinline__ float bf_hi(unsigned w) { return __uint_as_float(w & 0xffff0000u); }
typedef __bf16 bf16x2_t __attribute__((ext_vector_type(2)));
__device__ __forceinline__ unsigned pkbf(float lo, float hi) { const bf16x2_t v = {(__bf16)lo, (__bf16)hi}; return __builtin_bit_cast(unsigned, v); }
__device__ __forceinline__ bf16 f2bf(float f) { return __builtin_bit_cast(unsigned short, (__bf16)f); }
__device__ __forceinline__ float wave_sum(float v) {
#pragma unroll
    for (int o = 1; o < 64; o <<= 1) v += __shfl_xor(v, o);
    return v;
}
__device__ __forceinline__ float gelu_erf(float v) { return 0.5f * v * (1.0f + erff(v * 0.70710678118654752f)); }
__device__ __forceinline__ int tok_pos(int t) { return t < 32768 ? (t & 4095) : (t - 32768); }
__device__ __forceinline__ int tok_len(int t) { return t < 32768 ? 4096 : 8192; }
__device__ __forceinline__ void unpack8(const v4u q, float (&f)[8]) {
    f[0] = bf_lo(q.x); f[1] = bf_hi(q.x); f[2] = bf_lo(q.y); f[3] = bf_hi(q.y); f[4] = bf_lo(q.z); f[5] = bf_hi(q.z); f[6] = bf_lo(q.w); f[7] = bf_hi(q.w);
}
__device__ __forceinline__ v4u pack8(const float (&f)[8]) { v4u q; q.x = pkbf(f[0], f[1]); q.y = pkbf(f[2], f[3]); q.z = pkbf(f[4], f[5]); q.w = pkbf(f[6], f[7]); return q; }
#define LDS_WAIT() asm volatile("s_waitcnt lgkmcnt(0)" ::: "memory")
#define MFMA16(a, b, c) __builtin_amdgcn_mfma_f32_16x16x32_bf16((a), (b), (c), 0, 0, 0)

struct EpiStoreBf16 {
    static constexpr bool PERM = true, AFTER_DRAIN = false;
    bf16* O; int ldo;
    __device__ __forceinline__ void operator()(const f32x4 (&acc)[2][2][4][2], const pg8::Unit& u, int wr, int wc, int fr, int fq) const {
        const int row0 = u.pm * 256 + wr * 64 + fr, col0 = u.pn * 256 + wc * 32 + 8 * fq;
#pragma unroll
        for (int ai = 0; ai < 2; ++ai)
#pragma unroll
            for (int m = 0; m < 4; ++m) { bf16* rowp = O + (size_t)(row0 + ai * 128 + m * 16) * ldo + col0;
#pragma unroll
                for (int bj = 0; bj < 2; ++bj) { const f32x4 v0 = acc[ai][bj][m][0], v1 = acc[ai][bj][m][1];
                    v4u w; w.x = pkbf(v0[0], v0[1]); w.y = pkbf(v0[2], v0[3]); w.z = pkbf(v1[0], v1[1]); w.w = pkbf(v1[2], v1[3]);
                    *(v4u*)(rowp + bj * 128) = w; } }
    }
};
struct EpiGlu {
    static constexpr bool PERM = true, AFTER_DRAIN = false;
    const bf16* Y; int ldy; bf16* O; int ldo; const float* bias;
    __device__ __forceinline__ void operator()(const f32x4 (&acc)[2][2][4][2], const pg8::Unit& u, int wr, int wc, int fr, int fq) const {
        const int row0 = u.pm * 256 + wr * 64 + fr, col0 = u.pn * 256 + wc * 32 + 8 * fq;
#pragma unroll
        for (int bj = 0; bj < 2; ++bj) {
            const f32x4 b0 = *(const f32x4*)(bias + col0 + bj * 128), b1 = *(const f32x4*)(bias + col0 + bj * 128 + 4);
#pragma unroll
            for (int ai = 0; ai < 2; ++ai)
#pragma unroll
                for (int m = 0; m < 4; ++m) { const size_t r = (size_t)(row0 + ai * 128 + m * 16);
                    const v4u yq = *(const v4u*)(Y + r * ldy + col0 + bj * 128); float y[8]; unpack8(yq, y);
                    const f32x4 v0 = acc[ai][bj][m][0] + b0, v1 = acc[ai][bj][m][1] + b1; float o[8];
#pragma unroll
                    for (int k = 0; k < 4; ++k) { o[k] = y[k] / (1.0f + __expf(-v0[k])); o[4 + k] = y[4 + k] / (1.0f + __expf(-v1[k])); }
                    *(v4u*)(O + r * ldo + col0 + bj * 128) = pack8(o); }
        }
    }
};
struct EpiScaleBf16 {
    static constexpr bool PERM = true, AFTER_DRAIN = false;
    bf16* O; int ldo; const float* scale;
    __device__ __forceinline__ void operator()(const f32x4 (&acc)[2][2][4][2], const pg8::Unit& u, int wr, int wc, int fr, int fq) const {
        const int row0 = u.pm * 256 + wr * 64 + fr, col0 = u.pn * 256 + wc * 32 + 8 * fq;
#pragma unroll
        for (int bj = 0; bj < 2; ++bj) {
            const f32x4 s0 = *(const f32x4*)(scale + col0 + bj * 128), s1 = *(const f32x4*)(scale + col0 + bj * 128 + 4);
#pragma unroll
            for (int ai = 0; ai < 2; ++ai)
#pragma unroll
                for (int m = 0; m < 4; ++m) { const size_t r = (size_t)(row0 + ai * 128 + m * 16);
                    const f32x4 v0 = acc[ai][bj][m][0] * s0, v1 = acc[ai][bj][m][1] * s1;
                    v4u w; w.x = pkbf(v0[0], v0[1]); w.y = pkbf(v0[2], v0[3]); w.z = pkbf(v1[0], v1[1]); w.w = pkbf(v1[2], v1[3]);
                    *(v4u*)(O + r * ldo + col0 + bj * 128) = w; }
        }
    }
};
struct EpiResid {
    static constexpr bool PERM = false, AFTER_DRAIN = false;
    float* X; int ldx; float alpha;
    __device__ __forceinline__ void operator()(const f32x4 (&acc)[2][2][4][2], const pg8::Unit& u, int wr, int wc, int fr, int fq) const {
        const int row0 = u.pm * 256 + wr * 64 + fr, col0 = u.pn * 256 + wc * 32 + 4 * fq;
#pragma unroll
        for (int ai = 0; ai < 2; ++ai)
#pragma unroll
            for (int m = 0; m < 4; ++m) { float* rowp = X + (size_t)(row0 + ai * 128 + m * 16) * ldx + col0;
#pragma unroll
                for (int bj = 0; bj < 2; ++bj)
#pragma unroll
                    for (int n = 0; n < 2; ++n) { f32x4* p = (f32x4*)(rowp + bj * 128 + n * 16); const f32x4 x = *p; *p = x * alpha + acc[ai][bj][m][n]; } }
    }
};
struct EpiStoreF32 {
    static constexpr bool PERM = false, AFTER_DRAIN = false;
    float* C; int ldc;
    __device__ __forceinline__ void operator()(const f32x4 (&acc)[2][2][4][2], const pg8::Unit& u, int wr, int wc, int fr, int fq) const {
        const int row0 = u.pm * 256 + wr * 64 + fr, col0 = u.pn * 256 + wc * 32 + 4 * fq;
#pragma unroll
        for (int ai = 0; ai < 2; ++ai)
#pragma unroll
            for (int m = 0; m < 4; ++m) { float* rowp = C + (size_t)(row0 + ai * 128 + m * 16) * ldc + col0;
#pragma unroll
                for (int bj = 0; bj < 2; ++bj)
#pragma unroll
                    for (int n = 0; n < 2; ++n) *(f32x4*)(rowp + bj * 128 + n * 16) = acc[ai][bj][m][n]; }
    }
};

struct Args { const float* in[26]; float* out; unsigned char* ws; int ph_lo, ph_hi, li, pad; };
typedef const Args __attribute__((address_space(4))) CArgs;
struct Frame {
    LAS unsigned char* lds;
    int tid, lane, wave, G, bx;
    int gw, NGW;
    size_t gtid, NT;
    float* out; unsigned char* ws;
};
enum InIdx { I_XP = 0, I_XS, I_LNIN_G, I_LNIN_B, I_WIN, I_LAMRE, I_LAMIM, I_LOGSTEP, I_BRE, I_BIM, I_CRE, I_CIM, I_S5D, I_WGLU, I_BGLU, I_POOLW, I_POOLS,
             I_WOUT, I_LN1G, I_LN1B, I_WQ, I_KEYS, I_PU, I_PV, I_LN2G, I_LN2B };

__device__ __forceinline__ void ln_row(const float* src, const float* g, const float* b, float* dst, bf16* dstb, int lane) {
    f32x4 v[8]; float s = 0.f;
#pragma unroll
    for (int j = 0; j < 8; ++j) { v[j] = ((const f32x4*)src)[lane + 64 * j]; s += (v[j][0] + v[j][1]) + (v[j][2] + v[j][3]); }
    const float mean = wave_sum(s) * (1.0f / DM); float s2 = 0.f;
#pragma unroll
    for (int j = 0; j < 8; ++j) { v[j] = v[j] - mean; s2 += (v[j][0] * v[j][0] + v[j][1] * v[j][1]) + (v[j][2] * v[j][2] + v[j][3] * v[j][3]); }
    const float rstd = 1.0f / sqrtf(wave_sum(s2) * (1.0f / DM) + LN_EPS);
#pragma unroll
    for (int j = 0; j < 8; ++j) { const f32x4 gg = ((const f32x4*)g)[lane + 64 * j], bb = ((const f32x4*)b)[lane + 64 * j];
        const f32x4 o = v[j] * rstd * gg + bb; ((f32x4*)dst)[lane + 64 * j] = o;
        v2u w; w.x = pkbf(o[0], o[1]); w.y = pkbf(o[2], o[3]); ((v2u*)dstb)[lane + 64 * j] = w; }
}

__device__ __forceinline__ void transpose_item(const float* W, int K, int N, bf16* WT, LAS float* scr, int item, int lane) {
    const int nblk = N / 32, kb = item / nblk, nb = item % nblk, k0 = 64 * kb, n0 = 32 * nb;
#pragma unroll 8
    for (int i = 0; i < 32; ++i) { const int kk = 2 * i + (lane >> 5); scr[kk * 33 + (lane & 31)] = W[(size_t)(k0 + kk) * N + n0 + (lane & 31)]; }
    LDS_WAIT();
    const int c = lane & 7;
#pragma unroll
    for (int j = 0; j < 4; ++j) { const int n = (lane >> 3) + 8 * j; const LAS float* s = scr + (8 * c) * 33 + n;
        v4u o; o.x = pkbf(s[0 * 33], s[1 * 33]); o.y = pkbf(s[2 * 33], s[3 * 33]); o.z = pkbf(s[4 * 33], s[5 * 33]); o.w = pkbf(s[6 * 33], s[7 * 33]);
        *(v4u*)(WT + (size_t)(n0 + n) * K + k0 + 8 * c) = o; }
    LDS_WAIT();
}

__device__ __forceinline__ void p0_prologue(const Frame& F, CArgs& A) {
    {
        LAS float* scr = (LAS float*)(F.lds + F.wave * 16384);
        constexpr int I_IN = (DM / 64) * (INW / 32), I_OUT = (DM / 64) * (DM / 32), I_GLU = (512 / 64) * (512 / 32);
        constexpr int NITEMS = NLAYER * (I_IN + I_OUT + I_GLU);
        for (int it = F.gw; it < NITEMS; it += F.NGW) {
            int r = it;
            if (r < NLAYER * I_IN) { const int l = r / I_IN; transpose_item(A.in[I_WIN] + (size_t)l * DM * INW, DM, INW, (bf16*)(F.ws + WS_WIN) + (size_t)l * INW * DM, scr, r % I_IN, F.lane); continue; }
            r -= NLAYER * I_IN;
            if (r < NLAYER * I_OUT) { const int l = r / I_OUT; transpose_item(A.in[I_WOUT] + (size_t)l * DM * DM, DM, DM, (bf16*)(F.ws + WS_WOUT) + (size_t)l * DM * DM, scr, r % I_OUT, F.lane); continue; }
            r -= NLAYER * I_OUT;
            { const int l = r / I_GLU; transpose_item(A.in[I_WGLU] + (size_t)l * 512 * 512, 512, 512, (bf16*)(F.ws + WS_WGLU) + (size_t)l * 512 * 512, scr, r % I_GLU, F.lane); }
        }
    }
#if PEER_FP4
    {
        for (int r = F.gw; r < 2 * NLAYER * NEXP; r += F.NGW) {
            const int tab = r >= NLAYER * NEXP, ri = tab ? r - NLAYER * NEXP : r;
            const float* src = (tab ? A.in[I_PV] : A.in[I_PU]) + (size_t)ri * DM + F.lane * 32;
            f32x4 v[8]; float am = 0.f;
#pragma unroll
            for (int q = 0; q < 8; ++q) { v[q] = *(const f32x4*)(src + q * 4); am = fmaxf(am, fmaxf(fmaxf(fabsf(v[q][0]), fabsf(v[q][1])), fmaxf(fabsf(v[q][2]), fabsf(v[q][3])))); }
#pragma unroll
            for (int o = 1; o < 64; o <<= 1) am = fmaxf(am, __shfl_xor(am, o));
            const float sc = am > 0.f ? 6.0f / am : 1.0f, isc = am > 0.f ? am * (1.0f / 6.0f) : 1.0f;
            v4u w;
#pragma unroll
            for (int q = 0; q < 4; ++q) { unsigned pk = 0u;
                pk = __builtin_amdgcn_cvt_scalef32_pk_fp4_f32(pk, v[2 * q][0] * sc, v[2 * q][1] * sc, 1.0f, 0); pk = __builtin_amdgcn_cvt_scalef32_pk_fp4_f32(pk, v[2 * q][2] * sc, v[2 * q][3] * sc, 1.0f, 1);
                pk = __builtin_amdgcn_cvt_scalef32_pk_fp4_f32(pk, v[2 * q + 1][0] * sc, v[2 * q + 1][1] * sc, 1.0f, 2); pk = __builtin_amdgcn_cvt_scalef32_pk_fp4_f32(pk, v[2 * q + 1][2] * sc, v[2 * q + 1][3] * sc, 1.0f, 3);
                w[q] = pk; }
            *(v4u*)(F.ws + (tab ? WS_V8 : WS_U8) + (size_t)ri * (DM / 2) + F.lane * 16) = w;
            if (F.lane == 0) ((float*)(F.ws + (tab ? WS_VSC : WS_USC)))[ri] = isc;
        }
    }
#else
    {
        for (int r = F.gw; r < 2 * NLAYER * NEXP; r += F.NGW) {
            const int tab = r >= NLAYER * NEXP, ri = tab ? r - NLAYER * NEXP : r;
            const float* src = (tab ? A.in[I_PV] : A.in[I_PU]) + (size_t)ri * DM;
            f32x4 v[2][4]; float am = 0.f;
#pragma unroll
            for (int c = 0; c < 2; ++c)
#pragma unroll
                for (int q = 0; q < 4; ++q) { v[c][q] = *(const f32x4*)(src + (c * 64 + F.lane) * 16 + q * 4);
                    am = fmaxf(am, fmaxf(fmaxf(fabsf(v[c][q][0]), fabsf(v[c][q][1])), fmaxf(fabsf(v[c][q][2]), fabsf(v[c][q][3])))); }
#pragma unroll
            for (int o = 1; o < 64; o <<= 1) am = fmaxf(am, __shfl_xor(am, o));
            const float sc = am > 0.f ? 384.0f / am : 1.0f, isc = am > 0.f ? am * (1.0f / 384.0f) : 1.0f;
            unsigned char* dst = F.ws + (tab ? WS_V8 : WS_U8) + (size_t)ri * DM;
#pragma unroll
            for (int c = 0; c < 2; ++c) { v4u w;
#pragma unroll
                for (int q = 0; q < 4; ++q) { int pk = 0; pk = __builtin_amdgcn_cvt_pk_fp8_f32(v[c][q][0] * sc, v[c][q][1] * sc, pk, false); pk = __builtin_amdgcn_cvt_pk_fp8_f32(v[c][q][2] * sc, v[c][q][3] * sc, pk, true); w[q] = (unsigned)pk; }
                *(v4u*)(dst + (c * 64 + F.lane) * 16) = w; }
            if (F.lane == 0) ((float*)(F.ws + (tab ? WS_VSC : WS_USC)))[ri] = isc;
        }
    }
#endif
    {
        const float* pw = A.in[I_POOLW]; v4u* dst = (v4u*)(F.ws + WS_WPOOL);
        for (size_t i = F.gtid; i < (size_t)NLAYER * 512 * 64; i += F.NT) {
            const int k8 = (int)(i & 63), n = (int)((i >> 6) & 511), l = (int)(i >> 15);
            const int g = n >> 7, d = n & 127, kg = k8 >> 4, c0 = (k8 & 15) * 8;
            float f[8];
#pragma unroll
            for (int k = 0; k < 8; ++k) f[k] = (kg == g) ? pw[(((size_t)l * 4 + g) * 128 + (c0 + k)) * 128 + d] : 0.f;
            dst[i] = pack8(f);
        }
    }
    {
        const float* lre = A.in[I_LAMRE]; const float* lim = A.in[I_LAMIM]; const float* lst = A.in[I_LOGSTEP]; const float* bre = A.in[I_BRE]; const float* bim = A.in[I_BIM];
        f32x2v* ab = (f32x2v*)(F.ws + WS_S5A); f32x2v* ab64 = (f32x2v*)(F.ws + WS_S5A + 512 * 1024); f32x2v* bb = (f32x2v*)(F.ws + WS_S5B);
        for (size_t i = F.gtid; i < (size_t)NLAYER * 2 * 32 * 64; i += F.NT) {
            const float lr = lre[i], li = lim[i], dt = expf(lst[i >> 6]);
            const float mag = expf(lr * dt), ar = mag * cosf(li * dt), ai = mag * sinf(li * dt);
            const float den = lr * lr + li * li;
            const float zr = ((ar - 1.0f) * lr + ai * li) / den, zi = (ai * lr - (ar - 1.0f) * li) / den;
            ab[i] = (f32x2v){ar, ai};
            const float m64 = expf(lr * dt * 64.0f), an = li * dt * 64.0f;
            ab64[i] = (f32x2v){m64 * cosf(an), m64 * sinf(an)};
#pragma unroll
            for (int c = 0; c < 16; ++c) { const float br = bre[i * 16 + c], bi = bim[i * 16 + c]; bb[i * 16 + c] = (f32x2v){zr * br - zi * bi, zr * bi + zi * br}; }
        }
    }
    if (F.bx == 0 && F.tid < 128) {
        ((float*)(F.ws + WS_ROT))[F.tid] = (float)exp(-(double)F.tid / 127.0 * 9.210340371976184);
    }
    __syncthreads();
    {
        LAS float* KS = (LAS float*)F.lds;
        LAS float* WQ = (LAS float*)(F.lds + 128 * 132 * 4);
        const float* keys = A.in[I_KEYS]; const float* wq = A.in[I_WQ]; bf16* wst = (bf16*)(F.ws + WS_WS);
        for (int u = F.bx; u < NLAYER * 16 * 32; u += F.G) {
            const int dtl = u & 31, hp = (u >> 5) & 15, l = u >> 9, p = hp & 1;
#pragma unroll
            for (int r = 0; r < 8; ++r) { const int f = F.tid + 512 * r, nk = f >> 5, c4 = f & 31;
                *(LAS f32x4*)(KS + nk * 132 + c4 * 4) = *(const f32x4*)(keys + (((size_t)l * 2 + p) * 128 + nk) * 128 + c4 * 4); }
#pragma unroll
            for (int r = 0; r < 4; ++r) { const int f = F.tid + 512 * r, dd = f >> 5, c4 = f & 31;
                *(LAS f32x4*)(WQ + dd * 132 + c4 * 4) = *(const f32x4*)(wq + ((size_t)l * DM + dtl * 64 + dd) * DM + hp * 128 + c4 * 4); }
            __syncthreads();
            const int nk = F.tid & 127, dg = F.tid >> 7;
            float acc[16];
#pragma unroll
            for (int i = 0; i < 16; ++i) acc[i] = 0.f;
            for (int c4 = 0; c4 < 32; ++c4) {
                const f32x4 kv = *(const LAS f32x4*)(KS + nk * 132 + c4 * 4);
#pragma unroll
                for (int i = 0; i < 16; ++i) { const f32x4 wv = *(const LAS f32x4*)(WQ + (dg * 16 + i) * 132 + c4 * 4);
                    acc[i] += (kv[0] * wv[0] + kv[1] * wv[1]) + (kv[2] * wv[2] + kv[3] * wv[3]); }
            }
            bf16* o = wst + ((size_t)l * DM + hp * 128 + nk) * DM + dtl * 64 + dg * 16;
            v4u q0, q1; q0.x = pkbf(acc[0], acc[1]); q0.y = pkbf(acc[2], acc[3]); q0.z = pkbf(acc[4], acc[5]); q0.w = pkbf(acc[6], acc[7]);
            q1.x = pkbf(acc[8], acc[9]); q1.y = pkbf(acc[10], acc[11]); q1.z = pkbf(acc[12], acc[13]); q1.w = pkbf(acc[14], acc[15]);
            *(v4u*)o = q0; *(v4u*)(o + 8) = q1;
            __syncthreads();
        }
    }
    for (int t = F.gw; t < NTOK; t += F.NGW) {
        const float* src = t < 32768 ? A.in[I_XP] + (size_t)t * DM : A.in[I_XS] + (size_t)(t - 32768) * DM;
        ln_row(src, A.in[I_LNIN_G], A.in[I_LNIN_B], F.out + (size_t)t * DM, (bf16*)(F.ws + WS_XN) + (size_t)t * DM, F.lane);
    }
}

__device__ __forceinline__ float ret_log2_gamma(int h) { return log2f(1.0f - exp2f(-5.0f - (float)h)); }

__device__ __forceinline__ void s5_pass1(const Frame& F, CArgs& A, int l) {
    LAS float* Uw = (LAS float*)(F.lds + F.wave * 4096);
    const bf16* H = (const bf16*)(F.ws + WS_H);
    const f32x2v* ab = (const f32x2v*)(F.ws + WS_S5A); const f32x4* bb = (const f32x4*)(F.ws + WS_S5B);
    f32x2v* st = (f32x2v*)(F.ws + WS_S5ST);
    for (int task = F.gw; task < 640 * 32 * 2; task += F.NGW) {
        const int dir = task & 1, g = (task >> 1) & 31, ck = task >> 6;
        const int pidx = ((l * 2 + dir) * 32 + g) * 64 + F.lane;
        const f32x2v a = ab[pidx];
        float Br[16], Bi[16];
#pragma unroll
        for (int c2 = 0; c2 < 8; ++c2) { const f32x4 q = bb[(size_t)pidx * 8 + c2]; Br[2 * c2] = q[0]; Bi[2 * c2] = q[1]; Br[2 * c2 + 1] = q[2]; Bi[2 * c2 + 1] = q[3]; }
        {
            const bf16* urow = H + (size_t)(ck * 64 + F.lane) * INW + COL_UA + g * 16;
            const v4u q0 = *(const v4u*)urow, q1 = *(const v4u*)(urow + 8); float f0[8], f1[8]; unpack8(q0, f0); unpack8(q1, f1);
            LAS f32x4* d = (LAS f32x4*)(Uw + F.lane * 16);
            d[0] = (f32x4){f0[0], f0[1], f0[2], f0[3]}; d[1] = (f32x4){f0[4], f0[5], f0[6], f0[7]}; d[2] = (f32x4){f1[0], f1[1], f1[2], f1[3]}; d[3] = (f32x4){f1[4], f1[5], f1[6], f1[7]};
        }
        LDS_WAIT();
        float xr = 0.f, xi = 0.f;
        for (int s = 0; s < 64; ++s) {
            const int t = dir ? 63 - s : s;
            const LAS f32x4* up = (const LAS f32x4*)(Uw + t * 16);
            float bur = 0.f, bui = 0.f;
#pragma unroll
            for (int c4 = 0; c4 < 4; ++c4) { const f32x4 uv = up[c4];
#pragma unroll
                for (int k = 0; k < 4; ++k) { bur += Br[4 * c4 + k] * uv[k]; bui += Bi[4 * c4 + k] * uv[k]; } }
            const float nxr = a[0] * xr - a[1] * xi + bur, nxi = a[0] * xi + a[1] * xr + bui; xr = nxr; xi = nxi;
        }
        st[(size_t)((ck * 32 + g) * 2 + dir) * 64 + F.lane] = (f32x2v){xr, xi};
        LDS_WAIT();
    }
}
__device__ __forceinline__ void s5_carry(const Frame& F, CArgs& A, int l) {
    const f32x2v* ab64 = (const f32x2v*)(F.ws + WS_S5A + 512 * 1024); f32x2v* st = (f32x2v*)(F.ws + WS_S5ST);
    for (size_t it = F.gtid; it < (size_t)9 * 32 * 2 * 64; it += F.NT) {
        const int p = (int)(it & 63), dir = (int)((it >> 6) & 1), g = (int)((it >> 7) & 31), s = (int)(it >> 12);
        const int ck0 = s < 8 ? s * 64 : 512, n = s < 8 ? 64 : 128;
        const f32x2v a = ab64[((l * 2 + dir) * 32 + g) * 64 + p];
        float cr = 0.f, ci = 0.f;
        for (int k = 0; k < n; ++k) {
            const int ck = dir ? (ck0 + n - 1 - k) : (ck0 + k);
            f32x2v* q = st + (size_t)((ck * 32 + g) * 2 + dir) * 64 + p;
            const f32x2v le = *q; *q = (f32x2v){cr, ci};
            const float ncr = a[0] * cr - a[1] * ci + le[0], nci = a[0] * ci + a[1] * cr + le[1]; cr = ncr; ci = nci;
        }
    }
}
__device__ __forceinline__ void s5_pass3(const Frame& F, CArgs& A, int l) {
    LAS unsigned char* wb = F.lds + F.wave * 17152;
    LAS float* Uw = (LAS float*)wb;
    LAS bf16* Xw = (LAS bf16*)(wb + 4096);
    LAS bf16* Ctw = (LAS bf16*)(wb + 4096 + 8704);
    const bf16* H = (const bf16*)(F.ws + WS_H); bf16* BY = (bf16*)(F.ws + WS_BUFY);
    const f32x2v* ab = (const f32x2v*)(F.ws + WS_S5A); const f32x4* bb = (const f32x4*)(F.ws + WS_S5B);
    const f32x2v* st = (const f32x2v*)(F.ws + WS_S5ST);
    const float* cre = A.in[I_CRE]; const float* cim = A.in[I_CIM]; const float* dvec = A.in[I_S5D] + (size_t)l * 512;
    const int lane = F.lane, lr = lane & 15, lq = lane >> 4;
    for (int task = F.gw; task < 640 * 32; task += F.NGW) {
        const int g = task & 31, ck = task >> 5;
        {
            const bf16* urow = H + (size_t)(ck * 64 + lane) * INW + COL_UA + g * 16;
            const v4u q0 = *(const v4u*)urow, q1 = *(const v4u*)(urow + 8); float f0[8], f1[8]; unpack8(q0, f0); unpack8(q1, f1);
            LAS f32x4* d = (LAS f32x4*)(Uw + lane * 16);
            d[0] = (f32x4){f0[0], f0[1], f0[2], f0[3]}; d[1] = (f32x4){f0[4], f0[5], f0[6], f0[7]}; d[2] = (f32x4){f1[0], f1[1], f1[2], f1[3]}; d[3] = (f32x4){f1[4], f1[5], f1[6], f1[7]};
        }
        f32x4 Y[4];
#pragma unroll
        for (int m = 0; m < 4; ++m) Y[m] = (f32x4){0.f, 0.f, 0.f, 0.f};
#pragma unroll
        for (int dir = 0; dir < 2; ++dir) {
            const int pidx = ((l * 2 + dir) * 32 + g) * 64 + lane;
            const f32x2v a = ab[pidx];
            float Br[16], Bi[16];
#pragma unroll
            for (int c2 = 0; c2 < 8; ++c2) { const f32x4 q = bb[(size_t)pidx * 8 + c2]; Br[2 * c2] = q[0]; Bi[2 * c2] = q[1]; Br[2 * c2 + 1] = q[2]; Bi[2 * c2 + 1] = q[3]; }
            {
                const size_t cb = (size_t)((l * 2 + dir) * 32 + g) * 16 * 64;
#pragma unroll
                for (int c = 0; c < 16; ++c) { Ctw[c * 136 + lane] = f2bf(cre[cb + c * 64 + lane]); Ctw[c * 136 + 64 + lane] = f2bf(-cim[cb + c * 64 + lane]); }
            }
            const f32x2v x0 = st[(size_t)((ck * 32 + g) * 2 + dir) * 64 + lane];
            float xr = x0[0], xi = x0[1];
            LDS_WAIT();
#pragma unroll
            for (int half = 0; half < 2; ++half) {
                for (int s = 0; s < 32; ++s) {
                    const int step = half * 32 + s, t = dir ? 63 - step : step;
                    const LAS f32x4* up = (const LAS f32x4*)(Uw + t * 16);
                    float bur = 0.f, bui = 0.f;
#pragma unroll
                    for (int c4 = 0; c4 < 4; ++c4) { const f32x4 uv = up[c4];
#pragma unroll
                        for (int k = 0; k < 4; ++k) { bur += Br[4 * c4 + k] * uv[k]; bui += Bi[4 * c4 + k] * uv[k]; } }
                    const float nxr = a[0] * xr - a[1] * xi + bur, nxi = a[0] * xi + a[1] * xr + bui; xr = nxr; xi = nxi;
                    Xw[(t & 31) * 136 + lane] = f2bf(xr); Xw[(t & 31) * 136 + 64 + lane] = f2bf(xi);
                }
                LDS_WAIT();
                const int tb = dir ? (1 - half) : half;
#pragma unroll
                for (int m = 0; m < 2; ++m)
#pragma unroll
                    for (int ks = 0; ks < 4; ++ks) {
                        const bf16x8 av = *(const LAS bf16x8*)(Ctw + lr * 136 + 32 * ks + lq * 8);
                        const bf16x8 bv = *(const LAS bf16x8*)(Xw + (16 * m + lr) * 136 + 32 * ks + lq * 8);
                        Y[2 * tb + m] = MFMA16(av, bv, Y[2 * tb + m]);
                    }
                LDS_WAIT();
            }
        }
#pragma unroll
        for (int m = 0; m < 4; ++m) {
            const int t = 16 * m + lr, c0 = 4 * lq;
            const f32x4 uv = *(const LAS f32x4*)(Uw + t * 16 + c0); const f32x4 dv = *(const f32x4*)(dvec + g * 16 + c0);
            const f32x4 y = Y[m] + dv * uv;
            v2u w; w.x = pkbf(gelu_erf(y[0]), gelu_erf(y[1])); w.y = pkbf(gelu_erf(y[2]), gelu_erf(y[3]));
            *(v2u*)(BY + (size_t)(ck * 64 + t) * 512 + g * 16 + c0) = w;
        }
        LDS_WAIT();
    }
}
__device__ __forceinline__ void pool_phase(const Frame& F, CArgs& A) {
    const bf16* H = (const bf16*)(F.ws + WS_H); bf16* BP = (bf16*)(F.ws + WS_BUFP);
    for (size_t it = F.gtid; it < (size_t)NTOK * 64; it += F.NT) {
        const int t = (int)(it >> 6), o = (int)(it & 63), gi = o >> 4, w = 2 << gi;
        const int pos = tok_pos(t), L = tok_len(t);
        const int lo = max(pos - w / 2, 0), hi = min(pos + w / 2 - 1, L - 1);
        const bf16* base = H + (size_t)(t - pos) * INW + COL_UB + o * 8;
        float s[8];
#pragma unroll
        for (int k = 0; k < 8; ++k) s[k] = 0.f;
        for (int si = lo; si <= hi; ++si) { float f[8]; unpack8(*(const v4u*)(base + (size_t)si * INW), f);
#pragma unroll
            for (int k = 0; k < 8; ++k) s[k] += f[k]; }
        const float inv = 1.0f / (float)(hi - lo + 1);
        float c[8]; unpack8(*(const v4u*)(base + (size_t)pos * INW), c);
#pragma unroll
        for (int k = 0; k < 8; ++k) s[k] = s[k] * inv - c[k];
        *(v4u*)(BP + (size_t)t * 512 + o * 8) = pack8(s);
    }
}
__device__ __forceinline__ void rotary_phase(const Frame& F, CArgs& A) {
    bf16* H = (bf16*)(F.ws + WS_H); const float* rot = (const float*)(F.ws + WS_ROT);
    for (size_t it = F.gtid; it < (size_t)NTOK * 16; it += F.NT) {
        const int t = (int)(it >> 4), o = (int)(it & 15); const float pos = (float)tok_pos(t);
        float cs[8], sn[8];
#pragma unroll
        for (int k = 0; k < 8; ++k) { const float ang = pos * rot[o * 8 + k]; cs[k] = cosf(ang); sn[k] = sinf(ang); }
#pragma unroll
        for (int which = 0; which < 2; ++which) {
            const float sc = which ? 0.0625f : 1.0f;
#pragma unroll
            for (int hd = 0; hd < 4; ++hd) {
                bf16* p1 = H + (size_t)t * INW + (which ? COL_K : COL_Q) + hd * 256 + o * 8; bf16* p2 = p1 + 128;
                float x1[8], x2[8], o1[8], o2[8]; unpack8(*(const v4u*)p1, x1); unpack8(*(const v4u*)p2, x2);
#pragma unroll
                for (int k = 0; k < 8; ++k) { o1[k] = (x1[k] * cs[k] - x2[k] * sn[k]) * sc; o2[k] = (x2[k] * cs[k] + x1[k] * sn[k]) * sc; }
                *(v4u*)p1 = pack8(o1); *(v4u*)p2 = pack8(o2);
            }
        }
    }
}
constexpr int RS = 136;
__device__ __forceinline__ void ret_state_phase(const Frame& F, CArgs& A) {
    const bf16* H = (const bf16*)(F.ws + WS_H); bf16* STF = (bf16*)(F.ws + WS_STF); bf16* STB = (bf16*)(F.ws + WS_STB);
    LAS bf16* Kt = (LAS bf16*)F.lds; LAS bf16* VtF = Kt + 128 * RS; LAS bf16* VtB = Kt + 256 * RS;
    const int tid = F.tid, lane = F.lane, lr = lane & 15, lq = lane >> 4, we = F.wave >> 1, wd = F.wave & 1;
    for (int u = F.bx; u < 5120; u += F.G) {
        const int dh = u & 1, eh = (u >> 1) & 1, h = (u >> 2) & 3, c = u >> 4;
        {
            const int tq = opaque(tid), jp = tq & 63, j = 2 * jp, pc0 = tq >> 6;
            const bf16* krow = H + (size_t)(c * 128 + j) * INW + COL_K + h * 256 + dh * 128;
            const bf16* vrow = H + (size_t)(c * 128 + j) * INW + COL_V + h * 256 + eh * 128;
            const float lg = ret_log2_gamma(h), fF0 = exp2f(lg * (float)(127 - j)), fF1 = exp2f(lg * (float)(126 - j)), fB0 = exp2f(lg * (float)j), fB1 = exp2f(lg * (float)(j + 1));
            LAS unsigned* Kt32 = (LAS unsigned*)Kt; LAS unsigned* VtF32 = (LAS unsigned*)VtF; LAS unsigned* VtB32 = (LAS unsigned*)VtB;
#pragma unroll
            for (int r = 0; r < 2; ++r) {
                const int pc = pc0 + 8 * r;
                const v4u k0 = *(const v4u*)(krow + pc * 8), k1 = *(const v4u*)(krow + INW + pc * 8);
                const v4u v0 = *(const v4u*)(vrow + pc * 8), v1 = *(const v4u*)(vrow + INW + pc * 8);
                const unsigned ka0[4] = {k0.x, k0.y, k0.z, k0.w}, ka1[4] = {k1.x, k1.y, k1.z, k1.w};
                float f0[8], f1[8]; unpack8(v0, f0); unpack8(v1, f1);
#pragma unroll
                for (int i = 0; i < 8; ++i) {
                    const unsigned a = ka0[i >> 1], b = ka1[i >> 1];
                    const unsigned kk = (i & 1) ? ((a >> 16) | (b & 0xffff0000u)) : ((a & 0xffffu) | (b << 16));
                    const int o = ((pc * 8 + i) * RS) / 2 + jp;
                    Kt32[o] = kk; VtF32[o] = pkbf(f0[i] * fF0, f1[i] * fF1); VtB32[o] = pkbf(f0[i] * fB0, f1[i] * fB1);
                }
            }
        }
        __syncthreads();
        f32x4 aF[4][2], aB[4][2];
#pragma unroll
        for (int td = 0; td < 4; ++td)
#pragma unroll
            for (int te = 0; te < 2; ++te) { aF[td][te] = (f32x4){0.f, 0.f, 0.f, 0.f}; aB[td][te] = (f32x4){0.f, 0.f, 0.f, 0.f}; }
#pragma unroll
        for (int ks = 0; ks < 4; ++ks) {
            bf16x8 ka[4], vF[2], vB[2];
#pragma unroll
            for (int td = 0; td < 4; ++td) ka[td] = *(const LAS bf16x8*)(Kt + (64 * wd + 16 * td + lr) * RS + 32 * ks + lq * 8);
#pragma unroll
            for (int te = 0; te < 2; ++te) { vF[te] = *(const LAS bf16x8*)(VtF + (32 * we + 16 * te + lr) * RS + 32 * ks + lq * 8); vB[te] = *(const LAS bf16x8*)(VtB + (32 * we + 16 * te + lr) * RS + 32 * ks + lq * 8); }
#pragma unroll
            for (int td = 0; td < 4; ++td)
#pragma unroll
                for (int te = 0; te < 2; ++te) { aF[td][te] = MFMA16(ka[td], vF[te], aF[td][te]); aB[td][te] = MFMA16(ka[td], vB[te], aB[td][te]); }
        }
#pragma unroll
        for (int td = 0; td < 4; ++td)
#pragma unroll
            for (int te = 0; te < 2; ++te) {
                const int e = eh * 128 + 32 * we + 16 * te + lr, d = dh * 128 + 64 * wd + 16 * td + 4 * lq;
                const size_t off = ((size_t)(c * 4 + h) * 256 + e) * 256 + d;
                v2u w; w.x = pkbf(aF[td][te][0], aF[td][te][1]); w.y = pkbf(aF[td][te][2], aF[td][te][3]); *(v2u*)(STF + off) = w;
                v2u x; x.x = pkbf(aB[td][te][0], aB[td][te][1]); x.y = pkbf(aB[td][te][2], aB[td][te][3]); *(v2u*)(STB + off) = x;
            }
        __syncthreads();
    }
}
__device__ __forceinline__ void ret_prefix_phase(const Frame& F, CArgs& A) {
    bf16* STF = (bf16*)(F.ws + WS_STF); bf16* STB = (bf16*)(F.ws + WS_STB);
    for (size_t it = F.gtid; it < (size_t)36 * 2 * 8192; it += F.NT) {
        const int o = (int)(it & 8191), which = (int)((it >> 13) & 1), bh = (int)(it >> 14), h = bh & 3, s = bh >> 2;
        const int c0 = s < 8 ? s * 32 : 256, n = s < 8 ? 32 : 64;
        const float dec = exp2f(128.0f * ret_log2_gamma(h));
        float st[8];
#pragma unroll
        for (int k = 0; k < 8; ++k) st[k] = 0.f;
        bf16* base = (which ? STB : STF) + (size_t)h * 65536 + (size_t)o * 8;
        for (int k = 0; k < n; ++k) {
            const int c = which ? (c0 + n - 1 - k) : (c0 + k);
            v4u* p = (v4u*)(base + (size_t)c * 4 * 65536);
            float f[8]; unpack8(*p, f);
#pragma unroll
            for (int i = 0; i < 8; ++i) st[i] = dec * st[i] + f[i];
            *p = pack8(st);
        }
    }
}
__device__ __forceinline__ void ret_out_phase(const Frame& F, CArgs& A) {
    const bf16* H = (const bf16*)(F.ws + WS_H); const bf16* STF = (const bf16*)(F.ws + WS_STF); const bf16* STB = (const bf16*)(F.ws + WS_STB);
    bf16* CC = (bf16*)(F.ws + WS_CONCAT);
    LAS bf16* RA = (LAS bf16*)F.lds; LAS bf16* RB = RA + 128 * RS; LAS bf16* RC = RA + 384 * RS;
    const int tid = F.tid, lane = F.lane, lr = lane & 15, lq = lane >> 4, wi = F.wave >> 2, wj = F.wave & 3, we = F.wave & 3;
    for (int u = F.bx; u < 1280; u += F.G) {
        const int h = u & 3, c = u >> 2, t0 = c * 128;
        const int cs = c < 256 ? (c & 31) : (c - 256), ncs = c < 256 ? 32 : 64;
        const bool has_f = cs > 0, has_b = cs < ncs - 1;
        const float lg = ret_log2_gamma(h);
        f32x4 S[4][2];
#pragma unroll
        for (int ti = 0; ti < 4; ++ti)
#pragma unroll
            for (int tj = 0; tj < 2; ++tj) S[ti][tj] = (f32x4){0.f, 0.f, 0.f, 0.f};
#pragma unroll
        for (int dh = 0; dh < 2; ++dh) {
            if (dh) __syncthreads();
#pragma unroll 1
            for (int r = 0; r < 4; ++r) { const int f = opaque(tid) + 512 * r, row = f >> 4, pc = f & 15;
                const bf16* src = H + (size_t)(t0 + row) * INW + h * 256 + dh * 128 + pc * 8;
                *(LAS v4u*)(RA + row * RS + pc * 8) = *(const v4u*)(src + COL_Q);
                *(LAS v4u*)(RB + row * RS + pc * 8) = *(const v4u*)(src + COL_K); }
            __syncthreads();
#pragma unroll
            for (int ks = 0; ks < 4; ++ks) {
                bf16x8 ka[2], qb[4];
#pragma unroll
                for (int tj = 0; tj < 2; ++tj) ka[tj] = *(const LAS bf16x8*)(RB + (32 * wj + 16 * tj + lr) * RS + 32 * ks + lq * 8);
#pragma unroll
                for (int ti = 0; ti < 4; ++ti) qb[ti] = *(const LAS bf16x8*)(RA + (64 * wi + 16 * ti + lr) * RS + 32 * ks + lq * 8);
#pragma unroll
                for (int ti = 0; ti < 4; ++ti)
#pragma unroll
                    for (int tj = 0; tj < 2; ++tj) S[ti][tj] = MFMA16(ka[tj], qb[ti], S[ti][tj]);
            }
        }
#pragma unroll
        for (int ti = 0; ti < 4; ++ti)
#pragma unroll
            for (int tj = 0; tj < 2; ++tj) {
                const int i = 64 * wi + 16 * ti + lr, j0 = 32 * wj + 16 * tj + 4 * lq; float p[4];
#pragma unroll
                for (int jj = 0; jj < 4; ++jj) { const int d = i - (j0 + jj); p[jj] = S[ti][tj][jj] * exp2f(lg * (float)(d < 0 ? -d : d)); }
                v2u w; w.x = pkbf(p[0], p[1]); w.y = pkbf(p[2], p[3]); *(LAS v2u*)(RC + i * RS + j0) = w;
            }
        __syncthreads();
        {
            const int tq = opaque(tid), jp = tq & 63, pc0 = tq >> 6; const bf16* vrow = H + (size_t)(t0 + 2 * jp) * INW + COL_V + h * 256;
            LAS unsigned* RB32 = (LAS unsigned*)RB;
#pragma unroll 1
            for (int r = 0; r < 4; ++r) { const int pc = pc0 + 8 * r; const v4u v0 = *(const v4u*)(vrow + pc * 8), v1 = *(const v4u*)(vrow + INW + pc * 8);
                const unsigned va0[4] = {v0.x, v0.y, v0.z, v0.w}, va1[4] = {v1.x, v1.y, v1.z, v1.w};
#pragma unroll
                for (int i = 0; i < 8; ++i) { const unsigned a = va0[i >> 1], b = va1[i >> 1];
                    RB32[((pc * 8 + i) * RS) / 2 + jp] = (i & 1) ? ((a >> 16) | (b & 0xffff0000u)) : ((a & 0xffffu) | (b << 16)); } }
        }
        __syncthreads();
        f32x4 O[4][4];
#pragma unroll
        for (int ti = 0; ti < 4; ++ti)
#pragma unroll
            for (int te = 0; te < 4; ++te) O[ti][te] = (f32x4){0.f, 0.f, 0.f, 0.f};
#pragma unroll
        for (int ks = 0; ks < 4; ++ks) {
            bf16x8 va[4], pb[4];
#pragma unroll
            for (int te = 0; te < 4; ++te) va[te] = *(const LAS bf16x8*)(RB + (64 * we + 16 * te + lr) * RS + 32 * ks + lq * 8);
#pragma unroll
            for (int ti = 0; ti < 4; ++ti) pb[ti] = *(const LAS bf16x8*)(RC + (64 * wi + 16 * ti + lr) * RS + 32 * ks + lq * 8);
#pragma unroll
            for (int ti = 0; ti < 4; ++ti)
#pragma unroll
                for (int te = 0; te < 4; ++te) O[ti][te] = MFMA16(va[te], pb[ti], O[ti][te]);
        }
#pragma unroll
        for (int dir = 0; dir < 2; ++dir) {
            if (dir == 0 ? has_f : has_b) {
                const bf16* St = (dir == 0 ? STF + (size_t)((c - 1) * 4 + h) * 65536 : STB + (size_t)((c + 1) * 4 + h) * 65536);
#pragma unroll
                for (int dh = 0; dh < 2; ++dh) {
                    __syncthreads();
#pragma unroll 1
                    for (int r = 0; r < 4; ++r) { const int f = opaque(tid) + 512 * r, row = f >> 4, pc = f & 15;
                        const float fac = exp2f(lg * (dir == 0 ? (float)(row + 1) : (float)(128 - row)));
                        float qf[8]; unpack8(*(const v4u*)(H + (size_t)(t0 + row) * INW + COL_Q + h * 256 + dh * 128 + pc * 8), qf);
#pragma unroll
                        for (int k = 0; k < 8; ++k) qf[k] *= fac;
                        *(LAS v4u*)(RA + row * RS + pc * 8) = pack8(qf); }
#pragma unroll 2
                    for (int r = 0; r < 8; ++r) { const int f = opaque(tid) + 512 * r, row = f >> 4, pc = f & 15;
                        *(LAS v4u*)(RB + row * RS + pc * 8) = *(const v4u*)(St + (size_t)row * 256 + dh * 128 + pc * 8); }
                    __syncthreads();
#pragma unroll
                    for (int ks = 0; ks < 4; ++ks) {
                        bf16x8 sa[4], qb[4];
#pragma unroll
                        for (int te = 0; te < 4; ++te) sa[te] = *(const LAS bf16x8*)(RB + (64 * we + 16 * te + lr) * RS + 32 * ks + lq * 8);
#pragma unroll
                        for (int ti = 0; ti < 4; ++ti) qb[ti] = *(const LAS bf16x8*)(RA + (64 * wi + 16 * ti + lr) * RS + 32 * ks + lq * 8);
#pragma unroll
                        for (int ti = 0; ti < 4; ++ti)
#pragma unroll
                            for (int te = 0; te < 4; ++te) O[ti][te] = MFMA16(sa[te], qb[ti], O[ti][te]);
                    }
                }
            }
        }
        __syncthreads();
        LAS float* RED = (LAS float*)RA;
#pragma unroll
        for (int ti = 0; ti < 4; ++ti) { float s1 = 0.f, s2 = 0.f;
#pragma unroll
            for (int te = 0; te < 4; ++te)
#pragma unroll
                for (int jj = 0; jj < 4; ++jj) { const float v = O[ti][te][jj]; s1 += v; s2 += v * v; }
            s1 += __shfl_xor(s1, 16); s1 += __shfl_xor(s1, 32); s2 += __shfl_xor(s2, 16); s2 += __shfl_xor(s2, 32);
            if (lq == 0) { RED[((64 * wi + 16 * ti + lr) * 4 + we) * 2] = s1; RED[((64 * wi + 16 * ti + lr) * 4 + we) * 2 + 1] = s2; } }
        __syncthreads();
#pragma unroll
        for (int ti = 0; ti < 4; ++ti) { const int i = 64 * wi + 16 * ti + lr;
            const f32x4 r0 = *(const LAS f32x4*)(RED + i * 8), r1 = *(const LAS f32x4*)(RED + i * 8 + 4);
            const float m = (r0[0] + r0[2] + r1[0] + r1[2]) * (1.0f / 256.0f), q = (r0[1] + r0[3] + r1[1] + r1[3]) * (1.0f / 256.0f);
            const float var = fmaxf(q - m * m, 0.f), rstd = 1.0f / sqrtf(var + GN_EPS);
#pragma unroll
            for (int te = 0; te < 4; ++te) { const int e0 = 64 * we + 16 * te + 4 * lq;
                const v2u gq = *(const v2u*)(H + (size_t)(t0 + i) * INW + COL_G + h * 256 + e0);
                const float gv[4] = {bf_lo(gq.x), bf_hi(gq.x), bf_lo(gq.y), bf_hi(gq.y)}; float ov[4];
#pragma unroll
                for (int jj = 0; jj < 4; ++jj) { const float gg = gv[jj]; ov[jj] = (gg / (1.0f + __expf(-gg))) * ((O[ti][te][jj] - m) * rstd); }
                v2u w; w.x = pkbf(ov[0], ov[1]); w.y = pkbf(ov[2], ov[3]);
                *(v2u*)(CC + (size_t)(t0 + i) * DM + 1024 + h * 256 + e0) = w; } }
        __syncthreads();
    }
}

__device__ __forceinline__ unsigned f2key(float f) { const unsigned u = __float_as_uint(f); return (u & 0x80000000u) ? ~u : (u | 0x80000000u); }
__device__ __forceinline__ float key2f(unsigned k) { const unsigned u = (k & 0x80000000u) ? (k & 0x7fffffffu) : ~k; return __uint_as_float(u); }
#define TK_CE(a, b) do { const unsigned hi_ = (a) > (b) ? (a) : (b), lo_ = (a) > (b) ? (b) : (a); (a) = hi_; (b) = lo_; } while (0)
__device__ __forceinline__ void bitonic_merge16(unsigned (&v)[16]) {
#pragma unroll
    for (int j = 8; j > 0; j >>= 1)
#pragma unroll
        for (int i = 0; i < 16; ++i) { const int l = i ^ j; if (l > i) TK_CE(v[i], v[l]); }
}
__device__ __forceinline__ void bitonic_sort16(unsigned (&v)[16]) {
#pragma unroll
    for (int k = 2; k <= 16; k <<= 1)
#pragma unroll
        for (int j = k >> 1; j > 0; j >>= 1)
#pragma unroll
            for (int i = 0; i < 16; ++i) { const int l = i ^ j; if (l > i) { if ((i & k) == 0) TK_CE(v[i], v[l]); else TK_CE(v[l], v[i]); } }
}
__device__ __forceinline__ void topk_phase(const Frame& F, CArgs& A) {
    const float* SC = (const float*)(F.ws + WS_H); int* IDX = (int*)(F.ws + WS_IDX); float* GATE = (float*)(F.ws + WS_GATE);
    LAS unsigned* LK = (LAS unsigned*)F.lds;
    const int tid = F.tid, tl = tid >> 4, hp = tid & 15;
    for (int blk = F.bx; blk < NTOK / 32; blk += F.G) {
        const int t = blk * 32 + tl;
        const float* row = SC + (size_t)t * DM + hp * 128;
        unsigned run[16];
#pragma unroll
        for (int k = 0; k < 16; ++k) run[k] = 0u;
        f32x4 cur[8], nxt[8];
#pragma unroll
        for (int q = 0; q < 8; ++q) cur[q] = *(const f32x4*)(row + q * 4);
        for (int n32 = 0; n32 < 4; ++n32) {
            if (n32 < 3) {
#pragma unroll
                for (int q = 0; q < 8; ++q) nxt[q] = *(const f32x4*)(row + (n32 + 1) * 32 + q * 4);
            }
#pragma unroll
            for (int hc = 0; hc < 2; ++hc) {
                unsigned ch[16];
#pragma unroll
                for (int q = 0; q < 4; ++q)
#pragma unroll
                    for (int e = 0; e < 4; ++e) { const int n = n32 * 32 + hc * 16 + q * 4 + e; ch[q * 4 + e] = (f2key(cur[hc * 4 + q][e]) & ~127u) | (unsigned)(127 - n); }
                bitonic_sort16(ch);
#pragma unroll
                for (int i = 0; i < 16; ++i) run[i] = run[i] > ch[15 - i] ? run[i] : ch[15 - i];
                bitonic_merge16(run);
            }
#pragma unroll
            for (int q = 0; q < 8; ++q) cur[q] = nxt[q];
        }
#pragma unroll
        for (int k = 0; k < 16; ++k) LK[tid * 17 + k] = run[k];
        __syncthreads();
        if ((hp & 1) == 0) {
            float a[16], b[16];
#pragma unroll
            for (int k = 0; k < 16; ++k) { a[k] = key2f(LK[tid * 17 + k] & ~127u); b[k] = key2f(LK[(tid + 1) * 17 + k] & ~127u); }
            unsigned sk[16];
#pragma unroll
            for (int k = 0; k < 16; ++k) sk[k] = 0u;
#pragma unroll
            for (int i = 0; i < 16; ++i)
#pragma unroll
                for (int j = 0; j < 16; ++j) if ((i + 1) * (j + 1) <= 16) {
                    unsigned key = (f2key(a[i] + b[j]) & ~255u) | (unsigned)(255 - (i * 16 + j));
#pragma unroll
                    for (int k = 0; k < 16; ++k) { const unsigned hi = sk[k] > key ? sk[k] : key, lo = sk[k] > key ? key : sk[k]; sk[k] = hi; key = lo; }
                }
            float e[16], sum = 0.f; const float s0 = key2f(sk[0] & ~255u);
#pragma unroll
            for (int k = 0; k < 16; ++k) { e[k] = __expf(key2f(sk[k] & ~255u) - s0); sum += e[k]; }
            const float inv = 1.0f / sum; const int head = hp >> 1;
#pragma unroll
            for (int k = 0; k < 16; ++k) {
                const int cell = 255 - (int)(sk[k] & 255u);
                const int i1 = 127 - (int)(LK[tid * 17 + (cell >> 4)] & 127u), i2 = 127 - (int)(LK[(tid + 1) * 17 + (cell & 15)] & 127u);
                IDX[(size_t)t * 128 + head * 16 + k] = i1 * 128 + i2;
                GATE[(size_t)t * 128 + head * 16 + k] = e[k] * inv;
            }
        }
        __syncthreads();
    }
}
#if PEER_FP4
__device__ __forceinline__ void peer_gather_phase(const Frame& F, CArgs& A, int l) {
    constexpr int RB = DM / 2;
    const unsigned char* U8 = F.ws + WS_U8 + (size_t)l * NEXP * RB; const unsigned char* V8 = F.ws + WS_V8 + (size_t)l * NEXP * RB;
    const float* USC = (const float*)(F.ws + WS_USC) + (size_t)l * NEXP; const float* VSC = (const float*)(F.ws + WS_VSC) + (size_t)l * NEXP;
    const int* IDX = (const int*)(F.ws + WS_IDX); const float* GATE = (const float*)(F.ws + WS_GATE);
    const float* g2 = A.in[I_LN2G] + (size_t)l * DM; const float* b2 = A.in[I_LN2B] + (size_t)l * DM;
    bf16* XN = (bf16*)(F.ws + WS_XN);
    const int lane = F.lane, slot = 8 * (lane & 7) + (lane >> 3);
    for (int t = F.gw; t < NTOK; t += F.NGW) {
        float* xrow = F.out + (size_t)t * DM;
        f32x2v x[16];
#pragma unroll
        for (int q = 0; q < 8; ++q) { const f32x4 a = *(const f32x4*)(xrow + lane * 32 + q * 4); x[2 * q] = (f32x2v){a[0], a[1]}; x[2 * q + 1] = (f32x2v){a[2], a[3]}; }
        const int idx0 = IDX[(size_t)t * 128 + slot], idx1 = IDX[(size_t)t * 128 + 64 + slot];
        v4u BU[16];
        const unsigned loff = (unsigned)lane * 16u;
#define G_ROW_U(R) (U8 + (size_t)(unsigned)__builtin_amdgcn_readlane((((R) >> 6) & 1) ? idx1 : idx0, ((R) & 7) * 8 + (((R) >> 3) & 7)) * RB)
#define G_ROW_V(R) (V8 + (size_t)(unsigned)__builtin_amdgcn_readlane((((R) >> 6) & 1) ? idx1 : idx0, (R) & 63) * RB)
#define G_REQ(r, rowptr) do { BU[r] = *(const v4u*)((rowptr) + loff); } while (0)
#define G_DOT(r, dst) do { f32x2v s2_ = (f32x2v){0.f, 0.f}; \
            _Pragma("unroll") for (int q = 0; q < 4; ++q) { s2_ += __builtin_amdgcn_cvt_scalef32_pk_f32_fp4(BU[r][q], 1.0f, 0) * x[4 * q]; s2_ += __builtin_amdgcn_cvt_scalef32_pk_f32_fp4(BU[r][q], 1.0f, 1) * x[4 * q + 1]; \
                s2_ += __builtin_amdgcn_cvt_scalef32_pk_f32_fp4(BU[r][q], 1.0f, 2) * x[4 * q + 2]; s2_ += __builtin_amdgcn_cvt_scalef32_pk_f32_fp4(BU[r][q], 1.0f, 3) * x[4 * q + 3]; } \
            dst = s2_[0] + s2_[1]; } while (0)
#define G_REDUCE(g) do { \
            _Pragma("unroll") for (int i = 0; i < 4; ++i) { const float mine = b5 ? part[i + 4] : part[i], send = b5 ? part[i] : part[i + 4]; part[i] = mine + __shfl_xor(send, 32); } \
            _Pragma("unroll") for (int i = 0; i < 2; ++i) { const float mine = b4 ? part[i + 2] : part[i], send = b4 ? part[i] : part[i + 2]; part[i] = mine + __shfl_xor(send, 16); } \
            { const float mine = b3 ? part[1] : part[0], send = b3 ? part[0] : part[1]; part[0] = mine + __shfl_xor(send, 8); } \
            float v_ = part[0]; v_ += __shfl_xor(v_, 4); v_ += __shfl_xor(v_, 2); v_ += __shfl_xor(v_, 1); \
            const bool mine_ = (lane & 7) == ((g) & 7); hval0 = (mine_ && ((g) >> 3) == 0) ? v_ : hval0; hval1 = (mine_ && ((g) >> 3) == 1) ? v_ : hval1; } while (0)
        const bool b5 = (lane & 32) != 0, b4 = (lane & 16) != 0, b3 = (lane & 8) != 0;
        float hval0 = 0.f, hval1 = 0.f;
#pragma unroll
        for (int r = 0; r < 16; ++r) G_REQ(r, G_ROW_U(r));
        for (int it = 0; it < 7; ++it) {
            float part[8];
#pragma unroll
            for (int r = 0; r < 8; ++r) { G_DOT(r, part[r]); G_REQ(r, G_ROW_U(16 * (it + 1) + r)); }
            G_REDUCE(2 * it);
#pragma unroll
            for (int r = 8; r < 16; ++r) { G_DOT(r, part[r - 8]); G_REQ(r, G_ROW_U(16 * (it + 1) + r)); }
            G_REDUCE(2 * it + 1);
        }
        {
            float part[8];
#pragma unroll
            for (int r = 0; r < 8; ++r) { G_DOT(r, part[r]); G_REQ(r, G_ROW_V(r)); }
            G_REDUCE(14);
#pragma unroll
            for (int r = 8; r < 16; ++r) { G_DOT(r, part[r - 8]); G_REQ(r, G_ROW_V(r)); }
            G_REDUCE(15);
        }
        const float gate0 = GATE[(size_t)t * 128 + slot], gate1 = GATE[(size_t)t * 128 + 64 + slot];
        const float usc0 = USC[idx0], usc1 = USC[idx1], vsc0 = VSC[idx0], vsc1 = VSC[idx1];
        const float w0 = gate0 * gelu_erf(hval0 * usc0) * vsc0, w1 = gate1 * gelu_erf(hval1 * usc1) * vsc1;
        f32x2v acc[16];
#pragma unroll
        for (int k = 0; k < 16; ++k) acc[k] = (f32x2v){0.f, 0.f};
#define G_AXPY(r, R) do { const float w_ = __uint_as_float((unsigned)__builtin_amdgcn_readlane((int)__float_as_uint((((R) >> 6) & 1) ? w1 : w0), (R) & 63)); const f32x2v w2_ = (f32x2v){w_, w_}; \
            _Pragma("unroll") for (int q = 0; q < 4; ++q) { acc[4 * q] += w2_ * __builtin_amdgcn_cvt_scalef32_pk_f32_fp4(BU[r][q], 1.0f, 0); acc[4 * q + 1] += w2_ * __builtin_amdgcn_cvt_scalef32_pk_f32_fp4(BU[r][q], 1.0f, 1); \
                acc[4 * q + 2] += w2_ * __builtin_amdgcn_cvt_scalef32_pk_f32_fp4(BU[r][q], 1.0f, 2); acc[4 * q + 3] += w2_ * __builtin_amdgcn_cvt_scalef32_pk_f32_fp4(BU[r][q], 1.0f, 3); } } while (0)
        for (int it = 0; it < 7; ++it) {
#pragma unroll
            for (int r = 0; r < 16; ++r) { G_AXPY(r, 16 * it + r); G_REQ(r, G_ROW_V(16 * (it + 1) + r)); }
        }
#pragma unroll
        for (int r = 0; r < 16; ++r) G_AXPY(r, 112 + r);
#undef G_ROW_U
#undef G_ROW_V
#undef G_REQ
#undef G_DOT
#undef G_REDUCE
#undef G_AXPY
        const int le = opaque(lane);
        float s = 0.f;
#pragma unroll
        for (int k = 0; k < 16; ++k) { const f32x2v xr = *(const f32x2v*)(xrow + le * 32 + 2 * k); acc[k] = xr * ALPHA + acc[k]; s += acc[k][0] + acc[k][1]; }
        const float mean = wave_sum(s) * (1.0f / DM); float s2 = 0.f;
#pragma unroll
        for (int k = 0; k < 16; ++k) { acc[k] = acc[k] - mean; s2 += acc[k][0] * acc[k][0] + acc[k][1] * acc[k][1]; }
        const float rstd = 1.0f / sqrtf(wave_sum(s2) * (1.0f / DM) + LN_EPS);
#pragma unroll
        for (int h8 = 0; h8 < 4; ++h8) { const int col = le * 32 + h8 * 8; float o[8];
#pragma unroll
            for (int q = 0; q < 2; ++q) { const f32x4 gg = *(const f32x4*)(g2 + col + q * 4), bb = *(const f32x4*)(b2 + col + q * 4);
                const f32x2v a0 = acc[h8 * 4 + 2 * q], a1 = acc[h8 * 4 + 2 * q + 1];
                o[4 * q] = a0[0] * rstd * gg[0] + bb[0]; o[4 * q + 1] = a0[1] * rstd * gg[1] + bb[1]; o[4 * q + 2] = a1[0] * rstd * gg[2] + bb[2]; o[4 * q + 3] = a1[1] * rstd * gg[3] + bb[3];
                *(f32x4*)(xrow + col + q * 4) = (f32x4){o[4 * q], o[4 * q + 1], o[4 * q + 2], o[4 * q + 3]}; }
            *(v4u*)(XN + (size_t)t * DM + col) = pack8(o); }
    }
}

#else
__device__ __forceinline__ void peer_gather_phase(const Frame& F, CArgs& A, int l) {
    const unsigned char* U8 = F.ws + WS_U8 + (size_t)l * NEXP * DM; const unsigned char* V8 = F.ws + WS_V8 + (size_t)l * NEXP * DM;
    const float* USC = (const float*)(F.ws + WS_USC) + (size_t)l * NEXP; const float* VSC = (const float*)(F.ws + WS_VSC) + (size_t)l * NEXP;
    const int* IDX = (const int*)(F.ws + WS_IDX); const float* GATE = (const float*)(F.ws + WS_GATE);
    const float* g2 = A.in[I_LN2G] + (size_t)l * DM; const float* b2 = A.in[I_LN2B] + (size_t)l * DM;
    bf16* XN = (bf16*)(F.ws + WS_XN);
    const int lane = F.lane, slot = 8 * (lane & 7) + (lane >> 3);
    for (int t = F.gw; t < NTOK; t += F.NGW) {
        float* xrow = F.out + (size_t)t * DM;
        f32x2v x[2][8];
#pragma unroll
        for (int c = 0; c < 2; ++c)
#pragma unroll
            for (int q = 0; q < 4; ++q) { const f32x4 a = *(const f32x4*)(xrow + (c * 64 + lane) * 16 + q * 4); x[c][2 * q] = (f32x2v){a[0], a[1]}; x[c][2 * q + 1] = (f32x2v){a[2], a[3]}; }
        const int idx0 = IDX[(size_t)t * 128 + slot], idx1 = IDX[(size_t)t * 128 + 64 + slot];
        v4u BU[8][2];
        const unsigned loff0 = (unsigned)lane * 16u, loff1 = (unsigned)lane * 16u + 1024u;
#define G_ROW_U(i, b) (U8 + (size_t)(unsigned)__builtin_amdgcn_readlane(((b) >> 3) ? idx1 : idx0, (i) * 8 + ((b) & 7)) * DM)
#define G_ROW_V(i, b) (V8 + (size_t)(unsigned)__builtin_amdgcn_readlane(((b) >> 3) ? idx1 : idx0, ((b) & 7) * 8 + (i)) * DM)
#define G_REQ(i, rowptr) do { const unsigned char* r_ = (rowptr); BU[i][0] = *(const v4u*)(r_ + loff0); BU[i][1] = *(const v4u*)(r_ + loff1); } while (0)
#define G_DOT(i, dst) do { f32x2v s2_ = (f32x2v){0.f, 0.f}; \
            _Pragma("unroll") for (int c = 0; c < 2; ++c) _Pragma("unroll") for (int q = 0; q < 4; ++q) { s2_ += __builtin_amdgcn_cvt_pk_f32_fp8((int)BU[i][c][q], false) * x[c][2 * q]; s2_ += __builtin_amdgcn_cvt_pk_f32_fp8((int)BU[i][c][q], true) * x[c][2 * q + 1]; } \
            dst = s2_[0] + s2_[1]; } while (0)
#define G_REDUCE(b) do { \
            _Pragma("unroll") for (int i = 0; i < 4; ++i) { const float mine = b5 ? part[i + 4] : part[i], send = b5 ? part[i] : part[i + 4]; part[i] = mine + __shfl_xor(send, 32); } \
            _Pragma("unroll") for (int i = 0; i < 2; ++i) { const float mine = b4 ? part[i + 2] : part[i], send = b4 ? part[i] : part[i + 2]; part[i] = mine + __shfl_xor(send, 16); } \
            { const float mine = b3 ? part[1] : part[0], send = b3 ? part[0] : part[1]; part[0] = mine + __shfl_xor(send, 8); } \
            float v_ = part[0]; v_ += __shfl_xor(v_, 4); v_ += __shfl_xor(v_, 2); v_ += __shfl_xor(v_, 1); \
            const bool mine_ = (lane & 7) == ((b) & 7); hval0 = (mine_ && ((b) >> 3) == 0) ? v_ : hval0; hval1 = (mine_ && ((b) >> 3) == 1) ? v_ : hval1; } while (0)
        const bool b5 = (lane & 32) != 0, b4 = (lane & 16) != 0, b3 = (lane & 8) != 0;
        float hval0 = 0.f, hval1 = 0.f;
#pragma unroll
        for (int i = 0; i < 8; ++i) G_REQ(i, G_ROW_U(i, 0));
        for (int b = 0; b < 15; ++b) {
            float part[8];
#pragma unroll
            for (int i = 0; i < 8; ++i) { G_DOT(i, part[i]); G_REQ(i, G_ROW_U(i, b + 1)); }
            G_REDUCE(b);
        }
        {
            float part[8];
#pragma unroll
            for (int i = 0; i < 8; ++i) { G_DOT(i, part[i]); G_REQ(i, G_ROW_V(i, 0)); }
            G_REDUCE(15);
        }
        const float gate0 = GATE[(size_t)t * 128 + slot], gate1 = GATE[(size_t)t * 128 + 64 + slot];
        const float usc0 = USC[idx0], usc1 = USC[idx1], vsc0 = VSC[idx0], vsc1 = VSC[idx1];
        const float w0 = gate0 * gelu_erf(hval0 * usc0) * vsc0, w1 = gate1 * gelu_erf(hval1 * usc1) * vsc1;
        f32x2v acc[2][8];
#pragma unroll
        for (int c = 0; c < 2; ++c)
#pragma unroll
            for (int k = 0; k < 8; ++k) acc[c][k] = (f32x2v){0.f, 0.f};
#define G_AXPY(i, b) do { const float w_ = __uint_as_float((unsigned)__builtin_amdgcn_readlane((int)__float_as_uint(((b) >> 3) ? w1 : w0), ((b) & 7) * 8 + (i))); const f32x2v w2_ = (f32x2v){w_, w_}; \
            _Pragma("unroll") for (int c = 0; c < 2; ++c) _Pragma("unroll") for (int q = 0; q < 4; ++q) { acc[c][2 * q] += w2_ * __builtin_amdgcn_cvt_pk_f32_fp8((int)BU[i][c][q], false); acc[c][2 * q + 1] += w2_ * __builtin_amdgcn_cvt_pk_f32_fp8((int)BU[i][c][q], true); } } while (0)
        for (int b = 0; b < 15; ++b) {
#pragma unroll
            for (int i = 0; i < 8; ++i) { G_AXPY(i, b); G_REQ(i, G_ROW_V(i, b + 1)); }
        }
#pragma unroll
        for (int i = 0; i < 8; ++i) G_AXPY(i, 15);
#undef G_ROW_U
#undef G_ROW_V
#undef G_REQ
#undef G_DOT
#undef G_REDUCE
#undef G_AXPY
        const int le = opaque(lane);
        float s = 0.f;
#pragma unroll
        for (int c = 0; c < 2; ++c)
#pragma unroll
            for (int k = 0; k < 8; ++k) { const f32x2v xr = *(const f32x2v*)(xrow + (c * 64 + le) * 16 + 2 * k);
                acc[c][k] = xr * ALPHA + acc[c][k]; s += acc[c][k][0] + acc[c][k][1]; }
        const float mean = wave_sum(s) * (1.0f / DM); float s2 = 0.f;
#pragma unroll
        for (int c = 0; c < 2; ++c)
#pragma unroll
            for (int k = 0; k < 8; ++k) { acc[c][k] = acc[c][k] - mean; s2 += acc[c][k][0] * acc[c][k][0] + acc[c][k][1] * acc[c][k][1]; }
        const float rstd = 1.0f / sqrtf(wave_sum(s2) * (1.0f / DM) + LN_EPS);
#pragma unroll
        for (int c = 0; c < 2; ++c) { const int col = (c * 64 + le) * 16;
#pragma unroll
            for (int h8 = 0; h8 < 2; ++h8) { float o[8];
#pragma unroll
                for (int q = 0; q < 2; ++q) { const f32x4 gg = *(const f32x4*)(g2 + col + h8 * 8 + q * 4), bb = *(const f32x4*)(b2 + col + h8 * 8 + q * 4);
                    const f32x2v a0 = acc[c][h8 * 4 + 2 * q], a1 = acc[c][h8 * 4 + 2 * q + 1];
                    o[4 * q] = a0[0] * rstd * gg[0] + bb[0]; o[4 * q + 1] = a0[1] * rstd * gg[1] + bb[1]; o[4 * q + 2] = a1[0] * rstd * gg[2] + bb[2]; o[4 * q + 3] = a1[1] * rstd * gg[3] + bb[3];
                    *(f32x4*)(xrow + col + h8 * 8 + q * 4) = (f32x4){o[4 * q], o[4 * q + 1], o[4 * q + 2], o[4 * q + 3]}; }
                *(v4u*)(XN + (size_t)t * DM + col + h8 * 8) = pack8(o); } }
    }
}

#endif
#ifndef DUP_MASK
#define DUP_MASK 0
#endif
#ifndef PHASE_TEST_ONLY
__global__ void __launch_bounds__(NTHR, 2) fwd_kernel(Args A) {
    extern __shared__ __attribute__((aligned(16))) unsigned char lds_raw[];
#define MKFRAME() Frame F; CArgs& KA = *(CArgs*)opaque_u64((unsigned long long)__builtin_amdgcn_kernarg_segment_ptr()); { F.lds = (LAS unsigned char*)lds_raw; F.tid = opaque((int)threadIdx.x); F.lane = F.tid & 63; F.wave = __builtin_amdgcn_readfirstlane(F.tid >> 6); \
        const int bx_ = opaque_s((int)blockIdx.x); F.G = gridDim.x; F.gw = bx_ * NWAVES + F.wave; F.NGW = F.G * NWAVES; F.gtid = (size_t)bx_ * NTHR + F.tid; F.NT = (size_t)F.G * NTHR; F.out = (float*)opaque_p(KA.out); F.ws = (unsigned char*)opaque_p(KA.ws); F.bx = bx_; } \
        bf16* XN = (bf16*)(F.ws + WS_XN); bf16* H = (bf16*)(F.ws + WS_H); bf16* CC = (bf16*)(F.ws + WS_CONCAT); (void)XN; (void)H; (void)CC;
    volatile LAS unsigned* MISC = (volatile LAS unsigned*)((LAS unsigned char*)lds_raw + LDS_MISC);
    if (threadIdx.x < 64) MISC[threadIdx.x] = 0u;
    __syncthreads();
    XcdBarrier bar = xcd_barrier_post((unsigned*)(A.ws + WS_CTL) + CW_BAR + A.li * XCD_BAR_WORDS, MISC + 8);
    const int lo = A.ph_lo, hi = A.ph_hi;
#define IN(k) (lo <= (k) && (k) < hi)
#define SEAM(k) do { if (lo <= (k) && (k) + 1 < hi) xcd_barrier(bar); } while (0)

    if (IN(0)) { MKFRAME(); p0_prologue(F, KA); } SEAM(0);

    for (int l = 0; l < NLAYER; ++l) {
        const int pb = 1 + l * 10;
        if (IN(pb + 0)) { MKFRAME();
            pg8::Gemm g{XN, (const bf16*)(F.ws + WS_WIN) + (size_t)l * INW * DM, NTOK, INW, DM}; pg8::StaticOrder S; S.init(NTOK, INW, F.G, F.bx);
            EpiStoreBf16 E{H, INW};
            pg8::gemm_phase<EpiStoreBf16, pg8::StaticOrder, true, true>(F.lds, g, S, E);
            if (DUP_MASK & 64) { pg8::gemm_phase<EpiStoreBf16, pg8::StaticOrder, true, true>(F.lds, g, S, E); }
        } SEAM(pb + 0);
        if (IN(pb + 1)) { MKFRAME(); s5_pass1(F, KA, l); pool_phase(F, KA); if (DUP_MASK & 1) { s5_pass1(F, KA, l); } if (DUP_MASK & 2) { pool_phase(F, KA); } rotary_phase(F, KA); } SEAM(pb + 1);
        if (IN(pb + 2)) { MKFRAME(); s5_carry(F, KA, l); __syncthreads(); ret_state_phase(F, KA); if (DUP_MASK & 4) { ret_state_phase(F, KA); } } SEAM(pb + 2);
        if (IN(pb + 3)) { MKFRAME(); s5_pass3(F, KA, l); if (DUP_MASK & 8) { s5_pass3(F, KA, l); } ret_prefix_phase(F, KA); } SEAM(pb + 3);
        if (IN(pb + 4)) { MKFRAME();
            __syncthreads();
            ret_out_phase(F, KA);
            if (DUP_MASK & 16) { ret_out_phase(F, KA); }
            {
                pg8::Gemm g{(const bf16*)(F.ws + WS_BUFY), (const bf16*)(F.ws + WS_WGLU) + (size_t)l * 512 * 512, NTOK, 512, 512}; pg8::StaticOrder S; S.init(NTOK, 512, F.G, F.bx);
                EpiGlu E{(const bf16*)(F.ws + WS_BUFY), 512, CC, DM, KA.in[I_BGLU] + (size_t)l * 512};
                pg8::gemm_phase<EpiGlu, pg8::StaticOrder, true, true>(F.lds, g, S, E);
            }
            {
                pg8::Gemm g{(const bf16*)(F.ws + WS_BUFP), (const bf16*)(F.ws + WS_WPOOL) + (size_t)l * 512 * 512, NTOK, 512, 512}; pg8::StaticOrder S; S.init(NTOK, 512, F.G, F.bx);
                EpiScaleBf16 E{CC + 512, DM, KA.in[I_POOLS] + (size_t)l * 512};
                pg8::gemm_phase<EpiScaleBf16, pg8::StaticOrder, true, true>(F.lds, g, S, E);
            }
        } SEAM(pb + 4);
        if (IN(pb + 5)) { MKFRAME();
            pg8::Gemm g{CC, (const bf16*)(F.ws + WS_WOUT) + (size_t)l * DM * DM, NTOK, DM, DM}; pg8::StaticOrder S; S.init(NTOK, DM, F.G, F.bx);
            EpiResid E{F.out, DM, ALPHA};
            pg8::gemm_phase<EpiResid, pg8::StaticOrder, true, true>(F.lds, g, S, E);
        } SEAM(pb + 5);
        if (IN(pb + 6)) { MKFRAME();
            for (int t = F.gw; t < NTOK; t += F.NGW) ln_row(F.out + (size_t)t * DM, KA.in[I_LN1G] + (size_t)l * DM, KA.in[I_LN1B] + (size_t)l * DM, F.out + (size_t)t * DM, XN + (size_t)t * DM, F.lane);
        } SEAM(pb + 6);
        if (IN(pb + 7)) { MKFRAME();
            pg8::Gemm g{XN, (const bf16*)(F.ws + WS_WS) + (size_t)l * DM * DM, NTOK, DM, DM}; pg8::StaticOrder S; S.init(NTOK, DM, F.G, F.bx);
            EpiStoreF32 E{(float*)(F.ws + WS_H), DM};
            pg8::gemm_phase<EpiStoreF32, pg8::StaticOrder, true, true>(F.lds, g, S, E);
            if (DUP_MASK & 128) { pg8::gemm_phase<EpiStoreF32, pg8::StaticOrder, true, true>(F.lds, g, S, E); }
        } SEAM(pb + 7);
        if (IN(pb + 8)) { MKFRAME(); __syncthreads(); topk_phase(F, KA); if (DUP_MASK & 32) { topk_phase(F, KA); } } SEAM(pb + 8);
        if (IN(pb + 9)) { MKFRAME(); peer_gather_phase(F, KA, l); } SEAM(pb + 9);
    }
#undef IN
#undef SEAM
}


#ifndef DBG_STOP
#define DBG_STOP NPHASE
#endif
#ifndef DBG_DUMP
#define DBG_DUMP 0
#endif
__global__ void dbg_dump_kernel(float* out, const unsigned char* ws, int mode) {
    const size_t n = (size_t)NTOK * DM;
    for (size_t i = (size_t)blockIdx.x * blockDim.x + threadIdx.x; i < n; i += (size_t)gridDim.x * blockDim.x) {
        float v = 0.f;
        if (mode == 1) v = bf_lo(((const bf16*)(ws + WS_H))[i]);
        else if (mode == 2) v = bf_lo(((const bf16*)(ws + WS_CONCAT))[i]);
        else if (mode == 3) v = bf_lo(((const bf16*)(ws + WS_BUFY))[i % ((size_t)NTOK * 1024)]);
        else if (mode == 4) v = bf_lo(((const bf16*)(ws + WS_STF))[i]);
        else if (mode == 5) v = ((const float*)(ws + WS_H))[i];
        else if (mode == 6) v = (i < (size_t)NTOK * 128) ? (float)((const int*)(ws + WS_IDX))[i] : ((i < (size_t)NTOK * 256) ? ((const float*)(ws + WS_GATE))[i - (size_t)NTOK * 128] : 0.f);
        else if (mode == 7) v = bf_lo(((const bf16*)(ws + WS_XN))[i]);
        else if (mode == 8) v = bf_lo(((const bf16*)(ws + WS_STB))[i]);
        else if (mode == 9) v = bf_lo(((const bf16*)(ws + WS_H))[i + (size_t)NTOK * DM]);
        else if (mode == 10) v = bf_lo(((const bf16*)(ws + WS_WIN))[i % ((size_t)72 * 1024 * 1024)]);
        else if (mode == 11) v = ((const float*)(ws + WS_S5ST))[i % ((size_t)5 * 1024 * 1024)];
        else if (mode == 12) v = bf_lo(((const bf16*)(ws + WS_H))[i]) + bf_lo(((const bf16*)(ws + WS_H))[i + (size_t)NTOK * DM]) + bf_lo(((const bf16*)(ws + WS_BUFP))[i % ((size_t)NTOK * 512)]) + ((const float*)(ws + WS_S5ST))[i % ((size_t)5 * 1024 * 1024)];
        else if (mode == 13) v = bf_lo(((const bf16*)(ws + WS_STF))[i]) + bf_lo(((const bf16*)(ws + WS_STB))[i]) + ((const float*)(ws + WS_S5ST))[i % ((size_t)5 * 1024 * 1024)];
        else if (mode == 14) v = bf_lo(((const bf16*)(ws + WS_STF))[i]) + bf_lo(((const bf16*)(ws + WS_STB))[i]) + bf_lo(((const bf16*)(ws + WS_BUFY))[i % ((size_t)NTOK * 512)]);
        else if (mode == 15) v = bf_lo(((const bf16*)(ws + WS_H))[i]) + bf_lo(((const bf16*)(ws + WS_H))[i + (size_t)NTOK * DM]) + bf_lo(((const bf16*)(ws + WS_H))[i + (size_t)NTOK * 3072]);
        out[i] = v;
    }
}
#ifndef MK_ONE_LAUNCH
#define MK_ONE_LAUNCH 0
#endif
extern "C" void kernel_launch(void* const* d_in, const int* in_sizes, int n_in, void* d_out, int out_size, void* d_ws, size_t ws_size, hipStream_t stream) {
    static int grid = 0;
    if (grid == 0) {
        if (n_in != 26 || out_size != NTOK * DM || ws_size < WS_END) { fprintf(stderr, "kernel_launch: unexpected shapes (n_in %d out %d ws %zu)\n", n_in, out_size, ws_size); grid = -1; return; }
        int dev = 0, cus = 0, per_cu = 0;
        if (hipGetDevice(&dev) != hipSuccess || hipDeviceGetAttribute(&cus, hipDeviceAttributeMultiprocessorCount, dev) != hipSuccess) { grid = -1; return; }
        if (hipFuncSetAttribute((const void*)fwd_kernel, hipFuncAttributeMaxDynamicSharedMemorySize, LDS_BYTES) != hipSuccess) { fprintf(stderr, "kernel_launch: hipFuncSetAttribute failed\n"); grid = -1; return; }
        if (hipOccupancyMaxActiveBlocksPerMultiprocessor(&per_cu, (const void*)fwd_kernel, NTHR, LDS_BYTES) != hipSuccess || per_cu < 1) { fprintf(stderr, "kernel_launch: occupancy query says %d\n", per_cu); grid = -1; (void)hipGetLastError(); return; }
        (void)hipGetLastError();
        grid = cus;
    }
    if (grid < 0) return;
    if (hipMemsetAsync((char*)d_ws + WS_CTL, 0, CTL_ZERO_BYTES, stream) != hipSuccess) return;
    Args a{};
    for (int i = 0; i < 26; ++i) a.in[i] = (const float*)d_in[i];
    a.out = (float*)d_out; a.ws = (unsigned char*)d_ws; a.pad = 0;
#if MK_ONE_LAUNCH
    a.ph_lo = 0; a.ph_hi = NPHASE; a.li = 0;
    hipLaunchKernelGGL(fwd_kernel, dim3(grid), dim3(NTHR), LDS_BYTES, stream, a);
#else
    for (int p = 0; p < DBG_STOP; ++p) { a.ph_lo = p; a.ph_hi = p + 1; a.li = p; hipLaunchKernelGGL(fwd_kernel, dim3(grid), dim3(NTHR), LDS_BYTES, stream, a); }
#endif
    if (DBG_DUMP) hipLaunchKernelGGL(dbg_dump_kernel, dim3(2048), dim3(256), 0, stream, (float*)d_out, (const unsigned char*)d_ws, DBG_DUMP);
}
#endif
```

```cpp
#include <hip/hip_runtime.h>
#include <cstdio>
#include <cstdint>
#include <cmath>
__device__ __forceinline__ int opaque(int v) { asm volatile("" : "+v"(v)); return v; }
__device__ __forceinline__ int opaque_s(int v) { asm volatile("" : "+s"(v)); return v; }
__device__ __forceinline__ void* opaque_p(void* p) { asm volatile("" : "+s"(p)); return p; }
__device__ __forceinline__ unsigned long long opaque_u64(unsigned long long v) { asm volatile("" : "+s"(v)); return v; }
#ifndef PEER_FP4
#define PEER_FP4 1
#endif
#ifndef GATHER_ROWS
#define GATHER_ROWS 32
#endif
#ifndef GATHER_PROBE
#define GATHER_PROBE 0
#endif
#ifndef GATHER_PROBE2
#define GATHER_PROBE2 0
#endif
#define MK_ONE_LAUNCH 1
namespace pg8 {
#define PG8_LAS __attribute__((address_space(3)))
typedef unsigned short bf16_t;
typedef short bf16x8 __attribute__((ext_vector_type(8)));
typedef float f32x4 __attribute__((ext_vector_type(4)));
typedef unsigned u32x4 __attribute__((ext_vector_type(4)));
constexpr int BM = 256, BK = 64, HALF = 128, HTB = HALF * BK * 2  , STAGE_BYTES = 8 * HTB, NXCD = 8, WGM = 8;

__host__ __device__ __forceinline__ int lds_byte(int r, int c) { const int st = (r >> 4) * 2 + (c >> 5), rr = r & 15, cc = c & 31, ob = rr * 64 + cc * 2; return st * 1024 + (ob ^ (((ob >> 9) & 1) << 5)); }
__host__ __device__ __forceinline__ void stage_rc(int b, int& R, int& C) { const int st = b / 1024, sb = b % 1024, swz = sb ^ (((sb >> 9) & 1) << 5); R = (st >> 1) * 16 + swz / 64; C = (st & 1) * 32 + (swz % 64) / 2; }
__host__ __device__ __forceinline__ int perm32(int rho) { const int n = rho >> 4, i = rho & 15; return 8 * (i >> 2) + 4 * n + (i & 3); }

struct Unit { int pm, pn; };
struct Gemm { const bf16_t* A; const bf16_t* Bt; int M, N, K; };

struct StaticOrder {
    int nM, nN, nwg, G, c;
    __host__ __device__ void init(int M, int N, int G_, int c_) { nM = M / BM; nN = N / BM; nwg = nM * nN; G = G_; c = c_; }
    __host__ __device__ bool next(int i, Unit& u) const {
        const long L = (long)i * G + c; if (L >= nwg) return false;
        int wgid = (int)L; { const int q = nwg / NXCD, r = nwg % NXCD, xcd = wgid % NXCD, off = wgid / NXCD; wgid = (xcd < r ? xcd * (q + 1) : r * (q + 1) + (xcd - r) * q) + off; }
        const int nig = WGM * nN, gid = wgid / nig, fm = gid * WGM, gsz = (nM - fm) < WGM ? (nM - fm) : WGM;
        u.pm = fm + ((wgid % nig) % gsz); u.pn = (wgid % nig) / gsz; return true;
    }
    __device__ __forceinline__ void a_ready(const Unit&) const {}
    __device__ __forceinline__ void done(const Unit&) const {}
};
__device__ __forceinline__ unsigned cvt_pk_bf16(float lo, float hi) { unsigned r; asm volatile("v_cvt_pk_bf16_f32 %0, %1, %2" : "=v"(r) : "v"(lo), "v"(hi)); return r; }
typedef float f32x2 __attribute__((ext_vector_type(2)));
template <class Epi, class Sched, bool ALIGN_EPI = false, bool SP2 = false>
__device__ __forceinline__ void gemm_phase(PG8_LAS unsigned char* lds, const Gemm g, const Sched& S, const Epi& E) {
    const int tid = opaque((int)threadIdx.x), wid = __builtin_amdgcn_readfirstlane(tid >> 6), lane = tid & 63, wr = wid >> 2, wc = wid & 3, fr = lane & 15, fq = lane >> 4;
    const int K = g.K, nt = K / BK;
    unsigned voffA[2], voffB[2];
#pragma unroll
    for (int i = 0; i < 2; ++i) { int R, C; stage_rc(tid * 16 + i * 8192, R, C); const int Rb = Epi::PERM ? ((R & ~31) + perm32(R & 31)) : R;
        voffA[i] = (unsigned)(R * K + C) * 2u; voffB[i] = (unsigned)(Rb * K + C) * 2u; }
    const size_t kstep = (size_t)(BK * 2);
    const size_t hstep = (size_t)HALF * K * 2;
    const size_t tstep = 2 * hstep;
    const unsigned ldsw = (unsigned)wid * 1024u;
    const int aoff = lds_byte(wr * 64 + fr, fq * 8), boff = lds_byte(wc * 32 + fr, fq * 8);
#define PG8_SA(b, h) (((b) * 2 + (h)) * HTB)
#define PG8_SB(b, h) ((4 + (b) * 2 + (h)) * HTB)
#define PG8_STAGE(bufoff, gbase, voff) do { _Pragma("unroll") for (int _i = 0; _i < 2; ++_i) \
        __builtin_amdgcn_global_load_lds((const unsigned*)((const char*)(gbase) + (voff)[_i]), (PG8_LAS unsigned*)(lds + (bufoff) + ldsw + _i * 8192), 16, 0, 0); } while (0)
#define PG8_LDA(dst, b, h) do { _Pragma("unroll") for (int m = 0; m < 4; ++m) _Pragma("unroll") for (int k = 0; k < 2; ++k) dst[m][k] = *(const PG8_LAS bf16x8*)(lds + PG8_SA(b, h) + aoff + m * 2048 + k * 1024); } while (0)
#define PG8_LDB(dst, b, h) do { _Pragma("unroll") for (int n = 0; n < 2; ++n) _Pragma("unroll") for (int k = 0; k < 2; ++k) dst[n][k] = *(const PG8_LAS bf16x8*)(lds + PG8_SB(b, h) + boff + n * 2048 + k * 1024); } while (0)
#define PG8_MMA(ai, bj, At, Bt) do { __builtin_amdgcn_s_setprio(1); _Pragma("unroll") for (int m = 0; m < 4; ++m) _Pragma("unroll") for (int n = 0; n < 2; ++n) _Pragma("unroll") for (int k = 0; k < 2; ++k) \
        acc[ai][bj][m][n] = __builtin_amdgcn_mfma_f32_16x16x32_bf16(Bt[n][k], At[m][k], acc[ai][bj][m][n], 0, 0, 0); __builtin_amdgcn_s_setprio(0); } while (0)
#define PG8_WAIT_V(n) asm volatile("s_waitcnt vmcnt(" #n ")" ::: "memory")
#define PG8_WAIT_L(n) asm volatile("s_waitcnt lgkmcnt(" #n ")" ::: "memory")
#define PG8_BAR __builtin_amdgcn_s_barrier()
#define PG8_SCHED __builtin_amdgcn_sched_barrier(0)
    Unit cur, nxt; int ui = 0;
    if (!S.next(0, cur)) return;
    f32x4 acc[2][2][4][2];
#pragma unroll
    for (int a = 0; a < 2; ++a)
#pragma unroll
        for (int b = 0; b < 2; ++b)
#pragma unroll
            for (int m = 0; m < 4; ++m)
#pragma unroll
                for (int n = 0; n < 2; ++n) acc[a][b][m][n] = (f32x4){0.f, 0.f, 0.f, 0.f};
    bf16x8 At[4][2], B0[2][2], B1[2][2];
    const char* cA = (const char*)g.A + (size_t)cur.pm * tstep; const char* cB = (const char*)g.Bt + (size_t)cur.pn * tstep;
    S.a_ready(cur);
    if constexpr (SP2) {
        PG8_STAGE(PG8_SB(0, 0), cB, voffB); PG8_STAGE(PG8_SB(0, 1), cB + hstep, voffB); PG8_STAGE(PG8_SA(0, 0), cA, voffA); PG8_STAGE(PG8_SA(0, 1), cA + hstep, voffA);
        if (wr == 1) PG8_BAR;
        PG8_WAIT_V(2); PG8_BAR;
        PG8_STAGE(PG8_SB(1, 0), cB + kstep, voffB); PG8_STAGE(PG8_SA(1, 0), cA + kstep, voffA); PG8_STAGE(PG8_SB(1, 1), cB + hstep + kstep, voffB);
        PG8_WAIT_V(6); PG8_BAR;
    } else {
        PG8_STAGE(PG8_SB(0, 0), cB, voffB); PG8_STAGE(PG8_SA(0, 0), cA, voffA); PG8_STAGE(PG8_SB(0, 1), cB + hstep, voffB); PG8_STAGE(PG8_SA(0, 1), cA + hstep, voffA);
        if (wr == 1) PG8_BAR;
        PG8_WAIT_V(4); PG8_BAR;
        PG8_STAGE(PG8_SB(1, 0), cB + kstep, voffB); PG8_STAGE(PG8_SA(1, 0), cA + kstep, voffA); PG8_STAGE(PG8_SB(1, 1), cB + hstep + kstep, voffB);
        PG8_WAIT_V(6); PG8_BAR;
    }
    for (;;) {
        const bool has_next = S.next(ui + 1, nxt);
        const char* nA = has_next ? (const char*)g.A + (size_t)nxt.pm * tstep : cA; const char* nB = has_next ? (const char*)g.Bt + (size_t)nxt.pn * tstep : cB;
        for (int t = 0; t < nt; t += 2) {
            const bool last = (t == nt - 2);
            const char* a1 = cA + (size_t)(t + 1) * kstep;
            const char* a2 = last ? nA : cA + (size_t)(t + 2) * kstep; const char* b2 = last ? nB : cB + (size_t)(t + 2) * kstep;
            const char* a3 = a2 + kstep; const char* b3 = b2 + kstep;
            if (last && has_next) S.a_ready(nxt);
            if constexpr (SP2) {
            PG8_LDB(B0, 0, 0); PG8_LDB(B1, 0, 1); PG8_SCHED; PG8_LDA(At, 0, 0); PG8_STAGE(PG8_SA(1, 1), a1 + hstep, voffA);
            PG8_WAIT_V(8); PG8_WAIT_L(0); PG8_BAR; PG8_MMA(0, 0, At, B0); PG8_MMA(0, 1, At, B1); PG8_BAR; PG8_SCHED;
            PG8_LDA(At, 0, 1); PG8_STAGE(PG8_SB(0, 0), b2, voffB); PG8_STAGE(PG8_SB(0, 1), b2 + hstep, voffB); PG8_STAGE(PG8_SA(0, 0), a2, voffA);
            PG8_WAIT_V(8); PG8_WAIT_L(0); PG8_BAR; PG8_MMA(1, 0, At, B0); PG8_MMA(1, 1, At, B1); PG8_BAR; PG8_SCHED;
            PG8_LDB(B0, 1, 0); PG8_LDB(B1, 1, 1); PG8_SCHED; PG8_LDA(At, 1, 0); PG8_STAGE(PG8_SA(0, 1), a2 + hstep, voffA);
            PG8_WAIT_V(8); PG8_WAIT_L(0); PG8_BAR; PG8_MMA(0, 0, At, B0); PG8_MMA(0, 1, At, B1); PG8_BAR; PG8_SCHED;
            PG8_LDA(At, 1, 1); PG8_STAGE(PG8_SB(1, 0), b3, voffB); PG8_STAGE(PG8_SB(1, 1), b3 + hstep, voffB); PG8_STAGE(PG8_SA(1, 0), a3, voffA);
            PG8_WAIT_V(8); PG8_WAIT_L(0); PG8_BAR; PG8_MMA(1, 0, At, B0); PG8_MMA(1, 1, At, B1); PG8_BAR; PG8_SCHED;
            } else {
            PG8_LDB(B0, 0, 0); PG8_SCHED; PG8_LDA(At, 0, 0); PG8_STAGE(PG8_SA(1, 1), a1 + hstep, voffA);
            PG8_WAIT_L(8); PG8_BAR; PG8_WAIT_L(0); PG8_MMA(0, 0, At, B0); PG8_BAR; PG8_SCHED;
            PG8_LDB(B1, 0, 1); PG8_STAGE(PG8_SB(0, 0), b2, voffB);
            PG8_BAR; PG8_WAIT_L(0); PG8_MMA(0, 1, At, B1); PG8_BAR;
            PG8_LDA(At, 0, 1); PG8_STAGE(PG8_SA(0, 0), a2, voffA);
            PG8_BAR; PG8_WAIT_L(0); PG8_MMA(1, 0, At, B0); PG8_BAR; PG8_SCHED;
            PG8_STAGE(PG8_SB(0, 1), b2 + hstep, voffB);
            PG8_WAIT_V(6); PG8_BAR; PG8_MMA(1, 1, At, B1); PG8_BAR;
            PG8_LDB(B0, 1, 0); PG8_SCHED; PG8_LDA(At, 1, 0); PG8_STAGE(PG8_SA(0, 1), a2 + hstep, voffA);
            PG8_WAIT_L(8); PG8_BAR; PG8_WAIT_L(0); PG8_MMA(0, 0, At, B0); PG8_BAR; PG8_SCHED;
            PG8_LDB(B1, 1, 1); PG8_STAGE(PG8_SB(1, 0), b3, voffB);
            PG8_BAR; PG8_WAIT_L(0); PG8_MMA(0, 1, At, B1); PG8_BAR;
            PG8_LDA(At, 1, 1); PG8_STAGE(PG8_SA(1, 0), a3, voffA);
            PG8_BAR; PG8_WAIT_L(0); PG8_MMA(1, 0, At, B0); PG8_BAR; PG8_SCHED;
            PG8_STAGE(PG8_SB(1, 1), b3 + hstep, voffB);
            PG8_WAIT_V(6); PG8_BAR; PG8_MMA(1, 1, At, B1); PG8_BAR;
            }
        }
        if constexpr (ALIGN_EPI) { if (wr == 0) PG8_BAR; }
        if constexpr (!Epi::AFTER_DRAIN) { E(acc, cur, wr, wc, fr, fq); S.done(cur); }
        if (!has_next) break;
#pragma unroll
        for (int a = 0; a < 2; ++a)
#pragma unroll
            for (int b = 0; b < 2; ++b)
#pragma unroll
                for (int m = 0; m < 4; ++m)
#pragma unroll
                    for (int n = 0; n < 2; ++n) acc[a][b][m][n] = (f32x4){0.f, 0.f, 0.f, 0.f};
        cur = nxt; cA = nA; cB = nB; ++ui;
        if constexpr (ALIGN_EPI) { if (wr == 1) PG8_BAR; }
    }
    PG8_WAIT_V(0);
    if constexpr (!ALIGN_EPI) { if (wr == 0) PG8_BAR; }
    PG8_BAR;
    if constexpr (Epi::AFTER_DRAIN) { E.fused(acc, cur, wr, wc, fr, fq, lds, wid, lane); S.done(cur); }
#undef PG8_SA
#undef PG8_SB
#undef PG8_STAGE
#undef PG8_LDA
#undef PG8_LDB
#undef PG8_MMA
#undef PG8_WAIT_V
#undef PG8_WAIT_L
#undef PG8_BAR
#undef PG8_SCHED
}
}
#define LAS __attribute__((address_space(3)))
#define XB_TMO      128
#define XB_XCNT(j)  (256  + 64 * (j))
#define XB_XSUB(j)  (1280 + 64 * (j))
#define XB_XGEN(j)  (2304 + 64 * (j))
#define XB_TOP      3328
#define XB_TOPGEN   3392
#define XCD_BAR_WORDS 3456
#define XB_SPIN_CAP (1u << 18)

__device__ __forceinline__ unsigned xb_ld(unsigned* p)              { return __hip_atomic_load(p, __ATOMIC_RELAXED, __HIP_MEMORY_SCOPE_AGENT); }
__device__ __forceinline__ unsigned xb_add(unsigned* p, unsigned v) { return __hip_atomic_fetch_add(p, v, __ATOMIC_RELAXED, __HIP_MEMORY_SCOPE_AGENT); }
__device__ __forceinline__ unsigned xb_xcc_id() { return (unsigned)__builtin_amdgcn_s_getreg((3 << 11) | 20) & 0xFu; }
#define XB_SPIN(cond, bar) do { unsigned _sp = 0; while (cond) { __builtin_amdgcn_s_sleep(1); \
    if ((++_sp & 255u) == 0u) { if (xb_ld(&(bar)[XB_TMO])) break; if (_sp > XB_SPIN_CAP) { atomicAdd(&(bar)[XB_TMO], 1u); break; } } } } while (0)

struct XcdBarrier {
    unsigned* bar; unsigned x;
    volatile LAS unsigned* st;
};

__device__ __forceinline__ XcdBarrier xcd_barrier_post(unsigned* bar, volatile LAS unsigned* st) {
    XcdBarrier b; b.bar = bar; b.x = xb_xcc_id(); b.st = st;
    if (threadIdx.x == 0) (void)xb_add(&bar[XB_XCNT(b.x)], 1u);
    return b;
}
__device__ __forceinline__ void xcd_barrier_complete(unsigned* bar, unsigned x, unsigned& nloc, unsigned& nx) {
    const unsigned G = gridDim.x * gridDim.y * gridDim.z;
    unsigned sum, cnt, mine, sp = 0u;
    for (;;) {
        sum = 0u; cnt = 0u; mine = 0u;
#pragma unroll
        for (unsigned j = 0; j < 16; ++j) { const unsigned c = xb_ld(&bar[XB_XCNT(j)]); sum += c; cnt += (c > 0u) ? 1u : 0u; mine = (j == x) ? c : mine; }
        if (sum == G) break;
        __builtin_amdgcn_s_sleep(1);
        if ((++sp & 255u) == 0u) { if (xb_ld(&bar[XB_TMO])) break; if (sp > XB_SPIN_CAP) { atomicAdd(&bar[XB_TMO], 1u); break; } }
    }
    nloc = mine > 0u ? mine : 1u; nx = cnt > 0u ? cnt : 1u;
}

__device__ __forceinline__ void xcd_barrier(const XcdBarrier& b) {
    asm volatile("s_waitcnt vmcnt(0)" ::: "memory");
    __syncthreads();
    if (threadIdx.x == 0) {
        unsigned* bar = b.bar;
        __builtin_amdgcn_s_waitcnt(0);
        unsigned nloc = b.st[0], nx = b.st[1];
        if (nloc == 0u) { xcd_barrier_complete(bar, b.x, nloc, nx); b.st[0] = nloc; b.st[1] = nx; }
        const unsigned old = xb_add(&bar[XB_XSUB(b.x)], 1u);
        const unsigned gen = old / nloc;
        if (old + 1u == (gen + 1u) * nloc) {
            __builtin_amdgcn_fence(__ATOMIC_RELEASE, "agent");
            asm volatile("s_waitcnt vmcnt(0)" ::: "memory");
            const unsigned og = xb_add(&bar[XB_TOP], 1u);
            const unsigned tg = og / nx;
            if (og + 1u == (tg + 1u) * nx) xb_add(&bar[XB_TOPGEN], 1u);
            else XB_SPIN(xb_ld(&bar[XB_TOPGEN]) == tg, bar);
            __builtin_amdgcn_fence(__ATOMIC_ACQUIRE, "agent");
            xb_add(&bar[XB_XGEN(b.x)], 1u);
            asm volatile("s_waitcnt vmcnt(0)" ::: "memory");
        } else {
            XB_SPIN(xb_ld(&bar[XB_XGEN(b.x)]) == gen, bar);
            __builtin_amdgcn_fence(__ATOMIC_ACQUIRE, "agent");
            asm volatile("s_waitcnt vmcnt(0)" ::: "memory");
        }
    }
    __syncthreads();
}
#undef LAS
using pg8::bf16x8; using pg8::f32x4; using pg8::u32x4; using pg8::f32x2;
#define GAS __attribute__((address_space(1)))
#define LAS __attribute__((address_space(3)))
typedef unsigned short bf16;
typedef unsigned v4u __attribute__((ext_vector_type(4)));
typedef unsigned v2u __attribute__((ext_vector_type(2)));
typedef float f32x2v __attribute__((ext_vector_type(2)));

constexpr int NTOK = 40960, DM = 2048, NLAYER = 4, INW = 5120;
constexpr int COL_UA = 0, COL_UB = 512, COL_Q = 1024, COL_K = 2048, COL_V = 3072, COL_G = 4096;
constexpr float ALPHA = 1.6817928305074290f;
constexpr float LN_EPS = 1e-5f, GN_EPS = 1e-6f;
constexpr int NEXP = 16384;
constexpr int NWAVES = 8, NTHR = 512;

constexpr size_t MiB = 1u << 20;
constexpr size_t WS_CTL = 0, CTL_ZERO_BYTES = 1 * MiB;
constexpr size_t WS_WIN = 1 * MiB;
constexpr size_t WS_WOUT = 81 * MiB;
constexpr size_t WS_WS = 113 * MiB;
constexpr size_t WS_WGLU = 145 * MiB;
constexpr size_t WS_WPOOL = 147 * MiB;
constexpr size_t WS_S5A = 149 * MiB;
constexpr size_t WS_S5B = 150 * MiB;
constexpr size_t WS_ROT = 152 * MiB;
constexpr size_t WS_U16 = 160 * MiB;
constexpr size_t WS_V16 = 416 * MiB;
constexpr size_t WS_U8 = 160 * MiB;
constexpr size_t WS_V8 = 288 * MiB;
constexpr size_t WS_USC = 416 * MiB;
constexpr size_t WS_VSC = 417 * MiB;
constexpr size_t WS_XN = 672 * MiB;
constexpr size_t WS_H = 832 * MiB;
constexpr size_t WS_CONCAT = 1232 * MiB;
constexpr size_t WS_BUFY = 1392 * MiB;
constexpr size_t WS_BUFP = 1432 * MiB;
constexpr size_t WS_STF = 1472 * MiB;
constexpr size_t WS_STB = 1632 * MiB;
constexpr size_t WS_IDX = 1792 * MiB;
constexpr size_t WS_GATE = 1812 * MiB;
constexpr size_t WS_S5ST = 1832 * MiB;
constexpr size_t WS_END = 1852 * MiB;
constexpr int CW_BAR = 4096;
constexpr int NPHASE = 1 + NLAYER * 10;

constexpr int LDS_SCRATCH = 147456;
constexpr int LDS_MISC = LDS_SCRATCH;
constexpr int LDS_BYTES = LDS_SCRATCH + 256;

__device__ __forceinline__ float bf_lo(unsigned w) { return __uint_as_float(w << 16); }
__device__ __forceinline__ float bf_hi(unsigned w) { return __uint_as_float(w & 0xffff0000u); }
typedef __bf16 bf16x2_t __attribute__((ext_vector_type(2)));
__device__ __forceinline__ unsigned pkbf(float lo, float hi) { const bf16x2_t v = {(__bf16)lo, (__bf16)hi}; return __builtin_bit_cast(unsigned, v); }
__device__ __forceinline__ bf16 f2bf(float f) { return __builtin_bit_cast(unsigned short, (__bf16)f); }
__device__ __forceinline__ float wave_sum(float v) {
#pragma unroll
    for (int o = 1; o < 64; o <<= 1) v += __shfl_xor(v, o);
    return v;
}
__device__ __forceinline__ float gelu_erf(float v) { return 0.5f * v * (1.0f + erff(v * 0.70710678118654752f)); }
__device__ __forceinline__ int tok_pos(int t) { return t < 32768 ? (t & 4095) : (t - 32768); }
__device__ __forceinline__ int tok_len(int t) { return t < 32768 ? 4096 : 8192; }
__device__ __forceinline__ void unpack8(const v4u q, float (&f)[8]) {
    f[0] = bf_lo(q.x); f[1] = bf_hi(q.x); f[2] = bf_lo(q.y); f[3] = bf_hi(q.y); f[4] = bf_lo(q.z); f[5] = bf_hi(q.z); f[6] = bf_lo(q.w); f[7] = bf_hi(q.w);
}
__device__ __forceinline__ v4u pack8(const float (&f)[8]) { v4u q; q.x = pkbf(f[0], f[1]); q.y = pkbf(f[2], f[3]); q.z = pkbf(f[4], f[5]); q.w = pkbf(f[6], f[7]); return q; }
#define LDS_WAIT() asm volatile("s_waitcnt lgkmcnt(0)" ::: "memory")
#define MFMA16(a, b, c) __builtin_amdgcn_mfma_f32_16x16x32_bf16((a), (b), (c), 0, 0, 0)

struct EpiStoreBf16 {
    static constexpr bool PERM = true, AFTER_DRAIN = false;
    bf16* O; int ldo;
    __device__ __forceinline__ void operator()(const f32x4 (&acc)[2][2][4][2], const pg8::Unit& u, int wr, int wc, int fr, int fq) const {
        const int row0 = u.pm * 256 + wr * 64 + fr, col0 = u.pn * 256 + wc * 32 + 8 * fq;
#pragma unroll
        for (int ai = 0; ai < 2; ++ai)
#pragma unroll
            for (int m = 0; m < 4; ++m) { bf16* rowp = O + (size_t)(row0 + ai * 128 + m * 16) * ldo + col0;
#pragma unroll
                for (int bj = 0; bj < 2; ++bj) { const f32x4 v0 = acc[ai][bj][m][0], v1 = acc[ai][bj][m][1];
                    v4u w; w.x = pkbf(v0[0], v0[1]); w.y = pkbf(v0[2], v0[3]); w.z = pkbf(v1[0], v1[1]); w.w = pkbf(v1[2], v1[3]);
                    *(v4u*)(rowp + bj * 128) = w; } }
    }
};
struct EpiGlu {
    static constexpr bool PERM = true, AFTER_DRAIN = false;
    const bf16* Y; int ldy; bf16* O; int ldo; const float* bias;
    __device__ __forceinline__ void operator()(const f32x4 (&acc)[2][2][4][2], const pg8::Unit& u, int wr, int wc, int fr, int fq) const {
        const int row0 = u.pm * 256 + wr * 64 + fr, col0 = u.pn * 256 + wc * 32 + 8 * fq;
#pragma unroll
        for (int bj = 0; bj < 2; ++bj) {
            const f32x4 b0 = *(const f32x4*)(bias + col0 + bj * 128), b1 = *(const f32x4*)(bias + col0 + bj * 128 + 4);
#pragma unroll
            for (int ai = 0; ai < 2; ++ai)
#pragma unroll
                for (int m = 0; m < 4; ++m) { const size_t r = (size_t)(row0 + ai * 128 + m * 16);
                    const v4u yq = *(const v4u*)(Y + r * ldy + col0 + bj * 128); float y[8]; unpack8(yq, y);
                    const f32x4 v0 = acc[ai][bj][m][0] + b0, v1 = acc[ai][bj][m][1] + b1; float o[8];
#pragma unroll
                    for (int k = 0; k < 4; ++k) { o[k] = y[k] / (1.0f + __expf(-v0[k])); o[4 + k] = y[4 + k] / (1.0f + __expf(-v1[k])); }
                    *(v4u*)(O + r * ldo + col0 + bj * 128) = pack8(o); }
        }
    }
};
struct EpiScaleBf16 {
    static constexpr bool PERM = true, AFTER_DRAIN = false;
    bf16* O; int ldo; const float* scale;
    __device__ __forceinline__ void operator()(const f32x4 (&acc)[2][2][4][2], const pg8::Unit& u, int wr, int wc, int fr, int fq) const {
        const int row0 = u.pm * 256 + wr * 64 + fr, col0 = u.pn * 256 + wc * 32 + 8 * fq;
#pragma unroll
        for (int bj = 0; bj < 2; ++bj) {
            const f32x4 s0 = *(const f32x4*)(scale + col0 + bj * 128), s1 = *(const f32x4*)(scale + col0 + bj * 128 + 4);
#pragma unroll
            for (int ai = 0; ai < 2; ++ai)
#pragma unroll
                for (int m = 0; m < 4; ++m) { const size_t r = (size_t)(row0 + ai * 128 + m * 16);
                    const f32x4 v0 = acc[ai][bj][m][0] * s0, v1 = acc[ai][bj][m][1] * s1;
                    v4u w; w.x = pkbf(v0[0], v0[1]); w.y = pkbf(v0[2], v0[3]); w.z = pkbf(v1[0], v1[1]); w.w = pkbf(v1[2], v1[3]);
                    *(v4u*)(O + r * ldo + col0 + bj * 128) = w; }
        }
    }
};
struct EpiResid {
    static constexpr bool PERM = false, AFTER_DRAIN = false;
    float* X; int ldx; float alpha;
    __device__ __forceinline__ void operator()(const f32x4 (&acc)[2][2][4][2], const pg8::Unit& u, int wr, int wc, int fr, int fq) const {
        const int row0 = u.pm * 256 + wr * 64 + fr, col0 = u.pn * 256 + wc * 32 + 4 * fq;
#pragma unroll
        for (int ai = 0; ai < 2; ++ai)
#pragma unroll
            for (int m = 0; m < 4; ++m) { float* rowp = X + (size_t)(row0 + ai * 128 + m * 16) * ldx + col0;
#pragma unroll
                for (int bj = 0; bj < 2; ++bj)
#pragma unroll
                    for (int n = 0; n < 2; ++n) { f32x4* p = (f32x4*)(rowp + bj * 128 + n * 16); const f32x4 x = *p; *p = x * alpha + acc[ai][bj][m][n]; } }
    }
};
struct EpiStoreF32 {
    static constexpr bool PERM = false, AFTER_DRAIN = false;
    float* C; int ldc;
    __device__ __forceinline__ void operator()(const f32x4 (&acc)[2][2][4][2], const pg8::Unit& u, int wr, int wc, int fr, int fq) const {
        const int row0 = u.pm * 256 + wr * 64 + fr, col0 = u.pn * 256 + wc * 32 + 4 * fq;
#pragma unroll
        for (int ai = 0; ai < 2; ++ai)
#pragma unroll
            for (int m = 0; m < 4; ++m) { float* rowp = C + (size_t)(row0 + ai * 128 + m * 16) * ldc + col0;
#pragma unroll
                for (int bj = 0; bj < 2; ++bj)
#pragma unroll
                    for (int n = 0; n < 2; ++n) *(f32x4*)(rowp + bj * 128 + n * 16) = acc[ai][bj][m][n]; }
    }
};

struct Args { const float* in[26]; float* out; unsigned char* ws; int ph_lo, ph_hi, li, pad; };
typedef const Args __attribute__((address_space(4))) CArgs;
struct Frame {
    LAS unsigned char* lds;
    int tid, lane, wave, G, bx;
    int gw, NGW;
    size_t gtid, NT;
    float* out; unsigned char* ws;
};
enum InIdx { I_XP = 0, I_XS, I_LNIN_G, I_LNIN_B, I_WIN, I_LAMRE, I_LAMIM, I_LOGSTEP, I_BRE, I_BIM, I_CRE, I_CIM, I_S5D, I_WGLU, I_BGLU, I_POOLW, I_POOLS,
             I_WOUT, I_LN1G, I_LN1B, I_WQ, I_KEYS, I_PU, I_PV, I_LN2G, I_LN2B };

__device__ __forceinline__ void ln_row(const float* src, const float* g, const float* b, float* dst, bf16* dstb, int lane) {
    f32x4 v[8]; float s = 0.f;
#pragma unroll
    for (int j = 0; j < 8; ++j) { v[j] = ((const f32x4*)src)[lane + 64 * j]; s += (v[j][0] + v[j][1]) + (v[j][2] + v[j][3]); }
    const float mean = wave_sum(s) * (1.0f / DM); float s2 = 0.f;
#pragma unroll
    for (int j = 0; j < 8; ++j) { v[j] = v[j] - mean; s2 += (v[j][0] * v[j][0] + v[j][1] * v[j][1]) + (v[j][2] * v[j][2] + v[j][3] * v[j][3]); }
    const float rstd = 1.0f / sqrtf(wave_sum(s2) * (1.0f / DM) + LN_EPS);
#pragma unroll
    for (int j = 0; j < 8; ++j) { const f32x4 gg = ((const f32x4*)g)[lane + 64 * j], bb = ((const f32x4*)b)[lane + 64 * j];
        const f32x4 o = v[j] * rstd * gg + bb; ((f32x4*)dst)[lane + 64 * j] = o;
        v2u w; w.x = pkbf(o[0], o[1]); w.y = pkbf(o[2], o[3]); ((v2u*)dstb)[lane + 64 * j] = w; }
}

__device__ __forceinline__ void transpose_item(const float* W, int K, int N, bf16* WT, LAS float* scr, int item, int lane) {
    const int nblk = N / 32, kb = item / nblk, nb = item % nblk, k0 = 64 * kb, n0 = 32 * nb;
#pragma unroll 8
    for (int i = 0; i < 32; ++i) { const int kk = 2 * i + (lane >> 5); scr[kk * 33 + (lane & 31)] = W[(size_t)(k0 + kk) * N + n0 + (lane & 31)]; }
    LDS_WAIT();
    const int c = lane & 7;
#pragma unroll
    for (int j = 0; j < 4; ++j) { const int n = (lane >> 3) + 8 * j; const LAS float* s = scr + (8 * c) * 33 + n;
        v4u o; o.x = pkbf(s[0 * 33], s[1 * 33]); o.y = pkbf(s[2 * 33], s[3 * 33]); o.z = pkbf(s[4 * 33], s[5 * 33]); o.w = pkbf(s[6 * 33], s[7 * 33]);
        *(v4u*)(WT + (size_t)(n0 + n) * K + k0 + 8 * c) = o; }
    LDS_WAIT();
}

__device__ __forceinline__ void p0_prologue(const Frame& F, CArgs& A) {
    {
        LAS float* scr = (LAS float*)(F.lds + F.wave * 16384);
        constexpr int I_IN = (DM / 64) * (INW / 32), I_OUT = (DM / 64) * (DM / 32), I_GLU = (512 / 64) * (512 / 32);
        constexpr int NITEMS = NLAYER * (I_IN + I_OUT + I_GLU);
        for (int it = F.gw; it < NITEMS; it += F.NGW) {
            int r = it;
            if (r < NLAYER * I_IN) { const int l = r / I_IN; transpose_item(A.in[I_WIN] + (size_t)l * DM * INW, DM, INW, (bf16*)(F.ws + WS_WIN) + (size_t)l * INW * DM, scr, r % I_IN, F.lane); continue; }
            r -= NLAYER * I_IN;
            if (r < NLAYER * I_OUT) { const int l = r / I_OUT; transpose_item(A.in[I_WOUT] + (size_t)l * DM * DM, DM, DM, (bf16*)(F.ws + WS_WOUT) + (size_t)l * DM * DM, scr, r % I_OUT, F.lane); continue; }
            r -= NLAYER * I_OUT;
            { const int l = r / I_GLU; transpose_item(A.in[I_WGLU] + (size_t)l * 512 * 512, 512, 512, (bf16*)(F.ws + WS_WGLU) + (size_t)l * 512 * 512, scr, r % I_GLU, F.lane); }
        }
    }
#if PEER_FP4
    {
        for (int r = F.gw; r < 2 * NLAYER * NEXP; r += F.NGW) {
            const int tab = r >= NLAYER * NEXP, ri = tab ? r - NLAYER * NEXP : r;
            const float* src = (tab ? A.in[I_PV] : A.in[I_PU]) + (size_t)ri * DM + F.lane * 4;
            f32x4 v[8]; float am = 0.f;
#pragma unroll
            for (int q = 0; q < 8; ++q) { v[q] = *(const f32x4*)(src + q * 256); am = fmaxf(am, fmaxf(fmaxf(fabsf(v[q][0]), fabsf(v[q][1])), fmaxf(fabsf(v[q][2]), fabsf(v[q][3])))); }
#pragma unroll
            for (int o = 1; o < 64; o <<= 1) am = fmaxf(am, __shfl_xor(am, o));
            const float sc = am > 0.f ? 6.0f / am : 1.0f, isc = am > 0.f ? am * (1.0f / 6.0f) : 1.0f;
            v4u w;
#pragma unroll
            for (int q = 0; q < 4; ++q) { unsigned pk = 0u;
                pk = __builtin_amdgcn_cvt_scalef32_pk_fp4_f32(pk, v[2 * q][0] * sc, v[2 * q][1] * sc, 1.0f, 0); pk = __builtin_amdgcn_cvt_scalef32_pk_fp4_f32(pk, v[2 * q][2] * sc, v[2 * q][3] * sc, 1.0f, 1);
                pk = __builtin_amdgcn_cvt_scalef32_pk_fp4_f32(pk, v[2 * q + 1][0] * sc, v[2 * q + 1][1] * sc, 1.0f, 2); pk = __builtin_amdgcn_cvt_scalef32_pk_fp4_f32(pk, v[2 * q + 1][2] * sc, v[2 * q + 1][3] * sc, 1.0f, 3);
                w[q] = pk; }
            *(v4u*)(F.ws + (tab ? WS_V8 : WS_U8) + (size_t)ri * (DM / 2) + F.lane * 16) = w;
            if (F.lane == 0) ((float*)(F.ws + (tab ? WS_VSC : WS_USC)))[ri] = isc;
        }
    }
#else
    {
        for (int r = F.gw; r < 2 * NLAYER * NEXP; r += F.NGW) {
            const int tab = r >= NLAYER * NEXP, ri = tab ? r - NLAYER * NEXP : r;
            const float* src = (tab ? A.in[I_PV] : A.in[I_PU]) + (size_t)ri * DM;
            f32x4 v[2][4]; float am = 0.f;
#pragma unroll
            for (int c = 0; c < 2; ++c)
#pragma unroll
                for (int q = 0; q < 4; ++q) { v[c][q] = *(const f32x4*)(src + (c * 64 + F.lane) * 16 + q * 4);
                    am = fmaxf(am, fmaxf(fmaxf(fabsf(v[c][q][0]), fabsf(v[c][q][1])), fmaxf(fabsf(v[c][q][2]), fabsf(v[c][q][3])))); }
#pragma unroll
            for (int o = 1; o < 64; o <<= 1) am = fmaxf(am, __shfl_xor(am, o));
            const float sc = am > 0.f ? 384.0f / am : 1.0f, isc = am > 0.f ? am * (1.0f / 384.0f) : 1.0f;
            unsigned char* dst = F.ws + (tab ? WS_V8 : WS_U8) + (size_t)ri * DM;
#pragma unroll
            for (int c = 0; c < 2; ++c) { v4u w;
#pragma unroll
                for (int q = 0; q < 4; ++q) { int pk = 0; pk = __builtin_amdgcn_cvt_pk_fp8_f32(v[c][q][0] * sc, v[c][q][1] * sc, pk, false); pk = __builtin_amdgcn_cvt_pk_fp8_f32(v[c][q][2] * sc, v[c][q][3] * sc, pk, true); w[q] = (unsigned)pk; }
                *(v4u*)(dst + (c * 64 + F.lane) * 16) = w; }
            if (F.lane == 0) ((float*)(F.ws + (tab ? WS_VSC : WS_USC)))[ri] = isc;
        }
    }
#endif
    {
        const float* pw = A.in[I_POOLW]; v4u* dst = (v4u*)(F.ws + WS_WPOOL);
        for (size_t i = F.gtid; i < (size_t)NLAYER * 512 * 64; i += F.NT) {
            const int k8 = (int)(i & 63), n = (int)((i >> 6) & 511), l = (int)(i >> 15);
            const int g = n >> 7, d = n & 127, kg = k8 >> 4, c0 = (k8 & 15) * 8;
            float f[8];
#pragma unroll
            for (int k = 0; k < 8; ++k) f[k] = (kg == g) ? pw[(((size_t)l * 4 + g) * 128 + (c0 + k)) * 128 + d] : 0.f;
            dst[i] = pack8(f);
        }
    }
    {
        const float* lre = A.in[I_LAMRE]; const float* lim = A.in[I_LAMIM]; const float* lst = A.in[I_LOGSTEP]; const float* bre = A.in[I_BRE]; const float* bim = A.in[I_BIM];
        f32x2v* ab = (f32x2v*)(F.ws + WS_S5A); f32x2v* ab64 = (f32x2v*)(F.ws + WS_S5A + 512 * 1024); f32x2v* bb = (f32x2v*)(F.ws + WS_S5B);
        for (size_t i = F.gtid; i < (size_t)NLAYER * 2 * 32 * 64; i += F.NT) {
            const float lr = lre[i], li = lim[i], dt = expf(lst[i >> 6]);
            const float mag = expf(lr * dt), ar = mag * cosf(li * dt), ai = mag * sinf(li * dt);
            const float den = lr * lr + li * li;
            const float zr = ((ar - 1.0f) * lr + ai * li) / den, zi = (ai * lr - (ar - 1.0f) * li) / den;
            ab[i] = (f32x2v){ar, ai};
            const float m64 = expf(lr * dt * 64.0f), an = li * dt * 64.0f;
            ab64[i] = (f32x2v){m64 * cosf(an), m64 * sinf(an)};
#pragma unroll
            for (int c = 0; c < 16; ++c) { const float br = bre[i * 16 + c], bi = bim[i * 16 + c]; bb[i * 16 + c] = (f32x2v){zr * br - zi * bi, zr * bi + zi * br}; }
        }
    }
    if (F.bx == 0 && F.tid < 128) {
        ((float*)(F.ws + WS_ROT))[F.tid] = (float)exp(-(double)F.tid / 127.0 * 9.210340371976184);
    }
    __syncthreads();
    {
        LAS float* KS = (LAS float*)F.lds;
        LAS float* WQ = (LAS float*)(F.lds + 128 * 132 * 4);
        const float* keys = A.in[I_KEYS]; const float* wq = A.in[I_WQ]; bf16* wst = (bf16*)(F.ws + WS_WS);
        for (int u = F.bx; u < NLAYER * 16 * 32; u += F.G) {
            const int dtl = u & 31, hp = (u >> 5) & 15, l = u >> 9, p = hp & 1;
#pragma unroll
            for (int r = 0; r < 8; ++r) { const int f = F.tid + 512 * r, nk = f >> 5, c4 = f & 31;
                *(LAS f32x4*)(KS + nk * 132 + c4 * 4) = *(const f32x4*)(keys + (((size_t)l * 2 + p) * 128 + nk) * 128 + c4 * 4); }
#pragma unroll
            for (int r = 0; r < 4; ++r) { const int f = F.tid + 512 * r, dd = f >> 5, c4 = f & 31;
                *(LAS f32x4*)(WQ + dd * 132 + c4 * 4) = *(const f32x4*)(wq + ((size_t)l * DM + dtl * 64 + dd) * DM + hp * 128 + c4 * 4); }
            __syncthreads();
            const int nk = F.tid & 127, dg = F.tid >> 7;
            float acc[16];
#pragma unroll
            for (int i = 0; i < 16; ++i) acc[i] = 0.f;
            for (int c4 = 0; c4 < 32; ++c4) {
                const f32x4 kv = *(const LAS f32x4*)(KS + nk * 132 + c4 * 4);
#pragma unroll
                for (int i = 0; i < 16; ++i) { const f32x4 wv = *(const LAS f32x4*)(WQ + (dg * 16 + i) * 132 + c4 * 4);
                    acc[i] += (kv[0] * wv[0] + kv[1] * wv[1]) + (kv[2] * wv[2] + kv[3] * wv[3]); }
            }
            bf16* o = wst + ((size_t)l * DM + hp * 128 + nk) * DM + dtl * 64 + dg * 16;
            v4u q0, q1; q0.x = pkbf(acc[0], acc[1]); q0.y = pkbf(acc[2], acc[3]); q0.z = pkbf(acc[4], acc[5]); q0.w = pkbf(acc[6], acc[7]);
            q1.x = pkbf(acc[8], acc[9]); q1.y = pkbf(acc[10], acc[11]); q1.z = pkbf(acc[12], acc[13]); q1.w = pkbf(acc[14], acc[15]);
            *(v4u*)o = q0; *(v4u*)(o + 8) = q1;
            __syncthreads();
        }
    }
    for (int t = F.gw; t < NTOK; t += F.NGW) {
        const float* src = t < 32768 ? A.in[I_XP] + (size_t)t * DM : A.in[I_XS] + (size_t)(t - 32768) * DM;
        ln_row(src, A.in[I_LNIN_G], A.in[I_LNIN_B], F.out + (size_t)t * DM, (bf16*)(F.ws + WS_XN) + (size_t)t * DM, F.lane);
    }
}

__device__ __forceinline__ float ret_log2_gamma(int h) { return log2f(1.0f - exp2f(-5.0f - (float)h)); }

__device__ __forceinline__ void s5_pass1(const Frame& F, CArgs& A, int l) {
    LAS float* Uw = (LAS float*)(F.lds + F.wave * 4096);
    const bf16* H = (const bf16*)(F.ws + WS_H);
    const f32x2v* ab = (const f32x2v*)(F.ws + WS_S5A); const f32x4* bb = (const f32x4*)(F.ws + WS_S5B);
    f32x2v* st = (f32x2v*)(F.ws + WS_S5ST);
    const int gstep = F.G < 32 ? F.G : 32;
    for (int g = F.bx % 32; g < 32; g += gstep) {
        const int nwg = F.G < 32 ? 1 : (F.G - g + 31) / 32, rank = F.G < 32 ? 0 : F.bx / 32;
        f32x2v B2[2][16], a2[2], arot[2];
#pragma unroll
        for (int dir = 0; dir < 2; ++dir) { const int pidx = ((l * 2 + dir) * 32 + g) * 64 + F.lane; a2[dir] = ab[pidx]; arot[dir] = (f32x2v){-a2[dir][1], a2[dir][1]};
#pragma unroll
            for (int c2 = 0; c2 < 8; ++c2) { const f32x4 q = bb[(size_t)pidx * 8 + c2]; B2[dir][2 * c2] = (f32x2v){q[0], q[1]}; B2[dir][2 * c2 + 1] = (f32x2v){q[2], q[3]}; } }
        for (int ck = rank * NWAVES + F.wave; ck < 640; ck += nwg * NWAVES) {
            {
                const bf16* urow = H + (size_t)(ck * 64 + F.lane) * INW + COL_UA + g * 16;
                const v4u q0 = *(const v4u*)urow, q1 = *(const v4u*)(urow + 8); float f0[8], f1[8]; unpack8(q0, f0); unpack8(q1, f1);
                LAS f32x4* d = (LAS f32x4*)(Uw + F.lane * 16);
                d[0] = (f32x4){f0[0], f0[1], f0[2], f0[3]}; d[1] = (f32x4){f0[4], f0[5], f0[6], f0[7]}; d[2] = (f32x4){f1[0], f1[1], f1[2], f1[3]}; d[3] = (f32x4){f1[4], f1[5], f1[6], f1[7]};
            }
            LDS_WAIT();
            f32x2v xf = (f32x2v){0.f, 0.f}, xb = (f32x2v){0.f, 0.f};
            for (int s0 = 0; s0 < 64; s0 += 2) {
                f32x2v buf_[2], bub_[2];
#pragma unroll
                for (int j = 0; j < 2; ++j) {
                    const LAS f32x4* upf = (const LAS f32x4*)(Uw + (s0 + j) * 16); const LAS f32x4* upb = (const LAS f32x4*)(Uw + (63 - s0 - j) * 16);
                    f32x2v f0 = (f32x2v){0.f, 0.f}, f1 = (f32x2v){0.f, 0.f}, b0 = (f32x2v){0.f, 0.f}, b1 = (f32x2v){0.f, 0.f};
#pragma unroll
                    for (int c4 = 0; c4 < 4; ++c4) { const f32x4 uf = upf[c4], ub = upb[c4];
                        f0 += B2[0][4 * c4] * uf[0]; f1 += B2[0][4 * c4 + 1] * uf[1]; f0 += B2[0][4 * c4 + 2] * uf[2]; f1 += B2[0][4 * c4 + 3] * uf[3];
                        b0 += B2[1][4 * c4] * ub[0]; b1 += B2[1][4 * c4 + 1] * ub[1]; b0 += B2[1][4 * c4 + 2] * ub[2]; b1 += B2[1][4 * c4 + 3] * ub[3]; }
                    buf_[j] = f0 + f1; bub_[j] = b0 + b1; }
#pragma unroll
                for (int j = 0; j < 2; ++j) { xf = xf * a2[0][0] + (arot[0] * (f32x2v){xf[1], xf[0]} + buf_[j]); xb = xb * a2[1][0] + (arot[1] * (f32x2v){xb[1], xb[0]} + bub_[j]); }
            }
            st[(size_t)((ck * 32 + g) * 2 + 0) * 64 + F.lane] = xf; st[(size_t)((ck * 32 + g) * 2 + 1) * 64 + F.lane] = xb;
            LDS_WAIT();
        }
    }
}
__device__ __forceinline__ void s5_carry(const Frame& F, CArgs& A, int l) {
    const f32x2v* ab64 = (const f32x2v*)(F.ws + WS_S5A + 512 * 1024); f32x2v* st = (f32x2v*)(F.ws + WS_S5ST);
    for (size_t it = F.gtid; it < (size_t)9 * 32 * 2 * 64; it += F.NT) {
        const int p = (int)(it & 63), dir = (int)((it >> 6) & 1), g = (int)((it >> 7) & 31), s = (int)(it >> 12);
        const int ck0 = s < 8 ? s * 64 : 512, n = s < 8 ? 64 : 128;
        const f32x2v a = ab64[((l * 2 + dir) * 32 + g) * 64 + p];
        float cr = 0.f, ci = 0.f;
        for (int k = 0; k < n; ++k) {
            const int ck = dir ? (ck0 + n - 1 - k) : (ck0 + k);
            f32x2v* q = st + (size_t)((ck * 32 + g) * 2 + dir) * 64 + p;
            const f32x2v le = *q; *q = (f32x2v){cr, ci};
            const float ncr = a[0] * cr - a[1] * ci + le[0], nci = a[0] * ci + a[1] * cr + le[1]; cr = ncr; ci = nci;
        }
    }
}
__device__ __forceinline__ void s5_pass3(const Frame& F, CArgs& A, int l) {
    LAS bf16* CtS = (LAS bf16*)F.lds;
    LAS unsigned char* wb = F.lds + 8704 + F.wave * 12800;
    LAS float* Uw = (LAS float*)wb;
    LAS bf16* Xw = (LAS bf16*)(wb + 4096);
    const bf16* H = (const bf16*)(F.ws + WS_H); bf16* BY = (bf16*)(F.ws + WS_BUFY);
    const f32x2v* ab = (const f32x2v*)(F.ws + WS_S5A); const f32x4* bb = (const f32x4*)(F.ws + WS_S5B);
    const f32x2v* st = (const f32x2v*)(F.ws + WS_S5ST);
    const float* cre = A.in[I_CRE]; const float* cim = A.in[I_CIM]; const float* dvec = A.in[I_S5D] + (size_t)l * 512;
    const int lane = F.lane, lr = lane & 15, lq = lane >> 4;
    const int gstep = F.G < 32 ? F.G : 32;
    for (int g = F.bx % 32; g < 32; g += gstep) {
        const int nwg = F.G < 32 ? 1 : (F.G - g + 31) / 32, rank = F.G < 32 ? 0 : F.bx / 32;
        __syncthreads();
        {
            const int tq = opaque(F.tid);
#pragma unroll
            for (int r = 0; r < 8; ++r) { const int e = tq + 512 * r, pp = e & 127, c = (e >> 7) & 15, dir = e >> 11;
                const size_t cb = (size_t)(((l * 2 + dir) * 32 + g) * 16 + c) * 64;
                CtS[(dir * 16 + c) * 136 + pp] = f2bf(pp < 64 ? cre[cb + pp] : -cim[cb + pp - 64]); }
        }
        f32x2v B2[2][16], a2[2], arot[2];
#pragma unroll
        for (int dir = 0; dir < 2; ++dir) { const int pidx = ((l * 2 + dir) * 32 + g) * 64 + lane; a2[dir] = ab[pidx]; arot[dir] = (f32x2v){-a2[dir][1], a2[dir][1]};
#pragma unroll
            for (int c2 = 0; c2 < 8; ++c2) { const f32x4 q = bb[(size_t)pidx * 8 + c2]; B2[dir][2 * c2] = (f32x2v){q[0], q[1]}; B2[dir][2 * c2 + 1] = (f32x2v){q[2], q[3]}; } }
        __syncthreads();
        for (int ck = rank * NWAVES + F.wave; ck < 640; ck += nwg * NWAVES) {
            {
                const bf16* urow = H + (size_t)(ck * 64 + lane) * INW + COL_UA + g * 16;
                const v4u q0 = *(const v4u*)urow, q1 = *(const v4u*)(urow + 8); float f0[8], f1[8]; unpack8(q0, f0); unpack8(q1, f1);
                LAS f32x4* d = (LAS f32x4*)(Uw + lane * 16);
                d[0] = (f32x4){f0[0], f0[1], f0[2], f0[3]}; d[1] = (f32x4){f0[4], f0[5], f0[6], f0[7]}; d[2] = (f32x4){f1[0], f1[1], f1[2], f1[3]}; d[3] = (f32x4){f1[4], f1[5], f1[6], f1[7]};
            }
            f32x2v xin[2];
#pragma unroll
            for (int dir = 0; dir < 2; ++dir) xin[dir] = st[(size_t)((ck * 32 + g) * 2 + dir) * 64 + lane];
            f32x4 Y[4];
#pragma unroll
            for (int m = 0; m < 4; ++m) Y[m] = (f32x4){0.f, 0.f, 0.f, 0.f};
            LDS_WAIT();
#pragma unroll
            for (int dir = 0; dir < 2; ++dir) {
                f32x2v x2 = xin[dir];
#pragma unroll
                for (int half = 0; half < 2; ++half) {
                    for (int s0 = 0; s0 < 32; s0 += 4) {
                        f32x2v bu[4];
#pragma unroll
                        for (int j = 0; j < 4; ++j) { const int step = half * 32 + s0 + j, t = dir ? 63 - step : step;
                            const LAS f32x4* up = (const LAS f32x4*)(Uw + t * 16);
                            f32x2v b0 = (f32x2v){0.f, 0.f}, b1 = (f32x2v){0.f, 0.f};
#pragma unroll
                            for (int c4 = 0; c4 < 4; ++c4) { const f32x4 uv = up[c4]; b0 += B2[dir][4 * c4] * uv[0]; b1 += B2[dir][4 * c4 + 1] * uv[1]; b0 += B2[dir][4 * c4 + 2] * uv[2]; b1 += B2[dir][4 * c4 + 3] * uv[3]; }
                            bu[j] = b0 + b1; }
#pragma unroll
                        for (int j = 0; j < 4; ++j) { const int step = half * 32 + s0 + j, t = dir ? 63 - step : step;
                            x2 = x2 * a2[dir][0] + (arot[dir] * (f32x2v){x2[1], x2[0]} + bu[j]);
                            Xw[(t & 31) * 136 + lane] = f2bf(x2[0]); Xw[(t & 31) * 136 + 64 + lane] = f2bf(x2[1]); }
                    }
                    LDS_WAIT();
                    const int tb = dir ? (1 - half) : half;
#pragma unroll
                    for (int m = 0; m < 2; ++m)
#pragma unroll
                        for (int ks = 0; ks < 4; ++ks) {
                            const bf16x8 av = *(const LAS bf16x8*)(CtS + (dir * 16 + lr) * 136 + 32 * ks + lq * 8);
                            const bf16x8 bv = *(const LAS bf16x8*)(Xw + (16 * m + lr) * 136 + 32 * ks + lq * 8);
                            Y[2 * tb + m] = MFMA16(av, bv, Y[2 * tb + m]);
                        }
                    LDS_WAIT();
                }
            }
#pragma unroll
            for (int m = 0; m < 4; ++m) {
                const int t = 16 * m + lr, c0 = 4 * lq;
                const f32x4 uv = *(const LAS f32x4*)(Uw + t * 16 + c0); const f32x4 dv = *(const f32x4*)(dvec + g * 16 + c0);
                const f32x4 y = Y[m] + dv * uv;
                v2u w; w.x = pkbf(gelu_erf(y[0]), gelu_erf(y[1])); w.y = pkbf(gelu_erf(y[2]), gelu_erf(y[3]));
                *(v2u*)(BY + (size_t)(ck * 64 + t) * 512 + g * 16 + c0) = w;
            }
            LDS_WAIT();
        }
    }
}
__device__ __forceinline__ void pool_phase(const Frame& F, CArgs& A) {
    const bf16* H = (const bf16*)(F.ws + WS_H); bf16* BP = (bf16*)(F.ws + WS_BUFP);
    for (size_t it = F.gtid; it < (size_t)NTOK * 64; it += F.NT) {
        const int t = (int)(it >> 6), o = (int)(it & 63), gi = o >> 4, w = 2 << gi;
        const int pos = tok_pos(t), L = tok_len(t);
        const int lo = max(pos - w / 2, 0), hi = min(pos + w / 2 - 1, L - 1);
        const bf16* base = H + (size_t)(t - pos) * INW + COL_UB + o * 8;
        float s[8];
#pragma unroll
        for (int k = 0; k < 8; ++k) s[k] = 0.f;
        for (int si = lo; si <= hi; ++si) { float f[8]; unpack8(*(const v4u*)(base + (size_t)si * INW), f);
#pragma unroll
            for (int k = 0; k < 8; ++k) s[k] += f[k]; }
        const float inv = 1.0f / (float)(hi - lo + 1);
        float c[8]; unpack8(*(const v4u*)(base + (size_t)pos * INW), c);
#pragma unroll
        for (int k = 0; k < 8; ++k) s[k] = s[k] * inv - c[k];
        *(v4u*)(BP + (size_t)t * 512 + o * 8) = pack8(s);
    }
}
__device__ __forceinline__ void rotary_phase(const Frame& F, CArgs& A) {
    bf16* H = (bf16*)(F.ws + WS_H); const float* rot = (const float*)(F.ws + WS_ROT);
    for (size_t it = F.gtid; it < (size_t)NTOK * 16; it += F.NT) {
        const int t = (int)(it >> 4), o = (int)(it & 15); const float pos = (float)tok_pos(t);
        float cs[8], sn[8];
#pragma unroll
        for (int k = 0; k < 8; ++k) { const float ang = pos * rot[o * 8 + k]; cs[k] = cosf(ang); sn[k] = sinf(ang); }
#pragma unroll
        for (int which = 0; which < 2; ++which) {
            const float sc = which ? 0.0625f : 1.0f;
#pragma unroll
            for (int hd = 0; hd < 4; ++hd) {
                bf16* p1 = H + (size_t)t * INW + (which ? COL_K : COL_Q) + hd * 256 + o * 8; bf16* p2 = p1 + 128;
                float x1[8], x2[8], o1[8], o2[8]; unpack8(*(const v4u*)p1, x1); unpack8(*(const v4u*)p2, x2);
#pragma unroll
                for (int k = 0; k < 8; ++k) { o1[k] = (x1[k] * cs[k] - x2[k] * sn[k]) * sc; o2[k] = (x2[k] * cs[k] + x1[k] * sn[k]) * sc; }
                *(v4u*)p1 = pack8(o1); *(v4u*)p2 = pack8(o2);
            }
        }
    }
}
constexpr int RS = 136;
__device__ __forceinline__ void ret_state_phase(const Frame& F, CArgs& A) {
    const bf16* H = (const bf16*)(F.ws + WS_H); bf16* STF = (bf16*)(F.ws + WS_STF); bf16* STB = (bf16*)(F.ws + WS_STB);
    LAS bf16* Kt = (LAS bf16*)F.lds; LAS bf16* VtF = Kt + 128 * RS; LAS bf16* VtB = Kt + 256 * RS;
    const int tid = F.tid, lane = F.lane, lr = lane & 15, lq = lane >> 4, we = F.wave >> 1, wd = F.wave & 1;
    for (int u = F.bx; u < 5120; u += F.G) {
        const int dh = u & 1, eh = (u >> 1) & 1, h = (u >> 2) & 3, c = u >> 4;
        {
            const int tq = opaque(tid), jp = tq & 63, j = 2 * jp, pc0 = tq >> 6;
            const bf16* krow = H + (size_t)(c * 128 + j) * INW + COL_K + h * 256 + dh * 128;
            const bf16* vrow = H + (size_t)(c * 128 + j) * INW + COL_V + h * 256 + eh * 128;
            const float lg = ret_log2_gamma(h), fF0 = exp2f(lg * (float)(127 - j)), fF1 = exp2f(lg * (float)(126 - j)), fB0 = exp2f(lg * (float)j), fB1 = exp2f(lg * (float)(j + 1));
            LAS unsigned* Kt32 = (LAS unsigned*)Kt; LAS unsigned* VtF32 = (LAS unsigned*)VtF; LAS unsigned* VtB32 = (LAS unsigned*)VtB;
#pragma unroll
            for (int r = 0; r < 2; ++r) {
                const int pc = pc0 + 8 * r;
                const v4u k0 = *(const v4u*)(krow + pc * 8), k1 = *(const v4u*)(krow + INW + pc * 8);
                const v4u v0 = *(const v4u*)(vrow + pc * 8), v1 = *(const v4u*)(vrow + INW + pc * 8);
                const unsigned ka0[4] = {k0.x, k0.y, k0.z, k0.w}, ka1[4] = {k1.x, k1.y, k1.z, k1.w};
                float f0[8], f1[8]; unpack8(v0, f0); unpack8(v1, f1);
#pragma unroll
                for (int i = 0; i < 8; ++i) {
                    const unsigned a = ka0[i >> 1], b = ka1[i >> 1];
                    const unsigned kk = (i & 1) ? ((a >> 16) | (b & 0xffff0000u)) : ((a & 0xffffu) | (b << 16));
                    const int o = ((pc * 8 + i) * RS) / 2 + jp;
                    Kt32[o] = kk; VtF32[o] = pkbf(f0[i] * fF0, f1[i] * fF1); VtB32[o] = pkbf(f0[i] * fB0, f1[i] * fB1);
                }
            }
        }
        __syncthreads();
        f32x4 aF[4][2], aB[4][2];
#pragma unroll
        for (int td = 0; td < 4; ++td)
#pragma unroll
            for (int te = 0; te < 2; ++te) { aF[td][te] = (f32x4){0.f, 0.f, 0.f, 0.f}; aB[td][te] = (f32x4){0.f, 0.f, 0.f, 0.f}; }
#pragma unroll
        for (int ks = 0; ks < 4; ++ks) {
            bf16x8 ka[4], vF[2], vB[2];
#pragma unroll
            for (int td = 0; td < 4; ++td) ka[td] = *(const LAS bf16x8*)(Kt + (64 * wd + 16 * td + lr) * RS + 32 * ks + lq * 8);
#pragma unroll
            for (int te = 0; te < 2; ++te) { vF[te] = *(const LAS bf16x8*)(VtF + (32 * we + 16 * te + lr) * RS + 32 * ks + lq * 8); vB[te] = *(const LAS bf16x8*)(VtB + (32 * we + 16 * te + lr) * RS + 32 * ks + lq * 8); }
#pragma unroll
            for (int td = 0; td < 4; ++td)
#pragma unroll
                for (int te = 0; te < 2; ++te) { aF[td][te] = MFMA16(ka[td], vF[te], aF[td][te]); aB[td][te] = MFMA16(ka[td], vB[te], aB[td][te]); }
        }
#pragma unroll
        for (int td = 0; td < 4; ++td)
#pragma unroll
            for (int te = 0; te < 2; ++te) {
                const int e = eh * 128 + 32 * we + 16 * te + lr, d = dh * 128 + 64 * wd + 16 * td + 4 * lq;
                const size_t off = ((size_t)(c * 4 + h) * 256 + e) * 256 + d;
                v2u w; w.x = pkbf(aF[td][te][0], aF[td][te][1]); w.y = pkbf(aF[td][te][2], aF[td][te][3]); *(v2u*)(STF + off) = w;
                v2u x; x.x = pkbf(aB[td][te][0], aB[td][te][1]); x.y = pkbf(aB[td][te][2], aB[td][te][3]); *(v2u*)(STB + off) = x;
            }
        __syncthreads();
    }
}
__device__ __forceinline__ void ret_prefix_phase(const Frame& F, CArgs& A) {
    bf16* STF = (bf16*)(F.ws + WS_STF); bf16* STB = (bf16*)(F.ws + WS_STB);
    for (size_t it = F.gtid; it < (size_t)36 * 2 * 8192; it += F.NT) {
        const int o = (int)(it & 8191), which = (int)((it >> 13) & 1), bh = (int)(it >> 14), h = bh & 3, s = bh >> 2;
        const int c0 = s < 8 ? s * 32 : 256, n = s < 8 ? 32 : 64;
        const float dec = exp2f(128.0f * ret_log2_gamma(h));
        float st[8];
#pragma unroll
        for (int k = 0; k < 8; ++k) st[k] = 0.f;
        bf16* base = (which ? STB : STF) + (size_t)h * 65536 + (size_t)o * 8;
        for (int k = 0; k < n; ++k) {
            const int c = which ? (c0 + n - 1 - k) : (c0 + k);
            v4u* p = (v4u*)(base + (size_t)c * 4 * 65536);
            float f[8]; unpack8(*p, f);
#pragma unroll
            for (int i = 0; i < 8; ++i) st[i] = dec * st[i] + f[i];
            *p = pack8(st);
        }
    }
}
__device__ __forceinline__ void ret_out_phase(const Frame& F, CArgs& A) {
    const bf16* H = (const bf16*)(F.ws + WS_H); const bf16* STF = (const bf16*)(F.ws + WS_STF); const bf16* STB = (const bf16*)(F.ws + WS_STB);
    bf16* CC = (bf16*)(F.ws + WS_CONCAT);
    LAS bf16* RA = (LAS bf16*)F.lds; LAS bf16* RB = RA + 128 * RS; LAS bf16* RC = RA + 384 * RS;
    const int tid = F.tid, lane = F.lane, lr = lane & 15, lq = lane >> 4, wi = F.wave >> 2, wj = F.wave & 3, we = F.wave & 3;
    for (int u = F.bx; u < 1280; u += F.G) {
        const int h = u & 3, c = u >> 2, t0 = c * 128;
        const int cs = c < 256 ? (c & 31) : (c - 256), ncs = c < 256 ? 32 : 64;
        const bool has_f = cs > 0, has_b = cs < ncs - 1;
        const float lg = ret_log2_gamma(h);
        f32x4 S[4][2];
#pragma unroll
        for (int ti = 0; ti < 4; ++ti)
#pragma unroll
            for (int tj = 0; tj < 2; ++tj) S[ti][tj] = (f32x4){0.f, 0.f, 0.f, 0.f};
#pragma unroll
        for (int dh = 0; dh < 2; ++dh) {
            if (dh) __syncthreads();
#pragma unroll 1
            for (int r = 0; r < 4; ++r) { const int f = opaque(tid) + 512 * r, row = f >> 4, pc = f & 15;
                const bf16* src = H + (size_t)(t0 + row) * INW + h * 256 + dh * 128 + pc * 8;
                *(LAS v4u*)(RA + row * RS + pc * 8) = *(const v4u*)(src + COL_Q);
                *(LAS v4u*)(RB + row * RS + pc * 8) = *(const v4u*)(src + COL_K); }
            __syncthreads();
#pragma unroll
            for (int ks = 0; ks < 4; ++ks) {
                bf16x8 ka[2], qb[4];
#pragma unroll
                for (int tj = 0; tj < 2; ++tj) ka[tj] = *(const LAS bf16x8*)(RB + (32 * wj + 16 * tj + lr) * RS + 32 * ks + lq * 8);
#pragma unroll
                for (int ti = 0; ti < 4; ++ti) qb[ti] = *(const LAS bf16x8*)(RA + (64 * wi + 16 * ti + lr) * RS + 32 * ks + lq * 8);
#pragma unroll
                for (int ti = 0; ti < 4; ++ti)
#pragma unroll
                    for (int tj = 0; tj < 2; ++tj) S[ti][tj] = MFMA16(ka[tj], qb[ti], S[ti][tj]);
            }
        }
#pragma unroll
        for (int ti = 0; ti < 4; ++ti)
#pragma unroll
            for (int tj = 0; tj < 2; ++tj) {
                const int i = 64 * wi + 16 * ti + lr, j0 = 32 * wj + 16 * tj + 4 * lq; float p[4];
#pragma unroll
                for (int jj = 0; jj < 4; ++jj) { const int d = i - (j0 + jj); p[jj] = S[ti][tj][jj] * exp2f(lg * (float)(d < 0 ? -d : d)); }
                v2u w; w.x = pkbf(p[0], p[1]); w.y = pkbf(p[2], p[3]); *(LAS v2u*)(RC + i * RS + j0) = w;
            }
        __syncthreads();
        {
            const int tq = opaque(tid), jp = tq & 63, pc0 = tq >> 6; const bf16* vrow = H + (size_t)(t0 + 2 * jp) * INW + COL_V + h * 256;
            LAS unsigned* RB32 = (LAS unsigned*)RB;
#pragma unroll 1
            for (int r = 0; r < 4; ++r) { const int pc = pc0 + 8 * r; const v4u v0 = *(const v4u*)(vrow + pc * 8), v1 = *(const v4u*)(vrow + INW + pc * 8);
                const unsigned va0[4] = {v0.x, v0.y, v0.z, v0.w}, va1[4] = {v1.x, v1.y, v1.z, v1.w};
#pragma unroll
                for (int i = 0; i < 8; ++i) { const unsigned a = va0[i >> 1], b = va1[i >> 1];
                    RB32[((pc * 8 + i) * RS) / 2 + jp] = (i & 1) ? ((a >> 16) | (b & 0xffff0000u)) : ((a & 0xffffu) | (b << 16)); } }
        }
        __syncthreads();
        f32x4 O[4][4];
#pragma unroll
        for (int ti = 0; ti < 4; ++ti)
#pragma unroll
            for (int te = 0; te < 4; ++te) O[ti][te] = (f32x4){0.f, 0.f, 0.f, 0.f};
#pragma unroll
        for (int ks = 0; ks < 4; ++ks) {
            bf16x8 va[4], pb[4];
#pragma unroll
            for (int te = 0; te < 4; ++te) va[te] = *(const LAS bf16x8*)(RB + (64 * we + 16 * te + lr) * RS + 32 * ks + lq * 8);
#pragma unroll
            for (int ti = 0; ti < 4; ++ti) pb[ti] = *(const LAS bf16x8*)(RC + (64 * wi + 16 * ti + lr) * RS + 32 * ks + lq * 8);
#pragma unroll
            for (int ti = 0; ti < 4; ++ti)
#pragma unroll
                for (int te = 0; te < 4; ++te) O[ti][te] = MFMA16(va[te], pb[ti], O[ti][te]);
        }
#pragma unroll
        for (int dir = 0; dir < 2; ++dir) {
            if (dir == 0 ? has_f : has_b) {
                const bf16* St = (dir == 0 ? STF + (size_t)((c - 1) * 4 + h) * 65536 : STB + (size_t)((c + 1) * 4 + h) * 65536);
#pragma unroll
                for (int dh = 0; dh < 2; ++dh) {
                    __syncthreads();
#pragma unroll 1
                    for (int r = 0; r < 4; ++r) { const int f = opaque(tid) + 512 * r, row = f >> 4, pc = f & 15;
                        const float fac = exp2f(lg * (dir == 0 ? (float)(row + 1) : (float)(128 - row)));
                        float qf[8]; unpack8(*(const v4u*)(H + (size_t)(t0 + row) * INW + COL_Q + h * 256 + dh * 128 + pc * 8), qf);
#pragma unroll
                        for (int k = 0; k < 8; ++k) qf[k] *= fac;
                        *(LAS v4u*)(RA + row * RS + pc * 8) = pack8(qf); }
#pragma unroll 2
                    for (int r = 0; r < 8; ++r) { const int f = opaque(tid) + 512 * r, row = f >> 4, pc = f & 15;
                        *(LAS v4u*)(RB + row * RS + pc * 8) = *(const v4u*)(St + (size_t)row * 256 + dh * 128 + pc * 8); }
                    __syncthreads();
#pragma unroll
                    for (int ks = 0; ks < 4; ++ks) {
                        bf16x8 sa[4], qb[4];
#pragma unroll
                        for (int te = 0; te < 4; ++te) sa[te] = *(const LAS bf16x8*)(RB + (64 * we + 16 * te + lr) * RS + 32 * ks + lq * 8);
#pragma unroll
                        for (int ti = 0; ti < 4; ++ti) qb[ti] = *(const LAS bf16x8*)(RA + (64 * wi + 16 * ti + lr) * RS + 32 * ks + lq * 8);
#pragma unroll
                        for (int ti = 0; ti < 4; ++ti)
#pragma unroll
                            for (int te = 0; te < 4; ++te) O[ti][te] = MFMA16(sa[te], qb[ti], O[ti][te]);
                    }
                }
            }
        }
        __syncthreads();
        LAS float* RED = (LAS float*)RA;
#pragma unroll
        for (int ti = 0; ti < 4; ++ti) { float s1 = 0.f, s2 = 0.f;
#pragma unroll
            for (int te = 0; te < 4; ++te)
#pragma unroll
                for (int jj = 0; jj < 4; ++jj) { const float v = O[ti][te][jj]; s1 += v; s2 += v * v; }
            s1 += __shfl_xor(s1, 16); s1 += __shfl_xor(s1, 32); s2 += __shfl_xor(s2, 16); s2 += __shfl_xor(s2, 32);
            if (lq == 0) { RED[((64 * wi + 16 * ti + lr) * 4 + we) * 2] = s1; RED[((64 * wi + 16 * ti + lr) * 4 + we) * 2 + 1] = s2; } }
        __syncthreads();
#pragma unroll
        for (int ti = 0; ti < 4; ++ti) { const int i = 64 * wi + 16 * ti + lr;
            const f32x4 r0 = *(const LAS f32x4*)(RED + i * 8), r1 = *(const LAS f32x4*)(RED + i * 8 + 4);
            const float m = (r0[0] + r0[2] + r1[0] + r1[2]) * (1.0f / 256.0f), q = (r0[1] + r0[3] + r1[1] + r1[3]) * (1.0f / 256.0f);
            const float var = fmaxf(q - m * m, 0.f), rstd = 1.0f / sqrtf(var + GN_EPS);
#pragma unroll
            for (int te = 0; te < 4; ++te) { const int e0 = 64 * we + 16 * te + 4 * lq;
                const v2u gq = *(const v2u*)(H + (size_t)(t0 + i) * INW + COL_G + h * 256 + e0);
                const float gv[4] = {bf_lo(gq.x), bf_hi(gq.x), bf_lo(gq.y), bf_hi(gq.y)}; float ov[4];
#pragma unroll
                for (int jj = 0; jj < 4; ++jj) { const float gg = gv[jj]; ov[jj] = (gg / (1.0f + __expf(-gg))) * ((O[ti][te][jj] - m) * rstd); }
                v2u w; w.x = pkbf(ov[0], ov[1]); w.y = pkbf(ov[2], ov[3]);
                *(v2u*)(CC + (size_t)(t0 + i) * DM + 1024 + h * 256 + e0) = w; } }
        __syncthreads();
    }
}

__device__ __forceinline__ unsigned f2key(float f) { const unsigned u = __float_as_uint(f); return (u & 0x80000000u) ? ~u : (u | 0x80000000u); }
__device__ __forceinline__ float key2f(unsigned k) { const unsigned u = (k & 0x80000000u) ? (k & 0x7fffffffu) : ~k; return __uint_as_float(u); }
#define TK_CE(a, b) do { const unsigned hi_ = (a) > (b) ? (a) : (b), lo_ = (a) > (b) ? (b) : (a); (a) = hi_; (b) = lo_; } while (0)
__device__ __forceinline__ void bitonic_merge16(unsigned (&v)[16]) {
#pragma unroll
    for (int j = 8; j > 0; j >>= 1)
#pragma unroll
        for (int i = 0; i < 16; ++i) { const int l = i ^ j; if (l > i) TK_CE(v[i], v[l]); }
}
__device__ __forceinline__ void bitonic_sort16(unsigned (&v)[16]) {
#pragma unroll
    for (int k = 2; k <= 16; k <<= 1)
#pragma unroll
        for (int j = k >> 1; j > 0; j >>= 1)
#pragma unroll
            for (int i = 0; i < 16; ++i) { const int l = i ^ j; if (l > i) { if ((i & k) == 0) TK_CE(v[i], v[l]); else TK_CE(v[l], v[i]); } }
}
__device__ __forceinline__ void topk_phase(const Frame& F, CArgs& A) {
    const float* SC = (const float*)(F.ws + WS_H); int* IDX = (int*)(F.ws + WS_IDX); float* GATE = (float*)(F.ws + WS_GATE);
    LAS unsigned* LK = (LAS unsigned*)F.lds;
    const int tid = F.tid, tl = tid >> 4, hp = tid & 15;
    for (int blk = F.bx; blk < NTOK / 32; blk += F.G) {
        const int t = blk * 32 + tl;
        const float* row = SC + (size_t)t * DM + hp * 128;
        unsigned run[16];
#pragma unroll
        for (int k = 0; k < 16; ++k) run[k] = 0u;
        f32x4 cur[8], nxt[8];
#pragma unroll
        for (int q = 0; q < 8; ++q) cur[q] = *(const f32x4*)(row + q * 4);
        for (int n32 = 0; n32 < 4; ++n32) {
            if (n32 < 3) {
#pragma unroll
                for (int q = 0; q < 8; ++q) nxt[q] = *(const f32x4*)(row + (n32 + 1) * 32 + q * 4);
            }
#pragma unroll
            for (int hc = 0; hc < 2; ++hc) {
                unsigned ch[16];
#pragma unroll
                for (int q = 0; q < 4; ++q)
#pragma unroll
                    for (int e = 0; e < 4; ++e) { const int n = n32 * 32 + hc * 16 + q * 4 + e; ch[q * 4 + e] = (f2key(cur[hc * 4 + q][e]) & ~127u) | (unsigned)(127 - n); }
                bitonic_sort16(ch);
#pragma unroll
                for (int i = 0; i < 16; ++i) run[i] = run[i] > ch[15 - i] ? run[i] : ch[15 - i];
                bitonic_merge16(run);
            }
#pragma unroll
            for (int q = 0; q < 8; ++q) cur[q] = nxt[q];
        }
#pragma unroll
        for (int k = 0; k < 16; ++k) LK[tid * 17 + k] = run[k];
        __syncthreads();
        if ((hp & 1) == 0) {
            float a[16], b[16];
#pragma unroll
            for (int k = 0; k < 16; ++k) { a[k] = key2f(LK[tid * 17 + k] & ~127u); b[k] = key2f(LK[(tid + 1) * 17 + k] & ~127u); }
            unsigned sk[16];
#pragma unroll
            for (int k = 0; k < 16; ++k) sk[k] = 0u;
#pragma unroll
            for (int i = 0; i < 16; ++i)
#pragma unroll
                for (int j = 0; j < 16; ++j) if ((i + 1) * (j + 1) <= 16) {
                    unsigned key = (f2key(a[i] + b[j]) & ~255u) | (unsigned)(255 - (i * 16 + j));
#pragma unroll
                    for (int k = 0; k < 16; ++k) { const unsigned hi = sk[k] > key ? sk[k] : key, lo = sk[k] > key ? key : sk[k]; sk[k] = hi; key = lo; }
                }
            float e[16], sum = 0.f; const float s0 = key2f(sk[0] & ~255u);
#pragma unroll
            for (int k = 0; k < 16; ++k) { e[k] = __expf(key2f(sk[k] & ~255u) - s0); sum += e[k]; }
            const float inv = 1.0f / sum; const int head = hp >> 1;
#pragma unroll
            for (int k = 0; k < 16; ++k) {
                const int cell = 255 - (int)(sk[k] & 255u);
                const int i1 = 127 - (int)(LK[tid * 17 + (cell >> 4)] & 127u), i2 = 127 - (int)(LK[(tid + 1) * 17 + (cell & 15)] & 127u);
                IDX[(size_t)t * 128 + head * 16 + k] = i1 * 128 + i2;
                GATE[(size_t)t * 128 + head * 16 + k] = e[k] * inv;
            }
        }
        __syncthreads();
    }
}
#if PEER_FP4
__device__ __forceinline__ void peer_gather_phase(const Frame& F, CArgs& A, int l, float* xdst_base, bf16* XN) {
    constexpr int RB = DM / 2;
    constexpr int GNR = GATHER_ROWS;
    const unsigned char* U8 = F.ws + WS_U8 + (size_t)l * NEXP * RB; const unsigned char* V8 = F.ws + WS_V8 + (size_t)l * NEXP * RB;
    const float* USC = (const float*)(F.ws + WS_USC) + (size_t)l * NEXP; const float* VSC = (const float*)(F.ws + WS_VSC) + (size_t)l * NEXP;
    const int* IDX = (const int*)(F.ws + WS_IDX); const float* GATE = (const float*)(F.ws + WS_GATE);
    const float* g2 = A.in[I_LN2G] + (size_t)l * DM; const float* b2 = A.in[I_LN2B] + (size_t)l * DM;
    const int lane = F.lane, slot = 8 * (lane & 7) + (lane >> 3);
    for (int t = F.gw; t < NTOK; t += F.NGW) {
        float* xrow = F.out + (size_t)t * DM;
        f32x2v x[16];
#pragma unroll
        for (int q = 0; q < 8; ++q) { const f32x4 a = *(const f32x4*)(xrow + q * 256 + lane * 4); x[2 * q] = (f32x2v){a[0], a[1]}; x[2 * q + 1] = (f32x2v){a[2], a[3]}; }
        const int idx0 = IDX[(size_t)t * 128 + slot], idx1 = IDX[(size_t)t * 128 + 64 + slot];
        v4u BU[GNR];
        const unsigned loff = (unsigned)lane * 16u;
#define G_ROW_U(R) (U8 + (size_t)(unsigned)__builtin_amdgcn_readlane((((R) >> 6) & 1) ? idx1 : idx0, ((R) & 7) * 8 + (((R) >> 3) & 7)) * RB)
#define G_ROW_V(R) (V8 + (size_t)(unsigned)__builtin_amdgcn_readlane((((R) >> 6) & 1) ? idx1 : idx0, (R) & 63) * RB)
#define G_REQ(r, rowptr) do { BU[r] = *(const v4u*)((rowptr) + loff); } while (0)
#define G_DOT(r, dst) do { f32x2v s2_ = (f32x2v){0.f, 0.f}; \
            _Pragma("unroll") for (int q = 0; q < 4; ++q) { s2_ += __builtin_amdgcn_cvt_scalef32_pk_f32_fp4(BU[r][q], 1.0f, 0) * x[4 * q]; s2_ += __builtin_amdgcn_cvt_scalef32_pk_f32_fp4(BU[r][q], 1.0f, 1) * x[4 * q + 1]; \
                s2_ += __builtin_amdgcn_cvt_scalef32_pk_f32_fp4(BU[r][q], 1.0f, 2) * x[4 * q + 2]; s2_ += __builtin_amdgcn_cvt_scalef32_pk_f32_fp4(BU[r][q], 1.0f, 3) * x[4 * q + 3]; } \
            if (GATHER_PROBE) { f32x2v p2_ = (f32x2v){0.f, 0.f}; _Pragma("unroll") for (int q = 0; q < 4; ++q) { const unsigned wq_ = (unsigned)opaque((int)BU[r][q]); p2_ += __builtin_amdgcn_cvt_scalef32_pk_f32_fp4(wq_, 1.0f, 0) * x[4 * q]; p2_ += __builtin_amdgcn_cvt_scalef32_pk_f32_fp4(wq_, 1.0f, 1) * x[4 * q + 1]; p2_ += __builtin_amdgcn_cvt_scalef32_pk_f32_fp4(wq_, 1.0f, 2) * x[4 * q + 2]; p2_ += __builtin_amdgcn_cvt_scalef32_pk_f32_fp4(wq_, 1.0f, 3) * x[4 * q + 3]; } s2_ += p2_ * 0.0f; } \
            dst = s2_[0] + s2_[1]; } while (0)
#define G_REDUCE(g) do { \
            _Pragma("unroll") for (int i = 0; i < 4; ++i) { const float mine = b5 ? part[i + 4] : part[i], send = b5 ? part[i] : part[i + 4]; part[i] = mine + __shfl_xor(send, 32); } \
            _Pragma("unroll") for (int i = 0; i < 2; ++i) { const float mine = b4 ? part[i + 2] : part[i], send = b4 ? part[i] : part[i + 2]; part[i] = mine + __shfl_xor(send, 16); } \
            { const float mine = b3 ? part[1] : part[0], send = b3 ? part[0] : part[1]; part[0] = mine + __shfl_xor(send, 8); } \
            float v_ = part[0]; v_ += __shfl_xor(v_, 4); v_ += __shfl_xor(v_, 2); v_ += __shfl_xor(v_, 1); \
            const bool mine_ = (lane & 7) == ((g) & 7); hval0 = (mine_ && ((g) >> 3) == 0) ? v_ : hval0; hval1 = (mine_ && ((g) >> 3) == 1) ? v_ : hval1; } while (0)
        if (GATHER_PROBE2) {
            const int pm0 = idx0 & (GATHER_PROBE2 - 1), pm1 = idx1 & (GATHER_PROBE2 - 1); f32x2v ps = (f32x2v){0.f, 0.f};
#define G_ROW_P(R) (U8 + (size_t)(unsigned)__builtin_amdgcn_readlane((((R) >> 6) & 1) ? pm1 : pm0, (R) & 63) * RB)
#pragma unroll
            for (int r = 0; r < GNR; ++r) G_REQ(r, G_ROW_P(r));
            for (int it = 0; it < 128 / GNR - 1; ++it) {
#pragma unroll
                for (int r = 0; r < GNR; ++r) { float d_; G_DOT(r, d_); ps[0] += d_; G_REQ(r, G_ROW_P(GNR * (it + 1) + r)); }
            }
#pragma unroll
            for (int r = 0; r < GNR; ++r) { float d_; G_DOT(r, d_); ps[1] += d_; }
            asm volatile("" :: "v"(ps[0]), "v"(ps[1]));
#undef G_ROW_P
        }
        const bool b5 = (lane & 32) != 0, b4 = (lane & 16) != 0, b3 = (lane & 8) != 0;
        float hval0 = 0.f, hval1 = 0.f;
#pragma unroll
        for (int r = 0; r < GNR; ++r) G_REQ(r, G_ROW_U(r));
        for (int it = 0; it < 128 / GNR - 1; ++it) {
#pragma unroll
            for (int g4 = 0; g4 < GNR / 8; ++g4) { float part[8];
#pragma unroll
                for (int i = 0; i < 8; ++i) { G_DOT(g4 * 8 + i, part[i]); G_REQ(g4 * 8 + i, G_ROW_U(GNR * (it + 1) + g4 * 8 + i)); }
                G_REDUCE(it * (GNR / 8) + g4); }
        }
#pragma unroll
        for (int g4 = 0; g4 < GNR / 8; ++g4) { float part[8];
#pragma unroll
            for (int i = 0; i < 8; ++i) { G_DOT(g4 * 8 + i, part[i]); G_REQ(g4 * 8 + i, G_ROW_V(g4 * 8 + i)); }
            G_REDUCE(16 - GNR / 8 + g4); }
        const float gate0 = GATE[(size_t)t * 128 + slot], gate1 = GATE[(size_t)t * 128 + 64 + slot];
        const float usc0 = USC[idx0], usc1 = USC[idx1], vsc0 = VSC[idx0], vsc1 = VSC[idx1];
        const float w0 = gate0 * gelu_erf(hval0 * usc0) * vsc0, w1 = gate1 * gelu_erf(hval1 * usc1) * vsc1;
        f32x2v acc[16];
#pragma unroll
        for (int k = 0; k < 16; ++k) acc[k] = (f32x2v){0.f, 0.f};
#define G_AXPY(r, R) do { const float w_ = __uint_as_float((unsigned)__builtin_amdgcn_readlane((int)__float_as_uint((((R) >> 6) & 1) ? w1 : w0), (R) & 63)); const f32x2v w2_ = (f32x2v){w_, w_}; \
            _Pragma("unroll") for (int q = 0; q < 4; ++q) { acc[4 * q] += w2_ * __builtin_amdgcn_cvt_scalef32_pk_f32_fp4(BU[r][q], 1.0f, 0); acc[4 * q + 1] += w2_ * __builtin_amdgcn_cvt_scalef32_pk_f32_fp4(BU[r][q], 1.0f, 1); \
                acc[4 * q + 2] += w2_ * __builtin_amdgcn_cvt_scalef32_pk_f32_fp4(BU[r][q], 1.0f, 2); acc[4 * q + 3] += w2_ * __builtin_amdgcn_cvt_scalef32_pk_f32_fp4(BU[r][q], 1.0f, 3); } } while (0)
        for (int it = 0; it < 128 / GNR - 1; ++it) {
#pragma unroll
            for (int r = 0; r < GNR; ++r) { G_AXPY(r, GNR * it + r); G_REQ(r, G_ROW_V(GNR * (it + 1) + r)); }
        }
#pragma unroll
        for (int r = 0; r < GNR; ++r) G_AXPY(r, 128 - GNR + r);
#undef G_ROW_U
#undef G_ROW_V
#undef G_REQ
#undef G_DOT
#undef G_REDUCE
#undef G_AXPY
        const int le = opaque(lane);
        float s = 0.f;
#pragma unroll
        for (int j = 0; j < 8; ++j) { const f32x4 xr = *(const f32x4*)(xrow + j * 256 + le * 4);
            acc[2 * j] = (f32x2v){xr[0], xr[1]} * ALPHA + acc[2 * j]; acc[2 * j + 1] = (f32x2v){xr[2], xr[3]} * ALPHA + acc[2 * j + 1];
            s += (acc[2 * j][0] + acc[2 * j][1]) + (acc[2 * j + 1][0] + acc[2 * j + 1][1]); }
        const float mean = wave_sum(s) * (1.0f / DM); float s2 = 0.f;
#pragma unroll
        for (int k = 0; k < 16; ++k) { acc[k] = acc[k] - mean; s2 += acc[k][0] * acc[k][0] + acc[k][1] * acc[k][1]; }
        const float rstd = 1.0f / sqrtf(wave_sum(s2) * (1.0f / DM) + LN_EPS);
#pragma unroll
        for (int j = 0; j < 8; ++j) { const int col = j * 256 + le * 4;
            const f32x4 gg = *(const f32x4*)(g2 + col), bb = *(const f32x4*)(b2 + col);
            const f32x2v a0 = acc[2 * j], a1 = acc[2 * j + 1];
            const f32x4 o = (f32x4){a0[0] * rstd * gg[0] + bb[0], a0[1] * rstd * gg[1] + bb[1], a1[0] * rstd * gg[2] + bb[2], a1[1] * rstd * gg[3] + bb[3]};
            *(f32x4*)(xdst_base + (size_t)t * DM + col) = o;
            v2u w; w.x = pkbf(o[0], o[1]); w.y = pkbf(o[2], o[3]); *(v2u*)(XN + (size_t)t * DM + col) = w; }
    }
}

#else
__device__ __forceinline__ void peer_gather_phase(const Frame& F, CArgs& A, int l) {
    const unsigned char* U8 = F.ws + WS_U8 + (size_t)l * NEXP * DM; const unsigned char* V8 = F.ws + WS_V8 + (size_t)l * NEXP * DM;
    const float* USC = (const float*)(F.ws + WS_USC) + (size_t)l * NEXP; const float* VSC = (const float*)(F.ws + WS_VSC) + (size_t)l * NEXP;
    const int* IDX = (const int*)(F.ws + WS_IDX); const float* GATE = (const float*)(F.ws + WS_GATE);
    const float* g2 = A.in[I_LN2G] + (size_t)l * DM; const float* b2 = A.in[I_LN2B] + (size_t)l * DM;
    bf16* XN = (bf16*)(F.ws + WS_XN);
    const int lane = F.lane, slot = 8 * (lane & 7) + (lane >> 3);
    for (int t = F.gw; t < NTOK; t += F.NGW) {
        float* xrow = F.out + (size_t)t * DM;
        f32x2v x[2][8];
#pragma unroll
        for (int c = 0; c < 2; ++c)
#pragma unroll
            for (int q = 0; q < 4; ++q) { const f32x4 a = *(const f32x4*)(xrow + (c * 64 + lane) * 16 + q * 4); x[c][2 * q] = (f32x2v){a[0], a[1]}; x[c][2 * q + 1] = (f32x2v){a[2], a[3]}; }
        const int idx0 = IDX[(size_t)t * 128 + slot], idx1 = IDX[(size_t)t * 128 + 64 + slot];
        v4u BU[8][2];
        const unsigned loff0 = (unsigned)lane * 16u, loff1 = (unsigned)lane * 16u + 1024u;
#define G_ROW_U(i, b) (U8 + (size_t)(unsigned)__builtin_amdgcn_readlane(((b) >> 3) ? idx1 : idx0, (i) * 8 + ((b) & 7)) * DM)
#define G_ROW_V(i, b) (V8 + (size_t)(unsigned)__builtin_amdgcn_readlane(((b) >> 3) ? idx1 : idx0, ((b) & 7) * 8 + (i)) * DM)
#define G_REQ(i, rowptr) do { const unsigned char* r_ = (rowptr); BU[i][0] = *(const v4u*)(r_ + loff0); BU[i][1] = *(const v4u*)(r_ + loff1); } while (0)
#define G_DOT(i, dst) do { f32x2v s2_ = (f32x2v){0.f, 0.f}; \
            _Pragma("unroll") for (int c = 0; c < 2; ++c) _Pragma("unroll") for (int q = 0; q < 4; ++q) { s2_ += __builtin_amdgcn_cvt_pk_f32_fp8((int)BU[i][c][q], false) * x[c][2 * q]; s2_ += __builtin_amdgcn_cvt_pk_f32_fp8((int)BU[i][c][q], true) * x[c][2 * q + 1]; } \
            dst = s2_[0] + s2_[1]; } while (0)
#define G_REDUCE(b) do { \
            _Pragma("unroll") for (int i = 0; i < 4; ++i) { const float mine = b5 ? part[i + 4] : part[i], send = b5 ? part[i] : part[i + 4]; part[i] = mine + __shfl_xor(send, 32); } \
            _Pragma("unroll") for (int i = 0; i < 2; ++i) { const float mine = b4 ? part[i + 2] : part[i], send = b4 ? part[i] : part[i + 2]; part[i] = mine + __shfl_xor(send, 16); } \
            { const float mine = b3 ? part[1] : part[0], send = b3 ? part[0] : part[1]; part[0] = mine + __shfl_xor(send, 8); } \
            float v_ = part[0]; v_ += __shfl_xor(v_, 4); v_ += __shfl_xor(v_, 2); v_ += __shfl_xor(v_, 1); \
            const bool mine_ = (lane & 7) == ((b) & 7); hval0 = (mine_ && ((b) >> 3) == 0) ? v_ : hval0; hval1 = (mine_ && ((b) >> 3) == 1) ? v_ : hval1; } while (0)
        const bool b5 = (lane & 32) != 0, b4 = (lane & 16) != 0, b3 = (lane & 8) != 0;
        float hval0 = 0.f, hval1 = 0.f;
#pragma unroll
        for (int i = 0; i < 8; ++i) G_REQ(i, G_ROW_U(i, 0));
        for (int b = 0; b < 15; ++b) {
            float part[8];
#pragma unroll
            for (int i = 0; i < 8; ++i) { G_DOT(i, part[i]); G_REQ(i, G_ROW_U(i, b + 1)); }
            G_REDUCE(b);
        }
        {
            float part[8];
#pragma unroll
            for (int i = 0; i < 8; ++i) { G_DOT(i, part[i]); G_REQ(i, G_ROW_V(i, 0)); }
            G_REDUCE(15);
        }
        const float gate0 = GATE[(size_t)t * 128 + slot], gate1 = GATE[(size_t)t * 128 + 64 + slot];
        const float usc0 = USC[idx0], usc1 = USC[idx1], vsc0 = VSC[idx0], vsc1 = VSC[idx1];
        const float w0 = gate0 * gelu_erf(hval0 * usc0) * vsc0, w1 = gate1 * gelu_erf(hval1 * usc1) * vsc1;
        f32x2v acc[2][8];
#pragma unroll
        for (int c = 0; c < 2; ++c)
#pragma unroll
            for (int k = 0; k < 8; ++k) acc[c][k] = (f32x2v){0.f, 0.f};
#define G_AXPY(i, b) do { const float w_ = __uint_as_float((unsigned)__builtin_amdgcn_readlane((int)__float_as_uint(((b) >> 3) ? w1 : w0), ((b) & 7) * 8 + (i))); const f32x2v w2_ = (f32x2v){w_, w_}; \
            _Pragma("unroll") for (int c = 0; c < 2; ++c) _Pragma("unroll") for (int q = 0; q < 4; ++q) { acc[c][2 * q] += w2_ * __builtin_amdgcn_cvt_pk_f32_fp8((int)BU[i][c][q], false); acc[c][2 * q + 1] += w2_ * __builtin_amdgcn_cvt_pk_f32_fp8((int)BU[i][c][q], true); } } while (0)
        for (int b = 0; b < 15; ++b) {
#pragma unroll
            for (int i = 0; i < 8; ++i) { G_AXPY(i, b); G_REQ(i, G_ROW_V(i, b + 1)); }
        }
#pragma unroll
        for (int i = 0; i < 8; ++i) G_AXPY(i, 15);
#undef G_ROW_U
#undef G_ROW_V
#undef G_REQ
#undef G_DOT
#undef G_REDUCE
#undef G_AXPY
        const int le = opaque(lane);
        float s = 0.f;
#pragma unroll
        for (int c = 0; c < 2; ++c)
#pragma unroll
            for (int k = 0; k < 8; ++k) { const f32x2v xr = *(const f32x2v*)(xrow + (c * 64 + le) * 16 + 2 * k);
                acc[c][k] = xr * ALPHA + acc[c][k]; s += acc[c][k][0] + acc[c][k][1]; }
        const float mean = wave_sum(s) * (1.0f / DM); float s2 = 0.f;
#pragma unroll
        for (int c = 0; c < 2; ++c)
#pragma unroll
            for (int k = 0; k < 8; ++k) { acc[c][k] = acc[c][k] - mean; s2 += acc[c][k][0] * acc[c][k][0] + acc[c][k][1] * acc[c][k][1]; }
        const float rstd = 1.0f / sqrtf(wave_sum(s2) * (1.0f / DM) + LN_EPS);
#pragma unroll
        for (int c = 0; c < 2; ++c) { const int col = (c * 64 + le) * 16;
#pragma unroll
            for (int h8 = 0; h8 < 2; ++h8) { float o[8];
#pragma unroll
                for (int q = 0; q < 2; ++q) { const f32x4 gg = *(const f32x4*)(g2 + col + h8 * 8 + q * 4), bb = *(const f32x4*)(b2 + col + h8 * 8 + q * 4);
                    const f32x2v a0 = acc[c][h8 * 4 + 2 * q], a1 = acc[c][h8 * 4 + 2 * q + 1];
                    o[4 * q] = a0[0] * rstd * gg[0] + bb[0]; o[4 * q + 1] = a0[1] * rstd * gg[1] + bb[1]; o[4 * q + 2] = a1[0] * rstd * gg[2] + bb[2]; o[4 * q + 3] = a1[1] * rstd * gg[3] + bb[3];
                    *(f32x4*)(xrow + col + h8 * 8 + q * 4) = (f32x4){o[4 * q], o[4 * q + 1], o[4 * q + 2], o[4 * q + 3]}; }
                *(v4u*)(XN + (size_t)t * DM + col + h8 * 8) = pack8(o); } }
    }
}

#endif
#ifndef DUP_MASK
#define DUP_MASK 0
#endif
#ifndef PHASE_TEST_ONLY
__global__ void __launch_bounds__(NTHR, 2) fwd_kernel(Args A) {
    extern __shared__ __attribute__((aligned(16))) unsigned char lds_raw[];
#define MKFRAME() Frame F; CArgs& KA = *(CArgs*)opaque_u64((unsigned long long)__builtin_amdgcn_kernarg_segment_ptr()); { F.lds = (LAS unsigned char*)lds_raw; F.tid = opaque((int)threadIdx.x); F.lane = F.tid & 63; F.wave = __builtin_amdgcn_readfirstlane(F.tid >> 6); \
        const int bx_ = opaque_s((int)blockIdx.x); F.G = gridDim.x; F.gw = bx_ * NWAVES + F.wave; F.NGW = F.G * NWAVES; F.gtid = (size_t)bx_ * NTHR + F.tid; F.NT = (size_t)F.G * NTHR; F.out = (float*)opaque_p(KA.out); F.ws = (unsigned char*)opaque_p(KA.ws); F.bx = bx_; } \
        bf16* XN = (bf16*)(F.ws + WS_XN); bf16* H = (bf16*)(F.ws + WS_H); bf16* CC = (bf16*)(F.ws + WS_CONCAT); (void)XN; (void)H; (void)CC;
    volatile LAS unsigned* MISC = (volatile LAS unsigned*)((LAS unsigned char*)lds_raw + LDS_MISC);
    if (threadIdx.x < 64) MISC[threadIdx.x] = 0u;
    __syncthreads();
    XcdBarrier bar = xcd_barrier_post((unsigned*)(A.ws + WS_CTL) + CW_BAR + A.li * XCD_BAR_WORDS, MISC + 8);
    const int lo = A.ph_lo, hi = A.ph_hi;
#define IN(k) (lo <= (k) && (k) < hi)
#define SEAM(k) do { if (lo <= (k) && (k) + 1 < hi) xcd_barrier(bar); } while (0)

    if (IN(0)) { MKFRAME(); p0_prologue(F, KA); if (DUP_MASK & 256) { __syncthreads(); p0_prologue(F, KA); } } SEAM(0);

    for (int l = 0; l < NLAYER; ++l) {
        const int pb = 1 + l * 10;
        if (IN(pb + 0)) { MKFRAME();
            pg8::Gemm g{XN, (const bf16*)(F.ws + WS_WIN) + (size_t)l * INW * DM, NTOK, INW, DM}; pg8::StaticOrder S; S.init(NTOK, INW, F.G, F.bx);
            EpiStoreBf16 E{H, INW};
            pg8::gemm_phase<EpiStoreBf16, pg8::StaticOrder, true, true>(F.lds, g, S, E);
            if (DUP_MASK & 64) { pg8::gemm_phase<EpiStoreBf16, pg8::StaticOrder, true, true>(F.lds, g, S, E); }
        } SEAM(pb + 0);
        if (IN(pb + 1)) { MKFRAME(); s5_pass1(F, KA, l); pool_phase(F, KA); if (DUP_MASK & 1) { s5_pass1(F, KA, l); } if (DUP_MASK & 2) { pool_phase(F, KA); } rotary_phase(F, KA); } SEAM(pb + 1);
        if (IN(pb + 2)) { MKFRAME(); s5_carry(F, KA, l); __syncthreads(); ret_state_phase(F, KA); if (DUP_MASK & 4) { ret_state_phase(F, KA); } } SEAM(pb + 2);
        if (IN(pb + 3)) { MKFRAME(); s5_pass3(F, KA, l); if (DUP_MASK & 8) { s5_pass3(F, KA, l); } ret_prefix_phase(F, KA); } SEAM(pb + 3);
        if (IN(pb + 4)) { MKFRAME();
            __syncthreads();
            ret_out_phase(F, KA);
            if (DUP_MASK & 16) { ret_out_phase(F, KA); }
            {
                pg8::Gemm g{(const bf16*)(F.ws + WS_BUFY), (const bf16*)(F.ws + WS_WGLU) + (size_t)l * 512 * 512, NTOK, 512, 512}; pg8::StaticOrder S; S.init(NTOK, 512, F.G, F.bx);
                EpiGlu E{(const bf16*)(F.ws + WS_BUFY), 512, CC, DM, KA.in[I_BGLU] + (size_t)l * 512};
                pg8::gemm_phase<EpiGlu, pg8::StaticOrder, true, true>(F.lds, g, S, E);
                if (DUP_MASK & 512) { pg8::gemm_phase<EpiGlu, pg8::StaticOrder, true, true>(F.lds, g, S, E); }
            }
            {
                pg8::Gemm g{(const bf16*)(F.ws + WS_BUFP), (const bf16*)(F.ws + WS_WPOOL) + (size_t)l * 512 * 512, NTOK, 512, 512}; pg8::StaticOrder S; S.init(NTOK, 512, F.G, F.bx);
                EpiScaleBf16 E{CC + 512, DM, KA.in[I_POOLS] + (size_t)l * 512};
                pg8::gemm_phase<EpiScaleBf16, pg8::StaticOrder, true, true>(F.lds, g, S, E);
                if (DUP_MASK & 512) { pg8::gemm_phase<EpiScaleBf16, pg8::StaticOrder, true, true>(F.lds, g, S, E); }
            }
        } SEAM(pb + 4);
        if (IN(pb + 5)) { MKFRAME();
            pg8::Gemm g{CC, (const bf16*)(F.ws + WS_WOUT) + (size_t)l * DM * DM, NTOK, DM, DM}; pg8::StaticOrder S; S.init(NTOK, DM, F.G, F.bx);
            EpiResid E{F.out, DM, ALPHA};
            pg8::gemm_phase<EpiResid, pg8::StaticOrder, true, true>(F.lds, g, S, E);
        } SEAM(pb + 5);
        if (IN(pb + 6)) { MKFRAME();
            for (int t = F.gw; t < NTOK; t += F.NGW) ln_row(F.out + (size_t)t * DM, KA.in[I_LN1G] + (size_t)l * DM, KA.in[I_LN1B] + (size_t)l * DM, F.out + (size_t)t * DM, XN + (size_t)t * DM, F.lane);
        } SEAM(pb + 6);
        if (IN(pb + 7)) { MKFRAME();
            pg8::Gemm g{XN, (const bf16*)(F.ws + WS_WS) + (size_t)l * DM * DM, NTOK, DM, DM}; pg8::StaticOrder S; S.init(NTOK, DM, F.G, F.bx);
            EpiStoreF32 E{(float*)(F.ws + WS_H), DM};
            pg8::gemm_phase<EpiStoreF32, pg8::StaticOrder, true, true>(F.lds, g, S, E);
            if (DUP_MASK & 128) { pg8::gemm_phase<EpiStoreF32, pg8::StaticOrder, true, true>(F.lds, g, S, E); }
        } SEAM(pb + 7);
        if (IN(pb + 8)) { MKFRAME(); __syncthreads(); topk_phase(F, KA); if (DUP_MASK & 32) { topk_phase(F, KA); } } SEAM(pb + 8);
        if (IN(pb + 9)) { MKFRAME(); if (DUP_MASK & 1024) { peer_gather_phase(F, KA, l, (float*)(F.ws + WS_H), CC); } peer_gather_phase(F, KA, l, F.out, XN); } SEAM(pb + 9);
    }
#undef IN
#undef SEAM
}


#ifndef DBG_STOP
#define DBG_STOP NPHASE
#endif
#ifndef DBG_DUMP
#define DBG_DUMP 0
#endif
__global__ void dbg_dump_kernel(float* out, const unsigned char* ws, int mode) {
    const size_t n = (size_t)NTOK * DM;
    for (size_t i = (size_t)blockIdx.x * blockDim.x + threadIdx.x; i < n; i += (size_t)gridDim.x * blockDim.x) {
        float v = 0.f;
        if (mode == 1) v = bf_lo(((const bf16*)(ws + WS_H))[i]);
        else if (mode == 2) v = bf_lo(((const bf16*)(ws + WS_CONCAT))[i]);
        else if (mode == 3) v = bf_lo(((const bf16*)(ws + WS_BUFY))[i % ((size_t)NTOK * 1024)]);
        else if (mode == 4) v = bf_lo(((const bf16*)(ws + WS_STF))[i]);
        else if (mode == 5) v = ((const float*)(ws + WS_H))[i];
        else if (mode == 6) v = (i < (size_t)NTOK * 128) ? (float)((const int*)(ws + WS_IDX))[i] : ((i < (size_t)NTOK * 256) ? ((const float*)(ws + WS_GATE))[i - (size_t)NTOK * 128] : 0.f);
        else if (mode == 7) v = bf_lo(((const bf16*)(ws + WS_XN))[i]);
        else if (mode == 8) v = bf_lo(((const bf16*)(ws + WS_STB))[i]);
        else if (mode == 9) v = bf_lo(((const bf16*)(ws + WS_H))[i + (size_t)NTOK * DM]);
        else if (mode == 10) v = bf_lo(((const bf16*)(ws + WS_WIN))[i % ((size_t)72 * 1024 * 1024)]);
        else if (mode == 11) v = ((const float*)(ws + WS_S5ST))[i % ((size_t)5 * 1024 * 1024)];
        else if (mode == 12) v = bf_lo(((const bf16*)(ws + WS_H))[i]) + bf_lo(((const bf16*)(ws + WS_H))[i + (size_t)NTOK * DM]) + bf_lo(((const bf16*)(ws + WS_BUFP))[i % ((size_t)NTOK * 512)]) + ((const float*)(ws + WS_S5ST))[i % ((size_t)5 * 1024 * 1024)];
        else if (mode == 13) v = bf_lo(((const bf16*)(ws + WS_STF))[i]) + bf_lo(((const bf16*)(ws + WS_STB))[i]) + ((const float*)(ws + WS_S5ST))[i % ((size_t)5 * 1024 * 1024)];
        else if (mode == 14) v = bf_lo(((const bf16*)(ws + WS_STF))[i]) + bf_lo(((const bf16*)(ws + WS_STB))[i]) + bf_lo(((const bf16*)(ws + WS_BUFY))[i % ((size_t)NTOK * 512)]);
        else if (mode == 15) v = bf_lo(((const bf16*)(ws + WS_H))[i]) + bf_lo(((const bf16*)(ws + WS_H))[i + (size_t)NTOK * DM]) + bf_lo(((const bf16*)(ws + WS_H))[i + (size_t)NTOK * 3072]);
        out[i] = v;
    }
}
#ifndef MK_ONE_LAUNCH
#define MK_ONE_LAUNCH 0
#endif
extern "C" void kernel_launch(void* const* d_in, const int* in_sizes, int n_in, void* d_out, int out_size, void* d_ws, size_t ws_size, hipStream_t stream) {
    static int grid = 0;
    if (grid == 0) {
        if (n_in != 26 || out_size != NTOK * DM || ws_size < WS_END) { fprintf(stderr, "kernel_launch: unexpected shapes (n_in %d out %d ws %zu)\n", n_in, out_size, ws_size); grid = -1; return; }
        int dev = 0, cus = 0, per_cu = 0;
        if (hipGetDevice(&dev) != hipSuccess || hipDeviceGetAttribute(&cus, hipDeviceAttributeMultiprocessorCount, dev) != hipSuccess) { grid = -1; return; }
        if (hipFuncSetAttribute((const void*)fwd_kernel, hipFuncAttributeMaxDynamicSharedMemorySize, LDS_BYTES) != hipSuccess) { fprintf(stderr, "kernel_launch: hipFuncSetAttribute failed\n"); grid = -1; return; }
        if (hipOccupancyMaxActiveBlocksPerMultiprocessor(&per_cu, (const void*)fwd_kernel, NTHR, LDS_BYTES) != hipSuccess || per_cu < 1) { fprintf(stderr, "kernel_launch: occupancy query says %d\n", per_cu); grid = -1; (void)hipGetLastError(); return; }
        (void)hipGetLastError();
        grid = cus;
    }
    if (grid < 0) return;
    if (hipMemsetAsync((char*)d_ws + WS_CTL, 0, CTL_ZERO_BYTES, stream) != hipSuccess) return;
    Args a{};
    for (int i = 0; i < 26; ++i) a.in[i] = (const float*)d_in[i];
    a.out = (float*)d_out; a.ws = (unsigned char*)d_ws; a.pad = 0;
#if MK_ONE_LAUNCH
    a.ph_lo = 0; a.ph_hi = NPHASE; a.li = 0;
    hipLaunchKernelGGL(fwd_kernel, dim3(grid), dim3(NTHR), LDS_BYTES, stream, a);
#else
    for (int p = 0; p < DBG_STOP; ++p) { a.ph_lo = p; a.ph_hi = p + 1; a.li = p; hipLaunchKernelGGL(fwd_kernel, dim3(grid), dim3(NTHR), LDS_BYTES, stream, a); }
#endif
    if (DBG_DUMP) hipLaunchKernelGGL(dbg_dump_kernel, dim3(2048), dim3(256), 0, stream, (float*)d_out, (const unsigned char*)d_ws, DBG_DUMP);
}
#endif
```

```cpp
#include <hip/hip_runtime.h>
#include <cstdio>
#include <cstdint>
#include <cmath>
__device__ __forceinline__ int opaque(int v) { asm volatile("" : "+v"(v)); return v; }
__device__ __forceinline__ int opaque_s(int v) { asm volatile("" : "+s"(v)); return v; }
__device__ __forceinline__ void* opaque_p(void* p) { asm volatile("" : "+s"(p)); return p; }
__device__ __forceinline__ unsigned long long opaque_u64(unsigned long long v) { asm volatile("" : "+s"(v)); return v; }
#ifndef PEER_FP4
#define PEER_FP4 1
#endif
#ifndef GATHER_ROWS
#define GATHER_ROWS 32
#endif
#ifndef GATHER_PROBE
#define GATHER_PROBE 0
#endif
#ifndef GATHER_PROBE2
#define GATHER_PROBE2 0
#endif
#define MK_ONE_LAUNCH 1
namespace pg8 {
#define PG8_LAS __attribute__((address_space(3)))
typedef unsigned short bf16_t;
typedef short bf16x8 __attribute__((ext_vector_type(8)));
typedef float f32x4 __attribute__((ext_vector_type(4)));
typedef unsigned u32x4 __attribute__((ext_vector_type(4)));
constexpr int BM = 256, BK = 64, HALF = 128, HTB = HALF * BK * 2  , STAGE_BYTES = 8 * HTB, NXCD = 8, WGM = 8;

__host__ __device__ __forceinline__ int lds_byte(int r, int c) { const int st = (r >> 4) * 2 + (c >> 5), rr = r & 15, cc = c & 31, ob = rr * 64 + cc * 2; return st * 1024 + (ob ^ (((ob >> 9) & 1) << 5)); }
__host__ __device__ __forceinline__ void stage_rc(int b, int& R, int& C) { const int st = b / 1024, sb = b % 1024, swz = sb ^ (((sb >> 9) & 1) << 5); R = (st >> 1) * 16 + swz / 64; C = (st & 1) * 32 + (swz % 64) / 2; }
__host__ __device__ __forceinline__ int perm32(int rho) { const int n = rho >> 4, i = rho & 15; return 8 * (i >> 2) + 4 * n + (i & 3); }

struct Unit { int pm, pn; };
struct Gemm { const bf16_t* A; const bf16_t* Bt; int M, N, K; };

struct StaticOrder {
    int nM, nN, nwg, G, c;
    __host__ __device__ void init(int M, int N, int G_, int c_) { nM = M / BM; nN = N / BM; nwg = nM * nN; G = G_; c = c_; }
    __host__ __device__ bool next(int i, Unit& u) const {
        const long L = (long)i * G + c; if (L >= nwg) return false;
        int wgid = (int)L; { const int q = nwg / NXCD, r = nwg % NXCD, xcd = wgid % NXCD, off = wgid / NXCD; wgid = (xcd < r ? xcd * (q + 1) : r * (q + 1) + (xcd - r) * q) + off; }
        const int nig = WGM * nN, gid = wgid / nig, fm = gid * WGM, gsz = (nM - fm) < WGM ? (nM - fm) : WGM;
        u.pm = fm + ((wgid % nig) % gsz); u.pn = (wgid % nig) / gsz; return true;
    }
    __device__ __forceinline__ void a_ready(const Unit&) const {}
    __device__ __forceinline__ void done(const Unit&) const {}
};
__device__ __forceinline__ unsigned cvt_pk_bf16(float lo, float hi) { unsigned r; asm volatile("v_cvt_pk_bf16_f32 %0, %1, %2" : "=v"(r) : "v"(lo), "v"(hi)); return r; }
typedef float f32x2 __attribute__((ext_vector_type(2)));
template <class Epi, class Sched, bool ALIGN_EPI = false, bool SP2 = false>
__device__ __forceinline__ void gemm_phase(PG8_LAS unsigned char* lds, const Gemm g, const Sched& S, const Epi& E) {
    const int tid = opaque((int)threadIdx.x), wid = __builtin_amdgcn_readfirstlane(tid >> 6), lane = tid & 63, wr = wid >> 2, wc = wid & 3, fr = lane & 15, fq = lane >> 4;
    const int K = g.K, nt = K / BK;
    unsigned voffA[2], voffB[2];
#pragma unroll
    for (int i = 0; i < 2; ++i) { int R, C; stage_rc(tid * 16 + i * 8192, R, C); const int Rb = Epi::PERM ? ((R & ~31) + perm32(R & 31)) : R;
        voffA[i] = (unsigned)(R * K + C) * 2u; voffB[i] = (unsigned)(Rb * K + C) * 2u; }
    const size_t kstep = (size_t)(BK * 2);
    const size_t hstep = (size_t)HALF * K * 2;
    const size_t tstep = 2 * hstep;
    const unsigned ldsw = (unsigned)wid * 1024u;
    const int aoff = lds_byte(wr * 64 + fr, fq * 8), boff = lds_byte(wc * 32 + fr, fq * 8);
#define PG8_SA(b, h) (((b) * 2 + (h)) * HTB)
#define PG8_SB(b, h) ((4 + (b) * 2 + (h)) * HTB)
#define PG8_STAGE(bufoff, gbase, voff) do { _Pragma("unroll") for (int _i = 0; _i < 2; ++_i) \
        __builtin_amdgcn_global_load_lds((const unsigned*)((const char*)(gbase) + (voff)[_i]), (PG8_LAS unsigned*)(lds + (bufoff) + ldsw + _i * 8192), 16, 0, 0); } while (0)
#define PG8_LDA(dst, b, h) do { _Pragma("unroll") for (int m = 0; m < 4; ++m) _Pragma("unroll") for (int k = 0; k < 2; ++k) dst[m][k] = *(const PG8_LAS bf16x8*)(lds + PG8_SA(b, h) + aoff + m * 2048 + k * 1024); } while (0)
#define PG8_LDB(dst, b, h) do { _Pragma("unroll") for (int n = 0; n < 2; ++n) _Pragma("unroll") for (int k = 0; k < 2; ++k) dst[n][k] = *(const PG8_LAS bf16x8*)(lds + PG8_SB(b, h) + boff + n * 2048 + k * 1024); } while (0)
#define PG8_MMA(ai, bj, At, Bt) do { __builtin_amdgcn_s_setprio(1); _Pragma("unroll") for (int m = 0; m < 4; ++m) _Pragma("unroll") for (int n = 0; n < 2; ++n) _Pragma("unroll") for (int k = 0; k < 2; ++k) \
        acc[ai][bj][m][n] = __builtin_amdgcn_mfma_f32_16x16x32_bf16(Bt[n][k], At[m][k], acc[ai][bj][m][n], 0, 0, 0); __builtin_amdgcn_s_setprio(0); } while (0)
#define PG8_WAIT_V(n) asm volatile("s_waitcnt vmcnt(" #n ")" ::: "memory")
#define PG8_WAIT_L(n) asm volatile("s_waitcnt lgkmcnt(" #n ")" ::: "memory")
#define PG8_BAR __builtin_amdgcn_s_barrier()
#define PG8_SCHED __builtin_amdgcn_sched_barrier(0)
    Unit cur, nxt; int ui = 0;
    if (!S.next(0, cur)) return;
    f32x4 acc[2][2][4][2];
#pragma unroll
    for (int a = 0; a < 2; ++a)
#pragma unroll
        for (int b = 0; b < 2; ++b)
#pragma unroll
            for (int m = 0; m < 4; ++m)
#pragma unroll
                for (int n = 0; n < 2; ++n) acc[a][b][m][n] = (f32x4){0.f, 0.f, 0.f, 0.f};
    bf16x8 At[4][2], B0[2][2], B1[2][2];
    const char* cA = (const char*)g.A + (size_t)cur.pm * tstep; const char* cB = (const char*)g.Bt + (size_t)cur.pn * tstep;
    S.a_ready(cur);
    if constexpr (SP2) {
        PG8_STAGE(PG8_SB(0, 0), cB, voffB); PG8_STAGE(PG8_SB(0, 1), cB + hstep, voffB); PG8_STAGE(PG8_SA(0, 0), cA, voffA); PG8_STAGE(PG8_SA(0, 1), cA + hstep, voffA);
        if (wr == 1) PG8_BAR;
        PG8_WAIT_V(2); PG8_BAR;
        PG8_STAGE(PG8_SB(1, 0), cB + kstep, voffB); PG8_STAGE(PG8_SA(1, 0), cA + kstep, voffA); PG8_STAGE(PG8_SB(1, 1), cB + hstep + kstep, voffB);
        PG8_WAIT_V(6); PG8_BAR;
    } else {
        PG8_STAGE(PG8_SB(0, 0), cB, voffB); PG8_STAGE(PG8_SA(0, 0), cA, voffA); PG8_STAGE(PG8_SB(0, 1), cB + hstep, voffB); PG8_STAGE(PG8_SA(0, 1), cA + hstep, voffA);
        if (wr == 1) PG8_BAR;
        PG8_WAIT_V(4); PG8_BAR;
        PG8_STAGE(PG8_SB(1, 0), cB + kstep, voffB); PG8_STAGE(PG8_SA(1, 0), cA + kstep, voffA); PG8_STAGE(PG8_SB(1, 1), cB + hstep + kstep, voffB);
        PG8_WAIT_V(6); PG8_BAR;
    }
    for (;;) {
        const bool has_next = S.next(ui + 1, nxt);
        const char* nA = has_next ? (const char*)g.A + (size_t)nxt.pm * tstep : cA; const char* nB = has_next ? (const char*)g.Bt + (size_t)nxt.pn * tstep : cB;
        for (int t = 0; t < nt; t += 2) {
            const bool last = (t == nt - 2);
            const char* a1 = cA + (size_t)(t + 1) * kstep;
            const char* a2 = last ? nA : cA + (size_t)(t + 2) * kstep; const char* b2 = last ? nB : cB + (size_t)(t + 2) * kstep;
            const char* a3 = a2 + kstep; const char* b3 = b2 + kstep;
            if (last && has_next) S.a_ready(nxt);
            if constexpr (SP2) {
            PG8_LDB(B0, 0, 0); PG8_LDB(B1, 0, 1); PG8_SCHED; PG8_LDA(At, 0, 0); PG8_STAGE(PG8_SA(1, 1), a1 + hstep, voffA);
            PG8_WAIT_V(8); PG8_WAIT_L(0); PG8_BAR; PG8_MMA(0, 0, At, B0); PG8_MMA(0, 1, At, B1); PG8_BAR; PG8_SCHED;
            PG8_LDA(At, 0, 1); PG8_STAGE(PG8_SB(0, 0), b2, voffB); PG8_STAGE(PG8_SB(0, 1), b2 + hstep, voffB); PG8_STAGE(PG8_SA(0, 0), a2, voffA);
            PG8_WAIT_V(8); PG8_WAIT_L(0); PG8_BAR; PG8_MMA(1, 0, At, B0); PG8_MMA(1, 1, At, B1); PG8_BAR; PG8_SCHED;
            PG8_LDB(B0, 1, 0); PG8_LDB(B1, 1, 1); PG8_SCHED; PG8_LDA(At, 1, 0); PG8_STAGE(PG8_SA(0, 1), a2 + hstep, voffA);
            PG8_WAIT_V(8); PG8_WAIT_L(0); PG8_BAR; PG8_MMA(0, 0, At, B0); PG8_MMA(0, 1, At, B1); PG8_BAR; PG8_SCHED;
            PG8_LDA(At, 1, 1); PG8_STAGE(PG8_SB(1, 0), b3, voffB); PG8_STAGE(PG8_SB(1, 1), b3 + hstep, voffB); PG8_STAGE(PG8_SA(1, 0), a3, voffA);
            PG8_WAIT_V(8); PG8_WAIT_L(0); PG8_BAR; PG8_MMA(1, 0, At, B0); PG8_MMA(1, 1, At, B1); PG8_BAR; PG8_SCHED;
            } else {
            PG8_LDB(B0, 0, 0); PG8_SCHED; PG8_LDA(At, 0, 0); PG8_STAGE(PG8_SA(1, 1), a1 + hstep, voffA);
            PG8_WAIT_L(8); PG8_BAR; PG8_WAIT_L(0); PG8_MMA(0, 0, At, B0); PG8_BAR; PG8_SCHED;
            PG8_LDB(B1, 0, 1); PG8_STAGE(PG8_SB(0, 0), b2, voffB);
            PG8_BAR; PG8_WAIT_L(0); PG8_MMA(0, 1, At, B1); PG8_BAR;
            PG8_LDA(At, 0, 1); PG8_STAGE(PG8_SA(0, 0), a2, voffA);
            PG8_BAR; PG8_WAIT_L(0); PG8_MMA(1, 0, At, B0); PG8_BAR; PG8_SCHED;
            PG8_STAGE(PG8_SB(0, 1), b2 + hstep, voffB);
            PG8_WAIT_V(6); PG8_BAR; PG8_MMA(1, 1, At, B1); PG8_BAR;
            PG8_LDB(B0, 1, 0); PG8_SCHED; PG8_LDA(At, 1, 0); PG8_STAGE(PG8_SA(0, 1), a2 + hstep, voffA);
            PG8_WAIT_L(8); PG8_BAR; PG8_WAIT_L(0); PG8_MMA(0, 0, At, B0); PG8_BAR; PG8_SCHED;
            PG8_LDB(B1, 1, 1); PG8_STAGE(PG8_SB(1, 0), b3, voffB);
            PG8_BAR; PG8_WAIT_L(0); PG8_MMA(0, 1, At, B1); PG8_BAR;
            PG8_LDA(At, 1, 1); PG8_STAGE(PG8_SA(1, 0), a3, voffA);
            PG8_BAR; PG8_WAIT_L(0); PG8_MMA(1, 0, At, B0); PG8_BAR; PG8_SCHED;
            PG8_STAGE(PG8_SB(1, 1), b3 + hstep, voffB);
            PG8_WAIT_V(6); PG8_BAR; PG8_MMA(1, 1, At, B1); PG8_BAR;
            }
        }
        if constexpr (ALIGN_EPI) { if (wr == 0) PG8_BAR; }
        if constexpr (!Epi::AFTER_DRAIN) { E(acc, cur, wr, wc, fr, fq); S.done(cur); }
        if (!has_next) break;
#pragma unroll
        for (int a = 0; a < 2; ++a)
#pragma unroll
            for (int b = 0; b < 2; ++b)
#pragma unroll
                for (int m = 0; m < 4; ++m)
#pragma unroll
                    for (int n = 0; n < 2; ++n) acc[a][b][m][n] = (f32x4){0.f, 0.f, 0.f, 0.f};
        cur = nxt; cA = nA; cB = nB; ++ui;
        if constexpr (ALIGN_EPI) { if (wr == 1) PG8_BAR; }
    }
    PG8_WAIT_V(0);
    if constexpr (!ALIGN_EPI) { if (wr == 0) PG8_BAR; }
    PG8_BAR;
    if constexpr (Epi::AFTER_DRAIN) { E.fused(acc, cur, wr, wc, fr, fq, lds, wid, lane); S.done(cur); }
#undef PG8_SA
#undef PG8_SB
#undef PG8_STAGE
#undef PG8_LDA
#undef PG8_LDB
#undef PG8_MMA
#undef PG8_WAIT_V
#undef PG8_WAIT_L
#undef PG8_BAR
#undef PG8_SCHED
}
}
#define LAS __attribute__((address_space(3)))
#define XB_TMO      128
#define XB_XCNT(j)  (256  + 64 * (j))
#define XB_XSUB(j)  (1280 + 64 * (j))
#define XB_XGEN(j)  (2304 + 64 * (j))
#define XB_TOP      3328
#define XB_TOPGEN   3392
#define XCD_BAR_WORDS 3456
#define XB_SPIN_CAP (1u << 18)

__device__ __forceinline__ unsigned xb_ld(unsigned* p)              { return __hip_atomic_load(p, __ATOMIC_RELAXED, __HIP_MEMORY_SCOPE_AGENT); }
__device__ __forceinline__ unsigned xb_add(unsigned* p, unsigned v) { return __hip_atomic_fetch_add(p, v, __ATOMIC_RELAXED, __HIP_MEMORY_SCOPE_AGENT); }
__device__ __forceinline__ unsigned xb_xcc_id() { return (unsigned)__builtin_amdgcn_s_getreg((3 << 11) | 20) & 0xFu; }
#define XB_SPIN(cond, bar) do { unsigned _sp = 0; while (cond) { __builtin_amdgcn_s_sleep(1); \
    if ((++_sp & 255u) == 0u) { if (xb_ld(&(bar)[XB_TMO])) break; if (_sp > XB_SPIN_CAP) { atomicAdd(&(bar)[XB_TMO], 1u); break; } } } } while (0)

struct XcdBarrier {
    unsigned* bar; unsigned x;
    volatile LAS unsigned* st;
};

__device__ __forceinline__ XcdBarrier xcd_barrier_post(unsigned* bar, volatile LAS unsigned* st) {
    XcdBarrier b; b.bar = bar; b.x = xb_xcc_id(); b.st = st;
    if (threadIdx.x == 0) (void)xb_add(&bar[XB_XCNT(b.x)], 1u);
    return b;
}
__device__ __forceinline__ void xcd_barrier_complete(unsigned* bar, unsigned x, unsigned& nloc, unsigned& nx) {
    const unsigned G = gridDim.x * gridDim.y * gridDim.z;
    unsigned sum, cnt, mine, sp = 0u;
    for (;;) {
        sum = 0u; cnt = 0u; mine = 0u;
#pragma unroll
        for (unsigned j = 0; j < 16; ++j) { const unsigned c = xb_ld(&bar[XB_XCNT(j)]); sum += c; cnt += (c > 0u) ? 1u : 0u; mine = (j == x) ? c : mine; }
        if (sum == G) break;
        __builtin_amdgcn_s_sleep(1);
        if ((++sp & 255u) == 0u) { if (xb_ld(&bar[XB_TMO])) break; if (sp > XB_SPIN_CAP) { atomicAdd(&bar[XB_TMO], 1u); break; } }
    }
    nloc = mine > 0u ? mine : 1u; nx = cnt > 0u ? cnt : 1u;
}

__device__ __forceinline__ void xcd_barrier(const XcdBarrier& b) {
    asm volatile("s_waitcnt vmcnt(0)" ::: "memory");
    __syncthreads();
    if (threadIdx.x == 0) {
        unsigned* bar = b.bar;
        __builtin_amdgcn_s_waitcnt(0);
        unsigned nloc = b.st[0], nx = b.st[1];
        if (nloc == 0u) { xcd_barrier_complete(bar, b.x, nloc, nx); b.st[0] = nloc; b.st[1] = nx; }
        const unsigned old = xb_add(&bar[XB_XSUB(b.x)], 1u);
        const unsigned gen = old / nloc;
        if (old + 1u == (gen + 1u) * nloc) {
            __builtin_amdgcn_fence(__ATOMIC_RELEASE, "agent");
            asm volatile("s_waitcnt vmcnt(0)" ::: "memory");
            const unsigned og = xb_add(&bar[XB_TOP], 1u);
            const unsigned tg = og / nx;
            if (og + 1u == (tg + 1u) * nx) xb_add(&bar[XB_TOPGEN], 1u);
            else XB_SPIN(xb_ld(&bar[XB_TOPGEN]) == tg, bar);
            __builtin_amdgcn_fence(__ATOMIC_ACQUIRE, "agent");
            xb_add(&bar[XB_XGEN(b.x)], 1u);
            asm volatile("s_waitcnt vmcnt(0)" ::: "memory");
        } else {
            XB_SPIN(xb_ld(&bar[XB_XGEN(b.x)]) == gen, bar);
            __builtin_amdgcn_fence(__ATOMIC_ACQUIRE, "agent");
            asm volatile("s_waitcnt vmcnt(0)" ::: "memory");
        }
    }
    __syncthreads();
}
#undef LAS
using pg8::bf16x8; using pg8::f32x4; using pg8::u32x4; using pg8::f32x2;
#define GAS __attribute__((address_space(1)))
#define LAS __attribute__((address_space(3)))
typedef unsigned short bf16;
typedef unsigned v4u __attribute__((ext_vector_type(4)));
typedef unsigned v2u __attribute__((ext_vector_type(2)));
typedef float f32x2v __attribute__((ext_vector_type(2)));

constexpr int NTOK = 40960, DM = 2048, NLAYER = 4, INW = 5120;
constexpr int COL_UA = 0, COL_UB = 512, COL_Q = 1024, COL_K = 2048, COL_V = 3072, COL_G = 4096;
constexpr float ALPHA = 1.6817928305074290f;
constexpr float LN_EPS = 1e-5f, GN_EPS = 1e-6f;
constexpr int NEXP = 16384;
constexpr int NWAVES = 8, NTHR = 512;

constexpr size_t MiB = 1u << 20;
constexpr size_t WS_CTL = 0, CTL_ZERO_BYTES = 1 * MiB;
constexpr size_t WS_WIN = 1 * MiB;
constexpr size_t WS_WOUT = 81 * MiB;
constexpr size_t WS_WS = 113 * MiB;
constexpr size_t WS_WGLU = 145 * MiB;
constexpr size_t WS_WPOOL = 147 * MiB;
constexpr size_t WS_S5A = 149 * MiB;
constexpr size_t WS_S5B = 150 * MiB;
constexpr size_t WS_ROT = 152 * MiB;
constexpr size_t WS_S5BB = 153 * MiB;
constexpr size_t WS_U16 = 160 * MiB;
constexpr size_t WS_V16 = 416 * MiB;
constexpr size_t WS_U8 = 160 * MiB;
constexpr size_t WS_V8 = 288 * MiB;
constexpr size_t WS_USC = 416 * MiB;
constexpr size_t WS_VSC = 417 * MiB;
constexpr size_t WS_XN = 672 * MiB;
constexpr size_t WS_H = 832 * MiB;
constexpr size_t WS_CONCAT = 1232 * MiB;
constexpr size_t WS_BUFY = 1392 * MiB;
constexpr size_t WS_BUFP = 1432 * MiB;
constexpr size_t WS_STF = 1472 * MiB;
constexpr size_t WS_STB = 1632 * MiB;
constexpr size_t WS_IDX = 1792 * MiB;
constexpr size_t WS_GATE = 1812 * MiB;
constexpr size_t WS_S5ST = 1832 * MiB;
constexpr size_t WS_END = 1852 * MiB;
constexpr int CW_BAR = 4096;
constexpr int NPHASE = 1 + NLAYER * 10;

constexpr int LDS_SCRATCH = 147456;
constexpr int LDS_MISC = LDS_SCRATCH;
constexpr int LDS_BYTES = LDS_SCRATCH + 256;

__device__ __forceinline__ float bf_lo(unsigned w) { return __uint_as_float(w << 16); }
__device__ __forceinline__ float bf_hi(unsigned w) { return __uint_as_float(w & 0xffff0000u); }
typedef __bf16 bf16x2_t __attribute__((ext_vector_type(2)));
__device__ __forceinline__ unsigned pkbf(float lo, float hi) { const bf16x2_t v = {(__bf16)lo, (__bf16)hi}; return __builtin_bit_cast(unsigned, v); }
__device__ __forceinline__ bf16 f2bf(float f) { return __builtin_bit_cast(unsigned short, (__bf16)f); }
__device__ __forceinline__ float wave_sum(float v) {
#pragma unroll
    for (int o = 1; o < 64; o <<= 1) v += __shfl_xor(v, o);
    return v;
}
__device__ __forceinline__ float gelu_erf(float v) { return 0.5f * v * (1.0f + erff(v * 0.70710678118654752f)); }
__device__ __forceinline__ int tok_pos(int t) { return t < 32768 ? (t & 4095) : (t - 32768); }
__device__ __forceinline__ int tok_len(int t) { return t < 32768 ? 4096 : 8192; }
__device__ __forceinline__ void unpack8(const v4u q, float (&f)[8]) {
    f[0] = bf_lo(q.x); f[1] = bf_hi(q.x); f[2] = bf_lo(q.y); f[3] = bf_hi(q.y); f[4] = bf_lo(q.z); f[5] = bf_hi(q.z); f[6] = bf_lo(q.w); f[7] = bf_hi(q.w);
}
__device__ __forceinline__ v4u pack8(const float (&f)[8]) { v4u q; q.x = pkbf(f[0], f[1]); q.y = pkbf(f[2], f[3]); q.z = pkbf(f[4], f[5]); q.w = pkbf(f[6], f[7]); return q; }
#define LDS_WAIT() asm volatile("s_waitcnt lgkmcnt(0)" ::: "memory")
#define MFMA16(a, b, c) __builtin_amdgcn_mfma_f32_16x16x32_bf16((a), (b), (c), 0, 0, 0)

struct EpiStoreBf16 {
    static constexpr bool PERM = true, AFTER_DRAIN = false;
    bf16* O; int ldo;
    __device__ __forceinline__ void operator()(const f32x4 (&acc)[2][2][4][2], const pg8::Unit& u, int wr, int wc, int fr, int fq) const {
        const int row0 = u.pm * 256 + wr * 64 + fr, col0 = u.pn * 256 + wc * 32 + 8 * fq;
#pragma unroll
        for (int ai = 0; ai < 2; ++ai)
#pragma unroll
            for (int m = 0; m < 4; ++m) { bf16* rowp = O + (size_t)(row0 + ai * 128 + m * 16) * ldo + col0;
#pragma unroll
                for (int bj = 0; bj < 2; ++bj) { const f32x4 v0 = acc[ai][bj][m][0], v1 = acc[ai][bj][m][1];
                    v4u w; w.x = pkbf(v0[0], v0[1]); w.y = pkbf(v0[2], v0[3]); w.z = pkbf(v1[0], v1[1]); w.w = pkbf(v1[2], v1[3]);
                    *(v4u*)(rowp + bj * 128) = w; } }
    }
};
struct EpiGlu {
    static constexpr bool PERM = true, AFTER_DRAIN = false;
    const bf16* Y; int ldy; bf16* O; int ldo; const float* bias;
    __device__ __forceinline__ void operator()(const f32x4 (&acc)[2][2][4][2], const pg8::Unit& u, int wr, int wc, int fr, int fq) const {
        const int row0 = u.pm * 256 + wr * 64 + fr, col0 = u.pn * 256 + wc * 32 + 8 * fq;
#pragma unroll
        for (int bj = 0; bj < 2; ++bj) {
            const f32x4 b0 = *(const f32x4*)(bias + col0 + bj * 128), b1 = *(const f32x4*)(bias + col0 + bj * 128 + 4);
#pragma unroll
            for (int ai = 0; ai < 2; ++ai)
#pragma unroll
                for (int m = 0; m < 4; ++m) { const size_t r = (size_t)(row0 + ai * 128 + m * 16);
                    const v4u yq = *(const v4u*)(Y + r * ldy + col0 + bj * 128); float y[8]; unpack8(yq, y);
                    const f32x4 v0 = acc[ai][bj][m][0] + b0, v1 = acc[ai][bj][m][1] + b1; float o[8];
#pragma unroll
                    for (int k = 0; k < 4; ++k) { o[k] = y[k] / (1.0f + __expf(-v0[k])); o[4 + k] = y[4 + k] / (1.0f + __expf(-v1[k])); }
                    *(v4u*)(O + r * ldo + col0 + bj * 128) = pack8(o); }
        }
    }
};
struct EpiScaleBf16 {
    static constexpr bool PERM = true, AFTER_DRAIN = false;
    bf16* O; int ldo; const float* scale;
    __device__ __forceinline__ void operator()(const f32x4 (&acc)[2][2][4][2], const pg8::Unit& u, int wr, int wc, int fr, int fq) const {
        const int row0 = u.pm * 256 + wr * 64 + fr, col0 = u.pn * 256 + wc * 32 + 8 * fq;
#pragma unroll
        for (int bj = 0; bj < 2; ++bj) {
            const f32x4 s0 = *(const f32x4*)(scale + col0 + bj * 128), s1 = *(const f32x4*)(scale + col0 + bj * 128 + 4);
#pragma unroll
            for (int ai = 0; ai < 2; ++ai)
#pragma unroll
                for (int m = 0; m < 4; ++m) { const size_t r = (size_t)(row0 + ai * 128 + m * 16);
                    const f32x4 v0 = acc[ai][bj][m][0] * s0, v1 = acc[ai][bj][m][1] * s1;
                    v4u w; w.x = pkbf(v0[0], v0[1]); w.y = pkbf(v0[2], v0[3]); w.z = pkbf(v1[0], v1[1]); w.w = pkbf(v1[2], v1[3]);
                    *(v4u*)(O + r * ldo + col0 + bj * 128) = w; }
        }
    }
};
struct EpiResid {
    static constexpr bool PERM = false, AFTER_DRAIN = false;
    float* X; int ldx; float alpha;
    __device__ __forceinline__ void operator()(const f32x4 (&acc)[2][2][4][2], const pg8::Unit& u, int wr, int wc, int fr, int fq) const {
        const int row0 = u.pm * 256 + wr * 64 + fr, col0 = u.pn * 256 + wc * 32 + 4 * fq;
#pragma unroll
        for (int ai = 0; ai < 2; ++ai)
#pragma unroll
            for (int m = 0; m < 4; ++m) { float* rowp = X + (size_t)(row0 + ai * 128 + m * 16) * ldx + col0;
#pragma unroll
                for (int bj = 0; bj < 2; ++bj)
#pragma unroll
                    for (int n = 0; n < 2; ++n) { f32x4* p = (f32x4*)(rowp + bj * 128 + n * 16); const f32x4 x = *p; *p = x * alpha + acc[ai][bj][m][n]; } }
    }
};
struct EpiStoreF32 {
    static constexpr bool PERM = false, AFTER_DRAIN = false;
    float* C; int ldc;
    __device__ __forceinline__ void operator()(const f32x4 (&acc)[2][2][4][2], const pg8::Unit& u, int wr, int wc, int fr, int fq) const {
        const int row0 = u.pm * 256 + wr * 64 + fr, col0 = u.pn * 256 + wc * 32 + 4 * fq;
#pragma unroll
        for (int ai = 0; ai < 2; ++ai)
#pragma unroll
            for (int m = 0; m < 4; ++m) { float* rowp = C + (size_t)(row0 + ai * 128 + m * 16) * ldc + col0;
#pragma unroll
                for (int bj = 0; bj < 2; ++bj)
#pragma unroll
                    for (int n = 0; n < 2; ++n) *(f32x4*)(rowp + bj * 128 + n * 16) = acc[ai][bj][m][n]; }
    }
};

struct Args { const float* in[26]; float* out; unsigned char* ws; int ph_lo, ph_hi, li, pad; };
typedef const Args __attribute__((address_space(4))) CArgs;
struct Frame {
    LAS unsigned char* lds;
    int tid, lane, wave, G, bx;
    int gw, NGW;
    size_t gtid, NT;
    float* out; unsigned char* ws;
};
enum InIdx { I_XP = 0, I_XS, I_LNIN_G, I_LNIN_B, I_WIN, I_LAMRE, I_LAMIM, I_LOGSTEP, I_BRE, I_BIM, I_CRE, I_CIM, I_S5D, I_WGLU, I_BGLU, I_POOLW, I_POOLS,
             I_WOUT, I_LN1G, I_LN1B, I_WQ, I_KEYS, I_PU, I_PV, I_LN2G, I_LN2B };

__device__ __forceinline__ void ln_row(const float* src, const float* g, const float* b, float* dst, bf16* dstb, int lane) {
    f32x4 v[8]; float s = 0.f;
#pragma unroll
    for (int j = 0; j < 8; ++j) { v[j] = ((const f32x4*)src)[lane + 64 * j]; s += (v[j][0] + v[j][1]) + (v[j][2] + v[j][3]); }
    const float mean = wave_sum(s) * (1.0f / DM); float s2 = 0.f;
#pragma unroll
    for (int j = 0; j < 8; ++j) { v[j] = v[j] - mean; s2 += (v[j][0] * v[j][0] + v[j][1] * v[j][1]) + (v[j][2] * v[j][2] + v[j][3] * v[j][3]); }
    const float rstd = 1.0f / sqrtf(wave_sum(s2) * (1.0f / DM) + LN_EPS);
#pragma unroll
    for (int j = 0; j < 8; ++j) { const f32x4 gg = ((const f32x4*)g)[lane + 64 * j], bb = ((const f32x4*)b)[lane + 64 * j];
        const f32x4 o = v[j] * rstd * gg + bb; ((f32x4*)dst)[lane + 64 * j] = o;
        v2u w; w.x = pkbf(o[0], o[1]); w.y = pkbf(o[2], o[3]); ((v2u*)dstb)[lane + 64 * j] = w; }
}

__device__ __forceinline__ void ln_rows2(float* X, const float* g, const float* b, bf16* XB, int gw, int ngw, int lane) {
    for (int t = gw; t < NTOK; t += 2 * ngw) {
        const int t2 = t + ngw; const bool has2 = t2 < NTOK;
        float* r0 = X + (size_t)t * DM; float* r1 = X + (size_t)(has2 ? t2 : t) * DM;
        f32x4 v0[8], v1[8]; float s0 = 0.f, s1 = 0.f;
#pragma unroll
        for (int j = 0; j < 8; ++j) v0[j] = ((const f32x4*)r0)[lane + 64 * j];
#pragma unroll
        for (int j = 0; j < 8; ++j) v1[j] = ((const f32x4*)r1)[lane + 64 * j];
#pragma unroll
        for (int j = 0; j < 8; ++j) { s0 += (v0[j][0] + v0[j][1]) + (v0[j][2] + v0[j][3]); s1 += (v1[j][0] + v1[j][1]) + (v1[j][2] + v1[j][3]); }
        const float m0 = wave_sum(s0) * (1.0f / DM), m1 = wave_sum(s1) * (1.0f / DM); float q0 = 0.f, q1 = 0.f;
#pragma unroll
        for (int j = 0; j < 8; ++j) { v0[j] = v0[j] - m0; v1[j] = v1[j] - m1;
            q0 += (v0[j][0] * v0[j][0] + v0[j][1] * v0[j][1]) + (v0[j][2] * v0[j][2] + v0[j][3] * v0[j][3]); q1 += (v1[j][0] * v1[j][0] + v1[j][1] * v1[j][1]) + (v1[j][2] * v1[j][2] + v1[j][3] * v1[j][3]); }
        const float rs0 = 1.0f / sqrtf(wave_sum(q0) * (1.0f / DM) + LN_EPS), rs1 = 1.0f / sqrtf(wave_sum(q1) * (1.0f / DM) + LN_EPS);
#pragma unroll
        for (int j = 0; j < 8; ++j) { const f32x4 gg = ((const f32x4*)g)[lane + 64 * j], bb = ((const f32x4*)b)[lane + 64 * j];
            const f32x4 o0 = v0[j] * rs0 * gg + bb; ((f32x4*)r0)[lane + 64 * j] = o0;
            v2u w0; w0.x = pkbf(o0[0], o0[1]); w0.y = pkbf(o0[2], o0[3]); ((v2u*)(XB + (size_t)t * DM))[lane + 64 * j] = w0;
            if (has2) { const f32x4 o1 = v1[j] * rs1 * gg + bb; ((f32x4*)r1)[lane + 64 * j] = o1;
                v2u w1; w1.x = pkbf(o1[0], o1[1]); w1.y = pkbf(o1[2], o1[3]); ((v2u*)(XB + (size_t)t2 * DM))[lane + 64 * j] = w1; } }
    }
}

__device__ __forceinline__ void transpose_item(const float* W, int K, int N, bf16* WT, LAS float* scr, int item, int lane) {
    const int nblk = N / 32, kb = item / nblk, nb = item % nblk, k0 = 64 * kb, n0 = 32 * nb;
#pragma unroll 8
    for (int i = 0; i < 32; ++i) { const int kk = 2 * i + (lane >> 5); scr[kk * 33 + (lane & 31)] = W[(size_t)(k0 + kk) * N + n0 + (lane & 31)]; }
    LDS_WAIT();
    const int c = lane & 7;
#pragma unroll
    for (int j = 0; j < 4; ++j) { const int n = (lane >> 3) + 8 * j; const LAS float* s = scr + (8 * c) * 33 + n;
        v4u o; o.x = pkbf(s[0 * 33], s[1 * 33]); o.y = pkbf(s[2 * 33], s[3 * 33]); o.z = pkbf(s[4 * 33], s[5 * 33]); o.w = pkbf(s[6 * 33], s[7 * 33]);
        *(v4u*)(WT + (size_t)(n0 + n) * K + k0 + 8 * c) = o; }
    LDS_WAIT();
}

__device__ __forceinline__ void p0_prologue(const Frame& F, CArgs& A) {
    {
        LAS float* scr = (LAS float*)(F.lds + F.wave * 16384);
        constexpr int I_IN = (DM / 64) * (INW / 32), I_OUT = (DM / 64) * (DM / 32), I_GLU = (512 / 64) * (512 / 32);
        constexpr int NITEMS = NLAYER * (I_IN + I_OUT + I_GLU);
        for (int it = F.gw; it < NITEMS; it += F.NGW) {
            int r = it;
            if (r < NLAYER * I_IN) { const int l = r / I_IN; transpose_item(A.in[I_WIN] + (size_t)l * DM * INW, DM, INW, (bf16*)(F.ws + WS_WIN) + (size_t)l * INW * DM, scr, r % I_IN, F.lane); continue; }
            r -= NLAYER * I_IN;
            if (r < NLAYER * I_OUT) { const int l = r / I_OUT; transpose_item(A.in[I_WOUT] + (size_t)l * DM * DM, DM, DM, (bf16*)(F.ws + WS_WOUT) + (size_t)l * DM * DM, scr, r % I_OUT, F.lane); continue; }
            r -= NLAYER * I_OUT;
            { const int l = r / I_GLU; transpose_item(A.in[I_WGLU] + (size_t)l * 512 * 512, 512, 512, (bf16*)(F.ws + WS_WGLU) + (size_t)l * 512 * 512, scr, r % I_GLU, F.lane); }
        }
    }
#if PEER_FP4
    {
        for (int r = F.gw; r < 2 * NLAYER * NEXP; r += F.NGW) {
            const int tab = r >= NLAYER * NEXP, ri = tab ? r - NLAYER * NEXP : r;
            const float* src = (tab ? A.in[I_PV] : A.in[I_PU]) + (size_t)ri * DM + F.lane * 4;
            f32x4 v[8]; float am = 0.f;
#pragma unroll
            for (int q = 0; q < 8; ++q) { v[q] = *(const f32x4*)(src + q * 256); am = fmaxf(am, fmaxf(fmaxf(fabsf(v[q][0]), fabsf(v[q][1])), fmaxf(fabsf(v[q][2]), fabsf(v[q][3])))); }
#pragma unroll
            for (int o = 1; o < 64; o <<= 1) am = fmaxf(am, __shfl_xor(am, o));
            const float sc = am > 0.f ? 6.0f / am : 1.0f, isc = am > 0.f ? am * (1.0f / 6.0f) : 1.0f;
            v4u w;
#pragma unroll
            for (int q = 0; q < 4; ++q) { unsigned pk = 0u;
                pk = __builtin_amdgcn_cvt_scalef32_pk_fp4_f32(pk, v[2 * q][0] * sc, v[2 * q][1] * sc, 1.0f, 0); pk = __builtin_amdgcn_cvt_scalef32_pk_fp4_f32(pk, v[2 * q][2] * sc, v[2 * q][3] * sc, 1.0f, 1);
                pk = __builtin_amdgcn_cvt_scalef32_pk_fp4_f32(pk, v[2 * q + 1][0] * sc, v[2 * q + 1][1] * sc, 1.0f, 2); pk = __builtin_amdgcn_cvt_scalef32_pk_fp4_f32(pk, v[2 * q + 1][2] * sc, v[2 * q + 1][3] * sc, 1.0f, 3);
                w[q] = pk; }
            *(v4u*)(F.ws + (tab ? WS_V8 : WS_U8) + (size_t)ri * (DM / 2) + F.lane * 16) = w;
            if (F.lane == 0) ((float*)(F.ws + (tab ? WS_VSC : WS_USC)))[ri] = isc;
        }
    }
#else
    {
        for (int r = F.gw; r < 2 * NLAYER * NEXP; r += F.NGW) {
            const int tab = r >= NLAYER * NEXP, ri = tab ? r - NLAYER * NEXP : r;
            const float* src = (tab ? A.in[I_PV] : A.in[I_PU]) + (size_t)ri * DM;
            f32x4 v[2][4]; float am = 0.f;
#pragma unroll
            for (int c = 0; c < 2; ++c)
#pragma unroll
                for (int q = 0; q < 4; ++q) { v[c][q] = *(const f32x4*)(src + (c * 64 + F.lane) * 16 + q * 4);
                    am = fmaxf(am, fmaxf(fmaxf(fabsf(v[c][q][0]), fabsf(v[c][q][1])), fmaxf(fabsf(v[c][q][2]), fabsf(v[c][q][3])))); }
#pragma unroll
            for (int o = 1; o < 64; o <<= 1) am = fmaxf(am, __shfl_xor(am, o));
            const float sc = am > 0.f ? 384.0f / am : 1.0f, isc = am > 0.f ? am * (1.0f / 384.0f) : 1.0f;
            unsigned char* dst = F.ws + (tab ? WS_V8 : WS_U8) + (size_t)ri * DM;
#pragma unroll
            for (int c = 0; c < 2; ++c) { v4u w;
#pragma unroll
                for (int q = 0; q < 4; ++q) { int pk = 0; pk = __builtin_amdgcn_cvt_pk_fp8_f32(v[c][q][0] * sc, v[c][q][1] * sc, pk, false); pk = __builtin_amdgcn_cvt_pk_fp8_f32(v[c][q][2] * sc, v[c][q][3] * sc, pk, true); w[q] = (unsigned)pk; }
                *(v4u*)(dst + (c * 64 + F.lane) * 16) = w; }
            if (F.lane == 0) ((float*)(F.ws + (tab ? WS_VSC : WS_USC)))[ri] = isc;
        }
    }
#endif
    {
        const float* pw = A.in[I_POOLW]; v4u* dst = (v4u*)(F.ws + WS_WPOOL);
        for (size_t i = F.gtid; i < (size_t)NLAYER * 512 * 64; i += F.NT) {
            const int k8 = (int)(i & 63), n = (int)((i >> 6) & 511), l = (int)(i >> 15);
            const int g = n >> 7, d = n & 127, kg = k8 >> 4, c0 = (k8 & 15) * 8;
            float f[8];
#pragma unroll
            for (int k = 0; k < 8; ++k) f[k] = (kg == g) ? pw[(((size_t)l * 4 + g) * 128 + (c0 + k)) * 128 + d] : 0.f;
            dst[i] = pack8(f);
        }
    }
    {
        const float* lre = A.in[I_LAMRE]; const float* lim = A.in[I_LAMIM]; const float* lst = A.in[I_LOGSTEP]; const float* bre = A.in[I_BRE]; const float* bim = A.in[I_BIM];
        f32x2v* ab = (f32x2v*)(F.ws + WS_S5A); f32x2v* ab64 = (f32x2v*)(F.ws + WS_S5A + 512 * 1024); f32x2v* bb = (f32x2v*)(F.ws + WS_S5B);
        for (size_t i = F.gtid; i < (size_t)NLAYER * 2 * 32 * 64; i += F.NT) {
            const float lr = lre[i], li = lim[i], dt = expf(lst[i >> 6]);
            const float mag = expf(lr * dt), ar = mag * cosf(li * dt), ai = mag * sinf(li * dt);
            const float den = lr * lr + li * li;
            const float zr = ((ar - 1.0f) * lr + ai * li) / den, zi = (ai * lr - (ar - 1.0f) * li) / den;
            ab[i] = (f32x2v){ar, ai};
            const float m64 = expf(lr * dt * 64.0f), an = li * dt * 64.0f;
            ab64[i] = (f32x2v){m64 * cosf(an), m64 * sinf(an)};
#pragma unroll
            for (int c = 0; c < 16; ++c) { const float br = bre[i * 16 + c], bi = bim[i * 16 + c]; bb[i * 16 + c] = (f32x2v){zr * br - zi * bi, zr * bi + zi * br}; }
            {
                bf16* o = (bf16*)(F.ws + WS_S5BB) + ((size_t)(i >> 6) * 128 + 2 * (i & 63)) * 32;
#pragma unroll
                for (int c = 0; c < 16; ++c) { const float br = bre[i * 16 + c], bi = bim[i * 16 + c]; o[c] = f2bf(zr * br - zi * bi); o[32 + c] = f2bf(zr * bi + zi * br); o[16 + c] = 0; o[48 + c] = 0; }
            }
        }
    }
    if (F.bx == 0 && F.tid < 128) {
        ((float*)(F.ws + WS_ROT))[F.tid] = (float)exp(-(double)F.tid / 127.0 * 9.210340371976184);
    }
    __syncthreads();
    {
        LAS float* KS = (LAS float*)F.lds;
        LAS float* WQ = (LAS float*)(F.lds + 128 * 132 * 4);
        const float* keys = A.in[I_KEYS]; const float* wq = A.in[I_WQ]; bf16* wst = (bf16*)(F.ws + WS_WS);
        for (int u = F.bx; u < NLAYER * 16 * 32; u += F.G) {
            const int dtl = u & 31, hp = (u >> 5) & 15, l = u >> 9, p = hp & 1;
#pragma unroll
            for (int r = 0; r < 8; ++r) { const int f = F.tid + 512 * r, nk = f >> 5, c4 = f & 31;
                *(LAS f32x4*)(KS + nk * 132 + c4 * 4) = *(const f32x4*)(keys + (((size_t)l * 2 + p) * 128 + nk) * 128 + c4 * 4); }
#pragma unroll
            for (int r = 0; r < 4; ++r) { const int f = F.tid + 512 * r, dd = f >> 5, c4 = f & 31;
                *(LAS f32x4*)(WQ + dd * 132 + c4 * 4) = *(const f32x4*)(wq + ((size_t)l * DM + dtl * 64 + dd) * DM + hp * 128 + c4 * 4); }
            __syncthreads();
            const int nk = F.tid & 127, dg = F.tid >> 7;
            float acc[16];
#pragma unroll
            for (int i = 0; i < 16; ++i) acc[i] = 0.f;
            for (int c4 = 0; c4 < 32; ++c4) {
                const f32x4 kv = *(const LAS f32x4*)(KS + nk * 132 + c4 * 4);
#pragma unroll
                for (int i = 0; i < 16; ++i) { const f32x4 wv = *(const LAS f32x4*)(WQ + (dg * 16 + i) * 132 + c4 * 4);
                    acc[i] += (kv[0] * wv[0] + kv[1] * wv[1]) + (kv[2] * wv[2] + kv[3] * wv[3]); }
            }
            bf16* o = wst + ((size_t)l * DM + hp * 128 + nk) * DM + dtl * 64 + dg * 16;
            v4u q0, q1; q0.x = pkbf(acc[0], acc[1]); q0.y = pkbf(acc[2], acc[3]); q0.z = pkbf(acc[4], acc[5]); q0.w = pkbf(acc[6], acc[7]);
            q1.x = pkbf(acc[8], acc[9]); q1.y = pkbf(acc[10], acc[11]); q1.z = pkbf(acc[12], acc[13]); q1.w = pkbf(acc[14], acc[15]);
            *(v4u*)o = q0; *(v4u*)(o + 8) = q1;
            __syncthreads();
        }
    }
    for (int t = F.gw; t < NTOK; t += F.NGW) {
        const float* src = t < 32768 ? A.in[I_XP] + (size_t)t * DM : A.in[I_XS] + (size_t)(t - 32768) * DM;
        ln_row(src, A.in[I_LNIN_G], A.in[I_LNIN_B], F.out + (size_t)t * DM, (bf16*)(F.ws + WS_XN) + (size_t)t * DM, F.lane);
    }
}

__device__ __forceinline__ float ret_log2_gamma(int h) { return log2f(1.0f - exp2f(-5.0f - (float)h)); }

__device__ __forceinline__ void s5_pass1(const Frame& F, CArgs& A, int l) {
    LAS float* BUs = (LAS float*)(F.lds + F.wave * 8448);
    const bf16* H = (const bf16*)(F.ws + WS_H);
    const f32x2v* ab = (const f32x2v*)(F.ws + WS_S5A); const bf16* BB = (const bf16*)(F.ws + WS_S5BB);
    f32x2v* st = (f32x2v*)(F.ws + WS_S5ST);
    const int lane = F.lane, lr = lane & 15, lq = lane >> 4;
    const int gstep = F.G < 32 ? F.G : 32;
    for (int g = F.bx % 32; g < 32; g += gstep) {
        const int nwg = F.G < 32 ? 1 : (F.G - g + 31) / 32, rank = F.G < 32 ? 0 : F.bx / 32;
        bf16x8 Bop[2][8]; f32x2v a2[2], arot[2];
#pragma unroll
        for (int dir = 0; dir < 2; ++dir) { const int gi = (l * 2 + dir) * 32 + g; a2[dir] = ab[gi * 64 + lane]; arot[dir] = (f32x2v){-a2[dir][1], a2[dir][1]};
#pragma unroll
            for (int j = 0; j < 8; ++j) Bop[dir][j] = *(const bf16x8*)(BB + ((size_t)gi * 128 + 16 * j + lr) * 32 + lq * 8); }
        for (int ck = rank * NWAVES + F.wave; ck < 640; ck += nwg * NWAVES) {
            bf16x8 uop[4];
#pragma unroll
            for (int tb = 0; tb < 4; ++tb) { const v4u q = lq < 2 ? *(const v4u*)(H + (size_t)(ck * 64 + 16 * tb + lr) * INW + COL_UA + g * 16 + lq * 8) : (v4u){0u, 0u, 0u, 0u}; uop[tb] = __builtin_bit_cast(bf16x8, q); }
#pragma unroll
            for (int dir = 0; dir < 2; ++dir) {
                f32x2v x2 = (f32x2v){0.f, 0.f};
#pragma unroll
                for (int blk = 0; blk < 4; ++blk) {
                    const int tb = dir ? 3 - blk : blk;
#pragma unroll
                    for (int j = 0; j < 8; ++j) { const f32x4 d = MFMA16(Bop[dir][j], uop[tb], ((f32x4){0.f, 0.f, 0.f, 0.f}));
                        *(LAS f32x4*)(BUs + lr * 132 + 16 * j + 4 * lq) = d; }
                    LDS_WAIT();
#pragma unroll
                    for (int s = 0; s < 16; ++s) { const int tl = dir ? 15 - s : s;
                        const f32x2v bu = *(const LAS f32x2v*)(BUs + tl * 132 + 2 * lane);
                        x2 = x2 * a2[dir][0] + (arot[dir] * (f32x2v){x2[1], x2[0]} + bu); }
                    LDS_WAIT();
                }
                st[(size_t)((ck * 32 + g) * 2 + dir) * 64 + lane] = x2;
            }
        }
    }
}
__device__ __forceinline__ void s5_carry(const Frame& F, CArgs& A, int l) {
    const f32x2v* ab64 = (const f32x2v*)(F.ws + WS_S5A + 512 * 1024); f32x2v* st = (f32x2v*)(F.ws + WS_S5ST);
    for (size_t it = F.gtid; it < (size_t)9 * 32 * 2 * 64; it += F.NT) {
        const int p = (int)(it & 63), dir = (int)((it >> 6) & 1), g = (int)((it >> 7) & 31), s = (int)(it >> 12);
        const int ck0 = s < 8 ? s * 64 : 512, n = s < 8 ? 64 : 128;
        const f32x2v a = ab64[((l * 2 + dir) * 32 + g) * 64 + p];
        float cr = 0.f, ci = 0.f;
        for (int k0 = 0; k0 < n; k0 += 8) {
            f32x2v le[8];
#pragma unroll
            for (int kk = 0; kk < 8; ++kk) { const int ck = dir ? (ck0 + n - 1 - (k0 + kk)) : (ck0 + k0 + kk); le[kk] = st[(size_t)((ck * 32 + g) * 2 + dir) * 64 + p]; }
#pragma unroll
            for (int kk = 0; kk < 8; ++kk) { const int ck = dir ? (ck0 + n - 1 - (k0 + kk)) : (ck0 + k0 + kk);
                st[(size_t)((ck * 32 + g) * 2 + dir) * 64 + p] = (f32x2v){cr, ci};
                const float ncr = a[0] * cr - a[1] * ci + le[kk][0], nci = a[0] * ci + a[1] * cr + le[kk][1]; cr = ncr; ci = nci; }
        }
    }
}
__device__ __forceinline__ void s5_pass3(const Frame& F, CArgs& A, int l) {
    LAS bf16* CtS = (LAS bf16*)F.lds;
    LAS unsigned char* wb = F.lds + 8704 + F.wave * 12800;
    LAS float* BUs = (LAS float*)wb;
    LAS bf16* Xw = (LAS bf16*)(wb + 8448);
    const bf16* H = (const bf16*)(F.ws + WS_H); bf16* BY = (bf16*)(F.ws + WS_BUFY);
    const f32x2v* ab = (const f32x2v*)(F.ws + WS_S5A); const bf16* BB = (const bf16*)(F.ws + WS_S5BB);
    const f32x2v* st = (const f32x2v*)(F.ws + WS_S5ST);
    const float* cre = A.in[I_CRE]; const float* cim = A.in[I_CIM]; const float* dvec = A.in[I_S5D] + (size_t)l * 512;
    const int lane = F.lane, lr = lane & 15, lq = lane >> 4;
    const int gstep = F.G < 32 ? F.G : 32;
    for (int g = F.bx % 32; g < 32; g += gstep) {
        const int nwg = F.G < 32 ? 1 : (F.G - g + 31) / 32, rank = F.G < 32 ? 0 : F.bx / 32;
        __syncthreads();
        {
            const int tq = opaque(F.tid);
#pragma unroll
            for (int r = 0; r < 8; ++r) { const int e = tq + 512 * r, pp = e & 127, c = (e >> 7) & 15, dir = e >> 11;
                const size_t cb = (size_t)(((l * 2 + dir) * 32 + g) * 16 + c) * 64;
                CtS[(dir * 16 + c) * 136 + pp] = f2bf(pp < 64 ? cre[cb + pp] : -cim[cb + pp - 64]); }
        }
        bf16x8 Bop[2][8]; f32x2v a2[2], arot[2];
#pragma unroll
        for (int dir = 0; dir < 2; ++dir) { const int gi = (l * 2 + dir) * 32 + g; a2[dir] = ab[gi * 64 + lane]; arot[dir] = (f32x2v){-a2[dir][1], a2[dir][1]};
#pragma unroll
            for (int j = 0; j < 8; ++j) Bop[dir][j] = *(const bf16x8*)(BB + ((size_t)gi * 128 + 16 * j + lr) * 32 + lq * 8); }
        __syncthreads();
        for (int ck = rank * NWAVES + F.wave; ck < 640; ck += nwg * NWAVES) {
            bf16x8 uop[4];
#pragma unroll
            for (int tb = 0; tb < 4; ++tb) { const v4u q = lq < 2 ? *(const v4u*)(H + (size_t)(ck * 64 + 16 * tb + lr) * INW + COL_UA + g * 16 + lq * 8) : (v4u){0u, 0u, 0u, 0u}; uop[tb] = __builtin_bit_cast(bf16x8, q); }
            f32x2v xin[2];
#pragma unroll
            for (int dir = 0; dir < 2; ++dir) xin[dir] = st[(size_t)((ck * 32 + g) * 2 + dir) * 64 + lane];
            f32x4 Y[4];
#pragma unroll
            for (int m = 0; m < 4; ++m) Y[m] = (f32x4){0.f, 0.f, 0.f, 0.f};
#pragma unroll
            for (int dir = 0; dir < 2; ++dir) {
                f32x2v x2 = xin[dir];
#pragma unroll
                for (int blk = 0; blk < 4; ++blk) {
                    const int tb = dir ? 3 - blk : blk;
#pragma unroll
                    for (int j = 0; j < 8; ++j) { const f32x4 d = MFMA16(Bop[dir][j], uop[tb], ((f32x4){0.f, 0.f, 0.f, 0.f}));
                        *(LAS f32x4*)(BUs + lr * 132 + 16 * j + 4 * lq) = d; }
                    LDS_WAIT();
#pragma unroll
                    for (int s = 0; s < 16; ++s) { const int tl = dir ? 15 - s : s;
                        const f32x2v bu = *(const LAS f32x2v*)(BUs + tl * 132 + 2 * lane);
                        x2 = x2 * a2[dir][0] + (arot[dir] * (f32x2v){x2[1], x2[0]} + bu);
                        Xw[tl * 136 + lane] = f2bf(x2[0]); Xw[tl * 136 + 64 + lane] = f2bf(x2[1]); }
                    LDS_WAIT();
#pragma unroll
                    for (int ks = 0; ks < 4; ++ks) {
                        const bf16x8 av = *(const LAS bf16x8*)(CtS + (dir * 16 + lr) * 136 + 32 * ks + lq * 8);
                        const bf16x8 bv = *(const LAS bf16x8*)(Xw + lr * 136 + 32 * ks + lq * 8);
                        Y[tb] = MFMA16(av, bv, Y[tb]);
                    }
                    LDS_WAIT();
                }
            }
#pragma unroll
            for (int m = 0; m < 4; ++m) {
                const int t = 16 * m + lr, c0 = 4 * lq;
                const v2u uq = *(const v2u*)(H + (size_t)(ck * 64 + t) * INW + COL_UA + g * 16 + c0);
                const f32x4 uv = (f32x4){bf_lo(uq.x), bf_hi(uq.x), bf_lo(uq.y), bf_hi(uq.y)}; const f32x4 dv = *(const f32x4*)(dvec + g * 16 + c0);
                const f32x4 y = Y[m] + dv * uv;
                v2u w; w.x = pkbf(gelu_erf(y[0]), gelu_erf(y[1])); w.y = pkbf(gelu_erf(y[2]), gelu_erf(y[3]));
                *(v2u*)(BY + (size_t)(ck * 64 + t) * 512 + g * 16 + c0) = w;
            }
        }
    }
}
__device__ __forceinline__ void pool_phase(const Frame& F, CArgs& A) {
    const bf16* H = (const bf16*)(F.ws + WS_H); bf16* BP = (bf16*)(F.ws + WS_BUFP);
    for (size_t it = F.gtid; it < (size_t)NTOK * 64; it += F.NT) {
        const int t = (int)(it >> 6), o = (int)(it & 63), gi = o >> 4, w = 2 << gi;
        const int pos = tok_pos(t), L = tok_len(t);
        const int lo = max(pos - w / 2, 0), hi = min(pos + w / 2 - 1, L - 1);
        const bf16* base = H + (size_t)(t - pos) * INW + COL_UB + o * 8;
        float s[8];
#pragma unroll
        for (int k = 0; k < 8; ++k) s[k] = 0.f;
        v4u wq[16];
#pragma unroll
        for (int i = 0; i < 16; ++i) { const int si = lo + i <= hi ? lo + i : hi; wq[i] = *(const v4u*)(base + (size_t)si * INW); }
#pragma unroll
        for (int i = 0; i < 16; ++i) { float f[8]; unpack8(wq[i], f); const float wgt = lo + i <= hi ? 1.0f : 0.0f;
#pragma unroll
            for (int k = 0; k < 8; ++k) s[k] += wgt * f[k]; }
        const float inv = 1.0f / (float)(hi - lo + 1);
        float c[8]; unpack8(*(const v4u*)(base + (size_t)pos * INW), c);
#pragma unroll
        for (int k = 0; k < 8; ++k) s[k] = s[k] * inv - c[k];
        *(v4u*)(BP + (size_t)t * 512 + o * 8) = pack8(s);
    }
}
__device__ __forceinline__ void rotary_phase(const Frame& F, CArgs& A) {
    bf16* H = (bf16*)(F.ws + WS_H); const float* rot = (const float*)(F.ws + WS_ROT);
    for (size_t it = F.gtid; it < (size_t)NTOK * 16; it += F.NT) {
        const int t = (int)(it >> 4), o = (int)(it & 15); const float pos = (float)tok_pos(t);
        float cs[8], sn[8];
#pragma unroll
        for (int k = 0; k < 8; ++k) { const float ang = pos * rot[o * 8 + k]; cs[k] = cosf(ang); sn[k] = sinf(ang); }
#pragma unroll
        for (int which = 0; which < 2; ++which) {
            const float sc = which ? 0.0625f : 1.0f;
#pragma unroll
            for (int hd = 0; hd < 4; ++hd) {
                bf16* p1 = H + (size_t)t * INW + (which ? COL_K : COL_Q) + hd * 256 + o * 8; bf16* p2 = p1 + 128;
                float x1[8], x2[8], o1[8], o2[8]; unpack8(*(const v4u*)p1, x1); unpack8(*(const v4u*)p2, x2);
#pragma unroll
                for (int k = 0; k < 8; ++k) { o1[k] = (x1[k] * cs[k] - x2[k] * sn[k]) * sc; o2[k] = (x2[k] * cs[k] + x1[k] * sn[k]) * sc; }
                *(v4u*)p1 = pack8(o1); *(v4u*)p2 = pack8(o2);
            }
        }
    }
}
constexpr int RS = 136;
__device__ __forceinline__ void ret_state_phase(const Frame& F, CArgs& A) {
    const bf16* H = (const bf16*)(F.ws + WS_H); bf16* STF = (bf16*)(F.ws + WS_STF); bf16* STB = (bf16*)(F.ws + WS_STB);
    LAS bf16* Kt = (LAS bf16*)F.lds; LAS bf16* VtF = Kt + 128 * RS; LAS bf16* VtB = Kt + 256 * RS;
    LAS unsigned* Kt32 = (LAS unsigned*)Kt; LAS unsigned* VtF32 = (LAS unsigned*)VtF; LAS unsigned* VtB32 = (LAS unsigned*)VtB;
    const int tid = F.tid, lane = F.lane, lr = lane & 15, lq = lane >> 4, we = F.wave >> 1, wd = F.wave & 1;
    const int jp = tid & 63, j = 2 * jp, pc0 = tid >> 6;
    v4u pk0[2], pk1[2], pv0[2], pv1[2];
#define RS_LOAD(u_) do { const int dh_ = (u_) & 1, eh_ = ((u_) >> 1) & 1, h_ = ((u_) >> 2) & 3, c_ = (u_) >> 4; \
        const bf16* krow_ = H + (size_t)(c_ * 128 + j) * INW + COL_K + h_ * 256 + dh_ * 128; const bf16* vrow_ = H + (size_t)(c_ * 128 + j) * INW + COL_V + h_ * 256 + eh_ * 128; \
        _Pragma("unroll") for (int r = 0; r < 2; ++r) { const int pc = pc0 + 8 * r; pk0[r] = *(const v4u*)(krow_ + pc * 8); pk1[r] = *(const v4u*)(krow_ + INW + pc * 8); pv0[r] = *(const v4u*)(vrow_ + pc * 8); pv1[r] = *(const v4u*)(vrow_ + INW + pc * 8); } } while (0)
    if (F.bx < 5120) RS_LOAD(F.bx);
    for (int u = F.bx; u < 5120; u += F.G) {
        const int dh = u & 1, eh = (u >> 1) & 1, h = (u >> 2) & 3, c = u >> 4;
        {
            const float lg = ret_log2_gamma(h), fF0 = exp2f(lg * (float)(127 - j)), fF1 = exp2f(lg * (float)(126 - j)), fB0 = exp2f(lg * (float)j), fB1 = exp2f(lg * (float)(j + 1));
#pragma unroll
            for (int r = 0; r < 2; ++r) {
                const int pc = pc0 + 8 * r;
                const unsigned ka0[4] = {pk0[r].x, pk0[r].y, pk0[r].z, pk0[r].w}, ka1[4] = {pk1[r].x, pk1[r].y, pk1[r].z, pk1[r].w};
                float f0[8], f1[8]; unpack8(pv0[r], f0); unpack8(pv1[r], f1);
#pragma unroll
                for (int i = 0; i < 8; ++i) {
                    const unsigned a = ka0[i >> 1], b = ka1[i >> 1];
                    const unsigned kk = (i & 1) ? ((a >> 16) | (b & 0xffff0000u)) : ((a & 0xffffu) | (b << 16));
                    const int o = ((pc * 8 + i) * RS) / 2 + jp;
                    Kt32[o] = kk; VtF32[o] = pkbf(f0[i] * fF0, f1[i] * fF1); VtB32[o] = pkbf(f0[i] * fB0, f1[i] * fB1);
                }
            }
        }
        __syncthreads();
        if (u + F.G < 5120) RS_LOAD(u + F.G);
        f32x4 aF[4][2], aB[4][2];
#pragma unroll
        for (int td = 0; td < 4; ++td)
#pragma unroll
            for (int te = 0; te < 2; ++te) { aF[td][te] = (f32x4){0.f, 0.f, 0.f, 0.f}; aB[td][te] = (f32x4){0.f, 0.f, 0.f, 0.f}; }
#pragma unroll
        for (int ks = 0; ks < 4; ++ks) {
            bf16x8 ka[4], vF[2], vB[2];
#pragma unroll
            for (int td = 0; td < 4; ++td) ka[td] = *(const LAS bf16x8*)(Kt + (64 * wd + 16 * td + lr) * RS + 32 * ks + lq * 8);
#pragma unroll
            for (int te = 0; te < 2; ++te) { vF[te] = *(const LAS bf16x8*)(VtF + (32 * we + 16 * te + lr) * RS + 32 * ks + lq * 8); vB[te] = *(const LAS bf16x8*)(VtB + (32 * we + 16 * te + lr) * RS + 32 * ks + lq * 8); }
#pragma unroll
            for (int td = 0; td < 4; ++td)
#pragma unroll
                for (int te = 0; te < 2; ++te) { aF[td][te] = MFMA16(ka[td], vF[te], aF[td][te]); aB[td][te] = MFMA16(ka[td], vB[te], aB[td][te]); }
        }
#pragma unroll
        for (int td = 0; td < 4; ++td)
#pragma unroll
            for (int te = 0; te < 2; ++te) {
                const int e = eh * 128 + 32 * we + 16 * te + lr, d = dh * 128 + 64 * wd + 16 * td + 4 * lq;
                const size_t off = ((size_t)(c * 4 + h) * 256 + e) * 256 + d;
                v2u w; w.x = pkbf(aF[td][te][0], aF[td][te][1]); w.y = pkbf(aF[td][te][2], aF[td][te][3]); *(v2u*)(STF + off) = w;
                v2u x; x.x = pkbf(aB[td][te][0], aB[td][te][1]); x.y = pkbf(aB[td][te][2], aB[td][te][3]); *(v2u*)(STB + off) = x;
            }
        __syncthreads();
    }
#undef RS_LOAD
}
__device__ __forceinline__ void ret_prefix_phase(const Frame& F, CArgs& A) {
    bf16* STF = (bf16*)(F.ws + WS_STF); bf16* STB = (bf16*)(F.ws + WS_STB);
    for (size_t it = F.gtid; it < (size_t)36 * 2 * 8192; it += F.NT) {
        const int o = (int)(it & 8191), which = (int)((it >> 13) & 1), bh = (int)(it >> 14), h = bh & 3, s = bh >> 2;
        const int c0 = s < 8 ? s * 32 : 256, n = s < 8 ? 32 : 64;
        const float dec = exp2f(128.0f * ret_log2_gamma(h));
        float st[8];
#pragma unroll
        for (int k = 0; k < 8; ++k) st[k] = 0.f;
        bf16* base = (which ? STB : STF) + (size_t)h * 65536 + (size_t)o * 8;
        for (int k0 = 0; k0 < n; k0 += 8) {
            v4u q[8];
#pragma unroll
            for (int kk = 0; kk < 8; ++kk) { const int c = which ? (c0 + n - 1 - (k0 + kk)) : (c0 + k0 + kk); q[kk] = *(const v4u*)(base + (size_t)c * 4 * 65536); }
#pragma unroll
            for (int kk = 0; kk < 8; ++kk) { const int c = which ? (c0 + n - 1 - (k0 + kk)) : (c0 + k0 + kk);
                float f[8]; unpack8(q[kk], f);
#pragma unroll
                for (int i = 0; i < 8; ++i) st[i] = dec * st[i] + f[i];
                *(v4u*)(base + (size_t)c * 4 * 65536) = pack8(st); }
        }
    }
}
__device__ __forceinline__ void ret_out_phase(const Frame& F, CArgs& A) {
    const bf16* H = (const bf16*)(F.ws + WS_H); const bf16* STF = (const bf16*)(F.ws + WS_STF); const bf16* STB = (const bf16*)(F.ws + WS_STB);
    bf16* CC = (bf16*)(F.ws + WS_CONCAT);
    LAS bf16* RA = (LAS bf16*)F.lds; LAS bf16* RB = RA + 128 * RS; LAS bf16* RC = RA + 384 * RS;
    const int tid = F.tid, wi = F.wave >> 2, wj = F.wave & 3, we = F.wave & 3;
    for (int u = F.bx; u < 1280; u += F.G) {
        const int lane = opaque(F.lane), lr = lane & 15, lq = lane >> 4;
        const int h = u & 3, c = u >> 2, t0 = c * 128;
        const int cs = c < 256 ? (c & 31) : (c - 256), ncs = c < 256 ? 32 : 64;
        const bool has_f = cs > 0, has_b = cs < ncs - 1;
        const float lg = ret_log2_gamma(h);
        const int tq = opaque(tid);
        v4u pa[4], pb[8];
#define RO_LOAD_QK(dh_) do { _Pragma("unroll") for (int r = 0; r < 4; ++r) { const int f = tq + 512 * r, row = f >> 4, pc = f & 15; \
            const bf16* src = H + (size_t)(t0 + row) * INW + h * 256 + (dh_) * 128 + pc * 8; pa[r] = *(const v4u*)(src + COL_Q); pb[r] = *(const v4u*)(src + COL_K); } } while (0)
#define RO_STORE_QK() do { _Pragma("unroll") for (int r = 0; r < 4; ++r) { const int f = tq + 512 * r, row = f >> 4, pc = f & 15; \
            *(LAS v4u*)(RA + row * RS + pc * 8) = pa[r]; *(LAS v4u*)(RB + row * RS + pc * 8) = pb[r]; } } while (0)
#define RO_LOAD_V() do { const int jp_ = tq & 63, pc0_ = tq >> 6; const bf16* vrow = H + (size_t)(t0 + 2 * jp_) * INW + COL_V + h * 256; \
            _Pragma("unroll") for (int r = 0; r < 4; ++r) { const int pc = pc0_ + 8 * r; pb[r] = *(const v4u*)(vrow + pc * 8); pb[4 + r] = *(const v4u*)(vrow + INW + pc * 8); } } while (0)
#define RO_STORE_V() do { const int jp_ = tq & 63, pc0_ = tq >> 6; LAS unsigned* RB32 = (LAS unsigned*)RB; \
            _Pragma("unroll") for (int r = 0; r < 4; ++r) { const int pc = pc0_ + 8 * r; \
                const unsigned va0[4] = {pb[r].x, pb[r].y, pb[r].z, pb[r].w}, va1[4] = {pb[4 + r].x, pb[4 + r].y, pb[4 + r].z, pb[4 + r].w}; \
                _Pragma("unroll") for (int i = 0; i < 8; ++i) { const unsigned a = va0[i >> 1], b = va1[i >> 1]; \
                    RB32[((pc * 8 + i) * RS) / 2 + jp_] = (i & 1) ? ((a >> 16) | (b & 0xffff0000u)) : ((a & 0xffffu) | (b << 16)); } } } while (0)
#define RO_LOAD_I(dir_, dh_) do { const bool has_ = (dir_) == 0 ? has_f : has_b; const int cn_ = (dir_) == 0 ? c - 1 : c + 1; \
            const bf16* St = ((dir_) == 0 ? STF : STB) + (size_t)((has_ ? cn_ : c) * 4 + h) * 65536; \
            _Pragma("unroll") for (int r = 0; r < 8; ++r) { const int f = tq + 512 * r, row = f >> 4, pc = f & 15; pb[r] = has_ ? *(const v4u*)(St + (size_t)row * 256 + (dh_) * 128 + pc * 8) : (v4u){0u, 0u, 0u, 0u}; } } while (0)
#define RO_STORE_I(dir_, dh_) do { \
            _Pragma("unroll") for (int r = 0; r < 4; ++r) { const int f = tq + 512 * r, row = f >> 4, pc = f & 15; pa[r] = *(const v4u*)(H + (size_t)(t0 + row) * INW + COL_Q + h * 256 + (dh_) * 128 + pc * 8); } \
            _Pragma("unroll") for (int r = 0; r < 4; ++r) { const int f = tq + 512 * r, row = f >> 4, pc = f & 15; \
                const float fac = exp2f(lg * ((dir_) == 0 ? (float)(row + 1) : (float)(128 - row))); float qf[8]; unpack8(pa[r], qf); \
                _Pragma("unroll") for (int k = 0; k < 8; ++k) qf[k] *= fac; \
                *(LAS v4u*)(RA + row * RS + pc * 8) = pack8(qf); } \
            _Pragma("unroll") for (int r = 0; r < 8; ++r) { const int f = tq + 512 * r, row = f >> 4, pc = f & 15; *(LAS v4u*)(RB + row * RS + pc * 8) = pb[r]; } } while (0)
        f32x4 S[4][2];
#pragma unroll
        for (int ti = 0; ti < 4; ++ti)
#pragma unroll
            for (int tj = 0; tj < 2; ++tj) S[ti][tj] = (f32x4){0.f, 0.f, 0.f, 0.f};
        RO_LOAD_QK(0);
#pragma unroll
        for (int dh = 0; dh < 2; ++dh) {
            if (dh) __syncthreads();
            RO_STORE_QK();
            __syncthreads();
            if (dh == 0) RO_LOAD_QK(1); else RO_LOAD_V();
#pragma unroll
            for (int ks = 0; ks < 4; ++ks) {
                bf16x8 ka[2], qb[4];
#pragma unroll
                for (int tj = 0; tj < 2; ++tj) ka[tj] = *(const LAS bf16x8*)(RB + (32 * wj + 16 * tj + lr) * RS + 32 * ks + lq * 8);
#pragma unroll
                for (int ti = 0; ti < 4; ++ti) qb[ti] = *(const LAS bf16x8*)(RA + (64 * wi + 16 * ti + lr) * RS + 32 * ks + lq * 8);
#pragma unroll
                for (int ti = 0; ti < 4; ++ti)
#pragma unroll
                    for (int tj = 0; tj < 2; ++tj) S[ti][tj] = MFMA16(ka[tj], qb[ti], S[ti][tj]);
            }
        }
#pragma unroll
        for (int ti = 0; ti < 4; ++ti)
#pragma unroll
            for (int tj = 0; tj < 2; ++tj) {
                const int i = 64 * wi + 16 * ti + lr, j0 = 32 * wj + 16 * tj + 4 * lq; float p[4];
#pragma unroll
                for (int jj = 0; jj < 4; ++jj) { const int d = i - (j0 + jj); p[jj] = S[ti][tj][jj] * exp2f(lg * (float)(d < 0 ? -d : d)); }
                v2u w; w.x = pkbf(p[0], p[1]); w.y = pkbf(p[2], p[3]); *(LAS v2u*)(RC + i * RS + j0) = w;
            }
        __syncthreads();
        RO_STORE_V();
        __syncthreads();
        RO_LOAD_I(0, 0);
        f32x4 O[4][4];
#pragma unroll
        for (int ti = 0; ti < 4; ++ti)
#pragma unroll
            for (int te = 0; te < 4; ++te) O[ti][te] = (f32x4){0.f, 0.f, 0.f, 0.f};
#pragma unroll
        for (int ks = 0; ks < 4; ++ks) {
            bf16x8 va[4], pbf[4];
#pragma unroll
            for (int te = 0; te < 4; ++te) va[te] = *(const LAS bf16x8*)(RB + (64 * we + 16 * te + lr) * RS + 32 * ks + lq * 8);
#pragma unroll
            for (int ti = 0; ti < 4; ++ti) pbf[ti] = *(const LAS bf16x8*)(RC + (64 * wi + 16 * ti + lr) * RS + 32 * ks + lq * 8);
#pragma unroll
            for (int ti = 0; ti < 4; ++ti)
#pragma unroll
                for (int te = 0; te < 4; ++te) O[ti][te] = MFMA16(va[te], pbf[ti], O[ti][te]);
        }
#pragma unroll
        for (int stg = 0; stg < 4; ++stg) {
            __syncthreads();
            if (stg == 0) RO_STORE_I(0, 0); else if (stg == 1) RO_STORE_I(0, 1); else if (stg == 2) RO_STORE_I(1, 0); else RO_STORE_I(1, 1);
            __syncthreads();
            if (stg == 0) RO_LOAD_I(0, 1); else if (stg == 1) RO_LOAD_I(1, 0); else if (stg == 2) RO_LOAD_I(1, 1);
#pragma unroll
            for (int ks = 0; ks < 4; ++ks) {
                bf16x8 sa[4], qb[4];
#pragma unroll
                for (int te = 0; te < 4; ++te) sa[te] = *(const LAS bf16x8*)(RB + (64 * we + 16 * te + lr) * RS + 32 * ks + lq * 8);
#pragma unroll
                for (int ti = 0; ti < 4; ++ti) qb[ti] = *(const LAS bf16x8*)(RA + (64 * wi + 16 * ti + lr) * RS + 32 * ks + lq * 8);
#pragma unroll
                for (int ti = 0; ti < 4; ++ti)
#pragma unroll
                    for (int te = 0; te < 4; ++te) O[ti][te] = MFMA16(sa[te], qb[ti], O[ti][te]);
            }
        }
#undef RO_LOAD_QK
#undef RO_STORE_QK
#undef RO_LOAD_V
#undef RO_STORE_V
#undef RO_LOAD_I
#undef RO_STORE_I
        __syncthreads();
        LAS float* RED = (LAS float*)RA;
#pragma unroll
        for (int ti = 0; ti < 4; ++ti) { float s1 = 0.f, s2 = 0.f;
#pragma unroll
            for (int te = 0; te < 4; ++te)
#pragma unroll
                for (int jj = 0; jj < 4; ++jj) { const float v = O[ti][te][jj]; s1 += v; s2 += v * v; }
            s1 += __shfl_xor(s1, 16); s1 += __shfl_xor(s1, 32); s2 += __shfl_xor(s2, 16); s2 += __shfl_xor(s2, 32);
            if (lq == 0) { RED[((64 * wi + 16 * ti + lr) * 4 + we) * 2] = s1; RED[((64 * wi + 16 * ti + lr) * 4 + we) * 2 + 1] = s2; } }
        __syncthreads();
#pragma unroll
        for (int ti = 0; ti < 4; ++ti) { const int i = 64 * wi + 16 * ti + lr;
            const f32x4 r0 = *(const LAS f32x4*)(RED + i * 8), r1 = *(const LAS f32x4*)(RED + i * 8 + 4);
            const float m = (r0[0] + r0[2] + r1[0] + r1[2]) * (1.0f / 256.0f), q = (r0[1] + r0[3] + r1[1] + r1[3]) * (1.0f / 256.0f);
            const float var = fmaxf(q - m * m, 0.f), rstd = 1.0f / sqrtf(var + GN_EPS);
#pragma unroll
            for (int te = 0; te < 4; ++te) { const int e0 = 64 * we + 16 * te + 4 * lq;
                const v2u gq = *(const v2u*)(H + (size_t)(t0 + i) * INW + COL_G + h * 256 + e0);
                const float gv[4] = {bf_lo(gq.x), bf_hi(gq.x), bf_lo(gq.y), bf_hi(gq.y)}; float ov[4];
#pragma unroll
                for (int jj = 0; jj < 4; ++jj) { const float gg = gv[jj]; ov[jj] = (gg / (1.0f + __expf(-gg))) * ((O[ti][te][jj] - m) * rstd); }
                v2u w; w.x = pkbf(ov[0], ov[1]); w.y = pkbf(ov[2], ov[3]);
                *(v2u*)(CC + (size_t)(t0 + i) * DM + 1024 + h * 256 + e0) = w; } }
        __syncthreads();
    }
}

__device__ __forceinline__ unsigned f2key(float f) { const unsigned u = __float_as_uint(f); return (u & 0x80000000u) ? ~u : (u | 0x80000000u); }
__device__ __forceinline__ float key2f(unsigned k) { const unsigned u = (k & 0x80000000u) ? (k & 0x7fffffffu) : ~k; return __uint_as_float(u); }
#define TK_CE(a, b) do { const unsigned hi_ = (a) > (b) ? (a) : (b), lo_ = (a) > (b) ? (b) : (a); (a) = hi_; (b) = lo_; } while (0)
__device__ __forceinline__ void bitonic_merge16(unsigned (&v)[16]) {
#pragma unroll
    for (int j = 8; j > 0; j >>= 1)
#pragma unroll
        for (int i = 0; i < 16; ++i) { const int l = i ^ j; if (l > i) TK_CE(v[i], v[l]); }
}
__device__ __forceinline__ void bitonic_sort16(unsigned (&v)[16]) {
#pragma unroll
    for (int k = 2; k <= 16; k <<= 1)
#pragma unroll
        for (int j = k >> 1; j > 0; j >>= 1)
#pragma unroll
            for (int i = 0; i < 16; ++i) { const int l = i ^ j; if (l > i) { if ((i & k) == 0) TK_CE(v[i], v[l]); else TK_CE(v[l], v[i]); } }
}
__device__ __forceinline__ void topk_phase(const Frame& F, CArgs& A) {
    const float* SC = (const float*)(F.ws + WS_H); int* IDX = (int*)(F.ws + WS_IDX); float* GATE = (float*)(F.ws + WS_GATE);
    LAS unsigned* LK = (LAS unsigned*)F.lds;
    const int tid = F.tid, tl = tid >> 4, hp = tid & 15;
    for (int blk = F.bx; blk < NTOK / 32; blk += F.G) {
        const int t = blk * 32 + tl;
        const float* row = SC + (size_t)t * DM + hp * 128;
        unsigned run[16];
#pragma unroll
        for (int k = 0; k < 16; ++k) run[k] = 0u;
        f32x4 cur[8], nxt[8];
#pragma unroll
        for (int q = 0; q < 8; ++q) cur[q] = *(const f32x4*)(row + q * 4);
        for (int n32 = 0; n32 < 4; ++n32) {
            if (n32 < 3) {
#pragma unroll
                for (int q = 0; q < 8; ++q) nxt[q] = *(const f32x4*)(row + (n32 + 1) * 32 + q * 4);
            }
#pragma unroll
            for (int hc = 0; hc < 2; ++hc) {
                unsigned ch[16];
#pragma unroll
                for (int q = 0; q < 4; ++q)
#pragma unroll
                    for (int e = 0; e < 4; ++e) { const int n = n32 * 32 + hc * 16 + q * 4 + e; ch[q * 4 + e] = (f2key(cur[hc * 4 + q][e]) & ~127u) | (unsigned)(127 - n); }
                bitonic_sort16(ch);
#pragma unroll
                for (int i = 0; i < 16; ++i) run[i] = run[i] > ch[15 - i] ? run[i] : ch[15 - i];
                bitonic_merge16(run);
            }
#pragma unroll
            for (int q = 0; q < 8; ++q) cur[q] = nxt[q];
        }
#pragma unroll
        for (int k = 0; k < 16; ++k) LK[tid * 17 + k] = run[k];
        __syncthreads();
        if ((hp & 1) == 0) {
            float a[16], b[16];
#pragma unroll
            for (int k = 0; k < 16; ++k) { a[k] = key2f(LK[tid * 17 + k] & ~127u); b[k] = key2f(LK[(tid + 1) * 17 + k] & ~127u); }
            unsigned sk[16];
#pragma unroll
            for (int k = 0; k < 16; ++k) sk[k] = 0u;
#pragma unroll
            for (int i = 0; i < 16; ++i)
#pragma unroll
                for (int j = 0; j < 16; ++j) if ((i + 1) * (j + 1) <= 16) {
                    unsigned key = (f2key(a[i] + b[j]) & ~255u) | (unsigned)(255 - (i * 16 + j));
#pragma unroll
                    for (int k = 0; k < 16; ++k) { const unsigned hi = sk[k] > key ? sk[k] : key, lo = sk[k] > key ? key : sk[k]; sk[k] = hi; key = lo; }
                }
            float e[16], sum = 0.f; const float s0 = key2f(sk[0] & ~255u);
#pragma unroll
            for (int k = 0; k < 16; ++k) { e[k] = __expf(key2f(sk[k] & ~255u) - s0); sum += e[k]; }
            const float inv = 1.0f / sum; const int head = hp >> 1;
#pragma unroll
            for (int k = 0; k < 16; ++k) {
                const int cell = 255 - (int)(sk[k] & 255u);
                const int i1 = 127 - (int)(LK[tid * 17 + (cell >> 4)] & 127u), i2 = 127 - (int)(LK[(tid + 1) * 17 + (cell & 15)] & 127u);
                IDX[(size_t)t * 128 + head * 16 + k] = i1 * 128 + i2;
                GATE[(size_t)t * 128 + head * 16 + k] = e[k] * inv;
            }
        }
        __syncthreads();
    }
}
#if PEER_FP4
__device__ __forceinline__ void peer_gather_phase(const Frame& F, CArgs& A, int l, float* xdst_base, bf16* XN) {
    constexpr int RB = DM / 2;
    constexpr int GNR = GATHER_ROWS;
    const unsigned char* U8 = F.ws + WS_U8 + (size_t)l * NEXP * RB; const unsigned char* V8 = F.ws + WS_V8 + (size_t)l * NEXP * RB;
    const float* USC = (const float*)(F.ws + WS_USC) + (size_t)l * NEXP; const float* VSC = (const float*)(F.ws + WS_VSC) + (size_t)l * NEXP;
    const int* IDX = (const int*)(F.ws + WS_IDX); const float* GATE = (const float*)(F.ws + WS_GATE);
    const float* g2 = A.in[I_LN2G] + (size_t)l * DM; const float* b2 = A.in[I_LN2B] + (size_t)l * DM;
    const int lane = F.lane, slot = 8 * (lane & 7) + (lane >> 3);
    for (int t = F.gw; t < NTOK; t += F.NGW) {
        float* xrow = F.out + (size_t)t * DM;
        f32x2v x[16];
#pragma unroll
        for (int q = 0; q < 8; ++q) { const f32x4 a = *(const f32x4*)(xrow + q * 256 + lane * 4); x[2 * q] = (f32x2v){a[0], a[1]}; x[2 * q + 1] = (f32x2v){a[2], a[3]}; }
        const int idx0 = IDX[(size_t)t * 128 + slot], idx1 = IDX[(size_t)t * 128 + 64 + slot];
        v4u BU[GNR];
        const unsigned loff = (unsigned)lane * 16u;
#define G_ROW_U(R) (U8 + (size_t)(unsigned)__builtin_amdgcn_readlane((((R) >> 6) & 1) ? idx1 : idx0, ((R) & 7) * 8 + (((R) >> 3) & 7)) * RB)
#define G_ROW_V(R) (V8 + (size_t)(unsigned)__builtin_amdgcn_readlane((((R) >> 6) & 1) ? idx1 : idx0, (R) & 63) * RB)
#define G_REQ(r, rowptr) do { BU[r] = *(const v4u*)((rowptr) + loff); } while (0)
#define G_DOT(r, dst) do { f32x2v s2_ = (f32x2v){0.f, 0.f}; \
            _Pragma("unroll") for (int q = 0; q < 4; ++q) { s2_ += __builtin_amdgcn_cvt_scalef32_pk_f32_fp4(BU[r][q], 1.0f, 0) * x[4 * q]; s2_ += __builtin_amdgcn_cvt_scalef32_pk_f32_fp4(BU[r][q], 1.0f, 1) * x[4 * q + 1]; \
                s2_ += __builtin_amdgcn_cvt_scalef32_pk_f32_fp4(BU[r][q], 1.0f, 2) * x[4 * q + 2]; s2_ += __builtin_amdgcn_cvt_scalef32_pk_f32_fp4(BU[r][q], 1.0f, 3) * x[4 * q + 3]; } \
            if (GATHER_PROBE) { f32x2v p2_ = (f32x2v){0.f, 0.f}; _Pragma("unroll") for (int q = 0; q < 4; ++q) { const unsigned wq_ = (unsigned)opaque((int)BU[r][q]); p2_ += __builtin_amdgcn_cvt_scalef32_pk_f32_fp4(wq_, 1.0f, 0) * x[4 * q]; p2_ += __builtin_amdgcn_cvt_scalef32_pk_f32_fp4(wq_, 1.0f, 1) * x[4 * q + 1]; p2_ += __builtin_amdgcn_cvt_scalef32_pk_f32_fp4(wq_, 1.0f, 2) * x[4 * q + 2]; p2_ += __builtin_amdgcn_cvt_scalef32_pk_f32_fp4(wq_, 1.0f, 3) * x[4 * q + 3]; } s2_ += p2_ * 0.0f; } \
            dst = s2_[0] + s2_[1]; } while (0)
#define G_REDUCE(g) do { \
            _Pragma("unroll") for (int i = 0; i < 4; ++i) { const float mine = b5 ? part[i + 4] : part[i], send = b5 ? part[i] : part[i + 4]; part[i] = mine + __shfl_xor(send, 32); } \
            _Pragma("unroll") for (int i = 0; i < 2; ++i) { const float mine = b4 ? part[i + 2] : part[i], send = b4 ? part[i] : part[i + 2]; part[i] = mine + __shfl_xor(send, 16); } \
            { const float mine = b3 ? part[1] : part[0], send = b3 ? part[0] : part[1]; part[0] = mine + __shfl_xor(send, 8); } \
            float v_ = part[0]; v_ += __shfl_xor(v_, 4); v_ += __shfl_xor(v_, 2); v_ += __shfl_xor(v_, 1); \
            const bool mine_ = (lane & 7) == ((g) & 7); hval0 = (mine_ && ((g) >> 3) == 0) ? v_ : hval0; hval1 = (mine_ && ((g) >> 3) == 1) ? v_ : hval1; } while (0)
        if (GATHER_PROBE2) {
            const int pm0 = idx0 & (GATHER_PROBE2 - 1), pm1 = idx1 & (GATHER_PROBE2 - 1); f32x2v ps = (f32x2v){0.f, 0.f};
#define G_ROW_P(R) (U8 + (size_t)(unsigned)__builtin_amdgcn_readlane((((R) >> 6) & 1) ? pm1 : pm0, (R) & 63) * RB)
#pragma unroll
            for (int r = 0; r < GNR; ++r) G_REQ(r, G_ROW_P(r));
            for (int it = 0; it < 128 / GNR - 1; ++it) {
#pragma unroll
                for (int r = 0; r < GNR; ++r) { float d_; G_DOT(r, d_); ps[0] += d_; G_REQ(r, G_ROW_P(GNR * (it + 1) + r)); }
            }
#pragma unroll
            for (int r = 0; r < GNR; ++r) { float d_; G_DOT(r, d_); ps[1] += d_; }
            asm volatile("" :: "v"(ps[0]), "v"(ps[1]));
#undef G_ROW_P
        }
        const bool b5 = (lane & 32) != 0, b4 = (lane & 16) != 0, b3 = (lane & 8) != 0;
        float hval0 = 0.f, hval1 = 0.f;
#pragma unroll
        for (int r = 0; r < GNR; ++r) G_REQ(r, G_ROW_U(r));
        for (int it = 0; it < 128 / GNR - 1; ++it) {
#pragma unroll
            for (int g4 = 0; g4 < GNR / 8; ++g4) { float part[8];
#pragma unroll
                for (int i = 0; i < 8; ++i) { G_DOT(g4 * 8 + i, part[i]); G_REQ(g4 * 8 + i, G_ROW_U(GNR * (it + 1) + g4 * 8 + i)); }
                G_REDUCE(it * (GNR / 8) + g4); }
        }
#pragma unroll
        for (int g4 = 0; g4 < GNR / 8; ++g4) { float part[8];
#pragma unroll
            for (int i = 0; i < 8; ++i) { G_DOT(g4 * 8 + i, part[i]); G_REQ(g4 * 8 + i, G_ROW_V(g4 * 8 + i)); }
            G_REDUCE(16 - GNR / 8 + g4); }
        const float gate0 = GATE[(size_t)t * 128 + slot], gate1 = GATE[(size_t)t * 128 + 64 + slot];
        const float usc0 = USC[idx0], usc1 = USC[idx1], vsc0 = VSC[idx0], vsc1 = VSC[idx1];
        const float w0 = gate0 * gelu_erf(hval0 * usc0) * vsc0, w1 = gate1 * gelu_erf(hval1 * usc1) * vsc1;
        f32x2v acc[16];
#pragma unroll
        for (int k = 0; k < 16; ++k) acc[k] = (f32x2v){0.f, 0.f};
#define G_AXPY(r, R) do { const float w_ = __uint_as_float((unsigned)__builtin_amdgcn_readlane((int)__float_as_uint((((R) >> 6) & 1) ? w1 : w0), (R) & 63)); const f32x2v w2_ = (f32x2v){w_, w_}; \
            _Pragma("unroll") for (int q = 0; q < 4; ++q) { acc[4 * q] += w2_ * __builtin_amdgcn_cvt_scalef32_pk_f32_fp4(BU[r][q], 1.0f, 0); acc[4 * q + 1] += w2_ * __builtin_amdgcn_cvt_scalef32_pk_f32_fp4(BU[r][q], 1.0f, 1); \
                acc[4 * q + 2] += w2_ * __builtin_amdgcn_cvt_scalef32_pk_f32_fp4(BU[r][q], 1.0f, 2); acc[4 * q + 3] += w2_ * __builtin_amdgcn_cvt_scalef32_pk_f32_fp4(BU[r][q], 1.0f, 3); } } while (0)
        for (int it = 0; it < 128 / GNR - 1; ++it) {
#pragma unroll
            for (int r = 0; r < GNR; ++r) { G_AXPY(r, GNR * it + r); G_REQ(r, G_ROW_V(GNR * (it + 1) + r)); }
        }
#pragma unroll
        for (int r = 0; r < GNR; ++r) G_AXPY(r, 128 - GNR + r);
#undef G_ROW_U
#undef G_ROW_V
#undef G_REQ
#undef G_DOT
#undef G_REDUCE
#undef G_AXPY
        const int le = opaque(lane);
        float s = 0.f;
#pragma unroll
        for (int j = 0; j < 8; ++j) { const f32x4 xr = *(const f32x4*)(xrow + j * 256 + le * 4);
            acc[2 * j] = (f32x2v){xr[0], xr[1]} * ALPHA + acc[2 * j]; acc[2 * j + 1] = (f32x2v){xr[2], xr[3]} * ALPHA + acc[2 * j + 1];
            s += (acc[2 * j][0] + acc[2 * j][1]) + (acc[2 * j + 1][0] + acc[2 * j + 1][1]); }
        const float mean = wave_sum(s) * (1.0f / DM); float s2 = 0.f;
#pragma unroll
        for (int k = 0; k < 16; ++k) { acc[k] = acc[k] - mean; s2 += acc[k][0] * acc[k][0] + acc[k][1] * acc[k][1]; }
        const float rstd = 1.0f / sqrtf(wave_sum(s2) * (1.0f / DM) + LN_EPS);
#pragma unroll
        for (int j = 0; j < 8; ++j) { const int col = j * 256 + le * 4;
            const f32x4 gg = *(const f32x4*)(g2 + col), bb = *(const f32x4*)(b2 + col);
            const f32x2v a0 = acc[2 * j], a1 = acc[2 * j + 1];
            const f32x4 o = (f32x4){a0[0] * rstd * gg[0] + bb[0], a0[1] * rstd * gg[1] + bb[1], a1[0] * rstd * gg[2] + bb[2], a1[1] * rstd * gg[3] + bb[3]};
            *(f32x4*)(xdst_base + (size_t)t * DM + col) = o;
            v2u w; w.x = pkbf(o[0], o[1]); w.y = pkbf(o[2], o[3]); *(v2u*)(XN + (size_t)t * DM + col) = w; }
    }
}

#else
__device__ __forceinline__ void peer_gather_phase(const Frame& F, CArgs& A, int l) {
    const unsigned char* U8 = F.ws + WS_U8 + (size_t)l * NEXP * DM; const unsigned char* V8 = F.ws + WS_V8 + (size_t)l * NEXP * DM;
    const float* USC = (const float*)(F.ws + WS_USC) + (size_t)l * NEXP; const float* VSC = (const float*)(F.ws + WS_VSC) + (size_t)l * NEXP;
    const int* IDX = (const int*)(F.ws + WS_IDX); const float* GATE = (const float*)(F.ws + WS_GATE);
    const float* g2 = A.in[I_LN2G] + (size_t)l * DM; const float* b2 = A.in[I_LN2B] + (size_t)l * DM;
    bf16* XN = (bf16*)(F.ws + WS_XN);
    const int lane = F.lane, slot = 8 * (lane & 7) + (lane >> 3);
    for (int t = F.gw; t < NTOK; t += F.NGW) {
        float* xrow = F.out + (size_t)t * DM;
        f32x2v x[2][8];
#pragma unroll
        for (int c = 0; c < 2; ++c)
#pragma unroll
            for (int q = 0; q < 4; ++q) { const f32x4 a = *(const f32x4*)(xrow + (c * 64 + lane) * 16 + q * 4); x[c][2 * q] = (f32x2v){a[0], a[1]}; x[c][2 * q + 1] = (f32x2v){a[2], a[3]}; }
        const int idx0 = IDX[(size_t)t * 128 + slot], idx1 = IDX[(size_t)t * 128 + 64 + slot];
        v4u BU[8][2];
        const unsigned loff0 = (unsigned)lane * 16u, loff1 = (unsigned)lane * 16u + 1024u;
#define G_ROW_U(i, b) (U8 + (size_t)(unsigned)__builtin_amdgcn_readlane(((b) >> 3) ? idx1 : idx0, (i) * 8 + ((b) & 7)) * DM)
#define G_ROW_V(i, b) (V8 + (size_t)(unsigned)__builtin_amdgcn_readlane(((b) >> 3) ? idx1 : idx0, ((b) & 7) * 8 + (i)) * DM)
#define G_REQ(i, rowptr) do { const unsigned char* r_ = (rowptr); BU[i][0] = *(const v4u*)(r_ + loff0); BU[i][1] = *(const v4u*)(r_ + loff1); } while (0)
#define G_DOT(i, dst) do { f32x2v s2_ = (f32x2v){0.f, 0.f}; \
            _Pragma("unroll") for (int c = 0; c < 2; ++c) _Pragma("unroll") for (int q = 0; q < 4; ++q) { s2_ += __builtin_amdgcn_cvt_pk_f32_fp8((int)BU[i][c][q], false) * x[c][2 * q]; s2_ += __builtin_amdgcn_cvt_pk_f32_fp8((int)BU[i][c][q], true) * x[c][2 * q + 1]; } \
            dst = s2_[0] + s2_[1]; } while (0)
#define G_REDUCE(b) do { \
            _Pragma("unroll") for (int i = 0; i < 4; ++i) { const float mine = b5 ? part[i + 4] : part[i], send = b5 ? part[i] : part[i + 4]; part[i] = mine + __shfl_xor(send, 32); } \
            _Pragma("unroll") for (int i = 0; i < 2; ++i) { const float mine = b4 ? part[i + 2] : part[i], send = b4 ? part[i] : part[i + 2]; part[i] = mine + __shfl_xor(send, 16); } \
            { const float mine = b3 ? part[1] : part[0], send = b3 ? part[0] : part[1]; part[0] = mine + __shfl_xor(send, 8); } \
            float v_ = part[0]; v_ += __shfl_xor(v_, 4); v_ += __shfl_xor(v_, 2); v_ += __shfl_xor(v_, 1); \
            const bool mine_ = (lane & 7) == ((b) & 7); hval0 = (mine_ && ((b) >> 3) == 0) ? v_ : hval0; hval1 = (mine_ && ((b) >> 3) == 1) ? v_ : hval1; } while (0)
        const bool b5 = (lane & 32) != 0, b4 = (lane & 16) != 0, b3 = (lane & 8) != 0;
        float hval0 = 0.f, hval1 = 0.f;
#pragma unroll
        for (int i = 0; i < 8; ++i) G_REQ(i, G_ROW_U(i, 0));
        for (int b = 0; b < 15; ++b) {
            float part[8];
#pragma unroll
            for (int i = 0; i < 8; ++i) { G_DOT(i, part[i]); G_REQ(i, G_ROW_U(i, b + 1)); }
            G_REDUCE(b);
        }
        {
            float part[8];
#pragma unroll
            for (int i = 0; i < 8; ++i) { G_DOT(i, part[i]); G_REQ(i, G_ROW_V(i, 0)); }
            G_REDUCE(15);
        }
        const float gate0 = GATE[(size_t)t * 128 + slot], gate1 = GATE[(size_t)t * 128 + 64 + slot];
        const float usc0 = USC[idx0], usc1 = USC[idx1], vsc0 = VSC[idx0], vsc1 = VSC[idx1];
        const float w0 = gate0 * gelu_erf(hval0 * usc0) * vsc0, w1 = gate1 * gelu_erf(hval1 * usc1) * vsc1;
        f32x2v acc[2][8];
#pragma unroll
        for (int c = 0; c < 2; ++c)
#pragma unroll
            for (int k = 0; k < 8; ++k) acc[c][k] = (f32x2v){0.f, 0.f};
#define G_AXPY(i, b) do { const float w_ = __uint_as_float((unsigned)__builtin_amdgcn_readlane((int)__float_as_uint(((b) >> 3) ? w1 : w0), ((b) & 7) * 8 + (i))); const f32x2v w2_ = (f32x2v){w_, w_}; \
            _Pragma("unroll") for (int c = 0; c < 2; ++c) _Pragma("unroll") for (int q = 0; q < 4; ++q) { acc[c][2 * q] += w2_ * __builtin_amdgcn_cvt_pk_f32_fp8((int)BU[i][c][q], false); acc[c][2 * q + 1] += w2_ * __builtin_amdgcn_cvt_pk_f32_fp8((int)BU[i][c][q], true); } } while (0)
        for (int b = 0; b < 15; ++b) {
#pragma unroll
            for (int i = 0; i < 8; ++i) { G_AXPY(i, b); G_REQ(i, G_ROW_V(i, b + 1)); }
        }
#pragma unroll
        for (int i = 0; i < 8; ++i) G_AXPY(i, 15);
#undef G_ROW_U
#undef G_ROW_V
#undef G_REQ
#undef G_DOT
#undef G_REDUCE
#undef G_AXPY
        const int le = opaque(lane);
        float s = 0.f;
#pragma unroll
        for (int c = 0; c < 2; ++c)
#pragma unroll
            for (int k = 0; k < 8; ++k) { const f32x2v xr = *(const f32x2v*)(xrow + (c * 64 + le) * 16 + 2 * k);
                acc[c][k] = xr * ALPHA + acc[c][k]; s += acc[c][k][0] + acc[c][k][1]; }
        const float mean = wave_sum(s) * (1.0f / DM); float s2 = 0.f;
#pragma unroll
        for (int c = 0; c < 2; ++c)
#pragma unroll
            for (int k = 0; k < 8; ++k) { acc[c][k] = acc[c][k] - mean; s2 += acc[c][k][0] * acc[c][k][0] + acc[c][k][1] * acc[c][k][1]; }
        const float rstd = 1.0f / sqrtf(wave_sum(s2) * (1.0f / DM) + LN_EPS);
#pragma unroll
        for (int c = 0; c < 2; ++c) { const int col = (c * 64 + le) * 16;
#pragma unroll
            for (int h8 = 0; h8 < 2; ++h8) { float o[8];
#pragma unroll
                for (int q = 0; q < 2; ++q) { const f32x4 gg = *(const f32x4*)(g2 + col + h8 * 8 + q * 4), bb = *(const f32x4*)(b2 + col + h8 * 8 + q * 4);
                    const f32x2v a0 = acc[c][h8 * 4 + 2 * q], a1 = acc[c][h8 * 4 + 2 * q + 1];
                    o[4 * q] = a0[0] * rstd * gg[0] + bb[0]; o[4 * q + 1] = a0[1] * rstd * gg[1] + bb[1]; o[4 * q + 2] = a1[0] * rstd * gg[2] + bb[2]; o[4 * q + 3] = a1[1] * rstd * gg[3] + bb[3];
                    *(f32x4*)(xrow + col + h8 * 8 + q * 4) = (f32x4){o[4 * q], o[4 * q + 1], o[4 * q + 2], o[4 * q + 3]}; }
                *(v4u*)(XN + (size_t)t * DM + col + h8 * 8) = pack8(o); } }
    }
}

#endif
#ifndef DUP_MASK
#define DUP_MASK 0
#endif
#ifndef PHASE_TEST_ONLY
__global__ void __launch_bounds__(NTHR, 2) fwd_kernel(Args A) {
    extern __shared__ __attribute__((aligned(16))) unsigned char lds_raw[];
#define MKFRAME() Frame F; CArgs& KA = *(CArgs*)opaque_u64((unsigned long long)__builtin_amdgcn_kernarg_segment_ptr()); { F.lds = (LAS unsigned char*)lds_raw; F.tid = opaque((int)threadIdx.x); F.lane = F.tid & 63; F.wave = __builtin_amdgcn_readfirstlane(F.tid >> 6); \
        const int bx_ = opaque_s((int)blockIdx.x); F.G = gridDim.x; F.gw = bx_ * NWAVES + F.wave; F.NGW = F.G * NWAVES; F.gtid = (size_t)bx_ * NTHR + F.tid; F.NT = (size_t)F.G * NTHR; F.out = (float*)opaque_p(KA.out); F.ws = (unsigned char*)opaque_p(KA.ws); F.bx = bx_; } \
        bf16* XN = (bf16*)(F.ws + WS_XN); bf16* H = (bf16*)(F.ws + WS_H); bf16* CC = (bf16*)(F.ws + WS_CONCAT); (void)XN; (void)H; (void)CC;
    volatile LAS unsigned* MISC = (volatile LAS unsigned*)((LAS unsigned char*)lds_raw + LDS_MISC);
    if (threadIdx.x < 64) MISC[threadIdx.x] = 0u;
    __syncthreads();
    XcdBarrier bar = xcd_barrier_post((unsigned*)(A.ws + WS_CTL) + CW_BAR + A.li * XCD_BAR_WORDS, MISC + 8);
    const int lo = A.ph_lo, hi = A.ph_hi;
#define IN(k) (lo <= (k) && (k) < hi)
#define SEAM(k) do { if (lo <= (k) && (k) + 1 < hi) xcd_barrier(bar); } while (0)

    if (IN(0)) { MKFRAME(); p0_prologue(F, KA); if (DUP_MASK & 256) { __syncthreads(); p0_prologue(F, KA); } } SEAM(0);

    for (int l = 0; l < NLAYER; ++l) {
        const int pb = 1 + l * 10;
        if (IN(pb + 0)) { MKFRAME();
            pg8::Gemm g{XN, (const bf16*)(F.ws + WS_WIN) + (size_t)l * INW * DM, NTOK, INW, DM}; pg8::StaticOrder S; S.init(NTOK, INW, F.G, F.bx);
            EpiStoreBf16 E{H, INW};
            pg8::gemm_phase<EpiStoreBf16, pg8::StaticOrder, true, true>(F.lds, g, S, E);
            if (DUP_MASK & 64) { pg8::gemm_phase<EpiStoreBf16, pg8::StaticOrder, true, true>(F.lds, g, S, E); }
        } SEAM(pb + 0);
        if (IN(pb + 1)) { MKFRAME(); s5_pass1(F, KA, l); pool_phase(F, KA); if (DUP_MASK & 1) { s5_pass1(F, KA, l); } if (DUP_MASK & 2) { pool_phase(F, KA); } rotary_phase(F, KA); } SEAM(pb + 1);
        if (IN(pb + 2)) { MKFRAME(); s5_carry(F, KA, l); __syncthreads(); ret_state_phase(F, KA); if (DUP_MASK & 4) { ret_state_phase(F, KA); } } SEAM(pb + 2);
        if (IN(pb + 3)) { MKFRAME(); s5_pass3(F, KA, l); if (DUP_MASK & 8) { s5_pass3(F, KA, l); } ret_prefix_phase(F, KA); } SEAM(pb + 3);
        if (IN(pb + 4)) { MKFRAME();
            __syncthreads();
            ret_out_phase(F, KA);
            if (DUP_MASK & 16) { ret_out_phase(F, KA); }
            {
                pg8::Gemm g{(const bf16*)(F.ws + WS_BUFY), (const bf16*)(F.ws + WS_WGLU) + (size_t)l * 512 * 512, NTOK, 512, 512}; pg8::StaticOrder S; S.init(NTOK, 512, F.G, F.bx);
                EpiGlu E{(const bf16*)(F.ws + WS_BUFY), 512, CC, DM, KA.in[I_BGLU] + (size_t)l * 512};
                pg8::gemm_phase<EpiGlu, pg8::StaticOrder, true, true>(F.lds, g, S, E);
                if (DUP_MASK & 512) { pg8::gemm_phase<EpiGlu, pg8::StaticOrder, true, true>(F.lds, g, S, E); }
            }
            {
                pg8::Gemm g{(const bf16*)(F.ws + WS_BUFP), (const bf16*)(F.ws + WS_WPOOL) + (size_t)l * 512 * 512, NTOK, 512, 512}; pg8::StaticOrder S; S.init(NTOK, 512, F.G, F.bx);
                EpiScaleBf16 E{CC + 512, DM, KA.in[I_POOLS] + (size_t)l * 512};
                pg8::gemm_phase<EpiScaleBf16, pg8::StaticOrder, true, true>(F.lds, g, S, E);
                if (DUP_MASK & 512) { pg8::gemm_phase<EpiScaleBf16, pg8::StaticOrder, true, true>(F.lds, g, S, E); }
            }
        } SEAM(pb + 4);
        if (IN(pb + 5)) { MKFRAME();
            pg8::Gemm g{CC, (const bf16*)(F.ws + WS_WOUT) + (size_t)l * DM * DM, NTOK, DM, DM}; pg8::StaticOrder S; S.init(NTOK, DM, F.G, F.bx);
            EpiResid E{F.out, DM, ALPHA};
            pg8::gemm_phase<EpiResid, pg8::StaticOrder, true, true>(F.lds, g, S, E);
        } SEAM(pb + 5);
        if (IN(pb + 6)) { MKFRAME();
            ln_rows2(F.out, KA.in[I_LN1G] + (size_t)l * DM, KA.in[I_LN1B] + (size_t)l * DM, XN, F.gw, F.NGW, F.lane);
        } SEAM(pb + 6);
        if (IN(pb + 7)) { MKFRAME();
            pg8::Gemm g{XN, (const bf16*)(F.ws + WS_WS) + (size_t)l * DM * DM, NTOK, DM, DM}; pg8::StaticOrder S; S.init(NTOK, DM, F.G, F.bx);
            EpiStoreF32 E{(float*)(F.ws + WS_H), DM};
            pg8::gemm_phase<EpiStoreF32, pg8::StaticOrder, true, true>(F.lds, g, S, E);
            if (DUP_MASK & 128) { pg8::gemm_phase<EpiStoreF32, pg8::StaticOrder, true, true>(F.lds, g, S, E); }
        } SEAM(pb + 7);
        if (IN(pb + 8)) { MKFRAME(); __syncthreads(); topk_phase(F, KA); if (DUP_MASK & 32) { topk_phase(F, KA); } } SEAM(pb + 8);
        if (IN(pb + 9)) { MKFRAME(); if (DUP_MASK & 1024) { peer_gather_phase(F, KA, l, (float*)(F.ws + WS_H), CC); } peer_gather_phase(F, KA, l, F.out, XN); } SEAM(pb + 9);
    }
#undef IN
#undef SEAM
}


#ifndef DBG_STOP
#define DBG_STOP NPHASE
#endif
#ifndef DBG_DUMP
#define DBG_DUMP 0
#endif
__global__ void dbg_dump_kernel(float* out, const unsigned char* ws, int mode) {
    const size_t n = (size_t)NTOK * DM;
    for (size_t i = (size_t)blockIdx.x * blockDim.x + threadIdx.x; i < n; i += (size_t)gridDim.x * blockDim.x) {
        float v = 0.f;
        if (mode == 1) v = bf_lo(((const bf16*)(ws + WS_H))[i]);
        else if (mode == 2) v = bf_lo(((const bf16*)(ws + WS_CONCAT))[i]);
        else if (mode == 3) v = bf_lo(((const bf16*)(ws + WS_BUFY))[i % ((size_t)NTOK * 1024)]);
        else if (mode == 4) v = bf_lo(((const bf16*)(ws + WS_STF))[i]);
        else if (mode == 5) v = ((const float*)(ws + WS_H))[i];
        else if (mode == 6) v = (i < (size_t)NTOK * 128) ? (float)((const int*)(ws + WS_IDX))[i] : ((i < (size_t)NTOK * 256) ? ((const float*)(ws + WS_GATE))[i - (size_t)NTOK * 128] : 0.f);
        else if (mode == 7) v = bf_lo(((const bf16*)(ws + WS_XN))[i]);
        else if (mode == 8) v = bf_lo(((const bf16*)(ws + WS_STB))[i]);
        else if (mode == 9) v = bf_lo(((const bf16*)(ws + WS_H))[i + (size_t)NTOK * DM]);
        else if (mode == 10) v = bf_lo(((const bf16*)(ws + WS_WIN))[i % ((size_t)72 * 1024 * 1024)]);
        else if (mode == 11) v = ((const float*)(ws + WS_S5ST))[i % ((size_t)5 * 1024 * 1024)];
        else if (mode == 12) v = bf_lo(((const bf16*)(ws + WS_H))[i]) + bf_lo(((const bf16*)(ws + WS_H))[i + (size_t)NTOK * DM]) + bf_lo(((const bf16*)(ws + WS_BUFP))[i % ((size_t)NTOK * 512)]) + ((const float*)(ws + WS_S5ST))[i % ((size_t)5 * 1024 * 1024)];
        else if (mode == 13) v = bf_lo(((const bf16*)(ws + WS_STF))[i]) + bf_lo(((const bf16*)(ws + WS_STB))[i]) + ((const float*)(ws + WS_S5ST))[i % ((size_t)5 * 1024 * 1024)];
        else if (mode == 14) v = bf_lo(((const bf16*)(ws + WS_STF))[i]) + bf_lo(((const bf16*)(ws + WS_STB))[i]) + bf_lo(((const bf16*)(ws + WS_BUFY))[i % ((size_t)NTOK * 512)]);
        else if (mode == 15) v = bf_lo(((const bf16*)(ws + WS_H))[i]) + bf_lo(((const bf16*)(ws + WS_H))[i + (size_t)NTOK * DM]) + bf_lo(((const bf16*)(ws + WS_H))[i + (size_t)NTOK * 3072]);
        out[i] = v;
    }
}
#ifndef MK_ONE_LAUNCH
#define MK_ONE_LAUNCH 0
#endif
extern "C" void kernel_launch(void* const* d_in, const int* in_sizes, int n_in, void* d_out, int out_size, void* d_ws, size_t ws_size, hipStream_t stream) {
    static int grid = 0;
    if (grid == 0) {
        if (n_in != 26 || out_size != NTOK * DM || ws_size < WS_END) { fprintf(stderr, "kernel_launch: unexpected shapes (n_in %d out %d ws %zu)\n", n_in, out_size, ws_size); grid = -1; return; }
        int dev = 0, cus = 0, per_cu = 0;
        if (hipGetDevice(&dev) != hipSuccess || hipDeviceGetAttribute(&cus, hipDeviceAttributeMultiprocessorCount, dev) != hipSuccess) { grid = -1; return; }
        if (hipFuncSetAttribute((const void*)fwd_kernel, hipFuncAttributeMaxDynamicSharedMemorySize, LDS_BYTES) != hipSuccess) { fprintf(stderr, "kernel_launch: hipFuncSetAttribute failed\n"); grid = -1; return; }
        if (hipOccupancyMaxActiveBlocksPerMultiprocessor(&per_cu, (const void*)fwd_kernel, NTHR, LDS_BYTES) != hipSuccess || per_cu < 1) { fprintf(stderr, "kernel_launch: occupancy query says %d\n", per_cu); grid = -1; (void)hipGetLastError(); return; }
        (void)hipGetLastError();
        grid = cus;
    }
    if (grid < 0) return;
    if (hipMemsetAsync((char*)d_ws + WS_CTL, 0, CTL_ZERO_BYTES, stream) != hipSuccess) return;
    Args a{};
    for (int i = 0; i < 26; ++i) a.in[i] = (const float*)d_in[i];
    a.out = (float*)d_out; a.ws = (unsigned char*)d_ws; a.pad = 0;
#if MK_ONE_LAUNCH
    a.ph_lo = 0; a.ph_hi = NPHASE; a.li = 0;
    hipLaunchKernelGGL(fwd_kernel, dim3(grid), dim3(NTHR), LDS_BYTES, stream, a);
#else
    for (int p = 0; p < DBG_STOP; ++p) { a.ph_lo = p; a.ph_hi = p + 1; a.li = p; hipLaunchKernelGGL(fwd_kernel, dim3(grid), dim3(NTHR), LDS_BYTES, stream, a); }
#endif
    if (DBG_DUMP) hipLaunchKernelGGL(dbg_dump_kernel, dim3(2048), dim3(256), 0, stream, (float*)d_out, (const unsigned char*)d_ws, DBG_DUMP);
}
#endif
```

```cpp
#include <hip/hip_runtime.h>
#include <cstdio>
#include <cstdint>
#include <cmath>
__device__ __forceinline__ int opaque(int v) { asm volatile("" : "+v"(v)); return v; }
__device__ __forceinline__ int opaque_s(int v) { asm volatile("" : "+s"(v)); return v; }
__device__ __forceinline__ void* opaque_p(void* p) { asm volatile("" : "+s"(p)); return p; }
__device__ __forceinline__ unsigned long long opaque_u64(unsigned long long v) { asm volatile("" : "+s"(v)); return v; }
#ifndef PEER_FP4
#define PEER_FP4 1
#endif
#ifndef GATHER_ROWS
#define GATHER_ROWS 16
#endif
#ifndef GATHER_PROBE
#define GATHER_PROBE 0
#endif
#ifndef GATHER_PROBE2
#define GATHER_PROBE2 0
#endif
#define MK_ONE_LAUNCH 1
namespace pg8 {
#define PG8_LAS __attribute__((address_space(3)))
typedef unsigned short bf16_t;
typedef short bf16x8 __attribute__((ext_vector_type(8)));
typedef float f32x4 __attribute__((ext_vector_type(4)));
typedef unsigned u32x4 __attribute__((ext_vector_type(4)));
constexpr int BM = 256, BK = 64, HALF = 128, HTB = HALF * BK * 2  , STAGE_BYTES = 8 * HTB, NXCD = 8, WGM = 8;

__host__ __device__ __forceinline__ int lds_byte(int r, int c) { const int st = (r >> 4) * 2 + (c >> 5), rr = r & 15, cc = c & 31, ob = rr * 64 + cc * 2; return st * 1024 + (ob ^ (((ob >> 9) & 1) << 5)); }
__host__ __device__ __forceinline__ void stage_rc(int b, int& R, int& C) { const int st = b / 1024, sb = b % 1024, swz = sb ^ (((sb >> 9) & 1) << 5); R = (st >> 1) * 16 + swz / 64; C = (st & 1) * 32 + (swz % 64) / 2; }
__host__ __device__ __forceinline__ int perm32(int rho) { const int n = rho >> 4, i = rho & 15; return 8 * (i >> 2) + 4 * n + (i & 3); }

struct Unit { int pm, pn; };
struct Gemm { const bf16_t* A; const bf16_t* Bt; int M, N, K; };

struct StaticOrder {
    int nM, nN, nwg, G, c;
    __host__ __device__ void init(int M, int N, int G_, int c_) { nM = M / BM; nN = N / BM; nwg = nM * nN; G = G_; c = c_; }
    __host__ __device__ bool next(int i, Unit& u) const {
        const long L = (long)i * G + c; if (L >= nwg) return false;
        int wgid = (int)L; { const int q = nwg / NXCD, r = nwg % NXCD, xcd = wgid % NXCD, off = wgid / NXCD; wgid = (xcd < r ? xcd * (q + 1) : r * (q + 1) + (xcd - r) * q) + off; }
        const int nig = WGM * nN, gid = wgid / nig, fm = gid * WGM, gsz = (nM - fm) < WGM ? (nM - fm) : WGM;
        u.pm = fm + ((wgid % nig) % gsz); u.pn = (wgid % nig) / gsz; return true;
    }
    __device__ __forceinline__ void a_ready(const Unit&) const {}
    __device__ __forceinline__ void done(const Unit&) const {}
};
__device__ __forceinline__ unsigned cvt_pk_bf16(float lo, float hi) { unsigned r; asm volatile("v_cvt_pk_bf16_f32 %0, %1, %2" : "=v"(r) : "v"(lo), "v"(hi)); return r; }
typedef float f32x2 __attribute__((ext_vector_type(2)));
template <class Epi, class Sched, bool ALIGN_EPI = false, bool SP2 = false>
__device__ __forceinline__ void gemm_phase(PG8_LAS unsigned char* lds, const Gemm g, const Sched& S, const Epi& E) {
    const int tid = opaque((int)threadIdx.x), wid = __builtin_amdgcn_readfirstlane(tid >> 6), lane = tid & 63, wr = wid >> 2, wc = wid & 3, fr = lane & 15, fq = lane >> 4;
    const int K = g.K, nt = K / BK;
    unsigned voffA[2], voffB[2];
#pragma unroll
    for (int i = 0; i < 2; ++i) { int R, C; stage_rc(tid * 16 + i * 8192, R, C); const int Rb = Epi::PERM ? ((R & ~31) + perm32(R & 31)) : R;
        voffA[i] = (unsigned)(R * K + C) * 2u; voffB[i] = (unsigned)(Rb * K + C) * 2u; }
    const size_t kstep = (size_t)(BK * 2);
    const size_t hstep = (size_t)HALF * K * 2;
    const size_t tstep = 2 * hstep;
    const unsigned ldsw = (unsigned)wid * 1024u;
    const int aoff = lds_byte(wr * 64 + fr, fq * 8), boff = lds_byte(wc * 32 + fr, fq * 8);
#define PG8_SA(b, h) (((b) * 2 + (h)) * HTB)
#define PG8_SB(b, h) ((4 + (b) * 2 + (h)) * HTB)
#define PG8_STAGE(bufoff, gbase, voff) do { _Pragma("unroll") for (int _i = 0; _i < 2; ++_i) \
        __builtin_amdgcn_global_load_lds((const unsigned*)((const char*)(gbase) + (voff)[_i]), (PG8_LAS unsigned*)(lds + (bufoff) + ldsw + _i * 8192), 16, 0, 0); } while (0)
#define PG8_LDA(dst, b, h) do { _Pragma("unroll") for (int m = 0; m < 4; ++m) _Pragma("unroll") for (int k = 0; k < 2; ++k) dst[m][k] = *(const PG8_LAS bf16x8*)(lds + PG8_SA(b, h) + aoff + m * 2048 + k * 1024); } while (0)
#define PG8_LDB(dst, b, h) do { _Pragma("unroll") for (int n = 0; n < 2; ++n) _Pragma("unroll") for (int k = 0; k < 2; ++k) dst[n][k] = *(const PG8_LAS bf16x8*)(lds + PG8_SB(b, h) + boff + n * 2048 + k * 1024); } while (0)
#define PG8_MMA(ai, bj, At, Bt) do { __builtin_amdgcn_s_setprio(1); _Pragma("unroll") for (int m = 0; m < 4; ++m) _Pragma("unroll") for (int n = 0; n < 2; ++n) _Pragma("unroll") for (int k = 0; k < 2; ++k) \
        acc[ai][bj][m][n] = __builtin_amdgcn_mfma_f32_16x16x32_bf16(Bt[n][k], At[m][k], acc[ai][bj][m][n], 0, 0, 0); __builtin_amdgcn_s_setprio(0); } while (0)
#define PG8_WAIT_V(n) asm volatile("s_waitcnt vmcnt(" #n ")" ::: "memory")
#define PG8_WAIT_L(n) asm volatile("s_waitcnt lgkmcnt(" #n ")" ::: "memory")
#define PG8_BAR __builtin_amdgcn_s_barrier()
#define PG8_SCHED __builtin_amdgcn_sched_barrier(0)
    Unit cur, nxt; int ui = 0;
    if (!S.next(0, cur)) return;
    f32x4 acc[2][2][4][2];
#pragma unroll
    for (int a = 0; a < 2; ++a)
#pragma unroll
        for (int b = 0; b < 2; ++b)
#pragma unroll
            for (int m = 0; m < 4; ++m)
#pragma unroll
                for (int n = 0; n < 2; ++n) acc[a][b][m][n] = (f32x4){0.f, 0.f, 0.f, 0.f};
    bf16x8 At[4][2], B0[2][2], B1[2][2];
    const char* cA = (const char*)g.A + (size_t)cur.pm * tstep; const char* cB = (const char*)g.Bt + (size_t)cur.pn * tstep;
    S.a_ready(cur);
    if constexpr (SP2) {
        PG8_STAGE(PG8_SB(0, 0), cB, voffB); PG8_STAGE(PG8_SB(0, 1), cB + hstep, voffB); PG8_STAGE(PG8_SA(0, 0), cA, voffA); PG8_STAGE(PG8_SA(0, 1), cA + hstep, voffA);
        if (wr == 1) PG8_BAR;
        PG8_WAIT_V(2); PG8_BAR;
        PG8_STAGE(PG8_SB(1, 0), cB + kstep, voffB); PG8_STAGE(PG8_SA(1, 0), cA + kstep, voffA); PG8_STAGE(PG8_SB(1, 1), cB + hstep + kstep, voffB);
        PG8_WAIT_V(6); PG8_BAR;
    } else {
        PG8_STAGE(PG8_SB(0, 0), cB, voffB); PG8_STAGE(PG8_SA(0, 0), cA, voffA); PG8_STAGE(PG8_SB(0, 1), cB + hstep, voffB); PG8_STAGE(PG8_SA(0, 1), cA + hstep, voffA);
        if (wr == 1) PG8_BAR;
        PG8_WAIT_V(4); PG8_BAR;
        PG8_STAGE(PG8_SB(1, 0), cB + kstep, voffB); PG8_STAGE(PG8_SA(1, 0), cA + kstep, voffA); PG8_STAGE(PG8_SB(1, 1), cB + hstep + kstep, voffB);
        PG8_WAIT_V(6); PG8_BAR;
    }
    for (;;) {
        const bool has_next = S.next(ui + 1, nxt);
        const char* nA = has_next ? (const char*)g.A + (size_t)nxt.pm * tstep : cA; const char* nB = has_next ? (const char*)g.Bt + (size_t)nxt.pn * tstep : cB;
        for (int t = 0; t < nt; t += 2) {
            const bool last = (t == nt - 2);
            const char* a1 = cA + (size_t)(t + 1) * kstep;
            const char* a2 = last ? nA : cA + (size_t)(t + 2) * kstep; const char* b2 = last ? nB : cB + (size_t)(t + 2) * kstep;
            const char* a3 = a2 + kstep; const char* b3 = b2 + kstep;
            if (last && has_next) S.a_ready(nxt);
            if constexpr (SP2) {
            PG8_LDB(B0, 0, 0); PG8_LDB(B1, 0, 1); PG8_SCHED; PG8_LDA(At, 0, 0); PG8_STAGE(PG8_SA(1, 1), a1 + hstep, voffA);
            PG8_WAIT_V(8); PG8_WAIT_L(0); PG8_BAR; PG8_MMA(0, 0, At, B0); PG8_MMA(0, 1, At, B1); PG8_BAR; PG8_SCHED;
            PG8_LDA(At, 0, 1); PG8_STAGE(PG8_SB(0, 0), b2, voffB); PG8_STAGE(PG8_SB(0, 1), b2 + hstep, voffB); PG8_STAGE(PG8_SA(0, 0), a2, voffA);
            PG8_WAIT_V(8); PG8_WAIT_L(0); PG8_BAR; PG8_MMA(1, 0, At, B0); PG8_MMA(1, 1, At, B1); PG8_BAR; PG8_SCHED;
            PG8_LDB(B0, 1, 0); PG8_LDB(B1, 1, 1); PG8_SCHED; PG8_LDA(At, 1, 0); PG8_STAGE(PG8_SA(0, 1), a2 + hstep, voffA);
            PG8_WAIT_V(8); PG8_WAIT_L(0); PG8_BAR; PG8_MMA(0, 0, At, B0); PG8_MMA(0, 1, At, B1); PG8_BAR; PG8_SCHED;
            PG8_LDA(At, 1, 1); PG8_STAGE(PG8_SB(1, 0), b3, voffB); PG8_STAGE(PG8_SB(1, 1), b3 + hstep, voffB); PG8_STAGE(PG8_SA(1, 0), a3, voffA);
            PG8_WAIT_V(8); PG8_WAIT_L(0); PG8_BAR; PG8_MMA(1, 0, At, B0); PG8_MMA(1, 1, At, B1); PG8_BAR; PG8_SCHED;
            } else {
            PG8_LDB(B0, 0, 0); PG8_SCHED; PG8_LDA(At, 0, 0); PG8_STAGE(PG8_SA(1, 1), a1 + hstep, voffA);
            PG8_WAIT_L(8); PG8_BAR; PG8_WAIT_L(0); PG8_MMA(0, 0, At, B0); PG8_BAR; PG8_SCHED;
            PG8_LDB(B1, 0, 1); PG8_STAGE(PG8_SB(0, 0), b2, voffB);
            PG8_BAR; PG8_WAIT_L(0); PG8_MMA(0, 1, At, B1); PG8_BAR;
            PG8_LDA(At, 0, 1); PG8_STAGE(PG8_SA(0, 0), a2, voffA);
            PG8_BAR; PG8_WAIT_L(0); PG8_MMA(1, 0, At, B0); PG8_BAR; PG8_SCHED;
            PG8_STAGE(PG8_SB(0, 1), b2 + hstep, voffB);
            PG8_WAIT_V(6); PG8_BAR; PG8_MMA(1, 1, At, B1); PG8_BAR;
            PG8_LDB(B0, 1, 0); PG8_SCHED; PG8_LDA(At, 1, 0); PG8_STAGE(PG8_SA(0, 1), a2 + hstep, voffA);
            PG8_WAIT_L(8); PG8_BAR; PG8_WAIT_L(0); PG8_MMA(0, 0, At, B0); PG8_BAR; PG8_SCHED;
            PG8_LDB(B1, 1, 1); PG8_STAGE(PG8_SB(1, 0), b3, voffB);
            PG8_BAR; PG8_WAIT_L(0); PG8_MMA(0, 1, At, B1); PG8_BAR;
            PG8_LDA(At, 1, 1); PG8_STAGE(PG8_SA(1, 0), a3, voffA);
            PG8_BAR; PG8_WAIT_L(0); PG8_MMA(1, 0, At, B0); PG8_BAR; PG8_SCHED;
            PG8_STAGE(PG8_SB(1, 1), b3 + hstep, voffB);
            PG8_WAIT_V(6); PG8_BAR; PG8_MMA(1, 1, At, B1); PG8_BAR;
            }
        }
        if constexpr (ALIGN_EPI) { if (wr == 0) PG8_BAR; }
        if constexpr (!Epi::AFTER_DRAIN) { E(acc, cur, wr, wc, fr, fq); S.done(cur); }
        if (!has_next) break;
#pragma unroll
        for (int a = 0; a < 2; ++a)
#pragma unroll
            for (int b = 0; b < 2; ++b)
#pragma unroll
                for (int m = 0; m < 4; ++m)
#pragma unroll
                    for (int n = 0; n < 2; ++n) acc[a][b][m][n] = (f32x4){0.f, 0.f, 0.f, 0.f};
        cur = nxt; cA = nA; cB = nB; ++ui;
        if constexpr (ALIGN_EPI) { if (wr == 1) PG8_BAR; }
    }
    PG8_WAIT_V(0);
    if constexpr (!ALIGN_EPI) { if (wr == 0) PG8_BAR; }
    PG8_BAR;
    if constexpr (Epi::AFTER_DRAIN) { E.fused(acc, cur, wr, wc, fr, fq, lds, wid, lane); S.done(cur); }
#undef PG8_SA
#undef PG8_SB
#undef PG8_STAGE
#undef PG8_LDA
#undef PG8_LDB
#undef PG8_MMA
#undef PG8_WAIT_V
#undef PG8_WAIT_L
#undef PG8_BAR
#undef PG8_SCHED
}
}
#define LAS __attribute__((address_space(3)))
#define XB_TMO      128
#define XB_XCNT(j)  (256  + 64 * (j))
#define XB_XSUB(j)  (1280 + 64 * (j))
#define XB_XGEN(j)  (2304 + 64 * (j))
#define XB_TOP      3328
#define XB_TOPGEN   3392
#define XCD_BAR_WORDS 3456
#define XB_SPIN_CAP (1u << 18)

__device__ __forceinline__ unsigned xb_ld(unsigned* p)              { return __hip_atomic_load(p, __ATOMIC_RELAXED, __HIP_MEMORY_SCOPE_AGENT); }
__device__ __forceinline__ unsigned xb_add(unsigned* p, unsigned v) { return __hip_atomic_fetch_add(p, v, __ATOMIC_RELAXED, __HIP_MEMORY_SCOPE_AGENT); }
__device__ __forceinline__ unsigned xb_xcc_id() { return (unsigned)__builtin_amdgcn_s_getreg((3 << 11) | 20) & 0xFu; }
#define XB_SPIN(cond, bar) do { unsigned _sp = 0; while (cond) { __builtin_amdgcn_s_sleep(1); \
    if ((++_sp & 255u) == 0u) { if (xb_ld(&(bar)[XB_TMO])) break; if (_sp > XB_SPIN_CAP) { atomicAdd(&(bar)[XB_TMO], 1u); break; } } } } while (0)

struct XcdBarrier {
    unsigned* bar; unsigned x;
    volatile LAS unsigned* st;
};

__device__ __forceinline__ XcdBarrier xcd_barrier_post(unsigned* bar, volatile LAS unsigned* st) {
    XcdBarrier b; b.bar = bar; b.x = xb_xcc_id(); b.st = st;
    if (threadIdx.x == 0) (void)xb_add(&bar[XB_XCNT(b.x)], 1u);
    return b;
}
__device__ __forceinline__ void xcd_barrier_complete(unsigned* bar, unsigned x, unsigned& nloc, unsigned& nx) {
    const unsigned G = gridDim.x * gridDim.y * gridDim.z;
    unsigned sum, cnt, mine, sp = 0u;
    for (;;) {
        sum = 0u; cnt = 0u; mine = 0u;
#pragma unroll
        for (unsigned j = 0; j < 16; ++j) { const unsigned c = xb_ld(&bar[XB_XCNT(j)]); sum += c; cnt += (c > 0u) ? 1u : 0u; mine = (j == x) ? c : mine; }
        if (sum == G) break;
        __builtin_amdgcn_s_sleep(1);
        if ((++sp & 255u) == 0u) { if (xb_ld(&bar[XB_TMO])) break; if (sp > XB_SPIN_CAP) { atomicAdd(&bar[XB_TMO], 1u); break; } }
    }
    nloc = mine > 0u ? mine : 1u; nx = cnt > 0u ? cnt : 1u;
}

__device__ __forceinline__ void xcd_barrier(const XcdBarrier& b) {
    asm volatile("s_waitcnt vmcnt(0)" ::: "memory");
    __syncthreads();
    if (threadIdx.x == 0) {
        unsigned* bar = b.bar;
        __builtin_amdgcn_s_waitcnt(0);
        unsigned nloc = b.st[0], nx = b.st[1];
        if (nloc == 0u) { xcd_barrier_complete(bar, b.x, nloc, nx); b.st[0] = nloc; b.st[1] = nx; }
        const unsigned old = xb_add(&bar[XB_XSUB(b.x)], 1u);
        const unsigned gen = old / nloc;
        if (old + 1u == (gen + 1u) * nloc) {
            __builtin_amdgcn_fence(__ATOMIC_RELEASE, "agent");
            asm volatile("s_waitcnt vmcnt(0)" ::: "memory");
            const unsigned og = xb_add(&bar[XB_TOP], 1u);
            const unsigned tg = og / nx;
            if (og + 1u == (tg + 1u) * nx) xb_add(&bar[XB_TOPGEN], 1u);
            else XB_SPIN(xb_ld(&bar[XB_TOPGEN]) == tg, bar);
            __builtin_amdgcn_fence(__ATOMIC_ACQUIRE, "agent");
            xb_add(&bar[XB_XGEN(b.x)], 1u);
            asm volatile("s_waitcnt vmcnt(0)" ::: "memory");
        } else {
            XB_SPIN(xb_ld(&bar[XB_XGEN(b.x)]) == gen, bar);
            __builtin_amdgcn_fence(__ATOMIC_ACQUIRE, "agent");
            asm volatile("s_waitcnt vmcnt(0)" ::: "memory");
        }
    }
    __syncthreads();
}
#undef LAS
using pg8::bf16x8; using pg8::f32x4; using pg8::u32x4; using pg8::f32x2;
#define GAS __attribute__((address_space(1)))
#define LAS __attribute__((address_space(3)))
typedef unsigned short bf16;
typedef unsigned v4u __attribute__((ext_vector_type(4)));
typedef unsigned v2u __attribute__((ext_vector_type(2)));
typedef float f32x2v __attribute__((ext_vector_type(2)));

constexpr int NTOK = 40960, DM = 2048, NLAYER = 4, INW = 5120;
constexpr int COL_UA = 0, COL_UB = 512, COL_Q = 1024, COL_K = 2048, COL_V = 3072, COL_G = 4096;
constexpr float ALPHA = 1.6817928305074290f;
constexpr float LN_EPS = 1e-5f, GN_EPS = 1e-6f;
constexpr int NEXP = 16384;
constexpr int NWAVES = 8, NTHR = 512;

constexpr size_t MiB = 1u << 20;
constexpr size_t WS_CTL = 0, CTL_ZERO_BYTES = 1 * MiB;
constexpr size_t WS_WIN = 1 * MiB;
constexpr size_t WS_WOUT = 81 * MiB;
constexpr size_t WS_WS = 113 * MiB;
constexpr size_t WS_WGLU = 145 * MiB;
constexpr size_t WS_WPOOL = 147 * MiB;
constexpr size_t WS_S5A = 149 * MiB;
constexpr size_t WS_S5B = 150 * MiB;
constexpr size_t WS_ROT = 152 * MiB;
constexpr size_t WS_S5BB = 153 * MiB;
constexpr size_t WS_U16 = 160 * MiB;
constexpr size_t WS_V16 = 416 * MiB;
constexpr size_t WS_U8 = 160 * MiB;
constexpr size_t WS_V8 = 288 * MiB;
constexpr size_t WS_USC = 416 * MiB;
constexpr size_t WS_VSC = 417 * MiB;
constexpr size_t WS_ROTC = 420 * MiB;
constexpr size_t WS_ROTS = 424 * MiB;
constexpr size_t WS_XN = 672 * MiB;
constexpr size_t WS_H = 832 * MiB;
constexpr size_t WS_CONCAT = 1232 * MiB;
constexpr size_t WS_BUFY = 1392 * MiB;
constexpr size_t WS_BUFP = 1432 * MiB;
constexpr size_t WS_STF = 1472 * MiB;
constexpr size_t WS_STB = 1632 * MiB;
constexpr size_t WS_IDX = 1792 * MiB;
constexpr size_t WS_GATE = 1812 * MiB;
constexpr size_t WS_S5ST = 1832 * MiB;
constexpr size_t WS_END = 1852 * MiB;
constexpr int CW_BAR = 4096;
constexpr int NPHASE = 1 + NLAYER * 10;

constexpr int LDS_SCRATCH = 147456;
constexpr int LDS_MISC = LDS_SCRATCH;
constexpr int LDS_BYTES = LDS_SCRATCH + 256;

__device__ __forceinline__ float bf_lo(unsigned w) { return __uint_as_float(w << 16); }
__device__ __forceinline__ float bf_hi(unsigned w) { return __uint_as_float(w & 0xffff0000u); }
typedef __bf16 bf16x2_t __attribute__((ext_vector_type(2)));
__device__ __forceinline__ unsigned pkbf(float lo, float hi) { const bf16x2_t v = {(__bf16)lo, (__bf16)hi}; return __builtin_bit_cast(unsigned, v); }
__device__ __forceinline__ bf16 f2bf(float f) { return __builtin_bit_cast(unsigned short, (__bf16)f); }
__device__ __forceinline__ float wave_sum(float v) {
#pragma unroll
    for (int o = 1; o < 64; o <<= 1) v += __shfl_xor(v, o);
    return v;
}
__device__ __forceinline__ float gelu_erf(float v) { return 0.5f * v * (1.0f + erff(v * 0.70710678118654752f)); }
__device__ __forceinline__ int tok_pos(int t) { return t < 32768 ? (t & 4095) : (t - 32768); }
__device__ __forceinline__ int tok_len(int t) { return t < 32768 ? 4096 : 8192; }
__device__ __forceinline__ void unpack8(const v4u q, float (&f)[8]) {
    f[0] = bf_lo(q.x); f[1] = bf_hi(q.x); f[2] = bf_lo(q.y); f[3] = bf_hi(q.y); f[4] = bf_lo(q.z); f[5] = bf_hi(q.z); f[6] = bf_lo(q.w); f[7] = bf_hi(q.w);
}
__device__ __forceinline__ v4u pack8(const float (&f)[8]) { v4u q; q.x = pkbf(f[0], f[1]); q.y = pkbf(f[2], f[3]); q.z = pkbf(f[4], f[5]); q.w = pkbf(f[6], f[7]); return q; }
#define LDS_WAIT() asm volatile("s_waitcnt lgkmcnt(0)" ::: "memory")
#define MFMA16(a, b, c) __builtin_amdgcn_mfma_f32_16x16x32_bf16((a), (b), (c), 0, 0, 0)

struct EpiStoreBf16 {
    static constexpr bool PERM = true, AFTER_DRAIN = false;
    bf16* O; int ldo;
    __device__ __forceinline__ void operator()(const f32x4 (&acc)[2][2][4][2], const pg8::Unit& u, int wr, int wc, int fr, int fq) const {
        const int row0 = u.pm * 256 + wr * 64 + fr, col0 = u.pn * 256 + wc * 32 + 8 * fq;
#pragma unroll
        for (int ai = 0; ai < 2; ++ai)
#pragma unroll
            for (int m = 0; m < 4; ++m) { bf16* rowp = O + (size_t)(row0 + ai * 128 + m * 16) * ldo + col0;
#pragma unroll
                for (int bj = 0; bj < 2; ++bj) { const f32x4 v0 = acc[ai][bj][m][0], v1 = acc[ai][bj][m][1];
                    v4u w; w.x = pkbf(v0[0], v0[1]); w.y = pkbf(v0[2], v0[3]); w.z = pkbf(v1[0], v1[1]); w.w = pkbf(v1[2], v1[3]);
                    *(v4u*)(rowp + bj * 128) = w; } }
    }
};
struct EpiStoreRot {
    static constexpr bool PERM = true, AFTER_DRAIN = false;
    bf16* O; int ldo; const float* rc; const float* rs;
    __device__ __forceinline__ void operator()(const f32x4 (&acc)[2][2][4][2], const pg8::Unit& u, int wr, int wc, int fr, int fq) const {
        const int row0 = u.pm * 256 + wr * 64 + fr, col0 = u.pn * 256 + wc * 32 + 8 * fq;
        const bool rot = u.pn >= 4 && u.pn < 12; const float sc = u.pn >= 8 ? 0.0625f : 1.0f;
#pragma unroll
        for (int ai = 0; ai < 2; ++ai)
#pragma unroll
            for (int m = 0; m < 4; ++m) { const int row = row0 + ai * 128 + m * 16; bf16* rowp = O + (size_t)row * ldo + col0;
                f32x4 a0 = acc[ai][0][m][0], a1 = acc[ai][0][m][1], b0 = acc[ai][1][m][0], b1 = acc[ai][1][m][1];
                if (rot) { const int pos = row < 32768 ? (row & 4095) : (row - 32768); const size_t to = (size_t)pos * 128 + wc * 32 + 8 * fq;
                    const f32x4 c0 = *(const f32x4*)(rc + to), c1 = *(const f32x4*)(rc + to + 4), s0 = *(const f32x4*)(rs + to), s1 = *(const f32x4*)(rs + to + 4);
                    const f32x4 x0 = a0, x1 = a1, y0 = b0, y1 = b1;
                    a0 = (x0 * c0 - y0 * s0) * sc; a1 = (x1 * c1 - y1 * s1) * sc; b0 = (y0 * c0 + x0 * s0) * sc; b1 = (y1 * c1 + x1 * s1) * sc; }
                v4u w; w.x = pkbf(a0[0], a0[1]); w.y = pkbf(a0[2], a0[3]); w.z = pkbf(a1[0], a1[1]); w.w = pkbf(a1[2], a1[3]); *(v4u*)rowp = w;
                v4u x; x.x = pkbf(b0[0], b0[1]); x.y = pkbf(b0[2], b0[3]); x.z = pkbf(b1[0], b1[1]); x.w = pkbf(b1[2], b1[3]); *(v4u*)(rowp + 128) = x; }
    }
};
struct EpiGlu {
    static constexpr bool PERM = true, AFTER_DRAIN = false;
    const bf16* Y; int ldy; bf16* O; int ldo; const float* bias;
    __device__ __forceinline__ void operator()(const f32x4 (&acc)[2][2][4][2], const pg8::Unit& u, int wr, int wc, int fr, int fq) const {
        const int row0 = u.pm * 256 + wr * 64 + fr, col0 = u.pn * 256 + wc * 32 + 8 * fq;
#pragma unroll
        for (int bj = 0; bj < 2; ++bj) {
            const f32x4 b0 = *(const f32x4*)(bias + col0 + bj * 128), b1 = *(const f32x4*)(bias + col0 + bj * 128 + 4);
#pragma unroll
            for (int ai = 0; ai < 2; ++ai)
#pragma unroll
                for (int m = 0; m < 4; ++m) { const size_t r = (size_t)(row0 + ai * 128 + m * 16);
                    const v4u yq = *(const v4u*)(Y + r * ldy + col0 + bj * 128); float y[8]; unpack8(yq, y);
                    const f32x4 v0 = acc[ai][bj][m][0] + b0, v1 = acc[ai][bj][m][1] + b1; float o[8];
#pragma unroll
                    for (int k = 0; k < 4; ++k) { o[k] = y[k] / (1.0f + __expf(-v0[k])); o[4 + k] = y[4 + k] / (1.0f + __expf(-v1[k])); }
                    *(v4u*)(O + r * ldo + col0 + bj * 128) = pack8(o); }
        }
    }
};
struct EpiScaleBf16 {
    static constexpr bool PERM = true, AFTER_DRAIN = false;
    bf16* O; int ldo; const float* scale;
    __device__ __forceinline__ void operator()(const f32x4 (&acc)[2][2][4][2], const pg8::Unit& u, int wr, int wc, int fr, int fq) const {
        const int row0 = u.pm * 256 + wr * 64 + fr, col0 = u.pn * 256 + wc * 32 + 8 * fq;
#pragma unroll
        for (int bj = 0; bj < 2; ++bj) {
            const f32x4 s0 = *(const f32x4*)(scale + col0 + bj * 128), s1 = *(const f32x4*)(scale + col0 + bj * 128 + 4);
#pragma unroll
            for (int ai = 0; ai < 2; ++ai)
#pragma unroll
                for (int m = 0; m < 4; ++m) { const size_t r = (size_t)(row0 + ai * 128 + m * 16);
                    const f32x4 v0 = acc[ai][bj][m][0] * s0, v1 = acc[ai][bj][m][1] * s1;
                    v4u w; w.x = pkbf(v0[0], v0[1]); w.y = pkbf(v0[2], v0[3]); w.z = pkbf(v1[0], v1[1]); w.w = pkbf(v1[2], v1[3]);
                    *(v4u*)(O + r * ldo + col0 + bj * 128) = w; }
        }
    }
};
struct EpiResid {
    static constexpr bool PERM = false, AFTER_DRAIN = false;
    float* X; int ldx; float alpha;
    __device__ __forceinline__ void operator()(const f32x4 (&acc)[2][2][4][2], const pg8::Unit& u, int wr, int wc, int fr, int fq) const {
        const int row0 = u.pm * 256 + wr * 64 + fr, col0 = u.pn * 256 + wc * 32 + 4 * fq;
#pragma unroll
        for (int ai = 0; ai < 2; ++ai)
#pragma unroll
            for (int m = 0; m < 4; ++m) { float* rowp = X + (size_t)(row0 + ai * 128 + m * 16) * ldx + col0;
#pragma unroll
                for (int bj = 0; bj < 2; ++bj)
#pragma unroll
                    for (int n = 0; n < 2; ++n) { f32x4* p = (f32x4*)(rowp + bj * 128 + n * 16); const f32x4 x = *p; *p = x * alpha + acc[ai][bj][m][n]; } }
    }
};
struct EpiStoreF32 {
    static constexpr bool PERM = false, AFTER_DRAIN = false;
    float* C; int ldc;
    __device__ __forceinline__ void operator()(const f32x4 (&acc)[2][2][4][2], const pg8::Unit& u, int wr, int wc, int fr, int fq) const {
        const int row0 = u.pm * 256 + wr * 64 + fr, col0 = u.pn * 256 + wc * 32 + 4 * fq;
#pragma unroll
        for (int ai = 0; ai < 2; ++ai)
#pragma unroll
            for (int m = 0; m < 4; ++m) { float* rowp = C + (size_t)(row0 + ai * 128 + m * 16) * ldc + col0;
#pragma unroll
                for (int bj = 0; bj < 2; ++bj)
#pragma unroll
                    for (int n = 0; n < 2; ++n) *(f32x4*)(rowp + bj * 128 + n * 16) = acc[ai][bj][m][n]; }
    }
};

struct Args { const float* in[26]; float* out; unsigned char* ws; int ph_lo, ph_hi, li, pad; };
typedef const Args __attribute__((address_space(4))) CArgs;
struct Frame {
    LAS unsigned char* lds;
    int tid, lane, wave, G, bx;
    int gw, NGW;
    size_t gtid, NT;
    float* out; unsigned char* ws;
};
enum InIdx { I_XP = 0, I_XS, I_LNIN_G, I_LNIN_B, I_WIN, I_LAMRE, I_LAMIM, I_LOGSTEP, I_BRE, I_BIM, I_CRE, I_CIM, I_S5D, I_WGLU, I_BGLU, I_POOLW, I_POOLS,
             I_WOUT, I_LN1G, I_LN1B, I_WQ, I_KEYS, I_PU, I_PV, I_LN2G, I_LN2B };

__device__ __forceinline__ void ln_row(const float* src, const float* g, const float* b, float* dst, bf16* dstb, int lane) {
    f32x4 v[8]; float s = 0.f;
#pragma unroll
    for (int j = 0; j < 8; ++j) { v[j] = ((const f32x4*)src)[lane + 64 * j]; s += (v[j][0] + v[j][1]) + (v[j][2] + v[j][3]); }
    const float mean = wave_sum(s) * (1.0f / DM); float s2 = 0.f;
#pragma unroll
    for (int j = 0; j < 8; ++j) { v[j] = v[j] - mean; s2 += (v[j][0] * v[j][0] + v[j][1] * v[j][1]) + (v[j][2] * v[j][2] + v[j][3] * v[j][3]); }
    const float rstd = 1.0f / sqrtf(wave_sum(s2) * (1.0f / DM) + LN_EPS);
#pragma unroll
    for (int j = 0; j < 8; ++j) { const f32x4 gg = ((const f32x4*)g)[lane + 64 * j], bb = ((const f32x4*)b)[lane + 64 * j];
        const f32x4 o = v[j] * rstd * gg + bb; ((f32x4*)dst)[lane + 64 * j] = o;
        v2u w; w.x = pkbf(o[0], o[1]); w.y = pkbf(o[2], o[3]); ((v2u*)dstb)[lane + 64 * j] = w; }
}

__device__ __forceinline__ void ln_rows2(float* X, const bf16* MIX, float alpha, const float* g, const float* b, bf16* XB, int gw, int ngw, int lane) {
    for (int t = gw; t < NTOK; t += 2 * ngw) {
        const int t2 = t + ngw; const bool has2 = t2 < NTOK; const int tb = has2 ? t2 : t;
        float* r0 = X + (size_t)t * DM; float* r1 = X + (size_t)tb * DM;
        f32x4 v0[8], v1[8]; v2u m0q[8], m1q[8]; float s0 = 0.f, s1 = 0.f;
#pragma unroll
        for (int j = 0; j < 8; ++j) { v0[j] = ((const f32x4*)r0)[lane + 64 * j]; m0q[j] = ((const v2u*)(MIX + (size_t)t * DM))[lane + 64 * j]; }
#pragma unroll
        for (int j = 0; j < 8; ++j) { v1[j] = ((const f32x4*)r1)[lane + 64 * j]; m1q[j] = ((const v2u*)(MIX + (size_t)tb * DM))[lane + 64 * j]; }
#pragma unroll
        for (int j = 0; j < 8; ++j) {
            v0[j] = v0[j] * alpha + (f32x4){bf_lo(m0q[j].x), bf_hi(m0q[j].x), bf_lo(m0q[j].y), bf_hi(m0q[j].y)}; v1[j] = v1[j] * alpha + (f32x4){bf_lo(m1q[j].x), bf_hi(m1q[j].x), bf_lo(m1q[j].y), bf_hi(m1q[j].y)};
            s0 += (v0[j][0] + v0[j][1]) + (v0[j][2] + v0[j][3]); s1 += (v1[j][0] + v1[j][1]) + (v1[j][2] + v1[j][3]); }
        const float m0 = wave_sum(s0) * (1.0f / DM), m1 = wave_sum(s1) * (1.0f / DM); float q0 = 0.f, q1 = 0.f;
#pragma unroll
        for (int j = 0; j < 8; ++j) { v0[j] = v0[j] - m0; v1[j] = v1[j] - m1;
            q0 += (v0[j][0] * v0[j][0] + v0[j][1] * v0[j][1]) + (v0[j][2] * v0[j][2] + v0[j][3] * v0[j][3]); q1 += (v1[j][0] * v1[j][0] + v1[j][1] * v1[j][1]) + (v1[j][2] * v1[j][2] + v1[j][3] * v1[j][3]); }
        const float rs0 = 1.0f / sqrtf(wave_sum(q0) * (1.0f / DM) + LN_EPS), rs1 = 1.0f / sqrtf(wave_sum(q1) * (1.0f / DM) + LN_EPS);
#pragma unroll
        for (int j = 0; j < 8; ++j) { const f32x4 gg = ((const f32x4*)g)[lane + 64 * j], bb = ((const f32x4*)b)[lane + 64 * j];
            const f32x4 o0 = v0[j] * rs0 * gg + bb; ((f32x4*)r0)[lane + 64 * j] = o0;
            v2u w0; w0.x = pkbf(o0[0], o0[1]); w0.y = pkbf(o0[2], o0[3]); ((v2u*)(XB + (size_t)t * DM))[lane + 64 * j] = w0;
            if (has2) { const f32x4 o1 = v1[j] * rs1 * gg + bb; ((f32x4*)r1)[lane + 64 * j] = o1;
                v2u w1; w1.x = pkbf(o1[0], o1[1]); w1.y = pkbf(o1[2], o1[3]); ((v2u*)(XB + (size_t)t2 * DM))[lane + 64 * j] = w1; } }
    }
}

__device__ __forceinline__ void transpose_item(const float* W, int K, int N, bf16* WT, LAS float* scr, int item, int lane) {
    const int nblk = N / 32, kb = item / nblk, nb = item % nblk, k0 = 64 * kb, n0 = 32 * nb;
#pragma unroll 8
    for (int i = 0; i < 32; ++i) { const int kk = 2 * i + (lane >> 5); scr[kk * 33 + (lane & 31)] = W[(size_t)(k0 + kk) * N + n0 + (lane & 31)]; }
    LDS_WAIT();
    const int c = lane & 7;
#pragma unroll
    for (int j = 0; j < 4; ++j) { const int n = (lane >> 3) + 8 * j; const LAS float* s = scr + (8 * c) * 33 + n;
        v4u o; o.x = pkbf(s[0 * 33], s[1 * 33]); o.y = pkbf(s[2 * 33], s[3 * 33]); o.z = pkbf(s[4 * 33], s[5 * 33]); o.w = pkbf(s[6 * 33], s[7 * 33]);
        *(v4u*)(WT + (size_t)(n0 + n) * K + k0 + 8 * c) = o; }
    LDS_WAIT();
}

__device__ __forceinline__ void p0_prologue(const Frame& F, CArgs& A) {
    {
        LAS float* scr = (LAS float*)(F.lds + F.wave * 16384);
        constexpr int I_IN = (DM / 64) * (INW / 32), I_OUT = (DM / 64) * (DM / 32), I_GLU = (512 / 64) * (512 / 32);
        constexpr int NITEMS = NLAYER * (I_IN + I_OUT + I_GLU);
        for (int it = F.gw; it < NITEMS; it += F.NGW) {
            int r = it;
            if (r < NLAYER * I_IN) { const int l = r / I_IN; transpose_item(A.in[I_WIN] + (size_t)l * DM * INW, DM, INW, (bf16*)(F.ws + WS_WIN) + (size_t)l * INW * DM, scr, r % I_IN, F.lane); continue; }
            r -= NLAYER * I_IN;
            if (r < NLAYER * I_OUT) { const int l = r / I_OUT; transpose_item(A.in[I_WOUT] + (size_t)l * DM * DM, DM, DM, (bf16*)(F.ws + WS_WOUT) + (size_t)l * DM * DM, scr, r % I_OUT, F.lane); continue; }
            r -= NLAYER * I_OUT;
            { const int l = r / I_GLU; transpose_item(A.in[I_WGLU] + (size_t)l * 512 * 512, 512, 512, (bf16*)(F.ws + WS_WGLU) + (size_t)l * 512 * 512, scr, r % I_GLU, F.lane); }
        }
    }
#if PEER_FP4
    {
        const int NR2 = 2 * NLAYER * NEXP;
        for (int r = F.gw; r < NR2; r += 2 * F.NGW) {
            const int r2 = r + F.NGW < NR2 ? r + F.NGW : r;
            const int tabA = r >= NLAYER * NEXP, riA = tabA ? r - NLAYER * NEXP : r, tabB = r2 >= NLAYER * NEXP, riB = tabB ? r2 - NLAYER * NEXP : r2;
            const float* srcA = (tabA ? A.in[I_PV] : A.in[I_PU]) + (size_t)riA * DM + F.lane * 4; const float* srcB = (tabB ? A.in[I_PV] : A.in[I_PU]) + (size_t)riB * DM + F.lane * 4;
            f32x4 va[8], vb[8]; float ama = 0.f, amb = 0.f;
#pragma unroll
            for (int q = 0; q < 8; ++q) va[q] = *(const f32x4*)(srcA + q * 256);
#pragma unroll
            for (int q = 0; q < 8; ++q) vb[q] = *(const f32x4*)(srcB + q * 256);
#pragma unroll
            for (int q = 0; q < 8; ++q) { ama = fmaxf(ama, fmaxf(fmaxf(fabsf(va[q][0]), fabsf(va[q][1])), fmaxf(fabsf(va[q][2]), fabsf(va[q][3])))); amb = fmaxf(amb, fmaxf(fmaxf(fabsf(vb[q][0]), fabsf(vb[q][1])), fmaxf(fabsf(vb[q][2]), fabsf(vb[q][3])))); }
#pragma unroll
            for (int o = 1; o < 64; o <<= 1) { ama = fmaxf(ama, __shfl_xor(ama, o)); amb = fmaxf(amb, __shfl_xor(amb, o)); }
#pragma unroll
            for (int half = 0; half < 2; ++half) {
                if (half == 1 && r2 == r) break;
                const float am = half ? amb : ama; const int tab = half ? tabB : tabA, ri = half ? riB : riA;
                const float sc = am > 0.f ? 6.0f / am : 1.0f, isc = am > 0.f ? am * (1.0f / 6.0f) : 1.0f;
                v4u w;
#pragma unroll
                for (int q = 0; q < 4; ++q) { const f32x4 e0 = half ? vb[2 * q] : va[2 * q], e1 = half ? vb[2 * q + 1] : va[2 * q + 1]; unsigned pk = 0u;
                    pk = __builtin_amdgcn_cvt_scalef32_pk_fp4_f32(pk, e0[0] * sc, e0[1] * sc, 1.0f, 0); pk = __builtin_amdgcn_cvt_scalef32_pk_fp4_f32(pk, e0[2] * sc, e0[3] * sc, 1.0f, 1);
                    pk = __builtin_amdgcn_cvt_scalef32_pk_fp4_f32(pk, e1[0] * sc, e1[1] * sc, 1.0f, 2); pk = __builtin_amdgcn_cvt_scalef32_pk_fp4_f32(pk, e1[2] * sc, e1[3] * sc, 1.0f, 3);
                    w[q] = pk; }
                *(v4u*)(F.ws + (tab ? WS_V8 : WS_U8) + (size_t)ri * (DM / 2) + F.lane * 16) = w;
                if (F.lane == 0) ((float*)(F.ws + (tab ? WS_VSC : WS_USC)))[ri] = isc;
            }
        }
    }
#else
    {
        for (int r = F.gw; r < 2 * NLAYER * NEXP; r += F.NGW) {
            const int tab = r >= NLAYER * NEXP, ri = tab ? r - NLAYER * NEXP : r;
            const float* src = (tab ? A.in[I_PV] : A.in[I_PU]) + (size_t)ri * DM;
            f32x4 v[2][4]; float am = 0.f;
#pragma unroll
            for (int c = 0; c < 2; ++c)
#pragma unroll
                for (int q = 0; q < 4; ++q) { v[c][q] = *(const f32x4*)(src + (c * 64 + F.lane) * 16 + q * 4);
                    am = fmaxf(am, fmaxf(fmaxf(fabsf(v[c][q][0]), fabsf(v[c][q][1])), fmaxf(fabsf(v[c][q][2]), fabsf(v[c][q][3])))); }
#pragma unroll
            for (int o = 1; o < 64; o <<= 1) am = fmaxf(am, __shfl_xor(am, o));
            const float sc = am > 0.f ? 384.0f / am : 1.0f, isc = am > 0.f ? am * (1.0f / 384.0f) : 1.0f;
            unsigned char* dst = F.ws + (tab ? WS_V8 : WS_U8) + (size_t)ri * DM;
#pragma unroll
            for (int c = 0; c < 2; ++c) { v4u w;
#pragma unroll
                for (int q = 0; q < 4; ++q) { int pk = 0; pk = __builtin_amdgcn_cvt_pk_fp8_f32(v[c][q][0] * sc, v[c][q][1] * sc, pk, false); pk = __builtin_amdgcn_cvt_pk_fp8_f32(v[c][q][2] * sc, v[c][q][3] * sc, pk, true); w[q] = (unsigned)pk; }
                *(v4u*)(dst + (c * 64 + F.lane) * 16) = w; }
            if (F.lane == 0) ((float*)(F.ws + (tab ? WS_VSC : WS_USC)))[ri] = isc;
        }
    }
#endif
    {
        const float* pw = A.in[I_POOLW]; v4u* dst = (v4u*)(F.ws + WS_WPOOL);
        for (size_t i = F.gtid; i < (size_t)NLAYER * 512 * 64; i += F.NT) {
            const int k8 = (int)(i & 63), n = (int)((i >> 6) & 511), l = (int)(i >> 15);
            const int g = n >> 7, d = n & 127, kg = k8 >> 4, c0 = (k8 & 15) * 8;
            float f[8];
#pragma unroll
            for (int k = 0; k < 8; ++k) f[k] = (kg == g) ? pw[(((size_t)l * 4 + g) * 128 + (c0 + k)) * 128 + d] : 0.f;
            dst[i] = pack8(f);
        }
    }
    {
        const float* lre = A.in[I_LAMRE]; const float* lim = A.in[I_LAMIM]; const float* lst = A.in[I_LOGSTEP]; const float* bre = A.in[I_BRE]; const float* bim = A.in[I_BIM];
        f32x2v* ab = (f32x2v*)(F.ws + WS_S5A); f32x2v* ab64 = (f32x2v*)(F.ws + WS_S5A + 512 * 1024); f32x2v* bb = (f32x2v*)(F.ws + WS_S5B);
        for (size_t i = F.gtid; i < (size_t)NLAYER * 2 * 32 * 64; i += F.NT) {
            const float lr = lre[i], li = lim[i], dt = expf(lst[i >> 6]);
            const float mag = expf(lr * dt), ar = mag * cosf(li * dt), ai = mag * sinf(li * dt);
            const float den = lr * lr + li * li;
            const float zr = ((ar - 1.0f) * lr + ai * li) / den, zi = (ai * lr - (ar - 1.0f) * li) / den;
            ab[i] = (f32x2v){ar, ai};
            const float m64 = expf(lr * dt * 64.0f), an = li * dt * 64.0f;
            ab64[i] = (f32x2v){m64 * cosf(an), m64 * sinf(an)};
#pragma unroll
            for (int c = 0; c < 16; ++c) { const float br = bre[i * 16 + c], bi = bim[i * 16 + c]; bb[i * 16 + c] = (f32x2v){zr * br - zi * bi, zr * bi + zi * br}; }
            {
                bf16* o = (bf16*)(F.ws + WS_S5BB) + ((size_t)(i >> 6) * 128 + 2 * (i & 63)) * 32;
#pragma unroll
                for (int c = 0; c < 16; ++c) { const float br = bre[i * 16 + c], bi = bim[i * 16 + c]; o[c] = f2bf(zr * br - zi * bi); o[32 + c] = f2bf(zr * bi + zi * br); o[16 + c] = 0; o[48 + c] = 0; }
            }
        }
    }
    {
        float* rc = (float*)(F.ws + WS_ROTC); float* rs = (float*)(F.ws + WS_ROTS);
        for (size_t i = F.gtid; i < (size_t)8192 * 128; i += F.NT) { const float inv = (float)exp(-(double)(i & 127) / 127.0 * 9.210340371976184); const float ang = (float)(i >> 7) * inv; rc[i] = cosf(ang); rs[i] = sinf(ang); }
    }
    __syncthreads();
    {
        LAS float* KS = (LAS float*)F.lds;
        LAS float* WQ = (LAS float*)(F.lds + 128 * 132 * 4);
        const float* keys = A.in[I_KEYS]; const float* wq = A.in[I_WQ]; bf16* wst = (bf16*)(F.ws + WS_WS);
        for (int u = F.bx; u < NLAYER * 16 * 32; u += F.G) {
            const int dtl = u & 31, hp = (u >> 5) & 15, l = u >> 9, p = hp & 1;
#pragma unroll
            for (int r = 0; r < 8; ++r) { const int f = F.tid + 512 * r, nk = f >> 5, c4 = f & 31;
                *(LAS f32x4*)(KS + nk * 132 + c4 * 4) = *(const f32x4*)(keys + (((size_t)l * 2 + p) * 128 + nk) * 128 + c4 * 4); }
#pragma unroll
            for (int r = 0; r < 4; ++r) { const int f = F.tid + 512 * r, dd = f >> 5, c4 = f & 31;
                *(LAS f32x4*)(WQ + dd * 132 + c4 * 4) = *(const f32x4*)(wq + ((size_t)l * DM + dtl * 64 + dd) * DM + hp * 128 + c4 * 4); }
            __syncthreads();
            const int nk = F.tid & 127, dg = F.tid >> 7;
            float acc[16];
#pragma unroll
            for (int i = 0; i < 16; ++i) acc[i] = 0.f;
            for (int c4 = 0; c4 < 32; ++c4) {
                const f32x4 kv = *(const LAS f32x4*)(KS + nk * 132 + c4 * 4);
#pragma unroll
                for (int i = 0; i < 16; ++i) { const f32x4 wv = *(const LAS f32x4*)(WQ + (dg * 16 + i) * 132 + c4 * 4);
                    acc[i] += (kv[0] * wv[0] + kv[1] * wv[1]) + (kv[2] * wv[2] + kv[3] * wv[3]); }
            }
            bf16* o = wst + ((size_t)l * DM + hp * 128 + nk) * DM + dtl * 64 + dg * 16;
            v4u q0, q1; q0.x = pkbf(acc[0], acc[1]); q0.y = pkbf(acc[2], acc[3]); q0.z = pkbf(acc[4], acc[5]); q0.w = pkbf(acc[6], acc[7]);
            q1.x = pkbf(acc[8], acc[9]); q1.y = pkbf(acc[10], acc[11]); q1.z = pkbf(acc[12], acc[13]); q1.w = pkbf(acc[14], acc[15]);
            *(v4u*)o = q0; *(v4u*)(o + 8) = q1;
            __syncthreads();
        }
    }
    {
        const float* xp = A.in[I_XP]; const float* xs = A.in[I_XS]; const float* g = A.in[I_LNIN_G]; const float* b = A.in[I_LNIN_B]; bf16* XB = (bf16*)(F.ws + WS_XN);
        for (int t = F.gw; t < NTOK; t += 2 * F.NGW) {
            const int t2 = t + F.NGW; const bool has2 = t2 < NTOK; const int tb = has2 ? t2 : t;
            const float* s0p = t < 32768 ? xp + (size_t)t * DM : xs + (size_t)(t - 32768) * DM; const float* s1p = tb < 32768 ? xp + (size_t)tb * DM : xs + (size_t)(tb - 32768) * DM;
            f32x4 v0[8], v1[8]; float s0 = 0.f, s1 = 0.f;
#pragma unroll
            for (int j = 0; j < 8; ++j) v0[j] = ((const f32x4*)s0p)[F.lane + 64 * j];
#pragma unroll
            for (int j = 0; j < 8; ++j) v1[j] = ((const f32x4*)s1p)[F.lane + 64 * j];
#pragma unroll
            for (int j = 0; j < 8; ++j) { s0 += (v0[j][0] + v0[j][1]) + (v0[j][2] + v0[j][3]); s1 += (v1[j][0] + v1[j][1]) + (v1[j][2] + v1[j][3]); }
            const float m0 = wave_sum(s0) * (1.0f / DM), m1 = wave_sum(s1) * (1.0f / DM); float q0 = 0.f, q1 = 0.f;
#pragma unroll
            for (int j = 0; j < 8; ++j) { v0[j] = v0[j] - m0; v1[j] = v1[j] - m1;
                q0 += (v0[j][0] * v0[j][0] + v0[j][1] * v0[j][1]) + (v0[j][2] * v0[j][2] + v0[j][3] * v0[j][3]); q1 += (v1[j][0] * v1[j][0] + v1[j][1] * v1[j][1]) + (v1[j][2] * v1[j][2] + v1[j][3] * v1[j][3]); }
            const float rs0 = 1.0f / sqrtf(wave_sum(q0) * (1.0f / DM) + LN_EPS), rs1 = 1.0f / sqrtf(wave_sum(q1) * (1.0f / DM) + LN_EPS);
#pragma unroll
            for (int j = 0; j < 8; ++j) { const f32x4 gg = ((const f32x4*)g)[F.lane + 64 * j], bb = ((const f32x4*)b)[F.lane + 64 * j];
                const f32x4 o0 = v0[j] * rs0 * gg + bb; ((f32x4*)(F.out + (size_t)t * DM))[F.lane + 64 * j] = o0;
                v2u w0; w0.x = pkbf(o0[0], o0[1]); w0.y = pkbf(o0[2], o0[3]); ((v2u*)(XB + (size_t)t * DM))[F.lane + 64 * j] = w0;
                if (has2) { const f32x4 o1 = v1[j] * rs1 * gg + bb; ((f32x4*)(F.out + (size_t)t2 * DM))[F.lane + 64 * j] = o1;
                    v2u w1; w1.x = pkbf(o1[0], o1[1]); w1.y = pkbf(o1[2], o1[3]); ((v2u*)(XB + (size_t)t2 * DM))[F.lane + 64 * j] = w1; } }
        }
    }
}

__device__ __forceinline__ float ret_log2_gamma(int h) { return log2f(1.0f - exp2f(-5.0f - (float)h)); }

__device__ __forceinline__ void s5_pass1(const Frame& F, CArgs& A, int l) {
    LAS float* BUs = (LAS float*)(F.lds + F.wave * 8448);
    const bf16* H = (const bf16*)(F.ws + WS_H);
    const f32x2v* ab = (const f32x2v*)(F.ws + WS_S5A); const bf16* BB = (const bf16*)(F.ws + WS_S5BB);
    f32x2v* st = (f32x2v*)(F.ws + WS_S5ST);
    const int lane = F.lane, lr = lane & 15, lq = lane >> 4;
    const int gstep = F.G < 32 ? F.G : 32;
    for (int g = F.bx % 32; g < 32; g += gstep) {
        const int nwg = F.G < 32 ? 1 : (F.G - g + 31) / 32, rank = F.G < 32 ? 0 : F.bx / 32;
        bf16x8 Bop[2][8]; f32x2v a2[2], arot[2];
#pragma unroll
        for (int dir = 0; dir < 2; ++dir) { const int gi = (l * 2 + dir) * 32 + g; a2[dir] = ab[gi * 64 + lane]; arot[dir] = (f32x2v){-a2[dir][1], a2[dir][1]};
#pragma unroll
            for (int j = 0; j < 8; ++j) Bop[dir][j] = *(const bf16x8*)(BB + ((size_t)gi * 128 + 16 * j + lr) * 32 + lq * 8); }
        for (int ck = rank * NWAVES + F.wave; ck < 640; ck += nwg * NWAVES) {
            bf16x8 uop[4];
#pragma unroll
            for (int tb = 0; tb < 4; ++tb) { const v4u q = lq < 2 ? *(const v4u*)(H + (size_t)(ck * 64 + 16 * tb + lr) * INW + COL_UA + g * 16 + lq * 8) : (v4u){0u, 0u, 0u, 0u}; uop[tb] = __builtin_bit_cast(bf16x8, q); }
#pragma unroll
            for (int dir = 0; dir < 2; ++dir) {
                f32x2v x2 = (f32x2v){0.f, 0.f};
#pragma unroll
                for (int blk = 0; blk < 4; ++blk) {
                    const int tb = dir ? 3 - blk : blk;
#pragma unroll
                    for (int j = 0; j < 8; ++j) { const f32x4 d = MFMA16(Bop[dir][j], uop[tb], ((f32x4){0.f, 0.f, 0.f, 0.f}));
                        *(LAS f32x4*)(BUs + lr * 132 + 16 * j + 4 * lq) = d; }
                    LDS_WAIT();
#pragma unroll
                    for (int s = 0; s < 16; ++s) { const int tl = dir ? 15 - s : s;
                        const f32x2v bu = *(const LAS f32x2v*)(BUs + tl * 132 + 2 * lane);
                        x2 = x2 * a2[dir][0] + (arot[dir] * (f32x2v){x2[1], x2[0]} + bu); }
                    LDS_WAIT();
                }
                st[(size_t)((ck * 32 + g) * 2 + dir) * 64 + lane] = x2;
            }
        }
    }
}
__device__ __forceinline__ void s5_carry(const Frame& F, CArgs& A, int l) {
    const f32x2v* ab64 = (const f32x2v*)(F.ws + WS_S5A + 512 * 1024); f32x2v* st = (f32x2v*)(F.ws + WS_S5ST);
    for (size_t it = F.gtid; it < (size_t)9 * 32 * 2 * 64; it += F.NT) {
        const int p = (int)(it & 63), dir = (int)((it >> 6) & 1), g = (int)((it >> 7) & 31), s = (int)(it >> 12);
        const int ck0 = s < 8 ? s * 64 : 512, n = s < 8 ? 64 : 128;
        const f32x2v a = ab64[((l * 2 + dir) * 32 + g) * 64 + p];
        float cr = 0.f, ci = 0.f;
        for (int k0 = 0; k0 < n; k0 += 8) {
            f32x2v le[8];
#pragma unroll
            for (int kk = 0; kk < 8; ++kk) { const int ck = dir ? (ck0 + n - 1 - (k0 + kk)) : (ck0 + k0 + kk); le[kk] = st[(size_t)((ck * 32 + g) * 2 + dir) * 64 + p]; }
#pragma unroll
            for (int kk = 0; kk < 8; ++kk) { const int ck = dir ? (ck0 + n - 1 - (k0 + kk)) : (ck0 + k0 + kk);
                st[(size_t)((ck * 32 + g) * 2 + dir) * 64 + p] = (f32x2v){cr, ci};
                const float ncr = a[0] * cr - a[1] * ci + le[kk][0], nci = a[0] * ci + a[1] * cr + le[kk][1]; cr = ncr; ci = nci; }
        }
    }
}
__device__ __forceinline__ void s5_pass3(const Frame& F, CArgs& A, int l) {
    LAS bf16* CtS = (LAS bf16*)F.lds;
    LAS unsigned char* wb = F.lds + 8704 + F.wave * 12800;
    LAS float* BUs = (LAS float*)wb;
    LAS bf16* Xw = (LAS bf16*)(wb + 8448);
    const bf16* H = (const bf16*)(F.ws + WS_H); bf16* BY = (bf16*)(F.ws + WS_BUFY);
    const f32x2v* ab = (const f32x2v*)(F.ws + WS_S5A); const bf16* BB = (const bf16*)(F.ws + WS_S5BB);
    const f32x2v* st = (const f32x2v*)(F.ws + WS_S5ST);
    const float* cre = A.in[I_CRE]; const float* cim = A.in[I_CIM]; const float* dvec = A.in[I_S5D] + (size_t)l * 512;
    const int lane = F.lane, lr = lane & 15, lq = lane >> 4;
    const int gstep = F.G < 32 ? F.G : 32;
    for (int g = F.bx % 32; g < 32; g += gstep) {
        const int nwg = F.G < 32 ? 1 : (F.G - g + 31) / 32, rank = F.G < 32 ? 0 : F.bx / 32;
        __syncthreads();
        {
            const int tq = opaque(F.tid);
#pragma unroll
            for (int r = 0; r < 8; ++r) { const int e = tq + 512 * r, pp = e & 127, c = (e >> 7) & 15, dir = e >> 11;
                const size_t cb = (size_t)(((l * 2 + dir) * 32 + g) * 16 + c) * 64;
                CtS[(dir * 16 + c) * 136 + pp] = f2bf(pp < 64 ? cre[cb + pp] : -cim[cb + pp - 64]); }
        }
        bf16x8 Bop[2][8]; f32x2v a2[2], arot[2];
#pragma unroll
        for (int dir = 0; dir < 2; ++dir) { const int gi = (l * 2 + dir) * 32 + g; a2[dir] = ab[gi * 64 + lane]; arot[dir] = (f32x2v){-a2[dir][1], a2[dir][1]};
#pragma unroll
            for (int j = 0; j < 8; ++j) Bop[dir][j] = *(const bf16x8*)(BB + ((size_t)gi * 128 + 16 * j + lr) * 32 + lq * 8); }
        __syncthreads();
        for (int ck = rank * NWAVES + F.wave; ck < 640; ck += nwg * NWAVES) {
            bf16x8 uop[4];
#pragma unroll
            for (int tb = 0; tb < 4; ++tb) { const v4u q = lq < 2 ? *(const v4u*)(H + (size_t)(ck * 64 + 16 * tb + lr) * INW + COL_UA + g * 16 + lq * 8) : (v4u){0u, 0u, 0u, 0u}; uop[tb] = __builtin_bit_cast(bf16x8, q); }
            f32x2v xin[2];
#pragma unroll
            for (int dir = 0; dir < 2; ++dir) xin[dir] = st[(size_t)((ck * 32 + g) * 2 + dir) * 64 + lane];
            f32x4 Y[4];
#pragma unroll
            for (int m = 0; m < 4; ++m) Y[m] = (f32x4){0.f, 0.f, 0.f, 0.f};
#pragma unroll
            for (int dir = 0; dir < 2; ++dir) {
                f32x2v x2 = xin[dir];
#pragma unroll
                for (int blk = 0; blk < 4; ++blk) {
                    const int tb = dir ? 3 - blk : blk;
#pragma unroll
                    for (int j = 0; j < 8; ++j) { const f32x4 d = MFMA16(Bop[dir][j], uop[tb], ((f32x4){0.f, 0.f, 0.f, 0.f}));
                        *(LAS f32x4*)(BUs + lr * 132 + 16 * j + 4 * lq) = d; }
                    LDS_WAIT();
#pragma unroll
                    for (int s = 0; s < 16; ++s) { const int tl = dir ? 15 - s : s;
                        const f32x2v bu = *(const LAS f32x2v*)(BUs + tl * 132 + 2 * lane);
                        x2 = x2 * a2[dir][0] + (arot[dir] * (f32x2v){x2[1], x2[0]} + bu);
                        Xw[tl * 136 + lane] = f2bf(x2[0]); Xw[tl * 136 + 64 + lane] = f2bf(x2[1]); }
                    LDS_WAIT();
#pragma unroll
                    for (int ks = 0; ks < 4; ++ks) {
                        const bf16x8 av = *(const LAS bf16x8*)(CtS + (dir * 16 + lr) * 136 + 32 * ks + lq * 8);
                        const bf16x8 bv = *(const LAS bf16x8*)(Xw + lr * 136 + 32 * ks + lq * 8);
                        Y[tb] = MFMA16(av, bv, Y[tb]);
                    }
                    LDS_WAIT();
                }
            }
#pragma unroll
            for (int m = 0; m < 4; ++m) {
                const int t = 16 * m + lr, c0 = 4 * lq;
                const v2u uq = *(const v2u*)(H + (size_t)(ck * 64 + t) * INW + COL_UA + g * 16 + c0);
                const f32x4 uv = (f32x4){bf_lo(uq.x), bf_hi(uq.x), bf_lo(uq.y), bf_hi(uq.y)}; const f32x4 dv = *(const f32x4*)(dvec + g * 16 + c0);
                const f32x4 y = Y[m] + dv * uv;
                v2u w; w.x = pkbf(gelu_erf(y[0]), gelu_erf(y[1])); w.y = pkbf(gelu_erf(y[2]), gelu_erf(y[3]));
                *(v2u*)(BY + (size_t)(ck * 64 + t) * 512 + g * 16 + c0) = w;
            }
        }
    }
}
__device__ __forceinline__ void pool_phase(const Frame& F, CArgs& A) {
    const bf16* H = (const bf16*)(F.ws + WS_H); bf16* BP = (bf16*)(F.ws + WS_BUFP);
    for (size_t it = F.gtid; it < (size_t)NTOK * 64; it += F.NT) {
        const int t = (int)(it >> 6), o = (int)(it & 63), gi = o >> 4, w = 2 << gi;
        const int pos = tok_pos(t), L = tok_len(t);
        const int lo = max(pos - w / 2, 0), hi = min(pos + w / 2 - 1, L - 1);
        const bf16* base = H + (size_t)(t - pos) * INW + COL_UB + o * 8;
        float s[8];
#pragma unroll
        for (int k = 0; k < 8; ++k) s[k] = 0.f;
        v4u wq[16];
#pragma unroll
        for (int i = 0; i < 16; ++i) { const int si = lo + i <= hi ? lo + i : hi; wq[i] = *(const v4u*)(base + (size_t)si * INW); }
#pragma unroll
        for (int i = 0; i < 16; ++i) { float f[8]; unpack8(wq[i], f); const float wgt = lo + i <= hi ? 1.0f : 0.0f;
#pragma unroll
            for (int k = 0; k < 8; ++k) s[k] += wgt * f[k]; }
        const float inv = 1.0f / (float)(hi - lo + 1);
        float c[8]; unpack8(*(const v4u*)(base + (size_t)pos * INW), c);
#pragma unroll
        for (int k = 0; k < 8; ++k) s[k] = s[k] * inv - c[k];
        *(v4u*)(BP + (size_t)t * 512 + o * 8) = pack8(s);
    }
}
__device__ __forceinline__ void rotary_phase(const Frame& F, CArgs& A) {
    bf16* H = (bf16*)(F.ws + WS_H); const float* rot = (const float*)(F.ws + WS_ROT);
    for (size_t it = F.gtid; it < (size_t)NTOK * 16; it += F.NT) {
        const int t = (int)(it >> 4), o = (int)(it & 15); const float pos = (float)tok_pos(t);
        float cs[8], sn[8];
#pragma unroll
        for (int k = 0; k < 8; ++k) { const float ang = pos * rot[o * 8 + k]; cs[k] = cosf(ang); sn[k] = sinf(ang); }
#pragma unroll
        for (int which = 0; which < 2; ++which) {
            const float sc = which ? 0.0625f : 1.0f;
#pragma unroll
            for (int hd = 0; hd < 4; ++hd) {
                bf16* p1 = H + (size_t)t * INW + (which ? COL_K : COL_Q) + hd * 256 + o * 8; bf16* p2 = p1 + 128;
                float x1[8], x2[8], o1[8], o2[8]; unpack8(*(const v4u*)p1, x1); unpack8(*(const v4u*)p2, x2);
#pragma unroll
                for (int k = 0; k < 8; ++k) { o1[k] = (x1[k] * cs[k] - x2[k] * sn[k]) * sc; o2[k] = (x2[k] * cs[k] + x1[k] * sn[k]) * sc; }
                *(v4u*)p1 = pack8(o1); *(v4u*)p2 = pack8(o2);
            }
        }
    }
}
constexpr int RS = 136;
template <int MODE = 0> __device__ __forceinline__ void ret_state_phase(const Frame& F, CArgs& A) {
    const bf16* H = (const bf16*)(F.ws + WS_H); bf16* STF = (bf16*)(F.ws + WS_STF); bf16* STB = (bf16*)(F.ws + WS_STB);
    LAS bf16* Kt = (LAS bf16*)F.lds; LAS bf16* VtF = Kt + 128 * RS; LAS bf16* VtB = Kt + 256 * RS;
    LAS unsigned* Kt32 = (LAS unsigned*)Kt; LAS unsigned* VtF32 = (LAS unsigned*)VtF; LAS unsigned* VtB32 = (LAS unsigned*)VtB;
    const int tid = F.tid, lane = F.lane, lr = lane & 15, lq = lane >> 4, we = F.wave >> 1, wd = F.wave & 1;
    const int jp = tid & 63, j = 2 * jp, pc0 = tid >> 6;
    v4u pk0[2], pk1[2], pv0[2], pv1[2];
#define RS_LOAD(u_) do { const int dh_ = (u_) & 1, eh_ = ((u_) >> 1) & 1, h_ = ((u_) >> 2) & 3, c_ = (u_) >> 4; \
        const bf16* krow_ = H + (size_t)(c_ * 128 + j) * INW + COL_K + h_ * 256 + dh_ * 128; const bf16* vrow_ = H + (size_t)(c_ * 128 + j) * INW + COL_V + h_ * 256 + eh_ * 128; \
        _Pragma("unroll") for (int r = 0; r < 2; ++r) { const int pc = pc0 + 8 * r; pk0[r] = *(const v4u*)(krow_ + pc * 8); pk1[r] = *(const v4u*)(krow_ + INW + pc * 8); pv0[r] = *(const v4u*)(vrow_ + pc * 8); pv1[r] = *(const v4u*)(vrow_ + INW + pc * 8); } } while (0)
    if (F.bx < 5120) RS_LOAD(F.bx);
    for (int u = F.bx; u < 5120; u += F.G) {
        const int dh = u & 1, eh = (u >> 1) & 1, h = (u >> 2) & 3, c = u >> 4;
        if (MODE != 2) {
            const float lg = ret_log2_gamma(h), fF0 = exp2f(lg * (float)(127 - j)), fF1 = exp2f(lg * (float)(126 - j)), fB0 = exp2f(lg * (float)j), fB1 = exp2f(lg * (float)(j + 1));
#pragma unroll
            for (int r = 0; r < 2; ++r) {
                const int pc = pc0 + 8 * r;
                const unsigned ka0[4] = {pk0[r].x, pk0[r].y, pk0[r].z, pk0[r].w}, ka1[4] = {pk1[r].x, pk1[r].y, pk1[r].z, pk1[r].w};
                float f0[8], f1[8]; unpack8(pv0[r], f0); unpack8(pv1[r], f1);
#pragma unroll
                for (int i = 0; i < 8; ++i) {
                    const unsigned a = ka0[i >> 1], b = ka1[i >> 1];
                    const unsigned kk = (i & 1) ? ((a >> 16) | (b & 0xffff0000u)) : ((a & 0xffffu) | (b << 16));
                    const int o = ((pc * 8 + i) * RS) / 2 + jp;
                    Kt32[o] = kk; VtF32[o] = pkbf(f0[i] * fF0, f1[i] * fF1); VtB32[o] = pkbf(f0[i] * fB0, f1[i] * fB1);
                }
            }
        }
        __syncthreads();
        if (u + F.G < 5120) RS_LOAD(u + F.G);
        if (MODE == 1) { __syncthreads(); continue; }
        f32x4 aF[4][2], aB[4][2];
#pragma unroll
        for (int td = 0; td < 4; ++td)
#pragma unroll
            for (int te = 0; te < 2; ++te) { aF[td][te] = (f32x4){0.f, 0.f, 0.f, 0.f}; aB[td][te] = (f32x4){0.f, 0.f, 0.f, 0.f}; }
#pragma unroll
        for (int ks = 0; ks < 4; ++ks) {
            bf16x8 ka[4], vF[2], vB[2];
#pragma unroll
            for (int td = 0; td < 4; ++td) ka[td] = *(const LAS bf16x8*)(Kt + (64 * wd + 16 * td + lr) * RS + 32 * ks + lq * 8);
#pragma unroll
            for (int te = 0; te < 2; ++te) { vF[te] = *(const LAS bf16x8*)(VtF + (32 * we + 16 * te + lr) * RS + 32 * ks + lq * 8); vB[te] = *(const LAS bf16x8*)(VtB + (32 * we + 16 * te + lr) * RS + 32 * ks + lq * 8); }
#pragma unroll
            for (int td = 0; td < 4; ++td)
#pragma unroll
                for (int te = 0; te < 2; ++te) { aF[td][te] = MFMA16(ka[td], vF[te], aF[td][te]); aB[td][te] = MFMA16(ka[td], vB[te], aB[td][te]); }
        }
        __syncthreads();
        {
            LAS bf16* OutF = Kt; LAS bf16* OutB = Kt + 128 * RS;
#pragma unroll
            for (int td = 0; td < 4; ++td)
#pragma unroll
                for (int te = 0; te < 2; ++te) {
                    const int e = 32 * we + 16 * te + lr, d = 64 * wd + 16 * td + 4 * lq;
                    v2u w; w.x = pkbf(aF[td][te][0], aF[td][te][1]); w.y = pkbf(aF[td][te][2], aF[td][te][3]); *(LAS v2u*)(OutF + e * RS + d) = w;
                    v2u x; x.x = pkbf(aB[td][te][0], aB[td][te][1]); x.y = pkbf(aB[td][te][2], aB[td][te][3]); *(LAS v2u*)(OutB + e * RS + d) = x;
                }
            __syncthreads();
            const int tq = opaque(tid);
#pragma unroll
            for (int r = 0; r < 8; ++r) { const int f = tq + 512 * r, mat = f >> 11, row = (f >> 4) & 127, pc = f & 15;
                const v4u q = *(const LAS v4u*)(Kt + (mat * 128 + row) * RS + pc * 8);
                bf16* dst = (mat ? STB : STF) + ((size_t)(c * 4 + h) * 256 + eh * 128 + row) * 256 + dh * 128 + pc * 8;
                *(v4u*)dst = q; }
        }
        __syncthreads();
    }
#undef RS_LOAD
}
__device__ __forceinline__ void ret_prefix_phase(const Frame& F, CArgs& A) {
    bf16* STF = (bf16*)(F.ws + WS_STF); bf16* STB = (bf16*)(F.ws + WS_STB);
    for (size_t it = F.gtid; it < (size_t)36 * 2 * 8192; it += F.NT) {
        const int o = (int)(it & 8191), which = (int)((it >> 13) & 1), bh = (int)(it >> 14), h = bh & 3, s = bh >> 2;
        const int c0 = s < 8 ? s * 32 : 256, n = s < 8 ? 32 : 64;
        const float dec = exp2f(128.0f * ret_log2_gamma(h));
        float st[8];
#pragma unroll
        for (int k = 0; k < 8; ++k) st[k] = 0.f;
        bf16* base = (which ? STB : STF) + (size_t)h * 65536 + (size_t)o * 8;
        for (int k0 = 0; k0 < n; k0 += 8) {
            v4u q[8];
#pragma unroll
            for (int kk = 0; kk < 8; ++kk) { const int c = which ? (c0 + n - 1 - (k0 + kk)) : (c0 + k0 + kk); q[kk] = *(const v4u*)(base + (size_t)c * 4 * 65536); }
#pragma unroll
            for (int kk = 0; kk < 8; ++kk) { const int c = which ? (c0 + n - 1 - (k0 + kk)) : (c0 + k0 + kk);
                float f[8]; unpack8(q[kk], f);
#pragma unroll
                for (int i = 0; i < 8; ++i) st[i] = dec * st[i] + f[i];
                *(v4u*)(base + (size_t)c * 4 * 65536) = pack8(st); }
        }
    }
}
__device__ __forceinline__ void ret_out_phase(const Frame& F, CArgs& A) {
    const bf16* H = (const bf16*)(F.ws + WS_H); const bf16* STF = (const bf16*)(F.ws + WS_STF); const bf16* STB = (const bf16*)(F.ws + WS_STB);
    bf16* CC = (bf16*)(F.ws + WS_CONCAT);
    LAS bf16* RA = (LAS bf16*)F.lds; LAS bf16* RB = RA + 128 * RS; LAS bf16* RC = RA + 384 * RS;
    const int tid = F.tid, wi = F.wave >> 2, wj = F.wave & 3, we = F.wave & 3;
    for (int u = F.bx; u < 1280; u += F.G) {
        const int lane = opaque(F.lane), lr = lane & 15, lq = lane >> 4;
        const int h = u & 3, c = u >> 2, t0 = c * 128;
        const int cs = c < 256 ? (c & 31) : (c - 256), ncs = c < 256 ? 32 : 64;
        const bool has_f = cs > 0, has_b = cs < ncs - 1;
        const float lg = ret_log2_gamma(h);
        const int tq = opaque(tid);
        v4u pa[4], pb[8];
#define RO_LOAD_QK(dh_) do { _Pragma("unroll") for (int r = 0; r < 4; ++r) { const int f = tq + 512 * r, row = f >> 4, pc = f & 15; \
            const bf16* src = H + (size_t)(t0 + row) * INW + h * 256 + (dh_) * 128 + pc * 8; pa[r] = *(const v4u*)(src + COL_Q); pb[r] = *(const v4u*)(src + COL_K); } } while (0)
#define RO_STORE_QK() do { _Pragma("unroll") for (int r = 0; r < 4; ++r) { const int f = tq + 512 * r, row = f >> 4, pc = f & 15; \
            *(LAS v4u*)(RA + row * RS + pc * 8) = pa[r]; *(LAS v4u*)(RB + row * RS + pc * 8) = pb[r]; } } while (0)
#define RO_LOAD_V() do { const int jp_ = tq & 63, pc0_ = tq >> 6; const bf16* vrow = H + (size_t)(t0 + 2 * jp_) * INW + COL_V + h * 256; \
            _Pragma("unroll") for (int r = 0; r < 4; ++r) { const int pc = pc0_ + 8 * r; pb[r] = *(const v4u*)(vrow + pc * 8); pb[4 + r] = *(const v4u*)(vrow + INW + pc * 8); } } while (0)
#define RO_STORE_V() do { const int jp_ = tq & 63, pc0_ = tq >> 6; LAS unsigned* RB32 = (LAS unsigned*)RB; \
            _Pragma("unroll") for (int r = 0; r < 4; ++r) { const int pc = pc0_ + 8 * r; \
                const unsigned va0[4] = {pb[r].x, pb[r].y, pb[r].z, pb[r].w}, va1[4] = {pb[4 + r].x, pb[4 + r].y, pb[4 + r].z, pb[4 + r].w}; \
                _Pragma("unroll") for (int i = 0; i < 8; ++i) { const unsigned a = va0[i >> 1], b = va1[i >> 1]; \
                    RB32[((pc * 8 + i) * RS) / 2 + jp_] = (i & 1) ? ((a >> 16) | (b & 0xffff0000u)) : ((a & 0xffffu) | (b << 16)); } } } while (0)
#define RO_LOAD_I(dir_, dh_) do { const bool has_ = (dir_) == 0 ? has_f : has_b; const int cn_ = (dir_) == 0 ? c - 1 : c + 1; \
            const bf16* St = ((dir_) == 0 ? STF : STB) + (size_t)((has_ ? cn_ : c) * 4 + h) * 65536; \
            _Pragma("unroll") for (int r = 0; r < 8; ++r) { const int f = tq + 512 * r, row = f >> 4, pc = f & 15; pb[r] = has_ ? *(const v4u*)(St + (size_t)row * 256 + (dh_) * 128 + pc * 8) : (v4u){0u, 0u, 0u, 0u}; } } while (0)
#define RO_STORE_I(dir_, dh_) do { \
            _Pragma("unroll") for (int r = 0; r < 4; ++r) { const int f = tq + 512 * r, row = f >> 4, pc = f & 15; pa[r] = *(const v4u*)(H + (size_t)(t0 + row) * INW + COL_Q + h * 256 + (dh_) * 128 + pc * 8); } \
            _Pragma("unroll") for (int r = 0; r < 4; ++r) { const int f = tq + 512 * r, row = f >> 4, pc = f & 15; \
                const float fac = exp2f(lg * ((dir_) == 0 ? (float)(row + 1) : (float)(128 - row))); float qf[8]; unpack8(pa[r], qf); \
                _Pragma("unroll") for (int k = 0; k < 8; ++k) qf[k] *= fac; \
                *(LAS v4u*)(RA + row * RS + pc * 8) = pack8(qf); } \
            _Pragma("unroll") for (int r = 0; r < 8; ++r) { const int f = tq + 512 * r, row = f >> 4, pc = f & 15; *(LAS v4u*)(RB + row * RS + pc * 8) = pb[r]; } } while (0)
        f32x4 S[4][2];
#pragma unroll
        for (int ti = 0; ti < 4; ++ti)
#pragma unroll
            for (int tj = 0; tj < 2; ++tj) S[ti][tj] = (f32x4){0.f, 0.f, 0.f, 0.f};
        RO_LOAD_QK(0);
#pragma unroll
        for (int dh = 0; dh < 2; ++dh) {
            if (dh) __syncthreads();
            RO_STORE_QK();
            __syncthreads();
            if (dh == 0) RO_LOAD_QK(1); else RO_LOAD_V();
#pragma unroll
            for (int ks = 0; ks < 4; ++ks) {
                bf16x8 ka[2], qb[4];
#pragma unroll
                for (int tj = 0; tj < 2; ++tj) ka[tj] = *(const LAS bf16x8*)(RB + (32 * wj + 16 * tj + lr) * RS + 32 * ks + lq * 8);
#pragma unroll
                for (int ti = 0; ti < 4; ++ti) qb[ti] = *(const LAS bf16x8*)(RA + (64 * wi + 16 * ti + lr) * RS + 32 * ks + lq * 8);
#pragma unroll
                for (int ti = 0; ti < 4; ++ti)
#pragma unroll
                    for (int tj = 0; tj < 2; ++tj) S[ti][tj] = MFMA16(ka[tj], qb[ti], S[ti][tj]);
            }
        }
#pragma unroll
        for (int ti = 0; ti < 4; ++ti)
#pragma unroll
            for (int tj = 0; tj < 2; ++tj) {
                const int i = 64 * wi + 16 * ti + lr, j0 = 32 * wj + 16 * tj + 4 * lq; float p[4];
#pragma unroll
                for (int jj = 0; jj < 4; ++jj) { const int d = i - (j0 + jj); p[jj] = S[ti][tj][jj] * exp2f(lg * (float)(d < 0 ? -d : d)); }
                v2u w; w.x = pkbf(p[0], p[1]); w.y = pkbf(p[2], p[3]); *(LAS v2u*)(RC + i * RS + j0) = w;
            }
        __syncthreads();
        RO_STORE_V();
        __syncthreads();
        RO_LOAD_I(0, 0);
        f32x4 O[4][4];
#pragma unroll
        for (int ti = 0; ti < 4; ++ti)
#pragma unroll
            for (int te = 0; te < 4; ++te) O[ti][te] = (f32x4){0.f, 0.f, 0.f, 0.f};
#pragma unroll
        for (int ks = 0; ks < 4; ++ks) {
            bf16x8 va[4], pbf[4];
#pragma unroll
            for (int te = 0; te < 4; ++te) va[te] = *(const LAS bf16x8*)(RB + (64 * we + 16 * te + lr) * RS + 32 * ks + lq * 8);
#pragma unroll
            for (int ti = 0; ti < 4; ++ti) pbf[ti] = *(const LAS bf16x8*)(RC + (64 * wi + 16 * ti + lr) * RS + 32 * ks + lq * 8);
#pragma unroll
            for (int ti = 0; ti < 4; ++ti)
#pragma unroll
                for (int te = 0; te < 4; ++te) O[ti][te] = MFMA16(va[te], pbf[ti], O[ti][te]);
        }
#pragma unroll
        for (int stg = 0; stg < 4; ++stg) {
            __syncthreads();
            if (stg == 0) RO_STORE_I(0, 0); else if (stg == 1) RO_STORE_I(0, 1); else if (stg == 2) RO_STORE_I(1, 0); else RO_STORE_I(1, 1);
            __syncthreads();
            if (stg == 0) RO_LOAD_I(0, 1); else if (stg == 1) RO_LOAD_I(1, 0); else if (stg == 2) RO_LOAD_I(1, 1);
#pragma unroll
            for (int ks = 0; ks < 4; ++ks) {
                bf16x8 sa[4], qb[4];
#pragma unroll
                for (int te = 0; te < 4; ++te) sa[te] = *(const LAS bf16x8*)(RB + (64 * we + 16 * te + lr) * RS + 32 * ks + lq * 8);
#pragma unroll
                for (int ti = 0; ti < 4; ++ti) qb[ti] = *(const LAS bf16x8*)(RA + (64 * wi + 16 * ti + lr) * RS + 32 * ks + lq * 8);
#pragma unroll
                for (int ti = 0; ti < 4; ++ti)
#pragma unroll
                    for (int te = 0; te < 4; ++te) O[ti][te] = MFMA16(sa[te], qb[ti], O[ti][te]);
            }
        }
#undef RO_LOAD_QK
#undef RO_STORE_QK
#undef RO_LOAD_V
#undef RO_STORE_V
#undef RO_LOAD_I
#undef RO_STORE_I
        __syncthreads();
        LAS float* RED = (LAS float*)RA;
#pragma unroll
        for (int ti = 0; ti < 4; ++ti) { float s1 = 0.f, s2 = 0.f;
#pragma unroll
            for (int te = 0; te < 4; ++te)
#pragma unroll
                for (int jj = 0; jj < 4; ++jj) { const float v = O[ti][te][jj]; s1 += v; s2 += v * v; }
            s1 += __shfl_xor(s1, 16); s1 += __shfl_xor(s1, 32); s2 += __shfl_xor(s2, 16); s2 += __shfl_xor(s2, 32);
            if (lq == 0) { RED[((64 * wi + 16 * ti + lr) * 4 + we) * 2] = s1; RED[((64 * wi + 16 * ti + lr) * 4 + we) * 2 + 1] = s2; } }
        __syncthreads();
        LAS bf16* ON = RB;
#pragma unroll
        for (int ti = 0; ti < 4; ++ti) { const int i = 64 * wi + 16 * ti + lr;
            const f32x4 r0 = *(const LAS f32x4*)(RED + i * 8), r1 = *(const LAS f32x4*)(RED + i * 8 + 4);
            const float m = (r0[0] + r0[2] + r1[0] + r1[2]) * (1.0f / 256.0f), q = (r0[1] + r0[3] + r1[1] + r1[3]) * (1.0f / 256.0f);
            const float var = fmaxf(q - m * m, 0.f), rstd = 1.0f / sqrtf(var + GN_EPS);
#pragma unroll
            for (int te = 0; te < 4; ++te) { const int e0 = 64 * we + 16 * te + 4 * lq;
                v2u w; w.x = pkbf((O[ti][te][0] - m) * rstd, (O[ti][te][1] - m) * rstd); w.y = pkbf((O[ti][te][2] - m) * rstd, (O[ti][te][3] - m) * rstd);
                *(LAS v2u*)(ON + i * 264 + e0) = w; } }
        __syncthreads();
        {
            const int tq2 = opaque(tid);
#pragma unroll
            for (int r = 0; r < 8; ++r) { const int f = tq2 + 512 * r, row = f >> 5, pc = f & 31;
                float ov[8], gv[8]; unpack8(*(const LAS v4u*)(ON + row * 264 + pc * 8), ov); unpack8(*(const v4u*)(H + (size_t)(t0 + row) * INW + COL_G + h * 256 + pc * 8), gv);
#pragma unroll
                for (int k = 0; k < 8; ++k) ov[k] = (gv[k] / (1.0f + __expf(-gv[k]))) * ov[k];
                *(v4u*)(CC + (size_t)(t0 + row) * DM + 1024 + h * 256 + pc * 8) = pack8(ov); }
        }
        __syncthreads();
    }
}

__device__ __forceinline__ unsigned f2key(float f) { const unsigned u = __float_as_uint(f); return (u & 0x80000000u) ? ~u : (u | 0x80000000u); }
__device__ __forceinline__ float key2f(unsigned k) { const unsigned u = (k & 0x80000000u) ? (k & 0x7fffffffu) : ~k; return __uint_as_float(u); }
#define TK_CE(a, b) do { const unsigned hi_ = (a) > (b) ? (a) : (b), lo_ = (a) > (b) ? (b) : (a); (a) = hi_; (b) = lo_; } while (0)
__device__ __forceinline__ void bitonic_merge16(unsigned (&v)[16]) {
#pragma unroll
    for (int j = 8; j > 0; j >>= 1)
#pragma unroll
        for (int i = 0; i < 16; ++i) { const int l = i ^ j; if (l > i) TK_CE(v[i], v[l]); }
}
__device__ __forceinline__ void bitonic_sort16(unsigned (&v)[16]) {
#pragma unroll
    for (int k = 2; k <= 16; k <<= 1)
#pragma unroll
        for (int j = k >> 1; j > 0; j >>= 1)
#pragma unroll
            for (int i = 0; i < 16; ++i) { const int l = i ^ j; if (l > i) { if ((i & k) == 0) TK_CE(v[i], v[l]); else TK_CE(v[l], v[i]); } }
}
__device__ __forceinline__ void topk_phase(const Frame& F, CArgs& A) {
    const float* SC = (const float*)(F.ws + WS_H); int* IDX = (int*)(F.ws + WS_IDX); float* GATE = (float*)(F.ws + WS_GATE);
    LAS unsigned* LK = (LAS unsigned*)F.lds;
    const int tid = F.tid, tl = tid >> 4, hp = tid & 15;
    for (int blk = F.bx; blk < NTOK / 32; blk += F.G) {
        const int t = blk * 32 + tl;
        const float* row = SC + (size_t)t * DM + hp * 128;
        unsigned run[16];
#pragma unroll
        for (int k = 0; k < 16; ++k) run[k] = 0u;
        f32x4 cur[8], nxt[8];
#pragma unroll
        for (int q = 0; q < 8; ++q) cur[q] = *(const f32x4*)(row + q * 4);
        for (int n32 = 0; n32 < 4; ++n32) {
            if (n32 < 3) {
#pragma unroll
                for (int q = 0; q < 8; ++q) nxt[q] = *(const f32x4*)(row + (n32 + 1) * 32 + q * 4);
            }
#pragma unroll
            for (int hc = 0; hc < 2; ++hc) {
                unsigned ch[16];
#pragma unroll
                for (int q = 0; q < 4; ++q)
#pragma unroll
                    for (int e = 0; e < 4; ++e) { const int n = n32 * 32 + hc * 16 + q * 4 + e; ch[q * 4 + e] = (f2key(cur[hc * 4 + q][e]) & ~127u) | (unsigned)(127 - n); }
                bitonic_sort16(ch);
#pragma unroll
                for (int i = 0; i < 16; ++i) run[i] = run[i] > ch[15 - i] ? run[i] : ch[15 - i];
                bitonic_merge16(run);
            }
#pragma unroll
            for (int q = 0; q < 8; ++q) cur[q] = nxt[q];
        }
#pragma unroll
        for (int k = 0; k < 16; ++k) LK[tid * 17 + k] = run[k];
        __syncthreads();
        if ((hp & 1) == 0) {
            float a[16], b[16];
#pragma unroll
            for (int k = 0; k < 16; ++k) { a[k] = key2f(LK[tid * 17 + k] & ~127u); b[k] = key2f(LK[(tid + 1) * 17 + k] & ~127u); }
            unsigned sk[16];
#pragma unroll
            for (int k = 0; k < 16; ++k) sk[k] = 0u;
#pragma unroll
            for (int i = 0; i < 16; ++i)
#pragma unroll
                for (int j = 0; j < 16; ++j) if ((i + 1) * (j + 1) <= 16) {
                    unsigned key = (f2key(a[i] + b[j]) & ~255u) | (unsigned)(255 - (i * 16 + j));
#pragma unroll
                    for (int k = 0; k < 16; ++k) { const unsigned hi = sk[k] > key ? sk[k] : key, lo = sk[k] > key ? key : sk[k]; sk[k] = hi; key = lo; }
                }
            float e[16], sum = 0.f; const float s0 = key2f(sk[0] & ~255u);
#pragma unroll
            for (int k = 0; k < 16; ++k) { e[k] = __expf(key2f(sk[k] & ~255u) - s0); sum += e[k]; }
            const float inv = 1.0f / sum; const int head = hp >> 1;
#pragma unroll
            for (int k = 0; k < 16; ++k) {
                const int cell = 255 - (int)(sk[k] & 255u);
                const int i1 = 127 - (int)(LK[tid * 17 + (cell >> 4)] & 127u), i2 = 127 - (int)(LK[(tid + 1) * 17 + (cell & 15)] & 127u);
                IDX[(size_t)t * 128 + head * 16 + k] = i1 * 128 + i2;
                GATE[(size_t)t * 128 + head * 16 + k] = e[k] * inv;
            }
        }
        __syncthreads();
    }
}
#if PEER_FP4
__device__ __forceinline__ void peer_gather_phase(const Frame& F, CArgs& A, int l, float* xdst_base, bf16* XN) {
    constexpr int RB = DM / 2;
    constexpr int GNR = GATHER_ROWS;
    const unsigned char* U8 = F.ws + WS_U8 + (size_t)l * NEXP * RB; const unsigned char* V8 = F.ws + WS_V8 + (size_t)l * NEXP * RB;
    const float* USC = (const float*)(F.ws + WS_USC) + (size_t)l * NEXP; const float* VSC = (const float*)(F.ws + WS_VSC) + (size_t)l * NEXP;
    const int* IDX = (const int*)(F.ws + WS_IDX); const float* GATE = (const float*)(F.ws + WS_GATE);
    const float* g2 = A.in[I_LN2G] + (size_t)l * DM; const float* b2 = A.in[I_LN2B] + (size_t)l * DM;
    const int lane = F.lane, slot = 8 * (lane & 7) + (lane >> 3);
    for (int t = F.gw; t < NTOK; t += F.NGW) {
        float* xrow = F.out + (size_t)t * DM;
        f32x2v x[16];
#pragma unroll
        for (int q = 0; q < 8; ++q) { const f32x4 a = *(const f32x4*)(xrow + q * 256 + lane * 4); x[2 * q] = (f32x2v){a[0], a[1]}; x[2 * q + 1] = (f32x2v){a[2], a[3]}; }
        const int idx0 = IDX[(size_t)t * 128 + slot], idx1 = IDX[(size_t)t * 128 + 64 + slot];
        const float gate0 = GATE[(size_t)t * 128 + slot], gate1 = GATE[(size_t)t * 128 + 64 + slot];
        const float usc0 = USC[idx0], usc1 = USC[idx1], vsc0 = VSC[idx0], vsc1 = VSC[idx1];
        v4u BU[GNR];
        const unsigned loff = (unsigned)lane * 16u;
#define G_ROW_U(R) (U8 + (size_t)(unsigned)__builtin_amdgcn_readlane((((R) >> 6) & 1) ? idx1 : idx0, ((R) & 7) * 8 + (((R) >> 3) & 7)) * RB)
#define G_ROW_V(R) (V8 + (size_t)(unsigned)__builtin_amdgcn_readlane((((R) >> 6) & 1) ? idx1 : idx0, (R) & 63) * RB)
#define G_REQ(r, rowptr) do { BU[r] = *(const v4u*)((rowptr) + loff); } while (0)
#define G_DOT(r, dst) do { f32x2v s2_ = (f32x2v){0.f, 0.f}; \
            _Pragma("unroll") for (int q = 0; q < 4; ++q) { s2_ += __builtin_amdgcn_cvt_scalef32_pk_f32_fp4(BU[r][q], 1.0f, 0) * x[4 * q]; s2_ += __builtin_amdgcn_cvt_scalef32_pk_f32_fp4(BU[r][q], 1.0f, 1) * x[4 * q + 1]; \
                s2_ += __builtin_amdgcn_cvt_scalef32_pk_f32_fp4(BU[r][q], 1.0f, 2) * x[4 * q + 2]; s2_ += __builtin_amdgcn_cvt_scalef32_pk_f32_fp4(BU[r][q], 1.0f, 3) * x[4 * q + 3]; } \
            if (GATHER_PROBE) { f32x2v p2_ = (f32x2v){0.f, 0.f}; _Pragma("unroll") for (int q = 0; q < 4; ++q) { const unsigned wq_ = (unsigned)opaque((int)BU[r][q]); p2_ += __builtin_amdgcn_cvt_scalef32_pk_f32_fp4(wq_, 1.0f, 0) * x[4 * q]; p2_ += __builtin_amdgcn_cvt_scalef32_pk_f32_fp4(wq_, 1.0f, 1) * x[4 * q + 1]; p2_ += __builtin_amdgcn_cvt_scalef32_pk_f32_fp4(wq_, 1.0f, 2) * x[4 * q + 2]; p2_ += __builtin_amdgcn_cvt_scalef32_pk_f32_fp4(wq_, 1.0f, 3) * x[4 * q + 3]; } s2_ += p2_ * 0.0f; } \
            dst = s2_[0] + s2_[1]; } while (0)
#define G_REDUCE(g) do { \
            _Pragma("unroll") for (int i = 0; i < 4; ++i) { const float mine = b5 ? part[i + 4] : part[i], send = b5 ? part[i] : part[i + 4]; part[i] = mine + __shfl_xor(send, 32); } \
            _Pragma("unroll") for (int i = 0; i < 2; ++i) { const float mine = b4 ? part[i + 2] : part[i], send = b4 ? part[i] : part[i + 2]; part[i] = mine + __shfl_xor(send, 16); } \
            { const float mine = b3 ? part[1] : part[0], send = b3 ? part[0] : part[1]; part[0] = mine + __shfl_xor(send, 8); } \
            float v_ = part[0]; v_ += __shfl_xor(v_, 4); v_ += __shfl_xor(v_, 2); v_ += __shfl_xor(v_, 1); \
            const bool mine_ = (lane & 7) == ((g) & 7); hval0 = (mine_ && ((g) >> 3) == 0) ? v_ : hval0; hval1 = (mine_ && ((g) >> 3) == 1) ? v_ : hval1; } while (0)
        if (GATHER_PROBE2) {
            const int pm0 = idx0 & (GATHER_PROBE2 - 1), pm1 = idx1 & (GATHER_PROBE2 - 1); f32x2v ps = (f32x2v){0.f, 0.f};
#define G_ROW_P(R) (U8 + (size_t)(unsigned)__builtin_amdgcn_readlane((((R) >> 6) & 1) ? pm1 : pm0, (R) & 63) * RB)
#pragma unroll
            for (int r = 0; r < GNR; ++r) G_REQ(r, G_ROW_P(r));
            for (int it = 0; it < 128 / GNR - 1; ++it) {
#pragma unroll
                for (int r = 0; r < GNR; ++r) { float d_; G_DOT(r, d_); ps[0] += d_; G_REQ(r, G_ROW_P(GNR * (it + 1) + r)); }
            }
#pragma unroll
            for (int r = 0; r < GNR; ++r) { float d_; G_DOT(r, d_); ps[1] += d_; }
            asm volatile("" :: "v"(ps[0]), "v"(ps[1]));
#undef G_ROW_P
        }
        const bool b5 = (lane & 32) != 0, b4 = (lane & 16) != 0, b3 = (lane & 8) != 0;
        float hval0 = 0.f, hval1 = 0.f;
#pragma unroll
        for (int r = 0; r < GNR; ++r) G_REQ(r, G_ROW_U(r));
        for (int it = 0; it < 128 / GNR - 1; ++it) {
#pragma unroll
            for (int g4 = 0; g4 < GNR / 8; ++g4) { float part[8];
#pragma unroll
                for (int i = 0; i < 8; ++i) { G_DOT(g4 * 8 + i, part[i]); G_REQ(g4 * 8 + i, G_ROW_U(GNR * (it + 1) + g4 * 8 + i)); }
                G_REDUCE(it * (GNR / 8) + g4); }
        }
#pragma unroll
        for (int g4 = 0; g4 < GNR / 8; ++g4) { float part[8];
#pragma unroll
            for (int i = 0; i < 8; ++i) { G_DOT(g4 * 8 + i, part[i]); G_REQ(g4 * 8 + i, G_ROW_V(g4 * 8 + i)); }
            G_REDUCE(16 - GNR / 8 + g4); }
        const float w0 = gate0 * gelu_erf(hval0 * usc0) * vsc0, w1 = gate1 * gelu_erf(hval1 * usc1) * vsc1;
        f32x2v acc[16];
#pragma unroll
        for (int k = 0; k < 16; ++k) acc[k] = (f32x2v){0.f, 0.f};
#define G_AXPY(r, R) do { const float w_ = __uint_as_float((unsigned)__builtin_amdgcn_readlane((int)__float_as_uint((((R) >> 6) & 1) ? w1 : w0), (R) & 63)); const f32x2v w2_ = (f32x2v){w_, w_}; \
            _Pragma("unroll") for (int q = 0; q < 4; ++q) { acc[4 * q] += w2_ * __builtin_amdgcn_cvt_scalef32_pk_f32_fp4(BU[r][q], 1.0f, 0); acc[4 * q + 1] += w2_ * __builtin_amdgcn_cvt_scalef32_pk_f32_fp4(BU[r][q], 1.0f, 1); \
                acc[4 * q + 2] += w2_ * __builtin_amdgcn_cvt_scalef32_pk_f32_fp4(BU[r][q], 1.0f, 2); acc[4 * q + 3] += w2_ * __builtin_amdgcn_cvt_scalef32_pk_f32_fp4(BU[r][q], 1.0f, 3); } } while (0)
        for (int it = 0; it < 128 / GNR - 1; ++it) {
#pragma unroll
            for (int r = 0; r < GNR; ++r) { G_AXPY(r, GNR * it + r); G_REQ(r, G_ROW_V(GNR * (it + 1) + r)); }
        }
#pragma unroll
        for (int r = 0; r < GNR; ++r) G_AXPY(r, 128 - GNR + r);
#undef G_ROW_U
#undef G_ROW_V
#undef G_REQ
#undef G_DOT
#undef G_REDUCE
#undef G_AXPY
        const int le = opaque(lane);
        float s = 0.f;
#pragma unroll
        for (int j = 0; j < 8; ++j) { const f32x4 xr = *(const f32x4*)(xrow + j * 256 + le * 4);
            acc[2 * j] = (f32x2v){xr[0], xr[1]} * ALPHA + acc[2 * j]; acc[2 * j + 1] = (f32x2v){xr[2], xr[3]} * ALPHA + acc[2 * j + 1];
            s += (acc[2 * j][0] + acc[2 * j][1]) + (acc[2 * j + 1][0] + acc[2 * j + 1][1]); }
        const float mean = wave_sum(s) * (1.0f / DM); float s2 = 0.f;
#pragma unroll
        for (int k = 0; k < 16; ++k) { acc[k] = acc[k] - mean; s2 += acc[k][0] * acc[k][0] + acc[k][1] * acc[k][1]; }
        const float rstd = 1.0f / sqrtf(wave_sum(s2) * (1.0f / DM) + LN_EPS);
#pragma unroll
        for (int j = 0; j < 8; ++j) { const int col = j * 256 + le * 4;
            const f32x4 gg = *(const f32x4*)(g2 + col), bb = *(const f32x4*)(b2 + col);
            const f32x2v a0 = acc[2 * j], a1 = acc[2 * j + 1];
            const f32x4 o = (f32x4){a0[0] * rstd * gg[0] + bb[0], a0[1] * rstd * gg[1] + bb[1], a1[0] * rstd * gg[2] + bb[2], a1[1] * rstd * gg[3] + bb[3]};
            *(f32x4*)(xdst_base + (size_t)t * DM + col) = o;
            v2u w; w.x = pkbf(o[0], o[1]); w.y = pkbf(o[2], o[3]); *(v2u*)(XN + (size_t)t * DM + col) = w; }
    }
}

#else
__device__ __forceinline__ void peer_gather_phase(const Frame& F, CArgs& A, int l) {
    const unsigned char* U8 = F.ws + WS_U8 + (size_t)l * NEXP * DM; const unsigned char* V8 = F.ws + WS_V8 + (size_t)l * NEXP * DM;
    const float* USC = (const float*)(F.ws + WS_USC) + (size_t)l * NEXP; const float* VSC = (const float*)(F.ws + WS_VSC) + (size_t)l * NEXP;
    const int* IDX = (const int*)(F.ws + WS_IDX); const float* GATE = (const float*)(F.ws + WS_GATE);
    const float* g2 = A.in[I_LN2G] + (size_t)l * DM; const float* b2 = A.in[I_LN2B] + (size_t)l * DM;
    bf16* XN = (bf16*)(F.ws + WS_XN);
    const int lane = F.lane, slot = 8 * (lane & 7) + (lane >> 3);
    for (int t = F.gw; t < NTOK; t += F.NGW) {
        float* xrow = F.out + (size_t)t * DM;
        f32x2v x[2][8];
#pragma unroll
        for (int c = 0; c < 2; ++c)
#pragma unroll
            for (int q = 0; q < 4; ++q) { const f32x4 a = *(const f32x4*)(xrow + (c * 64 + lane) * 16 + q * 4); x[c][2 * q] = (f32x2v){a[0], a[1]}; x[c][2 * q + 1] = (f32x2v){a[2], a[3]}; }
        const int idx0 = IDX[(size_t)t * 128 + slot], idx1 = IDX[(size_t)t * 128 + 64 + slot];
        v4u BU[8][2];
        const unsigned loff0 = (unsigned)lane * 16u, loff1 = (unsigned)lane * 16u + 1024u;
#define G_ROW_U(i, b) (U8 + (size_t)(unsigned)__builtin_amdgcn_readlane(((b) >> 3) ? idx1 : idx0, (i) * 8 + ((b) & 7)) * DM)
#define G_ROW_V(i, b) (V8 + (size_t)(unsigned)__builtin_amdgcn_readlane(((b) >> 3) ? idx1 : idx0, ((b) & 7) * 8 + (i)) * DM)
#define G_REQ(i, rowptr) do { const unsigned char* r_ = (rowptr); BU[i][0] = *(const v4u*)(r_ + loff0); BU[i][1] = *(const v4u*)(r_ + loff1); } while (0)
#define G_DOT(i, dst) do { f32x2v s2_ = (f32x2v){0.f, 0.f}; \
            _Pragma("unroll") for (int c = 0; c < 2; ++c) _Pragma("unroll") for (int q = 0; q < 4; ++q) { s2_ += __builtin_amdgcn_cvt_pk_f32_fp8((int)BU[i][c][q], false) * x[c][2 * q]; s2_ += __builtin_amdgcn_cvt_pk_f32_fp8((int)BU[i][c][q], true) * x[c][2 * q + 1]; } \
            dst = s2_[0] + s2_[1]; } while (0)
#define G_REDUCE(b) do { \
            _Pragma("unroll") for (int i = 0; i < 4; ++i) { const float mine = b5 ? part[i + 4] : part[i], send = b5 ? part[i] : part[i + 4]; part[i] = mine + __shfl_xor(send, 32); } \
            _Pragma("unroll") for (int i = 0; i < 2; ++i) { const float mine = b4 ? part[i + 2] : part[i], send = b4 ? part[i] : part[i + 2]; part[i] = mine + __shfl_xor(send, 16); } \
            { const float mine = b3 ? part[1] : part[0], send = b3 ? part[0] : part[1]; part[0] = mine + __shfl_xor(send, 8); } \
            float v_ = part[0]; v_ += __shfl_xor(v_, 4); v_ += __shfl_xor(v_, 2); v_ += __shfl_xor(v_, 1); \
            const bool mine_ = (lane & 7) == ((b) & 7); hval0 = (mine_ && ((b) >> 3) == 0) ? v_ : hval0; hval1 = (mine_ && ((b) >> 3) == 1) ? v_ : hval1; } while (0)
        const bool b5 = (lane & 32) != 0, b4 = (lane & 16) != 0, b3 = (lane & 8) != 0;
        float hval0 = 0.f, hval1 = 0.f;
#pragma unroll
        for (int i = 0; i < 8; ++i) G_REQ(i, G_ROW_U(i, 0));
        for (int b = 0; b < 15; ++b) {
            float part[8];
#pragma unroll
            for (int i = 0; i < 8; ++i) { G_DOT(i, part[i]); G_REQ(i, G_ROW_U(i, b + 1)); }
            G_REDUCE(b);
        }
        {
            float part[8];
#pragma unroll
            for (int i = 0; i < 8; ++i) { G_DOT(i, part[i]); G_REQ(i, G_ROW_V(i, 0)); }
            G_REDUCE(15);
        }
        const float gate0 = GATE[(size_t)t * 128 + slot], gate1 = GATE[(size_t)t * 128 + 64 + slot];
        const float usc0 = USC[idx0], usc1 = USC[idx1], vsc0 = VSC[idx0], vsc1 = VSC[idx1];
        const float w0 = gate0 * gelu_erf(hval0 * usc0) * vsc0, w1 = gate1 * gelu_erf(hval1 * usc1) * vsc1;
        f32x2v acc[2][8];
#pragma unroll
        for (int c = 0; c < 2; ++c)
#pragma unroll
            for (int k = 0; k < 8; ++k) acc[c][k] = (f32x2v){0.f, 0.f};
#define G_AXPY(i, b) do { const float w_ = __uint_as_float((unsigned)__builtin_amdgcn_readlane((int)__float_as_uint(((b) >> 3) ? w1 : w0), ((b) & 7) * 8 + (i))); const f32x2v w2_ = (f32x2v){w_, w_}; \
            _Pragma("unroll") for (int c = 0; c < 2; ++c) _Pragma("unroll") for (int q = 0; q < 4; ++q) { acc[c][2 * q] += w2_ * __builtin_amdgcn_cvt_pk_f32_fp8((int)BU[i][c][q], false); acc[c][2 * q + 1] += w2_ * __builtin_amdgcn_cvt_pk_f32_fp8((int)BU[i][c][q], true); } } while (0)
        for (int b = 0; b < 15; ++b) {
#pragma unroll
            for (int i = 0; i < 8; ++i) { G_AXPY(i, b); G_REQ(i, G_ROW_V(i, b + 1)); }
        }
#pragma unroll
        for (int i = 0; i < 8; ++i) G_AXPY(i, 15);
#undef G_ROW_U
#undef G_ROW_V
#undef G_REQ
#undef G_DOT
#undef G_REDUCE
#undef G_AXPY
        const int le = opaque(lane);
        float s = 0.f;
#pragma unroll
        for (int c = 0; c < 2; ++c)
#pragma unroll
            for (int k = 0; k < 8; ++k) { const f32x2v xr = *(const f32x2v*)(xrow + (c * 64 + le) * 16 + 2 * k);
                acc[c][k] = xr * ALPHA + acc[c][k]; s += acc[c][k][0] + acc[c][k][1]; }
        const float mean = wave_sum(s) * (1.0f / DM); float s2 = 0.f;
#pragma unroll
        for (int c = 0; c < 2; ++c)
#pragma unroll
            for (int k = 0; k < 8; ++k) { acc[c][k] = acc[c][k] - mean; s2 += acc[c][k][0] * acc[c][k][0] + acc[c][k][1] * acc[c][k][1]; }
        const float rstd = 1.0f / sqrtf(wave_sum(s2) * (1.0f / DM) + LN_EPS);
#pragma unroll
        for (int c = 0; c < 2; ++c) { const int col = (c * 64 + le) * 16;
#pragma unroll
            for (int h8 = 0; h8 < 2; ++h8) { float o[8];
#pragma unroll
                for (int q = 0; q < 2; ++q) { const f32x4 gg = *(const f32x4*)(g2 + col + h8 * 8 + q * 4), bb = *(const f32x4*)(b2 + col + h8 * 8 + q * 4);
                    const f32x2v a0 = acc[c][h8 * 4 + 2 * q], a1 = acc[c][h8 * 4 + 2 * q + 1];
                    o[4 * q] = a0[0] * rstd * gg[0] + bb[0]; o[4 * q + 1] = a0[1] * rstd * gg[1] + bb[1]; o[4 * q + 2] = a1[0] * rstd * gg[2] + bb[2]; o[4 * q + 3] = a1[1] * rstd * gg[3] + bb[3];
                    *(f32x4*)(xrow + col + h8 * 8 + q * 4) = (f32x4){o[4 * q], o[4 * q + 1], o[4 * q + 2], o[4 * q + 3]}; }
                *(v4u*)(XN + (size_t)t * DM + col + h8 * 8) = pack8(o); } }
    }
}

#endif
#ifndef DUP_MASK
#define DUP_MASK 0
#endif
#ifndef PHASE_TEST_ONLY
__global__ void __launch_bounds__(NTHR, 2) fwd_kernel(Args A) {
    extern __shared__ __attribute__((aligned(16))) unsigned char lds_raw[];
#define MKFRAME() Frame F; CArgs& KA = *(CArgs*)opaque_u64((unsigned long long)__builtin_amdgcn_kernarg_segment_ptr()); { F.lds = (LAS unsigned char*)lds_raw; F.tid = opaque((int)threadIdx.x); F.lane = F.tid & 63; F.wave = __builtin_amdgcn_readfirstlane(F.tid >> 6); \
        const int bx_ = opaque_s((int)blockIdx.x); F.G = gridDim.x; F.gw = bx_ * NWAVES + F.wave; F.NGW = F.G * NWAVES; F.gtid = (size_t)bx_ * NTHR + F.tid; F.NT = (size_t)F.G * NTHR; F.out = (float*)opaque_p(KA.out); F.ws = (unsigned char*)opaque_p(KA.ws); F.bx = bx_; } \
        bf16* XN = (bf16*)(F.ws + WS_XN); bf16* H = (bf16*)(F.ws + WS_H); bf16* CC = (bf16*)(F.ws + WS_CONCAT); (void)XN; (void)H; (void)CC;
    volatile LAS unsigned* MISC = (volatile LAS unsigned*)((LAS unsigned char*)lds_raw + LDS_MISC);
    if (threadIdx.x < 64) MISC[threadIdx.x] = 0u;
    __syncthreads();
    XcdBarrier bar = xcd_barrier_post((unsigned*)(A.ws + WS_CTL) + CW_BAR + A.li * XCD_BAR_WORDS, MISC + 8);
    const int lo = A.ph_lo, hi = A.ph_hi;
#define IN(k) (lo <= (k) && (k) < hi)
#define SEAM(k) do { if (lo <= (k) && (k) + 1 < hi) xcd_barrier(bar); } while (0)

    if (IN(0)) { MKFRAME(); p0_prologue(F, KA); if (DUP_MASK & 256) { __syncthreads(); p0_prologue(F, KA); } } SEAM(0);

    for (int l = 0; l < NLAYER; ++l) {
        const int pb = 1 + l * 10;
        if (IN(pb + 0)) { MKFRAME();
            pg8::Gemm g{XN, (const bf16*)(F.ws + WS_WIN) + (size_t)l * INW * DM, NTOK, INW, DM}; pg8::StaticOrder S; S.init(NTOK, INW, F.G, F.bx);
            EpiStoreRot E{H, INW, (const float*)(F.ws + WS_ROTC), (const float*)(F.ws + WS_ROTS)};
            pg8::gemm_phase<EpiStoreRot, pg8::StaticOrder, true, true>(F.lds, g, S, E);
            if (DUP_MASK & 64) { pg8::gemm_phase<EpiStoreRot, pg8::StaticOrder, true, true>(F.lds, g, S, E); }
        } SEAM(pb + 0);
        if (IN(pb + 1)) { MKFRAME(); s5_pass1(F, KA, l); pool_phase(F, KA); if (DUP_MASK & 1) { s5_pass1(F, KA, l); } if (DUP_MASK & 2) { pool_phase(F, KA); } } SEAM(pb + 1);
        if (IN(pb + 2)) { MKFRAME(); s5_carry(F, KA, l); __syncthreads(); ret_state_phase(F, KA); if (DUP_MASK & 4) { ret_state_phase(F, KA); } if (DUP_MASK & 2048) { ret_state_phase<1>(F, KA); } if (DUP_MASK & 4096) { ret_state_phase<2>(F, KA); ret_state_phase(F, KA); } } SEAM(pb + 2);
        if (IN(pb + 3)) { MKFRAME(); s5_pass3(F, KA, l); if (DUP_MASK & 8) { s5_pass3(F, KA, l); } ret_prefix_phase(F, KA); } SEAM(pb + 3);
        if (IN(pb + 4)) { MKFRAME();
            __syncthreads();
            ret_out_phase(F, KA);
            if (DUP_MASK & 16) { ret_out_phase(F, KA); }
            {
                pg8::Gemm g{(const bf16*)(F.ws + WS_BUFY), (const bf16*)(F.ws + WS_WGLU) + (size_t)l * 512 * 512, NTOK, 512, 512}; pg8::StaticOrder S; S.init(NTOK, 512, F.G, F.bx);
                EpiGlu E{(const bf16*)(F.ws + WS_BUFY), 512, CC, DM, KA.in[I_BGLU] + (size_t)l * 512};
                pg8::gemm_phase<EpiGlu, pg8::StaticOrder, true, true>(F.lds, g, S, E);
                if (DUP_MASK & 512) { pg8::gemm_phase<EpiGlu, pg8::StaticOrder, true, true>(F.lds, g, S, E); }
            }
            {
                pg8::Gemm g{(const bf16*)(F.ws + WS_BUFP), (const bf16*)(F.ws + WS_WPOOL) + (size_t)l * 512 * 512, NTOK, 512, 512}; pg8::StaticOrder S; S.init(NTOK, 512, F.G, F.bx);
                EpiScaleBf16 E{CC + 512, DM, KA.in[I_POOLS] + (size_t)l * 512};
                pg8::gemm_phase<EpiScaleBf16, pg8::StaticOrder, true, true>(F.lds, g, S, E);
                if (DUP_MASK & 512) { pg8::gemm_phase<EpiScaleBf16, pg8::StaticOrder, true, true>(F.lds, g, S, E); }
            }
        } SEAM(pb + 4);
        if (IN(pb + 5)) { MKFRAME();
            pg8::Gemm g{CC, (const bf16*)(F.ws + WS_WOUT) + (size_t)l * DM * DM, NTOK, DM, DM}; pg8::StaticOrder S; S.init(NTOK, DM, F.G, F.bx);
            EpiStoreBf16 E{H, DM};
            pg8::gemm_phase<EpiStoreBf16, pg8::StaticOrder, true, true>(F.lds, g, S, E);
        } SEAM(pb + 5);
        if (IN(pb + 6)) { MKFRAME();
            ln_rows2(F.out, H, ALPHA, KA.in[I_LN1G] + (size_t)l * DM, KA.in[I_LN1B] + (size_t)l * DM, XN, F.gw, F.NGW, F.lane);
        } SEAM(pb + 6);
        if (IN(pb + 7)) { MKFRAME();
            pg8::Gemm g{XN, (const bf16*)(F.ws + WS_WS) + (size_t)l * DM * DM, NTOK, DM, DM}; pg8::StaticOrder S; S.init(NTOK, DM, F.G, F.bx);
            EpiStoreF32 E{(float*)(F.ws + WS_H), DM};
            pg8::gemm_phase<EpiStoreF32, pg8::StaticOrder, true, true>(F.lds, g, S, E);
            if (DUP_MASK & 128) { pg8::gemm_phase<EpiStoreF32, pg8::StaticOrder, true, true>(F.lds, g, S, E); }
        } SEAM(pb + 7);
        if (IN(pb + 8)) { MKFRAME(); __syncthreads(); topk_phase(F, KA); if (DUP_MASK & 32) { topk_phase(F, KA); } } SEAM(pb + 8);
        if (IN(pb + 9)) { MKFRAME(); if (DUP_MASK & 1024) { peer_gather_phase(F, KA, l, (float*)(F.ws + WS_H), CC); } peer_gather_phase(F, KA, l, F.out, XN); } SEAM(pb + 9);
    }
#undef IN
#undef SEAM
}


#ifndef DBG_STOP
#define DBG_STOP NPHASE
#endif
#ifndef DBG_DUMP
#define DBG_DUMP 0
#endif
__global__ void dbg_dump_kernel(float* out, const unsigned char* ws, int mode) {
    const size_t n = (size_t)NTOK * DM;
    for (size_t i = (size_t)blockIdx.x * blockDim.x + threadIdx.x; i < n; i += (size_t)gridDim.x * blockDim.x) {
        float v = 0.f;
        if (mode == 1) v = bf_lo(((const bf16*)(ws + WS_H))[i]);
        else if (mode == 2) v = bf_lo(((const bf16*)(ws + WS_CONCAT))[i]);
        else if (mode == 3) v = bf_lo(((const bf16*)(ws + WS_BUFY))[i % ((size_t)NTOK * 1024)]);
        else if (mode == 4) v = bf_lo(((const bf16*)(ws + WS_STF))[i]);
        else if (mode == 5) v = ((const float*)(ws + WS_H))[i];
        else if (mode == 6) v = (i < (size_t)NTOK * 128) ? (float)((const int*)(ws + WS_IDX))[i] : ((i < (size_t)NTOK * 256) ? ((const float*)(ws + WS_GATE))[i - (size_t)NTOK * 128] : 0.f);
        else if (mode == 7) v = bf_lo(((const bf16*)(ws + WS_XN))[i]);
        else if (mode == 8) v = bf_lo(((const bf16*)(ws + WS_STB))[i]);
        else if (mode == 9) v = bf_lo(((const bf16*)(ws + WS_H))[i + (size_t)NTOK * DM]);
        else if (mode == 10) v = bf_lo(((const bf16*)(ws + WS_WIN))[i % ((size_t)72 * 1024 * 1024)]);
        else if (mode == 11) v = ((const float*)(ws + WS_S5ST))[i % ((size_t)5 * 1024 * 1024)];
        else if (mode == 12) v = bf_lo(((const bf16*)(ws + WS_H))[i]) + bf_lo(((const bf16*)(ws + WS_H))[i + (size_t)NTOK * DM]) + bf_lo(((const bf16*)(ws + WS_BUFP))[i % ((size_t)NTOK * 512)]) + ((const float*)(ws + WS_S5ST))[i % ((size_t)5 * 1024 * 1024)];
        else if (mode == 13) v = bf_lo(((const bf16*)(ws + WS_STF))[i]) + bf_lo(((const bf16*)(ws + WS_STB))[i]) + ((const float*)(ws + WS_S5ST))[i % ((size_t)5 * 1024 * 1024)];
        else if (mode == 14) v = bf_lo(((const bf16*)(ws + WS_STF))[i]) + bf_lo(((const bf16*)(ws + WS_STB))[i]) + bf_lo(((const bf16*)(ws + WS_BUFY))[i % ((size_t)NTOK * 512)]);
        else if (mode == 15) v = bf_lo(((const bf16*)(ws + WS_H))[i]) + bf_lo(((const bf16*)(ws + WS_H))[i + (size_t)NTOK * DM]) + bf_lo(((const bf16*)(ws + WS_H))[i + (size_t)NTOK * 3072]);
        out[i] = v;
    }
}
#ifndef MK_ONE_LAUNCH
#define MK_ONE_LAUNCH 0
#endif
extern "C" void kernel_launch(void* const* d_in, const int* in_sizes, int n_in, void* d_out, int out_size, void* d_ws, size_t ws_size, hipStream_t stream) {
    static int grid = 0;
    if (grid == 0) {
        if (n_in != 26 || out_size != NTOK * DM || ws_size < WS_END) { fprintf(stderr, "kernel_launch: unexpected shapes (n_in %d out %d ws %zu)\n", n_in, out_size, ws_size); grid = -1; return; }
        int dev = 0, cus = 0, per_cu = 0;
        if (hipGetDevice(&dev) != hipSuccess || hipDeviceGetAttribute(&cus, hipDeviceAttributeMultiprocessorCount, dev) != hipSuccess) { grid = -1; return; }
        if (hipFuncSetAttribute((const void*)fwd_kernel, hipFuncAttributeMaxDynamicSharedMemorySize, LDS_BYTES) != hipSuccess) { fprintf(stderr, "kernel_launch: hipFuncSetAttribute failed\n"); grid = -1; return; }
        if (hipOccupancyMaxActiveBlocksPerMultiprocessor(&per_cu, (const void*)fwd_kernel, NTHR, LDS_BYTES) != hipSuccess || per_cu < 1) { fprintf(stderr, "kernel_launch: occupancy query says %d\n", per_cu); grid = -1; (void)hipGetLastError(); return; }
        (void)hipGetLastError();
        grid = cus;
    }
    if (grid < 0) return;
    if (hipMemsetAsync((char*)d_ws + WS_CTL, 0, CTL_ZERO_BYTES, stream) != hipSuccess) return;
    Args a{};
    for (int i = 0; i < 26; ++i) a.in[i] = (const float*)d_in[i];
    a.out = (float*)d_out; a.ws = (unsigned char*)d_ws; a.pad = 0;
#if MK_ONE_LAUNCH
    a.ph_lo = 0; a.ph_hi = NPHASE; a.li = 0;
    hipLaunchKernelGGL(fwd_kernel, dim3(grid), dim3(NTHR), LDS_BYTES, stream, a);
#else
    for (int p = 0; p < DBG_STOP; ++p) { a.ph_lo = p; a.ph_hi = p + 1; a.li = p; hipLaunchKernelGGL(fwd_kernel, dim3(grid), dim3(NTHR), LDS_BYTES, stream, a); }
#endif
    if (DBG_DUMP) hipLaunchKernelGGL(dbg_dump_kernel, dim3(2048), dim3(256), 0, stream, (float*)d_out, (const unsigned char*)d_ws, DBG_DUMP);
}
#endif
```

```cpp
#include <hip/hip_runtime.h>
#include <cstdio>
#include <cstdint>
#include <cmath>
__device__ __forceinline__ int opaque(int v) { asm volatile("" : "+v"(v)); return v; }
__device__ __forceinline__ int opaque_s(int v) { asm volatile("" : "+s"(v)); return v; }
__device__ __forceinline__ void* opaque_p(void* p) { asm volatile("" : "+s"(p)); return p; }
__device__ __forceinline__ unsigned long long opaque_u64(unsigned long long v) { asm volatile("" : "+s"(v)); return v; }
#ifndef PEER_FP4
#define PEER_FP4 1
#endif
#ifndef GATHER_ROWS
#define GATHER_ROWS 16
#endif
#ifndef GATHER_PROBE
#define GATHER_PROBE 0
#endif
#ifndef GATHER_PROBE2
#define GATHER_PROBE2 0
#endif
#define MK_ONE_LAUNCH 1
namespace pg8 {
#define PG8_LAS __attribute__((address_space(3)))
typedef unsigned short bf16_t;
typedef short bf16x8 __attribute__((ext_vector_type(8)));
typedef float f32x4 __attribute__((ext_vector_type(4)));
typedef unsigned u32x4 __attribute__((ext_vector_type(4)));
constexpr int BM = 256, BK = 64, HALF = 128, HTB = HALF * BK * 2  , STAGE_BYTES = 8 * HTB, NXCD = 8, WGM = 8;

__host__ __device__ __forceinline__ int lds_byte(int r, int c) { const int st = (r >> 4) * 2 + (c >> 5), rr = r & 15, cc = c & 31, ob = rr * 64 + cc * 2; return st * 1024 + (ob ^ (((ob >> 9) & 1) << 5)); }
__host__ __device__ __forceinline__ void stage_rc(int b, int& R, int& C) { const int st = b / 1024, sb = b % 1024, swz = sb ^ (((sb >> 9) & 1) << 5); R = (st >> 1) * 16 + swz / 64; C = (st & 1) * 32 + (swz % 64) / 2; }
__host__ __device__ __forceinline__ int perm32(int rho) { const int n = rho >> 4, i = rho & 15; return 8 * (i >> 2) + 4 * n + (i & 3); }

struct Unit { int pm, pn; };
struct Gemm { const bf16_t* A; const bf16_t* Bt; int M, N, K; };

struct StaticOrder {
    int nM, nN, nwg, G, c;
    __host__ __device__ void init(int M, int N, int G_, int c_) { nM = M / BM; nN = N / BM; nwg = nM * nN; G = G_; c = c_; }
    __host__ __device__ bool next(int i, Unit& u) const {
        const long L = (long)i * G + c; if (L >= nwg) return false;
        int wgid = (int)L; { const int q = nwg / NXCD, r = nwg % NXCD, xcd = wgid % NXCD, off = wgid / NXCD; wgid = (xcd < r ? xcd * (q + 1) : r * (q + 1) + (xcd - r) * q) + off; }
        const int nig = WGM * nN, gid = wgid / nig, fm = gid * WGM, gsz = (nM - fm) < WGM ? (nM - fm) : WGM;
        u.pm = fm + ((wgid % nig) % gsz); u.pn = (wgid % nig) / gsz; return true;
    }
    __device__ __forceinline__ void a_ready(const Unit&) const {}
    __device__ __forceinline__ void done(const Unit&) const {}
};
__device__ __forceinline__ unsigned cvt_pk_bf16(float lo, float hi) { unsigned r; asm volatile("v_cvt_pk_bf16_f32 %0, %1, %2" : "=v"(r) : "v"(lo), "v"(hi)); return r; }
typedef float f32x2 __attribute__((ext_vector_type(2)));
template <class Epi, class Sched, bool ALIGN_EPI = false, bool SP2 = false>
__device__ __forceinline__ void gemm_phase(PG8_LAS unsigned char* lds, const Gemm g, const Sched& S, const Epi& E) {
    const int tid = opaque((int)threadIdx.x), wid = __builtin_amdgcn_readfirstlane(tid >> 6), lane = tid & 63, wr = wid >> 2, wc = wid & 3, fr = lane & 15, fq = lane >> 4;
    const int K = g.K, nt = K / BK;
    unsigned voffA[2], voffB[2];
#pragma unroll
    for (int i = 0; i < 2; ++i) { int R, C; stage_rc(tid * 16 + i * 8192, R, C); const int Rb = Epi::PERM ? ((R & ~31) + perm32(R & 31)) : R;
        voffA[i] = (unsigned)(R * K + C) * 2u; voffB[i] = (unsigned)(Rb * K + C) * 2u; }
    const size_t kstep = (size_t)(BK * 2);
    const size_t hstep = (size_t)HALF * K * 2;
    const size_t tstep = 2 * hstep;
    const unsigned ldsw = (unsigned)wid * 1024u;
    const int aoff = lds_byte(wr * 64 + fr, fq * 8), boff = lds_byte(wc * 32 + fr, fq * 8);
#define PG8_SA(b, h) (((b) * 2 + (h)) * HTB)
#define PG8_SB(b, h) ((4 + (b) * 2 + (h)) * HTB)
#define PG8_STAGE(bufoff, gbase, voff) do { _Pragma("unroll") for (int _i = 0; _i < 2; ++_i) \
        __builtin_amdgcn_global_load_lds((const unsigned*)((const char*)(gbase) + (voff)[_i]), (PG8_LAS unsigned*)(lds + (bufoff) + ldsw + _i * 8192), 16, 0, 0); } while (0)
#define PG8_LDA(dst, b, h) do { _Pragma("unroll") for (int m = 0; m < 4; ++m) _Pragma("unroll") for (int k = 0; k < 2; ++k) dst[m][k] = *(const PG8_LAS bf16x8*)(lds + PG8_SA(b, h) + aoff + m * 2048 + k * 1024); } while (0)
#define PG8_LDB(dst, b, h) do { _Pragma("unroll") for (int n = 0; n < 2; ++n) _Pragma("unroll") for (int k = 0; k < 2; ++k) dst[n][k] = *(const PG8_LAS bf16x8*)(lds + PG8_SB(b, h) + boff + n * 2048 + k * 1024); } while (0)
#define PG8_MMA(ai, bj, At, Bt) do { __builtin_amdgcn_s_setprio(1); _Pragma("unroll") for (int m = 0; m < 4; ++m) _Pragma("unroll") for (int n = 0; n < 2; ++n) _Pragma("unroll") for (int k = 0; k < 2; ++k) \
        acc[ai][bj][m][n] = __builtin_amdgcn_mfma_f32_16x16x32_bf16(Bt[n][k], At[m][k], acc[ai][bj][m][n], 0, 0, 0); __builtin_amdgcn_s_setprio(0); } while (0)
#define PG8_WAIT_V(n) asm volatile("s_waitcnt vmcnt(" #n ")" ::: "memory")
#define PG8_WAIT_L(n) asm volatile("s_waitcnt lgkmcnt(" #n ")" ::: "memory")
#define PG8_BAR __builtin_amdgcn_s_barrier()
#define PG8_SCHED __builtin_amdgcn_sched_barrier(0)
    Unit cur, nxt; int ui = 0;
    if (!S.next(0, cur)) return;
    f32x4 acc[2][2][4][2];
#pragma unroll
    for (int a = 0; a < 2; ++a)
#pragma unroll
        for (int b = 0; b < 2; ++b)
#pragma unroll
            for (int m = 0; m < 4; ++m)
#pragma unroll
                for (int n = 0; n < 2; ++n) acc[a][b][m][n] = (f32x4){0.f, 0.f, 0.f, 0.f};
    bf16x8 At[4][2], B0[2][2], B1[2][2];
    const char* cA = (const char*)g.A + (size_t)cur.pm * tstep; const char* cB = (const char*)g.Bt + (size_t)cur.pn * tstep;
    S.a_ready(cur);
    if constexpr (SP2) {
        PG8_STAGE(PG8_SB(0, 0), cB, voffB); PG8_STAGE(PG8_SB(0, 1), cB + hstep, voffB); PG8_STAGE(PG8_SA(0, 0), cA, voffA); PG8_STAGE(PG8_SA(0, 1), cA + hstep, voffA);
        if (wr == 1) PG8_BAR;
        PG8_WAIT_V(2); PG8_BAR;
        PG8_STAGE(PG8_SB(1, 0), cB + kstep, voffB); PG8_STAGE(PG8_SA(1, 0), cA + kstep, voffA); PG8_STAGE(PG8_SB(1, 1), cB + hstep + kstep, voffB);
        PG8_WAIT_V(6); PG8_BAR;
    } else {
        PG8_STAGE(PG8_SB(0, 0), cB, voffB); PG8_STAGE(PG8_SA(0, 0), cA, voffA); PG8_STAGE(PG8_SB(0, 1), cB + hstep, voffB); PG8_STAGE(PG8_SA(0, 1), cA + hstep, voffA);
        if (wr == 1) PG8_BAR;
        PG8_WAIT_V(4); PG8_BAR;
        PG8_STAGE(PG8_SB(1, 0), cB + kstep, voffB); PG8_STAGE(PG8_SA(1, 0), cA + kstep, voffA); PG8_STAGE(PG8_SB(1, 1), cB + hstep + kstep, voffB);
        PG8_WAIT_V(6); PG8_BAR;
    }
    for (;;) {
        const bool has_next = S.next(ui + 1, nxt);
        const char* nA = has_next ? (const char*)g.A + (size_t)nxt.pm * tstep : cA; const char* nB = has_next ? (const char*)g.Bt + (size_t)nxt.pn * tstep : cB;
        for (int t = 0; t < nt; t += 2) {
            const bool last = (t == nt - 2);
            const char* a1 = cA + (size_t)(t + 1) * kstep;
            const char* a2 = last ? nA : cA + (size_t)(t + 2) * kstep; const char* b2 = last ? nB : cB + (size_t)(t + 2) * kstep;
            const char* a3 = a2 + kstep; const char* b3 = b2 + kstep;
            if (last && has_next) S.a_ready(nxt);
            if constexpr (SP2) {
            PG8_LDB(B0, 0, 0); PG8_LDB(B1, 0, 1); PG8_SCHED; PG8_LDA(At, 0, 0); PG8_STAGE(PG8_SA(1, 1), a1 + hstep, voffA);
            PG8_WAIT_V(8); PG8_WAIT_L(0); PG8_BAR; PG8_MMA(0, 0, At, B0); PG8_MMA(0, 1, At, B1); PG8_BAR; PG8_SCHED;
            PG8_LDA(At, 0, 1); PG8_STAGE(PG8_SB(0, 0), b2, voffB); PG8_STAGE(PG8_SB(0, 1), b2 + hstep, voffB); PG8_STAGE(PG8_SA(0, 0), a2, voffA);
            PG8_WAIT_V(8); PG8_WAIT_L(0); PG8_BAR; PG8_MMA(1, 0, At, B0); PG8_MMA(1, 1, At, B1); PG8_BAR; PG8_SCHED;
            PG8_LDB(B0, 1, 0); PG8_LDB(B1, 1, 1); PG8_SCHED; PG8_LDA(At, 1, 0); PG8_STAGE(PG8_SA(0, 1), a2 + hstep, voffA);
            PG8_WAIT_V(8); PG8_WAIT_L(0); PG8_BAR; PG8_MMA(0, 0, At, B0); PG8_MMA(0, 1, At, B1); PG8_BAR; PG8_SCHED;
            PG8_LDA(At, 1, 1); PG8_STAGE(PG8_SB(1, 0), b3, voffB); PG8_STAGE(PG8_SB(1, 1), b3 + hstep, voffB); PG8_STAGE(PG8_SA(1, 0), a3, voffA);
            PG8_WAIT_V(8); PG8_WAIT_L(0); PG8_BAR; PG8_MMA(1, 0, At, B0); PG8_MMA(1, 1, At, B1); PG8_BAR; PG8_SCHED;
            } else {
            PG8_LDB(B0, 0, 0); PG8_SCHED; PG8_LDA(At, 0, 0); PG8_STAGE(PG8_SA(1, 1), a1 + hstep, voffA);
            PG8_WAIT_L(8); PG8_BAR; PG8_WAIT_L(0); PG8_MMA(0, 0, At, B0); PG8_BAR; PG8_SCHED;
            PG8_LDB(B1, 0, 1); PG8_STAGE(PG8_SB(0, 0), b2, voffB);
            PG8_BAR; PG8_WAIT_L(0); PG8_MMA(0, 1, At, B1); PG8_BAR;
            PG8_LDA(At, 0, 1); PG8_STAGE(PG8_SA(0, 0), a2, voffA);
            PG8_BAR; PG8_WAIT_L(0); PG8_MMA(1, 0, At, B0); PG8_BAR; PG8_SCHED;
            PG8_STAGE(PG8_SB(0, 1), b2 + hstep, voffB);
            PG8_WAIT_V(6); PG8_BAR; PG8_MMA(1, 1, At, B1); PG8_BAR;
            PG8_LDB(B0, 1, 0); PG8_SCHED; PG8_LDA(At, 1, 0); PG8_STAGE(PG8_SA(0, 1), a2 + hstep, voffA);
            PG8_WAIT_L(8); PG8_BAR; PG8_WAIT_L(0); PG8_MMA(0, 0, At, B0); PG8_BAR; PG8_SCHED;
            PG8_LDB(B1, 1, 1); PG8_STAGE(PG8_SB(1, 0), b3, voffB);
            PG8_BAR; PG8_WAIT_L(0); PG8_MMA(0, 1, At, B1); PG8_BAR;
            PG8_LDA(At, 1, 1); PG8_STAGE(PG8_SA(1, 0), a3, voffA);
            PG8_BAR; PG8_WAIT_L(0); PG8_MMA(1, 0, At, B0); PG8_BAR; PG8_SCHED;
            PG8_STAGE(PG8_SB(1, 1), b3 + hstep, voffB);
            PG8_WAIT_V(6); PG8_BAR; PG8_MMA(1, 1, At, B1); PG8_BAR;
            }
        }
        if constexpr (ALIGN_EPI) { if (wr == 0) PG8_BAR; }
        if constexpr (!Epi::AFTER_DRAIN) { E(acc, cur, wr, wc, fr, fq); S.done(cur); }
        if (!has_next) break;
#pragma unroll
        for (int a = 0; a < 2; ++a)
#pragma unroll
            for (int b = 0; b < 2; ++b)
#pragma unroll
                for (int m = 0; m < 4; ++m)
#pragma unroll
                    for (int n = 0; n < 2; ++n) acc[a][b][m][n] = (f32x4){0.f, 0.f, 0.f, 0.f};
        cur = nxt; cA = nA; cB = nB; ++ui;
        if constexpr (ALIGN_EPI) { if (wr == 1) PG8_BAR; }
    }
    PG8_WAIT_V(0);
    if constexpr (!ALIGN_EPI) { if (wr == 0) PG8_BAR; }
    PG8_BAR;
    if constexpr (Epi::AFTER_DRAIN) { E.fused(acc, cur, wr, wc, fr, fq, lds, wid, lane); S.done(cur); }
#undef PG8_SA
#undef PG8_SB
#undef PG8_STAGE
#undef PG8_LDA
#undef PG8_LDB
#undef PG8_MMA
#undef PG8_WAIT_V
#undef PG8_WAIT_L
#undef PG8_BAR
#undef PG8_SCHED
}
}
#define LAS __attribute__((address_space(3)))
#define XB_TMO      128
#define XB_XCNT(j)  (256  + 64 * (j))
#define XB_XSUB(j)  (1280 + 64 * (j))
#define XB_XGEN(j)  (2304 + 64 * (j))
#define XB_TOP      3328
#define XB_TOPGEN   3392
#define XCD_BAR_WORDS 3456
#define XB_SPIN_CAP (1u << 18)

__device__ __forceinline__ unsigned xb_ld(unsigned* p)              { return __hip_atomic_load(p, __ATOMIC_RELAXED, __HIP_MEMORY_SCOPE_AGENT); }
__device__ __forceinline__ unsigned xb_add(unsigned* p, unsigned v) { return __hip_atomic_fetch_add(p, v, __ATOMIC_RELAXED, __HIP_MEMORY_SCOPE_AGENT); }
__device__ __forceinline__ unsigned xb_xcc_id() { return (unsigned)__builtin_amdgcn_s_getreg((3 << 11) | 20) & 0xFu; }
#define XB_SPIN(cond, bar) do { unsigned _sp = 0; while (cond) { __builtin_amdgcn_s_sleep(1); \
    if ((++_sp & 255u) == 0u) { if (xb_ld(&(bar)[XB_TMO])) break; if (_sp > XB_SPIN_CAP) { atomicAdd(&(bar)[XB_TMO], 1u); break; } } } } while (0)

struct XcdBarrier {
    unsigned* bar; unsigned x;
    volatile LAS unsigned* st;
};

__device__ __forceinline__ XcdBarrier xcd_barrier_post(unsigned* bar, volatile LAS unsigned* st) {
    XcdBarrier b; b.bar = bar; b.x = xb_xcc_id(); b.st = st;
    if (threadIdx.x == 0) (void)xb_add(&bar[XB_XCNT(b.x)], 1u);
    return b;
}
__device__ __forceinline__ void xcd_barrier_complete(unsigned* bar, unsigned x, unsigned& nloc, unsigned& nx) {
    const unsigned G = gridDim.x * gridDim.y * gridDim.z;
    unsigned sum, cnt, mine, sp = 0u;
    for (;;) {
        sum = 0u; cnt = 0u; mine = 0u;
#pragma unroll
        for (unsigned j = 0; j < 16; ++j) { const unsigned c = xb_ld(&bar[XB_XCNT(j)]); sum += c; cnt += (c > 0u) ? 1u : 0u; mine = (j == x) ? c : mine; }
        if (sum == G) break;
        __builtin_amdgcn_s_sleep(1);
        if ((++sp & 255u) == 0u) { if (xb_ld(&bar[XB_TMO])) break; if (sp > XB_SPIN_CAP) { atomicAdd(&bar[XB_TMO], 1u); break; } }
    }
    nloc = mine > 0u ? mine : 1u; nx = cnt > 0u ? cnt : 1u;
}

__device__ __forceinline__ void xcd_barrier(const XcdBarrier& b) {
    asm volatile("s_waitcnt vmcnt(0)" ::: "memory");
    __syncthreads();
    if (threadIdx.x == 0) {
        unsigned* bar = b.bar;
        __builtin_amdgcn_s_waitcnt(0);
        unsigned nloc = b.st[0], nx = b.st[1];
        if (nloc == 0u) { xcd_barrier_complete(bar, b.x, nloc, nx); b.st[0] = nloc; b.st[1] = nx; }
        const unsigned old = xb_add(&bar[XB_XSUB(b.x)], 1u);
        const unsigned gen = old / nloc;
        if (old + 1u == (gen + 1u) * nloc) {
            __builtin_amdgcn_fence(__ATOMIC_RELEASE, "agent");
            asm volatile("s_waitcnt vmcnt(0)" ::: "memory");
            const unsigned og = xb_add(&bar[XB_TOP], 1u);
            const unsigned tg = og / nx;
            if (og + 1u == (tg + 1u) * nx) xb_add(&bar[XB_TOPGEN], 1u);
            else XB_SPIN(xb_ld(&bar[XB_TOPGEN]) == tg, bar);
            __builtin_amdgcn_fence(__ATOMIC_ACQUIRE, "agent");
            xb_add(&bar[XB_XGEN(b.x)], 1u);
            asm volatile("s_waitcnt vmcnt(0)" ::: "memory");
        } else {
            XB_SPIN(xb_ld(&bar[XB_XGEN(b.x)]) == gen, bar);
            __builtin_amdgcn_fence(__ATOMIC_ACQUIRE, "agent");
            asm volatile("s_waitcnt vmcnt(0)" ::: "memory");
        }
    }
    __syncthreads();
}
#undef LAS
using pg8::bf16x8; using pg8::f32x4; using pg8::u32x4; using pg8::f32x2;
#define GAS __attribute__((address_space(1)))
#define LAS __attribute__((address_space(3)))
typedef unsigned short bf16;
typedef unsigned v4u __attribute__((ext_vector_type(4)));
typedef unsigned v2u __attribute__((ext_vector_type(2)));
typedef float f32x2v __attribute__((ext_vector_type(2)));

constexpr int NTOK = 40960, DM = 2048, NLAYER = 4, INW = 5120;
constexpr int COL_UA = 0, COL_UB = 512, COL_Q = 1024, COL_K = 2048, COL_V = 3072, COL_G = 4096;
constexpr float ALPHA = 1.6817928305074290f;
constexpr float LN_EPS = 1e-5f, GN_EPS = 1e-6f;
constexpr int NEXP = 16384;
constexpr int NWAVES = 8, NTHR = 512;

constexpr size_t MiB = 1u << 20;
constexpr size_t WS_CTL = 0, CTL_ZERO_BYTES = 1 * MiB;
constexpr size_t WS_WIN = 1 * MiB;
constexpr size_t WS_WOUT = 81 * MiB;
constexpr size_t WS_WS = 113 * MiB;
constexpr size_t WS_WGLU = 145 * MiB;
constexpr size_t WS_WPOOL = 147 * MiB;
constexpr size_t WS_S5A = 149 * MiB;
constexpr size_t WS_S5B = 150 * MiB;
constexpr size_t WS_ROT = 152 * MiB;
constexpr size_t WS_S5BB = 153 * MiB;
constexpr size_t WS_U16 = 160 * MiB;
constexpr size_t WS_V16 = 416 * MiB;
constexpr size_t WS_U8 = 160 * MiB;
constexpr size_t WS_V8 = 288 * MiB;
constexpr size_t WS_USC = 416 * MiB;
constexpr size_t WS_VSC = 417 * MiB;
constexpr size_t WS_ROTC = 420 * MiB;
constexpr size_t WS_ROTS = 424 * MiB;
constexpr size_t WS_XN = 672 * MiB;
constexpr size_t WS_H = 832 * MiB;
constexpr size_t WS_CONCAT = 1232 * MiB;
constexpr size_t WS_BUFY = 1392 * MiB;
constexpr size_t WS_BUFP = 1432 * MiB;
constexpr size_t WS_STF = 1472 * MiB;
constexpr size_t WS_STB = 1632 * MiB;
constexpr size_t WS_IDX = 1792 * MiB;
constexpr size_t WS_GATE = 1812 * MiB;
constexpr size_t WS_S5ST = 1832 * MiB;
constexpr size_t WS_END = 1852 * MiB;
constexpr int CW_BAR = 4096;
constexpr int NPHASE = 1 + NLAYER * 10;

constexpr int LDS_SCRATCH = 147456;
constexpr int LDS_MISC = LDS_SCRATCH;
constexpr int LDS_BYTES = LDS_SCRATCH + 256;

__device__ __forceinline__ float bf_lo(unsigned w) { return __uint_as_float(w << 16); }
__device__ __forceinline__ float bf_hi(unsigned w) { return __uint_as_float(w & 0xffff0000u); }
typedef __bf16 bf16x2_t __attribute__((ext_vector_type(2)));
__device__ __forceinline__ unsigned pkbf(float lo, float hi) { const bf16x2_t v = {(__bf16)lo, (__bf16)hi}; return __builtin_bit_cast(unsigned, v); }
__device__ __forceinline__ bf16 f2bf(float f) { return __builtin_bit_cast(unsigned short, (__bf16)f); }
__device__ __forceinline__ float wave_sum(float v) {
#pragma unroll
    for (int o = 1; o < 64; o <<= 1) v += __shfl_xor(v, o);
    return v;
}
__device__ __forceinline__ float gelu_erf(float v) { return 0.5f * v * (1.0f + erff(v * 0.70710678118654752f)); }
__device__ __forceinline__ int tok_pos(int t) { return t < 32768 ? (t & 4095) : (t - 32768); }
__device__ __forceinline__ int tok_len(int t) { return t < 32768 ? 4096 : 8192; }
__device__ __forceinline__ void unpack8(const v4u q, float (&f)[8]) {
    f[0] = bf_lo(q.x); f[1] = bf_hi(q.x); f[2] = bf_lo(q.y); f[3] = bf_hi(q.y); f[4] = bf_lo(q.z); f[5] = bf_hi(q.z); f[6] = bf_lo(q.w); f[7] = bf_hi(q.w);
}
__device__ __forceinline__ v4u pack8(const float (&f)[8]) { v4u q; q.x = pkbf(f[0], f[1]); q.y = pkbf(f[2], f[3]); q.z = pkbf(f[4], f[5]); q.w = pkbf(f[6], f[7]); return q; }
#define LDS_WAIT() asm volatile("s_waitcnt lgkmcnt(0)" ::: "memory")
#define MFMA16(a, b, c) __builtin_amdgcn_mfma_f32_16x16x32_bf16((a), (b), (c), 0, 0, 0)

struct EpiStoreBf16 {
    static constexpr bool PERM = true, AFTER_DRAIN = false;
    bf16* O; int ldo;
    __device__ __forceinline__ void operator()(const f32x4 (&acc)[2][2][4][2], const pg8::Unit& u, int wr, int wc, int fr, int fq) const {
        const int row0 = u.pm * 256 + wr * 64 + fr, col0 = u.pn * 256 + wc * 32 + 8 * fq;
#pragma unroll
        for (int ai = 0; ai < 2; ++ai)
#pragma unroll
            for (int m = 0; m < 4; ++m) { bf16* rowp = O + (size_t)(row0 + ai * 128 + m * 16) * ldo + col0;
#pragma unroll
                for (int bj = 0; bj < 2; ++bj) { const f32x4 v0 = acc[ai][bj][m][0], v1 = acc[ai][bj][m][1];
                    v4u w; w.x = pkbf(v0[0], v0[1]); w.y = pkbf(v0[2], v0[3]); w.z = pkbf(v1[0], v1[1]); w.w = pkbf(v1[2], v1[3]);
                    *(v4u*)(rowp + bj * 128) = w; } }
    }
};
struct EpiStoreRot {
    static constexpr bool PERM = true, AFTER_DRAIN = false;
    bf16* O; int ldo; const float* rc; const float* rs;
    __device__ __forceinline__ void operator()(const f32x4 (&acc)[2][2][4][2], const pg8::Unit& u, int wr, int wc, int fr, int fq) const {
        const int row0 = u.pm * 256 + wr * 64 + fr, col0 = u.pn * 256 + wc * 32 + 8 * fq;
        const bool rot = u.pn >= 4 && u.pn < 12; const float sc = u.pn >= 8 ? 0.0625f : 1.0f;
#pragma unroll
        for (int ai = 0; ai < 2; ++ai)
#pragma unroll
            for (int m = 0; m < 4; ++m) { const int row = row0 + ai * 128 + m * 16; bf16* rowp = O + (size_t)row * ldo + col0;
                f32x4 a0 = acc[ai][0][m][0], a1 = acc[ai][0][m][1], b0 = acc[ai][1][m][0], b1 = acc[ai][1][m][1];
                if (rot) { const int pos = row < 32768 ? (row & 4095) : (row - 32768); const size_t to = (size_t)pos * 128 + wc * 32 + 8 * fq;
                    const f32x4 c0 = *(const f32x4*)(rc + to), c1 = *(const f32x4*)(rc + to + 4), s0 = *(const f32x4*)(rs + to), s1 = *(const f32x4*)(rs + to + 4);
                    const f32x4 x0 = a0, x1 = a1, y0 = b0, y1 = b1;
                    a0 = (x0 * c0 - y0 * s0) * sc; a1 = (x1 * c1 - y1 * s1) * sc; b0 = (y0 * c0 + x0 * s0) * sc; b1 = (y1 * c1 + x1 * s1) * sc; }
                v4u w; w.x = pkbf(a0[0], a0[1]); w.y = pkbf(a0[2], a0[3]); w.z = pkbf(a1[0], a1[1]); w.w = pkbf(a1[2], a1[3]); *(v4u*)rowp = w;
                v4u x; x.x = pkbf(b0[0], b0[1]); x.y = pkbf(b0[2], b0[3]); x.z = pkbf(b1[0], b1[1]); x.w = pkbf(b1[2], b1[3]); *(v4u*)(rowp + 128) = x; }
    }
};
struct EpiGlu {
    static constexpr bool PERM = true, AFTER_DRAIN = false;
    const bf16* Y; int ldy; bf16* O; int ldo; const float* bias;
    __device__ __forceinline__ void operator()(const f32x4 (&acc)[2][2][4][2], const pg8::Unit& u, int wr, int wc, int fr, int fq) const {
        const int row0 = u.pm * 256 + wr * 64 + fr, col0 = u.pn * 256 + wc * 32 + 8 * fq;
#pragma unroll
        for (int bj = 0; bj < 2; ++bj) {
            const f32x4 b0 = *(const f32x4*)(bias + col0 + bj * 128), b1 = *(const f32x4*)(bias + col0 + bj * 128 + 4);
#pragma unroll
            for (int ai = 0; ai < 2; ++ai)
#pragma unroll
                for (int m = 0; m < 4; ++m) { const size_t r = (size_t)(row0 + ai * 128 + m * 16);
                    const v4u yq = *(const v4u*)(Y + r * ldy + col0 + bj * 128); float y[8]; unpack8(yq, y);
                    const f32x4 v0 = acc[ai][bj][m][0] + b0, v1 = acc[ai][bj][m][1] + b1; float o[8];
#pragma unroll
                    for (int k = 0; k < 4; ++k) { o[k] = y[k] / (1.0f + __expf(-v0[k])); o[4 + k] = y[4 + k] / (1.0f + __expf(-v1[k])); }
                    *(v4u*)(O + r * ldo + col0 + bj * 128) = pack8(o); }
        }
    }
};
struct EpiScaleBf16 {
    static constexpr bool PERM = true, AFTER_DRAIN = false;
    bf16* O; int ldo; const float* scale;
    __device__ __forceinline__ void operator()(const f32x4 (&acc)[2][2][4][2], const pg8::Unit& u, int wr, int wc, int fr, int fq) const {
        const int row0 = u.pm * 256 + wr * 64 + fr, col0 = u.pn * 256 + wc * 32 + 8 * fq;
#pragma unroll
        for (int bj = 0; bj < 2; ++bj) {
            const f32x4 s0 = *(const f32x4*)(scale + col0 + bj * 128), s1 = *(const f32x4*)(scale + col0 + bj * 128 + 4);
#pragma unroll
            for (int ai = 0; ai < 2; ++ai)
#pragma unroll
                for (int m = 0; m < 4; ++m) { const size_t r = (size_t)(row0 + ai * 128 + m * 16);
                    const f32x4 v0 = acc[ai][bj][m][0] * s0, v1 = acc[ai][bj][m][1] * s1;
                    v4u w; w.x = pkbf(v0[0], v0[1]); w.y = pkbf(v0[2], v0[3]); w.z = pkbf(v1[0], v1[1]); w.w = pkbf(v1[2], v1[3]);
                    *(v4u*)(O + r * ldo + col0 + bj * 128) = w; }
        }
    }
};
struct EpiResid {
    static constexpr bool PERM = false, AFTER_DRAIN = false;
    float* X; int ldx; float alpha;
    __device__ __forceinline__ void operator()(const f32x4 (&acc)[2][2][4][2], const pg8::Unit& u, int wr, int wc, int fr, int fq) const {
        const int row0 = u.pm * 256 + wr * 64 + fr, col0 = u.pn * 256 + wc * 32 + 4 * fq;
#pragma unroll
        for (int ai = 0; ai < 2; ++ai)
#pragma unroll
            for (int m = 0; m < 4; ++m) { float* rowp = X + (size_t)(row0 + ai * 128 + m * 16) * ldx + col0;
#pragma unroll
                for (int bj = 0; bj < 2; ++bj)
#pragma unroll
                    for (int n = 0; n < 2; ++n) { f32x4* p = (f32x4*)(rowp + bj * 128 + n * 16); const f32x4 x = *p; *p = x * alpha + acc[ai][bj][m][n]; } }
    }
};
struct EpiStoreF32 {
    static constexpr bool PERM = false, AFTER_DRAIN = false;
    float* C; int ldc;
    __device__ __forceinline__ void operator()(const f32x4 (&acc)[2][2][4][2], const pg8::Unit& u, int wr, int wc, int fr, int fq) const {
        const int row0 = u.pm * 256 + wr * 64 + fr, col0 = u.pn * 256 + wc * 32 + 4 * fq;
#pragma unroll
        for (int ai = 0; ai < 2; ++ai)
#pragma unroll
            for (int m = 0; m < 4; ++m) { float* rowp = C + (size_t)(row0 + ai * 128 + m * 16) * ldc + col0;
#pragma unroll
                for (int bj = 0; bj < 2; ++bj)
#pragma unroll
                    for (int n = 0; n < 2; ++n) *(f32x4*)(rowp + bj * 128 + n * 16) = acc[ai][bj][m][n]; }
    }
};

struct EpiStoreF16 {
    static constexpr bool PERM = true, AFTER_DRAIN = false;
    _Float16* C; int ldc;
    __device__ __forceinline__ void operator()(const f32x4 (&acc)[2][2][4][2], const pg8::Unit& u, int wr, int wc, int fr, int fq) const {
        typedef _Float16 h8 __attribute__((ext_vector_type(8)));
        const int row0 = u.pm * 256 + wr * 64 + fr, col0 = u.pn * 256 + wc * 32 + 8 * fq;
#pragma unroll
        for (int ai = 0; ai < 2; ++ai)
#pragma unroll
            for (int m = 0; m < 4; ++m) { _Float16* rowp = C + (size_t)(row0 + ai * 128 + m * 16) * ldc + col0;
#pragma unroll
                for (int bj = 0; bj < 2; ++bj) { const f32x4 v0 = acc[ai][bj][m][0], v1 = acc[ai][bj][m][1];
                    h8 w; w[0] = (_Float16)v0[0]; w[1] = (_Float16)v0[1]; w[2] = (_Float16)v0[2]; w[3] = (_Float16)v0[3]; w[4] = (_Float16)v1[0]; w[5] = (_Float16)v1[1]; w[6] = (_Float16)v1[2]; w[7] = (_Float16)v1[3];
                    *(h8*)(rowp + bj * 128) = w; } }
    }
};
struct Args { const float* in[26]; float* out; unsigned char* ws; int ph_lo, ph_hi, li, pad; };
typedef const Args __attribute__((address_space(4))) CArgs;
struct Frame {
    LAS unsigned char* lds;
    int tid, lane, wave, G, bx;
    int gw, NGW;
    size_t gtid, NT;
    float* out; unsigned char* ws;
};
enum InIdx { I_XP = 0, I_XS, I_LNIN_G, I_LNIN_B, I_WIN, I_LAMRE, I_LAMIM, I_LOGSTEP, I_BRE, I_BIM, I_CRE, I_CIM, I_S5D, I_WGLU, I_BGLU, I_POOLW, I_POOLS,
             I_WOUT, I_LN1G, I_LN1B, I_WQ, I_KEYS, I_PU, I_PV, I_LN2G, I_LN2B };

__device__ __forceinline__ void ln_row(const float* src, const float* g, const float* b, float* dst, bf16* dstb, int lane) {
    f32x4 v[8]; float s = 0.f;
#pragma unroll
    for (int j = 0; j < 8; ++j) { v[j] = ((const f32x4*)src)[lane + 64 * j]; s += (v[j][0] + v[j][1]) + (v[j][2] + v[j][3]); }
    const float mean = wave_sum(s) * (1.0f / DM); float s2 = 0.f;
#pragma unroll
    for (int j = 0; j < 8; ++j) { v[j] = v[j] - mean; s2 += (v[j][0] * v[j][0] + v[j][1] * v[j][1]) + (v[j][2] * v[j][2] + v[j][3] * v[j][3]); }
    const float rstd = 1.0f / sqrtf(wave_sum(s2) * (1.0f / DM) + LN_EPS);
#pragma unroll
    for (int j = 0; j < 8; ++j) { const f32x4 gg = ((const f32x4*)g)[lane + 64 * j], bb = ((const f32x4*)b)[lane + 64 * j];
        const f32x4 o = v[j] * rstd * gg + bb; ((f32x4*)dst)[lane + 64 * j] = o;
        v2u w; w.x = pkbf(o[0], o[1]); w.y = pkbf(o[2], o[3]); ((v2u*)dstb)[lane + 64 * j] = w; }
}

__device__ __forceinline__ void ln_rows2(bf16* XB, const bf16* MIX, float alpha, const float* g, const float* b, int gw, int ngw, int lane) {
    for (int t = gw; t < NTOK; t += 2 * ngw) {
        const int t2 = t + ngw; const bool has2 = t2 < NTOK; const int tb = has2 ? t2 : t;
        f32x4 v0[8], v1[8]; v2u x0q[8], x1q[8], m0q[8], m1q[8]; float s0 = 0.f, s1 = 0.f;
#pragma unroll
        for (int j = 0; j < 8; ++j) { x0q[j] = ((const v2u*)(XB + (size_t)t * DM))[lane + 64 * j]; m0q[j] = ((const v2u*)(MIX + (size_t)t * DM))[lane + 64 * j]; }
#pragma unroll
        for (int j = 0; j < 8; ++j) { x1q[j] = ((const v2u*)(XB + (size_t)tb * DM))[lane + 64 * j]; m1q[j] = ((const v2u*)(MIX + (size_t)tb * DM))[lane + 64 * j]; }
#pragma unroll
        for (int j = 0; j < 8; ++j) {
            v0[j] = (f32x4){bf_lo(x0q[j].x), bf_hi(x0q[j].x), bf_lo(x0q[j].y), bf_hi(x0q[j].y)} * alpha + (f32x4){bf_lo(m0q[j].x), bf_hi(m0q[j].x), bf_lo(m0q[j].y), bf_hi(m0q[j].y)};
            v1[j] = (f32x4){bf_lo(x1q[j].x), bf_hi(x1q[j].x), bf_lo(x1q[j].y), bf_hi(x1q[j].y)} * alpha + (f32x4){bf_lo(m1q[j].x), bf_hi(m1q[j].x), bf_lo(m1q[j].y), bf_hi(m1q[j].y)};
            s0 += (v0[j][0] + v0[j][1]) + (v0[j][2] + v0[j][3]); s1 += (v1[j][0] + v1[j][1]) + (v1[j][2] + v1[j][3]); }
        const float m0 = wave_sum(s0) * (1.0f / DM), m1 = wave_sum(s1) * (1.0f / DM); float q0 = 0.f, q1 = 0.f;
#pragma unroll
        for (int j = 0; j < 8; ++j) { v0[j] = v0[j] - m0; v1[j] = v1[j] - m1;
            q0 += (v0[j][0] * v0[j][0] + v0[j][1] * v0[j][1]) + (v0[j][2] * v0[j][2] + v0[j][3] * v0[j][3]); q1 += (v1[j][0] * v1[j][0] + v1[j][1] * v1[j][1]) + (v1[j][2] * v1[j][2] + v1[j][3] * v1[j][3]); }
        const float rs0 = 1.0f / sqrtf(wave_sum(q0) * (1.0f / DM) + LN_EPS), rs1 = 1.0f / sqrtf(wave_sum(q1) * (1.0f / DM) + LN_EPS);
#pragma unroll
        for (int j = 0; j < 8; ++j) { const f32x4 gg = ((const f32x4*)g)[lane + 64 * j], bb = ((const f32x4*)b)[lane + 64 * j];
            const f32x4 o0 = v0[j] * rs0 * gg + bb;
            v2u w0; w0.x = pkbf(o0[0], o0[1]); w0.y = pkbf(o0[2], o0[3]); ((v2u*)(XB + (size_t)t * DM))[lane + 64 * j] = w0;
            if (has2) { const f32x4 o1 = v1[j] * rs1 * gg + bb;
                v2u w1; w1.x = pkbf(o1[0], o1[1]); w1.y = pkbf(o1[2], o1[3]); ((v2u*)(XB + (size_t)t2 * DM))[lane + 64 * j] = w1; } }
    }
}

__device__ __forceinline__ void transpose_item(const float* W, int K, int N, bf16* WT, LAS float* scr, int item, int lane) {
    const int nblk = N / 32, kb = item / nblk, nb = item % nblk, k0 = 64 * kb, n0 = 32 * nb;
#pragma unroll 8
    for (int i = 0; i < 32; ++i) { const int kk = 2 * i + (lane >> 5); scr[kk * 33 + (lane & 31)] = W[(size_t)(k0 + kk) * N + n0 + (lane & 31)]; }
    LDS_WAIT();
    const int c = lane & 7;
#pragma unroll
    for (int j = 0; j < 4; ++j) { const int n = (lane >> 3) + 8 * j; const LAS float* s = scr + (8 * c) * 33 + n;
        v4u o; o.x = pkbf(s[0 * 33], s[1 * 33]); o.y = pkbf(s[2 * 33], s[3 * 33]); o.z = pkbf(s[4 * 33], s[5 * 33]); o.w = pkbf(s[6 * 33], s[7 * 33]);
        *(v4u*)(WT + (size_t)(n0 + n) * K + k0 + 8 * c) = o; }
    LDS_WAIT();
}

__device__ __forceinline__ void p0_prologue(const Frame& F, CArgs& A) {
    {
        LAS float* scr = (LAS float*)(F.lds + F.wave * 16384);
        constexpr int I_IN = (DM / 64) * (INW / 32), I_OUT = (DM / 64) * (DM / 32), I_GLU = (512 / 64) * (512 / 32);
        constexpr int NITEMS = NLAYER * (I_IN + I_OUT + I_GLU);
        for (int it = F.gw; it < NITEMS; it += F.NGW) {
            int r = it;
            if (r < NLAYER * I_IN) { const int l = r / I_IN; transpose_item(A.in[I_WIN] + (size_t)l * DM * INW, DM, INW, (bf16*)(F.ws + WS_WIN) + (size_t)l * INW * DM, scr, r % I_IN, F.lane); continue; }
            r -= NLAYER * I_IN;
            if (r < NLAYER * I_OUT) { const int l = r / I_OUT; transpose_item(A.in[I_WOUT] + (size_t)l * DM * DM, DM, DM, (bf16*)(F.ws + WS_WOUT) + (size_t)l * DM * DM, scr, r % I_OUT, F.lane); continue; }
            r -= NLAYER * I_OUT;
            { const int l = r / I_GLU; transpose_item(A.in[I_WGLU] + (size_t)l * 512 * 512, 512, 512, (bf16*)(F.ws + WS_WGLU) + (size_t)l * 512 * 512, scr, r % I_GLU, F.lane); }
        }
    }
#if PEER_FP4
    {
        const int NR2 = 2 * NLAYER * NEXP;
        for (int r = F.gw; r < NR2; r += 2 * F.NGW) {
            const int r2 = r + F.NGW < NR2 ? r + F.NGW : r;
            const int tabA = r >= NLAYER * NEXP, riA = tabA ? r - NLAYER * NEXP : r, tabB = r2 >= NLAYER * NEXP, riB = tabB ? r2 - NLAYER * NEXP : r2;
            const float* srcA = (tabA ? A.in[I_PV] : A.in[I_PU]) + (size_t)riA * DM + F.lane * 4; const float* srcB = (tabB ? A.in[I_PV] : A.in[I_PU]) + (size_t)riB * DM + F.lane * 4;
            f32x4 va[8], vb[8]; float ama = 0.f, amb = 0.f;
#pragma unroll
            for (int q = 0; q < 8; ++q) va[q] = *(const f32x4*)(srcA + q * 256);
#pragma unroll
            for (int q = 0; q < 8; ++q) vb[q] = *(const f32x4*)(srcB + q * 256);
#pragma unroll
            for (int q = 0; q < 8; ++q) { ama = fmaxf(ama, fmaxf(fmaxf(fabsf(va[q][0]), fabsf(va[q][1])), fmaxf(fabsf(va[q][2]), fabsf(va[q][3])))); amb = fmaxf(amb, fmaxf(fmaxf(fabsf(vb[q][0]), fabsf(vb[q][1])), fmaxf(fabsf(vb[q][2]), fabsf(vb[q][3])))); }
#pragma unroll
            for (int o = 1; o < 64; o <<= 1) { ama = fmaxf(ama, __shfl_xor(ama, o)); amb = fmaxf(amb, __shfl_xor(amb, o)); }
#pragma unroll
            for (int half = 0; half < 2; ++half) {
                if (half == 1 && r2 == r) break;
                const float am = half ? amb : ama; const int tab = half ? tabB : tabA, ri = half ? riB : riA;
                const float sc = am > 0.f ? 6.0f / am : 1.0f, isc = am > 0.f ? am * (1.0f / 6.0f) : 1.0f;
                v4u w;
#pragma unroll
                for (int q = 0; q < 4; ++q) { const f32x4 e0 = half ? vb[2 * q] : va[2 * q], e1 = half ? vb[2 * q + 1] : va[2 * q + 1]; unsigned pk = 0u;
                    pk = __builtin_amdgcn_cvt_scalef32_pk_fp4_f32(pk, e0[0] * sc, e0[1] * sc, 1.0f, 0); pk = __builtin_amdgcn_cvt_scalef32_pk_fp4_f32(pk, e0[2] * sc, e0[3] * sc, 1.0f, 1);
                    pk = __builtin_amdgcn_cvt_scalef32_pk_fp4_f32(pk, e1[0] * sc, e1[1] * sc, 1.0f, 2); pk = __builtin_amdgcn_cvt_scalef32_pk_fp4_f32(pk, e1[2] * sc, e1[3] * sc, 1.0f, 3);
                    w[q] = pk; }
                *(v4u*)(F.ws + (tab ? WS_V8 : WS_U8) + (size_t)ri * (DM / 2) + F.lane * 16) = w;
                if (F.lane == 0) ((float*)(F.ws + (tab ? WS_VSC : WS_USC)))[ri] = isc;
            }
        }
    }
#else
    {
        for (int r = F.gw; r < 2 * NLAYER * NEXP; r += F.NGW) {
            const int tab = r >= NLAYER * NEXP, ri = tab ? r - NLAYER * NEXP : r;
            const float* src = (tab ? A.in[I_PV] : A.in[I_PU]) + (size_t)ri * DM;
            f32x4 v[2][4]; float am = 0.f;
#pragma unroll
            for (int c = 0; c < 2; ++c)
#pragma unroll
                for (int q = 0; q < 4; ++q) { v[c][q] = *(const f32x4*)(src + (c * 64 + F.lane) * 16 + q * 4);
                    am = fmaxf(am, fmaxf(fmaxf(fabsf(v[c][q][0]), fabsf(v[c][q][1])), fmaxf(fabsf(v[c][q][2]), fabsf(v[c][q][3])))); }
#pragma unroll
            for (int o = 1; o < 64; o <<= 1) am = fmaxf(am, __shfl_xor(am, o));
            const float sc = am > 0.f ? 384.0f / am : 1.0f, isc = am > 0.f ? am * (1.0f / 384.0f) : 1.0f;
            unsigned char* dst = F.ws + (tab ? WS_V8 : WS_U8) + (size_t)ri * DM;
#pragma unroll
            for (int c = 0; c < 2; ++c) { v4u w;
#pragma unroll
                for (int q = 0; q < 4; ++q) { int pk = 0; pk = __builtin_amdgcn_cvt_pk_fp8_f32(v[c][q][0] * sc, v[c][q][1] * sc, pk, false); pk = __builtin_amdgcn_cvt_pk_fp8_f32(v[c][q][2] * sc, v[c][q][3] * sc, pk, true); w[q] = (unsigned)pk; }
                *(v4u*)(dst + (c * 64 + F.lane) * 16) = w; }
            if (F.lane == 0) ((float*)(F.ws + (tab ? WS_VSC : WS_USC)))[ri] = isc;
        }
    }
#endif
    {
        const float* pw = A.in[I_POOLW]; v4u* dst = (v4u*)(F.ws + WS_WPOOL);
        for (size_t i = F.gtid; i < (size_t)NLAYER * 512 * 64; i += F.NT) {
            const int k8 = (int)(i & 63), n = (int)((i >> 6) & 511), l = (int)(i >> 15);
            const int g = n >> 7, d = n & 127, kg = k8 >> 4, c0 = (k8 & 15) * 8;
            float f[8];
#pragma unroll
            for (int k = 0; k < 8; ++k) f[k] = (kg == g) ? pw[(((size_t)l * 4 + g) * 128 + (c0 + k)) * 128 + d] : 0.f;
            dst[i] = pack8(f);
        }
    }
    {
        const float* lre = A.in[I_LAMRE]; const float* lim = A.in[I_LAMIM]; const float* lst = A.in[I_LOGSTEP]; const float* bre = A.in[I_BRE]; const float* bim = A.in[I_BIM];
        f32x2v* ab = (f32x2v*)(F.ws + WS_S5A); f32x2v* ab64 = (f32x2v*)(F.ws + WS_S5A + 512 * 1024); f32x2v* bb = (f32x2v*)(F.ws + WS_S5B);
        for (size_t i = F.gtid; i < (size_t)NLAYER * 2 * 32 * 64; i += F.NT) {
            const float lr = lre[i], li = lim[i], dt = expf(lst[i >> 6]);
            const float mag = expf(lr * dt), ar = mag * cosf(li * dt), ai = mag * sinf(li * dt);
            const float den = lr * lr + li * li;
            const float zr = ((ar - 1.0f) * lr + ai * li) / den, zi = (ai * lr - (ar - 1.0f) * li) / den;
            ab[i] = (f32x2v){ar, ai};
            const float m64 = expf(lr * dt * 64.0f), an = li * dt * 64.0f;
            ab64[i] = (f32x2v){m64 * cosf(an), m64 * sinf(an)};
#pragma unroll
            for (int c = 0; c < 16; ++c) { const float br = bre[i * 16 + c], bi = bim[i * 16 + c]; bb[i * 16 + c] = (f32x2v){zr * br - zi * bi, zr * bi + zi * br}; }
            {
                bf16* o = (bf16*)(F.ws + WS_S5BB) + ((size_t)(i >> 6) * 128 + 2 * (i & 63)) * 32;
#pragma unroll
                for (int c = 0; c < 16; ++c) { const float br = bre[i * 16 + c], bi = bim[i * 16 + c]; o[c] = f2bf(zr * br - zi * bi); o[32 + c] = f2bf(zr * bi + zi * br); o[16 + c] = 0; o[48 + c] = 0; }
            }
        }
    }
    {
        float* rc = (float*)(F.ws + WS_ROTC); float* rs = (float*)(F.ws + WS_ROTS);
        for (size_t i = F.gtid; i < (size_t)8192 * 128; i += F.NT) { const float inv = (float)exp(-(double)(i & 127) / 127.0 * 9.210340371976184); const float ang = (float)(i >> 7) * inv; rc[i] = cosf(ang); rs[i] = sinf(ang); }
    }
    __syncthreads();
    {
        LAS float* KS = (LAS float*)F.lds;
        LAS float* WQ = (LAS float*)(F.lds + 128 * 132 * 4);
        const float* keys = A.in[I_KEYS]; const float* wq = A.in[I_WQ]; bf16* wst = (bf16*)(F.ws + WS_WS);
        for (int u = F.bx; u < NLAYER * 16 * 32; u += F.G) {
            const int dtl = u & 31, hp = (u >> 5) & 15, l = u >> 9, p = hp & 1;
#pragma unroll
            for (int r = 0; r < 8; ++r) { const int f = F.tid + 512 * r, nk = f >> 5, c4 = f & 31;
                *(LAS f32x4*)(KS + nk * 132 + c4 * 4) = *(const f32x4*)(keys + (((size_t)l * 2 + p) * 128 + nk) * 128 + c4 * 4); }
#pragma unroll
            for (int r = 0; r < 4; ++r) { const int f = F.tid + 512 * r, dd = f >> 5, c4 = f & 31;
                *(LAS f32x4*)(WQ + dd * 132 + c4 * 4) = *(const f32x4*)(wq + ((size_t)l * DM + dtl * 64 + dd) * DM + hp * 128 + c4 * 4); }
            __syncthreads();
            const int nk = F.tid & 127, dg = F.tid >> 7;
            float acc[16];
#pragma unroll
            for (int i = 0; i < 16; ++i) acc[i] = 0.f;
            for (int c4 = 0; c4 < 32; ++c4) {
                const f32x4 kv = *(const LAS f32x4*)(KS + nk * 132 + c4 * 4);
#pragma unroll
                for (int i = 0; i < 16; ++i) { const f32x4 wv = *(const LAS f32x4*)(WQ + (dg * 16 + i) * 132 + c4 * 4);
                    acc[i] += (kv[0] * wv[0] + kv[1] * wv[1]) + (kv[2] * wv[2] + kv[3] * wv[3]); }
            }
            bf16* o = wst + ((size_t)l * DM + hp * 128 + nk) * DM + dtl * 64 + dg * 16;
            v4u q0, q1; q0.x = pkbf(acc[0], acc[1]); q0.y = pkbf(acc[2], acc[3]); q0.z = pkbf(acc[4], acc[5]); q0.w = pkbf(acc[6], acc[7]);
            q1.x = pkbf(acc[8], acc[9]); q1.y = pkbf(acc[10], acc[11]); q1.z = pkbf(acc[12], acc[13]); q1.w = pkbf(acc[14], acc[15]);
            *(v4u*)o = q0; *(v4u*)(o + 8) = q1;
            __syncthreads();
        }
    }
    {
        const float* xp = A.in[I_XP]; const float* xs = A.in[I_XS]; const float* g = A.in[I_LNIN_G]; const float* b = A.in[I_LNIN_B]; bf16* XB = (bf16*)(F.ws + WS_XN);
        for (int t = F.gw; t < NTOK; t += 2 * F.NGW) {
            const int t2 = t + F.NGW; const bool has2 = t2 < NTOK; const int tb = has2 ? t2 : t;
            const float* s0p = t < 32768 ? xp + (size_t)t * DM : xs + (size_t)(t - 32768) * DM; const float* s1p = tb < 32768 ? xp + (size_t)tb * DM : xs + (size_t)(tb - 32768) * DM;
            f32x4 v0[8], v1[8]; float s0 = 0.f, s1 = 0.f;
#pragma unroll
            for (int j = 0; j < 8; ++j) v0[j] = ((const f32x4*)s0p)[F.lane + 64 * j];
#pragma unroll
            for (int j = 0; j < 8; ++j) v1[j] = ((const f32x4*)s1p)[F.lane + 64 * j];
#pragma unroll
            for (int j = 0; j < 8; ++j) { s0 += (v0[j][0] + v0[j][1]) + (v0[j][2] + v0[j][3]); s1 += (v1[j][0] + v1[j][1]) + (v1[j][2] + v1[j][3]); }
            const float m0 = wave_sum(s0) * (1.0f / DM), m1 = wave_sum(s1) * (1.0f / DM); float q0 = 0.f, q1 = 0.f;
#pragma unroll
            for (int j = 0; j < 8; ++j) { v0[j] = v0[j] - m0; v1[j] = v1[j] - m1;
                q0 += (v0[j][0] * v0[j][0] + v0[j][1] * v0[j][1]) + (v0[j][2] * v0[j][2] + v0[j][3] * v0[j][3]); q1 += (v1[j][0] * v1[j][0] + v1[j][1] * v1[j][1]) + (v1[j][2] * v1[j][2] + v1[j][3] * v1[j][3]); }
            const float rs0 = 1.0f / sqrtf(wave_sum(q0) * (1.0f / DM) + LN_EPS), rs1 = 1.0f / sqrtf(wave_sum(q1) * (1.0f / DM) + LN_EPS);
#pragma unroll
            for (int j = 0; j < 8; ++j) { const f32x4 gg = ((const f32x4*)g)[F.lane + 64 * j], bb = ((const f32x4*)b)[F.lane + 64 * j];
                const f32x4 o0 = v0[j] * rs0 * gg + bb;
                v2u w0; w0.x = pkbf(o0[0], o0[1]); w0.y = pkbf(o0[2], o0[3]); ((v2u*)(XB + (size_t)t * DM))[F.lane + 64 * j] = w0;
                if (has2) { const f32x4 o1 = v1[j] * rs1 * gg + bb;
                    v2u w1; w1.x = pkbf(o1[0], o1[1]); w1.y = pkbf(o1[2], o1[3]); ((v2u*)(XB + (size_t)t2 * DM))[F.lane + 64 * j] = w1; } }
        }
    }
}

__device__ __forceinline__ float ret_log2_gamma(int h) { return log2f(1.0f - exp2f(-5.0f - (float)h)); }

__device__ __forceinline__ void s5_pass1(const Frame& F, CArgs& A, int l) {
    LAS float* BUs = (LAS float*)(F.lds + F.wave * 8448);
    const bf16* H = (const bf16*)(F.ws + WS_H);
    const f32x2v* ab = (const f32x2v*)(F.ws + WS_S5A); const bf16* BB = (const bf16*)(F.ws + WS_S5BB);
    f32x2v* st = (f32x2v*)(F.ws + WS_S5ST);
    const int lane = F.lane, lr = lane & 15, lq = lane >> 4;
    const int gstep = F.G < 32 ? F.G : 32;
    for (int g = F.bx % 32; g < 32; g += gstep) {
        const int nwg = F.G < 32 ? 1 : (F.G - g + 31) / 32, rank = F.G < 32 ? 0 : F.bx / 32;
        bf16x8 Bop[2][8]; f32x2v a2[2], arot[2];
#pragma unroll
        for (int dir = 0; dir < 2; ++dir) { const int gi = (l * 2 + dir) * 32 + g; a2[dir] = ab[gi * 64 + lane]; arot[dir] = (f32x2v){-a2[dir][1], a2[dir][1]};
#pragma unroll
            for (int j = 0; j < 8; ++j) Bop[dir][j] = *(const bf16x8*)(BB + ((size_t)gi * 128 + 16 * j + lr) * 32 + lq * 8); }
        for (int ck = rank * NWAVES + F.wave; ck < 640; ck += nwg * NWAVES) {
            bf16x8 uop[4];
#pragma unroll
            for (int tb = 0; tb < 4; ++tb) { const v4u q = lq < 2 ? *(const v4u*)(H + (size_t)(ck * 64 + 16 * tb + lr) * INW + COL_UA + g * 16 + lq * 8) : (v4u){0u, 0u, 0u, 0u}; uop[tb] = __builtin_bit_cast(bf16x8, q); }
#pragma unroll
            for (int dir = 0; dir < 2; ++dir) {
                f32x2v x2 = (f32x2v){0.f, 0.f};
#pragma unroll
                for (int blk = 0; blk < 4; ++blk) {
                    const int tb = dir ? 3 - blk : blk;
#pragma unroll
                    for (int j = 0; j < 8; ++j) { const f32x4 d = MFMA16(Bop[dir][j], uop[tb], ((f32x4){0.f, 0.f, 0.f, 0.f}));
                        *(LAS f32x4*)(BUs + lr * 132 + 16 * j + 4 * lq) = d; }
                    LDS_WAIT();
#pragma unroll
                    for (int s = 0; s < 16; ++s) { const int tl = dir ? 15 - s : s;
                        const f32x2v bu = *(const LAS f32x2v*)(BUs + tl * 132 + 2 * lane);
                        x2 = x2 * a2[dir][0] + (arot[dir] * (f32x2v){x2[1], x2[0]} + bu); }
                    LDS_WAIT();
                }
                st[(size_t)((ck * 32 + g) * 2 + dir) * 64 + lane] = x2;
            }
        }
    }
}
__device__ __forceinline__ void s5_carry(const Frame& F, CArgs& A, int l) {
    const f32x2v* ab64 = (const f32x2v*)(F.ws + WS_S5A + 512 * 1024); f32x2v* st = (f32x2v*)(F.ws + WS_S5ST);
    for (size_t it = F.gtid; it < (size_t)9 * 32 * 2 * 64; it += F.NT) {
        const int p = (int)(it & 63), dir = (int)((it >> 6) & 1), g = (int)((it >> 7) & 31), s = (int)(it >> 12);
        const int ck0 = s < 8 ? s * 64 : 512, n = s < 8 ? 64 : 128;
        const f32x2v a = ab64[((l * 2 + dir) * 32 + g) * 64 + p];
        float cr = 0.f, ci = 0.f;
        for (int k0 = 0; k0 < n; k0 += 8) {
            f32x2v le[8];
#pragma unroll
            for (int kk = 0; kk < 8; ++kk) { const int ck = dir ? (ck0 + n - 1 - (k0 + kk)) : (ck0 + k0 + kk); le[kk] = st[(size_t)((ck * 32 + g) * 2 + dir) * 64 + p]; }
#pragma unroll
            for (int kk = 0; kk < 8; ++kk) { const int ck = dir ? (ck0 + n - 1 - (k0 + kk)) : (ck0 + k0 + kk);
                st[(size_t)((ck * 32 + g) * 2 + dir) * 64 + p] = (f32x2v){cr, ci};
                const float ncr = a[0] * cr - a[1] * ci + le[kk][0], nci = a[0] * ci + a[1] * cr + le[kk][1]; cr = ncr; ci = nci; }
        }
    }
}
__device__ __forceinline__ void s5_pass3(const Frame& F, CArgs& A, int l) {
    LAS bf16* CtS = (LAS bf16*)F.lds;
    LAS unsigned char* wb = F.lds + 8704 + F.wave * 12800;
    LAS float* BUs = (LAS float*)wb;
    LAS bf16* Xw = (LAS bf16*)(wb + 8448);
    const bf16* H = (const bf16*)(F.ws + WS_H); bf16* BY = (bf16*)(F.ws + WS_BUFY);
    const f32x2v* ab = (const f32x2v*)(F.ws + WS_S5A); const bf16* BB = (const bf16*)(F.ws + WS_S5BB);
    const f32x2v* st = (const f32x2v*)(F.ws + WS_S5ST);
    const float* cre = A.in[I_CRE]; const float* cim = A.in[I_CIM]; const float* dvec = A.in[I_S5D] + (size_t)l * 512;
    const int lane = F.lane, lr = lane & 15, lq = lane >> 4;
    const int gstep = F.G < 32 ? F.G : 32;
    for (int g = F.bx % 32; g < 32; g += gstep) {
        const int nwg = F.G < 32 ? 1 : (F.G - g + 31) / 32, rank = F.G < 32 ? 0 : F.bx / 32;
        __syncthreads();
        {
            const int tq = opaque(F.tid);
#pragma unroll
            for (int r = 0; r < 8; ++r) { const int e = tq + 512 * r, pp = e & 127, c = (e >> 7) & 15, dir = e >> 11;
                const size_t cb = (size_t)(((l * 2 + dir) * 32 + g) * 16 + c) * 64;
                CtS[(dir * 16 + c) * 136 + pp] = f2bf(pp < 64 ? cre[cb + pp] : -cim[cb + pp - 64]); }
        }
        bf16x8 Bop[2][8]; f32x2v a2[2], arot[2];
#pragma unroll
        for (int dir = 0; dir < 2; ++dir) { const int gi = (l * 2 + dir) * 32 + g; a2[dir] = ab[gi * 64 + lane]; arot[dir] = (f32x2v){-a2[dir][1], a2[dir][1]};
#pragma unroll
            for (int j = 0; j < 8; ++j) Bop[dir][j] = *(const bf16x8*)(BB + ((size_t)gi * 128 + 16 * j + lr) * 32 + lq * 8); }
        __syncthreads();
        for (int ck = rank * NWAVES + F.wave; ck < 640; ck += nwg * NWAVES) {
            bf16x8 uop[4];
#pragma unroll
            for (int tb = 0; tb < 4; ++tb) { const v4u q = lq < 2 ? *(const v4u*)(H + (size_t)(ck * 64 + 16 * tb + lr) * INW + COL_UA + g * 16 + lq * 8) : (v4u){0u, 0u, 0u, 0u}; uop[tb] = __builtin_bit_cast(bf16x8, q); }
            f32x2v xin[2];
#pragma unroll
            for (int dir = 0; dir < 2; ++dir) xin[dir] = st[(size_t)((ck * 32 + g) * 2 + dir) * 64 + lane];
            f32x4 Y[4];
#pragma unroll
            for (int m = 0; m < 4; ++m) Y[m] = (f32x4){0.f, 0.f, 0.f, 0.f};
#pragma unroll
            for (int dir = 0; dir < 2; ++dir) {
                f32x2v x2 = xin[dir];
#pragma unroll
                for (int blk = 0; blk < 4; ++blk) {
                    const int tb = dir ? 3 - blk : blk;
#pragma unroll
                    for (int j = 0; j < 8; ++j) { const f32x4 d = MFMA16(Bop[dir][j], uop[tb], ((f32x4){0.f, 0.f, 0.f, 0.f}));
                        *(LAS f32x4*)(BUs + lr * 132 + 16 * j + 4 * lq) = d; }
                    LDS_WAIT();
#pragma unroll
                    for (int s = 0; s < 16; ++s) { const int tl = dir ? 15 - s : s;
                        const f32x2v bu = *(const LAS f32x2v*)(BUs + tl * 132 + 2 * lane);
                        x2 = x2 * a2[dir][0] + (arot[dir] * (f32x2v){x2[1], x2[0]} + bu);
                        Xw[tl * 136 + lane] = f2bf(x2[0]); Xw[tl * 136 + 64 + lane] = f2bf(x2[1]); }
                    LDS_WAIT();
#pragma unroll
                    for (int ks = 0; ks < 4; ++ks) {
                        const bf16x8 av = *(const LAS bf16x8*)(CtS + (dir * 16 + lr) * 136 + 32 * ks + lq * 8);
                        const bf16x8 bv = *(const LAS bf16x8*)(Xw + lr * 136 + 32 * ks + lq * 8);
                        Y[tb] = MFMA16(av, bv, Y[tb]);
                    }
                    LDS_WAIT();
                }
            }
#pragma unroll
            for (int m = 0; m < 4; ++m) {
                const int t = 16 * m + lr, c0 = 4 * lq;
                const v2u uq = *(const v2u*)(H + (size_t)(ck * 64 + t) * INW + COL_UA + g * 16 + c0);
                const f32x4 uv = (f32x4){bf_lo(uq.x), bf_hi(uq.x), bf_lo(uq.y), bf_hi(uq.y)}; const f32x4 dv = *(const f32x4*)(dvec + g * 16 + c0);
                const f32x4 y = Y[m] + dv * uv;
                v2u w; w.x = pkbf(gelu_erf(y[0]), gelu_erf(y[1])); w.y = pkbf(gelu_erf(y[2]), gelu_erf(y[3]));
                *(v2u*)(BY + (size_t)(ck * 64 + t) * 512 + g * 16 + c0) = w;
            }
        }
    }
}
__device__ __forceinline__ void pool_phase(const Frame& F, CArgs& A) {
    const bf16* H = (const bf16*)(F.ws + WS_H); bf16* BP = (bf16*)(F.ws + WS_BUFP);
    for (size_t it = F.gtid; it < (size_t)NTOK * 64; it += F.NT) {
        const int t = (int)(it >> 6), o = (int)(it & 63), gi = o >> 4, w = 2 << gi;
        const int pos = tok_pos(t), L = tok_len(t);
        const int lo = max(pos - w / 2, 0), hi = min(pos + w / 2 - 1, L - 1);
        const bf16* base = H + (size_t)(t - pos) * INW + COL_UB + o * 8;
        float s[8];
#pragma unroll
        for (int k = 0; k < 8; ++k) s[k] = 0.f;
        v4u wq[16];
#pragma unroll
        for (int i = 0; i < 16; ++i) { const int si = lo + i <= hi ? lo + i : hi; wq[i] = *(const v4u*)(base + (size_t)si * INW); }
#pragma unroll
        for (int i = 0; i < 16; ++i) { float f[8]; unpack8(wq[i], f); const float wgt = lo + i <= hi ? 1.0f : 0.0f;
#pragma unroll
            for (int k = 0; k < 8; ++k) s[k] += wgt * f[k]; }
        const float inv = 1.0f / (float)(hi - lo + 1);
        float c[8]; unpack8(*(const v4u*)(base + (size_t)pos * INW), c);
#pragma unroll
        for (int k = 0; k < 8; ++k) s[k] = s[k] * inv - c[k];
        *(v4u*)(BP + (size_t)t * 512 + o * 8) = pack8(s);
    }
}
__device__ __forceinline__ void rotary_phase(const Frame& F, CArgs& A) {
    bf16* H = (bf16*)(F.ws + WS_H); const float* rot = (const float*)(F.ws + WS_ROT);
    for (size_t it = F.gtid; it < (size_t)NTOK * 16; it += F.NT) {
        const int t = (int)(it >> 4), o = (int)(it & 15); const float pos = (float)tok_pos(t);
        float cs[8], sn[8];
#pragma unroll
        for (int k = 0; k < 8; ++k) { const float ang = pos * rot[o * 8 + k]; cs[k] = cosf(ang); sn[k] = sinf(ang); }
#pragma unroll
        for (int which = 0; which < 2; ++which) {
            const float sc = which ? 0.0625f : 1.0f;
#pragma unroll
            for (int hd = 0; hd < 4; ++hd) {
                bf16* p1 = H + (size_t)t * INW + (which ? COL_K : COL_Q) + hd * 256 + o * 8; bf16* p2 = p1 + 128;
                float x1[8], x2[8], o1[8], o2[8]; unpack8(*(const v4u*)p1, x1); unpack8(*(const v4u*)p2, x2);
#pragma unroll
                for (int k = 0; k < 8; ++k) { o1[k] = (x1[k] * cs[k] - x2[k] * sn[k]) * sc; o2[k] = (x2[k] * cs[k] + x1[k] * sn[k]) * sc; }
                *(v4u*)p1 = pack8(o1); *(v4u*)p2 = pack8(o2);
            }
        }
    }
}
constexpr int RS = 136;
template <int MODE = 0> __device__ __forceinline__ void ret_state_phase(const Frame& F, CArgs& A) {
    const bf16* H = (const bf16*)(F.ws + WS_H); bf16* STF = (bf16*)(F.ws + WS_STF); bf16* STB = (bf16*)(F.ws + WS_STB);
    LAS bf16* Kt = (LAS bf16*)F.lds; LAS bf16* VtF = Kt + 128 * RS; LAS bf16* VtB = Kt + 256 * RS;
    LAS unsigned* Kt32 = (LAS unsigned*)Kt; LAS unsigned* VtF32 = (LAS unsigned*)VtF; LAS unsigned* VtB32 = (LAS unsigned*)VtB;
    const int tid = F.tid, lane = F.lane, lr = lane & 15, lq = lane >> 4, we = F.wave >> 1, wd = F.wave & 1;
    const int jp = tid & 63, j = 2 * jp, pc0 = tid >> 6;
    v4u pk0[2], pk1[2], pv0[2], pv1[2];
#define RS_LOAD(u_) do { const int dh_ = (u_) & 1, eh_ = ((u_) >> 1) & 1, h_ = ((u_) >> 2) & 3, c_ = (u_) >> 4; \
        const bf16* krow_ = H + (size_t)(c_ * 128 + j) * INW + COL_K + h_ * 256 + dh_ * 128; const bf16* vrow_ = H + (size_t)(c_ * 128 + j) * INW + COL_V + h_ * 256 + eh_ * 128; \
        _Pragma("unroll") for (int r = 0; r < 2; ++r) { const int pc = pc0 + 8 * r; pk0[r] = *(const v4u*)(krow_ + pc * 8); pk1[r] = *(const v4u*)(krow_ + INW + pc * 8); pv0[r] = *(const v4u*)(vrow_ + pc * 8); pv1[r] = *(const v4u*)(vrow_ + INW + pc * 8); } } while (0)
    if (F.bx < 5120) RS_LOAD(F.bx);
    for (int u = F.bx; u < 5120; u += F.G) {
        const int dh = u & 1, eh = (u >> 1) & 1, h = (u >> 2) & 3, c = u >> 4;
        if (MODE != 2) {
            const float lg = ret_log2_gamma(h), fF0 = exp2f(lg * (float)(127 - j)), fF1 = exp2f(lg * (float)(126 - j)), fB0 = exp2f(lg * (float)j), fB1 = exp2f(lg * (float)(j + 1));
#pragma unroll
            for (int r = 0; r < 2; ++r) {
                const int pc = pc0 + 8 * r;
                const unsigned ka0[4] = {pk0[r].x, pk0[r].y, pk0[r].z, pk0[r].w}, ka1[4] = {pk1[r].x, pk1[r].y, pk1[r].z, pk1[r].w};
                float f0[8], f1[8]; unpack8(pv0[r], f0); unpack8(pv1[r], f1);
#pragma unroll
                for (int i = 0; i < 8; ++i) {
                    const unsigned a = ka0[i >> 1], b = ka1[i >> 1];
                    const unsigned kk = (i & 1) ? ((a >> 16) | (b & 0xffff0000u)) : ((a & 0xffffu) | (b << 16));
                    const int o = ((pc * 8 + i) * RS) / 2 + jp;
                    Kt32[o] = kk; VtF32[o] = pkbf(f0[i] * fF0, f1[i] * fF1); VtB32[o] = pkbf(f0[i] * fB0, f1[i] * fB1);
                }
            }
        }
        __syncthreads();
        if (u + F.G < 5120) RS_LOAD(u + F.G);
        if (MODE == 1) { __syncthreads(); continue; }
        f32x4 aF[4][2], aB[4][2];
#pragma unroll
        for (int td = 0; td < 4; ++td)
#pragma unroll
            for (int te = 0; te < 2; ++te) { aF[td][te] = (f32x4){0.f, 0.f, 0.f, 0.f}; aB[td][te] = (f32x4){0.f, 0.f, 0.f, 0.f}; }
#pragma unroll
        for (int ks = 0; ks < 4; ++ks) {
            bf16x8 ka[4], vF[2], vB[2];
#pragma unroll
            for (int td = 0; td < 4; ++td) ka[td] = *(const LAS bf16x8*)(Kt + (64 * wd + 16 * td + lr) * RS + 32 * ks + lq * 8);
#pragma unroll
            for (int te = 0; te < 2; ++te) { vF[te] = *(const LAS bf16x8*)(VtF + (32 * we + 16 * te + lr) * RS + 32 * ks + lq * 8); vB[te] = *(const LAS bf16x8*)(VtB + (32 * we + 16 * te + lr) * RS + 32 * ks + lq * 8); }
#pragma unroll
            for (int td = 0; td < 4; ++td)
#pragma unroll
                for (int te = 0; te < 2; ++te) { aF[td][te] = MFMA16(ka[td], vF[te], aF[td][te]); aB[td][te] = MFMA16(ka[td], vB[te], aB[td][te]); }
        }
        __syncthreads();
        {
            LAS bf16* OutF = Kt; LAS bf16* OutB = Kt + 128 * RS;
#pragma unroll
            for (int td = 0; td < 4; ++td)
#pragma unroll
                for (int te = 0; te < 2; ++te) {
                    const int e = 32 * we + 16 * te + lr, d = 64 * wd + 16 * td + 4 * lq;
                    v2u w; w.x = pkbf(aF[td][te][0], aF[td][te][1]); w.y = pkbf(aF[td][te][2], aF[td][te][3]); *(LAS v2u*)(OutF + e * RS + d) = w;
                    v2u x; x.x = pkbf(aB[td][te][0], aB[td][te][1]); x.y = pkbf(aB[td][te][2], aB[td][te][3]); *(LAS v2u*)(OutB + e * RS + d) = x;
                }
            __syncthreads();
            const int tq = opaque(tid);
#pragma unroll
            for (int r = 0; r < 8; ++r) { const int f = tq + 512 * r, mat = f >> 11, row = (f >> 4) & 127, pc = f & 15;
                const v4u q = *(const LAS v4u*)(Kt + (mat * 128 + row) * RS + pc * 8);
                bf16* dst = (mat ? STB : STF) + ((size_t)(c * 4 + h) * 256 + eh * 128 + row) * 256 + dh * 128 + pc * 8;
                *(v4u*)dst = q; }
        }
        __syncthreads();
    }
#undef RS_LOAD
}
__device__ __forceinline__ void ret_prefix_phase(const Frame& F, CArgs& A) {
    bf16* STF = (bf16*)(F.ws + WS_STF); bf16* STB = (bf16*)(F.ws + WS_STB);
    for (size_t it = F.gtid; it < (size_t)36 * 2 * 8192; it += F.NT) {
        const int o = (int)(it & 8191), which = (int)((it >> 13) & 1), bh = (int)(it >> 14), h = bh & 3, s = bh >> 2;
        const int c0 = s < 8 ? s * 32 : 256, n = s < 8 ? 32 : 64;
        const float dec = exp2f(128.0f * ret_log2_gamma(h));
        float st[8];
#pragma unroll
        for (int k = 0; k < 8; ++k) st[k] = 0.f;
        bf16* base = (which ? STB : STF) + (size_t)h * 65536 + (size_t)o * 8;
        for (int k0 = 0; k0 < n; k0 += 8) {
            v4u q[8];
#pragma unroll
            for (int kk = 0; kk < 8; ++kk) { const int c = which ? (c0 + n - 1 - (k0 + kk)) : (c0 + k0 + kk); q[kk] = *(const v4u*)(base + (size_t)c * 4 * 65536); }
#pragma unroll
            for (int kk = 0; kk < 8; ++kk) { const int c = which ? (c0 + n - 1 - (k0 + kk)) : (c0 + k0 + kk);
                float f[8]; unpack8(q[kk], f);
#pragma unroll
                for (int i = 0; i < 8; ++i) st[i] = dec * st[i] + f[i];
                *(v4u*)(base + (size_t)c * 4 * 65536) = pack8(st); }
        }
    }
}
__device__ __forceinline__ void ret_out_phase(const Frame& F, CArgs& A) {
    const bf16* H = (const bf16*)(F.ws + WS_H); const bf16* STF = (const bf16*)(F.ws + WS_STF); const bf16* STB = (const bf16*)(F.ws + WS_STB);
    bf16* CC = (bf16*)(F.ws + WS_CONCAT);
    LAS bf16* RA = (LAS bf16*)F.lds; LAS bf16* RB = RA + 128 * RS; LAS bf16* RC = RA + 384 * RS;
    const int tid = F.tid, wi = F.wave >> 2, wj = F.wave & 3, we = F.wave & 3;
    for (int u = F.bx; u < 1280; u += F.G) {
        const int lane = opaque(F.lane), lr = lane & 15, lq = lane >> 4;
        const int h = u & 3, c = u >> 2, t0 = c * 128;
        const int cs = c < 256 ? (c & 31) : (c - 256), ncs = c < 256 ? 32 : 64;
        const bool has_f = cs > 0, has_b = cs < ncs - 1;
        const float lg = ret_log2_gamma(h);
        const int tq = opaque(tid);
        v4u pa[4], pb[8];
#define RO_LOAD_QK(dh_) do { _Pragma("unroll") for (int r = 0; r < 4; ++r) { const int f = tq + 512 * r, row = f >> 4, pc = f & 15; \
            const bf16* src = H + (size_t)(t0 + row) * INW + h * 256 + (dh_) * 128 + pc * 8; pa[r] = *(const v4u*)(src + COL_Q); pb[r] = *(const v4u*)(src + COL_K); } } while (0)
#define RO_STORE_QK() do { _Pragma("unroll") for (int r = 0; r < 4; ++r) { const int f = tq + 512 * r, row = f >> 4, pc = f & 15; \
            *(LAS v4u*)(RA + row * RS + pc * 8) = pa[r]; *(LAS v4u*)(RB + row * RS + pc * 8) = pb[r]; } } while (0)
#define RO_LOAD_V() do { const int jp_ = tq & 63, pc0_ = tq >> 6; const bf16* vrow = H + (size_t)(t0 + 2 * jp_) * INW + COL_V + h * 256; \
            _Pragma("unroll") for (int r = 0; r < 4; ++r) { const int pc = pc0_ + 8 * r; pb[r] = *(const v4u*)(vrow + pc * 8); pb[4 + r] = *(const v4u*)(vrow + INW + pc * 8); } } while (0)
#define RO_STORE_V() do { const int jp_ = tq & 63, pc0_ = tq >> 6; LAS unsigned* RB32 = (LAS unsigned*)RB; \
            _Pragma("unroll") for (int r = 0; r < 4; ++r) { const int pc = pc0_ + 8 * r; \
                const unsigned va0[4] = {pb[r].x, pb[r].y, pb[r].z, pb[r].w}, va1[4] = {pb[4 + r].x, pb[4 + r].y, pb[4 + r].z, pb[4 + r].w}; \
                _Pragma("unroll") for (int i = 0; i < 8; ++i) { const unsigned a = va0[i >> 1], b = va1[i >> 1]; \
                    RB32[((pc * 8 + i) * RS) / 2 + jp_] = (i & 1) ? ((a >> 16) | (b & 0xffff0000u)) : ((a & 0xffffu) | (b << 16)); } } } while (0)
#define RO_LOAD_I(dir_, dh_) do { const bool has_ = (dir_) == 0 ? has_f : has_b; const int cn_ = (dir_) == 0 ? c - 1 : c + 1; \
            const bf16* St = ((dir_) == 0 ? STF : STB) + (size_t)((has_ ? cn_ : c) * 4 + h) * 65536; \
            _Pragma("unroll") for (int r = 0; r < 8; ++r) { const int f = tq + 512 * r, row = f >> 4, pc = f & 15; pb[r] = has_ ? *(const v4u*)(St + (size_t)row * 256 + (dh_) * 128 + pc * 8) : (v4u){0u, 0u, 0u, 0u}; } } while (0)
#define RO_STORE_I(dir_, dh_) do { \
            _Pragma("unroll") for (int r = 0; r < 4; ++r) { const int f = tq + 512 * r, row = f >> 4, pc = f & 15; pa[r] = *(const v4u*)(H + (size_t)(t0 + row) * INW + COL_Q + h * 256 + (dh_) * 128 + pc * 8); } \
            _Pragma("unroll") for (int r = 0; r < 4; ++r) { const int f = tq + 512 * r, row = f >> 4, pc = f & 15; \
                const float fac = exp2f(lg * ((dir_) == 0 ? (float)(row + 1) : (float)(128 - row))); float qf[8]; unpack8(pa[r], qf); \
                _Pragma("unroll") for (int k = 0; k < 8; ++k) qf[k] *= fac; \
                *(LAS v4u*)(RA + row * RS + pc * 8) = pack8(qf); } \
            _Pragma("unroll") for (int r = 0; r < 8; ++r) { const int f = tq + 512 * r, row = f >> 4, pc = f & 15; *(LAS v4u*)(RB + row * RS + pc * 8) = pb[r]; } } while (0)
        f32x4 S[4][2];
#pragma unroll
        for (int ti = 0; ti < 4; ++ti)
#pragma unroll
            for (int tj = 0; tj < 2; ++tj) S[ti][tj] = (f32x4){0.f, 0.f, 0.f, 0.f};
        RO_LOAD_QK(0);
#pragma unroll
        for (int dh = 0; dh < 2; ++dh) {
            if (dh) __syncthreads();
            RO_STORE_QK();
            __syncthreads();
            if (dh == 0) RO_LOAD_QK(1); else RO_LOAD_V();
#pragma unroll
            for (int ks = 0; ks < 4; ++ks) {
                bf16x8 ka[2], qb[4];
#pragma unroll
                for (int tj = 0; tj < 2; ++tj) ka[tj] = *(const LAS bf16x8*)(RB + (32 * wj + 16 * tj + lr) * RS + 32 * ks + lq * 8);
#pragma unroll
                for (int ti = 0; ti < 4; ++ti) qb[ti] = *(const LAS bf16x8*)(RA + (64 * wi + 16 * ti + lr) * RS + 32 * ks + lq * 8);
#pragma unroll
                for (int ti = 0; ti < 4; ++ti)
#pragma unroll
                    for (int tj = 0; tj < 2; ++tj) S[ti][tj] = MFMA16(ka[tj], qb[ti], S[ti][tj]);
            }
        }
#pragma unroll
        for (int ti = 0; ti < 4; ++ti)
#pragma unroll
            for (int tj = 0; tj < 2; ++tj) {
                const int i = 64 * wi + 16 * ti + lr, j0 = 32 * wj + 16 * tj + 4 * lq; float p[4];
#pragma unroll
                for (int jj = 0; jj < 4; ++jj) { const int d = i - (j0 + jj); p[jj] = S[ti][tj][jj] * exp2f(lg * (float)(d < 0 ? -d : d)); }
                v2u w; w.x = pkbf(p[0], p[1]); w.y = pkbf(p[2], p[3]); *(LAS v2u*)(RC + i * RS + j0) = w;
            }
        __syncthreads();
        RO_STORE_V();
        __syncthreads();
        RO_LOAD_I(0, 0);
        f32x4 O[4][4];
#pragma unroll
        for (int ti = 0; ti < 4; ++ti)
#pragma unroll
            for (int te = 0; te < 4; ++te) O[ti][te] = (f32x4){0.f, 0.f, 0.f, 0.f};
#pragma unroll
        for (int ks = 0; ks < 4; ++ks) {
            bf16x8 va[4], pbf[4];
#pragma unroll
            for (int te = 0; te < 4; ++te) va[te] = *(const LAS bf16x8*)(RB + (64 * we + 16 * te + lr) * RS + 32 * ks + lq * 8);
#pragma unroll
            for (int ti = 0; ti < 4; ++ti) pbf[ti] = *(const LAS bf16x8*)(RC + (64 * wi + 16 * ti + lr) * RS + 32 * ks + lq * 8);
#pragma unroll
            for (int ti = 0; ti < 4; ++ti)
#pragma unroll
                for (int te = 0; te < 4; ++te) O[ti][te] = MFMA16(va[te], pbf[ti], O[ti][te]);
        }
#pragma unroll
        for (int stg = 0; stg < 4; ++stg) {
            __syncthreads();
            if (stg == 0) RO_STORE_I(0, 0); else if (stg == 1) RO_STORE_I(0, 1); else if (stg == 2) RO_STORE_I(1, 0); else RO_STORE_I(1, 1);
            __syncthreads();
            if (stg == 0) RO_LOAD_I(0, 1); else if (stg == 1) RO_LOAD_I(1, 0); else if (stg == 2) RO_LOAD_I(1, 1);
#pragma unroll
            for (int ks = 0; ks < 4; ++ks) {
                bf16x8 sa[4], qb[4];
#pragma unroll
                for (int te = 0; te < 4; ++te) sa[te] = *(const LAS bf16x8*)(RB + (64 * we + 16 * te + lr) * RS + 32 * ks + lq * 8);
#pragma unroll
                for (int ti = 0; ti < 4; ++ti) qb[ti] = *(const LAS bf16x8*)(RA + (64 * wi + 16 * ti + lr) * RS + 32 * ks + lq * 8);
#pragma unroll
                for (int ti = 0; ti < 4; ++ti)
#pragma unroll
                    for (int te = 0; te < 4; ++te) O[ti][te] = MFMA16(sa[te], qb[ti], O[ti][te]);
            }
        }
#undef RO_LOAD_QK
#undef RO_STORE_QK
#undef RO_LOAD_V
#undef RO_STORE_V
#undef RO_LOAD_I
#undef RO_STORE_I
        __syncthreads();
        LAS float* RED = (LAS float*)RA;
#pragma unroll
        for (int ti = 0; ti < 4; ++ti) { float s1 = 0.f, s2 = 0.f;
#pragma unroll
            for (int te = 0; te < 4; ++te)
#pragma unroll
                for (int jj = 0; jj < 4; ++jj) { const float v = O[ti][te][jj]; s1 += v; s2 += v * v; }
            s1 += __shfl_xor(s1, 16); s1 += __shfl_xor(s1, 32); s2 += __shfl_xor(s2, 16); s2 += __shfl_xor(s2, 32);
            if (lq == 0) { RED[((64 * wi + 16 * ti + lr) * 4 + we) * 2] = s1; RED[((64 * wi + 16 * ti + lr) * 4 + we) * 2 + 1] = s2; } }
        __syncthreads();
        LAS bf16* ON = RB;
#pragma unroll
        for (int ti = 0; ti < 4; ++ti) { const int i = 64 * wi + 16 * ti + lr;
            const f32x4 r0 = *(const LAS f32x4*)(RED + i * 8), r1 = *(const LAS f32x4*)(RED + i * 8 + 4);
            const float m = (r0[0] + r0[2] + r1[0] + r1[2]) * (1.0f / 256.0f), q = (r0[1] + r0[3] + r1[1] + r1[3]) * (1.0f / 256.0f);
            const float var = fmaxf(q - m * m, 0.f), rstd = 1.0f / sqrtf(var + GN_EPS);
#pragma unroll
            for (int te = 0; te < 4; ++te) { const int e0 = 64 * we + 16 * te + 4 * lq;
                v2u w; w.x = pkbf((O[ti][te][0] - m) * rstd, (O[ti][te][1] - m) * rstd); w.y = pkbf((O[ti][te][2] - m) * rstd, (O[ti][te][3] - m) * rstd);
                *(LAS v2u*)(ON + i * 264 + e0) = w; } }
        __syncthreads();
        {
            const int tq2 = opaque(tid);
#pragma unroll
            for (int r = 0; r < 8; ++r) { const int f = tq2 + 512 * r, row = f >> 5, pc = f & 31;
                float ov[8], gv[8]; unpack8(*(const LAS v4u*)(ON + row * 264 + pc * 8), ov); unpack8(*(const v4u*)(H + (size_t)(t0 + row) * INW + COL_G + h * 256 + pc * 8), gv);
#pragma unroll
                for (int k = 0; k < 8; ++k) ov[k] = (gv[k] / (1.0f + __expf(-gv[k]))) * ov[k];
                *(v4u*)(CC + (size_t)(t0 + row) * DM + 1024 + h * 256 + pc * 8) = pack8(ov); }
        }
        __syncthreads();
    }
}

__device__ __forceinline__ unsigned f2key(float f) { const unsigned u = __float_as_uint(f); return (u & 0x80000000u) ? ~u : (u | 0x80000000u); }
__device__ __forceinline__ float key2f(unsigned k) { const unsigned u = (k & 0x80000000u) ? (k & 0x7fffffffu) : ~k; return __uint_as_float(u); }
#define TK_CE(a, b) do { const unsigned hi_ = (a) > (b) ? (a) : (b), lo_ = (a) > (b) ? (b) : (a); (a) = hi_; (b) = lo_; } while (0)
__device__ __forceinline__ void bitonic_merge16(unsigned (&v)[16]) {
#pragma unroll
    for (int j = 8; j > 0; j >>= 1)
#pragma unroll
        for (int i = 0; i < 16; ++i) { const int l = i ^ j; if (l > i) TK_CE(v[i], v[l]); }
}
__device__ __forceinline__ void bitonic_sort16(unsigned (&v)[16]) {
#pragma unroll
    for (int k = 2; k <= 16; k <<= 1)
#pragma unroll
        for (int j = k >> 1; j > 0; j >>= 1)
#pragma unroll
            for (int i = 0; i < 16; ++i) { const int l = i ^ j; if (l > i) { if ((i & k) == 0) TK_CE(v[i], v[l]); else TK_CE(v[l], v[i]); } }
}
__device__ __forceinline__ void topk_phase(const Frame& F, CArgs& A) {
    const _Float16* SC = (const _Float16*)(F.ws + WS_H); int* IDX = (int*)(F.ws + WS_IDX); float* GATE = (float*)(F.ws + WS_GATE);
    typedef _Float16 h8 __attribute__((ext_vector_type(8)));
    LAS unsigned* LK = (LAS unsigned*)F.lds;
    const int tid = F.tid, tl = tid >> 4, hp = tid & 15;
    for (int blk = F.bx; blk < NTOK / 32; blk += F.G) {
        const int t = blk * 32 + tl;
        const _Float16* row = SC + (size_t)t * DM + hp * 128;
        unsigned run[16];
#pragma unroll
        for (int k = 0; k < 16; ++k) run[k] = 0u;
        h8 cur[16];
#pragma unroll
        for (int q = 0; q < 16; ++q) cur[q] = *(const h8*)(row + q * 8);
#pragma unroll
        for (int c16 = 0; c16 < 8; ++c16) {
            unsigned ch[16];
#pragma unroll
            for (int q = 0; q < 2; ++q)
#pragma unroll
                for (int e = 0; e < 8; ++e) { const int n = c16 * 16 + q * 8 + e; ch[q * 8 + e] = (f2key((float)cur[c16 * 2 + q][e]) & ~127u) | (unsigned)(127 - n); }
            bitonic_sort16(ch);
#pragma unroll
            for (int i = 0; i < 16; ++i) run[i] = run[i] > ch[15 - i] ? run[i] : ch[15 - i];
            bitonic_merge16(run);
        }
#pragma unroll
        for (int k = 0; k < 16; ++k) LK[tid * 17 + k] = run[k];
        __syncthreads();
        if ((hp & 1) == 0) {
            float a[16], b[16];
#pragma unroll
            for (int k = 0; k < 16; ++k) { a[k] = key2f(LK[tid * 17 + k] & ~127u); b[k] = key2f(LK[(tid + 1) * 17 + k] & ~127u); }
            unsigned sk[16];
#pragma unroll
            for (int k = 0; k < 16; ++k) sk[k] = 0u;
#pragma unroll
            for (int i = 0; i < 16; ++i)
#pragma unroll
                for (int j = 0; j < 16; ++j) if ((i + 1) * (j + 1) <= 16) {
                    unsigned key = (f2key(a[i] + b[j]) & ~255u) | (unsigned)(255 - (i * 16 + j));
#pragma unroll
                    for (int k = 0; k < 16; ++k) { const unsigned hi = sk[k] > key ? sk[k] : key, lo = sk[k] > key ? key : sk[k]; sk[k] = hi; key = lo; }
                }
            float e[16], sum = 0.f; const float s0 = key2f(sk[0] & ~255u);
#pragma unroll
            for (int k = 0; k < 16; ++k) { e[k] = __expf(key2f(sk[k] & ~255u) - s0); sum += e[k]; }
            const float inv = 1.0f / sum; const int head = hp >> 1;
#pragma unroll
            for (int k = 0; k < 16; ++k) {
                const int cell = 255 - (int)(sk[k] & 255u);
                const int i1 = 127 - (int)(LK[tid * 17 + (cell >> 4)] & 127u), i2 = 127 - (int)(LK[(tid + 1) * 17 + (cell & 15)] & 127u);
                IDX[(size_t)t * 128 + head * 16 + k] = i1 * 128 + i2;
                GATE[(size_t)t * 128 + head * 16 + k] = e[k] * inv;
            }
        }
        __syncthreads();
    }
}
#if PEER_FP4
__device__ __forceinline__ void peer_gather_phase(const Frame& F, CArgs& A, int l, float* xdst_base, bf16* XN) {
    constexpr int RB = DM / 2;
    constexpr int GNR = GATHER_ROWS;
    const unsigned char* U8 = F.ws + WS_U8 + (size_t)l * NEXP * RB; const unsigned char* V8 = F.ws + WS_V8 + (size_t)l * NEXP * RB;
    const float* USC = (const float*)(F.ws + WS_USC) + (size_t)l * NEXP; const float* VSC = (const float*)(F.ws + WS_VSC) + (size_t)l * NEXP;
    const int* IDX = (const int*)(F.ws + WS_IDX); const float* GATE = (const float*)(F.ws + WS_GATE);
    const float* g2 = A.in[I_LN2G] + (size_t)l * DM; const float* b2 = A.in[I_LN2B] + (size_t)l * DM;
    const int lane = F.lane, slot = 8 * (lane & 7) + (lane >> 3);
    for (int t = F.gw; t < NTOK; t += F.NGW) {
        const bf16* xrow = XN + (size_t)t * DM;
        f32x2v x[16];
#pragma unroll
        for (int q = 0; q < 8; ++q) { const v2u a = *(const v2u*)(xrow + q * 256 + lane * 4); x[2 * q] = (f32x2v){bf_lo(a.x), bf_hi(a.x)}; x[2 * q + 1] = (f32x2v){bf_lo(a.y), bf_hi(a.y)}; }
        const int idx0 = IDX[(size_t)t * 128 + slot], idx1 = IDX[(size_t)t * 128 + 64 + slot];
        const float gate0 = GATE[(size_t)t * 128 + slot], gate1 = GATE[(size_t)t * 128 + 64 + slot];
        const float usc0 = USC[idx0], usc1 = USC[idx1], vsc0 = VSC[idx0], vsc1 = VSC[idx1];
        v4u BU[GNR];
        const unsigned loff = (unsigned)lane * 16u;
#define G_ROW_U(R) (U8 + (size_t)(unsigned)__builtin_amdgcn_readlane((((R) >> 6) & 1) ? idx1 : idx0, ((R) & 7) * 8 + (((R) >> 3) & 7)) * RB)
#define G_ROW_V(R) (V8 + (size_t)(unsigned)__builtin_amdgcn_readlane((((R) >> 6) & 1) ? idx1 : idx0, (R) & 63) * RB)
#define G_REQ(r, rowptr) do { BU[r] = *(const v4u*)((rowptr) + loff); } while (0)
#define G_DOT(r, dst) do { f32x2v s2_ = (f32x2v){0.f, 0.f}; \
            _Pragma("unroll") for (int q = 0; q < 4; ++q) { s2_ += __builtin_amdgcn_cvt_scalef32_pk_f32_fp4(BU[r][q], 1.0f, 0) * x[4 * q]; s2_ += __builtin_amdgcn_cvt_scalef32_pk_f32_fp4(BU[r][q], 1.0f, 1) * x[4 * q + 1]; \
                s2_ += __builtin_amdgcn_cvt_scalef32_pk_f32_fp4(BU[r][q], 1.0f, 2) * x[4 * q + 2]; s2_ += __builtin_amdgcn_cvt_scalef32_pk_f32_fp4(BU[r][q], 1.0f, 3) * x[4 * q + 3]; } \
            if (GATHER_PROBE) { f32x2v p2_ = (f32x2v){0.f, 0.f}; _Pragma("unroll") for (int q = 0; q < 4; ++q) { const unsigned wq_ = (unsigned)opaque((int)BU[r][q]); p2_ += __builtin_amdgcn_cvt_scalef32_pk_f32_fp4(wq_, 1.0f, 0) * x[4 * q]; p2_ += __builtin_amdgcn_cvt_scalef32_pk_f32_fp4(wq_, 1.0f, 1) * x[4 * q + 1]; p2_ += __builtin_amdgcn_cvt_scalef32_pk_f32_fp4(wq_, 1.0f, 2) * x[4 * q + 2]; p2_ += __builtin_amdgcn_cvt_scalef32_pk_f32_fp4(wq_, 1.0f, 3) * x[4 * q + 3]; } s2_ += p2_ * 0.0f; } \
            dst = s2_[0] + s2_[1]; } while (0)
#define G_REDUCE(g) do { \
            _Pragma("unroll") for (int i = 0; i < 4; ++i) { const float mine = b5 ? part[i + 4] : part[i], send = b5 ? part[i] : part[i + 4]; part[i] = mine + __shfl_xor(send, 32); } \
            _Pragma("unroll") for (int i = 0; i < 2; ++i) { const float mine = b4 ? part[i + 2] : part[i], send = b4 ? part[i] : part[i + 2]; part[i] = mine + __shfl_xor(send, 16); } \
            { const float mine = b3 ? part[1] : part[0], send = b3 ? part[0] : part[1]; part[0] = mine + __shfl_xor(send, 8); } \
            float v_ = part[0]; v_ += __shfl_xor(v_, 4); v_ += __shfl_xor(v_, 2); v_ += __shfl_xor(v_, 1); \
            const bool mine_ = (lane & 7) == ((g) & 7); hval0 = (mine_ && ((g) >> 3) == 0) ? v_ : hval0; hval1 = (mine_ && ((g) >> 3) == 1) ? v_ : hval1; } while (0)
        if (GATHER_PROBE2) {
            const int pm0 = idx0 & (GATHER_PROBE2 - 1), pm1 = idx1 & (GATHER_PROBE2 - 1); f32x2v ps = (f32x2v){0.f, 0.f};
#define G_ROW_P(R) (U8 + (size_t)(unsigned)__builtin_amdgcn_readlane((((R) >> 6) & 1) ? pm1 : pm0, (R) & 63) * RB)
#pragma unroll
            for (int r = 0; r < GNR; ++r) G_REQ(r, G_ROW_P(r));
            for (int it = 0; it < 128 / GNR - 1; ++it) {
#pragma unroll
                for (int r = 0; r < GNR; ++r) { float d_; G_DOT(r, d_); ps[0] += d_; G_REQ(r, G_ROW_P(GNR * (it + 1) + r)); }
            }
#pragma unroll
            for (int r = 0; r < GNR; ++r) { float d_; G_DOT(r, d_); ps[1] += d_; }
            asm volatile("" :: "v"(ps[0]), "v"(ps[1]));
#undef G_ROW_P
        }
        const bool b5 = (lane & 32) != 0, b4 = (lane & 16) != 0, b3 = (lane & 8) != 0;
        float hval0 = 0.f, hval1 = 0.f;
#pragma unroll
        for (int r = 0; r < GNR; ++r) G_REQ(r, G_ROW_U(r));
        for (int it = 0; it < 128 / GNR - 1; ++it) {
#pragma unroll
            for (int g4 = 0; g4 < GNR / 8; ++g4) { float part[8];
#pragma unroll
                for (int i = 0; i < 8; ++i) { G_DOT(g4 * 8 + i, part[i]); G_REQ(g4 * 8 + i, G_ROW_U(GNR * (it + 1) + g4 * 8 + i)); }
                G_REDUCE(it * (GNR / 8) + g4); }
        }
#pragma unroll
        for (int g4 = 0; g4 < GNR / 8; ++g4) { float part[8];
#pragma unroll
            for (int i = 0; i < 8; ++i) { G_DOT(g4 * 8 + i, part[i]); G_REQ(g4 * 8 + i, G_ROW_V(g4 * 8 + i)); }
            G_REDUCE(16 - GNR / 8 + g4); }
        const float w0 = gate0 * gelu_erf(hval0 * usc0) * vsc0, w1 = gate1 * gelu_erf(hval1 * usc1) * vsc1;
        f32x2v acc[16];
#pragma unroll
        for (int k = 0; k < 16; ++k) acc[k] = (f32x2v){0.f, 0.f};
#define G_AXPY(r, R) do { const float w_ = __uint_as_float((unsigned)__builtin_amdgcn_readlane((int)__float_as_uint((((R) >> 6) & 1) ? w1 : w0), (R) & 63)); const f32x2v w2_ = (f32x2v){w_, w_}; \
            _Pragma("unroll") for (int q = 0; q < 4; ++q) { acc[4 * q] += w2_ * __builtin_amdgcn_cvt_scalef32_pk_f32_fp4(BU[r][q], 1.0f, 0); acc[4 * q + 1] += w2_ * __builtin_amdgcn_cvt_scalef32_pk_f32_fp4(BU[r][q], 1.0f, 1); \
                acc[4 * q + 2] += w2_ * __builtin_amdgcn_cvt_scalef32_pk_f32_fp4(BU[r][q], 1.0f, 2); acc[4 * q + 3] += w2_ * __builtin_amdgcn_cvt_scalef32_pk_f32_fp4(BU[r][q], 1.0f, 3); } } while (0)
        for (int it = 0; it < 128 / GNR - 1; ++it) {
#pragma unroll
            for (int r = 0; r < GNR; ++r) { G_AXPY(r, GNR * it + r); G_REQ(r, G_ROW_V(GNR * (it + 1) + r)); }
        }
#pragma unroll
        for (int r = 0; r < GNR; ++r) G_AXPY(r, 128 - GNR + r);
#undef G_ROW_U
#undef G_ROW_V
#undef G_REQ
#undef G_DOT
#undef G_REDUCE
#undef G_AXPY
        const int le = opaque(lane);
        float s = 0.f;
#pragma unroll
        for (int j = 0; j < 8; ++j) { const v2u xr = *(const v2u*)(xrow + j * 256 + le * 4);
            acc[2 * j] = (f32x2v){bf_lo(xr.x), bf_hi(xr.x)} * ALPHA + acc[2 * j]; acc[2 * j + 1] = (f32x2v){bf_lo(xr.y), bf_hi(xr.y)} * ALPHA + acc[2 * j + 1];
            s += (acc[2 * j][0] + acc[2 * j][1]) + (acc[2 * j + 1][0] + acc[2 * j + 1][1]); }
        const float mean = wave_sum(s) * (1.0f / DM); float s2 = 0.f;
#pragma unroll
        for (int k = 0; k < 16; ++k) { acc[k] = acc[k] - mean; s2 += acc[k][0] * acc[k][0] + acc[k][1] * acc[k][1]; }
        const float rstd = 1.0f / sqrtf(wave_sum(s2) * (1.0f / DM) + LN_EPS);
#pragma unroll
        for (int j = 0; j < 8; ++j) { const int col = j * 256 + le * 4;
            const f32x4 gg = *(const f32x4*)(g2 + col), bb = *(const f32x4*)(b2 + col);
            const f32x2v a0 = acc[2 * j], a1 = acc[2 * j + 1];
            const f32x4 o = (f32x4){a0[0] * rstd * gg[0] + bb[0], a0[1] * rstd * gg[1] + bb[1], a1[0] * rstd * gg[2] + bb[2], a1[1] * rstd * gg[3] + bb[3]};
            if (xdst_base) *(f32x4*)(xdst_base + (size_t)t * DM + col) = o;
            v2u w; w.x = pkbf(o[0], o[1]); w.y = pkbf(o[2], o[3]); *(v2u*)(XN + (size_t)t * DM + col) = w; }
    }
}

#else
__device__ __forceinline__ void peer_gather_phase(const Frame& F, CArgs& A, int l) {
    const unsigned char* U8 = F.ws + WS_U8 + (size_t)l * NEXP * DM; const unsigned char* V8 = F.ws + WS_V8 + (size_t)l * NEXP * DM;
    const float* USC = (const float*)(F.ws + WS_USC) + (size_t)l * NEXP; const float* VSC = (const float*)(F.ws + WS_VSC) + (size_t)l * NEXP;
    const int* IDX = (const int*)(F.ws + WS_IDX); const float* GATE = (const float*)(F.ws + WS_GATE);
    const float* g2 = A.in[I_LN2G] + (size_t)l * DM; const float* b2 = A.in[I_LN2B] + (size_t)l * DM;
    bf16* XN = (bf16*)(F.ws + WS_XN);
    const int lane = F.lane, slot = 8 * (lane & 7) + (lane >> 3);
    for (int t = F.gw; t < NTOK; t += F.NGW) {
        float* xrow = F.out + (size_t)t * DM;
        f32x2v x[2][8];
#pragma unroll
        for (int c = 0; c < 2; ++c)
#pragma unroll
            for (int q = 0; q < 4; ++q) { const f32x4 a = *(const f32x4*)(xrow + (c * 64 + lane) * 16 + q * 4); x[c][2 * q] = (f32x2v){a[0], a[1]}; x[c][2 * q + 1] = (f32x2v){a[2], a[3]}; }
        const int idx0 = IDX[(size_t)t * 128 + slot], idx1 = IDX[(size_t)t * 128 + 64 + slot];
        v4u BU[8][2];
        const unsigned loff0 = (unsigned)lane * 16u, loff1 = (unsigned)lane * 16u + 1024u;
#define G_ROW_U(i, b) (U8 + (size_t)(unsigned)__builtin_amdgcn_readlane(((b) >> 3) ? idx1 : idx0, (i) * 8 + ((b) & 7)) * DM)
#define G_ROW_V(i, b) (V8 + (size_t)(unsigned)__builtin_amdgcn_readlane(((b) >> 3) ? idx1 : idx0, ((b) & 7) * 8 + (i)) * DM)
#define G_REQ(i, rowptr) do { const unsigned char* r_ = (rowptr); BU[i][0] = *(const v4u*)(r_ + loff0); BU[i][1] = *(const v4u*)(r_ + loff1); } while (0)
#define G_DOT(i, dst) do { f32x2v s2_ = (f32x2v){0.f, 0.f}; \
            _Pragma("unroll") for (int c = 0; c < 2; ++c) _Pragma("unroll") for (int q = 0; q < 4; ++q) { s2_ += __builtin_amdgcn_cvt_pk_f32_fp8((int)BU[i][c][q], false) * x[c][2 * q]; s2_ += __builtin_amdgcn_cvt_pk_f32_fp8((int)BU[i][c][q], true) * x[c][2 * q + 1]; } \
            dst = s2_[0] + s2_[1]; } while (0)
#define G_REDUCE(b) do { \
            _Pragma("unroll") for (int i = 0; i < 4; ++i) { const float mine = b5 ? part[i + 4] : part[i], send = b5 ? part[i] : part[i + 4]; part[i] = mine + __shfl_xor(send, 32); } \
            _Pragma("unroll") for (int i = 0; i < 2; ++i) { const float mine = b4 ? part[i + 2] : part[i], send = b4 ? part[i] : part[i + 2]; part[i] = mine + __shfl_xor(send, 16); } \
            { const float mine = b3 ? part[1] : part[0], send = b3 ? part[0] : part[1]; part[0] = mine + __shfl_xor(send, 8); } \
            float v_ = part[0]; v_ += __shfl_xor(v_, 4); v_ += __shfl_xor(v_, 2); v_ += __shfl_xor(v_, 1); \
            const bool mine_ = (lane & 7) == ((b) & 7); hval0 = (mine_ && ((b) >> 3) == 0) ? v_ : hval0; hval1 = (mine_ && ((b) >> 3) == 1) ? v_ : hval1; } while (0)
        const bool b5 = (lane & 32) != 0, b4 = (lane & 16) != 0, b3 = (lane & 8) != 0;
        float hval0 = 0.f, hval1 = 0.f;
#pragma unroll
        for (int i = 0; i < 8; ++i) G_REQ(i, G_ROW_U(i, 0));
        for (int b = 0; b < 15; ++b) {
            float part[8];
#pragma unroll
            for (int i = 0; i < 8; ++i) { G_DOT(i, part[i]); G_REQ(i, G_ROW_U(i, b + 1)); }
            G_REDUCE(b);
        }
        {
            float part[8];
#pragma unroll
            for (int i = 0; i < 8; ++i) { G_DOT(i, part[i]); G_REQ(i, G_ROW_V(i, 0)); }
            G_REDUCE(15);
        }
        const float gate0 = GATE[(size_t)t * 128 + slot], gate1 = GATE[(size_t)t * 128 + 64 + slot];
        const float usc0 = USC[idx0], usc1 = USC[idx1], vsc0 = VSC[idx0], vsc1 = VSC[idx1];
        const float w0 = gate0 * gelu_erf(hval0 * usc0) * vsc0, w1 = gate1 * gelu_erf(hval1 * usc1) * vsc1;
        f32x2v acc[2][8];
#pragma unroll
        for (int c = 0; c < 2; ++c)
#pragma unroll
            for (int k = 0; k < 8; ++k) acc[c][k] = (f32x2v){0.f, 0.f};
#define G_AXPY(i, b) do { const float w_ = __uint_as_float((unsigned)__builtin_amdgcn_readlane((int)__float_as_uint(((b) >> 3) ? w1 : w0), ((b) & 7) * 8 + (i))); const f32x2v w2_ = (f32x2v){w_, w_}; \
            _Pragma("unroll") for (int c = 0; c < 2; ++c) _Pragma("unroll") for (int q = 0; q < 4; ++q) { acc[c][2 * q] += w2_ * __builtin_amdgcn_cvt_pk_f32_fp8((int)BU[i][c][q], false); acc[c][2 * q + 1] += w2_ * __builtin_amdgcn_cvt_pk_f32_fp8((int)BU[i][c][q], true); } } while (0)
        for (int b = 0; b < 15; ++b) {
#pragma unroll
            for (int i = 0; i < 8; ++i) { G_AXPY(i, b); G_REQ(i, G_ROW_V(i, b + 1)); }
        }
#pragma unroll
        for (int i = 0; i < 8; ++i) G_AXPY(i, 15);
#undef G_ROW_U
#undef G_ROW_V
#undef G_REQ
#undef G_DOT
#undef G_REDUCE
#undef G_AXPY
        const int le = opaque(lane);
        float s = 0.f;
#pragma unroll
        for (int c = 0; c < 2; ++c)
#pragma unroll
            for (int k = 0; k < 8; ++k) { const f32x2v xr = *(const f32x2v*)(xrow + (c * 64 + le) * 16 + 2 * k);
                acc[c][k] = xr * ALPHA + acc[c][k]; s += acc[c][k][0] + acc[c][k][1]; }
        const float mean = wave_sum(s) * (1.0f / DM); float s2 = 0.f;
#pragma unroll
        for (int c = 0; c < 2; ++c)
#pragma unroll
            for (int k = 0; k < 8; ++k) { acc[c][k] = acc[c][k] - mean; s2 += acc[c][k][0] * acc[c][k][0] + acc[c][k][1] * acc[c][k][1]; }
        const float rstd = 1.0f / sqrtf(wave_sum(s2) * (1.0f / DM) + LN_EPS);
#pragma unroll
        for (int c = 0; c < 2; ++c) { const int col = (c * 64 + le) * 16;
#pragma unroll
            for (int h8 = 0; h8 < 2; ++h8) { float o[8];
#pragma unroll
                for (int q = 0; q < 2; ++q) { const f32x4 gg = *(const f32x4*)(g2 + col + h8 * 8 + q * 4), bb = *(const f32x4*)(b2 + col + h8 * 8 + q * 4);
                    const f32x2v a0 = acc[c][h8 * 4 + 2 * q], a1 = acc[c][h8 * 4 + 2 * q + 1];
                    o[4 * q] = a0[0] * rstd * gg[0] + bb[0]; o[4 * q + 1] = a0[1] * rstd * gg[1] + bb[1]; o[4 * q + 2] = a1[0] * rstd * gg[2] + bb[2]; o[4 * q + 3] = a1[1] * rstd * gg[3] + bb[3];
                    *(f32x4*)(xrow + col + h8 * 8 + q * 4) = (f32x4){o[4 * q], o[4 * q + 1], o[4 * q + 2], o[4 * q + 3]}; }
                *(v4u*)(XN + (size_t)t * DM + col + h8 * 8) = pack8(o); } }
    }
}

#endif
#ifndef DUP_MASK
#define DUP_MASK 0
#endif
#ifndef PHASE_TEST_ONLY
__global__ void __launch_bounds__(NTHR, 2) fwd_kernel(Args A) {
    extern __shared__ __attribute__((aligned(16))) unsigned char lds_raw[];
#define MKFRAME() Frame F; CArgs& KA = *(CArgs*)opaque_u64((unsigned long long)__builtin_amdgcn_kernarg_segment_ptr()); { F.lds = (LAS unsigned char*)lds_raw; F.tid = opaque((int)threadIdx.x); F.lane = F.tid & 63; F.wave = __builtin_amdgcn_readfirstlane(F.tid >> 6); \
        const int bx_ = opaque_s((int)blockIdx.x); F.G = gridDim.x; F.gw = bx_ * NWAVES + F.wave; F.NGW = F.G * NWAVES; F.gtid = (size_t)bx_ * NTHR + F.tid; F.NT = (size_t)F.G * NTHR; F.out = (float*)opaque_p(KA.out); F.ws = (unsigned char*)opaque_p(KA.ws); F.bx = bx_; } \
        bf16* XN = (bf16*)(F.ws + WS_XN); bf16* H = (bf16*)(F.ws + WS_H); bf16* CC = (bf16*)(F.ws + WS_CONCAT); (void)XN; (void)H; (void)CC;
    volatile LAS unsigned* MISC = (volatile LAS unsigned*)((LAS unsigned char*)lds_raw + LDS_MISC);
    if (threadIdx.x < 64) MISC[threadIdx.x] = 0u;
    __syncthreads();
    XcdBarrier bar = xcd_barrier_post((unsigned*)(A.ws + WS_CTL) + CW_BAR + A.li * XCD_BAR_WORDS, MISC + 8);
    const int lo = A.ph_lo, hi = A.ph_hi;
#define IN(k) (lo <= (k) && (k) < hi)
#define SEAM(k) do { if (lo <= (k) && (k) + 1 < hi) xcd_barrier(bar); } while (0)

    if (IN(0)) { MKFRAME(); p0_prologue(F, KA); if (DUP_MASK & 256) { __syncthreads(); p0_prologue(F, KA); } } SEAM(0);

    for (int l = 0; l < NLAYER; ++l) {
        const int pb = 1 + l * 10;
        if (IN(pb + 0)) { MKFRAME();
            pg8::Gemm g{XN, (const bf16*)(F.ws + WS_WIN) + (size_t)l * INW * DM, NTOK, INW, DM}; pg8::StaticOrder S; S.init(NTOK, INW, F.G, F.bx);
            EpiStoreRot E{H, INW, (const float*)(F.ws + WS_ROTC), (const float*)(F.ws + WS_ROTS)};
            pg8::gemm_phase<EpiStoreRot, pg8::StaticOrder, true, true>(F.lds, g, S, E);
            if (DUP_MASK & 64) { pg8::gemm_phase<EpiStoreRot, pg8::StaticOrder, true, true>(F.lds, g, S, E); }
        } SEAM(pb + 0);
        if (IN(pb + 1)) { MKFRAME(); s5_pass1(F, KA, l); pool_phase(F, KA); if (DUP_MASK & 1) { s5_pass1(F, KA, l); } if (DUP_MASK & 2) { pool_phase(F, KA); } } SEAM(pb + 1);
        if (IN(pb + 2)) { MKFRAME(); s5_carry(F, KA, l); __syncthreads(); ret_state_phase(F, KA); if (DUP_MASK & 4) { ret_state_phase(F, KA); } if (DUP_MASK & 2048) { ret_state_phase<1>(F, KA); } if (DUP_MASK & 4096) { ret_state_phase<2>(F, KA); ret_state_phase(F, KA); } } SEAM(pb + 2);
        if (IN(pb + 3)) { MKFRAME(); s5_pass3(F, KA, l); if (DUP_MASK & 8) { s5_pass3(F, KA, l); } ret_prefix_phase(F, KA); } SEAM(pb + 3);
        if (IN(pb + 4)) { MKFRAME();
            __syncthreads();
            ret_out_phase(F, KA);
            if (DUP_MASK & 16) { ret_out_phase(F, KA); }
            {
                pg8::Gemm g{(const bf16*)(F.ws + WS_BUFY), (const bf16*)(F.ws + WS_WGLU) + (size_t)l * 512 * 512, NTOK, 512, 512}; pg8::StaticOrder S; S.init(NTOK, 512, F.G, F.bx);
                EpiGlu E{(const bf16*)(F.ws + WS_BUFY), 512, CC, DM, KA.in[I_BGLU] + (size_t)l * 512};
                pg8::gemm_phase<EpiGlu, pg8::StaticOrder, true, true>(F.lds, g, S, E);
                if (DUP_MASK & 512) { pg8::gemm_phase<EpiGlu, pg8::StaticOrder, true, true>(F.lds, g, S, E); }
            }
            {
                pg8::Gemm g{(const bf16*)(F.ws + WS_BUFP), (const bf16*)(F.ws + WS_WPOOL) + (size_t)l * 512 * 512, NTOK, 512, 512}; pg8::StaticOrder S; S.init(NTOK, 512, F.G, F.bx);
                EpiScaleBf16 E{CC + 512, DM, KA.in[I_POOLS] + (size_t)l * 512};
                pg8::gemm_phase<EpiScaleBf16, pg8::StaticOrder, true, true>(F.lds, g, S, E);
                if (DUP_MASK & 512) { pg8::gemm_phase<EpiScaleBf16, pg8::StaticOrder, true, true>(F.lds, g, S, E); }
            }
        } SEAM(pb + 4);
        if (IN(pb + 5)) { MKFRAME();
            pg8::Gemm g{CC, (const bf16*)(F.ws + WS_WOUT) + (size_t)l * DM * DM, NTOK, DM, DM}; pg8::StaticOrder S; S.init(NTOK, DM, F.G, F.bx);
            EpiStoreBf16 E{H, DM};
            pg8::gemm_phase<EpiStoreBf16, pg8::StaticOrder, true, true>(F.lds, g, S, E);
        } SEAM(pb + 5);
        if (IN(pb + 6)) { MKFRAME();
            ln_rows2(XN, H, ALPHA, KA.in[I_LN1G] + (size_t)l * DM, KA.in[I_LN1B] + (size_t)l * DM, F.gw, F.NGW, F.lane);
        } SEAM(pb + 6);
        if (IN(pb + 7)) { MKFRAME();
            pg8::Gemm g{XN, (const bf16*)(F.ws + WS_WS) + (size_t)l * DM * DM, NTOK, DM, DM}; pg8::StaticOrder S; S.init(NTOK, DM, F.G, F.bx);
            EpiStoreF16 E{(_Float16*)(F.ws + WS_H), DM};
            pg8::gemm_phase<EpiStoreF16, pg8::StaticOrder, true, true>(F.lds, g, S, E);
            if (DUP_MASK & 128) { pg8::gemm_phase<EpiStoreF16, pg8::StaticOrder, true, true>(F.lds, g, S, E); }
        } SEAM(pb + 7);
        if (IN(pb + 8)) { MKFRAME(); __syncthreads(); topk_phase(F, KA); if (DUP_MASK & 32) { topk_phase(F, KA); } } SEAM(pb + 8);
        if (IN(pb + 9)) { MKFRAME(); if (DUP_MASK & 1024) { peer_gather_phase(F, KA, l, (float*)(F.ws + WS_H), CC); } peer_gather_phase(F, KA, l, l == NLAYER - 1 ? F.out : (float*)nullptr, XN); } SEAM(pb + 9);
    }
#undef IN
#undef SEAM
}


#ifndef DBG_STOP
#define DBG_STOP NPHASE
#endif
#ifndef DBG_DUMP
#define DBG_DUMP 0
#endif
__global__ void dbg_dump_kernel(float* out, const unsigned char* ws, int mode) {
    const size_t n = (size_t)NTOK * DM;
    for (size_t i = (size_t)blockIdx.x * blockDim.x + threadIdx.x; i < n; i += (size_t)gridDim.x * blockDim.x) {
        float v = 0.f;
        if (mode == 1) v = bf_lo(((const bf16*)(ws + WS_H))[i]);
        else if (mode == 2) v = bf_lo(((const bf16*)(ws + WS_CONCAT))[i]);
        else if (mode == 3) v = bf_lo(((const bf16*)(ws + WS_BUFY))[i % ((size_t)NTOK * 1024)]);
        else if (mode == 4) v = bf_lo(((const bf16*)(ws + WS_STF))[i]);
        else if (mode == 5) v = ((const float*)(ws + WS_H))[i];
        else if (mode == 6) v = (i < (size_t)NTOK * 128) ? (float)((const int*)(ws + WS_IDX))[i] : ((i < (size_t)NTOK * 256) ? ((const float*)(ws + WS_GATE))[i - (size_t)NTOK * 128] : 0.f);
        else if (mode == 7) v = bf_lo(((const bf16*)(ws + WS_XN))[i]);
        else if (mode == 8) v = bf_lo(((const bf16*)(ws + WS_STB))[i]);
        else if (mode == 9) v = bf_lo(((const bf16*)(ws + WS_H))[i + (size_t)NTOK * DM]);
        else if (mode == 10) v = bf_lo(((const bf16*)(ws + WS_WIN))[i % ((size_t)72 * 1024 * 1024)]);
        else if (mode == 11) v = ((const float*)(ws + WS_S5ST))[i % ((size_t)5 * 1024 * 1024)];
        else if (mode == 12) v = bf_lo(((const bf16*)(ws + WS_H))[i]) + bf_lo(((const bf16*)(ws + WS_H))[i + (size_t)NTOK * DM]) + bf_lo(((const bf16*)(ws + WS_BUFP))[i % ((size_t)NTOK * 512)]) + ((const float*)(ws + WS_S5ST))[i % ((size_t)5 * 1024 * 1024)];
        else if (mode == 13) v = bf_lo(((const bf16*)(ws + WS_STF))[i]) + bf_lo(((const bf16*)(ws + WS_STB))[i]) + ((const float*)(ws + WS_S5ST))[i % ((size_t)5 * 1024 * 1024)];
        else if (mode == 14) v = bf_lo(((const bf16*)(ws + WS_STF))[i]) + bf_lo(((const bf16*)(ws + WS_STB))[i]) + bf_lo(((const bf16*)(ws + WS_BUFY))[i % ((size_t)NTOK * 512)]);
        else if (mode == 15) v = bf_lo(((const bf16*)(ws + WS_H))[i]) + bf_lo(((const bf16*)(ws + WS_H))[i + (size_t)NTOK * DM]) + bf_lo(((const bf16*)(ws + WS_H))[i + (size_t)NTOK * 3072]);
        out[i] = v;
    }
}
#ifndef MK_ONE_LAUNCH
#define MK_ONE_LAUNCH 0
#endif
extern "C" void kernel_launch(void* const* d_in, const int* in_sizes, int n_in, void* d_out, int out_size, void* d_ws, size_t ws_size, hipStream_t stream) {
    static int grid = 0;
    if (grid == 0) {
        if (n_in != 26 || out_size != NTOK * DM || ws_size < WS_END) { fprintf(stderr, "kernel_launch: unexpected shapes (n_in %d out %d ws %zu)\n", n_in, out_size, ws_size); grid = -1; return; }
        int dev = 0, cus = 0, per_cu = 0;
        if (hipGetDevice(&dev) != hipSuccess || hipDeviceGetAttribute(&cus, hipDeviceAttributeMultiprocessorCount, dev) != hipSuccess) { grid = -1; return; }
        if (hipFuncSetAttribute((const void*)fwd_kernel, hipFuncAttributeMaxDynamicSharedMemorySize, LDS_BYTES) != hipSuccess) { fprintf(stderr, "kernel_launch: hipFuncSetAttribute failed\n"); grid = -1; return; }
        if (hipOccupancyMaxActiveBlocksPerMultiprocessor(&per_cu, (const void*)fwd_kernel, NTHR, LDS_BYTES) != hipSuccess || per_cu < 1) { fprintf(stderr, "kernel_launch: occupancy query says %d\n", per_cu); grid = -1; (void)hipGetLastError(); return; }
        (void)hipGetLastError();
        grid = cus;
    }
    if (grid < 0) return;
    if (hipMemsetAsync((char*)d_ws + WS_CTL, 0, CTL_ZERO_BYTES, stream) != hipSuccess) return;
    Args a{};
    for (int i = 0; i < 26; ++i) a.in[i] = (const float*)d_in[i];
    a.out = (float*)d_out; a.ws = (unsigned char*)d_ws; a.pad = 0;
#if MK_ONE_LAUNCH
    a.ph_lo = 0; a.ph_hi = NPHASE; a.li = 0;
    hipLaunchKernelGGL(fwd_kernel, dim3(grid), dim3(NTHR), LDS_BYTES, stream, a);
#else
    for (int p = 0; p < DBG_STOP; ++p) { a.ph_lo = p; a.ph_hi = p + 1; a.li = p; hipLaunchKernelGGL(fwd_kernel, dim3(grid), dim3(NTHR), LDS_BYTES, stream, a); }
#endif
    if (DBG_DUMP) hipLaunchKernelGGL(dbg_dump_kernel, dim3(2048), dim3(256), 0, stream, (float*)d_out, (const unsigned char*)d_ws, DBG_DUMP);
}
#endif
```

```cpp
#include <hip/hip_runtime.h>
#include <cstdio>
#include <cstdint>
#include <cmath>
__device__ __forceinline__ int opaque(int v) { asm volatile("" : "+v"(v)); return v; }
__device__ __forceinline__ int opaque_s(int v) { asm volatile("" : "+s"(v)); return v; }
__device__ __forceinline__ void* opaque_p(void* p) { asm volatile("" : "+s"(p)); return p; }
__device__ __forceinline__ unsigned long long opaque_u64(unsigned long long v) { asm volatile("" : "+s"(v)); return v; }
#ifndef PEER_FP4
#define PEER_FP4 1
#endif
#ifndef GATHER_ROWS
#define GATHER_ROWS 16
#endif
#ifndef GATHER_PROBE
#define GATHER_PROBE 0
#endif
#ifndef GATHER_PROBE2
#define GATHER_PROBE2 0
#endif
#ifndef GATHER_MFMA
#define GATHER_MFMA 1
#endif
#ifndef MFMA_NIBSWAP
#define MFMA_NIBSWAP 0
#endif
#ifndef MFMA_DIAG
#define MFMA_DIAG 0
#endif
#ifndef MFMA_XFP4
#define MFMA_XFP4 0
#endif
#ifndef MFMA_BMAP
#define MFMA_BMAP 1
#endif
#define MK_ONE_LAUNCH 1
namespace pg8 {
#define PG8_LAS __attribute__((address_space(3)))
typedef unsigned short bf16_t;
typedef short bf16x8 __attribute__((ext_vector_type(8)));
typedef float f32x4 __attribute__((ext_vector_type(4)));
typedef unsigned u32x4 __attribute__((ext_vector_type(4)));
constexpr int BM = 256, BK = 64, HALF = 128, HTB = HALF * BK * 2  , STAGE_BYTES = 8 * HTB, NXCD = 8, WGM = 8;

__host__ __device__ __forceinline__ int lds_byte(int r, int c) { const int st = (r >> 4) * 2 + (c >> 5), rr = r & 15, cc = c & 31, ob = rr * 64 + cc * 2; return st * 1024 + (ob ^ (((ob >> 9) & 1) << 5)); }
__host__ __device__ __forceinline__ void stage_rc(int b, int& R, int& C) { const int st = b / 1024, sb = b % 1024, swz = sb ^ (((sb >> 9) & 1) << 5); R = (st >> 1) * 16 + swz / 64; C = (st & 1) * 32 + (swz % 64) / 2; }
__host__ __device__ __forceinline__ int perm32(int rho) { const int n = rho >> 4, i = rho & 15; return 8 * (i >> 2) + 4 * n + (i & 3); }

struct Unit { int pm, pn; };
struct Gemm { const bf16_t* A; const bf16_t* Bt; int M, N, K; };

struct StaticOrder {
    int nM, nN, nwg, G, c;
    __host__ __device__ void init(int M, int N, int G_, int c_) { nM = M / BM; nN = N / BM; nwg = nM * nN; G = G_; c = c_; }
    __host__ __device__ bool next(int i, Unit& u) const {
        const long L = (long)i * G + c; if (L >= nwg) return false;
        int wgid = (int)L; { const int q = nwg / NXCD, r = nwg % NXCD, xcd = wgid % NXCD, off = wgid / NXCD; wgid = (xcd < r ? xcd * (q + 1) : r * (q + 1) + (xcd - r) * q) + off; }
        const int nig = WGM * nN, gid = wgid / nig, fm = gid * WGM, gsz = (nM - fm) < WGM ? (nM - fm) : WGM;
        u.pm = fm + ((wgid % nig) % gsz); u.pn = (wgid % nig) / gsz; return true;
    }
    __device__ __forceinline__ void a_ready(const Unit&) const {}
    __device__ __forceinline__ void done(const Unit&) const {}
};
__device__ __forceinline__ unsigned cvt_pk_bf16(float lo, float hi) { unsigned r; asm volatile("v_cvt_pk_bf16_f32 %0, %1, %2" : "=v"(r) : "v"(lo), "v"(hi)); return r; }
typedef float f32x2 __attribute__((ext_vector_type(2)));
template <class Epi, class Sched, bool ALIGN_EPI = false, bool SP2 = false>
__device__ __forceinline__ void gemm_phase(PG8_LAS unsigned char* lds, const Gemm g, const Sched& S, const Epi& E) {
    const int tid = opaque((int)threadIdx.x), wid = __builtin_amdgcn_readfirstlane(tid >> 6), lane = tid & 63, wr = wid >> 2, wc = wid & 3, fr = lane & 15, fq = lane >> 4;
    const int K = g.K, nt = K / BK;
    unsigned voffA[2], voffB[2];
#pragma unroll
    for (int i = 0; i < 2; ++i) { int R, C; stage_rc(tid * 16 + i * 8192, R, C); const int Rb = Epi::PERM ? ((R & ~31) + perm32(R & 31)) : R;
        voffA[i] = (unsigned)(R * K + C) * 2u; voffB[i] = (unsigned)(Rb * K + C) * 2u; }
    const size_t kstep = (size_t)(BK * 2);
    const size_t hstep = (size_t)HALF * K * 2;
    const size_t tstep = 2 * hstep;
    const unsigned ldsw = (unsigned)wid * 1024u;
    const int aoff = lds_byte(wr * 64 + fr, fq * 8), boff = lds_byte(wc * 32 + fr, fq * 8);
#define PG8_SA(b, h) (((b) * 2 + (h)) * HTB)
#define PG8_SB(b, h) ((4 + (b) * 2 + (h)) * HTB)
#define PG8_STAGE(bufoff, gbase, voff) do { _Pragma("unroll") for (int _i = 0; _i < 2; ++_i) \
        __builtin_amdgcn_global_load_lds((const unsigned*)((const char*)(gbase) + (voff)[_i]), (PG8_LAS unsigned*)(lds + (bufoff) + ldsw + _i * 8192), 16, 0, 0); } while (0)
#define PG8_LDA(dst, b, h) do { _Pragma("unroll") for (int m = 0; m < 4; ++m) _Pragma("unroll") for (int k = 0; k < 2; ++k) dst[m][k] = *(const PG8_LAS bf16x8*)(lds + PG8_SA(b, h) + aoff + m * 2048 + k * 1024); } while (0)
#define PG8_LDB(dst, b, h) do { _Pragma("unroll") for (int n = 0; n < 2; ++n) _Pragma("unroll") for (int k = 0; k < 2; ++k) dst[n][k] = *(const PG8_LAS bf16x8*)(lds + PG8_SB(b, h) + boff + n * 2048 + k * 1024); } while (0)
#define PG8_MMA(ai, bj, At, Bt) do { __builtin_amdgcn_s_setprio(1); _Pragma("unroll") for (int m = 0; m < 4; ++m) _Pragma("unroll") for (int n = 0; n < 2; ++n) _Pragma("unroll") for (int k = 0; k < 2; ++k) \
        acc[ai][bj][m][n] = __builtin_amdgcn_mfma_f32_16x16x32_bf16(Bt[n][k], At[m][k], acc[ai][bj][m][n], 0, 0, 0); __builtin_amdgcn_s_setprio(0); } while (0)
#define PG8_WAIT_V(n) asm volatile("s_waitcnt vmcnt(" #n ")" ::: "memory")
#define PG8_WAIT_L(n) asm volatile("s_waitcnt lgkmcnt(" #n ")" ::: "memory")
#define PG8_BAR __builtin_amdgcn_s_barrier()
#define PG8_SCHED __builtin_amdgcn_sched_barrier(0)
    Unit cur, nxt; int ui = 0;
    if (!S.next(0, cur)) return;
    f32x4 acc[2][2][4][2];
#pragma unroll
    for (int a = 0; a < 2; ++a)
#pragma unroll
        for (int b = 0; b < 2; ++b)
#pragma unroll
            for (int m = 0; m < 4; ++m)
#pragma unroll
                for (int n = 0; n < 2; ++n) acc[a][b][m][n] = (f32x4){0.f, 0.f, 0.f, 0.f};
    bf16x8 At[4][2], B0[2][2], B1[2][2];
    const char* cA = (const char*)g.A + (size_t)cur.pm * tstep; const char* cB = (const char*)g.Bt + (size_t)cur.pn * tstep;
    S.a_ready(cur);
    if constexpr (SP2) {
        PG8_STAGE(PG8_SB(0, 0), cB, voffB); PG8_STAGE(PG8_SB(0, 1), cB + hstep, voffB); PG8_STAGE(PG8_SA(0, 0), cA, voffA); PG8_STAGE(PG8_SA(0, 1), cA + hstep, voffA);
        if (wr == 1) PG8_BAR;
        PG8_WAIT_V(2); PG8_BAR;
        PG8_STAGE(PG8_SB(1, 0), cB + kstep, voffB); PG8_STAGE(PG8_SA(1, 0), cA + kstep, voffA); PG8_STAGE(PG8_SB(1, 1), cB + hstep + kstep, voffB);
        PG8_WAIT_V(6); PG8_BAR;
    } else {
        PG8_STAGE(PG8_SB(0, 0), cB, voffB); PG8_STAGE(PG8_SA(0, 0), cA, voffA); PG8_STAGE(PG8_SB(0, 1), cB + hstep, voffB); PG8_STAGE(PG8_SA(0, 1), cA + hstep, voffA);
        if (wr == 1) PG8_BAR;
        PG8_WAIT_V(4); PG8_BAR;
        PG8_STAGE(PG8_SB(1, 0), cB + kstep, voffB); PG8_STAGE(PG8_SA(1, 0), cA + kstep, voffA); PG8_STAGE(PG8_SB(1, 1), cB + hstep + kstep, voffB);
        PG8_WAIT_V(6); PG8_BAR;
    }
    for (;;) {
        const bool has_next = S.next(ui + 1, nxt);
        const char* nA = has_next ? (const char*)g.A + (size_t)nxt.pm * tstep : cA; const char* nB = has_next ? (const char*)g.Bt + (size_t)nxt.pn * tstep : cB;
        for (int t = 0; t < nt; t += 2) {
            const bool last = (t == nt - 2);
            const char* a1 = cA + (size_t)(t + 1) * kstep;
            const char* a2 = last ? nA : cA + (size_t)(t + 2) * kstep; const char* b2 = last ? nB : cB + (size_t)(t + 2) * kstep;
            const char* a3 = a2 + kstep; const char* b3 = b2 + kstep;
            if (last && has_next) S.a_ready(nxt);
            if constexpr (SP2) {
            PG8_LDB(B0, 0, 0); PG8_LDB(B1, 0, 1); PG8_SCHED; PG8_LDA(At, 0, 0); PG8_STAGE(PG8_SA(1, 1), a1 + hstep, voffA);
            PG8_WAIT_V(8); PG8_WAIT_L(0); PG8_BAR; PG8_MMA(0, 0, At, B0); PG8_MMA(0, 1, At, B1); PG8_BAR; PG8_SCHED;
            PG8_LDA(At, 0, 1); PG8_STAGE(PG8_SB(0, 0), b2, voffB); PG8_STAGE(PG8_SB(0, 1), b2 + hstep, voffB); PG8_STAGE(PG8_SA(0, 0), a2, voffA);
            PG8_WAIT_V(8); PG8_WAIT_L(0); PG8_BAR; PG8_MMA(1, 0, At, B0); PG8_MMA(1, 1, At, B1); PG8_BAR; PG8_SCHED;
            PG8_LDB(B0, 1, 0); PG8_LDB(B1, 1, 1); PG8_SCHED; PG8_LDA(At, 1, 0); PG8_STAGE(PG8_SA(0, 1), a2 + hstep, voffA);
            PG8_WAIT_V(8); PG8_WAIT_L(0); PG8_BAR; PG8_MMA(0, 0, At, B0); PG8_MMA(0, 1, At, B1); PG8_BAR; PG8_SCHED;
            PG8_LDA(At, 1, 1); PG8_STAGE(PG8_SB(1, 0), b3, voffB); PG8_STAGE(PG8_SB(1, 1), b3 + hstep, voffB); PG8_STAGE(PG8_SA(1, 0), a3, voffA);
            PG8_WAIT_V(8); PG8_WAIT_L(0); PG8_BAR; PG8_MMA(1, 0, At, B0); PG8_MMA(1, 1, At, B1); PG8_BAR; PG8_SCHED;
            } else {
            PG8_LDB(B0, 0, 0); PG8_SCHED; PG8_LDA(At, 0, 0); PG8_STAGE(PG8_SA(1, 1), a1 + hstep, voffA);
            PG8_WAIT_L(8); PG8_BAR; PG8_WAIT_L(0); PG8_MMA(0, 0, At, B0); PG8_BAR; PG8_SCHED;
            PG8_LDB(B1, 0, 1); PG8_STAGE(PG8_SB(0, 0), b2, voffB);
            PG8_BAR; PG8_WAIT_L(0); PG8_MMA(0, 1, At, B1); PG8_BAR;
            PG8_LDA(At, 0, 1); PG8_STAGE(PG8_SA(0, 0), a2, voffA);
            PG8_BAR; PG8_WAIT_L(0); PG8_MMA(1, 0, At, B0); PG8_BAR; PG8_SCHED;
            PG8_STAGE(PG8_SB(0, 1), b2 + hstep, voffB);
            PG8_WAIT_V(6); PG8_BAR; PG8_MMA(1, 1, At, B1); PG8_BAR;
            PG8_LDB(B0, 1, 0); PG8_SCHED; PG8_LDA(At, 1, 0); PG8_STAGE(PG8_SA(0, 1), a2 + hstep, voffA);
            PG8_WAIT_L(8); PG8_BAR; PG8_WAIT_L(0); PG8_MMA(0, 0, At, B0); PG8_BAR; PG8_SCHED;
            PG8_LDB(B1, 1, 1); PG8_STAGE(PG8_SB(1, 0), b3, voffB);
            PG8_BAR; PG8_WAIT_L(0); PG8_MMA(0, 1, At, B1); PG8_BAR;
            PG8_LDA(At, 1, 1); PG8_STAGE(PG8_SA(1, 0), a3, voffA);
            PG8_BAR; PG8_WAIT_L(0); PG8_MMA(1, 0, At, B0); PG8_BAR; PG8_SCHED;
            PG8_STAGE(PG8_SB(1, 1), b3 + hstep, voffB);
            PG8_WAIT_V(6); PG8_BAR; PG8_MMA(1, 1, At, B1); PG8_BAR;
            }
        }
        if constexpr (ALIGN_EPI) { if (wr == 0) PG8_BAR; }
        if constexpr (!Epi::AFTER_DRAIN) { E(acc, cur, wr, wc, fr, fq); S.done(cur); }
        if (!has_next) break;
#pragma unroll
        for (int a = 0; a < 2; ++a)
#pragma unroll
            for (int b = 0; b < 2; ++b)
#pragma unroll
                for (int m = 0; m < 4; ++m)
#pragma unroll
                    for (int n = 0; n < 2; ++n) acc[a][b][m][n] = (f32x4){0.f, 0.f, 0.f, 0.f};
        cur = nxt; cA = nA; cB = nB; ++ui;
        if constexpr (ALIGN_EPI) { if (wr == 1) PG8_BAR; }
    }
    PG8_WAIT_V(0);
    if constexpr (!ALIGN_EPI) { if (wr == 0) PG8_BAR; }
    PG8_BAR;
    if constexpr (Epi::AFTER_DRAIN) { E.fused(acc, cur, wr, wc, fr, fq, lds, wid, lane); S.done(cur); }
#undef PG8_SA
#undef PG8_SB
#undef PG8_STAGE
#undef PG8_LDA
#undef PG8_LDB
#undef PG8_MMA
#undef PG8_WAIT_V
#undef PG8_WAIT_L
#undef PG8_BAR
#undef PG8_SCHED
}
}
#define LAS __attribute__((address_space(3)))
#define XB_TMO      128
#define XB_XCNT(j)  (256  + 64 * (j))
#define XB_XSUB(j)  (1280 + 64 * (j))
#define XB_XGEN(j)  (2304 + 64 * (j))
#define XB_TOP      3328
#define XB_TOPGEN   3392
#define XCD_BAR_WORDS 3456
#define XB_SPIN_CAP (1u << 18)

__device__ __forceinline__ unsigned xb_ld(unsigned* p)              { return __hip_atomic_load(p, __ATOMIC_RELAXED, __HIP_MEMORY_SCOPE_AGENT); }
__device__ __forceinline__ unsigned xb_add(unsigned* p, unsigned v) { return __hip_atomic_fetch_add(p, v, __ATOMIC_RELAXED, __HIP_MEMORY_SCOPE_AGENT); }
__device__ __forceinline__ unsigned xb_xcc_id() { return (unsigned)__builtin_amdgcn_s_getreg((3 << 11) | 20) & 0xFu; }
#define XB_SPIN(cond, bar) do { unsigned _sp = 0; while (cond) { __builtin_amdgcn_s_sleep(1); \
    if ((++_sp & 255u) == 0u) { if (xb_ld(&(bar)[XB_TMO])) break; if (_sp > XB_SPIN_CAP) { atomicAdd(&(bar)[XB_TMO], 1u); break; } } } } while (0)

struct XcdBarrier {
    unsigned* bar; unsigned x;
    volatile LAS unsigned* st;
};

__device__ __forceinline__ XcdBarrier xcd_barrier_post(unsigned* bar, volatile LAS unsigned* st) {
    XcdBarrier b; b.bar = bar; b.x = xb_xcc_id(); b.st = st;
    if (threadIdx.x == 0) (void)xb_add(&bar[XB_XCNT(b.x)], 1u);
    return b;
}
__device__ __forceinline__ void xcd_barrier_complete(unsigned* bar, unsigned x, unsigned& nloc, unsigned& nx) {
    const unsigned G = gridDim.x * gridDim.y * gridDim.z;
    unsigned sum, cnt, mine, sp = 0u;
    for (;;) {
        sum = 0u; cnt = 0u; mine = 0u;
#pragma unroll
        for (unsigned j = 0; j < 16; ++j) { const unsigned c = xb_ld(&bar[XB_XCNT(j)]); sum += c; cnt += (c > 0u) ? 1u : 0u; mine = (j == x) ? c : mine; }
        if (sum == G) break;
        __builtin_amdgcn_s_sleep(1);
        if ((++sp & 255u) == 0u) { if (xb_ld(&bar[XB_TMO])) break; if (sp > XB_SPIN_CAP) { atomicAdd(&bar[XB_TMO], 1u); break; } }
    }
    nloc = mine > 0u ? mine : 1u; nx = cnt > 0u ? cnt : 1u;
}

__device__ __forceinline__ void xcd_barrier(const XcdBarrier& b) {
    asm volatile("s_waitcnt vmcnt(0)" ::: "memory");
    __syncthreads();
    if (threadIdx.x == 0) {
        unsigned* bar = b.bar;
        __builtin_amdgcn_s_waitcnt(0);
        unsigned nloc = b.st[0], nx = b.st[1];
        if (nloc == 0u) { xcd_barrier_complete(bar, b.x, nloc, nx); b.st[0] = nloc; b.st[1] = nx; }
        const unsigned old = xb_add(&bar[XB_XSUB(b.x)], 1u);
        const unsigned gen = old / nloc;
        if (old + 1u == (gen + 1u) * nloc) {
            __builtin_amdgcn_fence(__ATOMIC_RELEASE, "agent");
            asm volatile("s_waitcnt vmcnt(0)" ::: "memory");
            const unsigned og = xb_add(&bar[XB_TOP], 1u);
            const unsigned tg = og / nx;
            if (og + 1u == (tg + 1u) * nx) xb_add(&bar[XB_TOPGEN], 1u);
            else XB_SPIN(xb_ld(&bar[XB_TOPGEN]) == tg, bar);
            __builtin_amdgcn_fence(__ATOMIC_ACQUIRE, "agent");
            xb_add(&bar[XB_XGEN(b.x)], 1u);
            asm volatile("s_waitcnt vmcnt(0)" ::: "memory");
        } else {
            XB_SPIN(xb_ld(&bar[XB_XGEN(b.x)]) == gen, bar);
            __builtin_amdgcn_fence(__ATOMIC_ACQUIRE, "agent");
            asm volatile("s_waitcnt vmcnt(0)" ::: "memory");
        }
    }
    __syncthreads();
}
#undef LAS
using pg8::bf16x8; using pg8::f32x4; using pg8::u32x4; using pg8::f32x2;
#define GAS __attribute__((address_space(1)))
#define LAS __attribute__((address_space(3)))
typedef unsigned short bf16;
typedef unsigned v4u __attribute__((ext_vector_type(4)));
typedef unsigned v2u __attribute__((ext_vector_type(2)));
typedef float f32x2v __attribute__((ext_vector_type(2)));

constexpr int NTOK = 40960, DM = 2048, NLAYER = 4, INW = 5120;
constexpr int COL_UA = 0, COL_UB = 512, COL_Q = 1024, COL_K = 2048, COL_V = 3072, COL_G = 4096;
constexpr float ALPHA = 1.6817928305074290f;
constexpr float LN_EPS = 1e-5f, GN_EPS = 1e-6f;
constexpr int NEXP = 16384;
constexpr int NWAVES = 8, NTHR = 512;

constexpr size_t MiB = 1u << 20;
constexpr size_t WS_CTL = 0, CTL_ZERO_BYTES = 1 * MiB;
constexpr size_t WS_WIN = 1 * MiB;
constexpr size_t WS_WOUT = 81 * MiB;
constexpr size_t WS_WS = 113 * MiB;
constexpr size_t WS_WGLU = 145 * MiB;
constexpr size_t WS_WPOOL = 147 * MiB;
constexpr size_t WS_S5A = 149 * MiB;
constexpr size_t WS_S5B = 150 * MiB;
constexpr size_t WS_ROT = 152 * MiB;
constexpr size_t WS_S5BB = 153 * MiB;
constexpr size_t WS_U16 = 160 * MiB;
constexpr size_t WS_V16 = 416 * MiB;
constexpr size_t WS_U8 = 160 * MiB;
constexpr size_t WS_V8 = 288 * MiB;
constexpr size_t WS_USC = 416 * MiB;
constexpr size_t WS_VSC = 417 * MiB;
constexpr size_t WS_ROTC = 420 * MiB;
constexpr size_t WS_ROTS = 424 * MiB;
constexpr size_t WS_XN = 672 * MiB;
constexpr size_t WS_H = 832 * MiB;
constexpr size_t WS_CONCAT = 1232 * MiB;
constexpr size_t WS_BUFY = 1392 * MiB;
constexpr size_t WS_BUFP = 1432 * MiB;
constexpr size_t WS_STF = 1472 * MiB;
constexpr size_t WS_STB = 1632 * MiB;
constexpr size_t WS_IDX = 1792 * MiB;
constexpr size_t WS_GATE = 1812 * MiB;
constexpr size_t WS_S5ST = 1832 * MiB;
constexpr size_t WS_END = 1852 * MiB;
constexpr int CW_BAR = 4096;
constexpr int NPHASE = 1 + NLAYER * 10;

constexpr int LDS_SCRATCH = 147456;
constexpr int LDS_MISC = LDS_SCRATCH;
constexpr int LDS_BYTES = LDS_SCRATCH + 256;

__device__ __forceinline__ float bf_lo(unsigned w) { return __uint_as_float(w << 16); }
__device__ __forceinline__ float bf_hi(unsigned w) { return __uint_as_float(w & 0xffff0000u); }
typedef __bf16 bf16x2_t __attribute__((ext_vector_type(2)));
__device__ __forceinline__ unsigned pkbf(float lo, float hi) { const bf16x2_t v = {(__bf16)lo, (__bf16)hi}; return __builtin_bit_cast(unsigned, v); }
__device__ __forceinline__ bf16 f2bf(float f) { return __builtin_bit_cast(unsigned short, (__bf16)f); }
__device__ __forceinline__ float wave_sum(float v) {
#pragma unroll
    for (int o = 1; o < 64; o <<= 1) v += __shfl_xor(v, o);
    return v;
}
__device__ __forceinline__ float gelu_erf(float v) { return 0.5f * v * (1.0f + erff(v * 0.70710678118654752f)); }
__device__ __forceinline__ int tok_pos(int t) { return t < 32768 ? (t & 4095) : (t - 32768); }
__device__ __forceinline__ int tok_len(int t) { return t < 32768 ? 4096 : 8192; }
__device__ __forceinline__ void unpack8(const v4u q, float (&f)[8]) {
    f[0] = bf_lo(q.x); f[1] = bf_hi(q.x); f[2] = bf_lo(q.y); f[3] = bf_hi(q.y); f[4] = bf_lo(q.z); f[5] = bf_hi(q.z); f[6] = bf_lo(q.w); f[7] = bf_hi(q.w);
}
__device__ __forceinline__ v4u pack8(const float (&f)[8]) { v4u q; q.x = pkbf(f[0], f[1]); q.y = pkbf(f[2], f[3]); q.z = pkbf(f[4], f[5]); q.w = pkbf(f[6], f[7]); return q; }
#define LDS_WAIT() asm volatile("s_waitcnt lgkmcnt(0)" ::: "memory")
#define MFMA16(a, b, c) __builtin_amdgcn_mfma_f32_16x16x32_bf16((a), (b), (c), 0, 0, 0)

struct EpiStoreBf16 {
    static constexpr bool PERM = true, AFTER_DRAIN = false;
    bf16* O; int ldo;
    __device__ __forceinline__ void operator()(const f32x4 (&acc)[2][2][4][2], const pg8::Unit& u, int wr, int wc, int fr, int fq) const {
        const int row0 = u.pm * 256 + wr * 64 + fr, col0 = u.pn * 256 + wc * 32 + 8 * fq;
#pragma unroll
        for (int ai = 0; ai < 2; ++ai)
#pragma unroll
            for (int m = 0; m < 4; ++m) { bf16* rowp = O + (size_t)(row0 + ai * 128 + m * 16) * ldo + col0;
#pragma unroll
                for (int bj = 0; bj < 2; ++bj) { const f32x4 v0 = acc[ai][bj][m][0], v1 = acc[ai][bj][m][1];
                    v4u w; w.x = pkbf(v0[0], v0[1]); w.y = pkbf(v0[2], v0[3]); w.z = pkbf(v1[0], v1[1]); w.w = pkbf(v1[2], v1[3]);
                    *(v4u*)(rowp + bj * 128) = w; } }
    }
};
struct EpiStoreRot {
    static constexpr bool PERM = true, AFTER_DRAIN = false;
    bf16* O; int ldo; const float* rc; const float* rs;
    __device__ __forceinline__ void operator()(const f32x4 (&acc)[2][2][4][2], const pg8::Unit& u, int wr, int wc, int fr, int fq) const {
        const int row0 = u.pm * 256 + wr * 64 + fr, col0 = u.pn * 256 + wc * 32 + 8 * fq;
        const bool rot = u.pn >= 4 && u.pn < 12; const float sc = u.pn >= 8 ? 0.0625f : 1.0f;
#pragma unroll
        for (int ai = 0; ai < 2; ++ai)
#pragma unroll
            for (int m = 0; m < 4; ++m) { const int row = row0 + ai * 128 + m * 16; bf16* rowp = O + (size_t)row * ldo + col0;
                f32x4 a0 = acc[ai][0][m][0], a1 = acc[ai][0][m][1], b0 = acc[ai][1][m][0], b1 = acc[ai][1][m][1];
                if (rot) { const int pos = row < 32768 ? (row & 4095) : (row - 32768); const size_t to = (size_t)pos * 128 + wc * 32 + 8 * fq;
                    const f32x4 c0 = *(const f32x4*)(rc + to), c1 = *(const f32x4*)(rc + to + 4), s0 = *(const f32x4*)(rs + to), s1 = *(const f32x4*)(rs + to + 4);
                    const f32x4 x0 = a0, x1 = a1, y0 = b0, y1 = b1;
                    a0 = (x0 * c0 - y0 * s0) * sc; a1 = (x1 * c1 - y1 * s1) * sc; b0 = (y0 * c0 + x0 * s0) * sc; b1 = (y1 * c1 + x1 * s1) * sc; }
                v4u w; w.x = pkbf(a0[0], a0[1]); w.y = pkbf(a0[2], a0[3]); w.z = pkbf(a1[0], a1[1]); w.w = pkbf(a1[2], a1[3]); *(v4u*)rowp = w;
                v4u x; x.x = pkbf(b0[0], b0[1]); x.y = pkbf(b0[2], b0[3]); x.z = pkbf(b1[0], b1[1]); x.w = pkbf(b1[2], b1[3]); *(v4u*)(rowp + 128) = x; }
    }
};
struct EpiGlu {
    static constexpr bool PERM = true, AFTER_DRAIN = false;
    const bf16* Y; int ldy; bf16* O; int ldo; const float* bias;
    __device__ __forceinline__ void operator()(const f32x4 (&acc)[2][2][4][2], const pg8::Unit& u, int wr, int wc, int fr, int fq) const {
        const int row0 = u.pm * 256 + wr * 64 + fr, col0 = u.pn * 256 + wc * 32 + 8 * fq;
#pragma unroll
        for (int bj = 0; bj < 2; ++bj) {
            const f32x4 b0 = *(const f32x4*)(bias + col0 + bj * 128), b1 = *(const f32x4*)(bias + col0 + bj * 128 + 4);
#pragma unroll
            for (int ai = 0; ai < 2; ++ai)
#pragma unroll
                for (int m = 0; m < 4; ++m) { const size_t r = (size_t)(row0 + ai * 128 + m * 16);
                    const v4u yq = *(const v4u*)(Y + r * ldy + col0 + bj * 128); float y[8]; unpack8(yq, y);
                    const f32x4 v0 = acc[ai][bj][m][0] + b0, v1 = acc[ai][bj][m][1] + b1; float o[8];
#pragma unroll
                    for (int k = 0; k < 4; ++k) { o[k] = y[k] / (1.0f + __expf(-v0[k])); o[4 + k] = y[4 + k] / (1.0f + __expf(-v1[k])); }
                    *(v4u*)(O + r * ldo + col0 + bj * 128) = pack8(o); }
        }
    }
};
struct EpiScaleBf16 {
    static constexpr bool PERM = true, AFTER_DRAIN = false;
    bf16* O; int ldo; const float* scale;
    __device__ __forceinline__ void operator()(const f32x4 (&acc)[2][2][4][2], const pg8::Unit& u, int wr, int wc, int fr, int fq) const {
        const int row0 = u.pm * 256 + wr * 64 + fr, col0 = u.pn * 256 + wc * 32 + 8 * fq;
#pragma unroll
        for (int bj = 0; bj < 2; ++bj) {
            const f32x4 s0 = *(const f32x4*)(scale + col0 + bj * 128), s1 = *(const f32x4*)(scale + col0 + bj * 128 + 4);
#pragma unroll
            for (int ai = 0; ai < 2; ++ai)
#pragma unroll
                for (int m = 0; m < 4; ++m) { const size_t r = (size_t)(row0 + ai * 128 + m * 16);
                    const f32x4 v0 = acc[ai][bj][m][0] * s0, v1 = acc[ai][bj][m][1] * s1;
                    v4u w; w.x = pkbf(v0[0], v0[1]); w.y = pkbf(v0[2], v0[3]); w.z = pkbf(v1[0], v1[1]); w.w = pkbf(v1[2], v1[3]);
                    *(v4u*)(O + r * ldo + col0 + bj * 128) = w; }
        }
    }
};
struct EpiResid {
    static constexpr bool PERM = false, AFTER_DRAIN = false;
    float* X; int ldx; float alpha;
    __device__ __forceinline__ void operator()(const f32x4 (&acc)[2][2][4][2], const pg8::Unit& u, int wr, int wc, int fr, int fq) const {
        const int row0 = u.pm * 256 + wr * 64 + fr, col0 = u.pn * 256 + wc * 32 + 4 * fq;
#pragma unroll
        for (int ai = 0; ai < 2; ++ai)
#pragma unroll
            for (int m = 0; m < 4; ++m) { float* rowp = X + (size_t)(row0 + ai * 128 + m * 16) * ldx + col0;
#pragma unroll
                for (int bj = 0; bj < 2; ++bj)
#pragma unroll
                    for (int n = 0; n < 2; ++n) { f32x4* p = (f32x4*)(rowp + bj * 128 + n * 16); const f32x4 x = *p; *p = x * alpha + acc[ai][bj][m][n]; } }
    }
};
struct EpiStoreF32 {
    static constexpr bool PERM = false, AFTER_DRAIN = false;
    float* C; int ldc;
    __device__ __forceinline__ void operator()(const f32x4 (&acc)[2][2][4][2], const pg8::Unit& u, int wr, int wc, int fr, int fq) const {
        const int row0 = u.pm * 256 + wr * 64 + fr, col0 = u.pn * 256 + wc * 32 + 4 * fq;
#pragma unroll
        for (int ai = 0; ai < 2; ++ai)
#pragma unroll
            for (int m = 0; m < 4; ++m) { float* rowp = C + (size_t)(row0 + ai * 128 + m * 16) * ldc + col0;
#pragma unroll
                for (int bj = 0; bj < 2; ++bj)
#pragma unroll
                    for (int n = 0; n < 2; ++n) *(f32x4*)(rowp + bj * 128 + n * 16) = acc[ai][bj][m][n]; }
    }
};

struct EpiStoreF16 {
    static constexpr bool PERM = true, AFTER_DRAIN = false;
    _Float16* C; int ldc;
    __device__ __forceinline__ void operator()(const f32x4 (&acc)[2][2][4][2], const pg8::Unit& u, int wr, int wc, int fr, int fq) const {
        typedef _Float16 h8 __attribute__((ext_vector_type(8)));
        const int row0 = u.pm * 256 + wr * 64 + fr, col0 = u.pn * 256 + wc * 32 + 8 * fq;
#pragma unroll
        for (int ai = 0; ai < 2; ++ai)
#pragma unroll
            for (int m = 0; m < 4; ++m) { _Float16* rowp = C + (size_t)(row0 + ai * 128 + m * 16) * ldc + col0;
#pragma unroll
                for (int bj = 0; bj < 2; ++bj) { const f32x4 v0 = acc[ai][bj][m][0], v1 = acc[ai][bj][m][1];
                    h8 w; w[0] = (_Float16)v0[0]; w[1] = (_Float16)v0[1]; w[2] = (_Float16)v0[2]; w[3] = (_Float16)v0[3]; w[4] = (_Float16)v1[0]; w[5] = (_Float16)v1[1]; w[6] = (_Float16)v1[2]; w[7] = (_Float16)v1[3];
                    *(h8*)(rowp + bj * 128) = w; } }
    }
};
struct Args { const float* in[26]; float* out; unsigned char* ws; int ph_lo, ph_hi, li, pad; };
typedef const Args __attribute__((address_space(4))) CArgs;
struct Frame {
    LAS unsigned char* lds;
    int tid, lane, wave, G, bx;
    int gw, NGW;
    size_t gtid, NT;
    float* out; unsigned char* ws;
};
enum InIdx { I_XP = 0, I_XS, I_LNIN_G, I_LNIN_B, I_WIN, I_LAMRE, I_LAMIM, I_LOGSTEP, I_BRE, I_BIM, I_CRE, I_CIM, I_S5D, I_WGLU, I_BGLU, I_POOLW, I_POOLS,
             I_WOUT, I_LN1G, I_LN1B, I_WQ, I_KEYS, I_PU, I_PV, I_LN2G, I_LN2B };

__device__ __forceinline__ void ln_row(const float* src, const float* g, const float* b, float* dst, bf16* dstb, int lane) {
    f32x4 v[8]; float s = 0.f;
#pragma unroll
    for (int j = 0; j < 8; ++j) { v[j] = ((const f32x4*)src)[lane + 64 * j]; s += (v[j][0] + v[j][1]) + (v[j][2] + v[j][3]); }
    const float mean = wave_sum(s) * (1.0f / DM); float s2 = 0.f;
#pragma unroll
    for (int j = 0; j < 8; ++j) { v[j] = v[j] - mean; s2 += (v[j][0] * v[j][0] + v[j][1] * v[j][1]) + (v[j][2] * v[j][2] + v[j][3] * v[j][3]); }
    const float rstd = 1.0f / sqrtf(wave_sum(s2) * (1.0f / DM) + LN_EPS);
#pragma unroll
    for (int j = 0; j < 8; ++j) { const f32x4 gg = ((const f32x4*)g)[lane + 64 * j], bb = ((const f32x4*)b)[lane + 64 * j];
        const f32x4 o = v[j] * rstd * gg + bb; ((f32x4*)dst)[lane + 64 * j] = o;
        v2u w; w.x = pkbf(o[0], o[1]); w.y = pkbf(o[2], o[3]); ((v2u*)dstb)[lane + 64 * j] = w; }
}

__device__ __forceinline__ void ln_rows2(bf16* XB, const bf16* MIX, float alpha, const float* g, const float* b, int gw, int ngw, int lane) {
    for (int t = gw; t < NTOK; t += 2 * ngw) {
        const int t2 = t + ngw; const bool has2 = t2 < NTOK; const int tb = has2 ? t2 : t;
        f32x4 v0[8], v1[8]; v2u x0q[8], x1q[8], m0q[8], m1q[8]; float s0 = 0.f, s1 = 0.f;
#pragma unroll
        for (int j = 0; j < 8; ++j) { x0q[j] = ((const v2u*)(XB + (size_t)t * DM))[lane + 64 * j]; m0q[j] = ((const v2u*)(MIX + (size_t)t * DM))[lane + 64 * j]; }
#pragma unroll
        for (int j = 0; j < 8; ++j) { x1q[j] = ((const v2u*)(XB + (size_t)tb * DM))[lane + 64 * j]; m1q[j] = ((const v2u*)(MIX + (size_t)tb * DM))[lane + 64 * j]; }
#pragma unroll
        for (int j = 0; j < 8; ++j) {
            v0[j] = (f32x4){bf_lo(x0q[j].x), bf_hi(x0q[j].x), bf_lo(x0q[j].y), bf_hi(x0q[j].y)} * alpha + (f32x4){bf_lo(m0q[j].x), bf_hi(m0q[j].x), bf_lo(m0q[j].y), bf_hi(m0q[j].y)};
            v1[j] = (f32x4){bf_lo(x1q[j].x), bf_hi(x1q[j].x), bf_lo(x1q[j].y), bf_hi(x1q[j].y)} * alpha + (f32x4){bf_lo(m1q[j].x), bf_hi(m1q[j].x), bf_lo(m1q[j].y), bf_hi(m1q[j].y)};
            s0 += (v0[j][0] + v0[j][1]) + (v0[j][2] + v0[j][3]); s1 += (v1[j][0] + v1[j][1]) + (v1[j][2] + v1[j][3]); }
        const float m0 = wave_sum(s0) * (1.0f / DM), m1 = wave_sum(s1) * (1.0f / DM); float q0 = 0.f, q1 = 0.f;
#pragma unroll
        for (int j = 0; j < 8; ++j) { v0[j] = v0[j] - m0; v1[j] = v1[j] - m1;
            q0 += (v0[j][0] * v0[j][0] + v0[j][1] * v0[j][1]) + (v0[j][2] * v0[j][2] + v0[j][3] * v0[j][3]); q1 += (v1[j][0] * v1[j][0] + v1[j][1] * v1[j][1]) + (v1[j][2] * v1[j][2] + v1[j][3] * v1[j][3]); }
        const float rs0 = 1.0f / sqrtf(wave_sum(q0) * (1.0f / DM) + LN_EPS), rs1 = 1.0f / sqrtf(wave_sum(q1) * (1.0f / DM) + LN_EPS);
#pragma unroll
        for (int j = 0; j < 8; ++j) { const f32x4 gg = ((const f32x4*)g)[lane + 64 * j], bb = ((const f32x4*)b)[lane + 64 * j];
            const f32x4 o0 = v0[j] * rs0 * gg + bb;
            v2u w0; w0.x = pkbf(o0[0], o0[1]); w0.y = pkbf(o0[2], o0[3]); ((v2u*)(XB + (size_t)t * DM))[lane + 64 * j] = w0;
            if (has2) { const f32x4 o1 = v1[j] * rs1 * gg + bb;
                v2u w1; w1.x = pkbf(o1[0], o1[1]); w1.y = pkbf(o1[2], o1[3]); ((v2u*)(XB + (size_t)t2 * DM))[lane + 64 * j] = w1; } }
    }
}

__device__ __forceinline__ void transpose_item(const float* W, int K, int N, bf16* WT, LAS float* scr, int item, int lane) {
    const int nblk = N / 32, kb = item / nblk, nb = item % nblk, k0 = 64 * kb, n0 = 32 * nb;
#pragma unroll 8
    for (int i = 0; i < 32; ++i) { const int kk = 2 * i + (lane >> 5); scr[kk * 33 + (lane & 31)] = W[(size_t)(k0 + kk) * N + n0 + (lane & 31)]; }
    LDS_WAIT();
    const int c = lane & 7;
#pragma unroll
    for (int j = 0; j < 4; ++j) { const int n = (lane >> 3) + 8 * j; const LAS float* s = scr + (8 * c) * 33 + n;
        v4u o; o.x = pkbf(s[0 * 33], s[1 * 33]); o.y = pkbf(s[2 * 33], s[3 * 33]); o.z = pkbf(s[4 * 33], s[5 * 33]); o.w = pkbf(s[6 * 33], s[7 * 33]);
        *(v4u*)(WT + (size_t)(n0 + n) * K + k0 + 8 * c) = o; }
    LDS_WAIT();
}

__device__ __forceinline__ void p0_prologue(const Frame& F, CArgs& A) {
    {
        LAS float* scr = (LAS float*)(F.lds + F.wave * 16384);
        constexpr int I_IN = (DM / 64) * (INW / 32), I_OUT = (DM / 64) * (DM / 32), I_GLU = (512 / 64) * (512 / 32);
        constexpr int NITEMS = NLAYER * (I_IN + I_OUT + I_GLU);
        for (int it = F.gw; it < NITEMS; it += F.NGW) {
            int r = it;
            if (r < NLAYER * I_IN) { const int l = r / I_IN; transpose_item(A.in[I_WIN] + (size_t)l * DM * INW, DM, INW, (bf16*)(F.ws + WS_WIN) + (size_t)l * INW * DM, scr, r % I_IN, F.lane); continue; }
            r -= NLAYER * I_IN;
            if (r < NLAYER * I_OUT) { const int l = r / I_OUT; transpose_item(A.in[I_WOUT] + (size_t)l * DM * DM, DM, DM, (bf16*)(F.ws + WS_WOUT) + (size_t)l * DM * DM, scr, r % I_OUT, F.lane); continue; }
            r -= NLAYER * I_OUT;
            { const int l = r / I_GLU; transpose_item(A.in[I_WGLU] + (size_t)l * 512 * 512, 512, 512, (bf16*)(F.ws + WS_WGLU) + (size_t)l * 512 * 512, scr, r % I_GLU, F.lane); }
        }
    }
#if PEER_FP4
    {
        const int NR2 = 2 * NLAYER * NEXP;
        for (int r = F.gw; r < NR2; r += 2 * F.NGW) {
            const int r2 = r + F.NGW < NR2 ? r + F.NGW : r;
            const int tabA = r >= NLAYER * NEXP, riA = tabA ? r - NLAYER * NEXP : r, tabB = r2 >= NLAYER * NEXP, riB = tabB ? r2 - NLAYER * NEXP : r2;
            const float* srcA = (tabA ? A.in[I_PV] : A.in[I_PU]) + (size_t)riA * DM + F.lane * 4; const float* srcB = (tabB ? A.in[I_PV] : A.in[I_PU]) + (size_t)riB * DM + F.lane * 4;
            f32x4 va[8], vb[8]; float ama = 0.f, amb = 0.f;
#pragma unroll
            for (int q = 0; q < 8; ++q) va[q] = *(const f32x4*)(srcA + q * 256);
#pragma unroll
            for (int q = 0; q < 8; ++q) vb[q] = *(const f32x4*)(srcB + q * 256);
#pragma unroll
            for (int q = 0; q < 8; ++q) { ama = fmaxf(ama, fmaxf(fmaxf(fabsf(va[q][0]), fabsf(va[q][1])), fmaxf(fabsf(va[q][2]), fabsf(va[q][3])))); amb = fmaxf(amb, fmaxf(fmaxf(fabsf(vb[q][0]), fabsf(vb[q][1])), fmaxf(fabsf(vb[q][2]), fabsf(vb[q][3])))); }
#pragma unroll
            for (int o = 1; o < 64; o <<= 1) { ama = fmaxf(ama, __shfl_xor(ama, o)); amb = fmaxf(amb, __shfl_xor(amb, o)); }
#pragma unroll
            for (int half = 0; half < 2; ++half) {
                if (half == 1 && r2 == r) break;
                const float am = half ? amb : ama; const int tab = half ? tabB : tabA, ri = half ? riB : riA;
                const float sc = am > 0.f ? 6.0f / am : 1.0f, isc = am > 0.f ? am * (1.0f / 6.0f) : 1.0f;
                v4u w;
#pragma unroll
                for (int q = 0; q < 4; ++q) { const f32x4 e0 = half ? vb[2 * q] : va[2 * q], e1 = half ? vb[2 * q + 1] : va[2 * q + 1]; unsigned pk = 0u;
                    pk = __builtin_amdgcn_cvt_scalef32_pk_fp4_f32(pk, e0[0] * sc, e0[1] * sc, 1.0f, 0); pk = __builtin_amdgcn_cvt_scalef32_pk_fp4_f32(pk, e0[2] * sc, e0[3] * sc, 1.0f, 1);
                    pk = __builtin_amdgcn_cvt_scalef32_pk_fp4_f32(pk, e1[0] * sc, e1[1] * sc, 1.0f, 2); pk = __builtin_amdgcn_cvt_scalef32_pk_fp4_f32(pk, e1[2] * sc, e1[3] * sc, 1.0f, 3);
                    w[q] = pk; }
                *(v4u*)(F.ws + (tab ? WS_V8 : WS_U8) + (size_t)ri * (DM / 2) + F.lane * 16) = w;
                if (F.lane == 0) ((float*)(F.ws + (tab ? WS_VSC : WS_USC)))[ri] = isc;
            }
        }
    }
#else
    {
        for (int r = F.gw; r < 2 * NLAYER * NEXP; r += F.NGW) {
            const int tab = r >= NLAYER * NEXP, ri = tab ? r - NLAYER * NEXP : r;
            const float* src = (tab ? A.in[I_PV] : A.in[I_PU]) + (size_t)ri * DM;
            f32x4 v[2][4]; float am = 0.f;
#pragma unroll
            for (int c = 0; c < 2; ++c)
#pragma unroll
                for (int q = 0; q < 4; ++q) { v[c][q] = *(const f32x4*)(src + (c * 64 + F.lane) * 16 + q * 4);
                    am = fmaxf(am, fmaxf(fmaxf(fabsf(v[c][q][0]), fabsf(v[c][q][1])), fmaxf(fabsf(v[c][q][2]), fabsf(v[c][q][3])))); }
#pragma unroll
            for (int o = 1; o < 64; o <<= 1) am = fmaxf(am, __shfl_xor(am, o));
            const float sc = am > 0.f ? 384.0f / am : 1.0f, isc = am > 0.f ? am * (1.0f / 384.0f) : 1.0f;
            unsigned char* dst = F.ws + (tab ? WS_V8 : WS_U8) + (size_t)ri * DM;
#pragma unroll
            for (int c = 0; c < 2; ++c) { v4u w;
#pragma unroll
                for (int q = 0; q < 4; ++q) { int pk = 0; pk = __builtin_amdgcn_cvt_pk_fp8_f32(v[c][q][0] * sc, v[c][q][1] * sc, pk, false); pk = __builtin_amdgcn_cvt_pk_fp8_f32(v[c][q][2] * sc, v[c][q][3] * sc, pk, true); w[q] = (unsigned)pk; }
                *(v4u*)(dst + (c * 64 + F.lane) * 16) = w; }
            if (F.lane == 0) ((float*)(F.ws + (tab ? WS_VSC : WS_USC)))[ri] = isc;
        }
    }
#endif
    {
        const float* pw = A.in[I_POOLW]; v4u* dst = (v4u*)(F.ws + WS_WPOOL);
        for (size_t i = F.gtid; i < (size_t)NLAYER * 512 * 64; i += F.NT) {
            const int k8 = (int)(i & 63), n = (int)((i >> 6) & 511), l = (int)(i >> 15);
            const int g = n >> 7, d = n & 127, kg = k8 >> 4, c0 = (k8 & 15) * 8;
            float f[8];
#pragma unroll
            for (int k = 0; k < 8; ++k) f[k] = (kg == g) ? pw[(((size_t)l * 4 + g) * 128 + (c0 + k)) * 128 + d] : 0.f;
            dst[i] = pack8(f);
        }
    }
    {
        const float* lre = A.in[I_LAMRE]; const float* lim = A.in[I_LAMIM]; const float* lst = A.in[I_LOGSTEP]; const float* bre = A.in[I_BRE]; const float* bim = A.in[I_BIM];
        f32x2v* ab = (f32x2v*)(F.ws + WS_S5A); f32x2v* ab64 = (f32x2v*)(F.ws + WS_S5A + 512 * 1024); f32x2v* bb = (f32x2v*)(F.ws + WS_S5B);
        for (size_t i = F.gtid; i < (size_t)NLAYER * 2 * 32 * 64; i += F.NT) {
            const float lr = lre[i], li = lim[i], dt = expf(lst[i >> 6]);
            const float mag = expf(lr * dt), ar = mag * cosf(li * dt), ai = mag * sinf(li * dt);
            const float den = lr * lr + li * li;
            const float zr = ((ar - 1.0f) * lr + ai * li) / den, zi = (ai * lr - (ar - 1.0f) * li) / den;
            ab[i] = (f32x2v){ar, ai};
            const float m64 = expf(lr * dt * 64.0f), an = li * dt * 64.0f;
            ab64[i] = (f32x2v){m64 * cosf(an), m64 * sinf(an)};
#pragma unroll
            for (int c = 0; c < 16; ++c) { const float br = bre[i * 16 + c], bi = bim[i * 16 + c]; bb[i * 16 + c] = (f32x2v){zr * br - zi * bi, zr * bi + zi * br}; }
            {
                bf16* o = (bf16*)(F.ws + WS_S5BB) + ((size_t)(i >> 6) * 128 + 2 * (i & 63)) * 32;
#pragma unroll
                for (int c = 0; c < 16; ++c) { const float br = bre[i * 16 + c], bi = bim[i * 16 + c]; o[c] = f2bf(zr * br - zi * bi); o[32 + c] = f2bf(zr * bi + zi * br); o[16 + c] = 0; o[48 + c] = 0; }
            }
        }
    }
    {
        float* rc = (float*)(F.ws + WS_ROTC); float* rs = (float*)(F.ws + WS_ROTS);
        for (size_t i = F.gtid; i < (size_t)8192 * 128; i += F.NT) { const float inv = (float)exp(-(double)(i & 127) / 127.0 * 9.210340371976184); const float ang = (float)(i >> 7) * inv; rc[i] = cosf(ang); rs[i] = sinf(ang); }
    }
    __syncthreads();
    {
        LAS float* KS = (LAS float*)F.lds;
        LAS float* WQ = (LAS float*)(F.lds + 128 * 132 * 4);
        const float* keys = A.in[I_KEYS]; const float* wq = A.in[I_WQ]; bf16* wst = (bf16*)(F.ws + WS_WS);
        for (int u = F.bx; u < NLAYER * 16 * 32; u += F.G) {
            const int dtl = u & 31, hp = (u >> 5) & 15, l = u >> 9, p = hp & 1;
#pragma unroll
            for (int r = 0; r < 8; ++r) { const int f = F.tid + 512 * r, nk = f >> 5, c4 = f & 31;
                *(LAS f32x4*)(KS + nk * 132 + c4 * 4) = *(const f32x4*)(keys + (((size_t)l * 2 + p) * 128 + nk) * 128 + c4 * 4); }
#pragma unroll
            for (int r = 0; r < 4; ++r) { const int f = F.tid + 512 * r, dd = f >> 5, c4 = f & 31;
                *(LAS f32x4*)(WQ + dd * 132 + c4 * 4) = *(const f32x4*)(wq + ((size_t)l * DM + dtl * 64 + dd) * DM + hp * 128 + c4 * 4); }
            __syncthreads();
            const int nk = F.tid & 127, dg = F.tid >> 7;
            float acc[16];
#pragma unroll
            for (int i = 0; i < 16; ++i) acc[i] = 0.f;
            for (int c4 = 0; c4 < 32; ++c4) {
                const f32x4 kv = *(const LAS f32x4*)(KS + nk * 132 + c4 * 4);
#pragma unroll
                for (int i = 0; i < 16; ++i) { const f32x4 wv = *(const LAS f32x4*)(WQ + (dg * 16 + i) * 132 + c4 * 4);
                    acc[i] += (kv[0] * wv[0] + kv[1] * wv[1]) + (kv[2] * wv[2] + kv[3] * wv[3]); }
            }
            bf16* o = wst + ((size_t)l * DM + hp * 128 + nk) * DM + dtl * 64 + dg * 16;
            v4u q0, q1; q0.x = pkbf(acc[0], acc[1]); q0.y = pkbf(acc[2], acc[3]); q0.z = pkbf(acc[4], acc[5]); q0.w = pkbf(acc[6], acc[7]);
            q1.x = pkbf(acc[8], acc[9]); q1.y = pkbf(acc[10], acc[11]); q1.z = pkbf(acc[12], acc[13]); q1.w = pkbf(acc[14], acc[15]);
            *(v4u*)o = q0; *(v4u*)(o + 8) = q1;
            __syncthreads();
        }
    }
    {
        const float* xp = A.in[I_XP]; const float* xs = A.in[I_XS]; const float* g = A.in[I_LNIN_G]; const float* b = A.in[I_LNIN_B]; bf16* XB = (bf16*)(F.ws + WS_XN);
        for (int t = F.gw; t < NTOK; t += 2 * F.NGW) {
            const int t2 = t + F.NGW; const bool has2 = t2 < NTOK; const int tb = has2 ? t2 : t;
            const float* s0p = t < 32768 ? xp + (size_t)t * DM : xs + (size_t)(t - 32768) * DM; const float* s1p = tb < 32768 ? xp + (size_t)tb * DM : xs + (size_t)(tb - 32768) * DM;
            f32x4 v0[8], v1[8]; float s0 = 0.f, s1 = 0.f;
#pragma unroll
            for (int j = 0; j < 8; ++j) v0[j] = ((const f32x4*)s0p)[F.lane + 64 * j];
#pragma unroll
            for (int j = 0; j < 8; ++j) v1[j] = ((const f32x4*)s1p)[F.lane + 64 * j];
#pragma unroll
            for (int j = 0; j < 8; ++j) { s0 += (v0[j][0] + v0[j][1]) + (v0[j][2] + v0[j][3]); s1 += (v1[j][0] + v1[j][1]) + (v1[j][2] + v1[j][3]); }
            const float m0 = wave_sum(s0) * (1.0f / DM), m1 = wave_sum(s1) * (1.0f / DM); float q0 = 0.f, q1 = 0.f;
#pragma unroll
            for (int j = 0; j < 8; ++j) { v0[j] = v0[j] - m0; v1[j] = v1[j] - m1;
                q0 += (v0[j][0] * v0[j][0] + v0[j][1] * v0[j][1]) + (v0[j][2] * v0[j][2] + v0[j][3] * v0[j][3]); q1 += (v1[j][0] * v1[j][0] + v1[j][1] * v1[j][1]) + (v1[j][2] * v1[j][2] + v1[j][3] * v1[j][3]); }
            const float rs0 = 1.0f / sqrtf(wave_sum(q0) * (1.0f / DM) + LN_EPS), rs1 = 1.0f / sqrtf(wave_sum(q1) * (1.0f / DM) + LN_EPS);
#pragma unroll
            for (int j = 0; j < 8; ++j) { const f32x4 gg = ((const f32x4*)g)[F.lane + 64 * j], bb = ((const f32x4*)b)[F.lane + 64 * j];
                const f32x4 o0 = v0[j] * rs0 * gg + bb;
                v2u w0; w0.x = pkbf(o0[0], o0[1]); w0.y = pkbf(o0[2], o0[3]); ((v2u*)(XB + (size_t)t * DM))[F.lane + 64 * j] = w0;
                if (has2) { const f32x4 o1 = v1[j] * rs1 * gg + bb;
                    v2u w1; w1.x = pkbf(o1[0], o1[1]); w1.y = pkbf(o1[2], o1[3]); ((v2u*)(XB + (size_t)t2 * DM))[F.lane + 64 * j] = w1; } }
        }
    }
}

__device__ __forceinline__ float ret_log2_gamma(int h) { return log2f(1.0f - exp2f(-5.0f - (float)h)); }

__device__ __forceinline__ void s5_pass1(const Frame& F, CArgs& A, int l) {
    LAS float* BUs = (LAS float*)(F.lds + F.wave * 8448);
    const bf16* H = (const bf16*)(F.ws + WS_H);
    const f32x2v* ab = (const f32x2v*)(F.ws + WS_S5A); const bf16* BB = (const bf16*)(F.ws + WS_S5BB);
    f32x2v* st = (f32x2v*)(F.ws + WS_S5ST);
    const int lane = F.lane, lr = lane & 15, lq = lane >> 4;
    const int gstep = F.G < 32 ? F.G : 32;
    for (int g = F.bx % 32; g < 32; g += gstep) {
        const int nwg = F.G < 32 ? 1 : (F.G - g + 31) / 32, rank = F.G < 32 ? 0 : F.bx / 32;
        bf16x8 Bop[2][8]; f32x2v a2[2], arot[2];
#pragma unroll
        for (int dir = 0; dir < 2; ++dir) { const int gi = (l * 2 + dir) * 32 + g; a2[dir] = ab[gi * 64 + lane]; arot[dir] = (f32x2v){-a2[dir][1], a2[dir][1]};
#pragma unroll
            for (int j = 0; j < 8; ++j) Bop[dir][j] = *(const bf16x8*)(BB + ((size_t)gi * 128 + 16 * j + lr) * 32 + lq * 8); }
        for (int ck = rank * NWAVES + F.wave; ck < 640; ck += nwg * NWAVES) {
            bf16x8 uop[4];
#pragma unroll
            for (int tb = 0; tb < 4; ++tb) { const v4u q = lq < 2 ? *(const v4u*)(H + (size_t)(ck * 64 + 16 * tb + lr) * INW + COL_UA + g * 16 + lq * 8) : (v4u){0u, 0u, 0u, 0u}; uop[tb] = __builtin_bit_cast(bf16x8, q); }
#pragma unroll
            for (int dir = 0; dir < 2; ++dir) {
                f32x2v x2 = (f32x2v){0.f, 0.f};
#pragma unroll
                for (int blk = 0; blk < 4; ++blk) {
                    const int tb = dir ? 3 - blk : blk;
#pragma unroll
                    for (int j = 0; j < 8; ++j) { const f32x4 d = MFMA16(Bop[dir][j], uop[tb], ((f32x4){0.f, 0.f, 0.f, 0.f}));
                        *(LAS f32x4*)(BUs + lr * 132 + 16 * j + 4 * lq) = d; }
                    LDS_WAIT();
#pragma unroll
                    for (int s = 0; s < 16; ++s) { const int tl = dir ? 15 - s : s;
                        const f32x2v bu = *(const LAS f32x2v*)(BUs + tl * 132 + 2 * lane);
                        x2 = x2 * a2[dir][0] + (arot[dir] * (f32x2v){x2[1], x2[0]} + bu); }
                    LDS_WAIT();
                }
                st[(size_t)((ck * 32 + g) * 2 + dir) * 64 + lane] = x2;
            }
        }
    }
}
__device__ __forceinline__ void s5_carry(const Frame& F, CArgs& A, int l) {
    const f32x2v* ab64 = (const f32x2v*)(F.ws + WS_S5A + 512 * 1024); f32x2v* st = (f32x2v*)(F.ws + WS_S5ST);
    for (size_t it = F.gtid; it < (size_t)9 * 32 * 2 * 64; it += F.NT) {
        const int p = (int)(it & 63), dir = (int)((it >> 6) & 1), g = (int)((it >> 7) & 31), s = (int)(it >> 12);
        const int ck0 = s < 8 ? s * 64 : 512, n = s < 8 ? 64 : 128;
        const f32x2v a = ab64[((l * 2 + dir) * 32 + g) * 64 + p];
        float cr = 0.f, ci = 0.f;
        for (int k0 = 0; k0 < n; k0 += 8) {
            f32x2v le[8];
#pragma unroll
            for (int kk = 0; kk < 8; ++kk) { const int ck = dir ? (ck0 + n - 1 - (k0 + kk)) : (ck0 + k0 + kk); le[kk] = st[(size_t)((ck * 32 + g) * 2 + dir) * 64 + p]; }
#pragma unroll
            for (int kk = 0; kk < 8; ++kk) { const int ck = dir ? (ck0 + n - 1 - (k0 + kk)) : (ck0 + k0 + kk);
                st[(size_t)((ck * 32 + g) * 2 + dir) * 64 + p] = (f32x2v){cr, ci};
                const float ncr = a[0] * cr - a[1] * ci + le[kk][0], nci = a[0] * ci + a[1] * cr + le[kk][1]; cr = ncr; ci = nci; }
        }
    }
}
__device__ __forceinline__ void s5_pass3(const Frame& F, CArgs& A, int l) {
    LAS bf16* CtS = (LAS bf16*)F.lds;
    LAS unsigned char* wb = F.lds + 8704 + F.wave * 12800;
    LAS float* BUs = (LAS float*)wb;
    LAS bf16* Xw = (LAS bf16*)(wb + 8448);
    const bf16* H = (const bf16*)(F.ws + WS_H); bf16* BY = (bf16*)(F.ws + WS_BUFY);
    const f32x2v* ab = (const f32x2v*)(F.ws + WS_S5A); const bf16* BB = (const bf16*)(F.ws + WS_S5BB);
    const f32x2v* st = (const f32x2v*)(F.ws + WS_S5ST);
    const float* cre = A.in[I_CRE]; const float* cim = A.in[I_CIM]; const float* dvec = A.in[I_S5D] + (size_t)l * 512;
    const int lane = F.lane, lr = lane & 15, lq = lane >> 4;
    const int gstep = F.G < 32 ? F.G : 32;
    for (int g = F.bx % 32; g < 32; g += gstep) {
        const int nwg = F.G < 32 ? 1 : (F.G - g + 31) / 32, rank = F.G < 32 ? 0 : F.bx / 32;
        __syncthreads();
        {
            const int tq = opaque(F.tid);
#pragma unroll
            for (int r = 0; r < 8; ++r) { const int e = tq + 512 * r, pp = e & 127, c = (e >> 7) & 15, dir = e >> 11;
                const size_t cb = (size_t)(((l * 2 + dir) * 32 + g) * 16 + c) * 64;
                CtS[(dir * 16 + c) * 136 + pp] = f2bf(pp < 64 ? cre[cb + pp] : -cim[cb + pp - 64]); }
        }
        bf16x8 Bop[2][8]; f32x2v a2[2], arot[2];
#pragma unroll
        for (int dir = 0; dir < 2; ++dir) { const int gi = (l * 2 + dir) * 32 + g; a2[dir] = ab[gi * 64 + lane]; arot[dir] = (f32x2v){-a2[dir][1], a2[dir][1]};
#pragma unroll
            for (int j = 0; j < 8; ++j) Bop[dir][j] = *(const bf16x8*)(BB + ((size_t)gi * 128 + 16 * j + lr) * 32 + lq * 8); }
        __syncthreads();
        for (int ck = rank * NWAVES + F.wave; ck < 640; ck += nwg * NWAVES) {
            bf16x8 uop[4];
#pragma unroll
            for (int tb = 0; tb < 4; ++tb) { const v4u q = lq < 2 ? *(const v4u*)(H + (size_t)(ck * 64 + 16 * tb + lr) * INW + COL_UA + g * 16 + lq * 8) : (v4u){0u, 0u, 0u, 0u}; uop[tb] = __builtin_bit_cast(bf16x8, q); }
            f32x2v xin[2];
#pragma unroll
            for (int dir = 0; dir < 2; ++dir) xin[dir] = st[(size_t)((ck * 32 + g) * 2 + dir) * 64 + lane];
            f32x4 Y[4];
#pragma unroll
            for (int m = 0; m < 4; ++m) Y[m] = (f32x4){0.f, 0.f, 0.f, 0.f};
#pragma unroll
            for (int dir = 0; dir < 2; ++dir) {
                f32x2v x2 = xin[dir];
#pragma unroll
                for (int blk = 0; blk < 4; ++blk) {
                    const int tb = dir ? 3 - blk : blk;
#pragma unroll
                    for (int j = 0; j < 8; ++j) { const f32x4 d = MFMA16(Bop[dir][j], uop[tb], ((f32x4){0.f, 0.f, 0.f, 0.f}));
                        *(LAS f32x4*)(BUs + lr * 132 + 16 * j + 4 * lq) = d; }
                    LDS_WAIT();
#pragma unroll
                    for (int s = 0; s < 16; ++s) { const int tl = dir ? 15 - s : s;
                        const f32x2v bu = *(const LAS f32x2v*)(BUs + tl * 132 + 2 * lane);
                        x2 = x2 * a2[dir][0] + (arot[dir] * (f32x2v){x2[1], x2[0]} + bu);
                        Xw[tl * 136 + lane] = f2bf(x2[0]); Xw[tl * 136 + 64 + lane] = f2bf(x2[1]); }
                    LDS_WAIT();
#pragma unroll
                    for (int ks = 0; ks < 4; ++ks) {
                        const bf16x8 av = *(const LAS bf16x8*)(CtS + (dir * 16 + lr) * 136 + 32 * ks + lq * 8);
                        const bf16x8 bv = *(const LAS bf16x8*)(Xw + lr * 136 + 32 * ks + lq * 8);
                        Y[tb] = MFMA16(av, bv, Y[tb]);
                    }
                    LDS_WAIT();
                }
            }
#pragma unroll
            for (int m = 0; m < 4; ++m) {
                const int t = 16 * m + lr, c0 = 4 * lq;
                const v2u uq = *(const v2u*)(H + (size_t)(ck * 64 + t) * INW + COL_UA + g * 16 + c0);
                const f32x4 uv = (f32x4){bf_lo(uq.x), bf_hi(uq.x), bf_lo(uq.y), bf_hi(uq.y)}; const f32x4 dv = *(const f32x4*)(dvec + g * 16 + c0);
                const f32x4 y = Y[m] + dv * uv;
                v2u w; w.x = pkbf(gelu_erf(y[0]), gelu_erf(y[1])); w.y = pkbf(gelu_erf(y[2]), gelu_erf(y[3]));
                *(v2u*)(BY + (size_t)(ck * 64 + t) * 512 + g * 16 + c0) = w;
            }
        }
    }
}
__device__ __forceinline__ void pool_phase(const Frame& F, CArgs& A) {
    const bf16* H = (const bf16*)(F.ws + WS_H); bf16* BP = (bf16*)(F.ws + WS_BUFP);
    for (size_t it = F.gtid; it < (size_t)NTOK * 64; it += F.NT) {
        const int t = (int)(it >> 6), o = (int)(it & 63), gi = o >> 4, w = 2 << gi;
        const int pos = tok_pos(t), L = tok_len(t);
        const int lo = max(pos - w / 2, 0), hi = min(pos + w / 2 - 1, L - 1);
        const bf16* base = H + (size_t)(t - pos) * INW + COL_UB + o * 8;
        float s[8];
#pragma unroll
        for (int k = 0; k < 8; ++k) s[k] = 0.f;
        v4u wq[16];
#pragma unroll
        for (int i = 0; i < 16; ++i) { const int si = lo + i <= hi ? lo + i : hi; wq[i] = *(const v4u*)(base + (size_t)si * INW); }
#pragma unroll
        for (int i = 0; i < 16; ++i) { float f[8]; unpack8(wq[i], f); const float wgt = lo + i <= hi ? 1.0f : 0.0f;
#pragma unroll
            for (int k = 0; k < 8; ++k) s[k] += wgt * f[k]; }
        const float inv = 1.0f / (float)(hi - lo + 1);
        float c[8]; unpack8(*(const v4u*)(base + (size_t)pos * INW), c);
#pragma unroll
        for (int k = 0; k < 8; ++k) s[k] = s[k] * inv - c[k];
        *(v4u*)(BP + (size_t)t * 512 + o * 8) = pack8(s);
    }
}
__device__ __forceinline__ void rotary_phase(const Frame& F, CArgs& A) {
    bf16* H = (bf16*)(F.ws + WS_H); const float* rot = (const float*)(F.ws + WS_ROT);
    for (size_t it = F.gtid; it < (size_t)NTOK * 16; it += F.NT) {
        const int t = (int)(it >> 4), o = (int)(it & 15); const float pos = (float)tok_pos(t);
        float cs[8], sn[8];
#pragma unroll
        for (int k = 0; k < 8; ++k) { const float ang = pos * rot[o * 8 + k]; cs[k] = cosf(ang); sn[k] = sinf(ang); }
#pragma unroll
        for (int which = 0; which < 2; ++which) {
            const float sc = which ? 0.0625f : 1.0f;
#pragma unroll
            for (int hd = 0; hd < 4; ++hd) {
                bf16* p1 = H + (size_t)t * INW + (which ? COL_K : COL_Q) + hd * 256 + o * 8; bf16* p2 = p1 + 128;
                float x1[8], x2[8], o1[8], o2[8]; unpack8(*(const v4u*)p1, x1); unpack8(*(const v4u*)p2, x2);
#pragma unroll
                for (int k = 0; k < 8; ++k) { o1[k] = (x1[k] * cs[k] - x2[k] * sn[k]) * sc; o2[k] = (x2[k] * cs[k] + x1[k] * sn[k]) * sc; }
                *(v4u*)p1 = pack8(o1); *(v4u*)p2 = pack8(o2);
            }
        }
    }
}
constexpr int RS = 136;
template <int MODE = 0> __device__ __forceinline__ void ret_state_phase(const Frame& F, CArgs& A) {
    const bf16* H = (const bf16*)(F.ws + WS_H); bf16* STF = (bf16*)(F.ws + WS_STF); bf16* STB = (bf16*)(F.ws + WS_STB);
    LAS bf16* Kt = (LAS bf16*)F.lds; LAS bf16* VtF = Kt + 128 * RS; LAS bf16* VtB = Kt + 256 * RS;
    LAS unsigned* Kt32 = (LAS unsigned*)Kt; LAS unsigned* VtF32 = (LAS unsigned*)VtF; LAS unsigned* VtB32 = (LAS unsigned*)VtB;
    const int tid = F.tid, lane = F.lane, lr = lane & 15, lq = lane >> 4, we = F.wave >> 1, wd = F.wave & 1;
    const int jp = tid & 63, j = 2 * jp, pc0 = tid >> 6;
    v4u pk0[2], pk1[2], pv0[2], pv1[2];
#define RS_LOAD(u_) do { const int dh_ = (u_) & 1, eh_ = ((u_) >> 1) & 1, h_ = ((u_) >> 2) & 3, c_ = (u_) >> 4; \
        const bf16* krow_ = H + (size_t)(c_ * 128 + j) * INW + COL_K + h_ * 256 + dh_ * 128; const bf16* vrow_ = H + (size_t)(c_ * 128 + j) * INW + COL_V + h_ * 256 + eh_ * 128; \
        _Pragma("unroll") for (int r = 0; r < 2; ++r) { const int pc = pc0 + 8 * r; pk0[r] = *(const v4u*)(krow_ + pc * 8); pk1[r] = *(const v4u*)(krow_ + INW + pc * 8); pv0[r] = *(const v4u*)(vrow_ + pc * 8); pv1[r] = *(const v4u*)(vrow_ + INW + pc * 8); } } while (0)
    if (F.bx < 5120) RS_LOAD(F.bx);
    for (int u = F.bx; u < 5120; u += F.G) {
        const int dh = u & 1, eh = (u >> 1) & 1, h = (u >> 2) & 3, c = u >> 4;
        if (MODE != 2) {
            const float lg = ret_log2_gamma(h), fF0 = exp2f(lg * (float)(127 - j)), fF1 = exp2f(lg * (float)(126 - j)), fB0 = exp2f(lg * (float)j), fB1 = exp2f(lg * (float)(j + 1));
#pragma unroll
            for (int r = 0; r < 2; ++r) {
                const int pc = pc0 + 8 * r;
                const unsigned ka0[4] = {pk0[r].x, pk0[r].y, pk0[r].z, pk0[r].w}, ka1[4] = {pk1[r].x, pk1[r].y, pk1[r].z, pk1[r].w};
                float f0[8], f1[8]; unpack8(pv0[r], f0); unpack8(pv1[r], f1);
#pragma unroll
                for (int i = 0; i < 8; ++i) {
                    const unsigned a = ka0[i >> 1], b = ka1[i >> 1];
                    const unsigned kk = (i & 1) ? ((a >> 16) | (b & 0xffff0000u)) : ((a & 0xffffu) | (b << 16));
                    const int o = ((pc * 8 + i) * RS) / 2 + jp;
                    Kt32[o] = kk; VtF32[o] = pkbf(f0[i] * fF0, f1[i] * fF1); VtB32[o] = pkbf(f0[i] * fB0, f1[i] * fB1);
                }
            }
        }
        __syncthreads();
        if (u + F.G < 5120) RS_LOAD(u + F.G);
        if (MODE == 1) { __syncthreads(); continue; }
        f32x4 aF[4][2], aB[4][2];
#pragma unroll
        for (int td = 0; td < 4; ++td)
#pragma unroll
            for (int te = 0; te < 2; ++te) { aF[td][te] = (f32x4){0.f, 0.f, 0.f, 0.f}; aB[td][te] = (f32x4){0.f, 0.f, 0.f, 0.f}; }
#pragma unroll
        for (int ks = 0; ks < 4; ++ks) {
            bf16x8 ka[4], vF[2], vB[2];
#pragma unroll
            for (int td = 0; td < 4; ++td) ka[td] = *(const LAS bf16x8*)(Kt + (64 * wd + 16 * td + lr) * RS + 32 * ks + lq * 8);
#pragma unroll
            for (int te = 0; te < 2; ++te) { vF[te] = *(const LAS bf16x8*)(VtF + (32 * we + 16 * te + lr) * RS + 32 * ks + lq * 8); vB[te] = *(const LAS bf16x8*)(VtB + (32 * we + 16 * te + lr) * RS + 32 * ks + lq * 8); }
#pragma unroll
            for (int td = 0; td < 4; ++td)
#pragma unroll
                for (int te = 0; te < 2; ++te) { aF[td][te] = MFMA16(ka[td], vF[te], aF[td][te]); aB[td][te] = MFMA16(ka[td], vB[te], aB[td][te]); }
        }
        __syncthreads();
        {
            LAS bf16* OutF = Kt; LAS bf16* OutB = Kt + 128 * RS;
#pragma unroll
            for (int td = 0; td < 4; ++td)
#pragma unroll
                for (int te = 0; te < 2; ++te) {
                    const int e = 32 * we + 16 * te + lr, d = 64 * wd + 16 * td + 4 * lq;
                    v2u w; w.x = pkbf(aF[td][te][0], aF[td][te][1]); w.y = pkbf(aF[td][te][2], aF[td][te][3]); *(LAS v2u*)(OutF + e * RS + d) = w;
                    v2u x; x.x = pkbf(aB[td][te][0], aB[td][te][1]); x.y = pkbf(aB[td][te][2], aB[td][te][3]); *(LAS v2u*)(OutB + e * RS + d) = x;
                }
            __syncthreads();
            const int tq = opaque(tid);
#pragma unroll
            for (int r = 0; r < 8; ++r) { const int f = tq + 512 * r, mat = f >> 11, row = (f >> 4) & 127, pc = f & 15;
                const v4u q = *(const LAS v4u*)(Kt + (mat * 128 + row) * RS + pc * 8);
                bf16* dst = (mat ? STB : STF) + ((size_t)(c * 4 + h) * 256 + eh * 128 + row) * 256 + dh * 128 + pc * 8;
                *(v4u*)dst = q; }
        }
        __syncthreads();
    }
#undef RS_LOAD
}
__device__ __forceinline__ void ret_prefix_phase(const Frame& F, CArgs& A) {
    bf16* STF = (bf16*)(F.ws + WS_STF); bf16* STB = (bf16*)(F.ws + WS_STB);
    for (size_t it = F.gtid; it < (size_t)36 * 2 * 8192; it += F.NT) {
        const int o = (int)(it & 8191), which = (int)((it >> 13) & 1), bh = (int)(it >> 14), h = bh & 3, s = bh >> 2;
        const int c0 = s < 8 ? s * 32 : 256, n = s < 8 ? 32 : 64;
        const float dec = exp2f(128.0f * ret_log2_gamma(h));
        float st[8];
#pragma unroll
        for (int k = 0; k < 8; ++k) st[k] = 0.f;
        bf16* base = (which ? STB : STF) + (size_t)h * 65536 + (size_t)o * 8;
        for (int k0 = 0; k0 < n; k0 += 8) {
            v4u q[8];
#pragma unroll
            for (int kk = 0; kk < 8; ++kk) { const int c = which ? (c0 + n - 1 - (k0 + kk)) : (c0 + k0 + kk); q[kk] = *(const v4u*)(base + (size_t)c * 4 * 65536); }
#pragma unroll
            for (int kk = 0; kk < 8; ++kk) { const int c = which ? (c0 + n - 1 - (k0 + kk)) : (c0 + k0 + kk);
                float f[8]; unpack8(q[kk], f);
#pragma unroll
                for (int i = 0; i < 8; ++i) st[i] = dec * st[i] + f[i];
                *(v4u*)(base + (size_t)c * 4 * 65536) = pack8(st); }
        }
    }
}
__device__ __forceinline__ void ret_out_phase(const Frame& F, CArgs& A) {
    const bf16* H = (const bf16*)(F.ws + WS_H); const bf16* STF = (const bf16*)(F.ws + WS_STF); const bf16* STB = (const bf16*)(F.ws + WS_STB);
    bf16* CC = (bf16*)(F.ws + WS_CONCAT);
    LAS bf16* RA = (LAS bf16*)F.lds; LAS bf16* RB = RA + 128 * RS; LAS bf16* RC = RA + 384 * RS;
    const int tid = F.tid, wi = F.wave >> 2, wj = F.wave & 3, we = F.wave & 3;
    for (int u = F.bx; u < 1280; u += F.G) {
        const int lane = opaque(F.lane), lr = lane & 15, lq = lane >> 4;
        const int h = u & 3, c = u >> 2, t0 = c * 128;
        const int cs = c < 256 ? (c & 31) : (c - 256), ncs = c < 256 ? 32 : 64;
        const bool has_f = cs > 0, has_b = cs < ncs - 1;
        const float lg = ret_log2_gamma(h);
        const int tq = opaque(tid);
        v4u pa[4], pb[8];
#define RO_LOAD_QK(dh_) do { _Pragma("unroll") for (int r = 0; r < 4; ++r) { const int f = tq + 512 * r, row = f >> 4, pc = f & 15; \
            const bf16* src = H + (size_t)(t0 + row) * INW + h * 256 + (dh_) * 128 + pc * 8; pa[r] = *(const v4u*)(src + COL_Q); pb[r] = *(const v4u*)(src + COL_K); } } while (0)
#define RO_STORE_QK() do { _Pragma("unroll") for (int r = 0; r < 4; ++r) { const int f = tq + 512 * r, row = f >> 4, pc = f & 15; \
            *(LAS v4u*)(RA + row * RS + pc * 8) = pa[r]; *(LAS v4u*)(RB + row * RS + pc * 8) = pb[r]; } } while (0)
#define RO_LOAD_V() do { const int jp_ = tq & 63, pc0_ = tq >> 6; const bf16* vrow = H + (size_t)(t0 + 2 * jp_) * INW + COL_V + h * 256; \
            _Pragma("unroll") for (int r = 0; r < 4; ++r) { const int pc = pc0_ + 8 * r; pb[r] = *(const v4u*)(vrow + pc * 8); pb[4 + r] = *(const v4u*)(vrow + INW + pc * 8); } } while (0)
#define RO_STORE_V() do { const int jp_ = tq & 63, pc0_ = tq >> 6; LAS unsigned* RB32 = (LAS unsigned*)RB; \
            _Pragma("unroll") for (int r = 0; r < 4; ++r) { const int pc = pc0_ + 8 * r; \
                const unsigned va0[4] = {pb[r].x, pb[r].y, pb[r].z, pb[r].w}, va1[4] = {pb[4 + r].x, pb[4 + r].y, pb[4 + r].z, pb[4 + r].w}; \
                _Pragma("unroll") for (int i = 0; i < 8; ++i) { const unsigned a = va0[i >> 1], b = va1[i >> 1]; \
                    RB32[((pc * 8 + i) * RS) / 2 + jp_] = (i & 1) ? ((a >> 16) | (b & 0xffff0000u)) : ((a & 0xffffu) | (b << 16)); } } } while (0)
#define RO_LOAD_I(dir_, dh_) do { const bool has_ = (dir_) == 0 ? has_f : has_b; const int cn_ = (dir_) == 0 ? c - 1 : c + 1; \
            const bf16* St = ((dir_) == 0 ? STF : STB) + (size_t)((has_ ? cn_ : c) * 4 + h) * 65536; \
            _Pragma("unroll") for (int r = 0; r < 8; ++r) { const int f = tq + 512 * r, row = f >> 4, pc = f & 15; pb[r] = has_ ? *(const v4u*)(St + (size_t)row * 256 + (dh_) * 128 + pc * 8) : (v4u){0u, 0u, 0u, 0u}; } } while (0)
#define RO_STORE_I(dir_, dh_) do { \
            _Pragma("unroll") for (int r = 0; r < 4; ++r) { const int f = tq + 512 * r, row = f >> 4, pc = f & 15; pa[r] = *(const v4u*)(H + (size_t)(t0 + row) * INW + COL_Q + h * 256 + (dh_) * 128 + pc * 8); } \
            _Pragma("unroll") for (int r = 0; r < 4; ++r) { const int f = tq + 512 * r, row = f >> 4, pc = f & 15; \
                const float fac = exp2f(lg * ((dir_) == 0 ? (float)(row + 1) : (float)(128 - row))); float qf[8]; unpack8(pa[r], qf); \
                _Pragma("unroll") for (int k = 0; k < 8; ++k) qf[k] *= fac; \
                *(LAS v4u*)(RA + row * RS + pc * 8) = pack8(qf); } \
            _Pragma("unroll") for (int r = 0; r < 8; ++r) { const int f = tq + 512 * r, row = f >> 4, pc = f & 15; *(LAS v4u*)(RB + row * RS + pc * 8) = pb[r]; } } while (0)
        f32x4 S[4][2];
#pragma unroll
        for (int ti = 0; ti < 4; ++ti)
#pragma unroll
            for (int tj = 0; tj < 2; ++tj) S[ti][tj] = (f32x4){0.f, 0.f, 0.f, 0.f};
        RO_LOAD_QK(0);
#pragma unroll
        for (int dh = 0; dh < 2; ++dh) {
            if (dh) __syncthreads();
            RO_STORE_QK();
            __syncthreads();
            if (dh == 0) RO_LOAD_QK(1); else RO_LOAD_V();
#pragma unroll
            for (int ks = 0; ks < 4; ++ks) {
                bf16x8 ka[2], qb[4];
#pragma unroll
                for (int tj = 0; tj < 2; ++tj) ka[tj] = *(const LAS bf16x8*)(RB + (32 * wj + 16 * tj + lr) * RS + 32 * ks + lq * 8);
#pragma unroll
                for (int ti = 0; ti < 4; ++ti) qb[ti] = *(const LAS bf16x8*)(RA + (64 * wi + 16 * ti + lr) * RS + 32 * ks + lq * 8);
#pragma unroll
                for (int ti = 0; ti < 4; ++ti)
#pragma unroll
                    for (int tj = 0; tj < 2; ++tj) S[ti][tj] = MFMA16(ka[tj], qb[ti], S[ti][tj]);
            }
        }
#pragma unroll
        for (int ti = 0; ti < 4; ++ti)
#pragma unroll
            for (int tj = 0; tj < 2; ++tj) {
                const int i = 64 * wi + 16 * ti + lr, j0 = 32 * wj + 16 * tj + 4 * lq; float p[4];
#pragma unroll
                for (int jj = 0; jj < 4; ++jj) { const int d = i - (j0 + jj); p[jj] = S[ti][tj][jj] * exp2f(lg * (float)(d < 0 ? -d : d)); }
                v2u w; w.x = pkbf(p[0], p[1]); w.y = pkbf(p[2], p[3]); *(LAS v2u*)(RC + i * RS + j0) = w;
            }
        __syncthreads();
        RO_STORE_V();
        __syncthreads();
        RO_LOAD_I(0, 0);
        f32x4 O[4][4];
#pragma unroll
        for (int ti = 0; ti < 4; ++ti)
#pragma unroll
            for (int te = 0; te < 4; ++te) O[ti][te] = (f32x4){0.f, 0.f, 0.f, 0.f};
#pragma unroll
        for (int ks = 0; ks < 4; ++ks) {
            bf16x8 va[4], pbf[4];
#pragma unroll
            for (int te = 0; te < 4; ++te) va[te] = *(const LAS bf16x8*)(RB + (64 * we + 16 * te + lr) * RS + 32 * ks + lq * 8);
#pragma unroll
            for (int ti = 0; ti < 4; ++ti) pbf[ti] = *(const LAS bf16x8*)(RC + (64 * wi + 16 * ti + lr) * RS + 32 * ks + lq * 8);
#pragma unroll
            for (int ti = 0; ti < 4; ++ti)
#pragma unroll
                for (int te = 0; te < 4; ++te) O[ti][te] = MFMA16(va[te], pbf[ti], O[ti][te]);
        }
#pragma unroll
        for (int stg = 0; stg < 4; ++stg) {
            __syncthreads();
            if (stg == 0) RO_STORE_I(0, 0); else if (stg == 1) RO_STORE_I(0, 1); else if (stg == 2) RO_STORE_I(1, 0); else RO_STORE_I(1, 1);
            __syncthreads();
            if (stg == 0) RO_LOAD_I(0, 1); else if (stg == 1) RO_LOAD_I(1, 0); else if (stg == 2) RO_LOAD_I(1, 1);
#pragma unroll
            for (int ks = 0; ks < 4; ++ks) {
                bf16x8 sa[4], qb[4];
#pragma unroll
                for (int te = 0; te < 4; ++te) sa[te] = *(const LAS bf16x8*)(RB + (64 * we + 16 * te + lr) * RS + 32 * ks + lq * 8);
#pragma unroll
                for (int ti = 0; ti < 4; ++ti) qb[ti] = *(const LAS bf16x8*)(RA + (64 * wi + 16 * ti + lr) * RS + 32 * ks + lq * 8);
#pragma unroll
                for (int ti = 0; ti < 4; ++ti)
#pragma unroll
                    for (int te = 0; te < 4; ++te) O[ti][te] = MFMA16(sa[te], qb[ti], O[ti][te]);
            }
        }
#undef RO_LOAD_QK
#undef RO_STORE_QK
#undef RO_LOAD_V
#undef RO_STORE_V
#undef RO_LOAD_I
#undef RO_STORE_I
        __syncthreads();
        LAS float* RED = (LAS float*)RA;
#pragma unroll
        for (int ti = 0; ti < 4; ++ti) { float s1 = 0.f, s2 = 0.f;
#pragma unroll
            for (int te = 0; te < 4; ++te)
#pragma unroll
                for (int jj = 0; jj < 4; ++jj) { const float v = O[ti][te][jj]; s1 += v; s2 += v * v; }
            s1 += __shfl_xor(s1, 16); s1 += __shfl_xor(s1, 32); s2 += __shfl_xor(s2, 16); s2 += __shfl_xor(s2, 32);
            if (lq == 0) { RED[((64 * wi + 16 * ti + lr) * 4 + we) * 2] = s1; RED[((64 * wi + 16 * ti + lr) * 4 + we) * 2 + 1] = s2; } }
        __syncthreads();
        LAS bf16* ON = RB;
#pragma unroll
        for (int ti = 0; ti < 4; ++ti) { const int i = 64 * wi + 16 * ti + lr;
            const f32x4 r0 = *(const LAS f32x4*)(RED + i * 8), r1 = *(const LAS f32x4*)(RED + i * 8 + 4);
            const float m = (r0[0] + r0[2] + r1[0] + r1[2]) * (1.0f / 256.0f), q = (r0[1] + r0[3] + r1[1] + r1[3]) * (1.0f / 256.0f);
            const float var = fmaxf(q - m * m, 0.f), rstd = 1.0f / sqrtf(var + GN_EPS);
#pragma unroll
            for (int te = 0; te < 4; ++te) { const int e0 = 64 * we + 16 * te + 4 * lq;
                v2u w; w.x = pkbf((O[ti][te][0] - m) * rstd, (O[ti][te][1] - m) * rstd); w.y = pkbf((O[ti][te][2] - m) * rstd, (O[ti][te][3] - m) * rstd);
                *(LAS v2u*)(ON + i * 264 + e0) = w; } }
        __syncthreads();
        {
            const int tq2 = opaque(tid);
#pragma unroll
            for (int r = 0; r < 8; ++r) { const int f = tq2 + 512 * r, row = f >> 5, pc = f & 31;
                float ov[8], gv[8]; unpack8(*(const LAS v4u*)(ON + row * 264 + pc * 8), ov); unpack8(*(const v4u*)(H + (size_t)(t0 + row) * INW + COL_G + h * 256 + pc * 8), gv);
#pragma unroll
                for (int k = 0; k < 8; ++k) ov[k] = (gv[k] / (1.0f + __expf(-gv[k]))) * ov[k];
                *(v4u*)(CC + (size_t)(t0 + row) * DM + 1024 + h * 256 + pc * 8) = pack8(ov); }
        }
        __syncthreads();
    }
}

__device__ __forceinline__ unsigned f2key(float f) { const unsigned u = __float_as_uint(f); return (u & 0x80000000u) ? ~u : (u | 0x80000000u); }
__device__ __forceinline__ float key2f(unsigned k) { const unsigned u = (k & 0x80000000u) ? (k & 0x7fffffffu) : ~k; return __uint_as_float(u); }
#define TK_CE(a, b) do { const unsigned hi_ = (a) > (b) ? (a) : (b), lo_ = (a) > (b) ? (b) : (a); (a) = hi_; (b) = lo_; } while (0)
__device__ __forceinline__ void bitonic_merge16(unsigned (&v)[16]) {
#pragma unroll
    for (int j = 8; j > 0; j >>= 1)
#pragma unroll
        for (int i = 0; i < 16; ++i) { const int l = i ^ j; if (l > i) TK_CE(v[i], v[l]); }
}
__device__ __forceinline__ void bitonic_sort16(unsigned (&v)[16]) {
#pragma unroll
    for (int k = 2; k <= 16; k <<= 1)
#pragma unroll
        for (int j = k >> 1; j > 0; j >>= 1)
#pragma unroll
            for (int i = 0; i < 16; ++i) { const int l = i ^ j; if (l > i) { if ((i & k) == 0) TK_CE(v[i], v[l]); else TK_CE(v[l], v[i]); } }
}
__device__ __forceinline__ void topk_phase(const Frame& F, CArgs& A) {
    const _Float16* SC = (const _Float16*)(F.ws + WS_H); int* IDX = (int*)(F.ws + WS_IDX); float* GATE = (float*)(F.ws + WS_GATE);
    typedef _Float16 h8 __attribute__((ext_vector_type(8)));
    LAS unsigned* LK = (LAS unsigned*)F.lds;
    const int tid = F.tid, tl = tid >> 4, hp = tid & 15;
    for (int blk = F.bx; blk < NTOK / 32; blk += F.G) {
        const int t = blk * 32 + tl;
        const _Float16* row = SC + (size_t)t * DM + hp * 128;
        unsigned run[16];
#pragma unroll
        for (int k = 0; k < 16; ++k) run[k] = 0u;
        h8 cur[16];
#pragma unroll
        for (int q = 0; q < 16; ++q) cur[q] = *(const h8*)(row + q * 8);
#pragma unroll
        for (int c16 = 0; c16 < 8; ++c16) {
            unsigned ch[16];
#pragma unroll
            for (int q = 0; q < 2; ++q)
#pragma unroll
                for (int e = 0; e < 8; ++e) { const int n = c16 * 16 + q * 8 + e; ch[q * 8 + e] = (f2key((float)cur[c16 * 2 + q][e]) & ~127u) | (unsigned)(127 - n); }
            bitonic_sort16(ch);
#pragma unroll
            for (int i = 0; i < 16; ++i) run[i] = run[i] > ch[15 - i] ? run[i] : ch[15 - i];
            bitonic_merge16(run);
        }
#pragma unroll
        for (int k = 0; k < 16; ++k) LK[tid * 17 + k] = run[k];
        __syncthreads();
        if ((hp & 1) == 0) {
            float a[16], b[16];
#pragma unroll
            for (int k = 0; k < 16; ++k) { a[k] = key2f(LK[tid * 17 + k] & ~127u); b[k] = key2f(LK[(tid + 1) * 17 + k] & ~127u); }
            unsigned sk[16];
#pragma unroll
            for (int k = 0; k < 16; ++k) sk[k] = 0u;
#pragma unroll
            for (int i = 0; i < 16; ++i)
#pragma unroll
                for (int j = 0; j < 16; ++j) if ((i + 1) * (j + 1) <= 16) {
                    unsigned key = (f2key(a[i] + b[j]) & ~255u) | (unsigned)(255 - (i * 16 + j));
#pragma unroll
                    for (int k = 0; k < 16; ++k) { const unsigned hi = sk[k] > key ? sk[k] : key, lo = sk[k] > key ? key : sk[k]; sk[k] = hi; key = lo; }
                }
            float e[16], sum = 0.f; const float s0 = key2f(sk[0] & ~255u);
#pragma unroll
            for (int k = 0; k < 16; ++k) { e[k] = __expf(key2f(sk[k] & ~255u) - s0); sum += e[k]; }
            const float inv = 1.0f / sum; const int head = hp >> 1;
#pragma unroll
            for (int k = 0; k < 16; ++k) {
                const int cell = 255 - (int)(sk[k] & 255u);
                const int i1 = 127 - (int)(LK[tid * 17 + (cell >> 4)] & 127u), i2 = 127 - (int)(LK[(tid + 1) * 17 + (cell & 15)] & 127u);
                IDX[(size_t)t * 128 + head * 16 + k] = i1 * 128 + i2;
                GATE[(size_t)t * 128 + head * 16 + k] = e[k] * inv;
            }
        }
        __syncthreads();
    }
}
#if PEER_FP4
#if GATHER_MFMA
typedef int v8i __attribute__((ext_vector_type(8)));
__device__ __forceinline__ void peer_gather_phase(const Frame& F, CArgs& A, int l, float* xdst_base, bf16* XN) {
    constexpr int RB = DM / 2;
    constexpr int GNR = GATHER_ROWS;
    const unsigned char* U8 = F.ws + WS_U8 + (size_t)l * NEXP * RB; const unsigned char* V8 = F.ws + WS_V8 + (size_t)l * NEXP * RB;
    const float* USC = (const float*)(F.ws + WS_USC) + (size_t)l * NEXP; const float* VSC = (const float*)(F.ws + WS_VSC) + (size_t)l * NEXP;
    const int* IDX = (const int*)(F.ws + WS_IDX); const float* GATE = (const float*)(F.ws + WS_GATE);
    const float* g2 = A.in[I_LN2G] + (size_t)l * DM; const float* b2 = A.in[I_LN2B] + (size_t)l * DM;
    LAS unsigned char* XF8 = F.lds + F.wave * 3584;
    LAS float* HS = (LAS float*)(F.lds + F.wave * 3584 + 2048);
    const int lane = F.lane, lr = lane & 15, lq = lane >> 4;
    for (int t = F.gw; t < NTOK; t += F.NGW) {
        const bf16* xrow = XN + (size_t)t * DM;
        {
            v4u w0, w1;
#pragma unroll
            for (int j = 0; j < 8; ++j) { const v2u a = *(const v2u*)(xrow + j * 256 + lane * 4); int pk = 0;
                if (MFMA_NIBSWAP) { pk = __builtin_amdgcn_cvt_pk_fp8_f32(bf_hi(a.x), bf_lo(a.x), pk, false); pk = __builtin_amdgcn_cvt_pk_fp8_f32(bf_hi(a.y), bf_lo(a.y), pk, true); }
                else { pk = __builtin_amdgcn_cvt_pk_fp8_f32(bf_lo(a.x), bf_hi(a.x), pk, false); pk = __builtin_amdgcn_cvt_pk_fp8_f32(bf_lo(a.y), bf_hi(a.y), pk, true); }
                if (j < 4) w0[j] = (unsigned)pk; else w1[j - 4] = (unsigned)pk; }
            *(LAS v4u*)(XF8 + lane * 32) = w0; *(LAS v4u*)(XF8 + lane * 32 + 16) = w1;
        }
#if MFMA_XFP4
        float xisc;
        {
            float f[32]; float am = 0.f;
#pragma unroll
            for (int j = 0; j < 8; ++j) { const v2u a = *(const v2u*)(xrow + j * 256 + lane * 4); f[4 * j] = bf_lo(a.x); f[4 * j + 1] = bf_hi(a.x); f[4 * j + 2] = bf_lo(a.y); f[4 * j + 3] = bf_hi(a.y);
                am = fmaxf(am, fmaxf(fmaxf(fabsf(f[4 * j]), fabsf(f[4 * j + 1])), fmaxf(fabsf(f[4 * j + 2]), fabsf(f[4 * j + 3])))); }
#pragma unroll
            for (int o = 1; o < 64; o <<= 1) am = fmaxf(am, __shfl_xor(am, o));
            const float sc = am > 0.f ? 6.0f / am : 1.0f; xisc = am > 0.f ? am * (1.0f / 6.0f) : 1.0f;
            v4u w;
#pragma unroll
            for (int q = 0; q < 4; ++q) { unsigned pk = 0u;
                pk = __builtin_amdgcn_cvt_scalef32_pk_fp4_f32(pk, f[8 * q] * sc, f[8 * q + 1] * sc, 1.0f, 0); pk = __builtin_amdgcn_cvt_scalef32_pk_fp4_f32(pk, f[8 * q + 2] * sc, f[8 * q + 3] * sc, 1.0f, 1);
                pk = __builtin_amdgcn_cvt_scalef32_pk_fp4_f32(pk, f[8 * q + 4] * sc, f[8 * q + 5] * sc, 1.0f, 2); pk = __builtin_amdgcn_cvt_scalef32_pk_fp4_f32(pk, f[8 * q + 6] * sc, f[8 * q + 7] * sc, 1.0f, 3);
                w[q] = pk; }
            *(LAS v4u*)(XF8 + 2048 + 512 + lane * 16) = w;
        }
#endif
        const int idx0 = IDX[(size_t)t * 128 + lane], idx1 = IDX[(size_t)t * 128 + 64 + lane];
        const float gate0 = GATE[(size_t)t * 128 + lane], gate1 = GATE[(size_t)t * 128 + 64 + lane];
        const float usc0 = USC[idx0], usc1 = USC[idx1], vsc0 = VSC[idx0], vsc1 = VSC[idx1];
        unsigned rowoff[8];
#pragma unroll
        for (int g = 0; g < 8; ++g) rowoff[g] = (unsigned)__shfl((g >> 2) ? idx1 : idx0, (g & 3) * 16 + lr) * (unsigned)RB + (unsigned)lq * 16u;
        v4u AB[8][2];
#pragma unroll
        for (int g = 0; g < 8; ++g) { AB[g][0] = *(const v4u*)(U8 + rowoff[g]); AB[g][1] = *(const v4u*)(U8 + rowoff[g] + 64); }
        f32x4 hacc[8];
#pragma unroll
        for (int g = 0; g < 8; ++g) hacc[g] = (f32x4){0.f, 0.f, 0.f, 0.f};
        LDS_WAIT();
#if MFMA_DIAG
#pragma unroll 1
        for (int ks2 = 0; ks2 < 64; ++ks2) {
            const LAS v4u* xb = (const LAS v4u*)(XF8 + ks2 * 32); const v4u b00 = xb[0], b01 = xb[1];
            const v8i B0 = (v8i){(int)b00[0], (int)b00[1], (int)b00[2], (int)b00[3], (int)b01[0], (int)b01[1], (int)b01[2], (int)b01[3]};
#pragma unroll
            for (int g = 0; g < 8; ++g) { const v4u a = *(const v4u*)(U8 + (rowoff[g] - (unsigned)lq * 16u) + ks2 * 16);
                const v8i A0 = (v8i){(int)a[0], (int)a[1], (int)a[2], (int)a[3], 0, 0, 0, 0};
                hacc[g] = __builtin_amdgcn_mfma_scale_f32_16x16x128_f8f6f4(A0, B0, hacc[g], 4, 0, 0, 0x7f7f7f7f, 0, 0x7f7f7f7f); }
        }
#pragma unroll
        for (int g = 0; g < 8; ++g) hacc[g] = hacc[g] * 0.125f;
#else
#pragma unroll 1
        for (int kp = 0; kp < 8; ++kp) {
#if MFMA_XFP4
            const LAS v4u* xb4 = (const LAS v4u*)(XF8 + 2560 + ((2 * kp) * 4 + lq) * 16);
            const v4u c0 = xb4[0], c1 = xb4[4];
            const v8i B0 = (v8i){(int)c0[0], (int)c0[1], (int)c0[2], (int)c0[3], 0, 0, 0, 0};
            const v8i B1 = (v8i){(int)c1[0], (int)c1[1], (int)c1[2], (int)c1[3], 0, 0, 0, 0};
#else
#if MFMA_BMAP == 1
            const LAS unsigned char* xq = XF8 + ((2 * kp) * 4 + (lq >> 1)) * 32 + 16 * (lq & 1);
            const v4u b00 = *(const LAS v4u*)xq, b01 = *(const LAS v4u*)(xq + 64), b10 = *(const LAS v4u*)(xq + 128), b11 = *(const LAS v4u*)(xq + 192);
#elif MFMA_BMAP == 2
            const int qa0 = 2 * (lq & 1), off0 = 16 * (lq >> 1);
            const LAS unsigned char* xq = XF8 + ((2 * kp) * 4 + qa0) * 32 + off0;
            const v4u b00 = *(const LAS v4u*)xq, b01 = *(const LAS v4u*)(xq + 32), b10 = *(const LAS v4u*)(xq + 128), b11 = *(const LAS v4u*)(xq + 160);
#else
            const LAS v4u* xb = (const LAS v4u*)(XF8 + ((2 * kp) * 4 + lq) * 32);
            const v4u b00 = xb[0], b01 = xb[1], b10 = xb[8], b11 = xb[9];
#endif
            const v8i B0 = (v8i){(int)b00[0], (int)b00[1], (int)b00[2], (int)b00[3], (int)b01[0], (int)b01[1], (int)b01[2], (int)b01[3]};
            const v8i B1 = (v8i){(int)b10[0], (int)b10[1], (int)b10[2], (int)b10[3], (int)b11[0], (int)b11[1], (int)b11[2], (int)b11[3]};
#endif
#pragma unroll
            for (int g = 0; g < 8; ++g) {
                const v8i A0 = (v8i){(int)AB[g][0][0], (int)AB[g][0][1], (int)AB[g][0][2], (int)AB[g][0][3], 0, 0, 0, 0};
                const v8i A1 = (v8i){(int)AB[g][1][0], (int)AB[g][1][1], (int)AB[g][1][2], (int)AB[g][1][3], 0, 0, 0, 0};
                hacc[g] = __builtin_amdgcn_mfma_scale_f32_16x16x128_f8f6f4(A0, B0, hacc[g], 4, MFMA_XFP4 ? 4 : 0, 0, 0x7f7f7f7f, 0, 0x7f7f7f7f);
                hacc[g] = __builtin_amdgcn_mfma_scale_f32_16x16x128_f8f6f4(A1, B1, hacc[g], 4, MFMA_XFP4 ? 4 : 0, 0, 0x7f7f7f7f, 0, 0x7f7f7f7f);
                if (kp < 7) { AB[g][0] = *(const v4u*)(U8 + rowoff[g] + (kp + 1) * 128); AB[g][1] = *(const v4u*)(U8 + rowoff[g] + (kp + 1) * 128 + 64); }
            }
        }
#endif
        if (lr == 0) {
#pragma unroll
            for (int g = 0; g < 8; ++g) *(LAS f32x4*)(HS + g * 16 + 4 * lq) = hacc[g];
        }
        LDS_WAIT();
#if MFMA_XFP4
        const float hval0 = HS[lane] * xisc, hval1 = HS[64 + lane] * xisc;
#else
        const float hval0 = HS[lane], hval1 = HS[64 + lane];
#endif
        const float w0 = gate0 * gelu_erf(hval0 * usc0) * vsc0, w1 = gate1 * gelu_erf(hval1 * usc1) * vsc1;
        v4u BU[GNR];
        const unsigned loff = (unsigned)lane * 16u;
#define G_ROW_V(R) (V8 + (size_t)(unsigned)__builtin_amdgcn_readlane((((R) >> 6) & 1) ? idx1 : idx0, (R) & 63) * RB)
#define G_REQ(r, rowptr) do { BU[r] = *(const v4u*)((rowptr) + loff); } while (0)
#pragma unroll
        for (int r = 0; r < GNR; ++r) G_REQ(r, G_ROW_V(r));
        f32x2v acc[16];
#pragma unroll
        for (int k = 0; k < 16; ++k) acc[k] = (f32x2v){0.f, 0.f};
#define G_AXPY(r, R) do { const float w_ = __uint_as_float((unsigned)__builtin_amdgcn_readlane((int)__float_as_uint((((R) >> 6) & 1) ? w1 : w0), (R) & 63)); const f32x2v w2_ = (f32x2v){w_, w_}; \
            _Pragma("unroll") for (int q = 0; q < 4; ++q) { acc[4 * q] += w2_ * __builtin_amdgcn_cvt_scalef32_pk_f32_fp4(BU[r][q], 1.0f, 0); acc[4 * q + 1] += w2_ * __builtin_amdgcn_cvt_scalef32_pk_f32_fp4(BU[r][q], 1.0f, 1); \
                acc[4 * q + 2] += w2_ * __builtin_amdgcn_cvt_scalef32_pk_f32_fp4(BU[r][q], 1.0f, 2); acc[4 * q + 3] += w2_ * __builtin_amdgcn_cvt_scalef32_pk_f32_fp4(BU[r][q], 1.0f, 3); } } while (0)
        for (int it = 0; it < 128 / GNR - 1; ++it) {
#pragma unroll
            for (int r = 0; r < GNR; ++r) { G_AXPY(r, GNR * it + r); G_REQ(r, G_ROW_V(GNR * (it + 1) + r)); }
        }
#pragma unroll
        for (int r = 0; r < GNR; ++r) G_AXPY(r, 128 - GNR + r);
#undef G_ROW_V
#undef G_REQ
#undef G_AXPY
        const int le = opaque(lane);
        float s = 0.f;
#pragma unroll
        for (int j = 0; j < 8; ++j) { const v2u xr = *(const v2u*)(xrow + j * 256 + le * 4);
            acc[2 * j] = (f32x2v){bf_lo(xr.x), bf_hi(xr.x)} * ALPHA + acc[2 * j]; acc[2 * j + 1] = (f32x2v){bf_lo(xr.y), bf_hi(xr.y)} * ALPHA + acc[2 * j + 1];
            s += (acc[2 * j][0] + acc[2 * j][1]) + (acc[2 * j + 1][0] + acc[2 * j + 1][1]); }
        const float mean = wave_sum(s) * (1.0f / DM); float s2 = 0.f;
#pragma unroll
        for (int k = 0; k < 16; ++k) { acc[k] = acc[k] - mean; s2 += acc[k][0] * acc[k][0] + acc[k][1] * acc[k][1]; }
        const float rstd = 1.0f / sqrtf(wave_sum(s2) * (1.0f / DM) + LN_EPS);
#pragma unroll
        for (int j = 0; j < 8; ++j) { const int col = j * 256 + le * 4;
            const f32x4 gg = *(const f32x4*)(g2 + col), bb = *(const f32x4*)(b2 + col);
            const f32x2v a0 = acc[2 * j], a1 = acc[2 * j + 1];
            const f32x4 o = (f32x4){a0[0] * rstd * gg[0] + bb[0], a0[1] * rstd * gg[1] + bb[1], a1[0] * rstd * gg[2] + bb[2], a1[1] * rstd * gg[3] + bb[3]};
            if (xdst_base) *(f32x4*)(xdst_base + (size_t)t * DM + col) = o;
            v2u w; w.x = pkbf(o[0], o[1]); w.y = pkbf(o[2], o[3]); *(v2u*)(XN + (size_t)t * DM + col) = w; }
        LDS_WAIT();
    }
}

#else
__device__ __forceinline__ void peer_gather_phase(const Frame& F, CArgs& A, int l, float* xdst_base, bf16* XN) {
    constexpr int RB = DM / 2;
    constexpr int GNR = GATHER_ROWS;
    const unsigned char* U8 = F.ws + WS_U8 + (size_t)l * NEXP * RB; const unsigned char* V8 = F.ws + WS_V8 + (size_t)l * NEXP * RB;
    const float* USC = (const float*)(F.ws + WS_USC) + (size_t)l * NEXP; const float* VSC = (const float*)(F.ws + WS_VSC) + (size_t)l * NEXP;
    const int* IDX = (const int*)(F.ws + WS_IDX); const float* GATE = (const float*)(F.ws + WS_GATE);
    const float* g2 = A.in[I_LN2G] + (size_t)l * DM; const float* b2 = A.in[I_LN2B] + (size_t)l * DM;
    const int lane = F.lane, slot = 8 * (lane & 7) + (lane >> 3);
    for (int t = F.gw; t < NTOK; t += F.NGW) {
        const bf16* xrow = XN + (size_t)t * DM;
        f32x2v x[16];
#pragma unroll
        for (int q = 0; q < 8; ++q) { const v2u a = *(const v2u*)(xrow + q * 256 + lane * 4); x[2 * q] = (f32x2v){bf_lo(a.x), bf_hi(a.x)}; x[2 * q + 1] = (f32x2v){bf_lo(a.y), bf_hi(a.y)}; }
        const int idx0 = IDX[(size_t)t * 128 + slot], idx1 = IDX[(size_t)t * 128 + 64 + slot];
        const float gate0 = GATE[(size_t)t * 128 + slot], gate1 = GATE[(size_t)t * 128 + 64 + slot];
        const float usc0 = USC[idx0], usc1 = USC[idx1], vsc0 = VSC[idx0], vsc1 = VSC[idx1];
        v4u BU[GNR];
        const unsigned loff = (unsigned)lane * 16u;
#define G_ROW_U(R) (U8 + (size_t)(unsigned)__builtin_amdgcn_readlane((((R) >> 6) & 1) ? idx1 : idx0, ((R) & 7) * 8 + (((R) >> 3) & 7)) * RB)
#define G_ROW_V(R) (V8 + (size_t)(unsigned)__builtin_amdgcn_readlane((((R) >> 6) & 1) ? idx1 : idx0, (R) & 63) * RB)
#define G_REQ(r, rowptr) do { BU[r] = *(const v4u*)((rowptr) + loff); } while (0)
#define G_DOT(r, dst) do { f32x2v s2_ = (f32x2v){0.f, 0.f}; \
            _Pragma("unroll") for (int q = 0; q < 4; ++q) { s2_ += __builtin_amdgcn_cvt_scalef32_pk_f32_fp4(BU[r][q], 1.0f, 0) * x[4 * q]; s2_ += __builtin_amdgcn_cvt_scalef32_pk_f32_fp4(BU[r][q], 1.0f, 1) * x[4 * q + 1]; \
                s2_ += __builtin_amdgcn_cvt_scalef32_pk_f32_fp4(BU[r][q], 1.0f, 2) * x[4 * q + 2]; s2_ += __builtin_amdgcn_cvt_scalef32_pk_f32_fp4(BU[r][q], 1.0f, 3) * x[4 * q + 3]; } \
            if (GATHER_PROBE) { f32x2v p2_ = (f32x2v){0.f, 0.f}; _Pragma("unroll") for (int q = 0; q < 4; ++q) { const unsigned wq_ = (unsigned)opaque((int)BU[r][q]); p2_ += __builtin_amdgcn_cvt_scalef32_pk_f32_fp4(wq_, 1.0f, 0) * x[4 * q]; p2_ += __builtin_amdgcn_cvt_scalef32_pk_f32_fp4(wq_, 1.0f, 1) * x[4 * q + 1]; p2_ += __builtin_amdgcn_cvt_scalef32_pk_f32_fp4(wq_, 1.0f, 2) * x[4 * q + 2]; p2_ += __builtin_amdgcn_cvt_scalef32_pk_f32_fp4(wq_, 1.0f, 3) * x[4 * q + 3]; } s2_ += p2_ * 0.0f; } \
            dst = s2_[0] + s2_[1]; } while (0)
#define G_REDUCE(g) do { \
            _Pragma("unroll") for (int i = 0; i < 4; ++i) { const float mine = b5 ? part[i + 4] : part[i], send = b5 ? part[i] : part[i + 4]; part[i] = mine + __shfl_xor(send, 32); } \
            _Pragma("unroll") for (int i = 0; i < 2; ++i) { const float mine = b4 ? part[i + 2] : part[i], send = b4 ? part[i] : part[i + 2]; part[i] = mine + __shfl_xor(send, 16); } \
            { const float mine = b3 ? part[1] : part[0], send = b3 ? part[0] : part[1]; part[0] = mine + __shfl_xor(send, 8); } \
            float v_ = part[0]; v_ += __shfl_xor(v_, 4); v_ += __shfl_xor(v_, 2); v_ += __shfl_xor(v_, 1); \
            const bool mine_ = (lane & 7) == ((g) & 7); hval0 = (mine_ && ((g) >> 3) == 0) ? v_ : hval0; hval1 = (mine_ && ((g) >> 3) == 1) ? v_ : hval1; } while (0)
        if (GATHER_PROBE2) {
            const int pm0 = idx0 & (GATHER_PROBE2 - 1), pm1 = idx1 & (GATHER_PROBE2 - 1); f32x2v ps = (f32x2v){0.f, 0.f};
#define G_ROW_P(R) (U8 + (size_t)(unsigned)__builtin_amdgcn_readlane((((R) >> 6) & 1) ? pm1 : pm0, (R) & 63) * RB)
#pragma unroll
            for (int r = 0; r < GNR; ++r) G_REQ(r, G_ROW_P(r));
            for (int it = 0; it < 128 / GNR - 1; ++it) {
#pragma unroll
                for (int r = 0; r < GNR; ++r) { float d_; G_DOT(r, d_); ps[0] += d_; G_REQ(r, G_ROW_P(GNR * (it + 1) + r)); }
            }
#pragma unroll
            for (int r = 0; r < GNR; ++r) { float d_; G_DOT(r, d_); ps[1] += d_; }
            asm volatile("" :: "v"(ps[0]), "v"(ps[1]));
#undef G_ROW_P
        }
        const bool b5 = (lane & 32) != 0, b4 = (lane & 16) != 0, b3 = (lane & 8) != 0;
        float hval0 = 0.f, hval1 = 0.f;
#pragma unroll
        for (int r = 0; r < GNR; ++r) G_REQ(r, G_ROW_U(r));
        for (int it = 0; it < 128 / GNR - 1; ++it) {
#pragma unroll
            for (int g4 = 0; g4 < GNR / 8; ++g4) { float part[8];
#pragma unroll
                for (int i = 0; i < 8; ++i) { G_DOT(g4 * 8 + i, part[i]); G_REQ(g4 * 8 + i, G_ROW_U(GNR * (it + 1) + g4 * 8 + i)); }
                G_REDUCE(it * (GNR / 8) + g4); }
        }
#pragma unroll
        for (int g4 = 0; g4 < GNR / 8; ++g4) { float part[8];
#pragma unroll
            for (int i = 0; i < 8; ++i) { G_DOT(g4 * 8 + i, part[i]); G_REQ(g4 * 8 + i, G_ROW_V(g4 * 8 + i)); }
            G_REDUCE(16 - GNR / 8 + g4); }
        const float w0 = gate0 * gelu_erf(hval0 * usc0) * vsc0, w1 = gate1 * gelu_erf(hval1 * usc1) * vsc1;
        f32x2v acc[16];
#pragma unroll
        for (int k = 0; k < 16; ++k) acc[k] = (f32x2v){0.f, 0.f};
#define G_AXPY(r, R) do { const float w_ = __uint_as_float((unsigned)__builtin_amdgcn_readlane((int)__float_as_uint((((R) >> 6) & 1) ? w1 : w0), (R) & 63)); const f32x2v w2_ = (f32x2v){w_, w_}; \
            _Pragma("unroll") for (int q = 0; q < 4; ++q) { acc[4 * q] += w2_ * __builtin_amdgcn_cvt_scalef32_pk_f32_fp4(BU[r][q], 1.0f, 0); acc[4 * q + 1] += w2_ * __builtin_amdgcn_cvt_scalef32_pk_f32_fp4(BU[r][q], 1.0f, 1); \
                acc[4 * q + 2] += w2_ * __builtin_amdgcn_cvt_scalef32_pk_f32_fp4(BU[r][q], 1.0f, 2); acc[4 * q + 3] += w2_ * __builtin_amdgcn_cvt_scalef32_pk_f32_fp4(BU[r][q], 1.0f, 3); } } while (0)
        for (int it = 0; it < 128 / GNR - 1; ++it) {
#pragma unroll
            for (int r = 0; r < GNR; ++r) { G_AXPY(r, GNR * it + r); G_REQ(r, G_ROW_V(GNR * (it + 1) + r)); }
        }
#pragma unroll
        for (int r = 0; r < GNR; ++r) G_AXPY(r, 128 - GNR + r);
#undef G_ROW_U
#undef G_ROW_V
#undef G_REQ
#undef G_DOT
#undef G_REDUCE
#undef G_AXPY
        const int le = opaque(lane);
        float s = 0.f;
#pragma unroll
        for (int j = 0; j < 8; ++j) { const v2u xr = *(const v2u*)(xrow + j * 256 + le * 4);
            acc[2 * j] = (f32x2v){bf_lo(xr.x), bf_hi(xr.x)} * ALPHA + acc[2 * j]; acc[2 * j + 1] = (f32x2v){bf_lo(xr.y), bf_hi(xr.y)} * ALPHA + acc[2 * j + 1];
            s += (acc[2 * j][0] + acc[2 * j][1]) + (acc[2 * j + 1][0] + acc[2 * j + 1][1]); }
        const float mean = wave_sum(s) * (1.0f / DM); float s2 = 0.f;
#pragma unroll
        for (int k = 0; k < 16; ++k) { acc[k] = acc[k] - mean; s2 += acc[k][0] * acc[k][0] + acc[k][1] * acc[k][1]; }
        const float rstd = 1.0f / sqrtf(wave_sum(s2) * (1.0f / DM) + LN_EPS);
#pragma unroll
        for (int j = 0; j < 8; ++j) { const int col = j * 256 + le * 4;
            const f32x4 gg = *(const f32x4*)(g2 + col), bb = *(const f32x4*)(b2 + col);
            const f32x2v a0 = acc[2 * j], a1 = acc[2 * j + 1];
            const f32x4 o = (f32x4){a0[0] * rstd * gg[0] + bb[0], a0[1] * rstd * gg[1] + bb[1], a1[0] * rstd * gg[2] + bb[2], a1[1] * rstd * gg[3] + bb[3]};
            if (xdst_base) *(f32x4*)(xdst_base + (size_t)t * DM + col) = o;
            v2u w; w.x = pkbf(o[0], o[1]); w.y = pkbf(o[2], o[3]); *(v2u*)(XN + (size_t)t * DM + col) = w; }
    }
}

#endif
#else
__device__ __forceinline__ void peer_gather_phase(const Frame& F, CArgs& A, int l) {
    const unsigned char* U8 = F.ws + WS_U8 + (size_t)l * NEXP * DM; const unsigned char* V8 = F.ws + WS_V8 + (size_t)l * NEXP * DM;
    const float* USC = (const float*)(F.ws + WS_USC) + (size_t)l * NEXP; const float* VSC = (const float*)(F.ws + WS_VSC) + (size_t)l * NEXP;
    const int* IDX = (const int*)(F.ws + WS_IDX); const float* GATE = (const float*)(F.ws + WS_GATE);
    const float* g2 = A.in[I_LN2G] + (size_t)l * DM; const float* b2 = A.in[I_LN2B] + (size_t)l * DM;
    bf16* XN = (bf16*)(F.ws + WS_XN);
    const int lane = F.lane, slot = 8 * (lane & 7) + (lane >> 3);
    for (int t = F.gw; t < NTOK; t += F.NGW) {
        float* xrow = F.out + (size_t)t * DM;
        f32x2v x[2][8];
#pragma unroll
        for (int c = 0; c < 2; ++c)
#pragma unroll
            for (int q = 0; q < 4; ++q) { const f32x4 a = *(const f32x4*)(xrow + (c * 64 + lane) * 16 + q * 4); x[c][2 * q] = (f32x2v){a[0], a[1]}; x[c][2 * q + 1] = (f32x2v){a[2], a[3]}; }
        const int idx0 = IDX[(size_t)t * 128 + slot], idx1 = IDX[(size_t)t * 128 + 64 + slot];
        v4u BU[8][2];
        const unsigned loff0 = (unsigned)lane * 16u, loff1 = (unsigned)lane * 16u + 1024u;
#define G_ROW_U(i, b) (U8 + (size_t)(unsigned)__builtin_amdgcn_readlane(((b) >> 3) ? idx1 : idx0, (i) * 8 + ((b) & 7)) * DM)
#define G_ROW_V(i, b) (V8 + (size_t)(unsigned)__builtin_amdgcn_readlane(((b) >> 3) ? idx1 : idx0, ((b) & 7) * 8 + (i)) * DM)
#define G_REQ(i, rowptr) do { const unsigned char* r_ = (rowptr); BU[i][0] = *(const v4u*)(r_ + loff0); BU[i][1] = *(const v4u*)(r_ + loff1); } while (0)
#define G_DOT(i, dst) do { f32x2v s2_ = (f32x2v){0.f, 0.f}; \
            _Pragma("unroll") for (int c = 0; c < 2; ++c) _Pragma("unroll") for (int q = 0; q < 4; ++q) { s2_ += __builtin_amdgcn_cvt_pk_f32_fp8((int)BU[i][c][q], false) * x[c][2 * q]; s2_ += __builtin_amdgcn_cvt_pk_f32_fp8((int)BU[i][c][q], true) * x[c][2 * q + 1]; } \
            dst = s2_[0] + s2_[1]; } while (0)
#define G_REDUCE(b) do { \
            _Pragma("unroll") for (int i = 0; i < 4; ++i) { const float mine = b5 ? part[i + 4] : part[i], send = b5 ? part[i] : part[i + 4]; part[i] = mine + __shfl_xor(send, 32); } \
            _Pragma("unroll") for (int i = 0; i < 2; ++i) { const float mine = b4 ? part[i + 2] : part[i], send = b4 ? part[i] : part[i + 2]; part[i] = mine + __shfl_xor(send, 16); } \
            { const float mine = b3 ? part[1] : part[0], send = b3 ? part[0] : part[1]; part[0] = mine + __shfl_xor(send, 8); } \
            float v_ = part[0]; v_ += __shfl_xor(v_, 4); v_ += __shfl_xor(v_, 2); v_ += __shfl_xor(v_, 1); \
            const bool mine_ = (lane & 7) == ((b) & 7); hval0 = (mine_ && ((b) >> 3) == 0) ? v_ : hval0; hval1 = (mine_ && ((b) >> 3) == 1) ? v_ : hval1; } while (0)
        const bool b5 = (lane & 32) != 0, b4 = (lane & 16) != 0, b3 = (lane & 8) != 0;
        float hval0 = 0.f, hval1 = 0.f;
#pragma unroll
        for (int i = 0; i < 8; ++i) G_REQ(i, G_ROW_U(i, 0));
        for (int b = 0; b < 15; ++b) {
            float part[8];
#pragma unroll
            for (int i = 0; i < 8; ++i) { G_DOT(i, part[i]); G_REQ(i, G_ROW_U(i, b + 1)); }
            G_REDUCE(b);
        }
        {
            float part[8];
#pragma unroll
            for (int i = 0; i < 8; ++i) { G_DOT(i, part[i]); G_REQ(i, G_ROW_V(i, 0)); }
            G_REDUCE(15);
        }
        const float gate0 = GATE[(size_t)t * 128 + slot], gate1 = GATE[(size_t)t * 128 + 64 + slot];
        const float usc0 = USC[idx0], usc1 = USC[idx1], vsc0 = VSC[idx0], vsc1 = VSC[idx1];
        const float w0 = gate0 * gelu_erf(hval0 * usc0) * vsc0, w1 = gate1 * gelu_erf(hval1 * usc1) * vsc1;
        f32x2v acc[2][8];
#pragma unroll
        for (int c = 0; c < 2; ++c)
#pragma unroll
            for (int k = 0; k < 8; ++k) acc[c][k] = (f32x2v){0.f, 0.f};
#define G_AXPY(i, b) do { const float w_ = __uint_as_float((unsigned)__builtin_amdgcn_readlane((int)__float_as_uint(((b) >> 3) ? w1 : w0), ((b) & 7) * 8 + (i))); const f32x2v w2_ = (f32x2v){w_, w_}; \
            _Pragma("unroll") for (int c = 0; c < 2; ++c) _Pragma("unroll") for (int q = 0; q < 4; ++q) { acc[c][2 * q] += w2_ * __builtin_amdgcn_cvt_pk_f32_fp8((int)BU[i][c][q], false); acc[c][2 * q + 1] += w2_ * __builtin_amdgcn_cvt_pk_f32_fp8((int)BU[i][c][q], true); } } while (0)
        for (int b = 0; b < 15; ++b) {
#pragma unroll
            for (int i = 0; i < 8; ++i) { G_AXPY(i, b); G_REQ(i, G_ROW_V(i, b + 1)); }
        }
#pragma unroll
        for (int i = 0; i < 8; ++i) G_AXPY(i, 15);
#undef G_ROW_U
#undef G_ROW_V
#undef G_REQ
#undef G_DOT
#undef G_REDUCE
#undef G_AXPY
        const int le = opaque(lane);
        float s = 0.f;
#pragma unroll
        for (int c = 0; c < 2; ++c)
#pragma unroll
            for (int k = 0; k < 8; ++k) { const f32x2v xr = *(const f32x2v*)(xrow + (c * 64 + le) * 16 + 2 * k);
                acc[c][k] = xr * ALPHA + acc[c][k]; s += acc[c][k][0] + acc[c][k][1]; }
        const float mean = wave_sum(s) * (1.0f / DM); float s2 = 0.f;
#pragma unroll
        for (int c = 0; c < 2; ++c)
#pragma unroll
            for (int k = 0; k < 8; ++k) { acc[c][k] = acc[c][k] - mean; s2 += acc[c][k][0] * acc[c][k][0] + acc[c][k][1] * acc[c][k][1]; }
        const float rstd = 1.0f / sqrtf(wave_sum(s2) * (1.0f / DM) + LN_EPS);
#pragma unroll
        for (int c = 0; c < 2; ++c) { const int col = (c * 64 + le) * 16;
#pragma unroll
            for (int h8 = 0; h8 < 2; ++h8) { float o[8];
#pragma unroll
                for (int q = 0; q < 2; ++q) { const f32x4 gg = *(const f32x4*)(g2 + col + h8 * 8 + q * 4), bb = *(const f32x4*)(b2 + col + h8 * 8 + q * 4);
                    const f32x2v a0 = acc[c][h8 * 4 + 2 * q], a1 = acc[c][h8 * 4 + 2 * q + 1];
                    o[4 * q] = a0[0] * rstd * gg[0] + bb[0]; o[4 * q + 1] = a0[1] * rstd * gg[1] + bb[1]; o[4 * q + 2] = a1[0] * rstd * gg[2] + bb[2]; o[4 * q + 3] = a1[1] * rstd * gg[3] + bb[3];
                    *(f32x4*)(xrow + col + h8 * 8 + q * 4) = (f32x4){o[4 * q], o[4 * q + 1], o[4 * q + 2], o[4 * q + 3]}; }
                *(v4u*)(XN + (size_t)t * DM + col + h8 * 8) = pack8(o); } }
    }
}

#endif
#ifndef DUP_MASK
#define DUP_MASK 0
#endif
#ifndef PHASE_TEST_ONLY
__global__ void __launch_bounds__(NTHR, 2) fwd_kernel(Args A) {
    extern __shared__ __attribute__((aligned(16))) unsigned char lds_raw[];
#define MKFRAME() Frame F; CArgs& KA = *(CArgs*)opaque_u64((unsigned long long)__builtin_amdgcn_kernarg_segment_ptr()); { F.lds = (LAS unsigned char*)lds_raw; F.tid = opaque((int)threadIdx.x); F.lane = F.tid & 63; F.wave = __builtin_amdgcn_readfirstlane(F.tid >> 6); \
        const int bx_ = opaque_s((int)blockIdx.x); F.G = gridDim.x; F.gw = bx_ * NWAVES + F.wave; F.NGW = F.G * NWAVES; F.gtid = (size_t)bx_ * NTHR + F.tid; F.NT = (size_t)F.G * NTHR; F.out = (float*)opaque_p(KA.out); F.ws = (unsigned char*)opaque_p(KA.ws); F.bx = bx_; } \
        bf16* XN = (bf16*)(F.ws + WS_XN); bf16* H = (bf16*)(F.ws + WS_H); bf16* CC = (bf16*)(F.ws + WS_CONCAT); (void)XN; (void)H; (void)CC;
    volatile LAS unsigned* MISC = (volatile LAS unsigned*)((LAS unsigned char*)lds_raw + LDS_MISC);
    if (threadIdx.x < 64) MISC[threadIdx.x] = 0u;
    __syncthreads();
    XcdBarrier bar = xcd_barrier_post((unsigned*)(A.ws + WS_CTL) + CW_BAR + A.li * XCD_BAR_WORDS, MISC + 8);
    const int lo = A.ph_lo, hi = A.ph_hi;
#define IN(k) (lo <= (k) && (k) < hi)
#define SEAM(k) do { if (lo <= (k) && (k) + 1 < hi) xcd_barrier(bar); } while (0)

    if (IN(0)) { MKFRAME(); p0_prologue(F, KA); if (DUP_MASK & 256) { __syncthreads(); p0_prologue(F, KA); } } SEAM(0);

    for (int l = 0; l < NLAYER; ++l) {
        const int pb = 1 + l * 10;
        if (IN(pb + 0)) { MKFRAME();
            pg8::Gemm g{XN, (const bf16*)(F.ws + WS_WIN) + (size_t)l * INW * DM, NTOK, INW, DM}; pg8::StaticOrder S; S.init(NTOK, INW, F.G, F.bx);
            EpiStoreRot E{H, INW, (const float*)(F.ws + WS_ROTC), (const float*)(F.ws + WS_ROTS)};
            pg8::gemm_phase<EpiStoreRot, pg8::StaticOrder, true, true>(F.lds, g, S, E);
            if (DUP_MASK & 64) { pg8::gemm_phase<EpiStoreRot, pg8::StaticOrder, true, true>(F.lds, g, S, E); }
        } SEAM(pb + 0);
        if (IN(pb + 1)) { MKFRAME(); s5_pass1(F, KA, l); pool_phase(F, KA); if (DUP_MASK & 1) { s5_pass1(F, KA, l); } if (DUP_MASK & 2) { pool_phase(F, KA); } } SEAM(pb + 1);
        if (IN(pb + 2)) { MKFRAME(); s5_carry(F, KA, l); __syncthreads(); ret_state_phase(F, KA); if (DUP_MASK & 4) { ret_state_phase(F, KA); } if (DUP_MASK & 2048) { ret_state_phase<1>(F, KA); } if (DUP_MASK & 4096) { ret_state_phase<2>(F, KA); ret_state_phase(F, KA); } } SEAM(pb + 2);
        if (IN(pb + 3)) { MKFRAME(); s5_pass3(F, KA, l); if (DUP_MASK & 8) { s5_pass3(F, KA, l); } ret_prefix_phase(F, KA); } SEAM(pb + 3);
        if (IN(pb + 4)) { MKFRAME();
            __syncthreads();
            ret_out_phase(F, KA);
            if (DUP_MASK & 16) { ret_out_phase(F, KA); }
            {
                pg8::Gemm g{(const bf16*)(F.ws + WS_BUFY), (const bf16*)(F.ws + WS_WGLU) + (size_t)l * 512 * 512, NTOK, 512, 512}; pg8::StaticOrder S; S.init(NTOK, 512, F.G, F.bx);
                EpiGlu E{(const bf16*)(F.ws + WS_BUFY), 512, CC, DM, KA.in[I_BGLU] + (size_t)l * 512};
                pg8::gemm_phase<EpiGlu, pg8::StaticOrder, true, true>(F.lds, g, S, E);
                if (DUP_MASK & 512) { pg8::gemm_phase<EpiGlu, pg8::StaticOrder, true, true>(F.lds, g, S, E); }
            }
            {
                pg8::Gemm g{(const bf16*)(F.ws + WS_BUFP), (const bf16*)(F.ws + WS_WPOOL) + (size_t)l * 512 * 512, NTOK, 512, 512}; pg8::StaticOrder S; S.init(NTOK, 512, F.G, F.bx);
                EpiScaleBf16 E{CC + 512, DM, KA.in[I_POOLS] + (size_t)l * 512};
                pg8::gemm_phase<EpiScaleBf16, pg8::StaticOrder, true, true>(F.lds, g, S, E);
                if (DUP_MASK & 512) { pg8::gemm_phase<EpiScaleBf16, pg8::StaticOrder, true, true>(F.lds, g, S, E); }
            }
        } SEAM(pb + 4);
        if (IN(pb + 5)) { MKFRAME();
            pg8::Gemm g{CC, (const bf16*)(F.ws + WS_WOUT) + (size_t)l * DM * DM, NTOK, DM, DM}; pg8::StaticOrder S; S.init(NTOK, DM, F.G, F.bx);
            EpiStoreBf16 E{H, DM};
            pg8::gemm_phase<EpiStoreBf16, pg8::StaticOrder, true, true>(F.lds, g, S, E);
        } SEAM(pb + 5);
        if (IN(pb + 6)) { MKFRAME();
            ln_rows2(XN, H, ALPHA, KA.in[I_LN1G] + (size_t)l * DM, KA.in[I_LN1B] + (size_t)l * DM, F.gw, F.NGW, F.lane);
        } SEAM(pb + 6);
        if (IN(pb + 7)) { MKFRAME();
            pg8::Gemm g{XN, (const bf16*)(F.ws + WS_WS) + (size_t)l * DM * DM, NTOK, DM, DM}; pg8::StaticOrder S; S.init(NTOK, DM, F.G, F.bx);
            EpiStoreF16 E{(_Float16*)(F.ws + WS_H), DM};
            pg8::gemm_phase<EpiStoreF16, pg8::StaticOrder, true, true>(F.lds, g, S, E);
            if (DUP_MASK & 128) { pg8::gemm_phase<EpiStoreF16, pg8::StaticOrder, true, true>(F.lds, g, S, E); }
        } SEAM(pb + 7);
        if (IN(pb + 8)) { MKFRAME(); __syncthreads(); topk_phase(F, KA); if (DUP_MASK & 32) { topk_phase(F, KA); } } SEAM(pb + 8);
        if (IN(pb + 9)) { MKFRAME(); if (DUP_MASK & 1024) { peer_gather_phase(F, KA, l, (float*)(F.ws + WS_H), CC); } peer_gather_phase(F, KA, l, l == NLAYER - 1 ? F.out : (float*)nullptr, XN); } SEAM(pb + 9);
    }
#undef IN
#undef SEAM
}


#ifndef DBG_STOP
#define DBG_STOP NPHASE
#endif
#ifndef DBG_DUMP
#define DBG_DUMP 0
#endif
__global__ void dbg_dump_kernel(float* out, const unsigned char* ws, int mode) {
    const size_t n = (size_t)NTOK * DM;
    for (size_t i = (size_t)blockIdx.x * blockDim.x + threadIdx.x; i < n; i += (size_t)gridDim.x * blockDim.x) {
        float v = 0.f;
        if (mode == 1) v = bf_lo(((const bf16*)(ws + WS_H))[i]);
        else if (mode == 2) v = bf_lo(((const bf16*)(ws + WS_CONCAT))[i]);
        else if (mode == 3) v = bf_lo(((const bf16*)(ws + WS_BUFY))[i % ((size_t)NTOK * 1024)]);
        else if (mode == 4) v = bf_lo(((const bf16*)(ws + WS_STF))[i]);
        else if (mode == 5) v = ((const float*)(ws + WS_H))[i];
        else if (mode == 6) v = (i < (size_t)NTOK * 128) ? (float)((const int*)(ws + WS_IDX))[i] : ((i < (size_t)NTOK * 256) ? ((const float*)(ws + WS_GATE))[i - (size_t)NTOK * 128] : 0.f);
        else if (mode == 7) v = bf_lo(((const bf16*)(ws + WS_XN))[i]);
        else if (mode == 8) v = bf_lo(((const bf16*)(ws + WS_STB))[i]);
        else if (mode == 9) v = bf_lo(((const bf16*)(ws + WS_H))[i + (size_t)NTOK * DM]);
        else if (mode == 10) v = bf_lo(((const bf16*)(ws + WS_WIN))[i % ((size_t)72 * 1024 * 1024)]);
        else if (mode == 11) v = ((const float*)(ws + WS_S5ST))[i % ((size_t)5 * 1024 * 1024)];
        else if (mode == 12) v = bf_lo(((const bf16*)(ws + WS_H))[i]) + bf_lo(((const bf16*)(ws + WS_H))[i + (size_t)NTOK * DM]) + bf_lo(((const bf16*)(ws + WS_BUFP))[i % ((size_t)NTOK * 512)]) + ((const float*)(ws + WS_S5ST))[i % ((size_t)5 * 1024 * 1024)];
        else if (mode == 13) v = bf_lo(((const bf16*)(ws + WS_STF))[i]) + bf_lo(((const bf16*)(ws + WS_STB))[i]) + ((const float*)(ws + WS_S5ST))[i % ((size_t)5 * 1024 * 1024)];
        else if (mode == 14) v = bf_lo(((const bf16*)(ws + WS_STF))[i]) + bf_lo(((const bf16*)(ws + WS_STB))[i]) + bf_lo(((const bf16*)(ws + WS_BUFY))[i % ((size_t)NTOK * 512)]);
        else if (mode == 15) v = bf_lo(((const bf16*)(ws + WS_H))[i]) + bf_lo(((const bf16*)(ws + WS_H))[i + (size_t)NTOK * DM]) + bf_lo(((const bf16*)(ws + WS_H))[i + (size_t)NTOK * 3072]);
        out[i] = v;
    }
}
#ifndef MK_ONE_LAUNCH
#define MK_ONE_LAUNCH 0
#endif
extern "C" void kernel_launch(void* const* d_in, const int* in_sizes, int n_in, void* d_out, int out_size, void* d_ws, size_t ws_size, hipStream_t stream) {
    static int grid = 0;
    if (grid == 0) {
        if (n_in != 26 || out_size != NTOK * DM || ws_size < WS_END) { fprintf(stderr, "kernel_launch: unexpected shapes (n_in %d out %d ws %zu)\n", n_in, out_size, ws_size); grid = -1; return; }
        int dev = 0, cus = 0, per_cu = 0;
        if (hipGetDevice(&dev) != hipSuccess || hipDeviceGetAttribute(&cus, hipDeviceAttributeMultiprocessorCount, dev) != hipSuccess) { grid = -1; return; }
        if (hipFuncSetAttribute((const void*)fwd_kernel, hipFuncAttributeMaxDynamicSharedMemorySize, LDS_BYTES) != hipSuccess) { fprintf(stderr, "kernel_launch: hipFuncSetAttribute failed\n"); grid = -1; return; }
        if (hipOccupancyMaxActiveBlocksPerMultiprocessor(&per_cu, (const void*)fwd_kernel, NTHR, LDS_BYTES) != hipSuccess || per_cu < 1) { fprintf(stderr, "kernel_launch: occupancy query says %d\n", per_cu); grid = -1; (void)hipGetLastError(); return; }
        (void)hipGetLastError();
        grid = cus;
    }
    if (grid < 0) return;
    if (hipMemsetAsync((char*)d_ws + WS_CTL, 0, CTL_ZERO_BYTES, stream) != hipSuccess) return;
    Args a{};
    for (int i = 0; i < 26; ++i) a.in[i] = (const float*)d_in[i];
    a.out = (float*)d_out; a.ws = (unsigned char*)d_ws; a.pad = 0;
#if MK_ONE_LAUNCH
    a.ph_lo = 0; a.ph_hi = NPHASE; a.li = 0;
    hipLaunchKernelGGL(fwd_kernel, dim3(grid), dim3(NTHR), LDS_BYTES, stream, a);
#else
    for (int p = 0; p < DBG_STOP; ++p) { a.ph_lo = p; a.ph_hi = p + 1; a.li = p; hipLaunchKernelGGL(fwd_kernel, dim3(grid), dim3(NTHR), LDS_BYTES, stream, a); }
#endif
    if (DBG_DUMP) hipLaunchKernelGGL(dbg_dump_kernel, dim3(2048), dim3(256), 0, stream, (float*)d_out, (const unsigned char*)d_ws, DBG_DUMP);
}
#endif
```

```cpp
#include <hip/hip_runtime.h>
#include <cstdio>
#include <cstdint>
#include <cmath>
__device__ __forceinline__ int opaque(int v) { asm volatile("" : "+v"(v)); return v; }
__device__ __forceinline__ int opaque_s(int v) { asm volatile("" : "+s"(v)); return v; }
__device__ __forceinline__ void* opaque_p(void* p) { asm volatile("" : "+s"(p)); return p; }
__device__ __forceinline__ unsigned long long opaque_u64(unsigned long long v) { asm volatile("" : "+s"(v)); return v; }
#ifndef GATHER_ROWS
#define GATHER_ROWS 16
#endif
__device__ __forceinline__ __attribute__((address_space(1))) unsigned char* opaque_g(__attribute__((address_space(1))) unsigned char* p) { asm volatile("" : "+s"(p)); return p; }
#define MK_ONE_LAUNCH 1
namespace pg8 {
#define PG8_LAS __attribute__((address_space(3)))
typedef unsigned short bf16_t;
typedef short bf16x8 __attribute__((ext_vector_type(8)));
typedef float f32x4 __attribute__((ext_vector_type(4)));
typedef unsigned u32x4 __attribute__((ext_vector_type(4)));
constexpr int BM = 256, BK = 64, HALF = 128, HTB = HALF * BK * 2  , STAGE_BYTES = 8 * HTB, NXCD = 8, WGM = 8;

__host__ __device__ __forceinline__ int lds_byte(int r, int c) { const int st = (r >> 4) * 2 + (c >> 5), rr = r & 15, cc = c & 31, ob = rr * 64 + cc * 2; return st * 1024 + (ob ^ (((ob >> 9) & 1) << 5)); }
__host__ __device__ __forceinline__ void stage_rc(int b, int& R, int& C) { const int st = b / 1024, sb = b % 1024, swz = sb ^ (((sb >> 9) & 1) << 5); R = (st >> 1) * 16 + swz / 64; C = (st & 1) * 32 + (swz % 64) / 2; }
__host__ __device__ __forceinline__ int perm32(int rho) { const int n = rho >> 4, i = rho & 15; return 8 * (i >> 2) + 4 * n + (i & 3); }

struct Unit { int pm, pn; };
struct Gemm { const bf16_t* A; const bf16_t* Bt; int M, N, K; };

struct StaticOrder {
    int nM, nN, nwg, G, c;
    __host__ __device__ void init(int M, int N, int G_, int c_) { nM = M / BM; nN = N / BM; nwg = nM * nN; G = G_; c = c_; }
    __host__ __device__ bool next(int i, Unit& u) const {
        const long L = (long)i * G + c; if (L >= nwg) return false;
        int wgid = (int)L; { const int q = nwg / NXCD, r = nwg % NXCD, xcd = wgid % NXCD, off = wgid / NXCD; wgid = (xcd < r ? xcd * (q + 1) : r * (q + 1) + (xcd - r) * q) + off; }
        const int nig = WGM * nN, gid = wgid / nig, fm = gid * WGM, gsz = (nM - fm) < WGM ? (nM - fm) : WGM;
        u.pm = fm + ((wgid % nig) % gsz); u.pn = (wgid % nig) / gsz; return true;
    }
    __device__ __forceinline__ void a_ready(const Unit&) const {}
    __device__ __forceinline__ void done(const Unit&) const {}
};
__device__ __forceinline__ unsigned cvt_pk_bf16(float lo, float hi) { unsigned r; asm volatile("v_cvt_pk_bf16_f32 %0, %1, %2" : "=v"(r) : "v"(lo), "v"(hi)); return r; }
typedef float f32x2 __attribute__((ext_vector_type(2)));
template <class Epi, class Sched, bool ALIGN_EPI = false, bool SP2 = false>
__device__ __forceinline__ void gemm_phase(PG8_LAS unsigned char* lds, const Gemm g, const Sched& S, const Epi& E) {
    const int tid = opaque((int)threadIdx.x), wid = __builtin_amdgcn_readfirstlane(tid >> 6), lane = tid & 63, wr = wid >> 2, wc = wid & 3, fr = lane & 15, fq = lane >> 4;
    const int K = g.K, nt = K / BK;
    unsigned voffA[2], voffB[2];
#pragma unroll
    for (int i = 0; i < 2; ++i) { int R, C; stage_rc(tid * 16 + i * 8192, R, C); const int Rb = Epi::PERM ? ((R & ~31) + perm32(R & 31)) : R;
        voffA[i] = (unsigned)(R * K + C) * 2u; voffB[i] = (unsigned)(Rb * K + C) * 2u; }
    const size_t kstep = (size_t)(BK * 2);
    const size_t hstep = (size_t)HALF * K * 2;
    const size_t tstep = 2 * hstep;
    const unsigned ldsw = (unsigned)wid * 1024u;
    const int aoff = lds_byte(wr * 64 + fr, fq * 8), boff = lds_byte(wc * 32 + fr, fq * 8);
#define PG8_SA(b, h) (((b) * 2 + (h)) * HTB)
#define PG8_SB(b, h) ((4 + (b) * 2 + (h)) * HTB)
#define PG8_STAGE(bufoff, gbase, voff) do { _Pragma("unroll") for (int _i = 0; _i < 2; ++_i) \
        __builtin_amdgcn_global_load_lds((const unsigned*)((const char*)(gbase) + (voff)[_i]), (PG8_LAS unsigned*)(lds + (bufoff) + ldsw + _i * 8192), 16, 0, 0); } while (0)
#define PG8_LDA(dst, b, h) do { _Pragma("unroll") for (int m = 0; m < 4; ++m) _Pragma("unroll") for (int k = 0; k < 2; ++k) dst[m][k] = *(const PG8_LAS bf16x8*)(lds + PG8_SA(b, h) + aoff + m * 2048 + k * 1024); } while (0)
#define PG8_LDB(dst, b, h) do { _Pragma("unroll") for (int n = 0; n < 2; ++n) _Pragma("unroll") for (int k = 0; k < 2; ++k) dst[n][k] = *(const PG8_LAS bf16x8*)(lds + PG8_SB(b, h) + boff + n * 2048 + k * 1024); } while (0)
#define PG8_MMA(ai, bj, At, Bt) do { __builtin_amdgcn_s_setprio(1); _Pragma("unroll") for (int m = 0; m < 4; ++m) _Pragma("unroll") for (int n = 0; n < 2; ++n) _Pragma("unroll") for (int k = 0; k < 2; ++k) \
        acc[ai][bj][m][n] = __builtin_amdgcn_mfma_f32_16x16x32_bf16(Bt[n][k], At[m][k], acc[ai][bj][m][n], 0, 0, 0); __builtin_amdgcn_s_setprio(0); } while (0)
#define PG8_WAIT_V(n) asm volatile("s_waitcnt vmcnt(" #n ")" ::: "memory")
#define PG8_WAIT_L(n) asm volatile("s_waitcnt lgkmcnt(" #n ")" ::: "memory")
#define PG8_BAR __builtin_amdgcn_s_barrier()
#define PG8_SCHED __builtin_amdgcn_sched_barrier(0)
    Unit cur, nxt; int ui = 0;
    if (!S.next(0, cur)) return;
    f32x4 acc[2][2][4][2];
#pragma unroll
    for (int a = 0; a < 2; ++a)
#pragma unroll
        for (int b = 0; b < 2; ++b)
#pragma unroll
            for (int m = 0; m < 4; ++m)
#pragma unroll
                for (int n = 0; n < 2; ++n) acc[a][b][m][n] = (f32x4){0.f, 0.f, 0.f, 0.f};
    bf16x8 At[4][2], B0[2][2], B1[2][2];
    const char* cA = (const char*)g.A + (size_t)cur.pm * tstep; const char* cB = (const char*)g.Bt + (size_t)cur.pn * tstep;
    S.a_ready(cur);
    if constexpr (SP2) {
        PG8_STAGE(PG8_SB(0, 0), cB, voffB); PG8_STAGE(PG8_SB(0, 1), cB + hstep, voffB); PG8_STAGE(PG8_SA(0, 0), cA, voffA); PG8_STAGE(PG8_SA(0, 1), cA + hstep, voffA);
        if (wr == 1) PG8_BAR;
        PG8_WAIT_V(2); PG8_BAR;
        PG8_STAGE(PG8_SB(1, 0), cB + kstep, voffB); PG8_STAGE(PG8_SA(1, 0), cA + kstep, voffA); PG8_STAGE(PG8_SB(1, 1), cB + hstep + kstep, voffB);
        PG8_WAIT_V(6); PG8_BAR;
    } else {
        PG8_STAGE(PG8_SB(0, 0), cB, voffB); PG8_STAGE(PG8_SA(0, 0), cA, voffA); PG8_STAGE(PG8_SB(0, 1), cB + hstep, voffB); PG8_STAGE(PG8_SA(0, 1), cA + hstep, voffA);
        if (wr == 1) PG8_BAR;
        PG8_WAIT_V(4); PG8_BAR;
        PG8_STAGE(PG8_SB(1, 0), cB + kstep, voffB); PG8_STAGE(PG8_SA(1, 0), cA + kstep, voffA); PG8_STAGE(PG8_SB(1, 1), cB + hstep + kstep, voffB);
        PG8_WAIT_V(6); PG8_BAR;
    }
    for (;;) {
        const bool has_next = S.next(ui + 1, nxt);
        const char* nA = has_next ? (const char*)g.A + (size_t)nxt.pm * tstep : cA; const char* nB = has_next ? (const char*)g.Bt + (size_t)nxt.pn * tstep : cB;
        for (int t = 0; t < nt; t += 2) {
            const bool last = (t == nt - 2);
            const char* a1 = cA + (size_t)(t + 1) * kstep;
            const char* a2 = last ? nA : cA + (size_t)(t + 2) * kstep; const char* b2 = last ? nB : cB + (size_t)(t + 2) * kstep;
            const char* a3 = a2 + kstep; const char* b3 = b2 + kstep;
            if (last && has_next) S.a_ready(nxt);
            if constexpr (SP2) {
            PG8_LDB(B0, 0, 0); PG8_LDB(B1, 0, 1); PG8_SCHED; PG8_LDA(At, 0, 0); PG8_STAGE(PG8_SA(1, 1), a1 + hstep, voffA);
            PG8_WAIT_V(8); PG8_WAIT_L(0); PG8_BAR; PG8_MMA(0, 0, At, B0); PG8_MMA(0, 1, At, B1); PG8_BAR; PG8_SCHED;
            PG8_LDA(At, 0, 1); PG8_STAGE(PG8_SB(0, 0), b2, voffB); PG8_STAGE(PG8_SB(0, 1), b2 + hstep, voffB); PG8_STAGE(PG8_SA(0, 0), a2, voffA);
            PG8_WAIT_V(8); PG8_WAIT_L(0); PG8_BAR; PG8_MMA(1, 0, At, B0); PG8_MMA(1, 1, At, B1); PG8_BAR; PG8_SCHED;
            PG8_LDB(B0, 1, 0); PG8_LDB(B1, 1, 1); PG8_SCHED; PG8_LDA(At, 1, 0); PG8_STAGE(PG8_SA(0, 1), a2 + hstep, voffA);
            PG8_WAIT_V(8); PG8_WAIT_L(0); PG8_BAR; PG8_MMA(0, 0, At, B0); PG8_MMA(0, 1, At, B1); PG8_BAR; PG8_SCHED;
            PG8_LDA(At, 1, 1); PG8_STAGE(PG8_SB(1, 0), b3, voffB); PG8_STAGE(PG8_SB(1, 1), b3 + hstep, voffB); PG8_STAGE(PG8_SA(1, 0), a3, voffA);
            PG8_WAIT_V(8); PG8_WAIT_L(0); PG8_BAR; PG8_MMA(1, 0, At, B0); PG8_MMA(1, 1, At, B1); PG8_BAR; PG8_SCHED;
            } else {
            PG8_LDB(B0, 0, 0); PG8_SCHED; PG8_LDA(At, 0, 0); PG8_STAGE(PG8_SA(1, 1), a1 + hstep, voffA);
            PG8_WAIT_L(8); PG8_BAR; PG8_WAIT_L(0); PG8_MMA(0, 0, At, B0); PG8_BAR; PG8_SCHED;
            PG8_LDB(B1, 0, 1); PG8_STAGE(PG8_SB(0, 0), b2, voffB);
            PG8_BAR; PG8_WAIT_L(0); PG8_MMA(0, 1, At, B1); PG8_BAR;
            PG8_LDA(At, 0, 1); PG8_STAGE(PG8_SA(0, 0), a2, voffA);
            PG8_BAR; PG8_WAIT_L(0); PG8_MMA(1, 0, At, B0); PG8_BAR; PG8_SCHED;
            PG8_STAGE(PG8_SB(0, 1), b2 + hstep, voffB);
            PG8_WAIT_V(6); PG8_BAR; PG8_MMA(1, 1, At, B1); PG8_BAR;
            PG8_LDB(B0, 1, 0); PG8_SCHED; PG8_LDA(At, 1, 0); PG8_STAGE(PG8_SA(0, 1), a2 + hstep, voffA);
            PG8_WAIT_L(8); PG8_BAR; PG8_WAIT_L(0); PG8_MMA(0, 0, At, B0); PG8_BAR; PG8_SCHED;
            PG8_LDB(B1, 1, 1); PG8_STAGE(PG8_SB(1, 0), b3, voffB);
            PG8_BAR; PG8_WAIT_L(0); PG8_MMA(0, 1, At, B1); PG8_BAR;
            PG8_LDA(At, 1, 1); PG8_STAGE(PG8_SA(1, 0), a3, voffA);
            PG8_BAR; PG8_WAIT_L(0); PG8_MMA(1, 0, At, B0); PG8_BAR; PG8_SCHED;
            PG8_STAGE(PG8_SB(1, 1), b3 + hstep, voffB);
            PG8_WAIT_V(6); PG8_BAR; PG8_MMA(1, 1, At, B1); PG8_BAR;
            }
        }
        if constexpr (ALIGN_EPI) { if (wr == 0) PG8_BAR; }
        if constexpr (!Epi::AFTER_DRAIN) { E(acc, cur, wr, wc, fr, fq); S.done(cur); }
        if (!has_next) break;
#pragma unroll
        for (int a = 0; a < 2; ++a)
#pragma unroll
            for (int b = 0; b < 2; ++b)
#pragma unroll
                for (int m = 0; m < 4; ++m)
#pragma unroll
                    for (int n = 0; n < 2; ++n) acc[a][b][m][n] = (f32x4){0.f, 0.f, 0.f, 0.f};
        cur = nxt; cA = nA; cB = nB; ++ui;
        if constexpr (ALIGN_EPI) { if (wr == 1) PG8_BAR; }
    }
    PG8_WAIT_V(0);
    if constexpr (!ALIGN_EPI) { if (wr == 0) PG8_BAR; }
    PG8_BAR;
    if constexpr (Epi::AFTER_DRAIN) { E.fused(acc, cur, wr, wc, fr, fq, lds, wid, lane); S.done(cur); }
#undef PG8_SA
#undef PG8_SB
#undef PG8_STAGE
#undef PG8_LDA
#undef PG8_LDB
#undef PG8_MMA
#undef PG8_WAIT_V
#undef PG8_WAIT_L
#undef PG8_BAR
#undef PG8_SCHED
}
}
#define LAS __attribute__((address_space(3)))
#define XB_TMO      128
#define XB_XCNT(j)  (256  + 64 * (j))
#define XB_XSUB(j)  (1280 + 64 * (j))
#define XB_XGEN(j)  (2304 + 64 * (j))
#define XB_TOP      3328
#define XB_TOPGEN   3392
#define XCD_BAR_WORDS 3456
#define XB_SPIN_CAP (1u << 18)

__device__ __forceinline__ unsigned xb_ld(unsigned* p)              { return __hip_atomic_load(p, __ATOMIC_RELAXED, __HIP_MEMORY_SCOPE_AGENT); }
__device__ __forceinline__ unsigned xb_add(unsigned* p, unsigned v) { return __hip_atomic_fetch_add(p, v, __ATOMIC_RELAXED, __HIP_MEMORY_SCOPE_AGENT); }
__device__ __forceinline__ unsigned xb_xcc_id() { return (unsigned)__builtin_amdgcn_s_getreg((3 << 11) | 20) & 0xFu; }
#define XB_SPIN(cond, bar) do { unsigned _sp = 0; while (cond) { __builtin_amdgcn_s_sleep(1); \
    if ((++_sp & 255u) == 0u) { if (xb_ld(&(bar)[XB_TMO])) break; if (_sp > XB_SPIN_CAP) { atomicAdd(&(bar)[XB_TMO], 1u); break; } } } } while (0)

struct XcdBarrier {
    unsigned* bar; unsigned x;
    volatile LAS unsigned* st;
};

__device__ __forceinline__ XcdBarrier xcd_barrier_post(unsigned* bar, volatile LAS unsigned* st) {
    XcdBarrier b; b.bar = bar; b.x = xb_xcc_id(); b.st = st;
    if (threadIdx.x == 0) (void)xb_add(&bar[XB_XCNT(b.x)], 1u);
    return b;
}
__device__ __forceinline__ void xcd_barrier_complete(unsigned* bar, unsigned x, unsigned& nloc, unsigned& nx) {
    const unsigned G = gridDim.x * gridDim.y * gridDim.z;
    unsigned sum, cnt, mine, sp = 0u;
    for (;;) {
        sum = 0u; cnt = 0u; mine = 0u;
#pragma unroll
        for (unsigned j = 0; j < 16; ++j) { const unsigned c = xb_ld(&bar[XB_XCNT(j)]); sum += c; cnt += (c > 0u) ? 1u : 0u; mine = (j == x) ? c : mine; }
        if (sum == G) break;
        __builtin_amdgcn_s_sleep(1);
        if ((++sp & 255u) == 0u) { if (xb_ld(&bar[XB_TMO])) break; if (sp > XB_SPIN_CAP) { atomicAdd(&bar[XB_TMO], 1u); break; } }
    }
    nloc = mine > 0u ? mine : 1u; nx = cnt > 0u ? cnt : 1u;
}

__device__ __forceinline__ void xcd_barrier(const XcdBarrier& b) {
    asm volatile("s_waitcnt vmcnt(0)" ::: "memory");
    __syncthreads();
    if (threadIdx.x == 0) {
        unsigned* bar = b.bar;
        __builtin_amdgcn_s_waitcnt(0);
        unsigned nloc = b.st[0], nx = b.st[1];
        if (nloc == 0u) { xcd_barrier_complete(bar, b.x, nloc, nx); b.st[0] = nloc; b.st[1] = nx; }
        const unsigned old = xb_add(&bar[XB_XSUB(b.x)], 1u);
        const unsigned gen = old / nloc;
        if (old + 1u == (gen + 1u) * nloc) {
            __builtin_amdgcn_fence(__ATOMIC_RELEASE, "agent");
            asm volatile("s_waitcnt vmcnt(0)" ::: "memory");
            const unsigned og = xb_add(&bar[XB_TOP], 1u);
            const unsigned tg = og / nx;
            if (og + 1u == (tg + 1u) * nx) xb_add(&bar[XB_TOPGEN], 1u);
            else XB_SPIN(xb_ld(&bar[XB_TOPGEN]) == tg, bar);
            __builtin_amdgcn_fence(__ATOMIC_ACQUIRE, "agent");
            xb_add(&bar[XB_XGEN(b.x)], 1u);
            asm volatile("s_waitcnt vmcnt(0)" ::: "memory");
        } else {
            XB_SPIN(xb_ld(&bar[XB_XGEN(b.x)]) == gen, bar);
            __builtin_amdgcn_fence(__ATOMIC_ACQUIRE, "agent");
            asm volatile("s_waitcnt vmcnt(0)" ::: "memory");
        }
    }
    __syncthreads();
}
#undef LAS
using pg8::bf16x8; using pg8::f32x4; using pg8::u32x4; using pg8::f32x2;
#define GAS __attribute__((address_space(1)))
#define LAS __attribute__((address_space(3)))
typedef unsigned short bf16;
typedef unsigned v4u __attribute__((ext_vector_type(4)));
typedef unsigned v2u __attribute__((ext_vector_type(2)));
typedef float f32x2v __attribute__((ext_vector_type(2)));

constexpr int NTOK = 40960, DM = 2048, NLAYER = 4, INW = 5120;
constexpr int COL_UA = 0, COL_UB = 512, COL_Q = 1024, COL_K = 2048, COL_V = 3072, COL_G = 4096;
constexpr float ALPHA = 1.6817928305074290f;
constexpr float LN_EPS = 1e-5f, GN_EPS = 1e-6f;
constexpr int NEXP = 16384;
constexpr int NWAVES = 8, NTHR = 512;

constexpr size_t MiB = 1u << 20;
constexpr size_t WS_CTL = 0, CTL_ZERO_BYTES = 1 * MiB;
constexpr size_t WS_WIN = 1 * MiB;
constexpr size_t WS_WOUT = 81 * MiB;
constexpr size_t WS_WS = 113 * MiB;
constexpr size_t WS_WGLU = 145 * MiB;
constexpr size_t WS_WPOOL = 147 * MiB;
constexpr size_t WS_S5A = 149 * MiB;
constexpr size_t WS_S5B = 150 * MiB;
constexpr size_t WS_S5BB = 153 * MiB;
constexpr size_t WS_U8 = 160 * MiB;
constexpr size_t WS_V8 = 288 * MiB;
constexpr size_t WS_USC = 416 * MiB;
constexpr size_t WS_VSC = 417 * MiB;
constexpr size_t WS_ROTC = 420 * MiB;
constexpr size_t WS_ROTS = 424 * MiB;
constexpr size_t WS_XN = 672 * MiB;
constexpr size_t WS_H = 832 * MiB;
constexpr size_t WS_CONCAT = 1232 * MiB;
constexpr size_t WS_BUFY = 1392 * MiB;
constexpr size_t WS_BUFP = 1432 * MiB;
constexpr size_t WS_STF = 1472 * MiB;
constexpr size_t WS_STB = 1632 * MiB;
constexpr size_t WS_IDX = 1792 * MiB;
constexpr size_t WS_GATE = 1812 * MiB;
constexpr size_t WS_S5ST = 1832 * MiB;
constexpr size_t WS_END = 1852 * MiB;
constexpr int CW_BAR = 4096;
constexpr int NPHASE = 1 + NLAYER * 10;

constexpr int LDS_SCRATCH = 147456;
constexpr int LDS_MISC = LDS_SCRATCH;
constexpr int LDS_BYTES = LDS_SCRATCH + 256;

__device__ __forceinline__ float bf_lo(unsigned w) { return __uint_as_float(w << 16); }
__device__ __forceinline__ float bf_hi(unsigned w) { return __uint_as_float(w & 0xffff0000u); }
typedef __bf16 bf16x2_t __attribute__((ext_vector_type(2)));
__device__ __forceinline__ unsigned pkbf(float lo, float hi) { const bf16x2_t v = {(__bf16)lo, (__bf16)hi}; return __builtin_bit_cast(unsigned, v); }
__device__ __forceinline__ bf16 f2bf(float f) { return __builtin_bit_cast(unsigned short, (__bf16)f); }
__device__ __forceinline__ float wave_sum(float v) {
#pragma unroll
    for (int o = 1; o < 64; o <<= 1) v += __shfl_xor(v, o);
    return v;
}
__device__ __forceinline__ float gelu_erf(float v) { return 0.5f * v * (1.0f + erff(v * 0.70710678118654752f)); }
__device__ __forceinline__ int tok_pos(int t) { return t < 32768 ? (t & 4095) : (t - 32768); }
__device__ __forceinline__ int tok_len(int t) { return t < 32768 ? 4096 : 8192; }
__device__ __forceinline__ void unpack8(const v4u q, float (&f)[8]) {
    f[0] = bf_lo(q.x); f[1] = bf_hi(q.x); f[2] = bf_lo(q.y); f[3] = bf_hi(q.y); f[4] = bf_lo(q.z); f[5] = bf_hi(q.z); f[6] = bf_lo(q.w); f[7] = bf_hi(q.w);
}
__device__ __forceinline__ v4u pack8(const float (&f)[8]) { v4u q; q.x = pkbf(f[0], f[1]); q.y = pkbf(f[2], f[3]); q.z = pkbf(f[4], f[5]); q.w = pkbf(f[6], f[7]); return q; }
#define LDS_WAIT() asm volatile("s_waitcnt lgkmcnt(0)" ::: "memory")
#define MFMA16(a, b, c) __builtin_amdgcn_mfma_f32_16x16x32_bf16((a), (b), (c), 0, 0, 0)

struct EpiStoreBf16 {
    static constexpr bool PERM = true, AFTER_DRAIN = false;
    bf16* O; int ldo;
    __device__ __forceinline__ void operator()(const f32x4 (&acc)[2][2][4][2], const pg8::Unit& u, int wr, int wc, int fr, int fq) const {
        const int row0 = u.pm * 256 + wr * 64 + fr, col0 = u.pn * 256 + wc * 32 + 8 * fq;
#pragma unroll
        for (int ai = 0; ai < 2; ++ai)
#pragma unroll
            for (int m = 0; m < 4; ++m) { bf16* rowp = O + (size_t)(row0 + ai * 128 + m * 16) * ldo + col0;
#pragma unroll
                for (int bj = 0; bj < 2; ++bj) { const f32x4 v0 = acc[ai][bj][m][0], v1 = acc[ai][bj][m][1];
                    v4u w; w.x = pkbf(v0[0], v0[1]); w.y = pkbf(v0[2], v0[3]); w.z = pkbf(v1[0], v1[1]); w.w = pkbf(v1[2], v1[3]);
                    *(v4u*)(rowp + bj * 128) = w; } }
    }
};
struct EpiStoreRot {
    static constexpr bool PERM = true, AFTER_DRAIN = false;
    bf16* O; int ldo; const float* rc; const float* rs;
    __device__ __forceinline__ void operator()(const f32x4 (&acc)[2][2][4][2], const pg8::Unit& u, int wr, int wc, int fr, int fq) const {
        const int row0 = u.pm * 256 + wr * 64 + fr, col0 = u.pn * 256 + wc * 32 + 8 * fq;
        const bool rot = u.pn >= 4 && u.pn < 12; const float sc = u.pn >= 8 ? 0.0625f : 1.0f;
#pragma unroll
        for (int ai = 0; ai < 2; ++ai)
#pragma unroll
            for (int m = 0; m < 4; ++m) { const int row = row0 + ai * 128 + m * 16; bf16* rowp = O + (size_t)row * ldo + col0;
                f32x4 a0 = acc[ai][0][m][0], a1 = acc[ai][0][m][1], b0 = acc[ai][1][m][0], b1 = acc[ai][1][m][1];
                if (rot) { const int pos = row < 32768 ? (row & 4095) : (row - 32768); const size_t to = (size_t)pos * 128 + wc * 32 + 8 * fq;
                    const f32x4 c0 = *(const f32x4*)(rc + to), c1 = *(const f32x4*)(rc + to + 4), s0 = *(const f32x4*)(rs + to), s1 = *(const f32x4*)(rs + to + 4);
                    const f32x4 x0 = a0, x1 = a1, y0 = b0, y1 = b1;
                    a0 = (x0 * c0 - y0 * s0) * sc; a1 = (x1 * c1 - y1 * s1) * sc; b0 = (y0 * c0 + x0 * s0) * sc; b1 = (y1 * c1 + x1 * s1) * sc; }
                v4u w; w.x = pkbf(a0[0], a0[1]); w.y = pkbf(a0[2], a0[3]); w.z = pkbf(a1[0], a1[1]); w.w = pkbf(a1[2], a1[3]); *(v4u*)rowp = w;
                v4u x; x.x = pkbf(b0[0], b0[1]); x.y = pkbf(b0[2], b0[3]); x.z = pkbf(b1[0], b1[1]); x.w = pkbf(b1[2], b1[3]); *(v4u*)(rowp + 128) = x; }
    }
};
struct EpiGlu {
    static constexpr bool PERM = true, AFTER_DRAIN = false;
    const bf16* Y; int ldy; bf16* O; int ldo; const float* bias;
    __device__ __forceinline__ void operator()(const f32x4 (&acc)[2][2][4][2], const pg8::Unit& u, int wr, int wc, int fr, int fq) const {
        const int row0 = u.pm * 256 + wr * 64 + fr, col0 = u.pn * 256 + wc * 32 + 8 * fq;
#pragma unroll
        for (int bj = 0; bj < 2; ++bj) {
            const f32x4 b0 = *(const f32x4*)(bias + col0 + bj * 128), b1 = *(const f32x4*)(bias + col0 + bj * 128 + 4);
#pragma unroll
            for (int ai = 0; ai < 2; ++ai)
#pragma unroll
                for (int m = 0; m < 4; ++m) { const size_t r = (size_t)(row0 + ai * 128 + m * 16);
                    const v4u yq = *(const v4u*)(Y + r * ldy + col0 + bj * 128); float y[8]; unpack8(yq, y);
                    const f32x4 v0 = acc[ai][bj][m][0] + b0, v1 = acc[ai][bj][m][1] + b1; float o[8];
#pragma unroll
                    for (int k = 0; k < 4; ++k) { o[k] = y[k] / (1.0f + __expf(-v0[k])); o[4 + k] = y[4 + k] / (1.0f + __expf(-v1[k])); }
                    *(v4u*)(O + r * ldo + col0 + bj * 128) = pack8(o); }
        }
    }
};
struct EpiScaleBf16 {
    static constexpr bool PERM = true, AFTER_DRAIN = false;
    bf16* O; int ldo; const float* scale;
    __device__ __forceinline__ void operator()(const f32x4 (&acc)[2][2][4][2], const pg8::Unit& u, int wr, int wc, int fr, int fq) const {
        const int row0 = u.pm * 256 + wr * 64 + fr, col0 = u.pn * 256 + wc * 32 + 8 * fq;
#pragma unroll
        for (int bj = 0; bj < 2; ++bj) {
            const f32x4 s0 = *(const f32x4*)(scale + col0 + bj * 128), s1 = *(const f32x4*)(scale + col0 + bj * 128 + 4);
#pragma unroll
            for (int ai = 0; ai < 2; ++ai)
#pragma unroll
                for (int m = 0; m < 4; ++m) { const size_t r = (size_t)(row0 + ai * 128 + m * 16);
                    const f32x4 v0 = acc[ai][bj][m][0] * s0, v1 = acc[ai][bj][m][1] * s1;
                    v4u w; w.x = pkbf(v0[0], v0[1]); w.y = pkbf(v0[2], v0[3]); w.z = pkbf(v1[0], v1[1]); w.w = pkbf(v1[2], v1[3]);
                    *(v4u*)(O + r * ldo + col0 + bj * 128) = w; }
        }
    }
};
struct EpiStoreF16 {
    static constexpr bool PERM = true, AFTER_DRAIN = false;
    _Float16* C; int ldc;
    __device__ __forceinline__ void operator()(const f32x4 (&acc)[2][2][4][2], const pg8::Unit& u, int wr, int wc, int fr, int fq) const {
        typedef _Float16 h8 __attribute__((ext_vector_type(8)));
        const int row0 = u.pm * 256 + wr * 64 + fr, col0 = u.pn * 256 + wc * 32 + 8 * fq;
#pragma unroll
        for (int ai = 0; ai < 2; ++ai)
#pragma unroll
            for (int m = 0; m < 4; ++m) { _Float16* rowp = C + (size_t)(row0 + ai * 128 + m * 16) * ldc + col0;
#pragma unroll
                for (int bj = 0; bj < 2; ++bj) { const f32x4 v0 = acc[ai][bj][m][0], v1 = acc[ai][bj][m][1];
                    h8 w; w[0] = (_Float16)v0[0]; w[1] = (_Float16)v0[1]; w[2] = (_Float16)v0[2]; w[3] = (_Float16)v0[3]; w[4] = (_Float16)v1[0]; w[5] = (_Float16)v1[1]; w[6] = (_Float16)v1[2]; w[7] = (_Float16)v1[3];
                    *(h8*)(rowp + bj * 128) = w; } }
    }
};
struct Args { const float* in[26]; float* out; unsigned char* ws; int ph_lo, ph_hi, li, pad; };
struct ArgsDev { const float GAS* in[26]; float GAS* out; unsigned char GAS* ws; int ph_lo, ph_hi, li, pad; };
typedef const ArgsDev __attribute__((address_space(4))) CArgs;
#define GIN(A_, k_) ((const float*)(A_).in[k_])
struct Frame {
    LAS unsigned char* lds;
    int tid, lane, wave, G, bx;
    int gw, NGW;
    size_t gtid, NT;
    float* out; unsigned char* ws;
};
enum InIdx { I_XP = 0, I_XS, I_LNIN_G, I_LNIN_B, I_WIN, I_LAMRE, I_LAMIM, I_LOGSTEP, I_BRE, I_BIM, I_CRE, I_CIM, I_S5D, I_WGLU, I_BGLU, I_POOLW, I_POOLS,
             I_WOUT, I_LN1G, I_LN1B, I_WQ, I_KEYS, I_PU, I_PV, I_LN2G, I_LN2B };

__device__ __forceinline__ void ln_rows2(bf16* XB, const bf16* MIX, float alpha, const float* g, const float* b, int gw, int ngw, int lane) {
    for (int t = gw; t < NTOK; t += 2 * ngw) {
        const int t2 = t + ngw; const bool has2 = t2 < NTOK; const int tb = has2 ? t2 : t;
        f32x4 v0[8], v1[8]; v2u x0q[8], x1q[8], m0q[8], m1q[8]; float s0 = 0.f, s1 = 0.f;
#pragma unroll
        for (int j = 0; j < 8; ++j) { x0q[j] = ((const v2u*)(XB + (size_t)t * DM))[lane + 64 * j]; m0q[j] = ((const v2u*)(MIX + (size_t)t * DM))[lane + 64 * j]; }
#pragma unroll
        for (int j = 0; j < 8; ++j) { x1q[j] = ((const v2u*)(XB + (size_t)tb * DM))[lane + 64 * j]; m1q[j] = ((const v2u*)(MIX + (size_t)tb * DM))[lane + 64 * j]; }
#pragma unroll
        for (int j = 0; j < 8; ++j) {
            v0[j] = (f32x4){bf_lo(x0q[j].x), bf_hi(x0q[j].x), bf_lo(x0q[j].y), bf_hi(x0q[j].y)} * alpha + (f32x4){bf_lo(m0q[j].x), bf_hi(m0q[j].x), bf_lo(m0q[j].y), bf_hi(m0q[j].y)};
            v1[j] = (f32x4){bf_lo(x1q[j].x), bf_hi(x1q[j].x), bf_lo(x1q[j].y), bf_hi(x1q[j].y)} * alpha + (f32x4){bf_lo(m1q[j].x), bf_hi(m1q[j].x), bf_lo(m1q[j].y), bf_hi(m1q[j].y)};
            s0 += (v0[j][0] + v0[j][1]) + (v0[j][2] + v0[j][3]); s1 += (v1[j][0] + v1[j][1]) + (v1[j][2] + v1[j][3]); }
        const float m0 = wave_sum(s0) * (1.0f / DM), m1 = wave_sum(s1) * (1.0f / DM); float q0 = 0.f, q1 = 0.f;
#pragma unroll
        for (int j = 0; j < 8; ++j) { v0[j] = v0[j] - m0; v1[j] = v1[j] - m1;
            q0 += (v0[j][0] * v0[j][0] + v0[j][1] * v0[j][1]) + (v0[j][2] * v0[j][2] + v0[j][3] * v0[j][3]); q1 += (v1[j][0] * v1[j][0] + v1[j][1] * v1[j][1]) + (v1[j][2] * v1[j][2] + v1[j][3] * v1[j][3]); }
        const float rs0 = 1.0f / sqrtf(wave_sum(q0) * (1.0f / DM) + LN_EPS), rs1 = 1.0f / sqrtf(wave_sum(q1) * (1.0f / DM) + LN_EPS);
#pragma unroll
        for (int j = 0; j < 8; ++j) { const f32x4 gg = ((const f32x4*)g)[lane + 64 * j], bb = ((const f32x4*)b)[lane + 64 * j];
            const f32x4 o0 = v0[j] * rs0 * gg + bb;
            v2u w0; w0.x = pkbf(o0[0], o0[1]); w0.y = pkbf(o0[2], o0[3]); ((v2u*)(XB + (size_t)t * DM))[lane + 64 * j] = w0;
            if (has2) { const f32x4 o1 = v1[j] * rs1 * gg + bb;
                v2u w1; w1.x = pkbf(o1[0], o1[1]); w1.y = pkbf(o1[2], o1[3]); ((v2u*)(XB + (size_t)t2 * DM))[lane + 64 * j] = w1; } }
    }
}

__device__ __forceinline__ void transpose_item(const float* W, int K, int N, bf16* WT, LAS float* scr, int item, int lane) {
    const int nblk = N / 32, kb = item / nblk, nb = item % nblk, k0 = 64 * kb, n0 = 32 * nb;
#pragma unroll 8
    for (int i = 0; i < 32; ++i) { const int kk = 2 * i + (lane >> 5); scr[kk * 33 + (lane & 31)] = W[(size_t)(k0 + kk) * N + n0 + (lane & 31)]; }
    LDS_WAIT();
    const int c = lane & 7;
#pragma unroll
    for (int j = 0; j < 4; ++j) { const int n = (lane >> 3) + 8 * j; const LAS float* s = scr + (8 * c) * 33 + n;
        v4u o; o.x = pkbf(s[0 * 33], s[1 * 33]); o.y = pkbf(s[2 * 33], s[3 * 33]); o.z = pkbf(s[4 * 33], s[5 * 33]); o.w = pkbf(s[6 * 33], s[7 * 33]);
        *(v4u*)(WT + (size_t)(n0 + n) * K + k0 + 8 * c) = o; }
    LDS_WAIT();
}

__device__ __forceinline__ void p0_prologue(const Frame& F, CArgs& A) {
    {
        LAS float* scr = (LAS float*)(F.lds + F.wave * 16384);
        constexpr int I_IN = (DM / 64) * (INW / 32), I_OUT = (DM / 64) * (DM / 32), I_GLU = (512 / 64) * (512 / 32);
        constexpr int NITEMS = NLAYER * (I_IN + I_OUT + I_GLU);
        for (int it = F.gw; it < NITEMS; it += F.NGW) {
            int r = it;
            if (r < NLAYER * I_IN) { const int l = r / I_IN; transpose_item(GIN(A, I_WIN) + (size_t)l * DM * INW, DM, INW, (bf16*)(F.ws + WS_WIN) + (size_t)l * INW * DM, scr, r % I_IN, F.lane); continue; }
            r -= NLAYER * I_IN;
            if (r < NLAYER * I_OUT) { const int l = r / I_OUT; transpose_item(GIN(A, I_WOUT) + (size_t)l * DM * DM, DM, DM, (bf16*)(F.ws + WS_WOUT) + (size_t)l * DM * DM, scr, r % I_OUT, F.lane); continue; }
            r -= NLAYER * I_OUT;
            { const int l = r / I_GLU; transpose_item(GIN(A, I_WGLU) + (size_t)l * 512 * 512, 512, 512, (bf16*)(F.ws + WS_WGLU) + (size_t)l * 512 * 512, scr, r % I_GLU, F.lane); }
        }
    }
    {
        const int NR2 = 2 * NLAYER * NEXP;
        for (int r = F.gw; r < NR2; r += 2 * F.NGW) {
            const int r2 = r + F.NGW < NR2 ? r + F.NGW : r;
            const int tabA = r >= NLAYER * NEXP, riA = tabA ? r - NLAYER * NEXP : r, tabB = r2 >= NLAYER * NEXP, riB = tabB ? r2 - NLAYER * NEXP : r2;
            const float* srcA = (tabA ? GIN(A, I_PV) : GIN(A, I_PU)) + (size_t)riA * DM + F.lane * 4; const float* srcB = (tabB ? GIN(A, I_PV) : GIN(A, I_PU)) + (size_t)riB * DM + F.lane * 4;
            f32x4 va[8], vb[8]; float ama = 0.f, amb = 0.f;
#pragma unroll
            for (int q = 0; q < 8; ++q) va[q] = *(const f32x4*)(srcA + q * 256);
#pragma unroll
            for (int q = 0; q < 8; ++q) vb[q] = *(const f32x4*)(srcB + q * 256);
#pragma unroll
            for (int q = 0; q < 8; ++q) { ama = fmaxf(ama, fmaxf(fmaxf(fabsf(va[q][0]), fabsf(va[q][1])), fmaxf(fabsf(va[q][2]), fabsf(va[q][3])))); amb = fmaxf(amb, fmaxf(fmaxf(fabsf(vb[q][0]), fabsf(vb[q][1])), fmaxf(fabsf(vb[q][2]), fabsf(vb[q][3])))); }
#pragma unroll
            for (int o = 1; o < 64; o <<= 1) { ama = fmaxf(ama, __shfl_xor(ama, o)); amb = fmaxf(amb, __shfl_xor(amb, o)); }
#pragma unroll
            for (int half = 0; half < 2; ++half) {
                if (half == 1 && r2 == r) break;
                const float am = half ? amb : ama; const int tab = half ? tabB : tabA, ri = half ? riB : riA;
                const float sc = am > 0.f ? 6.0f / am : 1.0f, isc = am > 0.f ? am * (1.0f / 6.0f) : 1.0f;
                v4u w;
#pragma unroll
                for (int q = 0; q < 4; ++q) { const f32x4 e0 = half ? vb[2 * q] : va[2 * q], e1 = half ? vb[2 * q + 1] : va[2 * q + 1]; unsigned pk = 0u;
                    pk = __builtin_amdgcn_cvt_scalef32_pk_fp4_f32(pk, e0[0] * sc, e0[1] * sc, 1.0f, 0); pk = __builtin_amdgcn_cvt_scalef32_pk_fp4_f32(pk, e0[2] * sc, e0[3] * sc, 1.0f, 1);
                    pk = __builtin_amdgcn_cvt_scalef32_pk_fp4_f32(pk, e1[0] * sc, e1[1] * sc, 1.0f, 2); pk = __builtin_amdgcn_cvt_scalef32_pk_fp4_f32(pk, e1[2] * sc, e1[3] * sc, 1.0f, 3);
                    w[q] = pk; }
                *(v4u*)(F.ws + (tab ? WS_V8 : WS_U8) + (size_t)ri * (DM / 2) + F.lane * 16) = w;
                if (F.lane == 0) ((float*)(F.ws + (tab ? WS_VSC : WS_USC)))[ri] = isc;
            }
        }
    }
    {
        const float* pw = GIN(A, I_POOLW); v4u* dst = (v4u*)(F.ws + WS_WPOOL);
        for (size_t i = F.gtid; i < (size_t)NLAYER * 512 * 64; i += F.NT) {
            const int k8 = (int)(i & 63), n = (int)((i >> 6) & 511), l = (int)(i >> 15);
            const int g = n >> 7, d = n & 127, kg = k8 >> 4, c0 = (k8 & 15) * 8;
            float f[8];
#pragma unroll
            for (int k = 0; k < 8; ++k) f[k] = (kg == g) ? pw[(((size_t)l * 4 + g) * 128 + (c0 + k)) * 128 + d] : 0.f;
            dst[i] = pack8(f);
        }
    }
    {
        const float* lre = GIN(A, I_LAMRE); const float* lim = GIN(A, I_LAMIM); const float* lst = GIN(A, I_LOGSTEP); const float* bre = GIN(A, I_BRE); const float* bim = GIN(A, I_BIM);
        f32x2v* ab = (f32x2v*)(F.ws + WS_S5A); f32x2v* ab64 = (f32x2v*)(F.ws + WS_S5A + 512 * 1024); f32x2v* bb = (f32x2v*)(F.ws + WS_S5B);
        for (size_t i = F.gtid; i < (size_t)NLAYER * 2 * 32 * 64; i += F.NT) {
            const float lr = lre[i], li = lim[i], dt = expf(lst[i >> 6]);
            const float mag = expf(lr * dt), ar = mag * cosf(li * dt), ai = mag * sinf(li * dt);
            const float den = lr * lr + li * li;
            const float zr = ((ar - 1.0f) * lr + ai * li) / den, zi = (ai * lr - (ar - 1.0f) * li) / den;
            ab[i] = (f32x2v){ar, ai};
            const float m64 = expf(lr * dt * 64.0f), an = li * dt * 64.0f;
            ab64[i] = (f32x2v){m64 * cosf(an), m64 * sinf(an)};
#pragma unroll
            for (int c = 0; c < 16; ++c) { const float br = bre[i * 16 + c], bi = bim[i * 16 + c]; bb[i * 16 + c] = (f32x2v){zr * br - zi * bi, zr * bi + zi * br}; }
            {
                bf16* o = (bf16*)(F.ws + WS_S5BB) + ((size_t)(i >> 6) * 128 + 2 * (i & 63)) * 32;
#pragma unroll
                for (int c = 0; c < 16; ++c) { const float br = bre[i * 16 + c], bi = bim[i * 16 + c]; o[c] = f2bf(zr * br - zi * bi); o[32 + c] = f2bf(zr * bi + zi * br); o[16 + c] = 0; o[48 + c] = 0; }
            }
        }
    }
    {
        float* rc = (float*)(F.ws + WS_ROTC); float* rs = (float*)(F.ws + WS_ROTS);
        for (size_t i = F.gtid; i < (size_t)8192 * 128; i += F.NT) { const float inv = (float)exp(-(double)(i & 127) / 127.0 * 9.210340371976184); const float ang = (float)(i >> 7) * inv; rc[i] = cosf(ang); rs[i] = sinf(ang); }
    }
    __syncthreads();
    {
        LAS float* KS = (LAS float*)F.lds;
        LAS float* WQ = (LAS float*)(F.lds + 128 * 132 * 4);
        const float* keys = GIN(A, I_KEYS); const float* wq = GIN(A, I_WQ); bf16* wst = (bf16*)(F.ws + WS_WS);
        for (int u = F.bx; u < NLAYER * 16 * 32; u += F.G) {
            const int dtl = u & 31, hp = (u >> 5) & 15, l = u >> 9, p = hp & 1;
#pragma unroll
            for (int r = 0; r < 8; ++r) { const int f = F.tid + 512 * r, nk = f >> 5, c4 = f & 31;
                *(LAS f32x4*)(KS + nk * 132 + c4 * 4) = *(const f32x4*)(keys + (((size_t)l * 2 + p) * 128 + nk) * 128 + c4 * 4); }
#pragma unroll
            for (int r = 0; r < 4; ++r) { const int f = F.tid + 512 * r, dd = f >> 5, c4 = f & 31;
                *(LAS f32x4*)(WQ + dd * 132 + c4 * 4) = *(const f32x4*)(wq + ((size_t)l * DM + dtl * 64 + dd) * DM + hp * 128 + c4 * 4); }
            __syncthreads();
            const int nk = F.tid & 127, dg = F.tid >> 7;
            float acc[16];
#pragma unroll
            for (int i = 0; i < 16; ++i) acc[i] = 0.f;
            for (int c4 = 0; c4 < 32; ++c4) {
                const f32x4 kv = *(const LAS f32x4*)(KS + nk * 132 + c4 * 4);
#pragma unroll
                for (int i = 0; i < 16; ++i) { const f32x4 wv = *(const LAS f32x4*)(WQ + (dg * 16 + i) * 132 + c4 * 4);
                    acc[i] += (kv[0] * wv[0] + kv[1] * wv[1]) + (kv[2] * wv[2] + kv[3] * wv[3]); }
            }
            bf16* o = wst + ((size_t)l * DM + hp * 128 + nk) * DM + dtl * 64 + dg * 16;
            v4u q0, q1; q0.x = pkbf(acc[0], acc[1]); q0.y = pkbf(acc[2], acc[3]); q0.z = pkbf(acc[4], acc[5]); q0.w = pkbf(acc[6], acc[7]);
            q1.x = pkbf(acc[8], acc[9]); q1.y = pkbf(acc[10], acc[11]); q1.z = pkbf(acc[12], acc[13]); q1.w = pkbf(acc[14], acc[15]);
            *(v4u*)o = q0; *(v4u*)(o + 8) = q1;
            __syncthreads();
        }
    }
    {
        const float* xp = GIN(A, I_XP); const float* xs = GIN(A, I_XS); const float* g = GIN(A, I_LNIN_G); const float* b = GIN(A, I_LNIN_B); bf16* XB = (bf16*)(F.ws + WS_XN);
        for (int t = F.gw; t < NTOK; t += 2 * F.NGW) {
            const int t2 = t + F.NGW; const bool has2 = t2 < NTOK; const int tb = has2 ? t2 : t;
            const float* s0p = t < 32768 ? xp + (size_t)t * DM : xs + (size_t)(t - 32768) * DM; const float* s1p = tb < 32768 ? xp + (size_t)tb * DM : xs + (size_t)(tb - 32768) * DM;
            f32x4 v0[8], v1[8]; float s0 = 0.f, s1 = 0.f;
#pragma unroll
            for (int j = 0; j < 8; ++j) v0[j] = ((const f32x4*)s0p)[F.lane + 64 * j];
#pragma unroll
            for (int j = 0; j < 8; ++j) v1[j] = ((const f32x4*)s1p)[F.lane + 64 * j];
#pragma unroll
            for (int j = 0; j < 8; ++j) { s0 += (v0[j][0] + v0[j][1]) + (v0[j][2] + v0[j][3]); s1 += (v1[j][0] + v1[j][1]) + (v1[j][2] + v1[j][3]); }
            const float m0 = wave_sum(s0) * (1.0f / DM), m1 = wave_sum(s1) * (1.0f / DM); float q0 = 0.f, q1 = 0.f;
#pragma unroll
            for (int j = 0; j < 8; ++j) { v0[j] = v0[j] - m0; v1[j] = v1[j] - m1;
                q0 += (v0[j][0] * v0[j][0] + v0[j][1] * v0[j][1]) + (v0[j][2] * v0[j][2] + v0[j][3] * v0[j][3]); q1 += (v1[j][0] * v1[j][0] + v1[j][1] * v1[j][1]) + (v1[j][2] * v1[j][2] + v1[j][3] * v1[j][3]); }
            const float rs0 = 1.0f / sqrtf(wave_sum(q0) * (1.0f / DM) + LN_EPS), rs1 = 1.0f / sqrtf(wave_sum(q1) * (1.0f / DM) + LN_EPS);
#pragma unroll
            for (int j = 0; j < 8; ++j) { const f32x4 gg = ((const f32x4*)g)[F.lane + 64 * j], bb = ((const f32x4*)b)[F.lane + 64 * j];
                const f32x4 o0 = v0[j] * rs0 * gg + bb;
                v2u w0; w0.x = pkbf(o0[0], o0[1]); w0.y = pkbf(o0[2], o0[3]); ((v2u*)(XB + (size_t)t * DM))[F.lane + 64 * j] = w0;
                if (has2) { const f32x4 o1 = v1[j] * rs1 * gg + bb;
                    v2u w1; w1.x = pkbf(o1[0], o1[1]); w1.y = pkbf(o1[2], o1[3]); ((v2u*)(XB + (size_t)t2 * DM))[F.lane + 64 * j] = w1; } }
        }
    }
}

__device__ __forceinline__ float ret_log2_gamma(int h) { return log2f(1.0f - exp2f(-5.0f - (float)h)); }

__device__ __forceinline__ void s5_pass1(const Frame& F, CArgs& A, int l) {
    LAS float* BUs = (LAS float*)(F.lds + F.wave * 8448);
    const bf16* H = (const bf16*)(F.ws + WS_H);
    const f32x2v* ab = (const f32x2v*)(F.ws + WS_S5A); const bf16* BB = (const bf16*)(F.ws + WS_S5BB);
    f32x2v* st = (f32x2v*)(F.ws + WS_S5ST);
    const int lane = F.lane, lr = lane & 15, lq = lane >> 4;
    const int gstep = F.G < 32 ? F.G : 32;
    for (int g = F.bx % 32; g < 32; g += gstep) {
        const int nwg = F.G < 32 ? 1 : (F.G - g + 31) / 32, rank = F.G < 32 ? 0 : F.bx / 32;
        bf16x8 Bop[2][8]; f32x2v a2[2], arot[2];
#pragma unroll
        for (int dir = 0; dir < 2; ++dir) { const int gi = (l * 2 + dir) * 32 + g; a2[dir] = ab[gi * 64 + lane]; arot[dir] = (f32x2v){-a2[dir][1], a2[dir][1]};
#pragma unroll
            for (int j = 0; j < 8; ++j) Bop[dir][j] = *(const bf16x8*)(BB + ((size_t)gi * 128 + 16 * j + lr) * 32 + lq * 8); }
        for (int ck = rank * NWAVES + F.wave; ck < 640; ck += nwg * NWAVES) {
            bf16x8 uop[4];
#pragma unroll
            for (int tb = 0; tb < 4; ++tb) { const v4u q = lq < 2 ? *(const v4u*)(H + (size_t)(ck * 64 + 16 * tb + lr) * INW + COL_UA + g * 16 + lq * 8) : (v4u){0u, 0u, 0u, 0u}; uop[tb] = __builtin_bit_cast(bf16x8, q); }
#pragma unroll
            for (int dir = 0; dir < 2; ++dir) {
                f32x2v x2 = (f32x2v){0.f, 0.f};
#pragma unroll
                for (int blk = 0; blk < 4; ++blk) {
                    const int tb = dir ? 3 - blk : blk;
#pragma unroll
                    for (int j = 0; j < 8; ++j) { const f32x4 d = MFMA16(Bop[dir][j], uop[tb], ((f32x4){0.f, 0.f, 0.f, 0.f}));
                        *(LAS f32x4*)(BUs + lr * 132 + 16 * j + 4 * lq) = d; }
                    LDS_WAIT();
#pragma unroll
                    for (int s = 0; s < 16; ++s) { const int tl = dir ? 15 - s : s;
                        const f32x2v bu = *(const LAS f32x2v*)(BUs + tl * 132 + 2 * lane);
                        x2 = x2 * a2[dir][0] + (arot[dir] * (f32x2v){x2[1], x2[0]} + bu); }
                    LDS_WAIT();
                }
                st[(size_t)((ck * 32 + g) * 2 + dir) * 64 + lane] = x2;
            }
        }
    }
}
__device__ __forceinline__ void s5_carry(const Frame& F, CArgs& A, int l) {
    const f32x2v* ab64 = (const f32x2v*)(F.ws + WS_S5A + 512 * 1024); f32x2v* st = (f32x2v*)(F.ws + WS_S5ST);
    for (size_t it = F.gtid; it < (size_t)9 * 32 * 2 * 64; it += F.NT) {
        const int p = (int)(it & 63), dir = (int)((it >> 6) & 1), g = (int)((it >> 7) & 31), s = (int)(it >> 12);
        const int ck0 = s < 8 ? s * 64 : 512, n = s < 8 ? 64 : 128;
        const f32x2v a = ab64[((l * 2 + dir) * 32 + g) * 64 + p];
        float cr = 0.f, ci = 0.f;
        for (int k0 = 0; k0 < n; k0 += 8) {
            f32x2v le[8];
#pragma unroll
            for (int kk = 0; kk < 8; ++kk) { const int ck = dir ? (ck0 + n - 1 - (k0 + kk)) : (ck0 + k0 + kk); le[kk] = st[(size_t)((ck * 32 + g) * 2 + dir) * 64 + p]; }
#pragma unroll
            for (int kk = 0; kk < 8; ++kk) { const int ck = dir ? (ck0 + n - 1 - (k0 + kk)) : (ck0 + k0 + kk);
                st[(size_t)((ck * 32 + g) * 2 + dir) * 64 + p] = (f32x2v){cr, ci};
                const float ncr = a[0] * cr - a[1] * ci + le[kk][0], nci = a[0] * ci + a[1] * cr + le[kk][1]; cr = ncr; ci = nci; }
        }
    }
}
__device__ __forceinline__ void s5_pass3(const Frame& F, CArgs& A, int l) {
    LAS bf16* CtS = (LAS bf16*)F.lds;
    LAS unsigned char* wb = F.lds + 8704 + F.wave * 12800;
    LAS float* BUs = (LAS float*)wb;
    LAS bf16* Xw = (LAS bf16*)(wb + 8448);
    const bf16* H = (const bf16*)(F.ws + WS_H); bf16* BY = (bf16*)(F.ws + WS_BUFY);
    const f32x2v* ab = (const f32x2v*)(F.ws + WS_S5A); const bf16* BB = (const bf16*)(F.ws + WS_S5BB);
    const f32x2v* st = (const f32x2v*)(F.ws + WS_S5ST);
    const float* cre = GIN(A, I_CRE); const float* cim = GIN(A, I_CIM); const float* dvec = GIN(A, I_S5D) + (size_t)l * 512;
    const int lane = F.lane, lr = lane & 15, lq = lane >> 4;
    const int gstep = F.G < 32 ? F.G : 32;
    for (int g = F.bx % 32; g < 32; g += gstep) {
        const int nwg = F.G < 32 ? 1 : (F.G - g + 31) / 32, rank = F.G < 32 ? 0 : F.bx / 32;
        __syncthreads();
        {
            const int tq = opaque(F.tid);
#pragma unroll
            for (int r = 0; r < 8; ++r) { const int e = tq + 512 * r, pp = e & 127, c = (e >> 7) & 15, dir = e >> 11;
                const size_t cb = (size_t)(((l * 2 + dir) * 32 + g) * 16 + c) * 64;
                CtS[(dir * 16 + c) * 136 + pp] = f2bf(pp < 64 ? cre[cb + pp] : -cim[cb + pp - 64]); }
        }
        bf16x8 Bop[2][8]; f32x2v a2[2], arot[2];
#pragma unroll
        for (int dir = 0; dir < 2; ++dir) { const int gi = (l * 2 + dir) * 32 + g; a2[dir] = ab[gi * 64 + lane]; arot[dir] = (f32x2v){-a2[dir][1], a2[dir][1]};
#pragma unroll
            for (int j = 0; j < 8; ++j) Bop[dir][j] = *(const bf16x8*)(BB + ((size_t)gi * 128 + 16 * j + lr) * 32 + lq * 8); }
        __syncthreads();
        for (int ck = rank * NWAVES + F.wave; ck < 640; ck += nwg * NWAVES) {
            bf16x8 uop[4];
#pragma unroll
            for (int tb = 0; tb < 4; ++tb) { const v4u q = lq < 2 ? *(const v4u*)(H + (size_t)(ck * 64 + 16 * tb + lr) * INW + COL_UA + g * 16 + lq * 8) : (v4u){0u, 0u, 0u, 0u}; uop[tb] = __builtin_bit_cast(bf16x8, q); }
            f32x2v xin[2];
#pragma unroll
            for (int dir = 0; dir < 2; ++dir) xin[dir] = st[(size_t)((ck * 32 + g) * 2 + dir) * 64 + lane];
            f32x4 Y[4];
#pragma unroll
            for (int m = 0; m < 4; ++m) Y[m] = (f32x4){0.f, 0.f, 0.f, 0.f};
#pragma unroll
            for (int dir = 0; dir < 2; ++dir) {
                f32x2v x2 = xin[dir];
#pragma unroll
                for (int blk = 0; blk < 4; ++blk) {
                    const int tb = dir ? 3 - blk : blk;
#pragma unroll
                    for (int j = 0; j < 8; ++j) { const f32x4 d = MFMA16(Bop[dir][j], uop[tb], ((f32x4){0.f, 0.f, 0.f, 0.f}));
                        *(LAS f32x4*)(BUs + lr * 132 + 16 * j + 4 * lq) = d; }
                    LDS_WAIT();
#pragma unroll
                    for (int s = 0; s < 16; ++s) { const int tl = dir ? 15 - s : s;
                        const f32x2v bu = *(const LAS f32x2v*)(BUs + tl * 132 + 2 * lane);
                        x2 = x2 * a2[dir][0] + (arot[dir] * (f32x2v){x2[1], x2[0]} + bu);
                        Xw[tl * 136 + lane] = f2bf(x2[0]); Xw[tl * 136 + 64 + lane] = f2bf(x2[1]); }
                    LDS_WAIT();
#pragma unroll
                    for (int ks = 0; ks < 4; ++ks) {
                        const bf16x8 av = *(const LAS bf16x8*)(CtS + (dir * 16 + lr) * 136 + 32 * ks + lq * 8);
                        const bf16x8 bv = *(const LAS bf16x8*)(Xw + lr * 136 + 32 * ks + lq * 8);
                        Y[tb] = MFMA16(av, bv, Y[tb]);
                    }
                    LDS_WAIT();
                }
            }
#pragma unroll
            for (int m = 0; m < 4; ++m) {
                const int t = 16 * m + lr, c0 = 4 * lq;
                const v2u uq = *(const v2u*)(H + (size_t)(ck * 64 + t) * INW + COL_UA + g * 16 + c0);
                const f32x4 uv = (f32x4){bf_lo(uq.x), bf_hi(uq.x), bf_lo(uq.y), bf_hi(uq.y)}; const f32x4 dv = *(const f32x4*)(dvec + g * 16 + c0);
                const f32x4 y = Y[m] + dv * uv;
                v2u w; w.x = pkbf(gelu_erf(y[0]), gelu_erf(y[1])); w.y = pkbf(gelu_erf(y[2]), gelu_erf(y[3]));
                *(v2u*)(BY + (size_t)(ck * 64 + t) * 512 + g * 16 + c0) = w;
            }
        }
    }
}
__device__ __forceinline__ void pool_phase(const Frame& F, CArgs& A) {
    const bf16* H = (const bf16*)(F.ws + WS_H); bf16* BP = (bf16*)(F.ws + WS_BUFP);
    for (size_t it = F.gtid; it < (size_t)NTOK * 64; it += F.NT) {
        const int t = (int)(it >> 6), o = (int)(it & 63), gi = o >> 4, w = 2 << gi;
        const int pos = tok_pos(t), L = tok_len(t);
        const int lo = max(pos - w / 2, 0), hi = min(pos + w / 2 - 1, L - 1);
        const bf16* base = H + (size_t)(t - pos) * INW + COL_UB + o * 8;
        float s[8];
#pragma unroll
        for (int k = 0; k < 8; ++k) s[k] = 0.f;
        v4u wq[16];
#pragma unroll
        for (int i = 0; i < 16; ++i) { const int si = lo + i <= hi ? lo + i : hi; wq[i] = *(const v4u*)(base + (size_t)si * INW); }
#pragma unroll
        for (int i = 0; i < 16; ++i) { float f[8]; unpack8(wq[i], f); const float wgt = lo + i <= hi ? 1.0f : 0.0f;
#pragma unroll
            for (int k = 0; k < 8; ++k) s[k] += wgt * f[k]; }
        const float inv = 1.0f / (float)(hi - lo + 1);
        float c[8]; unpack8(*(const v4u*)(base + (size_t)pos * INW), c);
#pragma unroll
        for (int k = 0; k < 8; ++k) s[k] = s[k] * inv - c[k];
        *(v4u*)(BP + (size_t)t * 512 + o * 8) = pack8(s);
    }
}
constexpr int RS = 136;
template <int MODE = 0> __device__ __forceinline__ void ret_state_phase(const Frame& F, CArgs& A) {
    const bf16* H = (const bf16*)(F.ws + WS_H); bf16* STF = (bf16*)(F.ws + WS_STF); bf16* STB = (bf16*)(F.ws + WS_STB);
    LAS bf16* Kt = (LAS bf16*)F.lds; LAS bf16* VtF = Kt + 128 * RS; LAS bf16* VtB = Kt + 256 * RS;
    LAS unsigned* Kt32 = (LAS unsigned*)Kt; LAS unsigned* VtF32 = (LAS unsigned*)VtF; LAS unsigned* VtB32 = (LAS unsigned*)VtB;
    const int tid = F.tid, lane = F.lane, lr = lane & 15, lq = lane >> 4, we = F.wave >> 1, wd = F.wave & 1;
    const int jp = tid & 63, j = 2 * jp, pc0 = tid >> 6;
    v4u pk0[2], pk1[2], pv0[2], pv1[2];
#define RS_LOAD(u_) do { const int dh_ = (u_) & 1, eh_ = ((u_) >> 1) & 1, h_ = ((u_) >> 2) & 3, c_ = (u_) >> 4; \
        const bf16* krow_ = H + (size_t)(c_ * 128 + j) * INW + COL_K + h_ * 256 + dh_ * 128; const bf16* vrow_ = H + (size_t)(c_ * 128 + j) * INW + COL_V + h_ * 256 + eh_ * 128; \
        _Pragma("unroll") for (int r = 0; r < 2; ++r) { const int pc = pc0 + 8 * r; pk0[r] = *(const v4u*)(krow_ + pc * 8); pk1[r] = *(const v4u*)(krow_ + INW + pc * 8); pv0[r] = *(const v4u*)(vrow_ + pc * 8); pv1[r] = *(const v4u*)(vrow_ + INW + pc * 8); } } while (0)
    if (F.bx < 5120) RS_LOAD(F.bx);
    for (int u = F.bx; u < 5120; u += F.G) {
        const int dh = u & 1, eh = (u >> 1) & 1, h = (u >> 2) & 3, c = u >> 4;
        if (MODE != 2) {
            const float lg = ret_log2_gamma(h), fF0 = exp2f(lg * (float)(127 - j)), fF1 = exp2f(lg * (float)(126 - j)), fB0 = exp2f(lg * (float)j), fB1 = exp2f(lg * (float)(j + 1));
#pragma unroll
            for (int r = 0; r < 2; ++r) {
                const int pc = pc0 + 8 * r;
                const unsigned ka0[4] = {pk0[r].x, pk0[r].y, pk0[r].z, pk0[r].w}, ka1[4] = {pk1[r].x, pk1[r].y, pk1[r].z, pk1[r].w};
                float f0[8], f1[8]; unpack8(pv0[r], f0); unpack8(pv1[r], f1);
#pragma unroll
                for (int i = 0; i < 8; ++i) {
                    const unsigned a = ka0[i >> 1], b = ka1[i >> 1];
                    const unsigned kk = (i & 1) ? ((a >> 16) | (b & 0xffff0000u)) : ((a & 0xffffu) | (b << 16));
                    const int o = ((pc * 8 + i) * RS) / 2 + jp;
                    Kt32[o] = kk; VtF32[o] = pkbf(f0[i] * fF0, f1[i] * fF1); VtB32[o] = pkbf(f0[i] * fB0, f1[i] * fB1);
                }
            }
        }
        __syncthreads();
        if (u + F.G < 5120) RS_LOAD(u + F.G);
        if (MODE == 1) { __syncthreads(); continue; }
        f32x4 aF[4][2], aB[4][2];
#pragma unroll
        for (int td = 0; td < 4; ++td)
#pragma unroll
            for (int te = 0; te < 2; ++te) { aF[td][te] = (f32x4){0.f, 0.f, 0.f, 0.f}; aB[td][te] = (f32x4){0.f, 0.f, 0.f, 0.f}; }
#pragma unroll
        for (int ks = 0; ks < 4; ++ks) {
            bf16x8 ka[4], vF[2], vB[2];
#pragma unroll
            for (int td = 0; td < 4; ++td) ka[td] = *(const LAS bf16x8*)(Kt + (64 * wd + 16 * td + lr) * RS + 32 * ks + lq * 8);
#pragma unroll
            for (int te = 0; te < 2; ++te) { vF[te] = *(const LAS bf16x8*)(VtF + (32 * we + 16 * te + lr) * RS + 32 * ks + lq * 8); vB[te] = *(const LAS bf16x8*)(VtB + (32 * we + 16 * te + lr) * RS + 32 * ks + lq * 8); }
#pragma unroll
            for (int td = 0; td < 4; ++td)
#pragma unroll
                for (int te = 0; te < 2; ++te) { aF[td][te] = MFMA16(ka[td], vF[te], aF[td][te]); aB[td][te] = MFMA16(ka[td], vB[te], aB[td][te]); }
        }
        __syncthreads();
        {
            LAS bf16* OutF = Kt; LAS bf16* OutB = Kt + 128 * RS;
#pragma unroll
            for (int td = 0; td < 4; ++td)
#pragma unroll
                for (int te = 0; te < 2; ++te) {
                    const int e = 32 * we + 16 * te + lr, d = 64 * wd + 16 * td + 4 * lq;
                    v2u w; w.x = pkbf(aF[td][te][0], aF[td][te][1]); w.y = pkbf(aF[td][te][2], aF[td][te][3]); *(LAS v2u*)(OutF + e * RS + d) = w;
                    v2u x; x.x = pkbf(aB[td][te][0], aB[td][te][1]); x.y = pkbf(aB[td][te][2], aB[td][te][3]); *(LAS v2u*)(OutB + e * RS + d) = x;
                }
            __syncthreads();
            const int tq = opaque(tid);
#pragma unroll
            for (int r = 0; r < 8; ++r) { const int f = tq + 512 * r, mat = f >> 11, row = (f >> 4) & 127, pc = f & 15;
                const v4u q = *(const LAS v4u*)(Kt + (mat * 128 + row) * RS + pc * 8);
                bf16* dst = (mat ? STB : STF) + ((size_t)(c * 4 + h) * 256 + eh * 128 + row) * 256 + dh * 128 + pc * 8;
                *(v4u*)dst = q; }
        }
        __syncthreads();
    }
#undef RS_LOAD
}
__device__ __forceinline__ void ret_prefix_phase(const Frame& F, CArgs& A) {
    bf16* STF = (bf16*)(F.ws + WS_STF); bf16* STB = (bf16*)(F.ws + WS_STB);
    for (size_t it = F.gtid; it < (size_t)36 * 2 * 8192; it += F.NT) {
        const int o = (int)(it & 8191), which = (int)((it >> 13) & 1), bh = (int)(it >> 14), h = bh & 3, s = bh >> 2;
        const int c0 = s < 8 ? s * 32 : 256, n = s < 8 ? 32 : 64;
        const float dec = exp2f(128.0f * ret_log2_gamma(h));
        float st[8];
#pragma unroll
        for (int k = 0; k < 8; ++k) st[k] = 0.f;
        bf16* base = (which ? STB : STF) + (size_t)h * 65536 + (size_t)o * 8;
        for (int k0 = 0; k0 < n; k0 += 8) {
            v4u q[8];
#pragma unroll
            for (int kk = 0; kk < 8; ++kk) { const int c = which ? (c0 + n - 1 - (k0 + kk)) : (c0 + k0 + kk); q[kk] = *(const v4u*)(base + (size_t)c * 4 * 65536); }
#pragma unroll
            for (int kk = 0; kk < 8; ++kk) { const int c = which ? (c0 + n - 1 - (k0 + kk)) : (c0 + k0 + kk);
                float f[8]; unpack8(q[kk], f);
#pragma unroll
                for (int i = 0; i < 8; ++i) st[i] = dec * st[i] + f[i];
                *(v4u*)(base + (size_t)c * 4 * 65536) = pack8(st); }
        }
    }
}
__device__ __forceinline__ void ret_out_phase(const Frame& F, CArgs& A) {
    const bf16* H = (const bf16*)(F.ws + WS_H); const bf16* STF = (const bf16*)(F.ws + WS_STF); const bf16* STB = (const bf16*)(F.ws + WS_STB);
    bf16* CC = (bf16*)(F.ws + WS_CONCAT);
    LAS bf16* RA = (LAS bf16*)F.lds; LAS bf16* RB = RA + 128 * RS; LAS bf16* RC = RA + 384 * RS;
    const int tid = F.tid, wi = F.wave >> 2, wj = F.wave & 3, we = F.wave & 3;
    for (int u = F.bx; u < 1280; u += F.G) {
        const int lane = opaque(F.lane), lr = lane & 15, lq = lane >> 4;
        const int h = u & 3, c = u >> 2, t0 = c * 128;
        const int cs = c < 256 ? (c & 31) : (c - 256), ncs = c < 256 ? 32 : 64;
        const bool has_f = cs > 0, has_b = cs < ncs - 1;
        const float lg = ret_log2_gamma(h);
        const int tq = opaque(tid);
        v4u pa[4], pb[8];
#define RO_LOAD_QK(dh_) do { _Pragma("unroll") for (int r = 0; r < 4; ++r) { const int f = tq + 512 * r, row = f >> 4, pc = f & 15; \
            const bf16* src = H + (size_t)(t0 + row) * INW + h * 256 + (dh_) * 128 + pc * 8; pa[r] = *(const v4u*)(src + COL_Q); pb[r] = *(const v4u*)(src + COL_K); } } while (0)
#define RO_STORE_QK() do { _Pragma("unroll") for (int r = 0; r < 4; ++r) { const int f = tq + 512 * r, row = f >> 4, pc = f & 15; \
            *(LAS v4u*)(RA + row * RS + pc * 8) = pa[r]; *(LAS v4u*)(RB + row * RS + pc * 8) = pb[r]; } } while (0)
#define RO_LOAD_V() do { const int jp_ = tq & 63, pc0_ = tq >> 6; const bf16* vrow = H + (size_t)(t0 + 2 * jp_) * INW + COL_V + h * 256; \
            _Pragma("unroll") for (int r = 0; r < 4; ++r) { const int pc = pc0_ + 8 * r; pb[r] = *(const v4u*)(vrow + pc * 8); pb[4 + r] = *(const v4u*)(vrow + INW + pc * 8); } } while (0)
#define RO_STORE_V() do { const int jp_ = tq & 63, pc0_ = tq >> 6; LAS unsigned* RB32 = (LAS unsigned*)RB; \
            _Pragma("unroll") for (int r = 0; r < 4; ++r) { const int pc = pc0_ + 8 * r; \
                const unsigned va0[4] = {pb[r].x, pb[r].y, pb[r].z, pb[r].w}, va1[4] = {pb[4 + r].x, pb[4 + r].y, pb[4 + r].z, pb[4 + r].w}; \
                _Pragma("unroll") for (int i = 0; i < 8; ++i) { const unsigned a = va0[i >> 1], b = va1[i >> 1]; \
                    RB32[((pc * 8 + i) * RS) / 2 + jp_] = (i & 1) ? ((a >> 16) | (b & 0xffff0000u)) : ((a & 0xffffu) | (b << 16)); } } } while (0)
#define RO_LOAD_I(dir_, dh_) do { const bool has_ = (dir_) == 0 ? has_f : has_b; const int cn_ = (dir_) == 0 ? c - 1 : c + 1; \
            const bf16* St = ((dir_) == 0 ? STF : STB) + (size_t)((has_ ? cn_ : c) * 4 + h) * 65536; \
            _Pragma("unroll") for (int r = 0; r < 8; ++r) { const int f = tq + 512 * r, row = f >> 4, pc = f & 15; pb[r] = has_ ? *(const v4u*)(St + (size_t)row * 256 + (dh_) * 128 + pc * 8) : (v4u){0u, 0u, 0u, 0u}; } } while (0)
#define RO_STORE_I(dir_, dh_) do { \
            _Pragma("unroll") for (int r = 0; r < 4; ++r) { const int f = tq + 512 * r, row = f >> 4, pc = f & 15; pa[r] = *(const v4u*)(H + (size_t)(t0 + row) * INW + COL_Q + h * 256 + (dh_) * 128 + pc * 8); } \
            _Pragma("unroll") for (int r = 0; r < 4; ++r) { const int f = tq + 512 * r, row = f >> 4, pc = f & 15; \
                const float fac = exp2f(lg * ((dir_) == 0 ? (float)(row + 1) : (float)(128 - row))); float qf[8]; unpack8(pa[r], qf); \
                _Pragma("unroll") for (int k = 0; k < 8; ++k) qf[k] *= fac; \
                *(LAS v4u*)(RA + row * RS + pc * 8) = pack8(qf); } \
            _Pragma("unroll") for (int r = 0; r < 8; ++r) { const int f = tq + 512 * r, row = f >> 4, pc = f & 15; *(LAS v4u*)(RB + row * RS + pc * 8) = pb[r]; } } while (0)
        f32x4 S[4][2];
#pragma unroll
        for (int ti = 0; ti < 4; ++ti)
#pragma unroll
            for (int tj = 0; tj < 2; ++tj) S[ti][tj] = (f32x4){0.f, 0.f, 0.f, 0.f};
        RO_LOAD_QK(0);
#pragma unroll
        for (int dh = 0; dh < 2; ++dh) {
            if (dh) __syncthreads();
            RO_STORE_QK();
            __syncthreads();
            if (dh == 0) RO_LOAD_QK(1); else RO_LOAD_V();
#pragma unroll
            for (int ks = 0; ks < 4; ++ks) {
                bf16x8 ka[2], qb[4];
#pragma unroll
                for (int tj = 0; tj < 2; ++tj) ka[tj] = *(const LAS bf16x8*)(RB + (32 * wj + 16 * tj + lr) * RS + 32 * ks + lq * 8);
#pragma unroll
                for (int ti = 0; ti < 4; ++ti) qb[ti] = *(const LAS bf16x8*)(RA + (64 * wi + 16 * ti + lr) * RS + 32 * ks + lq * 8);
#pragma unroll
                for (int ti = 0; ti < 4; ++ti)
#pragma unroll
                    for (int tj = 0; tj < 2; ++tj) S[ti][tj] = MFMA16(ka[tj], qb[ti], S[ti][tj]);
            }
        }
#pragma unroll
        for (int ti = 0; ti < 4; ++ti)
#pragma unroll
            for (int tj = 0; tj < 2; ++tj) {
                const int i = 64 * wi + 16 * ti + lr, j0 = 32 * wj + 16 * tj + 4 * lq; float p[4];
#pragma unroll
                for (int jj = 0; jj < 4; ++jj) { const int d = i - (j0 + jj); p[jj] = S[ti][tj][jj] * exp2f(lg * (float)(d < 0 ? -d : d)); }
                v2u w; w.x = pkbf(p[0], p[1]); w.y = pkbf(p[2], p[3]); *(LAS v2u*)(RC + i * RS + j0) = w;
            }
        __syncthreads();
        RO_STORE_V();
        __syncthreads();
        RO_LOAD_I(0, 0);
        f32x4 O[4][4];
#pragma unroll
        for (int ti = 0; ti < 4; ++ti)
#pragma unroll
            for (int te = 0; te < 4; ++te) O[ti][te] = (f32x4){0.f, 0.f, 0.f, 0.f};
#pragma unroll
        for (int ks = 0; ks < 4; ++ks) {
            bf16x8 va[4], pbf[4];
#pragma unroll
            for (int te = 0; te < 4; ++te) va[te] = *(const LAS bf16x8*)(RB + (64 * we + 16 * te + lr) * RS + 32 * ks + lq * 8);
#pragma unroll
            for (int ti = 0; ti < 4; ++ti) pbf[ti] = *(const LAS bf16x8*)(RC + (64 * wi + 16 * ti + lr) * RS + 32 * ks + lq * 8);
#pragma unroll
            for (int ti = 0; ti < 4; ++ti)
#pragma unroll
                for (int te = 0; te < 4; ++te) O[ti][te] = MFMA16(va[te], pbf[ti], O[ti][te]);
        }
#pragma unroll
        for (int stg = 0; stg < 4; ++stg) {
            __syncthreads();
            if (stg == 0) RO_STORE_I(0, 0); else if (stg == 1) RO_STORE_I(0, 1); else if (stg == 2) RO_STORE_I(1, 0); else RO_STORE_I(1, 1);
            __syncthreads();
            if (stg == 0) RO_LOAD_I(0, 1); else if (stg == 1) RO_LOAD_I(1, 0); else if (stg == 2) RO_LOAD_I(1, 1);
#pragma unroll
            for (int ks = 0; ks < 4; ++ks) {
                bf16x8 sa[4], qb[4];
#pragma unroll
                for (int te = 0; te < 4; ++te) sa[te] = *(const LAS bf16x8*)(RB + (64 * we + 16 * te + lr) * RS + 32 * ks + lq * 8);
#pragma unroll
                for (int ti = 0; ti < 4; ++ti) qb[ti] = *(const LAS bf16x8*)(RA + (64 * wi + 16 * ti + lr) * RS + 32 * ks + lq * 8);
#pragma unroll
                for (int ti = 0; ti < 4; ++ti)
#pragma unroll
                    for (int te = 0; te < 4; ++te) O[ti][te] = MFMA16(sa[te], qb[ti], O[ti][te]);
            }
        }
#undef RO_LOAD_QK
#undef RO_STORE_QK
#undef RO_LOAD_V
#undef RO_STORE_V
#undef RO_LOAD_I
#undef RO_STORE_I
        __syncthreads();
        LAS float* RED = (LAS float*)RA;
#pragma unroll
        for (int ti = 0; ti < 4; ++ti) { float s1 = 0.f, s2 = 0.f;
#pragma unroll
            for (int te = 0; te < 4; ++te)
#pragma unroll
                for (int jj = 0; jj < 4; ++jj) { const float v = O[ti][te][jj]; s1 += v; s2 += v * v; }
            s1 += __shfl_xor(s1, 16); s1 += __shfl_xor(s1, 32); s2 += __shfl_xor(s2, 16); s2 += __shfl_xor(s2, 32);
            if (lq == 0) { RED[((64 * wi + 16 * ti + lr) * 4 + we) * 2] = s1; RED[((64 * wi + 16 * ti + lr) * 4 + we) * 2 + 1] = s2; } }
        __syncthreads();
        LAS bf16* ON = RB;
#pragma unroll
        for (int ti = 0; ti < 4; ++ti) { const int i = 64 * wi + 16 * ti + lr;
            const f32x4 r0 = *(const LAS f32x4*)(RED + i * 8), r1 = *(const LAS f32x4*)(RED + i * 8 + 4);
            const float m = (r0[0] + r0[2] + r1[0] + r1[2]) * (1.0f / 256.0f), q = (r0[1] + r0[3] + r1[1] + r1[3]) * (1.0f / 256.0f);
            const float var = fmaxf(q - m * m, 0.f), rstd = 1.0f / sqrtf(var + GN_EPS);
#pragma unroll
            for (int te = 0; te < 4; ++te) { const int e0 = 64 * we + 16 * te + 4 * lq;
                v2u w; w.x = pkbf((O[ti][te][0] - m) * rstd, (O[ti][te][1] - m) * rstd); w.y = pkbf((O[ti][te][2] - m) * rstd, (O[ti][te][3] - m) * rstd);
                *(LAS v2u*)(ON + i * 264 + e0) = w; } }
        __syncthreads();
        {
            const int tq2 = opaque(tid);
#pragma unroll
            for (int r = 0; r < 8; ++r) { const int f = tq2 + 512 * r, row = f >> 5, pc = f & 31;
                float ov[8], gv[8]; unpack8(*(const LAS v4u*)(ON + row * 264 + pc * 8), ov); unpack8(*(const v4u*)(H + (size_t)(t0 + row) * INW + COL_G + h * 256 + pc * 8), gv);
#pragma unroll
                for (int k = 0; k < 8; ++k) ov[k] = (gv[k] / (1.0f + __expf(-gv[k]))) * ov[k];
                *(v4u*)(CC + (size_t)(t0 + row) * DM + 1024 + h * 256 + pc * 8) = pack8(ov); }
        }
        __syncthreads();
    }
}

__device__ __forceinline__ unsigned f2key(float f) { const unsigned u = __float_as_uint(f); return (u & 0x80000000u) ? ~u : (u | 0x80000000u); }
__device__ __forceinline__ float key2f(unsigned k) { const unsigned u = (k & 0x80000000u) ? (k & 0x7fffffffu) : ~k; return __uint_as_float(u); }
#define TK_CE(a, b) do { const unsigned hi_ = (a) > (b) ? (a) : (b), lo_ = (a) > (b) ? (b) : (a); (a) = hi_; (b) = lo_; } while (0)
__device__ __forceinline__ void bitonic_merge16(unsigned (&v)[16]) {
#pragma unroll
    for (int j = 8; j > 0; j >>= 1)
#pragma unroll
        for (int i = 0; i < 16; ++i) { const int l = i ^ j; if (l > i) TK_CE(v[i], v[l]); }
}
__device__ __forceinline__ void bitonic_sort16(unsigned (&v)[16]) {
#pragma unroll
    for (int k = 2; k <= 16; k <<= 1)
#pragma unroll
        for (int j = k >> 1; j > 0; j >>= 1)
#pragma unroll
            for (int i = 0; i < 16; ++i) { const int l = i ^ j; if (l > i) { if ((i & k) == 0) TK_CE(v[i], v[l]); else TK_CE(v[l], v[i]); } }
}
__device__ __forceinline__ void topk_phase(const Frame& F, CArgs& A) {
    const _Float16* SC = (const _Float16*)(F.ws + WS_H); int* IDX = (int*)(F.ws + WS_IDX); float* GATE = (float*)(F.ws + WS_GATE);
    typedef _Float16 h8 __attribute__((ext_vector_type(8)));
    LAS unsigned* LK = (LAS unsigned*)F.lds;
    const int tid = F.tid, tl = tid >> 4, hp = tid & 15;
    for (int blk = F.bx; blk < NTOK / 32; blk += F.G) {
        const int t = blk * 32 + tl;
        const _Float16* row = SC + (size_t)t * DM + hp * 128;
        unsigned run[16];
#pragma unroll
        for (int k = 0; k < 16; ++k) run[k] = 0u;
        h8 cur[16];
#pragma unroll
        for (int q = 0; q < 16; ++q) cur[q] = *(const h8*)(row + q * 8);
#pragma unroll
        for (int c16 = 0; c16 < 8; ++c16) {
            unsigned ch[16];
#pragma unroll
            for (int q = 0; q < 2; ++q)
#pragma unroll
                for (int e = 0; e < 8; ++e) { const int n = c16 * 16 + q * 8 + e; ch[q * 8 + e] = (f2key((float)cur[c16 * 2 + q][e]) & ~127u) | (unsigned)(127 - n); }
            bitonic_sort16(ch);
#pragma unroll
            for (int i = 0; i < 16; ++i) run[i] = run[i] > ch[15 - i] ? run[i] : ch[15 - i];
            bitonic_merge16(run);
        }
#pragma unroll
        for (int k = 0; k < 16; ++k) LK[tid * 17 + k] = run[k];
        __syncthreads();
        if ((hp & 1) == 0) {
            float a[16], b[16];
#pragma unroll
            for (int k = 0; k < 16; ++k) { a[k] = key2f(LK[tid * 17 + k] & ~127u); b[k] = key2f(LK[(tid + 1) * 17 + k] & ~127u); }
            unsigned sk[16];
#pragma unroll
            for (int k = 0; k < 16; ++k) sk[k] = 0u;
#pragma unroll
            for (int i = 0; i < 16; ++i)
#pragma unroll
                for (int j = 0; j < 16; ++j) if ((i + 1) * (j + 1) <= 16) {
                    unsigned key = (f2key(a[i] + b[j]) & ~255u) | (unsigned)(255 - (i * 16 + j));
#pragma unroll
                    for (int k = 0; k < 16; ++k) { const unsigned hi = sk[k] > key ? sk[k] : key, lo = sk[k] > key ? key : sk[k]; sk[k] = hi; key = lo; }
                }
            float e[16], sum = 0.f; const float s0 = key2f(sk[0] & ~255u);
#pragma unroll
            for (int k = 0; k < 16; ++k) { e[k] = __expf(key2f(sk[k] & ~255u) - s0); sum += e[k]; }
            const float inv = 1.0f / sum; const int head = hp >> 1;
#pragma unroll
            for (int k = 0; k < 16; ++k) {
                const int cell = 255 - (int)(sk[k] & 255u);
                const int i1 = 127 - (int)(LK[tid * 17 + (cell >> 4)] & 127u), i2 = 127 - (int)(LK[(tid + 1) * 17 + (cell & 15)] & 127u);
                IDX[(size_t)t * 128 + head * 16 + k] = i1 * 128 + i2;
                GATE[(size_t)t * 128 + head * 16 + k] = e[k] * inv;
            }
        }
        __syncthreads();
    }
}
typedef int v8i __attribute__((ext_vector_type(8)));
__device__ __forceinline__ void peer_gather_phase(const Frame& F, CArgs& A, int l, float* xdst_base, bf16* XN) {
    constexpr int RB = DM / 2;
    constexpr int GNR = GATHER_ROWS;
    const unsigned char* U8 = F.ws + WS_U8 + (size_t)l * NEXP * RB; const unsigned char* V8 = F.ws + WS_V8 + (size_t)l * NEXP * RB;
    const float* USC = (const float*)(F.ws + WS_USC) + (size_t)l * NEXP; const float* VSC = (const float*)(F.ws + WS_VSC) + (size_t)l * NEXP;
    const int* IDX = (const int*)(F.ws + WS_IDX); const float* GATE = (const float*)(F.ws + WS_GATE);
    const float* g2 = GIN(A, I_LN2G) + (size_t)l * DM; const float* b2 = GIN(A, I_LN2B) + (size_t)l * DM;
    LAS unsigned char* XF8 = F.lds + F.wave * 2560;
    LAS float* HS = (LAS float*)(F.lds + F.wave * 2560 + 2048);
    const int lane = F.lane, lr = lane & 15, lq = lane >> 4;
    for (int t = F.gw; t < NTOK; t += F.NGW) {
        const bf16* xrow = XN + (size_t)t * DM;
        {
            v4u w0, w1;
#pragma unroll
            for (int j = 0; j < 8; ++j) { const v2u a = *(const v2u*)(xrow + j * 256 + lane * 4); int pk = 0;
                pk = __builtin_amdgcn_cvt_pk_fp8_f32(bf_lo(a.x), bf_hi(a.x), pk, false); pk = __builtin_amdgcn_cvt_pk_fp8_f32(bf_lo(a.y), bf_hi(a.y), pk, true);
                if (j < 4) w0[j] = (unsigned)pk; else w1[j - 4] = (unsigned)pk; }
            *(LAS v4u*)(XF8 + lane * 32) = w0; *(LAS v4u*)(XF8 + lane * 32 + 16) = w1;
        }
        const int idx0 = IDX[(size_t)t * 128 + lane], idx1 = IDX[(size_t)t * 128 + 64 + lane];
        const float gate0 = GATE[(size_t)t * 128 + lane], gate1 = GATE[(size_t)t * 128 + 64 + lane];
        const float usc0 = USC[idx0], usc1 = USC[idx1], vsc0 = VSC[idx0], vsc1 = VSC[idx1];
        unsigned rowoff[8];
#pragma unroll
        for (int g = 0; g < 8; ++g) rowoff[g] = (unsigned)__shfl((g >> 2) ? idx1 : idx0, (g & 3) * 16 + lr) * (unsigned)RB + (unsigned)lq * 16u;
        v4u AB[8][2];
#pragma unroll
        for (int g = 0; g < 8; ++g) { AB[g][0] = *(const v4u*)(U8 + rowoff[g]); AB[g][1] = *(const v4u*)(U8 + rowoff[g] + 64); }
        f32x4 hacc[8];
#pragma unroll
        for (int g = 0; g < 8; ++g) hacc[g] = (f32x4){0.f, 0.f, 0.f, 0.f};
        LDS_WAIT();
#pragma unroll 1
        for (int kp = 0; kp < 8; ++kp) {
            const LAS unsigned char* xq = XF8 + ((2 * kp) * 4 + (lq >> 1)) * 32 + 16 * (lq & 1);
            const v4u b00 = *(const LAS v4u*)xq, b01 = *(const LAS v4u*)(xq + 64), b10 = *(const LAS v4u*)(xq + 128), b11 = *(const LAS v4u*)(xq + 192);
            const v8i B0 = (v8i){(int)b00[0], (int)b00[1], (int)b00[2], (int)b00[3], (int)b01[0], (int)b01[1], (int)b01[2], (int)b01[3]};
            const v8i B1 = (v8i){(int)b10[0], (int)b10[1], (int)b10[2], (int)b10[3], (int)b11[0], (int)b11[1], (int)b11[2], (int)b11[3]};
#pragma unroll
            for (int g = 0; g < 8; ++g) {
                const v8i A0 = (v8i){(int)AB[g][0][0], (int)AB[g][0][1], (int)AB[g][0][2], (int)AB[g][0][3], 0, 0, 0, 0};
                const v8i A1 = (v8i){(int)AB[g][1][0], (int)AB[g][1][1], (int)AB[g][1][2], (int)AB[g][1][3], 0, 0, 0, 0};
                hacc[g] = __builtin_amdgcn_mfma_scale_f32_16x16x128_f8f6f4(A0, B0, hacc[g], 4, 0, 0, 0x7f7f7f7f, 0, 0x7f7f7f7f);
                hacc[g] = __builtin_amdgcn_mfma_scale_f32_16x16x128_f8f6f4(A1, B1, hacc[g], 4, 0, 0, 0x7f7f7f7f, 0, 0x7f7f7f7f);
                if (kp < 7) { AB[g][0] = *(const v4u*)(U8 + rowoff[g] + (kp + 1) * 128); AB[g][1] = *(const v4u*)(U8 + rowoff[g] + (kp + 1) * 128 + 64); }
            }
        }
        if (lr == 0) {
#pragma unroll
            for (int g = 0; g < 8; ++g) *(LAS f32x4*)(HS + g * 16 + 4 * lq) = hacc[g];
        }
        LDS_WAIT();
        const float hval0 = HS[lane], hval1 = HS[64 + lane];
        const float w0 = gate0 * gelu_erf(hval0 * usc0) * vsc0, w1 = gate1 * gelu_erf(hval1 * usc1) * vsc1;
        v4u BU[GNR];
        const unsigned loff = (unsigned)lane * 16u;
#define G_ROW_V(R) (V8 + (size_t)(unsigned)__builtin_amdgcn_readlane((((R) >> 6) & 1) ? idx1 : idx0, (R) & 63) * RB)
#define G_REQ(r, rowptr) do { BU[r] = *(const v4u*)((rowptr) + loff); } while (0)
#pragma unroll
        for (int r = 0; r < GNR; ++r) G_REQ(r, G_ROW_V(r));
        f32x2v acc[16];
#pragma unroll
        for (int k = 0; k < 16; ++k) acc[k] = (f32x2v){0.f, 0.f};
#define G_AXPY(r, R) do { const float w_ = __uint_as_float((unsigned)__builtin_amdgcn_readlane((int)__float_as_uint((((R) >> 6) & 1) ? w1 : w0), (R) & 63)); const f32x2v w2_ = (f32x2v){w_, w_}; \
            _Pragma("unroll") for (int q = 0; q < 4; ++q) { acc[4 * q] += w2_ * __builtin_amdgcn_cvt_scalef32_pk_f32_fp4(BU[r][q], 1.0f, 0); acc[4 * q + 1] += w2_ * __builtin_amdgcn_cvt_scalef32_pk_f32_fp4(BU[r][q], 1.0f, 1); \
                acc[4 * q + 2] += w2_ * __builtin_amdgcn_cvt_scalef32_pk_f32_fp4(BU[r][q], 1.0f, 2); acc[4 * q + 3] += w2_ * __builtin_amdgcn_cvt_scalef32_pk_f32_fp4(BU[r][q], 1.0f, 3); } } while (0)
        for (int it = 0; it < 128 / GNR - 1; ++it) {
#pragma unroll
            for (int r = 0; r < GNR; ++r) { G_AXPY(r, GNR * it + r); G_REQ(r, G_ROW_V(GNR * (it + 1) + r)); }
        }
#pragma unroll
        for (int r = 0; r < GNR; ++r) G_AXPY(r, 128 - GNR + r);
#undef G_ROW_V
#undef G_REQ
#undef G_AXPY
        const int le = opaque(lane);
        float s = 0.f;
#pragma unroll
        for (int j = 0; j < 8; ++j) { const v2u xr = *(const v2u*)(xrow + j * 256 + le * 4);
            acc[2 * j] = (f32x2v){bf_lo(xr.x), bf_hi(xr.x)} * ALPHA + acc[2 * j]; acc[2 * j + 1] = (f32x2v){bf_lo(xr.y), bf_hi(xr.y)} * ALPHA + acc[2 * j + 1];
            s += (acc[2 * j][0] + acc[2 * j][1]) + (acc[2 * j + 1][0] + acc[2 * j + 1][1]); }
        const float mean = wave_sum(s) * (1.0f / DM); float s2 = 0.f;
#pragma unroll
        for (int k = 0; k < 16; ++k) { acc[k] = acc[k] - mean; s2 += acc[k][0] * acc[k][0] + acc[k][1] * acc[k][1]; }
        const float rstd = 1.0f / sqrtf(wave_sum(s2) * (1.0f / DM) + LN_EPS);
#pragma unroll
        for (int j = 0; j < 8; ++j) { const int col = j * 256 + le * 4;
            const f32x4 gg = *(const f32x4*)(g2 + col), bb = *(const f32x4*)(b2 + col);
            const f32x2v a0 = acc[2 * j], a1 = acc[2 * j + 1];
            const f32x4 o = (f32x4){a0[0] * rstd * gg[0] + bb[0], a0[1] * rstd * gg[1] + bb[1], a1[0] * rstd * gg[2] + bb[2], a1[1] * rstd * gg[3] + bb[3]};
            if (xdst_base) *(f32x4*)(xdst_base + (size_t)t * DM + col) = o;
            v2u w; w.x = pkbf(o[0], o[1]); w.y = pkbf(o[2], o[3]); *(v2u*)(XN + (size_t)t * DM + col) = w; }
        LDS_WAIT();
    }
}

#ifndef DUP_MASK
#define DUP_MASK 0
#endif
#ifndef PHASE_TEST_ONLY
__global__ void __launch_bounds__(NTHR, 2) fwd_kernel(Args A) {
    extern __shared__ __attribute__((aligned(16))) unsigned char lds_raw[];
#define MKFRAME() Frame F; CArgs& KA = *(CArgs*)opaque_u64((unsigned long long)__builtin_amdgcn_kernarg_segment_ptr()); { F.lds = (LAS unsigned char*)lds_raw; F.tid = opaque((int)threadIdx.x); F.lane = F.tid & 63; F.wave = __builtin_amdgcn_readfirstlane(F.tid >> 6); \
        const int bx_ = opaque_s((int)blockIdx.x); F.G = gridDim.x; F.gw = bx_ * NWAVES + F.wave; F.NGW = F.G * NWAVES; F.gtid = (size_t)bx_ * NTHR + F.tid; F.NT = (size_t)F.G * NTHR; F.out = (float*)(float GAS*)opaque_g((unsigned char GAS*)KA.out); F.ws = (unsigned char*)opaque_g(KA.ws); F.bx = bx_; } \
        bf16* XN = (bf16*)(F.ws + WS_XN); bf16* H = (bf16*)(F.ws + WS_H); bf16* CC = (bf16*)(F.ws + WS_CONCAT); (void)XN; (void)H; (void)CC;
    volatile LAS unsigned* MISC = (volatile LAS unsigned*)((LAS unsigned char*)lds_raw + LDS_MISC);
    if (threadIdx.x < 64) MISC[threadIdx.x] = 0u;
    __syncthreads();
    XcdBarrier bar = xcd_barrier_post((unsigned*)(A.ws + WS_CTL) + CW_BAR + A.li * XCD_BAR_WORDS, MISC + 8);
    const int lo = A.ph_lo, hi = A.ph_hi;
#define IN(k) (lo <= (k) && (k) < hi)
#define SEAM(k) do { if (lo <= (k) && (k) + 1 < hi) xcd_barrier(bar); } while (0)

    if (IN(0)) { MKFRAME(); p0_prologue(F, KA); if (DUP_MASK & 256) { __syncthreads(); p0_prologue(F, KA); } } SEAM(0);

    for (int l = 0; l < NLAYER; ++l) {
        const int pb = 1 + l * 10;
        if (IN(pb + 0)) { MKFRAME();
            pg8::Gemm g{XN, (const bf16*)(F.ws + WS_WIN) + (size_t)l * INW * DM, NTOK, INW, DM}; pg8::StaticOrder S; S.init(NTOK, INW, F.G, F.bx);
            EpiStoreRot E{H, INW, (const float*)(F.ws + WS_ROTC), (const float*)(F.ws + WS_ROTS)};
            pg8::gemm_phase<EpiStoreRot, pg8::StaticOrder, true, true>(F.lds, g, S, E);
            if (DUP_MASK & 64) { pg8::gemm_phase<EpiStoreRot, pg8::StaticOrder, true, true>(F.lds, g, S, E); }
        } SEAM(pb + 0);
        if (IN(pb + 1)) { MKFRAME(); s5_pass1(F, KA, l); pool_phase(F, KA); if (DUP_MASK & 1) { s5_pass1(F, KA, l); } if (DUP_MASK & 2) { pool_phase(F, KA); } } SEAM(pb + 1);
        if (IN(pb + 2)) { MKFRAME(); s5_carry(F, KA, l); __syncthreads(); ret_state_phase(F, KA); if (DUP_MASK & 4) { ret_state_phase(F, KA); } if (DUP_MASK & 2048) { ret_state_phase<1>(F, KA); } if (DUP_MASK & 4096) { ret_state_phase<2>(F, KA); ret_state_phase(F, KA); } } SEAM(pb + 2);
        if (IN(pb + 3)) { MKFRAME(); s5_pass3(F, KA, l); if (DUP_MASK & 8) { s5_pass3(F, KA, l); } ret_prefix_phase(F, KA); } SEAM(pb + 3);
        if (IN(pb + 4)) { MKFRAME();
            __syncthreads();
            ret_out_phase(F, KA);
            if (DUP_MASK & 16) { ret_out_phase(F, KA); }
            {
                pg8::Gemm g{(const bf16*)(F.ws + WS_BUFY), (const bf16*)(F.ws + WS_WGLU) + (size_t)l * 512 * 512, NTOK, 512, 512}; pg8::StaticOrder S; S.init(NTOK, 512, F.G, F.bx);
                EpiGlu E{(const bf16*)(F.ws + WS_BUFY), 512, CC, DM, GIN(KA, I_BGLU) + (size_t)l * 512};
                pg8::gemm_phase<EpiGlu, pg8::StaticOrder, true, true>(F.lds, g, S, E);
                if (DUP_MASK & 512) { pg8::gemm_phase<EpiGlu, pg8::StaticOrder, true, true>(F.lds, g, S, E); }
            }
            {
                pg8::Gemm g{(const bf16*)(F.ws + WS_BUFP), (const bf16*)(F.ws + WS_WPOOL) + (size_t)l * 512 * 512, NTOK, 512, 512}; pg8::StaticOrder S; S.init(NTOK, 512, F.G, F.bx);
                EpiScaleBf16 E{CC + 512, DM, GIN(KA, I_POOLS) + (size_t)l * 512};
                pg8::gemm_phase<EpiScaleBf16, pg8::StaticOrder, true, true>(F.lds, g, S, E);
                if (DUP_MASK & 512) { pg8::gemm_phase<EpiScaleBf16, pg8::StaticOrder, true, true>(F.lds, g, S, E); }
            }
        } SEAM(pb + 4);
        if (IN(pb + 5)) { MKFRAME();
            pg8::Gemm g{CC, (const bf16*)(F.ws + WS_WOUT) + (size_t)l * DM * DM, NTOK, DM, DM}; pg8::StaticOrder S; S.init(NTOK, DM, F.G, F.bx);
            EpiStoreBf16 E{H, DM};
            pg8::gemm_phase<EpiStoreBf16, pg8::StaticOrder, true, true>(F.lds, g, S, E);
        } SEAM(pb + 5);
        if (IN(pb + 6)) { MKFRAME();
            ln_rows2(XN, H, ALPHA, GIN(KA, I_LN1G) + (size_t)l * DM, GIN(KA, I_LN1B) + (size_t)l * DM, F.gw, F.NGW, F.lane);
        } SEAM(pb + 6);
        if (IN(pb + 7)) { MKFRAME();
            pg8::Gemm g{XN, (const bf16*)(F.ws + WS_WS) + (size_t)l * DM * DM, NTOK, DM, DM}; pg8::StaticOrder S; S.init(NTOK, DM, F.G, F.bx);
            EpiStoreF16 E{(_Float16*)(F.ws + WS_H), DM};
            pg8::gemm_phase<EpiStoreF16, pg8::StaticOrder, true, true>(F.lds, g, S, E);
            if (DUP_MASK & 128) { pg8::gemm_phase<EpiStoreF16, pg8::StaticOrder, true, true>(F.lds, g, S, E); }
        } SEAM(pb + 7);
        if (IN(pb + 8)) { MKFRAME(); __syncthreads(); topk_phase(F, KA); if (DUP_MASK & 32) { topk_phase(F, KA); } } SEAM(pb + 8);
        if (IN(pb + 9)) { MKFRAME(); if (DUP_MASK & 1024) { peer_gather_phase(F, KA, l, (float*)(F.ws + WS_H), CC); } peer_gather_phase(F, KA, l, l == NLAYER - 1 ? F.out : (float*)nullptr, XN); } SEAM(pb + 9);
    }
#undef IN
#undef SEAM
}


#ifndef DBG_STOP
#define DBG_STOP NPHASE
#endif
#ifndef MK_ONE_LAUNCH
#define MK_ONE_LAUNCH 0
#endif
extern "C" void kernel_launch(void* const* d_in, const int* in_sizes, int n_in, void* d_out, int out_size, void* d_ws, size_t ws_size, hipStream_t stream) {
    static int grid = 0;
    if (grid == 0) {
        if (n_in != 26 || out_size != NTOK * DM || ws_size < WS_END) { fprintf(stderr, "kernel_launch: unexpected shapes (n_in %d out %d ws %zu)\n", n_in, out_size, ws_size); grid = -1; return; }
        int dev = 0, cus = 0, per_cu = 0;
        if (hipGetDevice(&dev) != hipSuccess || hipDeviceGetAttribute(&cus, hipDeviceAttributeMultiprocessorCount, dev) != hipSuccess) { grid = -1; return; }
        if (hipFuncSetAttribute((const void*)fwd_kernel, hipFuncAttributeMaxDynamicSharedMemorySize, LDS_BYTES) != hipSuccess) { fprintf(stderr, "kernel_launch: hipFuncSetAttribute failed\n"); grid = -1; return; }
        if (hipOccupancyMaxActiveBlocksPerMultiprocessor(&per_cu, (const void*)fwd_kernel, NTHR, LDS_BYTES) != hipSuccess || per_cu < 1) { fprintf(stderr, "kernel_launch: occupancy query says %d\n", per_cu); grid = -1; (void)hipGetLastError(); return; }
        (void)hipGetLastError();
        grid = cus;
    }
    if (grid < 0) return;
    if (hipMemsetAsync((char*)d_ws + WS_CTL, 0, CTL_ZERO_BYTES, stream) != hipSuccess) return;
    Args a{};
    for (int i = 0; i < 26; ++i) a.in[i] = (const float*)d_in[i];
    a.out = (float*)d_out; a.ws = (unsigned char*)d_ws; a.pad = 0;
#if MK_ONE_LAUNCH
    a.ph_lo = 0; a.ph_hi = NPHASE; a.li = 0;
    hipLaunchKernelGGL(fwd_kernel, dim3(grid), dim3(NTHR), LDS_BYTES, stream, a);
#else
    for (int p = 0; p < DBG_STOP; ++p) { a.ph_lo = p; a.ph_hi = p + 1; a.li = p; hipLaunchKernelGGL(fwd_kernel, dim3(grid), dim3(NTHR), LDS_BYTES, stream, a); }
#endif
}
#endif
```

```cpp
#include <hip/hip_runtime.h>
#include <cstdio>
#include <cstdint>
#include <cmath>
__device__ __forceinline__ int opaque(int v) { asm volatile("" : "+v"(v)); return v; }
__device__ __forceinline__ int opaque_s(int v) { asm volatile("" : "+s"(v)); return v; }
__device__ __forceinline__ void* opaque_p(void* p) { asm volatile("" : "+s"(p)); return p; }
__device__ __forceinline__ unsigned long long opaque_u64(unsigned long long v) { asm volatile("" : "+s"(v)); return v; }
#ifndef GATHER_ROWS
#define GATHER_ROWS 16
#endif
__device__ __forceinline__ __attribute__((address_space(1))) unsigned char* opaque_g(__attribute__((address_space(1))) unsigned char* p) { asm volatile("" : "+s"(p)); return p; }
#define MK_ONE_LAUNCH 1
namespace pg8 {
#define PG8_LAS __attribute__((address_space(3)))
typedef unsigned short bf16_t;
typedef short bf16x8 __attribute__((ext_vector_type(8)));
typedef float f32x4 __attribute__((ext_vector_type(4)));
typedef unsigned u32x4 __attribute__((ext_vector_type(4)));
constexpr int BM = 256, BK = 64, HALF = 128, HTB = HALF * BK * 2  , STAGE_BYTES = 8 * HTB, NXCD = 8, WGM = 8;

__host__ __device__ __forceinline__ int lds_byte(int r, int c) { const int st = (r >> 4) * 2 + (c >> 5), rr = r & 15, cc = c & 31, ob = rr * 64 + cc * 2; return st * 1024 + (ob ^ (((ob >> 9) & 1) << 5)); }
__host__ __device__ __forceinline__ void stage_rc(int b, int& R, int& C) { const int st = b / 1024, sb = b % 1024, swz = sb ^ (((sb >> 9) & 1) << 5); R = (st >> 1) * 16 + swz / 64; C = (st & 1) * 32 + (swz % 64) / 2; }
__host__ __device__ __forceinline__ int perm32(int rho) { const int n = rho >> 4, i = rho & 15; return 8 * (i >> 2) + 4 * n + (i & 3); }

struct Unit { int pm, pn; };
struct Gemm { const bf16_t* A; const bf16_t* Bt; int M, N, K; };

struct StaticOrder {
    int nM, nN, nwg, G, c;
    __host__ __device__ void init(int M, int N, int G_, int c_) { nM = M / BM; nN = N / BM; nwg = nM * nN; G = G_; c = c_; }
    __host__ __device__ bool next(int i, Unit& u) const {
        const long L = (long)i * G + c; if (L >= nwg) return false;
        int wgid = (int)L; { const int q = nwg / NXCD, r = nwg % NXCD, xcd = wgid % NXCD, off = wgid / NXCD; wgid = (xcd < r ? xcd * (q + 1) : r * (q + 1) + (xcd - r) * q) + off; }
        const int nig = WGM * nN, gid = wgid / nig, fm = gid * WGM, gsz = (nM - fm) < WGM ? (nM - fm) : WGM;
        u.pm = fm + ((wgid % nig) % gsz); u.pn = (wgid % nig) / gsz; return true;
    }
    __device__ __forceinline__ void a_ready(const Unit&) const {}
    __device__ __forceinline__ void done(const Unit&) const {}
};
__device__ __forceinline__ unsigned cvt_pk_bf16(float lo, float hi) { unsigned r; asm volatile("v_cvt_pk_bf16_f32 %0, %1, %2" : "=v"(r) : "v"(lo), "v"(hi)); return r; }
typedef float f32x2 __attribute__((ext_vector_type(2)));
template <class Epi, class Sched, bool ALIGN_EPI = false, bool SP2 = false>
__device__ __forceinline__ void gemm_phase(PG8_LAS unsigned char* lds, const Gemm g, const Sched& S, const Epi& E) {
    const int tid = opaque((int)threadIdx.x), wid = __builtin_amdgcn_readfirstlane(tid >> 6), lane = tid & 63, wr = wid >> 2, wc = wid & 3, fr = lane & 15, fq = lane >> 4;
    const int K = g.K, nt = K / BK;
    unsigned voffA[2], voffB[2];
#pragma unroll
    for (int i = 0; i < 2; ++i) { int R, C; stage_rc(tid * 16 + i * 8192, R, C); const int Rb = Epi::PERM ? ((R & ~31) + perm32(R & 31)) : R;
        voffA[i] = (unsigned)(R * K + C) * 2u; voffB[i] = (unsigned)(Rb * K + C) * 2u; }
    const size_t kstep = (size_t)(BK * 2);
    const size_t hstep = (size_t)HALF * K * 2;
    const size_t tstep = 2 * hstep;
    const unsigned ldsw = (unsigned)wid * 1024u;
    const int aoff = lds_byte(wr * 64 + fr, fq * 8), boff = lds_byte(wc * 32 + fr, fq * 8);
#define PG8_SA(b, h) (((b) * 2 + (h)) * HTB)
#define PG8_SB(b, h) ((4 + (b) * 2 + (h)) * HTB)
#define PG8_STAGE(bufoff, gbase, voff) do { _Pragma("unroll") for (int _i = 0; _i < 2; ++_i) \
        __builtin_amdgcn_global_load_lds((const unsigned*)((const char*)(gbase) + (voff)[_i]), (PG8_LAS unsigned*)(lds + (bufoff) + ldsw + _i * 8192), 16, 0, 0); } while (0)
#define PG8_LDA(dst, b, h) do { _Pragma("unroll") for (int m = 0; m < 4; ++m) _Pragma("unroll") for (int k = 0; k < 2; ++k) dst[m][k] = *(const PG8_LAS bf16x8*)(lds + PG8_SA(b, h) + aoff + m * 2048 + k * 1024); } while (0)
#define PG8_LDB(dst, b, h) do { _Pragma("unroll") for (int n = 0; n < 2; ++n) _Pragma("unroll") for (int k = 0; k < 2; ++k) dst[n][k] = *(const PG8_LAS bf16x8*)(lds + PG8_SB(b, h) + boff + n * 2048 + k * 1024); } while (0)
#define PG8_MMA(ai, bj, At, Bt) do { __builtin_amdgcn_s_setprio(1); _Pragma("unroll") for (int m = 0; m < 4; ++m) _Pragma("unroll") for (int n = 0; n < 2; ++n) _Pragma("unroll") for (int k = 0; k < 2; ++k) \
        acc[ai][bj][m][n] = __builtin_amdgcn_mfma_f32_16x16x32_bf16(Bt[n][k], At[m][k], acc[ai][bj][m][n], 0, 0, 0); __builtin_amdgcn_s_setprio(0); } while (0)
#define PG8_WAIT_V(n) asm volatile("s_waitcnt vmcnt(" #n ")" ::: "memory")
#define PG8_WAIT_L(n) asm volatile("s_waitcnt lgkmcnt(" #n ")" ::: "memory")
#define PG8_BAR __builtin_amdgcn_s_barrier()
#define PG8_SCHED __builtin_amdgcn_sched_barrier(0)
    Unit cur, nxt; int ui = 0;
    if (!S.next(0, cur)) return;
    f32x4 acc[2][2][4][2];
#pragma unroll
    for (int a = 0; a < 2; ++a)
#pragma unroll
        for (int b = 0; b < 2; ++b)
#pragma unroll
            for (int m = 0; m < 4; ++m)
#pragma unroll
                for (int n = 0; n < 2; ++n) acc[a][b][m][n] = (f32x4){0.f, 0.f, 0.f, 0.f};
    bf16x8 At[4][2], B0[2][2], B1[2][2];
    const char* cA = (const char*)g.A + (size_t)cur.pm * tstep; const char* cB = (const char*)g.Bt + (size_t)cur.pn * tstep;
    S.a_ready(cur);
    if constexpr (SP2) {
        PG8_STAGE(PG8_SB(0, 0), cB, voffB); PG8_STAGE(PG8_SB(0, 1), cB + hstep, voffB); PG8_STAGE(PG8_SA(0, 0), cA, voffA); PG8_STAGE(PG8_SA(0, 1), cA + hstep, voffA);
        if (wr == 1) PG8_BAR;
        PG8_WAIT_V(2); PG8_BAR;
        PG8_STAGE(PG8_SB(1, 0), cB + kstep, voffB); PG8_STAGE(PG8_SA(1, 0), cA + kstep, voffA); PG8_STAGE(PG8_SB(1, 1), cB + hstep + kstep, voffB);
        PG8_WAIT_V(6); PG8_BAR;
    } else {
        PG8_STAGE(PG8_SB(0, 0), cB, voffB); PG8_STAGE(PG8_SA(0, 0), cA, voffA); PG8_STAGE(PG8_SB(0, 1), cB + hstep, voffB); PG8_STAGE(PG8_SA(0, 1), cA + hstep, voffA);
        if (wr == 1) PG8_BAR;
        PG8_WAIT_V(4); PG8_BAR;
        PG8_STAGE(PG8_SB(1, 0), cB + kstep, voffB); PG8_STAGE(PG8_SA(1, 0), cA + kstep, voffA); PG8_STAGE(PG8_SB(1, 1), cB + hstep + kstep, voffB);
        PG8_WAIT_V(6); PG8_BAR;
    }
    for (;;) {
        const bool has_next = S.next(ui + 1, nxt);
        const char* nA = has_next ? (const char*)g.A + (size_t)nxt.pm * tstep : cA; const char* nB = has_next ? (const char*)g.Bt + (size_t)nxt.pn * tstep : cB;
        for (int t = 0; t < nt; t += 2) {
            const bool last = (t == nt - 2);
            const char* a1 = cA + (size_t)(t + 1) * kstep;
            const char* a2 = last ? nA : cA + (size_t)(t + 2) * kstep; const char* b2 = last ? nB : cB + (size_t)(t + 2) * kstep;
            const char* a3 = a2 + kstep; const char* b3 = b2 + kstep;
            if (last && has_next) S.a_ready(nxt);
            if constexpr (SP2) {
            PG8_LDB(B0, 0, 0); PG8_LDB(B1, 0, 1); PG8_SCHED; PG8_LDA(At, 0, 0); PG8_STAGE(PG8_SA(1, 1), a1 + hstep, voffA);
            PG8_WAIT_V(8); PG8_WAIT_L(0); PG8_BAR; PG8_MMA(0, 0, At, B0); PG8_MMA(0, 1, At, B1); PG8_BAR; PG8_SCHED;
            PG8_LDA(At, 0, 1); PG8_STAGE(PG8_SB(0, 0), b2, voffB); PG8_STAGE(PG8_SB(0, 1), b2 + hstep, voffB); PG8_STAGE(PG8_SA(0, 0), a2, voffA);
            PG8_WAIT_V(8); PG8_WAIT_L(0); PG8_BAR; PG8_MMA(1, 0, At, B0); PG8_MMA(1, 1, At, B1); PG8_BAR; PG8_SCHED;
            PG8_LDB(B0, 1, 0); PG8_LDB(B1, 1, 1); PG8_SCHED; PG8_LDA(At, 1, 0); PG8_STAGE(PG8_SA(0, 1), a2 + hstep, voffA);
            PG8_WAIT_V(8); PG8_WAIT_L(0); PG8_BAR; PG8_MMA(0, 0, At, B0); PG8_MMA(0, 1, At, B1); PG8_BAR; PG8_SCHED;
            PG8_LDA(At, 1, 1); PG8_STAGE(PG8_SB(1, 0), b3, voffB); PG8_STAGE(PG8_SB(1, 1), b3 + hstep, voffB); PG8_STAGE(PG8_SA(1, 0), a3, voffA);
            PG8_WAIT_V(8); PG8_WAIT_L(0); PG8_BAR; PG8_MMA(1, 0, At, B0); PG8_MMA(1, 1, At, B1); PG8_BAR; PG8_SCHED;
            } else {
            PG8_LDB(B0, 0, 0); PG8_SCHED; PG8_LDA(At, 0, 0); PG8_STAGE(PG8_SA(1, 1), a1 + hstep, voffA);
            PG8_WAIT_L(8); PG8_BAR; PG8_WAIT_L(0); PG8_MMA(0, 0, At, B0); PG8_BAR; PG8_SCHED;
            PG8_LDB(B1, 0, 1); PG8_STAGE(PG8_SB(0, 0), b2, voffB);
            PG8_BAR; PG8_WAIT_L(0); PG8_MMA(0, 1, At, B1); PG8_BAR;
            PG8_LDA(At, 0, 1); PG8_STAGE(PG8_SA(0, 0), a2, voffA);
            PG8_BAR; PG8_WAIT_L(0); PG8_MMA(1, 0, At, B0); PG8_BAR; PG8_SCHED;
            PG8_STAGE(PG8_SB(0, 1), b2 + hstep, voffB);
            PG8_WAIT_V(6); PG8_BAR; PG8_MMA(1, 1, At, B1); PG8_BAR;
            PG8_LDB(B0, 1, 0); PG8_SCHED; PG8_LDA(At, 1, 0); PG8_STAGE(PG8_SA(0, 1), a2 + hstep, voffA);
            PG8_WAIT_L(8); PG8_BAR; PG8_WAIT_L(0); PG8_MMA(0, 0, At, B0); PG8_BAR; PG8_SCHED;
            PG8_LDB(B1, 1, 1); PG8_STAGE(PG8_SB(1, 0), b3, voffB);
            PG8_BAR; PG8_WAIT_L(0); PG8_MMA(0, 1, At, B1); PG8_BAR;
            PG8_LDA(At, 1, 1); PG8_STAGE(PG8_SA(1, 0), a3, voffA);
            PG8_BAR; PG8_WAIT_L(0); PG8_MMA(1, 0, At, B0); PG8_BAR; PG8_SCHED;
            PG8_STAGE(PG8_SB(1, 1), b3 + hstep, voffB);
            PG8_WAIT_V(6); PG8_BAR; PG8_MMA(1, 1, At, B1); PG8_BAR;
            }
        }
        if constexpr (ALIGN_EPI) { if (wr == 0) PG8_BAR; }
        if constexpr (!Epi::AFTER_DRAIN) { E(acc, cur, wr, wc, fr, fq); S.done(cur); }
        if (!has_next) break;
#pragma unroll
        for (int a = 0; a < 2; ++a)
#pragma unroll
            for (int b = 0; b < 2; ++b)
#pragma unroll
                for (int m = 0; m < 4; ++m)
#pragma unroll
                    for (int n = 0; n < 2; ++n) acc[a][b][m][n] = (f32x4){0.f, 0.f, 0.f, 0.f};
        cur = nxt; cA = nA; cB = nB; ++ui;
        if constexpr (ALIGN_EPI) { if (wr == 1) PG8_BAR; }
    }
    PG8_WAIT_V(0);
    if constexpr (!ALIGN_EPI) { if (wr == 0) PG8_BAR; }
    PG8_BAR;
    if constexpr (Epi::AFTER_DRAIN) { E.fused(acc, cur, wr, wc, fr, fq, lds, wid, lane); S.done(cur); }
#undef PG8_SA
#undef PG8_SB
#undef PG8_STAGE
#undef PG8_LDA
#undef PG8_LDB
#undef PG8_MMA
#undef PG8_WAIT_V
#undef PG8_WAIT_L
#undef PG8_BAR
#undef PG8_SCHED
}
}
#define LAS __attribute__((address_space(3)))
#define XB_TMO      128
#define XB_XCNT(j)  (256  + 64 * (j))
#define XB_XSUB(j)  (1280 + 64 * (j))
#define XB_XGEN(j)  (2304 + 64 * (j))
#define XB_TOP      3328
#define XB_TOPGEN   3392
#define XCD_BAR_WORDS 3456
#define XB_SPIN_CAP (1u << 18)

__device__ __forceinline__ unsigned xb_ld(unsigned* p)              { return __hip_atomic_load(p, __ATOMIC_RELAXED, __HIP_MEMORY_SCOPE_AGENT); }
__device__ __forceinline__ unsigned xb_add(unsigned* p, unsigned v) { return __hip_atomic_fetch_add(p, v, __ATOMIC_RELAXED, __HIP_MEMORY_SCOPE_AGENT); }
__device__ __forceinline__ unsigned xb_xcc_id() { return (unsigned)__builtin_amdgcn_s_getreg((3 << 11) | 20) & 0xFu; }
#define XB_SPIN(cond, bar) do { unsigned _sp = 0; while (cond) { __builtin_amdgcn_s_sleep(1); \
    if ((++_sp & 255u) == 0u) { if (xb_ld(&(bar)[XB_TMO])) break; if (_sp > XB_SPIN_CAP) { atomicAdd(&(bar)[XB_TMO], 1u); break; } } } } while (0)

struct XcdBarrier {
    unsigned* bar; unsigned x;
    volatile LAS unsigned* st;
};

__device__ __forceinline__ XcdBarrier xcd_barrier_post(unsigned* bar, volatile LAS unsigned* st) {
    XcdBarrier b; b.bar = bar; b.x = xb_xcc_id(); b.st = st;
    if (threadIdx.x == 0) (void)xb_add(&bar[XB_XCNT(b.x)], 1u);
    return b;
}
__device__ __forceinline__ void xcd_barrier_complete(unsigned* bar, unsigned x, unsigned& nloc, unsigned& nx) {
    const unsigned G = gridDim.x * gridDim.y * gridDim.z;
    unsigned sum, cnt, mine, sp = 0u;
    for (;;) {
        sum = 0u; cnt = 0u; mine = 0u;
#pragma unroll
        for (unsigned j = 0; j < 16; ++j) { const unsigned c = xb_ld(&bar[XB_XCNT(j)]); sum += c; cnt += (c > 0u) ? 1u : 0u; mine = (j == x) ? c : mine; }
        if (sum == G) break;
        __builtin_amdgcn_s_sleep(1);
        if ((++sp & 255u) == 0u) { if (xb_ld(&bar[XB_TMO])) break; if (sp > XB_SPIN_CAP) { atomicAdd(&bar[XB_TMO], 1u); break; } }
    }
    nloc = mine > 0u ? mine : 1u; nx = cnt > 0u ? cnt : 1u;
}

__device__ __forceinline__ void xcd_barrier(const XcdBarrier& b) {
    asm volatile("s_waitcnt vmcnt(0)" ::: "memory");
    __syncthreads();
    if (threadIdx.x == 0) {
        unsigned* bar = b.bar;
        __builtin_amdgcn_s_waitcnt(0);
        unsigned nloc = b.st[0], nx = b.st[1];
        if (nloc == 0u) { xcd_barrier_complete(bar, b.x, nloc, nx); b.st[0] = nloc; b.st[1] = nx; }
        const unsigned old = xb_add(&bar[XB_XSUB(b.x)], 1u);
        const unsigned gen = old / nloc;
        if (old + 1u == (gen + 1u) * nloc) {
            __builtin_amdgcn_fence(__ATOMIC_RELEASE, "agent");
            asm volatile("s_waitcnt vmcnt(0)" ::: "memory");
            const unsigned og = xb_add(&bar[XB_TOP], 1u);
            const unsigned tg = og / nx;
            if (og + 1u == (tg + 1u) * nx) xb_add(&bar[XB_TOPGEN], 1u);
            else XB_SPIN(xb_ld(&bar[XB_TOPGEN]) == tg, bar);
            __builtin_amdgcn_fence(__ATOMIC_ACQUIRE, "agent");
            xb_add(&bar[XB_XGEN(b.x)], 1u);
            asm volatile("s_waitcnt vmcnt(0)" ::: "memory");
        } else {
            XB_SPIN(xb_ld(&bar[XB_XGEN(b.x)]) == gen, bar);
            __builtin_amdgcn_fence(__ATOMIC_ACQUIRE, "agent");
            asm volatile("s_waitcnt vmcnt(0)" ::: "memory");
        }
    }
    __syncthreads();
}
#undef LAS
using pg8::bf16x8; using pg8::f32x4; using pg8::u32x4; using pg8::f32x2;
#define GAS __attribute__((address_space(1)))
#define LAS __attribute__((address_space(3)))
typedef unsigned short bf16;
typedef unsigned v4u __attribute__((ext_vector_type(4)));
typedef unsigned v2u __attribute__((ext_vector_type(2)));
typedef float f32x2v __attribute__((ext_vector_type(2)));

constexpr int NTOK = 40960, DM = 2048, NLAYER = 4, INW = 5120;
constexpr int COL_UA = 0, COL_UB = 512, COL_Q = 1024, COL_K = 2048, COL_V = 3072, COL_G = 4096;
constexpr float ALPHA = 1.6817928305074290f;
constexpr float LN_EPS = 1e-5f, GN_EPS = 1e-6f;
constexpr int NEXP = 16384;
constexpr int NWAVES = 8, NTHR = 512;

constexpr size_t MiB = 1u << 20;
constexpr size_t WS_CTL = 0, CTL_ZERO_BYTES = 1 * MiB;
constexpr size_t WS_WIN = 1 * MiB;
constexpr size_t WS_WOUT = 81 * MiB;
constexpr size_t WS_WS = 113 * MiB;
constexpr size_t WS_WGLU = 145 * MiB;
constexpr size_t WS_S5A = 149 * MiB;
constexpr size_t WS_S5B = 150 * MiB;
constexpr size_t WS_S5BB = 153 * MiB;
constexpr size_t WS_U8 = 160 * MiB;
constexpr size_t WS_V8 = 288 * MiB;
constexpr size_t WS_USC = 416 * MiB;
constexpr size_t WS_VSC = 417 * MiB;
constexpr size_t WS_ROTC = 420 * MiB;
constexpr size_t WS_ROTS = 424 * MiB;
constexpr size_t WS_XN = 672 * MiB;
constexpr size_t WS_H = 832 * MiB;
constexpr size_t WS_CONCAT = 1232 * MiB;
constexpr size_t WS_BUFY = 1392 * MiB;
constexpr size_t WS_STF = 1472 * MiB;
constexpr size_t WS_STB = 1632 * MiB;
constexpr size_t WS_IDX = 1792 * MiB;
constexpr size_t WS_GATE = 1812 * MiB;
constexpr size_t WS_S5ST = 1832 * MiB;
constexpr size_t WS_END = 1852 * MiB;
constexpr int CW_BAR = 4096;
constexpr int NPHASE = 1 + NLAYER * 10;

constexpr int LDS_SCRATCH = 147456;
constexpr int LDS_MISC = LDS_SCRATCH;
constexpr int LDS_BYTES = LDS_SCRATCH + 256;

__device__ __forceinline__ float bf_lo(unsigned w) { return __uint_as_float(w << 16); }
__device__ __forceinline__ float bf_hi(unsigned w) { return __uint_as_float(w & 0xffff0000u); }
typedef __bf16 bf16x2_t __attribute__((ext_vector_type(2)));
__device__ __forceinline__ unsigned pkbf(float lo, float hi) { const bf16x2_t v = {(__bf16)lo, (__bf16)hi}; return __builtin_bit_cast(unsigned, v); }
__device__ __forceinline__ bf16 f2bf(float f) { return __builtin_bit_cast(unsigned short, (__bf16)f); }
__device__ __forceinline__ float wave_sum(float v) {
#pragma unroll
    for (int o = 1; o < 64; o <<= 1) v += __shfl_xor(v, o);
    return v;
}
__device__ __forceinline__ float gelu_erf(float v) { return 0.5f * v * (1.0f + erff(v * 0.70710678118654752f)); }
__device__ __forceinline__ int tok_pos(int t) { return t < 32768 ? (t & 4095) : (t - 32768); }
__device__ __forceinline__ int tok_len(int t) { return t < 32768 ? 4096 : 8192; }
__device__ __forceinline__ void unpack8(const v4u q, float (&f)[8]) {
    f[0] = bf_lo(q.x); f[1] = bf_hi(q.x); f[2] = bf_lo(q.y); f[3] = bf_hi(q.y); f[4] = bf_lo(q.z); f[5] = bf_hi(q.z); f[6] = bf_lo(q.w); f[7] = bf_hi(q.w);
}
__device__ __forceinline__ v4u pack8(const float (&f)[8]) { v4u q; q.x = pkbf(f[0], f[1]); q.y = pkbf(f[2], f[3]); q.z = pkbf(f[4], f[5]); q.w = pkbf(f[6], f[7]); return q; }
#define LDS_WAIT() asm volatile("s_waitcnt lgkmcnt(0)" ::: "memory")
#define MFMA16(a, b, c) __builtin_amdgcn_mfma_f32_16x16x32_bf16((a), (b), (c), 0, 0, 0)

struct EpiStoreBf16 {
    static constexpr bool PERM = true, AFTER_DRAIN = false;
    bf16* O; int ldo;
    __device__ __forceinline__ void operator()(const f32x4 (&acc)[2][2][4][2], const pg8::Unit& u, int wr, int wc, int fr, int fq) const {
        const int row0 = u.pm * 256 + wr * 64 + fr, col0 = u.pn * 256 + wc * 32 + 8 * fq;
#pragma unroll
        for (int ai = 0; ai < 2; ++ai)
#pragma unroll
            for (int m = 0; m < 4; ++m) { bf16* rowp = O + (size_t)(row0 + ai * 128 + m * 16) * ldo + col0;
#pragma unroll
                for (int bj = 0; bj < 2; ++bj) { const f32x4 v0 = acc[ai][bj][m][0], v1 = acc[ai][bj][m][1];
                    v4u w; w.x = pkbf(v0[0], v0[1]); w.y = pkbf(v0[2], v0[3]); w.z = pkbf(v1[0], v1[1]); w.w = pkbf(v1[2], v1[3]);
                    *(v4u*)(rowp + bj * 128) = w; } }
    }
};
struct EpiStoreRot {
    static constexpr bool PERM = true, AFTER_DRAIN = false;
    bf16* O; int ldo; const float* rc; const float* rs;
    __device__ __forceinline__ void operator()(const f32x4 (&acc)[2][2][4][2], const pg8::Unit& u, int wr, int wc, int fr, int fq) const {
        const int row0 = u.pm * 256 + wr * 64 + fr, col0 = u.pn * 256 + wc * 32 + 8 * fq;
        const bool rot = u.pn >= 4 && u.pn < 12; const float sc = u.pn >= 8 ? 0.0625f : 1.0f;
#pragma unroll
        for (int ai = 0; ai < 2; ++ai)
#pragma unroll
            for (int m = 0; m < 4; ++m) { const int row = row0 + ai * 128 + m * 16; bf16* rowp = O + (size_t)row * ldo + col0;
                f32x4 a0 = acc[ai][0][m][0], a1 = acc[ai][0][m][1], b0 = acc[ai][1][m][0], b1 = acc[ai][1][m][1];
                if (rot) { const int pos = row < 32768 ? (row & 4095) : (row - 32768); const size_t to = (size_t)pos * 128 + wc * 32 + 8 * fq;
                    const f32x4 c0 = *(const f32x4*)(rc + to), c1 = *(const f32x4*)(rc + to + 4), s0 = *(const f32x4*)(rs + to), s1 = *(const f32x4*)(rs + to + 4);
                    const f32x4 x0 = a0, x1 = a1, y0 = b0, y1 = b1;
                    a0 = (x0 * c0 - y0 * s0) * sc; a1 = (x1 * c1 - y1 * s1) * sc; b0 = (y0 * c0 + x0 * s0) * sc; b1 = (y1 * c1 + x1 * s1) * sc; }
                v4u w; w.x = pkbf(a0[0], a0[1]); w.y = pkbf(a0[2], a0[3]); w.z = pkbf(a1[0], a1[1]); w.w = pkbf(a1[2], a1[3]); *(v4u*)rowp = w;
                v4u x; x.x = pkbf(b0[0], b0[1]); x.y = pkbf(b0[2], b0[3]); x.z = pkbf(b1[0], b1[1]); x.w = pkbf(b1[2], b1[3]); *(v4u*)(rowp + 128) = x; }
    }
};
struct EpiGlu {
    static constexpr bool PERM = true, AFTER_DRAIN = false;
    const bf16* Y; int ldy; bf16* O; int ldo; const float* bias;
    __device__ __forceinline__ void operator()(const f32x4 (&acc)[2][2][4][2], const pg8::Unit& u, int wr, int wc, int fr, int fq) const {
        const int row0 = u.pm * 256 + wr * 64 + fr, col0 = u.pn * 256 + wc * 32 + 8 * fq;
#pragma unroll
        for (int bj = 0; bj < 2; ++bj) {
            const f32x4 b0 = *(const f32x4*)(bias + col0 + bj * 128), b1 = *(const f32x4*)(bias + col0 + bj * 128 + 4);
#pragma unroll
            for (int ai = 0; ai < 2; ++ai)
#pragma unroll
                for (int m = 0; m < 4; ++m) { const size_t r = (size_t)(row0 + ai * 128 + m * 16);
                    const v4u yq = *(const v4u*)(Y + r * ldy + col0 + bj * 128); float y[8]; unpack8(yq, y);
                    const f32x4 v0 = acc[ai][bj][m][0] + b0, v1 = acc[ai][bj][m][1] + b1; float o[8];
#pragma unroll
                    for (int k = 0; k < 4; ++k) { o[k] = y[k] / (1.0f + __expf(-v0[k])); o[4 + k] = y[4 + k] / (1.0f + __expf(-v1[k])); }
                    *(v4u*)(O + r * ldo + col0 + bj * 128) = pack8(o); }
        }
    }
};
struct EpiStoreF16 {
    static constexpr bool PERM = true, AFTER_DRAIN = false;
    _Float16* C; int ldc;
    __device__ __forceinline__ void operator()(const f32x4 (&acc)[2][2][4][2], const pg8::Unit& u, int wr, int wc, int fr, int fq) const {
        typedef _Float16 h8 __attribute__((ext_vector_type(8)));
        const int row0 = u.pm * 256 + wr * 64 + fr, col0 = u.pn * 256 + wc * 32 + 8 * fq;
#pragma unroll
        for (int ai = 0; ai < 2; ++ai)
#pragma unroll
            for (int m = 0; m < 4; ++m) { _Float16* rowp = C + (size_t)(row0 + ai * 128 + m * 16) * ldc + col0;
#pragma unroll
                for (int bj = 0; bj < 2; ++bj) { const f32x4 v0 = acc[ai][bj][m][0], v1 = acc[ai][bj][m][1];
                    h8 w; w[0] = (_Float16)v0[0]; w[1] = (_Float16)v0[1]; w[2] = (_Float16)v0[2]; w[3] = (_Float16)v0[3]; w[4] = (_Float16)v1[0]; w[5] = (_Float16)v1[1]; w[6] = (_Float16)v1[2]; w[7] = (_Float16)v1[3];
                    *(h8*)(rowp + bj * 128) = w; } }
    }
};
struct Args { const float* in[26]; float* out; unsigned char* ws; int ph_lo, ph_hi, li, pad; };
struct ArgsDev { const float GAS* in[26]; float GAS* out; unsigned char GAS* ws; int ph_lo, ph_hi, li, pad; };
typedef const ArgsDev __attribute__((address_space(4))) CArgs;
#define GIN(A_, k_) ((const float*)(A_).in[k_])
struct Frame {
    LAS unsigned char* lds;
    int tid, lane, wave, G, bx;
    int gw, NGW;
    size_t gtid, NT;
    float* out; unsigned char* ws;
};
enum InIdx { I_XP = 0, I_XS, I_LNIN_G, I_LNIN_B, I_WIN, I_LAMRE, I_LAMIM, I_LOGSTEP, I_BRE, I_BIM, I_CRE, I_CIM, I_S5D, I_WGLU, I_BGLU, I_POOLW, I_POOLS,
             I_WOUT, I_LN1G, I_LN1B, I_WQ, I_KEYS, I_PU, I_PV, I_LN2G, I_LN2B };

__device__ __forceinline__ void ln_rows2(bf16* XB, const bf16* MIX, float alpha, const float* g, const float* b, int gw, int ngw, int lane) {
    for (int t = gw; t < NTOK; t += 2 * ngw) {
        const int t2 = t + ngw; const bool has2 = t2 < NTOK; const int tb = has2 ? t2 : t;
        f32x4 v0[8], v1[8]; v2u x0q[8], x1q[8], m0q[8], m1q[8]; float s0 = 0.f, s1 = 0.f;
#pragma unroll
        for (int j = 0; j < 8; ++j) { x0q[j] = ((const v2u*)(XB + (size_t)t * DM))[lane + 64 * j]; m0q[j] = ((const v2u*)(MIX + (size_t)t * DM))[lane + 64 * j]; }
#pragma unroll
        for (int j = 0; j < 8; ++j) { x1q[j] = ((const v2u*)(XB + (size_t)tb * DM))[lane + 64 * j]; m1q[j] = ((const v2u*)(MIX + (size_t)tb * DM))[lane + 64 * j]; }
#pragma unroll
        for (int j = 0; j < 8; ++j) {
            v0[j] = (f32x4){bf_lo(x0q[j].x), bf_hi(x0q[j].x), bf_lo(x0q[j].y), bf_hi(x0q[j].y)} * alpha + (f32x4){bf_lo(m0q[j].x), bf_hi(m0q[j].x), bf_lo(m0q[j].y), bf_hi(m0q[j].y)};
            v1[j] = (f32x4){bf_lo(x1q[j].x), bf_hi(x1q[j].x), bf_lo(x1q[j].y), bf_hi(x1q[j].y)} * alpha + (f32x4){bf_lo(m1q[j].x), bf_hi(m1q[j].x), bf_lo(m1q[j].y), bf_hi(m1q[j].y)};
            s0 += (v0[j][0] + v0[j][1]) + (v0[j][2] + v0[j][3]); s1 += (v1[j][0] + v1[j][1]) + (v1[j][2] + v1[j][3]); }
        const float m0 = wave_sum(s0) * (1.0f / DM), m1 = wave_sum(s1) * (1.0f / DM); float q0 = 0.f, q1 = 0.f;
#pragma unroll
        for (int j = 0; j < 8; ++j) { v0[j] = v0[j] - m0; v1[j] = v1[j] - m1;
            q0 += (v0[j][0] * v0[j][0] + v0[j][1] * v0[j][1]) + (v0[j][2] * v0[j][2] + v0[j][3] * v0[j][3]); q1 += (v1[j][0] * v1[j][0] + v1[j][1] * v1[j][1]) + (v1[j][2] * v1[j][2] + v1[j][3] * v1[j][3]); }
        const float rs0 = 1.0f / sqrtf(wave_sum(q0) * (1.0f / DM) + LN_EPS), rs1 = 1.0f / sqrtf(wave_sum(q1) * (1.0f / DM) + LN_EPS);
#pragma unroll
        for (int j = 0; j < 8; ++j) { const f32x4 gg = ((const f32x4*)g)[lane + 64 * j], bb = ((const f32x4*)b)[lane + 64 * j];
            const f32x4 o0 = v0[j] * rs0 * gg + bb;
            v2u w0; w0.x = pkbf(o0[0], o0[1]); w0.y = pkbf(o0[2], o0[3]); ((v2u*)(XB + (size_t)t * DM))[lane + 64 * j] = w0;
            if (has2) { const f32x4 o1 = v1[j] * rs1 * gg + bb;
                v2u w1; w1.x = pkbf(o1[0], o1[1]); w1.y = pkbf(o1[2], o1[3]); ((v2u*)(XB + (size_t)t2 * DM))[lane + 64 * j] = w1; } }
    }
}

__device__ __forceinline__ void transpose_item(const float* W, int K, int N, bf16* WT, LAS float* scr, int item, int lane) {
    const int nblk = N / 32, kb = item / nblk, nb = item % nblk, k0 = 64 * kb, n0 = 32 * nb;
#pragma unroll 8
    for (int i = 0; i < 32; ++i) { const int kk = 2 * i + (lane >> 5); scr[kk * 33 + (lane & 31)] = W[(size_t)(k0 + kk) * N + n0 + (lane & 31)]; }
    LDS_WAIT();
    const int c = lane & 7;
#pragma unroll
    for (int j = 0; j < 4; ++j) { const int n = (lane >> 3) + 8 * j; const LAS float* s = scr + (8 * c) * 33 + n;
        v4u o; o.x = pkbf(s[0 * 33], s[1 * 33]); o.y = pkbf(s[2 * 33], s[3 * 33]); o.z = pkbf(s[4 * 33], s[5 * 33]); o.w = pkbf(s[6 * 33], s[7 * 33]);
        *(v4u*)(WT + (size_t)(n0 + n) * K + k0 + 8 * c) = o; }
    LDS_WAIT();
}

__device__ __forceinline__ void p0_prologue(const Frame& F, CArgs& A) {
    {
        LAS float* scr = (LAS float*)(F.lds + F.wave * 16384);
        constexpr int I_IN = (DM / 64) * (INW / 32), I_OUT = (DM / 64) * (DM / 32), I_GLU = (512 / 64) * (512 / 32);
        constexpr int NITEMS = NLAYER * (I_IN + I_OUT + I_GLU);
        for (int it = F.gw; it < NITEMS; it += F.NGW) {
            int r = it;
            if (r < NLAYER * I_IN) { const int l = r / I_IN; { const int nb_ = (r % I_IN) % (INW / 32); if (nb_ >= 512 / 32 && nb_ < 1024 / 32) continue; }
                transpose_item(GIN(A, I_WIN) + (size_t)l * DM * INW, DM, INW, (bf16*)(F.ws + WS_WIN) + (size_t)l * INW * DM, scr, r % I_IN, F.lane); continue; }
            r -= NLAYER * I_IN;
            if (r < NLAYER * I_OUT) { const int l = r / I_OUT; transpose_item(GIN(A, I_WOUT) + (size_t)l * DM * DM, DM, DM, (bf16*)(F.ws + WS_WOUT) + (size_t)l * DM * DM, scr, r % I_OUT, F.lane); continue; }
            r -= NLAYER * I_OUT;
            { const int l = r / I_GLU; transpose_item(GIN(A, I_WGLU) + (size_t)l * 512 * 512, 512, 512, (bf16*)(F.ws + WS_WGLU) + (size_t)l * 512 * 512, scr, r % I_GLU, F.lane); }
        }
    }
    {
        const int NR2 = 2 * NLAYER * NEXP;
        for (int r = F.gw; r < NR2; r += 2 * F.NGW) {
            const int r2 = r + F.NGW < NR2 ? r + F.NGW : r;
            const int tabA = r >= NLAYER * NEXP, riA = tabA ? r - NLAYER * NEXP : r, tabB = r2 >= NLAYER * NEXP, riB = tabB ? r2 - NLAYER * NEXP : r2;
            const float* srcA = (tabA ? GIN(A, I_PV) : GIN(A, I_PU)) + (size_t)riA * DM + F.lane * 4; const float* srcB = (tabB ? GIN(A, I_PV) : GIN(A, I_PU)) + (size_t)riB * DM + F.lane * 4;
            f32x4 va[8], vb[8]; float ama = 0.f, amb = 0.f;
#pragma unroll
            for (int q = 0; q < 8; ++q) va[q] = *(const f32x4*)(srcA + q * 256);
#pragma unroll
            for (int q = 0; q < 8; ++q) vb[q] = *(const f32x4*)(srcB + q * 256);
#pragma unroll
            for (int q = 0; q < 8; ++q) { ama = fmaxf(ama, fmaxf(fmaxf(fabsf(va[q][0]), fabsf(va[q][1])), fmaxf(fabsf(va[q][2]), fabsf(va[q][3])))); amb = fmaxf(amb, fmaxf(fmaxf(fabsf(vb[q][0]), fabsf(vb[q][1])), fmaxf(fabsf(vb[q][2]), fabsf(vb[q][3])))); }
#pragma unroll
            for (int o = 1; o < 64; o <<= 1) { ama = fmaxf(ama, __shfl_xor(ama, o)); amb = fmaxf(amb, __shfl_xor(amb, o)); }
#pragma unroll
            for (int half = 0; half < 2; ++half) {
                if (half == 1 && r2 == r) break;
                const float am = half ? amb : ama; const int tab = half ? tabB : tabA, ri = half ? riB : riA;
                const float sc = am > 0.f ? 6.0f / am : 1.0f, isc = am > 0.f ? am * (1.0f / 6.0f) : 1.0f;
                v4u w;
#pragma unroll
                for (int q = 0; q < 4; ++q) { const f32x4 e0 = half ? vb[2 * q] : va[2 * q], e1 = half ? vb[2 * q + 1] : va[2 * q + 1]; unsigned pk = 0u;
                    pk = __builtin_amdgcn_cvt_scalef32_pk_fp4_f32(pk, e0[0] * sc, e0[1] * sc, 1.0f, 0); pk = __builtin_amdgcn_cvt_scalef32_pk_fp4_f32(pk, e0[2] * sc, e0[3] * sc, 1.0f, 1);
                    pk = __builtin_amdgcn_cvt_scalef32_pk_fp4_f32(pk, e1[0] * sc, e1[1] * sc, 1.0f, 2); pk = __builtin_amdgcn_cvt_scalef32_pk_fp4_f32(pk, e1[2] * sc, e1[3] * sc, 1.0f, 3);
                    w[q] = pk; }
                *(v4u*)(F.ws + (tab ? WS_V8 : WS_U8) + (size_t)ri * (DM / 2) + F.lane * 16) = w;
                if (F.lane == 0) ((float*)(F.ws + (tab ? WS_VSC : WS_USC)))[ri] = isc;
            }
        }
    }
    {
        const float* win = GIN(A, I_WIN); const float* pw = GIN(A, I_POOLW); const float* ps = GIN(A, I_POOLS); bf16* wt = (bf16*)(F.ws + WS_WIN);
        for (size_t it = F.gtid; it < (size_t)NLAYER * 512 * 256; it += F.NT) {
            const int n = (int)(it & 511), k8 = (int)((it >> 9) & 255), l = (int)(it >> 17), g = n >> 7, d = n & 127;
            float acc[8];
#pragma unroll
            for (int kk = 0; kk < 8; ++kk) acc[kk] = 0.f;
            const float* wrow = win + ((size_t)l * DM + k8 * 8) * INW + 512 + g * 128; const float* pcol = pw + ((size_t)(l * 4 + g) * 128) * 128 + d;
            for (int c4 = 0; c4 < 32; ++c4) {
                f32x4 wv[8];
#pragma unroll
                for (int kk = 0; kk < 8; ++kk) wv[kk] = *(const f32x4*)(wrow + (size_t)kk * INW + c4 * 4);
#pragma unroll
                for (int e = 0; e < 4; ++e) { const float pv = pcol[(size_t)(c4 * 4 + e) * 128];
#pragma unroll
                    for (int kk = 0; kk < 8; ++kk) acc[kk] += wv[kk][e] * pv; }
            }
            const float sc = ps[l * 512 + n];
#pragma unroll
            for (int kk = 0; kk < 8; ++kk) acc[kk] *= sc;
            *(v4u*)(wt + ((size_t)l * INW + 512 + n) * DM + k8 * 8) = pack8(acc);
        }
    }
    {
        const float* lre = GIN(A, I_LAMRE); const float* lim = GIN(A, I_LAMIM); const float* lst = GIN(A, I_LOGSTEP); const float* bre = GIN(A, I_BRE); const float* bim = GIN(A, I_BIM);
        f32x2v* ab = (f32x2v*)(F.ws + WS_S5A); f32x2v* ab64 = (f32x2v*)(F.ws + WS_S5A + 512 * 1024); f32x2v* bb = (f32x2v*)(F.ws + WS_S5B);
        for (size_t i = F.gtid; i < (size_t)NLAYER * 2 * 32 * 64; i += F.NT) {
            const float lr = lre[i], li = lim[i], dt = expf(lst[i >> 6]);
            const float mag = expf(lr * dt), ar = mag * cosf(li * dt), ai = mag * sinf(li * dt);
            const float den = lr * lr + li * li;
            const float zr = ((ar - 1.0f) * lr + ai * li) / den, zi = (ai * lr - (ar - 1.0f) * li) / den;
            ab[i] = (f32x2v){ar, ai};
            const float m64 = expf(lr * dt * 64.0f), an = li * dt * 64.0f;
            ab64[i] = (f32x2v){m64 * cosf(an), m64 * sinf(an)};
#pragma unroll
            for (int c = 0; c < 16; ++c) { const float br = bre[i * 16 + c], bi = bim[i * 16 + c]; bb[i * 16 + c] = (f32x2v){zr * br - zi * bi, zr * bi + zi * br}; }
            {
                bf16* o = (bf16*)(F.ws + WS_S5BB) + ((size_t)(i >> 6) * 128 + 2 * (i & 63)) * 32;
#pragma unroll
                for (int c = 0; c < 16; ++c) { const float br = bre[i * 16 + c], bi = bim[i * 16 + c]; o[c] = f2bf(zr * br - zi * bi); o[32 + c] = f2bf(zr * bi + zi * br); o[16 + c] = 0; o[48 + c] = 0; }
            }
        }
    }
    {
        float* rc = (float*)(F.ws + WS_ROTC); float* rs = (float*)(F.ws + WS_ROTS);
        for (size_t i = F.gtid; i < (size_t)8192 * 128; i += F.NT) { const float inv = (float)exp(-(double)(i & 127) / 127.0 * 9.210340371976184); const float ang = (float)(i >> 7) * inv; rc[i] = cosf(ang); rs[i] = sinf(ang); }
    }
    __syncthreads();
    {
        LAS float* KS = (LAS float*)F.lds;
        LAS float* WQ = (LAS float*)(F.lds + 128 * 132 * 4);
        const float* keys = GIN(A, I_KEYS); const float* wq = GIN(A, I_WQ); bf16* wst = (bf16*)(F.ws + WS_WS);
        for (int u = F.bx; u < NLAYER * 16 * 32; u += F.G) {
            const int dtl = u & 31, hp = (u >> 5) & 15, l = u >> 9, p = hp & 1;
#pragma unroll
            for (int r = 0; r < 8; ++r) { const int f = F.tid + 512 * r, nk = f >> 5, c4 = f & 31;
                *(LAS f32x4*)(KS + nk * 132 + c4 * 4) = *(const f32x4*)(keys + (((size_t)l * 2 + p) * 128 + nk) * 128 + c4 * 4); }
#pragma unroll
            for (int r = 0; r < 4; ++r) { const int f = F.tid + 512 * r, dd = f >> 5, c4 = f & 31;
                *(LAS f32x4*)(WQ + dd * 132 + c4 * 4) = *(const f32x4*)(wq + ((size_t)l * DM + dtl * 64 + dd) * DM + hp * 128 + c4 * 4); }
            __syncthreads();
            const int nk = F.tid & 127, dg = F.tid >> 7;
            float acc[16];
#pragma unroll
            for (int i = 0; i < 16; ++i) acc[i] = 0.f;
            for (int c4 = 0; c4 < 32; ++c4) {
                const f32x4 kv = *(const LAS f32x4*)(KS + nk * 132 + c4 * 4);
#pragma unroll
                for (int i = 0; i < 16; ++i) { const f32x4 wv = *(const LAS f32x4*)(WQ + (dg * 16 + i) * 132 + c4 * 4);
                    acc[i] += (kv[0] * wv[0] + kv[1] * wv[1]) + (kv[2] * wv[2] + kv[3] * wv[3]); }
            }
            bf16* o = wst + ((size_t)l * DM + hp * 128 + nk) * DM + dtl * 64 + dg * 16;
            v4u q0, q1; q0.x = pkbf(acc[0], acc[1]); q0.y = pkbf(acc[2], acc[3]); q0.z = pkbf(acc[4], acc[5]); q0.w = pkbf(acc[6], acc[7]);
            q1.x = pkbf(acc[8], acc[9]); q1.y = pkbf(acc[10], acc[11]); q1.z = pkbf(acc[12], acc[13]); q1.w = pkbf(acc[14], acc[15]);
            *(v4u*)o = q0; *(v4u*)(o + 8) = q1;
            __syncthreads();
        }
    }
    {
        const float* xp = GIN(A, I_XP); const float* xs = GIN(A, I_XS); const float* g = GIN(A, I_LNIN_G); const float* b = GIN(A, I_LNIN_B); bf16* XB = (bf16*)(F.ws + WS_XN);
        for (int t = F.gw; t < NTOK; t += 2 * F.NGW) {
            const int t2 = t + F.NGW; const bool has2 = t2 < NTOK; const int tb = has2 ? t2 : t;
            const float* s0p = t < 32768 ? xp + (size_t)t * DM : xs + (size_t)(t - 32768) * DM; const float* s1p = tb < 32768 ? xp + (size_t)tb * DM : xs + (size_t)(tb - 32768) * DM;
            f32x4 v0[8], v1[8]; float s0 = 0.f, s1 = 0.f;
#pragma unroll
            for (int j = 0; j < 8; ++j) v0[j] = ((const f32x4*)s0p)[F.lane + 64 * j];
#pragma unroll
            for (int j = 0; j < 8; ++j) v1[j] = ((const f32x4*)s1p)[F.lane + 64 * j];
#pragma unroll
            for (int j = 0; j < 8; ++j) { s0 += (v0[j][0] + v0[j][1]) + (v0[j][2] + v0[j][3]); s1 += (v1[j][0] + v1[j][1]) + (v1[j][2] + v1[j][3]); }
            const float m0 = wave_sum(s0) * (1.0f / DM), m1 = wave_sum(s1) * (1.0f / DM); float q0 = 0.f, q1 = 0.f;
#pragma unroll
            for (int j = 0; j < 8; ++j) { v0[j] = v0[j] - m0; v1[j] = v1[j] - m1;
                q0 += (v0[j][0] * v0[j][0] + v0[j][1] * v0[j][1]) + (v0[j][2] * v0[j][2] + v0[j][3] * v0[j][3]); q1 += (v1[j][0] * v1[j][0] + v1[j][1] * v1[j][1]) + (v1[j][2] * v1[j][2] + v1[j][3] * v1[j][3]); }
            const float rs0 = 1.0f / sqrtf(wave_sum(q0) * (1.0f / DM) + LN_EPS), rs1 = 1.0f / sqrtf(wave_sum(q1) * (1.0f / DM) + LN_EPS);
#pragma unroll
            for (int j = 0; j < 8; ++j) { const f32x4 gg = ((const f32x4*)g)[F.lane + 64 * j], bb = ((const f32x4*)b)[F.lane + 64 * j];
                const f32x4 o0 = v0[j] * rs0 * gg + bb;
                v2u w0; w0.x = pkbf(o0[0], o0[1]); w0.y = pkbf(o0[2], o0[3]); ((v2u*)(XB + (size_t)t * DM))[F.lane + 64 * j] = w0;
                if (has2) { const f32x4 o1 = v1[j] * rs1 * gg + bb;
                    v2u w1; w1.x = pkbf(o1[0], o1[1]); w1.y = pkbf(o1[2], o1[3]); ((v2u*)(XB + (size_t)t2 * DM))[F.lane + 64 * j] = w1; } }
        }
    }
}

__device__ __forceinline__ float ret_log2_gamma(int h) { return log2f(1.0f - exp2f(-5.0f - (float)h)); }

__device__ __forceinline__ void s5_pass1(const Frame& F, CArgs& A, int l) {
    LAS float* BUs = (LAS float*)(F.lds + F.wave * 8448);
    const bf16* H = (const bf16*)(F.ws + WS_H);
    const f32x2v* ab = (const f32x2v*)(F.ws + WS_S5A); const bf16* BB = (const bf16*)(F.ws + WS_S5BB);
    f32x2v* st = (f32x2v*)(F.ws + WS_S5ST);
    const int lane = F.lane, lr = lane & 15, lq = lane >> 4;
    const int gstep = F.G < 32 ? F.G : 32;
    for (int g = F.bx % 32; g < 32; g += gstep) {
        const int nwg = F.G < 32 ? 1 : (F.G - g + 31) / 32, rank = F.G < 32 ? 0 : F.bx / 32;
        bf16x8 Bop[2][8]; f32x2v a2[2], arot[2];
#pragma unroll
        for (int dir = 0; dir < 2; ++dir) { const int gi = (l * 2 + dir) * 32 + g; a2[dir] = ab[gi * 64 + lane]; arot[dir] = (f32x2v){-a2[dir][1], a2[dir][1]};
#pragma unroll
            for (int j = 0; j < 8; ++j) Bop[dir][j] = *(const bf16x8*)(BB + ((size_t)gi * 128 + 16 * j + lr) * 32 + lq * 8); }
        for (int ck = rank * NWAVES + F.wave; ck < 640; ck += nwg * NWAVES) {
            bf16x8 uop[4];
#pragma unroll
            for (int tb = 0; tb < 4; ++tb) { const v4u q = lq < 2 ? *(const v4u*)(H + (size_t)(ck * 64 + 16 * tb + lr) * INW + COL_UA + g * 16 + lq * 8) : (v4u){0u, 0u, 0u, 0u}; uop[tb] = __builtin_bit_cast(bf16x8, q); }
#pragma unroll
            for (int dir = 0; dir < 2; ++dir) {
                f32x2v x2 = (f32x2v){0.f, 0.f};
#pragma unroll
                for (int blk = 0; blk < 4; ++blk) {
                    const int tb = dir ? 3 - blk : blk;
#pragma unroll
                    for (int j = 0; j < 8; ++j) { const f32x4 d = MFMA16(Bop[dir][j], uop[tb], ((f32x4){0.f, 0.f, 0.f, 0.f}));
                        *(LAS f32x4*)(BUs + lr * 132 + 16 * j + 4 * lq) = d; }
                    LDS_WAIT();
#pragma unroll
                    for (int s = 0; s < 16; ++s) { const int tl = dir ? 15 - s : s;
                        const f32x2v bu = *(const LAS f32x2v*)(BUs + tl * 132 + 2 * lane);
                        x2 = x2 * a2[dir][0] + (arot[dir] * (f32x2v){x2[1], x2[0]} + bu); }
                    LDS_WAIT();
                }
                st[(size_t)((ck * 32 + g) * 2 + dir) * 64 + lane] = x2;
            }
        }
    }
}
__device__ __forceinline__ void s5_carry(const Frame& F, CArgs& A, int l) {
    const f32x2v* ab64 = (const f32x2v*)(F.ws + WS_S5A + 512 * 1024); f32x2v* st = (f32x2v*)(F.ws + WS_S5ST);
    for (size_t it = F.gtid; it < (size_t)9 * 32 * 2 * 64; it += F.NT) {
        const int p = (int)(it & 63), dir = (int)((it >> 6) & 1), g = (int)((it >> 7) & 31), s = (int)(it >> 12);
        const int ck0 = s < 8 ? s * 64 : 512, n = s < 8 ? 64 : 128;
        const f32x2v a = ab64[((l * 2 + dir) * 32 + g) * 64 + p];
        float cr = 0.f, ci = 0.f;
        for (int k0 = 0; k0 < n; k0 += 8) {
            f32x2v le[8];
#pragma unroll
            for (int kk = 0; kk < 8; ++kk) { const int ck = dir ? (ck0 + n - 1 - (k0 + kk)) : (ck0 + k0 + kk); le[kk] = st[(size_t)((ck * 32 + g) * 2 + dir) * 64 + p]; }
#pragma unroll
            for (int kk = 0; kk < 8; ++kk) { const int ck = dir ? (ck0 + n - 1 - (k0 + kk)) : (ck0 + k0 + kk);
                st[(size_t)((ck * 32 + g) * 2 + dir) * 64 + p] = (f32x2v){cr, ci};
                const float ncr = a[0] * cr - a[1] * ci + le[kk][0], nci = a[0] * ci + a[1] * cr + le[kk][1]; cr = ncr; ci = nci; }
        }
    }
}
__device__ __forceinline__ void s5_pass3(const Frame& F, CArgs& A, int l) {
    LAS bf16* CtS = (LAS bf16*)F.lds;
    LAS unsigned char* wb = F.lds + 8704 + F.wave * 12800;
    LAS float* BUs = (LAS float*)wb;
    LAS bf16* Xw = (LAS bf16*)(wb + 8448);
    const bf16* H = (const bf16*)(F.ws + WS_H); bf16* BY = (bf16*)(F.ws + WS_BUFY);
    const f32x2v* ab = (const f32x2v*)(F.ws + WS_S5A); const bf16* BB = (const bf16*)(F.ws + WS_S5BB);
    const f32x2v* st = (const f32x2v*)(F.ws + WS_S5ST);
    const float* cre = GIN(A, I_CRE); const float* cim = GIN(A, I_CIM); const float* dvec = GIN(A, I_S5D) + (size_t)l * 512;
    const int lane = F.lane, lr = lane & 15, lq = lane >> 4;
    const int gstep = F.G < 32 ? F.G : 32;
    for (int g = F.bx % 32; g < 32; g += gstep) {
        const int nwg = F.G < 32 ? 1 : (F.G - g + 31) / 32, rank = F.G < 32 ? 0 : F.bx / 32;
        __syncthreads();
        {
            const int tq = opaque(F.tid);
#pragma unroll
            for (int r = 0; r < 8; ++r) { const int e = tq + 512 * r, pp = e & 127, c = (e >> 7) & 15, dir = e >> 11;
                const size_t cb = (size_t)(((l * 2 + dir) * 32 + g) * 16 + c) * 64;
                CtS[(dir * 16 + c) * 136 + pp] = f2bf(pp < 64 ? cre[cb + pp] : -cim[cb + pp - 64]); }
        }
        bf16x8 Bop[2][8]; f32x2v a2[2], arot[2];
#pragma unroll
        for (int dir = 0; dir < 2; ++dir) { const int gi = (l * 2 + dir) * 32 + g; a2[dir] = ab[gi * 64 + lane]; arot[dir] = (f32x2v){-a2[dir][1], a2[dir][1]};
#pragma unroll
            for (int j = 0; j < 8; ++j) Bop[dir][j] = *(const bf16x8*)(BB + ((size_t)gi * 128 + 16 * j + lr) * 32 + lq * 8); }
        __syncthreads();
        for (int ck = rank * NWAVES + F.wave; ck < 640; ck += nwg * NWAVES) {
            bf16x8 uop[4];
#pragma unroll
            for (int tb = 0; tb < 4; ++tb) { const v4u q = lq < 2 ? *(const v4u*)(H + (size_t)(ck * 64 + 16 * tb + lr) * INW + COL_UA + g * 16 + lq * 8) : (v4u){0u, 0u, 0u, 0u}; uop[tb] = __builtin_bit_cast(bf16x8, q); }
            f32x2v xin[2];
#pragma unroll
            for (int dir = 0; dir < 2; ++dir) xin[dir] = st[(size_t)((ck * 32 + g) * 2 + dir) * 64 + lane];
            f32x4 Y[4];
#pragma unroll
            for (int m = 0; m < 4; ++m) Y[m] = (f32x4){0.f, 0.f, 0.f, 0.f};
#pragma unroll
            for (int dir = 0; dir < 2; ++dir) {
                f32x2v x2 = xin[dir];
#pragma unroll
                for (int blk = 0; blk < 4; ++blk) {
                    const int tb = dir ? 3 - blk : blk;
#pragma unroll
                    for (int j = 0; j < 8; ++j) { const f32x4 d = MFMA16(Bop[dir][j], uop[tb], ((f32x4){0.f, 0.f, 0.f, 0.f}));
                        *(LAS f32x4*)(BUs + lr * 132 + 16 * j + 4 * lq) = d; }
                    LDS_WAIT();
#pragma unroll
                    for (int s = 0; s < 16; ++s) { const int tl = dir ? 15 - s : s;
                        const f32x2v bu = *(const LAS f32x2v*)(BUs + tl * 132 + 2 * lane);
                        x2 = x2 * a2[dir][0] + (arot[dir] * (f32x2v){x2[1], x2[0]} + bu);
                        Xw[tl * 136 + lane] = f2bf(x2[0]); Xw[tl * 136 + 64 + lane] = f2bf(x2[1]); }
                    LDS_WAIT();
#pragma unroll
                    for (int ks = 0; ks < 4; ++ks) {
                        const bf16x8 av = *(const LAS bf16x8*)(CtS + (dir * 16 + lr) * 136 + 32 * ks + lq * 8);
                        const bf16x8 bv = *(const LAS bf16x8*)(Xw + lr * 136 + 32 * ks + lq * 8);
                        Y[tb] = MFMA16(av, bv, Y[tb]);
                    }
                    LDS_WAIT();
                }
            }
#pragma unroll
            for (int m = 0; m < 4; ++m) {
                const int t = 16 * m + lr, c0 = 4 * lq;
                const v2u uq = *(const v2u*)(H + (size_t)(ck * 64 + t) * INW + COL_UA + g * 16 + c0);
                const f32x4 uv = (f32x4){bf_lo(uq.x), bf_hi(uq.x), bf_lo(uq.y), bf_hi(uq.y)}; const f32x4 dv = *(const f32x4*)(dvec + g * 16 + c0);
                const f32x4 y = Y[m] + dv * uv;
                v2u w; w.x = pkbf(gelu_erf(y[0]), gelu_erf(y[1])); w.y = pkbf(gelu_erf(y[2]), gelu_erf(y[3]));
                *(v2u*)(BY + (size_t)(ck * 64 + t) * 512 + g * 16 + c0) = w;
            }
        }
    }
}
__device__ __forceinline__ void pool_phase(const Frame& F, CArgs& A) {
    const bf16* H = (const bf16*)(F.ws + WS_H); bf16* CCp = (bf16*)(F.ws + WS_CONCAT) + 512;
    for (size_t it = F.gtid; it < (size_t)NTOK * 64; it += F.NT) {
        const int t = (int)(it >> 6), o = (int)(it & 63), gi = o >> 4, w = 2 << gi;
        const int pos = tok_pos(t), L = tok_len(t);
        const int lo = max(pos - w / 2, 0), hi = min(pos + w / 2 - 1, L - 1);
        const bf16* base = H + (size_t)(t - pos) * INW + COL_UB + o * 8;
        float s[8];
#pragma unroll
        for (int k = 0; k < 8; ++k) s[k] = 0.f;
        v4u wq[16];
#pragma unroll
        for (int i = 0; i < 16; ++i) { const int si = lo + i <= hi ? lo + i : hi; wq[i] = *(const v4u*)(base + (size_t)si * INW); }
#pragma unroll
        for (int i = 0; i < 16; ++i) { float f[8]; unpack8(wq[i], f); const float wgt = lo + i <= hi ? 1.0f : 0.0f;
#pragma unroll
            for (int k = 0; k < 8; ++k) s[k] += wgt * f[k]; }
        const float inv = 1.0f / (float)(hi - lo + 1);
        float c[8]; unpack8(*(const v4u*)(base + (size_t)pos * INW), c);
#pragma unroll
        for (int k = 0; k < 8; ++k) s[k] = s[k] * inv - c[k];
        *(v4u*)(CCp + (size_t)t * DM + o * 8) = pack8(s);
    }
}
constexpr int RS = 136;
template <int MODE = 0> __device__ __forceinline__ void ret_state_phase(const Frame& F, CArgs& A) {
    const bf16* H = (const bf16*)(F.ws + WS_H); bf16* STF = (bf16*)(F.ws + WS_STF); bf16* STB = (bf16*)(F.ws + WS_STB);
    LAS bf16* Kt = (LAS bf16*)F.lds; LAS bf16* VtF = Kt + 128 * RS; LAS bf16* VtB = Kt + 256 * RS;
    LAS unsigned* Kt32 = (LAS unsigned*)Kt; LAS unsigned* VtF32 = (LAS unsigned*)VtF; LAS unsigned* VtB32 = (LAS unsigned*)VtB;
    const int tid = F.tid, lane = F.lane, lr = lane & 15, lq = lane >> 4, we = F.wave >> 1, wd = F.wave & 1;
    const int jp = tid & 63, j = 2 * jp, pc0 = tid >> 6;
    v4u pk0[2], pk1[2], pv0[2], pv1[2];
#define RS_LOAD(u_) do { const int dh_ = (u_) & 1, eh_ = ((u_) >> 1) & 1, h_ = ((u_) >> 2) & 3, c_ = (u_) >> 4; \
        const bf16* krow_ = H + (size_t)(c_ * 128 + j) * INW + COL_K + h_ * 256 + dh_ * 128; const bf16* vrow_ = H + (size_t)(c_ * 128 + j) * INW + COL_V + h_ * 256 + eh_ * 128; \
        _Pragma("unroll") for (int r = 0; r < 2; ++r) { const int pc = pc0 + 8 * r; pk0[r] = *(const v4u*)(krow_ + pc * 8); pk1[r] = *(const v4u*)(krow_ + INW + pc * 8); pv0[r] = *(const v4u*)(vrow_ + pc * 8); pv1[r] = *(const v4u*)(vrow_ + INW + pc * 8); } } while (0)
    if (F.bx < 5120) RS_LOAD(F.bx);
    for (int u = F.bx; u < 5120; u += F.G) {
        const int dh = u & 1, eh = (u >> 1) & 1, h = (u >> 2) & 3, c = u >> 4;
        if (MODE != 2) {
            const float lg = ret_log2_gamma(h), fF0 = exp2f(lg * (float)(127 - j)), fF1 = exp2f(lg * (float)(126 - j)), fB0 = exp2f(lg * (float)j), fB1 = exp2f(lg * (float)(j + 1));
#pragma unroll
            for (int r = 0; r < 2; ++r) {
                const int pc = pc0 + 8 * r;
                const unsigned ka0[4] = {pk0[r].x, pk0[r].y, pk0[r].z, pk0[r].w}, ka1[4] = {pk1[r].x, pk1[r].y, pk1[r].z, pk1[r].w};
                float f0[8], f1[8]; unpack8(pv0[r], f0); unpack8(pv1[r], f1);
#pragma unroll
                for (int i = 0; i < 8; ++i) {
                    const unsigned a = ka0[i >> 1], b = ka1[i >> 1];
                    const unsigned kk = (i & 1) ? ((a >> 16) | (b & 0xffff0000u)) : ((a & 0xffffu) | (b << 16));
                    const int o = ((pc * 8 + i) * RS) / 2 + jp;
                    Kt32[o] = kk; VtF32[o] = pkbf(f0[i] * fF0, f1[i] * fF1); VtB32[o] = pkbf(f0[i] * fB0, f1[i] * fB1);
                }
            }
        }
        __syncthreads();
        if (u + F.G < 5120) RS_LOAD(u + F.G);
        if (MODE == 1) { __syncthreads(); continue; }
        f32x4 aF[4][2], aB[4][2];
#pragma unroll
        for (int td = 0; td < 4; ++td)
#pragma unroll
            for (int te = 0; te < 2; ++te) { aF[td][te] = (f32x4){0.f, 0.f, 0.f, 0.f}; aB[td][te] = (f32x4){0.f, 0.f, 0.f, 0.f}; }
#pragma unroll
        for (int ks = 0; ks < 4; ++ks) {
            bf16x8 ka[4], vF[2], vB[2];
#pragma unroll
            for (int td = 0; td < 4; ++td) ka[td] = *(const LAS bf16x8*)(Kt + (64 * wd + 16 * td + lr) * RS + 32 * ks + lq * 8);
#pragma unroll
            for (int te = 0; te < 2; ++te) { vF[te] = *(const LAS bf16x8*)(VtF + (32 * we + 16 * te + lr) * RS + 32 * ks + lq * 8); vB[te] = *(const LAS bf16x8*)(VtB + (32 * we + 16 * te + lr) * RS + 32 * ks + lq * 8); }
#pragma unroll
            for (int td = 0; td < 4; ++td)
#pragma unroll
                for (int te = 0; te < 2; ++te) { aF[td][te] = MFMA16(ka[td], vF[te], aF[td][te]); aB[td][te] = MFMA16(ka[td], vB[te], aB[td][te]); }
        }
        __syncthreads();
        {
            LAS bf16* OutF = Kt; LAS bf16* OutB = Kt + 128 * RS;
#pragma unroll
            for (int td = 0; td < 4; ++td)
#pragma unroll
                for (int te = 0; te < 2; ++te) {
                    const int e = 32 * we + 16 * te + lr, d = 64 * wd + 16 * td + 4 * lq;
                    v2u w; w.x = pkbf(aF[td][te][0], aF[td][te][1]); w.y = pkbf(aF[td][te][2], aF[td][te][3]); *(LAS v2u*)(OutF + e * RS + d) = w;
                    v2u x; x.x = pkbf(aB[td][te][0], aB[td][te][1]); x.y = pkbf(aB[td][te][2], aB[td][te][3]); *(LAS v2u*)(OutB + e * RS + d) = x;
                }
            __syncthreads();
            const int tq = opaque(tid);
#pragma unroll
            for (int r = 0; r < 8; ++r) { const int f = tq + 512 * r, mat = f >> 11, row = (f >> 4) & 127, pc = f & 15;
                const v4u q = *(const LAS v4u*)(Kt + (mat * 128 + row) * RS + pc * 8);
                bf16* dst = (mat ? STB : STF) + ((size_t)(c * 4 + h) * 256 + eh * 128 + row) * 256 + dh * 128 + pc * 8;
                *(v4u*)dst = q; }
        }
        __syncthreads();
    }
#undef RS_LOAD
}
__device__ __forceinline__ void ret_prefix_phase(const Frame& F, CArgs& A) {
    bf16* STF = (bf16*)(F.ws + WS_STF); bf16* STB = (bf16*)(F.ws + WS_STB);
    for (size_t it = F.gtid; it < (size_t)36 * 2 * 8192; it += F.NT) {
        const int o = (int)(it & 8191), which = (int)((it >> 13) & 1), bh = (int)(it >> 14), h = bh & 3, s = bh >> 2;
        const int c0 = s < 8 ? s * 32 : 256, n = s < 8 ? 32 : 64;
        const float dec = exp2f(128.0f * ret_log2_gamma(h));
        float st[8];
#pragma unroll
        for (int k = 0; k < 8; ++k) st[k] = 0.f;
        bf16* base = (which ? STB : STF) + (size_t)h * 65536 + (size_t)o * 8;
        for (int k0 = 0; k0 < n; k0 += 8) {
            v4u q[8];
#pragma unroll
            for (int kk = 0; kk < 8; ++kk) { const int c = which ? (c0 + n - 1 - (k0 + kk)) : (c0 + k0 + kk); q[kk] = *(const v4u*)(base + (size_t)c * 4 * 65536); }
#pragma unroll
            for (int kk = 0; kk < 8; ++kk) { const int c = which ? (c0 + n - 1 - (k0 + kk)) : (c0 + k0 + kk);
                float f[8]; unpack8(q[kk], f);
#pragma unroll
                for (int i = 0; i < 8; ++i) st[i] = dec * st[i] + f[i];
                *(v4u*)(base + (size_t)c * 4 * 65536) = pack8(st); }
        }
    }
}
__device__ __forceinline__ void ret_out_phase(const Frame& F, CArgs& A) {
    const bf16* H = (const bf16*)(F.ws + WS_H); const bf16* STF = (const bf16*)(F.ws + WS_STF); const bf16* STB = (const bf16*)(F.ws + WS_STB);
    bf16* CC = (bf16*)(F.ws + WS_CONCAT);
    LAS bf16* RA = (LAS bf16*)F.lds; LAS bf16* RB = RA + 128 * RS; LAS bf16* RC = RA + 384 * RS;
    const int tid = F.tid, wi = F.wave >> 2, wj = F.wave & 3, we = F.wave & 3;
    for (int u = F.bx; u < 1280; u += F.G) {
        const int lane = opaque(F.lane), lr = lane & 15, lq = lane >> 4;
        const int h = u & 3, c = u >> 2, t0 = c * 128;
        const int cs = c < 256 ? (c & 31) : (c - 256), ncs = c < 256 ? 32 : 64;
        const bool has_f = cs > 0, has_b = cs < ncs - 1;
        const float lg = ret_log2_gamma(h);
        const int tq = opaque(tid);
        v4u pa[4], pb[8];
#define RO_LOAD_QK(dh_) do { _Pragma("unroll") for (int r = 0; r < 4; ++r) { const int f = tq + 512 * r, row = f >> 4, pc = f & 15; \
            const bf16* src = H + (size_t)(t0 + row) * INW + h * 256 + (dh_) * 128 + pc * 8; pa[r] = *(const v4u*)(src + COL_Q); pb[r] = *(const v4u*)(src + COL_K); } } while (0)
#define RO_STORE_QK() do { _Pragma("unroll") for (int r = 0; r < 4; ++r) { const int f = tq + 512 * r, row = f >> 4, pc = f & 15; \
            *(LAS v4u*)(RA + row * RS + pc * 8) = pa[r]; *(LAS v4u*)(RB + row * RS + pc * 8) = pb[r]; } } while (0)
#define RO_LOAD_V() do { const int jp_ = tq & 63, pc0_ = tq >> 6; const bf16* vrow = H + (size_t)(t0 + 2 * jp_) * INW + COL_V + h * 256; \
            _Pragma("unroll") for (int r = 0; r < 4; ++r) { const int pc = pc0_ + 8 * r; pb[r] = *(const v4u*)(vrow + pc * 8); pb[4 + r] = *(const v4u*)(vrow + INW + pc * 8); } } while (0)
#define RO_STORE_V() do { const int jp_ = tq & 63, pc0_ = tq >> 6; LAS unsigned* RB32 = (LAS unsigned*)RB; \
            _Pragma("unroll") for (int r = 0; r < 4; ++r) { const int pc = pc0_ + 8 * r; \
                const unsigned va0[4] = {pb[r].x, pb[r].y, pb[r].z, pb[r].w}, va1[4] = {pb[4 + r].x, pb[4 + r].y, pb[4 + r].z, pb[4 + r].w}; \
                _Pragma("unroll") for (int i = 0; i < 8; ++i) { const unsigned a = va0[i >> 1], b = va1[i >> 1]; \
                    RB32[((pc * 8 + i) * RS) / 2 + jp_] = (i & 1) ? ((a >> 16) | (b & 0xffff0000u)) : ((a & 0xffffu) | (b << 16)); } } } while (0)
#define RO_LOAD_I(dir_, dh_) do { const bool has_ = (dir_) == 0 ? has_f : has_b; const int cn_ = (dir_) == 0 ? c - 1 : c + 1; \
            const bf16* St = ((dir_) == 0 ? STF : STB) + (size_t)((has_ ? cn_ : c) * 4 + h) * 65536; \
            _Pragma("unroll") for (int r = 0; r < 8; ++r) { const int f = tq + 512 * r, row = f >> 4, pc = f & 15; pb[r] = has_ ? *(const v4u*)(St + (size_t)row * 256 + (dh_) * 128 + pc * 8) : (v4u){0u, 0u, 0u, 0u}; } } while (0)
#define RO_STORE_I(dir_, dh_) do { \
            _Pragma("unroll") for (int r = 0; r < 4; ++r) { const int f = tq + 512 * r, row = f >> 4, pc = f & 15; pa[r] = *(const v4u*)(H + (size_t)(t0 + row) * INW + COL_Q + h * 256 + (dh_) * 128 + pc * 8); } \
            _Pragma("unroll") for (int r = 0; r < 4; ++r) { const int f = tq + 512 * r, row = f >> 4, pc = f & 15; \
                const float fac = exp2f(lg * ((dir_) == 0 ? (float)(row + 1) : (float)(128 - row))); float qf[8]; unpack8(pa[r], qf); \
                _Pragma("unroll") for (int k = 0; k < 8; ++k) qf[k] *= fac; \
                *(LAS v4u*)(RA + row * RS + pc * 8) = pack8(qf); } \
            _Pragma("unroll") for (int r = 0; r < 8; ++r) { const int f = tq + 512 * r, row = f >> 4, pc = f & 15; *(LAS v4u*)(RB + row * RS + pc * 8) = pb[r]; } } while (0)
        f32x4 S[4][2];
#pragma unroll
        for (int ti = 0; ti < 4; ++ti)
#pragma unroll
            for (int tj = 0; tj < 2; ++tj) S[ti][tj] = (f32x4){0.f, 0.f, 0.f, 0.f};
        RO_LOAD_QK(0);
#pragma unroll
        for (int dh = 0; dh < 2; ++dh) {
            if (dh) __syncthreads();
            RO_STORE_QK();
            __syncthreads();
            if (dh == 0) RO_LOAD_QK(1); else RO_LOAD_V();
#pragma unroll
            for (int ks = 0; ks < 4; ++ks) {
                bf16x8 ka[2], qb[4];
#pragma unroll
                for (int tj = 0; tj < 2; ++tj) ka[tj] = *(const LAS bf16x8*)(RB + (32 * wj + 16 * tj + lr) * RS + 32 * ks + lq * 8);
#pragma unroll
                for (int ti = 0; ti < 4; ++ti) qb[ti] = *(const LAS bf16x8*)(RA + (64 * wi + 16 * ti + lr) * RS + 32 * ks + lq * 8);
#pragma unroll
                for (int ti = 0; ti < 4; ++ti)
#pragma unroll
                    for (int tj = 0; tj < 2; ++tj) S[ti][tj] = MFMA16(ka[tj], qb[ti], S[ti][tj]);
            }
        }
#pragma unroll
        for (int ti = 0; ti < 4; ++ti)
#pragma unroll
            for (int tj = 0; tj < 2; ++tj) {
                const int i = 64 * wi + 16 * ti + lr, j0 = 32 * wj + 16 * tj + 4 * lq; float p[4];
#pragma unroll
                for (int jj = 0; jj < 4; ++jj) { const int d = i - (j0 + jj); p[jj] = S[ti][tj][jj] * exp2f(lg * (float)(d < 0 ? -d : d)); }
                v2u w; w.x = pkbf(p[0], p[1]); w.y = pkbf(p[2], p[3]); *(LAS v2u*)(RC + i * RS + j0) = w;
            }
        __syncthreads();
        RO_STORE_V();
        __syncthreads();
        RO_LOAD_I(0, 0);
        f32x4 O[4][4];
#pragma unroll
        for (int ti = 0; ti < 4; ++ti)
#pragma unroll
            for (int te = 0; te < 4; ++te) O[ti][te] = (f32x4){0.f, 0.f, 0.f, 0.f};
#pragma unroll
        for (int ks = 0; ks < 4; ++ks) {
            bf16x8 va[4], pbf[4];
#pragma unroll
            for (int te = 0; te < 4; ++te) va[te] = *(const LAS bf16x8*)(RB + (64 * we + 16 * te + lr) * RS + 32 * ks + lq * 8);
#pragma unroll
            for (int ti = 0; ti < 4; ++ti) pbf[ti] = *(const LAS bf16x8*)(RC + (64 * wi + 16 * ti + lr) * RS + 32 * ks + lq * 8);
#pragma unroll
            for (int ti = 0; ti < 4; ++ti)
#pragma unroll
                for (int te = 0; te < 4; ++te) O[ti][te] = MFMA16(va[te], pbf[ti], O[ti][te]);
        }
#pragma unroll
        for (int stg = 0; stg < 4; ++stg) {
            __syncthreads();
            if (stg == 0) RO_STORE_I(0, 0); else if (stg == 1) RO_STORE_I(0, 1); else if (stg == 2) RO_STORE_I(1, 0); else RO_STORE_I(1, 1);
            __syncthreads();
            if (stg == 0) RO_LOAD_I(0, 1); else if (stg == 1) RO_LOAD_I(1, 0); else if (stg == 2) RO_LOAD_I(1, 1);
#pragma unroll
            for (int ks = 0; ks < 4; ++ks) {
                bf16x8 sa[4], qb[4];
#pragma unroll
                for (int te = 0; te < 4; ++te) sa[te] = *(const LAS bf16x8*)(RB + (64 * we + 16 * te + lr) * RS + 32 * ks + lq * 8);
#pragma unroll
                for (int ti = 0; ti < 4; ++ti) qb[ti] = *(const LAS bf16x8*)(RA + (64 * wi + 16 * ti + lr) * RS + 32 * ks + lq * 8);
#pragma unroll
                for (int ti = 0; ti < 4; ++ti)
#pragma unroll
                    for (int te = 0; te < 4; ++te) O[ti][te] = MFMA16(sa[te], qb[ti], O[ti][te]);
            }
        }
#undef RO_LOAD_QK
#undef RO_STORE_QK
#undef RO_LOAD_V
#undef RO_STORE_V
#undef RO_LOAD_I
#undef RO_STORE_I
        __syncthreads();
        LAS float* RED = (LAS float*)RA;
#pragma unroll
        for (int ti = 0; ti < 4; ++ti) { float s1 = 0.f, s2 = 0.f;
#pragma unroll
            for (int te = 0; te < 4; ++te)
#pragma unroll
                for (int jj = 0; jj < 4; ++jj) { const float v = O[ti][te][jj]; s1 += v; s2 += v * v; }
            s1 += __shfl_xor(s1, 16); s1 += __shfl_xor(s1, 32); s2 += __shfl_xor(s2, 16); s2 += __shfl_xor(s2, 32);
            if (lq == 0) { RED[((64 * wi + 16 * ti + lr) * 4 + we) * 2] = s1; RED[((64 * wi + 16 * ti + lr) * 4 + we) * 2 + 1] = s2; } }
        __syncthreads();
        LAS bf16* ON = RB;
#pragma unroll
        for (int ti = 0; ti < 4; ++ti) { const int i = 64 * wi + 16 * ti + lr;
            const f32x4 r0 = *(const LAS f32x4*)(RED + i * 8), r1 = *(const LAS f32x4*)(RED + i * 8 + 4);
            const float m = (r0[0] + r0[2] + r1[0] + r1[2]) * (1.0f / 256.0f), q = (r0[1] + r0[3] + r1[1] + r1[3]) * (1.0f / 256.0f);
            const float var = fmaxf(q - m * m, 0.f), rstd = 1.0f / sqrtf(var + GN_EPS);
#pragma unroll
            for (int te = 0; te < 4; ++te) { const int e0 = 64 * we + 16 * te + 4 * lq;
                v2u w; w.x = pkbf((O[ti][te][0] - m) * rstd, (O[ti][te][1] - m) * rstd); w.y = pkbf((O[ti][te][2] - m) * rstd, (O[ti][te][3] - m) * rstd);
                *(LAS v2u*)(ON + i * 264 + e0) = w; } }
        __syncthreads();
        {
            const int tq2 = opaque(tid);
#pragma unroll
            for (int r = 0; r < 8; ++r) { const int f = tq2 + 512 * r, row = f >> 5, pc = f & 31;
                float ov[8], gv[8]; unpack8(*(const LAS v4u*)(ON + row * 264 + pc * 8), ov); unpack8(*(const v4u*)(H + (size_t)(t0 + row) * INW + COL_G + h * 256 + pc * 8), gv);
#pragma unroll
                for (int k = 0; k < 8; ++k) ov[k] = (gv[k] / (1.0f + __expf(-gv[k]))) * ov[k];
                *(v4u*)(CC + (size_t)(t0 + row) * DM + 1024 + h * 256 + pc * 8) = pack8(ov); }
        }
        __syncthreads();
    }
}

__device__ __forceinline__ unsigned f2key(float f) { const unsigned u = __float_as_uint(f); return (u & 0x80000000u) ? ~u : (u | 0x80000000u); }
__device__ __forceinline__ float key2f(unsigned k) { const unsigned u = (k & 0x80000000u) ? (k & 0x7fffffffu) : ~k; return __uint_as_float(u); }
#define TK_CE(a, b) do { const unsigned hi_ = (a) > (b) ? (a) : (b), lo_ = (a) > (b) ? (b) : (a); (a) = hi_; (b) = lo_; } while (0)
__device__ __forceinline__ void bitonic_merge16(unsigned (&v)[16]) {
#pragma unroll
    for (int j = 8; j > 0; j >>= 1)
#pragma unroll
        for (int i = 0; i < 16; ++i) { const int l = i ^ j; if (l > i) TK_CE(v[i], v[l]); }
}
__device__ __forceinline__ void bitonic_sort16(unsigned (&v)[16]) {
#pragma unroll
    for (int k = 2; k <= 16; k <<= 1)
#pragma unroll
        for (int j = k >> 1; j > 0; j >>= 1)
#pragma unroll
            for (int i = 0; i < 16; ++i) { const int l = i ^ j; if (l > i) { if ((i & k) == 0) TK_CE(v[i], v[l]); else TK_CE(v[l], v[i]); } }
}
__device__ __forceinline__ void topk_phase(const Frame& F, CArgs& A) {
    const _Float16* SC = (const _Float16*)(F.ws + WS_H); int* IDX = (int*)(F.ws + WS_IDX); float* GATE = (float*)(F.ws + WS_GATE);
    typedef _Float16 h8 __attribute__((ext_vector_type(8)));
    LAS unsigned* LK = (LAS unsigned*)F.lds;
    const int tid = F.tid, tl = tid >> 4, hp = tid & 15;
    for (int blk = F.bx; blk < NTOK / 32; blk += F.G) {
        const int t = blk * 32 + tl;
        const _Float16* row = SC + (size_t)t * DM + hp * 128;
        unsigned run[16];
#pragma unroll
        for (int k = 0; k < 16; ++k) run[k] = 0u;
        h8 cur[16];
#pragma unroll
        for (int q = 0; q < 16; ++q) cur[q] = *(const h8*)(row + q * 8);
#pragma unroll
        for (int c16 = 0; c16 < 8; ++c16) {
            unsigned ch[16];
#pragma unroll
            for (int q = 0; q < 2; ++q)
#pragma unroll
                for (int e = 0; e < 8; ++e) { const int n = c16 * 16 + q * 8 + e; ch[q * 8 + e] = (f2key((float)cur[c16 * 2 + q][e]) & ~127u) | (unsigned)(127 - n); }
            bitonic_sort16(ch);
#pragma unroll
            for (int i = 0; i < 16; ++i) run[i] = run[i] > ch[15 - i] ? run[i] : ch[15 - i];
            bitonic_merge16(run);
        }
#pragma unroll
        for (int k = 0; k < 16; ++k) LK[tid * 17 + k] = run[k];
        __syncthreads();
        if ((hp & 1) == 0) {
            float a[16], b[16];
#pragma unroll
            for (int k = 0; k < 16; ++k) { a[k] = key2f(LK[tid * 17 + k] & ~127u); b[k] = key2f(LK[(tid + 1) * 17 + k] & ~127u); }
            unsigned sk[16];
#pragma unroll
            for (int k = 0; k < 16; ++k) sk[k] = 0u;
#pragma unroll
            for (int i = 0; i < 16; ++i)
#pragma unroll
                for (int j = 0; j < 16; ++j) if ((i + 1) * (j + 1) <= 16) {
                    unsigned key = (f2key(a[i] + b[j]) & ~255u) | (unsigned)(255 - (i * 16 + j));
#pragma unroll
                    for (int k = 0; k < 16; ++k) { const unsigned hi = sk[k] > key ? sk[k] : key, lo = sk[k] > key ? key : sk[k]; sk[k] = hi; key = lo; }
                }
            float e[16], sum = 0.f; const float s0 = key2f(sk[0] & ~255u);
#pragma unroll
            for (int k = 0; k < 16; ++k) { e[k] = __expf(key2f(sk[k] & ~255u) - s0); sum += e[k]; }
            const float inv = 1.0f / sum; const int head = hp >> 1;
#pragma unroll
            for (int k = 0; k < 16; ++k) {
                const int cell = 255 - (int)(sk[k] & 255u);
                const int i1 = 127 - (int)(LK[tid * 17 + (cell >> 4)] & 127u), i2 = 127 - (int)(LK[(tid + 1) * 17 + (cell & 15)] & 127u);
                IDX[(size_t)t * 128 + head * 16 + k] = i1 * 128 + i2;
                GATE[(size_t)t * 128 + head * 16 + k] = e[k] * inv;
            }
        }
        __syncthreads();
    }
}
typedef int v8i __attribute__((ext_vector_type(8)));
__device__ __forceinline__ void peer_gather_phase(const Frame& F, CArgs& A, int l, float* xdst_base, bf16* XN) {
    constexpr int RB = DM / 2;
    constexpr int GNR = GATHER_ROWS;
    const unsigned char* U8 = F.ws + WS_U8 + (size_t)l * NEXP * RB; const unsigned char* V8 = F.ws + WS_V8 + (size_t)l * NEXP * RB;
    const float* USC = (const float*)(F.ws + WS_USC) + (size_t)l * NEXP; const float* VSC = (const float*)(F.ws + WS_VSC) + (size_t)l * NEXP;
    const int* IDX = (const int*)(F.ws + WS_IDX); const float* GATE = (const float*)(F.ws + WS_GATE);
    const float* g2 = GIN(A, I_LN2G) + (size_t)l * DM; const float* b2 = GIN(A, I_LN2B) + (size_t)l * DM;
    LAS unsigned char* XF8 = F.lds + F.wave * 2560;
    LAS float* HS = (LAS float*)(F.lds + F.wave * 2560 + 2048);
    const int lane = F.lane, lr = lane & 15, lq = lane >> 4;
    for (int t = F.gw; t < NTOK; t += F.NGW) {
        const bf16* xrow = XN + (size_t)t * DM;
        {
            v4u w0, w1;
#pragma unroll
            for (int j = 0; j < 8; ++j) { const v2u a = *(const v2u*)(xrow + j * 256 + lane * 4); int pk = 0;
                pk = __builtin_amdgcn_cvt_pk_fp8_f32(bf_lo(a.x), bf_hi(a.x), pk, false); pk = __builtin_amdgcn_cvt_pk_fp8_f32(bf_lo(a.y), bf_hi(a.y), pk, true);
                if (j < 4) w0[j] = (unsigned)pk; else w1[j - 4] = (unsigned)pk; }
            *(LAS v4u*)(XF8 + lane * 32) = w0; *(LAS v4u*)(XF8 + lane * 32 + 16) = w1;
        }
        const int idx0 = IDX[(size_t)t * 128 + lane], idx1 = IDX[(size_t)t * 128 + 64 + lane];
        const float gate0 = GATE[(size_t)t * 128 + lane], gate1 = GATE[(size_t)t * 128 + 64 + lane];
        const float usc0 = USC[idx0], usc1 = USC[idx1], vsc0 = VSC[idx0], vsc1 = VSC[idx1];
        unsigned rowoff[8];
#pragma unroll
        for (int g = 0; g < 8; ++g) rowoff[g] = (unsigned)__shfl((g >> 2) ? idx1 : idx0, (g & 3) * 16 + lr) * (unsigned)RB + (unsigned)lq * 16u;
        v4u AB[8][2];
#pragma unroll
        for (int g = 0; g < 8; ++g) { AB[g][0] = *(const v4u*)(U8 + rowoff[g]); AB[g][1] = *(const v4u*)(U8 + rowoff[g] + 64); }
        f32x4 hacc[8];
#pragma unroll
        for (int g = 0; g < 8; ++g) hacc[g] = (f32x4){0.f, 0.f, 0.f, 0.f};
        LDS_WAIT();
#pragma unroll 1
        for (int kp = 0; kp < 8; ++kp) {
            const LAS unsigned char* xq = XF8 + ((2 * kp) * 4 + (lq >> 1)) * 32 + 16 * (lq & 1);
            const v4u b00 = *(const LAS v4u*)xq, b01 = *(const LAS v4u*)(xq + 64), b10 = *(const LAS v4u*)(xq + 128), b11 = *(const LAS v4u*)(xq + 192);
            const v8i B0 = (v8i){(int)b00[0], (int)b00[1], (int)b00[2], (int)b00[3], (int)b01[0], (int)b01[1], (int)b01[2], (int)b01[3]};
            const v8i B1 = (v8i){(int)b10[0], (int)b10[1], (int)b10[2], (int)b10[3], (int)b11[0], (int)b11[1], (int)b11[2], (int)b11[3]};
#pragma unroll
            for (int g = 0; g < 8; ++g) {
                const v8i A0 = (v8i){(int)AB[g][0][0], (int)AB[g][0][1], (int)AB[g][0][2], (int)AB[g][0][3], 0, 0, 0, 0};
                const v8i A1 = (v8i){(int)AB[g][1][0], (int)AB[g][1][1], (int)AB[g][1][2], (int)AB[g][1][3], 0, 0, 0, 0};
                hacc[g] = __builtin_amdgcn_mfma_scale_f32_16x16x128_f8f6f4(A0, B0, hacc[g], 4, 0, 0, 0x7f7f7f7f, 0, 0x7f7f7f7f);
                hacc[g] = __builtin_amdgcn_mfma_scale_f32_16x16x128_f8f6f4(A1, B1, hacc[g], 4, 0, 0, 0x7f7f7f7f, 0, 0x7f7f7f7f);
                if (kp < 7) { AB[g][0] = *(const v4u*)(U8 + rowoff[g] + (kp + 1) * 128); AB[g][1] = *(const v4u*)(U8 + rowoff[g] + (kp + 1) * 128 + 64); }
            }
        }
        if (lr == 0) {
#pragma unroll
            for (int g = 0; g < 8; ++g) *(LAS f32x4*)(HS + g * 16 + 4 * lq) = hacc[g];
        }
        LDS_WAIT();
        const float hval0 = HS[lane], hval1 = HS[64 + lane];
        const float w0 = gate0 * gelu_erf(hval0 * usc0) * vsc0, w1 = gate1 * gelu_erf(hval1 * usc1) * vsc1;
        v4u BU[GNR];
        const unsigned loff = (unsigned)lane * 16u;
#define G_ROW_V(R) (V8 + (size_t)(unsigned)__builtin_amdgcn_readlane((((R) >> 6) & 1) ? idx1 : idx0, (R) & 63) * RB)
#define G_REQ(r, rowptr) do { BU[r] = *(const v4u*)((rowptr) + loff); } while (0)
#pragma unroll
        for (int r = 0; r < GNR; ++r) G_REQ(r, G_ROW_V(r));
        f32x2v acc[16];
#pragma unroll
        for (int k = 0; k < 16; ++k) acc[k] = (f32x2v){0.f, 0.f};
#define G_AXPY(r, R) do { const float w_ = __uint_as_float((unsigned)__builtin_amdgcn_readlane((int)__float_as_uint((((R) >> 6) & 1) ? w1 : w0), (R) & 63)); const f32x2v w2_ = (f32x2v){w_, w_}; \
            _Pragma("unroll") for (int q = 0; q < 4; ++q) { acc[4 * q] += w2_ * __builtin_amdgcn_cvt_scalef32_pk_f32_fp4(BU[r][q], 1.0f, 0); acc[4 * q + 1] += w2_ * __builtin_amdgcn_cvt_scalef32_pk_f32_fp4(BU[r][q], 1.0f, 1); \
                acc[4 * q + 2] += w2_ * __builtin_amdgcn_cvt_scalef32_pk_f32_fp4(BU[r][q], 1.0f, 2); acc[4 * q + 3] += w2_ * __builtin_amdgcn_cvt_scalef32_pk_f32_fp4(BU[r][q], 1.0f, 3); } } while (0)
        for (int it = 0; it < 128 / GNR - 1; ++it) {
#pragma unroll
            for (int r = 0; r < GNR; ++r) { G_AXPY(r, GNR * it + r); G_REQ(r, G_ROW_V(GNR * (it + 1) + r)); }
        }
#pragma unroll
        for (int r = 0; r < GNR; ++r) G_AXPY(r, 128 - GNR + r);
#undef G_ROW_V
#undef G_REQ
#undef G_AXPY
        const int le = opaque(lane);
        float s = 0.f;
#pragma unroll
        for (int j = 0; j < 8; ++j) { const v2u xr = *(const v2u*)(xrow + j * 256 + le * 4);
            acc[2 * j] = (f32x2v){bf_lo(xr.x), bf_hi(xr.x)} * ALPHA + acc[2 * j]; acc[2 * j + 1] = (f32x2v){bf_lo(xr.y), bf_hi(xr.y)} * ALPHA + acc[2 * j + 1];
            s += (acc[2 * j][0] + acc[2 * j][1]) + (acc[2 * j + 1][0] + acc[2 * j + 1][1]); }
        const float mean = wave_sum(s) * (1.0f / DM); float s2 = 0.f;
#pragma unroll
        for (int k = 0; k < 16; ++k) { acc[k] = acc[k] - mean; s2 += acc[k][0] * acc[k][0] + acc[k][1] * acc[k][1]; }
        const float rstd = 1.0f / sqrtf(wave_sum(s2) * (1.0f / DM) + LN_EPS);
#pragma unroll
        for (int j = 0; j < 8; ++j) { const int col = j * 256 + le * 4;
            const f32x4 gg = *(const f32x4*)(g2 + col), bb = *(const f32x4*)(b2 + col);
            const f32x2v a0 = acc[2 * j], a1 = acc[2 * j + 1];
            const f32x4 o = (f32x4){a0[0] * rstd * gg[0] + bb[0], a0[1] * rstd * gg[1] + bb[1], a1[0] * rstd * gg[2] + bb[2], a1[1] * rstd * gg[3] + bb[3]};
            if (xdst_base) *(f32x4*)(xdst_base + (size_t)t * DM + col) = o;
            v2u w; w.x = pkbf(o[0], o[1]); w.y = pkbf(o[2], o[3]); *(v2u*)(XN + (size_t)t * DM + col) = w; }
        LDS_WAIT();
    }
}

#ifndef DUP_MASK
#define DUP_MASK 0
#endif
#ifndef PHASE_TEST_ONLY
__global__ void __launch_bounds__(NTHR, 2) fwd_kernel(Args A) {
    extern __shared__ __attribute__((aligned(16))) unsigned char lds_raw[];
#define MKFRAME() Frame F; CArgs& KA = *(CArgs*)opaque_u64((unsigned long long)__builtin_amdgcn_kernarg_segment_ptr()); { F.lds = (LAS unsigned char*)lds_raw; F.tid = opaque((int)threadIdx.x); F.lane = F.tid & 63; F.wave = __builtin_amdgcn_readfirstlane(F.tid >> 6); \
        const int bx_ = opaque_s((int)blockIdx.x); F.G = gridDim.x; F.gw = bx_ * NWAVES + F.wave; F.NGW = F.G * NWAVES; F.gtid = (size_t)bx_ * NTHR + F.tid; F.NT = (size_t)F.G * NTHR; F.out = (float*)(float GAS*)opaque_g((unsigned char GAS*)KA.out); F.ws = (unsigned char*)opaque_g(KA.ws); F.bx = bx_; } \
        bf16* XN = (bf16*)(F.ws + WS_XN); bf16* H = (bf16*)(F.ws + WS_H); bf16* CC = (bf16*)(F.ws + WS_CONCAT); (void)XN; (void)H; (void)CC;
    volatile LAS unsigned* MISC = (volatile LAS unsigned*)((LAS unsigned char*)lds_raw + LDS_MISC);
    if (threadIdx.x < 64) MISC[threadIdx.x] = 0u;
    __syncthreads();
    XcdBarrier bar = xcd_barrier_post((unsigned*)(A.ws + WS_CTL) + CW_BAR + A.li * XCD_BAR_WORDS, MISC + 8);
    const int lo = A.ph_lo, hi = A.ph_hi;
#define IN(k) (lo <= (k) && (k) < hi)
#define SEAM(k) do { if (lo <= (k) && (k) + 1 < hi) xcd_barrier(bar); } while (0)

    if (IN(0)) { MKFRAME(); p0_prologue(F, KA); if (DUP_MASK & 256) { __syncthreads(); p0_prologue(F, KA); } } SEAM(0);

    for (int l = 0; l < NLAYER; ++l) {
        const int pb = 1 + l * 10;
        if (IN(pb + 0)) { MKFRAME();
            pg8::Gemm g{XN, (const bf16*)(F.ws + WS_WIN) + (size_t)l * INW * DM, NTOK, INW, DM}; pg8::StaticOrder S; S.init(NTOK, INW, F.G, F.bx);
            EpiStoreRot E{H, INW, (const float*)(F.ws + WS_ROTC), (const float*)(F.ws + WS_ROTS)};
            pg8::gemm_phase<EpiStoreRot, pg8::StaticOrder, true, true>(F.lds, g, S, E);
            if (DUP_MASK & 64) { pg8::gemm_phase<EpiStoreRot, pg8::StaticOrder, true, true>(F.lds, g, S, E); }
        } SEAM(pb + 0);
        if (IN(pb + 1)) { MKFRAME(); s5_pass1(F, KA, l); pool_phase(F, KA); if (DUP_MASK & 1) { s5_pass1(F, KA, l); } if (DUP_MASK & 2) { pool_phase(F, KA); } } SEAM(pb + 1);
        if (IN(pb + 2)) { MKFRAME(); s5_carry(F, KA, l); __syncthreads(); ret_state_phase(F, KA); if (DUP_MASK & 4) { ret_state_phase(F, KA); } if (DUP_MASK & 2048) { ret_state_phase<1>(F, KA); } if (DUP_MASK & 4096) { ret_state_phase<2>(F, KA); ret_state_phase(F, KA); } } SEAM(pb + 2);
        if (IN(pb + 3)) { MKFRAME(); s5_pass3(F, KA, l); if (DUP_MASK & 8) { s5_pass3(F, KA, l); } ret_prefix_phase(F, KA); } SEAM(pb + 3);
        if (IN(pb + 4)) { MKFRAME();
            __syncthreads();
            ret_out_phase(F, KA);
            if (DUP_MASK & 16) { ret_out_phase(F, KA); }
            {
                pg8::Gemm g{(const bf16*)(F.ws + WS_BUFY), (const bf16*)(F.ws + WS_WGLU) + (size_t)l * 512 * 512, NTOK, 512, 512}; pg8::StaticOrder S; S.init(NTOK, 512, F.G, F.bx);
                EpiGlu E{(const bf16*)(F.ws + WS_BUFY), 512, CC, DM, GIN(KA, I_BGLU) + (size_t)l * 512};
                pg8::gemm_phase<EpiGlu, pg8::StaticOrder, true, true>(F.lds, g, S, E);
                if (DUP_MASK & 512) { pg8::gemm_phase<EpiGlu, pg8::StaticOrder, true, true>(F.lds, g, S, E); }
            }
        } SEAM(pb + 4);
        if (IN(pb + 5)) { MKFRAME();
            pg8::Gemm g{CC, (const bf16*)(F.ws + WS_WOUT) + (size_t)l * DM * DM, NTOK, DM, DM}; pg8::StaticOrder S; S.init(NTOK, DM, F.G, F.bx);
            EpiStoreBf16 E{H, DM};
            pg8::gemm_phase<EpiStoreBf16, pg8::StaticOrder, true, true>(F.lds, g, S, E);
        } SEAM(pb + 5);
        if (IN(pb + 6)) { MKFRAME();
            ln_rows2(XN, H, ALPHA, GIN(KA, I_LN1G) + (size_t)l * DM, GIN(KA, I_LN1B) + (size_t)l * DM, F.gw, F.NGW, F.lane);
        } SEAM(pb + 6);
        if (IN(pb + 7)) { MKFRAME();
            pg8::Gemm g{XN, (const bf16*)(F.ws + WS_WS) + (size_t)l * DM * DM, NTOK, DM, DM}; pg8::StaticOrder S; S.init(NTOK, DM, F.G, F.bx);
            EpiStoreF16 E{(_Float16*)(F.ws + WS_H), DM};
            pg8::gemm_phase<EpiStoreF16, pg8::StaticOrder, true, true>(F.lds, g, S, E);
            if (DUP_MASK & 128) { pg8::gemm_phase<EpiStoreF16, pg8::StaticOrder, true, true>(F.lds, g, S, E); }
        } SEAM(pb + 7);
        if (IN(pb + 8)) { MKFRAME(); __syncthreads(); topk_phase(F, KA); if (DUP_MASK & 32) { topk_phase(F, KA); } } SEAM(pb + 8);
        if (IN(pb + 9)) { MKFRAME(); if (DUP_MASK & 1024) { peer_gather_phase(F, KA, l, (float*)(F.ws + WS_H), CC); } peer_gather_phase(F, KA, l, l == NLAYER - 1 ? F.out : (float*)nullptr, XN); } SEAM(pb + 9);
    }
#undef IN
#undef SEAM
}


#ifndef DBG_STOP
#define DBG_STOP NPHASE
#endif
#ifndef MK_ONE_LAUNCH
#define MK_ONE_LAUNCH 0
#endif
extern "C" void kernel_launch(void* const* d_in, const int* in_sizes, int n_in, void* d_out, int out_size, void* d_ws, size_t ws_size, hipStream_t stream) {
    static int grid = 0;
    if (grid == 0) {
        if (n_in != 26 || out_size != NTOK * DM || ws_size < WS_END) { fprintf(stderr, "kernel_launch: unexpected shapes (n_in %d out %d ws %zu)\n", n_in, out_size, ws_size); grid = -1; return; }
        int dev = 0, cus = 0, per_cu = 0;
        if (hipGetDevice(&dev) != hipSuccess || hipDeviceGetAttribute(&cus, hipDeviceAttributeMultiprocessorCount, dev) != hipSuccess) { grid = -1; return; }
        if (hipFuncSetAttribute((const void*)fwd_kernel, hipFuncAttributeMaxDynamicSharedMemorySize, LDS_BYTES) != hipSuccess) { fprintf(stderr, "kernel_launch: hipFuncSetAttribute failed\n"); grid = -1; return; }
        if (hipOccupancyMaxActiveBlocksPerMultiprocessor(&per_cu, (const void*)fwd_kernel, NTHR, LDS_BYTES) != hipSuccess || per_cu < 1) { fprintf(stderr, "kernel_launch: occupancy query says %d\n", per_cu); grid = -1; (void)hipGetLastError(); return; }
        (void)hipGetLastError();
        grid = cus;
    }
    if (grid < 0) return;
    if (hipMemsetAsync((char*)d_ws + WS_CTL, 0, CTL_ZERO_BYTES, stream) != hipSuccess) return;
    Args a{};
    for (int i = 0; i < 26; ++i) a.in[i] = (const float*)d_in[i];
    a.out = (float*)d_out; a.ws = (unsigned char*)d_ws; a.pad = 0;
#if MK_ONE_LAUNCH
    a.ph_lo = 0; a.ph_hi = NPHASE; a.li = 0;
    hipLaunchKernelGGL(fwd_kernel, dim3(grid), dim3(NTHR), LDS_BYTES, stream, a);
#else
    for (int p = 0; p < DBG_STOP; ++p) { a.ph_lo = p; a.ph_hi = p + 1; a.li = p; hipLaunchKernelGGL(fwd_kernel, dim3(grid), dim3(NTHR), LDS_BYTES, stream, a); }
#endif
}
#endif
```

```cpp
#include <hip/hip_runtime.h>
#include <cstdio>
#include <cstdint>
#include <cmath>
__device__ __forceinline__ __attribute__((convergent)) void mk_syncthreads() { __builtin_amdgcn_fence(__ATOMIC_RELEASE, "workgroup"); __builtin_amdgcn_s_barrier(); __builtin_amdgcn_fence(__ATOMIC_ACQUIRE, "workgroup"); }
#define __syncthreads mk_syncthreads
__device__ __forceinline__ int opaque(int v) { asm volatile("" : "+v"(v)); return v; }
__device__ __forceinline__ int opaque_s(int v) { asm volatile("" : "+s"(v)); return v; }
__device__ __forceinline__ void* opaque_p(void* p) { asm volatile("" : "+s"(p)); return p; }
__device__ __forceinline__ unsigned long long opaque_u64(unsigned long long v) { asm volatile("" : "+s"(v)); return v; }
#ifndef GATHER_ROWS
#define GATHER_ROWS 16
#endif
__device__ __forceinline__ __attribute__((address_space(1))) unsigned char* opaque_g(__attribute__((address_space(1))) unsigned char* p) { asm volatile("" : "+s"(p)); return p; }
#ifndef GEMM_ALIGN
#define GEMM_ALIGN true
#endif
#ifndef GEMM_SP2
#define GEMM_SP2 true
#endif
#define MK_ONE_LAUNCH 1
namespace pg8 {
#define PG8_LAS __attribute__((address_space(3)))
typedef unsigned short bf16_t;
typedef short bf16x8 __attribute__((ext_vector_type(8)));
typedef float f32x4 __attribute__((ext_vector_type(4)));
typedef unsigned u32x4 __attribute__((ext_vector_type(4)));
constexpr int BM = 256, BK = 64, HALF = 128, HTB = HALF * BK * 2  , STAGE_BYTES = 8 * HTB, NXCD = 8, WGM = 8;

__host__ __device__ __forceinline__ int lds_byte(int r, int c) { const int st = (r >> 4) * 2 + (c >> 5), rr = r & 15, cc = c & 31, ob = rr * 64 + cc * 2; return st * 1024 + (ob ^ (((ob >> 9) & 1) << 5)); }
__host__ __device__ __forceinline__ void stage_rc(int b, int& R, int& C) { const int st = b / 1024, sb = b % 1024, swz = sb ^ (((sb >> 9) & 1) << 5); R = (st >> 1) * 16 + swz / 64; C = (st & 1) * 32 + (swz % 64) / 2; }
__host__ __device__ __forceinline__ int perm32(int rho) { const int n = rho >> 4, i = rho & 15; return 8 * (i >> 2) + 4 * n + (i & 3); }

struct Unit { int pm, pn; };
struct Gemm { const bf16_t* A; const bf16_t* Bt; int M, N, K; };

struct StaticOrder {
    int nM, nN, nwg, G, c;
    __host__ __device__ __forceinline__ void init(int M, int N, int G_, int c_) { nM = M / BM; nN = N / BM; nwg = nM * nN; G = G_; c = c_; }
    __host__ __device__ bool next(int i, Unit& u) const {
        const long L = (long)i * G + c; if (L >= nwg) return false;
        int wgid = (int)L; { const int q = nwg / NXCD, r = nwg % NXCD, xcd = wgid % NXCD, off = wgid / NXCD; wgid = (xcd < r ? xcd * (q + 1) : r * (q + 1) + (xcd - r) * q) + off; }
        const int nig = WGM * nN, gid = wgid / nig, fm = gid * WGM, gsz = (nM - fm) < WGM ? (nM - fm) : WGM;
        u.pm = fm + ((wgid % nig) % gsz); u.pn = (wgid % nig) / gsz; return true;
    }
    __device__ __forceinline__ void a_ready(const Unit&) const {}
    __device__ __forceinline__ void done(const Unit&) const {}
};
__device__ __forceinline__ unsigned cvt_pk_bf16(float lo, float hi) { unsigned r; asm volatile("v_cvt_pk_bf16_f32 %0, %1, %2" : "=v"(r) : "v"(lo), "v"(hi)); return r; }
typedef float f32x2 __attribute__((ext_vector_type(2)));
template <class Epi, class Sched, bool ALIGN_EPI = false, bool SP2 = false>
__device__ __forceinline__ void gemm_phase(PG8_LAS unsigned char* lds, const Gemm g, const Sched& S, const Epi& E) {
    const int tid = opaque((int)threadIdx.x), wid = __builtin_amdgcn_readfirstlane(tid >> 6), lane = tid & 63, wr = wid >> 2, wc = wid & 3, fr = lane & 15, fq = lane >> 4;
    const int K = g.K, nt = K / BK;
    unsigned voffA[2], voffB[2];
#pragma unroll
    for (int i = 0; i < 2; ++i) { int R, C; stage_rc(tid * 16 + i * 8192, R, C); const int Rb = Epi::PERM ? ((R & ~31) + perm32(R & 31)) : R;
        voffA[i] = (unsigned)(R * K + C) * 2u; voffB[i] = (unsigned)(Rb * K + C) * 2u; }
    const size_t kstep = (size_t)(BK * 2);
    const size_t hstep = (size_t)HALF * K * 2;
    const size_t tstep = 2 * hstep;
    const unsigned ldsw = (unsigned)wid * 1024u;
    const int aoff = lds_byte(wr * 64 + fr, fq * 8), boff = lds_byte(wc * 32 + fr, fq * 8);
#define PG8_SA(b, h) (((b) * 2 + (h)) * HTB)
#define PG8_SB(b, h) ((4 + (b) * 2 + (h)) * HTB)
#define PG8_STAGE(bufoff, gbase, voff) do { _Pragma("unroll") for (int _i = 0; _i < 2; ++_i) \
        __builtin_amdgcn_global_load_lds((const unsigned*)((const char*)(gbase) + (voff)[_i]), (PG8_LAS unsigned*)(lds + (bufoff) + ldsw + _i * 8192), 16, 0, 0); } while (0)
#define PG8_LDA(dst, b, h) do { _Pragma("unroll") for (int m = 0; m < 4; ++m) _Pragma("unroll") for (int k = 0; k < 2; ++k) dst[m][k] = *(const PG8_LAS bf16x8*)(lds + PG8_SA(b, h) + aoff + m * 2048 + k * 1024); } while (0)
#define PG8_LDB(dst, b, h) do { _Pragma("unroll") for (int n = 0; n < 2; ++n) _Pragma("unroll") for (int k = 0; k < 2; ++k) dst[n][k] = *(const PG8_LAS bf16x8*)(lds + PG8_SB(b, h) + boff + n * 2048 + k * 1024); } while (0)
#define PG8_MMA(ai, bj, At, Bt) do { __builtin_amdgcn_s_setprio(1); _Pragma("unroll") for (int m = 0; m < 4; ++m) _Pragma("unroll") for (int n = 0; n < 2; ++n) _Pragma("unroll") for (int k = 0; k < 2; ++k) \
        acc[ai][bj][m][n] = __builtin_amdgcn_mfma_f32_16x16x32_bf16(Bt[n][k], At[m][k], acc[ai][bj][m][n], 0, 0, 0); __builtin_amdgcn_s_setprio(0); } while (0)
#define PG8_WAIT_V(n) asm volatile("s_waitcnt vmcnt(" #n ")" ::: "memory")
#define PG8_WAIT_L(n) asm volatile("s_waitcnt lgkmcnt(" #n ")" ::: "memory")
#define PG8_BAR __builtin_amdgcn_s_barrier()
#define PG8_SCHED __builtin_amdgcn_sched_barrier(0)
    Unit cur, nxt; int ui = 0;
    if (!S.next(0, cur)) return;
    f32x4 acc[2][2][4][2];
#pragma unroll
    for (int a = 0; a < 2; ++a)
#pragma unroll
        for (int b = 0; b < 2; ++b)
#pragma unroll
            for (int m = 0; m < 4; ++m)
#pragma unroll
                for (int n = 0; n < 2; ++n) acc[a][b][m][n] = (f32x4){0.f, 0.f, 0.f, 0.f};
    bf16x8 At[4][2], B0[2][2], B1[2][2];
    const char* cA = (const char*)g.A + (size_t)cur.pm * tstep; const char* cB = (const char*)g.Bt + (size_t)cur.pn * tstep;
    S.a_ready(cur);
    if constexpr (SP2) {
        PG8_STAGE(PG8_SB(0, 0), cB, voffB); PG8_STAGE(PG8_SB(0, 1), cB + hstep, voffB); PG8_STAGE(PG8_SA(0, 0), cA, voffA); PG8_STAGE(PG8_SA(0, 1), cA + hstep, voffA);
        if (wr == 1) PG8_BAR;
        PG8_WAIT_V(2); PG8_BAR;
        PG8_STAGE(PG8_SB(1, 0), cB + kstep, voffB); PG8_STAGE(PG8_SA(1, 0), cA + kstep, voffA); PG8_STAGE(PG8_SB(1, 1), cB + hstep + kstep, voffB);
        PG8_WAIT_V(6); PG8_BAR;
    } else {
        PG8_STAGE(PG8_SB(0, 0), cB, voffB); PG8_STAGE(PG8_SA(0, 0), cA, voffA); PG8_STAGE(PG8_SB(0, 1), cB + hstep, voffB); PG8_STAGE(PG8_SA(0, 1), cA + hstep, voffA);
        if (wr == 1) PG8_BAR;
        PG8_WAIT_V(4); PG8_BAR;
        PG8_STAGE(PG8_SB(1, 0), cB + kstep, voffB); PG8_STAGE(PG8_SA(1, 0), cA + kstep, voffA); PG8_STAGE(PG8_SB(1, 1), cB + hstep + kstep, voffB);
        PG8_WAIT_V(6); PG8_BAR;
    }
    for (;;) {
        const bool has_next = S.next(ui + 1, nxt);
        const char* nA = has_next ? (const char*)g.A + (size_t)nxt.pm * tstep : cA; const char* nB = has_next ? (const char*)g.Bt + (size_t)nxt.pn * tstep : cB;
        for (int t = 0; t < nt; t += 2) {
            const bool last = (t == nt - 2);
            const char* a1 = cA + (size_t)(t + 1) * kstep;
            const char* a2 = last ? nA : cA + (size_t)(t + 2) * kstep; const char* b2 = last ? nB : cB + (size_t)(t + 2) * kstep;
            const char* a3 = a2 + kstep; const char* b3 = b2 + kstep;
            if (last && has_next) S.a_ready(nxt);
            if constexpr (SP2) {
            PG8_LDB(B0, 0, 0); PG8_LDB(B1, 0, 1); PG8_SCHED; PG8_LDA(At, 0, 0); PG8_STAGE(PG8_SA(1, 1), a1 + hstep, voffA);
            PG8_WAIT_V(8); PG8_WAIT_L(0); PG8_BAR; PG8_MMA(0, 0, At, B0); PG8_MMA(0, 1, At, B1); PG8_BAR; PG8_SCHED;
            PG8_LDA(At, 0, 1); PG8_STAGE(PG8_SB(0, 0), b2, voffB); PG8_STAGE(PG8_SB(0, 1), b2 + hstep, voffB); PG8_STAGE(PG8_SA(0, 0), a2, voffA);
            PG8_WAIT_V(8); PG8_WAIT_L(0); PG8_BAR; PG8_MMA(1, 0, At, B0); PG8_MMA(1, 1, At, B1); PG8_BAR; PG8_SCHED;
            PG8_LDB(B0, 1, 0); PG8_LDB(B1, 1, 1); PG8_SCHED; PG8_LDA(At, 1, 0); PG8_STAGE(PG8_SA(0, 1), a2 + hstep, voffA);
            PG8_WAIT_V(8); PG8_WAIT_L(0); PG8_BAR; PG8_MMA(0, 0, At, B0); PG8_MMA(0, 1, At, B1); PG8_BAR; PG8_SCHED;
            PG8_LDA(At, 1, 1); PG8_STAGE(PG8_SB(1, 0), b3, voffB); PG8_STAGE(PG8_SB(1, 1), b3 + hstep, voffB); PG8_STAGE(PG8_SA(1, 0), a3, voffA);
            PG8_WAIT_V(8); PG8_WAIT_L(0); PG8_BAR; PG8_MMA(1, 0, At, B0); PG8_MMA(1, 1, At, B1); PG8_BAR; PG8_SCHED;
            } else {
            PG8_LDB(B0, 0, 0); PG8_SCHED; PG8_LDA(At, 0, 0); PG8_STAGE(PG8_SA(1, 1), a1 + hstep, voffA);
            PG8_WAIT_L(8); PG8_BAR; PG8_WAIT_L(0); PG8_MMA(0, 0, At, B0); PG8_BAR; PG8_SCHED;
            PG8_LDB(B1, 0, 1); PG8_STAGE(PG8_SB(0, 0), b2, voffB);
            PG8_BAR; PG8_WAIT_L(0); PG8_MMA(0, 1, At, B1); PG8_BAR;
            PG8_LDA(At, 0, 1); PG8_STAGE(PG8_SA(0, 0), a2, voffA);
            PG8_BAR; PG8_WAIT_L(0); PG8_MMA(1, 0, At, B0); PG8_BAR; PG8_SCHED;
            PG8_STAGE(PG8_SB(0, 1), b2 + hstep, voffB);
            PG8_WAIT_V(6); PG8_BAR; PG8_MMA(1, 1, At, B1); PG8_BAR;
            PG8_LDB(B0, 1, 0); PG8_SCHED; PG8_LDA(At, 1, 0); PG8_STAGE(PG8_SA(0, 1), a2 + hstep, voffA);
            PG8_WAIT_L(8); PG8_BAR; PG8_WAIT_L(0); PG8_MMA(0, 0, At, B0); PG8_BAR; PG8_SCHED;
            PG8_LDB(B1, 1, 1); PG8_STAGE(PG8_SB(1, 0), b3, voffB);
            PG8_BAR; PG8_WAIT_L(0); PG8_MMA(0, 1, At, B1); PG8_BAR;
            PG8_LDA(At, 1, 1); PG8_STAGE(PG8_SA(1, 0), a3, voffA);
            PG8_BAR; PG8_WAIT_L(0); PG8_MMA(1, 0, At, B0); PG8_BAR; PG8_SCHED;
            PG8_STAGE(PG8_SB(1, 1), b3 + hstep, voffB);
            PG8_WAIT_V(6); PG8_BAR; PG8_MMA(1, 1, At, B1); PG8_BAR;
            }
        }
        if constexpr (ALIGN_EPI) { if (wr == 0) PG8_BAR; }
        if constexpr (!Epi::AFTER_DRAIN) { E(acc, cur, wr, wc, fr, fq); S.done(cur); }
        if (!has_next) break;
#pragma unroll
        for (int a = 0; a < 2; ++a)
#pragma unroll
            for (int b = 0; b < 2; ++b)
#pragma unroll
                for (int m = 0; m < 4; ++m)
#pragma unroll
                    for (int n = 0; n < 2; ++n) acc[a][b][m][n] = (f32x4){0.f, 0.f, 0.f, 0.f};
        cur = nxt; cA = nA; cB = nB; ++ui;
        if constexpr (ALIGN_EPI) { if (wr == 1) PG8_BAR; }
    }
    PG8_WAIT_V(0);
    if constexpr (!ALIGN_EPI) { if (wr == 0) PG8_BAR; }
    PG8_BAR;
    if constexpr (Epi::AFTER_DRAIN) { E.fused(acc, cur, wr, wc, fr, fq, lds, wid, lane); S.done(cur); }
#undef PG8_SA
#undef PG8_SB
#undef PG8_STAGE
#undef PG8_LDA
#undef PG8_LDB
#undef PG8_MMA
#undef PG8_WAIT_V
#undef PG8_WAIT_L
#undef PG8_BAR
#undef PG8_SCHED
}
}
#define LAS __attribute__((address_space(3)))
#define XB_TMO      128
#define XB_XCNT(j)  (256  + 64 * (j))
#define XB_XSUB(j)  (1280 + 64 * (j))
#define XB_XGEN(j)  (2304 + 64 * (j))
#define XB_TOP      3328
#define XB_TOPGEN   3392
#define XCD_BAR_WORDS 3456
#define XB_SPIN_CAP (1u << 18)

__device__ __forceinline__ unsigned xb_ld(unsigned* p)              { return __hip_atomic_load(p, __ATOMIC_RELAXED, __HIP_MEMORY_SCOPE_AGENT); }
__device__ __forceinline__ unsigned xb_add(unsigned* p, unsigned v) { return __hip_atomic_fetch_add(p, v, __ATOMIC_RELAXED, __HIP_MEMORY_SCOPE_AGENT); }
__device__ __forceinline__ unsigned xb_xcc_id() { return (unsigned)__builtin_amdgcn_s_getreg((3 << 11) | 20) & 0xFu; }
#define XB_SPIN(cond, bar) do { unsigned _sp = 0; while (cond) { __builtin_amdgcn_s_sleep(1); \
    if ((++_sp & 255u) == 0u) { if (xb_ld(&(bar)[XB_TMO])) break; if (_sp > XB_SPIN_CAP) { atomicAdd(&(bar)[XB_TMO], 1u); break; } } } } while (0)

struct XcdBarrier {
    unsigned* bar; unsigned x;
    volatile LAS unsigned* st;
};

__device__ __forceinline__ XcdBarrier xcd_barrier_post(unsigned* bar, volatile LAS unsigned* st) {
    XcdBarrier b; b.bar = bar; b.x = xb_xcc_id(); b.st = st;
    if (threadIdx.x == 0) (void)xb_add(&bar[XB_XCNT(b.x)], 1u);
    return b;
}
__device__ __forceinline__ void xcd_barrier_complete(unsigned* bar, unsigned x, unsigned& nloc, unsigned& nx) {
    const unsigned G = gridDim.x * gridDim.y * gridDim.z;
    unsigned sum, cnt, mine, sp = 0u;
    for (;;) {
        sum = 0u; cnt = 0u; mine = 0u;
#pragma unroll
        for (unsigned j = 0; j < 16; ++j) { const unsigned c = xb_ld(&bar[XB_XCNT(j)]); sum += c; cnt += (c > 0u) ? 1u : 0u; mine = (j == x) ? c : mine; }
        if (sum == G) break;
        __builtin_amdgcn_s_sleep(1);
        if ((++sp & 255u) == 0u) { if (xb_ld(&bar[XB_TMO])) break; if (sp > XB_SPIN_CAP) { atomicAdd(&bar[XB_TMO], 1u); break; } }
    }
    nloc = mine > 0u ? mine : 1u; nx = cnt > 0u ? cnt : 1u;
}

__device__ __forceinline__ void xcd_barrier(const XcdBarrier& b) {
    asm volatile("s_waitcnt vmcnt(0)" ::: "memory");
    __syncthreads();
    if (threadIdx.x == 0) {
        unsigned* bar = b.bar;
        __builtin_amdgcn_s_waitcnt(0);
        unsigned nloc = b.st[0], nx = b.st[1];
        if (nloc == 0u) { xcd_barrier_complete(bar, b.x, nloc, nx); b.st[0] = nloc; b.st[1] = nx; }
        const unsigned old = xb_add(&bar[XB_XSUB(b.x)], 1u);
        const unsigned gen = old / nloc;
        if (old + 1u == (gen + 1u) * nloc) {
            __builtin_amdgcn_fence(__ATOMIC_RELEASE, "agent");
            asm volatile("s_waitcnt vmcnt(0)" ::: "memory");
            const unsigned og = xb_add(&bar[XB_TOP], 1u);
            const unsigned tg = og / nx;
            if (og + 1u == (tg + 1u) * nx) xb_add(&bar[XB_TOPGEN], 1u);
            else XB_SPIN(xb_ld(&bar[XB_TOPGEN]) == tg, bar);
            __builtin_amdgcn_fence(__ATOMIC_ACQUIRE, "agent");
            xb_add(&bar[XB_XGEN(b.x)], 1u);
            asm volatile("s_waitcnt vmcnt(0)" ::: "memory");
        } else {
            XB_SPIN(xb_ld(&bar[XB_XGEN(b.x)]) == gen, bar);
            __builtin_amdgcn_fence(__ATOMIC_ACQUIRE, "agent");
            asm volatile("s_waitcnt vmcnt(0)" ::: "memory");
        }
    }
    __syncthreads();
}
#undef LAS
using pg8::bf16x8; using pg8::f32x4; using pg8::u32x4; using pg8::f32x2;
#define GAS __attribute__((address_space(1)))
#define LAS __attribute__((address_space(3)))
typedef unsigned short bf16;
typedef unsigned v4u __attribute__((ext_vector_type(4)));
typedef unsigned v2u __attribute__((ext_vector_type(2)));
typedef float f32x2v __attribute__((ext_vector_type(2)));

constexpr int NTOK = 40960, DM = 2048, NLAYER = 4, INW = 5120;
constexpr int COL_UA = 0, COL_UB = 512, COL_Q = 1024, COL_K = 2048, COL_V = 3072, COL_G = 4096;
constexpr float ALPHA = 1.6817928305074290f;
constexpr float LN_EPS = 1e-5f, GN_EPS = 1e-6f;
constexpr int NEXP = 16384;
constexpr int NWAVES = 8, NTHR = 512;

constexpr size_t MiB = 1u << 20;
constexpr size_t WS_CTL = 0, CTL_ZERO_BYTES = 1 * MiB;
constexpr size_t WS_WIN = 1 * MiB;
constexpr size_t WS_WOUT = 81 * MiB;
constexpr size_t WS_WS = 113 * MiB;
constexpr size_t WS_WGLU = 145 * MiB;
constexpr size_t WS_S5A = 149 * MiB;
constexpr size_t WS_S5B = 150 * MiB;
constexpr size_t WS_S5BB = 153 * MiB;
constexpr size_t WS_U8 = 160 * MiB;
constexpr size_t WS_V8 = 288 * MiB;
constexpr size_t WS_USC = 416 * MiB;
constexpr size_t WS_VSC = 417 * MiB;
constexpr size_t WS_ROTC = 420 * MiB;
constexpr size_t WS_ROTS = 424 * MiB;
constexpr size_t WS_XN = 672 * MiB;
constexpr size_t WS_H = 832 * MiB;
constexpr size_t WS_CONCAT = 1232 * MiB;
constexpr size_t WS_BUFY = 1392 * MiB;
constexpr size_t WS_STF = 1472 * MiB;
constexpr size_t WS_STB = 1632 * MiB;
constexpr size_t WS_IDX = 1792 * MiB;
constexpr size_t WS_GATE = 1812 * MiB;
constexpr size_t WS_S5ST = 1832 * MiB;
constexpr size_t WS_END = 1852 * MiB;
constexpr int CW_BAR = 4096;
constexpr int NPHASE = 1 + NLAYER * 10;

constexpr int LDS_SCRATCH = 147456;
constexpr int LDS_MISC = LDS_SCRATCH;
constexpr int LDS_BYTES = LDS_SCRATCH + 256;

__device__ __forceinline__ float bf_lo(unsigned w) { return __uint_as_float(w << 16); }
__device__ __forceinline__ float bf_hi(unsigned w) { return __uint_as_float(w & 0xffff0000u); }
typedef __bf16 bf16x2_t __attribute__((ext_vector_type(2)));
__device__ __forceinline__ unsigned pkbf(float lo, float hi) { const bf16x2_t v = {(__bf16)lo, (__bf16)hi}; return __builtin_bit_cast(unsigned, v); }
__device__ __forceinline__ bf16 f2bf(float f) { return __builtin_bit_cast(unsigned short, (__bf16)f); }
__device__ __forceinline__ float wave_sum(float v) {
#pragma unroll
    for (int o = 1; o < 64; o <<= 1) v += __shfl_xor(v, o);
    return v;
}
__device__ __forceinline__ float gelu_erf(float v) {
    const float z = fabsf(v) * 0.70710678118654752f;
    const float t = __builtin_amdgcn_rcpf(1.0f + 0.3275911f * z);
    const float poly = t * (0.254829592f + t * (-0.284496736f + t * (1.421413741f + t * (-1.453152027f + t * 1.061405429f))));
    const float ec = poly * __expf(-z * z);
    return 0.5f * v * (v < 0.f ? ec : 2.0f - ec);
}
__device__ __forceinline__ int tok_pos(int t) { return t < 32768 ? (t & 4095) : (t - 32768); }
__device__ __forceinline__ int tok_len(int t) { return t < 32768 ? 4096 : 8192; }
__device__ __forceinline__ void unpack8(const v4u q, float (&f)[8]) {
    f[0] = bf_lo(q.x); f[1] = bf_hi(q.x); f[2] = bf_lo(q.y); f[3] = bf_hi(q.y); f[4] = bf_lo(q.z); f[5] = bf_hi(q.z); f[6] = bf_lo(q.w); f[7] = bf_hi(q.w);
}
__device__ __forceinline__ v4u pack8(const float (&f)[8]) { v4u q; q.x = pkbf(f[0], f[1]); q.y = pkbf(f[2], f[3]); q.z = pkbf(f[4], f[5]); q.w = pkbf(f[6], f[7]); return q; }
#define LDS_WAIT() asm volatile("s_waitcnt lgkmcnt(0)" ::: "memory")
#define MFMA16(a, b, c) __builtin_amdgcn_mfma_f32_16x16x32_bf16((a), (b), (c), 0, 0, 0)

struct EpiStoreBf16 {
    static constexpr bool PERM = true, AFTER_DRAIN = false;
    bf16* O; int ldo;
    __device__ __forceinline__ void operator()(const f32x4 (&acc)[2][2][4][2], const pg8::Unit& u, int wr, int wc, int fr, int fq) const {
        const int row0 = u.pm * 256 + wr * 64 + fr, col0 = u.pn * 256 + wc * 32 + 8 * fq;
#pragma unroll
        for (int ai = 0; ai < 2; ++ai)
#pragma unroll
            for (int m = 0; m < 4; ++m) { bf16* rowp = O + (size_t)(row0 + ai * 128 + m * 16) * ldo + col0;
#pragma unroll
                for (int bj = 0; bj < 2; ++bj) { const f32x4 v0 = acc[ai][bj][m][0], v1 = acc[ai][bj][m][1];
                    v4u w; w.x = pkbf(v0[0], v0[1]); w.y = pkbf(v0[2], v0[3]); w.z = pkbf(v1[0], v1[1]); w.w = pkbf(v1[2], v1[3]);
                    *(v4u*)(rowp + bj * 128) = w; } }
    }
};
struct EpiStoreRot {
    static constexpr bool PERM = true, AFTER_DRAIN = false;
    bf16* O; int ldo; const float* rc; const float* rs;
    __device__ __forceinline__ void operator()(const f32x4 (&acc)[2][2][4][2], const pg8::Unit& u, int wr, int wc, int fr, int fq) const {
        const int row0 = u.pm * 256 + wr * 64 + fr, col0 = u.pn * 256 + wc * 32 + 8 * fq;
        const bool rot = u.pn >= 4 && u.pn < 12; const float sc = u.pn >= 8 ? 0.0625f : 1.0f;
#pragma unroll
        for (int ai = 0; ai < 2; ++ai)
#pragma unroll
            for (int m = 0; m < 4; ++m) { const int row = row0 + ai * 128 + m * 16; bf16* rowp = O + (size_t)row * ldo + col0;
                f32x4 a0 = acc[ai][0][m][0], a1 = acc[ai][0][m][1], b0 = acc[ai][1][m][0], b1 = acc[ai][1][m][1];
                if (rot) { const int pos = row < 32768 ? (row & 4095) : (row - 32768); const size_t to = (size_t)pos * 128 + wc * 32 + 8 * fq;
                    const f32x4 c0 = *(const f32x4*)(rc + to), c1 = *(const f32x4*)(rc + to + 4), s0 = *(const f32x4*)(rs + to), s1 = *(const f32x4*)(rs + to + 4);
                    const f32x4 x0 = a0, x1 = a1, y0 = b0, y1 = b1;
                    a0 = (x0 * c0 - y0 * s0) * sc; a1 = (x1 * c1 - y1 * s1) * sc; b0 = (y0 * c0 + x0 * s0) * sc; b1 = (y1 * c1 + x1 * s1) * sc; }
                v4u w; w.x = pkbf(a0[0], a0[1]); w.y = pkbf(a0[2], a0[3]); w.z = pkbf(a1[0], a1[1]); w.w = pkbf(a1[2], a1[3]); *(v4u*)rowp = w;
                v4u x; x.x = pkbf(b0[0], b0[1]); x.y = pkbf(b0[2], b0[3]); x.z = pkbf(b1[0], b1[1]); x.w = pkbf(b1[2], b1[3]); *(v4u*)(rowp + 128) = x; }
    }
};
struct EpiGlu {
    static constexpr bool PERM = true, AFTER_DRAIN = false;
    const bf16* Y; int ldy; bf16* O; int ldo; const float* bias;
    __device__ __forceinline__ void operator()(const f32x4 (&acc)[2][2][4][2], const pg8::Unit& u, int wr, int wc, int fr, int fq) const {
        const int row0 = u.pm * 256 + wr * 64 + fr, col0 = u.pn * 256 + wc * 32 + 8 * fq;
#pragma unroll
        for (int bj = 0; bj < 2; ++bj) {
            const f32x4 b0 = *(const f32x4*)(bias + col0 + bj * 128), b1 = *(const f32x4*)(bias + col0 + bj * 128 + 4);
#pragma unroll
            for (int ai = 0; ai < 2; ++ai)
#pragma unroll
                for (int m = 0; m < 4; ++m) { const size_t r = (size_t)(row0 + ai * 128 + m * 16);
                    const v4u yq = *(const v4u*)(Y + r * ldy + col0 + bj * 128); float y[8]; unpack8(yq, y);
                    const f32x4 v0 = acc[ai][bj][m][0] + b0, v1 = acc[ai][bj][m][1] + b1; float o[8];
#pragma unroll
                    for (int k = 0; k < 4; ++k) { o[k] = y[k] * __builtin_amdgcn_rcpf(1.0f + __expf(-v0[k])); o[4 + k] = y[4 + k] * __builtin_amdgcn_rcpf(1.0f + __expf(-v1[k])); }
                    *(v4u*)(O + r * ldo + col0 + bj * 128) = pack8(o); }
        }
    }
};
struct EpiStoreF16 {
    static constexpr bool PERM = true, AFTER_DRAIN = false;
    _Float16* C; int ldc;
    __device__ __forceinline__ void operator()(const f32x4 (&acc)[2][2][4][2], const pg8::Unit& u, int wr, int wc, int fr, int fq) const {
        typedef _Float16 h8 __attribute__((ext_vector_type(8)));
        const int row0 = u.pm * 256 + wr * 64 + fr, col0 = u.pn * 256 + wc * 32 + 8 * fq;
#pragma unroll
        for (int ai = 0; ai < 2; ++ai)
#pragma unroll
            for (int m = 0; m < 4; ++m) { _Float16* rowp = C + (size_t)(row0 + ai * 128 + m * 16) * ldc + col0;
#pragma unroll
                for (int bj = 0; bj < 2; ++bj) { const f32x4 v0 = acc[ai][bj][m][0], v1 = acc[ai][bj][m][1];
                    h8 w; w[0] = (_Float16)v0[0]; w[1] = (_Float16)v0[1]; w[2] = (_Float16)v0[2]; w[3] = (_Float16)v0[3]; w[4] = (_Float16)v1[0]; w[5] = (_Float16)v1[1]; w[6] = (_Float16)v1[2]; w[7] = (_Float16)v1[3];
                    *(h8*)(rowp + bj * 128) = w; } }
    }
};
struct Args { const float* in[26]; float* out; unsigned char* ws; int ph_lo, ph_hi, li, pad; };
struct ArgsDev { const float GAS* in[26]; float GAS* out; unsigned char GAS* ws; int ph_lo, ph_hi, li, pad; };
typedef const ArgsDev __attribute__((address_space(4))) CArgs;
#define GIN(A_, k_) ((const float*)(A_).in[k_])
struct Frame {
    LAS unsigned char* lds;
    int tid, lane, wave, G, bx;
    int gw, NGW;
    size_t gtid, NT;
    float* out; unsigned char* ws;
};
enum InIdx { I_XP = 0, I_XS, I_LNIN_G, I_LNIN_B, I_WIN, I_LAMRE, I_LAMIM, I_LOGSTEP, I_BRE, I_BIM, I_CRE, I_CIM, I_S5D, I_WGLU, I_BGLU, I_POOLW, I_POOLS,
             I_WOUT, I_LN1G, I_LN1B, I_WQ, I_KEYS, I_PU, I_PV, I_LN2G, I_LN2B };

__device__ __forceinline__ void ln_rows2(bf16* XB, const bf16* MIX, float alpha, const float* g, const float* b, int gw, int ngw, int lane) {
    for (int t = gw; t < NTOK; t += 2 * ngw) {
        const int t2 = t + ngw; const bool has2 = t2 < NTOK; const int tb = has2 ? t2 : t;
        f32x4 v0[8], v1[8]; v2u x0q[8], x1q[8], m0q[8], m1q[8]; float s0 = 0.f, s1 = 0.f;
#pragma unroll
        for (int j = 0; j < 8; ++j) { x0q[j] = ((const v2u*)(XB + (size_t)t * DM))[lane + 64 * j]; m0q[j] = ((const v2u*)(MIX + (size_t)t * DM))[lane + 64 * j]; }
#pragma unroll
        for (int j = 0; j < 8; ++j) { x1q[j] = ((const v2u*)(XB + (size_t)tb * DM))[lane + 64 * j]; m1q[j] = ((const v2u*)(MIX + (size_t)tb * DM))[lane + 64 * j]; }
#pragma unroll
        for (int j = 0; j < 8; ++j) {
            v0[j] = (f32x4){bf_lo(x0q[j].x), bf_hi(x0q[j].x), bf_lo(x0q[j].y), bf_hi(x0q[j].y)} * alpha + (f32x4){bf_lo(m0q[j].x), bf_hi(m0q[j].x), bf_lo(m0q[j].y), bf_hi(m0q[j].y)};
            v1[j] = (f32x4){bf_lo(x1q[j].x), bf_hi(x1q[j].x), bf_lo(x1q[j].y), bf_hi(x1q[j].y)} * alpha + (f32x4){bf_lo(m1q[j].x), bf_hi(m1q[j].x), bf_lo(m1q[j].y), bf_hi(m1q[j].y)};
            s0 += (v0[j][0] + v0[j][1]) + (v0[j][2] + v0[j][3]); s1 += (v1[j][0] + v1[j][1]) + (v1[j][2] + v1[j][3]); }
        const float m0 = wave_sum(s0) * (1.0f / DM), m1 = wave_sum(s1) * (1.0f / DM); float q0 = 0.f, q1 = 0.f;
#pragma unroll
        for (int j = 0; j < 8; ++j) { v0[j] = v0[j] - m0; v1[j] = v1[j] - m1;
            q0 += (v0[j][0] * v0[j][0] + v0[j][1] * v0[j][1]) + (v0[j][2] * v0[j][2] + v0[j][3] * v0[j][3]); q1 += (v1[j][0] * v1[j][0] + v1[j][1] * v1[j][1]) + (v1[j][2] * v1[j][2] + v1[j][3] * v1[j][3]); }
        f32x4 gq[8], bq[8];
#pragma unroll
        for (int j = 0; j < 8; ++j) { gq[j] = ((const f32x4*)g)[lane + 64 * j]; bq[j] = ((const f32x4*)b)[lane + 64 * j]; }
        const float rs0 = 1.0f / sqrtf(wave_sum(q0) * (1.0f / DM) + LN_EPS), rs1 = 1.0f / sqrtf(wave_sum(q1) * (1.0f / DM) + LN_EPS);
#pragma unroll
        for (int j = 0; j < 8; ++j) { const f32x4 gg = gq[j], bb = bq[j];
            const f32x4 o0 = v0[j] * rs0 * gg + bb;
            v2u w0; w0.x = pkbf(o0[0], o0[1]); w0.y = pkbf(o0[2], o0[3]); ((v2u*)(XB + (size_t)t * DM))[lane + 64 * j] = w0;
            if (has2) { const f32x4 o1 = v1[j] * rs1 * gg + bb;
                v2u w1; w1.x = pkbf(o1[0], o1[1]); w1.y = pkbf(o1[2], o1[3]); ((v2u*)(XB + (size_t)t2 * DM))[lane + 64 * j] = w1; } }
    }
}

__device__ __forceinline__ void transpose_item(const float* W, int K, int N, bf16* WT, LAS float* scr, int item, int lane) {
    const int nblk = N / 32, kb = item / nblk, nb = item % nblk, k0 = 64 * kb, n0 = 32 * nb;
    float wv[32];
#pragma unroll
    for (int i = 0; i < 32; ++i) { const int kk = 2 * i + (lane >> 5); wv[i] = W[(size_t)(k0 + kk) * N + n0 + (lane & 31)]; }
#pragma unroll
    for (int i = 0; i < 32; ++i) { const int kk = 2 * i + (lane >> 5); scr[kk * 33 + (lane & 31)] = wv[i]; }
    LDS_WAIT();
    const int c = lane & 7;
#pragma unroll
    for (int j = 0; j < 4; ++j) { const int n = (lane >> 3) + 8 * j; const LAS float* s = scr + (8 * c) * 33 + n;
        v4u o; o.x = pkbf(s[0 * 33], s[1 * 33]); o.y = pkbf(s[2 * 33], s[3 * 33]); o.z = pkbf(s[4 * 33], s[5 * 33]); o.w = pkbf(s[6 * 33], s[7 * 33]);
        *(v4u*)(WT + (size_t)(n0 + n) * K + k0 + 8 * c) = o; }
    LDS_WAIT();
}

__device__ __forceinline__ void p0_prologue(const Frame& F, CArgs& A) {
    {
        LAS float* scr = (LAS float*)(F.lds + F.wave * 16384);
        constexpr int I_IN = (DM / 64) * (INW / 32), I_OUT = (DM / 64) * (DM / 32), I_GLU = (512 / 64) * (512 / 32);
        constexpr int NITEMS = NLAYER * (I_IN + I_OUT + I_GLU);
        for (int it = F.gw; it < NITEMS; it += F.NGW) {
            int r = it;
            if (r < NLAYER * I_IN) { const int l = r / I_IN; { const int nb_ = (r % I_IN) % (INW / 32); if (nb_ >= 512 / 32 && nb_ < 1024 / 32) continue; }
                transpose_item(GIN(A, I_WIN) + (size_t)l * DM * INW, DM, INW, (bf16*)(F.ws + WS_WIN) + (size_t)l * INW * DM, scr, r % I_IN, F.lane); continue; }
            r -= NLAYER * I_IN;
            if (r < NLAYER * I_OUT) { const int l = r / I_OUT; transpose_item(GIN(A, I_WOUT) + (size_t)l * DM * DM, DM, DM, (bf16*)(F.ws + WS_WOUT) + (size_t)l * DM * DM, scr, r % I_OUT, F.lane); continue; }
            r -= NLAYER * I_OUT;
            { const int l = r / I_GLU; transpose_item(GIN(A, I_WGLU) + (size_t)l * 512 * 512, 512, 512, (bf16*)(F.ws + WS_WGLU) + (size_t)l * 512 * 512, scr, r % I_GLU, F.lane); }
        }
    }
    {
        const int NR2 = 2 * NLAYER * NEXP;
        for (int r = F.gw; r < NR2; r += 2 * F.NGW) {
            const int r2 = r + F.NGW < NR2 ? r + F.NGW : r;
            const int tabA = r >= NLAYER * NEXP, riA = tabA ? r - NLAYER * NEXP : r, tabB = r2 >= NLAYER * NEXP, riB = tabB ? r2 - NLAYER * NEXP : r2;
            const float* srcA = (tabA ? GIN(A, I_PV) : GIN(A, I_PU)) + (size_t)riA * DM + F.lane * 4; const float* srcB = (tabB ? GIN(A, I_PV) : GIN(A, I_PU)) + (size_t)riB * DM + F.lane * 4;
            f32x4 va[8], vb[8]; float ama = 0.f, amb = 0.f;
#pragma unroll
            for (int q = 0; q < 8; ++q) va[q] = *(const f32x4*)(srcA + q * 256);
#pragma unroll
            for (int q = 0; q < 8; ++q) vb[q] = *(const f32x4*)(srcB + q * 256);
#pragma unroll
            for (int q = 0; q < 8; ++q) { ama = fmaxf(ama, fmaxf(fmaxf(fabsf(va[q][0]), fabsf(va[q][1])), fmaxf(fabsf(va[q][2]), fabsf(va[q][3])))); amb = fmaxf(amb, fmaxf(fmaxf(fabsf(vb[q][0]), fabsf(vb[q][1])), fmaxf(fabsf(vb[q][2]), fabsf(vb[q][3])))); }
#pragma unroll
            for (int o = 1; o < 64; o <<= 1) { ama = fmaxf(ama, __shfl_xor(ama, o)); amb = fmaxf(amb, __shfl_xor(amb, o)); }
#pragma unroll
            for (int half = 0; half < 2; ++half) {
                if (half == 1 && r2 == r) break;
                const float am = half ? amb : ama; const int tab = half ? tabB : tabA, ri = half ? riB : riA;
                const float sc = am > 0.f ? 6.0f / am : 1.0f, isc = am > 0.f ? am * (1.0f / 6.0f) : 1.0f;
                v4u w;
#pragma unroll
                for (int q = 0; q < 4; ++q) { const f32x4 e0 = half ? vb[2 * q] : va[2 * q], e1 = half ? vb[2 * q + 1] : va[2 * q + 1]; unsigned pk = 0u;
                    pk = __builtin_amdgcn_cvt_scalef32_pk_fp4_f32(pk, e0[0] * sc, e0[1] * sc, 1.0f, 0); pk = __builtin_amdgcn_cvt_scalef32_pk_fp4_f32(pk, e0[2] * sc, e0[3] * sc, 1.0f, 1);
                    pk = __builtin_amdgcn_cvt_scalef32_pk_fp4_f32(pk, e1[0] * sc, e1[1] * sc, 1.0f, 2); pk = __builtin_amdgcn_cvt_scalef32_pk_fp4_f32(pk, e1[2] * sc, e1[3] * sc, 1.0f, 3);
                    w[q] = pk; }
                *(v4u*)(F.ws + (tab ? WS_V8 : WS_U8) + (size_t)ri * (DM / 2) + F.lane * 16) = w;
                if (F.lane == 0) ((float*)(F.ws + (tab ? WS_VSC : WS_USC)))[ri] = isc;
            }
        }
    }
    {
        const float* win = GIN(A, I_WIN); const float* pw = GIN(A, I_POOLW); const float* ps = GIN(A, I_POOLS); bf16* wt = (bf16*)(F.ws + WS_WIN);
        for (size_t it = F.gtid; it < (size_t)NLAYER * 512 * 256; it += F.NT) {
            const int n = (int)(it & 511), k8 = (int)((it >> 9) & 255), l = (int)(it >> 17), g = n >> 7, d = n & 127;
            float acc[8];
#pragma unroll
            for (int kk = 0; kk < 8; ++kk) acc[kk] = 0.f;
            const float* wrow = win + ((size_t)l * DM + k8 * 8) * INW + 512 + g * 128; const float* pcol = pw + ((size_t)(l * 4 + g) * 128) * 128 + d;
            for (int c4 = 0; c4 < 32; ++c4) {
                f32x4 wv[8];
#pragma unroll
                for (int kk = 0; kk < 8; ++kk) wv[kk] = *(const f32x4*)(wrow + (size_t)kk * INW + c4 * 4);
#pragma unroll
                for (int e = 0; e < 4; ++e) { const float pv = pcol[(size_t)(c4 * 4 + e) * 128];
#pragma unroll
                    for (int kk = 0; kk < 8; ++kk) acc[kk] += wv[kk][e] * pv; }
            }
            const float sc = ps[l * 512 + n];
#pragma unroll
            for (int kk = 0; kk < 8; ++kk) acc[kk] *= sc;
            *(v4u*)(wt + ((size_t)l * INW + 512 + n) * DM + k8 * 8) = pack8(acc);
        }
    }
    {
        const float* lre = GIN(A, I_LAMRE); const float* lim = GIN(A, I_LAMIM); const float* lst = GIN(A, I_LOGSTEP); const float* bre = GIN(A, I_BRE); const float* bim = GIN(A, I_BIM);
        f32x2v* ab = (f32x2v*)(F.ws + WS_S5A); f32x2v* ab64 = (f32x2v*)(F.ws + WS_S5A + 512 * 1024); f32x2v* bb = (f32x2v*)(F.ws + WS_S5B);
        for (size_t i = F.gtid; i < (size_t)NLAYER * 2 * 32 * 64; i += F.NT) {
            const float lr = lre[i], li = lim[i], dt = expf(lst[i >> 6]);
            const float mag = expf(lr * dt), ar = mag * cosf(li * dt), ai = mag * sinf(li * dt);
            const float den = lr * lr + li * li;
            const float zr = ((ar - 1.0f) * lr + ai * li) / den, zi = (ai * lr - (ar - 1.0f) * li) / den;
            ab[i] = (f32x2v){ar, ai};
            const float m64 = expf(lr * dt * 64.0f), an = li * dt * 64.0f;
            ab64[i] = (f32x2v){m64 * cosf(an), m64 * sinf(an)};
#pragma unroll
            for (int c = 0; c < 16; ++c) { const float br = bre[i * 16 + c], bi = bim[i * 16 + c]; bb[i * 16 + c] = (f32x2v){zr * br - zi * bi, zr * bi + zi * br}; }
            {
                bf16* o = (bf16*)(F.ws + WS_S5BB) + ((size_t)(i >> 6) * 128 + 2 * (i & 63)) * 32;
#pragma unroll
                for (int c = 0; c < 16; ++c) { const float br = bre[i * 16 + c], bi = bim[i * 16 + c]; o[c] = f2bf(zr * br - zi * bi); o[32 + c] = f2bf(zr * bi + zi * br); o[16 + c] = 0; o[48 + c] = 0; }
            }
        }
    }
    {
        float* rc = (float*)(F.ws + WS_ROTC); float* rs = (float*)(F.ws + WS_ROTS);
        for (size_t i = F.gtid; i < (size_t)8192 * 128; i += F.NT) { const float inv = (float)exp(-(double)(i & 127) / 127.0 * 9.210340371976184); const float ang = (float)(i >> 7) * inv; rc[i] = cosf(ang); rs[i] = sinf(ang); }
    }
    __syncthreads();
    {
        LAS float* KS = (LAS float*)F.lds;
        LAS float* WQ = (LAS float*)(F.lds + 128 * 132 * 4);
        const float* keys = GIN(A, I_KEYS); const float* wq = GIN(A, I_WQ); bf16* wst = (bf16*)(F.ws + WS_WS);
        for (int u = F.bx; u < NLAYER * 16 * 32; u += F.G) {
            const int dtl = u & 31, hp = (u >> 5) & 15, l = u >> 9, p = hp & 1;
#pragma unroll
            for (int r = 0; r < 8; ++r) { const int f = F.tid + 512 * r, nk = f >> 5, c4 = f & 31;
                *(LAS f32x4*)(KS + nk * 132 + c4 * 4) = *(const f32x4*)(keys + (((size_t)l * 2 + p) * 128 + nk) * 128 + c4 * 4); }
#pragma unroll
            for (int r = 0; r < 4; ++r) { const int f = F.tid + 512 * r, dd = f >> 5, c4 = f & 31;
                *(LAS f32x4*)(WQ + dd * 132 + c4 * 4) = *(const f32x4*)(wq + ((size_t)l * DM + dtl * 64 + dd) * DM + hp * 128 + c4 * 4); }
            __syncthreads();
            const int nt = F.wave, lr = F.lane & 15, lq = F.lane >> 4;
            f32x4 acc[4];
#pragma unroll
            for (int dt = 0; dt < 4; ++dt) acc[dt] = (f32x4){0.f, 0.f, 0.f, 0.f};
#pragma unroll 4
            for (int ks = 0; ks < 32; ++ks) {
                const float kb = KS[(nt * 16 + lr) * 132 + 4 * ks + lq];
#pragma unroll
                for (int dt = 0; dt < 4; ++dt) { const float wa = WQ[(dt * 16 + lr) * 132 + 4 * ks + lq]; acc[dt] = __builtin_amdgcn_mfma_f32_16x16x4f32(wa, kb, acc[dt], 0, 0, 0); }
            }
            bf16* o = wst + ((size_t)l * DM + hp * 128 + nt * 16 + lr) * DM + dtl * 64 + 4 * lq;
#pragma unroll
            for (int dt = 0; dt < 4; ++dt) { v2u w; w.x = pkbf(acc[dt][0], acc[dt][1]); w.y = pkbf(acc[dt][2], acc[dt][3]); *(v2u*)(o + dt * 16) = w; }
            __syncthreads();
        }
    }
    {
        const float* xp = GIN(A, I_XP); const float* xs = GIN(A, I_XS); const float* g = GIN(A, I_LNIN_G); const float* b = GIN(A, I_LNIN_B); bf16* XB = (bf16*)(F.ws + WS_XN);
        for (int t = F.gw; t < NTOK; t += 2 * F.NGW) {
            const int t2 = t + F.NGW; const bool has2 = t2 < NTOK; const int tb = has2 ? t2 : t;
            const float* s0p = t < 32768 ? xp + (size_t)t * DM : xs + (size_t)(t - 32768) * DM; const float* s1p = tb < 32768 ? xp + (size_t)tb * DM : xs + (size_t)(tb - 32768) * DM;
            f32x4 v0[8], v1[8]; float s0 = 0.f, s1 = 0.f;
#pragma unroll
            for (int j = 0; j < 8; ++j) v0[j] = ((const f32x4*)s0p)[F.lane + 64 * j];
#pragma unroll
            for (int j = 0; j < 8; ++j) v1[j] = ((const f32x4*)s1p)[F.lane + 64 * j];
#pragma unroll
            for (int j = 0; j < 8; ++j) { s0 += (v0[j][0] + v0[j][1]) + (v0[j][2] + v0[j][3]); s1 += (v1[j][0] + v1[j][1]) + (v1[j][2] + v1[j][3]); }
            const float m0 = wave_sum(s0) * (1.0f / DM), m1 = wave_sum(s1) * (1.0f / DM); float q0 = 0.f, q1 = 0.f;
#pragma unroll
            for (int j = 0; j < 8; ++j) { v0[j] = v0[j] - m0; v1[j] = v1[j] - m1;
                q0 += (v0[j][0] * v0[j][0] + v0[j][1] * v0[j][1]) + (v0[j][2] * v0[j][2] + v0[j][3] * v0[j][3]); q1 += (v1[j][0] * v1[j][0] + v1[j][1] * v1[j][1]) + (v1[j][2] * v1[j][2] + v1[j][3] * v1[j][3]); }
            const float rs0 = 1.0f / sqrtf(wave_sum(q0) * (1.0f / DM) + LN_EPS), rs1 = 1.0f / sqrtf(wave_sum(q1) * (1.0f / DM) + LN_EPS);
#pragma unroll
            for (int j = 0; j < 8; ++j) { const f32x4 gg = ((const f32x4*)g)[F.lane + 64 * j], bb = ((const f32x4*)b)[F.lane + 64 * j];
                const f32x4 o0 = v0[j] * rs0 * gg + bb;
                v2u w0; w0.x = pkbf(o0[0], o0[1]); w0.y = pkbf(o0[2], o0[3]); ((v2u*)(XB + (size_t)t * DM))[F.lane + 64 * j] = w0;
                if (has2) { const f32x4 o1 = v1[j] * rs1 * gg + bb;
                    v2u w1; w1.x = pkbf(o1[0], o1[1]); w1.y = pkbf(o1[2], o1[3]); ((v2u*)(XB + (size_t)t2 * DM))[F.lane + 64 * j] = w1; } }
        }
    }
}

__device__ __forceinline__ float ret_log2_gamma(int h) { return log2f(1.0f - exp2f(-5.0f - (float)h)); }

__device__ __forceinline__ void s5_pass1(const Frame& F, CArgs& A, int l) {
    LAS float* BUs = (LAS float*)(F.lds + F.wave * 8448);
    const bf16* H = (const bf16*)(F.ws + WS_H);
    const f32x2v* ab = (const f32x2v*)(F.ws + WS_S5A); const bf16* BB = (const bf16*)(F.ws + WS_S5BB);
    f32x2v* st = (f32x2v*)(F.ws + WS_S5ST);
    const int lane = F.lane, lr = lane & 15, lq = lane >> 4;
    const int gstep = F.G < 32 ? F.G : 32;
    for (int g = F.bx % 32; g < 32; g += gstep) {
        const int nwg = F.G < 32 ? 1 : (F.G - g + 31) / 32, rank = F.G < 32 ? 0 : F.bx / 32;
        bf16x8 Bop[2][8]; f32x2v a2[2], arot[2];
#pragma unroll
        for (int dir = 0; dir < 2; ++dir) { const int gi = (l * 2 + dir) * 32 + g; a2[dir] = ab[gi * 64 + lane]; arot[dir] = (f32x2v){-a2[dir][1], a2[dir][1]};
#pragma unroll
            for (int j = 0; j < 8; ++j) Bop[dir][j] = *(const bf16x8*)(BB + ((size_t)gi * 128 + 16 * j + lr) * 32 + lq * 8); }
        for (int ck = rank * NWAVES + F.wave; ck < 640; ck += nwg * NWAVES) {
            bf16x8 uop[4];
#pragma unroll
            for (int tb = 0; tb < 4; ++tb) { const v4u q = lq < 2 ? *(const v4u*)(H + (size_t)(ck * 64 + 16 * tb + lr) * INW + COL_UA + g * 16 + lq * 8) : (v4u){0u, 0u, 0u, 0u}; uop[tb] = __builtin_bit_cast(bf16x8, q); }
#pragma unroll
            for (int dir = 0; dir < 2; ++dir) {
                f32x2v x2 = (f32x2v){0.f, 0.f};
#pragma unroll
                for (int blk = 0; blk < 4; ++blk) {
                    const int tb = dir ? 3 - blk : blk;
#pragma unroll
                    for (int j = 0; j < 8; ++j) { const f32x4 d = MFMA16(Bop[dir][j], uop[tb], ((f32x4){0.f, 0.f, 0.f, 0.f}));
                        *(LAS f32x4*)(BUs + lr * 132 + 16 * j + 4 * lq) = d; }
                    LDS_WAIT();
#pragma unroll
                    for (int s = 0; s < 16; ++s) { const int tl = dir ? 15 - s : s;
                        const f32x2v bu = *(const LAS f32x2v*)(BUs + tl * 132 + 2 * lane);
                        x2 = x2 * a2[dir][0] + (arot[dir] * (f32x2v){x2[1], x2[0]} + bu); }
                    LDS_WAIT();
                }
                st[(size_t)((ck * 32 + g) * 2 + dir) * 64 + lane] = x2;
            }
        }
    }
}
__device__ __forceinline__ void s5_carry(const Frame& F, CArgs& A, int l) {
    const f32x2v* ab64 = (const f32x2v*)(F.ws + WS_S5A + 512 * 1024); f32x2v* st = (f32x2v*)(F.ws + WS_S5ST);
    for (size_t it = F.gtid; it < (size_t)9 * 32 * 2 * 64; it += F.NT) {
        const int p = (int)(it & 63), dir = (int)((it >> 6) & 1), g = (int)((it >> 7) & 31), s = (int)(it >> 12);
        const int ck0 = s < 8 ? s * 64 : 512, n = s < 8 ? 64 : 128;
        const f32x2v a = ab64[((l * 2 + dir) * 32 + g) * 64 + p];
        float cr = 0.f, ci = 0.f;
        for (int k0 = 0; k0 < n; k0 += 8) {
            f32x2v le[8];
#pragma unroll
            for (int kk = 0; kk < 8; ++kk) { const int ck = dir ? (ck0 + n - 1 - (k0 + kk)) : (ck0 + k0 + kk); le[kk] = st[(size_t)((ck * 32 + g) * 2 + dir) * 64 + p]; }
#pragma unroll
            for (int kk = 0; kk < 8; ++kk) { const int ck = dir ? (ck0 + n - 1 - (k0 + kk)) : (ck0 + k0 + kk);
                st[(size_t)((ck * 32 + g) * 2 + dir) * 64 + p] = (f32x2v){cr, ci};
                const float ncr = a[0] * cr - a[1] * ci + le[kk][0], nci = a[0] * ci + a[1] * cr + le[kk][1]; cr = ncr; ci = nci; }
        }
    }
}
__device__ __forceinline__ void s5_pass3(const Frame& F, CArgs& A, int l) {
    LAS bf16* CtS = (LAS bf16*)F.lds;
    LAS unsigned char* wb = F.lds + 8704 + F.wave * 12800;
    LAS float* BUs = (LAS float*)wb;
    LAS bf16* Xw = (LAS bf16*)(wb + 8448);
    const bf16* H = (const bf16*)(F.ws + WS_H); bf16* BY = (bf16*)(F.ws + WS_BUFY);
    const f32x2v* ab = (const f32x2v*)(F.ws + WS_S5A); const bf16* BB = (const bf16*)(F.ws + WS_S5BB);
    const f32x2v* st = (const f32x2v*)(F.ws + WS_S5ST);
    const float* cre = GIN(A, I_CRE); const float* cim = GIN(A, I_CIM); const float* dvec = GIN(A, I_S5D) + (size_t)l * 512;
    const int lane = F.lane, lr = lane & 15, lq = lane >> 4;
    const int gstep = F.G < 32 ? F.G : 32;
    for (int g = F.bx % 32; g < 32; g += gstep) {
        const int nwg = F.G < 32 ? 1 : (F.G - g + 31) / 32, rank = F.G < 32 ? 0 : F.bx / 32;
        __syncthreads();
        {
            const int tq = opaque(F.tid);
#pragma unroll
            for (int r = 0; r < 8; ++r) { const int e = tq + 512 * r, pp = e & 127, c = (e >> 7) & 15, dir = e >> 11;
                const size_t cb = (size_t)(((l * 2 + dir) * 32 + g) * 16 + c) * 64;
                CtS[(dir * 16 + c) * 136 + pp] = f2bf((pp & 1) ? -cim[cb + (pp >> 1)] : cre[cb + (pp >> 1)]); }
        }
        bf16x8 Bop[2][8]; f32x2v a2[2], arot[2];
#pragma unroll
        for (int dir = 0; dir < 2; ++dir) { const int gi = (l * 2 + dir) * 32 + g; a2[dir] = ab[gi * 64 + lane]; arot[dir] = (f32x2v){-a2[dir][1], a2[dir][1]};
#pragma unroll
            for (int j = 0; j < 8; ++j) Bop[dir][j] = *(const bf16x8*)(BB + ((size_t)gi * 128 + 16 * j + lr) * 32 + lq * 8); }
        __syncthreads();
        for (int ck = rank * NWAVES + F.wave; ck < 640; ck += nwg * NWAVES) {
            bf16x8 uop[4];
#pragma unroll
            for (int tb = 0; tb < 4; ++tb) { const v4u q = lq < 2 ? *(const v4u*)(H + (size_t)(ck * 64 + 16 * tb + lr) * INW + COL_UA + g * 16 + lq * 8) : (v4u){0u, 0u, 0u, 0u}; uop[tb] = __builtin_bit_cast(bf16x8, q); }
            f32x2v xin[2];
#pragma unroll
            for (int dir = 0; dir < 2; ++dir) xin[dir] = st[(size_t)((ck * 32 + g) * 2 + dir) * 64 + lane];
            const f32x4 dv4 = *(const f32x4*)(dvec + g * 16 + 4 * lq);
            v2u uq4[4];
#pragma unroll
            for (int m = 0; m < 4; ++m) uq4[m] = *(const v2u*)(H + (size_t)(ck * 64 + 16 * m + lr) * INW + COL_UA + g * 16 + 4 * lq);
            f32x4 Y[4];
#pragma unroll
            for (int m = 0; m < 4; ++m) Y[m] = (f32x4){0.f, 0.f, 0.f, 0.f};
#pragma unroll
            for (int dir = 0; dir < 2; ++dir) {
                f32x2v x2 = xin[dir];
#pragma unroll
                for (int blk = 0; blk < 4; ++blk) {
                    const int tb = dir ? 3 - blk : blk;
#pragma unroll
                    for (int j = 0; j < 8; ++j) { const f32x4 d = MFMA16(Bop[dir][j], uop[tb], ((f32x4){0.f, 0.f, 0.f, 0.f}));
                        *(LAS f32x4*)(BUs + lr * 132 + 16 * j + 4 * lq) = d; }
                    LDS_WAIT();
#pragma unroll
                    for (int s = 0; s < 16; ++s) { const int tl = dir ? 15 - s : s;
                        const f32x2v bu = *(const LAS f32x2v*)(BUs + tl * 132 + 2 * lane);
                        x2 = x2 * a2[dir][0] + (arot[dir] * (f32x2v){x2[1], x2[0]} + bu);
                        *(LAS unsigned*)(Xw + tl * 136 + 2 * lane) = pkbf(x2[0], x2[1]); }
                    LDS_WAIT();
#pragma unroll
                    for (int ks = 0; ks < 4; ++ks) {
                        const bf16x8 av = *(const LAS bf16x8*)(CtS + (dir * 16 + lr) * 136 + 32 * ks + lq * 8);
                        const bf16x8 bv = *(const LAS bf16x8*)(Xw + lr * 136 + 32 * ks + lq * 8);
                        Y[tb] = MFMA16(av, bv, Y[tb]);
                    }
                    LDS_WAIT();
                }
            }
#pragma unroll
            for (int m = 0; m < 4; ++m) {
                const int t = 16 * m + lr, c0 = 4 * lq;
                const v2u uq = uq4[m];
                const f32x4 uv = (f32x4){bf_lo(uq.x), bf_hi(uq.x), bf_lo(uq.y), bf_hi(uq.y)}; const f32x4 dv = dv4;
                const f32x4 y = Y[m] + dv * uv;
                v2u w; w.x = pkbf(gelu_erf(y[0]), gelu_erf(y[1])); w.y = pkbf(gelu_erf(y[2]), gelu_erf(y[3]));
                *(v2u*)(BY + (size_t)(ck * 64 + t) * 512 + g * 16 + c0) = w;
            }
        }
    }
}
__device__ __forceinline__ void pool_phase(const Frame& F, CArgs& A) {
    const bf16* H = (const bf16*)(F.ws + WS_H); bf16* CCp = (bf16*)(F.ws + WS_CONCAT) + 512;
    for (size_t it = F.gtid; it < (size_t)(NTOK / 8) * 64; it += F.NT) {
        const int r = (int)(it >> 6), o = (int)(it & 63), gi = o >> 4, half = 1 << gi;
        const int t0 = r * 8, pos0 = tok_pos(t0), L = tok_len(t0);
        const bf16* base = H + (size_t)(t0 - pos0) * INW + COL_UB + o * 8;
        v4u wq[23];
#pragma unroll
        for (int sl = 0; sl < 23; ++sl) { const int q = pos0 - 8 + sl; const int qc = q < 0 ? 0 : (q > L - 1 ? L - 1 : q); wq[sl] = *(const v4u*)(base + (size_t)qc * INW); }
#pragma unroll
        for (int i = 0; i < 8; ++i) {
            const int pos = pos0 + i;
            const int lo = max(pos - half, 0), hi = min(pos + half - 1, L - 1);
            float s[8];
#pragma unroll
            for (int k = 0; k < 8; ++k) s[k] = 0.f;
#pragma unroll
            for (int k = 0; k < 16; ++k) { const int q = pos - 8 + k; float f[8]; unpack8(wq[i + k], f); const float wgt = (q >= lo && q <= hi) ? 1.0f : 0.0f;
#pragma unroll
                for (int c = 0; c < 8; ++c) s[c] += wgt * f[c]; }
            const float inv = 1.0f / (float)(hi - lo + 1);
            float c[8]; unpack8(wq[8 + i], c);
#pragma unroll
            for (int k = 0; k < 8; ++k) s[k] = s[k] * inv - c[k];
            *(v4u*)(CCp + (size_t)(t0 + i) * DM + o * 8) = pack8(s);
        }
    }
}
constexpr int RS = 136;
template <int MODE = 0> __device__ __forceinline__ void ret_state_phase(const Frame& F, CArgs& A, unsigned* ctr = nullptr) {
    const bf16* H = (const bf16*)(F.ws + WS_H); bf16* STF = (bf16*)(F.ws + WS_STF); bf16* STB = (bf16*)(F.ws + WS_STB);
    LAS bf16* Kt = (LAS bf16*)F.lds; LAS bf16* VtF = Kt + 128 * RS; LAS bf16* VtB = Kt + 256 * RS;
    LAS unsigned* Kt32 = (LAS unsigned*)Kt; LAS unsigned* VtF32 = (LAS unsigned*)VtF; LAS unsigned* VtB32 = (LAS unsigned*)VtB;
    const int tid = F.tid, lane = F.lane, lr = lane & 15, lq = lane >> 4, we = F.wave >> 1, wd = F.wave & 1;
    const int jp = tid & 63, j = 2 * jp, pc0 = tid >> 6;
    v4u pk0[2], pk1[2], pv0[2], pv1[2];
#define RS_LOAD(u_) do { const int dh_ = (u_) & 1, eh_ = ((u_) >> 1) & 1, h_ = ((u_) >> 2) & 3, c_ = (u_) >> 4; \
        const bf16* krow_ = H + (size_t)(c_ * 128 + j) * INW + COL_K + h_ * 256 + dh_ * 128; const bf16* vrow_ = H + (size_t)(c_ * 128 + j) * INW + COL_V + h_ * 256 + eh_ * 128; \
        _Pragma("unroll") for (int r = 0; r < 2; ++r) { const int pc = pc0 + 8 * r; pk0[r] = *(const v4u*)(krow_ + pc * 8); pk1[r] = *(const v4u*)(krow_ + INW + pc * 8); pv0[r] = *(const v4u*)(vrow_ + pc * 8); pv1[r] = *(const v4u*)(vrow_ + INW + pc * 8); } } while (0)
    if (F.bx < 5120) RS_LOAD(F.bx);
    volatile LAS int* NXT = (volatile LAS int*)(F.lds + LDS_MISC) + 16;
    int un = F.bx + F.G, pend = 0;
    if (ctr && tid == 0) pend = 2 * F.G + (int)__hip_atomic_fetch_add(ctr, 1u, __ATOMIC_RELAXED, __HIP_MEMORY_SCOPE_AGENT);
    for (int u = F.bx; u < 5120;) {
        const int dh = u & 1, eh = (u >> 1) & 1, h = (u >> 2) & 3, c = u >> 4;
        if (MODE != 2) {
            const float lg = ret_log2_gamma(h), fF0 = exp2f(lg * (float)(127 - j)), fF1 = exp2f(lg * (float)(126 - j)), fB0 = exp2f(lg * (float)j), fB1 = exp2f(lg * (float)(j + 1));
#pragma unroll
            for (int r = 0; r < 2; ++r) {
                const int pc = pc0 + 8 * r;
                const unsigned ka0[4] = {pk0[r].x, pk0[r].y, pk0[r].z, pk0[r].w}, ka1[4] = {pk1[r].x, pk1[r].y, pk1[r].z, pk1[r].w};
                float f0[8], f1[8]; unpack8(pv0[r], f0); unpack8(pv1[r], f1);
#pragma unroll
                for (int i = 0; i < 8; ++i) {
                    const unsigned a = ka0[i >> 1], b = ka1[i >> 1];
                    const unsigned kk = (i & 1) ? ((a >> 16) | (b & 0xffff0000u)) : ((a & 0xffffu) | (b << 16));
                    const int o = ((pc * 8 + i) * RS) / 2 + jp;
                    Kt32[o] = kk; VtF32[o] = pkbf(f0[i] * fF0, f1[i] * fF1); VtB32[o] = pkbf(f0[i] * fB0, f1[i] * fB1);
                }
            }
        }
        if (ctr && tid == 0) { NXT[0] = pend; pend = 2 * F.G + (int)__hip_atomic_fetch_add(ctr, 1u, __ATOMIC_RELAXED, __HIP_MEMORY_SCOPE_AGENT); }
        __syncthreads();
        const int unn = ctr ? NXT[0] : un + F.G;
        if (un < 5120) RS_LOAD(un);
        if (MODE == 1) { __syncthreads(); u = un; un = unn; continue; }
        f32x4 aF[4][2], aB[4][2];
#pragma unroll
        for (int td = 0; td < 4; ++td)
#pragma unroll
            for (int te = 0; te < 2; ++te) { aF[td][te] = (f32x4){0.f, 0.f, 0.f, 0.f}; aB[td][te] = (f32x4){0.f, 0.f, 0.f, 0.f}; }
#pragma unroll
        for (int ks = 0; ks < 4; ++ks) {
            bf16x8 ka[4], vF[2], vB[2];
#pragma unroll
            for (int td = 0; td < 4; ++td) ka[td] = *(const LAS bf16x8*)(Kt + (64 * wd + 16 * td + lr) * RS + 32 * ks + lq * 8);
#pragma unroll
            for (int te = 0; te < 2; ++te) { vF[te] = *(const LAS bf16x8*)(VtF + (32 * we + 16 * te + lr) * RS + 32 * ks + lq * 8); vB[te] = *(const LAS bf16x8*)(VtB + (32 * we + 16 * te + lr) * RS + 32 * ks + lq * 8); }
#pragma unroll
            for (int td = 0; td < 4; ++td)
#pragma unroll
                for (int te = 0; te < 2; ++te) { aF[td][te] = MFMA16(ka[td], vF[te], aF[td][te]); aB[td][te] = MFMA16(ka[td], vB[te], aB[td][te]); }
        }
        __syncthreads();
        {
            LAS bf16* OutF = Kt; LAS bf16* OutB = Kt + 128 * RS;
#pragma unroll
            for (int td = 0; td < 4; ++td)
#pragma unroll
                for (int te = 0; te < 2; ++te) {
                    const int e = 32 * we + 16 * te + lr, d = 64 * wd + 16 * td + 4 * lq;
                    v2u w; w.x = pkbf(aF[td][te][0], aF[td][te][1]); w.y = pkbf(aF[td][te][2], aF[td][te][3]); *(LAS v2u*)(OutF + e * RS + d) = w;
                    v2u x; x.x = pkbf(aB[td][te][0], aB[td][te][1]); x.y = pkbf(aB[td][te][2], aB[td][te][3]); *(LAS v2u*)(OutB + e * RS + d) = x;
                }
            __syncthreads();
            const int tq = opaque(tid);
#pragma unroll
            for (int r = 0; r < 8; ++r) { const int f = tq + 512 * r, mat = f >> 11, row = (f >> 4) & 127, pc = f & 15;
                const v4u q = *(const LAS v4u*)(Kt + (mat * 128 + row) * RS + pc * 8);
                bf16* dst = (mat ? STB : STF) + ((size_t)(c * 4 + h) * 256 + eh * 128 + row) * 256 + dh * 128 + pc * 8;
                *(v4u*)dst = q; }
        }
        __syncthreads();
        u = un; un = unn;
    }
#undef RS_LOAD
}
__device__ __forceinline__ void ret_prefix_phase(const Frame& F, CArgs& A) {
    bf16* STF = (bf16*)(F.ws + WS_STF); bf16* STB = (bf16*)(F.ws + WS_STB);
    for (size_t it = F.gtid; it < (size_t)36 * 2 * 8192; it += F.NT) {
        const int o = (int)(it & 8191), which = (int)((it >> 13) & 1), bh = (int)(it >> 14), h = bh & 3, s = bh >> 2;
        const int c0 = s < 8 ? s * 32 : 256, n = s < 8 ? 32 : 64;
        const float dec = exp2f(128.0f * ret_log2_gamma(h));
        float st[8];
#pragma unroll
        for (int k = 0; k < 8; ++k) st[k] = 0.f;
        bf16* base = (which ? STB : STF) + (size_t)h * 65536 + (size_t)o * 8;
        for (int k0 = 0; k0 < n; k0 += 8) {
            v4u q[8];
#pragma unroll
            for (int kk = 0; kk < 8; ++kk) { const int c = which ? (c0 + n - 1 - (k0 + kk)) : (c0 + k0 + kk); q[kk] = *(const v4u*)(base + (size_t)c * 4 * 65536); }
#pragma unroll
            for (int kk = 0; kk < 8; ++kk) { const int c = which ? (c0 + n - 1 - (k0 + kk)) : (c0 + k0 + kk);
                float f[8]; unpack8(q[kk], f);
#pragma unroll
                for (int i = 0; i < 8; ++i) st[i] = dec * st[i] + f[i];
                *(v4u*)(base + (size_t)c * 4 * 65536) = pack8(st); }
        }
    }
}
__device__ __forceinline__ void ret_out_phase(const Frame& F, CArgs& A) {
    const bf16* H = (const bf16*)(F.ws + WS_H); const bf16* STF = (const bf16*)(F.ws + WS_STF); const bf16* STB = (const bf16*)(F.ws + WS_STB);
    bf16* CC = (bf16*)(F.ws + WS_CONCAT);
    LAS bf16* RA = (LAS bf16*)F.lds; LAS bf16* RB = RA + 128 * RS; LAS bf16* RC = RA + 384 * RS;
    const int tid = F.tid, wi = F.wave >> 2, wj = F.wave & 3, we = F.wave & 3;
    for (int u = F.bx; u < 1280; u += F.G) {
        const int lane = opaque(F.lane), lr = lane & 15, lq = lane >> 4;
        const int h = u & 3, c = u >> 2, t0 = c * 128;
        const int cs = c < 256 ? (c & 31) : (c - 256), ncs = c < 256 ? 32 : 64;
        const bool has_f = cs > 0, has_b = cs < ncs - 1;
        const float lg = ret_log2_gamma(h);
        const int tq = opaque(tid);
        v4u pa[4], pb[8];
#define RO_LOAD_QK(dh_) do { _Pragma("unroll") for (int r = 0; r < 4; ++r) { const int f = tq + 512 * r, row = f >> 4, pc = f & 15; \
            const bf16* src = H + (size_t)(t0 + row) * INW + h * 256 + (dh_) * 128 + pc * 8; pa[r] = *(const v4u*)(src + COL_Q); pb[r] = *(const v4u*)(src + COL_K); } } while (0)
#define RO_STORE_QK() do { _Pragma("unroll") for (int r = 0; r < 4; ++r) { const int f = tq + 512 * r, row = f >> 4, pc = f & 15; \
            *(LAS v4u*)(RA + row * RS + pc * 8) = pa[r]; *(LAS v4u*)(RB + row * RS + pc * 8) = pb[r]; } } while (0)
#define RO_LOAD_V() do { const int jp_ = tq & 63, pc0_ = tq >> 6; const bf16* vrow = H + (size_t)(t0 + 2 * jp_) * INW + COL_V + h * 256; \
            _Pragma("unroll") for (int r = 0; r < 4; ++r) { const int pc = pc0_ + 8 * r; pb[r] = *(const v4u*)(vrow + pc * 8); pb[4 + r] = *(const v4u*)(vrow + INW + pc * 8); } } while (0)
#define RO_STORE_V() do { const int jp_ = tq & 63, pc0_ = tq >> 6; LAS unsigned* RB32 = (LAS unsigned*)RB; \
            _Pragma("unroll") for (int r = 0; r < 4; ++r) { const int pc = pc0_ + 8 * r; \
                const unsigned va0[4] = {pb[r].x, pb[r].y, pb[r].z, pb[r].w}, va1[4] = {pb[4 + r].x, pb[4 + r].y, pb[4 + r].z, pb[4 + r].w}; \
                _Pragma("unroll") for (int i = 0; i < 8; ++i) { const unsigned a = va0[i >> 1], b = va1[i >> 1]; \
                    RB32[((pc * 8 + i) * RS) / 2 + jp_] = (i & 1) ? ((a >> 16) | (b & 0xffff0000u)) : ((a & 0xffffu) | (b << 16)); } } } while (0)
#define RO_LOAD_I(dir_, dh_) do { const bool has_ = (dir_) == 0 ? has_f : has_b; const int cn_ = (dir_) == 0 ? c - 1 : c + 1; \
            const bf16* St = ((dir_) == 0 ? STF : STB) + (size_t)((has_ ? cn_ : c) * 4 + h) * 65536; \
            _Pragma("unroll") for (int r = 0; r < 8; ++r) { const int f = tq + 512 * r, row = f >> 4, pc = f & 15; pb[r] = has_ ? *(const v4u*)(St + (size_t)row * 256 + (dh_) * 128 + pc * 8) : (v4u){0u, 0u, 0u, 0u}; } \
            _Pragma("unroll") for (int r = 0; r < 4; ++r) { const int f = tq + 512 * r, row = f >> 4, pc = f & 15; pa[r] = *(const v4u*)(H + (size_t)(t0 + row) * INW + COL_Q + h * 256 + (dh_) * 128 + pc * 8); } } while (0)
#define RO_STORE_I(dir_, dh_) do { \
            _Pragma("unroll") for (int r = 0; r < 4; ++r) { const int f = tq + 512 * r, row = f >> 4, pc = f & 15; \
                const float fac = exp2f(lg * ((dir_) == 0 ? (float)(row + 1) : (float)(128 - row))); float qf[8]; unpack8(pa[r], qf); \
                _Pragma("unroll") for (int k = 0; k < 8; ++k) qf[k] *= fac; \
                *(LAS v4u*)(RA + row * RS + pc * 8) = pack8(qf); } \
            _Pragma("unroll") for (int r = 0; r < 8; ++r) { const int f = tq + 512 * r, row = f >> 4, pc = f & 15; *(LAS v4u*)(RB + row * RS + pc * 8) = pb[r]; } } while (0)
        f32x4 S[4][2];
#pragma unroll
        for (int ti = 0; ti < 4; ++ti)
#pragma unroll
            for (int tj = 0; tj < 2; ++tj) S[ti][tj] = (f32x4){0.f, 0.f, 0.f, 0.f};
        RO_LOAD_QK(0);
#pragma unroll
        for (int dh = 0; dh < 2; ++dh) {
            if (dh) __syncthreads();
            RO_STORE_QK();
            __syncthreads();
            if (dh == 0) RO_LOAD_QK(1); else RO_LOAD_V();
#pragma unroll
            for (int ks = 0; ks < 4; ++ks) {
                bf16x8 ka[2], qb[4];
#pragma unroll
                for (int tj = 0; tj < 2; ++tj) ka[tj] = *(const LAS bf16x8*)(RB + (32 * wj + 16 * tj + lr) * RS + 32 * ks + lq * 8);
#pragma unroll
                for (int ti = 0; ti < 4; ++ti) qb[ti] = *(const LAS bf16x8*)(RA + (64 * wi + 16 * ti + lr) * RS + 32 * ks + lq * 8);
#pragma unroll
                for (int ti = 0; ti < 4; ++ti)
#pragma unroll
                    for (int tj = 0; tj < 2; ++tj) S[ti][tj] = MFMA16(ka[tj], qb[ti], S[ti][tj]);
            }
        }
#pragma unroll
        for (int ti = 0; ti < 4; ++ti)
#pragma unroll
            for (int tj = 0; tj < 2; ++tj) {
                const int i = 64 * wi + 16 * ti + lr, j0 = 32 * wj + 16 * tj + 4 * lq; float p[4];
#pragma unroll
                for (int jj = 0; jj < 4; ++jj) { const int d = i - (j0 + jj); p[jj] = S[ti][tj][jj] * exp2f(lg * (float)(d < 0 ? -d : d)); }
                v2u w; w.x = pkbf(p[0], p[1]); w.y = pkbf(p[2], p[3]); *(LAS v2u*)(RC + i * RS + j0) = w;
            }
        __syncthreads();
        RO_STORE_V();
        __syncthreads();
        RO_LOAD_I(0, 0);
        f32x4 O[4][4];
#pragma unroll
        for (int ti = 0; ti < 4; ++ti)
#pragma unroll
            for (int te = 0; te < 4; ++te) O[ti][te] = (f32x4){0.f, 0.f, 0.f, 0.f};
#pragma unroll
        for (int ks = 0; ks < 4; ++ks) {
            bf16x8 va[4], pbf[4];
#pragma unroll
            for (int te = 0; te < 4; ++te) va[te] = *(const LAS bf16x8*)(RB + (64 * we + 16 * te + lr) * RS + 32 * ks + lq * 8);
#pragma unroll
            for (int ti = 0; ti < 4; ++ti) pbf[ti] = *(const LAS bf16x8*)(RC + (64 * wi + 16 * ti + lr) * RS + 32 * ks + lq * 8);
#pragma unroll
            for (int ti = 0; ti < 4; ++ti)
#pragma unroll
                for (int te = 0; te < 4; ++te) O[ti][te] = MFMA16(va[te], pbf[ti], O[ti][te]);
        }
#pragma unroll
        for (int stg = 0; stg < 4; ++stg) {
            __syncthreads();
            if (stg == 0) RO_STORE_I(0, 0); else if (stg == 1) RO_STORE_I(0, 1); else if (stg == 2) RO_STORE_I(1, 0); else RO_STORE_I(1, 1);
            __syncthreads();
            if (stg == 0) RO_LOAD_I(0, 1); else if (stg == 1) RO_LOAD_I(1, 0); else if (stg == 2) RO_LOAD_I(1, 1);
#pragma unroll
            for (int ks = 0; ks < 4; ++ks) {
                bf16x8 sa[4], qb[4];
#pragma unroll
                for (int te = 0; te < 4; ++te) sa[te] = *(const LAS bf16x8*)(RB + (64 * we + 16 * te + lr) * RS + 32 * ks + lq * 8);
#pragma unroll
                for (int ti = 0; ti < 4; ++ti) qb[ti] = *(const LAS bf16x8*)(RA + (64 * wi + 16 * ti + lr) * RS + 32 * ks + lq * 8);
#pragma unroll
                for (int ti = 0; ti < 4; ++ti)
#pragma unroll
                    for (int te = 0; te < 4; ++te) O[ti][te] = MFMA16(sa[te], qb[ti], O[ti][te]);
            }
        }
#undef RO_LOAD_QK
#undef RO_STORE_QK
#undef RO_LOAD_V
#undef RO_STORE_V
#undef RO_LOAD_I
#undef RO_STORE_I
        __syncthreads();
        v4u gq[8];
        { const int tq3 = opaque(tid);
#pragma unroll
          for (int r = 0; r < 8; ++r) { const int f = tq3 + 512 * r, row = f >> 5, pc = f & 31; gq[r] = *(const v4u*)(H + (size_t)(t0 + row) * INW + COL_G + h * 256 + pc * 8); } }
        LAS float* RED = (LAS float*)RA;
#pragma unroll
        for (int ti = 0; ti < 4; ++ti) { float s1 = 0.f, s2 = 0.f;
#pragma unroll
            for (int te = 0; te < 4; ++te)
#pragma unroll
                for (int jj = 0; jj < 4; ++jj) { const float v = O[ti][te][jj]; s1 += v; s2 += v * v; }
            s1 += __shfl_xor(s1, 16); s1 += __shfl_xor(s1, 32); s2 += __shfl_xor(s2, 16); s2 += __shfl_xor(s2, 32);
            if (lq == 0) { RED[((64 * wi + 16 * ti + lr) * 4 + we) * 2] = s1; RED[((64 * wi + 16 * ti + lr) * 4 + we) * 2 + 1] = s2; } }
        __syncthreads();
        LAS bf16* ON = RB;
#pragma unroll
        for (int ti = 0; ti < 4; ++ti) { const int i = 64 * wi + 16 * ti + lr;
            const f32x4 r0 = *(const LAS f32x4*)(RED + i * 8), r1 = *(const LAS f32x4*)(RED + i * 8 + 4);
            const float m = (r0[0] + r0[2] + r1[0] + r1[2]) * (1.0f / 256.0f), q = (r0[1] + r0[3] + r1[1] + r1[3]) * (1.0f / 256.0f);
            const float var = fmaxf(q - m * m, 0.f), rstd = 1.0f / sqrtf(var + GN_EPS);
#pragma unroll
            for (int te = 0; te < 4; ++te) { const int e0 = 64 * we + 16 * te + 4 * lq;
                v2u w; w.x = pkbf((O[ti][te][0] - m) * rstd, (O[ti][te][1] - m) * rstd); w.y = pkbf((O[ti][te][2] - m) * rstd, (O[ti][te][3] - m) * rstd);
                *(LAS v2u*)(ON + i * 264 + e0) = w; } }
        __syncthreads();
        {
            const int tq2 = opaque(tid);
#pragma unroll
            for (int r = 0; r < 8; ++r) { const int f = tq2 + 512 * r, row = f >> 5, pc = f & 31;
                float ov[8], gv[8]; unpack8(*(const LAS v4u*)(ON + row * 264 + pc * 8), ov); unpack8(gq[r], gv);
#pragma unroll
                for (int k = 0; k < 8; ++k) ov[k] = (gv[k] * __builtin_amdgcn_rcpf(1.0f + __expf(-gv[k]))) * ov[k];
                *(v4u*)(CC + (size_t)(t0 + row) * DM + 1024 + h * 256 + pc * 8) = pack8(ov); }
        }
        __syncthreads();
    }
}

__device__ __forceinline__ unsigned f2key(float f) { const unsigned u = __float_as_uint(f); return (u & 0x80000000u) ? ~u : (u | 0x80000000u); }
__device__ __forceinline__ float key2f(unsigned k) { const unsigned u = (k & 0x80000000u) ? (k & 0x7fffffffu) : ~k; return __uint_as_float(u); }
#define TK_CE(a, b) do { const unsigned hi_ = (a) > (b) ? (a) : (b), lo_ = (a) > (b) ? (b) : (a); (a) = hi_; (b) = lo_; } while (0)
__device__ __forceinline__ void bitonic_merge16(unsigned (&v)[16]) {
#pragma unroll
    for (int j = 8; j > 0; j >>= 1)
#pragma unroll
        for (int i = 0; i < 16; ++i) { const int l = i ^ j; if (l > i) TK_CE(v[i], v[l]); }
}
__device__ __forceinline__ void bitonic_sort16(unsigned (&v)[16]) {
#pragma unroll
    for (int k = 2; k <= 16; k <<= 1)
#pragma unroll
        for (int j = k >> 1; j > 0; j >>= 1)
#pragma unroll
            for (int i = 0; i < 16; ++i) { const int l = i ^ j; if (l > i) { if ((i & k) == 0) TK_CE(v[i], v[l]); else TK_CE(v[l], v[i]); } }
}
__device__ __forceinline__ void topk_phase(const Frame& F, CArgs& A) {
    const _Float16* SC = (const _Float16*)(F.ws + WS_H); int* IDX = (int*)(F.ws + WS_IDX); float* GATE = (float*)(F.ws + WS_GATE);
    typedef _Float16 h8 __attribute__((ext_vector_type(8)));
    LAS unsigned* LK = (LAS unsigned*)F.lds;
    const int tid = F.tid, tl = tid >> 4, hp = tid & 15;
    for (int blk = F.bx; blk < NTOK / 32; blk += F.G) {
        const int t = blk * 32 + tl;
        const _Float16* row = SC + (size_t)t * DM + hp * 128;
        unsigned run[16];
#pragma unroll
        for (int k = 0; k < 16; ++k) run[k] = 0u;
        h8 cur[16];
#pragma unroll
        for (int q = 0; q < 16; ++q) cur[q] = *(const h8*)(row + q * 8);
#pragma unroll
        for (int c16 = 0; c16 < 8; ++c16) {
            unsigned ch[16];
#pragma unroll
            for (int q = 0; q < 2; ++q)
#pragma unroll
                for (int e = 0; e < 8; ++e) { const int n = c16 * 16 + q * 8 + e; ch[q * 8 + e] = (f2key((float)cur[c16 * 2 + q][e]) & ~127u) | (unsigned)(127 - n); }
            bitonic_sort16(ch);
#pragma unroll
            for (int i = 0; i < 16; ++i) run[i] = run[i] > ch[15 - i] ? run[i] : ch[15 - i];
            bitonic_merge16(run);
        }
#pragma unroll
        for (int k = 0; k < 16; ++k) LK[tid * 17 + k] = run[k];
        __syncthreads();
        {
            const int odd = hp & 1, te = tid & ~1;
            const int la = (te + odd) * 17, lb = (te + 1 - odd) * 17;
            float a[16], b[16];
#pragma unroll
            for (int k = 0; k < 16; ++k) { a[k] = key2f(LK[la + k] & ~127u); b[k] = key2f(LK[lb + k] & ~127u); }
            unsigned sk[16];
#pragma unroll
            for (int k = 0; k < 16; ++k) sk[k] = 0u;
#define TK_INS(sum_, cell_) do { unsigned key = (f2key(sum_) & ~255u) | (unsigned)(255 - (cell_)); \
                _Pragma("unroll") for (int k = 0; k < 16; ++k) { const unsigned hi = sk[k] > key ? sk[k] : key, lo = sk[k] > key ? key : sk[k]; sk[k] = hi; key = lo; } } while (0)
#pragma unroll
            for (int i = 0; i < 16; ++i)
#pragma unroll
                for (int j = i + 1; j < 16; ++j) if ((i + 1) * (j + 1) <= 16) TK_INS(a[i] + b[j], odd ? j * 16 + i : i * 16 + j);
            {
                float a0 = a[0], a1 = a[1], a2 = a[2], a3 = a[3], b0 = b[0], b1 = b[1], b2 = b[2], b3 = b[3];
                asm("" : "+v"(a0)); asm("" : "+v"(a1)); asm("" : "+v"(a2)); asm("" : "+v"(a3)); asm("" : "+v"(b0)); asm("" : "+v"(b1)); asm("" : "+v"(b2)); asm("" : "+v"(b3));
                TK_INS((odd ? a2 : a0) + (odd ? b2 : b0), odd ? 2 * 17 : 0);
                TK_INS((odd ? a3 : a1) + (odd ? b3 : b1), odd ? 3 * 17 : 17);
            }
#undef TK_INS
#pragma unroll
            for (int k = 0; k < 16; ++k) { const unsigned o = (unsigned)__shfl_xor((int)sk[15 - k], 1); sk[k] = sk[k] > o ? sk[k] : o; }
            bitonic_merge16(sk);
            float e[16], sum = 0.f; const float s0 = key2f(sk[0] & ~255u);
#pragma unroll
            for (int k = 0; k < 16; ++k) { e[k] = __expf(key2f(sk[k] & ~255u) - s0); sum += e[k]; }
            const float inv = 1.0f / sum; const int head = hp >> 1;
#pragma unroll
            for (int kk = 0; kk < 8; ++kk) {
                unsigned klo = sk[kk], khi = sk[8 + kk]; float elo = e[kk], ehi = e[8 + kk];
                asm("" : "+v"(klo)); asm("" : "+v"(khi)); asm("" : "+v"(elo)); asm("" : "+v"(ehi));
                const unsigned key = odd ? khi : klo; const float ev = odd ? ehi : elo; const int k = odd * 8 + kk;
                const int cell = 255 - (int)(key & 255u);
                const int i1 = 127 - (int)(LK[te * 17 + (cell >> 4)] & 127u), i2 = 127 - (int)(LK[(te + 1) * 17 + (cell & 15)] & 127u);
                IDX[(size_t)t * 128 + head * 16 + k] = i1 * 128 + i2;
                GATE[(size_t)t * 128 + head * 16 + k] = ev * inv;
            }
        }
        __syncthreads();
    }
}
typedef int v8i __attribute__((ext_vector_type(8)));
__device__ __forceinline__ void peer_gather_phase(const Frame& F, CArgs& A, int l, float* xdst_base, bf16* XN) {
    constexpr int RB = DM / 2;
    constexpr int GNR = GATHER_ROWS;
    const unsigned char* U8 = F.ws + WS_U8 + (size_t)l * NEXP * RB; const unsigned char* V8 = F.ws + WS_V8 + (size_t)l * NEXP * RB;
    const float* USC = (const float*)(F.ws + WS_USC) + (size_t)l * NEXP; const float* VSC = (const float*)(F.ws + WS_VSC) + (size_t)l * NEXP;
    const int* IDX = (const int*)(F.ws + WS_IDX); const float* GATE = (const float*)(F.ws + WS_GATE);
    const float* g2 = GIN(A, I_LN2G) + (size_t)l * DM; const float* b2 = GIN(A, I_LN2B) + (size_t)l * DM;
    LAS unsigned char* XF8 = F.lds + F.wave * 2560;
    LAS float* HS = (LAS float*)(F.lds + F.wave * 2560 + 2048);
    const int lane = F.lane, lr = lane & 15, lq = lane >> 4;
    for (int t = F.gw; t < NTOK; t += F.NGW) {
        const bf16* xrow = XN + (size_t)t * DM;
        {
            v4u w0, w1;
#pragma unroll
            for (int j = 0; j < 8; ++j) { const v2u a = *(const v2u*)(xrow + j * 256 + lane * 4); int pk = 0;
                pk = __builtin_amdgcn_cvt_pk_fp8_f32(bf_lo(a.x), bf_hi(a.x), pk, false); pk = __builtin_amdgcn_cvt_pk_fp8_f32(bf_lo(a.y), bf_hi(a.y), pk, true);
                if (j < 4) w0[j] = (unsigned)pk; else w1[j - 4] = (unsigned)pk; }
            *(LAS v4u*)(XF8 + lane * 32) = w0; *(LAS v4u*)(XF8 + lane * 32 + 16) = w1;
        }
        const int idx0 = IDX[(size_t)t * 128 + lane], idx1 = IDX[(size_t)t * 128 + 64 + lane];
        const float gate0 = GATE[(size_t)t * 128 + lane], gate1 = GATE[(size_t)t * 128 + 64 + lane];
        const float usc0 = USC[idx0], usc1 = USC[idx1], vsc0 = VSC[idx0], vsc1 = VSC[idx1];
        unsigned rowoff[8];
#pragma unroll
        for (int g = 0; g < 8; ++g) rowoff[g] = (unsigned)__shfl((g >> 2) ? idx1 : idx0, (g & 3) * 16 + lr) * (unsigned)RB + (unsigned)lq * 16u;
        v4u AB[8][2];
#pragma unroll
        for (int g = 0; g < 8; ++g) { AB[g][0] = *(const v4u*)(U8 + rowoff[g]); AB[g][1] = *(const v4u*)(U8 + rowoff[g] + 64); }
        f32x4 hacc[8];
#pragma unroll
        for (int g = 0; g < 8; ++g) hacc[g] = (f32x4){0.f, 0.f, 0.f, 0.f};
        LDS_WAIT();
#pragma unroll 1
        for (int kp = 0; kp < 8; ++kp) {
            const LAS unsigned char* xq = XF8 + ((2 * kp) * 4 + (lq >> 1)) * 32 + 16 * (lq & 1);
            const v4u b00 = *(const LAS v4u*)xq, b01 = *(const LAS v4u*)(xq + 64), b10 = *(const LAS v4u*)(xq + 128), b11 = *(const LAS v4u*)(xq + 192);
            const v8i B0 = (v8i){(int)b00[0], (int)b00[1], (int)b00[2], (int)b00[3], (int)b01[0], (int)b01[1], (int)b01[2], (int)b01[3]};
            const v8i B1 = (v8i){(int)b10[0], (int)b10[1], (int)b10[2], (int)b10[3], (int)b11[0], (int)b11[1], (int)b11[2], (int)b11[3]};
#pragma unroll
            for (int g = 0; g < 8; ++g) {
                const v8i A0 = (v8i){(int)AB[g][0][0], (int)AB[g][0][1], (int)AB[g][0][2], (int)AB[g][0][3], 0, 0, 0, 0};
                const v8i A1 = (v8i){(int)AB[g][1][0], (int)AB[g][1][1], (int)AB[g][1][2], (int)AB[g][1][3], 0, 0, 0, 0};
                hacc[g] = __builtin_amdgcn_mfma_scale_f32_16x16x128_f8f6f4(A0, B0, hacc[g], 4, 0, 0, 0x7f7f7f7f, 0, 0x7f7f7f7f);
                hacc[g] = __builtin_amdgcn_mfma_scale_f32_16x16x128_f8f6f4(A1, B1, hacc[g], 4, 0, 0, 0x7f7f7f7f, 0, 0x7f7f7f7f);
                if (kp < 7) { AB[g][0] = *(const v4u*)(U8 + rowoff[g] + (kp + 1) * 128); AB[g][1] = *(const v4u*)(U8 + rowoff[g] + (kp + 1) * 128 + 64); }
            }
        }
        if (lr == 0) {
#pragma unroll
            for (int g = 0; g < 8; ++g) *(LAS f32x4*)(HS + g * 16 + 4 * lq) = hacc[g];
        }
        LDS_WAIT();
        const float hval0 = HS[lane], hval1 = HS[64 + lane];
        const float w0 = gate0 * gelu_erf(hval0 * usc0) * vsc0, w1 = gate1 * gelu_erf(hval1 * usc1) * vsc1;
        v4u BU[GNR];
        const unsigned loff = (unsigned)lane * 16u;
#define G_ROW_V(R) (V8 + (size_t)(unsigned)__builtin_amdgcn_readlane((((R) >> 6) & 1) ? idx1 : idx0, (R) & 63) * RB)
#define G_REQ(r, rowptr) do { BU[r] = *(const v4u*)((rowptr) + loff); } while (0)
#pragma unroll
        for (int r = 0; r < GNR; ++r) G_REQ(r, G_ROW_V(r));
        f32x2v acc[16];
#pragma unroll
        for (int k = 0; k < 16; ++k) acc[k] = (f32x2v){0.f, 0.f};
#define G_AXPY(r, R) do { const float w_ = __uint_as_float((unsigned)__builtin_amdgcn_readlane((int)__float_as_uint((((R) >> 6) & 1) ? w1 : w0), (R) & 63)); const f32x2v w2_ = (f32x2v){w_, w_}; \
            _Pragma("unroll") for (int q = 0; q < 4; ++q) { acc[4 * q] += w2_ * __builtin_amdgcn_cvt_scalef32_pk_f32_fp4(BU[r][q], 1.0f, 0); acc[4 * q + 1] += w2_ * __builtin_amdgcn_cvt_scalef32_pk_f32_fp4(BU[r][q], 1.0f, 1); \
                acc[4 * q + 2] += w2_ * __builtin_amdgcn_cvt_scalef32_pk_f32_fp4(BU[r][q], 1.0f, 2); acc[4 * q + 3] += w2_ * __builtin_amdgcn_cvt_scalef32_pk_f32_fp4(BU[r][q], 1.0f, 3); } } while (0)
        for (int it = 0; it < 128 / GNR - 1; ++it) {
#pragma unroll
            for (int r = 0; r < GNR; ++r) { G_AXPY(r, GNR * it + r); G_REQ(r, G_ROW_V(GNR * (it + 1) + r)); }
        }
#pragma unroll
        for (int r = 0; r < GNR; ++r) G_AXPY(r, 128 - GNR + r);
#undef G_ROW_V
#undef G_REQ
#undef G_AXPY
        const int le = opaque(lane);
        float s = 0.f;
#pragma unroll
        for (int j = 0; j < 8; ++j) { const v2u xr = *(const v2u*)(xrow + j * 256 + le * 4);
            acc[2 * j] = (f32x2v){bf_lo(xr.x), bf_hi(xr.x)} * ALPHA + acc[2 * j]; acc[2 * j + 1] = (f32x2v){bf_lo(xr.y), bf_hi(xr.y)} * ALPHA + acc[2 * j + 1];
            s += (acc[2 * j][0] + acc[2 * j][1]) + (acc[2 * j + 1][0] + acc[2 * j + 1][1]); }
        const float mean = wave_sum(s) * (1.0f / DM); float s2 = 0.f;
#pragma unroll
        for (int k = 0; k < 16; ++k) { acc[k] = acc[k] - mean; s2 += acc[k][0] * acc[k][0] + acc[k][1] * acc[k][1]; }
        const float rstd = 1.0f / sqrtf(wave_sum(s2) * (1.0f / DM) + LN_EPS);
        f32x4 gq[8], bq[8];
#pragma unroll
        for (int j = 0; j < 8; ++j) { gq[j] = *(const f32x4*)(g2 + j * 256 + le * 4); bq[j] = *(const f32x4*)(b2 + j * 256 + le * 4); }
#pragma unroll
        for (int j = 0; j < 8; ++j) { const int col = j * 256 + le * 4;
            const f32x4 gg = gq[j], bb = bq[j];
            const f32x2v a0 = acc[2 * j], a1 = acc[2 * j + 1];
            const f32x4 o = (f32x4){a0[0] * rstd * gg[0] + bb[0], a0[1] * rstd * gg[1] + bb[1], a1[0] * rstd * gg[2] + bb[2], a1[1] * rstd * gg[3] + bb[3]};
            if (xdst_base) *(f32x4*)(xdst_base + (size_t)t * DM + col) = o;
            v2u w; w.x = pkbf(o[0], o[1]); w.y = pkbf(o[2], o[3]); *(v2u*)(XN + (size_t)t * DM + col) = w; }
        LDS_WAIT();
    }
}

#ifndef DUP_MASK
#define DUP_MASK 0
#endif
#ifndef PHASE_TEST_ONLY
__global__ void __launch_bounds__(NTHR, 2) fwd_kernel(Args A) {
    extern __shared__ __attribute__((aligned(16))) unsigned char lds_raw[];
#define MKFRAME() Frame F; CArgs& KA = *(CArgs*)opaque_u64((unsigned long long)__builtin_amdgcn_kernarg_segment_ptr()); { F.lds = (LAS unsigned char*)lds_raw; F.tid = opaque((int)threadIdx.x); F.lane = F.tid & 63; F.wave = __builtin_amdgcn_readfirstlane(F.tid >> 6); \
        const int bx_ = opaque_s((int)blockIdx.x); F.G = gridDim.x; F.gw = bx_ * NWAVES + F.wave; F.NGW = F.G * NWAVES; F.gtid = (size_t)bx_ * NTHR + F.tid; F.NT = (size_t)F.G * NTHR; F.out = (float*)(float GAS*)opaque_g((unsigned char GAS*)KA.out); F.ws = (unsigned char*)opaque_g(KA.ws); F.bx = bx_; } \
        bf16* XN = (bf16*)(F.ws + WS_XN); bf16* H = (bf16*)(F.ws + WS_H); bf16* CC = (bf16*)(F.ws + WS_CONCAT); (void)XN; (void)H; (void)CC;
    volatile LAS unsigned* MISC = (volatile LAS unsigned*)((LAS unsigned char*)lds_raw + LDS_MISC);
    if (threadIdx.x < 64) MISC[threadIdx.x] = 0u;
    __syncthreads();
    XcdBarrier bar = xcd_barrier_post((unsigned*)(A.ws + WS_CTL) + CW_BAR + A.li * XCD_BAR_WORDS, MISC + 8);
    const int lo = A.ph_lo, hi = A.ph_hi;
#define IN(k) (lo <= (k) && (k) < hi)
#define SEAM(k) do { if (lo <= (k) && (k) + 1 < hi) xcd_barrier(bar); } while (0)

    if (IN(0)) { MKFRAME(); p0_prologue(F, KA); if (DUP_MASK & 256) { __syncthreads(); p0_prologue(F, KA); } } SEAM(0);

    for (int l = 0; l < NLAYER; ++l) {
        const int pb = 1 + l * 10;
        if (IN(pb + 0)) { MKFRAME();
            pg8::Gemm g{XN, (const bf16*)(F.ws + WS_WIN) + (size_t)l * INW * DM, NTOK, INW, DM}; pg8::StaticOrder S; S.init(NTOK, INW, F.G, F.bx);
            EpiStoreRot E{H, INW, (const float*)(F.ws + WS_ROTC), (const float*)(F.ws + WS_ROTS)};
            pg8::gemm_phase<EpiStoreRot, pg8::StaticOrder, GEMM_ALIGN, GEMM_SP2>(F.lds, g, S, E);
            if (DUP_MASK & 64) { pg8::gemm_phase<EpiStoreRot, pg8::StaticOrder, GEMM_ALIGN, GEMM_SP2>(F.lds, g, S, E); }
        } SEAM(pb + 0);
        if (IN(pb + 1)) { MKFRAME(); s5_pass1(F, KA, l); pool_phase(F, KA); if (DUP_MASK & 1) { s5_pass1(F, KA, l); } if (DUP_MASK & 2) { pool_phase(F, KA); } } SEAM(pb + 1);
        if (IN(pb + 2)) { MKFRAME(); s5_carry(F, KA, l); __syncthreads(); ret_state_phase(F, KA, (unsigned*)(F.ws + WS_CTL) + 64 + 16 * l); if (DUP_MASK & 4) { ret_state_phase(F, KA); } if (DUP_MASK & 2048) { ret_state_phase<1>(F, KA); } if (DUP_MASK & 4096) { ret_state_phase<2>(F, KA); ret_state_phase(F, KA); } } SEAM(pb + 2);
        if (IN(pb + 3)) { MKFRAME(); s5_pass3(F, KA, l); if (DUP_MASK & 8) { s5_pass3(F, KA, l); } ret_prefix_phase(F, KA); } SEAM(pb + 3);
        if (IN(pb + 4)) { MKFRAME();
            __syncthreads();
            ret_out_phase(F, KA);
            if (DUP_MASK & 16) { ret_out_phase(F, KA); }
            {
                pg8::Gemm g{(const bf16*)(F.ws + WS_BUFY), (const bf16*)(F.ws + WS_WGLU) + (size_t)l * 512 * 512, NTOK, 512, 512}; pg8::StaticOrder S; S.init(NTOK, 512, F.G, F.bx);
                EpiGlu E{(const bf16*)(F.ws + WS_BUFY), 512, CC, DM, GIN(KA, I_BGLU) + (size_t)l * 512};
                pg8::gemm_phase<EpiGlu, pg8::StaticOrder, GEMM_ALIGN, GEMM_SP2>(F.lds, g, S, E);
                if (DUP_MASK & 512) { pg8::gemm_phase<EpiGlu, pg8::StaticOrder, GEMM_ALIGN, GEMM_SP2>(F.lds, g, S, E); }
            }
        } SEAM(pb + 4);
        if (IN(pb + 5)) { MKFRAME();
            pg8::Gemm g{CC, (const bf16*)(F.ws + WS_WOUT) + (size_t)l * DM * DM, NTOK, DM, DM}; pg8::StaticOrder S; S.init(NTOK, DM, F.G, F.bx);
            EpiStoreBf16 E{H, DM};
            pg8::gemm_phase<EpiStoreBf16, pg8::StaticOrder, GEMM_ALIGN, GEMM_SP2>(F.lds, g, S, E);
        } SEAM(pb + 5);
        if (IN(pb + 6)) { MKFRAME();
            ln_rows2(XN, H, ALPHA, GIN(KA, I_LN1G) + (size_t)l * DM, GIN(KA, I_LN1B) + (size_t)l * DM, F.gw, F.NGW, F.lane);
        } SEAM(pb + 6);
        if (IN(pb + 7)) { MKFRAME();
            pg8::Gemm g{XN, (const bf16*)(F.ws + WS_WS) + (size_t)l * DM * DM, NTOK, DM, DM}; pg8::StaticOrder S; S.init(NTOK, DM, F.G, F.bx);
            EpiStoreF16 E{(_Float16*)(F.ws + WS_H), DM};
            pg8::gemm_phase<EpiStoreF16, pg8::StaticOrder, GEMM_ALIGN, GEMM_SP2>(F.lds, g, S, E);
            if (DUP_MASK & 128) { pg8::gemm_phase<EpiStoreF16, pg8::StaticOrder, GEMM_ALIGN, GEMM_SP2>(F.lds, g, S, E); }
        } SEAM(pb + 7);
        if (IN(pb + 8)) { MKFRAME(); __syncthreads(); topk_phase(F, KA); if (DUP_MASK & 32) { topk_phase(F, KA); } } SEAM(pb + 8);
        if (IN(pb + 9)) { MKFRAME(); if (DUP_MASK & 1024) { peer_gather_phase(F, KA, l, (float*)(F.ws + WS_H), CC); } peer_gather_phase(F, KA, l, l == NLAYER - 1 ? F.out : (float*)nullptr, XN); } SEAM(pb + 9);
    }
#undef IN
#undef SEAM
}


#ifndef DBG_STOP
#define DBG_STOP NPHASE
#endif
#ifndef MK_ONE_LAUNCH
#define MK_ONE_LAUNCH 0
#endif
extern "C" void kernel_launch(void* const* d_in, const int* in_sizes, int n_in, void* d_out, int out_size, void* d_ws, size_t ws_size, hipStream_t stream) {
    static int grid = 0;
    if (grid == 0) {
        if (n_in != 26 || out_size != NTOK * DM || ws_size < WS_END) { fprintf(stderr, "kernel_launch: unexpected shapes (n_in %d out %d ws %zu)\n", n_in, out_size, ws_size); grid = -1; return; }
        int dev = 0, cus = 0, per_cu = 0;
        if (hipGetDevice(&dev) != hipSuccess || hipDeviceGetAttribute(&cus, hipDeviceAttributeMultiprocessorCount, dev) != hipSuccess) { grid = -1; return; }
        if (hipFuncSetAttribute((const void*)fwd_kernel, hipFuncAttributeMaxDynamicSharedMemorySize, LDS_BYTES) != hipSuccess) { fprintf(stderr, "kernel_launch: hipFuncSetAttribute failed\n"); grid = -1; return; }
        if (hipOccupancyMaxActiveBlocksPerMultiprocessor(&per_cu, (const void*)fwd_kernel, NTHR, LDS_BYTES) != hipSuccess || per_cu < 1) { fprintf(stderr, "kernel_launch: occupancy query says %d\n", per_cu); grid = -1; (void)hipGetLastError(); return; }
        (void)hipGetLastError();
        grid = cus;
    }
    if (grid < 0) return;
    if (hipMemsetAsync((char*)d_ws + WS_CTL, 0, CTL_ZERO_BYTES, stream) != hipSuccess) return;
    Args a{};
    for (int i = 0; i < 26; ++i) a.in[i] = (const float*)d_in[i];
    a.out = (float*)d_out; a.ws = (unsigned char*)d_ws; a.pad = 0;
#if MK_ONE_LAUNCH
    a.ph_lo = 0; a.ph_hi = NPHASE; a.li = 0;
    hipLaunchKernelGGL(fwd_kernel, dim3(grid), dim3(NTHR), LDS_BYTES, stream, a);
#else
    for (int p = 0; p < DBG_STOP; ++p) { a.ph_lo = p; a.ph_hi = p + 1; a.li = p; hipLaunchKernelGGL(fwd_kernel, dim3(grid), dim3(NTHR), LDS_BYTES, stream, a); }
#endif
}
#endif
```

```cpp
#include <hip/hip_runtime.h>
#include <cstdio>
#include <cstdint>
#include <cmath>
__device__ __forceinline__ __attribute__((convergent)) void mk_syncthreads() { __builtin_amdgcn_fence(__ATOMIC_RELEASE, "workgroup"); __builtin_amdgcn_s_barrier(); __builtin_amdgcn_fence(__ATOMIC_ACQUIRE, "workgroup"); }
#define __syncthreads mk_syncthreads
__device__ __forceinline__ int opaque(int v) { asm volatile("" : "+v"(v)); return v; }
__device__ __forceinline__ int opaque_s(int v) { asm volatile("" : "+s"(v)); return v; }
__device__ __forceinline__ void* opaque_p(void* p) { asm volatile("" : "+s"(p)); return p; }
__device__ __forceinline__ unsigned long long opaque_u64(unsigned long long v) { asm volatile("" : "+s"(v)); return v; }
#ifndef GATHER_ROWS
#define GATHER_ROWS 16
#endif
__device__ __forceinline__ __attribute__((address_space(1))) unsigned char* opaque_g(__attribute__((address_space(1))) unsigned char* p) { asm volatile("" : "+s"(p)); return p; }
#ifndef GEMM_ALIGN
#define GEMM_ALIGN true
#endif
#ifndef GEMM_SP2
#define GEMM_SP2 true
#endif
#define MK_ONE_LAUNCH 1
namespace pg8 {
#define PG8_LAS __attribute__((address_space(3)))
typedef unsigned short bf16_t;
typedef short bf16x8 __attribute__((ext_vector_type(8)));
typedef float f32x4 __attribute__((ext_vector_type(4)));
typedef unsigned u32x4 __attribute__((ext_vector_type(4)));
constexpr int BM = 256, BK = 64, HALF = 128, HTB = HALF * BK * 2  , STAGE_BYTES = 8 * HTB, NXCD = 8, WGM = 8;

__host__ __device__ __forceinline__ int lds_byte(int r, int c) { const int st = (r >> 4) * 2 + (c >> 5), rr = r & 15, cc = c & 31, ob = rr * 64 + cc * 2; return st * 1024 + (ob ^ (((ob >> 9) & 1) << 5)); }
__host__ __device__ __forceinline__ void stage_rc(int b, int& R, int& C) { const int st = b / 1024, sb = b % 1024, swz = sb ^ (((sb >> 9) & 1) << 5); R = (st >> 1) * 16 + swz / 64; C = (st & 1) * 32 + (swz % 64) / 2; }
__host__ __device__ __forceinline__ int perm32(int rho) { const int n = rho >> 4, i = rho & 15; return 8 * (i >> 2) + 4 * n + (i & 3); }

struct Unit { int pm, pn; };
struct Gemm { const bf16_t* A; const bf16_t* Bt; int M, N, K; };

struct StaticOrder {
    int nM, nN, nwg, G, c;
    __host__ __device__ __forceinline__ void init(int M, int N, int G_, int c_) { nM = M / BM; nN = N / BM; nwg = nM * nN; G = G_; c = c_; }
    __host__ __device__ bool next(int i, Unit& u) const {
        const long L = (long)i * G + c; if (L >= nwg) return false;
        int wgid = (int)L; { const int q = nwg / NXCD, r = nwg % NXCD, xcd = wgid % NXCD, off = wgid / NXCD; wgid = (xcd < r ? xcd * (q + 1) : r * (q + 1) + (xcd - r) * q) + off; }
        const int nig = WGM * nN, gid = wgid / nig, fm = gid * WGM, gsz = (nM - fm) < WGM ? (nM - fm) : WGM;
        u.pm = fm + ((wgid % nig) % gsz); u.pn = (wgid % nig) / gsz; return true;
    }
    __device__ __forceinline__ void a_ready(const Unit&) const {}
    __device__ __forceinline__ void done(const Unit&) const {}
};
__device__ __forceinline__ unsigned cvt_pk_bf16(float lo, float hi) { unsigned r; asm volatile("v_cvt_pk_bf16_f32 %0, %1, %2" : "=v"(r) : "v"(lo), "v"(hi)); return r; }
typedef float f32x2 __attribute__((ext_vector_type(2)));
template <class Epi, class Sched, bool ALIGN_EPI = false, bool SP2 = false>
__device__ __forceinline__ void gemm_phase(PG8_LAS unsigned char* lds, const Gemm g, const Sched& S, const Epi& E) {
    const int tid = opaque((int)threadIdx.x), wid = __builtin_amdgcn_readfirstlane(tid >> 6), lane = tid & 63, wr = wid >> 2, wc = wid & 3, fr = lane & 15, fq = lane >> 4;
    const int K = g.K, nt = K / BK;
    unsigned voffA[2], voffB[2];
#pragma unroll
    for (int i = 0; i < 2; ++i) { int R, C; stage_rc(tid * 16 + i * 8192, R, C); const int Rb = Epi::PERM ? ((R & ~31) + perm32(R & 31)) : R;
        voffA[i] = (unsigned)(R * K + C) * 2u; voffB[i] = (unsigned)(Rb * K + C) * 2u; }
    const size_t kstep = (size_t)(BK * 2);
    const size_t hstep = (size_t)HALF * K * 2;
    const size_t tstep = 2 * hstep;
    const unsigned ldsw = (unsigned)wid * 1024u;
    const int aoff = lds_byte(wr * 64 + fr, fq * 8), boff = lds_byte(wc * 32 + fr, fq * 8);
#define PG8_SA(b, h) (((b) * 2 + (h)) * HTB)
#define PG8_SB(b, h) ((4 + (b) * 2 + (h)) * HTB)
#define PG8_STAGE(bufoff, gbase, voff) do { _Pragma("unroll") for (int _i = 0; _i < 2; ++_i) \
        __builtin_amdgcn_global_load_lds((const unsigned*)((const char*)(gbase) + (voff)[_i]), (PG8_LAS unsigned*)(lds + (bufoff) + ldsw + _i * 8192), 16, 0, 0); } while (0)
#define PG8_LDA(dst, b, h) do { _Pragma("unroll") for (int m = 0; m < 4; ++m) _Pragma("unroll") for (int k = 0; k < 2; ++k) dst[m][k] = *(const PG8_LAS bf16x8*)(lds + PG8_SA(b, h) + aoff + m * 2048 + k * 1024); } while (0)
#define PG8_LDB(dst, b, h) do { _Pragma("unroll") for (int n = 0; n < 2; ++n) _Pragma("unroll") for (int k = 0; k < 2; ++k) dst[n][k] = *(const PG8_LAS bf16x8*)(lds + PG8_SB(b, h) + boff + n * 2048 + k * 1024); } while (0)
#define PG8_MMA(ai, bj, At, Bt) do { __builtin_amdgcn_s_setprio(1); _Pragma("unroll") for (int m = 0; m < 4; ++m) _Pragma("unroll") for (int n = 0; n < 2; ++n) _Pragma("unroll") for (int k = 0; k < 2; ++k) \
        acc[ai][bj][m][n] = __builtin_amdgcn_mfma_f32_16x16x32_bf16(Bt[n][k], At[m][k], acc[ai][bj][m][n], 0, 0, 0); __builtin_amdgcn_s_setprio(0); } while (0)
#define PG8_WAIT_V(n) asm volatile("s_waitcnt vmcnt(" #n ")" ::: "memory")
#define PG8_WAIT_L(n) asm volatile("s_waitcnt lgkmcnt(" #n ")" ::: "memory")
#define PG8_BAR __builtin_amdgcn_s_barrier()
#define PG8_SCHED __builtin_amdgcn_sched_barrier(0)
    Unit cur, nxt; int ui = 0;
    if (!S.next(0, cur)) return;
    f32x4 acc[2][2][4][2];
#pragma unroll
    for (int a = 0; a < 2; ++a)
#pragma unroll
        for (int b = 0; b < 2; ++b)
#pragma unroll
            for (int m = 0; m < 4; ++m)
#pragma unroll
                for (int n = 0; n < 2; ++n) acc[a][b][m][n] = (f32x4){0.f, 0.f, 0.f, 0.f};
    bf16x8 At[4][2], B0[2][2], B1[2][2];
    const char* cA = (const char*)g.A + (size_t)cur.pm * tstep; const char* cB = (const char*)g.Bt + (size_t)cur.pn * tstep;
    S.a_ready(cur);
    if constexpr (SP2) {
        PG8_STAGE(PG8_SB(0, 0), cB, voffB); PG8_STAGE(PG8_SB(0, 1), cB + hstep, voffB); PG8_STAGE(PG8_SA(0, 0), cA, voffA); PG8_STAGE(PG8_SA(0, 1), cA + hstep, voffA);
        if (wr == 1) PG8_BAR;
        PG8_WAIT_V(2); PG8_BAR;
        PG8_STAGE(PG8_SB(1, 0), cB + kstep, voffB); PG8_STAGE(PG8_SA(1, 0), cA + kstep, voffA); PG8_STAGE(PG8_SB(1, 1), cB + hstep + kstep, voffB);
        PG8_WAIT_V(6); PG8_BAR;
    } else {
        PG8_STAGE(PG8_SB(0, 0), cB, voffB); PG8_STAGE(PG8_SA(0, 0), cA, voffA); PG8_STAGE(PG8_SB(0, 1), cB + hstep, voffB); PG8_STAGE(PG8_SA(0, 1), cA + hstep, voffA);
        if (wr == 1) PG8_BAR;
        PG8_WAIT_V(4); PG8_BAR;
        PG8_STAGE(PG8_SB(1, 0), cB + kstep, voffB); PG8_STAGE(PG8_SA(1, 0), cA + kstep, voffA); PG8_STAGE(PG8_SB(1, 1), cB + hstep + kstep, voffB);
        PG8_WAIT_V(6); PG8_BAR;
    }
    for (;;) {
        const bool has_next = S.next(ui + 1, nxt);
        const char* nA = has_next ? (const char*)g.A + (size_t)nxt.pm * tstep : cA; const char* nB = has_next ? (const char*)g.Bt + (size_t)nxt.pn * tstep : cB;
        for (int t = 0; t < nt; t += 2) {
            const bool last = (t == nt - 2);
            const char* a1 = cA + (size_t)(t + 1) * kstep;
            const char* a2 = last ? nA : cA + (size_t)(t + 2) * kstep; const char* b2 = last ? nB : cB + (size_t)(t + 2) * kstep;
            const char* a3 = a2 + kstep; const char* b3 = b2 + kstep;
            if (last && has_next) S.a_ready(nxt);
            if constexpr (SP2) {
            PG8_LDB(B0, 0, 0); PG8_LDB(B1, 0, 1); PG8_SCHED; PG8_LDA(At, 0, 0); PG8_STAGE(PG8_SA(1, 1), a1 + hstep, voffA);
            PG8_WAIT_V(8); PG8_WAIT_L(0); PG8_BAR; PG8_MMA(0, 0, At, B0); PG8_MMA(0, 1, At, B1); PG8_BAR; PG8_SCHED;
            PG8_LDA(At, 0, 1); PG8_STAGE(PG8_SB(0, 0), b2, voffB); PG8_STAGE(PG8_SB(0, 1), b2 + hstep, voffB); PG8_STAGE(PG8_SA(0, 0), a2, voffA);
            PG8_WAIT_V(8); PG8_WAIT_L(0); PG8_BAR; PG8_MMA(1, 0, At, B0); PG8_MMA(1, 1, At, B1); PG8_BAR; PG8_SCHED;
            PG8_LDB(B0, 1, 0); PG8_LDB(B1, 1, 1); PG8_SCHED; PG8_LDA(At, 1, 0); PG8_STAGE(PG8_SA(0, 1), a2 + hstep, voffA);
            PG8_WAIT_V(8); PG8_WAIT_L(0); PG8_BAR; PG8_MMA(0, 0, At, B0); PG8_MMA(0, 1, At, B1); PG8_BAR; PG8_SCHED;
            PG8_LDA(At, 1, 1); PG8_STAGE(PG8_SB(1, 0), b3, voffB); PG8_STAGE(PG8_SB(1, 1), b3 + hstep, voffB); PG8_STAGE(PG8_SA(1, 0), a3, voffA);
            PG8_WAIT_V(8); PG8_WAIT_L(0); PG8_BAR; PG8_MMA(1, 0, At, B0); PG8_MMA(1, 1, At, B1); PG8_BAR; PG8_SCHED;
            } else {
            PG8_LDB(B0, 0, 0); PG8_SCHED; PG8_LDA(At, 0, 0); PG8_STAGE(PG8_SA(1, 1), a1 + hstep, voffA);
            PG8_WAIT_L(8); PG8_BAR; PG8_WAIT_L(0); PG8_MMA(0, 0, At, B0); PG8_BAR; PG8_SCHED;
            PG8_LDB(B1, 0, 1); PG8_STAGE(PG8_SB(0, 0), b2, voffB);
            PG8_BAR; PG8_WAIT_L(0); PG8_MMA(0, 1, At, B1); PG8_BAR;
            PG8_LDA(At, 0, 1); PG8_STAGE(PG8_SA(0, 0), a2, voffA);
            PG8_BAR; PG8_WAIT_L(0); PG8_MMA(1, 0, At, B0); PG8_BAR; PG8_SCHED;
            PG8_STAGE(PG8_SB(0, 1), b2 + hstep, voffB);
            PG8_WAIT_V(6); PG8_BAR; PG8_MMA(1, 1, At, B1); PG8_BAR;
            PG8_LDB(B0, 1, 0); PG8_SCHED; PG8_LDA(At, 1, 0); PG8_STAGE(PG8_SA(0, 1), a2 + hstep, voffA);
            PG8_WAIT_L(8); PG8_BAR; PG8_WAIT_L(0); PG8_MMA(0, 0, At, B0); PG8_BAR; PG8_SCHED;
            PG8_LDB(B1, 1, 1); PG8_STAGE(PG8_SB(1, 0), b3, voffB);
            PG8_BAR; PG8_WAIT_L(0); PG8_MMA(0, 1, At, B1); PG8_BAR;
            PG8_LDA(At, 1, 1); PG8_STAGE(PG8_SA(1, 0), a3, voffA);
            PG8_BAR; PG8_WAIT_L(0); PG8_MMA(1, 0, At, B0); PG8_BAR; PG8_SCHED;
            PG8_STAGE(PG8_SB(1, 1), b3 + hstep, voffB);
            PG8_WAIT_V(6); PG8_BAR; PG8_MMA(1, 1, At, B1); PG8_BAR;
            }
        }
        if constexpr (ALIGN_EPI) { if (wr == 0) PG8_BAR; }
        if constexpr (!Epi::AFTER_DRAIN) { E(acc, cur, wr, wc, fr, fq); S.done(cur); }
        if (!has_next) break;
#pragma unroll
        for (int a = 0; a < 2; ++a)
#pragma unroll
            for (int b = 0; b < 2; ++b)
#pragma unroll
                for (int m = 0; m < 4; ++m)
#pragma unroll
                    for (int n = 0; n < 2; ++n) acc[a][b][m][n] = (f32x4){0.f, 0.f, 0.f, 0.f};
        cur = nxt; cA = nA; cB = nB; ++ui;
        if constexpr (ALIGN_EPI) { if (wr == 1) PG8_BAR; }
    }
    PG8_WAIT_V(0);
    if constexpr (!ALIGN_EPI) { if (wr == 0) PG8_BAR; }
    PG8_BAR;
    if constexpr (Epi::AFTER_DRAIN) { E.fused(acc, cur, wr, wc, fr, fq, lds, wid, lane); S.done(cur); }
#undef PG8_SA
#undef PG8_SB
#undef PG8_STAGE
#undef PG8_LDA
#undef PG8_LDB
#undef PG8_MMA
#undef PG8_WAIT_V
#undef PG8_WAIT_L
#undef PG8_BAR
#undef PG8_SCHED
}
}
#define LAS __attribute__((address_space(3)))
#define XB_TMO      128
#define XB_XCNT(j)  (256  + 64 * (j))
#define XB_XSUB(j)  (1280 + 64 * (j))
#define XB_XGEN(j)  (2304 + 64 * (j))
#define XB_TOP      3328
#define XB_TOPGEN   3392
#define XCD_BAR_WORDS 3456
#define XB_SPIN_CAP (1u << 18)

__device__ __forceinline__ unsigned xb_ld(unsigned* p)              { return __hip_atomic_load(p, __ATOMIC_RELAXED, __HIP_MEMORY_SCOPE_AGENT); }
__device__ __forceinline__ unsigned xb_add(unsigned* p, unsigned v) { return __hip_atomic_fetch_add(p, v, __ATOMIC_RELAXED, __HIP_MEMORY_SCOPE_AGENT); }
__device__ __forceinline__ unsigned xb_xcc_id() { return (unsigned)__builtin_amdgcn_s_getreg((3 << 11) | 20) & 0xFu; }
#define XB_SPIN(cond, bar) do { unsigned _sp = 0; while (cond) { __builtin_amdgcn_s_sleep(1); \
    if ((++_sp & 255u) == 0u) { if (xb_ld(&(bar)[XB_TMO])) break; if (_sp > XB_SPIN_CAP) { atomicAdd(&(bar)[XB_TMO], 1u); break; } } } } while (0)

struct XcdBarrier {
    unsigned* bar; unsigned x;
    volatile LAS unsigned* st;
};

__device__ __forceinline__ XcdBarrier xcd_barrier_post(unsigned* bar, volatile LAS unsigned* st) {
    XcdBarrier b; b.bar = bar; b.x = xb_xcc_id(); b.st = st;
    if (threadIdx.x == 0) (void)xb_add(&bar[XB_XCNT(b.x)], 1u);
    return b;
}
__device__ __forceinline__ void xcd_barrier_complete(unsigned* bar, unsigned x, unsigned& nloc, unsigned& nx) {
    const unsigned G = gridDim.x * gridDim.y * gridDim.z;
    unsigned sum, cnt, mine, sp = 0u;
    for (;;) {
        sum = 0u; cnt = 0u; mine = 0u;
#pragma unroll
        for (unsigned j = 0; j < 16; ++j) { const unsigned c = xb_ld(&bar[XB_XCNT(j)]); sum += c; cnt += (c > 0u) ? 1u : 0u; mine = (j == x) ? c : mine; }
        if (sum == G) break;
        __builtin_amdgcn_s_sleep(1);
        if ((++sp & 255u) == 0u) { if (xb_ld(&bar[XB_TMO])) break; if (sp > XB_SPIN_CAP) { atomicAdd(&bar[XB_TMO], 1u); break; } }
    }
    nloc = mine > 0u ? mine : 1u; nx = cnt > 0u ? cnt : 1u;
}

__device__ __forceinline__ void xcd_barrier(const XcdBarrier& b) {
    asm volatile("s_waitcnt vmcnt(0)" ::: "memory");
    __syncthreads();
    if (threadIdx.x == 0) {
        unsigned* bar = b.bar;
        __builtin_amdgcn_s_waitcnt(0);
        unsigned nloc = b.st[0], nx = b.st[1];
        if (nloc == 0u) { xcd_barrier_complete(bar, b.x, nloc, nx); b.st[0] = nloc; b.st[1] = nx; }
        const unsigned old = xb_add(&bar[XB_XSUB(b.x)], 1u);
        const unsigned gen = old / nloc;
        if (old + 1u == (gen + 1u) * nloc) {
            __builtin_amdgcn_fence(__ATOMIC_RELEASE, "agent");
            asm volatile("s_waitcnt vmcnt(0)" ::: "memory");
            const unsigned og = xb_add(&bar[XB_TOP], 1u);
            const unsigned tg = og / nx;
            if (og + 1u == (tg + 1u) * nx) xb_add(&bar[XB_TOPGEN], 1u);
            else XB_SPIN(xb_ld(&bar[XB_TOPGEN]) == tg, bar);
            __builtin_amdgcn_fence(__ATOMIC_ACQUIRE, "agent");
            xb_add(&bar[XB_XGEN(b.x)], 1u);
            asm volatile("s_waitcnt vmcnt(0)" ::: "memory");
        } else {
            XB_SPIN(xb_ld(&bar[XB_XGEN(b.x)]) == gen, bar);
            __builtin_amdgcn_fence(__ATOMIC_ACQUIRE, "agent");
            asm volatile("s_waitcnt vmcnt(0)" ::: "memory");
        }
    }
    __syncthreads();
}
#undef LAS
using pg8::bf16x8; using pg8::f32x4; using pg8::u32x4; using pg8::f32x2;
#define GAS __attribute__((address_space(1)))
#define LAS __attribute__((address_space(3)))
typedef unsigned short bf16;
typedef unsigned v4u __attribute__((ext_vector_type(4)));
typedef unsigned v2u __attribute__((ext_vector_type(2)));
typedef float f32x2v __attribute__((ext_vector_type(2)));

constexpr int NTOK = 40960, DM = 2048, NLAYER = 4, INW = 5120;
constexpr int COL_UA = 0, COL_UB = 512, COL_Q = 1024, COL_K = 2048, COL_V = 3072, COL_G = 4096;
constexpr float ALPHA = 1.6817928305074290f;
constexpr float LN_EPS = 1e-5f, GN_EPS = 1e-6f;
constexpr int NEXP = 16384;
constexpr int NWAVES = 8, NTHR = 512;

constexpr size_t MiB = 1u << 20;
constexpr size_t WS_CTL = 0, CTL_ZERO_BYTES = 1 * MiB;
constexpr size_t WS_WIN = 1 * MiB;
constexpr size_t WS_WOUT = 81 * MiB;
constexpr size_t WS_WS = 113 * MiB;
constexpr size_t WS_WGLU = 145 * MiB;
constexpr size_t WS_S5A = 149 * MiB;
constexpr size_t WS_S5B = 150 * MiB;
constexpr size_t WS_S5BB = 153 * MiB;
constexpr size_t WS_U8 = 160 * MiB;
constexpr size_t WS_V8 = 288 * MiB;
constexpr size_t WS_USC = 416 * MiB;
constexpr size_t WS_VSC = 417 * MiB;
constexpr size_t WS_ROTC = 420 * MiB;
constexpr size_t WS_ROTS = 424 * MiB;
constexpr size_t WS_XN = 672 * MiB;
constexpr size_t WS_H = 832 * MiB;
constexpr size_t WS_CONCAT = 1232 * MiB;
constexpr size_t WS_BUFY = 1392 * MiB;
constexpr size_t WS_STF = 1472 * MiB;
constexpr size_t WS_STB = 1632 * MiB;
constexpr size_t WS_IDX = 1792 * MiB;
constexpr size_t WS_GATE = 1812 * MiB;
constexpr size_t WS_S5ST = 1832 * MiB;
constexpr size_t WS_END = 1852 * MiB;
constexpr int CW_BAR = 4096;
constexpr int NPHASE = 1 + NLAYER * 10;

constexpr int LDS_SCRATCH = 147456;
constexpr int LDS_MISC = LDS_SCRATCH;
constexpr int LDS_BYTES = LDS_SCRATCH + 256;

__device__ __forceinline__ float bf_lo(unsigned w) { return __uint_as_float(w << 16); }
__device__ __forceinline__ float bf_hi(unsigned w) { return __uint_as_float(w & 0xffff0000u); }
typedef __bf16 bf16x2_t __attribute__((ext_vector_type(2)));
__device__ __forceinline__ unsigned pkbf(float lo, float hi) { const bf16x2_t v = {(__bf16)lo, (__bf16)hi}; return __builtin_bit_cast(unsigned, v); }
__device__ __forceinline__ bf16 f2bf(float f) { return __builtin_bit_cast(unsigned short, (__bf16)f); }
__device__ __forceinline__ float wave_sum(float v) {
#pragma unroll
    for (int o = 1; o < 64; o <<= 1) v += __shfl_xor(v, o);
    return v;
}
__device__ __forceinline__ float gelu_erf(float v) {
    const float z = fabsf(v) * 0.70710678118654752f;
    const float t = __builtin_amdgcn_rcpf(1.0f + 0.3275911f * z);
    const float poly = t * (0.254829592f + t * (-0.284496736f + t * (1.421413741f + t * (-1.453152027f + t * 1.061405429f))));
    const float ec = poly * __expf(-z * z);
    return 0.5f * v * (v < 0.f ? ec : 2.0f - ec);
}
__device__ __forceinline__ int tok_pos(int t) { return t < 32768 ? (t & 4095) : (t - 32768); }
__device__ __forceinline__ int tok_len(int t) { return t < 32768 ? 4096 : 8192; }
__device__ __forceinline__ void unpack8(const v4u q, float (&f)[8]) {
    f[0] = bf_lo(q.x); f[1] = bf_hi(q.x); f[2] = bf_lo(q.y); f[3] = bf_hi(q.y); f[4] = bf_lo(q.z); f[5] = bf_hi(q.z); f[6] = bf_lo(q.w); f[7] = bf_hi(q.w);
}
__device__ __forceinline__ v4u pack8(const float (&f)[8]) { v4u q; q.x = pkbf(f[0], f[1]); q.y = pkbf(f[2], f[3]); q.z = pkbf(f[4], f[5]); q.w = pkbf(f[6], f[7]); return q; }
#define LDS_WAIT() asm volatile("s_waitcnt lgkmcnt(0)" ::: "memory")
#define MFMA16(a, b, c) __builtin_amdgcn_mfma_f32_16x16x32_bf16((a), (b), (c), 0, 0, 0)

struct EpiStoreBf16 {
    static constexpr bool PERM = true, AFTER_DRAIN = false;
    bf16* O; int ldo;
    __device__ __forceinline__ void operator()(const f32x4 (&acc)[2][2][4][2], const pg8::Unit& u, int wr, int wc, int fr, int fq) const {
        const int row0 = u.pm * 256 + wr * 64 + fr, col0 = u.pn * 256 + wc * 32 + 8 * fq;
#pragma unroll
        for (int ai = 0; ai < 2; ++ai)
#pragma unroll
            for (int m = 0; m < 4; ++m) { bf16* rowp = O + (size_t)(row0 + ai * 128 + m * 16) * ldo + col0;
#pragma unroll
                for (int bj = 0; bj < 2; ++bj) { const f32x4 v0 = acc[ai][bj][m][0], v1 = acc[ai][bj][m][1];
                    v4u w; w.x = pkbf(v0[0], v0[1]); w.y = pkbf(v0[2], v0[3]); w.z = pkbf(v1[0], v1[1]); w.w = pkbf(v1[2], v1[3]);
                    *(v4u*)(rowp + bj * 128) = w; } }
    }
};
struct EpiStoreRot {
    static constexpr bool PERM = true, AFTER_DRAIN = false;
    bf16* O; int ldo; const float* rc; const float* rs;
    __device__ __forceinline__ void operator()(const f32x4 (&acc)[2][2][4][2], const pg8::Unit& u, int wr, int wc, int fr, int fq) const {
        const int row0 = u.pm * 256 + wr * 64 + fr, col0 = u.pn * 256 + wc * 32 + 8 * fq;
        const bool rot = u.pn >= 4 && u.pn < 12; const float sc = u.pn >= 8 ? 0.0625f : 1.0f;
#pragma unroll
        for (int ai = 0; ai < 2; ++ai)
#pragma unroll
            for (int m = 0; m < 4; ++m) { const int row = row0 + ai * 128 + m * 16; bf16* rowp = O + (size_t)row * ldo + col0;
                f32x4 a0 = acc[ai][0][m][0], a1 = acc[ai][0][m][1], b0 = acc[ai][1][m][0], b1 = acc[ai][1][m][1];
                if (rot) { const int pos = row < 32768 ? (row & 4095) : (row - 32768); const size_t to = (size_t)pos * 128 + wc * 32 + 8 * fq;
                    const f32x4 c0 = *(const f32x4*)(rc + to), c1 = *(const f32x4*)(rc + to + 4), s0 = *(const f32x4*)(rs + to), s1 = *(const f32x4*)(rs + to + 4);
                    const f32x4 x0 = a0, x1 = a1, y0 = b0, y1 = b1;
                    a0 = (x0 * c0 - y0 * s0) * sc; a1 = (x1 * c1 - y1 * s1) * sc; b0 = (y0 * c0 + x0 * s0) * sc; b1 = (y1 * c1 + x1 * s1) * sc; }
                v4u w; w.x = pkbf(a0[0], a0[1]); w.y = pkbf(a0[2], a0[3]); w.z = pkbf(a1[0], a1[1]); w.w = pkbf(a1[2], a1[3]); *(v4u*)rowp = w;
                v4u x; x.x = pkbf(b0[0], b0[1]); x.y = pkbf(b0[2], b0[3]); x.z = pkbf(b1[0], b1[1]); x.w = pkbf(b1[2], b1[3]); *(v4u*)(rowp + 128) = x; }
    }
};
struct EpiGlu {
    static constexpr bool PERM = true, AFTER_DRAIN = false;
    const bf16* Y; int ldy; bf16* O; int ldo; const float* bias;
    __device__ __forceinline__ void operator()(const f32x4 (&acc)[2][2][4][2], const pg8::Unit& u, int wr, int wc, int fr, int fq) const {
        const int row0 = u.pm * 256 + wr * 64 + fr, col0 = u.pn * 256 + wc * 32 + 8 * fq;
#pragma unroll
        for (int bj = 0; bj < 2; ++bj) {
            const f32x4 b0 = *(const f32x4*)(bias + col0 + bj * 128), b1 = *(const f32x4*)(bias + col0 + bj * 128 + 4);
#pragma unroll
            for (int ai = 0; ai < 2; ++ai)
#pragma unroll
                for (int m = 0; m < 4; ++m) { const size_t r = (size_t)(row0 + ai * 128 + m * 16);
                    const v4u yq = *(const v4u*)(Y + r * ldy + col0 + bj * 128); float y[8]; unpack8(yq, y);
                    const f32x4 v0 = acc[ai][bj][m][0] + b0, v1 = acc[ai][bj][m][1] + b1; float o[8];
#pragma unroll
                    for (int k = 0; k < 4; ++k) { o[k] = y[k] * __builtin_amdgcn_rcpf(1.0f + __expf(-v0[k])); o[4 + k] = y[4 + k] * __builtin_amdgcn_rcpf(1.0f + __expf(-v1[k])); }
                    *(v4u*)(O + r * ldo + col0 + bj * 128) = pack8(o); }
        }
    }
};
struct EpiStoreF16 {
    static constexpr bool PERM = true, AFTER_DRAIN = false;
    _Float16* C; int ldc;
    __device__ __forceinline__ void operator()(const f32x4 (&acc)[2][2][4][2], const pg8::Unit& u, int wr, int wc, int fr, int fq) const {
        typedef _Float16 h8 __attribute__((ext_vector_type(8)));
        const int row0 = u.pm * 256 + wr * 64 + fr, col0 = u.pn * 256 + wc * 32 + 8 * fq;
#pragma unroll
        for (int ai = 0; ai < 2; ++ai)
#pragma unroll
            for (int m = 0; m < 4; ++m) { _Float16* rowp = C + (size_t)(row0 + ai * 128 + m * 16) * ldc + col0;
#pragma unroll
                for (int bj = 0; bj < 2; ++bj) { const f32x4 v0 = acc[ai][bj][m][0], v1 = acc[ai][bj][m][1];
                    h8 w; w[0] = (_Float16)v0[0]; w[1] = (_Float16)v0[1]; w[2] = (_Float16)v0[2]; w[3] = (_Float16)v0[3]; w[4] = (_Float16)v1[0]; w[5] = (_Float16)v1[1]; w[6] = (_Float16)v1[2]; w[7] = (_Float16)v1[3];
                    *(h8*)(rowp + bj * 128) = w; } }
    }
};
struct Args { const float* in[26]; float* out; unsigned char* ws; int ph_lo, ph_hi, li, pad; };
struct ArgsDev { const float GAS* in[26]; float GAS* out; unsigned char GAS* ws; int ph_lo, ph_hi, li, pad; };
typedef const ArgsDev __attribute__((address_space(4))) CArgs;
#define GIN(A_, k_) ((const float*)(A_).in[k_])
struct Frame {
    LAS unsigned char* lds;
    int tid, lane, wave, G, bx;
    int gw, NGW;
    size_t gtid, NT;
    float* out; unsigned char* ws;
};
enum InIdx { I_XP = 0, I_XS, I_LNIN_G, I_LNIN_B, I_WIN, I_LAMRE, I_LAMIM, I_LOGSTEP, I_BRE, I_BIM, I_CRE, I_CIM, I_S5D, I_WGLU, I_BGLU, I_POOLW, I_POOLS,
             I_WOUT, I_LN1G, I_LN1B, I_WQ, I_KEYS, I_PU, I_PV, I_LN2G, I_LN2B };

__device__ __forceinline__ void ln_rows2(bf16* XB, const bf16* MIX, float alpha, const float* g, const float* b, int gw, int ngw, int lane) {
    for (int t = gw; t < NTOK; t += 2 * ngw) {
        const int t2 = t + ngw; const bool has2 = t2 < NTOK; const int tb = has2 ? t2 : t;
        f32x4 v0[8], v1[8]; v2u x0q[8], x1q[8], m0q[8], m1q[8]; float s0 = 0.f, s1 = 0.f;
#pragma unroll
        for (int j = 0; j < 8; ++j) { x0q[j] = ((const v2u*)(XB + (size_t)t * DM))[lane + 64 * j]; m0q[j] = ((const v2u*)(MIX + (size_t)t * DM))[lane + 64 * j]; }
#pragma unroll
        for (int j = 0; j < 8; ++j) { x1q[j] = ((const v2u*)(XB + (size_t)tb * DM))[lane + 64 * j]; m1q[j] = ((const v2u*)(MIX + (size_t)tb * DM))[lane + 64 * j]; }
#pragma unroll
        for (int j = 0; j < 8; ++j) {
            v0[j] = (f32x4){bf_lo(x0q[j].x), bf_hi(x0q[j].x), bf_lo(x0q[j].y), bf_hi(x0q[j].y)} * alpha + (f32x4){bf_lo(m0q[j].x), bf_hi(m0q[j].x), bf_lo(m0q[j].y), bf_hi(m0q[j].y)};
            v1[j] = (f32x4){bf_lo(x1q[j].x), bf_hi(x1q[j].x), bf_lo(x1q[j].y), bf_hi(x1q[j].y)} * alpha + (f32x4){bf_lo(m1q[j].x), bf_hi(m1q[j].x), bf_lo(m1q[j].y), bf_hi(m1q[j].y)};
            s0 += (v0[j][0] + v0[j][1]) + (v0[j][2] + v0[j][3]); s1 += (v1[j][0] + v1[j][1]) + (v1[j][2] + v1[j][3]); }
        const float m0 = wave_sum(s0) * (1.0f / DM), m1 = wave_sum(s1) * (1.0f / DM); float q0 = 0.f, q1 = 0.f;
#pragma unroll
        for (int j = 0; j < 8; ++j) { v0[j] = v0[j] - m0; v1[j] = v1[j] - m1;
            q0 += (v0[j][0] * v0[j][0] + v0[j][1] * v0[j][1]) + (v0[j][2] * v0[j][2] + v0[j][3] * v0[j][3]); q1 += (v1[j][0] * v1[j][0] + v1[j][1] * v1[j][1]) + (v1[j][2] * v1[j][2] + v1[j][3] * v1[j][3]); }
        f32x4 gq[8], bq[8];
#pragma unroll
        for (int j = 0; j < 8; ++j) { gq[j] = ((const f32x4*)g)[lane + 64 * j]; bq[j] = ((const f32x4*)b)[lane + 64 * j]; }
        const float rs0 = 1.0f / sqrtf(wave_sum(q0) * (1.0f / DM) + LN_EPS), rs1 = 1.0f / sqrtf(wave_sum(q1) * (1.0f / DM) + LN_EPS);
#pragma unroll
        for (int j = 0; j < 8; ++j) { const f32x4 gg = gq[j], bb = bq[j];
            const f32x4 o0 = v0[j] * rs0 * gg + bb;
            v2u w0; w0.x = pkbf(o0[0], o0[1]); w0.y = pkbf(o0[2], o0[3]); ((v2u*)(XB + (size_t)t * DM))[lane + 64 * j] = w0;
            if (has2) { const f32x4 o1 = v1[j] * rs1 * gg + bb;
                v2u w1; w1.x = pkbf(o1[0], o1[1]); w1.y = pkbf(o1[2], o1[3]); ((v2u*)(XB + (size_t)t2 * DM))[lane + 64 * j] = w1; } }
    }
}

__device__ __forceinline__ void transpose_item(const float* W, int K, int N, bf16* WT, LAS float* scr, int item, int lane) {
    const int nblk = N / 32, kb = item / nblk, nb = item % nblk, k0 = 64 * kb, n0 = 32 * nb;
    float wv[32];
#pragma unroll
    for (int i = 0; i < 32; ++i) { const int kk = 2 * i + (lane >> 5); wv[i] = W[(size_t)(k0 + kk) * N + n0 + (lane & 31)]; }
#pragma unroll
    for (int i = 0; i < 32; ++i) { const int kk = 2 * i + (lane >> 5); scr[kk * 33 + (lane & 31)] = wv[i]; }
    LDS_WAIT();
    const int c = lane & 7;
#pragma unroll
    for (int j = 0; j < 4; ++j) { const int n = (lane >> 3) + 8 * j; const LAS float* s = scr + (8 * c) * 33 + n;
        v4u o; o.x = pkbf(s[0 * 33], s[1 * 33]); o.y = pkbf(s[2 * 33], s[3 * 33]); o.z = pkbf(s[4 * 33], s[5 * 33]); o.w = pkbf(s[6 * 33], s[7 * 33]);
        *(v4u*)(WT + (size_t)(n0 + n) * K + k0 + 8 * c) = o; }
    LDS_WAIT();
}

__device__ __forceinline__ void p0_prologue(const Frame& F, CArgs& A) {
    {
        LAS float* scr = (LAS float*)(F.lds + F.wave * 16384);
        constexpr int I_IN = (DM / 64) * (INW / 32), I_OUT = (DM / 64) * (DM / 32), I_GLU = (512 / 64) * (512 / 32);
        constexpr int NITEMS = NLAYER * (I_IN + I_OUT + I_GLU);
        for (int it = F.gw; it < NITEMS; it += F.NGW) {
            int r = it;
            if (r < NLAYER * I_IN) { const int l = r / I_IN; { const int nb_ = (r % I_IN) % (INW / 32); if (nb_ >= 512 / 32 && nb_ < 1024 / 32) continue; }
                transpose_item(GIN(A, I_WIN) + (size_t)l * DM * INW, DM, INW, (bf16*)(F.ws + WS_WIN) + (size_t)l * INW * DM, scr, r % I_IN, F.lane); continue; }
            r -= NLAYER * I_IN;
            if (r < NLAYER * I_OUT) { const int l = r / I_OUT; transpose_item(GIN(A, I_WOUT) + (size_t)l * DM * DM, DM, DM, (bf16*)(F.ws + WS_WOUT) + (size_t)l * DM * DM, scr, r % I_OUT, F.lane); continue; }
            r -= NLAYER * I_OUT;
            { const int l = r / I_GLU; transpose_item(GIN(A, I_WGLU) + (size_t)l * 512 * 512, 512, 512, (bf16*)(F.ws + WS_WGLU) + (size_t)l * 512 * 512, scr, r % I_GLU, F.lane); }
        }
    }
    {
        const int NR2 = 2 * NLAYER * NEXP;
        for (int r = F.gw; r < NR2; r += 2 * F.NGW) {
            const int r2 = r + F.NGW < NR2 ? r + F.NGW : r;
            const int tabA = r >= NLAYER * NEXP, riA = tabA ? r - NLAYER * NEXP : r, tabB = r2 >= NLAYER * NEXP, riB = tabB ? r2 - NLAYER * NEXP : r2;
            const float* srcA = (tabA ? GIN(A, I_PV) : GIN(A, I_PU)) + (size_t)riA * DM + F.lane * 4; const float* srcB = (tabB ? GIN(A, I_PV) : GIN(A, I_PU)) + (size_t)riB * DM + F.lane * 4;
            f32x4 va[8], vb[8]; float ama = 0.f, amb = 0.f;
#pragma unroll
            for (int q = 0; q < 8; ++q) va[q] = *(const f32x4*)(srcA + q * 256);
#pragma unroll
            for (int q = 0; q < 8; ++q) vb[q] = *(const f32x4*)(srcB + q * 256);
#pragma unroll
            for (int q = 0; q < 8; ++q) { ama = fmaxf(ama, fmaxf(fmaxf(fabsf(va[q][0]), fabsf(va[q][1])), fmaxf(fabsf(va[q][2]), fabsf(va[q][3])))); amb = fmaxf(amb, fmaxf(fmaxf(fabsf(vb[q][0]), fabsf(vb[q][1])), fmaxf(fabsf(vb[q][2]), fabsf(vb[q][3])))); }
#pragma unroll
            for (int o = 1; o < 64; o <<= 1) { ama = fmaxf(ama, __shfl_xor(ama, o)); amb = fmaxf(amb, __shfl_xor(amb, o)); }
#pragma unroll
            for (int half = 0; half < 2; ++half) {
                if (half == 1 && r2 == r) break;
                const float am = half ? amb : ama; const int tab = half ? tabB : tabA, ri = half ? riB : riA;
                const float sc = am > 0.f ? 6.0f / am : 1.0f, isc = am > 0.f ? am * (1.0f / 6.0f) : 1.0f;
                v4u w;
#pragma unroll
                for (int q = 0; q < 4; ++q) { const f32x4 e0 = half ? vb[2 * q] : va[2 * q], e1 = half ? vb[2 * q + 1] : va[2 * q + 1]; unsigned pk = 0u;
                    pk = __builtin_amdgcn_cvt_scalef32_pk_fp4_f32(pk, e0[0] * sc, e0[1] * sc, 1.0f, 0); pk = __builtin_amdgcn_cvt_scalef32_pk_fp4_f32(pk, e0[2] * sc, e0[3] * sc, 1.0f, 1);
                    pk = __builtin_amdgcn_cvt_scalef32_pk_fp4_f32(pk, e1[0] * sc, e1[1] * sc, 1.0f, 2); pk = __builtin_amdgcn_cvt_scalef32_pk_fp4_f32(pk, e1[2] * sc, e1[3] * sc, 1.0f, 3);
                    w[q] = pk; }
                *(v4u*)(F.ws + (tab ? WS_V8 : WS_U8) + (size_t)ri * (DM / 2) + F.lane * 16) = w;
                if (F.lane == 0) ((float*)(F.ws + (tab ? WS_VSC : WS_USC)))[ri] = isc;
            }
        }
    }
    {
        const float* win = GIN(A, I_WIN); const float* pw = GIN(A, I_POOLW); const float* ps = GIN(A, I_POOLS); bf16* wt = (bf16*)(F.ws + WS_WIN);
        for (size_t it = F.gtid; it < (size_t)NLAYER * 512 * 256; it += F.NT) {
            const int n = (int)(it & 511), k8 = (int)((it >> 9) & 255), l = (int)(it >> 17), g = n >> 7, d = n & 127;
            float acc[8];
#pragma unroll
            for (int kk = 0; kk < 8; ++kk) acc[kk] = 0.f;
            const float* wrow = win + ((size_t)l * DM + k8 * 8) * INW + 512 + g * 128; const float* pcol = pw + ((size_t)(l * 4 + g) * 128) * 128 + d;
            for (int c4 = 0; c4 < 32; ++c4) {
                f32x4 wv[8];
#pragma unroll
                for (int kk = 0; kk < 8; ++kk) wv[kk] = *(const f32x4*)(wrow + (size_t)kk * INW + c4 * 4);
#pragma unroll
                for (int e = 0; e < 4; ++e) { const float pv = pcol[(size_t)(c4 * 4 + e) * 128];
#pragma unroll
                    for (int kk = 0; kk < 8; ++kk) acc[kk] += wv[kk][e] * pv; }
            }
            const float sc = ps[l * 512 + n];
#pragma unroll
            for (int kk = 0; kk < 8; ++kk) acc[kk] *= sc;
            *(v4u*)(wt + ((size_t)l * INW + 512 + n) * DM + k8 * 8) = pack8(acc);
        }
    }
    {
        const float* lre = GIN(A, I_LAMRE); const float* lim = GIN(A, I_LAMIM); const float* lst = GIN(A, I_LOGSTEP); const float* bre = GIN(A, I_BRE); const float* bim = GIN(A, I_BIM);
        f32x2v* ab = (f32x2v*)(F.ws + WS_S5A); f32x2v* ab64 = (f32x2v*)(F.ws + WS_S5A + 512 * 1024); f32x2v* bb = (f32x2v*)(F.ws + WS_S5B);
        for (size_t i = F.gtid; i < (size_t)NLAYER * 2 * 32 * 64; i += F.NT) {
            const float lr = lre[i], li = lim[i], dt = expf(lst[i >> 6]);
            const float mag = expf(lr * dt), ar = mag * cosf(li * dt), ai = mag * sinf(li * dt);
            const float den = lr * lr + li * li;
            const float zr = ((ar - 1.0f) * lr + ai * li) / den, zi = (ai * lr - (ar - 1.0f) * li) / den;
            ab[i] = (f32x2v){ar, ai};
            const float m64 = expf(lr * dt * 64.0f), an = li * dt * 64.0f;
            ab64[i] = (f32x2v){m64 * cosf(an), m64 * sinf(an)};
#pragma unroll
            for (int c = 0; c < 16; ++c) { const float br = bre[i * 16 + c], bi = bim[i * 16 + c]; bb[i * 16 + c] = (f32x2v){zr * br - zi * bi, zr * bi + zi * br}; }
            {
                bf16* o = (bf16*)(F.ws + WS_S5BB) + ((size_t)(i >> 6) * 128 + 2 * (i & 63)) * 32;
#pragma unroll
                for (int c = 0; c < 16; ++c) { const float br = bre[i * 16 + c], bi = bim[i * 16 + c]; o[c] = f2bf(zr * br - zi * bi); o[32 + c] = f2bf(zr * bi + zi * br); o[16 + c] = 0; o[48 + c] = 0; }
            }
        }
    }
    {
        float* rc = (float*)(F.ws + WS_ROTC); float* rs = (float*)(F.ws + WS_ROTS);
        for (size_t i = F.gtid; i < (size_t)8192 * 128; i += F.NT) { const float inv = (float)exp(-(double)(i & 127) / 127.0 * 9.210340371976184); const float ang = (float)(i >> 7) * inv; rc[i] = cosf(ang); rs[i] = sinf(ang); }
    }
    __syncthreads();
    {
        LAS float* KS = (LAS float*)F.lds;
        LAS float* WQ = (LAS float*)(F.lds + 128 * 132 * 4);
        const float* keys = GIN(A, I_KEYS); const float* wq = GIN(A, I_WQ); bf16* wst = (bf16*)(F.ws + WS_WS);
        for (int u = F.bx; u < NLAYER * 16 * 32; u += F.G) {
            const int dtl = u & 31, hp = (u >> 5) & 15, l = u >> 9, p = hp & 1;
#pragma unroll
            for (int r = 0; r < 8; ++r) { const int f = F.tid + 512 * r, nk = f >> 5, c4 = f & 31;
                *(LAS f32x4*)(KS + nk * 132 + c4 * 4) = *(const f32x4*)(keys + (((size_t)l * 2 + p) * 128 + nk) * 128 + c4 * 4); }
#pragma unroll
            for (int r = 0; r < 4; ++r) { const int f = F.tid + 512 * r, dd = f >> 5, c4 = f & 31;
                *(LAS f32x4*)(WQ + dd * 132 + c4 * 4) = *(const f32x4*)(wq + ((size_t)l * DM + dtl * 64 + dd) * DM + hp * 128 + c4 * 4); }
            __syncthreads();
            const int nt = F.wave, lr = F.lane & 15, lq = F.lane >> 4;
            f32x4 acc[4];
#pragma unroll
            for (int dt = 0; dt < 4; ++dt) acc[dt] = (f32x4){0.f, 0.f, 0.f, 0.f};
#pragma unroll 4
            for (int ks = 0; ks < 32; ++ks) {
                const float kb = KS[(nt * 16 + lr) * 132 + 4 * ks + lq];
#pragma unroll
                for (int dt = 0; dt < 4; ++dt) { const float wa = WQ[(dt * 16 + lr) * 132 + 4 * ks + lq]; acc[dt] = __builtin_amdgcn_mfma_f32_16x16x4f32(wa, kb, acc[dt], 0, 0, 0); }
            }
            bf16* o = wst + ((size_t)l * DM + hp * 128 + nt * 16 + lr) * DM + dtl * 64 + 4 * lq;
#pragma unroll
            for (int dt = 0; dt < 4; ++dt) { v2u w; w.x = pkbf(acc[dt][0], acc[dt][1]); w.y = pkbf(acc[dt][2], acc[dt][3]); *(v2u*)(o + dt * 16) = w; }
            __syncthreads();
        }
    }
    {
        const float* xp = GIN(A, I_XP); const float* xs = GIN(A, I_XS); const float* g = GIN(A, I_LNIN_G); const float* b = GIN(A, I_LNIN_B); bf16* XB = (bf16*)(F.ws + WS_XN);
        for (int t = F.gw; t < NTOK; t += 2 * F.NGW) {
            const int t2 = t + F.NGW; const bool has2 = t2 < NTOK; const int tb = has2 ? t2 : t;
            const float* s0p = t < 32768 ? xp + (size_t)t * DM : xs + (size_t)(t - 32768) * DM; const float* s1p = tb < 32768 ? xp + (size_t)tb * DM : xs + (size_t)(tb - 32768) * DM;
            f32x4 v0[8], v1[8]; float s0 = 0.f, s1 = 0.f;
#pragma unroll
            for (int j = 0; j < 8; ++j) v0[j] = ((const f32x4*)s0p)[F.lane + 64 * j];
#pragma unroll
            for (int j = 0; j < 8; ++j) v1[j] = ((const f32x4*)s1p)[F.lane + 64 * j];
#pragma unroll
            for (int j = 0; j < 8; ++j) { s0 += (v0[j][0] + v0[j][1]) + (v0[j][2] + v0[j][3]); s1 += (v1[j][0] + v1[j][1]) + (v1[j][2] + v1[j][3]); }
            const float m0 = wave_sum(s0) * (1.0f / DM), m1 = wave_sum(s1) * (1.0f / DM); float q0 = 0.f, q1 = 0.f;
#pragma unroll
            for (int j = 0; j < 8; ++j) { v0[j] = v0[j] - m0; v1[j] = v1[j] - m1;
                q0 += (v0[j][0] * v0[j][0] + v0[j][1] * v0[j][1]) + (v0[j][2] * v0[j][2] + v0[j][3] * v0[j][3]); q1 += (v1[j][0] * v1[j][0] + v1[j][1] * v1[j][1]) + (v1[j][2] * v1[j][2] + v1[j][3] * v1[j][3]); }
            const float rs0 = 1.0f / sqrtf(wave_sum(q0) * (1.0f / DM) + LN_EPS), rs1 = 1.0f / sqrtf(wave_sum(q1) * (1.0f / DM) + LN_EPS);
#pragma unroll
            for (int j = 0; j < 8; ++j) { const f32x4 gg = ((const f32x4*)g)[F.lane + 64 * j], bb = ((const f32x4*)b)[F.lane + 64 * j];
                const f32x4 o0 = v0[j] * rs0 * gg + bb;
                v2u w0; w0.x = pkbf(o0[0], o0[1]); w0.y = pkbf(o0[2], o0[3]); ((v2u*)(XB + (size_t)t * DM))[F.lane + 64 * j] = w0;
                if (has2) { const f32x4 o1 = v1[j] * rs1 * gg + bb;
                    v2u w1; w1.x = pkbf(o1[0], o1[1]); w1.y = pkbf(o1[2], o1[3]); ((v2u*)(XB + (size_t)t2 * DM))[F.lane + 64 * j] = w1; } }
        }
    }
}

__device__ __forceinline__ float ret_log2_gamma(int h) { return log2f(1.0f - exp2f(-5.0f - (float)h)); }

__device__ __forceinline__ void s5_pass1(const Frame& F, CArgs& A, int l) {
    LAS float* BUs = (LAS float*)(F.lds + F.wave * 8448);
    const bf16* H = (const bf16*)(F.ws + WS_H);
    const f32x2v* ab = (const f32x2v*)(F.ws + WS_S5A); const bf16* BB = (const bf16*)(F.ws + WS_S5BB);
    f32x2v* st = (f32x2v*)(F.ws + WS_S5ST);
    const int lane = F.lane, lr = lane & 15, lq = lane >> 4;
    const int gstep = F.G < 32 ? F.G : 32;
    for (int g = F.bx % 32; g < 32; g += gstep) {
        const int nwg = F.G < 32 ? 1 : (F.G - g + 31) / 32, rank = F.G < 32 ? 0 : F.bx / 32;
        bf16x8 Bop[2][8]; f32x2v a2[2], arot[2];
#pragma unroll
        for (int dir = 0; dir < 2; ++dir) { const int gi = (l * 2 + dir) * 32 + g; a2[dir] = ab[gi * 64 + lane]; arot[dir] = (f32x2v){-a2[dir][1], a2[dir][1]};
#pragma unroll
            for (int j = 0; j < 8; ++j) Bop[dir][j] = *(const bf16x8*)(BB + ((size_t)gi * 128 + 16 * j + lr) * 32 + lq * 8); }
        for (int ck = rank * NWAVES + F.wave; ck < 640; ck += nwg * NWAVES) {
            bf16x8 uop[4];
#pragma unroll
            for (int tb = 0; tb < 4; ++tb) { const v4u q = lq < 2 ? *(const v4u*)(H + (size_t)(ck * 64 + 16 * tb + lr) * INW + COL_UA + g * 16 + lq * 8) : (v4u){0u, 0u, 0u, 0u}; uop[tb] = __builtin_bit_cast(bf16x8, q); }
#pragma unroll
            for (int dir = 0; dir < 2; ++dir) {
                f32x2v x2 = (f32x2v){0.f, 0.f};
#pragma unroll
                for (int blk = 0; blk < 4; ++blk) {
                    const int tb = dir ? 3 - blk : blk;
#pragma unroll
                    for (int j = 0; j < 8; ++j) { const f32x4 d = MFMA16(Bop[dir][j], uop[tb], ((f32x4){0.f, 0.f, 0.f, 0.f}));
                        *(LAS f32x4*)(BUs + lr * 132 + 16 * j + 4 * lq) = d; }
                    LDS_WAIT();
#pragma unroll
                    for (int s = 0; s < 16; ++s) { const int tl = dir ? 15 - s : s;
                        const f32x2v bu = *(const LAS f32x2v*)(BUs + tl * 132 + 2 * lane);
                        x2 = x2 * a2[dir][0] + (arot[dir] * (f32x2v){x2[1], x2[0]} + bu); }
                    LDS_WAIT();
                }
                st[(size_t)((ck * 32 + g) * 2 + dir) * 64 + lane] = x2;
            }
        }
    }
}
__device__ __forceinline__ void s5_carry(const Frame& F, CArgs& A, int l) {
    const f32x2v* ab64 = (const f32x2v*)(F.ws + WS_S5A + 512 * 1024); f32x2v* st = (f32x2v*)(F.ws + WS_S5ST);
    for (size_t it = F.gtid; it < (size_t)9 * 32 * 2 * 64; it += F.NT) {
        const int p = (int)(it & 63), dir = (int)((it >> 6) & 1), g = (int)((it >> 7) & 31), s = (int)(it >> 12);
        const int ck0 = s < 8 ? s * 64 : 512, n = s < 8 ? 64 : 128;
        const f32x2v a = ab64[((l * 2 + dir) * 32 + g) * 64 + p];
        float cr = 0.f, ci = 0.f;
        for (int k0 = 0; k0 < n; k0 += 8) {
            f32x2v le[8];
#pragma unroll
            for (int kk = 0; kk < 8; ++kk) { const int ck = dir ? (ck0 + n - 1 - (k0 + kk)) : (ck0 + k0 + kk); le[kk] = st[(size_t)((ck * 32 + g) * 2 + dir) * 64 + p]; }
#pragma unroll
            for (int kk = 0; kk < 8; ++kk) { const int ck = dir ? (ck0 + n - 1 - (k0 + kk)) : (ck0 + k0 + kk);
                st[(size_t)((ck * 32 + g) * 2 + dir) * 64 + p] = (f32x2v){cr, ci};
                const float ncr = a[0] * cr - a[1] * ci + le[kk][0], nci = a[0] * ci + a[1] * cr + le[kk][1]; cr = ncr; ci = nci; }
        }
    }
}
__device__ __forceinline__ void s5_pass3(const Frame& F, CArgs& A, int l) {
    LAS bf16* CtS = (LAS bf16*)F.lds;
    LAS unsigned char* wb = F.lds + 8704 + F.wave * 12800;
    LAS float* BUs = (LAS float*)wb;
    LAS bf16* Xw = (LAS bf16*)(wb + 8448);
    const bf16* H = (const bf16*)(F.ws + WS_H); bf16* BY = (bf16*)(F.ws + WS_BUFY);
    const f32x2v* ab = (const f32x2v*)(F.ws + WS_S5A); const bf16* BB = (const bf16*)(F.ws + WS_S5BB);
    const f32x2v* st = (const f32x2v*)(F.ws + WS_S5ST);
    const float* cre = GIN(A, I_CRE); const float* cim = GIN(A, I_CIM); const float* dvec = GIN(A, I_S5D) + (size_t)l * 512;
    const int lane = F.lane, lr = lane & 15, lq = lane >> 4;
    const int gstep = F.G < 32 ? F.G : 32;
    for (int g = F.bx % 32; g < 32; g += gstep) {
        const int nwg = F.G < 32 ? 1 : (F.G - g + 31) / 32, rank = F.G < 32 ? 0 : F.bx / 32;
        __syncthreads();
        {
            const int tq = opaque(F.tid);
#pragma unroll
            for (int r = 0; r < 8; ++r) { const int e = tq + 512 * r, pp = e & 127, c = (e >> 7) & 15, dir = e >> 11;
                const size_t cb = (size_t)(((l * 2 + dir) * 32 + g) * 16 + c) * 64;
                CtS[(dir * 16 + c) * 136 + pp] = f2bf((pp & 1) ? -cim[cb + (pp >> 1)] : cre[cb + (pp >> 1)]); }
        }
        bf16x8 Bop[2][8]; f32x2v a2[2], arot[2];
#pragma unroll
        for (int dir = 0; dir < 2; ++dir) { const int gi = (l * 2 + dir) * 32 + g; a2[dir] = ab[gi * 64 + lane]; arot[dir] = (f32x2v){-a2[dir][1], a2[dir][1]};
#pragma unroll
            for (int j = 0; j < 8; ++j) Bop[dir][j] = *(const bf16x8*)(BB + ((size_t)gi * 128 + 16 * j + lr) * 32 + lq * 8); }
        __syncthreads();
        for (int ck = rank * NWAVES + F.wave; ck < 640; ck += nwg * NWAVES) {
            bf16x8 uop[4];
#pragma unroll
            for (int tb = 0; tb < 4; ++tb) { const v4u q = lq < 2 ? *(const v4u*)(H + (size_t)(ck * 64 + 16 * tb + lr) * INW + COL_UA + g * 16 + lq * 8) : (v4u){0u, 0u, 0u, 0u}; uop[tb] = __builtin_bit_cast(bf16x8, q); }
            f32x2v xin[2];
#pragma unroll
            for (int dir = 0; dir < 2; ++dir) xin[dir] = st[(size_t)((ck * 32 + g) * 2 + dir) * 64 + lane];
            const f32x4 dv4 = *(const f32x4*)(dvec + g * 16 + 4 * lq);
            v2u uq4[4];
#pragma unroll
            for (int m = 0; m < 4; ++m) uq4[m] = *(const v2u*)(H + (size_t)(ck * 64 + 16 * m + lr) * INW + COL_UA + g * 16 + 4 * lq);
            f32x4 Y[4];
#pragma unroll
            for (int m = 0; m < 4; ++m) Y[m] = (f32x4){0.f, 0.f, 0.f, 0.f};
#pragma unroll
            for (int dir = 0; dir < 2; ++dir) {
                f32x2v x2 = xin[dir];
#pragma unroll
                for (int blk = 0; blk < 4; ++blk) {
                    const int tb = dir ? 3 - blk : blk;
#pragma unroll
                    for (int j = 0; j < 8; ++j) { const f32x4 d = MFMA16(Bop[dir][j], uop[tb], ((f32x4){0.f, 0.f, 0.f, 0.f}));
                        *(LAS f32x4*)(BUs + lr * 132 + 16 * j + 4 * lq) = d; }
                    LDS_WAIT();
#pragma unroll
                    for (int s = 0; s < 16; ++s) { const int tl = dir ? 15 - s : s;
                        const f32x2v bu = *(const LAS f32x2v*)(BUs + tl * 132 + 2 * lane);
                        x2 = x2 * a2[dir][0] + (arot[dir] * (f32x2v){x2[1], x2[0]} + bu);
                        *(LAS unsigned*)(Xw + tl * 136 + 2 * lane) = pkbf(x2[0], x2[1]); }
                    LDS_WAIT();
#pragma unroll
                    for (int ks = 0; ks < 4; ++ks) {
                        const bf16x8 av = *(const LAS bf16x8*)(CtS + (dir * 16 + lr) * 136 + 32 * ks + lq * 8);
                        const bf16x8 bv = *(const LAS bf16x8*)(Xw + lr * 136 + 32 * ks + lq * 8);
                        Y[tb] = MFMA16(av, bv, Y[tb]);
                    }
                    LDS_WAIT();
                }
            }
#pragma unroll
            for (int m = 0; m < 4; ++m) {
                const int t = 16 * m + lr, c0 = 4 * lq;
                const v2u uq = uq4[m];
                const f32x4 uv = (f32x4){bf_lo(uq.x), bf_hi(uq.x), bf_lo(uq.y), bf_hi(uq.y)}; const f32x4 dv = dv4;
                const f32x4 y = Y[m] + dv * uv;
                v2u w; w.x = pkbf(gelu_erf(y[0]), gelu_erf(y[1])); w.y = pkbf(gelu_erf(y[2]), gelu_erf(y[3]));
                *(v2u*)(BY + (size_t)(ck * 64 + t) * 512 + g * 16 + c0) = w;
            }
        }
    }
}
__device__ __forceinline__ void pool_phase(const Frame& F, CArgs& A) {
    const bf16* H = (const bf16*)(F.ws + WS_H); bf16* CCp = (bf16*)(F.ws + WS_CONCAT) + 512;
    for (size_t it = F.gtid; it < (size_t)(NTOK / 8) * 64; it += F.NT) {
        const int r = (int)(it >> 6), o = (int)(it & 63), gi = o >> 4, half = 1 << gi;
        const int t0 = r * 8, pos0 = tok_pos(t0), L = tok_len(t0);
        const bf16* base = H + (size_t)(t0 - pos0) * INW + COL_UB + o * 8;
        v4u wq[23];
#pragma unroll
        for (int sl = 0; sl < 23; ++sl) { const int q = pos0 - 8 + sl; const int qc = q < 0 ? 0 : (q > L - 1 ? L - 1 : q); wq[sl] = *(const v4u*)(base + (size_t)qc * INW); }
#pragma unroll
        for (int i = 0; i < 8; ++i) {
            const int pos = pos0 + i;
            const int lo = max(pos - half, 0), hi = min(pos + half - 1, L - 1);
            float s[8];
#pragma unroll
            for (int k = 0; k < 8; ++k) s[k] = 0.f;
#pragma unroll
            for (int k = 0; k < 16; ++k) { const int q = pos - 8 + k; float f[8]; unpack8(wq[i + k], f); const float wgt = (q >= lo && q <= hi) ? 1.0f : 0.0f;
#pragma unroll
                for (int c = 0; c < 8; ++c) s[c] += wgt * f[c]; }
            const float inv = 1.0f / (float)(hi - lo + 1);
            float c[8]; unpack8(wq[8 + i], c);
#pragma unroll
            for (int k = 0; k < 8; ++k) s[k] = s[k] * inv - c[k];
            *(v4u*)(CCp + (size_t)(t0 + i) * DM + o * 8) = pack8(s);
        }
    }
}
constexpr int RS = 136;
template <int MODE = 0> __device__ __forceinline__ void ret_state_phase(const Frame& F, CArgs& A, unsigned* ctr = nullptr) {
    const bf16* H = (const bf16*)(F.ws + WS_H); bf16* STF = (bf16*)(F.ws + WS_STF); bf16* STB = (bf16*)(F.ws + WS_STB);
    LAS bf16* Kt = (LAS bf16*)F.lds; LAS bf16* VtF = Kt + 128 * RS; LAS bf16* VtB = Kt + 256 * RS;
    LAS unsigned* Kt32 = (LAS unsigned*)Kt; LAS unsigned* VtF32 = (LAS unsigned*)VtF; LAS unsigned* VtB32 = (LAS unsigned*)VtB;
    const int tid = F.tid, lane = F.lane, lr = lane & 15, lq = lane >> 4, we = F.wave >> 1, wd = F.wave & 1;
    const int jp = tid & 63, j = 2 * jp, pc0 = tid >> 6;
    v4u pk0[2], pk1[2], pv0[2], pv1[2];
#define RS_LOAD(u_) do { const int dh_ = (u_) & 1, eh_ = ((u_) >> 1) & 1, h_ = ((u_) >> 2) & 3, c_ = (u_) >> 4; \
        const bf16* krow_ = H + (size_t)(c_ * 128 + j) * INW + COL_K + h_ * 256 + dh_ * 128; const bf16* vrow_ = H + (size_t)(c_ * 128 + j) * INW + COL_V + h_ * 256 + eh_ * 128; \
        _Pragma("unroll") for (int r = 0; r < 2; ++r) { const int pc = pc0 + 8 * r; pk0[r] = *(const v4u*)(krow_ + pc * 8); pk1[r] = *(const v4u*)(krow_ + INW + pc * 8); pv0[r] = *(const v4u*)(vrow_ + pc * 8); pv1[r] = *(const v4u*)(vrow_ + INW + pc * 8); } } while (0)
    if (F.bx < 5120) RS_LOAD(F.bx);
    volatile LAS int* NXT = (volatile LAS int*)(F.lds + LDS_MISC) + 16;
    int un = F.bx + F.G, pend = 0;
    if (ctr && tid == 0) pend = 2 * F.G + (int)__hip_atomic_fetch_add(ctr, 1u, __ATOMIC_RELAXED, __HIP_MEMORY_SCOPE_AGENT);
    for (int u = F.bx; u < 5120;) {
        const int dh = u & 1, eh = (u >> 1) & 1, h = (u >> 2) & 3, c = u >> 4;
        if (MODE != 2) {
            const float lg = ret_log2_gamma(h), fF0 = exp2f(lg * (float)(127 - j)), fF1 = exp2f(lg * (float)(126 - j)), fB0 = exp2f(lg * (float)j), fB1 = exp2f(lg * (float)(j + 1));
#pragma unroll
            for (int r = 0; r < 2; ++r) {
                const int pc = pc0 + 8 * r;
                const unsigned ka0[4] = {pk0[r].x, pk0[r].y, pk0[r].z, pk0[r].w}, ka1[4] = {pk1[r].x, pk1[r].y, pk1[r].z, pk1[r].w};
                float f0[8], f1[8]; unpack8(pv0[r], f0); unpack8(pv1[r], f1);
#pragma unroll
                for (int i = 0; i < 8; ++i) {
                    const unsigned a = ka0[i >> 1], b = ka1[i >> 1];
                    const unsigned kk = (i & 1) ? ((a >> 16) | (b & 0xffff0000u)) : ((a & 0xffffu) | (b << 16));
                    const int o = ((pc * 8 + i) * RS) / 2 + jp;
                    Kt32[o] = kk; VtF32[o] = pkbf(f0[i] * fF0, f1[i] * fF1); VtB32[o] = pkbf(f0[i] * fB0, f1[i] * fB1);
                }
            }
        }
        if (ctr && tid == 0) { NXT[0] = pend; pend = 2 * F.G + (int)__hip_atomic_fetch_add(ctr, 1u, __ATOMIC_RELAXED, __HIP_MEMORY_SCOPE_AGENT); }
        __syncthreads();
        const int unn = ctr ? NXT[0] : un + F.G;
        if (un < 5120) RS_LOAD(un);
        if (MODE == 1) { __syncthreads(); u = un; un = unn; continue; }
        f32x4 aF[4][2], aB[4][2];
#pragma unroll
        for (int td = 0; td < 4; ++td)
#pragma unroll
            for (int te = 0; te < 2; ++te) { aF[td][te] = (f32x4){0.f, 0.f, 0.f, 0.f}; aB[td][te] = (f32x4){0.f, 0.f, 0.f, 0.f}; }
#pragma unroll
        for (int ks = 0; ks < 4; ++ks) {
            bf16x8 ka[4], vF[2], vB[2];
#pragma unroll
            for (int td = 0; td < 4; ++td) ka[td] = *(const LAS bf16x8*)(Kt + (64 * wd + 16 * td + lr) * RS + 32 * ks + lq * 8);
#pragma unroll
            for (int te = 0; te < 2; ++te) { vF[te] = *(const LAS bf16x8*)(VtF + (32 * we + 16 * te + lr) * RS + 32 * ks + lq * 8); vB[te] = *(const LAS bf16x8*)(VtB + (32 * we + 16 * te + lr) * RS + 32 * ks + lq * 8); }
#pragma unroll
            for (int td = 0; td < 4; ++td)
#pragma unroll
                for (int te = 0; te < 2; ++te) { aF[td][te] = MFMA16(ka[td], vF[te], aF[td][te]); aB[td][te] = MFMA16(ka[td], vB[te], aB[td][te]); }
        }
        __syncthreads();
        {
            LAS bf16* OutF = Kt; LAS bf16* OutB = Kt + 128 * RS;
#pragma unroll
            for (int td = 0; td < 4; ++td)
#pragma unroll
                for (int te = 0; te < 2; ++te) {
                    const int e = 32 * we + 16 * te + lr, d = 64 * wd + 16 * td + 4 * lq;
                    v2u w; w.x = pkbf(aF[td][te][0], aF[td][te][1]); w.y = pkbf(aF[td][te][2], aF[td][te][3]); *(LAS v2u*)(OutF + e * RS + d) = w;
                    v2u x; x.x = pkbf(aB[td][te][0], aB[td][te][1]); x.y = pkbf(aB[td][te][2], aB[td][te][3]); *(LAS v2u*)(OutB + e * RS + d) = x;
                }
            __syncthreads();
            const int tq = opaque(tid);
#pragma unroll
            for (int r = 0; r < 8; ++r) { const int f = tq + 512 * r, mat = f >> 11, row = (f >> 4) & 127, pc = f & 15;
                const v4u q = *(const LAS v4u*)(Kt + (mat * 128 + row) * RS + pc * 8);
                bf16* dst = (mat ? STB : STF) + ((size_t)(c * 4 + h) * 256 + eh * 128 + row) * 256 + dh * 128 + pc * 8;
                *(v4u*)dst = q; }
        }
        __syncthreads();
        u = un; un = unn;
    }
#undef RS_LOAD
}
__device__ __forceinline__ void ret_prefix_phase(const Frame& F, CArgs& A) {
    bf16* STF = (bf16*)(F.ws + WS_STF); bf16* STB = (bf16*)(F.ws + WS_STB);
    for (size_t it = F.gtid; it < (size_t)36 * 2 * 8192; it += F.NT) {
        const int o = (int)(it & 8191), which = (int)((it >> 13) & 1), bh = (int)(it >> 14), h = bh & 3, s = bh >> 2;
        const int c0 = s < 8 ? s * 32 : 256, n = s < 8 ? 32 : 64;
        const float dec = exp2f(128.0f * ret_log2_gamma(h));
        float st[8];
#pragma unroll
        for (int k = 0; k < 8; ++k) st[k] = 0.f;
        bf16* base = (which ? STB : STF) + (size_t)h * 65536 + (size_t)o * 8;
        for (int k0 = 0; k0 < n; k0 += 8) {
            v4u q[8];
#pragma unroll
            for (int kk = 0; kk < 8; ++kk) { const int c = which ? (c0 + n - 1 - (k0 + kk)) : (c0 + k0 + kk); q[kk] = *(const v4u*)(base + (size_t)c * 4 * 65536); }
#pragma unroll
            for (int kk = 0; kk < 8; ++kk) { const int c = which ? (c0 + n - 1 - (k0 + kk)) : (c0 + k0 + kk);
                float f[8]; unpack8(q[kk], f);
#pragma unroll
                for (int i = 0; i < 8; ++i) st[i] = dec * st[i] + f[i];
                *(v4u*)(base + (size_t)c * 4 * 65536) = pack8(st); }
        }
    }
}
__device__ __forceinline__ void ret_out_phase(const Frame& F, CArgs& A) {
    const bf16* H = (const bf16*)(F.ws + WS_H); const bf16* STF = (const bf16*)(F.ws + WS_STF); const bf16* STB = (const bf16*)(F.ws + WS_STB);
    bf16* CC = (bf16*)(F.ws + WS_CONCAT);
    LAS bf16* RA = (LAS bf16*)F.lds; LAS bf16* RB = RA + 128 * RS; LAS bf16* RC = RA + 384 * RS;
    const int tid = F.tid, wi = F.wave >> 2, wj = F.wave & 3, we = F.wave & 3;
    for (int u = F.bx; u < 1280; u += F.G) {
        const int lane = opaque(F.lane), lr = lane & 15, lq = lane >> 4;
        const int h = u & 3, c = u >> 2, t0 = c * 128;
        const int cs = c < 256 ? (c & 31) : (c - 256), ncs = c < 256 ? 32 : 64;
        const bool has_f = cs > 0, has_b = cs < ncs - 1;
        const float lg = ret_log2_gamma(h);
        const int tq = opaque(tid);
        v4u pa[4], pb[8];
#define RO_LOAD_QK(dh_) do { _Pragma("unroll") for (int r = 0; r < 4; ++r) { const int f = tq + 512 * r, row = f >> 4, pc = f & 15; \
            const bf16* src = H + (size_t)(t0 + row) * INW + h * 256 + (dh_) * 128 + pc * 8; pa[r] = *(const v4u*)(src + COL_Q); pb[r] = *(const v4u*)(src + COL_K); } } while (0)
#define RO_STORE_QK() do { _Pragma("unroll") for (int r = 0; r < 4; ++r) { const int f = tq + 512 * r, row = f >> 4, pc = f & 15; \
            *(LAS v4u*)(RA + row * RS + pc * 8) = pa[r]; *(LAS v4u*)(RB + row * RS + pc * 8) = pb[r]; } } while (0)
#define RO_LOAD_V() do { const int jp_ = tq & 63, pc0_ = tq >> 6; const bf16* vrow = H + (size_t)(t0 + 2 * jp_) * INW + COL_V + h * 256; \
            _Pragma("unroll") for (int r = 0; r < 4; ++r) { const int pc = pc0_ + 8 * r; pb[r] = *(const v4u*)(vrow + pc * 8); pb[4 + r] = *(const v4u*)(vrow + INW + pc * 8); } } while (0)
#define RO_STORE_V() do { const int jp_ = tq & 63, pc0_ = tq >> 6; LAS unsigned* RB32 = (LAS unsigned*)RB; \
            _Pragma("unroll") for (int r = 0; r < 4; ++r) { const int pc = pc0_ + 8 * r; \
                const unsigned va0[4] = {pb[r].x, pb[r].y, pb[r].z, pb[r].w}, va1[4] = {pb[4 + r].x, pb[4 + r].y, pb[4 + r].z, pb[4 + r].w}; \
                _Pragma("unroll") for (int i = 0; i < 8; ++i) { const unsigned a = va0[i >> 1], b = va1[i >> 1]; \
                    RB32[((pc * 8 + i) * RS) / 2 + jp_] = (i & 1) ? ((a >> 16) | (b & 0xffff0000u)) : ((a & 0xffffu) | (b << 16)); } } } while (0)
#define RO_LOAD_I(dir_, dh_) do { const bool has_ = (dir_) == 0 ? has_f : has_b; const int cn_ = (dir_) == 0 ? c - 1 : c + 1; \
            const bf16* St = ((dir_) == 0 ? STF : STB) + (size_t)((has_ ? cn_ : c) * 4 + h) * 65536; \
            _Pragma("unroll") for (int r = 0; r < 8; ++r) { const int f = tq + 512 * r, row = f >> 4, pc = f & 15; pb[r] = has_ ? *(const v4u*)(St + (size_t)row * 256 + (dh_) * 128 + pc * 8) : (v4u){0u, 0u, 0u, 0u}; } } while (0)
#define RO_STORE_I(dir_, dh_) do { \
            _Pragma("unroll") for (int r = 0; r < 4; ++r) { const int f = tq + 512 * r, row = f >> 4, pc = f & 15; pa[r] = *(const v4u*)(H + (size_t)(t0 + row) * INW + COL_Q + h * 256 + (dh_) * 128 + pc * 8); } \
            _Pragma("unroll") for (int r = 0; r < 4; ++r) { const int f = tq + 512 * r, row = f >> 4, pc = f & 15; \
                const float fac = exp2f(lg * ((dir_) == 0 ? (float)(row + 1) : (float)(128 - row))); float qf[8]; unpack8(pa[r], qf); \
                _Pragma("unroll") for (int k = 0; k < 8; ++k) qf[k] *= fac; \
                *(LAS v4u*)(RA + row * RS + pc * 8) = pack8(qf); } \
            _Pragma("unroll") for (int r = 0; r < 8; ++r) { const int f = tq + 512 * r, row = f >> 4, pc = f & 15; *(LAS v4u*)(RB + row * RS + pc * 8) = pb[r]; } } while (0)
        f32x4 S[4][2];
#pragma unroll
        for (int ti = 0; ti < 4; ++ti)
#pragma unroll
            for (int tj = 0; tj < 2; ++tj) S[ti][tj] = (f32x4){0.f, 0.f, 0.f, 0.f};
        RO_LOAD_QK(0);
#pragma unroll
        for (int dh = 0; dh < 2; ++dh) {
            if (dh) __syncthreads();
            RO_STORE_QK();
            __syncthreads();
            if (dh == 0) RO_LOAD_QK(1); else RO_LOAD_V();
#pragma unroll
            for (int ks = 0; ks < 4; ++ks) {
                bf16x8 ka[2], qb[4];
#pragma unroll
                for (int tj = 0; tj < 2; ++tj) ka[tj] = *(const LAS bf16x8*)(RB + (32 * wj + 16 * tj + lr) * RS + 32 * ks + lq * 8);
#pragma unroll
                for (int ti = 0; ti < 4; ++ti) qb[ti] = *(const LAS bf16x8*)(RA + (64 * wi + 16 * ti + lr) * RS + 32 * ks + lq * 8);
#pragma unroll
                for (int ti = 0; ti < 4; ++ti)
#pragma unroll
                    for (int tj = 0; tj < 2; ++tj) S[ti][tj] = MFMA16(ka[tj], qb[ti], S[ti][tj]);
            }
        }
#pragma unroll
        for (int ti = 0; ti < 4; ++ti)
#pragma unroll
            for (int tj = 0; tj < 2; ++tj) {
                const int i = 64 * wi + 16 * ti + lr, j0 = 32 * wj + 16 * tj + 4 * lq; float p[4];
#pragma unroll
                for (int jj = 0; jj < 4; ++jj) { const int d = i - (j0 + jj); p[jj] = S[ti][tj][jj] * exp2f(lg * (float)(d < 0 ? -d : d)); }
                v2u w; w.x = pkbf(p[0], p[1]); w.y = pkbf(p[2], p[3]); *(LAS v2u*)(RC + i * RS + j0) = w;
            }
        __syncthreads();
        RO_STORE_V();
        __syncthreads();
        RO_LOAD_I(0, 0);
        f32x4 O[4][4];
#pragma unroll
        for (int ti = 0; ti < 4; ++ti)
#pragma unroll
            for (int te = 0; te < 4; ++te) O[ti][te] = (f32x4){0.f, 0.f, 0.f, 0.f};
#pragma unroll
        for (int ks = 0; ks < 4; ++ks) {
            bf16x8 va[4], pbf[4];
#pragma unroll
            for (int te = 0; te < 4; ++te) va[te] = *(const LAS bf16x8*)(RB + (64 * we + 16 * te + lr) * RS + 32 * ks + lq * 8);
#pragma unroll
            for (int ti = 0; ti < 4; ++ti) pbf[ti] = *(const LAS bf16x8*)(RC + (64 * wi + 16 * ti + lr) * RS + 32 * ks + lq * 8);
#pragma unroll
            for (int ti = 0; ti < 4; ++ti)
#pragma unroll
                for (int te = 0; te < 4; ++te) O[ti][te] = MFMA16(va[te], pbf[ti], O[ti][te]);
        }
#pragma unroll
        for (int stg = 0; stg < 4; ++stg) {
            __syncthreads();
            if (stg == 0) RO_STORE_I(0, 0); else if (stg == 1) RO_STORE_I(0, 1); else if (stg == 2) RO_STORE_I(1, 0); else RO_STORE_I(1, 1);
            __syncthreads();
            if (stg == 0) RO_LOAD_I(0, 1); else if (stg == 1) RO_LOAD_I(1, 0); else if (stg == 2) RO_LOAD_I(1, 1);
#pragma unroll
            for (int ks = 0; ks < 4; ++ks) {
                bf16x8 sa[4], qb[4];
#pragma unroll
                for (int te = 0; te < 4; ++te) sa[te] = *(const LAS bf16x8*)(RB + (64 * we + 16 * te + lr) * RS + 32 * ks + lq * 8);
#pragma unroll
                for (int ti = 0; ti < 4; ++ti) qb[ti] = *(const LAS bf16x8*)(RA + (64 * wi + 16 * ti + lr) * RS + 32 * ks + lq * 8);
#pragma unroll
                for (int ti = 0; ti < 4; ++ti)
#pragma unroll
                    for (int te = 0; te < 4; ++te) O[ti][te] = MFMA16(sa[te], qb[ti], O[ti][te]);
            }
        }
#undef RO_LOAD_QK
#undef RO_STORE_QK
#undef RO_LOAD_V
#undef RO_STORE_V
#undef RO_LOAD_I
#undef RO_STORE_I
        __syncthreads();
        v4u gq[8];
        { const int tq3 = opaque(tid);
#pragma unroll
          for (int r = 0; r < 8; ++r) { const int f = tq3 + 512 * r, row = f >> 5, pc = f & 31; gq[r] = *(const v4u*)(H + (size_t)(t0 + row) * INW + COL_G + h * 256 + pc * 8); } }
        LAS float* RED = (LAS float*)RA;
#pragma unroll
        for (int ti = 0; ti < 4; ++ti) { float s1 = 0.f, s2 = 0.f;
#pragma unroll
            for (int te = 0; te < 4; ++te)
#pragma unroll
                for (int jj = 0; jj < 4; ++jj) { const float v = O[ti][te][jj]; s1 += v; s2 += v * v; }
            s1 += __shfl_xor(s1, 16); s1 += __shfl_xor(s1, 32); s2 += __shfl_xor(s2, 16); s2 += __shfl_xor(s2, 32);
            if (lq == 0) { RED[((64 * wi + 16 * ti + lr) * 4 + we) * 2] = s1; RED[((64 * wi + 16 * ti + lr) * 4 + we) * 2 + 1] = s2; } }
        __syncthreads();
        LAS bf16* ON = RB;
#pragma unroll
        for (int ti = 0; ti < 4; ++ti) { const int i = 64 * wi + 16 * ti + lr;
            const f32x4 r0 = *(const LAS f32x4*)(RED + i * 8), r1 = *(const LAS f32x4*)(RED + i * 8 + 4);
            const float m = (r0[0] + r0[2] + r1[0] + r1[2]) * (1.0f / 256.0f), q = (r0[1] + r0[3] + r1[1] + r1[3]) * (1.0f / 256.0f);
            const float var = fmaxf(q - m * m, 0.f), rstd = 1.0f / sqrtf(var + GN_EPS);
#pragma unroll
            for (int te = 0; te < 4; ++te) { const int e0 = 64 * we + 16 * te + 4 * lq;
                v2u w; w.x = pkbf((O[ti][te][0] - m) * rstd, (O[ti][te][1] - m) * rstd); w.y = pkbf((O[ti][te][2] - m) * rstd, (O[ti][te][3] - m) * rstd);
                *(LAS v2u*)(ON + i * 264 + e0) = w; } }
        __syncthreads();
        {
            const int tq2 = opaque(tid);
#pragma unroll
            for (int r = 0; r < 8; ++r) { const int f = tq2 + 512 * r, row = f >> 5, pc = f & 31;
                float ov[8], gv[8]; unpack8(*(const LAS v4u*)(ON + row * 264 + pc * 8), ov); unpack8(gq[r], gv);
#pragma unroll
                for (int k = 0; k < 8; ++k) ov[k] = (gv[k] * __builtin_amdgcn_rcpf(1.0f + __expf(-gv[k]))) * ov[k];
                *(v4u*)(CC + (size_t)(t0 + row) * DM + 1024 + h * 256 + pc * 8) = pack8(ov); }
        }
        __syncthreads();
    }
}

__device__ __forceinline__ unsigned f2key(float f) { const unsigned u = __float_as_uint(f); return (u & 0x80000000u) ? ~u : (u | 0x80000000u); }
__device__ __forceinline__ float key2f(unsigned k) { const unsigned u = (k & 0x80000000u) ? (k & 0x7fffffffu) : ~k; return __uint_as_float(u); }
#define TK_CE(a, b) do { const unsigned hi_ = (a) > (b) ? (a) : (b), lo_ = (a) > (b) ? (b) : (a); (a) = hi_; (b) = lo_; } while (0)
__device__ __forceinline__ void bitonic_merge16(unsigned (&v)[16]) {
#pragma unroll
    for (int j = 8; j > 0; j >>= 1)
#pragma unroll
        for (int i = 0; i < 16; ++i) { const int l = i ^ j; if (l > i) TK_CE(v[i], v[l]); }
}
__device__ __forceinline__ void bitonic_sort16(unsigned (&v)[16]) {
#pragma unroll
    for (int k = 2; k <= 16; k <<= 1)
#pragma unroll
        for (int j = k >> 1; j > 0; j >>= 1)
#pragma unroll
            for (int i = 0; i < 16; ++i) { const int l = i ^ j; if (l > i) { if ((i & k) == 0) TK_CE(v[i], v[l]); else TK_CE(v[l], v[i]); } }
}
__device__ __forceinline__ void topk_phase(const Frame& F, CArgs& A) {
    const _Float16* SC = (const _Float16*)(F.ws + WS_H); int* IDX = (int*)(F.ws + WS_IDX); float* GATE = (float*)(F.ws + WS_GATE);
    typedef _Float16 h8 __attribute__((ext_vector_type(8)));
    LAS unsigned* LK = (LAS unsigned*)F.lds;
    const int tid = F.tid, tl = tid >> 4, hp = tid & 15;
    h8 cur[16];
    if (F.bx < NTOK / 32) { const _Float16* row = SC + (size_t)(F.bx * 32 + tl) * DM + hp * 128;
#pragma unroll
        for (int q = 0; q < 16; ++q) cur[q] = *(const h8*)(row + q * 8); }
    for (int blk = F.bx; blk < NTOK / 32; blk += F.G) {
        const int t = blk * 32 + tl;
        unsigned run[16];
#pragma unroll
        for (int k = 0; k < 16; ++k) run[k] = 0u;
#pragma unroll
        for (int c16 = 0; c16 < 8; ++c16) {
            unsigned ch[16];
#pragma unroll
            for (int q = 0; q < 2; ++q)
#pragma unroll
                for (int e = 0; e < 8; ++e) { const int n = c16 * 16 + q * 8 + e; ch[q * 8 + e] = (f2key((float)cur[c16 * 2 + q][e]) & ~127u) | (unsigned)(127 - n); }
            bitonic_sort16(ch);
#pragma unroll
            for (int i = 0; i < 16; ++i) run[i] = run[i] > ch[15 - i] ? run[i] : ch[15 - i];
            bitonic_merge16(run);
        }
        { const int bn = blk + F.G < NTOK / 32 ? blk + F.G : blk; const _Float16* rown = SC + (size_t)(bn * 32 + tl) * DM + hp * 128;
#pragma unroll
          for (int q = 0; q < 16; ++q) cur[q] = *(const h8*)(rown + q * 8); }
#pragma unroll
        for (int k = 0; k < 16; ++k) LK[tid * 17 + k] = run[k];
        __syncthreads();
        {
            const int odd = hp & 1, te = tid & ~1;
            const int la = (te + odd) * 17, lb = (te + 1 - odd) * 17;
            float a[16], b[16];
#pragma unroll
            for (int k = 0; k < 16; ++k) { a[k] = key2f(LK[la + k] & ~127u); b[k] = key2f(LK[lb + k] & ~127u); }
            unsigned sk[16];
#pragma unroll
            for (int k = 0; k < 16; ++k) sk[k] = 0u;
#define TK_INS(sum_, cell_) do { unsigned key = (f2key(sum_) & ~255u) | (unsigned)(255 - (cell_)); \
                _Pragma("unroll") for (int k = 0; k < 16; ++k) { const unsigned hi = sk[k] > key ? sk[k] : key, lo = sk[k] > key ? key : sk[k]; sk[k] = hi; key = lo; } } while (0)
#pragma unroll
            for (int i = 0; i < 16; ++i)
#pragma unroll
                for (int j = i + 1; j < 16; ++j) if ((i + 1) * (j + 1) <= 16) TK_INS(a[i] + b[j], odd ? j * 16 + i : i * 16 + j);
            {
                float a0 = a[0], a1 = a[1], a2 = a[2], a3 = a[3], b0 = b[0], b1 = b[1], b2 = b[2], b3 = b[3];
                asm("" : "+v"(a0)); asm("" : "+v"(a1)); asm("" : "+v"(a2)); asm("" : "+v"(a3)); asm("" : "+v"(b0)); asm("" : "+v"(b1)); asm("" : "+v"(b2)); asm("" : "+v"(b3));
                TK_INS((odd ? a2 : a0) + (odd ? b2 : b0), odd ? 2 * 17 : 0);
                TK_INS((odd ? a3 : a1) + (odd ? b3 : b1), odd ? 3 * 17 : 17);
            }
#undef TK_INS
#pragma unroll
            for (int k = 0; k < 16; ++k) { const unsigned o = (unsigned)__shfl_xor((int)sk[15 - k], 1); sk[k] = sk[k] > o ? sk[k] : o; }
            bitonic_merge16(sk);
            float e[16], sum = 0.f; const float s0 = key2f(sk[0] & ~255u);
#pragma unroll
            for (int k = 0; k < 16; ++k) { e[k] = __expf(key2f(sk[k] & ~255u) - s0); sum += e[k]; }
            const float inv = 1.0f / sum; const int head = hp >> 1;
#pragma unroll
            for (int kk = 0; kk < 8; ++kk) {
                unsigned klo = sk[kk], khi = sk[8 + kk]; float elo = e[kk], ehi = e[8 + kk];
                asm("" : "+v"(klo)); asm("" : "+v"(khi)); asm("" : "+v"(elo)); asm("" : "+v"(ehi));
                const unsigned key = odd ? khi : klo; const float ev = odd ? ehi : elo; const int k = odd * 8 + kk;
                const int cell = 255 - (int)(key & 255u);
                const int i1 = 127 - (int)(LK[te * 17 + (cell >> 4)] & 127u), i2 = 127 - (int)(LK[(te + 1) * 17 + (cell & 15)] & 127u);
                IDX[(size_t)t * 128 + head * 16 + k] = i1 * 128 + i2;
                GATE[(size_t)t * 128 + head * 16 + k] = ev * inv;
            }
        }
        __syncthreads();
    }
}
typedef int v8i __attribute__((ext_vector_type(8)));
__device__ __forceinline__ void peer_gather_phase(const Frame& F, CArgs& A, int l, float* xdst_base, bf16* XN) {
    constexpr int RB = DM / 2;
    constexpr int GNR = GATHER_ROWS;
    const unsigned char* U8 = F.ws + WS_U8 + (size_t)l * NEXP * RB; const unsigned char* V8 = F.ws + WS_V8 + (size_t)l * NEXP * RB;
    const float* USC = (const float*)(F.ws + WS_USC) + (size_t)l * NEXP; const float* VSC = (const float*)(F.ws + WS_VSC) + (size_t)l * NEXP;
    const int* IDX = (const int*)(F.ws + WS_IDX); const float* GATE = (const float*)(F.ws + WS_GATE);
    const float* g2 = GIN(A, I_LN2G) + (size_t)l * DM; const float* b2 = GIN(A, I_LN2B) + (size_t)l * DM;
    LAS unsigned char* XF8 = F.lds + F.wave * 2560;
    LAS float* HS = (LAS float*)(F.lds + F.wave * 2560 + 2048);
    const int lane = F.lane, lr = lane & 15, lq = lane >> 4;
    int nidx0 = 0, nidx1 = 0; float ngate0 = 0.f, ngate1 = 0.f;
    if (F.gw < NTOK) { nidx0 = IDX[(size_t)F.gw * 128 + lane]; nidx1 = IDX[(size_t)F.gw * 128 + 64 + lane]; ngate0 = GATE[(size_t)F.gw * 128 + lane]; ngate1 = GATE[(size_t)F.gw * 128 + 64 + lane]; }
    for (int t = F.gw; t < NTOK; t += F.NGW) {
        const bf16* xrow = XN + (size_t)t * DM;
        {
            v4u w0, w1;
#pragma unroll
            for (int j = 0; j < 8; ++j) { const v2u a = *(const v2u*)(xrow + j * 256 + lane * 4); int pk = 0;
                pk = __builtin_amdgcn_cvt_pk_fp8_f32(bf_lo(a.x), bf_hi(a.x), pk, false); pk = __builtin_amdgcn_cvt_pk_fp8_f32(bf_lo(a.y), bf_hi(a.y), pk, true);
                if (j < 4) w0[j] = (unsigned)pk; else w1[j - 4] = (unsigned)pk; }
            *(LAS v4u*)(XF8 + lane * 32) = w0; *(LAS v4u*)(XF8 + lane * 32 + 16) = w1;
        }
        const int idx0 = nidx0, idx1 = nidx1;
        const float gate0 = ngate0, gate1 = ngate1;
        const float usc0 = USC[idx0], usc1 = USC[idx1], vsc0 = VSC[idx0], vsc1 = VSC[idx1];
        unsigned rowoff[8];
#pragma unroll
        for (int g = 0; g < 8; ++g) rowoff[g] = (unsigned)__shfl((g >> 2) ? idx1 : idx0, (g & 3) * 16 + lr) * (unsigned)RB + (unsigned)lq * 16u;
        v4u AB[8][2];
#pragma unroll
        for (int g = 0; g < 8; ++g) { AB[g][0] = *(const v4u*)(U8 + rowoff[g]); AB[g][1] = *(const v4u*)(U8 + rowoff[g] + 64); }
        f32x4 hacc[8];
#pragma unroll
        for (int g = 0; g < 8; ++g) hacc[g] = (f32x4){0.f, 0.f, 0.f, 0.f};
        LDS_WAIT();
#pragma unroll 1
        for (int kp = 0; kp < 8; ++kp) {
            const LAS unsigned char* xq = XF8 + ((2 * kp) * 4 + (lq >> 1)) * 32 + 16 * (lq & 1);
            const v4u b00 = *(const LAS v4u*)xq, b01 = *(const LAS v4u*)(xq + 64), b10 = *(const LAS v4u*)(xq + 128), b11 = *(const LAS v4u*)(xq + 192);
            const v8i B0 = (v8i){(int)b00[0], (int)b00[1], (int)b00[2], (int)b00[3], (int)b01[0], (int)b01[1], (int)b01[2], (int)b01[3]};
            const v8i B1 = (v8i){(int)b10[0], (int)b10[1], (int)b10[2], (int)b10[3], (int)b11[0], (int)b11[1], (int)b11[2], (int)b11[3]};
#pragma unroll
            for (int g = 0; g < 8; ++g) {
                const v8i A0 = (v8i){(int)AB[g][0][0], (int)AB[g][0][1], (int)AB[g][0][2], (int)AB[g][0][3], 0, 0, 0, 0};
                const v8i A1 = (v8i){(int)AB[g][1][0], (int)AB[g][1][1], (int)AB[g][1][2], (int)AB[g][1][3], 0, 0, 0, 0};
                hacc[g] = __builtin_amdgcn_mfma_scale_f32_16x16x128_f8f6f4(A0, B0, hacc[g], 4, 0, 0, 0x7f7f7f7f, 0, 0x7f7f7f7f);
                hacc[g] = __builtin_amdgcn_mfma_scale_f32_16x16x128_f8f6f4(A1, B1, hacc[g], 4, 0, 0, 0x7f7f7f7f, 0, 0x7f7f7f7f);
                if (kp < 7) { AB[g][0] = *(const v4u*)(U8 + rowoff[g] + (kp + 1) * 128); AB[g][1] = *(const v4u*)(U8 + rowoff[g] + (kp + 1) * 128 + 64); }
            }
        }
        if (lr == 0) {
#pragma unroll
            for (int g = 0; g < 8; ++g) *(LAS f32x4*)(HS + g * 16 + 4 * lq) = hacc[g];
        }
        LDS_WAIT();
        const float hval0 = HS[lane], hval1 = HS[64 + lane];
        const float w0 = gate0 * gelu_erf(hval0 * usc0) * vsc0, w1 = gate1 * gelu_erf(hval1 * usc1) * vsc1;
        { const int tn = t + F.NGW, tp = tn < NTOK ? tn : t;
          nidx0 = IDX[(size_t)tp * 128 + lane]; nidx1 = IDX[(size_t)tp * 128 + 64 + lane]; ngate0 = GATE[(size_t)tp * 128 + lane]; ngate1 = GATE[(size_t)tp * 128 + 64 + lane]; }
        v4u BU[GNR];
        const unsigned loff = (unsigned)lane * 16u;
#define G_ROW_V(R) (V8 + (size_t)(unsigned)__builtin_amdgcn_readlane((((R) >> 6) & 1) ? idx1 : idx0, (R) & 63) * RB)
#define G_REQ(r, rowptr) do { BU[r] = *(const v4u*)((rowptr) + loff); } while (0)
#pragma unroll
        for (int r = 0; r < GNR; ++r) G_REQ(r, G_ROW_V(r));
        f32x2v acc[16];
#pragma unroll
        for (int k = 0; k < 16; ++k) acc[k] = (f32x2v){0.f, 0.f};
#define G_AXPY(r, R) do { const float w_ = __uint_as_float((unsigned)__builtin_amdgcn_readlane((int)__float_as_uint((((R) >> 6) & 1) ? w1 : w0), (R) & 63)); const f32x2v w2_ = (f32x2v){w_, w_}; \
            _Pragma("unroll") for (int q = 0; q < 4; ++q) { acc[4 * q] += w2_ * __builtin_amdgcn_cvt_scalef32_pk_f32_fp4(BU[r][q], 1.0f, 0); acc[4 * q + 1] += w2_ * __builtin_amdgcn_cvt_scalef32_pk_f32_fp4(BU[r][q], 1.0f, 1); \
                acc[4 * q + 2] += w2_ * __builtin_amdgcn_cvt_scalef32_pk_f32_fp4(BU[r][q], 1.0f, 2); acc[4 * q + 3] += w2_ * __builtin_amdgcn_cvt_scalef32_pk_f32_fp4(BU[r][q], 1.0f, 3); } } while (0)
        for (int it = 0; it < 128 / GNR - 1; ++it) {
#pragma unroll
            for (int r = 0; r < GNR; ++r) { G_AXPY(r, GNR * it + r); G_REQ(r, G_ROW_V(GNR * (it + 1) + r)); }
        }
#pragma unroll
        for (int r = 0; r < GNR; ++r) G_AXPY(r, 128 - GNR + r);
#undef G_ROW_V
#undef G_REQ
#undef G_AXPY
        const int le = opaque(lane);
        float s = 0.f;
#pragma unroll
        for (int j = 0; j < 8; ++j) { const v2u xr = *(const v2u*)(xrow + j * 256 + le * 4);
            acc[2 * j] = (f32x2v){bf_lo(xr.x), bf_hi(xr.x)} * ALPHA + acc[2 * j]; acc[2 * j + 1] = (f32x2v){bf_lo(xr.y), bf_hi(xr.y)} * ALPHA + acc[2 * j + 1];
            s += (acc[2 * j][0] + acc[2 * j][1]) + (acc[2 * j + 1][0] + acc[2 * j + 1][1]); }
        const float mean = wave_sum(s) * (1.0f / DM); float s2 = 0.f;
#pragma unroll
        for (int k = 0; k < 16; ++k) { acc[k] = acc[k] - mean; s2 += acc[k][0] * acc[k][0] + acc[k][1] * acc[k][1]; }
        const float rstd = 1.0f / sqrtf(wave_sum(s2) * (1.0f / DM) + LN_EPS);
        f32x4 gq[8], bq[8];
#pragma unroll
        for (int j = 0; j < 8; ++j) { gq[j] = *(const f32x4*)(g2 + j * 256 + le * 4); bq[j] = *(const f32x4*)(b2 + j * 256 + le * 4); }
#pragma unroll
        for (int j = 0; j < 8; ++j) { const int col = j * 256 + le * 4;
            const f32x4 gg = gq[j], bb = bq[j];
            const f32x2v a0 = acc[2 * j], a1 = acc[2 * j + 1];
            const f32x4 o = (f32x4){a0[0] * rstd * gg[0] + bb[0], a0[1] * rstd * gg[1] + bb[1], a1[0] * rstd * gg[2] + bb[2], a1[1] * rstd * gg[3] + bb[3]};
            if (xdst_base) *(f32x4*)(xdst_base + (size_t)t * DM + col) = o;
            v2u w; w.x = pkbf(o[0], o[1]); w.y = pkbf(o[2], o[3]); *(v2u*)(XN + (size_t)t * DM + col) = w; }
        LDS_WAIT();
    }
}

#ifndef DUP_MASK
#define DUP_MASK 0
#endif
#ifndef PHASE_TEST_ONLY
__global__ void __launch_bounds__(NTHR, 2) fwd_kernel(Args A) {
    extern __shared__ __attribute__((aligned(16))) unsigned char lds_raw[];
#define MKFRAME() Frame F; CArgs& KA = *(CArgs*)opaque_u64((unsigned long long)__builtin_amdgcn_kernarg_segment_ptr()); { F.lds = (LAS unsigned char*)lds_raw; F.tid = opaque((int)threadIdx.x); F.lane = F.tid & 63; F.wave = __builtin_amdgcn_readfirstlane(F.tid >> 6); \
        const int bx_ = opaque_s((int)blockIdx.x); F.G = gridDim.x; F.gw = bx_ * NWAVES + F.wave; F.NGW = F.G * NWAVES; F.gtid = (size_t)bx_ * NTHR + F.tid; F.NT = (size_t)F.G * NTHR; F.out = (float*)(float GAS*)opaque_g((unsigned char GAS*)KA.out); F.ws = (unsigned char*)opaque_g(KA.ws); F.bx = bx_; } \
        bf16* XN = (bf16*)(F.ws + WS_XN); bf16* H = (bf16*)(F.ws + WS_H); bf16* CC = (bf16*)(F.ws + WS_CONCAT); (void)XN; (void)H; (void)CC;
    volatile LAS unsigned* MISC = (volatile LAS unsigned*)((LAS unsigned char*)lds_raw + LDS_MISC);
    if (threadIdx.x < 64) MISC[threadIdx.x] = 0u;
    __syncthreads();
    XcdBarrier bar = xcd_barrier_post((unsigned*)(A.ws + WS_CTL) + CW_BAR + A.li * XCD_BAR_WORDS, MISC + 8);
    const int lo = A.ph_lo, hi = A.ph_hi;
#define IN(k) (lo <= (k) && (k) < hi)
#define SEAM(k) do { if (lo <= (k) && (k) + 1 < hi) xcd_barrier(bar); } while (0)

    if (IN(0)) { MKFRAME(); p0_prologue(F, KA); if (DUP_MASK & 256) { __syncthreads(); p0_prologue(F, KA); } } SEAM(0);

    for (int l = 0; l < NLAYER; ++l) {
        const int pb = 1 + l * 10;
        if (IN(pb + 0)) { MKFRAME();
            pg8::Gemm g{XN, (const bf16*)(F.ws + WS_WIN) + (size_t)l * INW * DM, NTOK, INW, DM}; pg8::StaticOrder S; S.init(NTOK, INW, F.G, F.bx);
            EpiStoreRot E{H, INW, (const float*)(F.ws + WS_ROTC), (const float*)(F.ws + WS_ROTS)};
            pg8::gemm_phase<EpiStoreRot, pg8::StaticOrder, GEMM_ALIGN, GEMM_SP2>(F.lds, g, S, E);
            if (DUP_MASK & 64) { pg8::gemm_phase<EpiStoreRot, pg8::StaticOrder, GEMM_ALIGN, GEMM_SP2>(F.lds, g, S, E); }
        } SEAM(pb + 0);
        if (IN(pb + 1)) { MKFRAME(); s5_pass1(F, KA, l); pool_phase(F, KA); if (DUP_MASK & 1) { s5_pass1(F, KA, l); } if (DUP_MASK & 2) { pool_phase(F, KA); } } SEAM(pb + 1);
        if (IN(pb + 2)) { MKFRAME(); s5_carry(F, KA, l); __syncthreads(); ret_state_phase(F, KA, (unsigned*)(F.ws + WS_CTL) + 64 + 16 * l); if (DUP_MASK & 4) { ret_state_phase(F, KA); } if (DUP_MASK & 2048) { ret_state_phase<1>(F, KA); } if (DUP_MASK & 4096) { ret_state_phase<2>(F, KA); ret_state_phase(F, KA); } } SEAM(pb + 2);
        if (IN(pb + 3)) { MKFRAME(); s5_pass3(F, KA, l); if (DUP_MASK & 8) { s5_pass3(F, KA, l); } ret_prefix_phase(F, KA); } SEAM(pb + 3);
        if (IN(pb + 4)) { MKFRAME();
            __syncthreads();
            ret_out_phase(F, KA);
            if (DUP_MASK & 16) { ret_out_phase(F, KA); }
            {
                pg8::Gemm g{(const bf16*)(F.ws + WS_BUFY), (const bf16*)(F.ws + WS_WGLU) + (size_t)l * 512 * 512, NTOK, 512, 512}; pg8::StaticOrder S; S.init(NTOK, 512, F.G, F.bx);
                EpiGlu E{(const bf16*)(F.ws + WS_BUFY), 512, CC, DM, GIN(KA, I_BGLU) + (size_t)l * 512};
                pg8::gemm_phase<EpiGlu, pg8::StaticOrder, GEMM_ALIGN, GEMM_SP2>(F.lds, g, S, E);
                if (DUP_MASK & 512) { pg8::gemm_phase<EpiGlu, pg8::StaticOrder, GEMM_ALIGN, GEMM_SP2>(F.lds, g, S, E); }
            }
        } SEAM(pb + 4);
        if (IN(pb + 5)) { MKFRAME();
            pg8::Gemm g{CC, (const bf16*)(F.ws + WS_WOUT) + (size_t)l * DM * DM, NTOK, DM, DM}; pg8::StaticOrder S; S.init(NTOK, DM, F.G, F.bx);
            EpiStoreBf16 E{H, DM};
            pg8::gemm_phase<EpiStoreBf16, pg8::StaticOrder, GEMM_ALIGN, GEMM_SP2>(F.lds, g, S, E);
        } SEAM(pb + 5);
        if (IN(pb + 6)) { MKFRAME();
            ln_rows2(XN, H, ALPHA, GIN(KA, I_LN1G) + (size_t)l * DM, GIN(KA, I_LN1B) + (size_t)l * DM, F.gw, F.NGW, F.lane);
        } SEAM(pb + 6);
        if (IN(pb + 7)) { MKFRAME();
            pg8::Gemm g{XN, (const bf16*)(F.ws + WS_WS) + (size_t)l * DM * DM, NTOK, DM, DM}; pg8::StaticOrder S; S.init(NTOK, DM, F.G, F.bx);
            EpiStoreF16 E{(_Float16*)(F.ws + WS_H), DM};
            pg8::gemm_phase<EpiStoreF16, pg8::StaticOrder, GEMM_ALIGN, GEMM_SP2>(F.lds, g, S, E);
            if (DUP_MASK & 128) { pg8::gemm_phase<EpiStoreF16, pg8::StaticOrder, GEMM_ALIGN, GEMM_SP2>(F.lds, g, S, E); }
        } SEAM(pb + 7);
        if (IN(pb + 8)) { MKFRAME(); __syncthreads(); topk_phase(F, KA); if (DUP_MASK & 32) { topk_phase(F, KA); } } SEAM(pb + 8);
        if (IN(pb + 9)) { MKFRAME(); if (DUP_MASK & 1024) { peer_gather_phase(F, KA, l, (float*)(F.ws + WS_H), CC); } peer_gather_phase(F, KA, l, l == NLAYER - 1 ? F.out : (float*)nullptr, XN); } SEAM(pb + 9);
    }
#undef IN
#undef SEAM
}


#ifndef DBG_STOP
#define DBG_STOP NPHASE
#endif
#ifndef MK_ONE_LAUNCH
#define MK_ONE_LAUNCH 0
#endif
extern "C" void kernel_launch(void* const* d_in, const int* in_sizes, int n_in, void* d_out, int out_size, void* d_ws, size_t ws_size, hipStream_t stream) {
    static int grid = 0;
    if (grid == 0) {
        if (n_in != 26 || out_size != NTOK * DM || ws_size < WS_END) { fprintf(stderr, "kernel_launch: unexpected shapes (n_in %d out %d ws %zu)\n", n_in, out_size, ws_size); grid = -1; return; }
        int dev = 0, cus = 0, per_cu = 0;
        if (hipGetDevice(&dev) != hipSuccess || hipDeviceGetAttribute(&cus, hipDeviceAttributeMultiprocessorCount, dev) != hipSuccess) { grid = -1; return; }
        if (hipFuncSetAttribute((const void*)fwd_kernel, hipFuncAttributeMaxDynamicSharedMemorySize, LDS_BYTES) != hipSuccess) { fprintf(stderr, "kernel_launch: hipFuncSetAttribute failed\n"); grid = -1; return; }
        if (hipOccupancyMaxActiveBlocksPerMultiprocessor(&per_cu, (const void*)fwd_kernel, NTHR, LDS_BYTES) != hipSuccess || per_cu < 1) { fprintf(stderr, "kernel_launch: occupancy query says %d\n", per_cu); grid = -1; (void)hipGetLastError(); return; }
        (void)hipGetLastError();
        grid = cus;
    }
    if (grid < 0) return;
    if (hipMemsetAsync((char*)d_ws + WS_CTL, 0, CTL_ZERO_BYTES, stream) != hipSuccess) return;
    Args a{};
    for (int i = 0; i < 26; ++i) a.in[i] = (const float*)d_in[i];
    a.out = (float*)d_out; a.ws = (unsigned char*)d_ws; a.pad = 0;
#if MK_ONE_LAUNCH
    a.ph_lo = 0; a.ph_hi = NPHASE; a.li = 0;
    hipLaunchKernelGGL(fwd_kernel, dim3(grid), dim3(NTHR), LDS_BYTES, stream, a);
#else
    for (int p = 0; p < DBG_STOP; ++p) { a.ph_lo = p; a.ph_hi = p + 1; a.li = p; hipLaunchKernelGGL(fwd_kernel, dim3(grid), dim3(NTHR), LDS_BYTES, stream, a); }
#endif
}
#endif
```

```cpp
#include <hip/hip_runtime.h>
#include <cstdio>
#include <cstdint>
#include <cmath>
__device__ __forceinline__ __attribute__((convergent)) void mk_syncthreads() { __builtin_amdgcn_fence(__ATOMIC_RELEASE, "workgroup"); __builtin_amdgcn_s_barrier(); __builtin_amdgcn_fence(__ATOMIC_ACQUIRE, "workgroup"); }
#define __syncthreads mk_syncthreads
__device__ __forceinline__ int opaque(int v) { asm volatile("" : "+v"(v)); return v; }
__device__ __forceinline__ int opaque_s(int v) { asm volatile("" : "+s"(v)); return v; }
__device__ __forceinline__ void* opaque_p(void* p) { asm volatile("" : "+s"(p)); return p; }
__device__ __forceinline__ unsigned long long opaque_u64(unsigned long long v) { asm volatile("" : "+s"(v)); return v; }
#ifndef GATHER_ROWS
#define GATHER_ROWS 16
#endif
__device__ __forceinline__ __attribute__((address_space(1))) unsigned char* opaque_g(__attribute__((address_space(1))) unsigned char* p) { asm volatile("" : "+s"(p)); return p; }
#ifndef GEMM_ALIGN
#define GEMM_ALIGN true
#endif
#ifndef GEMM_SP2
#define GEMM_SP2 true
#endif
#define MK_ONE_LAUNCH 1
namespace pg8 {
#define PG8_LAS __attribute__((address_space(3)))
typedef unsigned short bf16_t;
typedef short bf16x8 __attribute__((ext_vector_type(8)));
typedef float f32x4 __attribute__((ext_vector_type(4)));
typedef unsigned u32x4 __attribute__((ext_vector_type(4)));
constexpr int BM = 256, BK = 64, HALF = 128, HTB = HALF * BK * 2  , STAGE_BYTES = 8 * HTB, NXCD = 8, WGM = 8;

__host__ __device__ __forceinline__ int lds_byte(int r, int c) { const int st = (r >> 4) * 2 + (c >> 5), rr = r & 15, cc = c & 31, ob = rr * 64 + cc * 2; return st * 1024 + (ob ^ (((ob >> 9) & 1) << 5)); }
__host__ __device__ __forceinline__ void stage_rc(int b, int& R, int& C) { const int st = b / 1024, sb = b % 1024, swz = sb ^ (((sb >> 9) & 1) << 5); R = (st >> 1) * 16 + swz / 64; C = (st & 1) * 32 + (swz % 64) / 2; }
__host__ __device__ __forceinline__ int perm32(int rho) { const int n = rho >> 4, i = rho & 15; return 8 * (i >> 2) + 4 * n + (i & 3); }

struct Unit { int pm, pn; };
struct Gemm { const bf16_t* A; const bf16_t* Bt; int M, N, K; };

struct StaticOrder {
    int nM, nN, nwg, G, c;
    __host__ __device__ __forceinline__ void init(int M, int N, int G_, int c_) { nM = M / BM; nN = N / BM; nwg = nM * nN; G = G_; c = c_; }
    __host__ __device__ bool next(int i, Unit& u) const {
        const long L = (long)i * G + c; if (L >= nwg) return false;
        int wgid = (int)L; { const int q = nwg / NXCD, r = nwg % NXCD, xcd = wgid % NXCD, off = wgid / NXCD; wgid = (xcd < r ? xcd * (q + 1) : r * (q + 1) + (xcd - r) * q) + off; }
        const int nig = WGM * nN, gid = wgid / nig, fm = gid * WGM, gsz = (nM - fm) < WGM ? (nM - fm) : WGM;
        u.pm = fm + ((wgid % nig) % gsz); u.pn = (wgid % nig) / gsz; return true;
    }
    __device__ __forceinline__ void a_ready(const Unit&) const {}
    __device__ __forceinline__ void done(const Unit&) const {}
};
__device__ __forceinline__ unsigned cvt_pk_bf16(float lo, float hi) { unsigned r; asm volatile("v_cvt_pk_bf16_f32 %0, %1, %2" : "=v"(r) : "v"(lo), "v"(hi)); return r; }
typedef float f32x2 __attribute__((ext_vector_type(2)));
template <class Epi, class Sched, bool ALIGN_EPI = false, bool SP2 = false>
__device__ __forceinline__ void gemm_phase(PG8_LAS unsigned char* lds, const Gemm g, const Sched& S, const Epi& E) {
    const int tid = opaque((int)threadIdx.x), wid = __builtin_amdgcn_readfirstlane(tid >> 6), lane = tid & 63, wr = wid >> 2, wc = wid & 3, fr = lane & 15, fq = lane >> 4;
    const int K = g.K, nt = K / BK;
    unsigned voffA[2], voffB[2];
#pragma unroll
    for (int i = 0; i < 2; ++i) { int R, C; stage_rc(tid * 16 + i * 8192, R, C); const int Rb = Epi::PERM ? ((R & ~31) + perm32(R & 31)) : R;
        voffA[i] = (unsigned)(R * K + C) * 2u; voffB[i] = (unsigned)(Rb * K + C) * 2u; }
    const size_t kstep = (size_t)(BK * 2);
    const size_t hstep = (size_t)HALF * K * 2;
    const size_t tstep = 2 * hstep;
    const unsigned ldsw = (unsigned)wid * 1024u;
    const int aoff = lds_byte(wr * 64 + fr, fq * 8), boff = lds_byte(wc * 32 + fr, fq * 8);
#define PG8_SA(b, h) (((b) * 2 + (h)) * HTB)
#define PG8_SB(b, h) ((4 + (b) * 2 + (h)) * HTB)
#define PG8_STAGE(bufoff, gbase, voff) do { _Pragma("unroll") for (int _i = 0; _i < 2; ++_i) \
        __builtin_amdgcn_global_load_lds((const unsigned*)((const char*)(gbase) + (voff)[_i]), (PG8_LAS unsigned*)(lds + (bufoff) + ldsw + _i * 8192), 16, 0, 0); } while (0)
#define PG8_LDA(dst, b, h) do { _Pragma("unroll") for (int m = 0; m < 4; ++m) _Pragma("unroll") for (int k = 0; k < 2; ++k) dst[m][k] = *(const PG8_LAS bf16x8*)(lds + PG8_SA(b, h) + aoff + m * 2048 + k * 1024); } while (0)
#define PG8_LDB(dst, b, h) do { _Pragma("unroll") for (int n = 0; n < 2; ++n) _Pragma("unroll") for (int k = 0; k < 2; ++k) dst[n][k] = *(const PG8_LAS bf16x8*)(lds + PG8_SB(b, h) + boff + n * 2048 + k * 1024); } while (0)
#define PG8_MMA(ai, bj, At, Bt) do { __builtin_amdgcn_s_setprio(1); _Pragma("unroll") for (int m = 0; m < 4; ++m) _Pragma("unroll") for (int n = 0; n < 2; ++n) _Pragma("unroll") for (int k = 0; k < 2; ++k) \
        acc[ai][bj][m][n] = __builtin_amdgcn_mfma_f32_16x16x32_bf16(Bt[n][k], At[m][k], acc[ai][bj][m][n], 0, 0, 0); __builtin_amdgcn_s_setprio(0); } while (0)
#define PG8_WAIT_V(n) asm volatile("s_waitcnt vmcnt(" #n ")" ::: "memory")
#define PG8_WAIT_L(n) asm volatile("s_waitcnt lgkmcnt(" #n ")" ::: "memory")
#define PG8_BAR __builtin_amdgcn_s_barrier()
#define PG8_SCHED __builtin_amdgcn_sched_barrier(0)
    Unit cur, nxt; int ui = 0;
    if (!S.next(0, cur)) return;
    f32x4 acc[2][2][4][2];
#pragma unroll
    for (int a = 0; a < 2; ++a)
#pragma unroll
        for (int b = 0; b < 2; ++b)
#pragma unroll
            for (int m = 0; m < 4; ++m)
#pragma unroll
                for (int n = 0; n < 2; ++n) acc[a][b][m][n] = (f32x4){0.f, 0.f, 0.f, 0.f};
    bf16x8 At[4][2], B0[2][2], B1[2][2];
    const char* cA = (const char*)g.A + (size_t)cur.pm * tstep; const char* cB = (const char*)g.Bt + (size_t)cur.pn * tstep;
    S.a_ready(cur);
    if constexpr (SP2) {
        PG8_STAGE(PG8_SB(0, 0), cB, voffB); PG8_STAGE(PG8_SB(0, 1), cB + hstep, voffB); PG8_STAGE(PG8_SA(0, 0), cA, voffA); PG8_STAGE(PG8_SA(0, 1), cA + hstep, voffA);
        if (wr == 1) PG8_BAR;
        PG8_WAIT_V(2); PG8_BAR;
        PG8_STAGE(PG8_SB(1, 0), cB + kstep, voffB); PG8_STAGE(PG8_SA(1, 0), cA + kstep, voffA); PG8_STAGE(PG8_SB(1, 1), cB + hstep + kstep, voffB);
        PG8_WAIT_V(6); PG8_BAR;
    } else {
        PG8_STAGE(PG8_SB(0, 0), cB, voffB); PG8_STAGE(PG8_SA(0, 0), cA, voffA); PG8_STAGE(PG8_SB(0, 1), cB + hstep, voffB); PG8_STAGE(PG8_SA(0, 1), cA + hstep, voffA);
        if (wr == 1) PG8_BAR;
        PG8_WAIT_V(4); PG8_BAR;
        PG8_STAGE(PG8_SB(1, 0), cB + kstep, voffB); PG8_STAGE(PG8_SA(1, 0), cA + kstep, voffA); PG8_STAGE(PG8_SB(1, 1), cB + hstep + kstep, voffB);
        PG8_WAIT_V(6); PG8_BAR;
    }
    for (;;) {
        const bool has_next = S.next(ui + 1, nxt);
        const char* nA = has_next ? (const char*)g.A + (size_t)nxt.pm * tstep : cA; const char* nB = has_next ? (const char*)g.Bt + (size_t)nxt.pn * tstep : cB;
        for (int t = 0; t < nt; t += 2) {
            const bool last = (t == nt - 2);
            const char* a1 = cA + (size_t)(t + 1) * kstep;
            const char* a2 = last ? nA : cA + (size_t)(t + 2) * kstep; const char* b2 = last ? nB : cB + (size_t)(t + 2) * kstep;
            const char* a3 = a2 + kstep; const char* b3 = b2 + kstep;
            if (last && has_next) S.a_ready(nxt);
            if constexpr (SP2) {
            PG8_LDB(B0, 0, 0); PG8_LDB(B1, 0, 1); PG8_SCHED; PG8_LDA(At, 0, 0); PG8_STAGE(PG8_SA(1, 1), a1 + hstep, voffA);
            PG8_WAIT_V(8); PG8_WAIT_L(0); PG8_BAR; PG8_MMA(0, 0, At, B0); PG8_MMA(0, 1, At, B1); PG8_BAR; PG8_SCHED;
            PG8_LDA(At, 0, 1); PG8_STAGE(PG8_SB(0, 0), b2, voffB); PG8_STAGE(PG8_SB(0, 1), b2 + hstep, voffB); PG8_STAGE(PG8_SA(0, 0), a2, voffA);
            PG8_WAIT_V(8); PG8_WAIT_L(0); PG8_BAR; PG8_MMA(1, 0, At, B0); PG8_MMA(1, 1, At, B1); PG8_BAR; PG8_SCHED;
            PG8_LDB(B0, 1, 0); PG8_LDB(B1, 1, 1); PG8_SCHED; PG8_LDA(At, 1, 0); PG8_STAGE(PG8_SA(0, 1), a2 + hstep, voffA);
            PG8_WAIT_V(8); PG8_WAIT_L(0); PG8_BAR; PG8_MMA(0, 0, At, B0); PG8_MMA(0, 1, At, B1); PG8_BAR; PG8_SCHED;
            PG8_LDA(At, 1, 1); PG8_STAGE(PG8_SB(1, 0), b3, voffB); PG8_STAGE(PG8_SB(1, 1), b3 + hstep, voffB); PG8_STAGE(PG8_SA(1, 0), a3, voffA);
            PG8_WAIT_V(8); PG8_WAIT_L(0); PG8_BAR; PG8_MMA(1, 0, At, B0); PG8_MMA(1, 1, At, B1); PG8_BAR; PG8_SCHED;
            } else {
            PG8_LDB(B0, 0, 0); PG8_SCHED; PG8_LDA(At, 0, 0); PG8_STAGE(PG8_SA(1, 1), a1 + hstep, voffA);
            PG8_WAIT_L(8); PG8_BAR; PG8_WAIT_L(0); PG8_MMA(0, 0, At, B0); PG8_BAR; PG8_SCHED;
            PG8_LDB(B1, 0, 1); PG8_STAGE(PG8_SB(0, 0), b2, voffB);
            PG8_BAR; PG8_WAIT_L(0); PG8_MMA(0, 1, At, B1); PG8_BAR;
            PG8_LDA(At, 0, 1); PG8_STAGE(PG8_SA(0, 0), a2, voffA);
            PG8_BAR; PG8_WAIT_L(0); PG8_MMA(1, 0, At, B0); PG8_BAR; PG8_SCHED;
            PG8_STAGE(PG8_SB(0, 1), b2 + hstep, voffB);
            PG8_WAIT_V(6); PG8_BAR; PG8_MMA(1, 1, At, B1); PG8_BAR;
            PG8_LDB(B0, 1, 0); PG8_SCHED; PG8_LDA(At, 1, 0); PG8_STAGE(PG8_SA(0, 1), a2 + hstep, voffA);
            PG8_WAIT_L(8); PG8_BAR; PG8_WAIT_L(0); PG8_MMA(0, 0, At, B0); PG8_BAR; PG8_SCHED;
            PG8_LDB(B1, 1, 1); PG8_STAGE(PG8_SB(1, 0), b3, voffB);
            PG8_BAR; PG8_WAIT_L(0); PG8_MMA(0, 1, At, B1); PG8_BAR;
            PG8_LDA(At, 1, 1); PG8_STAGE(PG8_SA(1, 0), a3, voffA);
            PG8_BAR; PG8_WAIT_L(0); PG8_MMA(1, 0, At, B0); PG8_BAR; PG8_SCHED;
            PG8_STAGE(PG8_SB(1, 1), b3 + hstep, voffB);
            PG8_WAIT_V(6); PG8_BAR; PG8_MMA(1, 1, At, B1); PG8_BAR;
            }
        }
        if constexpr (ALIGN_EPI) { if (wr == 0) PG8_BAR; }
        if constexpr (!Epi::AFTER_DRAIN) { E(acc, cur, wr, wc, fr, fq); S.done(cur); }
        if (!has_next) break;
#pragma unroll
        for (int a = 0; a < 2; ++a)
#pragma unroll
            for (int b = 0; b < 2; ++b)
#pragma unroll
                for (int m = 0; m < 4; ++m)
#pragma unroll
                    for (int n = 0; n < 2; ++n) acc[a][b][m][n] = (f32x4){0.f, 0.f, 0.f, 0.f};
        cur = nxt; cA = nA; cB = nB; ++ui;
        if constexpr (ALIGN_EPI) { if (wr == 1) PG8_BAR; }
    }
    PG8_WAIT_V(0);
    if constexpr (!ALIGN_EPI) { if (wr == 0) PG8_BAR; }
    PG8_BAR;
    if constexpr (Epi::AFTER_DRAIN) { E.fused(acc, cur, wr, wc, fr, fq, lds, wid, lane); S.done(cur); }
#undef PG8_SA
#undef PG8_SB
#undef PG8_STAGE
#undef PG8_LDA
#undef PG8_LDB
#undef PG8_MMA
#undef PG8_WAIT_V
#undef PG8_WAIT_L
#undef PG8_BAR
#undef PG8_SCHED
}
}
#define LAS __attribute__((address_space(3)))
#define XB_TMO      128
#define XB_XCNT(j)  (256  + 64 * (j))
#define XB_XSUB(j)  (1280 + 64 * (j))
#define XB_XGEN(j)  (2304 + 64 * (j))
#define XB_TOP      3328
#define XB_TOPGEN   3392
#define XCD_BAR_WORDS 3456
#define XB_SPIN_CAP (1u << 18)

__device__ __forceinline__ unsigned xb_ld(unsigned* p)              { return __hip_atomic_load(p, __ATOMIC_RELAXED, __HIP_MEMORY_SCOPE_AGENT); }
__device__ __forceinline__ unsigned xb_add(unsigned* p, unsigned v) { return __hip_atomic_fetch_add(p, v, __ATOMIC_RELAXED, __HIP_MEMORY_SCOPE_AGENT); }
__device__ __forceinline__ unsigned xb_xcc_id() { return (unsigned)__builtin_amdgcn_s_getreg((3 << 11) | 20) & 0xFu; }
#define XB_SPIN(cond, bar) do { unsigned _sp = 0; while (cond) { __builtin_amdgcn_s_sleep(1); \
    if ((++_sp & 255u) == 0u) { if (xb_ld(&(bar)[XB_TMO])) break; if (_sp > XB_SPIN_CAP) { atomicAdd(&(bar)[XB_TMO], 1u); break; } } } } while (0)

struct XcdBarrier {
    unsigned* bar; unsigned x;
    volatile LAS unsigned* st;
};

__device__ __forceinline__ XcdBarrier xcd_barrier_post(unsigned* bar, volatile LAS unsigned* st) {
    XcdBarrier b; b.bar = bar; b.x = xb_xcc_id(); b.st = st;
    if (threadIdx.x == 0) (void)xb_add(&bar[XB_XCNT(b.x)], 1u);
    return b;
}
__device__ __forceinline__ void xcd_barrier_complete(unsigned* bar, unsigned x, unsigned& nloc, unsigned& nx) {
    const unsigned G = gridDim.x * gridDim.y * gridDim.z;
    unsigned sum, cnt, mine, sp = 0u;
    for (;;) {
        sum = 0u; cnt = 0u; mine = 0u;
#pragma unroll
        for (unsigned j = 0; j < 16; ++j) { const unsigned c = xb_ld(&bar[XB_XCNT(j)]); sum += c; cnt += (c > 0u) ? 1u : 0u; mine = (j == x) ? c : mine; }
        if (sum == G) break;
        __builtin_amdgcn_s_sleep(1);
        if ((++sp & 255u) == 0u) { if (xb_ld(&bar[XB_TMO])) break; if (sp > XB_SPIN_CAP) { atomicAdd(&bar[XB_TMO], 1u); break; } }
    }
    nloc = mine > 0u ? mine : 1u; nx = cnt > 0u ? cnt : 1u;
}

__device__ __forceinline__ void xcd_barrier(const XcdBarrier& b) {
    asm volatile("s_waitcnt vmcnt(0)" ::: "memory");
    __syncthreads();
    if (threadIdx.x == 0) {
        unsigned* bar = b.bar;
        __builtin_amdgcn_s_waitcnt(0);
        unsigned nloc = b.st[0], nx = b.st[1];
        if (nloc == 0u) { xcd_barrier_complete(bar, b.x, nloc, nx); b.st[0] = nloc; b.st[1] = nx; }
        const unsigned old = xb_add(&bar[XB_XSUB(b.x)], 1u);
        const unsigned gen = old / nloc;
        if (old + 1u == (gen + 1u) * nloc) {
            __builtin_amdgcn_fence(__ATOMIC_RELEASE, "agent");
            asm volatile("s_waitcnt vmcnt(0)" ::: "memory");
            const unsigned og = xb_add(&bar[XB_TOP], 1u);
            const unsigned tg = og / nx;
            if (og + 1u == (tg + 1u) * nx) xb_add(&bar[XB_TOPGEN], 1u);
            else XB_SPIN(xb_ld(&bar[XB_TOPGEN]) == tg, bar);
            __builtin_amdgcn_fence(__ATOMIC_ACQUIRE, "agent");
            xb_add(&bar[XB_XGEN(b.x)], 1u);
            asm volatile("s_waitcnt vmcnt(0)" ::: "memory");
        } else {
            XB_SPIN(xb_ld(&bar[XB_XGEN(b.x)]) == gen, bar);
            __builtin_amdgcn_fence(__ATOMIC_ACQUIRE, "agent");
            asm volatile("s_waitcnt vmcnt(0)" ::: "memory");
        }
    }
    __syncthreads();
}
#undef LAS
using pg8::bf16x8; using pg8::f32x4; using pg8::u32x4; using pg8::f32x2;
#define GAS __attribute__((address_space(1)))
#define LAS __attribute__((address_space(3)))
typedef unsigned short bf16;
typedef unsigned v4u __attribute__((ext_vector_type(4)));
typedef unsigned v2u __attribute__((ext_vector_type(2)));
typedef float f32x2v __attribute__((ext_vector_type(2)));

constexpr int NTOK = 40960, DM = 2048, NLAYER = 4, INW = 5120;
constexpr int COL_UA = 0, COL_UB = 512, COL_Q = 1024, COL_K = 2048, COL_V = 3072, COL_G = 4096;
constexpr float ALPHA = 1.6817928305074290f;
constexpr float LN_EPS = 1e-5f, GN_EPS = 1e-6f;
constexpr int NEXP = 16384;
constexpr int NWAVES = 8, NTHR = 512;

constexpr size_t MiB = 1u << 20;
constexpr size_t WS_CTL = 0, CTL_ZERO_BYTES = 1 * MiB;
constexpr size_t WS_WIN = 1 * MiB;
constexpr size_t WS_WOUT = 81 * MiB;
constexpr size_t WS_WS = 113 * MiB;
constexpr size_t WS_WGLU = 145 * MiB;
constexpr size_t WS_S5A = 149 * MiB;
constexpr size_t WS_S5B = 150 * MiB;
constexpr size_t WS_S5BB = 153 * MiB;
constexpr size_t WS_U8 = 160 * MiB;
constexpr size_t WS_V8 = 288 * MiB;
constexpr size_t WS_USC = 416 * MiB;
constexpr size_t WS_VSC = 417 * MiB;
constexpr size_t WS_ROTC = 420 * MiB;
constexpr size_t WS_ROTS = 424 * MiB;
constexpr size_t WS_XN = 672 * MiB;
constexpr size_t WS_H = 832 * MiB;
constexpr size_t WS_CONCAT = 1232 * MiB;
constexpr size_t WS_BUFY = 1392 * MiB;
constexpr size_t WS_STF = 1472 * MiB;
constexpr size_t WS_STB = 1632 * MiB;
constexpr size_t WS_IDX = 1792 * MiB;
constexpr size_t WS_GATE = 1812 * MiB;
constexpr size_t WS_S5ST = 1832 * MiB;
constexpr size_t WS_END = 1852 * MiB;
constexpr int CW_BAR = 4096;
constexpr int NPHASE = 1 + NLAYER * 10;

constexpr int LDS_SCRATCH = 147456;
constexpr int LDS_MISC = LDS_SCRATCH;
constexpr int LDS_BYTES = LDS_SCRATCH + 256;

__device__ __forceinline__ float bf_lo(unsigned w) { return __uint_as_float(w << 16); }
__device__ __forceinline__ float bf_hi(unsigned w) { return __uint_as_float(w & 0xffff0000u); }
typedef __bf16 bf16x2_t __attribute__((ext_vector_type(2)));
__device__ __forceinline__ unsigned pkbf(float lo, float hi) { const bf16x2_t v = {(__bf16)lo, (__bf16)hi}; return __builtin_bit_cast(unsigned, v); }
__device__ __forceinline__ bf16 f2bf(float f) { return __builtin_bit_cast(unsigned short, (__bf16)f); }
__device__ __forceinline__ float wave_sum(float v) {
#pragma unroll
    for (int o = 1; o < 64; o <<= 1) v += __shfl_xor(v, o);
    return v;
}
__device__ __forceinline__ float gelu_erf(float v) {
    const float z = fabsf(v) * 0.70710678118654752f;
    const float t = __builtin_amdgcn_rcpf(1.0f + 0.3275911f * z);
    const float poly = t * (0.254829592f + t * (-0.284496736f + t * (1.421413741f + t * (-1.453152027f + t * 1.061405429f))));
    const float ec = poly * __expf(-z * z);
    return 0.5f * v * (v < 0.f ? ec : 2.0f - ec);
}
__device__ __forceinline__ int tok_pos(int t) { return t < 32768 ? (t & 4095) : (t - 32768); }
__device__ __forceinline__ int tok_len(int t) { return t < 32768 ? 4096 : 8192; }
__device__ __forceinline__ void unpack8(const v4u q, float (&f)[8]) {
    f[0] = bf_lo(q.x); f[1] = bf_hi(q.x); f[2] = bf_lo(q.y); f[3] = bf_hi(q.y); f[4] = bf_lo(q.z); f[5] = bf_hi(q.z); f[6] = bf_lo(q.w); f[7] = bf_hi(q.w);
}
__device__ __forceinline__ v4u pack8(const float (&f)[8]) { v4u q; q.x = pkbf(f[0], f[1]); q.y = pkbf(f[2], f[3]); q.z = pkbf(f[4], f[5]); q.w = pkbf(f[6], f[7]); return q; }
#define LDS_WAIT() asm volatile("s_waitcnt lgkmcnt(0)" ::: "memory")
#define MFMA16(a, b, c) __builtin_amdgcn_mfma_f32_16x16x32_bf16((a), (b), (c), 0, 0, 0)

struct EpiStoreBf16 {
    static constexpr bool PERM = true, AFTER_DRAIN = false;
    bf16* O; int ldo;
    __device__ __forceinline__ void operator()(const f32x4 (&acc)[2][2][4][2], const pg8::Unit& u, int wr, int wc, int fr, int fq) const {
        const int row0 = u.pm * 256 + wr * 64 + fr, col0 = u.pn * 256 + wc * 32 + 8 * fq;
#pragma unroll
        for (int ai = 0; ai < 2; ++ai)
#pragma unroll
            for (int m = 0; m < 4; ++m) { bf16* rowp = O + (size_t)(row0 + ai * 128 + m * 16) * ldo + col0;
#pragma unroll
                for (int bj = 0; bj < 2; ++bj) { const f32x4 v0 = acc[ai][bj][m][0], v1 = acc[ai][bj][m][1];
                    v4u w; w.x = pkbf(v0[0], v0[1]); w.y = pkbf(v0[2], v0[3]); w.z = pkbf(v1[0], v1[1]); w.w = pkbf(v1[2], v1[3]);
                    *(v4u*)(rowp + bj * 128) = w; } }
    }
};
struct EpiStoreRot {
    static constexpr bool PERM = true, AFTER_DRAIN = false;
    bf16* O; int ldo; const float* rc; const float* rs;
    __device__ __forceinline__ void operator()(const f32x4 (&acc)[2][2][4][2], const pg8::Unit& u, int wr, int wc, int fr, int fq) const {
        const int row0 = u.pm * 256 + wr * 64 + fr, col0 = u.pn * 256 + wc * 32 + 8 * fq;
        const bool rot = u.pn >= 4 && u.pn < 12; const float sc = u.pn >= 8 ? 0.0625f : 1.0f;
#pragma unroll
        for (int ai = 0; ai < 2; ++ai)
#pragma unroll
            for (int m = 0; m < 4; ++m) { const int row = row0 + ai * 128 + m * 16; bf16* rowp = O + (size_t)row * ldo + col0;
                f32x4 a0 = acc[ai][0][m][0], a1 = acc[ai][0][m][1], b0 = acc[ai][1][m][0], b1 = acc[ai][1][m][1];
                if (rot) { const int pos = row < 32768 ? (row & 4095) : (row - 32768); const size_t to = (size_t)pos * 128 + wc * 32 + 8 * fq;
                    const f32x4 c0 = *(const f32x4*)(rc + to), c1 = *(const f32x4*)(rc + to + 4), s0 = *(const f32x4*)(rs + to), s1 = *(const f32x4*)(rs + to + 4);
                    const f32x4 x0 = a0, x1 = a1, y0 = b0, y1 = b1;
                    a0 = (x0 * c0 - y0 * s0) * sc; a1 = (x1 * c1 - y1 * s1) * sc; b0 = (y0 * c0 + x0 * s0) * sc; b1 = (y1 * c1 + x1 * s1) * sc; }
                v4u w; w.x = pkbf(a0[0], a0[1]); w.y = pkbf(a0[2], a0[3]); w.z = pkbf(a1[0], a1[1]); w.w = pkbf(a1[2], a1[3]); *(v4u*)rowp = w;
                v4u x; x.x = pkbf(b0[0], b0[1]); x.y = pkbf(b0[2], b0[3]); x.z = pkbf(b1[0], b1[1]); x.w = pkbf(b1[2], b1[3]); *(v4u*)(rowp + 128) = x; }
    }
};
struct EpiGlu {
    static constexpr bool PERM = true, AFTER_DRAIN = false;
    const bf16* Y; int ldy; bf16* O; int ldo; const float* bias;
    __device__ __forceinline__ void operator()(const f32x4 (&acc)[2][2][4][2], const pg8::Unit& u, int wr, int wc, int fr, int fq) const {
        const int row0 = u.pm * 256 + wr * 64 + fr, col0 = u.pn * 256 + wc * 32 + 8 * fq;
#pragma unroll
        for (int bj = 0; bj < 2; ++bj) {
            const f32x4 b0 = *(const f32x4*)(bias + col0 + bj * 128), b1 = *(const f32x4*)(bias + col0 + bj * 128 + 4);
#pragma unroll
            for (int ai = 0; ai < 2; ++ai)
#pragma unroll
                for (int m = 0; m < 4; ++m) { const size_t r = (size_t)(row0 + ai * 128 + m * 16);
                    const v4u yq = *(const v4u*)(Y + r * ldy + col0 + bj * 128); float y[8]; unpack8(yq, y);
                    const f32x4 v0 = acc[ai][bj][m][0] + b0, v1 = acc[ai][bj][m][1] + b1; float o[8];
#pragma unroll
                    for (int k = 0; k < 4; ++k) { o[k] = y[k] * __builtin_amdgcn_rcpf(1.0f + __expf(-v0[k])); o[4 + k] = y[4 + k] * __builtin_amdgcn_rcpf(1.0f + __expf(-v1[k])); }
                    *(v4u*)(O + r * ldo + col0 + bj * 128) = pack8(o); }
        }
    }
};
struct EpiStoreF16 {
    static constexpr bool PERM = true, AFTER_DRAIN = false;
    _Float16* C; int ldc;
    __device__ __forceinline__ void operator()(const f32x4 (&acc)[2][2][4][2], const pg8::Unit& u, int wr, int wc, int fr, int fq) const {
        typedef _Float16 h8 __attribute__((ext_vector_type(8)));
        const int row0 = u.pm * 256 + wr * 64 + fr, col0 = u.pn * 256 + wc * 32 + 8 * fq;
#pragma unroll
        for (int ai = 0; ai < 2; ++ai)
#pragma unroll
            for (int m = 0; m < 4; ++m) { _Float16* rowp = C + (size_t)(row0 + ai * 128 + m * 16) * ldc + col0;
#pragma unroll
                for (int bj = 0; bj < 2; ++bj) { const f32x4 v0 = acc[ai][bj][m][0], v1 = acc[ai][bj][m][1];
                    h8 w; w[0] = (_Float16)v0[0]; w[1] = (_Float16)v0[1]; w[2] = (_Float16)v0[2]; w[3] = (_Float16)v0[3]; w[4] = (_Float16)v1[0]; w[5] = (_Float16)v1[1]; w[6] = (_Float16)v1[2]; w[7] = (_Float16)v1[3];
                    *(h8*)(rowp + bj * 128) = w; } }
    }
};
struct Args { const float* in[26]; float* out; unsigned char* ws; int ph_lo, ph_hi, li, pad; };
struct ArgsDev { const float GAS* in[26]; float GAS* out; unsigned char GAS* ws; int ph_lo, ph_hi, li, pad; };
typedef const ArgsDev __attribute__((address_space(4))) CArgs;
#define GIN(A_, k_) ((const float*)(A_).in[k_])
struct Frame {
    LAS unsigned char* lds;
    int tid, lane, wave, G, bx;
    int gw, NGW;
    size_t gtid, NT;
    float* out; unsigned char* ws;
};
enum InIdx { I_XP = 0, I_XS, I_LNIN_G, I_LNIN_B, I_WIN, I_LAMRE, I_LAMIM, I_LOGSTEP, I_BRE, I_BIM, I_CRE, I_CIM, I_S5D, I_WGLU, I_BGLU, I_POOLW, I_POOLS,
             I_WOUT, I_LN1G, I_LN1B, I_WQ, I_KEYS, I_PU, I_PV, I_LN2G, I_LN2B };

__device__ __forceinline__ void ln_rows2(bf16* XB, const bf16* MIX, float alpha, const float* g, const float* b, int gw, int ngw, int lane) {
    for (int t = gw; t < NTOK; t += 2 * ngw) {
        const int t2 = t + ngw; const bool has2 = t2 < NTOK; const int tb = has2 ? t2 : t;
        f32x4 v0[8], v1[8]; v2u x0q[8], x1q[8], m0q[8], m1q[8]; float s0 = 0.f, s1 = 0.f;
#pragma unroll
        for (int j = 0; j < 8; ++j) { x0q[j] = ((const v2u*)(XB + (size_t)t * DM))[lane + 64 * j]; m0q[j] = ((const v2u*)(MIX + (size_t)t * DM))[lane + 64 * j]; }
#pragma unroll
        for (int j = 0; j < 8; ++j) { x1q[j] = ((const v2u*)(XB + (size_t)tb * DM))[lane + 64 * j]; m1q[j] = ((const v2u*)(MIX + (size_t)tb * DM))[lane + 64 * j]; }
#pragma unroll
        for (int j = 0; j < 8; ++j) {
            v0[j] = (f32x4){bf_lo(x0q[j].x), bf_hi(x0q[j].x), bf_lo(x0q[j].y), bf_hi(x0q[j].y)} * alpha + (f32x4){bf_lo(m0q[j].x), bf_hi(m0q[j].x), bf_lo(m0q[j].y), bf_hi(m0q[j].y)};
            v1[j] = (f32x4){bf_lo(x1q[j].x), bf_hi(x1q[j].x), bf_lo(x1q[j].y), bf_hi(x1q[j].y)} * alpha + (f32x4){bf_lo(m1q[j].x), bf_hi(m1q[j].x), bf_lo(m1q[j].y), bf_hi(m1q[j].y)};
            s0 += (v0[j][0] + v0[j][1]) + (v0[j][2] + v0[j][3]); s1 += (v1[j][0] + v1[j][1]) + (v1[j][2] + v1[j][3]); }
        const float m0 = wave_sum(s0) * (1.0f / DM), m1 = wave_sum(s1) * (1.0f / DM); float q0 = 0.f, q1 = 0.f;
#pragma unroll
        for (int j = 0; j < 8; ++j) { v0[j] = v0[j] - m0; v1[j] = v1[j] - m1;
            q0 += (v0[j][0] * v0[j][0] + v0[j][1] * v0[j][1]) + (v0[j][2] * v0[j][2] + v0[j][3] * v0[j][3]); q1 += (v1[j][0] * v1[j][0] + v1[j][1] * v1[j][1]) + (v1[j][2] * v1[j][2] + v1[j][3] * v1[j][3]); }
        f32x4 gq[8], bq[8];
#pragma unroll
        for (int j = 0; j < 8; ++j) { gq[j] = ((const f32x4*)g)[lane + 64 * j]; bq[j] = ((const f32x4*)b)[lane + 64 * j]; }
        const float rs0 = 1.0f / sqrtf(wave_sum(q0) * (1.0f / DM) + LN_EPS), rs1 = 1.0f / sqrtf(wave_sum(q1) * (1.0f / DM) + LN_EPS);
#pragma unroll
        for (int j = 0; j < 8; ++j) { const f32x4 gg = gq[j], bb = bq[j];
            const f32x4 o0 = v0[j] * rs0 * gg + bb;
            v2u w0; w0.x = pkbf(o0[0], o0[1]); w0.y = pkbf(o0[2], o0[3]); ((v2u*)(XB + (size_t)t * DM))[lane + 64 * j] = w0;
            if (has2) { const f32x4 o1 = v1[j] * rs1 * gg + bb;
                v2u w1; w1.x = pkbf(o1[0], o1[1]); w1.y = pkbf(o1[2], o1[3]); ((v2u*)(XB + (size_t)t2 * DM))[lane + 64 * j] = w1; } }
    }
}

__device__ __forceinline__ void transpose_item(const float* W, int K, int N, bf16* WT, LAS float* scr, int item, int lane) {
    const int nblk = N / 32, kb = item / nblk, nb = item % nblk, k0 = 64 * kb, n0 = 32 * nb;
    float wv[32];
#pragma unroll
    for (int i = 0; i < 32; ++i) { const int kk = 2 * i + (lane >> 5); wv[i] = W[(size_t)(k0 + kk) * N + n0 + (lane & 31)]; }
#pragma unroll
    for (int i = 0; i < 32; ++i) { const int kk = 2 * i + (lane >> 5); scr[kk * 33 + (lane & 31)] = wv[i]; }
    LDS_WAIT();
    const int c = lane & 7;
#pragma unroll
    for (int j = 0; j < 4; ++j) { const int n = (lane >> 3) + 8 * j; const LAS float* s = scr + (8 * c) * 33 + n;
        v4u o; o.x = pkbf(s[0 * 33], s[1 * 33]); o.y = pkbf(s[2 * 33], s[3 * 33]); o.z = pkbf(s[4 * 33], s[5 * 33]); o.w = pkbf(s[6 * 33], s[7 * 33]);
        *(v4u*)(WT + (size_t)(n0 + n) * K + k0 + 8 * c) = o; }
    LDS_WAIT();
}

__device__ __forceinline__ void p0_prologue(const Frame& F, CArgs& A) {
    {
        LAS float* scr = (LAS float*)(F.lds + F.wave * 16384);
        constexpr int I_IN = (DM / 64) * (INW / 32), I_OUT = (DM / 64) * (DM / 32), I_GLU = (512 / 64) * (512 / 32);
        constexpr int NITEMS = NLAYER * (I_IN + I_OUT + I_GLU);
        for (int it = F.gw; it < NITEMS; it += F.NGW) {
            int r = it;
            if (r < NLAYER * I_IN) { const int l = r / I_IN; { const int nb_ = (r % I_IN) % (INW / 32); if (nb_ >= 512 / 32 && nb_ < 1024 / 32) continue; }
                transpose_item(GIN(A, I_WIN) + (size_t)l * DM * INW, DM, INW, (bf16*)(F.ws + WS_WIN) + (size_t)l * INW * DM, scr, r % I_IN, F.lane); continue; }
            r -= NLAYER * I_IN;
            if (r < NLAYER * I_OUT) { const int l = r / I_OUT; transpose_item(GIN(A, I_WOUT) + (size_t)l * DM * DM, DM, DM, (bf16*)(F.ws + WS_WOUT) + (size_t)l * DM * DM, scr, r % I_OUT, F.lane); continue; }
            r -= NLAYER * I_OUT;
            { const int l = r / I_GLU; transpose_item(GIN(A, I_WGLU) + (size_t)l * 512 * 512, 512, 512, (bf16*)(F.ws + WS_WGLU) + (size_t)l * 512 * 512, scr, r % I_GLU, F.lane); }
        }
    }
    {
        const int NR2 = 2 * NLAYER * NEXP;
        for (int r = F.gw; r < NR2; r += 2 * F.NGW) {
            const int r2 = r + F.NGW < NR2 ? r + F.NGW : r;
            const int tabA = r >= NLAYER * NEXP, riA = tabA ? r - NLAYER * NEXP : r, tabB = r2 >= NLAYER * NEXP, riB = tabB ? r2 - NLAYER * NEXP : r2;
            const float* srcA = (tabA ? GIN(A, I_PV) : GIN(A, I_PU)) + (size_t)riA * DM + F.lane * 4; const float* srcB = (tabB ? GIN(A, I_PV) : GIN(A, I_PU)) + (size_t)riB * DM + F.lane * 4;
            f32x4 va[8], vb[8]; float ama = 0.f, amb = 0.f;
#pragma unroll
            for (int q = 0; q < 8; ++q) va[q] = *(const f32x4*)(srcA + q * 256);
#pragma unroll
            for (int q = 0; q < 8; ++q) vb[q] = *(const f32x4*)(srcB + q * 256);
#pragma unroll
            for (int q = 0; q < 8; ++q) { ama = fmaxf(ama, fmaxf(fmaxf(fabsf(va[q][0]), fabsf(va[q][1])), fmaxf(fabsf(va[q][2]), fabsf(va[q][3])))); amb = fmaxf(amb, fmaxf(fmaxf(fabsf(vb[q][0]), fabsf(vb[q][1])), fmaxf(fabsf(vb[q][2]), fabsf(vb[q][3])))); }
#pragma unroll
            for (int o = 1; o < 64; o <<= 1) { ama = fmaxf(ama, __shfl_xor(ama, o)); amb = fmaxf(amb, __shfl_xor(amb, o)); }
#pragma unroll
            for (int half = 0; half < 2; ++half) {
                if (half == 1 && r2 == r) break;
                const float am = half ? amb : ama; const int tab = half ? tabB : tabA, ri = half ? riB : riA;
                const float sc = am > 0.f ? 6.0f / am : 1.0f, isc = am > 0.f ? am * (1.0f / 6.0f) : 1.0f;
                v4u w;
#pragma unroll
                for (int q = 0; q < 4; ++q) { const f32x4 e0 = half ? vb[2 * q] : va[2 * q], e1 = half ? vb[2 * q + 1] : va[2 * q + 1]; unsigned pk = 0u;
                    pk = __builtin_amdgcn_cvt_scalef32_pk_fp4_f32(pk, e0[0] * sc, e0[1] * sc, 1.0f, 0); pk = __builtin_amdgcn_cvt_scalef32_pk_fp4_f32(pk, e0[2] * sc, e0[3] * sc, 1.0f, 1);
                    pk = __builtin_amdgcn_cvt_scalef32_pk_fp4_f32(pk, e1[0] * sc, e1[1] * sc, 1.0f, 2); pk = __builtin_amdgcn_cvt_scalef32_pk_fp4_f32(pk, e1[2] * sc, e1[3] * sc, 1.0f, 3);
                    w[q] = pk; }
                *(v4u*)(F.ws + (tab ? WS_V8 : WS_U8) + (size_t)ri * (DM / 2) + F.lane * 16) = w;
                if (F.lane == 0) ((float*)(F.ws + (tab ? WS_VSC : WS_USC)))[ri] = isc;
            }
        }
    }
    {
        const float* win = GIN(A, I_WIN); const float* pw = GIN(A, I_POOLW); const float* ps = GIN(A, I_POOLS); bf16* wt = (bf16*)(F.ws + WS_WIN);
        for (size_t it = F.gtid; it < (size_t)NLAYER * 512 * 256; it += F.NT) {
            const int n = (int)(it & 511), k8 = (int)((it >> 9) & 255), l = (int)(it >> 17), g = n >> 7, d = n & 127;
            float acc[8];
#pragma unroll
            for (int kk = 0; kk < 8; ++kk) acc[kk] = 0.f;
            const float* wrow = win + ((size_t)l * DM + k8 * 8) * INW + 512 + g * 128; const float* pcol = pw + ((size_t)(l * 4 + g) * 128) * 128 + d;
            for (int c4 = 0; c4 < 32; ++c4) {
                f32x4 wv[8];
#pragma unroll
                for (int kk = 0; kk < 8; ++kk) wv[kk] = *(const f32x4*)(wrow + (size_t)kk * INW + c4 * 4);
#pragma unroll
                for (int e = 0; e < 4; ++e) { const float pv = pcol[(size_t)(c4 * 4 + e) * 128];
#pragma unroll
                    for (int kk = 0; kk < 8; ++kk) acc[kk] += wv[kk][e] * pv; }
            }
            const float sc = ps[l * 512 + n];
#pragma unroll
            for (int kk = 0; kk < 8; ++kk) acc[kk] *= sc;
            *(v4u*)(wt + ((size_t)l * INW + 512 + n) * DM + k8 * 8) = pack8(acc);
        }
    }
    {
        const float* lre = GIN(A, I_LAMRE); const float* lim = GIN(A, I_LAMIM); const float* lst = GIN(A, I_LOGSTEP); const float* bre = GIN(A, I_BRE); const float* bim = GIN(A, I_BIM);
        f32x2v* ab = (f32x2v*)(F.ws + WS_S5A); f32x2v* ab64 = (f32x2v*)(F.ws + WS_S5A + 512 * 1024); f32x2v* bb = (f32x2v*)(F.ws + WS_S5B);
        for (size_t i = F.gtid; i < (size_t)NLAYER * 2 * 32 * 64; i += F.NT) {
            const float lr = lre[i], li = lim[i], dt = expf(lst[i >> 6]);
            const float mag = expf(lr * dt), ar = mag * cosf(li * dt), ai = mag * sinf(li * dt);
            const float den = lr * lr + li * li;
            const float zr = ((ar - 1.0f) * lr + ai * li) / den, zi = (ai * lr - (ar - 1.0f) * li) / den;
            ab[i] = (f32x2v){ar, ai};
            const float m64 = expf(lr * dt * 64.0f), an = li * dt * 64.0f;
            ab64[i] = (f32x2v){m64 * cosf(an), m64 * sinf(an)};
#pragma unroll
            for (int c = 0; c < 16; ++c) { const float br = bre[i * 16 + c], bi = bim[i * 16 + c]; bb[i * 16 + c] = (f32x2v){zr * br - zi * bi, zr * bi + zi * br}; }
            {
                bf16* o = (bf16*)(F.ws + WS_S5BB) + ((size_t)(i >> 6) * 128 + 2 * (i & 63)) * 32;
#pragma unroll
                for (int c = 0; c < 16; ++c) { const float br = bre[i * 16 + c], bi = bim[i * 16 + c]; o[c] = f2bf(zr * br - zi * bi); o[32 + c] = f2bf(zr * bi + zi * br); o[16 + c] = 0; o[48 + c] = 0; }
            }
        }
    }
    {
        float* rc = (float*)(F.ws + WS_ROTC); float* rs = (float*)(F.ws + WS_ROTS);
        for (size_t i = F.gtid; i < (size_t)8192 * 128; i += F.NT) { const float inv = (float)exp(-(double)(i & 127) / 127.0 * 9.210340371976184); const float ang = (float)(i >> 7) * inv; rc[i] = cosf(ang); rs[i] = sinf(ang); }
    }
    __syncthreads();
    {
        LAS float* KS = (LAS float*)F.lds;
        LAS float* WQ = (LAS float*)(F.lds + 128 * 132 * 4);
        const float* keys = GIN(A, I_KEYS); const float* wq = GIN(A, I_WQ); bf16* wst = (bf16*)(F.ws + WS_WS);
        for (int u = F.bx; u < NLAYER * 16 * 32; u += F.G) {
            const int dtl = u & 31, hp = (u >> 5) & 15, l = u >> 9, p = hp & 1;
#pragma unroll
            for (int r = 0; r < 8; ++r) { const int f = F.tid + 512 * r, nk = f >> 5, c4 = f & 31;
                *(LAS f32x4*)(KS + nk * 132 + c4 * 4) = *(const f32x4*)(keys + (((size_t)l * 2 + p) * 128 + nk) * 128 + c4 * 4); }
#pragma unroll
            for (int r = 0; r < 4; ++r) { const int f = F.tid + 512 * r, dd = f >> 5, c4 = f & 31;
                *(LAS f32x4*)(WQ + dd * 132 + c4 * 4) = *(const f32x4*)(wq + ((size_t)l * DM + dtl * 64 + dd) * DM + hp * 128 + c4 * 4); }
            __syncthreads();
            const int nt = F.wave, lr = F.lane & 15, lq = F.lane >> 4;
            f32x4 acc[4];
#pragma unroll
            for (int dt = 0; dt < 4; ++dt) acc[dt] = (f32x4){0.f, 0.f, 0.f, 0.f};
#pragma unroll 4
            for (int ks = 0; ks < 32; ++ks) {
                const float kb = KS[(nt * 16 + lr) * 132 + 4 * ks + lq];
#pragma unroll
                for (int dt = 0; dt < 4; ++dt) { const float wa = WQ[(dt * 16 + lr) * 132 + 4 * ks + lq]; acc[dt] = __builtin_amdgcn_mfma_f32_16x16x4f32(wa, kb, acc[dt], 0, 0, 0); }
            }
            bf16* o = wst + ((size_t)l * DM + hp * 128 + nt * 16 + lr) * DM + dtl * 64 + 4 * lq;
#pragma unroll
            for (int dt = 0; dt < 4; ++dt) { v2u w; w.x = pkbf(acc[dt][0], acc[dt][1]); w.y = pkbf(acc[dt][2], acc[dt][3]); *(v2u*)(o + dt * 16) = w; }
            __syncthreads();
        }
    }
    {
        const float* xp = GIN(A, I_XP); const float* xs = GIN(A, I_XS); const float* g = GIN(A, I_LNIN_G); const float* b = GIN(A, I_LNIN_B); bf16* XB = (bf16*)(F.ws + WS_XN);
        for (int t = F.gw; t < NTOK; t += 2 * F.NGW) {
            const int t2 = t + F.NGW; const bool has2 = t2 < NTOK; const int tb = has2 ? t2 : t;
            const float* s0p = t < 32768 ? xp + (size_t)t * DM : xs + (size_t)(t - 32768) * DM; const float* s1p = tb < 32768 ? xp + (size_t)tb * DM : xs + (size_t)(tb - 32768) * DM;
            f32x4 v0[8], v1[8]; float s0 = 0.f, s1 = 0.f;
#pragma unroll
            for (int j = 0; j < 8; ++j) v0[j] = ((const f32x4*)s0p)[F.lane + 64 * j];
#pragma unroll
            for (int j = 0; j < 8; ++j) v1[j] = ((const f32x4*)s1p)[F.lane + 64 * j];
#pragma unroll
            for (int j = 0; j < 8; ++j) { s0 += (v0[j][0] + v0[j][1]) + (v0[j][2] + v0[j][3]); s1 += (v1[j][0] + v1[j][1]) + (v1[j][2] + v1[j][3]); }
            const float m0 = wave_sum(s0) * (1.0f / DM), m1 = wave_sum(s1) * (1.0f / DM); float q0 = 0.f, q1 = 0.f;
#pragma unroll
            for (int j = 0; j < 8; ++j) { v0[j] = v0[j] - m0; v1[j] = v1[j] - m1;
                q0 += (v0[j][0] * v0[j][0] + v0[j][1] * v0[j][1]) + (v0[j][2] * v0[j][2] + v0[j][3] * v0[j][3]); q1 += (v1[j][0] * v1[j][0] + v1[j][1] * v1[j][1]) + (v1[j][2] * v1[j][2] + v1[j][3] * v1[j][3]); }
            const float rs0 = 1.0f / sqrtf(wave_sum(q0) * (1.0f / DM) + LN_EPS), rs1 = 1.0f / sqrtf(wave_sum(q1) * (1.0f / DM) + LN_EPS);
#pragma unroll
            for (int j = 0; j < 8; ++j) { const f32x4 gg = ((const f32x4*)g)[F.lane + 64 * j], bb = ((const f32x4*)b)[F.lane + 64 * j];
                const f32x4 o0 = v0[j] * rs0 * gg + bb;
                v2u w0; w0.x = pkbf(o0[0], o0[1]); w0.y = pkbf(o0[2], o0[3]); ((v2u*)(XB + (size_t)t * DM))[F.lane + 64 * j] = w0;
                if (has2) { const f32x4 o1 = v1[j] * rs1 * gg + bb;
                    v2u w1; w1.x = pkbf(o1[0], o1[1]); w1.y = pkbf(o1[2], o1[3]); ((v2u*)(XB + (size_t)t2 * DM))[F.lane + 64 * j] = w1; } }
        }
    }
}

__device__ __forceinline__ float ret_log2_gamma(int h) { return log2f(1.0f - exp2f(-5.0f - (float)h)); }

__device__ __forceinline__ void s5_pass1(const Frame& F, CArgs& A, int l) {
    LAS float* BUs = (LAS float*)(F.lds + F.wave * 8448);
    const bf16* H = (const bf16*)(F.ws + WS_H);
    const f32x2v* ab = (const f32x2v*)(F.ws + WS_S5A); const bf16* BB = (const bf16*)(F.ws + WS_S5BB);
    f32x2v* st = (f32x2v*)(F.ws + WS_S5ST);
    const int lane = F.lane, lr = lane & 15, lq = lane >> 4;
    const int gstep = F.G < 32 ? F.G : 32;
    for (int g = F.bx % 32; g < 32; g += gstep) {
        const int nwg = F.G < 32 ? 1 : (F.G - g + 31) / 32, rank = F.G < 32 ? 0 : F.bx / 32;
        bf16x8 Bop[2][8]; f32x2v a2[2], arot[2];
#pragma unroll
        for (int dir = 0; dir < 2; ++dir) { const int gi = (l * 2 + dir) * 32 + g; a2[dir] = ab[gi * 64 + lane]; arot[dir] = (f32x2v){-a2[dir][1], a2[dir][1]};
#pragma unroll
            for (int j = 0; j < 8; ++j) Bop[dir][j] = *(const bf16x8*)(BB + ((size_t)gi * 128 + 16 * j + lr) * 32 + lq * 8); }
        const int ck1 = rank * NWAVES + F.wave, ckst = nwg * NWAVES;
        v4u unx[4];
#pragma unroll
        for (int tb = 0; tb < 4; ++tb) unx[tb] = (lq < 2 && ck1 < 640) ? *(const v4u*)(H + (size_t)(ck1 * 64 + 16 * tb + lr) * INW + COL_UA + g * 16 + lq * 8) : (v4u){0u, 0u, 0u, 0u};
        for (int ck = ck1; ck < 640; ck += ckst) {
            bf16x8 uop[4];
#pragma unroll
            for (int tb = 0; tb < 4; ++tb) uop[tb] = __builtin_bit_cast(bf16x8, unx[tb]);
            { const int cn = ck + ckst < 640 ? ck + ckst : ck;
#pragma unroll
              for (int tb = 0; tb < 4; ++tb) unx[tb] = lq < 2 ? *(const v4u*)(H + (size_t)(cn * 64 + 16 * tb + lr) * INW + COL_UA + g * 16 + lq * 8) : (v4u){0u, 0u, 0u, 0u}; }
#pragma unroll
            for (int dir = 0; dir < 2; ++dir) {
                f32x2v x2 = (f32x2v){0.f, 0.f};
#pragma unroll
                for (int blk = 0; blk < 4; ++blk) {
                    const int tb = dir ? 3 - blk : blk;
#pragma unroll
                    for (int j = 0; j < 8; ++j) { const f32x4 d = MFMA16(Bop[dir][j], uop[tb], ((f32x4){0.f, 0.f, 0.f, 0.f}));
                        *(LAS f32x4*)(BUs + lr * 132 + 16 * j + 4 * lq) = d; }
                    LDS_WAIT();
#pragma unroll
                    for (int s = 0; s < 16; ++s) { const int tl = dir ? 15 - s : s;
                        const f32x2v bu = *(const LAS f32x2v*)(BUs + tl * 132 + 2 * lane);
                        x2 = x2 * a2[dir][0] + (arot[dir] * (f32x2v){x2[1], x2[0]} + bu); }
                    LDS_WAIT();
                }
                st[(size_t)((ck * 32 + g) * 2 + dir) * 64 + lane] = x2;
            }
        }
    }
}
__device__ __forceinline__ void s5_carry(const Frame& F, CArgs& A, int l) {
    const f32x2v* ab64 = (const f32x2v*)(F.ws + WS_S5A + 512 * 1024); f32x2v* st = (f32x2v*)(F.ws + WS_S5ST);
    for (size_t it = F.gtid; it < (size_t)9 * 32 * 2 * 64; it += F.NT) {
        const int p = (int)(it & 63), dir = (int)((it >> 6) & 1), g = (int)((it >> 7) & 31), s = (int)(it >> 12);
        const int ck0 = s < 8 ? s * 64 : 512, n = s < 8 ? 64 : 128;
        const f32x2v a = ab64[((l * 2 + dir) * 32 + g) * 64 + p];
        float cr = 0.f, ci = 0.f;
        for (int k0 = 0; k0 < n; k0 += 8) {
            f32x2v le[8];
#pragma unroll
            for (int kk = 0; kk < 8; ++kk) { const int ck = dir ? (ck0 + n - 1 - (k0 + kk)) : (ck0 + k0 + kk); le[kk] = st[(size_t)((ck * 32 + g) * 2 + dir) * 64 + p]; }
#pragma unroll
            for (int kk = 0; kk < 8; ++kk) { const int ck = dir ? (ck0 + n - 1 - (k0 + kk)) : (ck0 + k0 + kk);
                st[(size_t)((ck * 32 + g) * 2 + dir) * 64 + p] = (f32x2v){cr, ci};
                const float ncr = a[0] * cr - a[1] * ci + le[kk][0], nci = a[0] * ci + a[1] * cr + le[kk][1]; cr = ncr; ci = nci; }
        }
    }
}
__device__ __forceinline__ void s5_pass3(const Frame& F, CArgs& A, int l) {
    LAS bf16* CtS = (LAS bf16*)F.lds;
    LAS unsigned char* wb = F.lds + 8704 + F.wave * 12800;
    LAS float* BUs = (LAS float*)wb;
    LAS bf16* Xw = (LAS bf16*)(wb + 8448);
    const bf16* H = (const bf16*)(F.ws + WS_H); bf16* BY = (bf16*)(F.ws + WS_BUFY);
    const f32x2v* ab = (const f32x2v*)(F.ws + WS_S5A); const bf16* BB = (const bf16*)(F.ws + WS_S5BB);
    const f32x2v* st = (const f32x2v*)(F.ws + WS_S5ST);
    const float* cre = GIN(A, I_CRE); const float* cim = GIN(A, I_CIM); const float* dvec = GIN(A, I_S5D) + (size_t)l * 512;
    const int lane = F.lane, lr = lane & 15, lq = lane >> 4;
    const int gstep = F.G < 32 ? F.G : 32;
    for (int g = F.bx % 32; g < 32; g += gstep) {
        const int nwg = F.G < 32 ? 1 : (F.G - g + 31) / 32, rank = F.G < 32 ? 0 : F.bx / 32;
        __syncthreads();
        {
            const int tq = opaque(F.tid);
#pragma unroll
            for (int r = 0; r < 8; ++r) { const int e = tq + 512 * r, pp = e & 127, c = (e >> 7) & 15, dir = e >> 11;
                const size_t cb = (size_t)(((l * 2 + dir) * 32 + g) * 16 + c) * 64;
                CtS[(dir * 16 + c) * 136 + pp] = f2bf((pp & 1) ? -cim[cb + (pp >> 1)] : cre[cb + (pp >> 1)]); }
        }
        bf16x8 Bop[2][8]; f32x2v a2[2], arot[2];
#pragma unroll
        for (int dir = 0; dir < 2; ++dir) { const int gi = (l * 2 + dir) * 32 + g; a2[dir] = ab[gi * 64 + lane]; arot[dir] = (f32x2v){-a2[dir][1], a2[dir][1]};
#pragma unroll
            for (int j = 0; j < 8; ++j) Bop[dir][j] = *(const bf16x8*)(BB + ((size_t)gi * 128 + 16 * j + lr) * 32 + lq * 8); }
        __syncthreads();
        const int ck1 = rank * NWAVES + F.wave, ckst = nwg * NWAVES;
        const f32x4 dv4 = *(const f32x4*)(dvec + g * 16 + 4 * lq);
        v4u unx[4]; v2u uqn[4]; f32x2v xinn[2];
        { const int c1 = ck1 < 640 ? ck1 : 0;
#pragma unroll
          for (int tb = 0; tb < 4; ++tb) unx[tb] = lq < 2 ? *(const v4u*)(H + (size_t)(c1 * 64 + 16 * tb + lr) * INW + COL_UA + g * 16 + lq * 8) : (v4u){0u, 0u, 0u, 0u};
#pragma unroll
          for (int dir = 0; dir < 2; ++dir) xinn[dir] = st[(size_t)((c1 * 32 + g) * 2 + dir) * 64 + lane];
#pragma unroll
          for (int m = 0; m < 4; ++m) uqn[m] = *(const v2u*)(H + (size_t)(c1 * 64 + 16 * m + lr) * INW + COL_UA + g * 16 + 4 * lq); }
        for (int ck = ck1; ck < 640; ck += ckst) {
            bf16x8 uop[4]; f32x2v xin[2]; v2u uq4[4];
#pragma unroll
            for (int tb = 0; tb < 4; ++tb) uop[tb] = __builtin_bit_cast(bf16x8, unx[tb]);
#pragma unroll
            for (int dir = 0; dir < 2; ++dir) xin[dir] = xinn[dir];
#pragma unroll
            for (int m = 0; m < 4; ++m) uq4[m] = uqn[m];
            { const int cn = ck + ckst < 640 ? ck + ckst : ck;
#pragma unroll
              for (int tb = 0; tb < 4; ++tb) unx[tb] = lq < 2 ? *(const v4u*)(H + (size_t)(cn * 64 + 16 * tb + lr) * INW + COL_UA + g * 16 + lq * 8) : (v4u){0u, 0u, 0u, 0u};
#pragma unroll
              for (int dir = 0; dir < 2; ++dir) xinn[dir] = st[(size_t)((cn * 32 + g) * 2 + dir) * 64 + lane];
#pragma unroll
              for (int m = 0; m < 4; ++m) uqn[m] = *(const v2u*)(H + (size_t)(cn * 64 + 16 * m + lr) * INW + COL_UA + g * 16 + 4 * lq); }
            f32x4 Y[4];
#pragma unroll
            for (int m = 0; m < 4; ++m) Y[m] = (f32x4){0.f, 0.f, 0.f, 0.f};
#pragma unroll
            for (int dir = 0; dir < 2; ++dir) {
                f32x2v x2 = xin[dir];
#pragma unroll
                for (int blk = 0; blk < 4; ++blk) {
                    const int tb = dir ? 3 - blk : blk;
#pragma unroll
                    for (int j = 0; j < 8; ++j) { const f32x4 d = MFMA16(Bop[dir][j], uop[tb], ((f32x4){0.f, 0.f, 0.f, 0.f}));
                        *(LAS f32x4*)(BUs + lr * 132 + 16 * j + 4 * lq) = d; }
                    LDS_WAIT();
#pragma unroll
                    for (int s = 0; s < 16; ++s) { const int tl = dir ? 15 - s : s;
                        const f32x2v bu = *(const LAS f32x2v*)(BUs + tl * 132 + 2 * lane);
                        x2 = x2 * a2[dir][0] + (arot[dir] * (f32x2v){x2[1], x2[0]} + bu);
                        *(LAS unsigned*)(Xw + tl * 136 + 2 * lane) = pkbf(x2[0], x2[1]); }
                    LDS_WAIT();
#pragma unroll
                    for (int ks = 0; ks < 4; ++ks) {
                        const bf16x8 av = *(const LAS bf16x8*)(CtS + (dir * 16 + lr) * 136 + 32 * ks + lq * 8);
                        const bf16x8 bv = *(const LAS bf16x8*)(Xw + lr * 136 + 32 * ks + lq * 8);
                        Y[tb] = MFMA16(av, bv, Y[tb]);
                    }
                    LDS_WAIT();
                }
            }
#pragma unroll
            for (int m = 0; m < 4; ++m) {
                const int t = 16 * m + lr, c0 = 4 * lq;
                const v2u uq = uq4[m];
                const f32x4 uv = (f32x4){bf_lo(uq.x), bf_hi(uq.x), bf_lo(uq.y), bf_hi(uq.y)}; const f32x4 dv = dv4;
                const f32x4 y = Y[m] + dv * uv;
                v2u w; w.x = pkbf(gelu_erf(y[0]), gelu_erf(y[1])); w.y = pkbf(gelu_erf(y[2]), gelu_erf(y[3]));
                *(v2u*)(BY + (size_t)(ck * 64 + t) * 512 + g * 16 + c0) = w;
            }
        }
    }
}
__device__ __forceinline__ void pool_phase(const Frame& F, CArgs& A) {
    const bf16* H = (const bf16*)(F.ws + WS_H); bf16* CCp = (bf16*)(F.ws + WS_CONCAT) + 512;
    for (size_t it = F.gtid; it < (size_t)(NTOK / 8) * 64; it += F.NT) {
        const int r = (int)(it >> 6), o = (int)(it & 63), gi = o >> 4, half = 1 << gi;
        const int t0 = r * 8, pos0 = tok_pos(t0), L = tok_len(t0);
        const bf16* base = H + (size_t)(t0 - pos0) * INW + COL_UB + o * 8;
        v4u wq[23];
#pragma unroll
        for (int sl = 0; sl < 23; ++sl) { const int q = pos0 - 8 + sl; const int qc = q < 0 ? 0 : (q > L - 1 ? L - 1 : q); wq[sl] = *(const v4u*)(base + (size_t)qc * INW); }
#pragma unroll
        for (int i = 0; i < 8; ++i) {
            const int pos = pos0 + i;
            const int lo = max(pos - half, 0), hi = min(pos + half - 1, L - 1);
            float s[8];
#pragma unroll
            for (int k = 0; k < 8; ++k) s[k] = 0.f;
#pragma unroll
            for (int k = 0; k < 16; ++k) { const int q = pos - 8 + k; float f[8]; unpack8(wq[i + k], f); const float wgt = (q >= lo && q <= hi) ? 1.0f : 0.0f;
#pragma unroll
                for (int c = 0; c < 8; ++c) s[c] += wgt * f[c]; }
            const float inv = 1.0f / (float)(hi - lo + 1);
            float c[8]; unpack8(wq[8 + i], c);
#pragma unroll
            for (int k = 0; k < 8; ++k) s[k] = s[k] * inv - c[k];
            *(v4u*)(CCp + (size_t)(t0 + i) * DM + o * 8) = pack8(s);
        }
    }
}
constexpr int RS = 136;
template <int MODE = 0> __device__ __forceinline__ void ret_state_phase(const Frame& F, CArgs& A, unsigned* ctr = nullptr) {
    const bf16* H = (const bf16*)(F.ws + WS_H); bf16* STF = (bf16*)(F.ws + WS_STF); bf16* STB = (bf16*)(F.ws + WS_STB);
    LAS bf16* Kt = (LAS bf16*)F.lds; LAS bf16* VtF = Kt + 128 * RS; LAS bf16* VtB = Kt + 256 * RS;
    LAS unsigned* Kt32 = (LAS unsigned*)Kt; LAS unsigned* VtF32 = (LAS unsigned*)VtF; LAS unsigned* VtB32 = (LAS unsigned*)VtB;
    const int tid = F.tid, lane = F.lane, lr = lane & 15, lq = lane >> 4, we = F.wave >> 1, wd = F.wave & 1;
    const int jp = tid & 63, j = 2 * jp, pc0 = tid >> 6;
    v4u pk0[2], pk1[2], pv0[2], pv1[2];
#define RS_LOAD(u_) do { const int dh_ = (u_) & 1, eh_ = ((u_) >> 1) & 1, h_ = ((u_) >> 2) & 3, c_ = (u_) >> 4; \
        const bf16* krow_ = H + (size_t)(c_ * 128 + j) * INW + COL_K + h_ * 256 + dh_ * 128; const bf16* vrow_ = H + (size_t)(c_ * 128 + j) * INW + COL_V + h_ * 256 + eh_ * 128; \
        _Pragma("unroll") for (int r = 0; r < 2; ++r) { const int pc = pc0 + 8 * r; pk0[r] = *(const v4u*)(krow_ + pc * 8); pk1[r] = *(const v4u*)(krow_ + INW + pc * 8); pv0[r] = *(const v4u*)(vrow_ + pc * 8); pv1[r] = *(const v4u*)(vrow_ + INW + pc * 8); } } while (0)
    if (F.bx < 5120) RS_LOAD(F.bx);
    volatile LAS int* NXT = (volatile LAS int*)(F.lds + LDS_MISC) + 16;
    int un = F.bx + F.G, pend = 0;
    if (ctr && tid == 0) pend = 2 * F.G + (int)__hip_atomic_fetch_add(ctr, 1u, __ATOMIC_RELAXED, __HIP_MEMORY_SCOPE_AGENT);
    for (int u = F.bx; u < 5120;) {
        const int dh = u & 1, eh = (u >> 1) & 1, h = (u >> 2) & 3, c = u >> 4;
        if (MODE != 2) {
            const float lg = ret_log2_gamma(h), fF0 = exp2f(lg * (float)(127 - j)), fF1 = exp2f(lg * (float)(126 - j)), fB0 = exp2f(lg * (float)j), fB1 = exp2f(lg * (float)(j + 1));
#pragma unroll
            for (int r = 0; r < 2; ++r) {
                const int pc = pc0 + 8 * r;
                const unsigned ka0[4] = {pk0[r].x, pk0[r].y, pk0[r].z, pk0[r].w}, ka1[4] = {pk1[r].x, pk1[r].y, pk1[r].z, pk1[r].w};
                float f0[8], f1[8]; unpack8(pv0[r], f0); unpack8(pv1[r], f1);
#pragma unroll
                for (int i = 0; i < 8; ++i) {
                    const unsigned a = ka0[i >> 1], b = ka1[i >> 1];
                    const unsigned kk = (i & 1) ? ((a >> 16) | (b & 0xffff0000u)) : ((a & 0xffffu) | (b << 16));
                    const int o = ((pc * 8 + i) * RS) / 2 + jp;
                    Kt32[o] = kk; VtF32[o] = pkbf(f0[i] * fF0, f1[i] * fF1); VtB32[o] = pkbf(f0[i] * fB0, f1[i] * fB1);
                }
            }
        }
        if (ctr && tid == 0) { NXT[0] = pend; pend = 2 * F.G + (int)__hip_atomic_fetch_add(ctr, 1u, __ATOMIC_RELAXED, __HIP_MEMORY_SCOPE_AGENT); }
        __syncthreads();
        const int unn = ctr ? NXT[0] : un + F.G;
        if (un < 5120) RS_LOAD(un);
        if (MODE == 1) { __syncthreads(); u = un; un = unn; continue; }
        f32x4 aF[4][2], aB[4][2];
#pragma unroll
        for (int td = 0; td < 4; ++td)
#pragma unroll
            for (int te = 0; te < 2; ++te) { aF[td][te] = (f32x4){0.f, 0.f, 0.f, 0.f}; aB[td][te] = (f32x4){0.f, 0.f, 0.f, 0.f}; }
#pragma unroll
        for (int ks = 0; ks < 4; ++ks) {
            bf16x8 ka[4], vF[2], vB[2];
#pragma unroll
            for (int td = 0; td < 4; ++td) ka[td] = *(const LAS bf16x8*)(Kt + (64 * wd + 16 * td + lr) * RS + 32 * ks + lq * 8);
#pragma unroll
            for (int te = 0; te < 2; ++te) { vF[te] = *(const LAS bf16x8*)(VtF + (32 * we + 16 * te + lr) * RS + 32 * ks + lq * 8); vB[te] = *(const LAS bf16x8*)(VtB + (32 * we + 16 * te + lr) * RS + 32 * ks + lq * 8); }
#pragma unroll
            for (int td = 0; td < 4; ++td)
#pragma unroll
                for (int te = 0; te < 2; ++te) { aF[td][te] = MFMA16(ka[td], vF[te], aF[td][te]); aB[td][te] = MFMA16(ka[td], vB[te], aB[td][te]); }
        }
        __syncthreads();
        {
            LAS bf16* OutF = Kt; LAS bf16* OutB = Kt + 128 * RS;
#pragma unroll
            for (int td = 0; td < 4; ++td)
#pragma unroll
                for (int te = 0; te < 2; ++te) {
                    const int e = 32 * we + 16 * te + lr, d = 64 * wd + 16 * td + 4 * lq;
                    v2u w; w.x = pkbf(aF[td][te][0], aF[td][te][1]); w.y = pkbf(aF[td][te][2], aF[td][te][3]); *(LAS v2u*)(OutF + e * RS + d) = w;
                    v2u x; x.x = pkbf(aB[td][te][0], aB[td][te][1]); x.y = pkbf(aB[td][te][2], aB[td][te][3]); *(LAS v2u*)(OutB + e * RS + d) = x;
                }
            __syncthreads();
            const int tq = opaque(tid);
#pragma unroll
            for (int r = 0; r < 8; ++r) { const int f = tq + 512 * r, mat = f >> 11, row = (f >> 4) & 127, pc = f & 15;
                const v4u q = *(const LAS v4u*)(Kt + (mat * 128 + row) * RS + pc * 8);
                bf16* dst = (mat ? STB : STF) + ((size_t)(c * 4 + h) * 256 + eh * 128 + row) * 256 + dh * 128 + pc * 8;
                *(v4u*)dst = q; }
        }
        __syncthreads();
        u = un; un = unn;
    }
#undef RS_LOAD
}
__device__ __forceinline__ void ret_prefix_phase(const Frame& F, CArgs& A) {
    bf16* STF = (bf16*)(F.ws + WS_STF); bf16* STB = (bf16*)(F.ws + WS_STB);
    for (size_t it = F.gtid; it < (size_t)36 * 2 * 8192; it += F.NT) {
        const int o = (int)(it & 8191), which = (int)((it >> 13) & 1), bh = (int)(it >> 14), h = bh & 3, s = bh >> 2;
        const int c0 = s < 8 ? s * 32 : 256, n = s < 8 ? 32 : 64;
        const float dec = exp2f(128.0f * ret_log2_gamma(h));
        float st[8];
#pragma unroll
        for (int k = 0; k < 8; ++k) st[k] = 0.f;
        bf16* base = (which ? STB : STF) + (size_t)h * 65536 + (size_t)o * 8;
        for (int k0 = 0; k0 < n; k0 += 8) {
            v4u q[8];
#pragma unroll
            for (int kk = 0; kk < 8; ++kk) { const int c = which ? (c0 + n - 1 - (k0 + kk)) : (c0 + k0 + kk); q[kk] = *(const v4u*)(base + (size_t)c * 4 * 65536); }
#pragma unroll
            for (int kk = 0; kk < 8; ++kk) { const int c = which ? (c0 + n - 1 - (k0 + kk)) : (c0 + k0 + kk);
                float f[8]; unpack8(q[kk], f);
#pragma unroll
                for (int i = 0; i < 8; ++i) st[i] = dec * st[i] + f[i];
                *(v4u*)(base + (size_t)c * 4 * 65536) = pack8(st); }
        }
    }
}
__device__ __forceinline__ void ret_out_phase(const Frame& F, CArgs& A) {
    const bf16* H = (const bf16*)(F.ws + WS_H); const bf16* STF = (const bf16*)(F.ws + WS_STF); const bf16* STB = (const bf16*)(F.ws + WS_STB);
    bf16* CC = (bf16*)(F.ws + WS_CONCAT);
    LAS bf16* RA = (LAS bf16*)F.lds; LAS bf16* RB = RA + 128 * RS; LAS bf16* RC = RA + 384 * RS;
    const int tid = F.tid, wi = F.wave >> 2, wj = F.wave & 3, we = F.wave & 3;
    for (int u = F.bx; u < 1280; u += F.G) {
        const int lane = opaque(F.lane), lr = lane & 15, lq = lane >> 4;
        const int h = u & 3, c = u >> 2, t0 = c * 128;
        const int cs = c < 256 ? (c & 31) : (c - 256), ncs = c < 256 ? 32 : 64;
        const bool has_f = cs > 0, has_b = cs < ncs - 1;
        const float lg = ret_log2_gamma(h);
        const int tq = opaque(tid);
        v4u pa[4], pb[8];
#define RO_LOAD_QK(dh_) do { _Pragma("unroll") for (int r = 0; r < 4; ++r) { const int f = tq + 512 * r, row = f >> 4, pc = f & 15; \
            const bf16* src = H + (size_t)(t0 + row) * INW + h * 256 + (dh_) * 128 + pc * 8; pa[r] = *(const v4u*)(src + COL_Q); pb[r] = *(const v4u*)(src + COL_K); } } while (0)
#define RO_STORE_QK() do { _Pragma("unroll") for (int r = 0; r < 4; ++r) { const int f = tq + 512 * r, row = f >> 4, pc = f & 15; \
            *(LAS v4u*)(RA + row * RS + pc * 8) = pa[r]; *(LAS v4u*)(RB + row * RS + pc * 8) = pb[r]; } } while (0)
#define RO_LOAD_V() do { const int jp_ = tq & 63, pc0_ = tq >> 6; const bf16* vrow = H + (size_t)(t0 + 2 * jp_) * INW + COL_V + h * 256; \
            _Pragma("unroll") for (int r = 0; r < 4; ++r) { const int pc = pc0_ + 8 * r; pb[r] = *(const v4u*)(vrow + pc * 8); pb[4 + r] = *(const v4u*)(vrow + INW + pc * 8); } } while (0)
#define RO_STORE_V() do { const int jp_ = tq & 63, pc0_ = tq >> 6; LAS unsigned* RB32 = (LAS unsigned*)RB; \
            _Pragma("unroll") for (int r = 0; r < 4; ++r) { const int pc = pc0_ + 8 * r; \
                const unsigned va0[4] = {pb[r].x, pb[r].y, pb[r].z, pb[r].w}, va1[4] = {pb[4 + r].x, pb[4 + r].y, pb[4 + r].z, pb[4 + r].w}; \
                _Pragma("unroll") for (int i = 0; i < 8; ++i) { const unsigned a = va0[i >> 1], b = va1[i >> 1]; \
                    RB32[((pc * 8 + i) * RS) / 2 + jp_] = (i & 1) ? ((a >> 16) | (b & 0xffff0000u)) : ((a & 0xffffu) | (b << 16)); } } } while (0)
#define RO_LOAD_I(dir_, dh_) do { const bool has_ = (dir_) == 0 ? has_f : has_b; const int cn_ = (dir_) == 0 ? c - 1 : c + 1; \
            const bf16* St = ((dir_) == 0 ? STF : STB) + (size_t)((has_ ? cn_ : c) * 4 + h) * 65536; \
            _Pragma("unroll") for (int r = 0; r < 8; ++r) { const int f = tq + 512 * r, row = f >> 4, pc = f & 15; pb[r] = has_ ? *(const v4u*)(St + (size_t)row * 256 + (dh_) * 128 + pc * 8) : (v4u){0u, 0u, 0u, 0u}; } } while (0)
#define RO_STORE_I(dir_, dh_) do { \
            _Pragma("unroll") for (int r = 0; r < 4; ++r) { const int f = tq + 512 * r, row = f >> 4, pc = f & 15; pa[r] = *(const v4u*)(H + (size_t)(t0 + row) * INW + COL_Q + h * 256 + (dh_) * 128 + pc * 8); } \
            _Pragma("unroll") for (int r = 0; r < 4; ++r) { const int f = tq + 512 * r, row = f >> 4, pc = f & 15; \
                const float fac = exp2f(lg * ((dir_) == 0 ? (float)(row + 1) : (float)(128 - row))); float qf[8]; unpack8(pa[r], qf); \
                _Pragma("unroll") for (int k = 0; k < 8; ++k) qf[k] *= fac; \
                *(LAS v4u*)(RA + row * RS + pc * 8) = pack8(qf); } \
            _Pragma("unroll") for (int r = 0; r < 8; ++r) { const int f = tq + 512 * r, row = f >> 4, pc = f & 15; *(LAS v4u*)(RB + row * RS + pc * 8) = pb[r]; } } while (0)
        f32x4 S[4][2];
#pragma unroll
        for (int ti = 0; ti < 4; ++ti)
#pragma unroll
            for (int tj = 0; tj < 2; ++tj) S[ti][tj] = (f32x4){0.f, 0.f, 0.f, 0.f};
        RO_LOAD_QK(0);
#pragma unroll
        for (int dh = 0; dh < 2; ++dh) {
            if (dh) __syncthreads();
            RO_STORE_QK();
            __syncthreads();
            if (dh == 0) RO_LOAD_QK(1); else RO_LOAD_V();
#pragma unroll
            for (int ks = 0; ks < 4; ++ks) {
                bf16x8 ka[2], qb[4];
#pragma unroll
                for (int tj = 0; tj < 2; ++tj) ka[tj] = *(const LAS bf16x8*)(RB + (32 * wj + 16 * tj + lr) * RS + 32 * ks + lq * 8);
#pragma unroll
                for (int ti = 0; ti < 4; ++ti) qb[ti] = *(const LAS bf16x8*)(RA + (64 * wi + 16 * ti + lr) * RS + 32 * ks + lq * 8);
#pragma unroll
                for (int ti = 0; ti < 4; ++ti)
#pragma unroll
                    for (int tj = 0; tj < 2; ++tj) S[ti][tj] = MFMA16(ka[tj], qb[ti], S[ti][tj]);
            }
        }
#pragma unroll
        for (int ti = 0; ti < 4; ++ti)
#pragma unroll
            for (int tj = 0; tj < 2; ++tj) {
                const int i = 64 * wi + 16 * ti + lr, j0 = 32 * wj + 16 * tj + 4 * lq; float p[4];
#pragma unroll
                for (int jj = 0; jj < 4; ++jj) { const int d = i - (j0 + jj); p[jj] = S[ti][tj][jj] * exp2f(lg * (float)(d < 0 ? -d : d)); }
                v2u w; w.x = pkbf(p[0], p[1]); w.y = pkbf(p[2], p[3]); *(LAS v2u*)(RC + i * RS + j0) = w;
            }
        __syncthreads();
        RO_STORE_V();
        __syncthreads();
        RO_LOAD_I(0, 0);
        f32x4 O[4][4];
#pragma unroll
        for (int ti = 0; ti < 4; ++ti)
#pragma unroll
            for (int te = 0; te < 4; ++te) O[ti][te] = (f32x4){0.f, 0.f, 0.f, 0.f};
#pragma unroll
        for (int ks = 0; ks < 4; ++ks) {
            bf16x8 va[4], pbf[4];
#pragma unroll
            for (int te = 0; te < 4; ++te) va[te] = *(const LAS bf16x8*)(RB + (64 * we + 16 * te + lr) * RS + 32 * ks + lq * 8);
#pragma unroll
            for (int ti = 0; ti < 4; ++ti) pbf[ti] = *(const LAS bf16x8*)(RC + (64 * wi + 16 * ti + lr) * RS + 32 * ks + lq * 8);
#pragma unroll
            for (int ti = 0; ti < 4; ++ti)
#pragma unroll
                for (int te = 0; te < 4; ++te) O[ti][te] = MFMA16(va[te], pbf[ti], O[ti][te]);
        }
#pragma unroll
        for (int stg = 0; stg < 4; ++stg) {
            __syncthreads();
            if (stg == 0) RO_STORE_I(0, 0); else if (stg == 1) RO_STORE_I(0, 1); else if (stg == 2) RO_STORE_I(1, 0); else RO_STORE_I(1, 1);
            __syncthreads();
            if (stg == 0) RO_LOAD_I(0, 1); else if (stg == 1) RO_LOAD_I(1, 0); else if (stg == 2) RO_LOAD_I(1, 1);
#pragma unroll
            for (int ks = 0; ks < 4; ++ks) {
                bf16x8 sa[4], qb[4];
#pragma unroll
                for (int te = 0; te < 4; ++te) sa[te] = *(const LAS bf16x8*)(RB + (64 * we + 16 * te + lr) * RS + 32 * ks + lq * 8);
#pragma unroll
                for (int ti = 0; ti < 4; ++ti) qb[ti] = *(const LAS bf16x8*)(RA + (64 * wi + 16 * ti + lr) * RS + 32 * ks + lq * 8);
#pragma unroll
                for (int ti = 0; ti < 4; ++ti)
#pragma unroll
                    for (int te = 0; te < 4; ++te) O[ti][te] = MFMA16(sa[te], qb[ti], O[ti][te]);
            }
        }
#undef RO_LOAD_QK
#undef RO_STORE_QK
#undef RO_LOAD_V
#undef RO_STORE_V
#undef RO_LOAD_I
#undef RO_STORE_I
        __syncthreads();
        v4u gq[8];
        { const int tq3 = opaque(tid);
#pragma unroll
          for (int r = 0; r < 8; ++r) { const int f = tq3 + 512 * r, row = f >> 5, pc = f & 31; gq[r] = *(const v4u*)(H + (size_t)(t0 + row) * INW + COL_G + h * 256 + pc * 8); } }
        LAS float* RED = (LAS float*)RA;
#pragma unroll
        for (int ti = 0; ti < 4; ++ti) { float s1 = 0.f, s2 = 0.f;
#pragma unroll
            for (int te = 0; te < 4; ++te)
#pragma unroll
                for (int jj = 0; jj < 4; ++jj) { const float v = O[ti][te][jj]; s1 += v; s2 += v * v; }
            s1 += __shfl_xor(s1, 16); s1 += __shfl_xor(s1, 32); s2 += __shfl_xor(s2, 16); s2 += __shfl_xor(s2, 32);
            if (lq == 0) { RED[((64 * wi + 16 * ti + lr) * 4 + we) * 2] = s1; RED[((64 * wi + 16 * ti + lr) * 4 + we) * 2 + 1] = s2; } }
        __syncthreads();
        LAS bf16* ON = RB;
#pragma unroll
        for (int ti = 0; ti < 4; ++ti) { const int i = 64 * wi + 16 * ti + lr;
            const f32x4 r0 = *(const LAS f32x4*)(RED + i * 8), r1 = *(const LAS f32x4*)(RED + i * 8 + 4);
            const float m = (r0[0] + r0[2] + r1[0] + r1[2]) * (1.0f / 256.0f), q = (r0[1] + r0[3] + r1[1] + r1[3]) * (1.0f / 256.0f);
            const float var = fmaxf(q - m * m, 0.f), rstd = 1.0f / sqrtf(var + GN_EPS);
#pragma unroll
            for (int te = 0; te < 4; ++te) { const int e0 = 64 * we + 16 * te + 4 * lq;
                v2u w; w.x = pkbf((O[ti][te][0] - m) * rstd, (O[ti][te][1] - m) * rstd); w.y = pkbf((O[ti][te][2] - m) * rstd, (O[ti][te][3] - m) * rstd);
                *(LAS v2u*)(ON + i * 264 + e0) = w; } }
        __syncthreads();
        {
            const int tq2 = opaque(tid);
#pragma unroll
            for (int r = 0; r < 8; ++r) { const int f = tq2 + 512 * r, row = f >> 5, pc = f & 31;
                float ov[8], gv[8]; unpack8(*(const LAS v4u*)(ON + row * 264 + pc * 8), ov); unpack8(gq[r], gv);
#pragma unroll
                for (int k = 0; k < 8; ++k) ov[k] = (gv[k] * __builtin_amdgcn_rcpf(1.0f + __expf(-gv[k]))) * ov[k];
                *(v4u*)(CC + (size_t)(t0 + row) * DM + 1024 + h * 256 + pc * 8) = pack8(ov); }
        }
        __syncthreads();
    }
}

__device__ __forceinline__ unsigned f2key(float f) { const unsigned u = __float_as_uint(f); return (u & 0x80000000u) ? ~u : (u | 0x80000000u); }
__device__ __forceinline__ float key2f(unsigned k) { const unsigned u = (k & 0x80000000u) ? (k & 0x7fffffffu) : ~k; return __uint_as_float(u); }
#define TK_CE(a, b) do { const unsigned hi_ = (a) > (b) ? (a) : (b), lo_ = (a) > (b) ? (b) : (a); (a) = hi_; (b) = lo_; } while (0)
__device__ __forceinline__ void bitonic_merge16(unsigned (&v)[16]) {
#pragma unroll
    for (int j = 8; j > 0; j >>= 1)
#pragma unroll
        for (int i = 0; i < 16; ++i) { const int l = i ^ j; if (l > i) TK_CE(v[i], v[l]); }
}
__device__ __forceinline__ void bitonic_sort16(unsigned (&v)[16]) {
#pragma unroll
    for (int k = 2; k <= 16; k <<= 1)
#pragma unroll
        for (int j = k >> 1; j > 0; j >>= 1)
#pragma unroll
            for (int i = 0; i < 16; ++i) { const int l = i ^ j; if (l > i) { if ((i & k) == 0) TK_CE(v[i], v[l]); else TK_CE(v[l], v[i]); } }
}
__device__ __forceinline__ void topk_phase(const Frame& F, CArgs& A) {
    const _Float16* SC = (const _Float16*)(F.ws + WS_H); int* IDX = (int*)(F.ws + WS_IDX); float* GATE = (float*)(F.ws + WS_GATE);
    typedef _Float16 h8 __attribute__((ext_vector_type(8)));
    LAS unsigned* LK = (LAS unsigned*)F.lds;
    const int tid = F.tid, tl = tid >> 4, hp = tid & 15;
    h8 cur[16];
    if (F.bx < NTOK / 32) { const _Float16* row = SC + (size_t)(F.bx * 32 + tl) * DM + hp * 128;
#pragma unroll
        for (int q = 0; q < 16; ++q) cur[q] = *(const h8*)(row + q * 8); }
    for (int blk = F.bx; blk < NTOK / 32; blk += F.G) {
        const int t = blk * 32 + tl;
        unsigned run[16];
#pragma unroll
        for (int k = 0; k < 16; ++k) run[k] = 0u;
#pragma unroll
        for (int c16 = 0; c16 < 8; ++c16) {
            unsigned ch[16];
#pragma unroll
            for (int q = 0; q < 2; ++q)
#pragma unroll
                for (int e = 0; e < 8; ++e) { const int n = c16 * 16 + q * 8 + e; ch[q * 8 + e] = (f2key((float)cur[c16 * 2 + q][e]) & ~127u) | (unsigned)(127 - n); }
            bitonic_sort16(ch);
#pragma unroll
            for (int i = 0; i < 16; ++i) run[i] = run[i] > ch[15 - i] ? run[i] : ch[15 - i];
            bitonic_merge16(run);
        }
        { const int bn = blk + F.G < NTOK / 32 ? blk + F.G : blk; const _Float16* rown = SC + (size_t)(bn * 32 + tl) * DM + hp * 128;
#pragma unroll
          for (int q = 0; q < 16; ++q) cur[q] = *(const h8*)(rown + q * 8); }
#pragma unroll
        for (int k = 0; k < 16; ++k) LK[tid * 17 + k] = run[k];
        __syncthreads();
        {
            const int odd = hp & 1, te = tid & ~1;
            const int la = (te + odd) * 17, lb = (te + 1 - odd) * 17;
            float a[16], b[16];
#pragma unroll
            for (int k = 0; k < 16; ++k) { a[k] = key2f(LK[la + k] & ~127u); b[k] = key2f(LK[lb + k] & ~127u); }
            unsigned sk[16];
#pragma unroll
            for (int k = 0; k < 16; ++k) sk[k] = 0u;
#define TK_INS(sum_, cell_) do { unsigned key = (f2key(sum_) & ~255u) | (unsigned)(255 - (cell_)); \
                _Pragma("unroll") for (int k = 0; k < 16; ++k) { const unsigned hi = sk[k] > key ? sk[k] : key, lo = sk[k] > key ? key : sk[k]; sk[k] = hi; key = lo; } } while (0)
#pragma unroll
            for (int i = 0; i < 16; ++i)
#pragma unroll
                for (int j = i + 1; j < 16; ++j) if ((i + 1) * (j + 1) <= 16) TK_INS(a[i] + b[j], odd ? j * 16 + i : i * 16 + j);
            {
                float a0 = a[0], a1 = a[1], a2 = a[2], a3 = a[3], b0 = b[0], b1 = b[1], b2 = b[2], b3 = b[3];
                asm("" : "+v"(a0)); asm("" : "+v"(a1)); asm("" : "+v"(a2)); asm("" : "+v"(a3)); asm("" : "+v"(b0)); asm("" : "+v"(b1)); asm("" : "+v"(b2)); asm("" : "+v"(b3));
                TK_INS((odd ? a2 : a0) + (odd ? b2 : b0), odd ? 2 * 17 : 0);
                TK_INS((odd ? a3 : a1) + (odd ? b3 : b1), odd ? 3 * 17 : 17);
            }
#undef TK_INS
#pragma unroll
            for (int k = 0; k < 16; ++k) { const unsigned o = (unsigned)__shfl_xor((int)sk[15 - k], 1); sk[k] = sk[k] > o ? sk[k] : o; }
            bitonic_merge16(sk);
            float e[16], sum = 0.f; const float s0 = key2f(sk[0] & ~255u);
#pragma unroll
            for (int k = 0; k < 16; ++k) { e[k] = __expf(key2f(sk[k] & ~255u) - s0); sum += e[k]; }
            const float inv = 1.0f / sum; const int head = hp >> 1;
#pragma unroll
            for (int kk = 0; kk < 8; ++kk) {
                unsigned klo = sk[kk], khi = sk[8 + kk]; float elo = e[kk], ehi = e[8 + kk];
                asm("" : "+v"(klo)); asm("" : "+v"(khi)); asm("" : "+v"(elo)); asm("" : "+v"(ehi));
                const unsigned key = odd ? khi : klo; const float ev = odd ? ehi : elo; const int k = odd * 8 + kk;
                const int cell = 255 - (int)(key & 255u);
                const int i1 = 127 - (int)(LK[te * 17 + (cell >> 4)] & 127u), i2 = 127 - (int)(LK[(te + 1) * 17 + (cell & 15)] & 127u);
                IDX[(size_t)t * 128 + head * 16 + k] = i1 * 128 + i2;
                GATE[(size_t)t * 128 + head * 16 + k] = ev * inv;
            }
        }
        __syncthreads();
    }
}
typedef int v8i __attribute__((ext_vector_type(8)));
__device__ __forceinline__ void peer_gather_phase(const Frame& F, CArgs& A, int l, float* xdst_base, bf16* XN) {
    constexpr int RB = DM / 2;
    constexpr int GNR = GATHER_ROWS;
    const unsigned char* U8 = F.ws + WS_U8 + (size_t)l * NEXP * RB; const unsigned char* V8 = F.ws + WS_V8 + (size_t)l * NEXP * RB;
    const float* USC = (const float*)(F.ws + WS_USC) + (size_t)l * NEXP; const float* VSC = (const float*)(F.ws + WS_VSC) + (size_t)l * NEXP;
    const int* IDX = (const int*)(F.ws + WS_IDX); const float* GATE = (const float*)(F.ws + WS_GATE);
    const float* g2 = GIN(A, I_LN2G) + (size_t)l * DM; const float* b2 = GIN(A, I_LN2B) + (size_t)l * DM;
    LAS unsigned char* XF8 = F.lds + F.wave * 2560;
    LAS float* HS = (LAS float*)(F.lds + F.wave * 2560 + 2048);
    const int lane = F.lane, lr = lane & 15, lq = lane >> 4;
    int nidx0 = 0, nidx1 = 0; float ngate0 = 0.f, ngate1 = 0.f;
    if (F.gw < NTOK) { nidx0 = IDX[(size_t)F.gw * 128 + lane]; nidx1 = IDX[(size_t)F.gw * 128 + 64 + lane]; ngate0 = GATE[(size_t)F.gw * 128 + lane]; ngate1 = GATE[(size_t)F.gw * 128 + 64 + lane]; }
    for (int t = F.gw; t < NTOK; t += F.NGW) {
        const bf16* xrow = XN + (size_t)t * DM;
        {
            v4u w0, w1;
#pragma unroll
            for (int j = 0; j < 8; ++j) { const v2u a = *(const v2u*)(xrow + j * 256 + lane * 4); int pk = 0;
                pk = __builtin_amdgcn_cvt_pk_fp8_f32(bf_lo(a.x), bf_hi(a.x), pk, false); pk = __builtin_amdgcn_cvt_pk_fp8_f32(bf_lo(a.y), bf_hi(a.y), pk, true);
                if (j < 4) w0[j] = (unsigned)pk; else w1[j - 4] = (unsigned)pk; }
            *(LAS v4u*)(XF8 + lane * 32) = w0; *(LAS v4u*)(XF8 + lane * 32 + 16) = w1;
        }
        const int idx0 = nidx0, idx1 = nidx1;
        const float gate0 = ngate0, gate1 = ngate1;
        const float usc0 = USC[idx0], usc1 = USC[idx1], vsc0 = VSC[idx0], vsc1 = VSC[idx1];
        unsigned rowoff[8];
#pragma unroll
        for (int g = 0; g < 8; ++g) rowoff[g] = (unsigned)__shfl((g >> 2) ? idx1 : idx0, (g & 3) * 16 + lr) * (unsigned)RB + (unsigned)lq * 16u;
        v4u AB[8][2];
#pragma unroll
        for (int g = 0; g < 8; ++g) { AB[g][0] = *(const v4u*)(U8 + rowoff[g]); AB[g][1] = *(const v4u*)(U8 + rowoff[g] + 64); }
        f32x4 hacc[8];
#pragma unroll
        for (int g = 0; g < 8; ++g) hacc[g] = (f32x4){0.f, 0.f, 0.f, 0.f};
        LDS_WAIT();
#pragma unroll 1
        for (int kp = 0; kp < 8; ++kp) {
            const LAS unsigned char* xq = XF8 + ((2 * kp) * 4 + (lq >> 1)) * 32 + 16 * (lq & 1);
            const v4u b00 = *(const LAS v4u*)xq, b01 = *(const LAS v4u*)(xq + 64), b10 = *(const LAS v4u*)(xq + 128), b11 = *(const LAS v4u*)(xq + 192);
            const v8i B0 = (v8i){(int)b00[0], (int)b00[1], (int)b00[2], (int)b00[3], (int)b01[0], (int)b01[1], (int)b01[2], (int)b01[3]};
            const v8i B1 = (v8i){(int)b10[0], (int)b10[1], (int)b10[2], (int)b10[3], (int)b11[0], (int)b11[1], (int)b11[2], (int)b11[3]};
#pragma unroll
            for (int g = 0; g < 8; ++g) {
                const v8i A0 = (v8i){(int)AB[g][0][0], (int)AB[g][0][1], (int)AB[g][0][2], (int)AB[g][0][3], 0, 0, 0, 0};
                const v8i A1 = (v8i){(int)AB[g][1][0], (int)AB[g][1][1], (int)AB[g][1][2], (int)AB[g][1][3], 0, 0, 0, 0};
                hacc[g] = __builtin_amdgcn_mfma_scale_f32_16x16x128_f8f6f4(A0, B0, hacc[g], 4, 0, 0, 0x7f7f7f7f, 0, 0x7f7f7f7f);
                hacc[g] = __builtin_amdgcn_mfma_scale_f32_16x16x128_f8f6f4(A1, B1, hacc[g], 4, 0, 0, 0x7f7f7f7f, 0, 0x7f7f7f7f);
                if (kp < 7) { AB[g][0] = *(const v4u*)(U8 + rowoff[g] + (kp + 1) * 128); AB[g][1] = *(const v4u*)(U8 + rowoff[g] + (kp + 1) * 128 + 64); }
            }
        }
        if (lr == 0) {
#pragma unroll
            for (int g = 0; g < 8; ++g) *(LAS f32x4*)(HS + g * 16 + 4 * lq) = hacc[g];
        }
        LDS_WAIT();
        const float hval0 = HS[lane], hval1 = HS[64 + lane];
        const float w0 = gate0 * gelu_erf(hval0 * usc0) * vsc0, w1 = gate1 * gelu_erf(hval1 * usc1) * vsc1;
        { const int tn = t + F.NGW, tp = tn < NTOK ? tn : t;
          nidx0 = IDX[(size_t)tp * 128 + lane]; nidx1 = IDX[(size_t)tp * 128 + 64 + lane]; ngate0 = GATE[(size_t)tp * 128 + lane]; ngate1 = GATE[(size_t)tp * 128 + 64 + lane]; }
        v4u BU[GNR];
        const unsigned loff = (unsigned)lane * 16u;
#define G_ROW_V(R) (V8 + (size_t)(unsigned)__builtin_amdgcn_readlane((((R) >> 6) & 1) ? idx1 : idx0, (R) & 63) * RB)
#define G_REQ(r, rowptr) do { BU[r] = *(const v4u*)((rowptr) + loff); } while (0)
#pragma unroll
        for (int r = 0; r < GNR; ++r) G_REQ(r, G_ROW_V(r));
        f32x2v acc[16];
#pragma unroll
        for (int k = 0; k < 16; ++k) acc[k] = (f32x2v){0.f, 0.f};
#define G_AXPY(r, R) do { const float w_ = __uint_as_float((unsigned)__builtin_amdgcn_readlane((int)__float_as_uint((((R) >> 6) & 1) ? w1 : w0), (R) & 63)); const f32x2v w2_ = (f32x2v){w_, w_}; \
            _Pragma("unroll") for (int q = 0; q < 4; ++q) { acc[4 * q] += w2_ * __builtin_amdgcn_cvt_scalef32_pk_f32_fp4(BU[r][q], 1.0f, 0); acc[4 * q + 1] += w2_ * __builtin_amdgcn_cvt_scalef32_pk_f32_fp4(BU[r][q], 1.0f, 1); \
                acc[4 * q + 2] += w2_ * __builtin_amdgcn_cvt_scalef32_pk_f32_fp4(BU[r][q], 1.0f, 2); acc[4 * q + 3] += w2_ * __builtin_amdgcn_cvt_scalef32_pk_f32_fp4(BU[r][q], 1.0f, 3); } } while (0)
        for (int it = 0; it < 128 / GNR - 1; ++it) {
#pragma unroll
            for (int r = 0; r < GNR; ++r) { G_AXPY(r, GNR * it + r); G_REQ(r, G_ROW_V(GNR * (it + 1) + r)); }
        }
#pragma unroll
        for (int r = 0; r < GNR; ++r) G_AXPY(r, 128 - GNR + r);
#undef G_ROW_V
#undef G_REQ
#undef G_AXPY
        const int le = opaque(lane);
        float s = 0.f;
#pragma unroll
        for (int j = 0; j < 8; ++j) { const v2u xr = *(const v2u*)(xrow + j * 256 + le * 4);
            acc[2 * j] = (f32x2v){bf_lo(xr.x), bf_hi(xr.x)} * ALPHA + acc[2 * j]; acc[2 * j + 1] = (f32x2v){bf_lo(xr.y), bf_hi(xr.y)} * ALPHA + acc[2 * j + 1];
            s += (acc[2 * j][0] + acc[2 * j][1]) + (acc[2 * j + 1][0] + acc[2 * j + 1][1]); }
        const float mean = wave_sum(s) * (1.0f / DM); float s2 = 0.f;
#pragma unroll
        for (int k = 0; k < 16; ++k) { acc[k] = acc[k] - mean; s2 += acc[k][0] * acc[k][0] + acc[k][1] * acc[k][1]; }
        const float rstd = 1.0f / sqrtf(wave_sum(s2) * (1.0f / DM) + LN_EPS);
        f32x4 gq[8], bq[8];
#pragma unroll
        for (int j = 0; j < 8; ++j) { gq[j] = *(const f32x4*)(g2 + j * 256 + le * 4); bq[j] = *(const f32x4*)(b2 + j * 256 + le * 4); }
#pragma unroll
        for (int j = 0; j < 8; ++j) { const int col = j * 256 + le * 4;
            const f32x4 gg = gq[j], bb = bq[j];
            const f32x2v a0 = acc[2 * j], a1 = acc[2 * j + 1];
            const f32x4 o = (f32x4){a0[0] * rstd * gg[0] + bb[0], a0[1] * rstd * gg[1] + bb[1], a1[0] * rstd * gg[2] + bb[2], a1[1] * rstd * gg[3] + bb[3]};
            if (xdst_base) *(f32x4*)(xdst_base + (size_t)t * DM + col) = o;
            v2u w; w.x = pkbf(o[0], o[1]); w.y = pkbf(o[2], o[3]); *(v2u*)(XN + (size_t)t * DM + col) = w; }
        LDS_WAIT();
    }
}

#ifndef DUP_MASK
#define DUP_MASK 0
#endif
#ifndef PHASE_TEST_ONLY
__global__ void __launch_bounds__(NTHR, 2) fwd_kernel(Args A) {
    extern __shared__ __attribute__((aligned(16))) unsigned char lds_raw[];
#define MKFRAME() Frame F; CArgs& KA = *(CArgs*)opaque_u64((unsigned long long)__builtin_amdgcn_kernarg_segment_ptr()); { F.lds = (LAS unsigned char*)lds_raw; F.tid = opaque((int)threadIdx.x); F.lane = F.tid & 63; F.wave = __builtin_amdgcn_readfirstlane(F.tid >> 6); \
        const int bx_ = opaque_s((int)blockIdx.x); F.G = gridDim.x; F.gw = bx_ * NWAVES + F.wave; F.NGW = F.G * NWAVES; F.gtid = (size_t)bx_ * NTHR + F.tid; F.NT = (size_t)F.G * NTHR; F.out = (float*)(float GAS*)opaque_g((unsigned char GAS*)KA.out); F.ws = (unsigned char*)opaque_g(KA.ws); F.bx = bx_; } \
        bf16* XN = (bf16*)(F.ws + WS_XN); bf16* H = (bf16*)(F.ws + WS_H); bf16* CC = (bf16*)(F.ws + WS_CONCAT); (void)XN; (void)H; (void)CC;
    volatile LAS unsigned* MISC = (volatile LAS unsigned*)((LAS unsigned char*)lds_raw + LDS_MISC);
    if (threadIdx.x < 64) MISC[threadIdx.x] = 0u;
    __syncthreads();
    XcdBarrier bar = xcd_barrier_post((unsigned*)(A.ws + WS_CTL) + CW_BAR + A.li * XCD_BAR_WORDS, MISC + 8);
    const int lo = A.ph_lo, hi = A.ph_hi;
#define IN(k) (lo <= (k) && (k) < hi)
#define SEAM(k) do { if (lo <= (k) && (k) + 1 < hi) xcd_barrier(bar); } while (0)

    if (IN(0)) { MKFRAME(); p0_prologue(F, KA); if (DUP_MASK & 256) { __syncthreads(); p0_prologue(F, KA); } } SEAM(0);

    for (int l = 0; l < NLAYER; ++l) {
        const int pb = 1 + l * 10;
        if (IN(pb + 0)) { MKFRAME();
            pg8::Gemm g{XN, (const bf16*)(F.ws + WS_WIN) + (size_t)l * INW * DM, NTOK, INW, DM}; pg8::StaticOrder S; S.init(NTOK, INW, F.G, F.bx);
            EpiStoreRot E{H, INW, (const float*)(F.ws + WS_ROTC), (const float*)(F.ws + WS_ROTS)};
            pg8::gemm_phase<EpiStoreRot, pg8::StaticOrder, GEMM_ALIGN, GEMM_SP2>(F.lds, g, S, E);
            if (DUP_MASK & 64) { pg8::gemm_phase<EpiStoreRot, pg8::StaticOrder, GEMM_ALIGN, GEMM_SP2>(F.lds, g, S, E); }
        } SEAM(pb + 0);
        if (IN(pb + 1)) { MKFRAME(); s5_pass1(F, KA, l); pool_phase(F, KA); if (DUP_MASK & 1) { s5_pass1(F, KA, l); } if (DUP_MASK & 2) { pool_phase(F, KA); } } SEAM(pb + 1);
        if (IN(pb + 2)) { MKFRAME(); s5_carry(F, KA, l); __syncthreads(); ret_state_phase(F, KA, (unsigned*)(F.ws + WS_CTL) + 64 + 16 * l); if (DUP_MASK & 4) { ret_state_phase(F, KA); } if (DUP_MASK & 2048) { ret_state_phase<1>(F, KA); } if (DUP_MASK & 4096) { ret_state_phase<2>(F, KA); ret_state_phase(F, KA); } } SEAM(pb + 2);
        if (IN(pb + 3)) { MKFRAME(); s5_pass3(F, KA, l); if (DUP_MASK & 8) { s5_pass3(F, KA, l); } ret_prefix_phase(F, KA); } SEAM(pb + 3);
        if (IN(pb + 4)) { MKFRAME();
            __syncthreads();
            ret_out_phase(F, KA);
            if (DUP_MASK & 16) { ret_out_phase(F, KA); }
            {
                pg8::Gemm g{(const bf16*)(F.ws + WS_BUFY), (const bf16*)(F.ws + WS_WGLU) + (size_t)l * 512 * 512, NTOK, 512, 512}; pg8::StaticOrder S; S.init(NTOK, 512, F.G, F.bx);
                EpiGlu E{(const bf16*)(F.ws + WS_BUFY), 512, CC, DM, GIN(KA, I_BGLU) + (size_t)l * 512};
                pg8::gemm_phase<EpiGlu, pg8::StaticOrder, GEMM_ALIGN, GEMM_SP2>(F.lds, g, S, E);
                if (DUP_MASK & 512) { pg8::gemm_phase<EpiGlu, pg8::StaticOrder, GEMM_ALIGN, GEMM_SP2>(F.lds, g, S, E); }
            }
        } SEAM(pb + 4);
        if (IN(pb + 5)) { MKFRAME();
            pg8::Gemm g{CC, (const bf16*)(F.ws + WS_WOUT) + (size_t)l * DM * DM, NTOK, DM, DM}; pg8::StaticOrder S; S.init(NTOK, DM, F.G, F.bx);
            EpiStoreBf16 E{H, DM};
            pg8::gemm_phase<EpiStoreBf16, pg8::StaticOrder, GEMM_ALIGN, GEMM_SP2>(F.lds, g, S, E);
        } SEAM(pb + 5);
        if (IN(pb + 6)) { MKFRAME();
            ln_rows2(XN, H, ALPHA, GIN(KA, I_LN1G) + (size_t)l * DM, GIN(KA, I_LN1B) + (size_t)l * DM, F.gw, F.NGW, F.lane);
        } SEAM(pb + 6);
        if (IN(pb + 7)) { MKFRAME();
            pg8::Gemm g{XN, (const bf16*)(F.ws + WS_WS) + (size_t)l * DM * DM, NTOK, DM, DM}; pg8::StaticOrder S; S.init(NTOK, DM, F.G, F.bx);
            EpiStoreF16 E{(_Float16*)(F.ws + WS_H), DM};
            pg8::gemm_phase<EpiStoreF16, pg8::StaticOrder, GEMM_ALIGN, GEMM_SP2>(F.lds, g, S, E);
            if (DUP_MASK & 128) { pg8::gemm_phase<EpiStoreF16, pg8::StaticOrder, GEMM_ALIGN, GEMM_SP2>(F.lds, g, S, E); }
        } SEAM(pb + 7);
        if (IN(pb + 8)) { MKFRAME(); __syncthreads(); topk_phase(F, KA); if (DUP_MASK & 32) { topk_phase(F, KA); } } SEAM(pb + 8);
        if (IN(pb + 9)) { MKFRAME(); if (DUP_MASK & 1024) { peer_gather_phase(F, KA, l, (float*)(F.ws + WS_H), CC); } peer_gather_phase(F, KA, l, l == NLAYER - 1 ? F.out : (float*)nullptr, XN); } SEAM(pb + 9);
    }
#undef IN
#undef SEAM
}


#ifndef DBG_STOP
#define DBG_STOP NPHASE
#endif
#ifndef MK_ONE_LAUNCH
#define MK_ONE_LAUNCH 0
#endif
extern "C" void kernel_launch(void* const* d_in, const int* in_sizes, int n_in, void* d_out, int out_size, void* d_ws, size_t ws_size, hipStream_t stream) {
    static int grid = 0;
    if (grid == 0) {
        if (n_in != 26 || out_size != NTOK * DM || ws_size < WS_END) { fprintf(stderr, "kernel_launch: unexpected shapes (n_in %d out %d ws %zu)\n", n_in, out_size, ws_size); grid = -1; return; }
        int dev = 0, cus = 0, per_cu = 0;
        if (hipGetDevice(&dev) != hipSuccess || hipDeviceGetAttribute(&cus, hipDeviceAttributeMultiprocessorCount, dev) != hipSuccess) { grid = -1; return; }
        if (hipFuncSetAttribute((const void*)fwd_kernel, hipFuncAttributeMaxDynamicSharedMemorySize, LDS_BYTES) != hipSuccess) { fprintf(stderr, "kernel_launch: hipFuncSetAttribute failed\n"); grid = -1; return; }
        if (hipOccupancyMaxActiveBlocksPerMultiprocessor(&per_cu, (const void*)fwd_kernel, NTHR, LDS_BYTES) != hipSuccess || per_cu < 1) { fprintf(stderr, "kernel_launch: occupancy query says %d\n", per_cu); grid = -1; (void)hipGetLastError(); return; }
        (void)hipGetLastError();
        grid = cus;
    }
    if (grid < 0) return;
    if (hipMemsetAsync((char*)d_ws + WS_CTL, 0, CTL_ZERO_BYTES, stream) != hipSuccess) return;
    Args a{};
    for (int i = 0; i < 26; ++i) a.in[i] = (const float*)d_in[i];
    a.out = (float*)d_out; a.ws = (unsigned char*)d_ws; a.pad = 0;
#if MK_ONE_LAUNCH
    a.ph_lo = 0; a.ph_hi = NPHASE; a.li = 0;
    hipLaunchKernelGGL(fwd_kernel, dim3(grid), dim3(NTHR), LDS_BYTES, stream, a);
#else
    for (int p = 0; p < DBG_STOP; ++p) { a.ph_lo = p; a.ph_hi = p + 1; a.li = p; hipLaunchKernelGGL(fwd_kernel, dim3(grid), dim3(NTHR), LDS_BYTES, stream, a); }
#endif
}
#endif
```

```cpp
#include <hip/hip_runtime.h>
#include <cstdio>
#include <cstdint>
#include <cmath>
__device__ __forceinline__ __attribute__((convergent)) void mk_syncthreads() { __builtin_amdgcn_fence(__ATOMIC_RELEASE, "workgroup"); __builtin_amdgcn_s_barrier(); __builtin_amdgcn_fence(__ATOMIC_ACQUIRE, "workgroup"); }
#define __syncthreads mk_syncthreads
__device__ __forceinline__ int opaque(int v) { asm volatile("" : "+v"(v)); return v; }
__device__ __forceinline__ int opaque_s(int v) { asm volatile("" : "+s"(v)); return v; }
__device__ __forceinline__ void* opaque_p(void* p) { asm volatile("" : "+s"(p)); return p; }
__device__ __forceinline__ unsigned long long opaque_u64(unsigned long long v) { asm volatile("" : "+s"(v)); return v; }
#ifndef GATHER_ROWS
#define GATHER_ROWS 16
#endif
__device__ __forceinline__ __attribute__((address_space(1))) unsigned char* opaque_g(__attribute__((address_space(1))) unsigned char* p) { asm volatile("" : "+s"(p)); return p; }
#ifndef GEMM_ALIGN
#define GEMM_ALIGN true
#endif
#ifndef GEMM_SP2
#define GEMM_SP2 true
#endif
#define MK_ONE_LAUNCH 1
namespace pg8 {
#define PG8_LAS __attribute__((address_space(3)))
typedef unsigned short bf16_t;
typedef short bf16x8 __attribute__((ext_vector_type(8)));
typedef float f32x4 __attribute__((ext_vector_type(4)));
typedef unsigned u32x4 __attribute__((ext_vector_type(4)));
constexpr int BM = 256, BK = 64, HALF = 128, HTB = HALF * BK * 2  , STAGE_BYTES = 8 * HTB, NXCD = 8, WGM = 8;

__host__ __device__ __forceinline__ int lds_byte(int r, int c) { const int st = (r >> 4) * 2 + (c >> 5), rr = r & 15, cc = c & 31, ob = rr * 64 + cc * 2; return st * 1024 + (ob ^ (((ob >> 9) & 1) << 5)); }
__host__ __device__ __forceinline__ void stage_rc(int b, int& R, int& C) { const int st = b / 1024, sb = b % 1024, swz = sb ^ (((sb >> 9) & 1) << 5); R = (st >> 1) * 16 + swz / 64; C = (st & 1) * 32 + (swz % 64) / 2; }
__host__ __device__ __forceinline__ int perm32(int rho) { const int n = rho >> 4, i = rho & 15; return 8 * (i >> 2) + 4 * n + (i & 3); }

struct Unit { int pm, pn; };
struct Gemm { const bf16_t* A; const bf16_t* Bt; int M, N, K; };

struct StaticOrder {
    int nM, nN, nwg, G, c;
    __host__ __device__ __forceinline__ void init(int M, int N, int G_, int c_) { nM = M / BM; nN = N / BM; nwg = nM * nN; G = G_; c = c_; }
    __host__ __device__ bool next(int i, Unit& u) const {
        const long L = (long)i * G + c; if (L >= nwg) return false;
        int wgid = (int)L; { const int q = nwg / NXCD, r = nwg % NXCD, xcd = wgid % NXCD, off = wgid / NXCD; wgid = (xcd < r ? xcd * (q + 1) : r * (q + 1) + (xcd - r) * q) + off; }
        const int nig = WGM * nN, gid = wgid / nig, fm = gid * WGM, gsz = (nM - fm) < WGM ? (nM - fm) : WGM;
        u.pm = fm + ((wgid % nig) % gsz); u.pn = (wgid % nig) / gsz; return true;
    }
    __device__ __forceinline__ void a_ready(const Unit&) const {}
    __device__ __forceinline__ void done(const Unit&) const {}
};
__device__ __forceinline__ unsigned cvt_pk_bf16(float lo, float hi) { unsigned r; asm volatile("v_cvt_pk_bf16_f32 %0, %1, %2" : "=v"(r) : "v"(lo), "v"(hi)); return r; }
typedef float f32x2 __attribute__((ext_vector_type(2)));
template <class Epi, class Sched, bool ALIGN_EPI = false, bool SP2 = false>
__device__ __forceinline__ void gemm_phase(PG8_LAS unsigned char* lds, const Gemm g, const Sched& S, const Epi& E) {
    const int tid = opaque((int)threadIdx.x), wid = __builtin_amdgcn_readfirstlane(tid >> 6), lane = tid & 63, wr = wid >> 2, wc = wid & 3, fr = lane & 15, fq = lane >> 4;
    const int K = g.K, nt = K / BK;
    unsigned voffA[2], voffB[2];
#pragma unroll
    for (int i = 0; i < 2; ++i) { int R, C; stage_rc(tid * 16 + i * 8192, R, C); const int Rb = Epi::PERM ? ((R & ~31) + perm32(R & 31)) : R;
        voffA[i] = (unsigned)(R * K + C) * 2u; voffB[i] = (unsigned)(Rb * K + C) * 2u; }
    const size_t kstep = (size_t)(BK * 2);
    const size_t hstep = (size_t)HALF * K * 2;
    const size_t tstep = 2 * hstep;
    const unsigned ldsw = (unsigned)wid * 1024u;
    const int aoff = lds_byte(wr * 64 + fr, fq * 8), boff = lds_byte(wc * 32 + fr, fq * 8);
#define PG8_SA(b, h) (((b) * 2 + (h)) * HTB)
#define PG8_SB(b, h) ((4 + (b) * 2 + (h)) * HTB)
#define PG8_STAGE(bufoff, gbase, voff) do { _Pragma("unroll") for (int _i = 0; _i < 2; ++_i) \
        __builtin_amdgcn_global_load_lds((const unsigned*)((const char*)(gbase) + (voff)[_i]), (PG8_LAS unsigned*)(lds + (bufoff) + ldsw + _i * 8192), 16, 0, 0); } while (0)
#define PG8_LDA(dst, b, h) do { _Pragma("unroll") for (int m = 0; m < 4; ++m) _Pragma("unroll") for (int k = 0; k < 2; ++k) dst[m][k] = *(const PG8_LAS bf16x8*)(lds + PG8_SA(b, h) + aoff + m * 2048 + k * 1024); } while (0)
#define PG8_LDB(dst, b, h) do { _Pragma("unroll") for (int n = 0; n < 2; ++n) _Pragma("unroll") for (int k = 0; k < 2; ++k) dst[n][k] = *(const PG8_LAS bf16x8*)(lds + PG8_SB(b, h) + boff + n * 2048 + k * 1024); } while (0)
#define PG8_MMA(ai, bj, At, Bt) do { __builtin_amdgcn_s_setprio(1); _Pragma("unroll") for (int m = 0; m < 4; ++m) _Pragma("unroll") for (int n = 0; n < 2; ++n) _Pragma("unroll") for (int k = 0; k < 2; ++k) \
        acc[ai][bj][m][n] = __builtin_amdgcn_mfma_f32_16x16x32_bf16(Bt[n][k], At[m][k], acc[ai][bj][m][n], 0, 0, 0); __builtin_amdgcn_s_setprio(0); } while (0)
#define PG8_WAIT_V(n) asm volatile("s_waitcnt vmcnt(" #n ")" ::: "memory")
#define PG8_WAIT_L(n) asm volatile("s_waitcnt lgkmcnt(" #n ")" ::: "memory")
#define PG8_BAR __builtin_amdgcn_s_barrier()
#define PG8_SCHED __builtin_amdgcn_sched_barrier(0)
    Unit cur, nxt; int ui = 0;
    if (!S.next(0, cur)) return;
    f32x4 acc[2][2][4][2];
#pragma unroll
    for (int a = 0; a < 2; ++a)
#pragma unroll
        for (int b = 0; b < 2; ++b)
#pragma unroll
            for (int m = 0; m < 4; ++m)
#pragma unroll
                for (int n = 0; n < 2; ++n) acc[a][b][m][n] = (f32x4){0.f, 0.f, 0.f, 0.f};
    bf16x8 At[4][2], B0[2][2], B1[2][2];
    const char* cA = (const char*)g.A + (size_t)cur.pm * tstep; const char* cB = (const char*)g.Bt + (size_t)cur.pn * tstep;
    S.a_ready(cur);
    if constexpr (SP2) {
        PG8_STAGE(PG8_SB(0, 0), cB, voffB); PG8_STAGE(PG8_SB(0, 1), cB + hstep, voffB); PG8_STAGE(PG8_SA(0, 0), cA, voffA); PG8_STAGE(PG8_SA(0, 1), cA + hstep, voffA);
        if (wr == 1) PG8_BAR;
        PG8_WAIT_V(2); PG8_BAR;
        PG8_STAGE(PG8_SB(1, 0), cB + kstep, voffB); PG8_STAGE(PG8_SA(1, 0), cA + kstep, voffA); PG8_STAGE(PG8_SB(1, 1), cB + hstep + kstep, voffB);
        PG8_WAIT_V(6); PG8_BAR;
    } else {
        PG8_STAGE(PG8_SB(0, 0), cB, voffB); PG8_STAGE(PG8_SA(0, 0), cA, voffA); PG8_STAGE(PG8_SB(0, 1), cB + hstep, voffB); PG8_STAGE(PG8_SA(0, 1), cA + hstep, voffA);
        if (wr == 1) PG8_BAR;
        PG8_WAIT_V(4); PG8_BAR;
        PG8_STAGE(PG8_SB(1, 0), cB + kstep, voffB); PG8_STAGE(PG8_SA(1, 0), cA + kstep, voffA); PG8_STAGE(PG8_SB(1, 1), cB + hstep + kstep, voffB);
        PG8_WAIT_V(6); PG8_BAR;
    }
    for (;;) {
        const bool has_next = S.next(ui + 1, nxt);
        const char* nA = has_next ? (const char*)g.A + (size_t)nxt.pm * tstep : cA; const char* nB = has_next ? (const char*)g.Bt + (size_t)nxt.pn * tstep : cB;
        for (int t = 0; t < nt; t += 2) {
            const bool last = (t == nt - 2);
            const char* a1 = cA + (size_t)(t + 1) * kstep;
            const char* a2 = last ? nA : cA + (size_t)(t + 2) * kstep; const char* b2 = last ? nB : cB + (size_t)(t + 2) * kstep;
            const char* a3 = a2 + kstep; const char* b3 = b2 + kstep;
            if (last && has_next) S.a_ready(nxt);
            if constexpr (SP2) {
            PG8_LDB(B0, 0, 0); PG8_LDB(B1, 0, 1); PG8_SCHED; PG8_LDA(At, 0, 0); PG8_STAGE(PG8_SA(1, 1), a1 + hstep, voffA);
            PG8_WAIT_V(8); PG8_WAIT_L(0); PG8_BAR; PG8_MMA(0, 0, At, B0); PG8_MMA(0, 1, At, B1); PG8_BAR; PG8_SCHED;
            PG8_LDA(At, 0, 1); PG8_STAGE(PG8_SB(0, 0), b2, voffB); PG8_STAGE(PG8_SB(0, 1), b2 + hstep, voffB); PG8_STAGE(PG8_SA(0, 0), a2, voffA);
            PG8_WAIT_V(8); PG8_WAIT_L(0); PG8_BAR; PG8_MMA(1, 0, At, B0); PG8_MMA(1, 1, At, B1); PG8_BAR; PG8_SCHED;
            PG8_LDB(B0, 1, 0); PG8_LDB(B1, 1, 1); PG8_SCHED; PG8_LDA(At, 1, 0); PG8_STAGE(PG8_SA(0, 1), a2 + hstep, voffA);
            PG8_WAIT_V(8); PG8_WAIT_L(0); PG8_BAR; PG8_MMA(0, 0, At, B0); PG8_MMA(0, 1, At, B1); PG8_BAR; PG8_SCHED;
            PG8_LDA(At, 1, 1); PG8_STAGE(PG8_SB(1, 0), b3, voffB); PG8_STAGE(PG8_SB(1, 1), b3 + hstep, voffB); PG8_STAGE(PG8_SA(1, 0), a3, voffA);
            PG8_WAIT_V(8); PG8_WAIT_L(0); PG8_BAR; PG8_MMA(1, 0, At, B0); PG8_MMA(1, 1, At, B1); PG8_BAR; PG8_SCHED;
            } else {
            PG8_LDB(B0, 0, 0); PG8_SCHED; PG8_LDA(At, 0, 0); PG8_STAGE(PG8_SA(1, 1), a1 + hstep, voffA);
            PG8_WAIT_L(8); PG8_BAR; PG8_WAIT_L(0); PG8_MMA(0, 0, At, B0); PG8_BAR; PG8_SCHED;
            PG8_LDB(B1, 0, 1); PG8_STAGE(PG8_SB(0, 0), b2, voffB);
            PG8_BAR; PG8_WAIT_L(0); PG8_MMA(0, 1, At, B1); PG8_BAR;
            PG8_LDA(At, 0, 1); PG8_STAGE(PG8_SA(0, 0), a2, voffA);
            PG8_BAR; PG8_WAIT_L(0); PG8_MMA(1, 0, At, B0); PG8_BAR; PG8_SCHED;
            PG8_STAGE(PG8_SB(0, 1), b2 + hstep, voffB);
            PG8_WAIT_V(6); PG8_BAR; PG8_MMA(1, 1, At, B1); PG8_BAR;
            PG8_LDB(B0, 1, 0); PG8_SCHED; PG8_LDA(At, 1, 0); PG8_STAGE(PG8_SA(0, 1), a2 + hstep, voffA);
            PG8_WAIT_L(8); PG8_BAR; PG8_WAIT_L(0); PG8_MMA(0, 0, At, B0); PG8_BAR; PG8_SCHED;
            PG8_LDB(B1, 1, 1); PG8_STAGE(PG8_SB(1, 0), b3, voffB);
            PG8_BAR; PG8_WAIT_L(0); PG8_MMA(0, 1, At, B1); PG8_BAR;
            PG8_LDA(At, 1, 1); PG8_STAGE(PG8_SA(1, 0), a3, voffA);
            PG8_BAR; PG8_WAIT_L(0); PG8_MMA(1, 0, At, B0); PG8_BAR; PG8_SCHED;
            PG8_STAGE(PG8_SB(1, 1), b3 + hstep, voffB);
            PG8_WAIT_V(6); PG8_BAR; PG8_MMA(1, 1, At, B1); PG8_BAR;
            }
        }
        if constexpr (ALIGN_EPI) { if (wr == 0) PG8_BAR; }
        if constexpr (!Epi::AFTER_DRAIN) { E(acc, cur, wr, wc, fr, fq); S.done(cur); }
        if (!has_next) break;
#pragma unroll
        for (int a = 0; a < 2; ++a)
#pragma unroll
            for (int b = 0; b < 2; ++b)
#pragma unroll
                for (int m = 0; m < 4; ++m)
#pragma unroll
                    for (int n = 0; n < 2; ++n) acc[a][b][m][n] = (f32x4){0.f, 0.f, 0.f, 0.f};
        cur = nxt; cA = nA; cB = nB; ++ui;
        if constexpr (ALIGN_EPI) { if (wr == 1) PG8_BAR; }
    }
    PG8_WAIT_V(0);
    if constexpr (!ALIGN_EPI) { if (wr == 0) PG8_BAR; }
    PG8_BAR;
    if constexpr (Epi::AFTER_DRAIN) { E.fused(acc, cur, wr, wc, fr, fq, lds, wid, lane); S.done(cur); }
#undef PG8_SA
#undef PG8_SB
#undef PG8_STAGE
#undef PG8_LDA
#undef PG8_LDB
#undef PG8_MMA
#undef PG8_WAIT_V
#undef PG8_WAIT_L
#undef PG8_BAR
#undef PG8_SCHED
}
}
#define LAS __attribute__((address_space(3)))
#define XB_TMO      128
#define XB_XCNT(j)  (256  + 64 * (j))
#define XB_XSUB(j)  (1280 + 64 * (j))
#define XB_XGEN(j)  (2304 + 64 * (j))
#define XB_TOP      3328
#define XB_TOPGEN   3392
#define XCD_BAR_WORDS 3456
#define XB_SPIN_CAP (1u << 18)

__device__ __forceinline__ unsigned xb_ld(unsigned* p)              { return __hip_atomic_load(p, __ATOMIC_RELAXED, __HIP_MEMORY_SCOPE_AGENT); }
__device__ __forceinline__ unsigned xb_add(unsigned* p, unsigned v) { return __hip_atomic_fetch_add(p, v, __ATOMIC_RELAXED, __HIP_MEMORY_SCOPE_AGENT); }
__device__ __forceinline__ unsigned xb_xcc_id() { return (unsigned)__builtin_amdgcn_s_getreg((3 << 11) | 20) & 0xFu; }
#define XB_SPIN(cond, bar) do { unsigned _sp = 0; while (cond) { __builtin_amdgcn_s_sleep(1); \
    if ((++_sp & 255u) == 0u) { if (xb_ld(&(bar)[XB_TMO])) break; if (_sp > XB_SPIN_CAP) { atomicAdd(&(bar)[XB_TMO], 1u); break; } } } } while (0)

struct XcdBarrier {
    unsigned* bar; unsigned x;
    volatile LAS unsigned* st;
};

__device__ __forceinline__ XcdBarrier xcd_barrier_post(unsigned* bar, volatile LAS unsigned* st) {
    XcdBarrier b; b.bar = bar; b.x = xb_xcc_id(); b.st = st;
    if (threadIdx.x == 0) (void)xb_add(&bar[XB_XCNT(b.x)], 1u);
    return b;
}
__device__ __forceinline__ void xcd_barrier_complete(unsigned* bar, unsigned x, unsigned& nloc, unsigned& nx) {
    const unsigned G = gridDim.x * gridDim.y * gridDim.z;
    unsigned sum, cnt, mine, sp = 0u;
    for (;;) {
        sum = 0u; cnt = 0u; mine = 0u;
#pragma unroll
        for (unsigned j = 0; j < 16; ++j) { const unsigned c = xb_ld(&bar[XB_XCNT(j)]); sum += c; cnt += (c > 0u) ? 1u : 0u; mine = (j == x) ? c : mine; }
        if (sum == G) break;
        __builtin_amdgcn_s_sleep(1);
        if ((++sp & 255u) == 0u) { if (xb_ld(&bar[XB_TMO])) break; if (sp > XB_SPIN_CAP) { atomicAdd(&bar[XB_TMO], 1u); break; } }
    }
    nloc = mine > 0u ? mine : 1u; nx = cnt > 0u ? cnt : 1u;
}

__device__ __forceinline__ void xcd_barrier(const XcdBarrier& b) {
    asm volatile("s_waitcnt vmcnt(0)" ::: "memory");
    __syncthreads();
    if (threadIdx.x == 0) {
        unsigned* bar = b.bar;
        __builtin_amdgcn_s_waitcnt(0);
        unsigned nloc = b.st[0], nx = b.st[1];
        if (nloc == 0u) { xcd_barrier_complete(bar, b.x, nloc, nx); b.st[0] = nloc; b.st[1] = nx; }
        const unsigned old = xb_add(&bar[XB_XSUB(b.x)], 1u);
        const unsigned gen = old / nloc;
        if (old + 1u == (gen + 1u) * nloc) {
            __builtin_amdgcn_fence(__ATOMIC_RELEASE, "agent");
            asm volatile("s_waitcnt vmcnt(0)" ::: "memory");
            const unsigned og = xb_add(&bar[XB_TOP], 1u);
            const unsigned tg = og / nx;
            if (og + 1u == (tg + 1u) * nx) xb_add(&bar[XB_TOPGEN], 1u);
            else XB_SPIN(xb_ld(&bar[XB_TOPGEN]) == tg, bar);
            __builtin_amdgcn_fence(__ATOMIC_ACQUIRE, "agent");
            xb_add(&bar[XB_XGEN(b.x)], 1u);
            asm volatile("s_waitcnt vmcnt(0)" ::: "memory");
        } else {
            XB_SPIN(xb_ld(&bar[XB_XGEN(b.x)]) == gen, bar);
            __builtin_amdgcn_fence(__ATOMIC_ACQUIRE, "agent");
            asm volatile("s_waitcnt vmcnt(0)" ::: "memory");
        }
    }
    __syncthreads();
}
#undef LAS
using pg8::bf16x8; using pg8::f32x4; using pg8::u32x4; using pg8::f32x2;
#define GAS __attribute__((address_space(1)))
#define LAS __attribute__((address_space(3)))
typedef unsigned short bf16;
typedef unsigned v4u __attribute__((ext_vector_type(4)));
typedef unsigned v2u __attribute__((ext_vector_type(2)));
typedef float f32x2v __attribute__((ext_vector_type(2)));

constexpr int NTOK = 40960, DM = 2048, NLAYER = 4, INW = 5120;
constexpr int COL_UA = 0, COL_UB = 512, COL_Q = 1024, COL_K = 2048, COL_V = 3072, COL_G = 4096;
constexpr float ALPHA = 1.6817928305074290f;
constexpr float LN_EPS = 1e-5f, GN_EPS = 1e-6f;
constexpr int NEXP = 16384;
constexpr int NWAVES = 8, NTHR = 512;

constexpr size_t MiB = 1u << 20;
constexpr size_t WS_CTL = 0, CTL_ZERO_BYTES = 1 * MiB;
constexpr size_t WS_WIN = 1 * MiB;
constexpr size_t WS_WOUT = 81 * MiB;
constexpr size_t WS_WS = 113 * MiB;
constexpr size_t WS_WGLU = 145 * MiB;
constexpr size_t WS_S5A = 149 * MiB;
constexpr size_t WS_S5B = 150 * MiB;
constexpr size_t WS_S5BB = 153 * MiB;
constexpr size_t WS_U8 = 160 * MiB;
constexpr size_t WS_V8 = 288 * MiB;
constexpr size_t WS_USC = 416 * MiB;
constexpr size_t WS_VSC = 417 * MiB;
constexpr size_t WS_ROTC = 420 * MiB;
constexpr size_t WS_ROTS = 424 * MiB;
constexpr size_t WS_XN = 672 * MiB;
constexpr size_t WS_H = 832 * MiB;
constexpr size_t WS_CONCAT = 1232 * MiB;
constexpr size_t WS_BUFY = 1392 * MiB;
constexpr size_t WS_STF = 1472 * MiB;
constexpr size_t WS_STB = 1632 * MiB;
constexpr size_t WS_IDX = 1792 * MiB;
constexpr size_t WS_GATE = 1812 * MiB;
constexpr size_t WS_S5ST = 1832 * MiB;
constexpr size_t WS_END = 1852 * MiB;
constexpr int CW_BAR = 4096;
constexpr int NPHASE = 1 + NLAYER * 10;

constexpr int LDS_SCRATCH = 147456;
constexpr int LDS_MISC = LDS_SCRATCH;
constexpr int LDS_BYTES = LDS_SCRATCH + 256;

__device__ __forceinline__ float bf_lo(unsigned w) { return __uint_as_float(w << 16); }
__device__ __forceinline__ float bf_hi(unsigned w) { return __uint_as_float(w & 0xffff0000u); }
typedef __bf16 bf16x2_t __attribute__((ext_vector_type(2)));
__device__ __forceinline__ unsigned pkbf(float lo, float hi) { const bf16x2_t v = {(__bf16)lo, (__bf16)hi}; return __builtin_bit_cast(unsigned, v); }
__device__ __forceinline__ bf16 f2bf(float f) { return __builtin_bit_cast(unsigned short, (__bf16)f); }
__device__ __forceinline__ float wave_sum(float v) {
#pragma unroll
    for (int o = 1; o < 64; o <<= 1) v += __shfl_xor(v, o);
    return v;
}
__device__ __forceinline__ float gelu_erf(float v) {
    const float z = fabsf(v) * 0.70710678118654752f;
    const float t = __builtin_amdgcn_rcpf(1.0f + 0.3275911f * z);
    const float poly = t * (0.254829592f + t * (-0.284496736f + t * (1.421413741f + t * (-1.453152027f + t * 1.061405429f))));
    const float ec = poly * __expf(-z * z);
    return 0.5f * v * (v < 0.f ? ec : 2.0f - ec);
}
__device__ __forceinline__ int tok_pos(int t) { return t < 32768 ? (t & 4095) : (t - 32768); }
__device__ __forceinline__ int tok_len(int t) { return t < 32768 ? 4096 : 8192; }
__device__ __forceinline__ void unpack8(const v4u q, float (&f)[8]) {
    f[0] = bf_lo(q.x); f[1] = bf_hi(q.x); f[2] = bf_lo(q.y); f[3] = bf_hi(q.y); f[4] = bf_lo(q.z); f[5] = bf_hi(q.z); f[6] = bf_lo(q.w); f[7] = bf_hi(q.w);
}
__device__ __forceinline__ v4u pack8(const float (&f)[8]) { v4u q; q.x = pkbf(f[0], f[1]); q.y = pkbf(f[2], f[3]); q.z = pkbf(f[4], f[5]); q.w = pkbf(f[6], f[7]); return q; }
#define LDS_WAIT() asm volatile("s_waitcnt lgkmcnt(0)" ::: "memory")
#define MFMA16(a, b, c) __builtin_amdgcn_mfma_f32_16x16x32_bf16((a), (b), (c), 0, 0, 0)

struct EpiStoreBf16 {
    static constexpr bool PERM = true, AFTER_DRAIN = false;
    bf16* O; int ldo;
    __device__ __forceinline__ void operator()(const f32x4 (&acc)[2][2][4][2], const pg8::Unit& u, int wr, int wc, int fr, int fq) const {
        const int row0 = u.pm * 256 + wr * 64 + fr, col0 = u.pn * 256 + wc * 32 + 8 * fq;
#pragma unroll
        for (int ai = 0; ai < 2; ++ai)
#pragma unroll
            for (int m = 0; m < 4; ++m) { bf16* rowp = O + (size_t)(row0 + ai * 128 + m * 16) * ldo + col0;
#pragma unroll
                for (int bj = 0; bj < 2; ++bj) { const f32x4 v0 = acc[ai][bj][m][0], v1 = acc[ai][bj][m][1];
                    v4u w; w.x = pkbf(v0[0], v0[1]); w.y = pkbf(v0[2], v0[3]); w.z = pkbf(v1[0], v1[1]); w.w = pkbf(v1[2], v1[3]);
                    *(v4u*)(rowp + bj * 128) = w; } }
    }
};
struct EpiStoreRot {
    static constexpr bool PERM = true, AFTER_DRAIN = false;
    bf16* O; int ldo; const float* rc; const float* rs;
    __device__ __forceinline__ void operator()(const f32x4 (&acc)[2][2][4][2], const pg8::Unit& u, int wr, int wc, int fr, int fq) const {
        const int row0 = u.pm * 256 + wr * 64 + fr, col0 = u.pn * 256 + wc * 32 + 8 * fq;
        const bool rot = u.pn >= 4 && u.pn < 12; const float sc = u.pn >= 8 ? 0.0625f : 1.0f;
#pragma unroll
        for (int ai = 0; ai < 2; ++ai)
#pragma unroll
            for (int m = 0; m < 4; ++m) { const int row = row0 + ai * 128 + m * 16; bf16* rowp = O + (size_t)row * ldo + col0;
                f32x4 a0 = acc[ai][0][m][0], a1 = acc[ai][0][m][1], b0 = acc[ai][1][m][0], b1 = acc[ai][1][m][1];
                if (rot) { const int pos = row < 32768 ? (row & 4095) : (row - 32768); const size_t to = (size_t)pos * 128 + wc * 32 + 8 * fq;
                    const f32x4 c0 = *(const f32x4*)(rc + to), c1 = *(const f32x4*)(rc + to + 4), s0 = *(const f32x4*)(rs + to), s1 = *(const f32x4*)(rs + to + 4);
                    const f32x4 x0 = a0, x1 = a1, y0 = b0, y1 = b1;
                    a0 = (x0 * c0 - y0 * s0) * sc; a1 = (x1 * c1 - y1 * s1) * sc; b0 = (y0 * c0 + x0 * s0) * sc; b1 = (y1 * c1 + x1 * s1) * sc; }
                v4u w; w.x = pkbf(a0[0], a0[1]); w.y = pkbf(a0[2], a0[3]); w.z = pkbf(a1[0], a1[1]); w.w = pkbf(a1[2], a1[3]); *(v4u*)rowp = w;
                v4u x; x.x = pkbf(b0[0], b0[1]); x.y = pkbf(b0[2], b0[3]); x.z = pkbf(b1[0], b1[1]); x.w = pkbf(b1[2], b1[3]); *(v4u*)(rowp + 128) = x; }
    }
};
struct EpiGlu {
    static constexpr bool PERM = true, AFTER_DRAIN = false;
    const bf16* Y; int ldy; bf16* O; int ldo; const float* bias;
    __device__ __forceinline__ void operator()(const f32x4 (&acc)[2][2][4][2], const pg8::Unit& u, int wr, int wc, int fr, int fq) const {
        const int row0 = u.pm * 256 + wr * 64 + fr, col0 = u.pn * 256 + wc * 32 + 8 * fq;
#pragma unroll
        for (int bj = 0; bj < 2; ++bj) {
            const f32x4 b0 = *(const f32x4*)(bias + col0 + bj * 128), b1 = *(const f32x4*)(bias + col0 + bj * 128 + 4);
#pragma unroll
            for (int ai = 0; ai < 2; ++ai)
#pragma unroll
                for (int m = 0; m < 4; ++m) { const size_t r = (size_t)(row0 + ai * 128 + m * 16);
                    const v4u yq = *(const v4u*)(Y + r * ldy + col0 + bj * 128); float y[8]; unpack8(yq, y);
                    const f32x4 v0 = acc[ai][bj][m][0] + b0, v1 = acc[ai][bj][m][1] + b1; float o[8];
#pragma unroll
                    for (int k = 0; k < 4; ++k) { o[k] = y[k] * __builtin_amdgcn_rcpf(1.0f + __expf(-v0[k])); o[4 + k] = y[4 + k] * __builtin_amdgcn_rcpf(1.0f + __expf(-v1[k])); }
                    *(v4u*)(O + r * ldo + col0 + bj * 128) = pack8(o); }
        }
    }
};
struct EpiStoreF16 {
    static constexpr bool PERM = true, AFTER_DRAIN = false;
    _Float16* C; int ldc;
    __device__ __forceinline__ void operator()(const f32x4 (&acc)[2][2][4][2], const pg8::Unit& u, int wr, int wc, int fr, int fq) const {
        typedef _Float16 h8 __attribute__((ext_vector_type(8)));
        const int row0 = u.pm * 256 + wr * 64 + fr, col0 = u.pn * 256 + wc * 32 + 8 * fq;
#pragma unroll
        for (int ai = 0; ai < 2; ++ai)
#pragma unroll
            for (int m = 0; m < 4; ++m) { _Float16* rowp = C + (size_t)(row0 + ai * 128 + m * 16) * ldc + col0;
#pragma unroll
                for (int bj = 0; bj < 2; ++bj) { const f32x4 v0 = acc[ai][bj][m][0], v1 = acc[ai][bj][m][1];
                    h8 w; w[0] = (_Float16)v0[0]; w[1] = (_Float16)v0[1]; w[2] = (_Float16)v0[2]; w[3] = (_Float16)v0[3]; w[4] = (_Float16)v1[0]; w[5] = (_Float16)v1[1]; w[6] = (_Float16)v1[2]; w[7] = (_Float16)v1[3];
                    *(h8*)(rowp + bj * 128) = w; } }
    }
};
struct Args { const float* in[26]; float* out; unsigned char* ws; int ph_lo, ph_hi, li, pad; };
struct ArgsDev { const float GAS* in[26]; float GAS* out; unsigned char GAS* ws; int ph_lo, ph_hi, li, pad; };
typedef const ArgsDev __attribute__((address_space(4))) CArgs;
#define GIN(A_, k_) ((const float*)(A_).in[k_])
struct Frame {
    LAS unsigned char* lds;
    int tid, lane, wave, G, bx;
    int gw, NGW;
    size_t gtid, NT;
    float* out; unsigned char* ws;
};
enum InIdx { I_XP = 0, I_XS, I_LNIN_G, I_LNIN_B, I_WIN, I_LAMRE, I_LAMIM, I_LOGSTEP, I_BRE, I_BIM, I_CRE, I_CIM, I_S5D, I_WGLU, I_BGLU, I_POOLW, I_POOLS,
             I_WOUT, I_LN1G, I_LN1B, I_WQ, I_KEYS, I_PU, I_PV, I_LN2G, I_LN2B };

__device__ __forceinline__ void ln_rows2(bf16* XB, const bf16* MIX, float alpha, const float* g, const float* b, int gw, int ngw, int lane) {
    for (int t = gw; t < NTOK; t += 2 * ngw) {
        const int t2 = t + ngw; const bool has2 = t2 < NTOK; const int tb = has2 ? t2 : t;
        f32x4 v0[8], v1[8]; v2u x0q[8], x1q[8], m0q[8], m1q[8]; float s0 = 0.f, s1 = 0.f;
#pragma unroll
        for (int j = 0; j < 8; ++j) { x0q[j] = ((const v2u*)(XB + (size_t)t * DM))[lane + 64 * j]; m0q[j] = ((const v2u*)(MIX + (size_t)t * DM))[lane + 64 * j]; }
#pragma unroll
        for (int j = 0; j < 8; ++j) { x1q[j] = ((const v2u*)(XB + (size_t)tb * DM))[lane + 64 * j]; m1q[j] = ((const v2u*)(MIX + (size_t)tb * DM))[lane + 64 * j]; }
#pragma unroll
        for (int j = 0; j < 8; ++j) {
            v0[j] = (f32x4){bf_lo(x0q[j].x), bf_hi(x0q[j].x), bf_lo(x0q[j].y), bf_hi(x0q[j].y)} * alpha + (f32x4){bf_lo(m0q[j].x), bf_hi(m0q[j].x), bf_lo(m0q[j].y), bf_hi(m0q[j].y)};
            v1[j] = (f32x4){bf_lo(x1q[j].x), bf_hi(x1q[j].x), bf_lo(x1q[j].y), bf_hi(x1q[j].y)} * alpha + (f32x4){bf_lo(m1q[j].x), bf_hi(m1q[j].x), bf_lo(m1q[j].y), bf_hi(m1q[j].y)};
            s0 += (v0[j][0] + v0[j][1]) + (v0[j][2] + v0[j][3]); s1 += (v1[j][0] + v1[j][1]) + (v1[j][2] + v1[j][3]); }
        const float m0 = wave_sum(s0) * (1.0f / DM), m1 = wave_sum(s1) * (1.0f / DM); float q0 = 0.f, q1 = 0.f;
#pragma unroll
        for (int j = 0; j < 8; ++j) { v0[j] = v0[j] - m0; v1[j] = v1[j] - m1;
            q0 += (v0[j][0] * v0[j][0] + v0[j][1] * v0[j][1]) + (v0[j][2] * v0[j][2] + v0[j][3] * v0[j][3]); q1 += (v1[j][0] * v1[j][0] + v1[j][1] * v1[j][1]) + (v1[j][2] * v1[j][2] + v1[j][3] * v1[j][3]); }
        f32x4 gq[8], bq[8];
#pragma unroll
        for (int j = 0; j < 8; ++j) { gq[j] = ((const f32x4*)g)[lane + 64 * j]; bq[j] = ((const f32x4*)b)[lane + 64 * j]; }
        const float rs0 = 1.0f / sqrtf(wave_sum(q0) * (1.0f / DM) + LN_EPS), rs1 = 1.0f / sqrtf(wave_sum(q1) * (1.0f / DM) + LN_EPS);
#pragma unroll
        for (int j = 0; j < 8; ++j) { const f32x4 gg = gq[j], bb = bq[j];
            const f32x4 o0 = v0[j] * rs0 * gg + bb;
            v2u w0; w0.x = pkbf(o0[0], o0[1]); w0.y = pkbf(o0[2], o0[3]); ((v2u*)(XB + (size_t)t * DM))[lane + 64 * j] = w0;
            if (has2) { const f32x4 o1 = v1[j] * rs1 * gg + bb;
                v2u w1; w1.x = pkbf(o1[0], o1[1]); w1.y = pkbf(o1[2], o1[3]); ((v2u*)(XB + (size_t)t2 * DM))[lane + 64 * j] = w1; } }
    }
}

__device__ __forceinline__ void transpose_item(const float* W, int K, int N, bf16* WT, LAS float* scr, int item, int lane) {
    const int nblk = N / 32, kb = item / nblk, nb = item % nblk, k0 = 64 * kb, n0 = 32 * nb;
    float wv[32];
#pragma unroll
    for (int i = 0; i < 32; ++i) { const int kk = 2 * i + (lane >> 5); wv[i] = W[(size_t)(k0 + kk) * N + n0 + (lane & 31)]; }
#pragma unroll
    for (int i = 0; i < 32; ++i) { const int kk = 2 * i + (lane >> 5); scr[kk * 33 + (lane & 31)] = wv[i]; }
    LDS_WAIT();
    const int c = lane & 7;
#pragma unroll
    for (int j = 0; j < 4; ++j) { const int n = (lane >> 3) + 8 * j; const LAS float* s = scr + (8 * c) * 33 + n;
        v4u o; o.x = pkbf(s[0 * 33], s[1 * 33]); o.y = pkbf(s[2 * 33], s[3 * 33]); o.z = pkbf(s[4 * 33], s[5 * 33]); o.w = pkbf(s[6 * 33], s[7 * 33]);
        *(v4u*)(WT + (size_t)(n0 + n) * K + k0 + 8 * c) = o; }
    LDS_WAIT();
}

__device__ __forceinline__ void p0_prologue(const Frame& F, CArgs& A) {
    {
        LAS float* scr = (LAS float*)(F.lds + F.wave * 16384);
        constexpr int I_IN = (DM / 64) * (INW / 32), I_OUT = (DM / 64) * (DM / 32), I_GLU = (512 / 64) * (512 / 32);
        constexpr int NITEMS = NLAYER * (I_IN + I_OUT + I_GLU);
        for (int it = F.gw; it < NITEMS; it += F.NGW) {
            int r = it;
            if (r < NLAYER * I_IN) { const int l = r / I_IN; { const int nb_ = (r % I_IN) % (INW / 32); if (nb_ >= 512 / 32 && nb_ < 1024 / 32) continue; }
                transpose_item(GIN(A, I_WIN) + (size_t)l * DM * INW, DM, INW, (bf16*)(F.ws + WS_WIN) + (size_t)l * INW * DM, scr, r % I_IN, F.lane); continue; }
            r -= NLAYER * I_IN;
            if (r < NLAYER * I_OUT) { const int l = r / I_OUT; transpose_item(GIN(A, I_WOUT) + (size_t)l * DM * DM, DM, DM, (bf16*)(F.ws + WS_WOUT) + (size_t)l * DM * DM, scr, r % I_OUT, F.lane); continue; }
            r -= NLAYER * I_OUT;
            { const int l = r / I_GLU; transpose_item(GIN(A, I_WGLU) + (size_t)l * 512 * 512, 512, 512, (bf16*)(F.ws + WS_WGLU) + (size_t)l * 512 * 512, scr, r % I_GLU, F.lane); }
        }
    }
    {
        const int NR2 = 2 * NLAYER * NEXP;
        for (int r = F.gw; r < NR2; r += 2 * F.NGW) {
            const int r2 = r + F.NGW < NR2 ? r + F.NGW : r;
            const int tabA = r >= NLAYER * NEXP, riA = tabA ? r - NLAYER * NEXP : r, tabB = r2 >= NLAYER * NEXP, riB = tabB ? r2 - NLAYER * NEXP : r2;
            const float* srcA = (tabA ? GIN(A, I_PV) : GIN(A, I_PU)) + (size_t)riA * DM + F.lane * 4; const float* srcB = (tabB ? GIN(A, I_PV) : GIN(A, I_PU)) + (size_t)riB * DM + F.lane * 4;
            f32x4 va[8], vb[8]; float ama = 0.f, amb = 0.f;
#pragma unroll
            for (int q = 0; q < 8; ++q) va[q] = *(const f32x4*)(srcA + q * 256);
#pragma unroll
            for (int q = 0; q < 8; ++q) vb[q] = *(const f32x4*)(srcB + q * 256);
#pragma unroll
            for (int q = 0; q < 8; ++q) { ama = fmaxf(ama, fmaxf(fmaxf(fabsf(va[q][0]), fabsf(va[q][1])), fmaxf(fabsf(va[q][2]), fabsf(va[q][3])))); amb = fmaxf(amb, fmaxf(fmaxf(fabsf(vb[q][0]), fabsf(vb[q][1])), fmaxf(fabsf(vb[q][2]), fabsf(vb[q][3])))); }
#pragma unroll
            for (int o = 1; o < 64; o <<= 1) { ama = fmaxf(ama, __shfl_xor(ama, o)); amb = fmaxf(amb, __shfl_xor(amb, o)); }
#pragma unroll
            for (int half = 0; half < 2; ++half) {
                if (half == 1 && r2 == r) break;
                const float am = half ? amb : ama; const int tab = half ? tabB : tabA, ri = half ? riB : riA;
                const float sc = am > 0.f ? 6.0f / am : 1.0f, isc = am > 0.f ? am * (1.0f / 6.0f) : 1.0f;
                v4u w;
#pragma unroll
                for (int q = 0; q < 4; ++q) { const f32x4 e0 = half ? vb[2 * q] : va[2 * q], e1 = half ? vb[2 * q + 1] : va[2 * q + 1]; unsigned pk = 0u;
                    pk = __builtin_amdgcn_cvt_scalef32_pk_fp4_f32(pk, e0[0] * sc, e0[1] * sc, 1.0f, 0); pk = __builtin_amdgcn_cvt_scalef32_pk_fp4_f32(pk, e0[2] * sc, e0[3] * sc, 1.0f, 1);
                    pk = __builtin_amdgcn_cvt_scalef32_pk_fp4_f32(pk, e1[0] * sc, e1[1] * sc, 1.0f, 2); pk = __builtin_amdgcn_cvt_scalef32_pk_fp4_f32(pk, e1[2] * sc, e1[3] * sc, 1.0f, 3);
                    w[q] = pk; }
                *(v4u*)(F.ws + (tab ? WS_V8 : WS_U8) + (size_t)ri * (DM / 2) + F.lane * 16) = w;
                if (F.lane == 0) ((float*)(F.ws + (tab ? WS_VSC : WS_USC)))[ri] = isc;
            }
        }
    }
    {
        const float* win = GIN(A, I_WIN); const float* pw = GIN(A, I_POOLW); const float* ps = GIN(A, I_POOLS); bf16* wt = (bf16*)(F.ws + WS_WIN);
        for (size_t it = F.gtid; it < (size_t)NLAYER * 512 * 256; it += F.NT) {
            const int n = (int)(it & 511), k8 = (int)((it >> 9) & 255), l = (int)(it >> 17), g = n >> 7, d = n & 127;
            float acc[8];
#pragma unroll
            for (int kk = 0; kk < 8; ++kk) acc[kk] = 0.f;
            const float* wrow = win + ((size_t)l * DM + k8 * 8) * INW + 512 + g * 128; const float* pcol = pw + ((size_t)(l * 4 + g) * 128) * 128 + d;
            for (int c4 = 0; c4 < 32; ++c4) {
                f32x4 wv[8];
#pragma unroll
                for (int kk = 0; kk < 8; ++kk) wv[kk] = *(const f32x4*)(wrow + (size_t)kk * INW + c4 * 4);
#pragma unroll
                for (int e = 0; e < 4; ++e) { const float pv = pcol[(size_t)(c4 * 4 + e) * 128];
#pragma unroll
                    for (int kk = 0; kk < 8; ++kk) acc[kk] += wv[kk][e] * pv; }
            }
            const float sc = ps[l * 512 + n];
#pragma unroll
            for (int kk = 0; kk < 8; ++kk) acc[kk] *= sc;
            *(v4u*)(wt + ((size_t)l * INW + 512 + n) * DM + k8 * 8) = pack8(acc);
        }
    }
    {
        const float* lre = GIN(A, I_LAMRE); const float* lim = GIN(A, I_LAMIM); const float* lst = GIN(A, I_LOGSTEP); const float* bre = GIN(A, I_BRE); const float* bim = GIN(A, I_BIM);
        f32x2v* ab = (f32x2v*)(F.ws + WS_S5A); f32x2v* ab64 = (f32x2v*)(F.ws + WS_S5A + 512 * 1024); f32x2v* bb = (f32x2v*)(F.ws + WS_S5B);
        for (size_t i = F.gtid; i < (size_t)NLAYER * 2 * 32 * 64; i += F.NT) {
            const float lr = lre[i], li = lim[i], dt = expf(lst[i >> 6]);
            const float mag = expf(lr * dt), ar = mag * cosf(li * dt), ai = mag * sinf(li * dt);
            const float den = lr * lr + li * li;
            const float zr = ((ar - 1.0f) * lr + ai * li) / den, zi = (ai * lr - (ar - 1.0f) * li) / den;
            ab[i] = (f32x2v){ar, ai};
            const float m64 = expf(lr * dt * 64.0f), an = li * dt * 64.0f;
            ab64[i] = (f32x2v){m64 * cosf(an), m64 * sinf(an)};
#pragma unroll
            for (int c = 0; c < 16; ++c) { const float br = bre[i * 16 + c], bi = bim[i * 16 + c]; bb[i * 16 + c] = (f32x2v){zr * br - zi * bi, zr * bi + zi * br}; }
            {
                bf16* o = (bf16*)(F.ws + WS_S5BB) + ((size_t)(i >> 6) * 128 + 2 * (i & 63)) * 32;
#pragma unroll
                for (int c = 0; c < 16; ++c) { const float br = bre[i * 16 + c], bi = bim[i * 16 + c]; o[c] = f2bf(zr * br - zi * bi); o[32 + c] = f2bf(zr * bi + zi * br); o[16 + c] = 0; o[48 + c] = 0; }
            }
        }
    }
    {
        float* rc = (float*)(F.ws + WS_ROTC); float* rs = (float*)(F.ws + WS_ROTS);
        for (size_t i = F.gtid; i < (size_t)8192 * 128; i += F.NT) { const float inv = (float)exp(-(double)(i & 127) / 127.0 * 9.210340371976184); const float ang = (float)(i >> 7) * inv; rc[i] = cosf(ang); rs[i] = sinf(ang); }
    }
    __syncthreads();
    {
        LAS float* KS = (LAS float*)F.lds;
        LAS float* WQ = (LAS float*)(F.lds + 128 * 132 * 4);
        const float* keys = GIN(A, I_KEYS); const float* wq = GIN(A, I_WQ); bf16* wst = (bf16*)(F.ws + WS_WS);
        for (int u = F.bx; u < NLAYER * 16 * 32; u += F.G) {
            const int dtl = u & 31, hp = (u >> 5) & 15, l = u >> 9, p = hp & 1;
#pragma unroll
            for (int r = 0; r < 8; ++r) { const int f = F.tid + 512 * r, nk = f >> 5, c4 = f & 31;
                *(LAS f32x4*)(KS + nk * 132 + c4 * 4) = *(const f32x4*)(keys + (((size_t)l * 2 + p) * 128 + nk) * 128 + c4 * 4); }
#pragma unroll
            for (int r = 0; r < 4; ++r) { const int f = F.tid + 512 * r, dd = f >> 5, c4 = f & 31;
                *(LAS f32x4*)(WQ + dd * 132 + c4 * 4) = *(const f32x4*)(wq + ((size_t)l * DM + dtl * 64 + dd) * DM + hp * 128 + c4 * 4); }
            __syncthreads();
            const int nt = F.wave, lr = F.lane & 15, lq = F.lane >> 4;
            f32x4 acc[4];
#pragma unroll
            for (int dt = 0; dt < 4; ++dt) acc[dt] = (f32x4){0.f, 0.f, 0.f, 0.f};
#pragma unroll 4
            for (int ks = 0; ks < 32; ++ks) {
                const float kb = KS[(nt * 16 + lr) * 132 + 4 * ks + lq];
#pragma unroll
                for (int dt = 0; dt < 4; ++dt) { const float wa = WQ[(dt * 16 + lr) * 132 + 4 * ks + lq]; acc[dt] = __builtin_amdgcn_mfma_f32_16x16x4f32(wa, kb, acc[dt], 0, 0, 0); }
            }
            bf16* o = wst + ((size_t)l * DM + hp * 128 + nt * 16 + lr) * DM + dtl * 64 + 4 * lq;
#pragma unroll
            for (int dt = 0; dt < 4; ++dt) { v2u w; w.x = pkbf(acc[dt][0], acc[dt][1]); w.y = pkbf(acc[dt][2], acc[dt][3]); *(v2u*)(o + dt * 16) = w; }
            __syncthreads();
        }
    }
    {
        const float* xp = GIN(A, I_XP); const float* xs = GIN(A, I_XS); const float* g = GIN(A, I_LNIN_G); const float* b = GIN(A, I_LNIN_B); bf16* XB = (bf16*)(F.ws + WS_XN);
        for (int t = F.gw; t < NTOK; t += 2 * F.NGW) {
            const int t2 = t + F.NGW; const bool has2 = t2 < NTOK; const int tb = has2 ? t2 : t;
            const float* s0p = t < 32768 ? xp + (size_t)t * DM : xs + (size_t)(t - 32768) * DM; const float* s1p = tb < 32768 ? xp + (size_t)tb * DM : xs + (size_t)(tb - 32768) * DM;
            f32x4 v0[8], v1[8]; float s0 = 0.f, s1 = 0.f;
#pragma unroll
            for (int j = 0; j < 8; ++j) v0[j] = ((const f32x4*)s0p)[F.lane + 64 * j];
#pragma unroll
            for (int j = 0; j < 8; ++j) v1[j] = ((const f32x4*)s1p)[F.lane + 64 * j];
#pragma unroll
            for (int j = 0; j < 8; ++j) { s0 += (v0[j][0] + v0[j][1]) + (v0[j][2] + v0[j][3]); s1 += (v1[j][0] + v1[j][1]) + (v1[j][2] + v1[j][3]); }
            const float m0 = wave_sum(s0) * (1.0f / DM), m1 = wave_sum(s1) * (1.0f / DM); float q0 = 0.f, q1 = 0.f;
#pragma unroll
            for (int j = 0; j < 8; ++j) { v0[j] = v0[j] - m0; v1[j] = v1[j] - m1;
                q0 += (v0[j][0] * v0[j][0] + v0[j][1] * v0[j][1]) + (v0[j][2] * v0[j][2] + v0[j][3] * v0[j][3]); q1 += (v1[j][0] * v1[j][0] + v1[j][1] * v1[j][1]) + (v1[j][2] * v1[j][2] + v1[j][3] * v1[j][3]); }
            const float rs0 = 1.0f / sqrtf(wave_sum(q0) * (1.0f / DM) + LN_EPS), rs1 = 1.0f / sqrtf(wave_sum(q1) * (1.0f / DM) + LN_EPS);
#pragma unroll
            for (int j = 0; j < 8; ++j) { const f32x4 gg = ((const f32x4*)g)[F.lane + 64 * j], bb = ((const f32x4*)b)[F.lane + 64 * j];
                const f32x4 o0 = v0[j] * rs0 * gg + bb;
                v2u w0; w0.x = pkbf(o0[0], o0[1]); w0.y = pkbf(o0[2], o0[3]); ((v2u*)(XB + (size_t)t * DM))[F.lane + 64 * j] = w0;
                if (has2) { const f32x4 o1 = v1[j] * rs1 * gg + bb;
                    v2u w1; w1.x = pkbf(o1[0], o1[1]); w1.y = pkbf(o1[2], o1[3]); ((v2u*)(XB + (size_t)t2 * DM))[F.lane + 64 * j] = w1; } }
        }
    }
}

__device__ __forceinline__ float ret_log2_gamma(int h) { return log2f(1.0f - exp2f(-5.0f - (float)h)); }

__device__ __forceinline__ void s5_pass1(const Frame& F, CArgs& A, int l) {
    LAS float* BUs = (LAS float*)(F.lds + F.wave * 8448);
    const bf16* H = (const bf16*)(F.ws + WS_H);
    const f32x2v* ab = (const f32x2v*)(F.ws + WS_S5A); const bf16* BB = (const bf16*)(F.ws + WS_S5BB);
    f32x2v* st = (f32x2v*)(F.ws + WS_S5ST);
    const int lane = F.lane, lr = lane & 15, lq = lane >> 4;
    const int gstep = F.G < 32 ? F.G : 32;
    for (int g = F.bx % 32; g < 32; g += gstep) {
        const int nwg = F.G < 32 ? 1 : (F.G - g + 31) / 32, rank = F.G < 32 ? 0 : F.bx / 32;
        bf16x8 Bop[2][8]; f32x2v a2[2], arot[2];
#pragma unroll
        for (int dir = 0; dir < 2; ++dir) { const int gi = (l * 2 + dir) * 32 + g; a2[dir] = ab[gi * 64 + lane]; arot[dir] = (f32x2v){-a2[dir][1], a2[dir][1]};
#pragma unroll
            for (int j = 0; j < 8; ++j) Bop[dir][j] = *(const bf16x8*)(BB + ((size_t)gi * 128 + 16 * j + lr) * 32 + lq * 8); }
        const int ck1 = rank * NWAVES + F.wave, ckst = nwg * NWAVES;
        v4u unx[4];
#pragma unroll
        for (int tb = 0; tb < 4; ++tb) unx[tb] = (lq < 2 && ck1 < 640) ? *(const v4u*)(H + (size_t)(ck1 * 64 + 16 * tb + lr) * INW + COL_UA + g * 16 + lq * 8) : (v4u){0u, 0u, 0u, 0u};
        for (int ck = ck1; ck < 640; ck += ckst) {
            bf16x8 uop[4];
#pragma unroll
            for (int tb = 0; tb < 4; ++tb) uop[tb] = __builtin_bit_cast(bf16x8, unx[tb]);
            { const int cn = ck + ckst < 640 ? ck + ckst : ck;
#pragma unroll
              for (int tb = 0; tb < 4; ++tb) unx[tb] = lq < 2 ? *(const v4u*)(H + (size_t)(cn * 64 + 16 * tb + lr) * INW + COL_UA + g * 16 + lq * 8) : (v4u){0u, 0u, 0u, 0u}; }
#pragma unroll
            for (int dir = 0; dir < 2; ++dir) {
                f32x2v x2 = (f32x2v){0.f, 0.f};
#pragma unroll
                for (int blk = 0; blk < 4; ++blk) {
                    const int tb = dir ? 3 - blk : blk;
#pragma unroll
                    for (int j = 0; j < 8; ++j) { const f32x4 d = MFMA16(Bop[dir][j], uop[tb], ((f32x4){0.f, 0.f, 0.f, 0.f}));
                        *(LAS f32x4*)(BUs + lr * 132 + 16 * j + 4 * lq) = d; }
                    LDS_WAIT();
#pragma unroll
                    for (int s = 0; s < 16; ++s) { const int tl = dir ? 15 - s : s;
                        const f32x2v bu = *(const LAS f32x2v*)(BUs + tl * 132 + 2 * lane);
                        x2 = x2 * a2[dir][0] + (arot[dir] * (f32x2v){x2[1], x2[0]} + bu); }
                    LDS_WAIT();
                }
                st[(size_t)((ck * 32 + g) * 2 + dir) * 64 + lane] = x2;
            }
        }
    }
}
__device__ __forceinline__ void s5_carry(const Frame& F, CArgs& A, int l) {
    const f32x2v* ab64 = (const f32x2v*)(F.ws + WS_S5A + 512 * 1024); f32x2v* st = (f32x2v*)(F.ws + WS_S5ST);
    for (size_t it = F.gtid; it < (size_t)9 * 32 * 2 * 64; it += F.NT) {
        const int p = (int)(it & 63), dir = (int)((it >> 6) & 1), g = (int)((it >> 7) & 31), s = (int)(it >> 12);
        const int ck0 = s < 8 ? s * 64 : 512, n = s < 8 ? 64 : 128;
        const f32x2v a = ab64[((l * 2 + dir) * 32 + g) * 64 + p];
        float cr = 0.f, ci = 0.f;
        for (int k0 = 0; k0 < n; k0 += 8) {
            f32x2v le[8];
#pragma unroll
            for (int kk = 0; kk < 8; ++kk) { const int ck = dir ? (ck0 + n - 1 - (k0 + kk)) : (ck0 + k0 + kk); le[kk] = st[(size_t)((ck * 32 + g) * 2 + dir) * 64 + p]; }
#pragma unroll
            for (int kk = 0; kk < 8; ++kk) { const int ck = dir ? (ck0 + n - 1 - (k0 + kk)) : (ck0 + k0 + kk);
                st[(size_t)((ck * 32 + g) * 2 + dir) * 64 + p] = (f32x2v){cr, ci};
                const float ncr = a[0] * cr - a[1] * ci + le[kk][0], nci = a[0] * ci + a[1] * cr + le[kk][1]; cr = ncr; ci = nci; }
        }
    }
}
__device__ __forceinline__ void s5_pass3(const Frame& F, CArgs& A, int l) {
    LAS bf16* CtS = (LAS bf16*)F.lds;
    LAS unsigned char* wb = F.lds + 8704 + F.wave * 12800;
    LAS float* BUs = (LAS float*)wb;
    LAS bf16* Xw = (LAS bf16*)(wb + 8448);
    const bf16* H = (const bf16*)(F.ws + WS_H); bf16* BY = (bf16*)(F.ws + WS_BUFY);
    const f32x2v* ab = (const f32x2v*)(F.ws + WS_S5A); const bf16* BB = (const bf16*)(F.ws + WS_S5BB);
    const f32x2v* st = (const f32x2v*)(F.ws + WS_S5ST);
    const float* cre = GIN(A, I_CRE); const float* cim = GIN(A, I_CIM); const float* dvec = GIN(A, I_S5D) + (size_t)l * 512;
    const int lane = F.lane, lr = lane & 15, lq = lane >> 4;
    const int gstep = F.G < 32 ? F.G : 32;
    for (int g = F.bx % 32; g < 32; g += gstep) {
        const int nwg = F.G < 32 ? 1 : (F.G - g + 31) / 32, rank = F.G < 32 ? 0 : F.bx / 32;
        __syncthreads();
        {
            const int tq = opaque(F.tid);
#pragma unroll
            for (int r = 0; r < 8; ++r) { const int e = tq + 512 * r, pp = e & 127, c = (e >> 7) & 15, dir = e >> 11;
                const size_t cb = (size_t)(((l * 2 + dir) * 32 + g) * 16 + c) * 64;
                CtS[(dir * 16 + c) * 136 + pp] = f2bf((pp & 1) ? -cim[cb + (pp >> 1)] : cre[cb + (pp >> 1)]); }
        }
        bf16x8 Bop[2][8]; f32x2v a2[2], arot[2];
#pragma unroll
        for (int dir = 0; dir < 2; ++dir) { const int gi = (l * 2 + dir) * 32 + g; a2[dir] = ab[gi * 64 + lane]; arot[dir] = (f32x2v){-a2[dir][1], a2[dir][1]};
#pragma unroll
            for (int j = 0; j < 8; ++j) Bop[dir][j] = *(const bf16x8*)(BB + ((size_t)gi * 128 + 16 * j + lr) * 32 + lq * 8); }
        __syncthreads();
        const int ck1 = rank * NWAVES + F.wave, ckst = nwg * NWAVES;
        const f32x4 dv4 = *(const f32x4*)(dvec + g * 16 + 4 * lq);
        v4u unx[4]; v2u uqn[4]; f32x2v xinn[2];
        { const int c1 = ck1 < 640 ? ck1 : 0;
#pragma unroll
          for (int tb = 0; tb < 4; ++tb) unx[tb] = lq < 2 ? *(const v4u*)(H + (size_t)(c1 * 64 + 16 * tb + lr) * INW + COL_UA + g * 16 + lq * 8) : (v4u){0u, 0u, 0u, 0u};
#pragma unroll
          for (int dir = 0; dir < 2; ++dir) xinn[dir] = st[(size_t)((c1 * 32 + g) * 2 + dir) * 64 + lane];
#pragma unroll
          for (int m = 0; m < 4; ++m) uqn[m] = *(const v2u*)(H + (size_t)(c1 * 64 + 16 * m + lr) * INW + COL_UA + g * 16 + 4 * lq); }
        for (int ck = ck1; ck < 640; ck += ckst) {
            bf16x8 uop[4]; f32x2v xin[2]; v2u uq4[4];
#pragma unroll
            for (int tb = 0; tb < 4; ++tb) uop[tb] = __builtin_bit_cast(bf16x8, unx[tb]);
#pragma unroll
            for (int dir = 0; dir < 2; ++dir) xin[dir] = xinn[dir];
#pragma unroll
            for (int m = 0; m < 4; ++m) uq4[m] = uqn[m];
            { const int cn = ck + ckst < 640 ? ck + ckst : ck;
#pragma unroll
              for (int tb = 0; tb < 4; ++tb) unx[tb] = lq < 2 ? *(const v4u*)(H + (size_t)(cn * 64 + 16 * tb + lr) * INW + COL_UA + g * 16 + lq * 8) : (v4u){0u, 0u, 0u, 0u};
#pragma unroll
              for (int dir = 0; dir < 2; ++dir) xinn[dir] = st[(size_t)((cn * 32 + g) * 2 + dir) * 64 + lane];
#pragma unroll
              for (int m = 0; m < 4; ++m) uqn[m] = *(const v2u*)(H + (size_t)(cn * 64 + 16 * m + lr) * INW + COL_UA + g * 16 + 4 * lq); }
            f32x4 Y[4];
#pragma unroll
            for (int m = 0; m < 4; ++m) Y[m] = (f32x4){0.f, 0.f, 0.f, 0.f};
#pragma unroll
            for (int dir = 0; dir < 2; ++dir) {
                f32x2v x2 = xin[dir];
#pragma unroll
                for (int blk = 0; blk < 4; ++blk) {
                    const int tb = dir ? 3 - blk : blk;
#pragma unroll
                    for (int j = 0; j < 8; ++j) { const f32x4 d = MFMA16(Bop[dir][j], uop[tb], ((f32x4){0.f, 0.f, 0.f, 0.f}));
                        *(LAS f32x4*)(BUs + lr * 132 + 16 * j + 4 * lq) = d; }
                    LDS_WAIT();
#pragma unroll
                    for (int s = 0; s < 16; ++s) { const int tl = dir ? 15 - s : s;
                        const f32x2v bu = *(const LAS f32x2v*)(BUs + tl * 132 + 2 * lane);
                        x2 = x2 * a2[dir][0] + (arot[dir] * (f32x2v){x2[1], x2[0]} + bu);
                        *(LAS unsigned*)(Xw + tl * 136 + 2 * lane) = pkbf(x2[0], x2[1]); }
                    LDS_WAIT();
#pragma unroll
                    for (int ks = 0; ks < 4; ++ks) {
                        const bf16x8 av = *(const LAS bf16x8*)(CtS + (dir * 16 + lr) * 136 + 32 * ks + lq * 8);
                        const bf16x8 bv = *(const LAS bf16x8*)(Xw + lr * 136 + 32 * ks + lq * 8);
                        Y[tb] = MFMA16(av, bv, Y[tb]);
                    }
                    LDS_WAIT();
                }
            }
#pragma unroll
            for (int m = 0; m < 4; ++m) {
                const int t = 16 * m + lr, c0 = 4 * lq;
                const v2u uq = uq4[m];
                const f32x4 uv = (f32x4){bf_lo(uq.x), bf_hi(uq.x), bf_lo(uq.y), bf_hi(uq.y)}; const f32x4 dv = dv4;
                const f32x4 y = Y[m] + dv * uv;
                v2u w; w.x = pkbf(gelu_erf(y[0]), gelu_erf(y[1])); w.y = pkbf(gelu_erf(y[2]), gelu_erf(y[3]));
                *(v2u*)(BY + (size_t)(ck * 64 + t) * 512 + g * 16 + c0) = w;
            }
        }
    }
}
__device__ __forceinline__ void pool_phase(const Frame& F, CArgs& A) {
    const bf16* H = (const bf16*)(F.ws + WS_H); bf16* CCp = (bf16*)(F.ws + WS_CONCAT) + 512;
    for (size_t it = F.gtid; it < (size_t)(NTOK / 8) * 64; it += F.NT) {
        const int r = (int)(it >> 6), o = (int)(it & 63), gi = o >> 4, half = 1 << gi;
        const int t0 = r * 8, pos0 = tok_pos(t0), L = tok_len(t0);
        const bf16* base = H + (size_t)(t0 - pos0) * INW + COL_UB + o * 8;
        v4u wq[23];
#pragma unroll
        for (int sl = 0; sl < 23; ++sl) { const int q = pos0 - 8 + sl; const int qc = q < 0 ? 0 : (q > L - 1 ? L - 1 : q); wq[sl] = *(const v4u*)(base + (size_t)qc * INW); }
#pragma unroll
        for (int i = 0; i < 8; ++i) {
            const int pos = pos0 + i;
            const int lo = max(pos - half, 0), hi = min(pos + half - 1, L - 1);
            float s[8];
#pragma unroll
            for (int k = 0; k < 8; ++k) s[k] = 0.f;
#pragma unroll
            for (int k = 0; k < 16; ++k) { const int q = pos - 8 + k; float f[8]; unpack8(wq[i + k], f); const float wgt = (q >= lo && q <= hi) ? 1.0f : 0.0f;
#pragma unroll
                for (int c = 0; c < 8; ++c) s[c] += wgt * f[c]; }
            const float inv = 1.0f / (float)(hi - lo + 1);
            float c[8]; unpack8(wq[8 + i], c);
#pragma unroll
            for (int k = 0; k < 8; ++k) s[k] = s[k] * inv - c[k];
            *(v4u*)(CCp + (size_t)(t0 + i) * DM + o * 8) = pack8(s);
        }
    }
}
constexpr int RS = 136;
template <int MODE = 0> __device__ __forceinline__ void ret_state_phase(const Frame& F, CArgs& A, unsigned* ctr = nullptr) {
    const bf16* H = (const bf16*)(F.ws + WS_H); bf16* STF = (bf16*)(F.ws + WS_STF); bf16* STB = (bf16*)(F.ws + WS_STB);
    LAS bf16* Kt = (LAS bf16*)F.lds; LAS bf16* VtF = Kt + 128 * RS; LAS bf16* VtB = Kt + 256 * RS;
    LAS unsigned* Kt32 = (LAS unsigned*)Kt; LAS unsigned* VtF32 = (LAS unsigned*)VtF; LAS unsigned* VtB32 = (LAS unsigned*)VtB;
    const int tid = F.tid, lane = F.lane, lr = lane & 15, lq = lane >> 4, we = F.wave >> 1, wd = F.wave & 1;
    const int jp = tid & 63, j = 2 * jp, pc0 = tid >> 6;
    v4u pk0[2], pk1[2], pv0[2], pv1[2];
#define RS_LOAD(u_) do { const int dh_ = (u_) & 1, eh_ = ((u_) >> 1) & 1, h_ = ((u_) >> 2) & 3, c_ = (u_) >> 4; \
        const bf16* krow_ = H + (size_t)(c_ * 128 + j) * INW + COL_K + h_ * 256 + dh_ * 128; const bf16* vrow_ = H + (size_t)(c_ * 128 + j) * INW + COL_V + h_ * 256 + eh_ * 128; \
        _Pragma("unroll") for (int r = 0; r < 2; ++r) { const int pc = pc0 + 8 * r; pk0[r] = *(const v4u*)(krow_ + pc * 8); pk1[r] = *(const v4u*)(krow_ + INW + pc * 8); pv0[r] = *(const v4u*)(vrow_ + pc * 8); pv1[r] = *(const v4u*)(vrow_ + INW + pc * 8); } } while (0)
    if (F.bx < 5120) RS_LOAD(F.bx);
    volatile LAS int* NXT = (volatile LAS int*)(F.lds + LDS_MISC) + 16;
    int un = F.bx + F.G, pend = 0;
    if (ctr && tid == 0) pend = 2 * F.G + (int)__hip_atomic_fetch_add(ctr, 1u, __ATOMIC_RELAXED, __HIP_MEMORY_SCOPE_AGENT);
    for (int u = F.bx; u < 5120;) {
        const int dh = u & 1, eh = (u >> 1) & 1, h = (u >> 2) & 3, c = u >> 4;
        if (MODE != 2) {
            const float lg = ret_log2_gamma(h), fF0 = exp2f(lg * (float)(127 - j)), fF1 = exp2f(lg * (float)(126 - j)), fB0 = exp2f(lg * (float)j), fB1 = exp2f(lg * (float)(j + 1));
#pragma unroll
            for (int r = 0; r < 2; ++r) {
                const int pc = pc0 + 8 * r;
                const unsigned ka0[4] = {pk0[r].x, pk0[r].y, pk0[r].z, pk0[r].w}, ka1[4] = {pk1[r].x, pk1[r].y, pk1[r].z, pk1[r].w};
                float f0[8], f1[8]; unpack8(pv0[r], f0); unpack8(pv1[r], f1);
#pragma unroll
                for (int i = 0; i < 8; ++i) {
                    const unsigned a = ka0[i >> 1], b = ka1[i >> 1];
                    const unsigned kk = (i & 1) ? ((a >> 16) | (b & 0xffff0000u)) : ((a & 0xffffu) | (b << 16));
                    const int o = ((pc * 8 + i) * RS) / 2 + jp;
                    Kt32[o] = kk; VtF32[o] = pkbf(f0[i] * fF0, f1[i] * fF1); VtB32[o] = pkbf(f0[i] * fB0, f1[i] * fB1);
                }
            }
        }
        if (ctr && tid == 0) { NXT[0] = pend; pend = 2 * F.G + (int)__hip_atomic_fetch_add(ctr, 1u, __ATOMIC_RELAXED, __HIP_MEMORY_SCOPE_AGENT); }
        __syncthreads();
        const int unn = ctr ? NXT[0] : un + F.G;
        if (un < 5120) RS_LOAD(un);
        if (MODE == 1) { __syncthreads(); u = un; un = unn; continue; }
        f32x4 aF[4][2], aB[4][2];
#pragma unroll
        for (int td = 0; td < 4; ++td)
#pragma unroll
            for (int te = 0; te < 2; ++te) { aF[td][te] = (f32x4){0.f, 0.f, 0.f, 0.f}; aB[td][te] = (f32x4){0.f, 0.f, 0.f, 0.f}; }
#pragma unroll
        for (int ks = 0; ks < 4; ++ks) {
            bf16x8 ka[4], vF[2], vB[2];
#pragma unroll
            for (int td = 0; td < 4; ++td) ka[td] = *(const LAS bf16x8*)(Kt + (64 * wd + 16 * td + lr) * RS + 32 * ks + lq * 8);
#pragma unroll
            for (int te = 0; te < 2; ++te) { vF[te] = *(const LAS bf16x8*)(VtF + (32 * we + 16 * te + lr) * RS + 32 * ks + lq * 8); vB[te] = *(const LAS bf16x8*)(VtB + (32 * we + 16 * te + lr) * RS + 32 * ks + lq * 8); }
#pragma unroll
            for (int td = 0; td < 4; ++td)
#pragma unroll
                for (int te = 0; te < 2; ++te) { aF[td][te] = MFMA16(ka[td], vF[te], aF[td][te]); aB[td][te] = MFMA16(ka[td], vB[te], aB[td][te]); }
        }
        __syncthreads();
        {
            LAS bf16* OutF = Kt; LAS bf16* OutB = Kt + 128 * RS;
#pragma unroll
            for (int td = 0; td < 4; ++td)
#pragma unroll
                for (int te = 0; te < 2; ++te) {
                    const int e = 32 * we + 16 * te + lr, d = 64 * wd + 16 * td + 4 * lq;
                    v2u w; w.x = pkbf(aF[td][te][0], aF[td][te][1]); w.y = pkbf(aF[td][te][2], aF[td][te][3]); *(LAS v2u*)(OutF + e * RS + d) = w;
                    v2u x; x.x = pkbf(aB[td][te][0], aB[td][te][1]); x.y = pkbf(aB[td][te][2], aB[td][te][3]); *(LAS v2u*)(OutB + e * RS + d) = x;
                }
            __syncthreads();
            const int tq = opaque(tid);
#pragma unroll
            for (int r = 0; r < 8; ++r) { const int f = tq + 512 * r, mat = f >> 11, row = (f >> 4) & 127, pc = f & 15;
                const v4u q = *(const LAS v4u*)(Kt + (mat * 128 + row) * RS + pc * 8);
                bf16* dst = (mat ? STB : STF) + ((size_t)(c * 4 + h) * 256 + eh * 128 + row) * 256 + dh * 128 + pc * 8;
                *(v4u*)dst = q; }
        }
        __syncthreads();
        u = un; un = unn;
    }
#undef RS_LOAD
}
__device__ __forceinline__ void ret_prefix_phase(const Frame& F, CArgs& A) {
    bf16* STF = (bf16*)(F.ws + WS_STF); bf16* STB = (bf16*)(F.ws + WS_STB);
    for (size_t it = F.gtid; it < (size_t)36 * 2 * 8192; it += F.NT) {
        const int o = (int)(it & 8191), which = (int)((it >> 13) & 1), bh = (int)(it >> 14), h = bh & 3, s = bh >> 2;
        const int c0 = s < 8 ? s * 32 : 256, n = s < 8 ? 32 : 64;
        const float dec = exp2f(128.0f * ret_log2_gamma(h));
        float st[8];
#pragma unroll
        for (int k = 0; k < 8; ++k) st[k] = 0.f;
        bf16* base = (which ? STB : STF) + (size_t)h * 65536 + (size_t)o * 8;
        for (int k0 = 0; k0 < n; k0 += 8) {
            v4u q[8];
#pragma unroll
            for (int kk = 0; kk < 8; ++kk) { const int c = which ? (c0 + n - 1 - (k0 + kk)) : (c0 + k0 + kk); q[kk] = *(const v4u*)(base + (size_t)c * 4 * 65536); }
#pragma unroll
            for (int kk = 0; kk < 8; ++kk) { const int c = which ? (c0 + n - 1 - (k0 + kk)) : (c0 + k0 + kk);
                float f[8]; unpack8(q[kk], f);
#pragma unroll
                for (int i = 0; i < 8; ++i) st[i] = dec * st[i] + f[i];
                *(v4u*)(base + (size_t)c * 4 * 65536) = pack8(st); }
        }
    }
}
__device__ __forceinline__ void ret_out_phase(const Frame& F, CArgs& A) {
    const bf16* H = (const bf16*)(F.ws + WS_H); const bf16* STF = (const bf16*)(F.ws + WS_STF); const bf16* STB = (const bf16*)(F.ws + WS_STB);
    bf16* CC = (bf16*)(F.ws + WS_CONCAT);
    LAS bf16* RA = (LAS bf16*)F.lds; LAS bf16* RB = RA + 128 * RS; LAS bf16* RC = RA + 384 * RS;
    const int tid = F.tid, wi = F.wave >> 2, wj = F.wave & 3, we = F.wave & 3;
    v4u pa[4], pb[8];
#define RO_LOAD_QK_AT(t0_, h_, dh_, tq_) do { _Pragma("unroll") for (int r = 0; r < 4; ++r) { const int f = (tq_) + 512 * r, row = f >> 4, pc = f & 15; \
            const bf16* src = H + (size_t)((t0_) + row) * INW + (h_) * 256 + (dh_) * 128 + pc * 8; pa[r] = *(const v4u*)(src + COL_Q); pb[r] = *(const v4u*)(src + COL_K); } } while (0)
    if (F.bx < 1280) { const int tq0 = opaque(tid); RO_LOAD_QK_AT((F.bx >> 2) * 128, F.bx & 3, 0, tq0); }
    for (int u = F.bx; u < 1280; u += F.G) {
        const int lane = opaque(F.lane), lr = lane & 15, lq = lane >> 4;
        const int h = u & 3, c = u >> 2, t0 = c * 128;
        const int cs = c < 256 ? (c & 31) : (c - 256), ncs = c < 256 ? 32 : 64;
        const bool has_f = cs > 0, has_b = cs < ncs - 1;
        const float lg = ret_log2_gamma(h);
        const int tq = opaque(tid);
#define RO_LOAD_QK(dh_) do { _Pragma("unroll") for (int r = 0; r < 4; ++r) { const int f = tq + 512 * r, row = f >> 4, pc = f & 15; \
            const bf16* src = H + (size_t)(t0 + row) * INW + h * 256 + (dh_) * 128 + pc * 8; pa[r] = *(const v4u*)(src + COL_Q); pb[r] = *(const v4u*)(src + COL_K); } } while (0)
#define RO_STORE_QK() do { _Pragma("unroll") for (int r = 0; r < 4; ++r) { const int f = tq + 512 * r, row = f >> 4, pc = f & 15; \
            *(LAS v4u*)(RA + row * RS + pc * 8) = pa[r]; *(LAS v4u*)(RB + row * RS + pc * 8) = pb[r]; } } while (0)
#define RO_LOAD_V() do { const int jp_ = tq & 63, pc0_ = tq >> 6; const bf16* vrow = H + (size_t)(t0 + 2 * jp_) * INW + COL_V + h * 256; \
            _Pragma("unroll") for (int r = 0; r < 4; ++r) { const int pc = pc0_ + 8 * r; pb[r] = *(const v4u*)(vrow + pc * 8); pb[4 + r] = *(const v4u*)(vrow + INW + pc * 8); } } while (0)
#define RO_STORE_V() do { const int jp_ = tq & 63, pc0_ = tq >> 6; LAS unsigned* RB32 = (LAS unsigned*)RB; \
            _Pragma("unroll") for (int r = 0; r < 4; ++r) { const int pc = pc0_ + 8 * r; \
                const unsigned va0[4] = {pb[r].x, pb[r].y, pb[r].z, pb[r].w}, va1[4] = {pb[4 + r].x, pb[4 + r].y, pb[4 + r].z, pb[4 + r].w}; \
                _Pragma("unroll") for (int i = 0; i < 8; ++i) { const unsigned a = va0[i >> 1], b = va1[i >> 1]; \
                    RB32[((pc * 8 + i) * RS) / 2 + jp_] = (i & 1) ? ((a >> 16) | (b & 0xffff0000u)) : ((a & 0xffffu) | (b << 16)); } } } while (0)
#define RO_LOAD_I(dir_, dh_) do { const bool has_ = (dir_) == 0 ? has_f : has_b; const int cn_ = (dir_) == 0 ? c - 1 : c + 1; \
            const bf16* St = ((dir_) == 0 ? STF : STB) + (size_t)((has_ ? cn_ : c) * 4 + h) * 65536; \
            _Pragma("unroll") for (int r = 0; r < 8; ++r) { const int f = tq + 512 * r, row = f >> 4, pc = f & 15; pb[r] = has_ ? *(const v4u*)(St + (size_t)row * 256 + (dh_) * 128 + pc * 8) : (v4u){0u, 0u, 0u, 0u}; } } while (0)
#define RO_STORE_I(dir_, dh_) do { \
            _Pragma("unroll") for (int r = 0; r < 4; ++r) { const int f = tq + 512 * r, row = f >> 4, pc = f & 15; pa[r] = *(const v4u*)(H + (size_t)(t0 + row) * INW + COL_Q + h * 256 + (dh_) * 128 + pc * 8); } \
            _Pragma("unroll") for (int r = 0; r < 4; ++r) { const int f = tq + 512 * r, row = f >> 4, pc = f & 15; \
                const float fac = exp2f(lg * ((dir_) == 0 ? (float)(row + 1) : (float)(128 - row))); float qf[8]; unpack8(pa[r], qf); \
                _Pragma("unroll") for (int k = 0; k < 8; ++k) qf[k] *= fac; \
                *(LAS v4u*)(RA + row * RS + pc * 8) = pack8(qf); } \
            _Pragma("unroll") for (int r = 0; r < 8; ++r) { const int f = tq + 512 * r, row = f >> 4, pc = f & 15; *(LAS v4u*)(RB + row * RS + pc * 8) = pb[r]; } } while (0)
        f32x4 S[4][2];
#pragma unroll
        for (int ti = 0; ti < 4; ++ti)
#pragma unroll
            for (int tj = 0; tj < 2; ++tj) S[ti][tj] = (f32x4){0.f, 0.f, 0.f, 0.f};
#pragma unroll
        for (int dh = 0; dh < 2; ++dh) {
            if (dh) __syncthreads();
            RO_STORE_QK();
            __syncthreads();
            if (dh == 0) RO_LOAD_QK(1); else RO_LOAD_V();
#pragma unroll
            for (int ks = 0; ks < 4; ++ks) {
                bf16x8 ka[2], qb[4];
#pragma unroll
                for (int tj = 0; tj < 2; ++tj) ka[tj] = *(const LAS bf16x8*)(RB + (32 * wj + 16 * tj + lr) * RS + 32 * ks + lq * 8);
#pragma unroll
                for (int ti = 0; ti < 4; ++ti) qb[ti] = *(const LAS bf16x8*)(RA + (64 * wi + 16 * ti + lr) * RS + 32 * ks + lq * 8);
#pragma unroll
                for (int ti = 0; ti < 4; ++ti)
#pragma unroll
                    for (int tj = 0; tj < 2; ++tj) S[ti][tj] = MFMA16(ka[tj], qb[ti], S[ti][tj]);
            }
        }
#pragma unroll
        for (int ti = 0; ti < 4; ++ti)
#pragma unroll
            for (int tj = 0; tj < 2; ++tj) {
                const int i = 64 * wi + 16 * ti + lr, j0 = 32 * wj + 16 * tj + 4 * lq; float p[4];
#pragma unroll
                for (int jj = 0; jj < 4; ++jj) { const int d = i - (j0 + jj); p[jj] = S[ti][tj][jj] * exp2f(lg * (float)(d < 0 ? -d : d)); }
                v2u w; w.x = pkbf(p[0], p[1]); w.y = pkbf(p[2], p[3]); *(LAS v2u*)(RC + i * RS + j0) = w;
            }
        __syncthreads();
        RO_STORE_V();
        __syncthreads();
        RO_LOAD_I(0, 0);
        f32x4 O[4][4];
#pragma unroll
        for (int ti = 0; ti < 4; ++ti)
#pragma unroll
            for (int te = 0; te < 4; ++te) O[ti][te] = (f32x4){0.f, 0.f, 0.f, 0.f};
#pragma unroll
        for (int ks = 0; ks < 4; ++ks) {
            bf16x8 va[4], pbf[4];
#pragma unroll
            for (int te = 0; te < 4; ++te) va[te] = *(const LAS bf16x8*)(RB + (64 * we + 16 * te + lr) * RS + 32 * ks + lq * 8);
#pragma unroll
            for (int ti = 0; ti < 4; ++ti) pbf[ti] = *(const LAS bf16x8*)(RC + (64 * wi + 16 * ti + lr) * RS + 32 * ks + lq * 8);
#pragma unroll
            for (int ti = 0; ti < 4; ++ti)
#pragma unroll
                for (int te = 0; te < 4; ++te) O[ti][te] = MFMA16(va[te], pbf[ti], O[ti][te]);
        }
#pragma unroll
        for (int stg = 0; stg < 4; ++stg) {
            __syncthreads();
            if (stg == 0) RO_STORE_I(0, 0); else if (stg == 1) RO_STORE_I(0, 1); else if (stg == 2) RO_STORE_I(1, 0); else RO_STORE_I(1, 1);
            __syncthreads();
            if (stg == 0) RO_LOAD_I(0, 1); else if (stg == 1) RO_LOAD_I(1, 0); else if (stg == 2) RO_LOAD_I(1, 1);
#pragma unroll
            for (int ks = 0; ks < 4; ++ks) {
                bf16x8 sa[4], qb[4];
#pragma unroll
                for (int te = 0; te < 4; ++te) sa[te] = *(const LAS bf16x8*)(RB + (64 * we + 16 * te + lr) * RS + 32 * ks + lq * 8);
#pragma unroll
                for (int ti = 0; ti < 4; ++ti) qb[ti] = *(const LAS bf16x8*)(RA + (64 * wi + 16 * ti + lr) * RS + 32 * ks + lq * 8);
#pragma unroll
                for (int ti = 0; ti < 4; ++ti)
#pragma unroll
                    for (int te = 0; te < 4; ++te) O[ti][te] = MFMA16(sa[te], qb[ti], O[ti][te]);
            }
        }
#undef RO_LOAD_QK
#undef RO_STORE_QK
#undef RO_LOAD_V
#undef RO_STORE_V
#undef RO_LOAD_I
#undef RO_STORE_I
        __syncthreads();
        v4u gq[8];
        { const int tq3 = opaque(tid);
#pragma unroll
          for (int r = 0; r < 8; ++r) { const int f = tq3 + 512 * r, row = f >> 5, pc = f & 31; gq[r] = *(const v4u*)(H + (size_t)(t0 + row) * INW + COL_G + h * 256 + pc * 8); } }
        { const int un = u + F.G; if (un < 1280) { const int tq4 = opaque(tid); RO_LOAD_QK_AT((un >> 2) * 128, un & 3, 0, tq4); } }
        LAS float* RED = (LAS float*)RA;
#pragma unroll
        for (int ti = 0; ti < 4; ++ti) { float s1 = 0.f, s2 = 0.f;
#pragma unroll
            for (int te = 0; te < 4; ++te)
#pragma unroll
                for (int jj = 0; jj < 4; ++jj) { const float v = O[ti][te][jj]; s1 += v; s2 += v * v; }
            s1 += __shfl_xor(s1, 16); s1 += __shfl_xor(s1, 32); s2 += __shfl_xor(s2, 16); s2 += __shfl_xor(s2, 32);
            if (lq == 0) { RED[((64 * wi + 16 * ti + lr) * 4 + we) * 2] = s1; RED[((64 * wi + 16 * ti + lr) * 4 + we) * 2 + 1] = s2; } }
        __syncthreads();
        LAS bf16* ON = RB;
#pragma unroll
        for (int ti = 0; ti < 4; ++ti) { const int i = 64 * wi + 16 * ti + lr;
            const f32x4 r0 = *(const LAS f32x4*)(RED + i * 8), r1 = *(const LAS f32x4*)(RED + i * 8 + 4);
            const float m = (r0[0] + r0[2] + r1[0] + r1[2]) * (1.0f / 256.0f), q = (r0[1] + r0[3] + r1[1] + r1[3]) * (1.0f / 256.0f);
            const float var = fmaxf(q - m * m, 0.f), rstd = 1.0f / sqrtf(var + GN_EPS);
#pragma unroll
            for (int te = 0; te < 4; ++te) { const int e0 = 64 * we + 16 * te + 4 * lq;
                v2u w; w.x = pkbf((O[ti][te][0] - m) * rstd, (O[ti][te][1] - m) * rstd); w.y = pkbf((O[ti][te][2] - m) * rstd, (O[ti][te][3] - m) * rstd);
                *(LAS v2u*)(ON + i * 264 + e0) = w; } }
        __syncthreads();
        {
            const int tq2 = opaque(tid);
#pragma unroll
            for (int r = 0; r < 8; ++r) { const int f = tq2 + 512 * r, row = f >> 5, pc = f & 31;
                float ov[8], gv[8]; unpack8(*(const LAS v4u*)(ON + row * 264 + pc * 8), ov); unpack8(gq[r], gv);
#pragma unroll
                for (int k = 0; k < 8; ++k) ov[k] = (gv[k] * __builtin_amdgcn_rcpf(1.0f + __expf(-gv[k]))) * ov[k];
                *(v4u*)(CC + (size_t)(t0 + row) * DM + 1024 + h * 256 + pc * 8) = pack8(ov); }
        }
        __syncthreads();
    }
}

__device__ __forceinline__ unsigned f2key(float f) { const unsigned u = __float_as_uint(f); return (u & 0x80000000u) ? ~u : (u | 0x80000000u); }
__device__ __forceinline__ float key2f(unsigned k) { const unsigned u = (k & 0x80000000u) ? (k & 0x7fffffffu) : ~k; return __uint_as_float(u); }
#define TK_CE(a, b) do { const unsigned hi_ = (a) > (b) ? (a) : (b), lo_ = (a) > (b) ? (b) : (a); (a) = hi_; (b) = lo_; } while (0)
__device__ __forceinline__ void bitonic_merge16(unsigned (&v)[16]) {
#pragma unroll
    for (int j = 8; j > 0; j >>= 1)
#pragma unroll
        for (int i = 0; i < 16; ++i) { const int l = i ^ j; if (l > i) TK_CE(v[i], v[l]); }
}
__device__ __forceinline__ void bitonic_sort16(unsigned (&v)[16]) {
#pragma unroll
    for (int k = 2; k <= 16; k <<= 1)
#pragma unroll
        for (int j = k >> 1; j > 0; j >>= 1)
#pragma unroll
            for (int i = 0; i < 16; ++i) { const int l = i ^ j; if (l > i) { if ((i & k) == 0) TK_CE(v[i], v[l]); else TK_CE(v[l], v[i]); } }
}
__device__ __forceinline__ void topk_phase(const Frame& F, CArgs& A) {
    const _Float16* SC = (const _Float16*)(F.ws + WS_H); int* IDX = (int*)(F.ws + WS_IDX); float* GATE = (float*)(F.ws + WS_GATE);
    typedef _Float16 h8 __attribute__((ext_vector_type(8)));
    LAS unsigned* LK = (LAS unsigned*)F.lds;
    const int tid = F.tid, tl = tid >> 4, hp = tid & 15;
    h8 cur[16];
    if (F.bx < NTOK / 32) { const _Float16* row = SC + (size_t)(F.bx * 32 + tl) * DM + hp * 128;
#pragma unroll
        for (int q = 0; q < 16; ++q) cur[q] = *(const h8*)(row + q * 8); }
    for (int blk = F.bx; blk < NTOK / 32; blk += F.G) {
        const int t = blk * 32 + tl;
        unsigned run[16];
#pragma unroll
        for (int k = 0; k < 16; ++k) run[k] = 0u;
#pragma unroll
        for (int c16 = 0; c16 < 8; ++c16) {
            unsigned ch[16];
#pragma unroll
            for (int q = 0; q < 2; ++q)
#pragma unroll
                for (int e = 0; e < 8; ++e) { const int n = c16 * 16 + q * 8 + e; ch[q * 8 + e] = (f2key((float)cur[c16 * 2 + q][e]) & ~127u) | (unsigned)(127 - n); }
            bitonic_sort16(ch);
#pragma unroll
            for (int i = 0; i < 16; ++i) run[i] = run[i] > ch[15 - i] ? run[i] : ch[15 - i];
            bitonic_merge16(run);
        }
        { const int bn = blk + F.G < NTOK / 32 ? blk + F.G : blk; const _Float16* rown = SC + (size_t)(bn * 32 + tl) * DM + hp * 128;
#pragma unroll
          for (int q = 0; q < 16; ++q) cur[q] = *(const h8*)(rown + q * 8); }
#pragma unroll
        for (int k = 0; k < 16; ++k) LK[tid * 17 + k] = run[k];
        __syncthreads();
        {
            const int odd = hp & 1, te = tid & ~1;
            const int la = (te + odd) * 17, lb = (te + 1 - odd) * 17;
            float a[16], b[16];
#pragma unroll
            for (int k = 0; k < 16; ++k) { a[k] = key2f(LK[la + k] & ~127u); b[k] = key2f(LK[lb + k] & ~127u); }
            unsigned sk[16];
#pragma unroll
            for (int k = 0; k < 16; ++k) sk[k] = 0u;
#define TK_INS(sum_, cell_) do { unsigned key = (f2key(sum_) & ~255u) | (unsigned)(255 - (cell_)); \
                _Pragma("unroll") for (int k = 0; k < 16; ++k) { const unsigned hi = sk[k] > key ? sk[k] : key, lo = sk[k] > key ? key : sk[k]; sk[k] = hi; key = lo; } } while (0)
#pragma unroll
            for (int i = 0; i < 16; ++i)
#pragma unroll
                for (int j = i + 1; j < 16; ++j) if ((i + 1) * (j + 1) <= 16) TK_INS(a[i] + b[j], odd ? j * 16 + i : i * 16 + j);
            {
                float a0 = a[0], a1 = a[1], a2 = a[2], a3 = a[3], b0 = b[0], b1 = b[1], b2 = b[2], b3 = b[3];
                asm("" : "+v"(a0)); asm("" : "+v"(a1)); asm("" : "+v"(a2)); asm("" : "+v"(a3)); asm("" : "+v"(b0)); asm("" : "+v"(b1)); asm("" : "+v"(b2)); asm("" : "+v"(b3));
                TK_INS((odd ? a2 : a0) + (odd ? b2 : b0), odd ? 2 * 17 : 0);
                TK_INS((odd ? a3 : a1) + (odd ? b3 : b1), odd ? 3 * 17 : 17);
            }
#undef TK_INS
#pragma unroll
            for (int k = 0; k < 16; ++k) { const unsigned o = (unsigned)__shfl_xor((int)sk[15 - k], 1); sk[k] = sk[k] > o ? sk[k] : o; }
            bitonic_merge16(sk);
            float e[16], sum = 0.f; const float s0 = key2f(sk[0] & ~255u);
#pragma unroll
            for (int k = 0; k < 16; ++k) { e[k] = __expf(key2f(sk[k] & ~255u) - s0); sum += e[k]; }
            const float inv = 1.0f / sum; const int head = hp >> 1;
#pragma unroll
            for (int kk = 0; kk < 8; ++kk) {
                unsigned klo = sk[kk], khi = sk[8 + kk]; float elo = e[kk], ehi = e[8 + kk];
                asm("" : "+v"(klo)); asm("" : "+v"(khi)); asm("" : "+v"(elo)); asm("" : "+v"(ehi));
                const unsigned key = odd ? khi : klo; const float ev = odd ? ehi : elo; const int k = odd * 8 + kk;
                const int cell = 255 - (int)(key & 255u);
                const int i1 = 127 - (int)(LK[te * 17 + (cell >> 4)] & 127u), i2 = 127 - (int)(LK[(te + 1) * 17 + (cell & 15)] & 127u);
                IDX[(size_t)t * 128 + head * 16 + k] = i1 * 128 + i2;
                GATE[(size_t)t * 128 + head * 16 + k] = ev * inv;
            }
        }
        __syncthreads();
    }
}
typedef int v8i __attribute__((ext_vector_type(8)));
__device__ __forceinline__ void peer_gather_phase(const Frame& F, CArgs& A, int l, float* xdst_base, bf16* XN) {
    constexpr int RB = DM / 2;
    constexpr int GNR = GATHER_ROWS;
    const unsigned char* U8 = F.ws + WS_U8 + (size_t)l * NEXP * RB; const unsigned char* V8 = F.ws + WS_V8 + (size_t)l * NEXP * RB;
    const float* USC = (const float*)(F.ws + WS_USC) + (size_t)l * NEXP; const float* VSC = (const float*)(F.ws + WS_VSC) + (size_t)l * NEXP;
    const int* IDX = (const int*)(F.ws + WS_IDX); const float* GATE = (const float*)(F.ws + WS_GATE);
    const float* g2 = GIN(A, I_LN2G) + (size_t)l * DM; const float* b2 = GIN(A, I_LN2B) + (size_t)l * DM;
    LAS unsigned char* XF8 = F.lds + F.wave * 2560;
    LAS float* HS = (LAS float*)(F.lds + F.wave * 2560 + 2048);
    const int lane = F.lane, lr = lane & 15, lq = lane >> 4;
    int nidx0 = 0, nidx1 = 0; float ngate0 = 0.f, ngate1 = 0.f;
    if (F.gw < NTOK) { nidx0 = IDX[(size_t)F.gw * 128 + lane]; nidx1 = IDX[(size_t)F.gw * 128 + 64 + lane]; ngate0 = GATE[(size_t)F.gw * 128 + lane]; ngate1 = GATE[(size_t)F.gw * 128 + 64 + lane]; }
    for (int t = F.gw; t < NTOK; t += F.NGW) {
        const bf16* xrow = XN + (size_t)t * DM;
        {
            v4u w0, w1;
#pragma unroll
            for (int j = 0; j < 8; ++j) { const v2u a = *(const v2u*)(xrow + j * 256 + lane * 4); int pk = 0;
                pk = __builtin_amdgcn_cvt_pk_fp8_f32(bf_lo(a.x), bf_hi(a.x), pk, false); pk = __builtin_amdgcn_cvt_pk_fp8_f32(bf_lo(a.y), bf_hi(a.y), pk, true);
                if (j < 4) w0[j] = (unsigned)pk; else w1[j - 4] = (unsigned)pk; }
            *(LAS v4u*)(XF8 + lane * 32) = w0; *(LAS v4u*)(XF8 + lane * 32 + 16) = w1;
        }
        const int idx0 = nidx0, idx1 = nidx1;
        const float gate0 = ngate0, gate1 = ngate1;
        const float usc0 = USC[idx0], usc1 = USC[idx1], vsc0 = VSC[idx0], vsc1 = VSC[idx1];
        unsigned rowoff[8];
#pragma unroll
        for (int g = 0; g < 8; ++g) rowoff[g] = (unsigned)__shfl((g >> 2) ? idx1 : idx0, (g & 3) * 16 + lr) * (unsigned)RB + (unsigned)lq * 16u;
        v4u AB[8][2];
#pragma unroll
        for (int g = 0; g < 8; ++g) { AB[g][0] = *(const v4u*)(U8 + rowoff[g]); AB[g][1] = *(const v4u*)(U8 + rowoff[g] + 64); }
        f32x4 hacc[8];
#pragma unroll
        for (int g = 0; g < 8; ++g) hacc[g] = (f32x4){0.f, 0.f, 0.f, 0.f};
        LDS_WAIT();
#pragma unroll 1
        for (int kp = 0; kp < 8; ++kp) {
            const LAS unsigned char* xq = XF8 + ((2 * kp) * 4 + (lq >> 1)) * 32 + 16 * (lq & 1);
            const v4u b00 = *(const LAS v4u*)xq, b01 = *(const LAS v4u*)(xq + 64), b10 = *(const LAS v4u*)(xq + 128), b11 = *(const LAS v4u*)(xq + 192);
            const v8i B0 = (v8i){(int)b00[0], (int)b00[1], (int)b00[2], (int)b00[3], (int)b01[0], (int)b01[1], (int)b01[2], (int)b01[3]};
            const v8i B1 = (v8i){(int)b10[0], (int)b10[1], (int)b10[2], (int)b10[3], (int)b11[0], (int)b11[1], (int)b11[2], (int)b11[3]};
#pragma unroll
            for (int g = 0; g < 8; ++g) {
                const v8i A0 = (v8i){(int)AB[g][0][0], (int)AB[g][0][1], (int)AB[g][0][2], (int)AB[g][0][3], 0, 0, 0, 0};
                const v8i A1 = (v8i){(int)AB[g][1][0], (int)AB[g][1][1], (int)AB[g][1][2], (int)AB[g][1][3], 0, 0, 0, 0};
                hacc[g] = __builtin_amdgcn_mfma_scale_f32_16x16x128_f8f6f4(A0, B0, hacc[g], 4, 0, 0, 0x7f7f7f7f, 0, 0x7f7f7f7f);
                hacc[g] = __builtin_amdgcn_mfma_scale_f32_16x16x128_f8f6f4(A1, B1, hacc[g], 4, 0, 0, 0x7f7f7f7f, 0, 0x7f7f7f7f);
                if (kp < 7) { AB[g][0] = *(const v4u*)(U8 + rowoff[g] + (kp + 1) * 128); AB[g][1] = *(const v4u*)(U8 + rowoff[g] + (kp + 1) * 128 + 64); }
            }
        }
        if (lr == 0) {
#pragma unroll
            for (int g = 0; g < 8; ++g) *(LAS f32x4*)(HS + g * 16 + 4 * lq) = hacc[g];
        }
        LDS_WAIT();
        const float hval0 = HS[lane], hval1 = HS[64 + lane];
        const float w0 = gate0 * gelu_erf(hval0 * usc0) * vsc0, w1 = gate1 * gelu_erf(hval1 * usc1) * vsc1;
        { const int tn = t + F.NGW, tp = tn < NTOK ? tn : t;
          nidx0 = IDX[(size_t)tp * 128 + lane]; nidx1 = IDX[(size_t)tp * 128 + 64 + lane]; ngate0 = GATE[(size_t)tp * 128 + lane]; ngate1 = GATE[(size_t)tp * 128 + 64 + lane]; }
        v4u BU[GNR];
        const unsigned loff = (unsigned)lane * 16u;
#define G_ROW_V(R) (V8 + (size_t)(unsigned)__builtin_amdgcn_readlane((((R) >> 6) & 1) ? idx1 : idx0, (R) & 63) * RB)
#define G_REQ(r, rowptr) do { BU[r] = *(const v4u*)((rowptr) + loff); } while (0)
#pragma unroll
        for (int r = 0; r < GNR; ++r) G_REQ(r, G_ROW_V(r));
        f32x2v acc[16];
#pragma unroll
        for (int k = 0; k < 16; ++k) acc[k] = (f32x2v){0.f, 0.f};
#define G_AXPY(r, R) do { const float w_ = __uint_as_float((unsigned)__builtin_amdgcn_readlane((int)__float_as_uint((((R) >> 6) & 1) ? w1 : w0), (R) & 63)); const f32x2v w2_ = (f32x2v){w_, w_}; \
            _Pragma("unroll") for (int q = 0; q < 4; ++q) { acc[4 * q] += w2_ * __builtin_amdgcn_cvt_scalef32_pk_f32_fp4(BU[r][q], 1.0f, 0); acc[4 * q + 1] += w2_ * __builtin_amdgcn_cvt_scalef32_pk_f32_fp4(BU[r][q], 1.0f, 1); \
                acc[4 * q + 2] += w2_ * __builtin_amdgcn_cvt_scalef32_pk_f32_fp4(BU[r][q], 1.0f, 2); acc[4 * q + 3] += w2_ * __builtin_amdgcn_cvt_scalef32_pk_f32_fp4(BU[r][q], 1.0f, 3); } } while (0)
        for (int it = 0; it < 128 / GNR - 1; ++it) {
#pragma unroll
            for (int r = 0; r < GNR; ++r) { G_AXPY(r, GNR * it + r); G_REQ(r, G_ROW_V(GNR * (it + 1) + r)); }
        }
#pragma unroll
        for (int r = 0; r < GNR; ++r) G_AXPY(r, 128 - GNR + r);
#undef G_ROW_V
#undef G_REQ
#undef G_AXPY
        const int le = opaque(lane);
        float s = 0.f;
#pragma unroll
        for (int j = 0; j < 8; ++j) { const v2u xr = *(const v2u*)(xrow + j * 256 + le * 4);
            acc[2 * j] = (f32x2v){bf_lo(xr.x), bf_hi(xr.x)} * ALPHA + acc[2 * j]; acc[2 * j + 1] = (f32x2v){bf_lo(xr.y), bf_hi(xr.y)} * ALPHA + acc[2 * j + 1];
            s += (acc[2 * j][0] + acc[2 * j][1]) + (acc[2 * j + 1][0] + acc[2 * j + 1][1]); }
        const float mean = wave_sum(s) * (1.0f / DM); float s2 = 0.f;
#pragma unroll
        for (int k = 0; k < 16; ++k) { acc[k] = acc[k] - mean; s2 += acc[k][0] * acc[k][0] + acc[k][1] * acc[k][1]; }
        const float rstd = 1.0f / sqrtf(wave_sum(s2) * (1.0f / DM) + LN_EPS);
        f32x4 gq[8], bq[8];
#pragma unroll
        for (int j = 0; j < 8; ++j) { gq[j] = *(const f32x4*)(g2 + j * 256 + le * 4); bq[j] = *(const f32x4*)(b2 + j * 256 + le * 4); }
#pragma unroll
        for (int j = 0; j < 8; ++j) { const int col = j * 256 + le * 4;
            const f32x4 gg = gq[j], bb = bq[j];
            const f32x2v a0 = acc[2 * j], a1 = acc[2 * j + 1];
            const f32x4 o = (f32x4){a0[0] * rstd * gg[0] + bb[0], a0[1] * rstd * gg[1] + bb[1], a1[0] * rstd * gg[2] + bb[2], a1[1] * rstd * gg[3] + bb[3]};
            if (xdst_base) *(f32x4*)(xdst_base + (size_t)t * DM + col) = o;
            v2u w; w.x = pkbf(o[0], o[1]); w.y = pkbf(o[2], o[3]); *(v2u*)(XN + (size_t)t * DM + col) = w; }
        LDS_WAIT();
    }
}

#ifndef DUP_MASK
#define DUP_MASK 0
#endif
#ifndef PHASE_TEST_ONLY
__global__ void __launch_bounds__(NTHR, 2) fwd_kernel(Args A) {
    extern __shared__ __attribute__((aligned(16))) unsigned char lds_raw[];
#define MKFRAME() Frame F; CArgs& KA = *(CArgs*)opaque_u64((unsigned long long)__builtin_amdgcn_kernarg_segment_ptr()); { F.lds = (LAS unsigned char*)lds_raw; F.tid = opaque((int)threadIdx.x); F.lane = F.tid & 63; F.wave = __builtin_amdgcn_readfirstlane(F.tid >> 6); \
        const int bx_ = opaque_s((int)blockIdx.x); F.G = gridDim.x; F.gw = bx_ * NWAVES + F.wave; F.NGW = F.G * NWAVES; F.gtid = (size_t)bx_ * NTHR + F.tid; F.NT = (size_t)F.G * NTHR; F.out = (float*)(float GAS*)opaque_g((unsigned char GAS*)KA.out); F.ws = (unsigned char*)opaque_g(KA.ws); F.bx = bx_; } \
        bf16* XN = (bf16*)(F.ws + WS_XN); bf16* H = (bf16*)(F.ws + WS_H); bf16* CC = (bf16*)(F.ws + WS_CONCAT); (void)XN; (void)H; (void)CC;
    volatile LAS unsigned* MISC = (volatile LAS unsigned*)((LAS unsigned char*)lds_raw + LDS_MISC);
    if (threadIdx.x < 64) MISC[threadIdx.x] = 0u;
    __syncthreads();
    XcdBarrier bar = xcd_barrier_post((unsigned*)(A.ws + WS_CTL) + CW_BAR + A.li * XCD_BAR_WORDS, MISC + 8);
    const int lo = A.ph_lo, hi = A.ph_hi;
#define IN(k) (lo <= (k) && (k) < hi)
#define SEAM(k) do { if (lo <= (k) && (k) + 1 < hi) xcd_barrier(bar); } while (0)

    if (IN(0)) { MKFRAME(); p0_prologue(F, KA); if (DUP_MASK & 256) { __syncthreads(); p0_prologue(F, KA); } } SEAM(0);

    for (int l = 0; l < NLAYER; ++l) {
        const int pb = 1 + l * 10;
        if (IN(pb + 0)) { MKFRAME();
            pg8::Gemm g{XN, (const bf16*)(F.ws + WS_WIN) + (size_t)l * INW * DM, NTOK, INW, DM}; pg8::StaticOrder S; S.init(NTOK, INW, F.G, F.bx);
            EpiStoreRot E{H, INW, (const float*)(F.ws + WS_ROTC), (const float*)(F.ws + WS_ROTS)};
            pg8::gemm_phase<EpiStoreRot, pg8::StaticOrder, GEMM_ALIGN, GEMM_SP2>(F.lds, g, S, E);
            if (DUP_MASK & 64) { pg8::gemm_phase<EpiStoreRot, pg8::StaticOrder, GEMM_ALIGN, GEMM_SP2>(F.lds, g, S, E); }
        } SEAM(pb + 0);
        if (IN(pb + 1)) { MKFRAME(); s5_pass1(F, KA, l); pool_phase(F, KA); if (DUP_MASK & 1) { s5_pass1(F, KA, l); } if (DUP_MASK & 2) { pool_phase(F, KA); } } SEAM(pb + 1);
        if (IN(pb + 2)) { MKFRAME(); s5_carry(F, KA, l); __syncthreads(); ret_state_phase(F, KA, (unsigned*)(F.ws + WS_CTL) + 64 + 16 * l); if (DUP_MASK & 4) { ret_state_phase(F, KA); } if (DUP_MASK & 2048) { ret_state_phase<1>(F, KA); } if (DUP_MASK & 4096) { ret_state_phase<2>(F, KA); ret_state_phase(F, KA); } } SEAM(pb + 2);
        if (IN(pb + 3)) { MKFRAME(); s5_pass3(F, KA, l); if (DUP_MASK & 8) { s5_pass3(F, KA, l); } ret_prefix_phase(F, KA); } SEAM(pb + 3);
        if (IN(pb + 4)) { MKFRAME();
            __syncthreads();
            ret_out_phase(F, KA);
            if (DUP_MASK & 16) { ret_out_phase(F, KA); }
            {
                pg8::Gemm g{(const bf16*)(F.ws + WS_BUFY), (const bf16*)(F.ws + WS_WGLU) + (size_t)l * 512 * 512, NTOK, 512, 512}; pg8::StaticOrder S; S.init(NTOK, 512, F.G, F.bx);
                EpiGlu E{(const bf16*)(F.ws + WS_BUFY), 512, CC, DM, GIN(KA, I_BGLU) + (size_t)l * 512};
                pg8::gemm_phase<EpiGlu, pg8::StaticOrder, GEMM_ALIGN, GEMM_SP2>(F.lds, g, S, E);
                if (DUP_MASK & 512) { pg8::gemm_phase<EpiGlu, pg8::StaticOrder, GEMM_ALIGN, GEMM_SP2>(F.lds, g, S, E); }
            }
        } SEAM(pb + 4);
        if (IN(pb + 5)) { MKFRAME();
            pg8::Gemm g{CC, (const bf16*)(F.ws + WS_WOUT) + (size_t)l * DM * DM, NTOK, DM, DM}; pg8::StaticOrder S; S.init(NTOK, DM, F.G, F.bx);
            EpiStoreBf16 E{H, DM};
            pg8::gemm_phase<EpiStoreBf16, pg8::StaticOrder, GEMM_ALIGN, GEMM_SP2>(F.lds, g, S, E);
        } SEAM(pb + 5);
        if (IN(pb + 6)) { MKFRAME();
            ln_rows2(XN, H, ALPHA, GIN(KA, I_LN1G) + (size_t)l * DM, GIN(KA, I_LN1B) + (size_t)l * DM, F.gw, F.NGW, F.lane);
        } SEAM(pb + 6);
        if (IN(pb + 7)) { MKFRAME();
            pg8::Gemm g{XN, (const bf16*)(F.ws + WS_WS) + (size_t)l * DM * DM, NTOK, DM, DM}; pg8::StaticOrder S; S.init(NTOK, DM, F.G, F.bx);
            EpiStoreF16 E{(_Float16*)(F.ws + WS_H), DM};
            pg8::gemm_phase<EpiStoreF16, pg8::StaticOrder, GEMM_ALIGN, GEMM_SP2>(F.lds, g, S, E);
            if (DUP_MASK & 128) { pg8::gemm_phase<EpiStoreF16, pg8::StaticOrder, GEMM_ALIGN, GEMM_SP2>(F.lds, g, S, E); }
        } SEAM(pb + 7);
        if (IN(pb + 8)) { MKFRAME(); __syncthreads(); topk_phase(F, KA); if (DUP_MASK & 32) { topk_phase(F, KA); } } SEAM(pb + 8);
        if (IN(pb + 9)) { MKFRAME(); if (DUP_MASK & 1024) { peer_gather_phase(F, KA, l, (float*)(F.ws + WS_H), CC); } peer_gather_phase(F, KA, l, l == NLAYER - 1 ? F.out : (float*)nullptr, XN); } SEAM(pb + 9);
    }
#undef IN
#undef SEAM
}


#ifndef DBG_STOP
#define DBG_STOP NPHASE
#endif
#ifndef MK_ONE_LAUNCH
#define MK_ONE_LAUNCH 0
#endif
extern "C" void kernel_launch(void* const* d_in, const int* in_sizes, int n_in, void* d_out, int out_size, void* d_ws, size_t ws_size, hipStream_t stream) {
    static int grid = 0;
    if (grid == 0) {
        if (n_in != 26 || out_size != NTOK * DM || ws_size < WS_END) { fprintf(stderr, "kernel_launch: unexpected shapes (n_in %d out %d ws %zu)\n", n_in, out_size, ws_size); grid = -1; return; }
        int dev = 0, cus = 0, per_cu = 0;
        if (hipGetDevice(&dev) != hipSuccess || hipDeviceGetAttribute(&cus, hipDeviceAttributeMultiprocessorCount, dev) != hipSuccess) { grid = -1; return; }
        if (hipFuncSetAttribute((const void*)fwd_kernel, hipFuncAttributeMaxDynamicSharedMemorySize, LDS_BYTES) != hipSuccess) { fprintf(stderr, "kernel_launch: hipFuncSetAttribute failed\n"); grid = -1; return; }
        if (hipOccupancyMaxActiveBlocksPerMultiprocessor(&per_cu, (const void*)fwd_kernel, NTHR, LDS_BYTES) != hipSuccess || per_cu < 1) { fprintf(stderr, "kernel_launch: occupancy query says %d\n", per_cu); grid = -1; (void)hipGetLastError(); return; }
        (void)hipGetLastError();
        grid = cus;
    }
    if (grid < 0) return;
    if (hipMemsetAsync((char*)d_ws + WS_CTL, 0, CTL_ZERO_BYTES, stream) != hipSuccess) return;
    Args a{};
    for (int i = 0; i < 26; ++i) a.in[i] = (const float*)d_in[i];
    a.out = (float*)d_out; a.ws = (unsigned char*)d_ws; a.pad = 0;
#if MK_ONE_LAUNCH
    a.ph_lo = 0; a.ph_hi = NPHASE; a.li = 0;
    hipLaunchKernelGGL(fwd_kernel, dim3(grid), dim3(NTHR), LDS_BYTES, stream, a);
#else
    for (int p = 0; p < DBG_STOP; ++p) { a.ph_lo = p; a.ph_hi = p + 1; a.li = p; hipLaunchKernelGGL(fwd_kernel, dim3(grid), dim3(NTHR), LDS_BYTES, stream, a); }
#endif
}
#endif
```
